# Optimizing an MI355X kernel written in HIP

```python
import math
import jax, jax.numpy as jnp
from jax import lax
import numpy as np

D_MODEL = 1024
BATCH = 4
SEQ = 8192
DEPTH = 4

HEAD_DIM = 64
ATTN_SCALE = HEAD_DIM ** -0.5
Q_BLOCK = 128
A_HEADS = 8
A_LATENT = 128
IDX_HEADS = 4
IDX_DIM = 64
IDX_TOPK_MAX = 256
B_HEADS = 8
MOBA_BLOCK = 256
MOBA_TOPK = 3
C_HEADS = 16
EVEN_SPLITS = (A_HEADS * HEAD_DIM, A_LATENT, IDX_HEADS * IDX_DIM, IDX_DIM, IDX_HEADS, B_HEADS * HEAD_DIM, B_HEADS * HEAD_DIM, B_HEADS * HEAD_DIM)
EVEN_IN = sum(EVEN_SPLITS)
ODD_SPLITS = (C_HEADS * HEAD_DIM, C_HEADS * HEAD_DIM, C_HEADS * HEAD_DIM, C_HEADS)
ODD_IN = sum(ODD_SPLITS)
NUM_BUCKETS = 32
MAX_EXACT = NUM_BUCKETS // 2
MAX_DISTANCE = 1024
N_EXPERTS = 32
TOP_K = 4
D_FF = 1024
SWIGLU_LIMIT = 7.0
SWIGLU_ALPHA = 1.702
ROW_BLOCK = 128
NORM_EPS = 1e-5
DEEPNORM_ALPHA = (2 * DEPTH) ** 0.25
DEEPNORM_BETA = (8 * DEPTH) ** -0.25
N_EVEN = (DEPTH + 1) // 2
N_ODD = DEPTH // 2

kernel_name = 'hybrid_dsa_moba_fox_moe_deepnorm'


def split_cols(h, sizes):
    return jnp.split(h, np.cumsum(sizes)[:-1].tolist(), axis=-1)


def to_heads(t, n):
    return t.reshape(t.shape[0], t.shape[1], n, -1)


def layer_norm(x, g, b):
    xf = x.astype(jnp.float32)
    mu = jnp.mean(xf, -1, keepdims=True)
    var = jnp.mean(jnp.square(xf - mu), -1, keepdims=True)
    y = (xf - mu) * lax.rsqrt(var + NORM_EPS)
    return (y * g.astype(jnp.float32) + b.astype(jnp.float32)).astype(x.dtype)


def rms_norm(x, g):
    xf = x.astype(jnp.float32)
    y = xf * lax.rsqrt(jnp.mean(jnp.square(xf), -1, keepdims=True) + NORM_EPS)
    return (y * g.astype(jnp.float32)).astype(x.dtype)


def rel_bucket(dist):
    n = jnp.maximum(dist, 0)
    nf = jnp.maximum(n, MAX_EXACT).astype(jnp.float32)
    log_b = MAX_EXACT + (jnp.log(nf / MAX_EXACT) / math.log(MAX_DISTANCE / MAX_EXACT) * (NUM_BUCKETS - MAX_EXACT)).astype(jnp.int32)
    return jnp.where(n < MAX_EXACT, n, jnp.minimum(log_b, NUM_BUCKETS - 1))


def query_blocks(fn, n_batch, T):
    out = lax.map(fn, jnp.arange(T // Q_BLOCK))
    return jnp.moveaxis(out, 0, 1).reshape(n_batch, T, -1)


def dsa_attention(q, c_kv, q_idx, k_idx, w_idx, w_uk, w_uv, bias_tab):
    n_batch, T = q.shape[0], q.shape[1]
    topk = min(IDX_TOPK_MAX, T // 4)
    q_lat = jnp.einsum('bthd,hdc->bthc', q, w_uk)
    pos = jnp.arange(T)
    b_ix = jnp.arange(n_batch)[:, None, None]

    def block(i):
        s0 = i * Q_BLOCK
        tq = s0 + jnp.arange(Q_BLOCK)
        ql = lax.dynamic_slice_in_dim(q_lat, s0, Q_BLOCK, axis=1)
        qi = lax.dynamic_slice_in_dim(q_idx, s0, Q_BLOCK, axis=1)
        wi = lax.dynamic_slice_in_dim(w_idx, s0, Q_BLOCK, axis=1)
        rel = jax.nn.relu(jnp.einsum('bqjd,bsd->bqjs', qi, k_idx))
        score = jnp.einsum('bqj,bqjs->bqs', wi, rel).astype(jnp.float32)
        score = jnp.where(pos[None, None, :] <= tq[None, :, None], score, -jnp.inf)
        _, sel = lax.top_k(score, topk)
        c_sel = c_kv[b_ix, sel]
        logits = jnp.einsum('bqhc,bqkc->bqhk', ql, c_sel).astype(jnp.float32) * ATTN_SCALE
        dist = tq[None, :, None] - sel
        bias = jnp.swapaxes(bias_tab[rel_bucket(dist)], -1, -2).astype(jnp.float32)
        logits = jnp.where((dist >= 0)[:, :, None, :], logits + bias, -jnp.inf)
        p = jax.nn.softmax(logits, axis=-1).astype(c_sel.dtype)
        o_lat = jnp.einsum('bqhk,bqkc->bqhc', p, c_sel)
        return jnp.einsum('bqhc,hcd->bqhd', o_lat, w_uv)

    return query_blocks(block, n_batch, T)


def moba_attention(q, k, v, bias_tab):
    n_batch, T, H, dh = q.shape
    nb = -(-T // MOBA_BLOCK)
    pad = nb * MOBA_BLOCK - T
    kp = jnp.pad(k, ((0, 0), (0, pad), (0, 0), (0, 0)))
    vp = jnp.pad(v, ((0, 0), (0, pad), (0, 0), (0, 0)))
    kbh = kp.reshape(n_batch, nb, MOBA_BLOCK, H, dh).transpose(0, 3, 1, 2, 4)
    vbh = vp.reshape(n_batch, nb, MOBA_BLOCK, H, dh).transpose(0, 3, 1, 2, 4)
    kbar = jnp.mean(kbh.astype(jnp.float32), axis=3).astype(k.dtype)
    ksel = min(MOBA_TOPK, nb)
    b_ix = jnp.arange(n_batch)[:, None, None]
    h_ix = jnp.arange(H)[None, None, :]
    offs = jnp.arange(MOBA_BLOCK)

    def block(i):
        s0 = i * Q_BLOCK
        tq = s0 + jnp.arange(Q_BLOCK)
        own = s0 // MOBA_BLOCK
        qc = lax.dynamic_slice_in_dim(q, s0, Q_BLOCK, axis=1)
        gate = jnp.einsum('bqhd,bhnd->bqhn', qc, kbar).astype(jnp.float32)
        gate = jnp.where(jnp.arange(nb) < own, gate, -jnp.inf)
        _, sel = lax.top_k(gate, ksel)
        blks = [sel[..., j] for j in range(ksel)]
        parts = []
        for j, blk in enumerate(blks):
            kj = kbh[b_ix, h_ix, blk]
            sj = jnp.einsum('bqhd,bqhkd->bqhk', qc, kj).astype(jnp.float32) * ATTN_SCALE
            bucket = rel_bucket(tq[None, :, None, None] - (blk[..., None] * MOBA_BLOCK + offs))
            sj = sj + bias_tab[bucket, h_ix[..., None]].astype(jnp.float32)
            parts.append(jnp.where(j < own, sj, -jnp.inf))
        start = own * MOBA_BLOCK
        ko = lax.dynamic_slice_in_dim(kp, start, MOBA_BLOCK, axis=1)
        vo = lax.dynamic_slice_in_dim(vp, start, MOBA_BLOCK, axis=1)
        dist_o = tq[:, None] - (start + offs)[None, :]
        so = jnp.einsum('bqhd,bkhd->bqhk', qc, ko).astype(jnp.float32) * ATTN_SCALE
        so = so + jnp.swapaxes(bias_tab[rel_bucket(dist_o)], -1, -2).astype(jnp.float32)
        parts.append(jnp.where((dist_o >= 0)[:, None, :], so, -jnp.inf))
        p = jax.nn.softmax(jnp.concatenate(parts, axis=-1), axis=-1).astype(v.dtype)
        out = jnp.einsum('bqhk,bkhd->bqhd', p[..., ksel * MOBA_BLOCK:], vo)
        for j, blk in enumerate(blks):
            pj = p[..., j * MOBA_BLOCK:(j + 1) * MOBA_BLOCK]
            out = out + jnp.einsum('bqhk,bqhkd->bqhd', pj, vbh[b_ix, h_ix, blk])
        return out

    return query_blocks(block, n_batch, T)


def fox_attention(q, k, v, f_logit):
    n_batch, T = q.shape[0], q.shape[1]
    cum = jnp.cumsum(jax.nn.log_sigmoid(f_logit.astype(jnp.float32)), axis=1)
    cum_s = jnp.swapaxes(cum, 1, 2)[:, None]
    pos = jnp.arange(T)

    def block(i):
        s0 = i * Q_BLOCK
        tq = s0 + jnp.arange(Q_BLOCK)
        qc = lax.dynamic_slice_in_dim(q, s0, Q_BLOCK, axis=1)
        cq = lax.dynamic_slice_in_dim(cum, s0, Q_BLOCK, axis=1)
        logits = jnp.einsum('bqhd,bshd->bqhs', qc, k).astype(jnp.float32) * ATTN_SCALE + (cq[..., None] - cum_s)
        logits = jnp.where((pos[None, :] <= tq[:, None])[:, None, :], logits, -jnp.inf)
        p = jax.nn.softmax(logits, axis=-1).astype(v.dtype)
        return jnp.einsum('bqhs,bshd->bqhd', p, v)

    return query_blocks(block, n_batch, T)


def even_mixer(x, w_in, w_uk, w_uv, kv_g, w_out, rel_bias):
    qa, ckv, qi, ki, wi, qb, kb, vb = split_cols(x @ w_in, EVEN_SPLITS)
    oa = dsa_attention(to_heads(qa, A_HEADS), rms_norm(ckv, kv_g), to_heads(qi, IDX_HEADS), ki, wi,
                       w_uk, w_uv, rel_bias[:, :A_HEADS])
    ob = moba_attention(to_heads(qb, B_HEADS), to_heads(kb, B_HEADS), to_heads(vb, B_HEADS),
                        rel_bias[:, A_HEADS:])
    return jnp.concatenate([oa, ob], axis=-1) @ w_out


def odd_mixer(x, w_in, b_f, w_out):
    q, k, v, fz = split_cols(x @ w_in, ODD_SPLITS)
    o = fox_attention(to_heads(q, C_HEADS), to_heads(k, C_HEADS), to_heads(v, C_HEADS), fz + b_f)
    return o @ w_out


def moe(x, router_w, router_b, w_gu, b_gu, w_down, b_down):
    n_batch, T, D = x.shape
    N = n_batch * T
    xf = x.reshape(N, D)
    logits = (xf @ router_w + router_b).astype(jnp.float32)
    top_logit, top_e = lax.top_k(logits, TOP_K)
    gates = jax.nn.softmax(top_logit, axis=-1)
    flat_e = top_e.reshape(-1)
    flat_tok = jnp.repeat(jnp.arange(N), TOP_K)
    flat_g = gates.reshape(-1)
    order = jnp.argsort(flat_e)
    se = flat_e[order]
    counts = jnp.bincount(flat_e, length=N_EXPERTS)
    padded = (counts + ROW_BLOCK - 1) // ROW_BLOCK * ROW_BLOCK
    start = jnp.cumsum(counts) - counts
    pend = jnp.cumsum(padded)
    pstart = pend - padded
    dest = pstart[se] + (jnp.arange(N * TOP_K) - start[se])
    n_blocks = -(-(N * TOP_K) // ROW_BLOCK) + N_EXPERTS
    n_rows = n_blocks * ROW_BLOCK
    row_tok = jnp.zeros((n_rows,), jnp.int32).at[dest].set(flat_tok[order])
    row_gate = jnp.zeros((n_rows,), jnp.float32).at[dest].set(flat_g[order])
    block_e = jnp.minimum(jnp.searchsorted(pend, jnp.arange(n_blocks) * ROW_BLOCK, side='right'), N_EXPERTS - 1)

    def expert_rows(args):
        tok, e = args
        h = xf[tok] @ w_gu[e] + b_gu[e]
        g, u = jnp.split(h, 2, axis=-1)
        g = jnp.minimum(g, SWIGLU_LIMIT)
        u = jnp.clip(u, -SWIGLU_LIMIT, SWIGLU_LIMIT)
        act = (u + 1.0) * g * jax.nn.sigmoid(SWIGLU_ALPHA * g)
        return act @ w_down[e] + b_down[e]

    y_rows = lax.map(expert_rows, (row_tok.reshape(n_blocks, ROW_BLOCK), block_e)).reshape(n_rows, D)
    y_rows = y_rows * row_gate[:, None].astype(y_rows.dtype)
    y = jax.ops.segment_sum(y_rows, row_tok, num_segments=N)
    return y.reshape(n_batch, T, D)


def setup_inputs(seed: int = 0) -> dict:
    key = jax.random.key(seed)
    ks = jax.random.split(key, 18)

    def nrm(k, shape, s):
        return jax.random.normal(k, shape, jnp.float32) * s

    return {
        'x': nrm(ks[0], (BATCH, SEQ, D_MODEL), 1.0),
        'even_w_in': nrm(ks[1], (N_EVEN, D_MODEL, EVEN_IN), D_MODEL ** -0.5),
        'even_w_uk': nrm(ks[2], (N_EVEN, A_HEADS, HEAD_DIM, A_LATENT), A_LATENT ** -0.5),
        'even_w_uv': nrm(ks[3], (N_EVEN, A_HEADS, A_LATENT, HEAD_DIM), A_LATENT ** -0.5),
        'even_kv_g': 1.0 + nrm(ks[4], (N_EVEN, A_LATENT), 0.02),
        'even_w_out': nrm(ks[5], (N_EVEN, D_MODEL, D_MODEL), D_MODEL ** -0.5 * DEEPNORM_BETA),
        'odd_w_in': nrm(ks[6], (N_ODD, D_MODEL, ODD_IN), D_MODEL ** -0.5),
        'odd_b_f': 2.0 + nrm(ks[7], (N_ODD, C_HEADS), 0.5),
        'odd_w_out': nrm(ks[8], (N_ODD, D_MODEL, D_MODEL), D_MODEL ** -0.5 * DEEPNORM_BETA),
        'rel_bias': nrm(ks[9], (NUM_BUCKETS, A_HEADS + B_HEADS), 0.1),
        'ln_g': 1.0 + nrm(ks[10], (DEPTH, 2, D_MODEL), 0.02),
        'ln_b': nrm(ks[11], (DEPTH, 2, D_MODEL), 0.02),
        'router_w': nrm(ks[12], (DEPTH, D_MODEL, N_EXPERTS), D_MODEL ** -0.5),
        'router_b': nrm(ks[13], (DEPTH, N_EXPERTS), 0.01),
        'exp_w_gu': nrm(ks[14], (DEPTH, N_EXPERTS, D_MODEL, 2 * D_FF), D_MODEL ** -0.5),
        'exp_b_gu': nrm(ks[15], (DEPTH, N_EXPERTS, 2 * D_FF), 0.02),
        'exp_w_down': nrm(ks[16], (DEPTH, N_EXPERTS, D_FF, D_MODEL), D_FF ** -0.5 * DEEPNORM_BETA),
        'exp_b_down': nrm(ks[17], (DEPTH, N_EXPERTS, D_MODEL), 0.02),
    }


def reference(x, even_w_in, even_w_uk, even_w_uv, even_kv_g, even_w_out, odd_w_in, odd_b_f, odd_w_out,
              rel_bias, ln_g, ln_b, router_w, router_b, exp_w_gu, exp_b_gu, exp_w_down, exp_b_down):
    for layer in range(DEPTH):
        j = layer // 2
        if layer % 2 == 0:
            m = even_mixer(x, even_w_in[j], even_w_uk[j], even_w_uv[j], even_kv_g[j], even_w_out[j], rel_bias)
        else:
            m = odd_mixer(x, odd_w_in[j], odd_b_f[j], odd_w_out[j])
        x = layer_norm(DEEPNORM_ALPHA * x + m, ln_g[layer, 0], ln_b[layer, 0])
        f = moe(x, router_w[layer], router_b[layer], exp_w_gu[layer], exp_b_gu[layer],
                exp_w_down[layer], exp_b_down[layer])
        x = layer_norm(DEEPNORM_ALPHA * x + f, ln_g[layer, 1], ln_b[layer, 1])
    return x
```

```cpp
#include <hip/hip_runtime.h>
#include <cstdio>
#include <cstdint>
#ifdef EXP_SKIP
#define EXPF EXP_SKIP
#else
#define EXPF 0
#endif
constexpr int NB = 4, SEQ = 8192, DM = 1024, NTOK = NB * SEQ, DEPTH = 4;
constexpr int EV_N = 2560, OD_N = 3072;
constexpr int EC_QA = 0, EC_QB = 512, EC_KB = 1024, EC_VB = 1536, EC_CKV = 2048, EC_QI = 2176, EC_KI = 2432, EC_WI = 2496;
constexpr int OC_Q = 0, OC_K = 1024, OC_V = 2048;
constexpr float LOG2E = 1.4426950408889634f;
constexpr float C2F = 0.125f * LOG2E;
constexpr float ALPHA = 1.681792830507429f;
constexpr float LN_EPS = 1e-5f;
constexpr int NR_MAX = 131072 + 32 * 256;
constexpr int NWAVES = 8, NTHR = 512;
constexpr size_t MiB = (size_t)1 << 20;
constexpr size_t WS_CTL = 0, CTL_ZERO_BYTES = 4 * MiB;
constexpr size_t WS_WEV = 8 * MiB, WS_WOD = 18 * MiB, WS_WOUT = 30 * MiB, WS_WUKT = 38 * MiB, WS_WUVT = 39 * MiB;
constexpr size_t WS_WGU = 40 * MiB, WS_WDN = 552 * MiB;
constexpr size_t WS_X = 808 * MiB, WS_X1 = 936 * MiB, WS_YP = 1064 * MiB, WS_XB = 1192 * MiB;
constexpr size_t WS_PROJ = 1256 * MiB, WS_AO = 1448 * MiB, WS_XG = 1512 * MiB, WS_ACT = 1784 * MiB;
constexpr size_t WS_QL = 2056 * MiB, WS_OL = 2120 * MiB, WS_CKVN = 2184 * MiB, WS_SEL = 2192 * MiB;
constexpr size_t WS_KBAR = 2208 * MiB, WS_SEL3 = 2209 * MiB, WS_LOGF = 2210 * MiB, WS_CS = 2212 * MiB;
constexpr size_t WS_TOPE = 2213 * MiB, WS_GATE = 2214 * MiB, WS_RANK = 2215 * MiB, WS_DEST = 2216 * MiB, WS_PML = 2217 * MiB;
constexpr size_t WS_END = 2226 * MiB;
constexpr int CW_BAR = 4096, CW_Q = 8192, CW_KMAX = 12288, CW_CNT = 16384, CW_TILE = 32768;

#define GAS __attribute__((address_space(1)))
#define LAS __attribute__((address_space(3)))
#define DI __device__ __forceinline__
typedef unsigned short bf16;
typedef unsigned v4u __attribute__((ext_vector_type(4)));
typedef unsigned v2u __attribute__((ext_vector_type(2)));
typedef float f32x4 __attribute__((ext_vector_type(4)));
typedef float f32x2 __attribute__((ext_vector_type(2)));
typedef float f32x16 __attribute__((ext_vector_type(16)));
typedef short bf16x8 __attribute__((ext_vector_type(8)));
typedef short s16x4 __attribute__((ext_vector_type(4)));
typedef __bf16 bf16x2_t __attribute__((ext_vector_type(2)));
typedef GAS unsigned gu32;
#define RLX_AGENT __ATOMIC_RELAXED, __HIP_MEMORY_SCOPE_AGENT
#define LDS_WAIT() asm volatile("s_waitcnt lgkmcnt(0)" ::: "memory")

DI float bf2f(unsigned v) { return __uint_as_float(v << 16); }
DI unsigned cvtpk(float lo, float hi) { f32x2 v = {lo, hi}; bf16x2_t b = __builtin_convertvector(v, bf16x2_t); return __builtin_bit_cast(unsigned, b); }
DI unsigned f2bf(float f) { return cvtpk(f, 0.f) & 0xffffu; }
DI float ex2(float x) { return __builtin_amdgcn_exp2f(x); }
DI float wave_sum(float v) {
#pragma unroll
    for (int o = 1; o < 64; o <<= 1) v += __shfl_xor(v, o);
    return v;
}
DI float wave_max(float v) {
#pragma unroll
    for (int o = 1; o < 64; o <<= 1) v = fmaxf(v, __shfl_xor(v, o));
    return v;
}
DI unsigned ld_u32(const unsigned* p) { return __hip_atomic_load(p, RLX_AGENT); }
DI int crow(int r, int hi) { return (r & 3) + 8 * (r >> 2) + 4 * hi; }
DI f32x16 mfma32(bf16x8 a, bf16x8 b, f32x16 c) { return __builtin_amdgcn_mfma_f32_32x32x16_bf16(a, b, c, 0, 0, 0); }
DI f32x4 mfma16(bf16x8 a, bf16x8 b, f32x4 c) { return __builtin_amdgcn_mfma_f32_16x16x32_bf16(a, b, c, 0, 0, 0); }
typedef short v4i16_t __attribute__((ext_vector_type(4)));
DI s16x4 vtr(LAS const char* p) { return __builtin_bit_cast(s16x4, __builtin_amdgcn_ds_read_tr16_b64_v4i16((LAS v4i16_t*)p)); }
DI bf16x8 cat8(s16x4 a, s16x4 b) { return (bf16x8){a[0], a[1], a[2], a[3], b[0], b[1], b[2], b[3]}; }
DI int t5_bucket(int n) {
    if (n < 16) return n;
    int bkt = 16;
    bkt += (n >= 21); bkt += (n >= 27); bkt += (n >= 35); bkt += (n >= 46); bkt += (n >= 59); bkt += (n >= 77); bkt += (n >= 99); bkt += (n >= 128);
    bkt += (n >= 166); bkt += (n >= 216); bkt += (n >= 280); bkt += (n >= 363); bkt += (n >= 470); bkt += (n >= 609); bkt += (n >= 790);
    return bkt;
}
namespace pg8 {
#define PG8_LAS __attribute__((address_space(3)))
typedef unsigned short bf16_t;
typedef short bf16x8 __attribute__((ext_vector_type(8)));
typedef float f32x4 __attribute__((ext_vector_type(4)));
typedef unsigned u32x4 __attribute__((ext_vector_type(4)));
constexpr int BM = 256, BK = 64, HALF = 128, HTB = HALF * BK * 2  , STAGE_BYTES = 8 * HTB, NXCD = 8, WGM = 8;

__host__ __device__ __forceinline__ int lds_byte(int r, int c) { const int st = (r >> 4) * 2 + (c >> 5), rr = r & 15, cc = c & 31, ob = rr * 64 + cc * 2; return st * 1024 + (ob ^ (((ob >> 9) & 1) << 5)); }
__host__ __device__ __forceinline__ void stage_rc(int b, int& R, int& C) { const int st = b / 1024, sb = b % 1024, swz = sb ^ (((sb >> 9) & 1) << 5); R = (st >> 1) * 16 + swz / 64; C = (st & 1) * 32 + (swz % 64) / 2; }
__host__ __device__ __forceinline__ int perm32(int rho) { const int n = rho >> 4, i = rho & 15; return 8 * (i >> 2) + 4 * n + (i & 3); }

struct Unit { int pm, pn; };
struct Gemm { const bf16_t* A; const bf16_t* Bt; int M, N, K; };

struct StaticOrder {
    int nM, nN, nwg, G, c;
    __host__ __device__ void init(int M, int N, int G_, int c_) { nM = M / BM; nN = N / BM; nwg = nM * nN; G = G_; c = c_; }
    __host__ __device__ bool next(int i, Unit& u) const {
        const long L = (long)i * G + c; if (L >= nwg) return false;
        int wgid = (int)L; { const int q = nwg / NXCD, r = nwg % NXCD, xcd = wgid % NXCD, off = wgid / NXCD; wgid = (xcd < r ? xcd * (q + 1) : r * (q + 1) + (xcd - r) * q) + off; }
        const int nig = WGM * nN, gid = wgid / nig, fm = gid * WGM, gsz = (nM - fm) < WGM ? (nM - fm) : WGM;
        u.pm = fm + ((wgid % nig) % gsz); u.pn = (wgid % nig) / gsz; return true;
    }
    __device__ __forceinline__ void a_ready(const Unit&) const {}
    __device__ __forceinline__ void done(const Unit&) const {}
};

__device__ __forceinline__ unsigned cvt_pk_bf16(float lo, float hi) { unsigned r; asm volatile("v_cvt_pk_bf16_f32 %0, %1, %2" : "=v"(r) : "v"(lo), "v"(hi)); return r; }
typedef float f32x2 __attribute__((ext_vector_type(2)));
__device__ __forceinline__ f32x2 gelu_pk(f32x2 v) {
    const f32x2 av = __builtin_elementwise_abs(v), d = av * 0.2316418882f + 1.0f;
    f32x2 t; t.x = __builtin_amdgcn_rcpf(d.x); t.y = __builtin_amdgcn_rcpf(d.y);
    f32x2 q = t * 0.5307027145f + (-0.7265760135f); q = q * t + 0.7107068705f; q = q * t + (-0.142248368f); q = q * t + 0.127414796f; q = q * t;
    const f32x2 s = (v * v) * (-0.72134752044f);
    f32x2 e; e.x = __builtin_amdgcn_exp2f(s.x); e.y = __builtin_amdgcn_exp2f(s.y);
    const f32x2 m = v * (q * e), r = v - m;
    f32x2 o; o.x = v.x < 0.f ? m.x : r.x; o.y = v.y < 0.f ? m.y : r.y; return o;
}

template <int ACT  > struct EpiBf16 {
    static constexpr bool PERM = true, AFTER_DRAIN = false; static_assert(ACT == 0 || ACT == 1, "EpiBf16: ACT is 0 (none) or 1 (gelu_pk)");
    bf16_t* O; int ldc; const float* bias; int split_cols; size_t split_stride; float scale0;
    __device__ __forceinline__ void operator()(const f32x4 (&acc)[2][2][4][2], const Unit& u, int wr, int wc, int fr, int fq) const {
        const int row0 = u.pm * BM + wr * 64 + fr; int colt = u.pn * BM; bf16_t* base = O;
        float sc = 1.f; if (split_cols) { const int t = colt / split_cols; base += (size_t)t * split_stride; colt -= t * split_cols; if (t == 0) sc = scale0; }
        const int col0 = colt + wc * 32 + 8 * fq, bcol0 = u.pn * BM + wc * 32 + 8 * fq;
        f32x4 bv[2][2];
#pragma unroll
        for (int bj = 0; bj < 2; ++bj)
#pragma unroll
            for (int n = 0; n < 2; ++n) bv[bj][n] = bias ? *(const f32x4*)(bias + bcol0 + bj * HALF + 4 * n) : (f32x4){0.f, 0.f, 0.f, 0.f};
#pragma unroll
        for (int ai = 0; ai < 2; ++ai)
#pragma unroll
            for (int m = 0; m < 4; ++m) { bf16_t* rowp = base + (size_t)(row0 + ai * HALF + m * 16) * ldc + col0;
#pragma unroll
                for (int bj = 0; bj < 2; ++bj) { f32x4 v0 = acc[ai][bj][m][0] + bv[bj][0], v1 = acc[ai][bj][m][1] + bv[bj][1];
                    if (ACT == 1) { f32x2 a = gelu_pk((f32x2){v0[0], v0[1]}), b = gelu_pk((f32x2){v0[2], v0[3]}), c = gelu_pk((f32x2){v1[0], v1[1]}), d = gelu_pk((f32x2){v1[2], v1[3]});
                        v0 = (f32x4){a.x, a.y, b.x, b.y}; v1 = (f32x4){c.x, c.y, d.x, d.y}; }
                    v0 = v0 * sc; v1 = v1 * sc; u32x4 w; w.x = cvt_pk_bf16(v0[0], v0[1]); w.y = cvt_pk_bf16(v0[2], v0[3]); w.z = cvt_pk_bf16(v1[0], v1[1]); w.w = cvt_pk_bf16(v1[2], v1[3]);
                    *(u32x4*)(rowp + bj * HALF) = w; } }
    }
};

template <class Epi, class Sched, bool ALIGN_EPI = false, bool SP2 = false>
__device__ __forceinline__ void gemm_phase(PG8_LAS unsigned char* lds, const Gemm g, const Sched& S, const Epi& E, int tid_in) {
    int tid_l = tid_in; asm volatile("" : "+v"(tid_l));
    const int tid = tid_l, wid = __builtin_amdgcn_readfirstlane(tid >> 6), lane = tid & 63, wr = wid >> 2, wc = wid & 3, fr = lane & 15, fq = lane >> 4;
    const int K = g.K, nt = K / BK;
    unsigned voffA[2], voffB[2];
#pragma unroll
    for (int i = 0; i < 2; ++i) { int R, C; stage_rc(tid * 16 + i * 8192, R, C); const int Rb = Epi::PERM ? ((R & ~31) + perm32(R & 31)) : R;
        voffA[i] = (unsigned)(R * K + C) * 2u; voffB[i] = (unsigned)(Rb * K + C) * 2u; }
    const size_t kstep = (size_t)(BK * 2);
    const size_t hstep = (size_t)HALF * K * 2;
    const size_t tstep = 2 * hstep;
    const unsigned ldsw = (unsigned)wid * 1024u;
    const int aoff = lds_byte(wr * 64 + fr, fq * 8), boff = lds_byte(wc * 32 + fr, fq * 8);
#define PG8_SA(b, h) (((b) * 2 + (h)) * HTB)
#define PG8_SB(b, h) ((4 + (b) * 2 + (h)) * HTB)
#define PG8_STAGE(bufoff, gbase, voff) do { _Pragma("unroll") for (int _i = 0; _i < 2; ++_i) \
        __builtin_amdgcn_global_load_lds((const unsigned*)((const char*)(gbase) + (voff)[_i]), (PG8_LAS unsigned*)(lds + (bufoff) + ldsw + _i * 8192), 16, 0, 0); } while (0)
#define PG8_LDA(dst, b, h) do { _Pragma("unroll") for (int m = 0; m < 4; ++m) _Pragma("unroll") for (int k = 0; k < 2; ++k) dst[m][k] = *(const PG8_LAS bf16x8*)(lds + PG8_SA(b, h) + aoff + m * 2048 + k * 1024); } while (0)
#define PG8_LDB(dst, b, h) do { _Pragma("unroll") for (int n = 0; n < 2; ++n) _Pragma("unroll") for (int k = 0; k < 2; ++k) dst[n][k] = *(const PG8_LAS bf16x8*)(lds + PG8_SB(b, h) + boff + n * 2048 + k * 1024); } while (0)
#define PG8_MMA(ai, bj, At, Bt) do { __builtin_amdgcn_s_setprio(1); _Pragma("unroll") for (int m = 0; m < 4; ++m) _Pragma("unroll") for (int n = 0; n < 2; ++n) _Pragma("unroll") for (int k = 0; k < 2; ++k) \
        acc[ai][bj][m][n] = __builtin_amdgcn_mfma_f32_16x16x32_bf16(Bt[n][k], At[m][k], acc[ai][bj][m][n], 0, 0, 0); __builtin_amdgcn_s_setprio(0); } while (0)
#define PG8_WAIT_V(n) asm volatile("s_waitcnt vmcnt(" #n ")" ::: "memory")
#define PG8_WAIT_L(n) asm volatile("s_waitcnt lgkmcnt(" #n ")" ::: "memory")
#define PG8_BAR __builtin_amdgcn_s_barrier()
#define PG8_SCHED __builtin_amdgcn_sched_barrier(0)
    Unit cur, nxt; int ui = 0;
    if (!S.next(0, cur)) return;
    f32x4 acc[2][2][4][2];
#pragma unroll
    for (int a = 0; a < 2; ++a)
#pragma unroll
        for (int b = 0; b < 2; ++b)
#pragma unroll
            for (int m = 0; m < 4; ++m)
#pragma unroll
                for (int n = 0; n < 2; ++n) acc[a][b][m][n] = (f32x4){0.f, 0.f, 0.f, 0.f};
    bf16x8 At[4][2], B0[2][2], B1[2][2];
    const char* cA = (const char*)g.A + (size_t)cur.pm * tstep; const char* cB = (const char*)g.Bt + (size_t)cur.pn * tstep;
    S.a_ready(cur);
    if constexpr (SP2) {
        PG8_STAGE(PG8_SB(0, 0), cB, voffB); PG8_STAGE(PG8_SB(0, 1), cB + hstep, voffB); PG8_STAGE(PG8_SA(0, 0), cA, voffA); PG8_STAGE(PG8_SA(0, 1), cA + hstep, voffA);
        if (wr == 1) PG8_BAR;
        PG8_WAIT_V(2); PG8_BAR;
        PG8_STAGE(PG8_SB(1, 0), cB + kstep, voffB); PG8_STAGE(PG8_SA(1, 0), cA + kstep, voffA); PG8_STAGE(PG8_SB(1, 1), cB + hstep + kstep, voffB);
        PG8_WAIT_V(6); PG8_BAR;
    } else {
        PG8_STAGE(PG8_SB(0, 0), cB, voffB); PG8_STAGE(PG8_SA(0, 0), cA, voffA); PG8_STAGE(PG8_SB(0, 1), cB + hstep, voffB); PG8_STAGE(PG8_SA(0, 1), cA + hstep, voffA);
        if (wr == 1) PG8_BAR;
        PG8_WAIT_V(4); PG8_BAR;
        PG8_STAGE(PG8_SB(1, 0), cB + kstep, voffB); PG8_STAGE(PG8_SA(1, 0), cA + kstep, voffA); PG8_STAGE(PG8_SB(1, 1), cB + hstep + kstep, voffB);
        PG8_WAIT_V(6); PG8_BAR;
    }
    for (;;) {
        const bool has_next = S.next(ui + 1, nxt);
        const char* nA = has_next ? (const char*)g.A + (size_t)nxt.pm * tstep : cA; const char* nB = has_next ? (const char*)g.Bt + (size_t)nxt.pn * tstep : cB;
        for (int t = 0; t < nt; t += 2) {
            const bool last = (t == nt - 2);
            const char* a1 = cA + (size_t)(t + 1) * kstep;
            const char* a2 = last ? nA : cA + (size_t)(t + 2) * kstep; const char* b2 = last ? nB : cB + (size_t)(t + 2) * kstep;
            const char* a3 = a2 + kstep; const char* b3 = b2 + kstep;
            if (last && has_next) S.a_ready(nxt);
            if constexpr (SP2) {
            PG8_LDB(B0, 0, 0); PG8_LDB(B1, 0, 1); PG8_SCHED; PG8_LDA(At, 0, 0); PG8_STAGE(PG8_SA(1, 1), a1 + hstep, voffA);
            PG8_WAIT_V(8); PG8_WAIT_L(0); PG8_BAR; PG8_MMA(0, 0, At, B0); PG8_MMA(0, 1, At, B1); PG8_BAR; PG8_SCHED;
            PG8_LDA(At, 0, 1); PG8_STAGE(PG8_SB(0, 0), b2, voffB); PG8_STAGE(PG8_SB(0, 1), b2 + hstep, voffB); PG8_STAGE(PG8_SA(0, 0), a2, voffA);
            PG8_WAIT_V(8); PG8_WAIT_L(0); PG8_BAR; PG8_MMA(1, 0, At, B0); PG8_MMA(1, 1, At, B1); PG8_BAR; PG8_SCHED;
            PG8_LDB(B0, 1, 0); PG8_LDB(B1, 1, 1); PG8_SCHED; PG8_LDA(At, 1, 0); PG8_STAGE(PG8_SA(0, 1), a2 + hstep, voffA);
            PG8_WAIT_V(8); PG8_WAIT_L(0); PG8_BAR; PG8_MMA(0, 0, At, B0); PG8_MMA(0, 1, At, B1); PG8_BAR; PG8_SCHED;
            PG8_LDA(At, 1, 1); PG8_STAGE(PG8_SB(1, 0), b3, voffB); PG8_STAGE(PG8_SB(1, 1), b3 + hstep, voffB); PG8_STAGE(PG8_SA(1, 0), a3, voffA);
            PG8_WAIT_V(8); PG8_WAIT_L(0); PG8_BAR; PG8_MMA(1, 0, At, B0); PG8_MMA(1, 1, At, B1); PG8_BAR; PG8_SCHED;
            } else {
            PG8_LDB(B0, 0, 0); PG8_SCHED; PG8_LDA(At, 0, 0); PG8_STAGE(PG8_SA(1, 1), a1 + hstep, voffA);
            PG8_WAIT_L(8); PG8_BAR; PG8_WAIT_L(0); PG8_MMA(0, 0, At, B0); PG8_BAR; PG8_SCHED;
            PG8_LDB(B1, 0, 1); PG8_STAGE(PG8_SB(0, 0), b2, voffB);
            PG8_BAR; PG8_WAIT_L(0); PG8_MMA(0, 1, At, B1); PG8_BAR;
            PG8_LDA(At, 0, 1); PG8_STAGE(PG8_SA(0, 0), a2, voffA);
            PG8_BAR; PG8_WAIT_L(0); PG8_MMA(1, 0, At, B0); PG8_BAR; PG8_SCHED;
            PG8_STAGE(PG8_SB(0, 1), b2 + hstep, voffB);
            PG8_WAIT_V(6); PG8_BAR; PG8_MMA(1, 1, At, B1); PG8_BAR;
            PG8_LDB(B0, 1, 0); PG8_SCHED; PG8_LDA(At, 1, 0); PG8_STAGE(PG8_SA(0, 1), a2 + hstep, voffA);
            PG8_WAIT_L(8); PG8_BAR; PG8_WAIT_L(0); PG8_MMA(0, 0, At, B0); PG8_BAR; PG8_SCHED;
            PG8_LDB(B1, 1, 1); PG8_STAGE(PG8_SB(1, 0), b3, voffB);
            PG8_BAR; PG8_WAIT_L(0); PG8_MMA(0, 1, At, B1); PG8_BAR;
            PG8_LDA(At, 1, 1); PG8_STAGE(PG8_SA(1, 0), a3, voffA);
            PG8_BAR; PG8_WAIT_L(0); PG8_MMA(1, 0, At, B0); PG8_BAR; PG8_SCHED;
            PG8_STAGE(PG8_SB(1, 1), b3 + hstep, voffB);
            PG8_WAIT_V(6); PG8_BAR; PG8_MMA(1, 1, At, B1); PG8_BAR;
            }
        }
        if constexpr (ALIGN_EPI) { if (wr == 0) PG8_BAR; }
        if constexpr (!Epi::AFTER_DRAIN) { E(acc, cur, wr, wc, fr, fq); S.done(cur); }
        if (!has_next) break;
#pragma unroll
        for (int a = 0; a < 2; ++a)
#pragma unroll
            for (int b = 0; b < 2; ++b)
#pragma unroll
                for (int m = 0; m < 4; ++m)
#pragma unroll
                    for (int n = 0; n < 2; ++n) acc[a][b][m][n] = (f32x4){0.f, 0.f, 0.f, 0.f};
        cur = nxt; cA = nA; cB = nB; ++ui;
        if constexpr (ALIGN_EPI) { if (wr == 1) PG8_BAR; }
    }
    PG8_WAIT_V(0);
    if constexpr (!ALIGN_EPI) { if (wr == 0) PG8_BAR; }
    PG8_BAR;
    if constexpr (Epi::AFTER_DRAIN) { E.fused(acc, cur, wr, wc, fr, fq, lds, wid, lane); S.done(cur); }
#undef PG8_SA
#undef PG8_SB
#undef PG8_STAGE
#undef PG8_LDA
#undef PG8_LDB
#undef PG8_MMA
#undef PG8_WAIT_V
#undef PG8_WAIT_L
#undef PG8_BAR
#undef PG8_SCHED
}
}

#ifndef PG8_SP2
#define PG8_SP2 true
#endif
#ifndef PG8_ALIGN
#define PG8_ALIGN true
#endif
#define XB_TMO      128
#define XB_XCNT(j)  (256  + 64 * (j))
#define XB_XSUB(j)  (1280 + 64 * (j))
#define XB_XGEN(j)  (2304 + 64 * (j))
#define XB_TOP      3328
#define XB_TOPGEN   3392
#define XCD_BAR_WORDS 3456
#define XB_SPIN_CAP (1u << 18)

__device__ __forceinline__ unsigned xb_ld(unsigned* p)              { return __hip_atomic_load(p, __ATOMIC_RELAXED, __HIP_MEMORY_SCOPE_AGENT); }
__device__ __forceinline__ unsigned xb_add(unsigned* p, unsigned v) { return __hip_atomic_fetch_add(p, v, __ATOMIC_RELAXED, __HIP_MEMORY_SCOPE_AGENT); }
__device__ __forceinline__ unsigned xb_xcc_id() { return (unsigned)__builtin_amdgcn_s_getreg((3 << 11) | 20) & 0xFu; }
#define XB_SPIN(cond, bar) do { unsigned _sp = 0; while (cond) { __builtin_amdgcn_s_sleep(1); \
    if ((++_sp & 255u) == 0u) { if (xb_ld(&(bar)[XB_TMO])) break; if (_sp > XB_SPIN_CAP) { atomicAdd(&(bar)[XB_TMO], 1u); break; } } } } while (0)

struct XcdBarrier {
    unsigned* bar; unsigned x;
    volatile LAS unsigned* st;
};

__device__ __forceinline__ XcdBarrier xcd_barrier_post(unsigned* bar, volatile LAS unsigned* st) {
    XcdBarrier b; b.bar = bar; b.x = xb_xcc_id(); b.st = st;
    if (threadIdx.x == 0) (void)xb_add(&bar[XB_XCNT(b.x)], 1u);
    return b;
}
__device__ __forceinline__ void xcd_barrier_complete(unsigned* bar, unsigned x, unsigned& nloc, unsigned& nx) {
    const unsigned G = gridDim.x * gridDim.y * gridDim.z;
    unsigned sum, cnt, mine, sp = 0u;
    for (;;) {
        sum = 0u; cnt = 0u; mine = 0u;
#pragma unroll
        for (unsigned j = 0; j < 16; ++j) { const unsigned c = xb_ld(&bar[XB_XCNT(j)]); sum += c; cnt += (c > 0u) ? 1u : 0u; mine = (j == x) ? c : mine; }
        if (sum == G) break;
        __builtin_amdgcn_s_sleep(1);
        if ((++sp & 255u) == 0u) { if (xb_ld(&bar[XB_TMO])) break; if (sp > XB_SPIN_CAP) { atomicAdd(&bar[XB_TMO], 1u); break; } }
    }
    nloc = mine > 0u ? mine : 1u; nx = cnt > 0u ? cnt : 1u;
}

__device__ __forceinline__ void xcd_barrier(const XcdBarrier& b) {
    asm volatile("s_waitcnt vmcnt(0)" ::: "memory");
    __syncthreads();
    if (threadIdx.x == 0) {
        unsigned* bar = b.bar;
        __builtin_amdgcn_s_waitcnt(0);
        unsigned nloc = b.st[0], nx = b.st[1];
        if (nloc == 0u) { xcd_barrier_complete(bar, b.x, nloc, nx); b.st[0] = nloc; b.st[1] = nx; }
        const unsigned old = xb_add(&bar[XB_XSUB(b.x)], 1u);
        const unsigned gen = old / nloc;
        if (old + 1u == (gen + 1u) * nloc) {
            __builtin_amdgcn_fence(__ATOMIC_RELEASE, "agent");
            asm volatile("s_waitcnt vmcnt(0)" ::: "memory");
            const unsigned og = xb_add(&bar[XB_TOP], 1u);
            const unsigned tg = og / nx;
            if (og + 1u == (tg + 1u) * nx) xb_add(&bar[XB_TOPGEN], 1u);
            else XB_SPIN(xb_ld(&bar[XB_TOPGEN]) == tg, bar);
            __builtin_amdgcn_fence(__ATOMIC_ACQUIRE, "agent");
            xb_add(&bar[XB_XGEN(b.x)], 1u);
            asm volatile("s_waitcnt vmcnt(0)" ::: "memory");
        } else {
            XB_SPIN(xb_ld(&bar[XB_XGEN(b.x)]) == gen, bar);
            __builtin_amdgcn_fence(__ATOMIC_ACQUIRE, "agent");
            asm volatile("s_waitcnt vmcnt(0)" ::: "memory");
        }
    }
    __syncthreads();
}
struct EpiResF32 {
    static constexpr bool PERM = true, AFTER_DRAIN = false;
    const float* xin; float* yp; float alpha;
    DI void operator()(const pg8::f32x4 (&acc)[2][2][4][2], const pg8::Unit& u, int wr, int wc, int fr, int fq) const {
        const int row0 = u.pm * 256 + wr * 64 + fr, col0 = u.pn * 256 + wc * 32 + 8 * fq;
#pragma unroll
        for (int ai = 0; ai < 2; ++ai)
#pragma unroll
            for (int m = 0; m < 4; ++m) {
                const size_t ro = (size_t)(row0 + ai * 128 + m * 16) * DM;
#pragma unroll
                for (int bj = 0; bj < 2; ++bj) {
                    const size_t o = ro + col0 + bj * 128;
                    const f32x4 x0 = *(const f32x4*)(xin + o), x1 = *(const f32x4*)(xin + o + 4);
                    *(f32x4*)(yp + o) = x0 * alpha + acc[ai][bj][m][0];
                    *(f32x4*)(yp + o + 4) = x1 * alpha + acc[ai][bj][m][1];
                }
            }
    }
};
struct EpiSwiglu {
    static constexpr bool PERM = true, AFTER_DRAIN = false;
    bf16* act; const float* bgu;
    DI void operator()(const pg8::f32x4 (&acc)[2][2][4][2], const pg8::Unit& u, int wr, int wc, int fr, int fq) const {
        const int e = u.pn >> 3, pl = u.pn & 7;
        const int row0 = u.pm * 256 + wr * 64 + fr, cih = pl * 128 + wc * 32 + 8 * fq;
        const float* bg = bgu + e * 2048 + cih;
        const f32x4 bg0 = *(const f32x4*)(bg), bg1 = *(const f32x4*)(bg + 4), bu0 = *(const f32x4*)(bg + 1024), bu1 = *(const f32x4*)(bg + 1028);
#pragma unroll
        for (int ai = 0; ai < 2; ++ai)
#pragma unroll
            for (int m = 0; m < 4; ++m) {
                const f32x4 g0 = acc[ai][0][m][0] + bg0, g1 = acc[ai][0][m][1] + bg1, u0 = acc[ai][1][m][0] + bu0, u1 = acc[ai][1][m][1] + bu1;
                float r[8];
#pragma unroll
                for (int i = 0; i < 8; ++i) {
                    float g = i < 4 ? g0[i & 3] : g1[i & 3], uu = i < 4 ? u0[i & 3] : u1[i & 3];
                    g = fminf(g, 7.0f); uu = fminf(fmaxf(uu, -7.0f), 7.0f);
                    const float sg = __builtin_amdgcn_rcpf(1.0f + ex2(-1.702f * LOG2E * g));
                    r[i] = (uu + 1.0f) * g * sg;
                }
                v4u w; w.x = cvtpk(r[0], r[1]); w.y = cvtpk(r[2], r[3]); w.z = cvtpk(r[4], r[5]); w.w = cvtpk(r[6], r[7]);
                *(v4u*)(act + (size_t)(row0 + ai * 128 + m * 16) * DM + cih) = w;
            }
    }
};
struct EpiDown {
    static constexpr bool PERM = true, AFTER_DRAIN = false;
    bf16* yr; const float* bdn;
    DI void operator()(const pg8::f32x4 (&acc)[2][2][4][2], const pg8::Unit& u, int wr, int wc, int fr, int fq) const {
        const int e = u.pn >> 2, pl = u.pn & 3;
        const int row0 = u.pm * 256 + wr * 64 + fr, col0 = pl * 256 + wc * 32 + 8 * fq;
        f32x4 bv[2][2];
#pragma unroll
        for (int bj = 0; bj < 2; ++bj) { bv[bj][0] = *(const f32x4*)(bdn + e * 1024 + col0 + bj * 128); bv[bj][1] = *(const f32x4*)(bdn + e * 1024 + col0 + bj * 128 + 4); }
#pragma unroll
        for (int ai = 0; ai < 2; ++ai)
#pragma unroll
            for (int m = 0; m < 4; ++m) {
                bf16* rp = yr + (size_t)(row0 + ai * 128 + m * 16) * DM + col0;
#pragma unroll
                for (int bj = 0; bj < 2; ++bj) {
                    const f32x4 v0 = acc[ai][bj][m][0] + bv[bj][0], v1 = acc[ai][bj][m][1] + bv[bj][1];
                    v4u w; w.x = cvtpk(v0[0], v0[1]); w.y = cvtpk(v0[2], v0[3]); w.z = cvtpk(v1[0], v1[1]); w.w = cvtpk(v1[2], v1[3]);
                    *(v4u*)(rp + bj * 128) = w;
                }
            }
    }
};
struct GroupOrder {
    const unsigned* tile_e; int ntiles, lg, G, c;
    DI bool next(int i, pg8::Unit& u) const {
        const long L = (long)i * G + c; if (L >= ((long)ntiles << lg)) return false;
        const int pm = (int)(L >> lg), pl = (int)(L & ((1 << lg) - 1));
        const int e = __builtin_amdgcn_readfirstlane((int)ld_u32(tile_e + pm));
        u.pm = pm; u.pn = (e << lg) + pl; return true;
    }
    DI void a_ready(const pg8::Unit&) const {}
    DI void done(const pg8::Unit&) const {}
};
struct Args { const float* in[18]; float* out; unsigned char* ws; int ph_lo, ph_hi; };
struct Fr { LAS unsigned char* lds; unsigned char* ws; unsigned* ctl; int tid, lane, wave, blk, G; };

DI void tr_item(const float* W, int ldw, int K, int k0, int sc0, int nvalid, bf16* WT, int drow0, LAS float* scr, int lane) {
    const int c = lane & 31;
#pragma unroll 8
    for (int i = 0; i < 32; ++i) { const int kk = 2 * i + (lane >> 5); scr[kk * 33 + c] = (c < nvalid) ? W[(size_t)(k0 + kk) * ldw + sc0 + c] : 0.f; }
    LDS_WAIT(); asm volatile("" ::: "memory");
    const int c8 = lane & 7;
#pragma unroll
    for (int j = 0; j < 4; ++j) { const int n = (lane >> 3) + 8 * j; const LAS float* s = scr + (8 * c8) * 33 + n;
        v4u o; o.x = cvtpk(s[0 * 33], s[1 * 33]); o.y = cvtpk(s[2 * 33], s[3 * 33]); o.z = cvtpk(s[4 * 33], s[5 * 33]); o.w = cvtpk(s[6 * 33], s[7 * 33]);
        *(v4u*)(WT + (size_t)(drow0 + n) * K + k0 + 8 * c8) = o; }
    LDS_WAIT(); asm volatile("" ::: "memory");
}
DI void ph_prologue(const Args& a, const Fr& F) {
    LAS float* scr = (LAS float*)(F.lds + F.wave * 16384);
    const int gw = F.blk * NWAVES + F.wave, NGW = F.G * NWAVES;
    constexpr int I_EV = 2 * 16 * 80, I_OD = 2 * 16 * 96, I_WO = 4 * 16 * 32, I_GU = 128 * 16 * 64, I_DN = 128 * 16 * 32;
    constexpr int NITEMS = I_EV + I_OD + I_WO + I_GU + I_DN;
    bf16* wev = (bf16*)(F.ws + WS_WEV); bf16* wod = (bf16*)(F.ws + WS_WOD); bf16* wout = (bf16*)(F.ws + WS_WOUT);
    bf16* wgu = (bf16*)(F.ws + WS_WGU); bf16* wdn = (bf16*)(F.ws + WS_WDN);
    for (int it = gw; it < NITEMS; it += NGW) {
        int r = it;
        if (r < I_EV) { const int l = r / 1280; r %= 1280; const int kb = r / 80, n0 = (r % 80) * 32; int sc0, nv = 32;
            if (n0 < 512) sc0 = n0; else if (n0 < 1024) sc0 = 964 + (n0 - 512); else if (n0 < 1536) sc0 = 1476 + (n0 - 1024); else if (n0 < 2048) sc0 = 1988 + (n0 - 1536);
            else if (n0 < 2176) sc0 = 512 + (n0 - 2048); else if (n0 < 2432) sc0 = 640 + (n0 - 2176); else if (n0 < 2496) sc0 = 896 + (n0 - 2432);
            else if (n0 < 2528) { sc0 = 960; nv = 4; } else { sc0 = 0; nv = 0; }
            tr_item(a.in[1] + (size_t)l * 1024 * 2500, 2500, 1024, kb * 64, sc0, nv, wev + (size_t)l * EV_N * 1024, n0, scr, F.lane); continue; }
        r -= I_EV;
        if (r < I_OD) { const int l = r / 1536; r %= 1536; const int kb = r / 96, n0 = (r % 96) * 32;
            tr_item(a.in[6] + (size_t)l * 1024 * 3088, 3088, 1024, kb * 64, n0, 32, wod + (size_t)l * OD_N * 1024, n0, scr, F.lane); continue; }
        r -= I_OD;
        if (r < I_WO) { const int l = r / 512; r %= 512; const int kb = r / 32, n0 = (r % 32) * 32;
            const float* src = (l & 1) ? a.in[8] + (size_t)(l >> 1) * 1024 * 1024 : a.in[5] + (size_t)(l >> 1) * 1024 * 1024;
            tr_item(src, 1024, 1024, kb * 64, n0, 32, wout + (size_t)l * 1024 * 1024, n0, scr, F.lane); continue; }
        r -= I_WO;
        if (r < I_GU) { const int le = r / 1024; r %= 1024; const int kb = r / 64, n0 = (r % 64) * 32;
            const int pn = n0 >> 8, bj = (n0 >> 7) & 1, j0 = n0 & 127;
            tr_item(a.in[14] + (size_t)le * 1024 * 2048, 2048, 1024, kb * 64, bj * 1024 + pn * 128 + j0, 32, wgu + (size_t)le * 2048 * 1024, n0, scr, F.lane); continue; }
        r -= I_GU;
        { const int le = r / 512; r %= 512; const int kb = r / 32, n0 = (r % 32) * 32;
            tr_item(a.in[16] + (size_t)le * 1024 * 1024, 1024, 1024, kb * 64, n0, 32, wdn + (size_t)le * 1024 * 1024, n0, scr, F.lane); }
    }
    bf16* xb = (bf16*)(F.ws + WS_XB);
    for (int m = gw; m < NTOK; m += NGW) {
        const f32x4* xr = (const f32x4*)(a.in[0] + (size_t)m * DM) + F.lane; v2u* o = (v2u*)(xb + (size_t)m * DM) + F.lane;
#pragma unroll
        for (int j = 0; j < 4; ++j) { const f32x4 v = xr[64 * j]; v2u w; w.x = cvtpk(v[0], v[1]); w.y = cvtpk(v[2], v[3]); o[64 * j] = w; }
    }
    bf16* wukt = (bf16*)(F.ws + WS_WUKT); bf16* wuvt = (bf16*)(F.ws + WS_WUVT);
    for (int i = F.blk * NTHR + F.tid; i < 2 * 8 * 128 * 64; i += F.G * NTHR) {
        { const int d = i & 63, c = (i >> 6) & 127, lh = i >> 13; wukt[i] = (bf16)f2bf(a.in[2][((size_t)lh * 64 + d) * 128 + c]); }
        { const int c = i & 127, d = (i >> 7) & 63, lh = i >> 13; wuvt[i] = (bf16)f2bf(a.in[3][((size_t)lh * 128 + c) * 64 + d]); }
    }
}

DI void ln_row(f32x4 (&v)[4], const float* g, const float* b, int lane) {
    float s = 0.f;
#pragma unroll
    for (int j = 0; j < 4; ++j) s += (v[j][0] + v[j][1]) + (v[j][2] + v[j][3]);
    const float mean = wave_sum(s) * (1.f / DM); float s2 = 0.f;
#pragma unroll
    for (int j = 0; j < 4; ++j) { v[j] = v[j] - mean; s2 += (v[j][0] * v[j][0] + v[j][1] * v[j][1]) + (v[j][2] * v[j][2] + v[j][3] * v[j][3]); }
    const float rstd = 1.f / sqrtf(wave_sum(s2) * (1.f / DM) + LN_EPS);
#pragma unroll
    for (int j = 0; j < 4; ++j) { const f32x4 gg = *((const f32x4*)g + lane + 64 * j), bb = *((const f32x4*)b + lane + 64 * j); v[j] = v[j] * rstd * gg + bb; }
}
DI void store_row_f32(float* p, const f32x4 (&v)[4], int lane) {
#pragma unroll
    for (int j = 0; j < 4; ++j) *((f32x4*)p + lane + 64 * j) = v[j];
}
DI void store_row_bf16(bf16* p, const f32x4 (&v)[4], int lane) {
#pragma unroll
    for (int j = 0; j < 4; ++j) { v2u w; w.x = cvtpk(v[j][0], v[j][1]); w.y = cvtpk(v[j][2], v[j][3]); *((v2u*)p + lane + 64 * j) = w; }
}
template <int NL> DI void small_proj(LAS const float* xs, const float* W, int ldw, int lane, float (&acc)[4]) {
    constexpr int PARTS = 64 / NL, DPER = 1024 / PARTS;
    const int n = lane & (NL - 1), part = lane / NL;
    acc[0] = acc[1] = acc[2] = acc[3] = 0.f;
    const float* wp = W + (size_t)(part * DPER) * ldw + n;
    LAS const float* xp = xs + part * DPER;
#pragma unroll 8
    for (int d = 0; d < DPER; ++d) { const float w = wp[(size_t)d * ldw];
        acc[0] += w * xp[d]; acc[1] += w * xp[1024 + d]; acc[2] += w * xp[2048 + d]; acc[3] += w * xp[3072 + d]; }
#pragma unroll
    for (int o = NL; o < 64; o <<= 1) {
#pragma unroll
        for (int k = 0; k < 4; ++k) acc[k] += __shfl_xor(acc[k], o); }
}

DI void ph_even_prep(const Args& a, const Fr& F, int j) {
    const bf16* proj = (const bf16*)(F.ws + WS_PROJ);
    bf16* ckvn = (bf16*)(F.ws + WS_CKVN); bf16* ql = (bf16*)(F.ws + WS_QL); float* kbar = (float*)(F.ws + WS_KBAR);
    const float* kvg = a.in[4] + j * 128;
    const bf16* wukt = (const bf16*)(F.ws + WS_WUKT) + (size_t)j * 8 * 128 * 64;
    const int lane = F.lane, wave = F.wave;
    for (int chunk = F.blk; chunk < 256; chunk += F.G) {
        const int tok0 = chunk * 128;
        for (int i = 0; i < 16; ++i) { const int tok = tok0 + wave * 16 + i;
            const unsigned w = *((const unsigned*)(proj + (size_t)tok * EV_N + EC_CKV) + lane);
            const float v0 = bf2f(w & 0xffffu), v1 = bf2f(w >> 16);
            const float ss = wave_sum(v0 * v0 + v1 * v1);
            const float r = 1.f / sqrtf(ss * (1.f / 128.f) + LN_EPS);
            *((unsigned*)(ckvn + (size_t)tok * 128) + lane) = cvtpk(v0 * r * kvg[2 * lane], v1 * r * kvg[2 * lane + 1]); }
        { const int h = wave, l15 = lane & 15, kg = lane >> 4;
            bf16x8 af[8][2];
#pragma unroll
            for (int ct = 0; ct < 8; ++ct)
#pragma unroll
                for (int ks = 0; ks < 2; ++ks) af[ct][ks] = *(const bf16x8*)(wukt + ((size_t)h * 128 + ct * 16 + l15) * 64 + ks * 32 + kg * 8);
            for (int tg = 0; tg < 8; ++tg) { const int tok = tok0 + tg * 16 + l15;
                bf16x8 qf[2];
#pragma unroll
                for (int ks = 0; ks < 2; ++ks) qf[ks] = *(const bf16x8*)(proj + (size_t)tok * EV_N + EC_QA + h * 64 + ks * 32 + kg * 8);
#pragma unroll
                for (int ct = 0; ct < 8; ++ct) { f32x4 d = {0.f, 0.f, 0.f, 0.f};
                    d = mfma16(af[ct][0], qf[0], d); d = mfma16(af[ct][1], qf[1], d);
                    v2u w; w.x = cvtpk(d[0], d[1]); w.y = cvtpk(d[2], d[3]);
                    *(v2u*)(ql + (size_t)tok * 1024 + h * 128 + ct * 16 + 4 * kg) = w; } } }
        if (chunk < 128) { const int b = chunk >> 5, n = chunk & 31; float s = 0.f;
            const bf16* kp = proj + ((size_t)b * SEQ + n * 256) * EV_N + EC_KB + F.tid;
#pragma unroll 8
            for (int r = 0; r < 256; ++r) s += bf2f(kp[(size_t)r * EV_N]);
            const int h = F.tid >> 6, d = F.tid & 63;
            kbar[(((size_t)b * 8 + h) * 32 + n) * 64 + d] = s * (1.f / 256.f); }
    }
}

DI void moba_gate_chunk(const Fr& F, int chunk) {
    const bf16* proj = (const bf16*)(F.ws + WS_PROJ); const float* kbar = (const float*)(F.ws + WS_KBAR); unsigned* sel3 = (unsigned*)(F.ws + WS_SEL3);
    const int tok0 = chunk * 128, b = tok0 / SEQ, own = (tok0 % SEQ) >> 8, h = F.wave, lane = F.lane;
    float q0[64], q1[64];
    { const v4u* p0 = (const v4u*)(proj + (size_t)(tok0 + lane) * EV_N + EC_QB + h * 64); const v4u* p1 = (const v4u*)(proj + (size_t)(tok0 + 64 + lane) * EV_N + EC_QB + h * 64);
#pragma unroll
        for (int i = 0; i < 8; ++i) { const v4u w0 = p0[i], w1 = p1[i];
#pragma unroll
            for (int k = 0; k < 4; ++k) { q0[8 * i + 2 * k] = bf2f(w0[k] & 0xffffu); q0[8 * i + 2 * k + 1] = bf2f(w0[k] >> 16); q1[8 * i + 2 * k] = bf2f(w1[k] & 0xffffu); q1[8 * i + 2 * k + 1] = bf2f(w1[k] >> 16); } } }
    float a0 = -INFINITY, a1 = -INFINITY, a2 = -INFINITY, c0 = -INFINITY, c1 = -INFINITY, c2 = -INFINITY; int ai0 = 0, ai1 = 0, ai2 = 0, ci0 = 0, ci1 = 0, ci2 = 0;
    const float* kb = kbar + (((size_t)b * 8 + h) * 32) * 64;
    for (int n = 0; n < own; ++n) { float g0 = 0.f, g1 = 0.f;
#pragma unroll
        for (int d = 0; d < 64; d += 4) { const f32x4 kv = *(const f32x4*)(kb + n * 64 + d);
#pragma unroll
            for (int k = 0; k < 4; ++k) { g0 += q0[d + k] * kv[k]; g1 += q1[d + k] * kv[k]; } }
        if (g0 > a2) { if (g0 > a1) { a2 = a1; ai2 = ai1; if (g0 > a0) { a1 = a0; ai1 = ai0; a0 = g0; ai0 = n; } else { a1 = g0; ai1 = n; } } else { a2 = g0; ai2 = n; } }
        if (g1 > c2) { if (g1 > c1) { c2 = c1; ci2 = ci1; if (g1 > c0) { c1 = c0; ci1 = ci0; c0 = g1; ci0 = n; } else { c1 = g1; ci1 = n; } } else { c2 = g1; ci2 = n; } }
    }
    const unsigned nv = own < 3 ? own : 3;
    sel3[(size_t)(tok0 + lane) * 8 + h] = (unsigned)ai0 | ((unsigned)ai1 << 8) | ((unsigned)ai2 << 16) | (nv << 24);
    sel3[(size_t)(tok0 + 64 + lane) * 8 + h] = (unsigned)ci0 | ((unsigned)ci1 << 8) | ((unsigned)ci2 << 16) | (nv << 24);
}

template <int MODE> DI void idx_pass(const bf16* proj, int rowbase, int qt, const bf16x8 (&qf)[4][4], const float (&wj)[4], LAS unsigned* hist, LAS unsigned* mask, LAS unsigned* cmask, LAS unsigned long long* cand, LAS unsigned* rinfo, int wave, int lane) {
    const int q = lane & 31, hi = lane >> 5, nkt = qt + 1, t = qt * 32 + q;
    const unsigned b1 = rinfo[q], thr16 = rinfo[64 + q];
    for (int ch = 0; ch * 8 < nkt; ++ch) { const int kt = ch * 8 + wave; if (kt >= nkt) continue;
        const bf16* kp = proj + (size_t)(rowbase + kt * 32 + q) * EV_N + EC_KI + hi * 8;
        bf16x8 kf[4];
#pragma unroll
        for (int s = 0; s < 4; ++s) kf[s] = *(const bf16x8*)(kp + s * 16);
        f32x16 sc;
#pragma unroll
        for (int r = 0; r < 16; ++r) sc[r] = 0.f;
#pragma unroll
        for (int j = 0; j < 4; ++j) { f32x16 acc;
#pragma unroll
            for (int r = 0; r < 16; ++r) acc[r] = 0.f;
#pragma unroll
            for (int s = 0; s < 4; ++s) acc = mfma32(kf[s], qf[j][s], acc);
#pragma unroll
            for (int r = 0; r < 16; ++r) sc[r] += wj[j] * fmaxf(acc[r], 0.f); }
#pragma unroll
        for (int r = 0; r < 16; ++r) { const int s = kt * 32 + crow(r, hi);
            if (s <= t) { unsigned u = __float_as_uint(sc[r]); if (u == 0x80000000u) u = 0u; const unsigned key = (u >> 31) ? ~u : (u | 0x80000000u);
                if (MODE == 1) __hip_atomic_fetch_add(hist + q * 256 + (key >> 24), 1u, __ATOMIC_RELAXED, __HIP_MEMORY_SCOPE_WORKGROUP);
                else if (MODE == 2) { if ((key >> 24) == b1) __hip_atomic_fetch_add(hist + q * 256 + ((key >> 16) & 255u), 1u, __ATOMIC_RELAXED, __HIP_MEMORY_SCOPE_WORKGROUP); }
                else { const unsigned k16 = key >> 16;
                    if (k16 > thr16) __hip_atomic_fetch_or(mask + q * 256 + (s >> 5), 1u << (s & 31), __ATOMIC_RELAXED, __HIP_MEMORY_SCOPE_WORKGROUP);
                    else if (k16 == thr16) { const unsigned pos = __hip_atomic_fetch_add(rinfo + 128 + q, 1u, __ATOMIC_RELAXED, __HIP_MEMORY_SCOPE_WORKGROUP);
                        __hip_atomic_fetch_or(cmask + q * 256 + (s >> 5), 1u << (s & 31), __ATOMIC_RELAXED, __HIP_MEMORY_SCOPE_WORKGROUP);
                        if (pos < 64u) cand[q * 64 + pos] = ((unsigned long long)key << 32) | (unsigned)(~(unsigned)s); } } } }
    }
}
DI void hist_pick(LAS const unsigned* hrow, unsigned need, int lane, unsigned& bin, unsigned& above) {
    const v4u h4 = *((LAS const v4u*)hrow + lane);
    const unsigned ssum = h4[0] + h4[1] + h4[2] + h4[3];
    unsigned x = ssum;
#pragma unroll
    for (int o = 1; o < 64; o <<= 1) { const unsigned y = __shfl_down(x, o); if (lane + o < 64) x += y; }
    const unsigned long long m = __ballot(x >= need);
    const int Ls = m ? 63 - __builtin_clzll(m) : 0;
    const unsigned xs = __shfl(x, Ls), ss = __shfl(ssum, Ls);
    const unsigned h0 = __shfl(h4[0], Ls), h1 = __shfl(h4[1], Ls), h2 = __shfl(h4[2], Ls), h3 = __shfl(h4[3], Ls);
    unsigned cum = xs - ss;
    if (cum + h3 >= need) { bin = 4 * Ls + 3; above = cum; return; } cum += h3;
    if (cum + h2 >= need) { bin = 4 * Ls + 2; above = cum; return; } cum += h2;
    if (cum + h1 >= need) { bin = 4 * Ls + 1; above = cum; return; } cum += h1;
    bin = 4 * Ls; above = cum; (void)h0;
}
DI void idx_unit(const Fr& F, int b, int qt) {
    const bf16* proj = (const bf16*)(F.ws + WS_PROJ); unsigned short* sel = (unsigned short*)(F.ws + WS_SEL);
    LAS unsigned* hist = (LAS unsigned*)(F.lds); LAS unsigned* mask = (LAS unsigned*)(F.lds + 32768);
    LAS unsigned* cmask = (LAS unsigned*)(F.lds + 98304);
    LAS unsigned long long* cand = (LAS unsigned long long*)(F.lds + 65536); LAS unsigned* rinfo = (LAS unsigned*)(F.lds + 81920);
    const int lane = F.lane, wave = F.wave, tid = F.tid, t0 = qt * 32, rowbase = b * SEQ;
    __syncthreads();
    for (int i = tid; i < 16384; i += NTHR) hist[i] = 0u;
    for (int i = tid; i < 8192; i += NTHR) cmask[i] = 0u;
    if (tid < 160) rinfo[tid] = 0u;
    __syncthreads();
    if (t0 + 31 <= 255 || (EXPF & 64)) {
        if (lane < 8) {
#pragma unroll
            for (int rr = 0; rr < 4; ++rr) { const int row = wave * 4 + rr, nv = t0 + row + 1;
                const int nv0 = t0 + row + 1; const int nvc = nv0 < 256 ? nv0 : 256; (void)nv; mask[row * 256 + lane] = nvc >= 32 * (lane + 1) ? 0xffffffffu : (nvc > 32 * lane ? ((1u << (nvc - 32 * lane)) - 1u) : 0u); } }
    } else {
        const int q = lane & 31, hi = lane >> 5;
        bf16x8 qf[4][4]; float wj[4];
        { const bf16* qp = proj + (size_t)(rowbase + t0 + q) * EV_N;
#pragma unroll
            for (int j = 0; j < 4; ++j) { wj[j] = bf2f(qp[EC_WI + j]);
#pragma unroll
                for (int s = 0; s < 4; ++s) qf[j][s] = *(const bf16x8*)(qp + EC_QI + j * 64 + s * 16 + hi * 8); } }
        idx_pass<1>(proj, rowbase, qt, qf, wj, hist, mask, cmask, cand, rinfo, wave, lane);
        __syncthreads();
#pragma unroll 1
        for (int rr = 0; rr < 4; ++rr) { const int row = wave * 4 + rr; unsigned bin, above; hist_pick(hist + row * 256, 256u, lane, bin, above);
            if (lane == 0) { rinfo[row] = bin; rinfo[32 + row] = 256u - above; } }
        __syncthreads();
        for (int i = tid; i < 8192; i += NTHR) hist[i] = 0u;
        __syncthreads();
        idx_pass<2>(proj, rowbase, qt, qf, wj, hist, mask, cmask, cand, rinfo, wave, lane);
        __syncthreads();
#pragma unroll 1
        for (int rr = 0; rr < 4; ++rr) { const int row = wave * 4 + rr; const unsigned need1 = rinfo[32 + row]; unsigned bin, above; hist_pick(hist + row * 256, need1, lane, bin, above);
            if (lane == 0) { rinfo[64 + row] = (rinfo[row] << 8) | bin; rinfo[96 + row] = need1 - above; } }
        __syncthreads();
        idx_pass<3>(proj, rowbase, qt, qf, wj, hist, mask, cmask, cand, rinfo, wave, lane);
        __syncthreads();
#pragma unroll 1
        for (int rr = 0; rr < 4; ++rr) { const int row = wave * 4 + rr; const unsigned call = rinfo[128 + row], need2 = rinfo[96 + row];
            if (call <= 64u) { const unsigned c = call;
                const unsigned long long mine = cand[row * 64 + lane]; unsigned rank = 0u;
                for (unsigned k = 0; k < c; ++k) rank += (cand[row * 64 + k] > mine) ? 1u : 0u;
                if ((unsigned)lane < c && rank < need2) { const unsigned s = ~(unsigned)mine;
                    __hip_atomic_fetch_or(mask + row * 256 + (s >> 5), 1u << (s & 31), __ATOMIC_RELAXED, __HIP_MEMORY_SCOPE_WORKGROUP); } }
            else { const v4u w4 = *((LAS const v4u*)(cmask + row * 256) + lane);
                const unsigned cnt = __popc(w4[0]) + __popc(w4[1]) + __popc(w4[2]) + __popc(w4[3]);
                unsigned x = cnt;
#pragma unroll
                for (int o = 1; o < 64; o <<= 1) { const unsigned y = __shfl_up(x, o); if (lane >= o) x += y; }
                unsigned before = x - cnt;
#pragma unroll
                for (int k = 0; k < 4; ++k) { unsigned w = w4[k]; const unsigned pc = __popc(w); unsigned take = 0u;
                    if (before < need2) { if (before + pc <= need2) take = w; else { unsigned left = need2 - before; while (left) { const unsigned b = w & (0u - w); take |= b; w ^= b; --left; } } }
                    before += pc;
                    if (take) mask[row * 256 + 4 * lane + k] |= take; } }
        }
    }
    __syncthreads();
    if ((EXPF & 512) && t0 >= 256) {
        for (int i = tid; i < 8192; i += NTHR) mask[i] = 0u;
        __syncthreads();
        for (int i = tid; i < 32 * 256; i += NTHR) { const int row = i >> 8, k = i & 255, t = t0 + row; const unsigned s = (unsigned)(k * 31 + 7 * t) % (unsigned)(t + 1);
            __hip_atomic_fetch_or(mask + row * 256 + (s >> 5), 1u << (s & 31), __ATOMIC_RELAXED, __HIP_MEMORY_SCOPE_WORKGROUP); }
        __syncthreads();
    }
#pragma unroll 1
    for (int rr = 0; rr < 4; ++rr) { const int row = wave * 4 + rr; unsigned short* out = sel + (size_t)(rowbase + t0 + row) * 256;
        const v4u w4 = *((LAS const v4u*)(mask + row * 256) + lane);
        const unsigned cnt = __popc(w4[0]) + __popc(w4[1]) + __popc(w4[2]) + __popc(w4[3]);
        unsigned x = cnt;
#pragma unroll
        for (int o = 1; o < 64; o <<= 1) { const unsigned y = __shfl_up(x, o); if (lane >= o) x += y; }
        const unsigned total = __shfl(x, 63); unsigned pos = x - cnt;
#pragma unroll
        for (int k = 0; k < 4; ++k) { unsigned w = w4[k]; const unsigned base = (unsigned)(4 * lane + k) * 32u;
            while (w) { const unsigned bit = __builtin_ctz(w); if (pos < 256u) out[pos] = (unsigned short)(base + bit); ++pos; w &= w - 1u; } }
        for (unsigned i = total + lane; i < 256u; i += 64u) out[i] = (unsigned short)0xffffu; }
}

struct AttSt { float m, l; f32x16 o0, o1; };
template <class BF> DI void att_subtile(AttSt& S, const bf16x8 (&qf)[4], LAS const char* Kst, LAS const char* Vb, int vdh, int vrow0, int lane, const BF& bias) {
    const int r32 = lane & 31, hi = lane >> 5;
    f32x16 p;
#pragma unroll
    for (int r = 0; r < 16; ++r) p[r] = 0.f;
    LAS const char* kp = Kst + hi * 512 + r32 * 16;
#pragma unroll
    for (int s = 0; s < 4; ++s) { const bf16x8 kf = *(LAS const bf16x8*)(kp + s * 1024); p = mfma32(kf, qf[s], p); }
    float mx = -INFINITY;
#pragma unroll
    for (int r = 0; r < 16; ++r) { p[r] = bias(p[r], crow(r, hi)); mx = fmaxf(mx, p[r]); }
    mx = fmaxf(mx, __shfl_xor(mx, 32));
    const float mn = fmaxf(S.m, mx), sc = ex2(S.m - mn);
    S.m = mn;
    float ps = 0.f;
#pragma unroll
    for (int r = 0; r < 16; ++r) { p[r] = ex2(p[r] - mn); ps += p[r]; }
    S.l = S.l * sc + ps;
#pragma unroll
    for (int r = 0; r < 16; ++r) { S.o0[r] *= sc; S.o1[r] *= sc; }
    v4u pw0, pw1;
    pw0.x = cvtpk(p[0], p[1]); pw0.y = cvtpk(p[2], p[3]); pw0.z = cvtpk(p[4], p[5]); pw0.w = cvtpk(p[6], p[7]);
    pw1.x = cvtpk(p[8], p[9]); pw1.y = cvtpk(p[10], p[11]); pw1.z = cvtpk(p[12], p[13]); pw1.w = cvtpk(p[14], p[15]);
    const bf16x8 pf0 = __builtin_bit_cast(bf16x8, pw0), pf1 = __builtin_bit_cast(bf16x8, pw1);
    LAS const char* vp = Vb + (vrow0 + 4 * hi + ((lane & 15) >> 2)) * 64 + ((lane >> 4) & 1) * 32 + (lane & 3) * 8;
    { const bf16x8 v00 = cat8(vtr(vp), vtr(vp + 512)), v10 = cat8(vtr(vp + vdh), vtr(vp + vdh + 512));
      const bf16x8 v01 = cat8(vtr(vp + 1024), vtr(vp + 1536)), v11 = cat8(vtr(vp + vdh + 1024), vtr(vp + vdh + 1536));
      S.o0 = mfma32(v00, pf0, S.o0); S.o1 = mfma32(v10, pf0, S.o1);
      S.o0 = mfma32(v01, pf1, S.o0); S.o1 = mfma32(v11, pf1, S.o1); }
}

struct MobaBias { LAS const float* lut; int tq, s0; bool causal;
    DI float operator()(float p, int kvrel) const { const int dist = tq - (s0 + kvrel); const float v = p + lut[dist < 0 ? 0 : (dist > 1023 ? 1023 : dist)]; return (causal && dist < 0) ? -INFINITY : v; } };
DI void moba_tile(const Fr& F, const bf16* proj, int rowbase, int h, int n, int tq, bool valid, int slot, bool own, int wave_tile) {
    LAS const char* Kb = (LAS const char*)F.lds; LAS const char* Vb = (LAS const char*)(F.lds + 32768); LAS const float* lut = (LAS const float*)(F.lds + 98304);
    bf16* po = (bf16*)(F.ws + WS_ACT); float* pml = (float*)(F.ws + WS_PML);
    const int lane = F.lane, hi = lane >> 5;
    bf16x8 qf[4];
    { const bf16* qp = proj + (size_t)(rowbase + tq) * EV_N + EC_QB + h * 64 + hi * 8;
#pragma unroll
        for (int s = 0; s < 4; ++s) qf[s] = *(const bf16x8*)(qp + s * 16); }
    AttSt S; S.m = -1e30f; S.l = 0.f;
#pragma unroll
    for (int r = 0; r < 16; ++r) { S.o0[r] = 0.f; S.o1[r] = 0.f; }
    const int nst = own ? wave_tile + 1 : 8;
    for (int st = 0; st < nst; ++st) { MobaBias bf{lut, tq, n * 256 + st * 32, own && st == wave_tile};
        att_subtile(S, qf, Kb + st * 4096, Vb, 16384, st * 32, lane, bf); }
    const float lt = S.l + __shfl_xor(S.l, 32), inv = 1.f / lt;
    if (valid) { const size_t pi = ((size_t)(rowbase + tq) * 8 + h) * 4 + slot; bf16* o = po + pi * 64;
#pragma unroll
        for (int a4 = 0; a4 < 4; ++a4) { v2u w0, w1;
            w0.x = cvtpk(S.o0[4 * a4] * inv, S.o0[4 * a4 + 1] * inv); w0.y = cvtpk(S.o0[4 * a4 + 2] * inv, S.o0[4 * a4 + 3] * inv);
            w1.x = cvtpk(S.o1[4 * a4] * inv, S.o1[4 * a4 + 1] * inv); w1.y = cvtpk(S.o1[4 * a4 + 2] * inv, S.o1[4 * a4 + 3] * inv);
            *(v2u*)(o + 8 * a4 + 4 * hi) = w0; *(v2u*)(o + 32 + 8 * a4 + 4 * hi) = w1; }
        if (hi == 0) { f32x2 ml = {S.m, lt}; *(f32x2*)(pml + pi * 2) = ml; } }
}
DI void moba_unit(const Args& a, const Fr& F, int b, int h, int n) {
    const bf16* proj = (const bf16*)(F.ws + WS_PROJ); const unsigned* sel3 = (const unsigned*)(F.ws + WS_SEL3);
    LAS unsigned char* lds = F.lds; LAS unsigned* list = (LAS unsigned*)(lds + 65536); LAS float* lut = (LAS float*)(lds + 98304); LAS unsigned* misc = (LAS unsigned*)(lds + 102400);
    const int tid = F.tid, lane = F.lane, wave = F.wave, rowbase = b * SEQ;
    __syncthreads();
    { const bf16* kg = proj + (size_t)(rowbase + n * 256) * EV_N + EC_KB + h * 64; const bf16* vg = proj + (size_t)(rowbase + n * 256) * EV_N + EC_VB + h * 64;
#pragma unroll
        for (int i = 0; i < 4; ++i) { const int p = tid + i * NTHR;
            { const int r = p & 31, c = (p >> 5) & 7, st = p >> 8; const v4u v = *(const v4u*)(kg + (size_t)(st * 32 + r) * EV_N + c * 8); *(LAS v4u*)(lds + st * 4096 + c * 512 + r * 16) = v; }
            { const int cc = p & 3, row = (p >> 2) & 255, dh = p >> 10; const v4u v = *(const v4u*)(vg + (size_t)row * EV_N + dh * 32 + cc * 8); *(LAS v4u*)(lds + 32768 + dh * 16384 + row * 64 + cc * 16) = v; } }
        for (int d = tid; d < 1024; d += NTHR) lut[d] = a.in[9][t5_bucket(d) * 16 + 8 + h] * LOG2E; }
    if (tid == 0) misc[16] = 0u;
    __syncthreads();
    for (int tb = (n + 1) * 256; tb < SEQ; tb += NTHR) { const int t = tb + tid; const bool inr = t < SEQ;
        const unsigned s = inr ? sel3[(size_t)(rowbase + t) * 8 + h] : 0u; const unsigned nv = s >> 24; int slot = -1;
        if (nv > 0u && (s & 255u) == (unsigned)n) slot = 0; else if (nv > 1u && ((s >> 8) & 255u) == (unsigned)n) slot = 1; else if (nv > 2u && ((s >> 16) & 255u) == (unsigned)n) slot = 2;
        const unsigned long long bal = __ballot(slot >= 0); const unsigned wcnt = __popcll(bal);
        if (lane == 0) misc[wave] = wcnt;
        __syncthreads();
        unsigned off = misc[16], tot = 0u;
#pragma unroll
        for (int w = 0; w < 8; ++w) { const unsigned c = misc[w]; if (w < wave) off += c; tot += c; }
        if (slot >= 0) list[off + __popcll(bal & ((1ull << lane) - 1ull))] = ((unsigned)t << 2) | (unsigned)slot;
        __syncthreads();
        if (tid == 0) misc[16] += tot; }
    __syncthreads();
    const int nlist = (int)misc[16];
    moba_tile(F, proj, rowbase, h, n, n * 256 + wave * 32 + (lane & 31), true, 3, true, wave);
    const int ntl = (nlist + 31) >> 5;
    for (int tl = wave; tl < ntl; tl += 8) { const int li = tl * 32 + (lane & 31); const bool valid = li < nlist; const unsigned e = list[valid ? li : nlist - 1];
        moba_tile(F, proj, rowbase, h, n, (int)(e >> 2), valid, (int)(e & 3u), false, 0); }
}

DI void dsa_query(const Fr& F, int tok, LAS unsigned char* wl, LAS const unsigned char* bkt, LAS const float* tab) {
    const bf16* ql = (const bf16*)(F.ws + WS_QL); const bf16* ckvn = (const bf16*)(F.ws + WS_CKVN); const unsigned short* sel = (const unsigned short*)(F.ws + WS_SEL); bf16* ol = (bf16*)(F.ws + WS_OL);
    const int lane = F.lane, l15 = lane & 15, kg = lane >> 4, t = tok % SEQ, rowbase = tok - t;
    LAS unsigned short* selb = (LAS unsigned short*)wl; LAS unsigned char* cbuf = wl + 1024;
    *((LAS v2u*)selb + lane) = *((const v2u*)(sel + (size_t)tok * 256) + lane);
    bf16x8 qlf[4];
#pragma unroll
    for (int ks = 0; ks < 4; ++ks) { qlf[ks] = *(const bf16x8*)(ql + (size_t)tok * 1024 + (l15 & 7) * 128 + ks * 32 + kg * 8); if (l15 >= 8) qlf[ks] = (bf16x8){0, 0, 0, 0, 0, 0, 0, 0}; }
    float m = -1e30f, l = 0.f; f32x4 oT[8];
#pragma unroll
    for (int ct = 0; ct < 8; ++ct) oT[ct] = (f32x4){0.f, 0.f, 0.f, 0.f};
    const int nvalid = t + 1 < 256 ? t + 1 : 256, nch = (nvalid + 31) >> 5;
    LDS_WAIT();
    for (int ch = 0; ch < nch; ++ch) {
        bf16x8 af[2][4];
#pragma unroll
        for (int mt = 0; mt < 2; ++mt) { unsigned idx = selb[ch * 32 + mt * 16 + l15]; if (idx == 0xffffu) idx = 0u;
            const bf16* cp = ckvn + (size_t)(rowbase + (int)idx) * 128 + kg * 8;
#pragma unroll
            for (int ks = 0; ks < 4; ++ks) af[mt][ks] = *(const bf16x8*)(cp + ks * 32); }
        f32x4 acc[2];
#pragma unroll
        for (int mt = 0; mt < 2; ++mt) { acc[mt] = (f32x4){0.f, 0.f, 0.f, 0.f};
#pragma unroll
            for (int ks = 0; ks < 4; ++ks) { acc[mt] = mfma16(af[mt][ks], qlf[ks], acc[mt]); *(LAS bf16x8*)(cbuf + (mt * 16 + l15) * 288 + (ks * 32 + kg * 8) * 2) = af[mt][ks]; } }
        float mx = -INFINITY;
#pragma unroll
        for (int mt = 0; mt < 2; ++mt)
#pragma unroll
            for (int i = 0; i < 4; ++i) { const unsigned s = selb[ch * 32 + mt * 16 + 4 * kg + i]; const int dist = t - (int)s;
                const bool ok = (s != 0xffffu) && dist >= 0; const int dc = ok ? (dist > 1023 ? 1023 : dist) : 0;
                const float v = ok ? acc[mt][i] + tab[(int)bkt[dc] * 8 + (l15 & 7)] : -INFINITY; acc[mt][i] = v; mx = fmaxf(mx, v); }
        mx = fmaxf(mx, __shfl_xor(mx, 16)); mx = fmaxf(mx, __shfl_xor(mx, 32));
        const float mn = fmaxf(m, mx), sc = ex2(m - mn); m = mn;
        float ps = 0.f;
#pragma unroll
        for (int mt = 0; mt < 2; ++mt)
#pragma unroll
            for (int i = 0; i < 4; ++i) { acc[mt][i] = ex2(acc[mt][i] - mn); ps += acc[mt][i]; }
        l = l * sc + ps;
#pragma unroll
        for (int ct = 0; ct < 8; ++ct) oT[ct] = oT[ct] * sc;
        v4u pw; pw.x = cvtpk(acc[0][0], acc[0][1]); pw.y = cvtpk(acc[0][2], acc[0][3]); pw.z = cvtpk(acc[1][0], acc[1][1]); pw.w = cvtpk(acc[1][2], acc[1][3]);
        const bf16x8 pf = __builtin_bit_cast(bf16x8, pw);
        LDS_WAIT();
        LAS const char* tp = (LAS const char*)cbuf + (4 * kg + (l15 >> 2)) * 288 + (lane & 3) * 8;
#pragma unroll
        for (int ct = 0; ct < 8; ++ct) { const bf16x8 cf = cat8(vtr(tp + ct * 32), vtr(tp + 16 * 288 + ct * 32)); oT[ct] = mfma16(cf, pf, oT[ct]); }
        LDS_WAIT();
    }
    l += __shfl_xor(l, 16); l += __shfl_xor(l, 32);
    const float inv = 1.f / l;
    if (l15 < 8) { bf16* o = ol + (size_t)tok * 1024 + l15 * 128 + 4 * kg;
#pragma unroll
        for (int ct = 0; ct < 8; ++ct) { v2u w; w.x = cvtpk(oT[ct][0] * inv, oT[ct][1] * inv); w.y = cvtpk(oT[ct][2] * inv, oT[ct][3] * inv); *(v2u*)(o + ct * 16) = w; } }
}
DI void dsa_chunk(const Args& a, const Fr& F, int c32) {
    LAS unsigned char* bkt = F.lds + 81920; LAS float* tab = (LAS float*)(F.lds + 82944);
    __syncthreads();
    for (int d = F.tid; d < 1024; d += NTHR) bkt[d] = (unsigned char)t5_bucket(d);
    if (F.tid < 256) tab[F.tid] = a.in[9][(F.tid >> 3) * 16 + (F.tid & 7)] * LOG2E;
    __syncthreads();
#pragma unroll 1
    for (int i = 0; i < 4; ++i) dsa_query(F, c32 * 32 + F.wave * 4 + i, F.lds + F.wave * 10240, bkt, tab);
}

DI void ph_even_post(const Fr& F, int j) {
    const bf16* ol = (const bf16*)(F.ws + WS_OL); bf16* ao = (bf16*)(F.ws + WS_AO);
    const bf16* wuvt = (const bf16*)(F.ws + WS_WUVT) + (size_t)j * 8 * 64 * 128;
    const bf16* po = (const bf16*)(F.ws + WS_ACT); const float* pml = (const float*)(F.ws + WS_PML); const unsigned* sel3 = (const unsigned*)(F.ws + WS_SEL3);
    const int lane = F.lane, wave = F.wave, l15 = lane & 15, kg = lane >> 4;
    for (int chunk = F.blk; chunk < 256; chunk += F.G) { const int tok0 = chunk * 128;
        { const int h = wave; bf16x8 af[4][4];
#pragma unroll
            for (int mt = 0; mt < 4; ++mt)
#pragma unroll
                for (int ks = 0; ks < 4; ++ks) af[mt][ks] = *(const bf16x8*)(wuvt + ((size_t)h * 64 + mt * 16 + l15) * 128 + ks * 32 + kg * 8);
            for (int tg = 0; tg < 8; ++tg) { const int tok = tok0 + tg * 16 + l15; bf16x8 bf[4];
#pragma unroll
                for (int ks = 0; ks < 4; ++ks) bf[ks] = *(const bf16x8*)(ol + (size_t)tok * 1024 + h * 128 + ks * 32 + kg * 8);
#pragma unroll
                for (int mt = 0; mt < 4; ++mt) { f32x4 d = {0.f, 0.f, 0.f, 0.f};
#pragma unroll
                    for (int ks = 0; ks < 4; ++ks) d = mfma16(af[mt][ks], bf[ks], d);
                    v2u w; w.x = cvtpk(d[0], d[1]); w.y = cvtpk(d[2], d[3]); *(v2u*)(ao + (size_t)tok * 1024 + h * 64 + mt * 16 + 4 * kg) = w; } } }
        if (!(EXPF & 32)) for (int i = 0; i < 16; ++i) { const int tok = tok0 + wave * 16 + i, h = lane >> 3, d0 = (lane & 7) * 8;
            const unsigned nv = sel3[(size_t)tok * 8 + h] >> 24; const size_t pi = ((size_t)tok * 8 + h) * 4;
            float mj[4], lj[4];
#pragma unroll
            for (int s = 0; s < 4; ++s) { const bool ok = (s == 3) || ((unsigned)s < nv); const f32x2 ml = *(const f32x2*)(pml + (pi + s) * 2); mj[s] = ok ? ml[0] : -1e30f; lj[s] = ok ? ml[1] : 0.f; }
            const float ms = fmaxf(fmaxf(mj[0], mj[1]), fmaxf(mj[2], mj[3])); float wsum = 0.f, acc[8];
#pragma unroll
            for (int k = 0; k < 8; ++k) acc[k] = 0.f;
#pragma unroll
            for (int s = 0; s < 4; ++s) { const float w = lj[s] * ex2(mj[s] - ms); wsum += w;
                if (w > 0.f) { const v4u v = *(const v4u*)(po + (pi + s) * 64 + d0);
#pragma unroll
                    for (int k = 0; k < 4; ++k) { acc[2 * k] += w * bf2f(v[k] & 0xffffu); acc[2 * k + 1] += w * bf2f(v[k] >> 16); } } }
            const float inv = 1.f / wsum; v4u o; o.x = cvtpk(acc[0] * inv, acc[1] * inv); o.y = cvtpk(acc[2] * inv, acc[3] * inv); o.z = cvtpk(acc[4] * inv, acc[5] * inv); o.w = cvtpk(acc[6] * inv, acc[7] * inv);
            *(v4u*)(ao + (size_t)tok * 1024 + 512 + h * 64 + d0) = o; }
    }
}
DI void ph_odd_prep(const Args& a, const Fr& F, int j, int layer) {
    const bf16* proj = (const bf16*)(F.ws + WS_PROJ); const float* x = (const float*)(F.ws + WS_X);
    float* logf = (float*)(F.ws + WS_LOGF); float* cs = (float*)(F.ws + WS_CS);
    const float* wf = a.in[6] + (size_t)j * 1024 * 3088 + 3072; const float* bfv = a.in[7] + j * 16;
    LAS float* xs = (LAS float*)(F.lds + F.wave * 16384); LAS float* lfb = (LAS float*)(F.lds + 131072);
    LAS unsigned* kmx = (LAS unsigned*)(F.lds + 131072 + 8192);
    const int lane = F.lane, wave = F.wave, tid = F.tid;
    for (int chunk = F.blk; chunk < 256; chunk += F.G) { const int tok0 = chunk * 128, b = tok0 / SEQ, t0 = tok0 % SEQ;
        __syncthreads();
        if (tid < 16) kmx[tid] = 0u;
        __syncthreads();
        for (int grp = 0; grp < 4; ++grp) { const int tl0 = wave * 16 + grp * 4;
#pragma unroll
            for (int k = 0; k < 4; ++k) { const f32x4* xr = (const f32x4*)(x + (size_t)(tok0 + tl0 + k) * DM) + lane;
#pragma unroll
                for (int jj = 0; jj < 4; ++jj) *((LAS f32x4*)(xs + k * 1024) + lane + 64 * jj) = xr[64 * jj]; }
            LDS_WAIT();
            float acc[4]; small_proj<16>(xs, wf, 3088, lane, acc);
            const int n = lane & 15;
#pragma unroll
            for (int k = 0; k < 4; ++k) { const float z = acc[k] + bfv[n];
                const float ls = fminf(z, 0.f) - log1pf(__expf(-fabsf(z)));
                if (lane < 16) lfb[(tl0 + k) * 16 + n] = ls * LOG2E; }
            LDS_WAIT(); }
#pragma unroll 1
        for (int i = 0; i < 4; ++i) { const int p = tid + i * NTHR, tl = p >> 4, h = p & 15; const v4u* kp = (const v4u*)(proj + (size_t)(tok0 + tl) * OD_N + OC_K + h * 64); float s = 0.f;
#pragma unroll
            for (int c = 0; c < 8; ++c) { const v4u w = kp[c];
#pragma unroll
                for (int k = 0; k < 4; ++k) { const float e0 = bf2f(w[k] & 0xffffu), e1 = bf2f(w[k] >> 16); s += e0 * e0 + e1 * e1; } }
            __hip_atomic_fetch_max(kmx + h, __float_as_uint(s), __ATOMIC_RELAXED, __HIP_MEMORY_SCOPE_WORKGROUP); }
        __syncthreads();
        for (int i = tid; i < 2048; i += NTHR) { const int h = i >> 7, tl = i & 127; logf[((size_t)b * 16 + h) * SEQ + t0 + tl] = lfb[tl * 16 + h]; }
        if (tid < 32) { const int h = tid & 15, c = tid >> 4; float s = 0.f;
            for (int k = 0; k < 64; ++k) s += lfb[(c * 64 + k) * 16 + h];
            cs[((size_t)b * 16 + h) * 128 + (t0 >> 6) + c] = s; }
        if (tid < 16) __hip_atomic_fetch_max(F.ctl + CW_KMAX + layer * 64 + b * 16 + tid, kmx[tid], RLX_AGENT);
    }
}

struct FoxBias { LAS const float* ng; int tq, kabs0; bool diag;
    DI float operator()(float p, int kvrel) const { const float v = p + ng[kvrel]; return (diag && (kabs0 + kvrel) > tq) ? -INFINITY : v; } };
DI void fox_unit(const Fr& F, int layer, int b, int h, int qb) {
    const bf16* proj = (const bf16*)(F.ws + WS_PROJ); const float* logf = (const float*)(F.ws + WS_LOGF); const float* cs = (const float*)(F.ws + WS_CS); bf16* ao = (bf16*)(F.ws + WS_AO);
    LAS unsigned char* lds = F.lds; LAS float* ng = (LAS float*)(lds + 32768); LAS float* red = (LAS float*)(lds + 65536 + 1024); LAS int* ibox = (LAS int*)(lds + 65536 + 2048);
    const int tid = F.tid, lane = F.lane, wave = F.wave, r32 = lane & 31, hi = lane >> 5, t0 = qb * 256, rowbase = b * SEQ, tq = t0 + wave * 32 + r32;
    __syncthreads();
    bf16x8 qf[4]; float qs = 0.f;
    { const bf16* qp = proj + (size_t)(rowbase + tq) * OD_N + OC_Q + h * 64 + hi * 8;
#pragma unroll
        for (int s = 0; s < 4; ++s) { qf[s] = *(const bf16x8*)(qp + s * 16);
#pragma unroll
            for (int k = 0; k < 8; ++k) { const float e = bf2f((unsigned short)qf[s][k]); qs += e * e; } } }
    qs += __shfl_xor(qs, 32); qs = wave_max(qs);
    if (lane == 0) red[wave] = qs;
    __syncthreads();
    if (tid == 0) { float qm = red[0];
        for (int w = 1; w < 8; ++w) qm = fmaxf(qm, red[w]);
        const float km = __uint_as_float(ld_u32(F.ctl + CW_KMAX + layer * 64 + b * 16 + h));
        const float B2 = 2.f * (sqrtf(qm * km) * 1.01f + 1.f);
        int kt = t0 / 64 - 1, kts = t0 / 64; float D = 0.f;
        while (kt >= 0 && B2 + D >= -160.f) { kts = kt; D += cs[((size_t)b * 16 + h) * 128 + kt]; --kt; }
        ibox[0] = kts; }
    __syncthreads();
    const int kts = ibox[0], s_start = kts * 64, nel = t0 + 256 - s_start;
    { const int i0 = tid * 16; float v[16]; const float* lp = logf + ((size_t)b * 16 + h) * SEQ + s_start + i0;
        if (i0 < nel) {
#pragma unroll
            for (int c = 0; c < 4; ++c) { const f32x4 w = *(const f32x4*)(lp + 4 * c); v[4 * c] = w[0]; v[4 * c + 1] = w[1]; v[4 * c + 2] = w[2]; v[4 * c + 3] = w[3]; } }
        else {
#pragma unroll
            for (int c = 0; c < 16; ++c) v[c] = 0.f; }
#pragma unroll
        for (int c = 1; c < 16; ++c) v[c] += v[c - 1];
        float xsum = v[15];
#pragma unroll
        for (int o = 1; o < 64; o <<= 1) { const float y = __shfl_up(xsum, o); if (lane >= o) xsum += y; }
        if (lane == 63) red[16 + wave] = xsum;
        __syncthreads();
        float off = xsum - v[15];
        for (int w = 0; w < wave; ++w) off += red[16 + w];
        if (i0 < nel) {
#pragma unroll
            for (int c = 0; c < 4; ++c) { f32x4 w = {-(off + v[4 * c]), -(off + v[4 * c + 1]), -(off + v[4 * c + 2]), -(off + v[4 * c + 3])}; *(LAS f32x4*)(ng + i0 + 4 * c) = w; } }
    }
    const int ntile = t0 / 64 + 4 - kts;
    const bf16* kg = proj + (size_t)rowbase * OD_N + OC_K + h * 64; const bf16* vg = proj + (size_t)rowbase * OD_N + OC_V + h * 64;
    const int kr = tid & 31, kc = (tid >> 5) & 7, kst = tid >> 8, vcc = tid & 3, vrow = (tid >> 2) & 63, vdh = tid >> 8;
    const int koff = kst * 4096 + kc * 512 + kr * 16, voff = 8192 + vdh * 4096 + vrow * 64 + vcc * 16;
    { const v4u kv = *(const v4u*)(kg + (size_t)(kts * 64 + kst * 32 + kr) * OD_N + kc * 8), vv = *(const v4u*)(vg + (size_t)(kts * 64 + vrow) * OD_N + vdh * 32 + vcc * 8);
        *(LAS v4u*)(lds + koff) = kv; *(LAS v4u*)(lds + voff) = vv; }
    __syncthreads();
    AttSt S; S.m = -1e30f; S.l = 0.f;
#pragma unroll
    for (int r = 0; r < 16; ++r) { S.o0[r] = 0.f; S.o1[r] = 0.f; }
    const int wlast = t0 + wave * 32 + 31, wfirst = t0 + wave * 32;
    for (int i = 0; i < ntile; ++i) { const int kt = kts + i; LAS unsigned char* buf = lds + (i & 1) * 16384; LAS unsigned char* nbuf = lds + ((i + 1) & 1) * 16384;
        v4u kv, vv; const bool more = i + 1 < ntile;
        if (more) { kv = *(const v4u*)(kg + (size_t)((kt + 1) * 64 + kst * 32 + kr) * OD_N + kc * 8); vv = *(const v4u*)(vg + (size_t)((kt + 1) * 64 + vrow) * OD_N + vdh * 32 + vcc * 8); }
#pragma unroll
        for (int sub = 0; sub < 2; ++sub) { const int kv0 = kt * 64 + sub * 32;
            if (kv0 <= wlast) { FoxBias bf{ng + (kv0 - s_start), tq, kv0, kv0 + 31 > wfirst};
                att_subtile(S, qf, (LAS const char*)buf + sub * 4096, (LAS const char*)buf + 8192, 4096, sub * 32, lane, bf); } }
        if (more) { *(LAS v4u*)(nbuf + koff) = kv; *(LAS v4u*)(nbuf + voff - 8192 + 8192) = vv; }
        __syncthreads(); }
    const float lt = S.l + __shfl_xor(S.l, 32), inv = 1.f / lt;
    bf16* o = ao + (size_t)(rowbase + tq) * 1024 + h * 64;
#pragma unroll
    for (int a4 = 0; a4 < 4; ++a4) { v2u w0, w1;
        w0.x = cvtpk(S.o0[4 * a4] * inv, S.o0[4 * a4 + 1] * inv); w0.y = cvtpk(S.o0[4 * a4 + 2] * inv, S.o0[4 * a4 + 3] * inv);
        w1.x = cvtpk(S.o1[4 * a4] * inv, S.o1[4 * a4 + 1] * inv); w1.y = cvtpk(S.o1[4 * a4 + 2] * inv, S.o1[4 * a4 + 3] * inv);
        *(v2u*)(o + 8 * a4 + 4 * hi) = w0; *(v2u*)(o + 32 + 8 * a4 + 4 * hi) = w1; }
}

DI void ph_ln1_router(const Args& a, const Fr& F, int layer) {
    const float* yp = (const float*)(F.ws + WS_YP); float* x1 = (float*)(F.ws + WS_X1); bf16* xb = (bf16*)(F.ws + WS_XB);
    unsigned* tope = (unsigned*)(F.ws + WS_TOPE); float* gate = (float*)(F.ws + WS_GATE); unsigned* rank = (unsigned*)(F.ws + WS_RANK);
    const float* g = a.in[10] + (size_t)(layer * 2) * DM; const float* bb = a.in[11] + (size_t)(layer * 2) * DM;
    const float* rw = a.in[12] + (size_t)layer * 1024 * 32; const float* rb = a.in[13] + layer * 32;
    LAS float* xs = (LAS float*)(F.lds + F.wave * 16384); LAS unsigned* lcnt = (LAS unsigned*)(F.lds + 131072);
    const int lane = F.lane, wave = F.wave, tid = F.tid;
    for (int chunk = F.blk; chunk < 256; chunk += F.G) { const int tok0 = chunk * 128;
        __syncthreads();
        if (tid < 32) lcnt[tid] = 0u;
        __syncthreads();
        for (int grp = 0; grp < 4; ++grp) { const int tb = tok0 + wave * 16 + grp * 4;
#pragma unroll 1
            for (int k = 0; k < 4; ++k) { const int tok = tb + k; f32x4 v[4];
#pragma unroll
                for (int jj = 0; jj < 4; ++jj) v[jj] = *((const f32x4*)(yp + (size_t)tok * DM) + lane + 64 * jj);
                ln_row(v, g, bb, lane);
                store_row_f32(x1 + (size_t)tok * DM, v, lane); store_row_bf16(xb + (size_t)tok * DM, v, lane);
#pragma unroll
                for (int jj = 0; jj < 4; ++jj) *((LAS f32x4*)(xs + k * 1024) + lane + 64 * jj) = v[jj]; }
            LDS_WAIT();
            float acc[4]; small_proj<32>(xs, rw, 32, lane, acc);
            const float rbn = rb[lane & 31];
#pragma unroll
            for (int k = 0; k < 4; ++k) { float v = lane < 32 ? acc[k] + rbn : -INFINITY; float tv[4]; int te[4];
#pragma unroll
                for (int r = 0; r < 4; ++r) { const float mx = wave_max(v); const unsigned long long mk = __ballot(v == mx); const int e = __builtin_ctzll(mk) & 31; tv[r] = mx; te[r] = e; if (lane == e) v = -INFINITY; }
                const float e1 = __expf(tv[1] - tv[0]), e2 = __expf(tv[2] - tv[0]), e3 = __expf(tv[3] - tv[0]); const float inv = 1.f / (1.f + e1 + e2 + e3);
                if (lane < 4) { const int e = lane == 0 ? te[0] : lane == 1 ? te[1] : lane == 2 ? te[2] : te[3]; const float gv = (lane == 0 ? 1.f : lane == 1 ? e1 : lane == 2 ? e2 : e3) * inv;
                    const unsigned rk = __hip_atomic_fetch_add(lcnt + e, 1u, __ATOMIC_RELAXED, __HIP_MEMORY_SCOPE_WORKGROUP);
                    const size_t o = (size_t)(tb + k) * 4 + lane; tope[o] = (unsigned)e; gate[o] = gv; rank[o] = rk; } }
            LDS_WAIT(); }
        __syncthreads();
        if (tid < 32) __hip_atomic_store(F.ctl + CW_CNT + chunk * 32 + tid, lcnt[tid], RLX_AGENT);
    }
}

DI void ph_route(const Fr& F) {
    const bf16* xb = (const bf16*)(F.ws + WS_XB); bf16* xg = (bf16*)(F.ws + WS_XG);
    const unsigned* tope = (const unsigned*)(F.ws + WS_TOPE); const unsigned* rank = (const unsigned*)(F.ws + WS_RANK); unsigned* dest = (unsigned*)(F.ws + WS_DEST);
    LAS unsigned* P = (LAS unsigned*)(F.lds); LAS unsigned* pst = P + 512; LAS unsigned* pad = P + 544; LAS unsigned* base = P + 576; LAS unsigned* nt = P + 608;
    const int tid = F.tid, lane = F.lane, wave = F.wave;
    __syncthreads();
    { const int e = tid & 31, part = tid >> 5; unsigned s = 0u;
        for (int c = 0; c < 16; ++c) s += ld_u32(F.ctl + CW_CNT + (part * 16 + c) * 32 + e);
        P[part * 32 + e] = s; }
    __syncthreads();
    if (tid < 32) { unsigned tot = 0u;
        for (int p = 0; p < 16; ++p) tot += P[p * 32 + tid];
        pad[tid] = (tot + 255u) & ~255u; }
    __syncthreads();
    if (tid == 0) { unsigned acc = 0u;
        for (int e = 0; e < 32; ++e) { pst[e] = acc; acc += pad[e]; }
        nt[0] = acc >> 8; }
    __syncthreads();
    for (int chunk = F.blk; chunk < 256; chunk += F.G) {
        __syncthreads();
        if (tid < 32) { unsigned off = 0u; const int pf = chunk >> 4;
            for (int p = 0; p < pf; ++p) off += P[p * 32 + tid];
            for (int c = pf * 16; c < chunk; ++c) off += ld_u32(F.ctl + CW_CNT + c * 32 + tid);
            base[tid] = pst[tid] + off; }
        __syncthreads();
        for (int i = 0; i < 16; ++i) { const int tok = chunk * 128 + wave * 16 + i;
            const v4u src0 = *((const v4u*)(xb + (size_t)tok * DM) + lane), src1 = *((const v4u*)(xb + (size_t)tok * DM) + 64 + lane);
#pragma unroll
            for (int k = 0; k < 4; ++k) { const unsigned e = tope[(size_t)tok * 4 + k], d = base[e] + rank[(size_t)tok * 4 + k];
                if (lane == 0) dest[(size_t)tok * 4 + k] = d;
                *((v4u*)(xg + (size_t)d * DM) + lane) = src0; *((v4u*)(xg + (size_t)d * DM) + 64 + lane) = src1; } }
        if (chunk == 0) { const unsigned ntl = nt[0];
            if (tid == 0) __hip_atomic_store(F.ctl + CW_TILE, ntl, RLX_AGENT);
            for (unsigned i = tid; i < ntl; i += NTHR) { unsigned e = 0u;
                for (unsigned k = 1; k < 32; ++k) if (pst[k] <= i * 256u) e = k;
                __hip_atomic_store(F.ctl + CW_TILE + 64 + i, e, RLX_AGENT); } }
    }
}

DI void ph_combine_ln2(const Args& a, const Fr& F, int layer) {
    const float* x1 = (const float*)(F.ws + WS_X1); const bf16* yr = (const bf16*)(F.ws + WS_XG); float* xo = (float*)(F.ws + WS_X); bf16* xb = (bf16*)(F.ws + WS_XB);
    const float* gate = (const float*)(F.ws + WS_GATE); const unsigned* dest = (const unsigned*)(F.ws + WS_DEST);
    const float* g = a.in[10] + (size_t)(layer * 2 + 1) * DM; const float* bb = a.in[11] + (size_t)(layer * 2 + 1) * DM;
    const int lane = F.lane; const int gw = F.blk * NWAVES + F.wave, NGW = F.G * NWAVES;
    for (int tok = gw; tok < NTOK; tok += NGW) { f32x4 v[4];
#pragma unroll
        for (int jj = 0; jj < 4; ++jj) v[jj] = *((const f32x4*)(x1 + (size_t)tok * DM) + lane + 64 * jj) * ALPHA;
#pragma unroll
        for (int k = 0; k < 4; ++k) { const float gk = gate[(size_t)tok * 4 + k]; const unsigned d = dest[(size_t)tok * 4 + k];
#pragma unroll
            for (int jj = 0; jj < 4; ++jj) { const v2u w = *((const v2u*)(yr + (size_t)d * DM) + lane + 64 * jj);
                v[jj][0] += gk * bf2f(w.x & 0xffffu); v[jj][1] += gk * bf2f(w.x >> 16); v[jj][2] += gk * bf2f(w.y & 0xffffu); v[jj][3] += gk * bf2f(w.y >> 16); } }
        ln_row(v, g, bb, lane);
        if (layer == DEPTH - 1) store_row_f32(a.out + (size_t)tok * DM, v, lane);
        else { store_row_f32(xo + (size_t)tok * DM, v, lane); store_row_bf16(xb + (size_t)tok * DM, v, lane); } }
}
constexpr int LDS_BYTES = 147456;
constexpr int LDS_BARW = 145408, LDS_QSLOT = 145472;
constexpr int NPL = 11;
constexpr int NPHASE = 1 + NPL * DEPTH;
#ifndef MK_SINGLE
#define MK_SINGLE 0
#endif
DI int q_next(const Fr& F, unsigned* ctr) {
    LAS int* slot = (LAS int*)(F.lds + LDS_QSLOT);
    __syncthreads();
    if (F.tid == 0) *slot = (int)__hip_atomic_fetch_add(ctr, 1u, RLX_AGENT);
    __syncthreads();
    return *slot;
}
#define RETID(F) do { int t2_ = F.tid; asm volatile("" : "+v"(t2_)); F.tid = t2_; F.lane = t2_ & 63; F.wave = __builtin_amdgcn_readfirstlane(t2_ >> 6); } while (0)
#define AS4 __attribute__((address_space(4)))
#define SITE() Args a; Fr F; { const AS4 Args* ap = (const AS4 Args*)__builtin_amdgcn_kernarg_segment_ptr(); asm volatile("" : "+s"(ap)); \
        _Pragma("unroll") for (int i_ = 0; i_ < 18; ++i_) a.in[i_] = ap->in[i_]; a.out = ap->out; a.ws = ap->ws; a.ph_lo = 0; a.ph_hi = 0; \
        int w_ = wv_s; asm volatile("" : "+s"(w_)); int t_ = w_ * 64 + (int)__builtin_amdgcn_mbcnt_hi(~0u, __builtin_amdgcn_mbcnt_lo(~0u, 0u)); asm volatile("" : "+v"(t_)); F.tid = t_; F.lane = t_ & 63; F.wave = __builtin_amdgcn_readfirstlane(t_ >> 6); \
        F.lds = (LAS unsigned char*)lds_raw; F.ws = a.ws; F.ctl = (unsigned*)(a.ws + WS_CTL); F.blk = blockIdx.x; F.G = gridDim.x; }
__global__ void __launch_bounds__(NTHR, 2) mega_fwd(Args a0) {
    extern __shared__ __attribute__((aligned(16))) unsigned char lds_raw[];
    const int wv_s = __builtin_amdgcn_readfirstlane((int)(threadIdx.x >> 6));
#if MK_SINGLE
    constexpr int lo = 0, hi = NPHASE; constexpr bool single = true;
#else
    const int lo = a0.ph_lo, hi = a0.ph_hi; constexpr bool single = false;
#endif
    if (threadIdx.x == 0) *(LAS v4u*)((LAS unsigned char*)lds_raw + LDS_BARW) = (v4u){0u, 0u, 0u, 0u};
    __syncthreads();
    XcdBarrier bar; bar.bar = (unsigned*)(a0.ws + WS_CTL) + CW_BAR; bar.x = 0; bar.st = (volatile LAS unsigned*)((LAS unsigned char*)lds_raw + LDS_BARW);
    if (single) bar = xcd_barrier_post((unsigned*)(a0.ws + WS_CTL) + CW_BAR, (volatile LAS unsigned*)((LAS unsigned char*)lds_raw + LDS_BARW));
#define IN(k) (lo <= (k) && (k) < hi)
#define SEAM() do { if (single) xcd_barrier(bar); } while (0)
    if (IN(0)) { { SITE(); ph_prologue(a, F); } SEAM(); }
#pragma unroll 1
    for (int L = 0; L < DEPTH; ++L) {
        const int pb = 1 + NPL * L, j = L >> 1; const bool odd = (L & 1) != 0;
        if (IN(pb + 0)) {
            { SITE();
            const bf16* w = odd ? (const bf16*)(F.ws + WS_WOD) + (size_t)j * OD_N * 1024 : (const bf16*)(F.ws + WS_WEV) + (size_t)j * EV_N * 1024;
            const int N = odd ? OD_N : EV_N;
            pg8::Gemm g{(const bf16*)(F.ws + WS_XB), w, NTOK, N, 1024}; pg8::StaticOrder S; S.init(NTOK, N, F.G, F.blk);
            pg8::EpiBf16<0> E{(bf16*)(F.ws + WS_PROJ), N, nullptr, 1024, (size_t)1024, C2F};
            pg8::gemm_phase<pg8::EpiBf16<0>, pg8::StaticOrder, true, true>(F.lds, g, S, E, F.tid); }
            SEAM(); }
        if (IN(pb + 1)) { { SITE(); if (odd) ph_odd_prep(a, F, j, L); else ph_even_prep(a, F, j); } SEAM(); }
        if (!odd && IN(pb + 2)) {
            { SITE(); unsigned* ctr = F.ctl + CW_Q + 64 * (L * 2);
            for (;;) { const int it = q_next(F, ctr); if (it >= 1280) break; RETID(F);
                if (it < 1024) { if (!(EXPF & 16)) idx_unit(F, it & 3, 255 - (it >> 2)); } else { if (!(EXPF & 32)) moba_gate_chunk(F, it - 1024); } } }
            SEAM(); }
        if (IN(pb + 3)) {
            { SITE(); unsigned* ctr = F.ctl + CW_Q + 64 * (L * 2 + 1);
            if (odd) { for (;;) { const int it = q_next(F, ctr); if (it >= 2048) break; RETID(F); const int bh = it & 63; fox_unit(F, L, bh >> 4, bh & 15, 31 - (it >> 6)); } }
            else { for (;;) { const int it = q_next(F, ctr); if (it >= 2048) break; RETID(F);
                    if (it < 1024) { const int bh = it & 31; if (!(EXPF & 32)) moba_unit(a, F, bh >> 3, bh & 7, it >> 5); } else { if (!(EXPF & 16) && !(EXPF & 256)) dsa_chunk(a, F, it - 1024); } } } }
            SEAM(); }
        if (!odd && IN(pb + 4)) { { SITE(); ph_even_post(F, j); } SEAM(); }
        if (IN(pb + 5)) {
            { SITE();
            const float* xin = (L == 0) ? a.in[0] : (const float*)(F.ws + WS_X);
            pg8::Gemm g{(const bf16*)(F.ws + WS_AO), (const bf16*)(F.ws + WS_WOUT) + (size_t)L * 1024 * 1024, NTOK, 1024, 1024}; pg8::StaticOrder S; S.init(NTOK, 1024, F.G, F.blk);
            EpiResF32 E{xin, (float*)(F.ws + WS_YP), ALPHA};
            pg8::gemm_phase<EpiResF32, pg8::StaticOrder, true, true>(F.lds, g, S, E, F.tid); }
            SEAM(); }
        if (IN(pb + 6)) { { SITE(); ph_ln1_router(a, F, L); } SEAM(); }
        if (IN(pb + 7)) { { SITE(); ph_route(F); } SEAM(); }
        if (IN(pb + 8)) {
            { SITE(); const int ntl = (int)ld_u32(F.ctl + CW_TILE);
            pg8::Gemm g{(const bf16*)(F.ws + WS_XG), (const bf16*)(F.ws + WS_WGU) + (size_t)L * 32 * 2048 * 1024, NR_MAX, 32 * 2048, 1024};
            GroupOrder S{F.ctl + CW_TILE + 64, ntl, 3, F.G, F.blk};
            EpiSwiglu E{(bf16*)(F.ws + WS_ACT), a.in[15] + (size_t)L * 32 * 2048};
            pg8::gemm_phase<EpiSwiglu, GroupOrder, true, true>(F.lds, g, S, E, F.tid); }
            SEAM(); }
        if (IN(pb + 9)) {
            { SITE(); const int ntl = (int)ld_u32(F.ctl + CW_TILE);
            pg8::Gemm g{(const bf16*)(F.ws + WS_ACT), (const bf16*)(F.ws + WS_WDN) + (size_t)L * 32 * 1024 * 1024, NR_MAX, 32 * 1024, 1024};
            GroupOrder S{F.ctl + CW_TILE + 64, ntl, 2, F.G, F.blk};
            EpiDown E{(bf16*)(F.ws + WS_XG), a.in[17] + (size_t)L * 32 * 1024};
            pg8::gemm_phase<EpiDown, GroupOrder, true, true>(F.lds, g, S, E, F.tid); }
            SEAM(); }
        if (IN(pb + 10)) { { SITE(); ph_combine_ln2(a, F, L); } if (L + 1 < DEPTH) SEAM(); }
    }
#undef IN
#undef SEAM
}

extern "C" void kernel_launch(void* const* d_in, const int* in_sizes, int n_in, void* d_out, int out_size, void* d_ws, size_t ws_size, hipStream_t stream) {
    static int grid = 0;
    if (grid == 0) {
        if (n_in != 18 || out_size != NTOK * DM || ws_size < WS_END) { fprintf(stderr, "kernel_launch: unexpected shapes (n_in %d, out %d, ws %zu); nothing launched\n", n_in, out_size, ws_size); grid = -1; return; }
        int dev = 0, cus = 0, per_cu = 0;
        if (hipGetDevice(&dev) != hipSuccess || hipDeviceGetAttribute(&cus, hipDeviceAttributeMultiprocessorCount, dev) != hipSuccess) { grid = -1; return; }
        if (hipFuncSetAttribute((const void*)mega_fwd, hipFuncAttributeMaxDynamicSharedMemorySize, LDS_BYTES) != hipSuccess) { fprintf(stderr, "kernel_launch: hipFuncSetAttribute failed\n"); grid = -1; return; }
        if (hipOccupancyMaxActiveBlocksPerMultiprocessor(&per_cu, (const void*)mega_fwd, NTHR, LDS_BYTES) != hipSuccess || per_cu < 1) fprintf(stderr, "kernel_launch: occupancy query reports %d\n", per_cu);
        (void)hipGetLastError();
        grid = cus;
    }
    if (grid < 0) return;
    (void)hipMemsetAsync((char*)d_ws + WS_CTL, 0, CTL_ZERO_BYTES, stream);
#ifdef EXP_SKIP
    (void)hipMemsetAsync((char*)d_ws + WS_AO, 0, 64 * MiB, stream);
    (void)hipMemsetAsync((char*)d_ws + WS_OL, 0, 64 * MiB, stream);
    if (EXP_SKIP & 4) { (void)hipMemsetAsync((char*)d_ws + WS_XG, 0, 272 * MiB, stream); (void)hipMemsetAsync((char*)d_ws + WS_DEST, 0, 1 * MiB, stream); }
#endif
    Args a{};
    for (int i = 0; i < 18; ++i) a.in[i] = (const float*)d_in[i];
    a.out = (float*)d_out; a.ws = (unsigned char*)d_ws;
#if MK_SINGLE
    a.ph_lo = 0; a.ph_hi = NPHASE;
    hipLaunchKernelGGL(mega_fwd, dim3(grid), dim3(NTHR), LDS_BYTES, stream, a);
#else
    for (int p = 0; p < NPHASE; ++p) {
        if (p > 0) { const int L = (p - 1) / NPL, q = (p - 1) % NPL; if ((L & 1) && (q == 2 || q == 4)) continue;
#ifdef EXP_SKIP
            if ((EXP_SKIP & 1) && !(L & 1) && q <= 4) continue;
            if ((EXP_SKIP & 2) && (L & 1) && q <= 4) continue;
            if ((EXP_SKIP & 4) && q >= 7 && q <= 9) continue;
#endif
        }
        a.ph_lo = p; a.ph_hi = p + 1;
        hipLaunchKernelGGL(mega_fwd, dim3(grid), dim3(NTHR), LDS_BYTES, stream, a);
    }
#endif
}
```

```cpp
#include <hip/hip_runtime.h>
#include <cstdio>
#include <cstdint>
#ifdef EXP_SKIP
#define EXPF EXP_SKIP
#else
#define EXPF 0
#endif
constexpr int NB = 4, SEQ = 8192, DM = 1024, NTOK = NB * SEQ, DEPTH = 4;
constexpr int EV_N = 2560, OD_N = 3072;
constexpr int EC_QA = 0, EC_QB = 512, EC_KB = 1024, EC_VB = 1536, EC_CKV = 2048, EC_QI = 2176, EC_KI = 2432, EC_WI = 2496;
constexpr int OC_Q = 0, OC_K = 1024, OC_V = 2048;
constexpr float LOG2E = 1.4426950408889634f;
constexpr float C2F = 0.125f * LOG2E;
constexpr float ALPHA = 1.681792830507429f;
constexpr float LN_EPS = 1e-5f;
constexpr int NR_MAX = 131072 + 32 * 256;
constexpr int NWAVES = 8, NTHR = 512;
constexpr size_t MiB = (size_t)1 << 20;
constexpr size_t WS_CTL = 0, CTL_ZERO_BYTES = 4 * MiB;
constexpr size_t WS_WEV = 8 * MiB, WS_WOD = 18 * MiB, WS_WOUT = 30 * MiB, WS_WUKT = 38 * MiB, WS_WUVT = 39 * MiB;
constexpr size_t WS_WGU = 40 * MiB, WS_WDN = 552 * MiB;
constexpr size_t WS_X = 808 * MiB, WS_X1 = 936 * MiB, WS_YP = 1064 * MiB, WS_XB = 1192 * MiB;
constexpr size_t WS_PROJ = 1256 * MiB, WS_AO = 1448 * MiB, WS_XG = 1512 * MiB, WS_ACT = 1784 * MiB;
constexpr size_t WS_QL = 2056 * MiB, WS_OL = 2120 * MiB, WS_CKVN = 2184 * MiB, WS_SEL = 2192 * MiB;
constexpr size_t WS_KBAR = 2208 * MiB, WS_SEL3 = 2209 * MiB, WS_LOGF = 2210 * MiB, WS_CS = 2212 * MiB;
constexpr size_t WS_TOPE = 2213 * MiB, WS_GATE = 2214 * MiB, WS_RANK = 2215 * MiB, WS_DEST = 2216 * MiB, WS_PML = 2217 * MiB;
constexpr size_t WS_END = 2226 * MiB;
constexpr int CW_BAR = 4096, CW_Q = 8192, CW_KMAX = 12288, CW_CNT = 16384, CW_TILE = 32768;

#define GAS __attribute__((address_space(1)))
#define LAS __attribute__((address_space(3)))
#define DI __device__ __forceinline__
typedef unsigned short bf16;
typedef unsigned v4u __attribute__((ext_vector_type(4)));
typedef unsigned v2u __attribute__((ext_vector_type(2)));
typedef float f32x4 __attribute__((ext_vector_type(4)));
typedef float f32x2 __attribute__((ext_vector_type(2)));
typedef float f32x16 __attribute__((ext_vector_type(16)));
typedef short bf16x8 __attribute__((ext_vector_type(8)));
typedef short s16x4 __attribute__((ext_vector_type(4)));
typedef __bf16 bf16x2_t __attribute__((ext_vector_type(2)));
typedef GAS unsigned gu32;
#define RLX_AGENT __ATOMIC_RELAXED, __HIP_MEMORY_SCOPE_AGENT
#define LDS_WAIT() asm volatile("s_waitcnt lgkmcnt(0)" ::: "memory")

DI float bf2f(unsigned v) { return __uint_as_float(v << 16); }
DI unsigned cvtpk(float lo, float hi) { f32x2 v = {lo, hi}; bf16x2_t b = __builtin_convertvector(v, bf16x2_t); return __builtin_bit_cast(unsigned, b); }
DI unsigned f2bf(float f) { return cvtpk(f, 0.f) & 0xffffu; }
DI float ex2(float x) { return __builtin_amdgcn_exp2f(x); }
DI float wave_sum(float v) {
#pragma unroll
    for (int o = 1; o < 64; o <<= 1) v += __shfl_xor(v, o);
    return v;
}
DI float wave_max(float v) {
#pragma unroll
    for (int o = 1; o < 64; o <<= 1) v = fmaxf(v, __shfl_xor(v, o));
    return v;
}
DI unsigned ld_u32(const unsigned* p) { return __hip_atomic_load(p, RLX_AGENT); }
DI int crow(int r, int hi) { return (r & 3) + 8 * (r >> 2) + 4 * hi; }
DI f32x16 mfma32(bf16x8 a, bf16x8 b, f32x16 c) { return __builtin_amdgcn_mfma_f32_32x32x16_bf16(a, b, c, 0, 0, 0); }
DI f32x4 mfma16(bf16x8 a, bf16x8 b, f32x4 c) { return __builtin_amdgcn_mfma_f32_16x16x32_bf16(a, b, c, 0, 0, 0); }
typedef short v4i16_t __attribute__((ext_vector_type(4)));
DI s16x4 vtr(LAS const char* p) { return __builtin_bit_cast(s16x4, __builtin_amdgcn_ds_read_tr16_b64_v4i16((LAS v4i16_t*)p)); }
DI bf16x8 cat8(s16x4 a, s16x4 b) { return (bf16x8){a[0], a[1], a[2], a[3], b[0], b[1], b[2], b[3]}; }
DI int t5_bucket(int n) {
    if (n < 16) return n;
    int bkt = 16;
    bkt += (n >= 21); bkt += (n >= 27); bkt += (n >= 35); bkt += (n >= 46); bkt += (n >= 59); bkt += (n >= 77); bkt += (n >= 99); bkt += (n >= 128);
    bkt += (n >= 166); bkt += (n >= 216); bkt += (n >= 280); bkt += (n >= 363); bkt += (n >= 470); bkt += (n >= 609); bkt += (n >= 790);
    return bkt;
}
namespace pg8 {
#define PG8_LAS __attribute__((address_space(3)))
typedef unsigned short bf16_t;
typedef short bf16x8 __attribute__((ext_vector_type(8)));
typedef float f32x4 __attribute__((ext_vector_type(4)));
typedef unsigned u32x4 __attribute__((ext_vector_type(4)));
constexpr int BM = 256, BK = 64, HALF = 128, HTB = HALF * BK * 2  , STAGE_BYTES = 8 * HTB, NXCD = 8, WGM = 8;

__host__ __device__ __forceinline__ int lds_byte(int r, int c) { const int st = (r >> 4) * 2 + (c >> 5), rr = r & 15, cc = c & 31, ob = rr * 64 + cc * 2; return st * 1024 + (ob ^ (((ob >> 9) & 1) << 5)); }
__host__ __device__ __forceinline__ void stage_rc(int b, int& R, int& C) { const int st = b / 1024, sb = b % 1024, swz = sb ^ (((sb >> 9) & 1) << 5); R = (st >> 1) * 16 + swz / 64; C = (st & 1) * 32 + (swz % 64) / 2; }
__host__ __device__ __forceinline__ int perm32(int rho) { const int n = rho >> 4, i = rho & 15; return 8 * (i >> 2) + 4 * n + (i & 3); }

struct Unit { int pm, pn; };
struct Gemm { const bf16_t* A; const bf16_t* Bt; int M, N, K; };

struct StaticOrder {
    int nM, nN, nwg, G, c;
    __host__ __device__ void init(int M, int N, int G_, int c_) { nM = M / BM; nN = N / BM; nwg = nM * nN; G = G_; c = c_; }
    __host__ __device__ bool next(int i, Unit& u) const {
        const long L = (long)i * G + c; if (L >= nwg) return false;
        int wgid = (int)L; { const int q = nwg / NXCD, r = nwg % NXCD, xcd = wgid % NXCD, off = wgid / NXCD; wgid = (xcd < r ? xcd * (q + 1) : r * (q + 1) + (xcd - r) * q) + off; }
        const int nig = WGM * nN, gid = wgid / nig, fm = gid * WGM, gsz = (nM - fm) < WGM ? (nM - fm) : WGM;
        u.pm = fm + ((wgid % nig) % gsz); u.pn = (wgid % nig) / gsz; return true;
    }
    __device__ __forceinline__ void a_ready(const Unit&) const {}
    __device__ __forceinline__ void done(const Unit&) const {}
};

__device__ __forceinline__ unsigned cvt_pk_bf16(float lo, float hi) { unsigned r; asm volatile("v_cvt_pk_bf16_f32 %0, %1, %2" : "=v"(r) : "v"(lo), "v"(hi)); return r; }
typedef float f32x2 __attribute__((ext_vector_type(2)));
__device__ __forceinline__ f32x2 gelu_pk(f32x2 v) {
    const f32x2 av = __builtin_elementwise_abs(v), d = av * 0.2316418882f + 1.0f;
    f32x2 t; t.x = __builtin_amdgcn_rcpf(d.x); t.y = __builtin_amdgcn_rcpf(d.y);
    f32x2 q = t * 0.5307027145f + (-0.7265760135f); q = q * t + 0.7107068705f; q = q * t + (-0.142248368f); q = q * t + 0.127414796f; q = q * t;
    const f32x2 s = (v * v) * (-0.72134752044f);
    f32x2 e; e.x = __builtin_amdgcn_exp2f(s.x); e.y = __builtin_amdgcn_exp2f(s.y);
    const f32x2 m = v * (q * e), r = v - m;
    f32x2 o; o.x = v.x < 0.f ? m.x : r.x; o.y = v.y < 0.f ? m.y : r.y; return o;
}

template <int ACT  > struct EpiBf16 {
    static constexpr bool PERM = true, AFTER_DRAIN = false; static_assert(ACT == 0 || ACT == 1, "EpiBf16: ACT is 0 (none) or 1 (gelu_pk)");
    bf16_t* O; int ldc; const float* bias; int split_cols; size_t split_stride; float scale0;
    __device__ __forceinline__ void operator()(const f32x4 (&acc)[2][2][4][2], const Unit& u, int wr, int wc, int fr, int fq) const {
        const int row0 = u.pm * BM + wr * 64 + fr; int colt = u.pn * BM; bf16_t* base = O;
        float sc = 1.f; if (split_cols) { const int t = colt / split_cols; base += (size_t)t * split_stride; colt -= t * split_cols; if (t == 0) sc = scale0; }
        const int col0 = colt + wc * 32 + 8 * fq, bcol0 = u.pn * BM + wc * 32 + 8 * fq;
        f32x4 bv[2][2];
#pragma unroll
        for (int bj = 0; bj < 2; ++bj)
#pragma unroll
            for (int n = 0; n < 2; ++n) bv[bj][n] = bias ? *(const f32x4*)(bias + bcol0 + bj * HALF + 4 * n) : (f32x4){0.f, 0.f, 0.f, 0.f};
#pragma unroll
        for (int ai = 0; ai < 2; ++ai)
#pragma unroll
            for (int m = 0; m < 4; ++m) { bf16_t* rowp = base + (size_t)(row0 + ai * HALF + m * 16) * ldc + col0;
#pragma unroll
                for (int bj = 0; bj < 2; ++bj) { f32x4 v0 = acc[ai][bj][m][0] + bv[bj][0], v1 = acc[ai][bj][m][1] + bv[bj][1];
                    if (ACT == 1) { f32x2 a = gelu_pk((f32x2){v0[0], v0[1]}), b = gelu_pk((f32x2){v0[2], v0[3]}), c = gelu_pk((f32x2){v1[0], v1[1]}), d = gelu_pk((f32x2){v1[2], v1[3]});
                        v0 = (f32x4){a.x, a.y, b.x, b.y}; v1 = (f32x4){c.x, c.y, d.x, d.y}; }
                    v0 = v0 * sc; v1 = v1 * sc; u32x4 w; w.x = cvt_pk_bf16(v0[0], v0[1]); w.y = cvt_pk_bf16(v0[2], v0[3]); w.z = cvt_pk_bf16(v1[0], v1[1]); w.w = cvt_pk_bf16(v1[2], v1[3]);
                    *(u32x4*)(rowp + bj * HALF) = w; } }
    }
};

template <class Epi, class Sched, bool ALIGN_EPI = false, bool SP2 = false>
__device__ __forceinline__ void gemm_phase(PG8_LAS unsigned char* lds, const Gemm g, const Sched& S, const Epi& E, int tid_in) {
    int tid_l = tid_in; asm volatile("" : "+v"(tid_l));
    const int tid = tid_l, wid = __builtin_amdgcn_readfirstlane(tid >> 6), lane = tid & 63, wr = wid >> 2, wc = wid & 3, fr = lane & 15, fq = lane >> 4;
    const int K = g.K, nt = K / BK;
    unsigned voffA[2], voffB[2];
#pragma unroll
    for (int i = 0; i < 2; ++i) { int R, C; stage_rc(tid * 16 + i * 8192, R, C); const int Rb = Epi::PERM ? ((R & ~31) + perm32(R & 31)) : R;
        voffA[i] = (unsigned)(R * K + C) * 2u; voffB[i] = (unsigned)(Rb * K + C) * 2u; }
    const size_t kstep = (size_t)(BK * 2);
    const size_t hstep = (size_t)HALF * K * 2;
    const size_t tstep = 2 * hstep;
    const unsigned ldsw = (unsigned)wid * 1024u;
    const int aoff = lds_byte(wr * 64 + fr, fq * 8), boff = lds_byte(wc * 32 + fr, fq * 8);
#define PG8_SA(b, h) (((b) * 2 + (h)) * HTB)
#define PG8_SB(b, h) ((4 + (b) * 2 + (h)) * HTB)
#define PG8_STAGE(bufoff, gbase, voff) do { _Pragma("unroll") for (int _i = 0; _i < 2; ++_i) \
        __builtin_amdgcn_global_load_lds((const unsigned*)((const char*)(gbase) + (voff)[_i]), (PG8_LAS unsigned*)(lds + (bufoff) + ldsw + _i * 8192), 16, 0, 0); } while (0)
#define PG8_LDA(dst, b, h) do { _Pragma("unroll") for (int m = 0; m < 4; ++m) _Pragma("unroll") for (int k = 0; k < 2; ++k) dst[m][k] = *(const PG8_LAS bf16x8*)(lds + PG8_SA(b, h) + aoff + m * 2048 + k * 1024); } while (0)
#define PG8_LDB(dst, b, h) do { _Pragma("unroll") for (int n = 0; n < 2; ++n) _Pragma("unroll") for (int k = 0; k < 2; ++k) dst[n][k] = *(const PG8_LAS bf16x8*)(lds + PG8_SB(b, h) + boff + n * 2048 + k * 1024); } while (0)
#define PG8_MMA(ai, bj, At, Bt) do { __builtin_amdgcn_s_setprio(1); _Pragma("unroll") for (int m = 0; m < 4; ++m) _Pragma("unroll") for (int n = 0; n < 2; ++n) _Pragma("unroll") for (int k = 0; k < 2; ++k) \
        acc[ai][bj][m][n] = __builtin_amdgcn_mfma_f32_16x16x32_bf16(Bt[n][k], At[m][k], acc[ai][bj][m][n], 0, 0, 0); __builtin_amdgcn_s_setprio(0); } while (0)
#define PG8_WAIT_V(n) asm volatile("s_waitcnt vmcnt(" #n ")" ::: "memory")
#define PG8_WAIT_L(n) asm volatile("s_waitcnt lgkmcnt(" #n ")" ::: "memory")
#define PG8_BAR __builtin_amdgcn_s_barrier()
#define PG8_SCHED __builtin_amdgcn_sched_barrier(0)
    Unit cur, nxt; int ui = 0;
    if (!S.next(0, cur)) return;
    f32x4 acc[2][2][4][2];
#pragma unroll
    for (int a = 0; a < 2; ++a)
#pragma unroll
        for (int b = 0; b < 2; ++b)
#pragma unroll
            for (int m = 0; m < 4; ++m)
#pragma unroll
                for (int n = 0; n < 2; ++n) acc[a][b][m][n] = (f32x4){0.f, 0.f, 0.f, 0.f};
    bf16x8 At[4][2], B0[2][2], B1[2][2];
    const char* cA = (const char*)g.A + (size_t)cur.pm * tstep; const char* cB = (const char*)g.Bt + (size_t)cur.pn * tstep;
    S.a_ready(cur);
    if constexpr (SP2) {
        PG8_STAGE(PG8_SB(0, 0), cB, voffB); PG8_STAGE(PG8_SB(0, 1), cB + hstep, voffB); PG8_STAGE(PG8_SA(0, 0), cA, voffA); PG8_STAGE(PG8_SA(0, 1), cA + hstep, voffA);
        if (wr == 1) PG8_BAR;
        PG8_WAIT_V(2); PG8_BAR;
        PG8_STAGE(PG8_SB(1, 0), cB + kstep, voffB); PG8_STAGE(PG8_SA(1, 0), cA + kstep, voffA); PG8_STAGE(PG8_SB(1, 1), cB + hstep + kstep, voffB);
        PG8_WAIT_V(6); PG8_BAR;
    } else {
        PG8_STAGE(PG8_SB(0, 0), cB, voffB); PG8_STAGE(PG8_SA(0, 0), cA, voffA); PG8_STAGE(PG8_SB(0, 1), cB + hstep, voffB); PG8_STAGE(PG8_SA(0, 1), cA + hstep, voffA);
        if (wr == 1) PG8_BAR;
        PG8_WAIT_V(4); PG8_BAR;
        PG8_STAGE(PG8_SB(1, 0), cB + kstep, voffB); PG8_STAGE(PG8_SA(1, 0), cA + kstep, voffA); PG8_STAGE(PG8_SB(1, 1), cB + hstep + kstep, voffB);
        PG8_WAIT_V(6); PG8_BAR;
    }
    for (;;) {
        const bool has_next = S.next(ui + 1, nxt);
        const char* nA = has_next ? (const char*)g.A + (size_t)nxt.pm * tstep : cA; const char* nB = has_next ? (const char*)g.Bt + (size_t)nxt.pn * tstep : cB;
        for (int t = 0; t < nt; t += 2) {
            const bool last = (t == nt - 2);
            const char* a1 = cA + (size_t)(t + 1) * kstep;
            const char* a2 = last ? nA : cA + (size_t)(t + 2) * kstep; const char* b2 = last ? nB : cB + (size_t)(t + 2) * kstep;
            const char* a3 = a2 + kstep; const char* b3 = b2 + kstep;
            if (last && has_next) S.a_ready(nxt);
            if constexpr (SP2) {
            PG8_LDB(B0, 0, 0); PG8_LDB(B1, 0, 1); PG8_SCHED; PG8_LDA(At, 0, 0); PG8_STAGE(PG8_SA(1, 1), a1 + hstep, voffA);
            PG8_WAIT_V(8); PG8_WAIT_L(0); PG8_BAR; PG8_MMA(0, 0, At, B0); PG8_MMA(0, 1, At, B1); PG8_BAR; PG8_SCHED;
            PG8_LDA(At, 0, 1); PG8_STAGE(PG8_SB(0, 0), b2, voffB); PG8_STAGE(PG8_SB(0, 1), b2 + hstep, voffB); PG8_STAGE(PG8_SA(0, 0), a2, voffA);
            PG8_WAIT_V(8); PG8_WAIT_L(0); PG8_BAR; PG8_MMA(1, 0, At, B0); PG8_MMA(1, 1, At, B1); PG8_BAR; PG8_SCHED;
            PG8_LDB(B0, 1, 0); PG8_LDB(B1, 1, 1); PG8_SCHED; PG8_LDA(At, 1, 0); PG8_STAGE(PG8_SA(0, 1), a2 + hstep, voffA);
            PG8_WAIT_V(8); PG8_WAIT_L(0); PG8_BAR; PG8_MMA(0, 0, At, B0); PG8_MMA(0, 1, At, B1); PG8_BAR; PG8_SCHED;
            PG8_LDA(At, 1, 1); PG8_STAGE(PG8_SB(1, 0), b3, voffB); PG8_STAGE(PG8_SB(1, 1), b3 + hstep, voffB); PG8_STAGE(PG8_SA(1, 0), a3, voffA);
            PG8_WAIT_V(8); PG8_WAIT_L(0); PG8_BAR; PG8_MMA(1, 0, At, B0); PG8_MMA(1, 1, At, B1); PG8_BAR; PG8_SCHED;
            } else {
            PG8_LDB(B0, 0, 0); PG8_SCHED; PG8_LDA(At, 0, 0); PG8_STAGE(PG8_SA(1, 1), a1 + hstep, voffA);
            PG8_WAIT_L(8); PG8_BAR; PG8_WAIT_L(0); PG8_MMA(0, 0, At, B0); PG8_BAR; PG8_SCHED;
            PG8_LDB(B1, 0, 1); PG8_STAGE(PG8_SB(0, 0), b2, voffB);
            PG8_BAR; PG8_WAIT_L(0); PG8_MMA(0, 1, At, B1); PG8_BAR;
            PG8_LDA(At, 0, 1); PG8_STAGE(PG8_SA(0, 0), a2, voffA);
            PG8_BAR; PG8_WAIT_L(0); PG8_MMA(1, 0, At, B0); PG8_BAR; PG8_SCHED;
            PG8_STAGE(PG8_SB(0, 1), b2 + hstep, voffB);
            PG8_WAIT_V(6); PG8_BAR; PG8_MMA(1, 1, At, B1); PG8_BAR;
            PG8_LDB(B0, 1, 0); PG8_SCHED; PG8_LDA(At, 1, 0); PG8_STAGE(PG8_SA(0, 1), a2 + hstep, voffA);
            PG8_WAIT_L(8); PG8_BAR; PG8_WAIT_L(0); PG8_MMA(0, 0, At, B0); PG8_BAR; PG8_SCHED;
            PG8_LDB(B1, 1, 1); PG8_STAGE(PG8_SB(1, 0), b3, voffB);
            PG8_BAR; PG8_WAIT_L(0); PG8_MMA(0, 1, At, B1); PG8_BAR;
            PG8_LDA(At, 1, 1); PG8_STAGE(PG8_SA(1, 0), a3, voffA);
            PG8_BAR; PG8_WAIT_L(0); PG8_MMA(1, 0, At, B0); PG8_BAR; PG8_SCHED;
            PG8_STAGE(PG8_SB(1, 1), b3 + hstep, voffB);
            PG8_WAIT_V(6); PG8_BAR; PG8_MMA(1, 1, At, B1); PG8_BAR;
            }
        }
        if constexpr (ALIGN_EPI) { if (wr == 0) PG8_BAR; }
        if constexpr (!Epi::AFTER_DRAIN) { E(acc, cur, wr, wc, fr, fq); S.done(cur); }
        if (!has_next) break;
#pragma unroll
        for (int a = 0; a < 2; ++a)
#pragma unroll
            for (int b = 0; b < 2; ++b)
#pragma unroll
                for (int m = 0; m < 4; ++m)
#pragma unroll
                    for (int n = 0; n < 2; ++n) acc[a][b][m][n] = (f32x4){0.f, 0.f, 0.f, 0.f};
        cur = nxt; cA = nA; cB = nB; ++ui;
        if constexpr (ALIGN_EPI) { if (wr == 1) PG8_BAR; }
    }
    PG8_WAIT_V(0);
    if constexpr (!ALIGN_EPI) { if (wr == 0) PG8_BAR; }
    PG8_BAR;
    if constexpr (Epi::AFTER_DRAIN) { E.fused(acc, cur, wr, wc, fr, fq, lds, wid, lane); S.done(cur); }
#undef PG8_SA
#undef PG8_SB
#undef PG8_STAGE
#undef PG8_LDA
#undef PG8_LDB
#undef PG8_MMA
#undef PG8_WAIT_V
#undef PG8_WAIT_L
#undef PG8_BAR
#undef PG8_SCHED
}
}

#ifndef PG8_SP2
#define PG8_SP2 true
#endif
#ifndef PG8_ALIGN
#define PG8_ALIGN true
#endif
#define XB_TMO      128
#define XB_XCNT(j)  (256  + 64 * (j))
#define XB_XSUB(j)  (1280 + 64 * (j))
#define XB_XGEN(j)  (2304 + 64 * (j))
#define XB_TOP      3328
#define XB_TOPGEN   3392
#define XCD_BAR_WORDS 3456
#define XB_SPIN_CAP (1u << 18)

__device__ __forceinline__ unsigned xb_ld(unsigned* p)              { return __hip_atomic_load(p, __ATOMIC_RELAXED, __HIP_MEMORY_SCOPE_AGENT); }
__device__ __forceinline__ unsigned xb_add(unsigned* p, unsigned v) { return __hip_atomic_fetch_add(p, v, __ATOMIC_RELAXED, __HIP_MEMORY_SCOPE_AGENT); }
__device__ __forceinline__ unsigned xb_xcc_id() { return (unsigned)__builtin_amdgcn_s_getreg((3 << 11) | 20) & 0xFu; }
#define XB_SPIN(cond, bar) do { unsigned _sp = 0; while (cond) { __builtin_amdgcn_s_sleep(1); \
    if ((++_sp & 255u) == 0u) { if (xb_ld(&(bar)[XB_TMO])) break; if (_sp > XB_SPIN_CAP) { atomicAdd(&(bar)[XB_TMO], 1u); break; } } } } while (0)

struct XcdBarrier {
    unsigned* bar; unsigned x;
    volatile LAS unsigned* st;
};

__device__ __forceinline__ XcdBarrier xcd_barrier_post(unsigned* bar, volatile LAS unsigned* st) {
    XcdBarrier b; b.bar = bar; b.x = xb_xcc_id(); b.st = st;
    if (threadIdx.x == 0) (void)xb_add(&bar[XB_XCNT(b.x)], 1u);
    return b;
}
__device__ __forceinline__ void xcd_barrier_complete(unsigned* bar, unsigned x, unsigned& nloc, unsigned& nx) {
    const unsigned G = gridDim.x * gridDim.y * gridDim.z;
    unsigned sum, cnt, mine, sp = 0u;
    for (;;) {
        sum = 0u; cnt = 0u; mine = 0u;
#pragma unroll
        for (unsigned j = 0; j < 16; ++j) { const unsigned c = xb_ld(&bar[XB_XCNT(j)]); sum += c; cnt += (c > 0u) ? 1u : 0u; mine = (j == x) ? c : mine; }
        if (sum == G) break;
        __builtin_amdgcn_s_sleep(1);
        if ((++sp & 255u) == 0u) { if (xb_ld(&bar[XB_TMO])) break; if (sp > XB_SPIN_CAP) { atomicAdd(&bar[XB_TMO], 1u); break; } }
    }
    nloc = mine > 0u ? mine : 1u; nx = cnt > 0u ? cnt : 1u;
}

__device__ __forceinline__ void xcd_barrier(const XcdBarrier& b, const bool is_t0  ) {
    asm volatile("s_waitcnt vmcnt(0)" ::: "memory");
    __syncthreads();
    if (is_t0) {
        unsigned* bar = b.bar;
        __builtin_amdgcn_s_waitcnt(0);
        unsigned nloc = b.st[0], nx = b.st[1];
        if (nloc == 0u) { xcd_barrier_complete(bar, b.x, nloc, nx); b.st[0] = nloc; b.st[1] = nx; }
        const unsigned old = xb_add(&bar[XB_XSUB(b.x)], 1u);
        const unsigned gen = old / nloc;
        if (old + 1u == (gen + 1u) * nloc) {
            __builtin_amdgcn_fence(__ATOMIC_RELEASE, "agent");
            asm volatile("s_waitcnt vmcnt(0)" ::: "memory");
            const unsigned og = xb_add(&bar[XB_TOP], 1u);
            const unsigned tg = og / nx;
            if (og + 1u == (tg + 1u) * nx) xb_add(&bar[XB_TOPGEN], 1u);
            else XB_SPIN(xb_ld(&bar[XB_TOPGEN]) == tg, bar);
            __builtin_amdgcn_fence(__ATOMIC_ACQUIRE, "agent");
            xb_add(&bar[XB_XGEN(b.x)], 1u);
            asm volatile("s_waitcnt vmcnt(0)" ::: "memory");
        } else {
            XB_SPIN(xb_ld(&bar[XB_XGEN(b.x)]) == gen, bar);
            __builtin_amdgcn_fence(__ATOMIC_ACQUIRE, "agent");
            asm volatile("s_waitcnt vmcnt(0)" ::: "memory");
        }
    }
    __syncthreads();
}
struct EpiResF32 {
    static constexpr bool PERM = true, AFTER_DRAIN = false;
    const float* xin; float* yp; float alpha;
    DI void operator()(const pg8::f32x4 (&acc)[2][2][4][2], const pg8::Unit& u, int wr, int wc, int fr, int fq) const {
        const int row0 = u.pm * 256 + wr * 64 + fr, col0 = u.pn * 256 + wc * 32 + 8 * fq;
#pragma unroll
        for (int ai = 0; ai < 2; ++ai)
#pragma unroll
            for (int m = 0; m < 4; ++m) {
                const size_t ro = (size_t)(row0 + ai * 128 + m * 16) * DM;
#pragma unroll
                for (int bj = 0; bj < 2; ++bj) {
                    const size_t o = ro + col0 + bj * 128;
                    const f32x4 x0 = *(const f32x4*)(xin + o), x1 = *(const f32x4*)(xin + o + 4);
                    *(f32x4*)(yp + o) = x0 * alpha + acc[ai][bj][m][0];
                    *(f32x4*)(yp + o + 4) = x1 * alpha + acc[ai][bj][m][1];
                }
            }
    }
};
struct EpiSwiglu {
    static constexpr bool PERM = true, AFTER_DRAIN = false;
    bf16* act; const float* bgu;
    DI void operator()(const pg8::f32x4 (&acc)[2][2][4][2], const pg8::Unit& u, int wr, int wc, int fr, int fq) const {
        const int e = u.pn >> 3, pl = u.pn & 7;
        const int row0 = u.pm * 256 + wr * 64 + fr, cih = pl * 128 + wc * 32 + 8 * fq;
        const float* bg = bgu + e * 2048 + cih;
        const f32x4 bg0 = *(const f32x4*)(bg), bg1 = *(const f32x4*)(bg + 4), bu0 = *(const f32x4*)(bg + 1024), bu1 = *(const f32x4*)(bg + 1028);
#pragma unroll
        for (int ai = 0; ai < 2; ++ai)
#pragma unroll
            for (int m = 0; m < 4; ++m) {
                const f32x4 g0 = acc[ai][0][m][0] + bg0, g1 = acc[ai][0][m][1] + bg1, u0 = acc[ai][1][m][0] + bu0, u1 = acc[ai][1][m][1] + bu1;
                float r[8];
#pragma unroll
                for (int i = 0; i < 8; ++i) {
                    float g = i < 4 ? g0[i & 3] : g1[i & 3], uu = i < 4 ? u0[i & 3] : u1[i & 3];
                    g = fminf(g, 7.0f); uu = fminf(fmaxf(uu, -7.0f), 7.0f);
                    const float sg = __builtin_amdgcn_rcpf(1.0f + ex2(-1.702f * LOG2E * g));
                    r[i] = (uu + 1.0f) * g * sg;
                }
                v4u w; w.x = cvtpk(r[0], r[1]); w.y = cvtpk(r[2], r[3]); w.z = cvtpk(r[4], r[5]); w.w = cvtpk(r[6], r[7]);
                *(v4u*)(act + (size_t)(row0 + ai * 128 + m * 16) * DM + cih) = w;
            }
    }
};
struct EpiDown {
    static constexpr bool PERM = true, AFTER_DRAIN = false;
    bf16* yr; const float* bdn;
    DI void operator()(const pg8::f32x4 (&acc)[2][2][4][2], const pg8::Unit& u, int wr, int wc, int fr, int fq) const {
        const int e = u.pn >> 2, pl = u.pn & 3;
        const int row0 = u.pm * 256 + wr * 64 + fr, col0 = pl * 256 + wc * 32 + 8 * fq;
        f32x4 bv[2][2];
#pragma unroll
        for (int bj = 0; bj < 2; ++bj) { bv[bj][0] = *(const f32x4*)(bdn + e * 1024 + col0 + bj * 128); bv[bj][1] = *(const f32x4*)(bdn + e * 1024 + col0 + bj * 128 + 4); }
#pragma unroll
        for (int ai = 0; ai < 2; ++ai)
#pragma unroll
            for (int m = 0; m < 4; ++m) {
                bf16* rp = yr + (size_t)(row0 + ai * 128 + m * 16) * DM + col0;
#pragma unroll
                for (int bj = 0; bj < 2; ++bj) {
                    const f32x4 v0 = acc[ai][bj][m][0] + bv[bj][0], v1 = acc[ai][bj][m][1] + bv[bj][1];
                    v4u w; w.x = cvtpk(v0[0], v0[1]); w.y = cvtpk(v0[2], v0[3]); w.z = cvtpk(v1[0], v1[1]); w.w = cvtpk(v1[2], v1[3]);
                    *(v4u*)(rp + bj * 128) = w;
                }
            }
    }
};
struct GroupOrder {
    const unsigned* tile_e; int ntiles, lg, G, c;
    DI bool next(int i, pg8::Unit& u) const {
        const long L = (long)i * G + c; if (L >= ((long)ntiles << lg)) return false;
        const int pm = (int)(L >> lg), pl = (int)(L & ((1 << lg) - 1));
        const int e = __builtin_amdgcn_readfirstlane((int)ld_u32(tile_e + pm));
        u.pm = pm; u.pn = (e << lg) + pl; return true;
    }
    DI void a_ready(const pg8::Unit&) const {}
    DI void done(const pg8::Unit&) const {}
};
struct Args { const float* in[18]; float* out; unsigned char* ws; int ph_lo, ph_hi; };
struct Fr { LAS unsigned char* lds; unsigned char* ws; unsigned* ctl; int tid, lane, wave, blk, G; };

DI void tr_item(const float* W, int ldw, int K, int k0, int sc0, int nvalid, bf16* WT, int drow0, LAS float* scr, int lane) {
    const int c = lane & 31;
#pragma unroll 8
    for (int i = 0; i < 32; ++i) { const int kk = 2 * i + (lane >> 5); scr[kk * 33 + c] = (c < nvalid) ? W[(size_t)(k0 + kk) * ldw + sc0 + c] : 0.f; }
    LDS_WAIT(); asm volatile("" ::: "memory");
    const int c8 = lane & 7;
#pragma unroll
    for (int j = 0; j < 4; ++j) { const int n = (lane >> 3) + 8 * j; const LAS float* s = scr + (8 * c8) * 33 + n;
        v4u o; o.x = cvtpk(s[0 * 33], s[1 * 33]); o.y = cvtpk(s[2 * 33], s[3 * 33]); o.z = cvtpk(s[4 * 33], s[5 * 33]); o.w = cvtpk(s[6 * 33], s[7 * 33]);
        *(v4u*)(WT + (size_t)(drow0 + n) * K + k0 + 8 * c8) = o; }
    LDS_WAIT(); asm volatile("" ::: "memory");
}
DI void ph_prologue(const Args& a, const Fr& F) {
    LAS float* scr = (LAS float*)(F.lds + F.wave * 16384);
    const int gw = F.blk * NWAVES + F.wave, NGW = F.G * NWAVES;
    constexpr int I_EV = 2 * 16 * 80, I_OD = 2 * 16 * 96, I_WO = 4 * 16 * 32, I_GU = 128 * 16 * 64, I_DN = 128 * 16 * 32;
    constexpr int NITEMS = I_EV + I_OD + I_WO + I_GU + I_DN;
    bf16* wev = (bf16*)(F.ws + WS_WEV); bf16* wod = (bf16*)(F.ws + WS_WOD); bf16* wout = (bf16*)(F.ws + WS_WOUT);
    bf16* wgu = (bf16*)(F.ws + WS_WGU); bf16* wdn = (bf16*)(F.ws + WS_WDN);
    for (int it = gw; it < NITEMS; it += NGW) {
        int r = it;
        if (r < I_EV) { const int l = r / 1280; r %= 1280; const int kb = r / 80, n0 = (r % 80) * 32; int sc0, nv = 32;
            if (n0 < 512) sc0 = n0; else if (n0 < 1024) sc0 = 964 + (n0 - 512); else if (n0 < 1536) sc0 = 1476 + (n0 - 1024); else if (n0 < 2048) sc0 = 1988 + (n0 - 1536);
            else if (n0 < 2176) sc0 = 512 + (n0 - 2048); else if (n0 < 2432) sc0 = 640 + (n0 - 2176); else if (n0 < 2496) sc0 = 896 + (n0 - 2432);
            else if (n0 < 2528) { sc0 = 960; nv = 4; } else { sc0 = 0; nv = 0; }
            tr_item(a.in[1] + (size_t)l * 1024 * 2500, 2500, 1024, kb * 64, sc0, nv, wev + (size_t)l * EV_N * 1024, n0, scr, F.lane); continue; }
        r -= I_EV;
        if (r < I_OD) { const int l = r / 1536; r %= 1536; const int kb = r / 96, n0 = (r % 96) * 32;
            tr_item(a.in[6] + (size_t)l * 1024 * 3088, 3088, 1024, kb * 64, n0, 32, wod + (size_t)l * OD_N * 1024, n0, scr, F.lane); continue; }
        r -= I_OD;
        if (r < I_WO) { const int l = r / 512; r %= 512; const int kb = r / 32, n0 = (r % 32) * 32;
            const float* src = (l & 1) ? a.in[8] + (size_t)(l >> 1) * 1024 * 1024 : a.in[5] + (size_t)(l >> 1) * 1024 * 1024;
            tr_item(src, 1024, 1024, kb * 64, n0, 32, wout + (size_t)l * 1024 * 1024, n0, scr, F.lane); continue; }
        r -= I_WO;
        if (r < I_GU) { const int le = r / 1024; r %= 1024; const int kb = r / 64, n0 = (r % 64) * 32;
            const int pn = n0 >> 8, bj = (n0 >> 7) & 1, j0 = n0 & 127;
            tr_item(a.in[14] + (size_t)le * 1024 * 2048, 2048, 1024, kb * 64, bj * 1024 + pn * 128 + j0, 32, wgu + (size_t)le * 2048 * 1024, n0, scr, F.lane); continue; }
        r -= I_GU;
        { const int le = r / 512; r %= 512; const int kb = r / 32, n0 = (r % 32) * 32;
            tr_item(a.in[16] + (size_t)le * 1024 * 1024, 1024, 1024, kb * 64, n0, 32, wdn + (size_t)le * 1024 * 1024, n0, scr, F.lane); }
    }
    bf16* xb = (bf16*)(F.ws + WS_XB);
    for (int m = gw; m < NTOK; m += NGW) {
        const f32x4* xr = (const f32x4*)(a.in[0] + (size_t)m * DM) + F.lane; v2u* o = (v2u*)(xb + (size_t)m * DM) + F.lane;
#pragma unroll
        for (int j = 0; j < 4; ++j) { const f32x4 v = xr[64 * j]; v2u w; w.x = cvtpk(v[0], v[1]); w.y = cvtpk(v[2], v[3]); o[64 * j] = w; }
    }
    bf16* wukt = (bf16*)(F.ws + WS_WUKT); bf16* wuvt = (bf16*)(F.ws + WS_WUVT);
    for (int i = F.blk * NTHR + F.tid; i < 2 * 8 * 128 * 64; i += F.G * NTHR) {
        { const int d = i & 63, c = (i >> 6) & 127, lh = i >> 13; wukt[i] = (bf16)f2bf(a.in[2][((size_t)lh * 64 + d) * 128 + c]); }
        { const int c = i & 127, d = (i >> 7) & 63, lh = i >> 13; wuvt[i] = (bf16)f2bf(a.in[3][((size_t)lh * 128 + c) * 64 + d]); }
    }
}

DI void ln_row(f32x4 (&v)[4], const float* g, const float* b, int lane) {
    float s = 0.f;
#pragma unroll
    for (int j = 0; j < 4; ++j) s += (v[j][0] + v[j][1]) + (v[j][2] + v[j][3]);
    const float mean = wave_sum(s) * (1.f / DM); float s2 = 0.f;
#pragma unroll
    for (int j = 0; j < 4; ++j) { v[j] = v[j] - mean; s2 += (v[j][0] * v[j][0] + v[j][1] * v[j][1]) + (v[j][2] * v[j][2] + v[j][3] * v[j][3]); }
    const float rstd = 1.f / sqrtf(wave_sum(s2) * (1.f / DM) + LN_EPS);
#pragma unroll
    for (int j = 0; j < 4; ++j) { const f32x4 gg = *((const f32x4*)g + lane + 64 * j), bb = *((const f32x4*)b + lane + 64 * j); v[j] = v[j] * rstd * gg + bb; }
}
DI void store_row_f32(float* p, const f32x4 (&v)[4], int lane) {
#pragma unroll
    for (int j = 0; j < 4; ++j) *((f32x4*)p + lane + 64 * j) = v[j];
}
DI void store_row_bf16(bf16* p, const f32x4 (&v)[4], int lane) {
#pragma unroll
    for (int j = 0; j < 4; ++j) { v2u w; w.x = cvtpk(v[j][0], v[j][1]); w.y = cvtpk(v[j][2], v[j][3]); *((v2u*)p + lane + 64 * j) = w; }
}
template <int NL> DI void small_proj(LAS const float* xs, const float* W, int ldw, int lane, float (&acc)[4]) {
    constexpr int PARTS = 64 / NL, DPER = 1024 / PARTS;
    const int n = lane & (NL - 1), part = lane / NL;
    acc[0] = acc[1] = acc[2] = acc[3] = 0.f;
    const float* wp = W + (size_t)(part * DPER) * ldw + n;
    LAS const float* xp = xs + part * DPER;
#pragma unroll 8
    for (int d = 0; d < DPER; ++d) { const float w = wp[(size_t)d * ldw];
        acc[0] += w * xp[d]; acc[1] += w * xp[1024 + d]; acc[2] += w * xp[2048 + d]; acc[3] += w * xp[3072 + d]; }
#pragma unroll
    for (int o = NL; o < 64; o <<= 1) {
#pragma unroll
        for (int k = 0; k < 4; ++k) acc[k] += __shfl_xor(acc[k], o); }
}

DI void ph_even_prep(const Args& a, const Fr& F, int j) {
    const bf16* proj = (const bf16*)(F.ws + WS_PROJ);
    bf16* ckvn = (bf16*)(F.ws + WS_CKVN); bf16* ql = (bf16*)(F.ws + WS_QL); float* kbar = (float*)(F.ws + WS_KBAR);
    const float* kvg = a.in[4] + j * 128;
    const bf16* wukt = (const bf16*)(F.ws + WS_WUKT) + (size_t)j * 8 * 128 * 64;
    const int lane = F.lane, wave = F.wave;
    for (int chunk = F.blk; chunk < 256; chunk += F.G) {
        const int tok0 = chunk * 128;
        for (int i = 0; i < 16; ++i) { const int tok = tok0 + wave * 16 + i;
            const unsigned w = *((const unsigned*)(proj + (size_t)tok * EV_N + EC_CKV) + lane);
            const float v0 = bf2f(w & 0xffffu), v1 = bf2f(w >> 16);
            const float ss = wave_sum(v0 * v0 + v1 * v1);
            const float r = 1.f / sqrtf(ss * (1.f / 128.f) + LN_EPS);
            *((unsigned*)(ckvn + (size_t)tok * 128) + lane) = cvtpk(v0 * r * kvg[2 * lane], v1 * r * kvg[2 * lane + 1]); }
        { const int h = wave, l15 = lane & 15, kg = lane >> 4;
            bf16x8 af[8][2];
#pragma unroll
            for (int ct = 0; ct < 8; ++ct)
#pragma unroll
                for (int ks = 0; ks < 2; ++ks) af[ct][ks] = *(const bf16x8*)(wukt + ((size_t)h * 128 + ct * 16 + l15) * 64 + ks * 32 + kg * 8);
            for (int tg = 0; tg < 8; ++tg) { const int tok = tok0 + tg * 16 + l15;
                bf16x8 qf[2];
#pragma unroll
                for (int ks = 0; ks < 2; ++ks) qf[ks] = *(const bf16x8*)(proj + (size_t)tok * EV_N + EC_QA + h * 64 + ks * 32 + kg * 8);
#pragma unroll
                for (int ct = 0; ct < 8; ++ct) { f32x4 d = {0.f, 0.f, 0.f, 0.f};
                    d = mfma16(af[ct][0], qf[0], d); d = mfma16(af[ct][1], qf[1], d);
                    v2u w; w.x = cvtpk(d[0], d[1]); w.y = cvtpk(d[2], d[3]);
                    *(v2u*)(ql + (size_t)tok * 1024 + h * 128 + ct * 16 + 4 * kg) = w; } } }
        if (chunk < 128) { const int b = chunk >> 5, n = chunk & 31; float s = 0.f;
            const bf16* kp = proj + ((size_t)b * SEQ + n * 256) * EV_N + EC_KB + F.tid;
#pragma unroll 8
            for (int r = 0; r < 256; ++r) s += bf2f(kp[(size_t)r * EV_N]);
            const int h = F.tid >> 6, d = F.tid & 63;
            kbar[(((size_t)b * 8 + h) * 32 + n) * 64 + d] = s * (1.f / 256.f); }
    }
}

DI void moba_gate_chunk(const Fr& F, int chunk) {
    const bf16* proj = (const bf16*)(F.ws + WS_PROJ); const float* kbar = (const float*)(F.ws + WS_KBAR); unsigned* sel3 = (unsigned*)(F.ws + WS_SEL3);
    const int tok0 = chunk * 128, b = tok0 / SEQ, own = (tok0 % SEQ) >> 8, h = F.wave, lane = F.lane;
    float q0[64], q1[64];
    { const v4u* p0 = (const v4u*)(proj + (size_t)(tok0 + lane) * EV_N + EC_QB + h * 64); const v4u* p1 = (const v4u*)(proj + (size_t)(tok0 + 64 + lane) * EV_N + EC_QB + h * 64);
#pragma unroll
        for (int i = 0; i < 8; ++i) { const v4u w0 = p0[i], w1 = p1[i];
#pragma unroll
            for (int k = 0; k < 4; ++k) { q0[8 * i + 2 * k] = bf2f(w0[k] & 0xffffu); q0[8 * i + 2 * k + 1] = bf2f(w0[k] >> 16); q1[8 * i + 2 * k] = bf2f(w1[k] & 0xffffu); q1[8 * i + 2 * k + 1] = bf2f(w1[k] >> 16); } } }
    float a0 = -INFINITY, a1 = -INFINITY, a2 = -INFINITY, c0 = -INFINITY, c1 = -INFINITY, c2 = -INFINITY; int ai0 = 0, ai1 = 0, ai2 = 0, ci0 = 0, ci1 = 0, ci2 = 0;
    const float* kb = kbar + (((size_t)b * 8 + h) * 32) * 64;
    for (int n = 0; n < own; ++n) { float g0 = 0.f, g1 = 0.f;
#pragma unroll
        for (int d = 0; d < 64; d += 4) { const f32x4 kv = *(const f32x4*)(kb + n * 64 + d);
#pragma unroll
            for (int k = 0; k < 4; ++k) { g0 += q0[d + k] * kv[k]; g1 += q1[d + k] * kv[k]; } }
        if (g0 > a2) { if (g0 > a1) { a2 = a1; ai2 = ai1; if (g0 > a0) { a1 = a0; ai1 = ai0; a0 = g0; ai0 = n; } else { a1 = g0; ai1 = n; } } else { a2 = g0; ai2 = n; } }
        if (g1 > c2) { if (g1 > c1) { c2 = c1; ci2 = ci1; if (g1 > c0) { c1 = c0; ci1 = ci0; c0 = g1; ci0 = n; } else { c1 = g1; ci1 = n; } } else { c2 = g1; ci2 = n; } }
    }
    const unsigned nv = own < 3 ? own : 3;
    sel3[(size_t)(tok0 + lane) * 8 + h] = (unsigned)ai0 | ((unsigned)ai1 << 8) | ((unsigned)ai2 << 16) | (nv << 24);
    sel3[(size_t)(tok0 + 64 + lane) * 8 + h] = (unsigned)ci0 | ((unsigned)ci1 << 8) | ((unsigned)ci2 << 16) | (nv << 24);
}

template <int MODE> DI void idx_pass(const bf16* proj, int rowbase, int qt, const bf16x8 (&qf)[4][4], const float (&wj)[4], LAS unsigned* hist, LAS unsigned* mask, LAS unsigned* cmask, LAS unsigned long long* cand, LAS unsigned* rinfo, int wave, int lane) {
    const int q = lane & 31, hi = lane >> 5, nkt = qt + 1, t = qt * 32 + q;
    const unsigned b1 = rinfo[q], thr16 = rinfo[64 + q];
    for (int ch = 0; ch * 8 < nkt; ++ch) { const int kt = ch * 8 + wave; if (kt >= nkt) continue;
        const bf16* kp = proj + (size_t)(rowbase + kt * 32 + q) * EV_N + EC_KI + hi * 8;
        bf16x8 kf[4];
#pragma unroll
        for (int s = 0; s < 4; ++s) kf[s] = *(const bf16x8*)(kp + s * 16);
        f32x16 sc;
#pragma unroll
        for (int r = 0; r < 16; ++r) sc[r] = 0.f;
#pragma unroll
        for (int j = 0; j < 4; ++j) { f32x16 acc;
#pragma unroll
            for (int r = 0; r < 16; ++r) acc[r] = 0.f;
#pragma unroll
            for (int s = 0; s < 4; ++s) acc = mfma32(kf[s], qf[j][s], acc);
#pragma unroll
            for (int r = 0; r < 16; ++r) sc[r] += wj[j] * fmaxf(acc[r], 0.f); }
#pragma unroll
        for (int r = 0; r < 16; ++r) { const int s = kt * 32 + crow(r, hi);
            if (s <= t) { unsigned u = __float_as_uint(sc[r]); if (u == 0x80000000u) u = 0u; const unsigned key = (u >> 31) ? ~u : (u | 0x80000000u);
                if (MODE == 1) __hip_atomic_fetch_add(hist + q * 256 + (key >> 24), 1u, __ATOMIC_RELAXED, __HIP_MEMORY_SCOPE_WORKGROUP);
                else if (MODE == 2) { if ((key >> 24) == b1) __hip_atomic_fetch_add(hist + q * 256 + ((key >> 16) & 255u), 1u, __ATOMIC_RELAXED, __HIP_MEMORY_SCOPE_WORKGROUP); }
                else { const unsigned k16 = key >> 16;
                    if (k16 > thr16) __hip_atomic_fetch_or(mask + q * 256 + (s >> 5), 1u << (s & 31), __ATOMIC_RELAXED, __HIP_MEMORY_SCOPE_WORKGROUP);
                    else if (k16 == thr16) { const unsigned pos = __hip_atomic_fetch_add(rinfo + 128 + q, 1u, __ATOMIC_RELAXED, __HIP_MEMORY_SCOPE_WORKGROUP);
                        __hip_atomic_fetch_or(cmask + q * 256 + (s >> 5), 1u << (s & 31), __ATOMIC_RELAXED, __HIP_MEMORY_SCOPE_WORKGROUP);
                        if (pos < 64u) cand[q * 64 + pos] = ((unsigned long long)key << 32) | (unsigned)(~(unsigned)s); } } } }
    }
}
DI void hist_pick(LAS const unsigned* hrow, unsigned need, int lane, unsigned& bin, unsigned& above) {
    const v4u h4 = *((LAS const v4u*)hrow + lane);
    const unsigned ssum = h4[0] + h4[1] + h4[2] + h4[3];
    unsigned x = ssum;
#pragma unroll
    for (int o = 1; o < 64; o <<= 1) { const unsigned y = __shfl_down(x, o); if (lane + o < 64) x += y; }
    const unsigned long long m = __ballot(x >= need);
    const int Ls = m ? 63 - __builtin_clzll(m) : 0;
    const unsigned xs = __shfl(x, Ls), ss = __shfl(ssum, Ls);
    const unsigned h0 = __shfl(h4[0], Ls), h1 = __shfl(h4[1], Ls), h2 = __shfl(h4[2], Ls), h3 = __shfl(h4[3], Ls);
    unsigned cum = xs - ss;
    if (cum + h3 >= need) { bin = 4 * Ls + 3; above = cum; return; } cum += h3;
    if (cum + h2 >= need) { bin = 4 * Ls + 2; above = cum; return; } cum += h2;
    if (cum + h1 >= need) { bin = 4 * Ls + 1; above = cum; return; } cum += h1;
    bin = 4 * Ls; above = cum; (void)h0;
}
DI void idx_unit(const Fr& F, int b, int qt) {
    const bf16* proj = (const bf16*)(F.ws + WS_PROJ); unsigned short* sel = (unsigned short*)(F.ws + WS_SEL);
    LAS unsigned* hist = (LAS unsigned*)(F.lds); LAS unsigned* mask = (LAS unsigned*)(F.lds + 32768);
    LAS unsigned* cmask = (LAS unsigned*)(F.lds + 98304);
    LAS unsigned long long* cand = (LAS unsigned long long*)(F.lds + 65536); LAS unsigned* rinfo = (LAS unsigned*)(F.lds + 81920);
    const int lane = F.lane, wave = F.wave, tid = F.tid, t0 = qt * 32, rowbase = b * SEQ;
    __syncthreads();
    for (int i = tid; i < 16384; i += NTHR) hist[i] = 0u;
    for (int i = tid; i < 8192; i += NTHR) cmask[i] = 0u;
    if (tid < 160) rinfo[tid] = 0u;
    __syncthreads();
    if (t0 + 31 <= 255 || (EXPF & 64)) {
        if (lane < 8) {
#pragma unroll
            for (int rr = 0; rr < 4; ++rr) { const int row = wave * 4 + rr, nv = t0 + row + 1;
                const int nv0 = t0 + row + 1; const int nvc = nv0 < 256 ? nv0 : 256; (void)nv; mask[row * 256 + lane] = nvc >= 32 * (lane + 1) ? 0xffffffffu : (nvc > 32 * lane ? ((1u << (nvc - 32 * lane)) - 1u) : 0u); } }
    } else {
        const int q = lane & 31, hi = lane >> 5;
        bf16x8 qf[4][4]; float wj[4];
        { const bf16* qp = proj + (size_t)(rowbase + t0 + q) * EV_N;
#pragma unroll
            for (int j = 0; j < 4; ++j) { wj[j] = bf2f(qp[EC_WI + j]);
#pragma unroll
                for (int s = 0; s < 4; ++s) qf[j][s] = *(const bf16x8*)(qp + EC_QI + j * 64 + s * 16 + hi * 8); } }
        idx_pass<1>(proj, rowbase, qt, qf, wj, hist, mask, cmask, cand, rinfo, wave, lane);
        __syncthreads();
#pragma unroll 1
        for (int rr = 0; rr < 4; ++rr) { const int row = wave * 4 + rr; unsigned bin, above; hist_pick(hist + row * 256, 256u, lane, bin, above);
            if (lane == 0) { rinfo[row] = bin; rinfo[32 + row] = 256u - above; } }
        __syncthreads();
        for (int i = tid; i < 8192; i += NTHR) hist[i] = 0u;
        __syncthreads();
        idx_pass<2>(proj, rowbase, qt, qf, wj, hist, mask, cmask, cand, rinfo, wave, lane);
        __syncthreads();
#pragma unroll 1
        for (int rr = 0; rr < 4; ++rr) { const int row = wave * 4 + rr; const unsigned need1 = rinfo[32 + row]; unsigned bin, above; hist_pick(hist + row * 256, need1, lane, bin, above);
            if (lane == 0) { rinfo[64 + row] = (rinfo[row] << 8) | bin; rinfo[96 + row] = need1 - above; } }
        __syncthreads();
        idx_pass<3>(proj, rowbase, qt, qf, wj, hist, mask, cmask, cand, rinfo, wave, lane);
        __syncthreads();
#pragma unroll 1
        for (int rr = 0; rr < 4; ++rr) { const int row = wave * 4 + rr; const unsigned call = rinfo[128 + row], need2 = rinfo[96 + row];
            if (call <= 64u) { const unsigned c = call;
                const unsigned long long mine = cand[row * 64 + lane]; unsigned rank = 0u;
                for (unsigned k = 0; k < c; ++k) rank += (cand[row * 64 + k] > mine) ? 1u : 0u;
                if ((unsigned)lane < c && rank < need2) { const unsigned s = ~(unsigned)mine;
                    __hip_atomic_fetch_or(mask + row * 256 + (s >> 5), 1u << (s & 31), __ATOMIC_RELAXED, __HIP_MEMORY_SCOPE_WORKGROUP); } }
            else { const v4u w4 = *((LAS const v4u*)(cmask + row * 256) + lane);
                const unsigned cnt = __popc(w4[0]) + __popc(w4[1]) + __popc(w4[2]) + __popc(w4[3]);
                unsigned x = cnt;
#pragma unroll
                for (int o = 1; o < 64; o <<= 1) { const unsigned y = __shfl_up(x, o); if (lane >= o) x += y; }
                unsigned before = x - cnt;
#pragma unroll
                for (int k = 0; k < 4; ++k) { unsigned w = w4[k]; const unsigned pc = __popc(w); unsigned take = 0u;
                    if (before < need2) { if (before + pc <= need2) take = w; else { unsigned left = need2 - before; while (left) { const unsigned b = w & (0u - w); take |= b; w ^= b; --left; } } }
                    before += pc;
                    if (take) mask[row * 256 + 4 * lane + k] |= take; } }
        }
    }
    __syncthreads();
    if ((EXPF & 512) && t0 >= 256) {
        for (int i = tid; i < 8192; i += NTHR) mask[i] = 0u;
        __syncthreads();
        for (int i = tid; i < 32 * 256; i += NTHR) { const int row = i >> 8, k = i & 255, t = t0 + row; const unsigned s = (unsigned)(k * 31 + 7 * t) % (unsigned)(t + 1);
            __hip_atomic_fetch_or(mask + row * 256 + (s >> 5), 1u << (s & 31), __ATOMIC_RELAXED, __HIP_MEMORY_SCOPE_WORKGROUP); }
        __syncthreads();
    }
#pragma unroll 1
    for (int rr = 0; rr < 4; ++rr) { const int row = wave * 4 + rr; unsigned short* out = sel + (size_t)(rowbase + t0 + row) * 256;
        const v4u w4 = *((LAS const v4u*)(mask + row * 256) + lane);
        const unsigned cnt = __popc(w4[0]) + __popc(w4[1]) + __popc(w4[2]) + __popc(w4[3]);
        unsigned x = cnt;
#pragma unroll
        for (int o = 1; o < 64; o <<= 1) { const unsigned y = __shfl_up(x, o); if (lane >= o) x += y; }
        const unsigned total = __shfl(x, 63); unsigned pos = x - cnt;
#pragma unroll
        for (int k = 0; k < 4; ++k) { unsigned w = w4[k]; const unsigned base = (unsigned)(4 * lane + k) * 32u;
            while (w) { const unsigned bit = __builtin_ctz(w); if (pos < 256u) out[pos] = (unsigned short)(base + bit); ++pos; w &= w - 1u; } }
        for (unsigned i = total + lane; i < 256u; i += 64u) out[i] = (unsigned short)0xffffu; }
}

struct AttSt { float m, l; f32x16 o0, o1; };
template <class BF> DI void att_subtile(AttSt& S, const bf16x8 (&qf)[4], LAS const char* Kst, LAS const char* Vb, int vdh, int vrow0, int lane, const BF& bias) {
    const int r32 = lane & 31, hi = lane >> 5;
    f32x16 p;
#pragma unroll
    for (int r = 0; r < 16; ++r) p[r] = 0.f;
    LAS const char* kp = Kst + hi * 512 + r32 * 16;
#pragma unroll
    for (int s = 0; s < 4; ++s) { const bf16x8 kf = *(LAS const bf16x8*)(kp + s * 1024); p = mfma32(kf, qf[s], p); }
    float mx = -INFINITY;
#pragma unroll
    for (int r = 0; r < 16; ++r) { p[r] = bias(p[r], crow(r, hi)); mx = fmaxf(mx, p[r]); }
    mx = fmaxf(mx, __shfl_xor(mx, 32));
    const float mn = fmaxf(S.m, mx), sc = ex2(S.m - mn);
    S.m = mn;
    float ps = 0.f;
#pragma unroll
    for (int r = 0; r < 16; ++r) { p[r] = ex2(p[r] - mn); ps += p[r]; }
    S.l = S.l * sc + ps;
#pragma unroll
    for (int r = 0; r < 16; ++r) { S.o0[r] *= sc; S.o1[r] *= sc; }
    v4u pw0, pw1;
    pw0.x = cvtpk(p[0], p[1]); pw0.y = cvtpk(p[2], p[3]); pw0.z = cvtpk(p[4], p[5]); pw0.w = cvtpk(p[6], p[7]);
    pw1.x = cvtpk(p[8], p[9]); pw1.y = cvtpk(p[10], p[11]); pw1.z = cvtpk(p[12], p[13]); pw1.w = cvtpk(p[14], p[15]);
    const bf16x8 pf0 = __builtin_bit_cast(bf16x8, pw0), pf1 = __builtin_bit_cast(bf16x8, pw1);
    LAS const char* vp = Vb + (vrow0 + 4 * hi + ((lane & 15) >> 2)) * 64 + ((lane >> 4) & 1) * 32 + (lane & 3) * 8;
    { const bf16x8 v00 = cat8(vtr(vp), vtr(vp + 512)), v10 = cat8(vtr(vp + vdh), vtr(vp + vdh + 512));
      const bf16x8 v01 = cat8(vtr(vp + 1024), vtr(vp + 1536)), v11 = cat8(vtr(vp + vdh + 1024), vtr(vp + vdh + 1536));
      S.o0 = mfma32(v00, pf0, S.o0); S.o1 = mfma32(v10, pf0, S.o1);
      S.o0 = mfma32(v01, pf1, S.o0); S.o1 = mfma32(v11, pf1, S.o1); }
}

struct MobaBias { LAS const float* lut; int tq, s0; bool causal;
    DI float operator()(float p, int kvrel) const { const int dist = tq - (s0 + kvrel); const float v = p + lut[dist < 0 ? 0 : (dist > 1023 ? 1023 : dist)]; return (causal && dist < 0) ? -INFINITY : v; } };
DI void moba_tile(const Fr& F, const bf16* proj, int rowbase, int h, int n, int tq, bool valid, int slot, bool own, int wave_tile) {
    LAS const char* Kb = (LAS const char*)F.lds; LAS const char* Vb = (LAS const char*)(F.lds + 32768); LAS const float* lut = (LAS const float*)(F.lds + 98304);
    bf16* po = (bf16*)(F.ws + WS_ACT); float* pml = (float*)(F.ws + WS_PML);
    const int lane = F.lane, hi = lane >> 5;
    bf16x8 qf[4];
    { const bf16* qp = proj + (size_t)(rowbase + tq) * EV_N + EC_QB + h * 64 + hi * 8;
#pragma unroll
        for (int s = 0; s < 4; ++s) qf[s] = *(const bf16x8*)(qp + s * 16); }
    AttSt S; S.m = -1e30f; S.l = 0.f;
#pragma unroll
    for (int r = 0; r < 16; ++r) { S.o0[r] = 0.f; S.o1[r] = 0.f; }
    const int nst = own ? wave_tile + 1 : 8;
    for (int st = 0; st < nst; ++st) { MobaBias bf{lut, tq, n * 256 + st * 32, own && st == wave_tile};
        att_subtile(S, qf, Kb + st * 4096, Vb, 16384, st * 32, lane, bf); }
    const float lt = S.l + __shfl_xor(S.l, 32), inv = 1.f / lt;
    if (valid) { const size_t pi = ((size_t)(rowbase + tq) * 8 + h) * 4 + slot; bf16* o = po + pi * 64;
#pragma unroll
        for (int a4 = 0; a4 < 4; ++a4) { v2u w0, w1;
            w0.x = cvtpk(S.o0[4 * a4] * inv, S.o0[4 * a4 + 1] * inv); w0.y = cvtpk(S.o0[4 * a4 + 2] * inv, S.o0[4 * a4 + 3] * inv);
            w1.x = cvtpk(S.o1[4 * a4] * inv, S.o1[4 * a4 + 1] * inv); w1.y = cvtpk(S.o1[4 * a4 + 2] * inv, S.o1[4 * a4 + 3] * inv);
            *(v2u*)(o + 8 * a4 + 4 * hi) = w0; *(v2u*)(o + 32 + 8 * a4 + 4 * hi) = w1; }
        if (hi == 0) { f32x2 ml = {S.m, lt}; *(f32x2*)(pml + pi * 2) = ml; } }
}
DI void moba_unit(const Args& a, const Fr& F, int b, int h, int n) {
    const bf16* proj = (const bf16*)(F.ws + WS_PROJ); const unsigned* sel3 = (const unsigned*)(F.ws + WS_SEL3);
    LAS unsigned char* lds = F.lds; LAS unsigned* list = (LAS unsigned*)(lds + 65536); LAS float* lut = (LAS float*)(lds + 98304); LAS unsigned* misc = (LAS unsigned*)(lds + 102400);
    const int tid = F.tid, lane = F.lane, wave = F.wave, rowbase = b * SEQ;
    __syncthreads();
    { const bf16* kg = proj + (size_t)(rowbase + n * 256) * EV_N + EC_KB + h * 64; const bf16* vg = proj + (size_t)(rowbase + n * 256) * EV_N + EC_VB + h * 64;
#pragma unroll
        for (int i = 0; i < 4; ++i) { const int p = tid + i * NTHR;
            { const int r = p & 31, c = (p >> 5) & 7, st = p >> 8; const v4u v = *(const v4u*)(kg + (size_t)(st * 32 + r) * EV_N + c * 8); *(LAS v4u*)(lds + st * 4096 + c * 512 + r * 16) = v; }
            { const int cc = p & 3, row = (p >> 2) & 255, dh = p >> 10; const v4u v = *(const v4u*)(vg + (size_t)row * EV_N + dh * 32 + cc * 8); *(LAS v4u*)(lds + 32768 + dh * 16384 + row * 64 + cc * 16) = v; } }
        for (int d = tid; d < 1024; d += NTHR) lut[d] = a.in[9][t5_bucket(d) * 16 + 8 + h] * LOG2E; }
    if (tid == 0) misc[16] = 0u;
    __syncthreads();
    for (int tb = (n + 1) * 256; tb < SEQ; tb += NTHR) { const int t = tb + tid; const bool inr = t < SEQ;
        const unsigned s = inr ? sel3[(size_t)(rowbase + t) * 8 + h] : 0u; const unsigned nv = s >> 24; int slot = -1;
        if (nv > 0u && (s & 255u) == (unsigned)n) slot = 0; else if (nv > 1u && ((s >> 8) & 255u) == (unsigned)n) slot = 1; else if (nv > 2u && ((s >> 16) & 255u) == (unsigned)n) slot = 2;
        const unsigned long long bal = __ballot(slot >= 0); const unsigned wcnt = __popcll(bal);
        if (lane == 0) misc[wave] = wcnt;
        __syncthreads();
        unsigned off = misc[16], tot = 0u;
#pragma unroll
        for (int w = 0; w < 8; ++w) { const unsigned c = misc[w]; if (w < wave) off += c; tot += c; }
        if (slot >= 0) list[off + __popcll(bal & ((1ull << lane) - 1ull))] = ((unsigned)t << 2) | (unsigned)slot;
        __syncthreads();
        if (tid == 0) misc[16] += tot; }
    __syncthreads();
    const int nlist = (int)misc[16];
    moba_tile(F, proj, rowbase, h, n, n * 256 + wave * 32 + (lane & 31), true, 3, true, wave);
    const int ntl = (nlist + 31) >> 5;
    for (int tl = wave; tl < ntl; tl += 8) { const int li = tl * 32 + (lane & 31); const bool valid = li < nlist; const unsigned e = list[valid ? li : nlist - 1];
        moba_tile(F, proj, rowbase, h, n, (int)(e >> 2), valid, (int)(e & 3u), false, 0); }
}

DI void dsa_query(const Fr& F, int tok, LAS unsigned char* wl, LAS const unsigned char* bkt, LAS const float* tab) {
    const bf16* ql = (const bf16*)(F.ws + WS_QL); const bf16* ckvn = (const bf16*)(F.ws + WS_CKVN); const unsigned short* sel = (const unsigned short*)(F.ws + WS_SEL); bf16* ol = (bf16*)(F.ws + WS_OL);
    const int lane = F.lane, l15 = lane & 15, kg = lane >> 4, t = tok % SEQ, rowbase = tok - t;
    LAS unsigned short* selb = (LAS unsigned short*)wl; LAS unsigned char* cbuf = wl + 1024;
    *((LAS v2u*)selb + lane) = *((const v2u*)(sel + (size_t)tok * 256) + lane);
    bf16x8 qlf[4];
#pragma unroll
    for (int ks = 0; ks < 4; ++ks) { qlf[ks] = *(const bf16x8*)(ql + (size_t)tok * 1024 + (l15 & 7) * 128 + ks * 32 + kg * 8); if (l15 >= 8) qlf[ks] = (bf16x8){0, 0, 0, 0, 0, 0, 0, 0}; }
    float m = -1e30f, l = 0.f; f32x4 oT[8];
#pragma unroll
    for (int ct = 0; ct < 8; ++ct) oT[ct] = (f32x4){0.f, 0.f, 0.f, 0.f};
    const int nvalid = t + 1 < 256 ? t + 1 : 256, nch = (nvalid + 31) >> 5;
    LDS_WAIT();
    for (int ch = 0; ch < nch; ++ch) {
        bf16x8 af[2][4];
#pragma unroll
        for (int mt = 0; mt < 2; ++mt) { unsigned idx = selb[ch * 32 + mt * 16 + l15]; if (idx == 0xffffu) idx = 0u;
            const bf16* cp = ckvn + (size_t)(rowbase + (int)idx) * 128 + kg * 8;
#pragma unroll
            for (int ks = 0; ks < 4; ++ks) af[mt][ks] = *(const bf16x8*)(cp + ks * 32); }
        f32x4 acc[2];
#pragma unroll
        for (int mt = 0; mt < 2; ++mt) { acc[mt] = (f32x4){0.f, 0.f, 0.f, 0.f};
#pragma unroll
            for (int ks = 0; ks < 4; ++ks) { acc[mt] = mfma16(af[mt][ks], qlf[ks], acc[mt]); *(LAS bf16x8*)(cbuf + (mt * 16 + l15) * 288 + (ks * 32 + kg * 8) * 2) = af[mt][ks]; } }
        float mx = -INFINITY;
#pragma unroll
        for (int mt = 0; mt < 2; ++mt)
#pragma unroll
            for (int i = 0; i < 4; ++i) { const unsigned s = selb[ch * 32 + mt * 16 + 4 * kg + i]; const int dist = t - (int)s;
                const bool ok = (s != 0xffffu) && dist >= 0; const int dc = ok ? (dist > 1023 ? 1023 : dist) : 0;
                const float v = ok ? acc[mt][i] + tab[(int)bkt[dc] * 8 + (l15 & 7)] : -INFINITY; acc[mt][i] = v; mx = fmaxf(mx, v); }
        mx = fmaxf(mx, __shfl_xor(mx, 16)); mx = fmaxf(mx, __shfl_xor(mx, 32));
        const float mn = fmaxf(m, mx), sc = ex2(m - mn); m = mn;
        float ps = 0.f;
#pragma unroll
        for (int mt = 0; mt < 2; ++mt)
#pragma unroll
            for (int i = 0; i < 4; ++i) { acc[mt][i] = ex2(acc[mt][i] - mn); ps += acc[mt][i]; }
        l = l * sc + ps;
#pragma unroll
        for (int ct = 0; ct < 8; ++ct) oT[ct] = oT[ct] * sc;
        v4u pw; pw.x = cvtpk(acc[0][0], acc[0][1]); pw.y = cvtpk(acc[0][2], acc[0][3]); pw.z = cvtpk(acc[1][0], acc[1][1]); pw.w = cvtpk(acc[1][2], acc[1][3]);
        const bf16x8 pf = __builtin_bit_cast(bf16x8, pw);
        LDS_WAIT();
        LAS const char* tp = (LAS const char*)cbuf + (4 * kg + (l15 >> 2)) * 288 + (lane & 3) * 8;
#pragma unroll
        for (int ct = 0; ct < 8; ++ct) { const bf16x8 cf = cat8(vtr(tp + ct * 32), vtr(tp + 16 * 288 + ct * 32)); oT[ct] = mfma16(cf, pf, oT[ct]); }
        LDS_WAIT();
    }
    l += __shfl_xor(l, 16); l += __shfl_xor(l, 32);
    const float inv = 1.f / l;
    if (l15 < 8) { bf16* o = ol + (size_t)tok * 1024 + l15 * 128 + 4 * kg;
#pragma unroll
        for (int ct = 0; ct < 8; ++ct) { v2u w; w.x = cvtpk(oT[ct][0] * inv, oT[ct][1] * inv); w.y = cvtpk(oT[ct][2] * inv, oT[ct][3] * inv); *(v2u*)(o + ct * 16) = w; } }
}
DI void dsa_chunk(const Args& a, const Fr& F, int c32) {
    LAS unsigned char* bkt = F.lds + 81920; LAS float* tab = (LAS float*)(F.lds + 82944);
    __syncthreads();
    for (int d = F.tid; d < 1024; d += NTHR) bkt[d] = (unsigned char)t5_bucket(d);
    if (F.tid < 256) tab[F.tid] = a.in[9][(F.tid >> 3) * 16 + (F.tid & 7)] * LOG2E;
    __syncthreads();
#pragma unroll 1
    for (int i = 0; i < 4; ++i) dsa_query(F, c32 * 32 + F.wave * 4 + i, F.lds + F.wave * 10240, bkt, tab);
}

DI void ph_even_post(const Fr& F, int j) {
    const bf16* ol = (const bf16*)(F.ws + WS_OL); bf16* ao = (bf16*)(F.ws + WS_AO);
    const bf16* wuvt = (const bf16*)(F.ws + WS_WUVT) + (size_t)j * 8 * 64 * 128;
    const bf16* po = (const bf16*)(F.ws + WS_ACT); const float* pml = (const float*)(F.ws + WS_PML); const unsigned* sel3 = (const unsigned*)(F.ws + WS_SEL3);
    const int lane = F.lane, wave = F.wave, l15 = lane & 15, kg = lane >> 4;
    for (int chunk = F.blk; chunk < 256; chunk += F.G) { const int tok0 = chunk * 128;
        { const int h = wave; bf16x8 af[4][4];
#pragma unroll
            for (int mt = 0; mt < 4; ++mt)
#pragma unroll
                for (int ks = 0; ks < 4; ++ks) af[mt][ks] = *(const bf16x8*)(wuvt + ((size_t)h * 64 + mt * 16 + l15) * 128 + ks * 32 + kg * 8);
            for (int tg = 0; tg < 8; ++tg) { const int tok = tok0 + tg * 16 + l15; bf16x8 bf[4];
#pragma unroll
                for (int ks = 0; ks < 4; ++ks) bf[ks] = *(const bf16x8*)(ol + (size_t)tok * 1024 + h * 128 + ks * 32 + kg * 8);
#pragma unroll
                for (int mt = 0; mt < 4; ++mt) { f32x4 d = {0.f, 0.f, 0.f, 0.f};
#pragma unroll
                    for (int ks = 0; ks < 4; ++ks) d = mfma16(af[mt][ks], bf[ks], d);
                    v2u w; w.x = cvtpk(d[0], d[1]); w.y = cvtpk(d[2], d[3]); *(v2u*)(ao + (size_t)tok * 1024 + h * 64 + mt * 16 + 4 * kg) = w; } } }
        if (!(EXPF & 32)) for (int i = 0; i < 16; ++i) { const int tok = tok0 + wave * 16 + i, h = lane >> 3, d0 = (lane & 7) * 8;
            const unsigned nv = sel3[(size_t)tok * 8 + h] >> 24; const size_t pi = ((size_t)tok * 8 + h) * 4;
            float mj[4], lj[4];
#pragma unroll
            for (int s = 0; s < 4; ++s) { const bool ok = (s == 3) || ((unsigned)s < nv); const f32x2 ml = *(const f32x2*)(pml + (pi + s) * 2); mj[s] = ok ? ml[0] : -1e30f; lj[s] = ok ? ml[1] : 0.f; }
            const float ms = fmaxf(fmaxf(mj[0], mj[1]), fmaxf(mj[2], mj[3])); float wsum = 0.f, acc[8];
#pragma unroll
            for (int k = 0; k < 8; ++k) acc[k] = 0.f;
#pragma unroll
            for (int s = 0; s < 4; ++s) { const float w = lj[s] * ex2(mj[s] - ms); wsum += w;
                if (w > 0.f) { const v4u v = *(const v4u*)(po + (pi + s) * 64 + d0);
#pragma unroll
                    for (int k = 0; k < 4; ++k) { acc[2 * k] += w * bf2f(v[k] & 0xffffu); acc[2 * k + 1] += w * bf2f(v[k] >> 16); } } }
            const float inv = 1.f / wsum; v4u o; o.x = cvtpk(acc[0] * inv, acc[1] * inv); o.y = cvtpk(acc[2] * inv, acc[3] * inv); o.z = cvtpk(acc[4] * inv, acc[5] * inv); o.w = cvtpk(acc[6] * inv, acc[7] * inv);
            *(v4u*)(ao + (size_t)tok * 1024 + 512 + h * 64 + d0) = o; }
    }
}
DI void ph_odd_prep(const Args& a, const Fr& F, int j, int layer) {
    const bf16* proj = (const bf16*)(F.ws + WS_PROJ); const float* x = (const float*)(F.ws + WS_X);
    float* logf = (float*)(F.ws + WS_LOGF); float* cs = (float*)(F.ws + WS_CS);
    const float* wf = a.in[6] + (size_t)j * 1024 * 3088 + 3072; const float* bfv = a.in[7] + j * 16;
    LAS float* xs = (LAS float*)(F.lds + F.wave * 16384); LAS float* lfb = (LAS float*)(F.lds + 131072);
    LAS unsigned* kmx = (LAS unsigned*)(F.lds + 131072 + 8192);
    const int lane = F.lane, wave = F.wave, tid = F.tid;
    for (int chunk = F.blk; chunk < 256; chunk += F.G) { const int tok0 = chunk * 128, b = tok0 / SEQ, t0 = tok0 % SEQ;
        __syncthreads();
        if (tid < 16) kmx[tid] = 0u;
        __syncthreads();
        for (int grp = 0; grp < 4; ++grp) { const int tl0 = wave * 16 + grp * 4;
#pragma unroll
            for (int k = 0; k < 4; ++k) { const f32x4* xr = (const f32x4*)(x + (size_t)(tok0 + tl0 + k) * DM) + lane;
#pragma unroll
                for (int jj = 0; jj < 4; ++jj) *((LAS f32x4*)(xs + k * 1024) + lane + 64 * jj) = xr[64 * jj]; }
            LDS_WAIT();
            float acc[4]; small_proj<16>(xs, wf, 3088, lane, acc);
            const int n = lane & 15;
#pragma unroll
            for (int k = 0; k < 4; ++k) { const float z = acc[k] + bfv[n];
                const float ls = fminf(z, 0.f) - log1pf(__expf(-fabsf(z)));
                if (lane < 16) lfb[(tl0 + k) * 16 + n] = ls * LOG2E; }
            LDS_WAIT(); }
#pragma unroll 1
        for (int i = 0; i < 4; ++i) { const int p = tid + i * NTHR, tl = p >> 4, h = p & 15; const v4u* kp = (const v4u*)(proj + (size_t)(tok0 + tl) * OD_N + OC_K + h * 64); float s = 0.f;
#pragma unroll
            for (int c = 0; c < 8; ++c) { const v4u w = kp[c];
#pragma unroll
                for (int k = 0; k < 4; ++k) { const float e0 = bf2f(w[k] & 0xffffu), e1 = bf2f(w[k] >> 16); s += e0 * e0 + e1 * e1; } }
            __hip_atomic_fetch_max(kmx + h, __float_as_uint(s), __ATOMIC_RELAXED, __HIP_MEMORY_SCOPE_WORKGROUP); }
        __syncthreads();
        for (int i = tid; i < 2048; i += NTHR) { const int h = i >> 7, tl = i & 127; logf[((size_t)b * 16 + h) * SEQ + t0 + tl] = lfb[tl * 16 + h]; }
        if (tid < 32) { const int h = tid & 15, c = tid >> 4; float s = 0.f;
            for (int k = 0; k < 64; ++k) s += lfb[(c * 64 + k) * 16 + h];
            cs[((size_t)b * 16 + h) * 128 + (t0 >> 6) + c] = s; }
        if (tid < 16) __hip_atomic_fetch_max(F.ctl + CW_KMAX + layer * 64 + b * 16 + tid, kmx[tid], RLX_AGENT);
    }
}

struct FoxBias { LAS const float* ng; int tq, kabs0; bool diag;
    DI float operator()(float p, int kvrel) const { const float v = p + ng[kvrel]; return (diag && (kabs0 + kvrel) > tq) ? -INFINITY : v; } };
DI void fox_unit(const Fr& F, int layer, int b, int h, int qb) {
    const bf16* proj = (const bf16*)(F.ws + WS_PROJ); const float* logf = (const float*)(F.ws + WS_LOGF); const float* cs = (const float*)(F.ws + WS_CS); bf16* ao = (bf16*)(F.ws + WS_AO);
    LAS unsigned char* lds = F.lds; LAS float* ng = (LAS float*)(lds + 32768); LAS float* red = (LAS float*)(lds + 65536 + 1024); LAS int* ibox = (LAS int*)(lds + 65536 + 2048);
    const int tid = F.tid, lane = F.lane, wave = F.wave, r32 = lane & 31, hi = lane >> 5, t0 = qb * 256, rowbase = b * SEQ, tq = t0 + wave * 32 + r32;
    __syncthreads();
    bf16x8 qf[4]; float qs = 0.f;
    { const bf16* qp = proj + (size_t)(rowbase + tq) * OD_N + OC_Q + h * 64 + hi * 8;
#pragma unroll
        for (int s = 0; s < 4; ++s) { qf[s] = *(const bf16x8*)(qp + s * 16);
#pragma unroll
            for (int k = 0; k < 8; ++k) { const float e = bf2f((unsigned short)qf[s][k]); qs += e * e; } } }
    qs += __shfl_xor(qs, 32); qs = wave_max(qs);
    if (lane == 0) red[wave] = qs;
    __syncthreads();
    if (tid == 0) { float qm = red[0];
        for (int w = 1; w < 8; ++w) qm = fmaxf(qm, red[w]);
        const float km = __uint_as_float(ld_u32(F.ctl + CW_KMAX + layer * 64 + b * 16 + h));
        const float B2 = 2.f * (sqrtf(qm * km) * 1.01f + 1.f);
        int kt = t0 / 64 - 1, kts = t0 / 64; float D = 0.f;
        while (kt >= 0 && B2 + D >= -160.f) { kts = kt; D += cs[((size_t)b * 16 + h) * 128 + kt]; --kt; }
        ibox[0] = kts; }
    __syncthreads();
    const int kts = ibox[0], s_start = kts * 64, nel = t0 + 256 - s_start;
    { const int i0 = tid * 16; float v[16]; const float* lp = logf + ((size_t)b * 16 + h) * SEQ + s_start + i0;
        if (i0 < nel) {
#pragma unroll
            for (int c = 0; c < 4; ++c) { const f32x4 w = *(const f32x4*)(lp + 4 * c); v[4 * c] = w[0]; v[4 * c + 1] = w[1]; v[4 * c + 2] = w[2]; v[4 * c + 3] = w[3]; } }
        else {
#pragma unroll
            for (int c = 0; c < 16; ++c) v[c] = 0.f; }
#pragma unroll
        for (int c = 1; c < 16; ++c) v[c] += v[c - 1];
        float xsum = v[15];
#pragma unroll
        for (int o = 1; o < 64; o <<= 1) { const float y = __shfl_up(xsum, o); if (lane >= o) xsum += y; }
        if (lane == 63) red[16 + wave] = xsum;
        __syncthreads();
        float off = xsum - v[15];
        for (int w = 0; w < wave; ++w) off += red[16 + w];
        if (i0 < nel) {
#pragma unroll
            for (int c = 0; c < 4; ++c) { f32x4 w = {-(off + v[4 * c]), -(off + v[4 * c + 1]), -(off + v[4 * c + 2]), -(off + v[4 * c + 3])}; *(LAS f32x4*)(ng + i0 + 4 * c) = w; } }
    }
    const int ntile = t0 / 64 + 4 - kts;
    const bf16* kg = proj + (size_t)rowbase * OD_N + OC_K + h * 64; const bf16* vg = proj + (size_t)rowbase * OD_N + OC_V + h * 64;
    const int kr = tid & 31, kc = (tid >> 5) & 7, kst = tid >> 8, vcc = tid & 3, vrow = (tid >> 2) & 63, vdh = tid >> 8;
    const int koff = kst * 4096 + kc * 512 + kr * 16, voff = 8192 + vdh * 4096 + vrow * 64 + vcc * 16;
    { const v4u kv = *(const v4u*)(kg + (size_t)(kts * 64 + kst * 32 + kr) * OD_N + kc * 8), vv = *(const v4u*)(vg + (size_t)(kts * 64 + vrow) * OD_N + vdh * 32 + vcc * 8);
        *(LAS v4u*)(lds + koff) = kv; *(LAS v4u*)(lds + voff) = vv; }
    __syncthreads();
    AttSt S; S.m = -1e30f; S.l = 0.f;
#pragma unroll
    for (int r = 0; r < 16; ++r) { S.o0[r] = 0.f; S.o1[r] = 0.f; }
    const int wlast = t0 + wave * 32 + 31, wfirst = t0 + wave * 32;
    for (int i = 0; i < ntile; ++i) { const int kt = kts + i; LAS unsigned char* buf = lds + (i & 1) * 16384; LAS unsigned char* nbuf = lds + ((i + 1) & 1) * 16384;
        v4u kv, vv; const bool more = i + 1 < ntile;
        if (more) { kv = *(const v4u*)(kg + (size_t)((kt + 1) * 64 + kst * 32 + kr) * OD_N + kc * 8); vv = *(const v4u*)(vg + (size_t)((kt + 1) * 64 + vrow) * OD_N + vdh * 32 + vcc * 8); }
#pragma unroll
        for (int sub = 0; sub < 2; ++sub) { const int kv0 = kt * 64 + sub * 32;
            if (kv0 <= wlast) { FoxBias bf{ng + (kv0 - s_start), tq, kv0, kv0 + 31 > wfirst};
                att_subtile(S, qf, (LAS const char*)buf + sub * 4096, (LAS const char*)buf + 8192, 4096, sub * 32, lane, bf); } }
        if (more) { *(LAS v4u*)(nbuf + koff) = kv; *(LAS v4u*)(nbuf + voff - 8192 + 8192) = vv; }
        __syncthreads(); }
    const float lt = S.l + __shfl_xor(S.l, 32), inv = 1.f / lt;
    bf16* o = ao + (size_t)(rowbase + tq) * 1024 + h * 64;
#pragma unroll
    for (int a4 = 0; a4 < 4; ++a4) { v2u w0, w1;
        w0.x = cvtpk(S.o0[4 * a4] * inv, S.o0[4 * a4 + 1] * inv); w0.y = cvtpk(S.o0[4 * a4 + 2] * inv, S.o0[4 * a4 + 3] * inv);
        w1.x = cvtpk(S.o1[4 * a4] * inv, S.o1[4 * a4 + 1] * inv); w1.y = cvtpk(S.o1[4 * a4 + 2] * inv, S.o1[4 * a4 + 3] * inv);
        *(v2u*)(o + 8 * a4 + 4 * hi) = w0; *(v2u*)(o + 32 + 8 * a4 + 4 * hi) = w1; }
}

DI void ph_ln1_router(const Args& a, const Fr& F, int layer) {
    const float* yp = (const float*)(F.ws + WS_YP); float* x1 = (float*)(F.ws + WS_X1); bf16* xb = (bf16*)(F.ws + WS_XB);
    unsigned* tope = (unsigned*)(F.ws + WS_TOPE); float* gate = (float*)(F.ws + WS_GATE); unsigned* rank = (unsigned*)(F.ws + WS_RANK);
    const float* g = a.in[10] + (size_t)(layer * 2) * DM; const float* bb = a.in[11] + (size_t)(layer * 2) * DM;
    const float* rw = a.in[12] + (size_t)layer * 1024 * 32; const float* rb = a.in[13] + layer * 32;
    LAS float* xs = (LAS float*)(F.lds + F.wave * 16384); LAS unsigned* lcnt = (LAS unsigned*)(F.lds + 131072);
    const int lane = F.lane, wave = F.wave, tid = F.tid;
    for (int chunk = F.blk; chunk < 256; chunk += F.G) { const int tok0 = chunk * 128;
        __syncthreads();
        if (tid < 32) lcnt[tid] = 0u;
        __syncthreads();
        for (int grp = 0; grp < 4; ++grp) { const int tb = tok0 + wave * 16 + grp * 4;
#pragma unroll 1
            for (int k = 0; k < 4; ++k) { const int tok = tb + k; f32x4 v[4];
#pragma unroll
                for (int jj = 0; jj < 4; ++jj) v[jj] = *((const f32x4*)(yp + (size_t)tok * DM) + lane + 64 * jj);
                ln_row(v, g, bb, lane);
                store_row_f32(x1 + (size_t)tok * DM, v, lane); store_row_bf16(xb + (size_t)tok * DM, v, lane);
#pragma unroll
                for (int jj = 0; jj < 4; ++jj) *((LAS f32x4*)(xs + k * 1024) + lane + 64 * jj) = v[jj]; }
            LDS_WAIT();
            float acc[4]; small_proj<32>(xs, rw, 32, lane, acc);
            const float rbn = rb[lane & 31];
#pragma unroll
            for (int k = 0; k < 4; ++k) { float v = lane < 32 ? acc[k] + rbn : -INFINITY; float tv[4]; int te[4];
#pragma unroll
                for (int r = 0; r < 4; ++r) { const float mx = wave_max(v); const unsigned long long mk = __ballot(v == mx); const int e = __builtin_ctzll(mk) & 31; tv[r] = mx; te[r] = e; if (lane == e) v = -INFINITY; }
                const float e1 = __expf(tv[1] - tv[0]), e2 = __expf(tv[2] - tv[0]), e3 = __expf(tv[3] - tv[0]); const float inv = 1.f / (1.f + e1 + e2 + e3);
                if (lane < 4) { const int e = lane == 0 ? te[0] : lane == 1 ? te[1] : lane == 2 ? te[2] : te[3]; const float gv = (lane == 0 ? 1.f : lane == 1 ? e1 : lane == 2 ? e2 : e3) * inv;
                    const unsigned rk = __hip_atomic_fetch_add(lcnt + e, 1u, __ATOMIC_RELAXED, __HIP_MEMORY_SCOPE_WORKGROUP);
                    const size_t o = (size_t)(tb + k) * 4 + lane; tope[o] = (unsigned)e; gate[o] = gv; rank[o] = rk; } }
            LDS_WAIT(); }
        __syncthreads();
        if (tid < 32) __hip_atomic_store(F.ctl + CW_CNT + chunk * 32 + tid, lcnt[tid], RLX_AGENT);
    }
}

DI void ph_route(const Fr& F) {
    const bf16* xb = (const bf16*)(F.ws + WS_XB); bf16* xg = (bf16*)(F.ws + WS_XG);
    const unsigned* tope = (const unsigned*)(F.ws + WS_TOPE); const unsigned* rank = (const unsigned*)(F.ws + WS_RANK); unsigned* dest = (unsigned*)(F.ws + WS_DEST);
    LAS unsigned* P = (LAS unsigned*)(F.lds); LAS unsigned* pst = P + 512; LAS unsigned* pad = P + 544; LAS unsigned* base = P + 576; LAS unsigned* nt = P + 608;
    const int tid = F.tid, lane = F.lane, wave = F.wave;
    __syncthreads();
    { const int e = tid & 31, part = tid >> 5; unsigned s = 0u;
        for (int c = 0; c < 16; ++c) s += ld_u32(F.ctl + CW_CNT + (part * 16 + c) * 32 + e);
        P[part * 32 + e] = s; }
    __syncthreads();
    if (tid < 32) { unsigned tot = 0u;
        for (int p = 0; p < 16; ++p) tot += P[p * 32 + tid];
        pad[tid] = (tot + 255u) & ~255u; }
    __syncthreads();
    if (tid == 0) { unsigned acc = 0u;
        for (int e = 0; e < 32; ++e) { pst[e] = acc; acc += pad[e]; }
        nt[0] = acc >> 8; }
    __syncthreads();
    for (int chunk = F.blk; chunk < 256; chunk += F.G) {
        __syncthreads();
        if (tid < 32) { unsigned off = 0u; const int pf = chunk >> 4;
            for (int p = 0; p < pf; ++p) off += P[p * 32 + tid];
            for (int c = pf * 16; c < chunk; ++c) off += ld_u32(F.ctl + CW_CNT + c * 32 + tid);
            base[tid] = pst[tid] + off; }
        __syncthreads();
        for (int i = 0; i < 16; ++i) { const int tok = chunk * 128 + wave * 16 + i;
            const v4u src0 = *((const v4u*)(xb + (size_t)tok * DM) + lane), src1 = *((const v4u*)(xb + (size_t)tok * DM) + 64 + lane);
#pragma unroll
            for (int k = 0; k < 4; ++k) { const unsigned e = tope[(size_t)tok * 4 + k], d = base[e] + rank[(size_t)tok * 4 + k];
                if (lane == 0) dest[(size_t)tok * 4 + k] = d;
                *((v4u*)(xg + (size_t)d * DM) + lane) = src0; *((v4u*)(xg + (size_t)d * DM) + 64 + lane) = src1; } }
        if (chunk == 0) { const unsigned ntl = nt[0];
            if (tid == 0) __hip_atomic_store(F.ctl + CW_TILE, ntl, RLX_AGENT);
            for (unsigned i = tid; i < ntl; i += NTHR) { unsigned e = 0u;
                for (unsigned k = 1; k < 32; ++k) if (pst[k] <= i * 256u) e = k;
                __hip_atomic_store(F.ctl + CW_TILE + 64 + i, e, RLX_AGENT); } }
    }
}

DI void ph_combine_ln2(const Args& a, const Fr& F, int layer) {
    const float* x1 = (const float*)(F.ws + WS_X1); const bf16* yr = (const bf16*)(F.ws + WS_XG); float* xo = (float*)(F.ws + WS_X); bf16* xb = (bf16*)(F.ws + WS_XB);
    const float* gate = (const float*)(F.ws + WS_GATE); const unsigned* dest = (const unsigned*)(F.ws + WS_DEST);
    const float* g = a.in[10] + (size_t)(layer * 2 + 1) * DM; const float* bb = a.in[11] + (size_t)(layer * 2 + 1) * DM;
    const int lane = F.lane; const int gw = F.blk * NWAVES + F.wave, NGW = F.G * NWAVES;
    for (int tok = gw; tok < NTOK; tok += NGW) { f32x4 v[4];
#pragma unroll
        for (int jj = 0; jj < 4; ++jj) v[jj] = *((const f32x4*)(x1 + (size_t)tok * DM) + lane + 64 * jj) * ALPHA;
#pragma unroll
        for (int k = 0; k < 4; ++k) { const float gk = gate[(size_t)tok * 4 + k]; const unsigned d = dest[(size_t)tok * 4 + k];
#pragma unroll
            for (int jj = 0; jj < 4; ++jj) { const v2u w = *((const v2u*)(yr + (size_t)d * DM) + lane + 64 * jj);
                v[jj][0] += gk * bf2f(w.x & 0xffffu); v[jj][1] += gk * bf2f(w.x >> 16); v[jj][2] += gk * bf2f(w.y & 0xffffu); v[jj][3] += gk * bf2f(w.y >> 16); } }
        ln_row(v, g, bb, lane);
        if (layer == DEPTH - 1) store_row_f32(a.out + (size_t)tok * DM, v, lane);
        else { store_row_f32(xo + (size_t)tok * DM, v, lane); store_row_bf16(xb + (size_t)tok * DM, v, lane); } }
}
constexpr int LDS_BYTES = 147456;
constexpr int LDS_BARW = 145408, LDS_QSLOT = 145472;
constexpr int NPL = 11;
constexpr int NPHASE = 1 + NPL * DEPTH;
#ifndef MK_SINGLE
#define MK_SINGLE 1
#endif
DI int q_next(const Fr& F, unsigned* ctr) {
    LAS int* slot = (LAS int*)(F.lds + LDS_QSLOT);
    __syncthreads();
    if (F.tid == 0) *slot = (int)__hip_atomic_fetch_add(ctr, 1u, RLX_AGENT);
    __syncthreads();
    return *slot;
}
DI int lane_id_fresh() { unsigned m_ = ~0u; asm volatile("" : "+s"(m_)); return (int)__builtin_amdgcn_mbcnt_hi(m_, __builtin_amdgcn_mbcnt_lo(m_, 0u)); }
#define RETID(F) do { int t2_ = F.tid; asm volatile("" : "+v"(t2_)); F.tid = t2_; F.lane = t2_ & 63; F.wave = __builtin_amdgcn_readfirstlane(t2_ >> 6); } while (0)
#define AS4 __attribute__((address_space(4)))
#define SITE() Args a; Fr F; { const AS4 Args* ap = (const AS4 Args*)__builtin_amdgcn_kernarg_segment_ptr(); asm volatile("" : "+s"(ap)); \
        _Pragma("unroll") for (int i_ = 0; i_ < 18; ++i_) a.in[i_] = ap->in[i_]; a.out = ap->out; a.ws = ap->ws; a.ph_lo = 0; a.ph_hi = 0; \
        int w_ = wv_s; asm volatile("" : "+s"(w_)); int t_ = w_ * 64 + lane_id_fresh(); asm volatile("" : "+v"(t_)); F.tid = t_; F.lane = t_ & 63; F.wave = __builtin_amdgcn_readfirstlane(t_ >> 6); \
        F.lds = (LAS unsigned char*)lds_raw; F.ws = a.ws; F.ctl = (unsigned*)(a.ws + WS_CTL); F.blk = blockIdx.x; F.G = gridDim.x; }
__global__ void __launch_bounds__(NTHR, 2) mega_fwd(Args a0) {
    extern __shared__ __attribute__((aligned(16))) unsigned char lds_raw[];
    const int wv_s = __builtin_amdgcn_readfirstlane((int)(threadIdx.x >> 6));
#if MK_SINGLE
    constexpr int lo = 0, hi = NPHASE; constexpr bool single = true;
#else
    const int lo = a0.ph_lo, hi = a0.ph_hi; constexpr bool single = false;
#endif
    if (threadIdx.x == 0) *(LAS v4u*)((LAS unsigned char*)lds_raw + LDS_BARW) = (v4u){0u, 0u, 0u, 0u};
    __syncthreads();
    if (single) (void)xcd_barrier_post((unsigned*)(a0.ws + WS_CTL) + CW_BAR, (volatile LAS unsigned*)((LAS unsigned char*)lds_raw + LDS_BARW));
#define IN(k) (lo <= (k) && (k) < hi)
#define SEAM() do { if (single) { const AS4 Args* ap_ = (const AS4 Args*)__builtin_amdgcn_kernarg_segment_ptr(); asm volatile("" : "+s"(ap_)); int w_ = wv_s; asm volatile("" : "+s"(w_)); \
        XcdBarrier b_; b_.bar = (unsigned*)(ap_->ws + WS_CTL) + CW_BAR; b_.x = xb_xcc_id(); b_.st = (volatile LAS unsigned*)((LAS unsigned char*)lds_raw + LDS_BARW); \
        xcd_barrier(b_, (w_ == 0) && (lane_id_fresh() == 0)); } } while (0)
    if (IN(0)) { { SITE(); ph_prologue(a, F); } SEAM(); }
#pragma unroll 1
    for (int L = 0; L < DEPTH; ++L) {
        const int pb = 1 + NPL * L, j = L >> 1; const bool odd = (L & 1) != 0;
        if (IN(pb + 0)) {
            { SITE();
            const bf16* w = odd ? (const bf16*)(F.ws + WS_WOD) + (size_t)j * OD_N * 1024 : (const bf16*)(F.ws + WS_WEV) + (size_t)j * EV_N * 1024;
            const int N = odd ? OD_N : EV_N;
            pg8::Gemm g{(const bf16*)(F.ws + WS_XB), w, NTOK, N, 1024}; pg8::StaticOrder S; S.init(NTOK, N, F.G, F.blk);
            pg8::EpiBf16<0> E{(bf16*)(F.ws + WS_PROJ), N, nullptr, 1024, (size_t)1024, C2F};
            pg8::gemm_phase<pg8::EpiBf16<0>, pg8::StaticOrder, true, true>(F.lds, g, S, E, F.tid); }
            SEAM(); }
        if (IN(pb + 1)) { { SITE(); if (odd) ph_odd_prep(a, F, j, L); else ph_even_prep(a, F, j); } SEAM(); }
        if (!odd && IN(pb + 2)) {
            { SITE(); unsigned* ctr = F.ctl + CW_Q + 64 * (L * 2);
            for (;;) { const int it = q_next(F, ctr); if (it >= 1280) break; RETID(F);
                if (it < 1024) { if (!(EXPF & 16)) idx_unit(F, it & 3, 255 - (it >> 2)); } else { if (!(EXPF & 32)) moba_gate_chunk(F, it - 1024); } } }
            SEAM(); }
        if (IN(pb + 3)) {
            { SITE(); unsigned* ctr = F.ctl + CW_Q + 64 * (L * 2 + 1);
            if (odd) { for (;;) { const int it = q_next(F, ctr); if (it >= 2048) break; RETID(F); const int bh = it & 63; fox_unit(F, L, bh >> 4, bh & 15, 31 - (it >> 6)); } }
            else { for (;;) { const int it = q_next(F, ctr); if (it >= 2048) break; RETID(F);
                    if (it < 1024) { const int bh = it & 31; if (!(EXPF & 32)) moba_unit(a, F, bh >> 3, bh & 7, it >> 5); } else { if (!(EXPF & 16) && !(EXPF & 256)) dsa_chunk(a, F, it - 1024); } } } }
            SEAM(); }
        if (!odd && IN(pb + 4)) { { SITE(); ph_even_post(F, j); } SEAM(); }
        if (IN(pb + 5)) {
            { SITE();
            const float* xin = (L == 0) ? a.in[0] : (const float*)(F.ws + WS_X);
            pg8::Gemm g{(const bf16*)(F.ws + WS_AO), (const bf16*)(F.ws + WS_WOUT) + (size_t)L * 1024 * 1024, NTOK, 1024, 1024}; pg8::StaticOrder S; S.init(NTOK, 1024, F.G, F.blk);
            EpiResF32 E{xin, (float*)(F.ws + WS_YP), ALPHA};
            pg8::gemm_phase<EpiResF32, pg8::StaticOrder, true, true>(F.lds, g, S, E, F.tid); }
            SEAM(); }
        if (IN(pb + 6)) { { SITE(); ph_ln1_router(a, F, L); } SEAM(); }
        if (IN(pb + 7)) { { SITE(); ph_route(F); } SEAM(); }
        if (IN(pb + 8)) {
            { SITE(); const int ntl = (int)ld_u32(F.ctl + CW_TILE);
            pg8::Gemm g{(const bf16*)(F.ws + WS_XG), (const bf16*)(F.ws + WS_WGU) + (size_t)L * 32 * 2048 * 1024, NR_MAX, 32 * 2048, 1024};
            GroupOrder S{F.ctl + CW_TILE + 64, ntl, 3, F.G, F.blk};
            EpiSwiglu E{(bf16*)(F.ws + WS_ACT), a.in[15] + (size_t)L * 32 * 2048};
            pg8::gemm_phase<EpiSwiglu, GroupOrder, true, true>(F.lds, g, S, E, F.tid); }
            SEAM(); }
        if (IN(pb + 9)) {
            { SITE(); const int ntl = (int)ld_u32(F.ctl + CW_TILE);
            pg8::Gemm g{(const bf16*)(F.ws + WS_ACT), (const bf16*)(F.ws + WS_WDN) + (size_t)L * 32 * 1024 * 1024, NR_MAX, 32 * 1024, 1024};
            GroupOrder S{F.ctl + CW_TILE + 64, ntl, 2, F.G, F.blk};
            EpiDown E{(bf16*)(F.ws + WS_XG), a.in[17] + (size_t)L * 32 * 1024};
            pg8::gemm_phase<EpiDown, GroupOrder, true, true>(F.lds, g, S, E, F.tid); }
            SEAM(); }
        if (IN(pb + 10)) { { SITE(); ph_combine_ln2(a, F, L); } if (L + 1 < DEPTH) SEAM(); }
    }
#undef IN
#undef SEAM
}

extern "C" void kernel_launch(void* const* d_in, const int* in_sizes, int n_in, void* d_out, int out_size, void* d_ws, size_t ws_size, hipStream_t stream) {
    static int grid = 0;
    if (grid == 0) {
        if (n_in != 18 || out_size != NTOK * DM || ws_size < WS_END) { fprintf(stderr, "kernel_launch: unexpected shapes (n_in %d, out %d, ws %zu); nothing launched\n", n_in, out_size, ws_size); grid = -1; return; }
        int dev = 0, cus = 0, per_cu = 0;
        if (hipGetDevice(&dev) != hipSuccess || hipDeviceGetAttribute(&cus, hipDeviceAttributeMultiprocessorCount, dev) != hipSuccess) { grid = -1; return; }
        if (hipFuncSetAttribute((const void*)mega_fwd, hipFuncAttributeMaxDynamicSharedMemorySize, LDS_BYTES) != hipSuccess) { fprintf(stderr, "kernel_launch: hipFuncSetAttribute failed\n"); grid = -1; return; }
        if (hipOccupancyMaxActiveBlocksPerMultiprocessor(&per_cu, (const void*)mega_fwd, NTHR, LDS_BYTES) != hipSuccess || per_cu < 1) fprintf(stderr, "kernel_launch: occupancy query reports %d\n", per_cu);
        (void)hipGetLastError();
        grid = cus;
    }
    if (grid < 0) return;
    (void)hipMemsetAsync((char*)d_ws + WS_CTL, 0, CTL_ZERO_BYTES, stream);
#ifdef EXP_SKIP
    (void)hipMemsetAsync((char*)d_ws + WS_AO, 0, 64 * MiB, stream);
    (void)hipMemsetAsync((char*)d_ws + WS_OL, 0, 64 * MiB, stream);
    if (EXP_SKIP & 4) { (void)hipMemsetAsync((char*)d_ws + WS_XG, 0, 272 * MiB, stream); (void)hipMemsetAsync((char*)d_ws + WS_DEST, 0, 1 * MiB, stream); }
#endif
    Args a{};
    for (int i = 0; i < 18; ++i) a.in[i] = (const float*)d_in[i];
    a.out = (float*)d_out; a.ws = (unsigned char*)d_ws;
#if MK_SINGLE
    a.ph_lo = 0; a.ph_hi = NPHASE;
    hipLaunchKernelGGL(mega_fwd, dim3(grid), dim3(NTHR), LDS_BYTES, stream, a);
#else
    for (int p = 0; p < NPHASE; ++p) {
        if (p > 0) { const int L = (p - 1) / NPL, q = (p - 1) % NPL; if ((L & 1) && (q == 2 || q == 4)) continue;
#ifdef EXP_SKIP
            if ((EXP_SKIP & 1) && !(L & 1) && q <= 4) continue;
            if ((EXP_SKIP & 2) && (L & 1) && q <= 4) continue;
            if ((EXP_SKIP & 4) && q >= 7 && q <= 9) continue;
#endif
        }
        a.ph_lo = p; a.ph_hi = p + 1;
        hipLaunchKernelGGL(mega_fwd, dim3(grid), dim3(NTHR), LDS_BYTES, stream, a);
    }
#endif
}
```

```cpp
#include <hip/hip_runtime.h>
#include <cstdio>
#include <cstdint>
#ifdef EXP_SKIP
#define EXPF EXP_SKIP
#else
#define EXPF 0
#endif
constexpr int NB = 4, SEQ = 8192, DM = 1024, NTOK = NB * SEQ, DEPTH = 4;
constexpr int EV_N = 2560, OD_N = 3072;
constexpr int EC_QA = 0, EC_QB = 512, EC_KB = 1024, EC_VB = 1536, EC_CKV = 2048, EC_QI = 2176, EC_KI = 2432, EC_WI = 2496;
constexpr int OC_Q = 0, OC_K = 1024, OC_V = 2048;
constexpr float LOG2E = 1.4426950408889634f;
constexpr float C2F = 0.125f * LOG2E;
constexpr float ALPHA = 1.681792830507429f;
constexpr float LN_EPS = 1e-5f;
constexpr int NR_MAX = 131072 + 32 * 256;
constexpr int NWAVES = 8, NTHR = 512;
constexpr size_t MiB = (size_t)1 << 20;
constexpr size_t WS_CTL = 0, CTL_ZERO_BYTES = 4 * MiB;
constexpr size_t WS_WEV = 8 * MiB, WS_WOD = 18 * MiB, WS_WOUT = 30 * MiB, WS_WUKT = 38 * MiB, WS_WUVT = 39 * MiB;
constexpr size_t WS_WGU = 40 * MiB, WS_WDN = 552 * MiB;
constexpr size_t WS_X = 808 * MiB, WS_X1 = 936 * MiB, WS_YP = 1064 * MiB, WS_XB = 1192 * MiB;
constexpr size_t WS_PROJ = 1256 * MiB, WS_AO = 1448 * MiB, WS_XG = 1512 * MiB, WS_ACT = 1784 * MiB;
constexpr size_t WS_QL = 2056 * MiB, WS_OL = 2120 * MiB, WS_CKVN = 2184 * MiB, WS_SEL = 2192 * MiB;
constexpr size_t WS_KBAR = 2208 * MiB, WS_SEL3 = 2209 * MiB, WS_LOGF = 2210 * MiB, WS_CS = 2212 * MiB;
constexpr size_t WS_TOPE = 2213 * MiB, WS_GATE = 2214 * MiB, WS_RANK = 2215 * MiB, WS_DEST = 2216 * MiB, WS_PML = 2217 * MiB;
constexpr size_t WS_END = 2226 * MiB;
constexpr int CW_BAR = 4096, CW_Q = 8192, CW_KMAX = 12288, CW_CNT = 16384, CW_TILE = 32768;

#define GAS __attribute__((address_space(1)))
#define LAS __attribute__((address_space(3)))
#define DI __device__ __forceinline__
typedef unsigned short bf16;
typedef unsigned v4u __attribute__((ext_vector_type(4)));
typedef unsigned v2u __attribute__((ext_vector_type(2)));
typedef float f32x4 __attribute__((ext_vector_type(4)));
typedef float f32x2 __attribute__((ext_vector_type(2)));
typedef float f32x16 __attribute__((ext_vector_type(16)));
typedef short bf16x8 __attribute__((ext_vector_type(8)));
typedef short s16x4 __attribute__((ext_vector_type(4)));
typedef __bf16 bf16x2_t __attribute__((ext_vector_type(2)));
typedef GAS unsigned gu32;
#define RLX_AGENT __ATOMIC_RELAXED, __HIP_MEMORY_SCOPE_AGENT
#define LDS_WAIT() asm volatile("s_waitcnt lgkmcnt(0)" ::: "memory")

DI float bf2f(unsigned v) { return __uint_as_float(v << 16); }
DI unsigned cvtpk(float lo, float hi) { f32x2 v = {lo, hi}; bf16x2_t b = __builtin_convertvector(v, bf16x2_t); return __builtin_bit_cast(unsigned, b); }
DI unsigned f2bf(float f) { return cvtpk(f, 0.f) & 0xffffu; }
DI float ex2(float x) { return __builtin_amdgcn_exp2f(x); }
DI float wave_sum(float v) {
#pragma unroll
    for (int o = 1; o < 64; o <<= 1) v += __shfl_xor(v, o);
    return v;
}
DI float wave_max(float v) {
#pragma unroll
    for (int o = 1; o < 64; o <<= 1) v = fmaxf(v, __shfl_xor(v, o));
    return v;
}
DI unsigned ld_u32(const unsigned* p) { return __hip_atomic_load(p, RLX_AGENT); }
DI int crow(int r, int hi) { return (r & 3) + 8 * (r >> 2) + 4 * hi; }
DI f32x16 mfma32(bf16x8 a, bf16x8 b, f32x16 c) { return __builtin_amdgcn_mfma_f32_32x32x16_bf16(a, b, c, 0, 0, 0); }
DI f32x4 mfma16(bf16x8 a, bf16x8 b, f32x4 c) { return __builtin_amdgcn_mfma_f32_16x16x32_bf16(a, b, c, 0, 0, 0); }
typedef short v4i16_t __attribute__((ext_vector_type(4)));
DI s16x4 vtr(LAS const char* p) { return __builtin_bit_cast(s16x4, __builtin_amdgcn_ds_read_tr16_b64_v4i16((LAS v4i16_t*)p)); }
DI bf16x8 cat8(s16x4 a, s16x4 b) { return (bf16x8){a[0], a[1], a[2], a[3], b[0], b[1], b[2], b[3]}; }
DI int t5_bucket(int n) {
    if (n < 16) return n;
    int bkt = 16;
    bkt += (n >= 21); bkt += (n >= 27); bkt += (n >= 35); bkt += (n >= 46); bkt += (n >= 59); bkt += (n >= 77); bkt += (n >= 99); bkt += (n >= 128);
    bkt += (n >= 166); bkt += (n >= 216); bkt += (n >= 280); bkt += (n >= 363); bkt += (n >= 470); bkt += (n >= 609); bkt += (n >= 790);
    return bkt;
}
namespace pg8 {
#define PG8_LAS __attribute__((address_space(3)))
typedef unsigned short bf16_t;
typedef short bf16x8 __attribute__((ext_vector_type(8)));
typedef float f32x4 __attribute__((ext_vector_type(4)));
typedef unsigned u32x4 __attribute__((ext_vector_type(4)));
constexpr int BM = 256, BK = 64, HALF = 128, HTB = HALF * BK * 2  , STAGE_BYTES = 8 * HTB, NXCD = 8, WGM = 8;

__host__ __device__ __forceinline__ int lds_byte(int r, int c) { const int st = (r >> 4) * 2 + (c >> 5), rr = r & 15, cc = c & 31, ob = rr * 64 + cc * 2; return st * 1024 + (ob ^ (((ob >> 9) & 1) << 5)); }
__host__ __device__ __forceinline__ void stage_rc(int b, int& R, int& C) { const int st = b / 1024, sb = b % 1024, swz = sb ^ (((sb >> 9) & 1) << 5); R = (st >> 1) * 16 + swz / 64; C = (st & 1) * 32 + (swz % 64) / 2; }
__host__ __device__ __forceinline__ int perm32(int rho) { const int n = rho >> 4, i = rho & 15; return 8 * (i >> 2) + 4 * n + (i & 3); }

struct Unit { int pm, pn; };
struct Gemm { const bf16_t* A; const bf16_t* Bt; int M, N, K; };

struct StaticOrder {
    int nM, nN, nwg, G, c;
    __host__ __device__ void init(int M, int N, int G_, int c_) { nM = M / BM; nN = N / BM; nwg = nM * nN; G = G_; c = c_; }
    __host__ __device__ bool next(int i, Unit& u) const {
        const long L = (long)i * G + c; if (L >= nwg) return false;
        int wgid = (int)L; { const int q = nwg / NXCD, r = nwg % NXCD, xcd = wgid % NXCD, off = wgid / NXCD; wgid = (xcd < r ? xcd * (q + 1) : r * (q + 1) + (xcd - r) * q) + off; }
        const int nig = WGM * nN, gid = wgid / nig, fm = gid * WGM, gsz = (nM - fm) < WGM ? (nM - fm) : WGM;
        u.pm = fm + ((wgid % nig) % gsz); u.pn = (wgid % nig) / gsz; return true;
    }
    __device__ __forceinline__ void a_ready(const Unit&) const {}
    __device__ __forceinline__ void done(const Unit&) const {}
};

__device__ __forceinline__ unsigned cvt_pk_bf16(float lo, float hi) { unsigned r; asm volatile("v_cvt_pk_bf16_f32 %0, %1, %2" : "=v"(r) : "v"(lo), "v"(hi)); return r; }
typedef float f32x2 __attribute__((ext_vector_type(2)));
__device__ __forceinline__ f32x2 gelu_pk(f32x2 v) {
    const f32x2 av = __builtin_elementwise_abs(v), d = av * 0.2316418882f + 1.0f;
    f32x2 t; t.x = __builtin_amdgcn_rcpf(d.x); t.y = __builtin_amdgcn_rcpf(d.y);
    f32x2 q = t * 0.5307027145f + (-0.7265760135f); q = q * t + 0.7107068705f; q = q * t + (-0.142248368f); q = q * t + 0.127414796f; q = q * t;
    const f32x2 s = (v * v) * (-0.72134752044f);
    f32x2 e; e.x = __builtin_amdgcn_exp2f(s.x); e.y = __builtin_amdgcn_exp2f(s.y);
    const f32x2 m = v * (q * e), r = v - m;
    f32x2 o; o.x = v.x < 0.f ? m.x : r.x; o.y = v.y < 0.f ? m.y : r.y; return o;
}

template <int ACT  > struct EpiBf16 {
    static constexpr bool PERM = true, AFTER_DRAIN = false; static_assert(ACT == 0 || ACT == 1, "EpiBf16: ACT is 0 (none) or 1 (gelu_pk)");
    bf16_t* O; int ldc; const float* bias; int split_cols; size_t split_stride; float scale0;
    __device__ __forceinline__ void operator()(const f32x4 (&acc)[2][2][4][2], const Unit& u, int wr, int wc, int fr, int fq) const {
        const int row0 = u.pm * BM + wr * 64 + fr; int colt = u.pn * BM; bf16_t* base = O;
        float sc = 1.f; if (split_cols) { const int t = colt / split_cols; base += (size_t)t * split_stride; colt -= t * split_cols; if (t == 0) sc = scale0; }
        const int col0 = colt + wc * 32 + 8 * fq, bcol0 = u.pn * BM + wc * 32 + 8 * fq;
        f32x4 bv[2][2];
#pragma unroll
        for (int bj = 0; bj < 2; ++bj)
#pragma unroll
            for (int n = 0; n < 2; ++n) bv[bj][n] = bias ? *(const f32x4*)(bias + bcol0 + bj * HALF + 4 * n) : (f32x4){0.f, 0.f, 0.f, 0.f};
#pragma unroll
        for (int ai = 0; ai < 2; ++ai)
#pragma unroll
            for (int m = 0; m < 4; ++m) { bf16_t* rowp = base + (size_t)(row0 + ai * HALF + m * 16) * ldc + col0;
#pragma unroll
                for (int bj = 0; bj < 2; ++bj) { f32x4 v0 = acc[ai][bj][m][0] + bv[bj][0], v1 = acc[ai][bj][m][1] + bv[bj][1];
                    if (ACT == 1) { f32x2 a = gelu_pk((f32x2){v0[0], v0[1]}), b = gelu_pk((f32x2){v0[2], v0[3]}), c = gelu_pk((f32x2){v1[0], v1[1]}), d = gelu_pk((f32x2){v1[2], v1[3]});
                        v0 = (f32x4){a.x, a.y, b.x, b.y}; v1 = (f32x4){c.x, c.y, d.x, d.y}; }
                    v0 = v0 * sc; v1 = v1 * sc; u32x4 w; w.x = cvt_pk_bf16(v0[0], v0[1]); w.y = cvt_pk_bf16(v0[2], v0[3]); w.z = cvt_pk_bf16(v1[0], v1[1]); w.w = cvt_pk_bf16(v1[2], v1[3]);
                    *(u32x4*)(rowp + bj * HALF) = w; } }
    }
};

template <class Epi, class Sched, bool ALIGN_EPI = false, bool SP2 = false>
__device__ __forceinline__ void gemm_phase(PG8_LAS unsigned char* lds, const Gemm g, const Sched& S, const Epi& E, int tid_in) {
    int tid_l = tid_in; asm volatile("" : "+v"(tid_l));
    const int tid = tid_l, wid = __builtin_amdgcn_readfirstlane(tid >> 6), lane = tid & 63, wr = wid >> 2, wc = wid & 3, fr = lane & 15, fq = lane >> 4;
    const int K = g.K, nt = K / BK;
    unsigned voffA[2], voffB[2];
#pragma unroll
    for (int i = 0; i < 2; ++i) { int R, C; stage_rc(tid * 16 + i * 8192, R, C); const int Rb = Epi::PERM ? ((R & ~31) + perm32(R & 31)) : R;
        voffA[i] = (unsigned)(R * K + C) * 2u; voffB[i] = (unsigned)(Rb * K + C) * 2u; }
    const size_t kstep = (size_t)(BK * 2);
    const size_t hstep = (size_t)HALF * K * 2;
    const size_t tstep = 2 * hstep;
    const unsigned ldsw = (unsigned)wid * 1024u;
    const int aoff = lds_byte(wr * 64 + fr, fq * 8), boff = lds_byte(wc * 32 + fr, fq * 8);
#define PG8_SA(b, h) (((b) * 2 + (h)) * HTB)
#define PG8_SB(b, h) ((4 + (b) * 2 + (h)) * HTB)
#define PG8_STAGE(bufoff, gbase, voff) do { _Pragma("unroll") for (int _i = 0; _i < 2; ++_i) \
        __builtin_amdgcn_global_load_lds((const unsigned*)((const char*)(gbase) + (voff)[_i]), (PG8_LAS unsigned*)(lds + (bufoff) + ldsw + _i * 8192), 16, 0, 0); } while (0)
#define PG8_LDA(dst, b, h) do { _Pragma("unroll") for (int m = 0; m < 4; ++m) _Pragma("unroll") for (int k = 0; k < 2; ++k) dst[m][k] = *(const PG8_LAS bf16x8*)(lds + PG8_SA(b, h) + aoff + m * 2048 + k * 1024); } while (0)
#define PG8_LDB(dst, b, h) do { _Pragma("unroll") for (int n = 0; n < 2; ++n) _Pragma("unroll") for (int k = 0; k < 2; ++k) dst[n][k] = *(const PG8_LAS bf16x8*)(lds + PG8_SB(b, h) + boff + n * 2048 + k * 1024); } while (0)
#define PG8_MMA(ai, bj, At, Bt) do { __builtin_amdgcn_s_setprio(1); _Pragma("unroll") for (int m = 0; m < 4; ++m) _Pragma("unroll") for (int n = 0; n < 2; ++n) _Pragma("unroll") for (int k = 0; k < 2; ++k) \
        acc[ai][bj][m][n] = __builtin_amdgcn_mfma_f32_16x16x32_bf16(Bt[n][k], At[m][k], acc[ai][bj][m][n], 0, 0, 0); __builtin_amdgcn_s_setprio(0); } while (0)
#define PG8_WAIT_V(n) asm volatile("s_waitcnt vmcnt(" #n ")" ::: "memory")
#define PG8_WAIT_L(n) asm volatile("s_waitcnt lgkmcnt(" #n ")" ::: "memory")
#define PG8_BAR __builtin_amdgcn_s_barrier()
#define PG8_SCHED __builtin_amdgcn_sched_barrier(0)
    Unit cur, nxt; int ui = 0;
    if (!S.next(0, cur)) return;
    f32x4 acc[2][2][4][2];
#pragma unroll
    for (int a = 0; a < 2; ++a)
#pragma unroll
        for (int b = 0; b < 2; ++b)
#pragma unroll
            for (int m = 0; m < 4; ++m)
#pragma unroll
                for (int n = 0; n < 2; ++n) acc[a][b][m][n] = (f32x4){0.f, 0.f, 0.f, 0.f};
    bf16x8 At[4][2], B0[2][2], B1[2][2];
    const char* cA = (const char*)g.A + (size_t)cur.pm * tstep; const char* cB = (const char*)g.Bt + (size_t)cur.pn * tstep;
    S.a_ready(cur);
    if constexpr (SP2) {
        PG8_STAGE(PG8_SB(0, 0), cB, voffB); PG8_STAGE(PG8_SB(0, 1), cB + hstep, voffB); PG8_STAGE(PG8_SA(0, 0), cA, voffA); PG8_STAGE(PG8_SA(0, 1), cA + hstep, voffA);
        if (wr == 1) PG8_BAR;
        PG8_WAIT_V(2); PG8_BAR;
        PG8_STAGE(PG8_SB(1, 0), cB + kstep, voffB); PG8_STAGE(PG8_SA(1, 0), cA + kstep, voffA); PG8_STAGE(PG8_SB(1, 1), cB + hstep + kstep, voffB);
        PG8_WAIT_V(6); PG8_BAR;
    } else {
        PG8_STAGE(PG8_SB(0, 0), cB, voffB); PG8_STAGE(PG8_SA(0, 0), cA, voffA); PG8_STAGE(PG8_SB(0, 1), cB + hstep, voffB); PG8_STAGE(PG8_SA(0, 1), cA + hstep, voffA);
        if (wr == 1) PG8_BAR;
        PG8_WAIT_V(4); PG8_BAR;
        PG8_STAGE(PG8_SB(1, 0), cB + kstep, voffB); PG8_STAGE(PG8_SA(1, 0), cA + kstep, voffA); PG8_STAGE(PG8_SB(1, 1), cB + hstep + kstep, voffB);
        PG8_WAIT_V(6); PG8_BAR;
    }
    for (;;) {
        const bool has_next = S.next(ui + 1, nxt);
        const char* nA = has_next ? (const char*)g.A + (size_t)nxt.pm * tstep : cA; const char* nB = has_next ? (const char*)g.Bt + (size_t)nxt.pn * tstep : cB;
        for (int t = 0; t < nt; t += 2) {
            const bool last = (t == nt - 2);
            const char* a1 = cA + (size_t)(t + 1) * kstep;
            const char* a2 = last ? nA : cA + (size_t)(t + 2) * kstep; const char* b2 = last ? nB : cB + (size_t)(t + 2) * kstep;
            const char* a3 = a2 + kstep; const char* b3 = b2 + kstep;
            if (last && has_next) S.a_ready(nxt);
            if constexpr (SP2) {
            PG8_LDB(B0, 0, 0); PG8_LDB(B1, 0, 1); PG8_SCHED; PG8_LDA(At, 0, 0); PG8_STAGE(PG8_SA(1, 1), a1 + hstep, voffA);
            PG8_WAIT_V(8); PG8_WAIT_L(0); PG8_BAR; PG8_MMA(0, 0, At, B0); PG8_MMA(0, 1, At, B1); PG8_BAR; PG8_SCHED;
            PG8_LDA(At, 0, 1); PG8_STAGE(PG8_SB(0, 0), b2, voffB); PG8_STAGE(PG8_SB(0, 1), b2 + hstep, voffB); PG8_STAGE(PG8_SA(0, 0), a2, voffA);
            PG8_WAIT_V(8); PG8_WAIT_L(0); PG8_BAR; PG8_MMA(1, 0, At, B0); PG8_MMA(1, 1, At, B1); PG8_BAR; PG8_SCHED;
            PG8_LDB(B0, 1, 0); PG8_LDB(B1, 1, 1); PG8_SCHED; PG8_LDA(At, 1, 0); PG8_STAGE(PG8_SA(0, 1), a2 + hstep, voffA);
            PG8_WAIT_V(8); PG8_WAIT_L(0); PG8_BAR; PG8_MMA(0, 0, At, B0); PG8_MMA(0, 1, At, B1); PG8_BAR; PG8_SCHED;
            PG8_LDA(At, 1, 1); PG8_STAGE(PG8_SB(1, 0), b3, voffB); PG8_STAGE(PG8_SB(1, 1), b3 + hstep, voffB); PG8_STAGE(PG8_SA(1, 0), a3, voffA);
            PG8_WAIT_V(8); PG8_WAIT_L(0); PG8_BAR; PG8_MMA(1, 0, At, B0); PG8_MMA(1, 1, At, B1); PG8_BAR; PG8_SCHED;
            } else {
            PG8_LDB(B0, 0, 0); PG8_SCHED; PG8_LDA(At, 0, 0); PG8_STAGE(PG8_SA(1, 1), a1 + hstep, voffA);
            PG8_WAIT_L(8); PG8_BAR; PG8_WAIT_L(0); PG8_MMA(0, 0, At, B0); PG8_BAR; PG8_SCHED;
            PG8_LDB(B1, 0, 1); PG8_STAGE(PG8_SB(0, 0), b2, voffB);
            PG8_BAR; PG8_WAIT_L(0); PG8_MMA(0, 1, At, B1); PG8_BAR;
            PG8_LDA(At, 0, 1); PG8_STAGE(PG8_SA(0, 0), a2, voffA);
            PG8_BAR; PG8_WAIT_L(0); PG8_MMA(1, 0, At, B0); PG8_BAR; PG8_SCHED;
            PG8_STAGE(PG8_SB(0, 1), b2 + hstep, voffB);
            PG8_WAIT_V(6); PG8_BAR; PG8_MMA(1, 1, At, B1); PG8_BAR;
            PG8_LDB(B0, 1, 0); PG8_SCHED; PG8_LDA(At, 1, 0); PG8_STAGE(PG8_SA(0, 1), a2 + hstep, voffA);
            PG8_WAIT_L(8); PG8_BAR; PG8_WAIT_L(0); PG8_MMA(0, 0, At, B0); PG8_BAR; PG8_SCHED;
            PG8_LDB(B1, 1, 1); PG8_STAGE(PG8_SB(1, 0), b3, voffB);
            PG8_BAR; PG8_WAIT_L(0); PG8_MMA(0, 1, At, B1); PG8_BAR;
            PG8_LDA(At, 1, 1); PG8_STAGE(PG8_SA(1, 0), a3, voffA);
            PG8_BAR; PG8_WAIT_L(0); PG8_MMA(1, 0, At, B0); PG8_BAR; PG8_SCHED;
            PG8_STAGE(PG8_SB(1, 1), b3 + hstep, voffB);
            PG8_WAIT_V(6); PG8_BAR; PG8_MMA(1, 1, At, B1); PG8_BAR;
            }
        }
        if constexpr (ALIGN_EPI) { if (wr == 0) PG8_BAR; }
        if constexpr (!Epi::AFTER_DRAIN) { E(acc, cur, wr, wc, fr, fq); S.done(cur); }
        if (!has_next) break;
#pragma unroll
        for (int a = 0; a < 2; ++a)
#pragma unroll
            for (int b = 0; b < 2; ++b)
#pragma unroll
                for (int m = 0; m < 4; ++m)
#pragma unroll
                    for (int n = 0; n < 2; ++n) acc[a][b][m][n] = (f32x4){0.f, 0.f, 0.f, 0.f};
        cur = nxt; cA = nA; cB = nB; ++ui;
        if constexpr (ALIGN_EPI) { if (wr == 1) PG8_BAR; }
    }
    PG8_WAIT_V(0);
    if constexpr (!ALIGN_EPI) { if (wr == 0) PG8_BAR; }
    PG8_BAR;
    if constexpr (Epi::AFTER_DRAIN) { E.fused(acc, cur, wr, wc, fr, fq, lds, wid, lane); S.done(cur); }
#undef PG8_SA
#undef PG8_SB
#undef PG8_STAGE
#undef PG8_LDA
#undef PG8_LDB
#undef PG8_MMA
#undef PG8_WAIT_V
#undef PG8_WAIT_L
#undef PG8_BAR
#undef PG8_SCHED
}
}

#ifndef PG8_SP2
#define PG8_SP2 true
#endif
#ifndef PG8_ALIGN
#define PG8_ALIGN true
#endif
#define XB_TMO      128
#define XB_XCNT(j)  (256  + 64 * (j))
#define XB_XSUB(j)  (1280 + 64 * (j))
#define XB_XGEN(j)  (2304 + 64 * (j))
#define XB_TOP      3328
#define XB_TOPGEN   3392
#define XCD_BAR_WORDS 3456
#define XB_SPIN_CAP (1u << 18)

__device__ __forceinline__ unsigned xb_ld(unsigned* p)              { return __hip_atomic_load(p, __ATOMIC_RELAXED, __HIP_MEMORY_SCOPE_AGENT); }
__device__ __forceinline__ unsigned xb_add(unsigned* p, unsigned v) { return __hip_atomic_fetch_add(p, v, __ATOMIC_RELAXED, __HIP_MEMORY_SCOPE_AGENT); }
__device__ __forceinline__ unsigned xb_xcc_id() { return (unsigned)__builtin_amdgcn_s_getreg((3 << 11) | 20) & 0xFu; }
#define XB_SPIN(cond, bar) do { unsigned _sp = 0; while (cond) { __builtin_amdgcn_s_sleep(1); \
    if ((++_sp & 255u) == 0u) { if (xb_ld(&(bar)[XB_TMO])) break; if (_sp > XB_SPIN_CAP) { atomicAdd(&(bar)[XB_TMO], 1u); break; } } } } while (0)

struct XcdBarrier {
    unsigned* bar; unsigned x;
    volatile LAS unsigned* st;
};

__device__ __forceinline__ XcdBarrier xcd_barrier_post(unsigned* bar, volatile LAS unsigned* st) {
    XcdBarrier b; b.bar = bar; b.x = xb_xcc_id(); b.st = st;
    if (threadIdx.x == 0) (void)xb_add(&bar[XB_XCNT(b.x)], 1u);
    return b;
}
__device__ __forceinline__ void xcd_barrier_complete(unsigned* bar, unsigned x, unsigned& nloc, unsigned& nx) {
    const unsigned G = gridDim.x * gridDim.y * gridDim.z;
    unsigned sum, cnt, mine, sp = 0u;
    for (;;) {
        sum = 0u; cnt = 0u; mine = 0u;
#pragma unroll
        for (unsigned j = 0; j < 16; ++j) { const unsigned c = xb_ld(&bar[XB_XCNT(j)]); sum += c; cnt += (c > 0u) ? 1u : 0u; mine = (j == x) ? c : mine; }
        if (sum == G) break;
        __builtin_amdgcn_s_sleep(1);
        if ((++sp & 255u) == 0u) { if (xb_ld(&bar[XB_TMO])) break; if (sp > XB_SPIN_CAP) { atomicAdd(&bar[XB_TMO], 1u); break; } }
    }
    nloc = mine > 0u ? mine : 1u; nx = cnt > 0u ? cnt : 1u;
}

__device__ __forceinline__ void xcd_barrier(const XcdBarrier& b, const bool is_t0  ) {
    asm volatile("s_waitcnt vmcnt(0)" ::: "memory");
    __syncthreads();
    if (is_t0) {
        unsigned* bar = b.bar;
        __builtin_amdgcn_s_waitcnt(0);
        unsigned nloc = b.st[0], nx = b.st[1];
        if (nloc == 0u) { xcd_barrier_complete(bar, b.x, nloc, nx); b.st[0] = nloc; b.st[1] = nx; }
        const unsigned old = xb_add(&bar[XB_XSUB(b.x)], 1u);
        const unsigned gen = old / nloc;
        if (old + 1u == (gen + 1u) * nloc) {
            __builtin_amdgcn_fence(__ATOMIC_RELEASE, "agent");
            asm volatile("s_waitcnt vmcnt(0)" ::: "memory");
            const unsigned og = xb_add(&bar[XB_TOP], 1u);
            const unsigned tg = og / nx;
            if (og + 1u == (tg + 1u) * nx) xb_add(&bar[XB_TOPGEN], 1u);
            else XB_SPIN(xb_ld(&bar[XB_TOPGEN]) == tg, bar);
            __builtin_amdgcn_fence(__ATOMIC_ACQUIRE, "agent");
            xb_add(&bar[XB_XGEN(b.x)], 1u);
            asm volatile("s_waitcnt vmcnt(0)" ::: "memory");
        } else {
            XB_SPIN(xb_ld(&bar[XB_XGEN(b.x)]) == gen, bar);
            __builtin_amdgcn_fence(__ATOMIC_ACQUIRE, "agent");
            asm volatile("s_waitcnt vmcnt(0)" ::: "memory");
        }
    }
    __syncthreads();
}
struct EpiResF32 {
    static constexpr bool PERM = true, AFTER_DRAIN = false;
    const float* xin; float* yp; float alpha;
    DI void operator()(const pg8::f32x4 (&acc)[2][2][4][2], const pg8::Unit& u, int wr, int wc, int fr, int fq) const {
        const int row0 = u.pm * 256 + wr * 64 + fr, col0 = u.pn * 256 + wc * 32 + 8 * fq;
#pragma unroll
        for (int ai = 0; ai < 2; ++ai)
#pragma unroll
            for (int m = 0; m < 4; ++m) {
                const size_t ro = (size_t)(row0 + ai * 128 + m * 16) * DM;
#pragma unroll
                for (int bj = 0; bj < 2; ++bj) {
                    const size_t o = ro + col0 + bj * 128;
                    const f32x4 x0 = *(const f32x4*)(xin + o), x1 = *(const f32x4*)(xin + o + 4);
                    *(f32x4*)(yp + o) = x0 * alpha + acc[ai][bj][m][0];
                    *(f32x4*)(yp + o + 4) = x1 * alpha + acc[ai][bj][m][1];
                }
            }
    }
};
struct EpiSwiglu {
    static constexpr bool PERM = true, AFTER_DRAIN = false;
    bf16* act; const float* bgu;
    DI void operator()(const pg8::f32x4 (&acc)[2][2][4][2], const pg8::Unit& u, int wr, int wc, int fr, int fq) const {
        const int e = u.pn >> 3, pl = u.pn & 7;
        const int row0 = u.pm * 256 + wr * 64 + fr, cih = pl * 128 + wc * 32 + 8 * fq;
        const float* bg = bgu + e * 2048 + cih;
        const f32x4 bg0 = *(const f32x4*)(bg), bg1 = *(const f32x4*)(bg + 4), bu0 = *(const f32x4*)(bg + 1024), bu1 = *(const f32x4*)(bg + 1028);
#pragma unroll
        for (int ai = 0; ai < 2; ++ai)
#pragma unroll
            for (int m = 0; m < 4; ++m) {
                const f32x4 g0 = acc[ai][0][m][0] + bg0, g1 = acc[ai][0][m][1] + bg1, u0 = acc[ai][1][m][0] + bu0, u1 = acc[ai][1][m][1] + bu1;
                float r[8];
#pragma unroll
                for (int i = 0; i < 8; ++i) {
                    float g = i < 4 ? g0[i & 3] : g1[i & 3], uu = i < 4 ? u0[i & 3] : u1[i & 3];
                    g = fminf(g, 7.0f); uu = fminf(fmaxf(uu, -7.0f), 7.0f);
                    const float sg = __builtin_amdgcn_rcpf(1.0f + ex2(-1.702f * LOG2E * g));
                    r[i] = (uu + 1.0f) * g * sg;
                }
                v4u w; w.x = cvtpk(r[0], r[1]); w.y = cvtpk(r[2], r[3]); w.z = cvtpk(r[4], r[5]); w.w = cvtpk(r[6], r[7]);
                *(v4u*)(act + (size_t)(row0 + ai * 128 + m * 16) * DM + cih) = w;
            }
    }
};
struct EpiDown {
    static constexpr bool PERM = true, AFTER_DRAIN = false;
    bf16* yr; const float* bdn;
    DI void operator()(const pg8::f32x4 (&acc)[2][2][4][2], const pg8::Unit& u, int wr, int wc, int fr, int fq) const {
        const int e = u.pn >> 2, pl = u.pn & 3;
        const int row0 = u.pm * 256 + wr * 64 + fr, col0 = pl * 256 + wc * 32 + 8 * fq;
        f32x4 bv[2][2];
#pragma unroll
        for (int bj = 0; bj < 2; ++bj) { bv[bj][0] = *(const f32x4*)(bdn + e * 1024 + col0 + bj * 128); bv[bj][1] = *(const f32x4*)(bdn + e * 1024 + col0 + bj * 128 + 4); }
#pragma unroll
        for (int ai = 0; ai < 2; ++ai)
#pragma unroll
            for (int m = 0; m < 4; ++m) {
                bf16* rp = yr + (size_t)(row0 + ai * 128 + m * 16) * DM + col0;
#pragma unroll
                for (int bj = 0; bj < 2; ++bj) {
                    const f32x4 v0 = acc[ai][bj][m][0] + bv[bj][0], v1 = acc[ai][bj][m][1] + bv[bj][1];
                    v4u w; w.x = cvtpk(v0[0], v0[1]); w.y = cvtpk(v0[2], v0[3]); w.z = cvtpk(v1[0], v1[1]); w.w = cvtpk(v1[2], v1[3]);
                    *(v4u*)(rp + bj * 128) = w;
                }
            }
    }
};
struct GroupOrder {
    const unsigned* tile_e; int ntiles, lg, G, c;
    DI bool next(int i, pg8::Unit& u) const {
        const long L = (long)i * G + c; if (L >= ((long)ntiles << lg)) return false;
        const int pm = (int)(L >> lg), pl = (int)(L & ((1 << lg) - 1));
        const int e = __builtin_amdgcn_readfirstlane((int)ld_u32(tile_e + pm));
        u.pm = pm; u.pn = (e << lg) + pl; return true;
    }
    DI void a_ready(const pg8::Unit&) const {}
    DI void done(const pg8::Unit&) const {}
};
struct Args { const float* in[18]; float* out; unsigned char* ws; int ph_lo, ph_hi; };
struct Fr { LAS unsigned char* lds; unsigned char* ws; unsigned* ctl; int tid, lane, wave, blk, G; };

DI void tr_item(const float* W, int ldw, int K, int k0, int sc0, int nvalid, bf16* WT, int drow0, LAS float* scr, int lane) {
    const int c = lane & 31;
#pragma unroll 8
    for (int i = 0; i < 32; ++i) { const int kk = 2 * i + (lane >> 5); scr[kk * 33 + c] = (c < nvalid) ? W[(size_t)(k0 + kk) * ldw + sc0 + c] : 0.f; }
    LDS_WAIT(); asm volatile("" ::: "memory");
    const int c8 = lane & 7;
#pragma unroll
    for (int j = 0; j < 4; ++j) { const int n = (lane >> 3) + 8 * j; const LAS float* s = scr + (8 * c8) * 33 + n;
        v4u o; o.x = cvtpk(s[0 * 33], s[1 * 33]); o.y = cvtpk(s[2 * 33], s[3 * 33]); o.z = cvtpk(s[4 * 33], s[5 * 33]); o.w = cvtpk(s[6 * 33], s[7 * 33]);
        *(v4u*)(WT + (size_t)(drow0 + n) * K + k0 + 8 * c8) = o; }
    LDS_WAIT(); asm volatile("" ::: "memory");
}
DI void ph_prologue(const Args& a, const Fr& F) {
    LAS float* scr = (LAS float*)(F.lds + F.wave * 16384);
    const int gw = F.blk * NWAVES + F.wave, NGW = F.G * NWAVES;
    constexpr int I_EV = 2 * 16 * 80, I_OD = 2 * 16 * 96, I_WO = 4 * 16 * 32, I_GU = 128 * 16 * 64, I_DN = 128 * 16 * 32;
    constexpr int NITEMS = I_EV + I_OD + I_WO + I_GU + I_DN;
    bf16* wev = (bf16*)(F.ws + WS_WEV); bf16* wod = (bf16*)(F.ws + WS_WOD); bf16* wout = (bf16*)(F.ws + WS_WOUT);
    bf16* wgu = (bf16*)(F.ws + WS_WGU); bf16* wdn = (bf16*)(F.ws + WS_WDN);
    for (int it = gw; it < NITEMS; it += NGW) {
        int r = it;
        if (r < I_EV) { const int l = r / 1280; r %= 1280; const int kb = r / 80, n0 = (r % 80) * 32; int sc0, nv = 32;
            if (n0 < 512) sc0 = n0; else if (n0 < 1024) sc0 = 964 + (n0 - 512); else if (n0 < 1536) sc0 = 1476 + (n0 - 1024); else if (n0 < 2048) sc0 = 1988 + (n0 - 1536);
            else if (n0 < 2176) sc0 = 512 + (n0 - 2048); else if (n0 < 2432) sc0 = 640 + (n0 - 2176); else if (n0 < 2496) sc0 = 896 + (n0 - 2432);
            else if (n0 < 2528) { sc0 = 960; nv = 4; } else { sc0 = 0; nv = 0; }
            tr_item(a.in[1] + (size_t)l * 1024 * 2500, 2500, 1024, kb * 64, sc0, nv, wev + (size_t)l * EV_N * 1024, n0, scr, F.lane); continue; }
        r -= I_EV;
        if (r < I_OD) { const int l = r / 1536; r %= 1536; const int kb = r / 96, n0 = (r % 96) * 32;
            tr_item(a.in[6] + (size_t)l * 1024 * 3088, 3088, 1024, kb * 64, n0, 32, wod + (size_t)l * OD_N * 1024, n0, scr, F.lane); continue; }
        r -= I_OD;
        if (r < I_WO) { const int l = r / 512; r %= 512; const int kb = r / 32, n0 = (r % 32) * 32;
            const float* src = (l & 1) ? a.in[8] + (size_t)(l >> 1) * 1024 * 1024 : a.in[5] + (size_t)(l >> 1) * 1024 * 1024;
            tr_item(src, 1024, 1024, kb * 64, n0, 32, wout + (size_t)l * 1024 * 1024, n0, scr, F.lane); continue; }
        r -= I_WO;
        if (r < I_GU) { const int le = r / 1024; r %= 1024; const int kb = r / 64, n0 = (r % 64) * 32;
            const int pn = n0 >> 8, bj = (n0 >> 7) & 1, j0 = n0 & 127;
            tr_item(a.in[14] + (size_t)le * 1024 * 2048, 2048, 1024, kb * 64, bj * 1024 + pn * 128 + j0, 32, wgu + (size_t)le * 2048 * 1024, n0, scr, F.lane); continue; }
        r -= I_GU;
        { const int le = r / 512; r %= 512; const int kb = r / 32, n0 = (r % 32) * 32;
            tr_item(a.in[16] + (size_t)le * 1024 * 1024, 1024, 1024, kb * 64, n0, 32, wdn + (size_t)le * 1024 * 1024, n0, scr, F.lane); }
    }
    bf16* xb = (bf16*)(F.ws + WS_XB);
    for (int m = gw; m < NTOK; m += NGW) {
        const f32x4* xr = (const f32x4*)(a.in[0] + (size_t)m * DM) + F.lane; v2u* o = (v2u*)(xb + (size_t)m * DM) + F.lane;
#pragma unroll
        for (int j = 0; j < 4; ++j) { const f32x4 v = xr[64 * j]; v2u w; w.x = cvtpk(v[0], v[1]); w.y = cvtpk(v[2], v[3]); o[64 * j] = w; }
    }
    bf16* wukt = (bf16*)(F.ws + WS_WUKT); bf16* wuvt = (bf16*)(F.ws + WS_WUVT);
    for (int i = F.blk * NTHR + F.tid; i < 2 * 8 * 128 * 64; i += F.G * NTHR) {
        { const int d = i & 63, c = (i >> 6) & 127, lh = i >> 13; wukt[i] = (bf16)f2bf(a.in[2][((size_t)lh * 64 + d) * 128 + c]); }
        { const int c = i & 127, d = (i >> 7) & 63, lh = i >> 13; wuvt[i] = (bf16)f2bf(a.in[3][((size_t)lh * 128 + c) * 64 + d]); }
    }
}

DI void ln_row(f32x4 (&v)[4], const float* g, const float* b, int lane) {
    float s = 0.f;
#pragma unroll
    for (int j = 0; j < 4; ++j) s += (v[j][0] + v[j][1]) + (v[j][2] + v[j][3]);
    const float mean = wave_sum(s) * (1.f / DM); float s2 = 0.f;
#pragma unroll
    for (int j = 0; j < 4; ++j) { v[j] = v[j] - mean; s2 += (v[j][0] * v[j][0] + v[j][1] * v[j][1]) + (v[j][2] * v[j][2] + v[j][3] * v[j][3]); }
    const float rstd = 1.f / sqrtf(wave_sum(s2) * (1.f / DM) + LN_EPS);
#pragma unroll
    for (int j = 0; j < 4; ++j) { const f32x4 gg = *((const f32x4*)g + lane + 64 * j), bb = *((const f32x4*)b + lane + 64 * j); v[j] = v[j] * rstd * gg + bb; }
}
DI void store_row_f32(float* p, const f32x4 (&v)[4], int lane) {
#pragma unroll
    for (int j = 0; j < 4; ++j) *((f32x4*)p + lane + 64 * j) = v[j];
}
DI void store_row_bf16(bf16* p, const f32x4 (&v)[4], int lane) {
#pragma unroll
    for (int j = 0; j < 4; ++j) { v2u w; w.x = cvtpk(v[j][0], v[j][1]); w.y = cvtpk(v[j][2], v[j][3]); *((v2u*)p + lane + 64 * j) = w; }
}
template <int NL> DI void small_proj(LAS const float* xs, const float* W, int ldw, int lane, float (&acc)[4]) {
    constexpr int PARTS = 64 / NL, DPER = 1024 / PARTS;
    const int n = lane & (NL - 1), part = lane / NL;
    acc[0] = acc[1] = acc[2] = acc[3] = 0.f;
    const float* wp = W + (size_t)(part * DPER) * ldw + n;
    LAS const float* xp = xs + part * DPER;
#pragma unroll 8
    for (int d = 0; d < DPER; ++d) { const float w = wp[(size_t)d * ldw];
        acc[0] += w * xp[d]; acc[1] += w * xp[1024 + d]; acc[2] += w * xp[2048 + d]; acc[3] += w * xp[3072 + d]; }
#pragma unroll
    for (int o = NL; o < 64; o <<= 1) {
#pragma unroll
        for (int k = 0; k < 4; ++k) acc[k] += __shfl_xor(acc[k], o); }
}

DI void ph_even_prep(const Args& a, const Fr& F, int j) {
    const bf16* proj = (const bf16*)(F.ws + WS_PROJ);
    bf16* ckvn = (bf16*)(F.ws + WS_CKVN); bf16* ql = (bf16*)(F.ws + WS_QL); float* kbar = (float*)(F.ws + WS_KBAR);
    const float* kvg = a.in[4] + j * 128;
    const bf16* wukt = (const bf16*)(F.ws + WS_WUKT) + (size_t)j * 8 * 128 * 64;
    const int lane = F.lane, wave = F.wave;
    for (int chunk = F.blk; chunk < 256; chunk += F.G) {
        const int tok0 = chunk * 128;
        for (int i = 0; i < 16; ++i) { const int tok = tok0 + wave * 16 + i;
            const unsigned w = *((const unsigned*)(proj + (size_t)tok * EV_N + EC_CKV) + lane);
            const float v0 = bf2f(w & 0xffffu), v1 = bf2f(w >> 16);
            const float ss = wave_sum(v0 * v0 + v1 * v1);
            const float r = 1.f / sqrtf(ss * (1.f / 128.f) + LN_EPS);
            *((unsigned*)(ckvn + (size_t)tok * 128) + lane) = cvtpk(v0 * r * kvg[2 * lane], v1 * r * kvg[2 * lane + 1]); }
        { const int h = wave, l15 = lane & 15, kg = lane >> 4;
            bf16x8 af[8][2];
#pragma unroll
            for (int ct = 0; ct < 8; ++ct)
#pragma unroll
                for (int ks = 0; ks < 2; ++ks) af[ct][ks] = *(const bf16x8*)(wukt + ((size_t)h * 128 + ct * 16 + l15) * 64 + ks * 32 + kg * 8);
            for (int tg = 0; tg < 8; ++tg) { const int tok = tok0 + tg * 16 + l15;
                bf16x8 qf[2];
#pragma unroll
                for (int ks = 0; ks < 2; ++ks) qf[ks] = *(const bf16x8*)(proj + (size_t)tok * EV_N + EC_QA + h * 64 + ks * 32 + kg * 8);
#pragma unroll
                for (int ct = 0; ct < 8; ++ct) { f32x4 d = {0.f, 0.f, 0.f, 0.f};
                    d = mfma16(af[ct][0], qf[0], d); d = mfma16(af[ct][1], qf[1], d);
                    v2u w; w.x = cvtpk(d[0], d[1]); w.y = cvtpk(d[2], d[3]);
                    *(v2u*)(ql + (size_t)tok * 1024 + h * 128 + ct * 16 + 4 * kg) = w; } } }
        if (chunk < 128) { const int b = chunk >> 5, n = chunk & 31; float s8[8];
#pragma unroll
            for (int k = 0; k < 8; ++k) s8[k] = 0.f;
            const bf16* kp = proj + ((size_t)b * SEQ + n * 256 + wave * 32) * EV_N + EC_KB + lane * 8;
#pragma unroll 8
            for (int r = 0; r < 32; ++r) { const v4u w = *(const v4u*)(kp + (size_t)r * EV_N);
#pragma unroll
                for (int k = 0; k < 4; ++k) { s8[2 * k] += bf2f(w[k] & 0xffffu); s8[2 * k + 1] += bf2f(w[k] >> 16); } }
            LAS float* red = (LAS float*)F.lds;
            __syncthreads();
#pragma unroll
            for (int k = 0; k < 8; ++k) red[wave * 512 + lane * 8 + k] = s8[k];
            __syncthreads();
            float s = 0.f;
#pragma unroll
            for (int w = 0; w < 8; ++w) s += red[w * 512 + F.tid];
            const int h = F.tid >> 6, d = F.tid & 63;
            kbar[(((size_t)b * 8 + h) * 32 + n) * 64 + d] = s * (1.f / 256.f); }
    }
}

DI void moba_gate_chunk(const Fr& F, int chunk) {
    const bf16* proj = (const bf16*)(F.ws + WS_PROJ); const float* kbar = (const float*)(F.ws + WS_KBAR); unsigned* sel3 = (unsigned*)(F.ws + WS_SEL3);
    const int tok0 = chunk * 128, b = tok0 / SEQ, own = (tok0 % SEQ) >> 8, h = F.wave, lane = F.lane;
    float q0[64], q1[64];
    { const v4u* p0 = (const v4u*)(proj + (size_t)(tok0 + lane) * EV_N + EC_QB + h * 64); const v4u* p1 = (const v4u*)(proj + (size_t)(tok0 + 64 + lane) * EV_N + EC_QB + h * 64);
#pragma unroll
        for (int i = 0; i < 8; ++i) { const v4u w0 = p0[i], w1 = p1[i];
#pragma unroll
            for (int k = 0; k < 4; ++k) { q0[8 * i + 2 * k] = bf2f(w0[k] & 0xffffu); q0[8 * i + 2 * k + 1] = bf2f(w0[k] >> 16); q1[8 * i + 2 * k] = bf2f(w1[k] & 0xffffu); q1[8 * i + 2 * k + 1] = bf2f(w1[k] >> 16); } } }
    float a0 = -INFINITY, a1 = -INFINITY, a2 = -INFINITY, c0 = -INFINITY, c1 = -INFINITY, c2 = -INFINITY; int ai0 = 0, ai1 = 0, ai2 = 0, ci0 = 0, ci1 = 0, ci2 = 0;
    const float* kb = kbar + (((size_t)b * 8 + h) * 32) * 64;
    for (int n = 0; n < own; ++n) { float g0 = 0.f, g1 = 0.f;
#pragma unroll
        for (int d = 0; d < 64; d += 4) { const f32x4 kv = *(const f32x4*)(kb + n * 64 + d);
#pragma unroll
            for (int k = 0; k < 4; ++k) { g0 += q0[d + k] * kv[k]; g1 += q1[d + k] * kv[k]; } }
        if (g0 > a2) { if (g0 > a1) { a2 = a1; ai2 = ai1; if (g0 > a0) { a1 = a0; ai1 = ai0; a0 = g0; ai0 = n; } else { a1 = g0; ai1 = n; } } else { a2 = g0; ai2 = n; } }
        if (g1 > c2) { if (g1 > c1) { c2 = c1; ci2 = ci1; if (g1 > c0) { c1 = c0; ci1 = ci0; c0 = g1; ci0 = n; } else { c1 = g1; ci1 = n; } } else { c2 = g1; ci2 = n; } }
    }
    const unsigned nv = own < 3 ? own : 3;
    sel3[(size_t)(tok0 + lane) * 8 + h] = (unsigned)ai0 | ((unsigned)ai1 << 8) | ((unsigned)ai2 << 16) | (nv << 24);
    sel3[(size_t)(tok0 + 64 + lane) * 8 + h] = (unsigned)ci0 | ((unsigned)ci1 << 8) | ((unsigned)ci2 << 16) | (nv << 24);
}

constexpr int HS = 257;
template <int MODE> DI void idx_pass(const bf16* proj, int rowbase, int qt, const bf16x8 (&qf)[4][4], const float (&wj)[4], LAS unsigned* hist, LAS unsigned* mask, LAS unsigned* cmask, LAS unsigned long long* cand, LAS unsigned* rinfo, int wave, int lane) {
    const int q = lane & 31, hi = lane >> 5, nkt = qt + 1, t = qt * 32 + q;
    const unsigned b1 = rinfo[q], thr16 = rinfo[64 + q];
    for (int ch = 0; ch * 8 < nkt; ++ch) { const int kt = ch * 8 + wave; if (kt >= nkt) continue;
        const bf16* kp = proj + (size_t)(rowbase + kt * 32 + q) * EV_N + EC_KI + hi * 8;
        bf16x8 kf[4];
#pragma unroll
        for (int s = 0; s < 4; ++s) kf[s] = *(const bf16x8*)(kp + s * 16);
        f32x16 sc;
#pragma unroll
        for (int r = 0; r < 16; ++r) sc[r] = 0.f;
#pragma unroll
        for (int j = 0; j < 4; ++j) { f32x16 acc;
#pragma unroll
            for (int r = 0; r < 16; ++r) acc[r] = 0.f;
#pragma unroll
            for (int s = 0; s < 4; ++s) acc = mfma32(kf[s], qf[j][s], acc);
#pragma unroll
            for (int r = 0; r < 16; ++r) sc[r] += wj[j] * fmaxf(acc[r], 0.f); }
#pragma unroll
        for (int r = 0; r < 16; ++r) { const int s = kt * 32 + crow(r, hi);
            if (s <= t) { unsigned u = __float_as_uint(sc[r]); if (u == 0x80000000u) u = 0u; const unsigned key = (u >> 31) ? ~u : (u | 0x80000000u);
                if (MODE == 1) __hip_atomic_fetch_add(hist + q * HS + (key >> 24), 1u, __ATOMIC_RELAXED, __HIP_MEMORY_SCOPE_WORKGROUP);
                else if (MODE == 2) { if ((key >> 24) == b1) __hip_atomic_fetch_add(hist + q * HS + ((key >> 16) & 255u), 1u, __ATOMIC_RELAXED, __HIP_MEMORY_SCOPE_WORKGROUP); }
                else { const unsigned k16 = key >> 16;
                    if (k16 > thr16) __hip_atomic_fetch_or(mask + q * HS + (s >> 5), 1u << (s & 31), __ATOMIC_RELAXED, __HIP_MEMORY_SCOPE_WORKGROUP);
                    else if (k16 == thr16) { const unsigned pos = __hip_atomic_fetch_add(rinfo + 128 + q, 1u, __ATOMIC_RELAXED, __HIP_MEMORY_SCOPE_WORKGROUP);
                        __hip_atomic_fetch_or(cmask + q * HS + (s >> 5), 1u << (s & 31), __ATOMIC_RELAXED, __HIP_MEMORY_SCOPE_WORKGROUP);
                        if (pos < 64u) cand[q * 64 + pos] = ((unsigned long long)key << 32) | (unsigned)(~(unsigned)s); } } } }
    }
}
DI void hist_pick(LAS const unsigned* hrow, unsigned need, int lane, unsigned& bin, unsigned& above) {
    unsigned h4[4];
#pragma unroll
    for (int k = 0; k < 4; ++k) h4[k] = hrow[4 * lane + k];
    const unsigned ssum = h4[0] + h4[1] + h4[2] + h4[3];
    unsigned x = ssum;
#pragma unroll
    for (int o = 1; o < 64; o <<= 1) { const unsigned y = __shfl_down(x, o); if (lane + o < 64) x += y; }
    const unsigned long long m = __ballot(x >= need);
    const int Ls = m ? 63 - __builtin_clzll(m) : 0;
    const unsigned xs = __shfl(x, Ls), ss = __shfl(ssum, Ls);
    const unsigned h0 = __shfl(h4[0], Ls), h1 = __shfl(h4[1], Ls), h2 = __shfl(h4[2], Ls), h3 = __shfl(h4[3], Ls);
    unsigned cum = xs - ss;
    if (cum + h3 >= need) { bin = 4 * Ls + 3; above = cum; return; } cum += h3;
    if (cum + h2 >= need) { bin = 4 * Ls + 2; above = cum; return; } cum += h2;
    if (cum + h1 >= need) { bin = 4 * Ls + 1; above = cum; return; } cum += h1;
    bin = 4 * Ls; above = cum; (void)h0;
}
DI void idx_unit(const Fr& F, int b, int qt) {
    const bf16* proj = (const bf16*)(F.ws + WS_PROJ); unsigned short* sel = (unsigned short*)(F.ws + WS_SEL);
    LAS unsigned* hist = (LAS unsigned*)(F.lds); LAS unsigned* mask = hist + 32 * HS; LAS unsigned* cmask = mask + 32 * HS;
    LAS unsigned long long* cand = (LAS unsigned long long*)(F.lds + 99328); LAS unsigned* rinfo = (LAS unsigned*)(F.lds + 115712);
    const int lane = F.lane, wave = F.wave, tid = F.tid, t0 = qt * 32, rowbase = b * SEQ;
    __syncthreads();
    for (int i = tid; i < 3 * 32 * HS; i += NTHR) hist[i] = 0u;
    if (tid < 160) rinfo[tid] = 0u;
    __syncthreads();
    if (t0 + 31 <= 255 || (EXPF & 64)) {
        if (lane < 8) {
#pragma unroll
            for (int rr = 0; rr < 4; ++rr) { const int row = wave * 4 + rr, nv = t0 + row + 1;
                const int nv0 = t0 + row + 1; const int nvc = nv0 < 256 ? nv0 : 256; (void)nv; mask[row * HS + lane] = nvc >= 32 * (lane + 1) ? 0xffffffffu : (nvc > 32 * lane ? ((1u << (nvc - 32 * lane)) - 1u) : 0u); } }
    } else {
        const int q = lane & 31, hi = lane >> 5;
        bf16x8 qf[4][4]; float wj[4];
        { const bf16* qp = proj + (size_t)(rowbase + t0 + q) * EV_N;
#pragma unroll
            for (int j = 0; j < 4; ++j) { wj[j] = bf2f(qp[EC_WI + j]);
#pragma unroll
                for (int s = 0; s < 4; ++s) qf[j][s] = *(const bf16x8*)(qp + EC_QI + j * 64 + s * 16 + hi * 8); } }
        idx_pass<1>(proj, rowbase, qt, qf, wj, hist, mask, cmask, cand, rinfo, wave, lane);
        __syncthreads();
#pragma unroll 1
        for (int rr = 0; rr < 4; ++rr) { const int row = wave * 4 + rr; unsigned bin, above; hist_pick(hist + row * HS, 256u, lane, bin, above);
            if (lane == 0) { rinfo[row] = bin; rinfo[32 + row] = 256u - above; } }
        __syncthreads();
        for (int i = tid; i < 32 * HS; i += NTHR) hist[i] = 0u;
        __syncthreads();
        idx_pass<2>(proj, rowbase, qt, qf, wj, hist, mask, cmask, cand, rinfo, wave, lane);
        __syncthreads();
#pragma unroll 1
        for (int rr = 0; rr < 4; ++rr) { const int row = wave * 4 + rr; const unsigned need1 = rinfo[32 + row]; unsigned bin, above; hist_pick(hist + row * HS, need1, lane, bin, above);
            if (lane == 0) { rinfo[64 + row] = (rinfo[row] << 8) | bin; rinfo[96 + row] = need1 - above; } }
        __syncthreads();
        idx_pass<3>(proj, rowbase, qt, qf, wj, hist, mask, cmask, cand, rinfo, wave, lane);
        __syncthreads();
#pragma unroll 1
        for (int rr = 0; rr < 4; ++rr) { const int row = wave * 4 + rr; const unsigned call = rinfo[128 + row], need2 = rinfo[96 + row];
            if (call <= 64u) { const unsigned c = call;
                const unsigned long long mine = cand[row * 64 + lane]; unsigned rank = 0u;
                for (unsigned k = 0; k < c; ++k) rank += (cand[row * 64 + k] > mine) ? 1u : 0u;
                if ((unsigned)lane < c && rank < need2) { const unsigned s = ~(unsigned)mine;
                    __hip_atomic_fetch_or(mask + row * HS + (s >> 5), 1u << (s & 31), __ATOMIC_RELAXED, __HIP_MEMORY_SCOPE_WORKGROUP); } }
            else { unsigned w4[4];
#pragma unroll
                for (int k = 0; k < 4; ++k) w4[k] = cmask[row * HS + 4 * lane + k];
                const unsigned cnt = __popc(w4[0]) + __popc(w4[1]) + __popc(w4[2]) + __popc(w4[3]);
                unsigned x = cnt;
#pragma unroll
                for (int o = 1; o < 64; o <<= 1) { const unsigned y = __shfl_up(x, o); if (lane >= o) x += y; }
                unsigned before = x - cnt;
#pragma unroll
                for (int k = 0; k < 4; ++k) { unsigned w = w4[k]; const unsigned pc = __popc(w); unsigned take = 0u;
                    if (before < need2) { if (before + pc <= need2) take = w; else { unsigned left = need2 - before; while (left) { const unsigned b = w & (0u - w); take |= b; w ^= b; --left; } } }
                    before += pc;
                    if (take) mask[row * HS + 4 * lane + k] |= take; } }
        }
    }
    __syncthreads();
#pragma unroll 1
    for (int rr = 0; rr < 4; ++rr) { const int row = wave * 4 + rr; unsigned short* out = sel + (size_t)(rowbase + t0 + row) * 256;
        unsigned w4[4];
#pragma unroll
        for (int k = 0; k < 4; ++k) w4[k] = mask[row * HS + 4 * lane + k];
        const unsigned cnt = __popc(w4[0]) + __popc(w4[1]) + __popc(w4[2]) + __popc(w4[3]);
        unsigned x = cnt;
#pragma unroll
        for (int o = 1; o < 64; o <<= 1) { const unsigned y = __shfl_up(x, o); if (lane >= o) x += y; }
        const unsigned total = __shfl(x, 63); unsigned pos = x - cnt;
#pragma unroll
        for (int k = 0; k < 4; ++k) { unsigned w = w4[k]; const unsigned base = (unsigned)(4 * lane + k) * 32u;
            while (w) { const unsigned bit = __builtin_ctz(w); if (pos < 256u) out[pos] = (unsigned short)(base + bit); ++pos; w &= w - 1u; } }
        for (unsigned i = total + lane; i < 256u; i += 64u) out[i] = (unsigned short)0xffffu; }
}

struct AttSt { float m, l; f32x16 o0, o1; };
template <class BF> DI void att_subtile(AttSt& S, const bf16x8 (&qf)[4], LAS const char* Kst, LAS const char* Vb, int vdh, int vrow0, int lane, const BF& bias) {
    const int r32 = lane & 31, hi = lane >> 5;
    f32x16 p;
#pragma unroll
    for (int r = 0; r < 16; ++r) p[r] = 0.f;
    LAS const char* kp = Kst + hi * 512 + r32 * 16;
#pragma unroll
    for (int s = 0; s < 4; ++s) { const bf16x8 kf = *(LAS const bf16x8*)(kp + s * 1024); p = mfma32(kf, qf[s], p); }
    float mx = -INFINITY;
#pragma unroll
    for (int r = 0; r < 16; ++r) { p[r] = bias(p[r], crow(r, hi)); mx = fmaxf(mx, p[r]); }
    mx = fmaxf(mx, __shfl_xor(mx, 32));
    const float mn = fmaxf(S.m, mx), sc = ex2(S.m - mn);
    S.m = mn;
    float ps = 0.f;
#pragma unroll
    for (int r = 0; r < 16; ++r) { p[r] = ex2(p[r] - mn); ps += p[r]; }
    S.l = S.l * sc + ps;
#pragma unroll
    for (int r = 0; r < 16; ++r) { S.o0[r] *= sc; S.o1[r] *= sc; }
    v4u pw0, pw1;
    pw0.x = cvtpk(p[0], p[1]); pw0.y = cvtpk(p[2], p[3]); pw0.z = cvtpk(p[4], p[5]); pw0.w = cvtpk(p[6], p[7]);
    pw1.x = cvtpk(p[8], p[9]); pw1.y = cvtpk(p[10], p[11]); pw1.z = cvtpk(p[12], p[13]); pw1.w = cvtpk(p[14], p[15]);
    const bf16x8 pf0 = __builtin_bit_cast(bf16x8, pw0), pf1 = __builtin_bit_cast(bf16x8, pw1);
    LAS const char* vp = Vb + (vrow0 + 4 * hi + ((lane & 15) >> 2)) * 64 + ((lane >> 4) & 1) * 32 + (lane & 3) * 8;
    { const bf16x8 v00 = cat8(vtr(vp), vtr(vp + 512)), v10 = cat8(vtr(vp + vdh), vtr(vp + vdh + 512));
      const bf16x8 v01 = cat8(vtr(vp + 1024), vtr(vp + 1536)), v11 = cat8(vtr(vp + vdh + 1024), vtr(vp + vdh + 1536));
      S.o0 = mfma32(v00, pf0, S.o0); S.o1 = mfma32(v10, pf0, S.o1);
      S.o0 = mfma32(v01, pf1, S.o0); S.o1 = mfma32(v11, pf1, S.o1); }
}

struct MobaBias { LAS const float* lut; int tq, s0; bool causal;
    DI float operator()(float p, int kvrel) const { const int dist = tq - (s0 + kvrel); const float v = p + lut[dist < 0 ? 0 : (dist > 1023 ? 1023 : dist)]; return (causal && dist < 0) ? -INFINITY : v; } };
DI void moba_tile(const Fr& F, const bf16* proj, int rowbase, int h, int n, int tq, bool valid, int slot, bool own, int wave_tile) {
    LAS const char* Kb = (LAS const char*)F.lds; LAS const char* Vb = (LAS const char*)(F.lds + 32768); LAS const float* lut = (LAS const float*)(F.lds + 98304);
    bf16* po = (bf16*)(F.ws + WS_ACT); float* pml = (float*)(F.ws + WS_PML);
    const int lane = F.lane, hi = lane >> 5;
    bf16x8 qf[4];
    { const bf16* qp = proj + (size_t)(rowbase + tq) * EV_N + EC_QB + h * 64 + hi * 8;
#pragma unroll
        for (int s = 0; s < 4; ++s) qf[s] = *(const bf16x8*)(qp + s * 16); }
    AttSt S; S.m = -1e30f; S.l = 0.f;
#pragma unroll
    for (int r = 0; r < 16; ++r) { S.o0[r] = 0.f; S.o1[r] = 0.f; }
    const int nst = own ? wave_tile + 1 : 8;
    for (int st = 0; st < nst; ++st) { MobaBias bf{lut, tq, n * 256 + st * 32, own && st == wave_tile};
        att_subtile(S, qf, Kb + st * 4096, Vb, 16384, st * 32, lane, bf); }
    const float lt = S.l + __shfl_xor(S.l, 32), inv = 1.f / lt;
    if (valid) { const size_t pi = ((size_t)(rowbase + tq) * 8 + h) * 4 + slot; bf16* o = po + pi * 64;
#pragma unroll
        for (int a4 = 0; a4 < 4; ++a4) { v2u w0, w1;
            w0.x = cvtpk(S.o0[4 * a4] * inv, S.o0[4 * a4 + 1] * inv); w0.y = cvtpk(S.o0[4 * a4 + 2] * inv, S.o0[4 * a4 + 3] * inv);
            w1.x = cvtpk(S.o1[4 * a4] * inv, S.o1[4 * a4 + 1] * inv); w1.y = cvtpk(S.o1[4 * a4 + 2] * inv, S.o1[4 * a4 + 3] * inv);
            *(v2u*)(o + 8 * a4 + 4 * hi) = w0; *(v2u*)(o + 32 + 8 * a4 + 4 * hi) = w1; }
        if (hi == 0) { f32x2 ml = {S.m, lt}; *(f32x2*)(pml + pi * 2) = ml; } }
}
DI void moba_unit(const Args& a, const Fr& F, int b, int h, int n) {
    const bf16* proj = (const bf16*)(F.ws + WS_PROJ); const unsigned* sel3 = (const unsigned*)(F.ws + WS_SEL3);
    LAS unsigned char* lds = F.lds; LAS unsigned* list = (LAS unsigned*)(lds + 65536); LAS float* lut = (LAS float*)(lds + 98304); LAS unsigned* misc = (LAS unsigned*)(lds + 102400);
    const int tid = F.tid, lane = F.lane, wave = F.wave, rowbase = b * SEQ;
    __syncthreads();
    { const bf16* kg = proj + (size_t)(rowbase + n * 256) * EV_N + EC_KB + h * 64; const bf16* vg = proj + (size_t)(rowbase + n * 256) * EV_N + EC_VB + h * 64;
#pragma unroll
        for (int i = 0; i < 4; ++i) { const int p = tid + i * NTHR;
            { const int r = p & 31, c = (p >> 5) & 7, st = p >> 8; const v4u v = *(const v4u*)(kg + (size_t)(st * 32 + r) * EV_N + c * 8); *(LAS v4u*)(lds + st * 4096 + c * 512 + r * 16) = v; }
            { const int cc = p & 3, row = (p >> 2) & 255, dh = p >> 10; const v4u v = *(const v4u*)(vg + (size_t)row * EV_N + dh * 32 + cc * 8); *(LAS v4u*)(lds + 32768 + dh * 16384 + row * 64 + cc * 16) = v; } }
        for (int d = tid; d < 1024; d += NTHR) lut[d] = a.in[9][t5_bucket(d) * 16 + 8 + h] * LOG2E; }
    if (tid == 0) misc[16] = 0u;
    __syncthreads();
    for (int tb = (n + 1) * 256; tb < SEQ; tb += NTHR) { const int t = tb + tid; const bool inr = t < SEQ;
        const unsigned s = inr ? sel3[(size_t)(rowbase + t) * 8 + h] : 0u; const unsigned nv = s >> 24; int slot = -1;
        if (nv > 0u && (s & 255u) == (unsigned)n) slot = 0; else if (nv > 1u && ((s >> 8) & 255u) == (unsigned)n) slot = 1; else if (nv > 2u && ((s >> 16) & 255u) == (unsigned)n) slot = 2;
        const unsigned long long bal = __ballot(slot >= 0); const unsigned wcnt = __popcll(bal);
        if (lane == 0) misc[wave] = wcnt;
        __syncthreads();
        unsigned off = misc[16], tot = 0u;
#pragma unroll
        for (int w = 0; w < 8; ++w) { const unsigned c = misc[w]; if (w < wave) off += c; tot += c; }
        if (slot >= 0) list[off + __popcll(bal & ((1ull << lane) - 1ull))] = ((unsigned)t << 2) | (unsigned)slot;
        __syncthreads();
        if (tid == 0) misc[16] += tot; }
    __syncthreads();
    const int nlist = (int)misc[16];
    moba_tile(F, proj, rowbase, h, n, n * 256 + wave * 32 + (lane & 31), true, 3, true, wave);
    const int ntl = (nlist + 31) >> 5;
    for (int tl = wave; tl < ntl; tl += 8) { const int li = tl * 32 + (lane & 31); const bool valid = li < nlist; const unsigned e = list[valid ? li : nlist - 1];
        moba_tile(F, proj, rowbase, h, n, (int)(e >> 2), valid, (int)(e & 3u), false, 0); }
}

DI void dsa_query(const Fr& F, int tok, LAS unsigned char* wl, LAS const unsigned char* bkt, LAS const float* tab) {
    const bf16* ql = (const bf16*)(F.ws + WS_QL); const bf16* ckvn = (const bf16*)(F.ws + WS_CKVN); const unsigned short* sel = (const unsigned short*)(F.ws + WS_SEL); bf16* ol = (bf16*)(F.ws + WS_OL);
    const int lane = F.lane, l15 = lane & 15, kg = lane >> 4, t = tok % SEQ, rowbase = tok - t;
    LAS unsigned short* selb = (LAS unsigned short*)wl; LAS unsigned char* cbuf = wl + 1024;
    *((LAS v2u*)selb + lane) = *((const v2u*)(sel + (size_t)tok * 256) + lane);
    bf16x8 qlf[4];
#pragma unroll
    for (int ks = 0; ks < 4; ++ks) { qlf[ks] = *(const bf16x8*)(ql + (size_t)tok * 1024 + (l15 & 7) * 128 + ks * 32 + kg * 8); if (l15 >= 8) qlf[ks] = (bf16x8){0, 0, 0, 0, 0, 0, 0, 0}; }
    float m = -1e30f, l = 0.f; f32x4 oT[8];
#pragma unroll
    for (int ct = 0; ct < 8; ++ct) oT[ct] = (f32x4){0.f, 0.f, 0.f, 0.f};
    const int nvalid = t + 1 < 256 ? t + 1 : 256, nch = (nvalid + 31) >> 5;
    LDS_WAIT();
    for (int ch = 0; ch < nch; ++ch) {
        bf16x8 af[2][4];
#pragma unroll
        for (int mt = 0; mt < 2; ++mt) { unsigned idx = selb[ch * 32 + mt * 16 + l15]; if (idx == 0xffffu) idx = 0u;
            const bf16* cp = ckvn + (size_t)(rowbase + (int)idx) * 128 + kg * 8;
#pragma unroll
            for (int ks = 0; ks < 4; ++ks) af[mt][ks] = *(const bf16x8*)(cp + ks * 32); }
        f32x4 acc[2];
#pragma unroll
        for (int mt = 0; mt < 2; ++mt) { acc[mt] = (f32x4){0.f, 0.f, 0.f, 0.f};
#pragma unroll
            for (int ks = 0; ks < 4; ++ks) { acc[mt] = mfma16(af[mt][ks], qlf[ks], acc[mt]); *(LAS bf16x8*)(cbuf + (mt * 16 + l15) * 288 + (ks * 32 + kg * 8) * 2) = af[mt][ks]; } }
        float mx = -INFINITY;
#pragma unroll
        for (int mt = 0; mt < 2; ++mt)
#pragma unroll
            for (int i = 0; i < 4; ++i) { const unsigned s = selb[ch * 32 + mt * 16 + 4 * kg + i]; const int dist = t - (int)s;
                const bool ok = (s != 0xffffu) && dist >= 0; const int dc = ok ? (dist > 1023 ? 1023 : dist) : 0;
                const float v = ok ? acc[mt][i] + tab[(int)bkt[dc] * 8 + (l15 & 7)] : -INFINITY; acc[mt][i] = v; mx = fmaxf(mx, v); }
        mx = fmaxf(mx, __shfl_xor(mx, 16)); mx = fmaxf(mx, __shfl_xor(mx, 32));
        const float mn = fmaxf(m, mx), sc = ex2(m - mn); m = mn;
        float ps = 0.f;
#pragma unroll
        for (int mt = 0; mt < 2; ++mt)
#pragma unroll
            for (int i = 0; i < 4; ++i) { acc[mt][i] = ex2(acc[mt][i] - mn); ps += acc[mt][i]; }
        l = l * sc + ps;
#pragma unroll
        for (int ct = 0; ct < 8; ++ct) oT[ct] = oT[ct] * sc;
        v4u pw; pw.x = cvtpk(acc[0][0], acc[0][1]); pw.y = cvtpk(acc[0][2], acc[0][3]); pw.z = cvtpk(acc[1][0], acc[1][1]); pw.w = cvtpk(acc[1][2], acc[1][3]);
        const bf16x8 pf = __builtin_bit_cast(bf16x8, pw);
        LDS_WAIT();
        LAS const char* tp = (LAS const char*)cbuf + (4 * kg + (l15 >> 2)) * 288 + (lane & 3) * 8;
#pragma unroll
        for (int ct = 0; ct < 8; ++ct) { const bf16x8 cf = cat8(vtr(tp + ct * 32), vtr(tp + 16 * 288 + ct * 32)); oT[ct] = mfma16(cf, pf, oT[ct]); }
        LDS_WAIT();
    }
    l += __shfl_xor(l, 16); l += __shfl_xor(l, 32);
    const float inv = 1.f / l;
    if (l15 < 8) { bf16* o = ol + (size_t)tok * 1024 + l15 * 128 + 4 * kg;
#pragma unroll
        for (int ct = 0; ct < 8; ++ct) { v2u w; w.x = cvtpk(oT[ct][0] * inv, oT[ct][1] * inv); w.y = cvtpk(oT[ct][2] * inv, oT[ct][3] * inv); *(v2u*)(o + ct * 16) = w; } }
}
DI void dsa_chunk(const Args& a, const Fr& F, int c32) {
    LAS unsigned char* bkt = F.lds + 81920; LAS float* tab = (LAS float*)(F.lds + 82944);
    __syncthreads();
    for (int d = F.tid; d < 1024; d += NTHR) bkt[d] = (unsigned char)t5_bucket(d);
    if (F.tid < 256) tab[F.tid] = a.in[9][(F.tid >> 3) * 16 + (F.tid & 7)] * LOG2E;
    __syncthreads();
#pragma unroll 1
    for (int i = 0; i < 4; ++i) dsa_query(F, c32 * 32 + F.wave * 4 + i, F.lds + F.wave * 10240, bkt, tab);
}

DI void ph_even_post(const Fr& F, int j) {
    const bf16* ol = (const bf16*)(F.ws + WS_OL); bf16* ao = (bf16*)(F.ws + WS_AO);
    const bf16* wuvt = (const bf16*)(F.ws + WS_WUVT) + (size_t)j * 8 * 64 * 128;
    const bf16* po = (const bf16*)(F.ws + WS_ACT); const float* pml = (const float*)(F.ws + WS_PML); const unsigned* sel3 = (const unsigned*)(F.ws + WS_SEL3);
    const int lane = F.lane, wave = F.wave, l15 = lane & 15, kg = lane >> 4;
    for (int chunk = F.blk; chunk < 256; chunk += F.G) { const int tok0 = chunk * 128;
        { const int h = wave; bf16x8 af[4][4];
#pragma unroll
            for (int mt = 0; mt < 4; ++mt)
#pragma unroll
                for (int ks = 0; ks < 4; ++ks) af[mt][ks] = *(const bf16x8*)(wuvt + ((size_t)h * 64 + mt * 16 + l15) * 128 + ks * 32 + kg * 8);
            for (int tg = 0; tg < 8; ++tg) { const int tok = tok0 + tg * 16 + l15; bf16x8 bf[4];
#pragma unroll
                for (int ks = 0; ks < 4; ++ks) bf[ks] = *(const bf16x8*)(ol + (size_t)tok * 1024 + h * 128 + ks * 32 + kg * 8);
#pragma unroll
                for (int mt = 0; mt < 4; ++mt) { f32x4 d = {0.f, 0.f, 0.f, 0.f};
#pragma unroll
                    for (int ks = 0; ks < 4; ++ks) d = mfma16(af[mt][ks], bf[ks], d);
                    v2u w; w.x = cvtpk(d[0], d[1]); w.y = cvtpk(d[2], d[3]); *(v2u*)(ao + (size_t)tok * 1024 + h * 64 + mt * 16 + 4 * kg) = w; } } }
        if (!(EXPF & 32)) for (int i = 0; i < 16; ++i) { const int tok = tok0 + wave * 16 + i, h = lane >> 3, d0 = (lane & 7) * 8;
            const unsigned nv = sel3[(size_t)tok * 8 + h] >> 24; const size_t pi = ((size_t)tok * 8 + h) * 4;
            float mj[4], lj[4];
#pragma unroll
            for (int s = 0; s < 4; ++s) { const bool ok = (s == 3) || ((unsigned)s < nv); const f32x2 ml = *(const f32x2*)(pml + (pi + s) * 2); mj[s] = ok ? ml[0] : -1e30f; lj[s] = ok ? ml[1] : 0.f; }
            const float ms = fmaxf(fmaxf(mj[0], mj[1]), fmaxf(mj[2], mj[3])); float wsum = 0.f, acc[8];
#pragma unroll
            for (int k = 0; k < 8; ++k) acc[k] = 0.f;
#pragma unroll
            for (int s = 0; s < 4; ++s) { const float w = lj[s] * ex2(mj[s] - ms); wsum += w;
                if (w > 0.f) { const v4u v = *(const v4u*)(po + (pi + s) * 64 + d0);
#pragma unroll
                    for (int k = 0; k < 4; ++k) { acc[2 * k] += w * bf2f(v[k] & 0xffffu); acc[2 * k + 1] += w * bf2f(v[k] >> 16); } } }
            const float inv = 1.f / wsum; v4u o; o.x = cvtpk(acc[0] * inv, acc[1] * inv); o.y = cvtpk(acc[2] * inv, acc[3] * inv); o.z = cvtpk(acc[4] * inv, acc[5] * inv); o.w = cvtpk(acc[6] * inv, acc[7] * inv);
            *(v4u*)(ao + (size_t)tok * 1024 + 512 + h * 64 + d0) = o; }
    }
}
DI f32x16 proj32_f32(const float* W, int ldw, int ncols, const float* xrow, int d_lo, int lane) {
    const int e = lane & 31, kh = lane >> 5; const bool ev = e < ncols;
    f32x16 D;
#pragma unroll
    for (int r = 0; r < 16; ++r) D[r] = 0.f;
    const float* wp = W + (size_t)(d_lo + 4 * kh) * ldw + (ev ? e : 0);
    const float* xp = xrow + d_lo + 4 * kh;
#pragma unroll 4
    for (int i = 0; i < 64; ++i) { const f32x4 xv = *(const f32x4*)(xp + 8 * i);
        float a0 = wp[(size_t)(8 * i + 0) * ldw], a1 = wp[(size_t)(8 * i + 1) * ldw], a2 = wp[(size_t)(8 * i + 2) * ldw], a3 = wp[(size_t)(8 * i + 3) * ldw];
        if (!ev) { a0 = 0.f; a1 = 0.f; a2 = 0.f; a3 = 0.f; }
        D = __builtin_amdgcn_mfma_f32_32x32x2f32(a0, xv[0], D, 0, 0, 0); D = __builtin_amdgcn_mfma_f32_32x32x2f32(a1, xv[1], D, 0, 0, 0);
        D = __builtin_amdgcn_mfma_f32_32x32x2f32(a2, xv[2], D, 0, 0, 0); D = __builtin_amdgcn_mfma_f32_32x32x2f32(a3, xv[3], D, 0, 0, 0); }
    return D;
}
DI void ph_odd_prep(const Args& a, const Fr& F, int j, int layer) {
    const bf16* proj = (const bf16*)(F.ws + WS_PROJ); const float* x = (const float*)(F.ws + WS_X);
    float* logf = (float*)(F.ws + WS_LOGF); float* cs = (float*)(F.ws + WS_CS);
    const float* wf = a.in[6] + (size_t)j * 1024 * 3088 + 3072; const float* bfv = a.in[7] + j * 16;
    LAS float* red = (LAS float*)(F.lds); LAS float* lfb = (LAS float*)(F.lds + 131072);
    LAS unsigned* kmx = (LAS unsigned*)(F.lds + 131072 + 8192);
    const int lane = F.lane, wave = F.wave, tid = F.tid, l31 = lane & 31, hi = lane >> 5;
    for (int chunk = F.blk; chunk < 256; chunk += F.G) { const int tok0 = chunk * 128, b = tok0 / SEQ, t0 = tok0 % SEQ;
        __syncthreads();
        if (tid < 16) kmx[tid] = 0u;
        const int tl = wave & 3, kr = wave >> 2;
        f32x16 D = proj32_f32(wf, 3088, 16, x + (size_t)(tok0 + tl * 32 + l31) * DM, kr * 512, lane);
        if (kr == 1) {
#pragma unroll
            for (int r = 0; r < 8; ++r) red[(tl * 8 + r) * 64 + lane] = D[r]; }
        __syncthreads();
        if (kr == 0) {
#pragma unroll
            for (int r = 0; r < 8; ++r) { const int h = (r & 3) + 8 * (r >> 2) + 4 * hi; const float z = D[r] + red[(tl * 8 + r) * 64 + lane] + bfv[h];
                const float ls = fminf(z, 0.f) - log1pf(__expf(-fabsf(z)));
                lfb[(tl * 32 + l31) * 16 + h] = ls * LOG2E; } }
#pragma unroll 1
        for (int i = 0; i < 4; ++i) { const int p = tid + i * NTHR, tk = p >> 4, h = p & 15; const v4u* kp = (const v4u*)(proj + (size_t)(tok0 + tk) * OD_N + OC_K + h * 64); float s = 0.f;
#pragma unroll
            for (int c = 0; c < 8; ++c) { const v4u w = kp[c];
#pragma unroll
                for (int k = 0; k < 4; ++k) { const float e0 = bf2f(w[k] & 0xffffu), e1 = bf2f(w[k] >> 16); s += e0 * e0 + e1 * e1; } }
            __hip_atomic_fetch_max(kmx + h, __float_as_uint(s), __ATOMIC_RELAXED, __HIP_MEMORY_SCOPE_WORKGROUP); }
        __syncthreads();
        for (int i = tid; i < 2048; i += NTHR) { const int h = i >> 7, tk = i & 127; logf[((size_t)b * 16 + h) * SEQ + t0 + tk] = lfb[tk * 16 + h]; }
        if (tid < 32) { const int h = tid & 15, c = tid >> 4; float s = 0.f;
            for (int k = 0; k < 64; ++k) s += lfb[(c * 64 + k) * 16 + h];
            cs[((size_t)b * 16 + h) * 128 + (t0 >> 6) + c] = s; }
        if (tid < 16) __hip_atomic_fetch_max(F.ctl + CW_KMAX + layer * 64 + b * 16 + tid, kmx[tid], RLX_AGENT);
    }
}

struct FoxBias { LAS const float* ng; int tq, kabs0; bool diag;
    DI float operator()(float p, int kvrel) const { const float v = p + ng[kvrel]; return (diag && (kabs0 + kvrel) > tq) ? -INFINITY : v; } };
DI void fox_unit(const Fr& F, int layer, int b, int h, int qb) {
    const bf16* proj = (const bf16*)(F.ws + WS_PROJ); const float* logf = (const float*)(F.ws + WS_LOGF); const float* cs = (const float*)(F.ws + WS_CS); bf16* ao = (bf16*)(F.ws + WS_AO);
    LAS unsigned char* lds = F.lds; LAS float* ng = (LAS float*)(lds + 32768); LAS float* red = (LAS float*)(lds + 65536 + 1024); LAS int* ibox = (LAS int*)(lds + 65536 + 2048);
    const int tid = F.tid, lane = F.lane, wave = F.wave, r32 = lane & 31, hi = lane >> 5, t0 = qb * 256, rowbase = b * SEQ, tq = t0 + wave * 32 + r32;
    __syncthreads();
    bf16x8 qf[4]; float qs = 0.f;
    { const bf16* qp = proj + (size_t)(rowbase + tq) * OD_N + OC_Q + h * 64 + hi * 8;
#pragma unroll
        for (int s = 0; s < 4; ++s) { qf[s] = *(const bf16x8*)(qp + s * 16);
#pragma unroll
            for (int k = 0; k < 8; ++k) { const float e = bf2f((unsigned short)qf[s][k]); qs += e * e; } } }
    qs += __shfl_xor(qs, 32); qs = wave_max(qs);
    if (lane == 0) red[wave] = qs;
    __syncthreads();
    if (tid == 0) { float qm = red[0];
        for (int w = 1; w < 8; ++w) qm = fmaxf(qm, red[w]);
        const float km = __uint_as_float(ld_u32(F.ctl + CW_KMAX + layer * 64 + b * 16 + h));
        const float B2 = 2.f * (sqrtf(qm * km) * 1.01f + 1.f);
        int kt = t0 / 64 - 1, kts = t0 / 64; float D = 0.f;
        while (kt >= 0 && B2 + D >= -160.f) { kts = kt; D += cs[((size_t)b * 16 + h) * 128 + kt]; --kt; }
        ibox[0] = kts; }
    __syncthreads();
    const int kts = ibox[0], s_start = kts * 64, nel = t0 + 256 - s_start;
    { const int i0 = tid * 16; float v[16]; const float* lp = logf + ((size_t)b * 16 + h) * SEQ + s_start + i0;
        if (i0 < nel) {
#pragma unroll
            for (int c = 0; c < 4; ++c) { const f32x4 w = *(const f32x4*)(lp + 4 * c); v[4 * c] = w[0]; v[4 * c + 1] = w[1]; v[4 * c + 2] = w[2]; v[4 * c + 3] = w[3]; } }
        else {
#pragma unroll
            for (int c = 0; c < 16; ++c) v[c] = 0.f; }
#pragma unroll
        for (int c = 1; c < 16; ++c) v[c] += v[c - 1];
        float xsum = v[15];
#pragma unroll
        for (int o = 1; o < 64; o <<= 1) { const float y = __shfl_up(xsum, o); if (lane >= o) xsum += y; }
        if (lane == 63) red[16 + wave] = xsum;
        __syncthreads();
        float off = xsum - v[15];
        for (int w = 0; w < wave; ++w) off += red[16 + w];
        if (i0 < nel) {
#pragma unroll
            for (int c = 0; c < 4; ++c) { f32x4 w = {-(off + v[4 * c]), -(off + v[4 * c + 1]), -(off + v[4 * c + 2]), -(off + v[4 * c + 3])}; *(LAS f32x4*)(ng + i0 + 4 * c) = w; } }
    }
    const int ntile = t0 / 64 + 4 - kts;
    const bf16* kg = proj + (size_t)rowbase * OD_N + OC_K + h * 64; const bf16* vg = proj + (size_t)rowbase * OD_N + OC_V + h * 64;
    const int kr = tid & 31, kc = (tid >> 5) & 7, kst = tid >> 8, vcc = tid & 3, vrow = (tid >> 2) & 63, vdh = tid >> 8;
    const int koff = kst * 4096 + kc * 512 + kr * 16, voff = 8192 + vdh * 4096 + vrow * 64 + vcc * 16;
    { const v4u kv = *(const v4u*)(kg + (size_t)(kts * 64 + kst * 32 + kr) * OD_N + kc * 8), vv = *(const v4u*)(vg + (size_t)(kts * 64 + vrow) * OD_N + vdh * 32 + vcc * 8);
        *(LAS v4u*)(lds + koff) = kv; *(LAS v4u*)(lds + voff) = vv; }
    __syncthreads();
    AttSt S; S.m = -1e30f; S.l = 0.f;
#pragma unroll
    for (int r = 0; r < 16; ++r) { S.o0[r] = 0.f; S.o1[r] = 0.f; }
    const int wlast = t0 + wave * 32 + 31, wfirst = t0 + wave * 32;
    for (int i = 0; i < ntile; ++i) { const int kt = kts + i; LAS unsigned char* buf = lds + (i & 1) * 16384; LAS unsigned char* nbuf = lds + ((i + 1) & 1) * 16384;
        v4u kv, vv; const bool more = i + 1 < ntile;
        if (more) { kv = *(const v4u*)(kg + (size_t)((kt + 1) * 64 + kst * 32 + kr) * OD_N + kc * 8); vv = *(const v4u*)(vg + (size_t)((kt + 1) * 64 + vrow) * OD_N + vdh * 32 + vcc * 8); }
#pragma unroll
        for (int sub = 0; sub < 2; ++sub) { const int kv0 = kt * 64 + sub * 32;
            if (kv0 <= wlast) { FoxBias bf{ng + (kv0 - s_start), tq, kv0, kv0 + 31 > wfirst};
                att_subtile(S, qf, (LAS const char*)buf + sub * 4096, (LAS const char*)buf + 8192, 4096, sub * 32, lane, bf); } }
        if (more) { *(LAS v4u*)(nbuf + koff) = kv; *(LAS v4u*)(nbuf + voff - 8192 + 8192) = vv; }
        __syncthreads(); }
    const float lt = S.l + __shfl_xor(S.l, 32), inv = 1.f / lt;
    bf16* o = ao + (size_t)(rowbase + tq) * 1024 + h * 64;
#pragma unroll
    for (int a4 = 0; a4 < 4; ++a4) { v2u w0, w1;
        w0.x = cvtpk(S.o0[4 * a4] * inv, S.o0[4 * a4 + 1] * inv); w0.y = cvtpk(S.o0[4 * a4 + 2] * inv, S.o0[4 * a4 + 3] * inv);
        w1.x = cvtpk(S.o1[4 * a4] * inv, S.o1[4 * a4 + 1] * inv); w1.y = cvtpk(S.o1[4 * a4 + 2] * inv, S.o1[4 * a4 + 3] * inv);
        *(v2u*)(o + 8 * a4 + 4 * hi) = w0; *(v2u*)(o + 32 + 8 * a4 + 4 * hi) = w1; }
}

DI void ph_ln1_router(const Args& a, const Fr& F, int layer) {
    const float* yp = (const float*)(F.ws + WS_YP); float* x1 = (float*)(F.ws + WS_X1); bf16* xb = (bf16*)(F.ws + WS_XB);
    unsigned* tope = (unsigned*)(F.ws + WS_TOPE); float* gate = (float*)(F.ws + WS_GATE); unsigned* rank = (unsigned*)(F.ws + WS_RANK);
    const float* g = a.in[10] + (size_t)(layer * 2) * DM; const float* bb = a.in[11] + (size_t)(layer * 2) * DM;
    const float* rw = a.in[12] + (size_t)layer * 1024 * 32; const float* rb = a.in[13] + layer * 32;
    LAS float* red = (LAS float*)(F.lds); LAS unsigned* lcnt = (LAS unsigned*)(F.lds + 131072);
    const int lane = F.lane, wave = F.wave, tid = F.tid, l31 = lane & 31, hi = lane >> 5;
    for (int chunk = F.blk; chunk < 256; chunk += F.G) { const int tok0 = chunk * 128;
        __syncthreads();
        if (tid < 32) lcnt[tid] = 0u;
#pragma unroll 1
        for (int k = 0; k < 16; ++k) { const int tok = tok0 + wave * 16 + k; f32x4 v[4];
#pragma unroll
            for (int jj = 0; jj < 4; ++jj) v[jj] = *((const f32x4*)(yp + (size_t)tok * DM) + lane + 64 * jj);
            ln_row(v, g, bb, lane);
            store_row_f32(x1 + (size_t)tok * DM, v, lane); store_row_bf16(xb + (size_t)tok * DM, v, lane); }
        asm volatile("s_waitcnt vmcnt(0)" ::: "memory");
        __syncthreads();
        const int tl = wave & 3, kr = wave >> 2, tokl = tok0 + tl * 32 + l31;
        f32x16 D = proj32_f32(rw, 32, 32, x1 + (size_t)tokl * DM, kr * 512, lane);
        if (kr == 1) {
#pragma unroll
            for (int r = 0; r < 16; ++r) red[(tl * 16 + r) * 64 + lane] = D[r]; }
        __syncthreads();
        if (kr == 0) {
            float lv[32];
#pragma unroll
            for (int r = 0; r < 16; ++r) { const float own = D[r] + red[(tl * 16 + r) * 64 + lane] + rb[crow(r, hi)]; const float oth = __shfl_xor(own, 32);
                lv[crow(r, 0)] = hi == 0 ? own : oth; lv[crow(r, 1)] = hi == 0 ? oth : own; }
            float tv[4]; int te[4];
#pragma unroll
            for (int r = 0; r < 4; ++r) { float mx = -INFINITY; int me = 0;
#pragma unroll
                for (int e = 0; e < 32; ++e) { if (lv[e] > mx) { mx = lv[e]; me = e; } }
                tv[r] = mx; te[r] = me;
#pragma unroll
                for (int e = 0; e < 32; ++e) { if (e == me) lv[e] = -INFINITY; } }
            const float e1 = __expf(tv[1] - tv[0]), e2 = __expf(tv[2] - tv[0]), e3 = __expf(tv[3] - tv[0]); const float inv = 1.f / (1.f + e1 + e2 + e3);
            if (hi == 0) { const size_t o = (size_t)tokl * 4;
                const float gv[4] = {inv, e1 * inv, e2 * inv, e3 * inv};
#pragma unroll
                for (int r = 0; r < 4; ++r) { const unsigned rk = __hip_atomic_fetch_add(lcnt + (te[r] & 31), 1u, __ATOMIC_RELAXED, __HIP_MEMORY_SCOPE_WORKGROUP);
                    tope[o + r] = (unsigned)(te[r] & 31); gate[o + r] = gv[r]; rank[o + r] = rk; } } }
        __syncthreads();
        if (tid < 32) __hip_atomic_store(F.ctl + CW_CNT + chunk * 32 + tid, lcnt[tid], RLX_AGENT);
    }
}

DI void ph_route(const Fr& F) {
    const bf16* xb = (const bf16*)(F.ws + WS_XB); bf16* xg = (bf16*)(F.ws + WS_XG);
    const unsigned* tope = (const unsigned*)(F.ws + WS_TOPE); const unsigned* rank = (const unsigned*)(F.ws + WS_RANK); unsigned* dest = (unsigned*)(F.ws + WS_DEST);
    LAS unsigned* P = (LAS unsigned*)(F.lds); LAS unsigned* pst = P + 512; LAS unsigned* pad = P + 544; LAS unsigned* base = P + 576; LAS unsigned* nt = P + 608;
    const int tid = F.tid, lane = F.lane, wave = F.wave;
    __syncthreads();
    { const int e = tid & 31, part = tid >> 5; unsigned s = 0u;
        for (int c = 0; c < 16; ++c) s += ld_u32(F.ctl + CW_CNT + (part * 16 + c) * 32 + e);
        P[part * 32 + e] = s; }
    __syncthreads();
    if (tid < 32) { unsigned tot = 0u;
        for (int p = 0; p < 16; ++p) tot += P[p * 32 + tid];
        pad[tid] = (tot + 255u) & ~255u; }
    __syncthreads();
    if (tid == 0) { unsigned acc = 0u;
        for (int e = 0; e < 32; ++e) { pst[e] = acc; acc += pad[e]; }
        nt[0] = acc >> 8; }
    __syncthreads();
    for (int chunk = F.blk; chunk < 256; chunk += F.G) {
        __syncthreads();
        if (tid < 32) { unsigned off = 0u; const int pf = chunk >> 4;
            for (int p = 0; p < pf; ++p) off += P[p * 32 + tid];
            for (int c = pf * 16; c < chunk; ++c) off += ld_u32(F.ctl + CW_CNT + c * 32 + tid);
            base[tid] = pst[tid] + off; }
        __syncthreads();
        for (int i = 0; i < 16; ++i) { const int tok = chunk * 128 + wave * 16 + i;
            const v4u src0 = *((const v4u*)(xb + (size_t)tok * DM) + lane), src1 = *((const v4u*)(xb + (size_t)tok * DM) + 64 + lane);
#pragma unroll
            for (int k = 0; k < 4; ++k) { const unsigned e = tope[(size_t)tok * 4 + k], d = base[e] + rank[(size_t)tok * 4 + k];
                if (lane == 0) dest[(size_t)tok * 4 + k] = d;
                *((v4u*)(xg + (size_t)d * DM) + lane) = src0; *((v4u*)(xg + (size_t)d * DM) + 64 + lane) = src1; } }
        if (chunk == 0) { const unsigned ntl = nt[0];
            if (tid == 0) __hip_atomic_store(F.ctl + CW_TILE, ntl, RLX_AGENT);
            for (unsigned i = tid; i < ntl; i += NTHR) { unsigned e = 0u;
                for (unsigned k = 1; k < 32; ++k) if (pst[k] <= i * 256u) e = k;
                __hip_atomic_store(F.ctl + CW_TILE + 64 + i, e, RLX_AGENT); } }
    }
}

DI void ph_combine_ln2(const Args& a, const Fr& F, int layer) {
    const float* x1 = (const float*)(F.ws + WS_X1); const bf16* yr = (const bf16*)(F.ws + WS_XG); float* xo = (float*)(F.ws + WS_X); bf16* xb = (bf16*)(F.ws + WS_XB);
    const float* gate = (const float*)(F.ws + WS_GATE); const unsigned* dest = (const unsigned*)(F.ws + WS_DEST);
    const float* g = a.in[10] + (size_t)(layer * 2 + 1) * DM; const float* bb = a.in[11] + (size_t)(layer * 2 + 1) * DM;
    const int lane = F.lane; const int gw = F.blk * NWAVES + F.wave, NGW = F.G * NWAVES;
    for (int tok = gw; tok < NTOK; tok += NGW) { f32x4 v[4];
#pragma unroll
        for (int jj = 0; jj < 4; ++jj) v[jj] = *((const f32x4*)(x1 + (size_t)tok * DM) + lane + 64 * jj) * ALPHA;
#pragma unroll
        for (int k = 0; k < 4; ++k) { const float gk = gate[(size_t)tok * 4 + k]; const unsigned d = dest[(size_t)tok * 4 + k];
#pragma unroll
            for (int jj = 0; jj < 4; ++jj) { const v2u w = *((const v2u*)(yr + (size_t)d * DM) + lane + 64 * jj);
                v[jj][0] += gk * bf2f(w.x & 0xffffu); v[jj][1] += gk * bf2f(w.x >> 16); v[jj][2] += gk * bf2f(w.y & 0xffffu); v[jj][3] += gk * bf2f(w.y >> 16); } }
        ln_row(v, g, bb, lane);
        if (layer == DEPTH - 1) store_row_f32(a.out + (size_t)tok * DM, v, lane);
        else { store_row_f32(xo + (size_t)tok * DM, v, lane); store_row_bf16(xb + (size_t)tok * DM, v, lane); } }
}
constexpr int LDS_BYTES = 147456;
constexpr int LDS_BARW = 145408, LDS_QSLOT = 145472;
constexpr int NPL = 11;
constexpr int NPHASE = 1 + NPL * DEPTH;
#ifndef MK_SINGLE
#define MK_SINGLE 1
#endif
DI int q_next(const Fr& F, unsigned* ctr) {
    LAS int* slot = (LAS int*)(F.lds + LDS_QSLOT);
    __syncthreads();
    if (F.tid == 0) *slot = (int)__hip_atomic_fetch_add(ctr, 1u, RLX_AGENT);
    __syncthreads();
    return *slot;
}
DI int lane_id_fresh() { unsigned m_ = ~0u; asm volatile("" : "+s"(m_)); return (int)__builtin_amdgcn_mbcnt_hi(m_, __builtin_amdgcn_mbcnt_lo(m_, 0u)); }
#define RETID(F) do { int t2_ = F.tid; asm volatile("" : "+v"(t2_)); F.tid = t2_; F.lane = t2_ & 63; F.wave = __builtin_amdgcn_readfirstlane(t2_ >> 6); } while (0)
#ifndef PROBE_DUP
#define PROBE_DUP -1
#endif
#define NREP(q) ((PROBE_DUP == (q)) ? 2 : 1)
#define AS4 __attribute__((address_space(4)))
#define SITE() Args a; Fr F; { const AS4 Args* ap = (const AS4 Args*)__builtin_amdgcn_kernarg_segment_ptr(); asm volatile("" : "+s"(ap)); \
        _Pragma("unroll") for (int i_ = 0; i_ < 18; ++i_) a.in[i_] = ap->in[i_]; a.out = ap->out; a.ws = ap->ws; a.ph_lo = 0; a.ph_hi = 0; \
        int w_ = wv_s; asm volatile("" : "+s"(w_)); int t_ = w_ * 64 + lane_id_fresh(); asm volatile("" : "+v"(t_)); F.tid = t_; F.lane = t_ & 63; F.wave = __builtin_amdgcn_readfirstlane(t_ >> 6); \
        F.lds = (LAS unsigned char*)lds_raw; F.ws = a.ws; F.ctl = (unsigned*)(a.ws + WS_CTL); F.blk = blockIdx.x; F.G = gridDim.x; }
__global__ void __launch_bounds__(NTHR, 2) mega_fwd(Args a0) {
    extern __shared__ __attribute__((aligned(16))) unsigned char lds_raw[];
    const int wv_s = __builtin_amdgcn_readfirstlane((int)(threadIdx.x >> 6));
#if MK_SINGLE
    constexpr int lo = 0, hi = NPHASE; constexpr bool single = true;
#else
    const int lo = a0.ph_lo, hi = a0.ph_hi; constexpr bool single = false;
#endif
    if (threadIdx.x == 0) *(LAS v4u*)((LAS unsigned char*)lds_raw + LDS_BARW) = (v4u){0u, 0u, 0u, 0u};
    __syncthreads();
    if (single) (void)xcd_barrier_post((unsigned*)(a0.ws + WS_CTL) + CW_BAR, (volatile LAS unsigned*)((LAS unsigned char*)lds_raw + LDS_BARW));
#define IN(k) (lo <= (k) && (k) < hi)
#define SEAM() do { if (single) { const AS4 Args* ap_ = (const AS4 Args*)__builtin_amdgcn_kernarg_segment_ptr(); asm volatile("" : "+s"(ap_)); int w_ = wv_s; asm volatile("" : "+s"(w_)); \
        XcdBarrier b_; b_.bar = (unsigned*)(ap_->ws + WS_CTL) + CW_BAR; b_.x = xb_xcc_id(); b_.st = (volatile LAS unsigned*)((LAS unsigned char*)lds_raw + LDS_BARW); \
        xcd_barrier(b_, (w_ == 0) && (lane_id_fresh() == 0)); } } while (0)
    if (IN(0)) { _Pragma("unroll 1") for (int rep = 0; rep < NREP(100); ++rep) { { SITE(); ph_prologue(a, F); } SEAM(); } }
#pragma unroll 1
    for (int L = 0; L < DEPTH; ++L) {
        const int pb = 1 + NPL * L, j = L >> 1; const bool odd = (L & 1) != 0;
        if (IN(pb + 0)) _Pragma("unroll 1") for (int rep = 0; rep < NREP(0); ++rep) {
            { SITE();
            const bf16* w = odd ? (const bf16*)(F.ws + WS_WOD) + (size_t)j * OD_N * 1024 : (const bf16*)(F.ws + WS_WEV) + (size_t)j * EV_N * 1024;
            const int N = odd ? OD_N : EV_N;
            pg8::Gemm g{(const bf16*)(F.ws + WS_XB), w, NTOK, N, 1024}; pg8::StaticOrder S; S.init(NTOK, N, F.G, F.blk);
            pg8::EpiBf16<0> E{(bf16*)(F.ws + WS_PROJ), N, nullptr, 1024, (size_t)1024, C2F};
            pg8::gemm_phase<pg8::EpiBf16<0>, pg8::StaticOrder, true, true>(F.lds, g, S, E, F.tid); }
            SEAM(); }
        if (IN(pb + 1)) _Pragma("unroll 1") for (int rep = 0; rep < NREP(1); ++rep) { { SITE(); if (odd) ph_odd_prep(a, F, j, L); else ph_even_prep(a, F, j); } SEAM(); }
        if (!odd && IN(pb + 2)) _Pragma("unroll 1") for (int rep = 0; rep < NREP(2); ++rep) {
            { SITE(); unsigned* ctr = F.ctl + CW_Q + 64 * (L * 2) + 1024 * rep;
            for (;;) { const int it = q_next(F, ctr); if (it >= 1280) break; RETID(F);
                if (it < 1024) { if (!(EXPF & 16)) idx_unit(F, it & 3, 255 - (it >> 2)); } else { if (!(EXPF & 32)) moba_gate_chunk(F, it - 1024); } } }
            SEAM(); }
        if (IN(pb + 3)) _Pragma("unroll 1") for (int rep = 0; rep < NREP(3); ++rep) {
            { SITE(); unsigned* ctr = F.ctl + CW_Q + 64 * (L * 2 + 1) + 1024 * rep;
            if (odd) { for (;;) { const int it = q_next(F, ctr); if (it >= 2048) break; RETID(F); const int bh = it & 63; fox_unit(F, L, bh >> 4, bh & 15, 31 - (it >> 6)); } }
            else { for (;;) { const int it = q_next(F, ctr); if (it >= 2048) break; RETID(F);
                    if (it < 1024) { const int bh = it & 31; if (!(EXPF & 32)) moba_unit(a, F, bh >> 3, bh & 7, it >> 5); } else { if (!(EXPF & 16) && !(EXPF & 256)) dsa_chunk(a, F, it - 1024); } } } }
            SEAM(); }
        if (!odd && IN(pb + 4)) _Pragma("unroll 1") for (int rep = 0; rep < NREP(4); ++rep) { { SITE(); ph_even_post(F, j); } SEAM(); }
        if (IN(pb + 5)) _Pragma("unroll 1") for (int rep = 0; rep < NREP(5); ++rep) {
            { SITE();
            const float* xin = (L == 0) ? a.in[0] : (const float*)(F.ws + WS_X);
            pg8::Gemm g{(const bf16*)(F.ws + WS_AO), (const bf16*)(F.ws + WS_WOUT) + (size_t)L * 1024 * 1024, NTOK, 1024, 1024}; pg8::StaticOrder S; S.init(NTOK, 1024, F.G, F.blk);
            EpiResF32 E{xin, (float*)(F.ws + WS_YP), ALPHA};
            pg8::gemm_phase<EpiResF32, pg8::StaticOrder, true, true>(F.lds, g, S, E, F.tid); }
            SEAM(); }
        if (IN(pb + 6)) _Pragma("unroll 1") for (int rep = 0; rep < NREP(6); ++rep) { { SITE(); ph_ln1_router(a, F, L); } SEAM(); }
        if (IN(pb + 7)) _Pragma("unroll 1") for (int rep = 0; rep < NREP(7); ++rep) { { SITE(); ph_route(F); } SEAM(); }
        if (IN(pb + 8)) _Pragma("unroll 1") for (int rep = 0; rep < NREP(8); ++rep) {
            { SITE(); const int ntl = (int)ld_u32(F.ctl + CW_TILE);
            pg8::Gemm g{(const bf16*)(F.ws + WS_XG), (const bf16*)(F.ws + WS_WGU) + (size_t)L * 32 * 2048 * 1024, NR_MAX, 32 * 2048, 1024};
            GroupOrder S{F.ctl + CW_TILE + 64, ntl, 3, F.G, F.blk};
            EpiSwiglu E{(bf16*)(F.ws + WS_ACT), a.in[15] + (size_t)L * 32 * 2048};
            pg8::gemm_phase<EpiSwiglu, GroupOrder, true, true>(F.lds, g, S, E, F.tid); }
            SEAM(); }
        if (IN(pb + 9)) _Pragma("unroll 1") for (int rep = 0; rep < NREP(9); ++rep) {
            { SITE(); const int ntl = (int)ld_u32(F.ctl + CW_TILE);
            pg8::Gemm g{(const bf16*)(F.ws + WS_ACT), (const bf16*)(F.ws + WS_WDN) + (size_t)L * 32 * 1024 * 1024, NR_MAX, 32 * 1024, 1024};
            GroupOrder S{F.ctl + CW_TILE + 64, ntl, 2, F.G, F.blk};
            EpiDown E{(bf16*)(F.ws + WS_XG), a.in[17] + (size_t)L * 32 * 1024};
            pg8::gemm_phase<EpiDown, GroupOrder, true, true>(F.lds, g, S, E, F.tid); }
            SEAM(); }
        if (IN(pb + 10)) _Pragma("unroll 1") for (int rep = 0; rep < NREP(10); ++rep) { { SITE(); ph_combine_ln2(a, F, L); } if (L + 1 < DEPTH || rep + 1 < NREP(10)) SEAM(); }
    }
#undef IN
#undef SEAM
}

extern "C" void kernel_launch(void* const* d_in, const int* in_sizes, int n_in, void* d_out, int out_size, void* d_ws, size_t ws_size, hipStream_t stream) {
    static int grid = 0;
    if (grid == 0) {
        if (n_in != 18 || out_size != NTOK * DM || ws_size < WS_END) { fprintf(stderr, "kernel_launch: unexpected shapes (n_in %d, out %d, ws %zu); nothing launched\n", n_in, out_size, ws_size); grid = -1; return; }
        int dev = 0, cus = 0, per_cu = 0;
        if (hipGetDevice(&dev) != hipSuccess || hipDeviceGetAttribute(&cus, hipDeviceAttributeMultiprocessorCount, dev) != hipSuccess) { grid = -1; return; }
        if (hipFuncSetAttribute((const void*)mega_fwd, hipFuncAttributeMaxDynamicSharedMemorySize, LDS_BYTES) != hipSuccess) { fprintf(stderr, "kernel_launch: hipFuncSetAttribute failed\n"); grid = -1; return; }
        if (hipOccupancyMaxActiveBlocksPerMultiprocessor(&per_cu, (const void*)mega_fwd, NTHR, LDS_BYTES) != hipSuccess || per_cu < 1) fprintf(stderr, "kernel_launch: occupancy query reports %d\n", per_cu);
        (void)hipGetLastError();
        grid = cus;
    }
    if (grid < 0) return;
    (void)hipMemsetAsync((char*)d_ws + WS_CTL, 0, CTL_ZERO_BYTES, stream);
#ifdef EXP_SKIP
    (void)hipMemsetAsync((char*)d_ws + WS_AO, 0, 64 * MiB, stream);
    (void)hipMemsetAsync((char*)d_ws + WS_OL, 0, 64 * MiB, stream);
    if (EXP_SKIP & 4) { (void)hipMemsetAsync((char*)d_ws + WS_XG, 0, 272 * MiB, stream); (void)hipMemsetAsync((char*)d_ws + WS_DEST, 0, 1 * MiB, stream); }
#endif
    Args a{};
    for (int i = 0; i < 18; ++i) a.in[i] = (const float*)d_in[i];
    a.out = (float*)d_out; a.ws = (unsigned char*)d_ws;
#if MK_SINGLE
    a.ph_lo = 0; a.ph_hi = NPHASE;
    hipLaunchKernelGGL(mega_fwd, dim3(grid), dim3(NTHR), LDS_BYTES, stream, a);
#else
    for (int p = 0; p < NPHASE; ++p) {
        if (p > 0) { const int L = (p - 1) / NPL, q = (p - 1) % NPL; if ((L & 1) && (q == 2 || q == 4)) continue;
#ifdef EXP_SKIP
            if ((EXP_SKIP & 1) && !(L & 1) && q <= 4) continue;
            if ((EXP_SKIP & 2) && (L & 1) && q <= 4) continue;
            if ((EXP_SKIP & 4) && q >= 7 && q <= 9) continue;
#endif
        }
        a.ph_lo = p; a.ph_hi = p + 1;
        hipLaunchKernelGGL(mega_fwd, dim3(grid), dim3(NTHR), LDS_BYTES, stream, a);
    }
#endif
}
```

```cpp
#include <hip/hip_runtime.h>
#include <cstdio>
#include <cstdint>
#ifdef EXP_SKIP
#define EXPF EXP_SKIP
#else
#define EXPF 0
#endif
constexpr int NB = 4, SEQ = 8192, DM = 1024, NTOK = NB * SEQ, DEPTH = 4;
constexpr int EV_N = 2560, OD_N = 3072;
constexpr int EC_QA = 0, EC_QB = 512, EC_KB = 1024, EC_VB = 1536, EC_CKV = 2048, EC_QI = 2176, EC_KI = 2432, EC_WI = 2496;
constexpr int OC_Q = 0, OC_K = 1024, OC_V = 2048;
constexpr float LOG2E = 1.4426950408889634f;
constexpr float C2F = 0.125f * LOG2E;
constexpr float ALPHA = 1.681792830507429f;
constexpr float LN_EPS = 1e-5f;
constexpr int NR_MAX = 131072 + 32 * 256;
constexpr int NWAVES = 8, NTHR = 512;
constexpr size_t MiB = (size_t)1 << 20;
constexpr size_t WS_CTL = 0, CTL_ZERO_BYTES = 4 * MiB;
constexpr size_t WS_WEV = 8 * MiB, WS_WOD = 18 * MiB, WS_WOUT = 30 * MiB, WS_WUKT = 38 * MiB, WS_WUVT = 39 * MiB;
constexpr size_t WS_WGU = 40 * MiB, WS_WDN = 552 * MiB;
constexpr size_t WS_X = 808 * MiB, WS_X1 = 936 * MiB, WS_YP = 1064 * MiB, WS_XB = 1192 * MiB;
constexpr size_t WS_PROJ = 1256 * MiB, WS_AO = 1448 * MiB, WS_XG = 1512 * MiB, WS_ACT = 1784 * MiB;
constexpr size_t WS_QL = 2056 * MiB, WS_OL = 2120 * MiB, WS_CKVN = 2184 * MiB, WS_SEL = 2192 * MiB;
constexpr size_t WS_KBAR = 2208 * MiB, WS_SEL3 = 2209 * MiB, WS_LOGF = 2210 * MiB, WS_CS = 2212 * MiB;
constexpr size_t WS_TOPE = 2213 * MiB, WS_GATE = 2214 * MiB, WS_RANK = 2215 * MiB, WS_DEST = 2216 * MiB, WS_PML = 2217 * MiB;
constexpr size_t WS_XB8 = 2226 * MiB;
constexpr size_t WS_END = 2258 * MiB;
constexpr float F8_SX = 16.f, F8_SWG = 256.f, F8_SA = 4.f, F8_SWD = 512.f;
constexpr int CW_BAR = 4096, CW_Q = 8192, CW_KMAX = 12288, CW_CNT = 16384, CW_TILE = 32768;

#define GAS __attribute__((address_space(1)))
#define LAS __attribute__((address_space(3)))
#define DI __device__ __forceinline__
typedef unsigned short bf16;
typedef unsigned v4u __attribute__((ext_vector_type(4)));
typedef unsigned v2u __attribute__((ext_vector_type(2)));
typedef float f32x4 __attribute__((ext_vector_type(4)));
typedef float f32x2 __attribute__((ext_vector_type(2)));
typedef float f32x16 __attribute__((ext_vector_type(16)));
typedef short bf16x8 __attribute__((ext_vector_type(8)));
typedef short s16x4 __attribute__((ext_vector_type(4)));
typedef __bf16 bf16x2_t __attribute__((ext_vector_type(2)));
typedef GAS unsigned gu32;
#define RLX_AGENT __ATOMIC_RELAXED, __HIP_MEMORY_SCOPE_AGENT
#define LDS_WAIT() asm volatile("s_waitcnt lgkmcnt(0)" ::: "memory")

DI float bf2f(unsigned v) { return __uint_as_float(v << 16); }
DI unsigned cvtpk(float lo, float hi) { f32x2 v = {lo, hi}; bf16x2_t b = __builtin_convertvector(v, bf16x2_t); return __builtin_bit_cast(unsigned, b); }
DI unsigned f2bf(float f) { return cvtpk(f, 0.f) & 0xffffu; }
DI unsigned pk4_fp8(float a, float b, float c, float d) {
    a = fminf(fmaxf(a, -448.f), 448.f); b = fminf(fmaxf(b, -448.f), 448.f); c = fminf(fmaxf(c, -448.f), 448.f); d = fminf(fmaxf(d, -448.f), 448.f);
    int w = 0; w = __builtin_amdgcn_cvt_pk_fp8_f32(a, b, w, false); w = __builtin_amdgcn_cvt_pk_fp8_f32(c, d, w, true); return (unsigned)w; }
DI float ex2(float x) { return __builtin_amdgcn_exp2f(x); }
DI float wave_sum(float v) {
#pragma unroll
    for (int o = 1; o < 64; o <<= 1) v += __shfl_xor(v, o);
    return v;
}
DI float wave_max(float v) {
#pragma unroll
    for (int o = 1; o < 64; o <<= 1) v = fmaxf(v, __shfl_xor(v, o));
    return v;
}
DI unsigned ld_u32(const unsigned* p) { return __hip_atomic_load(p, RLX_AGENT); }
DI int crow(int r, int hi) { return (r & 3) + 8 * (r >> 2) + 4 * hi; }
DI f32x16 mfma32(bf16x8 a, bf16x8 b, f32x16 c) { return __builtin_amdgcn_mfma_f32_32x32x16_bf16(a, b, c, 0, 0, 0); }
DI f32x4 mfma16(bf16x8 a, bf16x8 b, f32x4 c) { return __builtin_amdgcn_mfma_f32_16x16x32_bf16(a, b, c, 0, 0, 0); }
typedef short v4i16_t __attribute__((ext_vector_type(4)));
DI s16x4 vtr(LAS const char* p) { return __builtin_bit_cast(s16x4, __builtin_amdgcn_ds_read_tr16_b64_v4i16((LAS v4i16_t*)p)); }
DI bf16x8 cat8(s16x4 a, s16x4 b) { return (bf16x8){a[0], a[1], a[2], a[3], b[0], b[1], b[2], b[3]}; }
DI int t5_bucket(int n) {
    if (n < 16) return n;
    int bkt = 16;
    bkt += (n >= 21); bkt += (n >= 27); bkt += (n >= 35); bkt += (n >= 46); bkt += (n >= 59); bkt += (n >= 77); bkt += (n >= 99); bkt += (n >= 128);
    bkt += (n >= 166); bkt += (n >= 216); bkt += (n >= 280); bkt += (n >= 363); bkt += (n >= 470); bkt += (n >= 609); bkt += (n >= 790);
    return bkt;
}
namespace pg8 {
#define PG8_LAS __attribute__((address_space(3)))
typedef unsigned short bf16_t;
typedef short bf16x8 __attribute__((ext_vector_type(8)));
typedef float f32x4 __attribute__((ext_vector_type(4)));
typedef unsigned u32x4 __attribute__((ext_vector_type(4)));
constexpr int BM = 256, BK = 64, HALF = 128, HTB = HALF * BK * 2  , STAGE_BYTES = 8 * HTB, NXCD = 8, WGM = 8;

__host__ __device__ __forceinline__ int lds_byte(int r, int c) { const int st = (r >> 4) * 2 + (c >> 5), rr = r & 15, cc = c & 31, ob = rr * 64 + cc * 2; return st * 1024 + (ob ^ (((ob >> 9) & 1) << 5)); }
__host__ __device__ __forceinline__ void stage_rc(int b, int& R, int& C) { const int st = b / 1024, sb = b % 1024, swz = sb ^ (((sb >> 9) & 1) << 5); R = (st >> 1) * 16 + swz / 64; C = (st & 1) * 32 + (swz % 64) / 2; }
__host__ __device__ __forceinline__ int perm32(int rho) { const int n = rho >> 4, i = rho & 15; return 8 * (i >> 2) + 4 * n + (i & 3); }

typedef int i32x8 __attribute__((ext_vector_type(8))); typedef int i32x4v __attribute__((ext_vector_type(4)));
__device__ __forceinline__ i32x8 pg8_cat8(bf16x8 lo, bf16x8 hi) { const i32x4v a = __builtin_bit_cast(i32x4v, lo), b = __builtin_bit_cast(i32x4v, hi); return (i32x8){a[0], a[1], a[2], a[3], b[0], b[1], b[2], b[3]}; }
struct Unit { int pm, pn; };
struct Gemm { const bf16_t* A; const bf16_t* Bt; int M, N, K; };

struct StaticOrder {
    int nM, nN, nwg, G, c;
    __host__ __device__ void init(int M, int N, int G_, int c_) { nM = M / BM; nN = N / BM; nwg = nM * nN; G = G_; c = c_; }
    __host__ __device__ bool next(int i, Unit& u) const {
        const long L = (long)i * G + c; if (L >= nwg) return false;
        int wgid = (int)L; { const int q = nwg / NXCD, r = nwg % NXCD, xcd = wgid % NXCD, off = wgid / NXCD; wgid = (xcd < r ? xcd * (q + 1) : r * (q + 1) + (xcd - r) * q) + off; }
        const int nig = WGM * nN, gid = wgid / nig, fm = gid * WGM, gsz = (nM - fm) < WGM ? (nM - fm) : WGM;
        u.pm = fm + ((wgid % nig) % gsz); u.pn = (wgid % nig) / gsz; return true;
    }
    __device__ __forceinline__ void a_ready(const Unit&) const {}
    __device__ __forceinline__ void done(const Unit&) const {}
};

__device__ __forceinline__ unsigned cvt_pk_bf16(float lo, float hi) { unsigned r; asm volatile("v_cvt_pk_bf16_f32 %0, %1, %2" : "=v"(r) : "v"(lo), "v"(hi)); return r; }
typedef float f32x2 __attribute__((ext_vector_type(2)));
__device__ __forceinline__ f32x2 gelu_pk(f32x2 v) {
    const f32x2 av = __builtin_elementwise_abs(v), d = av * 0.2316418882f + 1.0f;
    f32x2 t; t.x = __builtin_amdgcn_rcpf(d.x); t.y = __builtin_amdgcn_rcpf(d.y);
    f32x2 q = t * 0.5307027145f + (-0.7265760135f); q = q * t + 0.7107068705f; q = q * t + (-0.142248368f); q = q * t + 0.127414796f; q = q * t;
    const f32x2 s = (v * v) * (-0.72134752044f);
    f32x2 e; e.x = __builtin_amdgcn_exp2f(s.x); e.y = __builtin_amdgcn_exp2f(s.y);
    const f32x2 m = v * (q * e), r = v - m;
    f32x2 o; o.x = v.x < 0.f ? m.x : r.x; o.y = v.y < 0.f ? m.y : r.y; return o;
}

template <int ACT  > struct EpiBf16 {
    static constexpr bool PERM = true, AFTER_DRAIN = false; static_assert(ACT == 0 || ACT == 1, "EpiBf16: ACT is 0 (none) or 1 (gelu_pk)");
    bf16_t* O; int ldc; const float* bias; int split_cols; size_t split_stride; float scale0;
    __device__ __forceinline__ void operator()(const f32x4 (&acc)[2][2][4][2], const Unit& u, int wr, int wc, int fr, int fq) const {
        const int row0 = u.pm * BM + wr * 64 + fr; int colt = u.pn * BM; bf16_t* base = O;
        float sc = 1.f; if (split_cols) { const int t = colt / split_cols; base += (size_t)t * split_stride; colt -= t * split_cols; if (t == 0) sc = scale0; }
        const int col0 = colt + wc * 32 + 8 * fq, bcol0 = u.pn * BM + wc * 32 + 8 * fq;
        f32x4 bv[2][2];
#pragma unroll
        for (int bj = 0; bj < 2; ++bj)
#pragma unroll
            for (int n = 0; n < 2; ++n) bv[bj][n] = bias ? *(const f32x4*)(bias + bcol0 + bj * HALF + 4 * n) : (f32x4){0.f, 0.f, 0.f, 0.f};
#pragma unroll
        for (int ai = 0; ai < 2; ++ai)
#pragma unroll
            for (int m = 0; m < 4; ++m) { bf16_t* rowp = base + (size_t)(row0 + ai * HALF + m * 16) * ldc + col0;
#pragma unroll
                for (int bj = 0; bj < 2; ++bj) { f32x4 v0 = acc[ai][bj][m][0] + bv[bj][0], v1 = acc[ai][bj][m][1] + bv[bj][1];
                    if (ACT == 1) { f32x2 a = gelu_pk((f32x2){v0[0], v0[1]}), b = gelu_pk((f32x2){v0[2], v0[3]}), c = gelu_pk((f32x2){v1[0], v1[1]}), d = gelu_pk((f32x2){v1[2], v1[3]});
                        v0 = (f32x4){a.x, a.y, b.x, b.y}; v1 = (f32x4){c.x, c.y, d.x, d.y}; }
                    v0 = v0 * sc; v1 = v1 * sc; u32x4 w; w.x = cvt_pk_bf16(v0[0], v0[1]); w.y = cvt_pk_bf16(v0[2], v0[3]); w.z = cvt_pk_bf16(v1[0], v1[1]); w.w = cvt_pk_bf16(v1[2], v1[3]);
                    *(u32x4*)(rowp + bj * HALF) = w; } }
    }
};

template <class Epi, class Sched, bool ALIGN_EPI = false, bool SP2 = false, bool F8 = false>
__device__ __forceinline__ void gemm_phase(PG8_LAS unsigned char* lds, const Gemm g, const Sched& S, const Epi& E, int tid_in) {
    int tid_l = tid_in; asm volatile("" : "+v"(tid_l));
    const int tid = tid_l, wid = __builtin_amdgcn_readfirstlane(tid >> 6), lane = tid & 63, wr = wid >> 2, wc = wid & 3, fr = lane & 15, fq = lane >> 4;
    const int K = g.K, nt = K / BK;
    unsigned voffA[2], voffB[2];
#pragma unroll
    for (int i = 0; i < 2; ++i) { int R, C; stage_rc(tid * 16 + i * 8192, R, C); const int Rb = Epi::PERM ? ((R & ~31) + perm32(R & 31)) : R;
        voffA[i] = (unsigned)(R * K + C) * 2u; voffB[i] = (unsigned)(Rb * K + C) * 2u; }
    const size_t kstep = (size_t)(BK * 2);
    const size_t hstep = (size_t)HALF * K * 2;
    const size_t tstep = 2 * hstep;
    const unsigned ldsw = (unsigned)wid * 1024u;
    const int aoff = lds_byte(wr * 64 + fr, fq * 8), boff = lds_byte(wc * 32 + fr, fq * 8);
#define PG8_SA(b, h) (((b) * 2 + (h)) * HTB)
#define PG8_SB(b, h) ((4 + (b) * 2 + (h)) * HTB)
#define PG8_STAGE(bufoff, gbase, voff) do { _Pragma("unroll") for (int _i = 0; _i < 2; ++_i) \
        __builtin_amdgcn_global_load_lds((const unsigned*)((const char*)(gbase) + (voff)[_i]), (PG8_LAS unsigned*)(lds + (bufoff) + ldsw + _i * 8192), 16, 0, 0); } while (0)
#define PG8_LDA(dst, b, h) do { _Pragma("unroll") for (int m = 0; m < 4; ++m) _Pragma("unroll") for (int k = 0; k < 2; ++k) dst[m][k] = *(const PG8_LAS bf16x8*)(lds + PG8_SA(b, h) + aoff + m * 2048 + k * 1024); } while (0)
#define PG8_LDB(dst, b, h) do { _Pragma("unroll") for (int n = 0; n < 2; ++n) _Pragma("unroll") for (int k = 0; k < 2; ++k) dst[n][k] = *(const PG8_LAS bf16x8*)(lds + PG8_SB(b, h) + boff + n * 2048 + k * 1024); } while (0)
#define PG8_MMA(ai, bj, At, Bt) do { __builtin_amdgcn_s_setprio(1); if constexpr (!F8) { _Pragma("unroll") for (int m = 0; m < 4; ++m) _Pragma("unroll") for (int n = 0; n < 2; ++n) _Pragma("unroll") for (int k = 0; k < 2; ++k) \
        acc[ai][bj][m][n] = __builtin_amdgcn_mfma_f32_16x16x32_bf16(Bt[n][k], At[m][k], acc[ai][bj][m][n], 0, 0, 0); } else { _Pragma("unroll") for (int m = 0; m < 4; ++m) _Pragma("unroll") for (int n = 0; n < 2; ++n) \
        acc[ai][bj][m][n] = __builtin_amdgcn_mfma_scale_f32_16x16x128_f8f6f4(pg8_cat8(Bt[n][0], Bt[n][1]), pg8_cat8(At[m][0], At[m][1]), acc[ai][bj][m][n], 0, 0, 0, 0x7F7F7F7F, 0, 0x7F7F7F7F); \
        _Pragma("unroll") for (int m = 0; m < 4; ++m) _Pragma("unroll") for (int n = 0; n < 2; ++n) asm volatile("" : "+v"(acc[ai][bj][m][n]));   } __builtin_amdgcn_s_setprio(0); } while (0)
#define PG8_WAIT_V(n) asm volatile("s_waitcnt vmcnt(" #n ")" ::: "memory")
#define PG8_WAIT_L(n) asm volatile("s_waitcnt lgkmcnt(" #n ")" ::: "memory")
#define PG8_BAR __builtin_amdgcn_s_barrier()
#define PG8_SCHED __builtin_amdgcn_sched_barrier(0)
    Unit cur, nxt; int ui = 0;
    if (!S.next(0, cur)) return;
    f32x4 acc[2][2][4][2];
#pragma unroll
    for (int a = 0; a < 2; ++a)
#pragma unroll
        for (int b = 0; b < 2; ++b)
#pragma unroll
            for (int m = 0; m < 4; ++m)
#pragma unroll
                for (int n = 0; n < 2; ++n) acc[a][b][m][n] = (f32x4){0.f, 0.f, 0.f, 0.f};
    bf16x8 At[4][2], B0[2][2], B1[2][2];
    const char* cA = (const char*)g.A + (size_t)cur.pm * tstep; const char* cB = (const char*)g.Bt + (size_t)cur.pn * tstep;
    S.a_ready(cur);
    if constexpr (SP2) {
        PG8_STAGE(PG8_SB(0, 0), cB, voffB); PG8_STAGE(PG8_SB(0, 1), cB + hstep, voffB); PG8_STAGE(PG8_SA(0, 0), cA, voffA); PG8_STAGE(PG8_SA(0, 1), cA + hstep, voffA);
        if (wr == 1) PG8_BAR;
        PG8_WAIT_V(2); PG8_BAR;
        PG8_STAGE(PG8_SB(1, 0), cB + kstep, voffB); PG8_STAGE(PG8_SA(1, 0), cA + kstep, voffA); PG8_STAGE(PG8_SB(1, 1), cB + hstep + kstep, voffB);
        PG8_WAIT_V(6); PG8_BAR;
    } else {
        PG8_STAGE(PG8_SB(0, 0), cB, voffB); PG8_STAGE(PG8_SA(0, 0), cA, voffA); PG8_STAGE(PG8_SB(0, 1), cB + hstep, voffB); PG8_STAGE(PG8_SA(0, 1), cA + hstep, voffA);
        if (wr == 1) PG8_BAR;
        PG8_WAIT_V(4); PG8_BAR;
        PG8_STAGE(PG8_SB(1, 0), cB + kstep, voffB); PG8_STAGE(PG8_SA(1, 0), cA + kstep, voffA); PG8_STAGE(PG8_SB(1, 1), cB + hstep + kstep, voffB);
        PG8_WAIT_V(6); PG8_BAR;
    }
    for (;;) {
        const bool has_next = S.next(ui + 1, nxt);
        const char* nA = has_next ? (const char*)g.A + (size_t)nxt.pm * tstep : cA; const char* nB = has_next ? (const char*)g.Bt + (size_t)nxt.pn * tstep : cB;
        for (int t = 0; t < nt; t += 2) {
            const bool last = (t == nt - 2);
            const char* a1 = cA + (size_t)(t + 1) * kstep;
            const char* a2 = last ? nA : cA + (size_t)(t + 2) * kstep; const char* b2 = last ? nB : cB + (size_t)(t + 2) * kstep;
            const char* a3 = a2 + kstep; const char* b3 = b2 + kstep;
            if (last && has_next) S.a_ready(nxt);
            if constexpr (SP2) {
            PG8_LDB(B0, 0, 0); PG8_LDB(B1, 0, 1); PG8_SCHED; PG8_LDA(At, 0, 0); PG8_STAGE(PG8_SA(1, 1), a1 + hstep, voffA);
            PG8_WAIT_V(8); PG8_WAIT_L(0); PG8_BAR; PG8_MMA(0, 0, At, B0); PG8_MMA(0, 1, At, B1); PG8_BAR; PG8_SCHED;
            PG8_LDA(At, 0, 1); PG8_STAGE(PG8_SB(0, 0), b2, voffB); PG8_STAGE(PG8_SB(0, 1), b2 + hstep, voffB); PG8_STAGE(PG8_SA(0, 0), a2, voffA);
            PG8_WAIT_V(8); PG8_WAIT_L(0); PG8_BAR; PG8_MMA(1, 0, At, B0); PG8_MMA(1, 1, At, B1); PG8_BAR; PG8_SCHED;
            PG8_LDB(B0, 1, 0); PG8_LDB(B1, 1, 1); PG8_SCHED; PG8_LDA(At, 1, 0); PG8_STAGE(PG8_SA(0, 1), a2 + hstep, voffA);
            PG8_WAIT_V(8); PG8_WAIT_L(0); PG8_BAR; PG8_MMA(0, 0, At, B0); PG8_MMA(0, 1, At, B1); PG8_BAR; PG8_SCHED;
            PG8_LDA(At, 1, 1); PG8_STAGE(PG8_SB(1, 0), b3, voffB); PG8_STAGE(PG8_SB(1, 1), b3 + hstep, voffB); PG8_STAGE(PG8_SA(1, 0), a3, voffA);
            PG8_WAIT_V(8); PG8_WAIT_L(0); PG8_BAR; PG8_MMA(1, 0, At, B0); PG8_MMA(1, 1, At, B1); PG8_BAR; PG8_SCHED;
            } else {
            PG8_LDB(B0, 0, 0); PG8_SCHED; PG8_LDA(At, 0, 0); PG8_STAGE(PG8_SA(1, 1), a1 + hstep, voffA);
            PG8_WAIT_L(8); PG8_BAR; PG8_WAIT_L(0); PG8_MMA(0, 0, At, B0); PG8_BAR; PG8_SCHED;
            PG8_LDB(B1, 0, 1); PG8_STAGE(PG8_SB(0, 0), b2, voffB);
            PG8_BAR; PG8_WAIT_L(0); PG8_MMA(0, 1, At, B1); PG8_BAR;
            PG8_LDA(At, 0, 1); PG8_STAGE(PG8_SA(0, 0), a2, voffA);
            PG8_BAR; PG8_WAIT_L(0); PG8_MMA(1, 0, At, B0); PG8_BAR; PG8_SCHED;
            PG8_STAGE(PG8_SB(0, 1), b2 + hstep, voffB);
            PG8_WAIT_V(6); PG8_BAR; PG8_MMA(1, 1, At, B1); PG8_BAR;
            PG8_LDB(B0, 1, 0); PG8_SCHED; PG8_LDA(At, 1, 0); PG8_STAGE(PG8_SA(0, 1), a2 + hstep, voffA);
            PG8_WAIT_L(8); PG8_BAR; PG8_WAIT_L(0); PG8_MMA(0, 0, At, B0); PG8_BAR; PG8_SCHED;
            PG8_LDB(B1, 1, 1); PG8_STAGE(PG8_SB(1, 0), b3, voffB);
            PG8_BAR; PG8_WAIT_L(0); PG8_MMA(0, 1, At, B1); PG8_BAR;
            PG8_LDA(At, 1, 1); PG8_STAGE(PG8_SA(1, 0), a3, voffA);
            PG8_BAR; PG8_WAIT_L(0); PG8_MMA(1, 0, At, B0); PG8_BAR; PG8_SCHED;
            PG8_STAGE(PG8_SB(1, 1), b3 + hstep, voffB);
            PG8_WAIT_V(6); PG8_BAR; PG8_MMA(1, 1, At, B1); PG8_BAR;
            }
        }
        if constexpr (ALIGN_EPI) { if (wr == 0) PG8_BAR; }
        if constexpr (!Epi::AFTER_DRAIN) { E(acc, cur, wr, wc, fr, fq); S.done(cur); }
        if (!has_next) break;
#pragma unroll
        for (int a = 0; a < 2; ++a)
#pragma unroll
            for (int b = 0; b < 2; ++b)
#pragma unroll
                for (int m = 0; m < 4; ++m)
#pragma unroll
                    for (int n = 0; n < 2; ++n) acc[a][b][m][n] = (f32x4){0.f, 0.f, 0.f, 0.f};
        cur = nxt; cA = nA; cB = nB; ++ui;
        if constexpr (ALIGN_EPI) { if (wr == 1) PG8_BAR; }
    }
    PG8_WAIT_V(0);
    if constexpr (!ALIGN_EPI) { if (wr == 0) PG8_BAR; }
    PG8_BAR;
    if constexpr (Epi::AFTER_DRAIN) { E.fused(acc, cur, wr, wc, fr, fq, lds, wid, lane); S.done(cur); }
#undef PG8_SA
#undef PG8_SB
#undef PG8_STAGE
#undef PG8_LDA
#undef PG8_LDB
#undef PG8_MMA
#undef PG8_WAIT_V
#undef PG8_WAIT_L
#undef PG8_BAR
#undef PG8_SCHED
}
}

#ifndef PG8_SP2
#define PG8_SP2 true
#endif
#ifndef PG8_ALIGN
#define PG8_ALIGN true
#endif
#define XB_TMO      128
#define XB_XCNT(j)  (256  + 64 * (j))
#define XB_XSUB(j)  (1280 + 64 * (j))
#define XB_XGEN(j)  (2304 + 64 * (j))
#define XB_TOP      3328
#define XB_TOPGEN   3392
#define XCD_BAR_WORDS 3456
#define XB_SPIN_CAP (1u << 18)

__device__ __forceinline__ unsigned xb_ld(unsigned* p)              { return __hip_atomic_load(p, __ATOMIC_RELAXED, __HIP_MEMORY_SCOPE_AGENT); }
__device__ __forceinline__ unsigned xb_add(unsigned* p, unsigned v) { return __hip_atomic_fetch_add(p, v, __ATOMIC_RELAXED, __HIP_MEMORY_SCOPE_AGENT); }
__device__ __forceinline__ unsigned xb_xcc_id() { return (unsigned)__builtin_amdgcn_s_getreg((3 << 11) | 20) & 0xFu; }
#define XB_SPIN(cond, bar) do { unsigned _sp = 0; while (cond) { __builtin_amdgcn_s_sleep(1); \
    if ((++_sp & 255u) == 0u) { if (xb_ld(&(bar)[XB_TMO])) break; if (_sp > XB_SPIN_CAP) { atomicAdd(&(bar)[XB_TMO], 1u); break; } } } } while (0)

struct XcdBarrier {
    unsigned* bar; unsigned x;
    volatile LAS unsigned* st;
};

__device__ __forceinline__ XcdBarrier xcd_barrier_post(unsigned* bar, volatile LAS unsigned* st) {
    XcdBarrier b; b.bar = bar; b.x = xb_xcc_id(); b.st = st;
    if (threadIdx.x == 0) (void)xb_add(&bar[XB_XCNT(b.x)], 1u);
    return b;
}
__device__ __forceinline__ void xcd_barrier_complete(unsigned* bar, unsigned x, unsigned& nloc, unsigned& nx) {
    const unsigned G = gridDim.x * gridDim.y * gridDim.z;
    unsigned sum, cnt, mine, sp = 0u;
    for (;;) {
        sum = 0u; cnt = 0u; mine = 0u;
#pragma unroll
        for (unsigned j = 0; j < 16; ++j) { const unsigned c = xb_ld(&bar[XB_XCNT(j)]); sum += c; cnt += (c > 0u) ? 1u : 0u; mine = (j == x) ? c : mine; }
        if (sum == G) break;
        __builtin_amdgcn_s_sleep(1);
        if ((++sp & 255u) == 0u) { if (xb_ld(&bar[XB_TMO])) break; if (sp > XB_SPIN_CAP) { atomicAdd(&bar[XB_TMO], 1u); break; } }
    }
    nloc = mine > 0u ? mine : 1u; nx = cnt > 0u ? cnt : 1u;
}

__device__ __forceinline__ void xcd_barrier(const XcdBarrier& b, const bool is_t0  ) {
    asm volatile("s_waitcnt vmcnt(0)" ::: "memory");
    __syncthreads();
    if (is_t0) {
        unsigned* bar = b.bar;
        __builtin_amdgcn_s_waitcnt(0);
        unsigned nloc = b.st[0], nx = b.st[1];
        if (nloc == 0u) { xcd_barrier_complete(bar, b.x, nloc, nx); b.st[0] = nloc; b.st[1] = nx; }
        const unsigned old = xb_add(&bar[XB_XSUB(b.x)], 1u);
        const unsigned gen = old / nloc;
        if (old + 1u == (gen + 1u) * nloc) {
            __builtin_amdgcn_fence(__ATOMIC_RELEASE, "agent");
            asm volatile("s_waitcnt vmcnt(0)" ::: "memory");
            const unsigned og = xb_add(&bar[XB_TOP], 1u);
            const unsigned tg = og / nx;
            if (og + 1u == (tg + 1u) * nx) xb_add(&bar[XB_TOPGEN], 1u);
            else XB_SPIN(xb_ld(&bar[XB_TOPGEN]) == tg, bar);
            __builtin_amdgcn_fence(__ATOMIC_ACQUIRE, "agent");
            xb_add(&bar[XB_XGEN(b.x)], 1u);
            asm volatile("s_waitcnt vmcnt(0)" ::: "memory");
        } else {
            XB_SPIN(xb_ld(&bar[XB_XGEN(b.x)]) == gen, bar);
            __builtin_amdgcn_fence(__ATOMIC_ACQUIRE, "agent");
            asm volatile("s_waitcnt vmcnt(0)" ::: "memory");
        }
    }
    __syncthreads();
}
struct EpiResF32 {
    static constexpr bool PERM = true, AFTER_DRAIN = false;
    const float* xin; float* yp; float alpha;
    DI void operator()(const pg8::f32x4 (&acc)[2][2][4][2], const pg8::Unit& u, int wr, int wc, int fr, int fq) const {
        const int row0 = u.pm * 256 + wr * 64 + fr, col0 = u.pn * 256 + wc * 32 + 8 * fq;
#pragma unroll
        for (int ai = 0; ai < 2; ++ai)
#pragma unroll
            for (int m = 0; m < 4; ++m) {
                const size_t ro = (size_t)(row0 + ai * 128 + m * 16) * DM;
#pragma unroll
                for (int bj = 0; bj < 2; ++bj) {
                    const size_t o = ro + col0 + bj * 128;
                    const f32x4 x0 = *(const f32x4*)(xin + o), x1 = *(const f32x4*)(xin + o + 4);
                    *(f32x4*)(yp + o) = x0 * alpha + acc[ai][bj][m][0];
                    *(f32x4*)(yp + o + 4) = x1 * alpha + acc[ai][bj][m][1];
                }
            }
    }
};
struct EpiSwiglu {
    static constexpr bool PERM = true, AFTER_DRAIN = false;
    unsigned char* act; const float* bgu;
    DI void operator()(const pg8::f32x4 (&acc)[2][2][4][2], const pg8::Unit& u, int wr, int wc, int fr, int fq) const {
        const int e = u.pn >> 3, pl = u.pn & 7;
        const int row0 = u.pm * 256 + wr * 64 + fr, cih = pl * 128 + wc * 32 + 8 * fq;
        const float* bg = bgu + e * 2048 + cih;
        const f32x4 bg0 = *(const f32x4*)(bg), bg1 = *(const f32x4*)(bg + 4), bu0 = *(const f32x4*)(bg + 1024), bu1 = *(const f32x4*)(bg + 1028);
#pragma unroll
        for (int ai = 0; ai < 2; ++ai)
#pragma unroll
            for (int m = 0; m < 4; ++m) {
                constexpr float RS = 1.f / (F8_SX * F8_SWG);
                const f32x4 g0 = acc[ai][0][m][0] * RS + bg0, g1 = acc[ai][0][m][1] * RS + bg1, u0 = acc[ai][1][m][0] * RS + bu0, u1 = acc[ai][1][m][1] * RS + bu1;
                float r[8];
#pragma unroll
                for (int i = 0; i < 8; ++i) {
                    float g = i < 4 ? g0[i & 3] : g1[i & 3], uu = i < 4 ? u0[i & 3] : u1[i & 3];
                    g = fminf(g, 7.0f); uu = fminf(fmaxf(uu, -7.0f), 7.0f);
                    const float sg = __builtin_amdgcn_rcpf(1.0f + ex2(-1.702f * LOG2E * g));
                    r[i] = (uu + 1.0f) * g * sg * F8_SA;
                }
                v2u w; w.x = pk4_fp8(r[0], r[1], r[2], r[3]); w.y = pk4_fp8(r[4], r[5], r[6], r[7]);
                *(v2u*)(act + (size_t)(row0 + ai * 128 + m * 16) * DM + cih) = w;
            }
    }
};
struct EpiDown {
    static constexpr bool PERM = true, AFTER_DRAIN = false;
    bf16* yr; const float* bdn;
    DI void operator()(const pg8::f32x4 (&acc)[2][2][4][2], const pg8::Unit& u, int wr, int wc, int fr, int fq) const {
        const int e = u.pn >> 2, pl = u.pn & 3;
        const int row0 = u.pm * 256 + wr * 64 + fr, col0 = pl * 256 + wc * 32 + 8 * fq;
        f32x4 bv[2][2];
#pragma unroll
        for (int bj = 0; bj < 2; ++bj) { bv[bj][0] = *(const f32x4*)(bdn + e * 1024 + col0 + bj * 128); bv[bj][1] = *(const f32x4*)(bdn + e * 1024 + col0 + bj * 128 + 4); }
#pragma unroll
        for (int ai = 0; ai < 2; ++ai)
#pragma unroll
            for (int m = 0; m < 4; ++m) {
                bf16* rp = yr + (size_t)(row0 + ai * 128 + m * 16) * DM + col0;
#pragma unroll
                for (int bj = 0; bj < 2; ++bj) {
                    constexpr float RS = 1.f / (F8_SA * F8_SWD);
                    const f32x4 v0 = acc[ai][bj][m][0] * RS + bv[bj][0], v1 = acc[ai][bj][m][1] * RS + bv[bj][1];
                    v4u w; w.x = cvtpk(v0[0], v0[1]); w.y = cvtpk(v0[2], v0[3]); w.z = cvtpk(v1[0], v1[1]); w.w = cvtpk(v1[2], v1[3]);
                    *(v4u*)(rp + bj * 128) = w;
                }
            }
    }
};
struct GroupOrder {
    const unsigned* tile_e; int ntiles, lg, G, c;
    DI bool next(int i, pg8::Unit& u) const {
        const long L = (long)i * G + c; if (L >= ((long)ntiles << lg)) return false;
        const int pm = (int)(L >> lg), pl = (int)(L & ((1 << lg) - 1));
        const int e = __builtin_amdgcn_readfirstlane((int)ld_u32(tile_e + pm));
        u.pm = pm; u.pn = (e << lg) + pl; return true;
    }
    DI void a_ready(const pg8::Unit&) const {}
    DI void done(const pg8::Unit&) const {}
};
struct Args { const float* in[18]; float* out; unsigned char* ws; int ph_lo, ph_hi; };
struct Fr { LAS unsigned char* lds; unsigned char* ws; unsigned* ctl; int tid, lane, wave, blk, G; };

DI void tr_item(const float* W, int ldw, int K, int k0, int sc0, int nvalid, bf16* WT, int drow0, LAS float* scr, int lane) {
    const int c = lane & 31;
#pragma unroll 8
    for (int i = 0; i < 32; ++i) { const int kk = 2 * i + (lane >> 5); scr[kk * 33 + c] = (c < nvalid) ? W[(size_t)(k0 + kk) * ldw + sc0 + c] : 0.f; }
    LDS_WAIT(); asm volatile("" ::: "memory");
    const int c8 = lane & 7;
#pragma unroll
    for (int j = 0; j < 4; ++j) { const int n = (lane >> 3) + 8 * j; const LAS float* s = scr + (8 * c8) * 33 + n;
        v4u o; o.x = cvtpk(s[0 * 33], s[1 * 33]); o.y = cvtpk(s[2 * 33], s[3 * 33]); o.z = cvtpk(s[4 * 33], s[5 * 33]); o.w = cvtpk(s[6 * 33], s[7 * 33]);
        *(v4u*)(WT + (size_t)(drow0 + n) * K + k0 + 8 * c8) = o; }
    LDS_WAIT(); asm volatile("" ::: "memory");
}
DI void tr_item8(const float* W, int ldw, int K, int k0, int sc0, float scale, unsigned char* WT8, int drow0, LAS float* scr, int lane) {
    const int c = lane & 31;
#pragma unroll 8
    for (int i = 0; i < 32; ++i) { const int kk = 2 * i + (lane >> 5); scr[kk * 33 + c] = W[(size_t)(k0 + kk) * ldw + sc0 + c] * scale; }
    LDS_WAIT(); asm volatile("" ::: "memory");
    const int c16 = lane & 3;
#pragma unroll
    for (int j = 0; j < 2; ++j) { const int n = (lane >> 2) + 16 * j; const LAS float* s = scr + (16 * c16) * 33 + n;
        v4u o; o.x = pk4_fp8(s[0 * 33], s[1 * 33], s[2 * 33], s[3 * 33]); o.y = pk4_fp8(s[4 * 33], s[5 * 33], s[6 * 33], s[7 * 33]);
        o.z = pk4_fp8(s[8 * 33], s[9 * 33], s[10 * 33], s[11 * 33]); o.w = pk4_fp8(s[12 * 33], s[13 * 33], s[14 * 33], s[15 * 33]);
        *(v4u*)(WT8 + (size_t)(drow0 + n) * K + k0 + 16 * c16) = o; }
    LDS_WAIT(); asm volatile("" ::: "memory");
}
DI void ph_prologue(const Args& a, const Fr& F) {
    LAS float* scr = (LAS float*)(F.lds + F.wave * 16384);
    const int gw = F.blk * NWAVES + F.wave, NGW = F.G * NWAVES;
    constexpr int I_EV = 2 * 16 * 80, I_OD = 2 * 16 * 96, I_WO = 4 * 16 * 32, I_GU = 128 * 16 * 64, I_DN = 128 * 16 * 32;
    constexpr int NITEMS = I_EV + I_OD + I_WO + I_GU + I_DN;
    bf16* wev = (bf16*)(F.ws + WS_WEV); bf16* wod = (bf16*)(F.ws + WS_WOD); bf16* wout = (bf16*)(F.ws + WS_WOUT);
    unsigned char* wgu = F.ws + WS_WGU; unsigned char* wdn = F.ws + WS_WDN;
    for (int it = gw; it < NITEMS; it += NGW) {
        int r = it;
        if (r < I_EV) { const int l = r / 1280; r %= 1280; const int kb = r / 80, n0 = (r % 80) * 32; int sc0, nv = 32;
            if (n0 < 512) sc0 = n0; else if (n0 < 1024) sc0 = 964 + (n0 - 512); else if (n0 < 1536) sc0 = 1476 + (n0 - 1024); else if (n0 < 2048) sc0 = 1988 + (n0 - 1536);
            else if (n0 < 2176) sc0 = 512 + (n0 - 2048); else if (n0 < 2432) sc0 = 640 + (n0 - 2176); else if (n0 < 2496) sc0 = 896 + (n0 - 2432);
            else if (n0 < 2528) { sc0 = 960; nv = 4; } else { sc0 = 0; nv = 0; }
            tr_item(a.in[1] + (size_t)l * 1024 * 2500, 2500, 1024, kb * 64, sc0, nv, wev + (size_t)l * EV_N * 1024, n0, scr, F.lane); continue; }
        r -= I_EV;
        if (r < I_OD) { const int l = r / 1536; r %= 1536; const int kb = r / 96, n0 = (r % 96) * 32;
            tr_item(a.in[6] + (size_t)l * 1024 * 3088, 3088, 1024, kb * 64, n0, 32, wod + (size_t)l * OD_N * 1024, n0, scr, F.lane); continue; }
        r -= I_OD;
        if (r < I_WO) { const int l = r / 512; r %= 512; const int kb = r / 32, n0 = (r % 32) * 32;
            const float* src = (l & 1) ? a.in[8] + (size_t)(l >> 1) * 1024 * 1024 : a.in[5] + (size_t)(l >> 1) * 1024 * 1024;
            tr_item(src, 1024, 1024, kb * 64, n0, 32, wout + (size_t)l * 1024 * 1024, n0, scr, F.lane); continue; }
        r -= I_WO;
        if (r < I_GU) { const int le = r / 1024; r %= 1024; const int kb = r / 64, n0 = (r % 64) * 32;
            const int pn = n0 >> 8, bj = (n0 >> 7) & 1, j0 = n0 & 127;
            tr_item8(a.in[14] + (size_t)le * 1024 * 2048, 2048, 1024, kb * 64, bj * 1024 + pn * 128 + j0, F8_SWG, wgu + (size_t)le * 2048 * 1024, n0, scr, F.lane); continue; }
        r -= I_GU;
        { const int le = r / 512; r %= 512; const int kb = r / 32, n0 = (r % 32) * 32;
            tr_item8(a.in[16] + (size_t)le * 1024 * 1024, 1024, 1024, kb * 64, n0, F8_SWD, wdn + (size_t)le * 1024 * 1024, n0, scr, F.lane); }
    }
    bf16* xb = (bf16*)(F.ws + WS_XB);
    for (int m = gw; m < NTOK; m += NGW) {
        const f32x4* xr = (const f32x4*)(a.in[0] + (size_t)m * DM) + F.lane; v2u* o = (v2u*)(xb + (size_t)m * DM) + F.lane;
#pragma unroll
        for (int j = 0; j < 4; ++j) { const f32x4 v = xr[64 * j]; v2u w; w.x = cvtpk(v[0], v[1]); w.y = cvtpk(v[2], v[3]); o[64 * j] = w; }
    }
    bf16* wukt = (bf16*)(F.ws + WS_WUKT); bf16* wuvt = (bf16*)(F.ws + WS_WUVT);
    for (int i = F.blk * NTHR + F.tid; i < 2 * 8 * 128 * 64; i += F.G * NTHR) {
        { const int d = i & 63, c = (i >> 6) & 127, lh = i >> 13; wukt[i] = (bf16)f2bf(a.in[2][((size_t)lh * 64 + d) * 128 + c]); }
        { const int c = i & 127, d = (i >> 7) & 63, lh = i >> 13; wuvt[i] = (bf16)f2bf(a.in[3][((size_t)lh * 128 + c) * 64 + d]); }
    }
}

DI void ln_row(f32x4 (&v)[4], const float* g, const float* b, int lane) {
    float s = 0.f;
#pragma unroll
    for (int j = 0; j < 4; ++j) s += (v[j][0] + v[j][1]) + (v[j][2] + v[j][3]);
    const float mean = wave_sum(s) * (1.f / DM); float s2 = 0.f;
#pragma unroll
    for (int j = 0; j < 4; ++j) { v[j] = v[j] - mean; s2 += (v[j][0] * v[j][0] + v[j][1] * v[j][1]) + (v[j][2] * v[j][2] + v[j][3] * v[j][3]); }
    const float rstd = 1.f / sqrtf(wave_sum(s2) * (1.f / DM) + LN_EPS);
#pragma unroll
    for (int j = 0; j < 4; ++j) { const f32x4 gg = *((const f32x4*)g + lane + 64 * j), bb = *((const f32x4*)b + lane + 64 * j); v[j] = v[j] * rstd * gg + bb; }
}
DI void store_row_f32(float* p, const f32x4 (&v)[4], int lane) {
#pragma unroll
    for (int j = 0; j < 4; ++j) *((f32x4*)p + lane + 64 * j) = v[j];
}
DI void store_row_bf16(bf16* p, const f32x4 (&v)[4], int lane) {
#pragma unroll
    for (int j = 0; j < 4; ++j) { v2u w; w.x = cvtpk(v[j][0], v[j][1]); w.y = cvtpk(v[j][2], v[j][3]); *((v2u*)p + lane + 64 * j) = w; }
}
template <int NL> DI void small_proj(LAS const float* xs, const float* W, int ldw, int lane, float (&acc)[4]) {
    constexpr int PARTS = 64 / NL, DPER = 1024 / PARTS;
    const int n = lane & (NL - 1), part = lane / NL;
    acc[0] = acc[1] = acc[2] = acc[3] = 0.f;
    const float* wp = W + (size_t)(part * DPER) * ldw + n;
    LAS const float* xp = xs + part * DPER;
#pragma unroll 8
    for (int d = 0; d < DPER; ++d) { const float w = wp[(size_t)d * ldw];
        acc[0] += w * xp[d]; acc[1] += w * xp[1024 + d]; acc[2] += w * xp[2048 + d]; acc[3] += w * xp[3072 + d]; }
#pragma unroll
    for (int o = NL; o < 64; o <<= 1) {
#pragma unroll
        for (int k = 0; k < 4; ++k) acc[k] += __shfl_xor(acc[k], o); }
}

DI void ph_even_prep(const Args& a, const Fr& F, int j) {
    const bf16* proj = (const bf16*)(F.ws + WS_PROJ);
    bf16* ckvn = (bf16*)(F.ws + WS_CKVN); bf16* ql = (bf16*)(F.ws + WS_QL); float* kbar = (float*)(F.ws + WS_KBAR);
    const float* kvg = a.in[4] + j * 128;
    const bf16* wukt = (const bf16*)(F.ws + WS_WUKT) + (size_t)j * 8 * 128 * 64;
    const int lane = F.lane, wave = F.wave;
    for (int chunk = F.blk; chunk < 256; chunk += F.G) {
        const int tok0 = chunk * 128;
        for (int i = 0; i < 16; ++i) { const int tok = tok0 + wave * 16 + i;
            const unsigned w = *((const unsigned*)(proj + (size_t)tok * EV_N + EC_CKV) + lane);
            const float v0 = bf2f(w & 0xffffu), v1 = bf2f(w >> 16);
            const float ss = wave_sum(v0 * v0 + v1 * v1);
            const float r = 1.f / sqrtf(ss * (1.f / 128.f) + LN_EPS);
            *((unsigned*)(ckvn + (size_t)tok * 128) + lane) = cvtpk(v0 * r * kvg[2 * lane], v1 * r * kvg[2 * lane + 1]); }
        { const int h = wave, l15 = lane & 15, kg = lane >> 4;
            bf16x8 af[8][2];
#pragma unroll
            for (int ct = 0; ct < 8; ++ct)
#pragma unroll
                for (int ks = 0; ks < 2; ++ks) af[ct][ks] = *(const bf16x8*)(wukt + ((size_t)h * 128 + ct * 16 + l15) * 64 + ks * 32 + kg * 8);
            for (int tg = 0; tg < 8; ++tg) { const int tok = tok0 + tg * 16 + l15;
                bf16x8 qf[2];
#pragma unroll
                for (int ks = 0; ks < 2; ++ks) qf[ks] = *(const bf16x8*)(proj + (size_t)tok * EV_N + EC_QA + h * 64 + ks * 32 + kg * 8);
#pragma unroll
                for (int ct = 0; ct < 8; ++ct) { f32x4 d = {0.f, 0.f, 0.f, 0.f};
                    d = mfma16(af[ct][0], qf[0], d); d = mfma16(af[ct][1], qf[1], d);
                    v2u w; w.x = cvtpk(d[0], d[1]); w.y = cvtpk(d[2], d[3]);
                    *(v2u*)(ql + (size_t)tok * 1024 + h * 128 + ct * 16 + 4 * kg) = w; } } }
        if (chunk < 128) { const int b = chunk >> 5, n = chunk & 31; float s8[8];
#pragma unroll
            for (int k = 0; k < 8; ++k) s8[k] = 0.f;
            const bf16* kp = proj + ((size_t)b * SEQ + n * 256 + wave * 32) * EV_N + EC_KB + lane * 8;
#pragma unroll 8
            for (int r = 0; r < 32; ++r) { const v4u w = *(const v4u*)(kp + (size_t)r * EV_N);
#pragma unroll
                for (int k = 0; k < 4; ++k) { s8[2 * k] += bf2f(w[k] & 0xffffu); s8[2 * k + 1] += bf2f(w[k] >> 16); } }
            LAS float* red = (LAS float*)F.lds;
            __syncthreads();
#pragma unroll
            for (int k = 0; k < 8; ++k) red[wave * 512 + lane * 8 + k] = s8[k];
            __syncthreads();
            float s = 0.f;
#pragma unroll
            for (int w = 0; w < 8; ++w) s += red[w * 512 + F.tid];
            const int h = F.tid >> 6, d = F.tid & 63;
            kbar[(((size_t)b * 8 + h) * 32 + n) * 64 + d] = s * (1.f / 256.f); }
    }
}

DI void moba_gate_chunk(const Fr& F, int chunk) {
    const bf16* proj = (const bf16*)(F.ws + WS_PROJ); const float* kbar = (const float*)(F.ws + WS_KBAR); unsigned* sel3 = (unsigned*)(F.ws + WS_SEL3);
    const int tok0 = chunk * 128, b = tok0 / SEQ, own = (tok0 % SEQ) >> 8, h = F.wave, lane = F.lane;
    float q0[64], q1[64];
    { const v4u* p0 = (const v4u*)(proj + (size_t)(tok0 + lane) * EV_N + EC_QB + h * 64); const v4u* p1 = (const v4u*)(proj + (size_t)(tok0 + 64 + lane) * EV_N + EC_QB + h * 64);
#pragma unroll
        for (int i = 0; i < 8; ++i) { const v4u w0 = p0[i], w1 = p1[i];
#pragma unroll
            for (int k = 0; k < 4; ++k) { q0[8 * i + 2 * k] = bf2f(w0[k] & 0xffffu); q0[8 * i + 2 * k + 1] = bf2f(w0[k] >> 16); q1[8 * i + 2 * k] = bf2f(w1[k] & 0xffffu); q1[8 * i + 2 * k + 1] = bf2f(w1[k] >> 16); } } }
    float a0 = -INFINITY, a1 = -INFINITY, a2 = -INFINITY, c0 = -INFINITY, c1 = -INFINITY, c2 = -INFINITY; int ai0 = 0, ai1 = 0, ai2 = 0, ci0 = 0, ci1 = 0, ci2 = 0;
    const float* kb = kbar + (((size_t)b * 8 + h) * 32) * 64;
    for (int n = 0; n < own; ++n) { float g0 = 0.f, g1 = 0.f;
#pragma unroll
        for (int d = 0; d < 64; d += 4) { const f32x4 kv = *(const f32x4*)(kb + n * 64 + d);
#pragma unroll
            for (int k = 0; k < 4; ++k) { g0 += q0[d + k] * kv[k]; g1 += q1[d + k] * kv[k]; } }
        if (g0 > a2) { if (g0 > a1) { a2 = a1; ai2 = ai1; if (g0 > a0) { a1 = a0; ai1 = ai0; a0 = g0; ai0 = n; } else { a1 = g0; ai1 = n; } } else { a2 = g0; ai2 = n; } }
        if (g1 > c2) { if (g1 > c1) { c2 = c1; ci2 = ci1; if (g1 > c0) { c1 = c0; ci1 = ci0; c0 = g1; ci0 = n; } else { c1 = g1; ci1 = n; } } else { c2 = g1; ci2 = n; } }
    }
    const unsigned nv = own < 3 ? own : 3;
    sel3[(size_t)(tok0 + lane) * 8 + h] = (unsigned)ai0 | ((unsigned)ai1 << 8) | ((unsigned)ai2 << 16) | (nv << 24);
    sel3[(size_t)(tok0 + 64 + lane) * 8 + h] = (unsigned)ci0 | ((unsigned)ci1 << 8) | ((unsigned)ci2 << 16) | (nv << 24);
}

constexpr int HS = 257;
template <int MODE> DI void idx_pass(const bf16* proj, int rowbase, int qt, const bf16x8 (&qf)[4][4], const float (&wj)[4], LAS unsigned* hist, LAS unsigned* mask, LAS unsigned* cmask, LAS unsigned long long* cand, LAS unsigned* rinfo, int wave, int lane) {
    const int q = lane & 31, hi = lane >> 5, nkt = qt + 1, t = qt * 32 + q;
    const unsigned b1 = rinfo[q], thr16 = rinfo[64 + q];
    for (int ch = 0; ch * 8 < nkt; ++ch) { const int kt = ch * 8 + wave; if (kt >= nkt) continue;
        const bf16* kp = proj + (size_t)(rowbase + kt * 32 + q) * EV_N + EC_KI + hi * 8;
        bf16x8 kf[4];
#pragma unroll
        for (int s = 0; s < 4; ++s) kf[s] = *(const bf16x8*)(kp + s * 16);
        f32x16 sc;
#pragma unroll
        for (int r = 0; r < 16; ++r) sc[r] = 0.f;
#pragma unroll
        for (int j = 0; j < 4; ++j) { f32x16 acc;
#pragma unroll
            for (int r = 0; r < 16; ++r) acc[r] = 0.f;
#pragma unroll
            for (int s = 0; s < 4; ++s) acc = mfma32(kf[s], qf[j][s], acc);
#pragma unroll
            for (int r = 0; r < 16; ++r) sc[r] += wj[j] * fmaxf(acc[r], 0.f); }
#pragma unroll
        for (int r = 0; r < 16; ++r) { const int s = kt * 32 + crow(r, hi);
            if (s <= t) { unsigned u = __float_as_uint(sc[r]); if (u == 0x80000000u) u = 0u; const unsigned key = (u >> 31) ? ~u : (u | 0x80000000u);
                if (MODE == 1) __hip_atomic_fetch_add(hist + q * HS + (key >> 24), 1u, __ATOMIC_RELAXED, __HIP_MEMORY_SCOPE_WORKGROUP);
                else if (MODE == 2) { if ((key >> 24) == b1) __hip_atomic_fetch_add(hist + q * HS + ((key >> 16) & 255u), 1u, __ATOMIC_RELAXED, __HIP_MEMORY_SCOPE_WORKGROUP); }
                else { const unsigned k16 = key >> 16;
                    if (k16 > thr16) __hip_atomic_fetch_or(mask + q * HS + (s >> 5), 1u << (s & 31), __ATOMIC_RELAXED, __HIP_MEMORY_SCOPE_WORKGROUP);
                    else if (k16 == thr16) { const unsigned pos = __hip_atomic_fetch_add(rinfo + 128 + q, 1u, __ATOMIC_RELAXED, __HIP_MEMORY_SCOPE_WORKGROUP);
                        __hip_atomic_fetch_or(cmask + q * HS + (s >> 5), 1u << (s & 31), __ATOMIC_RELAXED, __HIP_MEMORY_SCOPE_WORKGROUP);
                        if (pos < 64u) cand[q * 64 + pos] = ((unsigned long long)key << 32) | (unsigned)(~(unsigned)s); } } } }
    }
}
DI void hist_pick(LAS const unsigned* hrow, unsigned need, int lane, unsigned& bin, unsigned& above) {
    unsigned h4[4];
#pragma unroll
    for (int k = 0; k < 4; ++k) h4[k] = hrow[4 * lane + k];
    const unsigned ssum = h4[0] + h4[1] + h4[2] + h4[3];
    unsigned x = ssum;
#pragma unroll
    for (int o = 1; o < 64; o <<= 1) { const unsigned y = __shfl_down(x, o); if (lane + o < 64) x += y; }
    const unsigned long long m = __ballot(x >= need);
    const int Ls = m ? 63 - __builtin_clzll(m) : 0;
    const unsigned xs = __shfl(x, Ls), ss = __shfl(ssum, Ls);
    const unsigned h0 = __shfl(h4[0], Ls), h1 = __shfl(h4[1], Ls), h2 = __shfl(h4[2], Ls), h3 = __shfl(h4[3], Ls);
    unsigned cum = xs - ss;
    if (cum + h3 >= need) { bin = 4 * Ls + 3; above = cum; return; } cum += h3;
    if (cum + h2 >= need) { bin = 4 * Ls + 2; above = cum; return; } cum += h2;
    if (cum + h1 >= need) { bin = 4 * Ls + 1; above = cum; return; } cum += h1;
    bin = 4 * Ls; above = cum; (void)h0;
}
DI void idx_unit(const Fr& F, int b, int qt) {
    const bf16* proj = (const bf16*)(F.ws + WS_PROJ); unsigned short* sel = (unsigned short*)(F.ws + WS_SEL);
    LAS unsigned* hist = (LAS unsigned*)(F.lds); LAS unsigned* mask = hist + 32 * HS; LAS unsigned* cmask = mask + 32 * HS;
    LAS unsigned long long* cand = (LAS unsigned long long*)(F.lds + 99328); LAS unsigned* rinfo = (LAS unsigned*)(F.lds + 115712);
    const int lane = F.lane, wave = F.wave, tid = F.tid, t0 = qt * 32, rowbase = b * SEQ;
    __syncthreads();
    for (int i = tid; i < 3 * 32 * HS; i += NTHR) hist[i] = 0u;
    if (tid < 160) rinfo[tid] = 0u;
    __syncthreads();
    if (t0 + 31 <= 255 || (EXPF & 64)) {
        if (lane < 8) {
#pragma unroll
            for (int rr = 0; rr < 4; ++rr) { const int row = wave * 4 + rr, nv = t0 + row + 1;
                const int nv0 = t0 + row + 1; const int nvc = nv0 < 256 ? nv0 : 256; (void)nv; mask[row * HS + lane] = nvc >= 32 * (lane + 1) ? 0xffffffffu : (nvc > 32 * lane ? ((1u << (nvc - 32 * lane)) - 1u) : 0u); } }
    } else {
        const int q = lane & 31, hi = lane >> 5;
        bf16x8 qf[4][4]; float wj[4];
        { const bf16* qp = proj + (size_t)(rowbase + t0 + q) * EV_N;
#pragma unroll
            for (int j = 0; j < 4; ++j) { wj[j] = bf2f(qp[EC_WI + j]);
#pragma unroll
                for (int s = 0; s < 4; ++s) qf[j][s] = *(const bf16x8*)(qp + EC_QI + j * 64 + s * 16 + hi * 8); } }
        idx_pass<1>(proj, rowbase, qt, qf, wj, hist, mask, cmask, cand, rinfo, wave, lane);
        __syncthreads();
#pragma unroll 1
        for (int rr = 0; rr < 4; ++rr) { const int row = wave * 4 + rr; unsigned bin, above; hist_pick(hist + row * HS, 256u, lane, bin, above);
            if (lane == 0) { rinfo[row] = bin; rinfo[32 + row] = 256u - above; } }
        __syncthreads();
        for (int i = tid; i < 32 * HS; i += NTHR) hist[i] = 0u;
        __syncthreads();
        idx_pass<2>(proj, rowbase, qt, qf, wj, hist, mask, cmask, cand, rinfo, wave, lane);
        __syncthreads();
#pragma unroll 1
        for (int rr = 0; rr < 4; ++rr) { const int row = wave * 4 + rr; const unsigned need1 = rinfo[32 + row]; unsigned bin, above; hist_pick(hist + row * HS, need1, lane, bin, above);
            if (lane == 0) { rinfo[64 + row] = (rinfo[row] << 8) | bin; rinfo[96 + row] = need1 - above; } }
        __syncthreads();
        idx_pass<3>(proj, rowbase, qt, qf, wj, hist, mask, cmask, cand, rinfo, wave, lane);
        __syncthreads();
#pragma unroll 1
        for (int rr = 0; rr < 4; ++rr) { const int row = wave * 4 + rr; const unsigned call = rinfo[128 + row], need2 = rinfo[96 + row];
            if (call <= 64u) { const unsigned c = call;
                const unsigned long long mine = cand[row * 64 + lane]; unsigned rank = 0u;
                for (unsigned k = 0; k < c; ++k) rank += (cand[row * 64 + k] > mine) ? 1u : 0u;
                if ((unsigned)lane < c && rank < need2) { const unsigned s = ~(unsigned)mine;
                    __hip_atomic_fetch_or(mask + row * HS + (s >> 5), 1u << (s & 31), __ATOMIC_RELAXED, __HIP_MEMORY_SCOPE_WORKGROUP); } }
            else { unsigned w4[4];
#pragma unroll
                for (int k = 0; k < 4; ++k) w4[k] = cmask[row * HS + 4 * lane + k];
                const unsigned cnt = __popc(w4[0]) + __popc(w4[1]) + __popc(w4[2]) + __popc(w4[3]);
                unsigned x = cnt;
#pragma unroll
                for (int o = 1; o < 64; o <<= 1) { const unsigned y = __shfl_up(x, o); if (lane >= o) x += y; }
                unsigned before = x - cnt;
#pragma unroll
                for (int k = 0; k < 4; ++k) { unsigned w = w4[k]; const unsigned pc = __popc(w); unsigned take = 0u;
                    if (before < need2) { if (before + pc <= need2) take = w; else { unsigned left = need2 - before; while (left) { const unsigned b = w & (0u - w); take |= b; w ^= b; --left; } } }
                    before += pc;
                    if (take) mask[row * HS + 4 * lane + k] |= take; } }
        }
    }
    __syncthreads();
#pragma unroll 1
    for (int rr = 0; rr < 4; ++rr) { const int row = wave * 4 + rr; unsigned short* out = sel + (size_t)(rowbase + t0 + row) * 256;
        unsigned w4[4];
#pragma unroll
        for (int k = 0; k < 4; ++k) w4[k] = mask[row * HS + 4 * lane + k];
        const unsigned cnt = __popc(w4[0]) + __popc(w4[1]) + __popc(w4[2]) + __popc(w4[3]);
        unsigned x = cnt;
#pragma unroll
        for (int o = 1; o < 64; o <<= 1) { const unsigned y = __shfl_up(x, o); if (lane >= o) x += y; }
        const unsigned total = __shfl(x, 63); unsigned pos = x - cnt;
#pragma unroll
        for (int k = 0; k < 4; ++k) { unsigned w = w4[k]; const unsigned base = (unsigned)(4 * lane + k) * 32u;
            while (w) { const unsigned bit = __builtin_ctz(w); if (pos < 256u) out[pos] = (unsigned short)(base + bit); ++pos; w &= w - 1u; } }
        for (unsigned i = total + lane; i < 256u; i += 64u) out[i] = (unsigned short)0xffffu; }
}

struct AttSt { float m, l; f32x16 o0, o1; };
template <class BF> DI void att_subtile(AttSt& S, const bf16x8 (&qf)[4], LAS const char* Kst, LAS const char* Vb, int vdh, int vrow0, int lane, const BF& bias) {
    const int r32 = lane & 31, hi = lane >> 5;
    f32x16 p;
#pragma unroll
    for (int r = 0; r < 16; ++r) p[r] = 0.f;
    LAS const char* kp = Kst + hi * 512 + r32 * 16;
#pragma unroll
    for (int s = 0; s < 4; ++s) { const bf16x8 kf = *(LAS const bf16x8*)(kp + s * 1024); p = mfma32(kf, qf[s], p); }
    float mx = -INFINITY;
#pragma unroll
    for (int r = 0; r < 16; ++r) { p[r] = bias(p[r], crow(r, hi)); mx = fmaxf(mx, p[r]); }
    mx = fmaxf(mx, __shfl_xor(mx, 32));
    const float mn = fmaxf(S.m, mx), sc = ex2(S.m - mn);
    S.m = mn;
    float ps = 0.f;
#pragma unroll
    for (int r = 0; r < 16; ++r) { p[r] = ex2(p[r] - mn); ps += p[r]; }
    S.l = S.l * sc + ps;
#pragma unroll
    for (int r = 0; r < 16; ++r) { S.o0[r] *= sc; S.o1[r] *= sc; }
    v4u pw0, pw1;
    pw0.x = cvtpk(p[0], p[1]); pw0.y = cvtpk(p[2], p[3]); pw0.z = cvtpk(p[4], p[5]); pw0.w = cvtpk(p[6], p[7]);
    pw1.x = cvtpk(p[8], p[9]); pw1.y = cvtpk(p[10], p[11]); pw1.z = cvtpk(p[12], p[13]); pw1.w = cvtpk(p[14], p[15]);
    const bf16x8 pf0 = __builtin_bit_cast(bf16x8, pw0), pf1 = __builtin_bit_cast(bf16x8, pw1);
    LAS const char* vp = Vb + (vrow0 + 4 * hi + ((lane & 15) >> 2)) * 64 + ((lane >> 4) & 1) * 32 + (lane & 3) * 8;
    { const bf16x8 v00 = cat8(vtr(vp), vtr(vp + 512)), v10 = cat8(vtr(vp + vdh), vtr(vp + vdh + 512));
      const bf16x8 v01 = cat8(vtr(vp + 1024), vtr(vp + 1536)), v11 = cat8(vtr(vp + vdh + 1024), vtr(vp + vdh + 1536));
      S.o0 = mfma32(v00, pf0, S.o0); S.o1 = mfma32(v10, pf0, S.o1);
      S.o0 = mfma32(v01, pf1, S.o0); S.o1 = mfma32(v11, pf1, S.o1); }
}

struct MobaBias { LAS const float* lut; int tq, s0; bool causal;
    DI float operator()(float p, int kvrel) const { const int dist = tq - (s0 + kvrel); const float v = p + lut[dist < 0 ? 0 : (dist > 1023 ? 1023 : dist)]; return (causal && dist < 0) ? -INFINITY : v; } };
DI void moba_tile(const Fr& F, const bf16* proj, int rowbase, int h, int n, int tq, bool valid, int slot, bool own, int wave_tile) {
    LAS const char* Kb = (LAS const char*)F.lds; LAS const char* Vb = (LAS const char*)(F.lds + 32768); LAS const float* lut = (LAS const float*)(F.lds + 98304);
    bf16* po = (bf16*)(F.ws + WS_ACT); float* pml = (float*)(F.ws + WS_PML);
    const int lane = F.lane, hi = lane >> 5;
    bf16x8 qf[4];
    { const bf16* qp = proj + (size_t)(rowbase + tq) * EV_N + EC_QB + h * 64 + hi * 8;
#pragma unroll
        for (int s = 0; s < 4; ++s) qf[s] = *(const bf16x8*)(qp + s * 16); }
    AttSt S; S.m = -1e30f; S.l = 0.f;
#pragma unroll
    for (int r = 0; r < 16; ++r) { S.o0[r] = 0.f; S.o1[r] = 0.f; }
    const int nst = own ? wave_tile + 1 : 8;
    for (int st = 0; st < nst; ++st) { MobaBias bf{lut, tq, n * 256 + st * 32, own && st == wave_tile};
        att_subtile(S, qf, Kb + st * 4096, Vb, 16384, st * 32, lane, bf); }
    const float lt = S.l + __shfl_xor(S.l, 32), inv = 1.f / lt;
    if (valid) { const size_t pi = ((size_t)(rowbase + tq) * 8 + h) * 4 + slot; bf16* o = po + pi * 64;
#pragma unroll
        for (int a4 = 0; a4 < 4; ++a4) { v2u w0, w1;
            w0.x = cvtpk(S.o0[4 * a4] * inv, S.o0[4 * a4 + 1] * inv); w0.y = cvtpk(S.o0[4 * a4 + 2] * inv, S.o0[4 * a4 + 3] * inv);
            w1.x = cvtpk(S.o1[4 * a4] * inv, S.o1[4 * a4 + 1] * inv); w1.y = cvtpk(S.o1[4 * a4 + 2] * inv, S.o1[4 * a4 + 3] * inv);
            *(v2u*)(o + 8 * a4 + 4 * hi) = w0; *(v2u*)(o + 32 + 8 * a4 + 4 * hi) = w1; }
        if (hi == 0) { f32x2 ml = {S.m, lt}; *(f32x2*)(pml + pi * 2) = ml; } }
}
DI void moba_unit(const Args& a, const Fr& F, int b, int h, int n) {
    const bf16* proj = (const bf16*)(F.ws + WS_PROJ); const unsigned* sel3 = (const unsigned*)(F.ws + WS_SEL3);
    LAS unsigned char* lds = F.lds; LAS unsigned* list = (LAS unsigned*)(lds + 65536); LAS float* lut = (LAS float*)(lds + 98304); LAS unsigned* misc = (LAS unsigned*)(lds + 102400);
    const int tid = F.tid, lane = F.lane, wave = F.wave, rowbase = b * SEQ;
    __syncthreads();
    { const bf16* kg = proj + (size_t)(rowbase + n * 256) * EV_N + EC_KB + h * 64; const bf16* vg = proj + (size_t)(rowbase + n * 256) * EV_N + EC_VB + h * 64;
#pragma unroll
        for (int i = 0; i < 4; ++i) { const int p = tid + i * NTHR;
            { const int r = p & 31, c = (p >> 5) & 7, st = p >> 8; const v4u v = *(const v4u*)(kg + (size_t)(st * 32 + r) * EV_N + c * 8); *(LAS v4u*)(lds + st * 4096 + c * 512 + r * 16) = v; }
            { const int cc = p & 3, row = (p >> 2) & 255, dh = p >> 10; const v4u v = *(const v4u*)(vg + (size_t)row * EV_N + dh * 32 + cc * 8); *(LAS v4u*)(lds + 32768 + dh * 16384 + row * 64 + cc * 16) = v; } }
        for (int d = tid; d < 1024; d += NTHR) lut[d] = a.in[9][t5_bucket(d) * 16 + 8 + h] * LOG2E; }
    if (tid == 0) misc[16] = 0u;
    __syncthreads();
    for (int tb = (n + 1) * 256; tb < SEQ; tb += NTHR) { const int t = tb + tid; const bool inr = t < SEQ;
        const unsigned s = inr ? sel3[(size_t)(rowbase + t) * 8 + h] : 0u; const unsigned nv = s >> 24; int slot = -1;
        if (nv > 0u && (s & 255u) == (unsigned)n) slot = 0; else if (nv > 1u && ((s >> 8) & 255u) == (unsigned)n) slot = 1; else if (nv > 2u && ((s >> 16) & 255u) == (unsigned)n) slot = 2;
        const unsigned long long bal = __ballot(slot >= 0); const unsigned wcnt = __popcll(bal);
        if (lane == 0) misc[wave] = wcnt;
        __syncthreads();
        unsigned off = misc[16], tot = 0u;
#pragma unroll
        for (int w = 0; w < 8; ++w) { const unsigned c = misc[w]; if (w < wave) off += c; tot += c; }
        if (slot >= 0) list[off + __popcll(bal & ((1ull << lane) - 1ull))] = ((unsigned)t << 2) | (unsigned)slot;
        __syncthreads();
        if (tid == 0) misc[16] += tot; }
    __syncthreads();
    const int nlist = (int)misc[16];
    moba_tile(F, proj, rowbase, h, n, n * 256 + wave * 32 + (lane & 31), true, 3, true, wave);
    const int ntl = (nlist + 31) >> 5;
    for (int tl = wave; tl < ntl; tl += 8) { const int li = tl * 32 + (lane & 31); const bool valid = li < nlist; const unsigned e = list[valid ? li : nlist - 1];
        moba_tile(F, proj, rowbase, h, n, (int)(e >> 2), valid, (int)(e & 3u), false, 0); }
}

DI void dsa_query(const Fr& F, int tok, LAS unsigned char* wl, LAS const unsigned char* bkt, LAS const float* tab) {
    const bf16* ql = (const bf16*)(F.ws + WS_QL); const bf16* ckvn = (const bf16*)(F.ws + WS_CKVN); const unsigned short* sel = (const unsigned short*)(F.ws + WS_SEL); bf16* ol = (bf16*)(F.ws + WS_OL);
    const int lane = F.lane, l15 = lane & 15, kg = lane >> 4, t = tok % SEQ, rowbase = tok - t;
    LAS unsigned short* selb = (LAS unsigned short*)wl; LAS unsigned char* cbuf = wl + 1024;
    *((LAS v2u*)selb + lane) = *((const v2u*)(sel + (size_t)tok * 256) + lane);
    bf16x8 qlf[4];
#pragma unroll
    for (int ks = 0; ks < 4; ++ks) { qlf[ks] = *(const bf16x8*)(ql + (size_t)tok * 1024 + (l15 & 7) * 128 + ks * 32 + kg * 8); if (l15 >= 8) qlf[ks] = (bf16x8){0, 0, 0, 0, 0, 0, 0, 0}; }
    float m = -1e30f, l = 0.f; f32x4 oT[8];
#pragma unroll
    for (int ct = 0; ct < 8; ++ct) oT[ct] = (f32x4){0.f, 0.f, 0.f, 0.f};
    const int nvalid = t + 1 < 256 ? t + 1 : 256, nch = (nvalid + 31) >> 5;
    LDS_WAIT();
    for (int ch = 0; ch < nch; ++ch) {
        bf16x8 af[2][4];
#pragma unroll
        for (int mt = 0; mt < 2; ++mt) { unsigned idx = selb[ch * 32 + mt * 16 + l15]; if (idx == 0xffffu) idx = 0u;
            const bf16* cp = ckvn + (size_t)(rowbase + (int)idx) * 128 + kg * 8;
#pragma unroll
            for (int ks = 0; ks < 4; ++ks) af[mt][ks] = *(const bf16x8*)(cp + ks * 32); }
        f32x4 acc[2];
#pragma unroll
        for (int mt = 0; mt < 2; ++mt) { acc[mt] = (f32x4){0.f, 0.f, 0.f, 0.f};
#pragma unroll
            for (int ks = 0; ks < 4; ++ks) { acc[mt] = mfma16(af[mt][ks], qlf[ks], acc[mt]); *(LAS bf16x8*)(cbuf + (mt * 16 + l15) * 288 + (ks * 32 + kg * 8) * 2) = af[mt][ks]; } }
        float mx = -INFINITY;
#pragma unroll
        for (int mt = 0; mt < 2; ++mt)
#pragma unroll
            for (int i = 0; i < 4; ++i) { const unsigned s = selb[ch * 32 + mt * 16 + 4 * kg + i]; const int dist = t - (int)s;
                const bool ok = (s != 0xffffu) && dist >= 0; const int dc = ok ? (dist > 1023 ? 1023 : dist) : 0;
                const float v = ok ? acc[mt][i] + tab[(int)bkt[dc] * 8 + (l15 & 7)] : -INFINITY; acc[mt][i] = v; mx = fmaxf(mx, v); }
        mx = fmaxf(mx, __shfl_xor(mx, 16)); mx = fmaxf(mx, __shfl_xor(mx, 32));
        const float mn = fmaxf(m, mx), sc = ex2(m - mn); m = mn;
        float ps = 0.f;
#pragma unroll
        for (int mt = 0; mt < 2; ++mt)
#pragma unroll
            for (int i = 0; i < 4; ++i) { acc[mt][i] = ex2(acc[mt][i] - mn); ps += acc[mt][i]; }
        l = l * sc + ps;
#pragma unroll
        for (int ct = 0; ct < 8; ++ct) oT[ct] = oT[ct] * sc;
        v4u pw; pw.x = cvtpk(acc[0][0], acc[0][1]); pw.y = cvtpk(acc[0][2], acc[0][3]); pw.z = cvtpk(acc[1][0], acc[1][1]); pw.w = cvtpk(acc[1][2], acc[1][3]);
        const bf16x8 pf = __builtin_bit_cast(bf16x8, pw);
        LDS_WAIT();
        LAS const char* tp = (LAS const char*)cbuf + (4 * kg + (l15 >> 2)) * 288 + (lane & 3) * 8;
#pragma unroll
        for (int ct = 0; ct < 8; ++ct) { const bf16x8 cf = cat8(vtr(tp + ct * 32), vtr(tp + 16 * 288 + ct * 32)); oT[ct] = mfma16(cf, pf, oT[ct]); }
        LDS_WAIT();
    }
    l += __shfl_xor(l, 16); l += __shfl_xor(l, 32);
    const float inv = 1.f / l;
    if (l15 < 8) { bf16* o = ol + (size_t)tok * 1024 + l15 * 128 + 4 * kg;
#pragma unroll
        for (int ct = 0; ct < 8; ++ct) { v2u w; w.x = cvtpk(oT[ct][0] * inv, oT[ct][1] * inv); w.y = cvtpk(oT[ct][2] * inv, oT[ct][3] * inv); *(v2u*)(o + ct * 16) = w; } }
}
DI void dsa_chunk(const Args& a, const Fr& F, int c32) {
    LAS unsigned char* bkt = F.lds + 81920; LAS float* tab = (LAS float*)(F.lds + 82944);
    __syncthreads();
    for (int d = F.tid; d < 1024; d += NTHR) bkt[d] = (unsigned char)t5_bucket(d);
    if (F.tid < 256) tab[F.tid] = a.in[9][(F.tid >> 3) * 16 + (F.tid & 7)] * LOG2E;
    __syncthreads();
#pragma unroll 1
    for (int i = 0; i < 4; ++i) dsa_query(F, c32 * 32 + F.wave * 4 + i, F.lds + F.wave * 10240, bkt, tab);
}

DI void ph_even_post(const Fr& F, int j) {
    const bf16* ol = (const bf16*)(F.ws + WS_OL); bf16* ao = (bf16*)(F.ws + WS_AO);
    const bf16* wuvt = (const bf16*)(F.ws + WS_WUVT) + (size_t)j * 8 * 64 * 128;
    const bf16* po = (const bf16*)(F.ws + WS_ACT); const float* pml = (const float*)(F.ws + WS_PML); const unsigned* sel3 = (const unsigned*)(F.ws + WS_SEL3);
    const int lane = F.lane, wave = F.wave, l15 = lane & 15, kg = lane >> 4;
    for (int chunk = F.blk; chunk < 256; chunk += F.G) { const int tok0 = chunk * 128;
        { const int h = wave; bf16x8 af[4][4];
#pragma unroll
            for (int mt = 0; mt < 4; ++mt)
#pragma unroll
                for (int ks = 0; ks < 4; ++ks) af[mt][ks] = *(const bf16x8*)(wuvt + ((size_t)h * 64 + mt * 16 + l15) * 128 + ks * 32 + kg * 8);
            for (int tg = 0; tg < 8; ++tg) { const int tok = tok0 + tg * 16 + l15; bf16x8 bf[4];
#pragma unroll
                for (int ks = 0; ks < 4; ++ks) bf[ks] = *(const bf16x8*)(ol + (size_t)tok * 1024 + h * 128 + ks * 32 + kg * 8);
#pragma unroll
                for (int mt = 0; mt < 4; ++mt) { f32x4 d = {0.f, 0.f, 0.f, 0.f};
#pragma unroll
                    for (int ks = 0; ks < 4; ++ks) d = mfma16(af[mt][ks], bf[ks], d);
                    v2u w; w.x = cvtpk(d[0], d[1]); w.y = cvtpk(d[2], d[3]); *(v2u*)(ao + (size_t)tok * 1024 + h * 64 + mt * 16 + 4 * kg) = w; } } }
        if (!(EXPF & 32)) for (int i = 0; i < 16; ++i) { const int tok = tok0 + wave * 16 + i, h = lane >> 3, d0 = (lane & 7) * 8;
            const unsigned nv = sel3[(size_t)tok * 8 + h] >> 24; const size_t pi = ((size_t)tok * 8 + h) * 4;
            float mj[4], lj[4];
#pragma unroll
            for (int s = 0; s < 4; ++s) { const bool ok = (s == 3) || ((unsigned)s < nv); const f32x2 ml = *(const f32x2*)(pml + (pi + s) * 2); mj[s] = ok ? ml[0] : -1e30f; lj[s] = ok ? ml[1] : 0.f; }
            const float ms = fmaxf(fmaxf(mj[0], mj[1]), fmaxf(mj[2], mj[3])); float wsum = 0.f, acc[8];
#pragma unroll
            for (int k = 0; k < 8; ++k) acc[k] = 0.f;
#pragma unroll
            for (int s = 0; s < 4; ++s) { const float w = lj[s] * ex2(mj[s] - ms); wsum += w;
                if (w > 0.f) { const v4u v = *(const v4u*)(po + (pi + s) * 64 + d0);
#pragma unroll
                    for (int k = 0; k < 4; ++k) { acc[2 * k] += w * bf2f(v[k] & 0xffffu); acc[2 * k + 1] += w * bf2f(v[k] >> 16); } } }
            const float inv = 1.f / wsum; v4u o; o.x = cvtpk(acc[0] * inv, acc[1] * inv); o.y = cvtpk(acc[2] * inv, acc[3] * inv); o.z = cvtpk(acc[4] * inv, acc[5] * inv); o.w = cvtpk(acc[6] * inv, acc[7] * inv);
            *(v4u*)(ao + (size_t)tok * 1024 + 512 + h * 64 + d0) = o; }
    }
}
DI f32x16 proj32_f32(const float* W, int ldw, int ncols, const float* xrow, int d_lo, int lane) {
    const int e = lane & 31, kh = lane >> 5; const bool ev = e < ncols;
    f32x16 D;
#pragma unroll
    for (int r = 0; r < 16; ++r) D[r] = 0.f;
    const float* wp = W + (size_t)(d_lo + 4 * kh) * ldw + (ev ? e : 0);
    const float* xp = xrow + d_lo + 4 * kh;
#pragma unroll 4
    for (int i = 0; i < 64; ++i) { const f32x4 xv = *(const f32x4*)(xp + 8 * i);
        float a0 = wp[(size_t)(8 * i + 0) * ldw], a1 = wp[(size_t)(8 * i + 1) * ldw], a2 = wp[(size_t)(8 * i + 2) * ldw], a3 = wp[(size_t)(8 * i + 3) * ldw];
        if (!ev) { a0 = 0.f; a1 = 0.f; a2 = 0.f; a3 = 0.f; }
        D = __builtin_amdgcn_mfma_f32_32x32x2f32(a0, xv[0], D, 0, 0, 0); D = __builtin_amdgcn_mfma_f32_32x32x2f32(a1, xv[1], D, 0, 0, 0);
        D = __builtin_amdgcn_mfma_f32_32x32x2f32(a2, xv[2], D, 0, 0, 0); D = __builtin_amdgcn_mfma_f32_32x32x2f32(a3, xv[3], D, 0, 0, 0); }
    return D;
}
DI void ph_odd_prep(const Args& a, const Fr& F, int j, int layer) {
    const bf16* proj = (const bf16*)(F.ws + WS_PROJ); const float* x = (const float*)(F.ws + WS_X);
    float* logf = (float*)(F.ws + WS_LOGF); float* cs = (float*)(F.ws + WS_CS);
    const float* wf = a.in[6] + (size_t)j * 1024 * 3088 + 3072; const float* bfv = a.in[7] + j * 16;
    LAS float* red = (LAS float*)(F.lds); LAS float* lfb = (LAS float*)(F.lds + 131072);
    LAS unsigned* kmx = (LAS unsigned*)(F.lds + 131072 + 8192);
    const int lane = F.lane, wave = F.wave, tid = F.tid, l31 = lane & 31, hi = lane >> 5;
    for (int chunk = F.blk; chunk < 256; chunk += F.G) { const int tok0 = chunk * 128, b = tok0 / SEQ, t0 = tok0 % SEQ;
        __syncthreads();
        if (tid < 16) kmx[tid] = 0u;
        const int tl = wave & 3, kr = wave >> 2;
        f32x16 D = proj32_f32(wf, 3088, 16, x + (size_t)(tok0 + tl * 32 + l31) * DM, kr * 512, lane);
        if (kr == 1) {
#pragma unroll
            for (int r = 0; r < 8; ++r) red[(tl * 8 + r) * 64 + lane] = D[r]; }
        __syncthreads();
        if (kr == 0) {
#pragma unroll
            for (int r = 0; r < 8; ++r) { const int h = (r & 3) + 8 * (r >> 2) + 4 * hi; const float z = D[r] + red[(tl * 8 + r) * 64 + lane] + bfv[h];
                const float ls = fminf(z, 0.f) - log1pf(__expf(-fabsf(z)));
                lfb[(tl * 32 + l31) * 16 + h] = ls * LOG2E; } }
#pragma unroll 1
        for (int i = 0; i < 4; ++i) { const int p = tid + i * NTHR, tk = p >> 4, h = p & 15; const v4u* kp = (const v4u*)(proj + (size_t)(tok0 + tk) * OD_N + OC_K + h * 64); float s = 0.f;
#pragma unroll
            for (int c = 0; c < 8; ++c) { const v4u w = kp[c];
#pragma unroll
                for (int k = 0; k < 4; ++k) { const float e0 = bf2f(w[k] & 0xffffu), e1 = bf2f(w[k] >> 16); s += e0 * e0 + e1 * e1; } }
            __hip_atomic_fetch_max(kmx + h, __float_as_uint(s), __ATOMIC_RELAXED, __HIP_MEMORY_SCOPE_WORKGROUP); }
        __syncthreads();
        for (int i = tid; i < 2048; i += NTHR) { const int h = i >> 7, tk = i & 127; logf[((size_t)b * 16 + h) * SEQ + t0 + tk] = lfb[tk * 16 + h]; }
        if (tid < 32) { const int h = tid & 15, c = tid >> 4; float s = 0.f;
            for (int k = 0; k < 64; ++k) s += lfb[(c * 64 + k) * 16 + h];
            cs[((size_t)b * 16 + h) * 128 + (t0 >> 6) + c] = s; }
        if (tid < 16) __hip_atomic_fetch_max(F.ctl + CW_KMAX + layer * 64 + b * 16 + tid, kmx[tid], RLX_AGENT);
    }
}

struct FoxBias { LAS const float* ng; int tq, kabs0; bool diag;
    DI float operator()(float p, int kvrel) const { const float v = p + ng[kvrel]; return (diag && (kabs0 + kvrel) > tq) ? -INFINITY : v; } };
DI void fox_unit(const Fr& F, int layer, int b, int h, int qb) {
    const bf16* proj = (const bf16*)(F.ws + WS_PROJ); const float* logf = (const float*)(F.ws + WS_LOGF); const float* cs = (const float*)(F.ws + WS_CS); bf16* ao = (bf16*)(F.ws + WS_AO);
    LAS unsigned char* lds = F.lds; LAS float* ng = (LAS float*)(lds + 32768); LAS float* red = (LAS float*)(lds + 65536 + 1024); LAS int* ibox = (LAS int*)(lds + 65536 + 2048);
    const int tid = F.tid, lane = F.lane, wave = F.wave, r32 = lane & 31, hi = lane >> 5, t0 = qb * 256, rowbase = b * SEQ, tq = t0 + wave * 32 + r32;
    __syncthreads();
    bf16x8 qf[4]; float qs = 0.f;
    { const bf16* qp = proj + (size_t)(rowbase + tq) * OD_N + OC_Q + h * 64 + hi * 8;
#pragma unroll
        for (int s = 0; s < 4; ++s) { qf[s] = *(const bf16x8*)(qp + s * 16);
#pragma unroll
            for (int k = 0; k < 8; ++k) { const float e = bf2f((unsigned short)qf[s][k]); qs += e * e; } } }
    qs += __shfl_xor(qs, 32); qs = wave_max(qs);
    if (lane == 0) red[wave] = qs;
    __syncthreads();
    if (tid == 0) { float qm = red[0];
        for (int w = 1; w < 8; ++w) qm = fmaxf(qm, red[w]);
        const float km = __uint_as_float(ld_u32(F.ctl + CW_KMAX + layer * 64 + b * 16 + h));
        const float B2 = 2.f * (sqrtf(qm * km) * 1.01f + 1.f);
        int kt = t0 / 64 - 1, kts = t0 / 64; float D = 0.f;
        while (kt >= 0 && B2 + D >= -160.f) { kts = kt; D += cs[((size_t)b * 16 + h) * 128 + kt]; --kt; }
        ibox[0] = kts; }
    __syncthreads();
    const int kts = ibox[0], s_start = kts * 64, nel = t0 + 256 - s_start;
    { const int i0 = tid * 16; float v[16]; const float* lp = logf + ((size_t)b * 16 + h) * SEQ + s_start + i0;
        if (i0 < nel) {
#pragma unroll
            for (int c = 0; c < 4; ++c) { const f32x4 w = *(const f32x4*)(lp + 4 * c); v[4 * c] = w[0]; v[4 * c + 1] = w[1]; v[4 * c + 2] = w[2]; v[4 * c + 3] = w[3]; } }
        else {
#pragma unroll
            for (int c = 0; c < 16; ++c) v[c] = 0.f; }
#pragma unroll
        for (int c = 1; c < 16; ++c) v[c] += v[c - 1];
        float xsum = v[15];
#pragma unroll
        for (int o = 1; o < 64; o <<= 1) { const float y = __shfl_up(xsum, o); if (lane >= o) xsum += y; }
        if (lane == 63) red[16 + wave] = xsum;
        __syncthreads();
        float off = xsum - v[15];
        for (int w = 0; w < wave; ++w) off += red[16 + w];
        if (i0 < nel) {
#pragma unroll
            for (int c = 0; c < 4; ++c) { f32x4 w = {-(off + v[4 * c]), -(off + v[4 * c + 1]), -(off + v[4 * c + 2]), -(off + v[4 * c + 3])}; *(LAS f32x4*)(ng + i0 + 4 * c) = w; } }
    }
    const int ntile = t0 / 64 + 4 - kts;
    const bf16* kg = proj + (size_t)rowbase * OD_N + OC_K + h * 64; const bf16* vg = proj + (size_t)rowbase * OD_N + OC_V + h * 64;
    const int kr = tid & 31, kc = (tid >> 5) & 7, kst = tid >> 8, vcc = tid & 3, vrow = (tid >> 2) & 63, vdh = tid >> 8;
    const int koff = kst * 4096 + kc * 512 + kr * 16, voff = 8192 + vdh * 4096 + vrow * 64 + vcc * 16;
    { const v4u kv = *(const v4u*)(kg + (size_t)(kts * 64 + kst * 32 + kr) * OD_N + kc * 8), vv = *(const v4u*)(vg + (size_t)(kts * 64 + vrow) * OD_N + vdh * 32 + vcc * 8);
        *(LAS v4u*)(lds + koff) = kv; *(LAS v4u*)(lds + voff) = vv; }
    __syncthreads();
    AttSt S; S.m = -1e30f; S.l = 0.f;
#pragma unroll
    for (int r = 0; r < 16; ++r) { S.o0[r] = 0.f; S.o1[r] = 0.f; }
    const int wlast = t0 + wave * 32 + 31, wfirst = t0 + wave * 32;
    for (int i = 0; i < ntile; ++i) { const int kt = kts + i; LAS unsigned char* buf = lds + (i & 1) * 16384; LAS unsigned char* nbuf = lds + ((i + 1) & 1) * 16384;
        v4u kv, vv; const bool more = i + 1 < ntile;
        if (more) { kv = *(const v4u*)(kg + (size_t)((kt + 1) * 64 + kst * 32 + kr) * OD_N + kc * 8); vv = *(const v4u*)(vg + (size_t)((kt + 1) * 64 + vrow) * OD_N + vdh * 32 + vcc * 8); }
#pragma unroll
        for (int sub = 0; sub < 2; ++sub) { const int kv0 = kt * 64 + sub * 32;
            if (kv0 <= wlast) { FoxBias bf{ng + (kv0 - s_start), tq, kv0, kv0 + 31 > wfirst};
                att_subtile(S, qf, (LAS const char*)buf + sub * 4096, (LAS const char*)buf + 8192, 4096, sub * 32, lane, bf); } }
        if (more) { *(LAS v4u*)(nbuf + koff) = kv; *(LAS v4u*)(nbuf + voff - 8192 + 8192) = vv; }
        __syncthreads(); }
    const float lt = S.l + __shfl_xor(S.l, 32), inv = 1.f / lt;
    bf16* o = ao + (size_t)(rowbase + tq) * 1024 + h * 64;
#pragma unroll
    for (int a4 = 0; a4 < 4; ++a4) { v2u w0, w1;
        w0.x = cvtpk(S.o0[4 * a4] * inv, S.o0[4 * a4 + 1] * inv); w0.y = cvtpk(S.o0[4 * a4 + 2] * inv, S.o0[4 * a4 + 3] * inv);
        w1.x = cvtpk(S.o1[4 * a4] * inv, S.o1[4 * a4 + 1] * inv); w1.y = cvtpk(S.o1[4 * a4 + 2] * inv, S.o1[4 * a4 + 3] * inv);
        *(v2u*)(o + 8 * a4 + 4 * hi) = w0; *(v2u*)(o + 32 + 8 * a4 + 4 * hi) = w1; }
}

DI void ph_ln1_router(const Args& a, const Fr& F, int layer) {
    const float* yp = (const float*)(F.ws + WS_YP); float* x1 = (float*)(F.ws + WS_X1); unsigned char* xb8 = F.ws + WS_XB8;
    unsigned* tope = (unsigned*)(F.ws + WS_TOPE); float* gate = (float*)(F.ws + WS_GATE); unsigned* rank = (unsigned*)(F.ws + WS_RANK);
    const float* g = a.in[10] + (size_t)(layer * 2) * DM; const float* bb = a.in[11] + (size_t)(layer * 2) * DM;
    const float* rw = a.in[12] + (size_t)layer * 1024 * 32; const float* rb = a.in[13] + layer * 32;
    LAS float* red = (LAS float*)(F.lds); LAS unsigned* lcnt = (LAS unsigned*)(F.lds + 131072);
    const int lane = F.lane, wave = F.wave, tid = F.tid, l31 = lane & 31, hi = lane >> 5;
    for (int chunk = F.blk; chunk < 256; chunk += F.G) { const int tok0 = chunk * 128;
        __syncthreads();
        if (tid < 32) lcnt[tid] = 0u;
#pragma unroll 1
        for (int k = 0; k < 16; ++k) { const int tok = tok0 + wave * 16 + k; f32x4 v[4];
#pragma unroll
            for (int jj = 0; jj < 4; ++jj) v[jj] = *((const f32x4*)(yp + (size_t)tok * DM) + lane + 64 * jj);
            ln_row(v, g, bb, lane);
            store_row_f32(x1 + (size_t)tok * DM, v, lane);
#pragma unroll
            for (int jj = 0; jj < 4; ++jj) *((unsigned*)(xb8 + (size_t)tok * DM) + lane + 64 * jj) = pk4_fp8(v[jj][0] * F8_SX, v[jj][1] * F8_SX, v[jj][2] * F8_SX, v[jj][3] * F8_SX); }
        asm volatile("s_waitcnt vmcnt(0)" ::: "memory");
        __syncthreads();
        const int tl = wave & 3, kr = wave >> 2, tokl = tok0 + tl * 32 + l31;
        f32x16 D = proj32_f32(rw, 32, 32, x1 + (size_t)tokl * DM, kr * 512, lane);
        if (kr == 1) {
#pragma unroll
            for (int r = 0; r < 16; ++r) red[(tl * 16 + r) * 64 + lane] = D[r]; }
        __syncthreads();
        if (kr == 0) {
            float lv[32];
#pragma unroll
            for (int r = 0; r < 16; ++r) { const float own = D[r] + red[(tl * 16 + r) * 64 + lane] + rb[crow(r, hi)]; const float oth = __shfl_xor(own, 32);
                lv[crow(r, 0)] = hi == 0 ? own : oth; lv[crow(r, 1)] = hi == 0 ? oth : own; }
            float tv[4]; int te[4];
#pragma unroll
            for (int r = 0; r < 4; ++r) { float mx = -INFINITY; int me = 0;
#pragma unroll
                for (int e = 0; e < 32; ++e) { if (lv[e] > mx) { mx = lv[e]; me = e; } }
                tv[r] = mx; te[r] = me;
#pragma unroll
                for (int e = 0; e < 32; ++e) { if (e == me) lv[e] = -INFINITY; } }
            const float e1 = __expf(tv[1] - tv[0]), e2 = __expf(tv[2] - tv[0]), e3 = __expf(tv[3] - tv[0]); const float inv = 1.f / (1.f + e1 + e2 + e3);
            if (hi == 0) { const size_t o = (size_t)tokl * 4;
                const float gv[4] = {inv, e1 * inv, e2 * inv, e3 * inv};
#pragma unroll
                for (int r = 0; r < 4; ++r) { const unsigned rk = __hip_atomic_fetch_add(lcnt + (te[r] & 31), 1u, __ATOMIC_RELAXED, __HIP_MEMORY_SCOPE_WORKGROUP);
                    tope[o + r] = (unsigned)(te[r] & 31); gate[o + r] = gv[r]; rank[o + r] = rk; } } }
        __syncthreads();
        if (tid < 32) __hip_atomic_store(F.ctl + CW_CNT + chunk * 32 + tid, lcnt[tid], RLX_AGENT);
    }
}

DI void ph_route(const Fr& F) {
    const unsigned char* xb8 = F.ws + WS_XB8; unsigned char* xg = F.ws + WS_XG;
    const unsigned* tope = (const unsigned*)(F.ws + WS_TOPE); const unsigned* rank = (const unsigned*)(F.ws + WS_RANK); unsigned* dest = (unsigned*)(F.ws + WS_DEST);
    LAS unsigned* P = (LAS unsigned*)(F.lds); LAS unsigned* pst = P + 512; LAS unsigned* pad = P + 544; LAS unsigned* base = P + 576; LAS unsigned* nt = P + 608;
    const int tid = F.tid, lane = F.lane, wave = F.wave;
    __syncthreads();
    { const int e = tid & 31, part = tid >> 5; unsigned s = 0u;
        for (int c = 0; c < 16; ++c) s += ld_u32(F.ctl + CW_CNT + (part * 16 + c) * 32 + e);
        P[part * 32 + e] = s; }
    __syncthreads();
    if (tid < 32) { unsigned tot = 0u;
        for (int p = 0; p < 16; ++p) tot += P[p * 32 + tid];
        pad[tid] = (tot + 255u) & ~255u; }
    __syncthreads();
    if (tid == 0) { unsigned acc = 0u;
        for (int e = 0; e < 32; ++e) { pst[e] = acc; acc += pad[e]; }
        nt[0] = acc >> 8; }
    __syncthreads();
    for (int chunk = F.blk; chunk < 256; chunk += F.G) {
        __syncthreads();
        if (tid < 32) { unsigned off = 0u; const int pf = chunk >> 4;
            for (int p = 0; p < pf; ++p) off += P[p * 32 + tid];
            for (int c = pf * 16; c < chunk; ++c) off += ld_u32(F.ctl + CW_CNT + c * 32 + tid);
            base[tid] = pst[tid] + off; }
        __syncthreads();
        for (int i = 0; i < 16; ++i) { const int tok = chunk * 128 + wave * 16 + i;
            const v4u src0 = *((const v4u*)(xb8 + (size_t)tok * DM) + lane);
#pragma unroll
            for (int k = 0; k < 4; ++k) { const unsigned e = tope[(size_t)tok * 4 + k], d = base[e] + rank[(size_t)tok * 4 + k];
                if (lane == 0) dest[(size_t)tok * 4 + k] = d;
                *((v4u*)(xg + (size_t)d * DM) + lane) = src0; } }
        if (chunk == 0) { const unsigned ntl = nt[0];
            if (tid == 0) __hip_atomic_store(F.ctl + CW_TILE, ntl, RLX_AGENT);
            for (unsigned i = tid; i < ntl; i += NTHR) { unsigned e = 0u;
                for (unsigned k = 1; k < 32; ++k) if (pst[k] <= i * 256u) e = k;
                __hip_atomic_store(F.ctl + CW_TILE + 64 + i, e, RLX_AGENT); } }
    }
}

DI void ph_combine_ln2(const Args& a, const Fr& F, int layer) {
    const float* x1 = (const float*)(F.ws + WS_X1); const bf16* yr = (const bf16*)(F.ws + WS_XG); float* xo = (float*)(F.ws + WS_X); bf16* xb = (bf16*)(F.ws + WS_XB);
    const float* gate = (const float*)(F.ws + WS_GATE); const unsigned* dest = (const unsigned*)(F.ws + WS_DEST);
    const float* g = a.in[10] + (size_t)(layer * 2 + 1) * DM; const float* bb = a.in[11] + (size_t)(layer * 2 + 1) * DM;
    const int lane = F.lane; const int gw = F.blk * NWAVES + F.wave, NGW = F.G * NWAVES;
    for (int tok = gw; tok < NTOK; tok += NGW) { f32x4 v[4];
#pragma unroll
        for (int jj = 0; jj < 4; ++jj) v[jj] = *((const f32x4*)(x1 + (size_t)tok * DM) + lane + 64 * jj) * ALPHA;
#pragma unroll
        for (int k = 0; k < 4; ++k) { const float gk = gate[(size_t)tok * 4 + k]; const unsigned d = dest[(size_t)tok * 4 + k];
#pragma unroll
            for (int jj = 0; jj < 4; ++jj) { const v2u w = *((const v2u*)(yr + (size_t)d * DM) + lane + 64 * jj);
                v[jj][0] += gk * bf2f(w.x & 0xffffu); v[jj][1] += gk * bf2f(w.x >> 16); v[jj][2] += gk * bf2f(w.y & 0xffffu); v[jj][3] += gk * bf2f(w.y >> 16); } }
        ln_row(v, g, bb, lane);
        if (layer == DEPTH - 1) store_row_f32(a.out + (size_t)tok * DM, v, lane);
        else { store_row_f32(xo + (size_t)tok * DM, v, lane); store_row_bf16(xb + (size_t)tok * DM, v, lane); } }
}
constexpr int LDS_BYTES = 147456;
constexpr int LDS_BARW = 145408, LDS_QSLOT = 145472;
constexpr int NPL = 11;
constexpr int NPHASE = 1 + NPL * DEPTH;
#ifndef MK_SINGLE
#define MK_SINGLE 1
#endif
DI int q_next(const Fr& F, unsigned* ctr) {
    LAS int* slot = (LAS int*)(F.lds + LDS_QSLOT);
    __syncthreads();
    if (F.tid == 0) *slot = (int)__hip_atomic_fetch_add(ctr, 1u, RLX_AGENT);
    __syncthreads();
    return *slot;
}
DI int lane_id_fresh() { unsigned m_ = ~0u; asm volatile("" : "+s"(m_)); return (int)__builtin_amdgcn_mbcnt_hi(m_, __builtin_amdgcn_mbcnt_lo(m_, 0u)); }
#define RETID(F) do { int t2_ = F.tid; asm volatile("" : "+v"(t2_)); F.tid = t2_; F.lane = t2_ & 63; F.wave = __builtin_amdgcn_readfirstlane(t2_ >> 6); } while (0)
#ifndef PROBE_DUP
#define PROBE_DUP -1
#endif
#define NREP(q) ((PROBE_DUP == (q)) ? 2 : 1)
#define AS4 __attribute__((address_space(4)))
#define SITE() Args a; Fr F; { const AS4 Args* ap = (const AS4 Args*)__builtin_amdgcn_kernarg_segment_ptr(); asm volatile("" : "+s"(ap)); \
        _Pragma("unroll") for (int i_ = 0; i_ < 18; ++i_) a.in[i_] = ap->in[i_]; a.out = ap->out; a.ws = ap->ws; a.ph_lo = 0; a.ph_hi = 0; \
        int w_ = wv_s; asm volatile("" : "+s"(w_)); int t_ = w_ * 64 + lane_id_fresh(); asm volatile("" : "+v"(t_)); F.tid = t_; F.lane = t_ & 63; F.wave = __builtin_amdgcn_readfirstlane(t_ >> 6); \
        F.lds = (LAS unsigned char*)lds_raw; F.ws = a.ws; F.ctl = (unsigned*)(a.ws + WS_CTL); F.blk = blockIdx.x; F.G = gridDim.x; }
__global__ void __launch_bounds__(NTHR, 2) mega_fwd(Args a0) {
    extern __shared__ __attribute__((aligned(16))) unsigned char lds_raw[];
    const int wv_s = __builtin_amdgcn_readfirstlane((int)(threadIdx.x >> 6));
#if MK_SINGLE
    constexpr int lo = 0, hi = NPHASE; constexpr bool single = true;
#else
    const int lo = a0.ph_lo, hi = a0.ph_hi; constexpr bool single = false;
#endif
    if (threadIdx.x == 0) *(LAS v4u*)((LAS unsigned char*)lds_raw + LDS_BARW) = (v4u){0u, 0u, 0u, 0u};
    __syncthreads();
    if (single) (void)xcd_barrier_post((unsigned*)(a0.ws + WS_CTL) + CW_BAR, (volatile LAS unsigned*)((LAS unsigned char*)lds_raw + LDS_BARW));
#define IN(k) (lo <= (k) && (k) < hi)
#define SEAM() do { if (single) { const AS4 Args* ap_ = (const AS4 Args*)__builtin_amdgcn_kernarg_segment_ptr(); asm volatile("" : "+s"(ap_)); int w_ = wv_s; asm volatile("" : "+s"(w_)); \
        XcdBarrier b_; b_.bar = (unsigned*)(ap_->ws + WS_CTL) + CW_BAR; b_.x = xb_xcc_id(); b_.st = (volatile LAS unsigned*)((LAS unsigned char*)lds_raw + LDS_BARW); \
        xcd_barrier(b_, (w_ == 0) && (lane_id_fresh() == 0)); } } while (0)
    if (IN(0)) { _Pragma("unroll 1") for (int rep = 0; rep < NREP(100); ++rep) { { SITE(); ph_prologue(a, F); } SEAM(); } }
#pragma unroll 1
    for (int L = 0; L < DEPTH; ++L) {
        const int pb = 1 + NPL * L, j = L >> 1; const bool odd = (L & 1) != 0;
        if (IN(pb + 0)) _Pragma("unroll 1") for (int rep = 0; rep < NREP(0); ++rep) {
            { SITE();
            const bf16* w = odd ? (const bf16*)(F.ws + WS_WOD) + (size_t)j * OD_N * 1024 : (const bf16*)(F.ws + WS_WEV) + (size_t)j * EV_N * 1024;
            const int N = odd ? OD_N : EV_N;
            pg8::Gemm g{(const bf16*)(F.ws + WS_XB), w, NTOK, N, 1024}; pg8::StaticOrder S; S.init(NTOK, N, F.G, F.blk);
            pg8::EpiBf16<0> E{(bf16*)(F.ws + WS_PROJ), N, nullptr, 1024, (size_t)1024, C2F};
            pg8::gemm_phase<pg8::EpiBf16<0>, pg8::StaticOrder, true, true>(F.lds, g, S, E, F.tid); }
            SEAM(); }
        if (IN(pb + 1)) _Pragma("unroll 1") for (int rep = 0; rep < NREP(1); ++rep) { { SITE(); if (odd) ph_odd_prep(a, F, j, L); else ph_even_prep(a, F, j); } SEAM(); }
        if (!odd && IN(pb + 2)) _Pragma("unroll 1") for (int rep = 0; rep < NREP(2); ++rep) {
            { SITE(); unsigned* ctr = F.ctl + CW_Q + 64 * (L * 2) + 1024 * rep;
            for (;;) { const int it = q_next(F, ctr); if (it >= 1280) break; RETID(F);
                if (it < 1024) { if (!(EXPF & 16)) idx_unit(F, it & 3, 255 - (it >> 2)); } else { if (!(EXPF & 32)) moba_gate_chunk(F, it - 1024); } } }
            SEAM(); }
        if (IN(pb + 3)) _Pragma("unroll 1") for (int rep = 0; rep < ((PROBE_DUP == 3 || (PROBE_DUP == 31 && odd) || ((PROBE_DUP == 32 || PROBE_DUP == 33) && !odd)) ? 2 : 1); ++rep) {
            { SITE(); unsigned* ctr = F.ctl + CW_Q + 64 * (L * 2 + 1) + 1024 * rep;
            if (odd) { for (;;) { const int it = q_next(F, ctr); if (it >= 2048) break; RETID(F); const int bh = it & 63; fox_unit(F, L, bh >> 4, bh & 15, 31 - (it >> 6)); } }
            else { for (;;) { const int it = q_next(F, ctr); if (it >= 2048) break; RETID(F);
                    if (it < 1024) { const int bh = it & 31; if (!(rep == 1 && PROBE_DUP == 33)) moba_unit(a, F, bh >> 3, bh & 7, it >> 5); } else { if (!(rep == 1 && PROBE_DUP == 32)) dsa_chunk(a, F, it - 1024); } } } }
            SEAM(); }
        if (!odd && IN(pb + 4)) _Pragma("unroll 1") for (int rep = 0; rep < NREP(4); ++rep) { { SITE(); ph_even_post(F, j); } SEAM(); }
        if (IN(pb + 5)) _Pragma("unroll 1") for (int rep = 0; rep < NREP(5); ++rep) {
            { SITE();
            const float* xin = (L == 0) ? a.in[0] : (const float*)(F.ws + WS_X);
            pg8::Gemm g{(const bf16*)(F.ws + WS_AO), (const bf16*)(F.ws + WS_WOUT) + (size_t)L * 1024 * 1024, NTOK, 1024, 1024}; pg8::StaticOrder S; S.init(NTOK, 1024, F.G, F.blk);
            EpiResF32 E{xin, (float*)(F.ws + WS_YP), ALPHA};
            pg8::gemm_phase<EpiResF32, pg8::StaticOrder, true, true>(F.lds, g, S, E, F.tid); }
            SEAM(); }
        if (IN(pb + 6)) _Pragma("unroll 1") for (int rep = 0; rep < NREP(6); ++rep) { { SITE(); ph_ln1_router(a, F, L); } SEAM(); }
        if (IN(pb + 7)) _Pragma("unroll 1") for (int rep = 0; rep < NREP(7); ++rep) { { SITE(); ph_route(F); } SEAM(); }
        if (IN(pb + 8)) _Pragma("unroll 1") for (int rep = 0; rep < NREP(8); ++rep) {
            { SITE(); const int ntl = (int)ld_u32(F.ctl + CW_TILE);
            pg8::Gemm g{(const bf16*)(F.ws + WS_XG), (const bf16*)(F.ws + WS_WGU + (size_t)L * 32 * 2048 * 1024), NR_MAX, 32 * 2048, 512};
            GroupOrder S{F.ctl + CW_TILE + 64, ntl, 3, F.G, F.blk};
            EpiSwiglu E{F.ws + WS_ACT, a.in[15] + (size_t)L * 32 * 2048};
            pg8::gemm_phase<EpiSwiglu, GroupOrder, true, true, true>(F.lds, g, S, E, F.tid); }
            SEAM(); }
        if (IN(pb + 9)) _Pragma("unroll 1") for (int rep = 0; rep < NREP(9); ++rep) {
            { SITE(); const int ntl = (int)ld_u32(F.ctl + CW_TILE);
            pg8::Gemm g{(const bf16*)(F.ws + WS_ACT), (const bf16*)(F.ws + WS_WDN + (size_t)L * 32 * 1024 * 1024), NR_MAX, 32 * 1024, 512};
            GroupOrder S{F.ctl + CW_TILE + 64, ntl, 2, F.G, F.blk};
            EpiDown E{(bf16*)(F.ws + WS_XG), a.in[17] + (size_t)L * 32 * 1024};
            pg8::gemm_phase<EpiDown, GroupOrder, true, true, true>(F.lds, g, S, E, F.tid); }
            SEAM(); }
        if (IN(pb + 10)) _Pragma("unroll 1") for (int rep = 0; rep < NREP(10); ++rep) { { SITE(); ph_combine_ln2(a, F, L); } if (L + 1 < DEPTH || rep + 1 < NREP(10)) SEAM(); }
    }
#undef IN
#undef SEAM
}

extern "C" void kernel_launch(void* const* d_in, const int* in_sizes, int n_in, void* d_out, int out_size, void* d_ws, size_t ws_size, hipStream_t stream) {
    static int grid = 0;
    if (grid == 0) {
        if (n_in != 18 || out_size != NTOK * DM || ws_size < WS_END) { fprintf(stderr, "kernel_launch: unexpected shapes (n_in %d, out %d, ws %zu); nothing launched\n", n_in, out_size, ws_size); grid = -1; return; }
        int dev = 0, cus = 0, per_cu = 0;
        if (hipGetDevice(&dev) != hipSuccess || hipDeviceGetAttribute(&cus, hipDeviceAttributeMultiprocessorCount, dev) != hipSuccess) { grid = -1; return; }
        if (hipFuncSetAttribute((const void*)mega_fwd, hipFuncAttributeMaxDynamicSharedMemorySize, LDS_BYTES) != hipSuccess) { fprintf(stderr, "kernel_launch: hipFuncSetAttribute failed\n"); grid = -1; return; }
        if (hipOccupancyMaxActiveBlocksPerMultiprocessor(&per_cu, (const void*)mega_fwd, NTHR, LDS_BYTES) != hipSuccess || per_cu < 1) fprintf(stderr, "kernel_launch: occupancy query reports %d\n", per_cu);
        (void)hipGetLastError();
        grid = cus;
    }
    if (grid < 0) return;
    (void)hipMemsetAsync((char*)d_ws + WS_CTL, 0, CTL_ZERO_BYTES, stream);
#ifdef EXP_SKIP
    (void)hipMemsetAsync((char*)d_ws + WS_AO, 0, 64 * MiB, stream);
    (void)hipMemsetAsync((char*)d_ws + WS_OL, 0, 64 * MiB, stream);
    if (EXP_SKIP & 4) { (void)hipMemsetAsync((char*)d_ws + WS_XG, 0, 272 * MiB, stream); (void)hipMemsetAsync((char*)d_ws + WS_DEST, 0, 1 * MiB, stream); }
#endif
    Args a{};
    for (int i = 0; i < 18; ++i) a.in[i] = (const float*)d_in[i];
    a.out = (float*)d_out; a.ws = (unsigned char*)d_ws;
#if MK_SINGLE
    a.ph_lo = 0; a.ph_hi = NPHASE;
    hipLaunchKernelGGL(mega_fwd, dim3(grid), dim3(NTHR), LDS_BYTES, stream, a);
#else
    for (int p = 0; p < NPHASE; ++p) {
        if (p > 0) { const int L = (p - 1) / NPL, q = (p - 1) % NPL; if ((L & 1) && (q == 2 || q == 4)) continue;
#ifdef EXP_SKIP
            if ((EXP_SKIP & 1) && !(L & 1) && q <= 4) continue;
            if ((EXP_SKIP & 2) && (L & 1) && q <= 4) continue;
            if ((EXP_SKIP & 4) && q >= 7 && q <= 9) continue;
#endif
        }
        a.ph_lo = p; a.ph_hi = p + 1;
        hipLaunchKernelGGL(mega_fwd, dim3(grid), dim3(NTHR), LDS_BYTES, stream, a);
    }
#endif
}
```

```cpp
#include <hip/hip_runtime.h>
#include <cstdio>
#include <cstdint>
#ifdef EXP_SKIP
#define EXPF EXP_SKIP
#else
#define EXPF 0
#endif
constexpr int NB = 4, SEQ = 8192, DM = 1024, NTOK = NB * SEQ, DEPTH = 4;
constexpr int EV_N = 2560, OD_N = 3072;
constexpr int EC_QA = 0, EC_QB = 512, EC_KB = 1024, EC_VB = 1536, EC_CKV = 2048, EC_QI = 2176, EC_KI = 2432, EC_WI = 2496;
constexpr int OC_Q = 0, OC_K = 1024, OC_V = 2048;
constexpr float LOG2E = 1.4426950408889634f;
constexpr float C2F = 0.125f * LOG2E;
constexpr float ALPHA = 1.681792830507429f;
constexpr float LN_EPS = 1e-5f;
constexpr int NR_MAX = 131072 + 32 * 256;
constexpr int NWAVES = 8, NTHR = 512;
constexpr size_t MiB = (size_t)1 << 20;
constexpr size_t WS_CTL = 0, CTL_ZERO_BYTES = 4 * MiB;
constexpr size_t WS_WEV = 8 * MiB, WS_WOD = 18 * MiB, WS_WOUT = 30 * MiB, WS_WUKT = 38 * MiB, WS_WUVT = 39 * MiB;
constexpr size_t WS_WGU = 40 * MiB, WS_WDN = 552 * MiB;
constexpr size_t WS_X = 808 * MiB, WS_X1 = 936 * MiB, WS_YP = 1064 * MiB, WS_XB = 1192 * MiB;
constexpr size_t WS_PROJ = 1256 * MiB, WS_AO = 1448 * MiB, WS_XG = 1512 * MiB, WS_ACT = 1784 * MiB;
constexpr size_t WS_QL = 2056 * MiB, WS_OL = 2120 * MiB, WS_CKVN = 2184 * MiB, WS_SEL = 2192 * MiB;
constexpr size_t WS_KBAR = 2208 * MiB, WS_SEL3 = 2209 * MiB, WS_LOGF = 2210 * MiB, WS_CS = 2212 * MiB;
constexpr size_t WS_TOPE = 2213 * MiB, WS_GATE = 2214 * MiB, WS_RANK = 2215 * MiB, WS_DEST = 2216 * MiB, WS_PML = 2217 * MiB;
constexpr size_t WS_XB8 = 2226 * MiB;
constexpr size_t WS_END = 2258 * MiB;
constexpr float F8_SX = 16.f, F8_SWG = 256.f, F8_SA = 4.f, F8_SWD = 512.f;
constexpr int CW_BAR = 4096, CW_Q = 8192, CW_KMAX = 12288, CW_CNT = 16384, CW_TILE = 32768;

#define GAS __attribute__((address_space(1)))
#define LAS __attribute__((address_space(3)))
#define DI __device__ __forceinline__
typedef unsigned short bf16;
typedef unsigned v4u __attribute__((ext_vector_type(4)));
typedef unsigned v2u __attribute__((ext_vector_type(2)));
typedef float f32x4 __attribute__((ext_vector_type(4)));
typedef float f32x2 __attribute__((ext_vector_type(2)));
typedef float f32x16 __attribute__((ext_vector_type(16)));
typedef short bf16x8 __attribute__((ext_vector_type(8)));
typedef short s16x4 __attribute__((ext_vector_type(4)));
typedef __bf16 bf16x2_t __attribute__((ext_vector_type(2)));
typedef GAS unsigned gu32;
#define RLX_AGENT __ATOMIC_RELAXED, __HIP_MEMORY_SCOPE_AGENT
#define LDS_WAIT() asm volatile("s_waitcnt lgkmcnt(0)" ::: "memory")

DI float bf2f(unsigned v) { return __uint_as_float(v << 16); }
DI unsigned cvtpk(float lo, float hi) { f32x2 v = {lo, hi}; bf16x2_t b = __builtin_convertvector(v, bf16x2_t); return __builtin_bit_cast(unsigned, b); }
DI unsigned f2bf(float f) { return cvtpk(f, 0.f) & 0xffffu; }
DI unsigned pk4_fp8(float a, float b, float c, float d) {
    a = fminf(fmaxf(a, -448.f), 448.f); b = fminf(fmaxf(b, -448.f), 448.f); c = fminf(fmaxf(c, -448.f), 448.f); d = fminf(fmaxf(d, -448.f), 448.f);
    int w = 0; w = __builtin_amdgcn_cvt_pk_fp8_f32(a, b, w, false); w = __builtin_amdgcn_cvt_pk_fp8_f32(c, d, w, true); return (unsigned)w; }
DI float ex2(float x) { return __builtin_amdgcn_exp2f(x); }
DI float wave_sum(float v) {
#pragma unroll
    for (int o = 1; o < 64; o <<= 1) v += __shfl_xor(v, o);
    return v;
}
DI float wave_max(float v) {
#pragma unroll
    for (int o = 1; o < 64; o <<= 1) v = fmaxf(v, __shfl_xor(v, o));
    return v;
}
DI unsigned ld_u32(const unsigned* p) { return __hip_atomic_load(p, RLX_AGENT); }
DI int crow(int r, int hi) { return (r & 3) + 8 * (r >> 2) + 4 * hi; }
DI f32x16 mfma32(bf16x8 a, bf16x8 b, f32x16 c) { return __builtin_amdgcn_mfma_f32_32x32x16_bf16(a, b, c, 0, 0, 0); }
DI f32x4 mfma16(bf16x8 a, bf16x8 b, f32x4 c) { return __builtin_amdgcn_mfma_f32_16x16x32_bf16(a, b, c, 0, 0, 0); }
typedef short v4i16_t __attribute__((ext_vector_type(4)));
DI s16x4 vtr(LAS const char* p) { return __builtin_bit_cast(s16x4, __builtin_amdgcn_ds_read_tr16_b64_v4i16((LAS v4i16_t*)p)); }
DI bf16x8 cat8(s16x4 a, s16x4 b) { return (bf16x8){a[0], a[1], a[2], a[3], b[0], b[1], b[2], b[3]}; }
DI int t5_bucket(int n) {
    if (n < 16) return n;
    int bkt = 16;
    bkt += (n >= 21); bkt += (n >= 27); bkt += (n >= 35); bkt += (n >= 46); bkt += (n >= 59); bkt += (n >= 77); bkt += (n >= 99); bkt += (n >= 128);
    bkt += (n >= 166); bkt += (n >= 216); bkt += (n >= 280); bkt += (n >= 363); bkt += (n >= 470); bkt += (n >= 609); bkt += (n >= 790);
    return bkt;
}
namespace pg8 {
#define PG8_LAS __attribute__((address_space(3)))
typedef unsigned short bf16_t;
typedef short bf16x8 __attribute__((ext_vector_type(8)));
typedef float f32x4 __attribute__((ext_vector_type(4)));
typedef unsigned u32x4 __attribute__((ext_vector_type(4)));
constexpr int BM = 256, BK = 64, HALF = 128, HTB = HALF * BK * 2  , STAGE_BYTES = 8 * HTB, NXCD = 8, WGM = 8;

__host__ __device__ __forceinline__ int lds_byte(int r, int c) { const int st = (r >> 4) * 2 + (c >> 5), rr = r & 15, cc = c & 31, ob = rr * 64 + cc * 2; return st * 1024 + (ob ^ (((ob >> 9) & 1) << 5)); }
__host__ __device__ __forceinline__ void stage_rc(int b, int& R, int& C) { const int st = b / 1024, sb = b % 1024, swz = sb ^ (((sb >> 9) & 1) << 5); R = (st >> 1) * 16 + swz / 64; C = (st & 1) * 32 + (swz % 64) / 2; }
__host__ __device__ __forceinline__ int perm32(int rho) { const int n = rho >> 4, i = rho & 15; return 8 * (i >> 2) + 4 * n + (i & 3); }

typedef int i32x8 __attribute__((ext_vector_type(8))); typedef int i32x4v __attribute__((ext_vector_type(4)));
__device__ __forceinline__ i32x8 pg8_cat8(bf16x8 lo, bf16x8 hi) { const i32x4v a = __builtin_bit_cast(i32x4v, lo), b = __builtin_bit_cast(i32x4v, hi); return (i32x8){a[0], a[1], a[2], a[3], b[0], b[1], b[2], b[3]}; }
struct Unit { int pm, pn; };
struct Gemm { const bf16_t* A; const bf16_t* Bt; int M, N, K; };

struct StaticOrder {
    int nM, nN, nwg, G, c;
    __host__ __device__ void init(int M, int N, int G_, int c_) { nM = M / BM; nN = N / BM; nwg = nM * nN; G = G_; c = c_; }
    __host__ __device__ bool next(int i, Unit& u) const {
        const long L = (long)i * G + c; if (L >= nwg) return false;
        int wgid = (int)L; { const int q = nwg / NXCD, r = nwg % NXCD, xcd = wgid % NXCD, off = wgid / NXCD; wgid = (xcd < r ? xcd * (q + 1) : r * (q + 1) + (xcd - r) * q) + off; }
        const int nig = WGM * nN, gid = wgid / nig, fm = gid * WGM, gsz = (nM - fm) < WGM ? (nM - fm) : WGM;
        u.pm = fm + ((wgid % nig) % gsz); u.pn = (wgid % nig) / gsz; return true;
    }
    __device__ __forceinline__ void a_ready(const Unit&) const {}
    __device__ __forceinline__ void done(const Unit&) const {}
};

__device__ __forceinline__ unsigned cvt_pk_bf16(float lo, float hi) { unsigned r; asm volatile("v_cvt_pk_bf16_f32 %0, %1, %2" : "=v"(r) : "v"(lo), "v"(hi)); return r; }
typedef float f32x2 __attribute__((ext_vector_type(2)));
__device__ __forceinline__ f32x2 gelu_pk(f32x2 v) {
    const f32x2 av = __builtin_elementwise_abs(v), d = av * 0.2316418882f + 1.0f;
    f32x2 t; t.x = __builtin_amdgcn_rcpf(d.x); t.y = __builtin_amdgcn_rcpf(d.y);
    f32x2 q = t * 0.5307027145f + (-0.7265760135f); q = q * t + 0.7107068705f; q = q * t + (-0.142248368f); q = q * t + 0.127414796f; q = q * t;
    const f32x2 s = (v * v) * (-0.72134752044f);
    f32x2 e; e.x = __builtin_amdgcn_exp2f(s.x); e.y = __builtin_amdgcn_exp2f(s.y);
    const f32x2 m = v * (q * e), r = v - m;
    f32x2 o; o.x = v.x < 0.f ? m.x : r.x; o.y = v.y < 0.f ? m.y : r.y; return o;
}

template <int ACT  > struct EpiBf16 {
    static constexpr bool PERM = true, AFTER_DRAIN = false; static_assert(ACT == 0 || ACT == 1, "EpiBf16: ACT is 0 (none) or 1 (gelu_pk)");
    bf16_t* O; int ldc; const float* bias; int split_cols; size_t split_stride; float scale0;
    __device__ __forceinline__ void operator()(const f32x4 (&acc)[2][2][4][2], const Unit& u, int wr, int wc, int fr, int fq) const {
        const int row0 = u.pm * BM + wr * 64 + fr; int colt = u.pn * BM; bf16_t* base = O;
        float sc = 1.f; if (split_cols) { const int t = colt / split_cols; base += (size_t)t * split_stride; colt -= t * split_cols; if (t == 0) sc = scale0; }
        const int col0 = colt + wc * 32 + 8 * fq, bcol0 = u.pn * BM + wc * 32 + 8 * fq;
        f32x4 bv[2][2];
#pragma unroll
        for (int bj = 0; bj < 2; ++bj)
#pragma unroll
            for (int n = 0; n < 2; ++n) bv[bj][n] = bias ? *(const f32x4*)(bias + bcol0 + bj * HALF + 4 * n) : (f32x4){0.f, 0.f, 0.f, 0.f};
#pragma unroll
        for (int ai = 0; ai < 2; ++ai)
#pragma unroll
            for (int m = 0; m < 4; ++m) { bf16_t* rowp = base + (size_t)(row0 + ai * HALF + m * 16) * ldc + col0;
#pragma unroll
                for (int bj = 0; bj < 2; ++bj) { f32x4 v0 = acc[ai][bj][m][0] + bv[bj][0], v1 = acc[ai][bj][m][1] + bv[bj][1];
                    if (ACT == 1) { f32x2 a = gelu_pk((f32x2){v0[0], v0[1]}), b = gelu_pk((f32x2){v0[2], v0[3]}), c = gelu_pk((f32x2){v1[0], v1[1]}), d = gelu_pk((f32x2){v1[2], v1[3]});
                        v0 = (f32x4){a.x, a.y, b.x, b.y}; v1 = (f32x4){c.x, c.y, d.x, d.y}; }
                    v0 = v0 * sc; v1 = v1 * sc; u32x4 w; w.x = cvt_pk_bf16(v0[0], v0[1]); w.y = cvt_pk_bf16(v0[2], v0[3]); w.z = cvt_pk_bf16(v1[0], v1[1]); w.w = cvt_pk_bf16(v1[2], v1[3]);
                    *(u32x4*)(rowp + bj * HALF) = w; } }
    }
};

template <class Epi, class Sched, bool ALIGN_EPI = false, bool SP2 = false, bool F8 = false>
__device__ __forceinline__ void gemm_phase(PG8_LAS unsigned char* lds, const Gemm g, const Sched& S, const Epi& E, int tid_in) {
    int tid_l = tid_in; asm volatile("" : "+v"(tid_l));
    const int tid = tid_l, wid = __builtin_amdgcn_readfirstlane(tid >> 6), lane = tid & 63, wr = wid >> 2, wc = wid & 3, fr = lane & 15, fq = lane >> 4;
    const int K = g.K, nt = K / BK;
    unsigned voffA[2], voffB[2];
#pragma unroll
    for (int i = 0; i < 2; ++i) { int R, C; stage_rc(tid * 16 + i * 8192, R, C); const int Rb = Epi::PERM ? ((R & ~31) + perm32(R & 31)) : R;
        voffA[i] = (unsigned)(R * K + C) * 2u; voffB[i] = (unsigned)(Rb * K + C) * 2u; }
    const size_t kstep = (size_t)(BK * 2);
    const size_t hstep = (size_t)HALF * K * 2;
    const size_t tstep = 2 * hstep;
    const unsigned ldsw = (unsigned)wid * 1024u;
    const int aoff = lds_byte(wr * 64 + fr, fq * 8), boff = lds_byte(wc * 32 + fr, fq * 8);
#define PG8_SA(b, h) (((b) * 2 + (h)) * HTB)
#define PG8_SB(b, h) ((4 + (b) * 2 + (h)) * HTB)
#define PG8_STAGE(bufoff, gbase, voff) do { _Pragma("unroll") for (int _i = 0; _i < 2; ++_i) \
        __builtin_amdgcn_global_load_lds((const unsigned*)((const char*)(gbase) + (voff)[_i]), (PG8_LAS unsigned*)(lds + (bufoff) + ldsw + _i * 8192), 16, 0, 0); } while (0)
#define PG8_LDA(dst, b, h) do { _Pragma("unroll") for (int m = 0; m < 4; ++m) _Pragma("unroll") for (int k = 0; k < 2; ++k) dst[m][k] = *(const PG8_LAS bf16x8*)(lds + PG8_SA(b, h) + aoff + m * 2048 + k * 1024); } while (0)
#define PG8_LDB(dst, b, h) do { _Pragma("unroll") for (int n = 0; n < 2; ++n) _Pragma("unroll") for (int k = 0; k < 2; ++k) dst[n][k] = *(const PG8_LAS bf16x8*)(lds + PG8_SB(b, h) + boff + n * 2048 + k * 1024); } while (0)
#define PG8_MMA(ai, bj, At, Bt) do { __builtin_amdgcn_s_setprio(1); if constexpr (!F8) { _Pragma("unroll") for (int m = 0; m < 4; ++m) _Pragma("unroll") for (int n = 0; n < 2; ++n) _Pragma("unroll") for (int k = 0; k < 2; ++k) \
        acc[ai][bj][m][n] = __builtin_amdgcn_mfma_f32_16x16x32_bf16(Bt[n][k], At[m][k], acc[ai][bj][m][n], 0, 0, 0); } else { _Pragma("unroll") for (int m = 0; m < 4; ++m) _Pragma("unroll") for (int n = 0; n < 2; ++n) \
        acc[ai][bj][m][n] = __builtin_amdgcn_mfma_scale_f32_16x16x128_f8f6f4(pg8_cat8(Bt[n][0], Bt[n][1]), pg8_cat8(At[m][0], At[m][1]), acc[ai][bj][m][n], 0, 0, 0, 0x7F7F7F7F, 0, 0x7F7F7F7F); \
        _Pragma("unroll") for (int m = 0; m < 4; ++m) _Pragma("unroll") for (int n = 0; n < 2; ++n) asm volatile("" : "+v"(acc[ai][bj][m][n]));   } __builtin_amdgcn_s_setprio(0); } while (0)
#define PG8_WAIT_V(n) asm volatile("s_waitcnt vmcnt(" #n ")" ::: "memory")
#define PG8_WAIT_L(n) asm volatile("s_waitcnt lgkmcnt(" #n ")" ::: "memory")
#define PG8_BAR __builtin_amdgcn_s_barrier()
#define PG8_SCHED __builtin_amdgcn_sched_barrier(0)
    Unit cur, nxt; int ui = 0;
    if (!S.next(0, cur)) return;
    f32x4 acc[2][2][4][2];
#pragma unroll
    for (int a = 0; a < 2; ++a)
#pragma unroll
        for (int b = 0; b < 2; ++b)
#pragma unroll
            for (int m = 0; m < 4; ++m)
#pragma unroll
                for (int n = 0; n < 2; ++n) acc[a][b][m][n] = (f32x4){0.f, 0.f, 0.f, 0.f};
    bf16x8 At[4][2], B0[2][2], B1[2][2];
    const char* cA = (const char*)g.A + (size_t)cur.pm * tstep; const char* cB = (const char*)g.Bt + (size_t)cur.pn * tstep;
    S.a_ready(cur);
    if constexpr (SP2) {
        PG8_STAGE(PG8_SB(0, 0), cB, voffB); PG8_STAGE(PG8_SB(0, 1), cB + hstep, voffB); PG8_STAGE(PG8_SA(0, 0), cA, voffA); PG8_STAGE(PG8_SA(0, 1), cA + hstep, voffA);
        if (wr == 1) PG8_BAR;
        PG8_WAIT_V(2); PG8_BAR;
        PG8_STAGE(PG8_SB(1, 0), cB + kstep, voffB); PG8_STAGE(PG8_SA(1, 0), cA + kstep, voffA); PG8_STAGE(PG8_SB(1, 1), cB + hstep + kstep, voffB);
        PG8_WAIT_V(6); PG8_BAR;
    } else {
        PG8_STAGE(PG8_SB(0, 0), cB, voffB); PG8_STAGE(PG8_SA(0, 0), cA, voffA); PG8_STAGE(PG8_SB(0, 1), cB + hstep, voffB); PG8_STAGE(PG8_SA(0, 1), cA + hstep, voffA);
        if (wr == 1) PG8_BAR;
        PG8_WAIT_V(4); PG8_BAR;
        PG8_STAGE(PG8_SB(1, 0), cB + kstep, voffB); PG8_STAGE(PG8_SA(1, 0), cA + kstep, voffA); PG8_STAGE(PG8_SB(1, 1), cB + hstep + kstep, voffB);
        PG8_WAIT_V(6); PG8_BAR;
    }
    for (;;) {
        const bool has_next = S.next(ui + 1, nxt);
        const char* nA = has_next ? (const char*)g.A + (size_t)nxt.pm * tstep : cA; const char* nB = has_next ? (const char*)g.Bt + (size_t)nxt.pn * tstep : cB;
        for (int t = 0; t < nt; t += 2) {
            const bool last = (t == nt - 2);
            const char* a1 = cA + (size_t)(t + 1) * kstep;
            const char* a2 = last ? nA : cA + (size_t)(t + 2) * kstep; const char* b2 = last ? nB : cB + (size_t)(t + 2) * kstep;
            const char* a3 = a2 + kstep; const char* b3 = b2 + kstep;
            if (last && has_next) S.a_ready(nxt);
            if constexpr (SP2) {
            PG8_LDB(B0, 0, 0); PG8_LDB(B1, 0, 1); PG8_SCHED; PG8_LDA(At, 0, 0); PG8_STAGE(PG8_SA(1, 1), a1 + hstep, voffA);
            PG8_WAIT_V(8); PG8_WAIT_L(0); PG8_BAR; PG8_MMA(0, 0, At, B0); PG8_MMA(0, 1, At, B1); PG8_BAR; PG8_SCHED;
            PG8_LDA(At, 0, 1); PG8_STAGE(PG8_SB(0, 0), b2, voffB); PG8_STAGE(PG8_SB(0, 1), b2 + hstep, voffB); PG8_STAGE(PG8_SA(0, 0), a2, voffA);
            PG8_WAIT_V(8); PG8_WAIT_L(0); PG8_BAR; PG8_MMA(1, 0, At, B0); PG8_MMA(1, 1, At, B1); PG8_BAR; PG8_SCHED;
            PG8_LDB(B0, 1, 0); PG8_LDB(B1, 1, 1); PG8_SCHED; PG8_LDA(At, 1, 0); PG8_STAGE(PG8_SA(0, 1), a2 + hstep, voffA);
            PG8_WAIT_V(8); PG8_WAIT_L(0); PG8_BAR; PG8_MMA(0, 0, At, B0); PG8_MMA(0, 1, At, B1); PG8_BAR; PG8_SCHED;
            PG8_LDA(At, 1, 1); PG8_STAGE(PG8_SB(1, 0), b3, voffB); PG8_STAGE(PG8_SB(1, 1), b3 + hstep, voffB); PG8_STAGE(PG8_SA(1, 0), a3, voffA);
            PG8_WAIT_V(8); PG8_WAIT_L(0); PG8_BAR; PG8_MMA(1, 0, At, B0); PG8_MMA(1, 1, At, B1); PG8_BAR; PG8_SCHED;
            } else {
            PG8_LDB(B0, 0, 0); PG8_SCHED; PG8_LDA(At, 0, 0); PG8_STAGE(PG8_SA(1, 1), a1 + hstep, voffA);
            PG8_WAIT_L(8); PG8_BAR; PG8_WAIT_L(0); PG8_MMA(0, 0, At, B0); PG8_BAR; PG8_SCHED;
            PG8_LDB(B1, 0, 1); PG8_STAGE(PG8_SB(0, 0), b2, voffB);
            PG8_BAR; PG8_WAIT_L(0); PG8_MMA(0, 1, At, B1); PG8_BAR;
            PG8_LDA(At, 0, 1); PG8_STAGE(PG8_SA(0, 0), a2, voffA);
            PG8_BAR; PG8_WAIT_L(0); PG8_MMA(1, 0, At, B0); PG8_BAR; PG8_SCHED;
            PG8_STAGE(PG8_SB(0, 1), b2 + hstep, voffB);
            PG8_WAIT_V(6); PG8_BAR; PG8_MMA(1, 1, At, B1); PG8_BAR;
            PG8_LDB(B0, 1, 0); PG8_SCHED; PG8_LDA(At, 1, 0); PG8_STAGE(PG8_SA(0, 1), a2 + hstep, voffA);
            PG8_WAIT_L(8); PG8_BAR; PG8_WAIT_L(0); PG8_MMA(0, 0, At, B0); PG8_BAR; PG8_SCHED;
            PG8_LDB(B1, 1, 1); PG8_STAGE(PG8_SB(1, 0), b3, voffB);
            PG8_BAR; PG8_WAIT_L(0); PG8_MMA(0, 1, At, B1); PG8_BAR;
            PG8_LDA(At, 1, 1); PG8_STAGE(PG8_SA(1, 0), a3, voffA);
            PG8_BAR; PG8_WAIT_L(0); PG8_MMA(1, 0, At, B0); PG8_BAR; PG8_SCHED;
            PG8_STAGE(PG8_SB(1, 1), b3 + hstep, voffB);
            PG8_WAIT_V(6); PG8_BAR; PG8_MMA(1, 1, At, B1); PG8_BAR;
            }
        }
        if constexpr (ALIGN_EPI) { if (wr == 0) PG8_BAR; }
        if constexpr (!Epi::AFTER_DRAIN) { E(acc, cur, wr, wc, fr, fq); S.done(cur); }
        if (!has_next) break;
#pragma unroll
        for (int a = 0; a < 2; ++a)
#pragma unroll
            for (int b = 0; b < 2; ++b)
#pragma unroll
                for (int m = 0; m < 4; ++m)
#pragma unroll
                    for (int n = 0; n < 2; ++n) acc[a][b][m][n] = (f32x4){0.f, 0.f, 0.f, 0.f};
        cur = nxt; cA = nA; cB = nB; ++ui;
        if constexpr (ALIGN_EPI) { if (wr == 1) PG8_BAR; }
    }
    PG8_WAIT_V(0);
    if constexpr (!ALIGN_EPI) { if (wr == 0) PG8_BAR; }
    PG8_BAR;
    if constexpr (Epi::AFTER_DRAIN) { E.fused(acc, cur, wr, wc, fr, fq, lds, wid, lane); S.done(cur); }
#undef PG8_SA
#undef PG8_SB
#undef PG8_STAGE
#undef PG8_LDA
#undef PG8_LDB
#undef PG8_MMA
#undef PG8_WAIT_V
#undef PG8_WAIT_L
#undef PG8_BAR
#undef PG8_SCHED
}
}

#ifndef PG8_SP2
#define PG8_SP2 true
#endif
#ifndef PG8_ALIGN
#define PG8_ALIGN true
#endif
#define XB_TMO      128
#define XB_XCNT(j)  (256  + 64 * (j))
#define XB_XSUB(j)  (1280 + 64 * (j))
#define XB_XGEN(j)  (2304 + 64 * (j))
#define XB_TOP      3328
#define XB_TOPGEN   3392
#define XCD_BAR_WORDS 3456
#define XB_SPIN_CAP (1u << 18)

__device__ __forceinline__ unsigned xb_ld(unsigned* p)              { return __hip_atomic_load(p, __ATOMIC_RELAXED, __HIP_MEMORY_SCOPE_AGENT); }
__device__ __forceinline__ unsigned xb_add(unsigned* p, unsigned v) { return __hip_atomic_fetch_add(p, v, __ATOMIC_RELAXED, __HIP_MEMORY_SCOPE_AGENT); }
__device__ __forceinline__ unsigned xb_xcc_id() { return (unsigned)__builtin_amdgcn_s_getreg((3 << 11) | 20) & 0xFu; }
#define XB_SPIN(cond, bar) do { unsigned _sp = 0; while (cond) { __builtin_amdgcn_s_sleep(1); \
    if ((++_sp & 255u) == 0u) { if (xb_ld(&(bar)[XB_TMO])) break; if (_sp > XB_SPIN_CAP) { atomicAdd(&(bar)[XB_TMO], 1u); break; } } } } while (0)

struct XcdBarrier {
    unsigned* bar; unsigned x;
    volatile LAS unsigned* st;
};

__device__ __forceinline__ XcdBarrier xcd_barrier_post(unsigned* bar, volatile LAS unsigned* st) {
    XcdBarrier b; b.bar = bar; b.x = xb_xcc_id(); b.st = st;
    if (threadIdx.x == 0) (void)xb_add(&bar[XB_XCNT(b.x)], 1u);
    return b;
}
__device__ __forceinline__ void xcd_barrier_complete(unsigned* bar, unsigned x, unsigned& nloc, unsigned& nx) {
    const unsigned G = gridDim.x * gridDim.y * gridDim.z;
    unsigned sum, cnt, mine, sp = 0u;
    for (;;) {
        sum = 0u; cnt = 0u; mine = 0u;
#pragma unroll
        for (unsigned j = 0; j < 16; ++j) { const unsigned c = xb_ld(&bar[XB_XCNT(j)]); sum += c; cnt += (c > 0u) ? 1u : 0u; mine = (j == x) ? c : mine; }
        if (sum == G) break;
        __builtin_amdgcn_s_sleep(1);
        if ((++sp & 255u) == 0u) { if (xb_ld(&bar[XB_TMO])) break; if (sp > XB_SPIN_CAP) { atomicAdd(&bar[XB_TMO], 1u); break; } }
    }
    nloc = mine > 0u ? mine : 1u; nx = cnt > 0u ? cnt : 1u;
}

__device__ __forceinline__ void xcd_barrier(const XcdBarrier& b, const bool is_t0  ) {
    asm volatile("s_waitcnt vmcnt(0)" ::: "memory");
    __syncthreads();
    if (is_t0) {
        unsigned* bar = b.bar;
        __builtin_amdgcn_s_waitcnt(0);
        unsigned nloc = b.st[0], nx = b.st[1];
        if (nloc == 0u) { xcd_barrier_complete(bar, b.x, nloc, nx); b.st[0] = nloc; b.st[1] = nx; }
        const unsigned old = xb_add(&bar[XB_XSUB(b.x)], 1u);
        const unsigned gen = old / nloc;
        if (old + 1u == (gen + 1u) * nloc) {
            __builtin_amdgcn_fence(__ATOMIC_RELEASE, "agent");
            asm volatile("s_waitcnt vmcnt(0)" ::: "memory");
            const unsigned og = xb_add(&bar[XB_TOP], 1u);
            const unsigned tg = og / nx;
            if (og + 1u == (tg + 1u) * nx) xb_add(&bar[XB_TOPGEN], 1u);
            else XB_SPIN(xb_ld(&bar[XB_TOPGEN]) == tg, bar);
            __builtin_amdgcn_fence(__ATOMIC_ACQUIRE, "agent");
            xb_add(&bar[XB_XGEN(b.x)], 1u);
            asm volatile("s_waitcnt vmcnt(0)" ::: "memory");
        } else {
            XB_SPIN(xb_ld(&bar[XB_XGEN(b.x)]) == gen, bar);
            __builtin_amdgcn_fence(__ATOMIC_ACQUIRE, "agent");
            asm volatile("s_waitcnt vmcnt(0)" ::: "memory");
        }
    }
    __syncthreads();
}
struct EpiResF32 {
    static constexpr bool PERM = true, AFTER_DRAIN = false;
    const float* xin; float* yp; float alpha;
    DI void operator()(const pg8::f32x4 (&acc)[2][2][4][2], const pg8::Unit& u, int wr, int wc, int fr, int fq) const {
        const int row0 = u.pm * 256 + wr * 64 + fr, col0 = u.pn * 256 + wc * 32 + 8 * fq;
#pragma unroll
        for (int ai = 0; ai < 2; ++ai)
#pragma unroll
            for (int m = 0; m < 4; ++m) {
                const size_t ro = (size_t)(row0 + ai * 128 + m * 16) * DM;
#pragma unroll
                for (int bj = 0; bj < 2; ++bj) {
                    const size_t o = ro + col0 + bj * 128;
                    const f32x4 x0 = *(const f32x4*)(xin + o), x1 = *(const f32x4*)(xin + o + 4);
                    *(f32x4*)(yp + o) = x0 * alpha + acc[ai][bj][m][0];
                    *(f32x4*)(yp + o + 4) = x1 * alpha + acc[ai][bj][m][1];
                }
            }
    }
};
struct EpiSwiglu {
    static constexpr bool PERM = true, AFTER_DRAIN = false;
    unsigned char* act; const float* bgu;
    DI void operator()(const pg8::f32x4 (&acc)[2][2][4][2], const pg8::Unit& u, int wr, int wc, int fr, int fq) const {
        const int e = u.pn >> 3, pl = u.pn & 7;
        const int row0 = u.pm * 256 + wr * 64 + fr, cih = pl * 128 + wc * 32 + 8 * fq;
        const float* bg = bgu + e * 2048 + cih;
        const f32x4 bg0 = *(const f32x4*)(bg), bg1 = *(const f32x4*)(bg + 4), bu0 = *(const f32x4*)(bg + 1024), bu1 = *(const f32x4*)(bg + 1028);
#pragma unroll
        for (int ai = 0; ai < 2; ++ai)
#pragma unroll
            for (int m = 0; m < 4; ++m) {
                constexpr float RS = 1.f / (F8_SX * F8_SWG);
                const f32x4 g0 = acc[ai][0][m][0] * RS + bg0, g1 = acc[ai][0][m][1] * RS + bg1, u0 = acc[ai][1][m][0] * RS + bu0, u1 = acc[ai][1][m][1] * RS + bu1;
                float r[8];
#pragma unroll
                for (int i = 0; i < 8; ++i) {
                    float g = i < 4 ? g0[i & 3] : g1[i & 3], uu = i < 4 ? u0[i & 3] : u1[i & 3];
                    g = fminf(g, 7.0f); uu = fminf(fmaxf(uu, -7.0f), 7.0f);
                    const float sg = __builtin_amdgcn_rcpf(1.0f + ex2(-1.702f * LOG2E * g));
                    r[i] = (uu + 1.0f) * g * sg * F8_SA;
                }
                v2u w; w.x = pk4_fp8(r[0], r[1], r[2], r[3]); w.y = pk4_fp8(r[4], r[5], r[6], r[7]);
                *(v2u*)(act + (size_t)(row0 + ai * 128 + m * 16) * DM + cih) = w;
            }
    }
};
struct EpiDown {
    static constexpr bool PERM = true, AFTER_DRAIN = false;
    bf16* yr; const float* bdn;
    DI void operator()(const pg8::f32x4 (&acc)[2][2][4][2], const pg8::Unit& u, int wr, int wc, int fr, int fq) const {
        const int e = u.pn >> 2, pl = u.pn & 3;
        const int row0 = u.pm * 256 + wr * 64 + fr, col0 = pl * 256 + wc * 32 + 8 * fq;
        f32x4 bv[2][2];
#pragma unroll
        for (int bj = 0; bj < 2; ++bj) { bv[bj][0] = *(const f32x4*)(bdn + e * 1024 + col0 + bj * 128); bv[bj][1] = *(const f32x4*)(bdn + e * 1024 + col0 + bj * 128 + 4); }
#pragma unroll
        for (int ai = 0; ai < 2; ++ai)
#pragma unroll
            for (int m = 0; m < 4; ++m) {
                bf16* rp = yr + (size_t)(row0 + ai * 128 + m * 16) * DM + col0;
#pragma unroll
                for (int bj = 0; bj < 2; ++bj) {
                    constexpr float RS = 1.f / (F8_SA * F8_SWD);
                    const f32x4 v0 = acc[ai][bj][m][0] * RS + bv[bj][0], v1 = acc[ai][bj][m][1] * RS + bv[bj][1];
                    v4u w; w.x = cvtpk(v0[0], v0[1]); w.y = cvtpk(v0[2], v0[3]); w.z = cvtpk(v1[0], v1[1]); w.w = cvtpk(v1[2], v1[3]);
                    *(v4u*)(rp + bj * 128) = w;
                }
            }
    }
};
struct GroupOrder {
    const unsigned* tile_e; int ntiles, lg, G, c;
    DI bool next(int i, pg8::Unit& u) const {
        const long L = (long)i * G + c; if (L >= ((long)ntiles << lg)) return false;
        const int pm = (int)(L >> lg), pl = (int)(L & ((1 << lg) - 1));
        const int e = __builtin_amdgcn_readfirstlane((int)ld_u32(tile_e + pm));
        u.pm = pm; u.pn = (e << lg) + pl; return true;
    }
    DI void a_ready(const pg8::Unit&) const {}
    DI void done(const pg8::Unit&) const {}
};
struct Args { const float* in[18]; float* out; unsigned char* ws; int ph_lo, ph_hi; };
struct Fr { LAS unsigned char* lds; unsigned char* ws; unsigned* ctl; int tid, lane, wave, blk, G; };

DI void tr_item(const float* W, int ldw, int K, int k0, int sc0, int nvalid, bf16* WT, int drow0, LAS float* scr, int lane) {
    const int c = lane & 31;
#pragma unroll 8
    for (int i = 0; i < 32; ++i) { const int kk = 2 * i + (lane >> 5); scr[kk * 33 + c] = (c < nvalid) ? W[(size_t)(k0 + kk) * ldw + sc0 + c] : 0.f; }
    LDS_WAIT(); asm volatile("" ::: "memory");
    const int c8 = lane & 7;
#pragma unroll
    for (int j = 0; j < 4; ++j) { const int n = (lane >> 3) + 8 * j; const LAS float* s = scr + (8 * c8) * 33 + n;
        v4u o; o.x = cvtpk(s[0 * 33], s[1 * 33]); o.y = cvtpk(s[2 * 33], s[3 * 33]); o.z = cvtpk(s[4 * 33], s[5 * 33]); o.w = cvtpk(s[6 * 33], s[7 * 33]);
        *(v4u*)(WT + (size_t)(drow0 + n) * K + k0 + 8 * c8) = o; }
    LDS_WAIT(); asm volatile("" ::: "memory");
}
DI void tr_item8(const float* W, int ldw, int K, int k0, int sc0, float scale, unsigned char* WT8, int drow0, LAS float* scr, int lane) {
    const int c = lane & 31;
#pragma unroll 8
    for (int i = 0; i < 32; ++i) { const int kk = 2 * i + (lane >> 5); scr[kk * 33 + c] = W[(size_t)(k0 + kk) * ldw + sc0 + c] * scale; }
    LDS_WAIT(); asm volatile("" ::: "memory");
    const int c16 = lane & 3;
#pragma unroll
    for (int j = 0; j < 2; ++j) { const int n = (lane >> 2) + 16 * j; const LAS float* s = scr + (16 * c16) * 33 + n;
        v4u o; o.x = pk4_fp8(s[0 * 33], s[1 * 33], s[2 * 33], s[3 * 33]); o.y = pk4_fp8(s[4 * 33], s[5 * 33], s[6 * 33], s[7 * 33]);
        o.z = pk4_fp8(s[8 * 33], s[9 * 33], s[10 * 33], s[11 * 33]); o.w = pk4_fp8(s[12 * 33], s[13 * 33], s[14 * 33], s[15 * 33]);
        *(v4u*)(WT8 + (size_t)(drow0 + n) * K + k0 + 16 * c16) = o; }
    LDS_WAIT(); asm volatile("" ::: "memory");
}
DI void ph_prologue(const Args& a, const Fr& F) {
    LAS float* scr = (LAS float*)(F.lds + F.wave * 16384);
    const int gw = F.blk * NWAVES + F.wave, NGW = F.G * NWAVES;
    constexpr int I_EV = 2 * 16 * 80, I_OD = 2 * 16 * 96, I_WO = 4 * 16 * 32, I_GU = 128 * 16 * 64, I_DN = 128 * 16 * 32;
    constexpr int NITEMS = I_EV + I_OD + I_WO + I_GU + I_DN;
    bf16* wev = (bf16*)(F.ws + WS_WEV); bf16* wod = (bf16*)(F.ws + WS_WOD); bf16* wout = (bf16*)(F.ws + WS_WOUT);
    unsigned char* wgu = F.ws + WS_WGU; unsigned char* wdn = F.ws + WS_WDN;
    for (int it = gw; it < NITEMS; it += NGW) {
        int r = it;
        if (r < I_EV) { const int l = r / 1280; r %= 1280; const int kb = r / 80, n0 = (r % 80) * 32; int sc0, nv = 32;
            if (n0 < 512) sc0 = n0; else if (n0 < 1024) sc0 = 964 + (n0 - 512); else if (n0 < 1536) sc0 = 1476 + (n0 - 1024); else if (n0 < 2048) sc0 = 1988 + (n0 - 1536);
            else if (n0 < 2176) sc0 = 512 + (n0 - 2048); else if (n0 < 2432) sc0 = 640 + (n0 - 2176); else if (n0 < 2496) sc0 = 896 + (n0 - 2432);
            else if (n0 < 2528) { sc0 = 960; nv = 4; } else { sc0 = 0; nv = 0; }
            tr_item(a.in[1] + (size_t)l * 1024 * 2500, 2500, 1024, kb * 64, sc0, nv, wev + (size_t)l * EV_N * 1024, n0, scr, F.lane); continue; }
        r -= I_EV;
        if (r < I_OD) { const int l = r / 1536; r %= 1536; const int kb = r / 96, n0 = (r % 96) * 32;
            tr_item(a.in[6] + (size_t)l * 1024 * 3088, 3088, 1024, kb * 64, n0, 32, wod + (size_t)l * OD_N * 1024, n0, scr, F.lane); continue; }
        r -= I_OD;
        if (r < I_WO) { const int l = r / 512; r %= 512; const int kb = r / 32, n0 = (r % 32) * 32;
            const float* src = (l & 1) ? a.in[8] + (size_t)(l >> 1) * 1024 * 1024 : a.in[5] + (size_t)(l >> 1) * 1024 * 1024;
            tr_item(src, 1024, 1024, kb * 64, n0, 32, wout + (size_t)l * 1024 * 1024, n0, scr, F.lane); continue; }
        r -= I_WO;
        if (r < I_GU) { const int le = r / 1024; r %= 1024; const int kb = r / 64, n0 = (r % 64) * 32;
            const int pn = n0 >> 8, bj = (n0 >> 7) & 1, j0 = n0 & 127;
            tr_item8(a.in[14] + (size_t)le * 1024 * 2048, 2048, 1024, kb * 64, bj * 1024 + pn * 128 + j0, F8_SWG, wgu + (size_t)le * 2048 * 1024, n0, scr, F.lane); continue; }
        r -= I_GU;
        { const int le = r / 512; r %= 512; const int kb = r / 32, n0 = (r % 32) * 32;
            tr_item8(a.in[16] + (size_t)le * 1024 * 1024, 1024, 1024, kb * 64, n0, F8_SWD, wdn + (size_t)le * 1024 * 1024, n0, scr, F.lane); }
    }
    bf16* xb = (bf16*)(F.ws + WS_XB);
    for (int m = gw; m < NTOK; m += NGW) {
        const f32x4* xr = (const f32x4*)(a.in[0] + (size_t)m * DM) + F.lane; v2u* o = (v2u*)(xb + (size_t)m * DM) + F.lane;
#pragma unroll
        for (int j = 0; j < 4; ++j) { const f32x4 v = xr[64 * j]; v2u w; w.x = cvtpk(v[0], v[1]); w.y = cvtpk(v[2], v[3]); o[64 * j] = w; }
    }
    bf16* wukt = (bf16*)(F.ws + WS_WUKT); bf16* wuvt = (bf16*)(F.ws + WS_WUVT);
    for (int i = F.blk * NTHR + F.tid; i < 2 * 8 * 128 * 64; i += F.G * NTHR) {
        { const int d = i & 63, c = (i >> 6) & 127, lh = i >> 13; wukt[i] = (bf16)f2bf(a.in[2][((size_t)lh * 64 + d) * 128 + c]); }
        { const int c = i & 127, d = (i >> 7) & 63, lh = i >> 13; wuvt[i] = (bf16)f2bf(a.in[3][((size_t)lh * 128 + c) * 64 + d]); }
    }
}

DI void ln_row(f32x4 (&v)[4], const float* g, const float* b, int lane) {
    float s = 0.f;
#pragma unroll
    for (int j = 0; j < 4; ++j) s += (v[j][0] + v[j][1]) + (v[j][2] + v[j][3]);
    const float mean = wave_sum(s) * (1.f / DM); float s2 = 0.f;
#pragma unroll
    for (int j = 0; j < 4; ++j) { v[j] = v[j] - mean; s2 += (v[j][0] * v[j][0] + v[j][1] * v[j][1]) + (v[j][2] * v[j][2] + v[j][3] * v[j][3]); }
    const float rstd = 1.f / sqrtf(wave_sum(s2) * (1.f / DM) + LN_EPS);
#pragma unroll
    for (int j = 0; j < 4; ++j) { const f32x4 gg = *((const f32x4*)g + lane + 64 * j), bb = *((const f32x4*)b + lane + 64 * j); v[j] = v[j] * rstd * gg + bb; }
}
DI void store_row_f32(float* p, const f32x4 (&v)[4], int lane) {
#pragma unroll
    for (int j = 0; j < 4; ++j) *((f32x4*)p + lane + 64 * j) = v[j];
}
DI void store_row_bf16(bf16* p, const f32x4 (&v)[4], int lane) {
#pragma unroll
    for (int j = 0; j < 4; ++j) { v2u w; w.x = cvtpk(v[j][0], v[j][1]); w.y = cvtpk(v[j][2], v[j][3]); *((v2u*)p + lane + 64 * j) = w; }
}
template <int NL> DI void small_proj(LAS const float* xs, const float* W, int ldw, int lane, float (&acc)[4]) {
    constexpr int PARTS = 64 / NL, DPER = 1024 / PARTS;
    const int n = lane & (NL - 1), part = lane / NL;
    acc[0] = acc[1] = acc[2] = acc[3] = 0.f;
    const float* wp = W + (size_t)(part * DPER) * ldw + n;
    LAS const float* xp = xs + part * DPER;
#pragma unroll 8
    for (int d = 0; d < DPER; ++d) { const float w = wp[(size_t)d * ldw];
        acc[0] += w * xp[d]; acc[1] += w * xp[1024 + d]; acc[2] += w * xp[2048 + d]; acc[3] += w * xp[3072 + d]; }
#pragma unroll
    for (int o = NL; o < 64; o <<= 1) {
#pragma unroll
        for (int k = 0; k < 4; ++k) acc[k] += __shfl_xor(acc[k], o); }
}

DI void ph_even_prep(const Args& a, const Fr& F, int j) {
    const bf16* proj = (const bf16*)(F.ws + WS_PROJ);
    bf16* ckvn = (bf16*)(F.ws + WS_CKVN); bf16* ql = (bf16*)(F.ws + WS_QL); float* kbar = (float*)(F.ws + WS_KBAR);
    const float* kvg = a.in[4] + j * 128;
    const bf16* wukt = (const bf16*)(F.ws + WS_WUKT) + (size_t)j * 8 * 128 * 64;
    const int lane = F.lane, wave = F.wave;
    for (int chunk = F.blk; chunk < 256; chunk += F.G) {
        const int tok0 = chunk * 128;
        for (int i = 0; i < 16; ++i) { const int tok = tok0 + wave * 16 + i;
            const unsigned w = *((const unsigned*)(proj + (size_t)tok * EV_N + EC_CKV) + lane);
            const float v0 = bf2f(w & 0xffffu), v1 = bf2f(w >> 16);
            const float ss = wave_sum(v0 * v0 + v1 * v1);
            const float r = 1.f / sqrtf(ss * (1.f / 128.f) + LN_EPS);
            *((unsigned*)(ckvn + (size_t)tok * 128) + lane) = cvtpk(v0 * r * kvg[2 * lane], v1 * r * kvg[2 * lane + 1]); }
        { const int h = wave, l15 = lane & 15, kg = lane >> 4;
            bf16x8 af[8][2];
#pragma unroll
            for (int ct = 0; ct < 8; ++ct)
#pragma unroll
                for (int ks = 0; ks < 2; ++ks) af[ct][ks] = *(const bf16x8*)(wukt + ((size_t)h * 128 + ct * 16 + l15) * 64 + ks * 32 + kg * 8);
            for (int tg = 0; tg < 8; ++tg) { const int tok = tok0 + tg * 16 + l15;
                bf16x8 qf[2];
#pragma unroll
                for (int ks = 0; ks < 2; ++ks) qf[ks] = *(const bf16x8*)(proj + (size_t)tok * EV_N + EC_QA + h * 64 + ks * 32 + kg * 8);
#pragma unroll
                for (int ct = 0; ct < 8; ++ct) { f32x4 d = {0.f, 0.f, 0.f, 0.f};
                    d = mfma16(af[ct][0], qf[0], d); d = mfma16(af[ct][1], qf[1], d);
                    v2u w; w.x = cvtpk(d[0], d[1]); w.y = cvtpk(d[2], d[3]);
                    *(v2u*)(ql + (size_t)tok * 1024 + h * 128 + ct * 16 + 4 * kg) = w; } } }
        if (chunk < 128) { const int b = chunk >> 5, n = chunk & 31; float s8[8];
#pragma unroll
            for (int k = 0; k < 8; ++k) s8[k] = 0.f;
            const bf16* kp = proj + ((size_t)b * SEQ + n * 256 + wave * 32) * EV_N + EC_KB + lane * 8;
#pragma unroll 8
            for (int r = 0; r < 32; ++r) { const v4u w = *(const v4u*)(kp + (size_t)r * EV_N);
#pragma unroll
                for (int k = 0; k < 4; ++k) { s8[2 * k] += bf2f(w[k] & 0xffffu); s8[2 * k + 1] += bf2f(w[k] >> 16); } }
            LAS float* red = (LAS float*)F.lds;
            __syncthreads();
#pragma unroll
            for (int k = 0; k < 8; ++k) red[wave * 512 + lane * 8 + k] = s8[k];
            __syncthreads();
            float s = 0.f;
#pragma unroll
            for (int w = 0; w < 8; ++w) s += red[w * 512 + F.tid];
            const int h = F.tid >> 6, d = F.tid & 63;
            kbar[(((size_t)b * 8 + h) * 32 + n) * 64 + d] = s * (1.f / 256.f); }
    }
}

DI void moba_gate_chunk(const Fr& F, int chunk) {
    const bf16* proj = (const bf16*)(F.ws + WS_PROJ); const float* kbar = (const float*)(F.ws + WS_KBAR); unsigned* sel3 = (unsigned*)(F.ws + WS_SEL3);
    const int tok0 = chunk * 128, b = tok0 / SEQ, own = (tok0 % SEQ) >> 8, h = F.wave, lane = F.lane;
    float q0[64], q1[64];
    { const v4u* p0 = (const v4u*)(proj + (size_t)(tok0 + lane) * EV_N + EC_QB + h * 64); const v4u* p1 = (const v4u*)(proj + (size_t)(tok0 + 64 + lane) * EV_N + EC_QB + h * 64);
#pragma unroll
        for (int i = 0; i < 8; ++i) { const v4u w0 = p0[i], w1 = p1[i];
#pragma unroll
            for (int k = 0; k < 4; ++k) { q0[8 * i + 2 * k] = bf2f(w0[k] & 0xffffu); q0[8 * i + 2 * k + 1] = bf2f(w0[k] >> 16); q1[8 * i + 2 * k] = bf2f(w1[k] & 0xffffu); q1[8 * i + 2 * k + 1] = bf2f(w1[k] >> 16); } } }
    float a0 = -INFINITY, a1 = -INFINITY, a2 = -INFINITY, c0 = -INFINITY, c1 = -INFINITY, c2 = -INFINITY; int ai0 = 0, ai1 = 0, ai2 = 0, ci0 = 0, ci1 = 0, ci2 = 0;
    const float* kb = kbar + (((size_t)b * 8 + h) * 32) * 64;
    for (int n = 0; n < own; ++n) { float g0 = 0.f, g1 = 0.f;
#pragma unroll
        for (int d = 0; d < 64; d += 4) { const f32x4 kv = *(const f32x4*)(kb + n * 64 + d);
#pragma unroll
            for (int k = 0; k < 4; ++k) { g0 += q0[d + k] * kv[k]; g1 += q1[d + k] * kv[k]; } }
        if (g0 > a2) { if (g0 > a1) { a2 = a1; ai2 = ai1; if (g0 > a0) { a1 = a0; ai1 = ai0; a0 = g0; ai0 = n; } else { a1 = g0; ai1 = n; } } else { a2 = g0; ai2 = n; } }
        if (g1 > c2) { if (g1 > c1) { c2 = c1; ci2 = ci1; if (g1 > c0) { c1 = c0; ci1 = ci0; c0 = g1; ci0 = n; } else { c1 = g1; ci1 = n; } } else { c2 = g1; ci2 = n; } }
    }
    const unsigned nv = own < 3 ? own : 3;
    sel3[(size_t)(tok0 + lane) * 8 + h] = (unsigned)ai0 | ((unsigned)ai1 << 8) | ((unsigned)ai2 << 16) | (nv << 24);
    sel3[(size_t)(tok0 + 64 + lane) * 8 + h] = (unsigned)ci0 | ((unsigned)ci1 << 8) | ((unsigned)ci2 << 16) | (nv << 24);
}

constexpr int HS = 257;
template <int MODE, bool DIAG> DI void idx_tile(const bf16x8 (&kf)[4], const bf16x8 (&qf)[4][4], const float (&wj)[4], int kt, int q, int hi, unsigned b1, unsigned thr16,
                                     LAS unsigned* hist, LAS unsigned* mask, LAS unsigned* cmask, LAS unsigned long long* cand, LAS unsigned* rinfo) {
    f32x16 sc;
#pragma unroll
    for (int r = 0; r < 16; ++r) sc[r] = 0.f;
#pragma unroll
    for (int j = 0; j < 4; ++j) { f32x16 acc;
#pragma unroll
        for (int r = 0; r < 16; ++r) acc[r] = 0.f;
#pragma unroll
        for (int s = 0; s < 4; ++s) acc = mfma32(kf[s], qf[j][s], acc);
#pragma unroll
        for (int r = 0; r < 16; ++r) sc[r] += wj[j] * __builtin_amdgcn_fmed3f(acc[r], 0.f, 3.0e38f); }
    unsigned sel = 0u, cnd = 0u;
#pragma unroll
    for (int r = 0; r < 16; ++r) { const int kr = crow(r, hi);
        const bool ok = !DIAG || kr <= q;
        const unsigned u = __float_as_uint(sc[r]); const unsigned key = u ^ ((unsigned)((int)u >> 31) | 0x80000000u);
        if (MODE == 1) { if (ok) __hip_atomic_fetch_add(hist + q * HS + (key >> 24), 1u, __ATOMIC_RELAXED, __HIP_MEMORY_SCOPE_WORKGROUP); }
        else if (MODE == 2) { if (ok && (key >> 24) == b1) __hip_atomic_fetch_add(hist + q * HS + ((key >> 16) & 255u), 1u, __ATOMIC_RELAXED, __HIP_MEMORY_SCOPE_WORKGROUP); }
        else { const unsigned k16 = key >> 16;
            if (ok && k16 > thr16) sel |= 1u << kr;
            if (ok && k16 == thr16) { cnd |= 1u << kr; const unsigned pos = __hip_atomic_fetch_add(rinfo + 128 + q, 1u, __ATOMIC_RELAXED, __HIP_MEMORY_SCOPE_WORKGROUP);
                if (pos < 64u) cand[q * 64 + pos] = ((unsigned long long)key << 32) | (unsigned)(~(unsigned)(kt * 32 + kr)); } } }
    if (MODE == 3) { if (sel) __hip_atomic_fetch_or(mask + q * HS + kt, sel, __ATOMIC_RELAXED, __HIP_MEMORY_SCOPE_WORKGROUP);
        if (cnd) __hip_atomic_fetch_or(cmask + q * HS + kt, cnd, __ATOMIC_RELAXED, __HIP_MEMORY_SCOPE_WORKGROUP); }
}
template <int MODE> DI void idx_pass(const bf16* proj, int rowbase, int qt, const bf16x8 (&qf)[4][4], const float (&wj)[4], LAS unsigned* hist, LAS unsigned* mask, LAS unsigned* cmask, LAS unsigned long long* cand, LAS unsigned* rinfo, int wave, int lane) {
    const int q = lane & 31, hi = lane >> 5, nkt = qt + 1;
    const unsigned b1 = rinfo[q], thr16 = rinfo[64 + q];
    const bf16* kp0 = proj + (size_t)(rowbase + q) * EV_N + EC_KI + hi * 8;
    bf16x8 kfa[4], kfb[4];
    if (wave < nkt) {
#pragma unroll
        for (int s = 0; s < 4; ++s) kfa[s] = *(const bf16x8*)(kp0 + (size_t)(wave * 32) * EV_N + s * 16); }
    for (int kt = wave; kt < nkt; kt += 16) {
        const bool hb = kt + 8 < nkt, hc = kt + 16 < nkt;
        if (hb) {
#pragma unroll
            for (int s = 0; s < 4; ++s) kfb[s] = *(const bf16x8*)(kp0 + (size_t)((kt + 8) * 32) * EV_N + s * 16); }
        if (kt == qt) idx_tile<MODE, true>(kfa, qf, wj, kt, q, hi, b1, thr16, hist, mask, cmask, cand, rinfo); else idx_tile<MODE, false>(kfa, qf, wj, kt, q, hi, b1, thr16, hist, mask, cmask, cand, rinfo);
        if (hb) {
            if (hc) {
#pragma unroll
                for (int s = 0; s < 4; ++s) kfa[s] = *(const bf16x8*)(kp0 + (size_t)((kt + 16) * 32) * EV_N + s * 16); }
            if (kt + 8 == qt) idx_tile<MODE, true>(kfb, qf, wj, kt + 8, q, hi, b1, thr16, hist, mask, cmask, cand, rinfo); else idx_tile<MODE, false>(kfb, qf, wj, kt + 8, q, hi, b1, thr16, hist, mask, cmask, cand, rinfo); }
    }
}
DI void hist_pick(LAS const unsigned* hrow, unsigned need, int lane, unsigned& bin, unsigned& above) {
    unsigned h4[4];
#pragma unroll
    for (int k = 0; k < 4; ++k) h4[k] = hrow[4 * lane + k];
    const unsigned ssum = h4[0] + h4[1] + h4[2] + h4[3];
    unsigned x = ssum;
#pragma unroll
    for (int o = 1; o < 64; o <<= 1) { const unsigned y = __shfl_down(x, o); if (lane + o < 64) x += y; }
    const unsigned long long m = __ballot(x >= need);
    const int Ls = m ? 63 - __builtin_clzll(m) : 0;
    const unsigned xs = __shfl(x, Ls), ss = __shfl(ssum, Ls);
    const unsigned h0 = __shfl(h4[0], Ls), h1 = __shfl(h4[1], Ls), h2 = __shfl(h4[2], Ls), h3 = __shfl(h4[3], Ls);
    unsigned cum = xs - ss;
    if (cum + h3 >= need) { bin = 4 * Ls + 3; above = cum; return; } cum += h3;
    if (cum + h2 >= need) { bin = 4 * Ls + 2; above = cum; return; } cum += h2;
    if (cum + h1 >= need) { bin = 4 * Ls + 1; above = cum; return; } cum += h1;
    bin = 4 * Ls; above = cum; (void)h0;
}
DI void idx_unit(const Fr& F, int b, int qt) {
    const bf16* proj = (const bf16*)(F.ws + WS_PROJ); unsigned short* sel = (unsigned short*)(F.ws + WS_SEL);
    LAS unsigned* hist = (LAS unsigned*)(F.lds); LAS unsigned* mask = hist + 32 * HS; LAS unsigned* cmask = mask + 32 * HS;
    LAS unsigned long long* cand = (LAS unsigned long long*)(F.lds + 99328); LAS unsigned* rinfo = (LAS unsigned*)(F.lds + 115712);
    const int lane = F.lane, wave = F.wave, tid = F.tid, t0 = qt * 32, rowbase = b * SEQ;
    __syncthreads();
    for (int i = tid; i < 3 * 32 * HS; i += NTHR) hist[i] = 0u;
    if (tid < 160) rinfo[tid] = 0u;
    __syncthreads();
    if (t0 + 31 <= 255 || (EXPF & 64)) {
        if (lane < 8) {
#pragma unroll
            for (int rr = 0; rr < 4; ++rr) { const int row = wave * 4 + rr, nv = t0 + row + 1;
                const int nv0 = t0 + row + 1; const int nvc = nv0 < 256 ? nv0 : 256; (void)nv; mask[row * HS + lane] = nvc >= 32 * (lane + 1) ? 0xffffffffu : (nvc > 32 * lane ? ((1u << (nvc - 32 * lane)) - 1u) : 0u); } }
    } else {
        const int q = lane & 31, hi = lane >> 5;
        bf16x8 qf[4][4]; float wj[4];
        { const bf16* qp = proj + (size_t)(rowbase + t0 + q) * EV_N;
#pragma unroll
            for (int j = 0; j < 4; ++j) { wj[j] = bf2f(qp[EC_WI + j]);
#pragma unroll
                for (int s = 0; s < 4; ++s) qf[j][s] = *(const bf16x8*)(qp + EC_QI + j * 64 + s * 16 + hi * 8); } }
        idx_pass<1>(proj, rowbase, qt, qf, wj, hist, mask, cmask, cand, rinfo, wave, lane);
        __syncthreads();
#pragma unroll 1
        for (int rr = 0; rr < 4; ++rr) { const int row = wave * 4 + rr; unsigned bin, above; hist_pick(hist + row * HS, 256u, lane, bin, above);
            if (lane == 0) { rinfo[row] = bin; rinfo[32 + row] = 256u - above; } }
        __syncthreads();
        for (int i = tid; i < 32 * HS; i += NTHR) hist[i] = 0u;
        __syncthreads();
        idx_pass<2>(proj, rowbase, qt, qf, wj, hist, mask, cmask, cand, rinfo, wave, lane);
        __syncthreads();
#pragma unroll 1
        for (int rr = 0; rr < 4; ++rr) { const int row = wave * 4 + rr; const unsigned need1 = rinfo[32 + row]; unsigned bin, above; hist_pick(hist + row * HS, need1, lane, bin, above);
            if (lane == 0) { rinfo[64 + row] = (rinfo[row] << 8) | bin; rinfo[96 + row] = need1 - above; } }
        __syncthreads();
        idx_pass<3>(proj, rowbase, qt, qf, wj, hist, mask, cmask, cand, rinfo, wave, lane);
        __syncthreads();
#pragma unroll 1
        for (int rr = 0; rr < 4; ++rr) { const int row = wave * 4 + rr; const unsigned call = rinfo[128 + row], need2 = rinfo[96 + row];
            if (call <= 64u) { const unsigned c = call;
                const unsigned long long mine = cand[row * 64 + lane]; unsigned rank = 0u;
                for (unsigned k = 0; k < c; ++k) rank += (cand[row * 64 + k] > mine) ? 1u : 0u;
                if ((unsigned)lane < c && rank < need2) { const unsigned s = ~(unsigned)mine;
                    __hip_atomic_fetch_or(mask + row * HS + (s >> 5), 1u << (s & 31), __ATOMIC_RELAXED, __HIP_MEMORY_SCOPE_WORKGROUP); } }
            else { unsigned w4[4];
#pragma unroll
                for (int k = 0; k < 4; ++k) w4[k] = cmask[row * HS + 4 * lane + k];
                const unsigned cnt = __popc(w4[0]) + __popc(w4[1]) + __popc(w4[2]) + __popc(w4[3]);
                unsigned x = cnt;
#pragma unroll
                for (int o = 1; o < 64; o <<= 1) { const unsigned y = __shfl_up(x, o); if (lane >= o) x += y; }
                unsigned before = x - cnt;
#pragma unroll
                for (int k = 0; k < 4; ++k) { unsigned w = w4[k]; const unsigned pc = __popc(w); unsigned take = 0u;
                    if (before < need2) { if (before + pc <= need2) take = w; else { unsigned left = need2 - before; while (left) { const unsigned b = w & (0u - w); take |= b; w ^= b; --left; } } }
                    before += pc;
                    if (take) mask[row * HS + 4 * lane + k] |= take; } }
        }
    }
    __syncthreads();
#pragma unroll 1
    for (int rr = 0; rr < 4; ++rr) { const int row = wave * 4 + rr; unsigned short* out = sel + (size_t)(rowbase + t0 + row) * 256;
        unsigned w4[4];
#pragma unroll
        for (int k = 0; k < 4; ++k) w4[k] = mask[row * HS + 4 * lane + k];
        const unsigned cnt = __popc(w4[0]) + __popc(w4[1]) + __popc(w4[2]) + __popc(w4[3]);
        unsigned x = cnt;
#pragma unroll
        for (int o = 1; o < 64; o <<= 1) { const unsigned y = __shfl_up(x, o); if (lane >= o) x += y; }
        const unsigned total = __shfl(x, 63); unsigned pos = x - cnt;
#pragma unroll
        for (int k = 0; k < 4; ++k) { unsigned w = w4[k]; const unsigned base = (unsigned)(4 * lane + k) * 32u;
            while (w) { const unsigned bit = __builtin_ctz(w); if (pos < 256u) out[pos] = (unsigned short)(base + bit); ++pos; w &= w - 1u; } }
        for (unsigned i = total + lane; i < 256u; i += 64u) out[i] = (unsigned short)0xffffu; }
}

struct AttSt { float m, l; f32x16 o0, o1; };
template <class BF> DI void att_subtile(AttSt& S, const bf16x8 (&qf)[4], LAS const char* Kst, LAS const char* Vb, int vdh, int vrow0, int lane, const BF& bias) {
    const int r32 = lane & 31, hi = lane >> 5;
    f32x16 p;
#pragma unroll
    for (int r = 0; r < 16; ++r) p[r] = 0.f;
    LAS const char* kp = Kst + hi * 512 + r32 * 16;
#pragma unroll
    for (int s = 0; s < 4; ++s) { const bf16x8 kf = *(LAS const bf16x8*)(kp + s * 1024); p = mfma32(kf, qf[s], p); }
    float mx = -INFINITY;
#pragma unroll
    for (int r = 0; r < 16; ++r) { p[r] = bias(p[r], crow(r, hi)); mx = fmaxf(mx, p[r]); }
    mx = fmaxf(mx, __shfl_xor(mx, 32));
    const float mn = fmaxf(S.m, mx), sc = ex2(S.m - mn);
    S.m = mn;
    float ps = 0.f;
#pragma unroll
    for (int r = 0; r < 16; ++r) { p[r] = ex2(p[r] - mn); ps += p[r]; }
    S.l = S.l * sc + ps;
#pragma unroll
    for (int r = 0; r < 16; ++r) { S.o0[r] *= sc; S.o1[r] *= sc; }
    v4u pw0, pw1;
    pw0.x = cvtpk(p[0], p[1]); pw0.y = cvtpk(p[2], p[3]); pw0.z = cvtpk(p[4], p[5]); pw0.w = cvtpk(p[6], p[7]);
    pw1.x = cvtpk(p[8], p[9]); pw1.y = cvtpk(p[10], p[11]); pw1.z = cvtpk(p[12], p[13]); pw1.w = cvtpk(p[14], p[15]);
    const bf16x8 pf0 = __builtin_bit_cast(bf16x8, pw0), pf1 = __builtin_bit_cast(bf16x8, pw1);
    LAS const char* vp = Vb + (vrow0 + 4 * hi + ((lane & 15) >> 2)) * 64 + ((lane >> 4) & 1) * 32 + (lane & 3) * 8;
    { const bf16x8 v00 = cat8(vtr(vp), vtr(vp + 512)), v10 = cat8(vtr(vp + vdh), vtr(vp + vdh + 512));
      const bf16x8 v01 = cat8(vtr(vp + 1024), vtr(vp + 1536)), v11 = cat8(vtr(vp + vdh + 1024), vtr(vp + vdh + 1536));
      S.o0 = mfma32(v00, pf0, S.o0); S.o1 = mfma32(v10, pf0, S.o1);
      S.o0 = mfma32(v01, pf1, S.o0); S.o1 = mfma32(v11, pf1, S.o1); }
}

struct MobaBias { LAS const float* lut; int tq, s0; bool causal;
    DI float operator()(float p, int kvrel) const { const int dist = tq - (s0 + kvrel); const float v = p + lut[dist < 0 ? 0 : (dist > 1023 ? 1023 : dist)]; return (causal && dist < 0) ? -INFINITY : v; } };
DI void moba_tile(const Fr& F, const bf16* proj, int rowbase, int h, int n, int tq, bool valid, int slot, bool own, int wave_tile) {
    LAS const char* Kb = (LAS const char*)F.lds; LAS const char* Vb = (LAS const char*)(F.lds + 32768); LAS const float* lut = (LAS const float*)(F.lds + 98304);
    bf16* po = (bf16*)(F.ws + WS_ACT); float* pml = (float*)(F.ws + WS_PML);
    const int lane = F.lane, hi = lane >> 5;
    bf16x8 qf[4];
    { const bf16* qp = proj + (size_t)(rowbase + tq) * EV_N + EC_QB + h * 64 + hi * 8;
#pragma unroll
        for (int s = 0; s < 4; ++s) qf[s] = *(const bf16x8*)(qp + s * 16); }
    AttSt S; S.m = -1e30f; S.l = 0.f;
#pragma unroll
    for (int r = 0; r < 16; ++r) { S.o0[r] = 0.f; S.o1[r] = 0.f; }
    const int nst = own ? wave_tile + 1 : 8;
    for (int st = 0; st < nst; ++st) { MobaBias bf{lut, tq, n * 256 + st * 32, own && st == wave_tile};
        att_subtile(S, qf, Kb + st * 4096, Vb, 16384, st * 32, lane, bf); }
    const float lt = S.l + __shfl_xor(S.l, 32), inv = 1.f / lt;
    if (valid) { const size_t pi = ((size_t)(rowbase + tq) * 8 + h) * 4 + slot; bf16* o = po + pi * 64;
#pragma unroll
        for (int a4 = 0; a4 < 4; ++a4) { v2u w0, w1;
            w0.x = cvtpk(S.o0[4 * a4] * inv, S.o0[4 * a4 + 1] * inv); w0.y = cvtpk(S.o0[4 * a4 + 2] * inv, S.o0[4 * a4 + 3] * inv);
            w1.x = cvtpk(S.o1[4 * a4] * inv, S.o1[4 * a4 + 1] * inv); w1.y = cvtpk(S.o1[4 * a4 + 2] * inv, S.o1[4 * a4 + 3] * inv);
            *(v2u*)(o + 8 * a4 + 4 * hi) = w0; *(v2u*)(o + 32 + 8 * a4 + 4 * hi) = w1; }
        if (hi == 0) { f32x2 ml = {S.m, lt}; *(f32x2*)(pml + pi * 2) = ml; } }
}
DI void moba_unit(const Args& a, const Fr& F, int b, int h, int n) {
    const bf16* proj = (const bf16*)(F.ws + WS_PROJ); const unsigned* sel3 = (const unsigned*)(F.ws + WS_SEL3);
    LAS unsigned char* lds = F.lds; LAS unsigned* list = (LAS unsigned*)(lds + 65536); LAS float* lut = (LAS float*)(lds + 98304); LAS unsigned* misc = (LAS unsigned*)(lds + 102400);
    const int tid = F.tid, lane = F.lane, wave = F.wave, rowbase = b * SEQ;
    __syncthreads();
    { const bf16* kg = proj + (size_t)(rowbase + n * 256) * EV_N + EC_KB + h * 64; const bf16* vg = proj + (size_t)(rowbase + n * 256) * EV_N + EC_VB + h * 64;
#pragma unroll
        for (int i = 0; i < 4; ++i) { const int p = tid + i * NTHR;
            { const int r = p & 31, c = (p >> 5) & 7, st = p >> 8; const v4u v = *(const v4u*)(kg + (size_t)(st * 32 + r) * EV_N + c * 8); *(LAS v4u*)(lds + st * 4096 + c * 512 + r * 16) = v; }
            { const int cc = p & 3, row = (p >> 2) & 255, dh = p >> 10; const v4u v = *(const v4u*)(vg + (size_t)row * EV_N + dh * 32 + cc * 8); *(LAS v4u*)(lds + 32768 + dh * 16384 + row * 64 + cc * 16) = v; } }
        for (int d = tid; d < 1024; d += NTHR) lut[d] = a.in[9][t5_bucket(d) * 16 + 8 + h] * LOG2E; }
    if (tid == 0) misc[16] = 0u;
    __syncthreads();
    for (int tb = (n + 1) * 256; tb < SEQ; tb += NTHR) { const int t = tb + tid; const bool inr = t < SEQ;
        const unsigned s = inr ? sel3[(size_t)(rowbase + t) * 8 + h] : 0u; const unsigned nv = s >> 24; int slot = -1;
        if (nv > 0u && (s & 255u) == (unsigned)n) slot = 0; else if (nv > 1u && ((s >> 8) & 255u) == (unsigned)n) slot = 1; else if (nv > 2u && ((s >> 16) & 255u) == (unsigned)n) slot = 2;
        const unsigned long long bal = __ballot(slot >= 0); const unsigned wcnt = __popcll(bal);
        if (lane == 0) misc[wave] = wcnt;
        __syncthreads();
        unsigned off = misc[16], tot = 0u;
#pragma unroll
        for (int w = 0; w < 8; ++w) { const unsigned c = misc[w]; if (w < wave) off += c; tot += c; }
        if (slot >= 0) list[off + __popcll(bal & ((1ull << lane) - 1ull))] = ((unsigned)t << 2) | (unsigned)slot;
        __syncthreads();
        if (tid == 0) misc[16] += tot; }
    __syncthreads();
    const int nlist = (int)misc[16];
    moba_tile(F, proj, rowbase, h, n, n * 256 + wave * 32 + (lane & 31), true, 3, true, wave);
    const int ntl = (nlist + 31) >> 5;
    for (int tl = wave; tl < ntl; tl += 8) { const int li = tl * 32 + (lane & 31); const bool valid = li < nlist; const unsigned e = list[valid ? li : nlist - 1];
        moba_tile(F, proj, rowbase, h, n, (int)(e >> 2), valid, (int)(e & 3u), false, 0); }
}

DI void dsa_step(const bf16x8 (&af)[2][4], const bf16x8 (&qlf)[4], int ch, LAS const unsigned char* bsel, LAS unsigned char* cbuf, LAS const float* tab,
                 float& m, float& l, f32x4 (&oT)[8], int l15, int kg, int lane) {
    f32x4 acc[2];
#pragma unroll
    for (int mt = 0; mt < 2; ++mt) { acc[mt] = (f32x4){0.f, 0.f, 0.f, 0.f};
#pragma unroll
        for (int ks = 0; ks < 4; ++ks) { acc[mt] = mfma16(af[mt][ks], qlf[ks], acc[mt]); *(LAS bf16x8*)(cbuf + (mt * 16 + l15) * 288 + (ks * 32 + kg * 8) * 2) = af[mt][ks]; } }
    float mx = -INFINITY;
#pragma unroll
    for (int mt = 0; mt < 2; ++mt) { const unsigned b4 = *(LAS const unsigned*)(bsel + ch * 32 + mt * 16 + 4 * kg);
#pragma unroll
        for (int i = 0; i < 4; ++i) { const unsigned bb = (b4 >> (8 * i)) & 255u;
            const float v = bb != 255u ? acc[mt][i] + tab[bb * 8 + (l15 & 7)] : -INFINITY; acc[mt][i] = v; mx = fmaxf(mx, v); } }
    mx = fmaxf(mx, __shfl_xor(mx, 16)); mx = fmaxf(mx, __shfl_xor(mx, 32));
    const float mn = fmaxf(m, mx), sc = ex2(m - mn); m = mn;
    float ps = 0.f;
#pragma unroll
    for (int mt = 0; mt < 2; ++mt)
#pragma unroll
        for (int i = 0; i < 4; ++i) { acc[mt][i] = ex2(acc[mt][i] - mn); ps += acc[mt][i]; }
    l = l * sc + ps;
#pragma unroll
    for (int ct = 0; ct < 8; ++ct) oT[ct] = oT[ct] * sc;
    v4u pw; pw.x = cvtpk(acc[0][0], acc[0][1]); pw.y = cvtpk(acc[0][2], acc[0][3]); pw.z = cvtpk(acc[1][0], acc[1][1]); pw.w = cvtpk(acc[1][2], acc[1][3]);
    const bf16x8 pf = __builtin_bit_cast(bf16x8, pw);
    LDS_WAIT();
    LAS const char* tp = (LAS const char*)cbuf + (4 * kg + (l15 >> 2)) * 288 + (lane & 3) * 8;
#pragma unroll
    for (int ct = 0; ct < 8; ++ct) { const bf16x8 cf = cat8(vtr(tp + ct * 32), vtr(tp + 16 * 288 + ct * 32)); oT[ct] = mfma16(cf, pf, oT[ct]); }
    LDS_WAIT();
}
DI void dsa_gather(bf16x8 (&af)[2][4], const bf16* ckvn, int rowbase, LAS const unsigned short* selb, int ch, int l15, int kg) {
#pragma unroll
    for (int mt = 0; mt < 2; ++mt) { unsigned idx = selb[ch * 32 + mt * 16 + l15]; if (idx == 0xffffu) idx = 0u;
        const bf16* cp = ckvn + (size_t)(rowbase + (int)idx) * 128 + kg * 8;
#pragma unroll
        for (int ks = 0; ks < 4; ++ks) af[mt][ks] = *(const bf16x8*)(cp + ks * 32); }
}
DI void dsa_query(const Fr& F, int tok, LAS unsigned char* wl, LAS const unsigned char* bkt, LAS const float* tab) {
    const bf16* ql = (const bf16*)(F.ws + WS_QL); const bf16* ckvn = (const bf16*)(F.ws + WS_CKVN); const unsigned short* sel = (const unsigned short*)(F.ws + WS_SEL); bf16* ol = (bf16*)(F.ws + WS_OL);
    const int lane = F.lane, l15 = lane & 15, kg = lane >> 4, t = tok % SEQ, rowbase = tok - t;
    LAS unsigned short* selb = (LAS unsigned short*)wl; LAS unsigned char* bsel = wl + 512; LAS unsigned char* cbuf = wl + 1024;
    { const v2u sv = *((const v2u*)(sel + (size_t)tok * 256) + lane); *((LAS v2u*)selb + lane) = sv; unsigned bw = 0u;
#pragma unroll
        for (int i = 0; i < 4; ++i) { const unsigned s = (i < 2 ? (sv.x >> (16 * i)) : (sv.y >> (16 * (i - 2)))) & 0xffffu; const int dist = t - (int)s;
            const unsigned bb = (s != 0xffffu && dist >= 0) ? (unsigned)bkt[dist > 1023 ? 1023 : dist] : 255u; bw |= bb << (8 * i); }
        *((LAS unsigned*)bsel + lane) = bw; }
    bf16x8 qlf[4];
#pragma unroll
    for (int ks = 0; ks < 4; ++ks) { qlf[ks] = *(const bf16x8*)(ql + (size_t)tok * 1024 + (l15 & 7) * 128 + ks * 32 + kg * 8); if (l15 >= 8) qlf[ks] = (bf16x8){0, 0, 0, 0, 0, 0, 0, 0}; }
    float m = -1e30f, l = 0.f; f32x4 oT[8];
#pragma unroll
    for (int ct = 0; ct < 8; ++ct) oT[ct] = (f32x4){0.f, 0.f, 0.f, 0.f};
    const int nvalid = t + 1 < 256 ? t + 1 : 256, nch = (nvalid + 31) >> 5;
    LDS_WAIT();
    bf16x8 afa[2][4], afb[2][4];
    dsa_gather(afa, ckvn, rowbase, selb, 0, l15, kg);
    for (int ch = 0; ch < nch; ch += 2) {
        const bool hb = ch + 1 < nch;
        if (hb) dsa_gather(afb, ckvn, rowbase, selb, ch + 1, l15, kg);
        dsa_step(afa, qlf, ch, bsel, cbuf, tab, m, l, oT, l15, kg, lane);
        if (hb) { if (ch + 2 < nch) dsa_gather(afa, ckvn, rowbase, selb, ch + 2, l15, kg);
            dsa_step(afb, qlf, ch + 1, bsel, cbuf, tab, m, l, oT, l15, kg, lane); }
    }
    l += __shfl_xor(l, 16); l += __shfl_xor(l, 32);
    const float inv = 1.f / l;
    if (l15 < 8) { bf16* o = ol + (size_t)tok * 1024 + l15 * 128 + 4 * kg;
#pragma unroll
        for (int ct = 0; ct < 8; ++ct) { v2u w; w.x = cvtpk(oT[ct][0] * inv, oT[ct][1] * inv); w.y = cvtpk(oT[ct][2] * inv, oT[ct][3] * inv); *(v2u*)(o + ct * 16) = w; } }
}
DI void dsa_chunk(const Args& a, const Fr& F, int c32) {
    LAS unsigned char* bkt = F.lds + 81920; LAS float* tab = (LAS float*)(F.lds + 82944);
    __syncthreads();
    for (int d = F.tid; d < 1024; d += NTHR) bkt[d] = (unsigned char)t5_bucket(d);
    if (F.tid < 256) tab[F.tid] = a.in[9][(F.tid >> 3) * 16 + (F.tid & 7)] * LOG2E;
    __syncthreads();
#pragma unroll 1
    for (int i = 0; i < 4; ++i) dsa_query(F, c32 * 32 + F.wave * 4 + i, F.lds + F.wave * 10240, bkt, tab);
}

DI void ph_even_post(const Fr& F, int j) {
    const bf16* ol = (const bf16*)(F.ws + WS_OL); bf16* ao = (bf16*)(F.ws + WS_AO);
    const bf16* wuvt = (const bf16*)(F.ws + WS_WUVT) + (size_t)j * 8 * 64 * 128;
    const bf16* po = (const bf16*)(F.ws + WS_ACT); const float* pml = (const float*)(F.ws + WS_PML); const unsigned* sel3 = (const unsigned*)(F.ws + WS_SEL3);
    const int lane = F.lane, wave = F.wave, l15 = lane & 15, kg = lane >> 4;
    for (int chunk = F.blk; chunk < 256; chunk += F.G) { const int tok0 = chunk * 128;
        { const int h = wave; bf16x8 af[4][4];
#pragma unroll
            for (int mt = 0; mt < 4; ++mt)
#pragma unroll
                for (int ks = 0; ks < 4; ++ks) af[mt][ks] = *(const bf16x8*)(wuvt + ((size_t)h * 64 + mt * 16 + l15) * 128 + ks * 32 + kg * 8);
            for (int tg = 0; tg < 8; ++tg) { const int tok = tok0 + tg * 16 + l15; bf16x8 bf[4];
#pragma unroll
                for (int ks = 0; ks < 4; ++ks) bf[ks] = *(const bf16x8*)(ol + (size_t)tok * 1024 + h * 128 + ks * 32 + kg * 8);
#pragma unroll
                for (int mt = 0; mt < 4; ++mt) { f32x4 d = {0.f, 0.f, 0.f, 0.f};
#pragma unroll
                    for (int ks = 0; ks < 4; ++ks) d = mfma16(af[mt][ks], bf[ks], d);
                    v2u w; w.x = cvtpk(d[0], d[1]); w.y = cvtpk(d[2], d[3]); *(v2u*)(ao + (size_t)tok * 1024 + h * 64 + mt * 16 + 4 * kg) = w; } } }
        if (!(EXPF & 32)) for (int i = 0; i < 16; ++i) { const int tok = tok0 + wave * 16 + i, h = lane >> 3, d0 = (lane & 7) * 8;
            const unsigned nv = sel3[(size_t)tok * 8 + h] >> 24; const size_t pi = ((size_t)tok * 8 + h) * 4;
            float mj[4], lj[4];
#pragma unroll
            for (int s = 0; s < 4; ++s) { const bool ok = (s == 3) || ((unsigned)s < nv); const f32x2 ml = *(const f32x2*)(pml + (pi + s) * 2); mj[s] = ok ? ml[0] : -1e30f; lj[s] = ok ? ml[1] : 0.f; }
            const float ms = fmaxf(fmaxf(mj[0], mj[1]), fmaxf(mj[2], mj[3])); float wsum = 0.f, acc[8];
#pragma unroll
            for (int k = 0; k < 8; ++k) acc[k] = 0.f;
#pragma unroll
            for (int s = 0; s < 4; ++s) { const float w = lj[s] * ex2(mj[s] - ms); wsum += w;
                if (w > 0.f) { const v4u v = *(const v4u*)(po + (pi + s) * 64 + d0);
#pragma unroll
                    for (int k = 0; k < 4; ++k) { acc[2 * k] += w * bf2f(v[k] & 0xffffu); acc[2 * k + 1] += w * bf2f(v[k] >> 16); } } }
            const float inv = 1.f / wsum; v4u o; o.x = cvtpk(acc[0] * inv, acc[1] * inv); o.y = cvtpk(acc[2] * inv, acc[3] * inv); o.z = cvtpk(acc[4] * inv, acc[5] * inv); o.w = cvtpk(acc[6] * inv, acc[7] * inv);
            *(v4u*)(ao + (size_t)tok * 1024 + 512 + h * 64 + d0) = o; }
    }
}
DI f32x16 proj32_f32(const float* W, int ldw, int ncols, const float* xrow, int d_lo, int lane) {
    const int e = lane & 31, kh = lane >> 5; const bool ev = e < ncols;
    f32x16 D;
#pragma unroll
    for (int r = 0; r < 16; ++r) D[r] = 0.f;
    const float* wp = W + (size_t)(d_lo + 4 * kh) * ldw + (ev ? e : 0);
    const float* xp = xrow + d_lo + 4 * kh;
#pragma unroll 4
    for (int i = 0; i < 64; ++i) { const f32x4 xv = *(const f32x4*)(xp + 8 * i);
        float a0 = wp[(size_t)(8 * i + 0) * ldw], a1 = wp[(size_t)(8 * i + 1) * ldw], a2 = wp[(size_t)(8 * i + 2) * ldw], a3 = wp[(size_t)(8 * i + 3) * ldw];
        if (!ev) { a0 = 0.f; a1 = 0.f; a2 = 0.f; a3 = 0.f; }
        D = __builtin_amdgcn_mfma_f32_32x32x2f32(a0, xv[0], D, 0, 0, 0); D = __builtin_amdgcn_mfma_f32_32x32x2f32(a1, xv[1], D, 0, 0, 0);
        D = __builtin_amdgcn_mfma_f32_32x32x2f32(a2, xv[2], D, 0, 0, 0); D = __builtin_amdgcn_mfma_f32_32x32x2f32(a3, xv[3], D, 0, 0, 0); }
    return D;
}
DI void ph_odd_prep(const Args& a, const Fr& F, int j, int layer) {
    const bf16* proj = (const bf16*)(F.ws + WS_PROJ); const float* x = (const float*)(F.ws + WS_X);
    float* logf = (float*)(F.ws + WS_LOGF); float* cs = (float*)(F.ws + WS_CS);
    const float* wf = a.in[6] + (size_t)j * 1024 * 3088 + 3072; const float* bfv = a.in[7] + j * 16;
    LAS float* red = (LAS float*)(F.lds); LAS float* lfb = (LAS float*)(F.lds + 131072);
    LAS unsigned* kmx = (LAS unsigned*)(F.lds + 131072 + 8192);
    const int lane = F.lane, wave = F.wave, tid = F.tid, l31 = lane & 31, hi = lane >> 5;
    for (int chunk = F.blk; chunk < 256; chunk += F.G) { const int tok0 = chunk * 128, b = tok0 / SEQ, t0 = tok0 % SEQ;
        __syncthreads();
        if (tid < 16) kmx[tid] = 0u;
        const int tl = wave & 3, kr = wave >> 2;
        f32x16 D = proj32_f32(wf, 3088, 16, x + (size_t)(tok0 + tl * 32 + l31) * DM, kr * 512, lane);
        if (kr == 1) {
#pragma unroll
            for (int r = 0; r < 8; ++r) red[(tl * 8 + r) * 64 + lane] = D[r]; }
        __syncthreads();
        if (kr == 0) {
#pragma unroll
            for (int r = 0; r < 8; ++r) { const int h = (r & 3) + 8 * (r >> 2) + 4 * hi; const float z = D[r] + red[(tl * 8 + r) * 64 + lane] + bfv[h];
                const float ls = fminf(z, 0.f) - log1pf(__expf(-fabsf(z)));
                lfb[(tl * 32 + l31) * 16 + h] = ls * LOG2E; } }
#pragma unroll 1
        for (int i = 0; i < 4; ++i) { const int p = tid + i * NTHR, tk = p >> 4, h = p & 15; const v4u* kp = (const v4u*)(proj + (size_t)(tok0 + tk) * OD_N + OC_K + h * 64); float s = 0.f;
#pragma unroll
            for (int c = 0; c < 8; ++c) { const v4u w = kp[c];
#pragma unroll
                for (int k = 0; k < 4; ++k) { const float e0 = bf2f(w[k] & 0xffffu), e1 = bf2f(w[k] >> 16); s += e0 * e0 + e1 * e1; } }
            __hip_atomic_fetch_max(kmx + h, __float_as_uint(s), __ATOMIC_RELAXED, __HIP_MEMORY_SCOPE_WORKGROUP); }
        __syncthreads();
        for (int i = tid; i < 2048; i += NTHR) { const int h = i >> 7, tk = i & 127; logf[((size_t)b * 16 + h) * SEQ + t0 + tk] = lfb[tk * 16 + h]; }
        if (tid < 32) { const int h = tid & 15, c = tid >> 4; float s = 0.f;
            for (int k = 0; k < 64; ++k) s += lfb[(c * 64 + k) * 16 + h];
            cs[((size_t)b * 16 + h) * 128 + (t0 >> 6) + c] = s; }
        if (tid < 16) __hip_atomic_fetch_max(F.ctl + CW_KMAX + layer * 64 + b * 16 + tid, kmx[tid], RLX_AGENT);
    }
}

struct FoxBias { LAS const float* ng; int tq, kabs0; bool diag;
    DI float operator()(float p, int kvrel) const { const float v = p + ng[kvrel]; return (diag && (kabs0 + kvrel) > tq) ? -INFINITY : v; } };
DI void fox_unit(const Fr& F, int layer, int b, int h, int qb) {
    const bf16* proj = (const bf16*)(F.ws + WS_PROJ); const float* logf = (const float*)(F.ws + WS_LOGF); const float* cs = (const float*)(F.ws + WS_CS); bf16* ao = (bf16*)(F.ws + WS_AO);
    LAS unsigned char* lds = F.lds; LAS float* ng = (LAS float*)(lds + 32768); LAS float* red = (LAS float*)(lds + 65536 + 1024); LAS int* ibox = (LAS int*)(lds + 65536 + 2048);
    const int tid = F.tid, lane = F.lane, wave = F.wave, r32 = lane & 31, hi = lane >> 5, t0 = qb * 256, rowbase = b * SEQ, tq = t0 + wave * 32 + r32;
    __syncthreads();
    bf16x8 qf[4]; float qs = 0.f;
    { const bf16* qp = proj + (size_t)(rowbase + tq) * OD_N + OC_Q + h * 64 + hi * 8;
#pragma unroll
        for (int s = 0; s < 4; ++s) { qf[s] = *(const bf16x8*)(qp + s * 16);
#pragma unroll
            for (int k = 0; k < 8; ++k) { const float e = bf2f((unsigned short)qf[s][k]); qs += e * e; } } }
    qs += __shfl_xor(qs, 32); qs = wave_max(qs);
    if (lane == 0) red[wave] = qs;
    __syncthreads();
    if (tid == 0) { float qm = red[0];
        for (int w = 1; w < 8; ++w) qm = fmaxf(qm, red[w]);
        const float km = __uint_as_float(ld_u32(F.ctl + CW_KMAX + layer * 64 + b * 16 + h));
        const float B2 = 2.f * (sqrtf(qm * km) * 1.01f + 1.f);
        int kt = t0 / 64 - 1, kts = t0 / 64; float D = 0.f;
        while (kt >= 0 && B2 + D >= -160.f) { kts = kt; D += cs[((size_t)b * 16 + h) * 128 + kt]; --kt; }
        ibox[0] = kts; }
    __syncthreads();
    const int kts = ibox[0], s_start = kts * 64, nel = t0 + 256 - s_start;
    { const int i0 = tid * 16; float v[16]; const float* lp = logf + ((size_t)b * 16 + h) * SEQ + s_start + i0;
        if (i0 < nel) {
#pragma unroll
            for (int c = 0; c < 4; ++c) { const f32x4 w = *(const f32x4*)(lp + 4 * c); v[4 * c] = w[0]; v[4 * c + 1] = w[1]; v[4 * c + 2] = w[2]; v[4 * c + 3] = w[3]; } }
        else {
#pragma unroll
            for (int c = 0; c < 16; ++c) v[c] = 0.f; }
#pragma unroll
        for (int c = 1; c < 16; ++c) v[c] += v[c - 1];
        float xsum = v[15];
#pragma unroll
        for (int o = 1; o < 64; o <<= 1) { const float y = __shfl_up(xsum, o); if (lane >= o) xsum += y; }
        if (lane == 63) red[16 + wave] = xsum;
        __syncthreads();
        float off = xsum - v[15];
        for (int w = 0; w < wave; ++w) off += red[16 + w];
        if (i0 < nel) {
#pragma unroll
            for (int c = 0; c < 4; ++c) { f32x4 w = {-(off + v[4 * c]), -(off + v[4 * c + 1]), -(off + v[4 * c + 2]), -(off + v[4 * c + 3])}; *(LAS f32x4*)(ng + i0 + 4 * c) = w; } }
    }
    const int ntile = t0 / 64 + 4 - kts;
    const bf16* kg = proj + (size_t)rowbase * OD_N + OC_K + h * 64; const bf16* vg = proj + (size_t)rowbase * OD_N + OC_V + h * 64;
    const int kr = tid & 31, kc = (tid >> 5) & 7, kst = tid >> 8, vcc = tid & 3, vrow = (tid >> 2) & 63, vdh = tid >> 8;
    const int koff = kst * 4096 + kc * 512 + kr * 16, voff = 8192 + vdh * 4096 + vrow * 64 + vcc * 16;
    { const v4u kv = *(const v4u*)(kg + (size_t)(kts * 64 + kst * 32 + kr) * OD_N + kc * 8), vv = *(const v4u*)(vg + (size_t)(kts * 64 + vrow) * OD_N + vdh * 32 + vcc * 8);
        *(LAS v4u*)(lds + koff) = kv; *(LAS v4u*)(lds + voff) = vv; }
    __syncthreads();
    AttSt S; S.m = -1e30f; S.l = 0.f;
#pragma unroll
    for (int r = 0; r < 16; ++r) { S.o0[r] = 0.f; S.o1[r] = 0.f; }
    const int wlast = t0 + wave * 32 + 31, wfirst = t0 + wave * 32;
    for (int i = 0; i < ntile; ++i) { const int kt = kts + i; LAS unsigned char* buf = lds + (i & 1) * 16384; LAS unsigned char* nbuf = lds + ((i + 1) & 1) * 16384;
        v4u kv, vv; const bool more = i + 1 < ntile;
        if (more) { kv = *(const v4u*)(kg + (size_t)((kt + 1) * 64 + kst * 32 + kr) * OD_N + kc * 8); vv = *(const v4u*)(vg + (size_t)((kt + 1) * 64 + vrow) * OD_N + vdh * 32 + vcc * 8); }
#pragma unroll
        for (int sub = 0; sub < 2; ++sub) { const int kv0 = kt * 64 + sub * 32;
            if (kv0 <= wlast) { FoxBias bf{ng + (kv0 - s_start), tq, kv0, kv0 + 31 > wfirst};
                att_subtile(S, qf, (LAS const char*)buf + sub * 4096, (LAS const char*)buf + 8192, 4096, sub * 32, lane, bf); } }
        if (more) { *(LAS v4u*)(nbuf + koff) = kv; *(LAS v4u*)(nbuf + voff - 8192 + 8192) = vv; }
        __syncthreads(); }
    const float lt = S.l + __shfl_xor(S.l, 32), inv = 1.f / lt;
    bf16* o = ao + (size_t)(rowbase + tq) * 1024 + h * 64;
#pragma unroll
    for (int a4 = 0; a4 < 4; ++a4) { v2u w0, w1;
        w0.x = cvtpk(S.o0[4 * a4] * inv, S.o0[4 * a4 + 1] * inv); w0.y = cvtpk(S.o0[4 * a4 + 2] * inv, S.o0[4 * a4 + 3] * inv);
        w1.x = cvtpk(S.o1[4 * a4] * inv, S.o1[4 * a4 + 1] * inv); w1.y = cvtpk(S.o1[4 * a4 + 2] * inv, S.o1[4 * a4 + 3] * inv);
        *(v2u*)(o + 8 * a4 + 4 * hi) = w0; *(v2u*)(o + 32 + 8 * a4 + 4 * hi) = w1; }
}

DI void ph_ln1_router(const Args& a, const Fr& F, int layer) {
    const float* yp = (const float*)(F.ws + WS_YP); float* x1 = (float*)(F.ws + WS_X1); unsigned char* xb8 = F.ws + WS_XB8;
    unsigned* tope = (unsigned*)(F.ws + WS_TOPE); float* gate = (float*)(F.ws + WS_GATE); unsigned* rank = (unsigned*)(F.ws + WS_RANK);
    const float* g = a.in[10] + (size_t)(layer * 2) * DM; const float* bb = a.in[11] + (size_t)(layer * 2) * DM;
    const float* rw = a.in[12] + (size_t)layer * 1024 * 32; const float* rb = a.in[13] + layer * 32;
    LAS float* red = (LAS float*)(F.lds); LAS unsigned* lcnt = (LAS unsigned*)(F.lds + 131072);
    const int lane = F.lane, wave = F.wave, tid = F.tid, l31 = lane & 31, hi = lane >> 5;
    for (int chunk = F.blk; chunk < 256; chunk += F.G) { const int tok0 = chunk * 128;
        __syncthreads();
        if (tid < 32) lcnt[tid] = 0u;
#pragma unroll 1
        for (int k = 0; k < 16; k += 4) { f32x4 v[4][4];
#pragma unroll
            for (int i = 0; i < 4; ++i)
#pragma unroll
                for (int jj = 0; jj < 4; ++jj) v[i][jj] = *((const f32x4*)(yp + (size_t)(tok0 + wave * 16 + k + i) * DM) + lane + 64 * jj);
#pragma unroll
            for (int i = 0; i < 4; ++i) { const int tok = tok0 + wave * 16 + k + i;
                ln_row(v[i], g, bb, lane);
                store_row_f32(x1 + (size_t)tok * DM, v[i], lane);
#pragma unroll
                for (int jj = 0; jj < 4; ++jj) *((unsigned*)(xb8 + (size_t)tok * DM) + lane + 64 * jj) = pk4_fp8(v[i][jj][0] * F8_SX, v[i][jj][1] * F8_SX, v[i][jj][2] * F8_SX, v[i][jj][3] * F8_SX); } }
        asm volatile("s_waitcnt vmcnt(0)" ::: "memory");
        __syncthreads();
        const int tl = wave & 3, kr = wave >> 2, tokl = tok0 + tl * 32 + l31;
        f32x16 D = proj32_f32(rw, 32, 32, x1 + (size_t)tokl * DM, kr * 512, lane);
        if (kr == 1) {
#pragma unroll
            for (int r = 0; r < 16; ++r) red[(tl * 16 + r) * 64 + lane] = D[r]; }
        __syncthreads();
        if (kr == 0) {
            float lv[32];
#pragma unroll
            for (int r = 0; r < 16; ++r) { const float own = D[r] + red[(tl * 16 + r) * 64 + lane] + rb[crow(r, hi)]; const float oth = __shfl_xor(own, 32);
                lv[crow(r, 0)] = hi == 0 ? own : oth; lv[crow(r, 1)] = hi == 0 ? oth : own; }
            float tv[4]; int te[4];
#pragma unroll
            for (int r = 0; r < 4; ++r) { float mx = -INFINITY; int me = 0;
#pragma unroll
                for (int e = 0; e < 32; ++e) { if (lv[e] > mx) { mx = lv[e]; me = e; } }
                tv[r] = mx; te[r] = me;
#pragma unroll
                for (int e = 0; e < 32; ++e) { if (e == me) lv[e] = -INFINITY; } }
            const float e1 = __expf(tv[1] - tv[0]), e2 = __expf(tv[2] - tv[0]), e3 = __expf(tv[3] - tv[0]); const float inv = 1.f / (1.f + e1 + e2 + e3);
            if (hi == 0) { const size_t o = (size_t)tokl * 4;
                const float gv[4] = {inv, e1 * inv, e2 * inv, e3 * inv};
#pragma unroll
                for (int r = 0; r < 4; ++r) { const unsigned rk = __hip_atomic_fetch_add(lcnt + (te[r] & 31), 1u, __ATOMIC_RELAXED, __HIP_MEMORY_SCOPE_WORKGROUP);
                    tope[o + r] = (unsigned)(te[r] & 31); gate[o + r] = gv[r]; rank[o + r] = rk; } } }
        __syncthreads();
        if (tid < 32) __hip_atomic_store(F.ctl + CW_CNT + chunk * 32 + tid, lcnt[tid], RLX_AGENT);
    }
}

DI void ph_route(const Fr& F) {
    const unsigned char* xb8 = F.ws + WS_XB8; unsigned char* xg = F.ws + WS_XG;
    const unsigned* tope = (const unsigned*)(F.ws + WS_TOPE); const unsigned* rank = (const unsigned*)(F.ws + WS_RANK); unsigned* dest = (unsigned*)(F.ws + WS_DEST);
    LAS unsigned* P = (LAS unsigned*)(F.lds); LAS unsigned* pst = P + 512; LAS unsigned* pad = P + 544; LAS unsigned* base = P + 576; LAS unsigned* nt = P + 608;
    const int tid = F.tid, lane = F.lane, wave = F.wave;
    __syncthreads();
    { const int e = tid & 31, part = tid >> 5; unsigned s = 0u;
        for (int c = 0; c < 16; ++c) s += ld_u32(F.ctl + CW_CNT + (part * 16 + c) * 32 + e);
        P[part * 32 + e] = s; }
    __syncthreads();
    if (tid < 32) { unsigned tot = 0u;
        for (int p = 0; p < 16; ++p) tot += P[p * 32 + tid];
        pad[tid] = (tot + 255u) & ~255u; }
    __syncthreads();
    if (tid == 0) { unsigned acc = 0u;
        for (int e = 0; e < 32; ++e) { pst[e] = acc; acc += pad[e]; }
        nt[0] = acc >> 8; }
    __syncthreads();
    for (int chunk = F.blk; chunk < 256; chunk += F.G) {
        __syncthreads();
        if (tid < 32) { unsigned off = 0u; const int pf = chunk >> 4;
            for (int p = 0; p < pf; ++p) off += P[p * 32 + tid];
            for (int c = pf * 16; c < chunk; ++c) off += ld_u32(F.ctl + CW_CNT + c * 32 + tid);
            base[tid] = pst[tid] + off; }
        __syncthreads();
        for (int i = 0; i < 16; ++i) { const int tok = chunk * 128 + wave * 16 + i;
            const v4u src0 = *((const v4u*)(xb8 + (size_t)tok * DM) + lane);
#pragma unroll
            for (int k = 0; k < 4; ++k) { const unsigned e = tope[(size_t)tok * 4 + k], d = base[e] + rank[(size_t)tok * 4 + k];
                if (lane == 0) dest[(size_t)tok * 4 + k] = d;
                *((v4u*)(xg + (size_t)d * DM) + lane) = src0; } }
        if (chunk == 0) { const unsigned ntl = nt[0];
            if (tid == 0) __hip_atomic_store(F.ctl + CW_TILE, ntl, RLX_AGENT);
            for (unsigned i = tid; i < ntl; i += NTHR) { unsigned e = 0u;
                for (unsigned k = 1; k < 32; ++k) if (pst[k] <= i * 256u) e = k;
                __hip_atomic_store(F.ctl + CW_TILE + 64 + i, e, RLX_AGENT); } }
    }
}

DI void ph_combine_ln2(const Args& a, const Fr& F, int layer) {
    const float* x1 = (const float*)(F.ws + WS_X1); const bf16* yr = (const bf16*)(F.ws + WS_XG); float* xo = (float*)(F.ws + WS_X); bf16* xb = (bf16*)(F.ws + WS_XB);
    const float* gate = (const float*)(F.ws + WS_GATE); const unsigned* dest = (const unsigned*)(F.ws + WS_DEST);
    const float* g = a.in[10] + (size_t)(layer * 2 + 1) * DM; const float* bb = a.in[11] + (size_t)(layer * 2 + 1) * DM;
    const int lane = F.lane; const int gw = F.blk * NWAVES + F.wave, NGW = F.G * NWAVES;
    for (int tok = gw; tok < NTOK; tok += 2 * NGW) { f32x4 v[2][4];
#pragma unroll
        for (int i = 0; i < 2; ++i) { const int tk = tok + i * NGW; if (tk < NTOK) {
#pragma unroll
            for (int jj = 0; jj < 4; ++jj) v[i][jj] = *((const f32x4*)(x1 + (size_t)tk * DM) + lane + 64 * jj) * ALPHA;
#pragma unroll
            for (int k = 0; k < 4; ++k) { const float gk = gate[(size_t)tk * 4 + k]; const unsigned d = dest[(size_t)tk * 4 + k];
#pragma unroll
                for (int jj = 0; jj < 4; ++jj) { const v2u w = *((const v2u*)(yr + (size_t)d * DM) + lane + 64 * jj);
                    v[i][jj][0] += gk * bf2f(w.x & 0xffffu); v[i][jj][1] += gk * bf2f(w.x >> 16); v[i][jj][2] += gk * bf2f(w.y & 0xffffu); v[i][jj][3] += gk * bf2f(w.y >> 16); } } } }
#pragma unroll
        for (int i = 0; i < 2; ++i) { const int tk = tok + i * NGW; if (tk < NTOK) {
            ln_row(v[i], g, bb, lane);
            if (layer == DEPTH - 1) store_row_f32(a.out + (size_t)tk * DM, v[i], lane);
            else { store_row_f32(xo + (size_t)tk * DM, v[i], lane); store_row_bf16(xb + (size_t)tk * DM, v[i], lane); } } } }
}
constexpr int LDS_BYTES = 147456;
constexpr int LDS_BARW = 145408, LDS_QSLOT = 145472;
constexpr int NPL = 11;
constexpr int NPHASE = 1 + NPL * DEPTH;
#ifndef MK_SINGLE
#define MK_SINGLE 1
#endif
DI int q_next(const Fr& F, unsigned* ctr) {
    LAS int* slot = (LAS int*)(F.lds + LDS_QSLOT);
    __syncthreads();
    if (F.tid == 0) *slot = (int)__hip_atomic_fetch_add(ctr, 1u, RLX_AGENT);
    __syncthreads();
    return *slot;
}
DI int lane_id_fresh() { unsigned m_ = ~0u; asm volatile("" : "+s"(m_)); return (int)__builtin_amdgcn_mbcnt_hi(m_, __builtin_amdgcn_mbcnt_lo(m_, 0u)); }
#define RETID(F) do { int t2_ = F.tid; asm volatile("" : "+v"(t2_)); F.tid = t2_; F.lane = t2_ & 63; F.wave = __builtin_amdgcn_readfirstlane(t2_ >> 6); } while (0)
#ifndef PROBE_DUP
#define PROBE_DUP -1
#endif
#define NREP(q) ((PROBE_DUP == (q)) ? 2 : 1)
#define AS4 __attribute__((address_space(4)))
#define SITE() Args a; Fr F; { const AS4 Args* ap = (const AS4 Args*)__builtin_amdgcn_kernarg_segment_ptr(); asm volatile("" : "+s"(ap)); \
        _Pragma("unroll") for (int i_ = 0; i_ < 18; ++i_) a.in[i_] = ap->in[i_]; a.out = ap->out; a.ws = ap->ws; a.ph_lo = 0; a.ph_hi = 0; \
        int w_ = wv_s; asm volatile("" : "+s"(w_)); int t_ = w_ * 64 + lane_id_fresh(); asm volatile("" : "+v"(t_)); F.tid = t_; F.lane = t_ & 63; F.wave = __builtin_amdgcn_readfirstlane(t_ >> 6); \
        F.lds = (LAS unsigned char*)lds_raw; F.ws = a.ws; F.ctl = (unsigned*)(a.ws + WS_CTL); F.blk = blockIdx.x; F.G = gridDim.x; }
__global__ void __launch_bounds__(NTHR, 2) mega_fwd(Args a0) {
    extern __shared__ __attribute__((aligned(16))) unsigned char lds_raw[];
    const int wv_s = __builtin_amdgcn_readfirstlane((int)(threadIdx.x >> 6));
#if MK_SINGLE
    constexpr int lo = 0, hi = NPHASE; constexpr bool single = true;
#else
    const int lo = a0.ph_lo, hi = a0.ph_hi; constexpr bool single = false;
#endif
    if (threadIdx.x == 0) *(LAS v4u*)((LAS unsigned char*)lds_raw + LDS_BARW) = (v4u){0u, 0u, 0u, 0u};
    __syncthreads();
    if (single) (void)xcd_barrier_post((unsigned*)(a0.ws + WS_CTL) + CW_BAR, (volatile LAS unsigned*)((LAS unsigned char*)lds_raw + LDS_BARW));
#define IN(k) (lo <= (k) && (k) < hi)
#define SEAM() do { if (single) { const AS4 Args* ap_ = (const AS4 Args*)__builtin_amdgcn_kernarg_segment_ptr(); asm volatile("" : "+s"(ap_)); int w_ = wv_s; asm volatile("" : "+s"(w_)); \
        XcdBarrier b_; b_.bar = (unsigned*)(ap_->ws + WS_CTL) + CW_BAR; b_.x = xb_xcc_id(); b_.st = (volatile LAS unsigned*)((LAS unsigned char*)lds_raw + LDS_BARW); \
        xcd_barrier(b_, (w_ == 0) && (lane_id_fresh() == 0)); } } while (0)
    if (IN(0)) { _Pragma("unroll 1") for (int rep = 0; rep < NREP(100); ++rep) { { SITE(); ph_prologue(a, F); } SEAM(); } }
#pragma unroll 1
    for (int L = 0; L < DEPTH; ++L) {
        const int pb = 1 + NPL * L, j = L >> 1; const bool odd = (L & 1) != 0;
        if (IN(pb + 0)) _Pragma("unroll 1") for (int rep = 0; rep < NREP(0); ++rep) {
            { SITE();
            const bf16* w = odd ? (const bf16*)(F.ws + WS_WOD) + (size_t)j * OD_N * 1024 : (const bf16*)(F.ws + WS_WEV) + (size_t)j * EV_N * 1024;
            const int N = odd ? OD_N : EV_N;
            pg8::Gemm g{(const bf16*)(F.ws + WS_XB), w, NTOK, N, 1024}; pg8::StaticOrder S; S.init(NTOK, N, F.G, F.blk);
            pg8::EpiBf16<0> E{(bf16*)(F.ws + WS_PROJ), N, nullptr, 1024, (size_t)1024, C2F};
            pg8::gemm_phase<pg8::EpiBf16<0>, pg8::StaticOrder, true, true>(F.lds, g, S, E, F.tid); }
            SEAM(); }
        if (IN(pb + 1)) _Pragma("unroll 1") for (int rep = 0; rep < NREP(1); ++rep) { { SITE(); if (odd) ph_odd_prep(a, F, j, L); else ph_even_prep(a, F, j); } SEAM(); }
        if (!odd && IN(pb + 2)) _Pragma("unroll 1") for (int rep = 0; rep < NREP(2); ++rep) {
            { SITE(); unsigned* ctr = F.ctl + CW_Q + 64 * (L * 2) + 1024 * rep;
            for (;;) { const int it = q_next(F, ctr); if (it >= 1280) break; RETID(F);
                if (it < 1024) { if (!(EXPF & 16)) idx_unit(F, it & 3, 255 - (it >> 2)); } else { if (!(EXPF & 32)) moba_gate_chunk(F, it - 1024); } } }
            SEAM(); }
        if (IN(pb + 3)) _Pragma("unroll 1") for (int rep = 0; rep < ((PROBE_DUP == 3 || (PROBE_DUP == 31 && odd) || ((PROBE_DUP == 32 || PROBE_DUP == 33) && !odd)) ? 2 : 1); ++rep) {
            { SITE(); unsigned* ctr = F.ctl + CW_Q + 64 * (L * 2 + 1) + 1024 * rep;
            if (odd) { for (;;) { const int it = q_next(F, ctr); if (it >= 2048) break; RETID(F); const int bh = it & 63; fox_unit(F, L, bh >> 4, bh & 15, 31 - (it >> 6)); } }
            else { for (;;) { const int it = q_next(F, ctr); if (it >= 2048) break; RETID(F);
                    if (it < 1024) { const int bh = it & 31; if (!(rep == 1 && PROBE_DUP == 33)) moba_unit(a, F, bh >> 3, bh & 7, it >> 5); } else { if (!(rep == 1 && PROBE_DUP == 32)) dsa_chunk(a, F, it - 1024); } } } }
            SEAM(); }
        if (!odd && IN(pb + 4)) _Pragma("unroll 1") for (int rep = 0; rep < NREP(4); ++rep) { { SITE(); ph_even_post(F, j); } SEAM(); }
        if (IN(pb + 5)) _Pragma("unroll 1") for (int rep = 0; rep < NREP(5); ++rep) {
            { SITE();
            const float* xin = (L == 0) ? a.in[0] : (const float*)(F.ws + WS_X);
            pg8::Gemm g{(const bf16*)(F.ws + WS_AO), (const bf16*)(F.ws + WS_WOUT) + (size_t)L * 1024 * 1024, NTOK, 1024, 1024}; pg8::StaticOrder S; S.init(NTOK, 1024, F.G, F.blk);
            EpiResF32 E{xin, (float*)(F.ws + WS_YP), ALPHA};
            pg8::gemm_phase<EpiResF32, pg8::StaticOrder, true, true>(F.lds, g, S, E, F.tid); }
            SEAM(); }
        if (IN(pb + 6)) _Pragma("unroll 1") for (int rep = 0; rep < NREP(6); ++rep) { { SITE(); ph_ln1_router(a, F, L); } SEAM(); }
        if (IN(pb + 7)) _Pragma("unroll 1") for (int rep = 0; rep < NREP(7); ++rep) { { SITE(); ph_route(F); } SEAM(); }
        if (IN(pb + 8)) _Pragma("unroll 1") for (int rep = 0; rep < NREP(8); ++rep) {
            { SITE(); const int ntl = (int)ld_u32(F.ctl + CW_TILE);
            pg8::Gemm g{(const bf16*)(F.ws + WS_XG), (const bf16*)(F.ws + WS_WGU + (size_t)L * 32 * 2048 * 1024), NR_MAX, 32 * 2048, 512};
            GroupOrder S{F.ctl + CW_TILE + 64, ntl, 3, F.G, F.blk};
            EpiSwiglu E{F.ws + WS_ACT, a.in[15] + (size_t)L * 32 * 2048};
            pg8::gemm_phase<EpiSwiglu, GroupOrder, true, true, true>(F.lds, g, S, E, F.tid); }
            SEAM(); }
        if (IN(pb + 9)) _Pragma("unroll 1") for (int rep = 0; rep < NREP(9); ++rep) {
            { SITE(); const int ntl = (int)ld_u32(F.ctl + CW_TILE);
            pg8::Gemm g{(const bf16*)(F.ws + WS_ACT), (const bf16*)(F.ws + WS_WDN + (size_t)L * 32 * 1024 * 1024), NR_MAX, 32 * 1024, 512};
            GroupOrder S{F.ctl + CW_TILE + 64, ntl, 2, F.G, F.blk};
            EpiDown E{(bf16*)(F.ws + WS_XG), a.in[17] + (size_t)L * 32 * 1024};
            pg8::gemm_phase<EpiDown, GroupOrder, true, true, true>(F.lds, g, S, E, F.tid); }
            SEAM(); }
        if (IN(pb + 10)) _Pragma("unroll 1") for (int rep = 0; rep < NREP(10); ++rep) { { SITE(); ph_combine_ln2(a, F, L); } if (L + 1 < DEPTH || rep + 1 < NREP(10)) SEAM(); }
    }
#undef IN
#undef SEAM
}

extern "C" void kernel_launch(void* const* d_in, const int* in_sizes, int n_in, void* d_out, int out_size, void* d_ws, size_t ws_size, hipStream_t stream) {
    static int grid = 0;
    if (grid == 0) {
        if (n_in != 18 || out_size != NTOK * DM || ws_size < WS_END) { fprintf(stderr, "kernel_launch: unexpected shapes (n_in %d, out %d, ws %zu); nothing launched\n", n_in, out_size, ws_size); grid = -1; return; }
        int dev = 0, cus = 0, per_cu = 0;
        if (hipGetDevice(&dev) != hipSuccess || hipDeviceGetAttribute(&cus, hipDeviceAttributeMultiprocessorCount, dev) != hipSuccess) { grid = -1; return; }
        if (hipFuncSetAttribute((const void*)mega_fwd, hipFuncAttributeMaxDynamicSharedMemorySize, LDS_BYTES) != hipSuccess) { fprintf(stderr, "kernel_launch: hipFuncSetAttribute failed\n"); grid = -1; return; }
        if (hipOccupancyMaxActiveBlocksPerMultiprocessor(&per_cu, (const void*)mega_fwd, NTHR, LDS_BYTES) != hipSuccess || per_cu < 1) fprintf(stderr, "kernel_launch: occupancy query reports %d\n", per_cu);
        (void)hipGetLastError();
        grid = cus;
    }
    if (grid < 0) return;
    (void)hipMemsetAsync((char*)d_ws + WS_CTL, 0, CTL_ZERO_BYTES, stream);
#ifdef EXP_SKIP
    (void)hipMemsetAsync((char*)d_ws + WS_AO, 0, 64 * MiB, stream);
    (void)hipMemsetAsync((char*)d_ws + WS_OL, 0, 64 * MiB, stream);
    if (EXP_SKIP & 4) { (void)hipMemsetAsync((char*)d_ws + WS_XG, 0, 272 * MiB, stream); (void)hipMemsetAsync((char*)d_ws + WS_DEST, 0, 1 * MiB, stream); }
#endif
    Args a{};
    for (int i = 0; i < 18; ++i) a.in[i] = (const float*)d_in[i];
    a.out = (float*)d_out; a.ws = (unsigned char*)d_ws;
#if MK_SINGLE
    a.ph_lo = 0; a.ph_hi = NPHASE;
    hipLaunchKernelGGL(mega_fwd, dim3(grid), dim3(NTHR), LDS_BYTES, stream, a);
#else
    for (int p = 0; p < NPHASE; ++p) {
        if (p > 0) { const int L = (p - 1) / NPL, q = (p - 1) % NPL; if ((L & 1) && (q == 2 || q == 4)) continue;
#ifdef EXP_SKIP
            if ((EXP_SKIP & 1) && !(L & 1) && q <= 4) continue;
            if ((EXP_SKIP & 2) && (L & 1) && q <= 4) continue;
            if ((EXP_SKIP & 4) && q >= 7 && q <= 9) continue;
#endif
        }
        a.ph_lo = p; a.ph_hi = p + 1;
        hipLaunchKernelGGL(mega_fwd, dim3(grid), dim3(NTHR), LDS_BYTES, stream, a);
    }
#endif
}
```

```cpp
#include <hip/hip_runtime.h>
#include <cstdio>
#include <cstdint>
#ifdef EXP_SKIP
#define EXPF EXP_SKIP
#else
#define EXPF 0
#endif
constexpr int NB = 4, SEQ = 8192, DM = 1024, NTOK = NB * SEQ, DEPTH = 4;
constexpr int EV_N = 2560, OD_N = 3072;
constexpr int EC_QA = 0, EC_QB = 512, EC_KB = 1024, EC_VB = 1536, EC_CKV = 2048, EC_QI = 2176, EC_KI = 2432, EC_WI = 2496;
constexpr int OC_Q = 0, OC_K = 1024, OC_V = 2048;
constexpr float LOG2E = 1.4426950408889634f;
constexpr float C2F = 0.125f * LOG2E;
constexpr float ALPHA = 1.681792830507429f;
constexpr float LN_EPS = 1e-5f;
constexpr int NR_MAX = 131072 + 32 * 256;
constexpr int NWAVES = 8, NTHR = 512;
constexpr size_t MiB = (size_t)1 << 20;
constexpr size_t WS_CTL = 0, CTL_ZERO_BYTES = 4 * MiB;
constexpr size_t WS_WEV = 8 * MiB, WS_WOD = 18 * MiB, WS_WOUT = 30 * MiB, WS_WUKT = 38 * MiB, WS_WUVT = 39 * MiB;
constexpr size_t WS_WGU = 40 * MiB, WS_WDN = 552 * MiB;
constexpr size_t WS_X = 808 * MiB, WS_X1 = 936 * MiB, WS_YP = 1064 * MiB, WS_XB = 1192 * MiB;
constexpr size_t WS_PROJ = 1256 * MiB, WS_AO = 1448 * MiB, WS_XG = 1512 * MiB, WS_ACT = 1784 * MiB;
constexpr size_t WS_QL = 2056 * MiB, WS_OL = 2120 * MiB, WS_CKVN = 2184 * MiB, WS_SEL = 2192 * MiB;
constexpr size_t WS_KBAR = 2208 * MiB, WS_SEL3 = 2209 * MiB, WS_LOGF = 2210 * MiB, WS_CS = 2212 * MiB;
constexpr size_t WS_TOPE = 2213 * MiB, WS_GATE = 2214 * MiB, WS_RANK = 2215 * MiB, WS_DEST = 2216 * MiB, WS_PML = 2217 * MiB;
constexpr size_t WS_XB8 = 2226 * MiB;
constexpr size_t WS_KIC = 2258 * MiB;
constexpr size_t WS_END = 2262 * MiB;
constexpr float F8_SX = 16.f, F8_SWG = 256.f, F8_SA = 4.f, F8_SWD = 512.f;
constexpr int CW_BAR = 4096, CW_Q = 8192, CW_KMAX = 12288, CW_CNT = 16384, CW_TILE = 32768;

#define GAS __attribute__((address_space(1)))
#define LAS __attribute__((address_space(3)))
#define DI __device__ __forceinline__
typedef unsigned short bf16;
typedef unsigned v4u __attribute__((ext_vector_type(4)));
typedef unsigned v2u __attribute__((ext_vector_type(2)));
typedef float f32x4 __attribute__((ext_vector_type(4)));
typedef float f32x2 __attribute__((ext_vector_type(2)));
typedef float f32x16 __attribute__((ext_vector_type(16)));
typedef short bf16x8 __attribute__((ext_vector_type(8)));
typedef short s16x4 __attribute__((ext_vector_type(4)));
typedef __bf16 bf16x2_t __attribute__((ext_vector_type(2)));
typedef GAS unsigned gu32;
#define RLX_AGENT __ATOMIC_RELAXED, __HIP_MEMORY_SCOPE_AGENT
#define LDS_WAIT() asm volatile("s_waitcnt lgkmcnt(0)" ::: "memory")

DI float bf2f(unsigned v) { return __uint_as_float(v << 16); }
DI unsigned cvtpk(float lo, float hi) { f32x2 v = {lo, hi}; bf16x2_t b = __builtin_convertvector(v, bf16x2_t); return __builtin_bit_cast(unsigned, b); }
DI unsigned f2bf(float f) { return cvtpk(f, 0.f) & 0xffffu; }
DI unsigned pk4_fp8(float a, float b, float c, float d) {
    a = fminf(fmaxf(a, -448.f), 448.f); b = fminf(fmaxf(b, -448.f), 448.f); c = fminf(fmaxf(c, -448.f), 448.f); d = fminf(fmaxf(d, -448.f), 448.f);
    int w = 0; w = __builtin_amdgcn_cvt_pk_fp8_f32(a, b, w, false); w = __builtin_amdgcn_cvt_pk_fp8_f32(c, d, w, true); return (unsigned)w; }
DI float ex2(float x) { return __builtin_amdgcn_exp2f(x); }
DI float wave_sum(float v) {
#pragma unroll
    for (int o = 1; o < 64; o <<= 1) v += __shfl_xor(v, o);
    return v;
}
DI float wave_max(float v) {
#pragma unroll
    for (int o = 1; o < 64; o <<= 1) v = fmaxf(v, __shfl_xor(v, o));
    return v;
}
DI unsigned ld_u32(const unsigned* p) { return __hip_atomic_load(p, RLX_AGENT); }
DI int crow(int r, int hi) { return (r & 3) + 8 * (r >> 2) + 4 * hi; }
DI f32x16 mfma32(bf16x8 a, bf16x8 b, f32x16 c) { return __builtin_amdgcn_mfma_f32_32x32x16_bf16(a, b, c, 0, 0, 0); }
DI f32x4 mfma16(bf16x8 a, bf16x8 b, f32x4 c) { return __builtin_amdgcn_mfma_f32_16x16x32_bf16(a, b, c, 0, 0, 0); }
typedef short v4i16_t __attribute__((ext_vector_type(4)));
DI s16x4 vtr(LAS const char* p) { return __builtin_bit_cast(s16x4, __builtin_amdgcn_ds_read_tr16_b64_v4i16((LAS v4i16_t*)p)); }
DI bf16x8 cat8(s16x4 a, s16x4 b) { return (bf16x8){a[0], a[1], a[2], a[3], b[0], b[1], b[2], b[3]}; }
DI int t5_bucket(int n) {
    if (n < 16) return n;
    int bkt = 16;
    bkt += (n >= 21); bkt += (n >= 27); bkt += (n >= 35); bkt += (n >= 46); bkt += (n >= 59); bkt += (n >= 77); bkt += (n >= 99); bkt += (n >= 128);
    bkt += (n >= 166); bkt += (n >= 216); bkt += (n >= 280); bkt += (n >= 363); bkt += (n >= 470); bkt += (n >= 609); bkt += (n >= 790);
    return bkt;
}
namespace pg8 {
#define PG8_LAS __attribute__((address_space(3)))
typedef unsigned short bf16_t;
typedef short bf16x8 __attribute__((ext_vector_type(8)));
typedef float f32x4 __attribute__((ext_vector_type(4)));
typedef unsigned u32x4 __attribute__((ext_vector_type(4)));
constexpr int BM = 256, BK = 64, HALF = 128, HTB = HALF * BK * 2  , STAGE_BYTES = 8 * HTB, NXCD = 8, WGM = 8;

__host__ __device__ __forceinline__ int lds_byte(int r, int c) { const int st = (r >> 4) * 2 + (c >> 5), rr = r & 15, cc = c & 31, ob = rr * 64 + cc * 2; return st * 1024 + (ob ^ (((ob >> 9) & 1) << 5)); }
__host__ __device__ __forceinline__ void stage_rc(int b, int& R, int& C) { const int st = b / 1024, sb = b % 1024, swz = sb ^ (((sb >> 9) & 1) << 5); R = (st >> 1) * 16 + swz / 64; C = (st & 1) * 32 + (swz % 64) / 2; }
__host__ __device__ __forceinline__ int perm32(int rho) { const int n = rho >> 4, i = rho & 15; return 8 * (i >> 2) + 4 * n + (i & 3); }

typedef int i32x8 __attribute__((ext_vector_type(8))); typedef int i32x4v __attribute__((ext_vector_type(4)));
__device__ __forceinline__ i32x8 pg8_cat8(bf16x8 lo, bf16x8 hi) { const i32x4v a = __builtin_bit_cast(i32x4v, lo), b = __builtin_bit_cast(i32x4v, hi); return (i32x8){a[0], a[1], a[2], a[3], b[0], b[1], b[2], b[3]}; }
struct Unit { int pm, pn; };
struct Gemm { const bf16_t* A; const bf16_t* Bt; int M, N, K; };

struct StaticOrder {
    int nM, nN, nwg, G, c;
    __host__ __device__ void init(int M, int N, int G_, int c_) { nM = M / BM; nN = N / BM; nwg = nM * nN; G = G_; c = c_; }
    __host__ __device__ bool next(int i, Unit& u) const {
        const long L = (long)i * G + c; if (L >= nwg) return false;
        int wgid = (int)L; { const int q = nwg / NXCD, r = nwg % NXCD, xcd = wgid % NXCD, off = wgid / NXCD; wgid = (xcd < r ? xcd * (q + 1) : r * (q + 1) + (xcd - r) * q) + off; }
        const int nig = WGM * nN, gid = wgid / nig, fm = gid * WGM, gsz = (nM - fm) < WGM ? (nM - fm) : WGM;
        u.pm = fm + ((wgid % nig) % gsz); u.pn = (wgid % nig) / gsz; return true;
    }
    __device__ __forceinline__ void a_ready(const Unit&) const {}
    __device__ __forceinline__ void done(const Unit&) const {}
};

__device__ __forceinline__ unsigned cvt_pk_bf16(float lo, float hi) { unsigned r; asm volatile("v_cvt_pk_bf16_f32 %0, %1, %2" : "=v"(r) : "v"(lo), "v"(hi)); return r; }
typedef float f32x2 __attribute__((ext_vector_type(2)));
__device__ __forceinline__ f32x2 gelu_pk(f32x2 v) {
    const f32x2 av = __builtin_elementwise_abs(v), d = av * 0.2316418882f + 1.0f;
    f32x2 t; t.x = __builtin_amdgcn_rcpf(d.x); t.y = __builtin_amdgcn_rcpf(d.y);
    f32x2 q = t * 0.5307027145f + (-0.7265760135f); q = q * t + 0.7107068705f; q = q * t + (-0.142248368f); q = q * t + 0.127414796f; q = q * t;
    const f32x2 s = (v * v) * (-0.72134752044f);
    f32x2 e; e.x = __builtin_amdgcn_exp2f(s.x); e.y = __builtin_amdgcn_exp2f(s.y);
    const f32x2 m = v * (q * e), r = v - m;
    f32x2 o; o.x = v.x < 0.f ? m.x : r.x; o.y = v.y < 0.f ? m.y : r.y; return o;
}

template <int ACT  > struct EpiBf16 {
    static constexpr bool PERM = true, AFTER_DRAIN = false; static_assert(ACT == 0 || ACT == 1, "EpiBf16: ACT is 0 (none) or 1 (gelu_pk)");
    bf16_t* O; int ldc; const float* bias; int split_cols; size_t split_stride; float scale0;
    __device__ __forceinline__ void operator()(const f32x4 (&acc)[2][2][4][2], const Unit& u, int wr, int wc, int fr, int fq) const {
        const int row0 = u.pm * BM + wr * 64 + fr; int colt = u.pn * BM; bf16_t* base = O;
        float sc = 1.f; if (split_cols) { const int t = colt / split_cols; base += (size_t)t * split_stride; colt -= t * split_cols; if (t == 0) sc = scale0; }
        const int col0 = colt + wc * 32 + 8 * fq, bcol0 = u.pn * BM + wc * 32 + 8 * fq;
        f32x4 bv[2][2];
#pragma unroll
        for (int bj = 0; bj < 2; ++bj)
#pragma unroll
            for (int n = 0; n < 2; ++n) bv[bj][n] = bias ? *(const f32x4*)(bias + bcol0 + bj * HALF + 4 * n) : (f32x4){0.f, 0.f, 0.f, 0.f};
#pragma unroll
        for (int ai = 0; ai < 2; ++ai)
#pragma unroll
            for (int m = 0; m < 4; ++m) { bf16_t* rowp = base + (size_t)(row0 + ai * HALF + m * 16) * ldc + col0;
#pragma unroll
                for (int bj = 0; bj < 2; ++bj) { f32x4 v0 = acc[ai][bj][m][0] + bv[bj][0], v1 = acc[ai][bj][m][1] + bv[bj][1];
                    if (ACT == 1) { f32x2 a = gelu_pk((f32x2){v0[0], v0[1]}), b = gelu_pk((f32x2){v0[2], v0[3]}), c = gelu_pk((f32x2){v1[0], v1[1]}), d = gelu_pk((f32x2){v1[2], v1[3]});
                        v0 = (f32x4){a.x, a.y, b.x, b.y}; v1 = (f32x4){c.x, c.y, d.x, d.y}; }
                    v0 = v0 * sc; v1 = v1 * sc; u32x4 w; w.x = cvt_pk_bf16(v0[0], v0[1]); w.y = cvt_pk_bf16(v0[2], v0[3]); w.z = cvt_pk_bf16(v1[0], v1[1]); w.w = cvt_pk_bf16(v1[2], v1[3]);
                    *(u32x4*)(rowp + bj * HALF) = w; } }
    }
};

template <class Epi, class Sched, bool ALIGN_EPI = false, bool SP2 = false, bool F8 = false>
__device__ __forceinline__ void gemm_phase(PG8_LAS unsigned char* lds, const Gemm g, const Sched& S, const Epi& E, int tid_in) {
    int tid_l = tid_in; asm volatile("" : "+v"(tid_l));
    const int tid = tid_l, wid = __builtin_amdgcn_readfirstlane(tid >> 6), lane = tid & 63, wr = wid >> 2, wc = wid & 3, fr = lane & 15, fq = lane >> 4;
    const int K = g.K, nt = K / BK;
    unsigned voffA[2], voffB[2];
#pragma unroll
    for (int i = 0; i < 2; ++i) { int R, C; stage_rc(tid * 16 + i * 8192, R, C); const int Rb = Epi::PERM ? ((R & ~31) + perm32(R & 31)) : R;
        voffA[i] = (unsigned)(R * K + C) * 2u; voffB[i] = (unsigned)(Rb * K + C) * 2u; }
    const size_t kstep = (size_t)(BK * 2);
    const size_t hstep = (size_t)HALF * K * 2;
    const size_t tstep = 2 * hstep;
    const unsigned ldsw = (unsigned)wid * 1024u;
    const int aoff = lds_byte(wr * 64 + fr, fq * 8), boff = lds_byte(wc * 32 + fr, fq * 8);
#define PG8_SA(b, h) (((b) * 2 + (h)) * HTB)
#define PG8_SB(b, h) ((4 + (b) * 2 + (h)) * HTB)
#define PG8_STAGE(bufoff, gbase, voff) do { _Pragma("unroll") for (int _i = 0; _i < 2; ++_i) \
        __builtin_amdgcn_global_load_lds((const unsigned*)((const char*)(gbase) + (voff)[_i]), (PG8_LAS unsigned*)(lds + (bufoff) + ldsw + _i * 8192), 16, 0, 0); } while (0)
#define PG8_LDA(dst, b, h) do { _Pragma("unroll") for (int m = 0; m < 4; ++m) _Pragma("unroll") for (int k = 0; k < 2; ++k) dst[m][k] = *(const PG8_LAS bf16x8*)(lds + PG8_SA(b, h) + aoff + m * 2048 + k * 1024); } while (0)
#define PG8_LDB(dst, b, h) do { _Pragma("unroll") for (int n = 0; n < 2; ++n) _Pragma("unroll") for (int k = 0; k < 2; ++k) dst[n][k] = *(const PG8_LAS bf16x8*)(lds + PG8_SB(b, h) + boff + n * 2048 + k * 1024); } while (0)
#define PG8_MMA(ai, bj, At, Bt) do { __builtin_amdgcn_s_setprio(1); if constexpr (!F8) { _Pragma("unroll") for (int m = 0; m < 4; ++m) _Pragma("unroll") for (int n = 0; n < 2; ++n) _Pragma("unroll") for (int k = 0; k < 2; ++k) \
        acc[ai][bj][m][n] = __builtin_amdgcn_mfma_f32_16x16x32_bf16(Bt[n][k], At[m][k], acc[ai][bj][m][n], 0, 0, 0); } else { _Pragma("unroll") for (int m = 0; m < 4; ++m) _Pragma("unroll") for (int n = 0; n < 2; ++n) \
        acc[ai][bj][m][n] = __builtin_amdgcn_mfma_scale_f32_16x16x128_f8f6f4(pg8_cat8(Bt[n][0], Bt[n][1]), pg8_cat8(At[m][0], At[m][1]), acc[ai][bj][m][n], 0, 0, 0, 0x7F7F7F7F, 0, 0x7F7F7F7F); \
        _Pragma("unroll") for (int m = 0; m < 4; ++m) _Pragma("unroll") for (int n = 0; n < 2; ++n) asm volatile("" : "+v"(acc[ai][bj][m][n]));   } __builtin_amdgcn_s_setprio(0); } while (0)
#define PG8_WAIT_V(n) asm volatile("s_waitcnt vmcnt(" #n ")" ::: "memory")
#define PG8_WAIT_L(n) asm volatile("s_waitcnt lgkmcnt(" #n ")" ::: "memory")
#define PG8_BAR __builtin_amdgcn_s_barrier()
#define PG8_SCHED __builtin_amdgcn_sched_barrier(0)
    Unit cur, nxt; int ui = 0;
    if (!S.next(0, cur)) return;
    f32x4 acc[2][2][4][2];
#pragma unroll
    for (int a = 0; a < 2; ++a)
#pragma unroll
        for (int b = 0; b < 2; ++b)
#pragma unroll
            for (int m = 0; m < 4; ++m)
#pragma unroll
                for (int n = 0; n < 2; ++n) acc[a][b][m][n] = (f32x4){0.f, 0.f, 0.f, 0.f};
    bf16x8 At[4][2], B0[2][2], B1[2][2];
    const char* cA = (const char*)g.A + (size_t)cur.pm * tstep; const char* cB = (const char*)g.Bt + (size_t)cur.pn * tstep;
    S.a_ready(cur);
    if constexpr (SP2) {
        PG8_STAGE(PG8_SB(0, 0), cB, voffB); PG8_STAGE(PG8_SB(0, 1), cB + hstep, voffB); PG8_STAGE(PG8_SA(0, 0), cA, voffA); PG8_STAGE(PG8_SA(0, 1), cA + hstep, voffA);
        if (wr == 1) PG8_BAR;
        PG8_WAIT_V(2); PG8_BAR;
        PG8_STAGE(PG8_SB(1, 0), cB + kstep, voffB); PG8_STAGE(PG8_SA(1, 0), cA + kstep, voffA); PG8_STAGE(PG8_SB(1, 1), cB + hstep + kstep, voffB);
        PG8_WAIT_V(6); PG8_BAR;
    } else {
        PG8_STAGE(PG8_SB(0, 0), cB, voffB); PG8_STAGE(PG8_SA(0, 0), cA, voffA); PG8_STAGE(PG8_SB(0, 1), cB + hstep, voffB); PG8_STAGE(PG8_SA(0, 1), cA + hstep, voffA);
        if (wr == 1) PG8_BAR;
        PG8_WAIT_V(4); PG8_BAR;
        PG8_STAGE(PG8_SB(1, 0), cB + kstep, voffB); PG8_STAGE(PG8_SA(1, 0), cA + kstep, voffA); PG8_STAGE(PG8_SB(1, 1), cB + hstep + kstep, voffB);
        PG8_WAIT_V(6); PG8_BAR;
    }
    for (;;) {
        const bool has_next = S.next(ui + 1, nxt);
        const char* nA = has_next ? (const char*)g.A + (size_t)nxt.pm * tstep : cA; const char* nB = has_next ? (const char*)g.Bt + (size_t)nxt.pn * tstep : cB;
        for (int t = 0; t < nt; t += 2) {
            const bool last = (t == nt - 2);
            const char* a1 = cA + (size_t)(t + 1) * kstep;
            const char* a2 = last ? nA : cA + (size_t)(t + 2) * kstep; const char* b2 = last ? nB : cB + (size_t)(t + 2) * kstep;
            const char* a3 = a2 + kstep; const char* b3 = b2 + kstep;
            if (last && has_next) S.a_ready(nxt);
            if constexpr (SP2) {
            PG8_LDB(B0, 0, 0); PG8_LDB(B1, 0, 1); PG8_SCHED; PG8_LDA(At, 0, 0); PG8_STAGE(PG8_SA(1, 1), a1 + hstep, voffA);
            PG8_WAIT_V(8); PG8_WAIT_L(0); PG8_BAR; PG8_MMA(0, 0, At, B0); PG8_MMA(0, 1, At, B1); PG8_BAR; PG8_SCHED;
            PG8_LDA(At, 0, 1); PG8_STAGE(PG8_SB(0, 0), b2, voffB); PG8_STAGE(PG8_SB(0, 1), b2 + hstep, voffB); PG8_STAGE(PG8_SA(0, 0), a2, voffA);
            PG8_WAIT_V(8); PG8_WAIT_L(0); PG8_BAR; PG8_MMA(1, 0, At, B0); PG8_MMA(1, 1, At, B1); PG8_BAR; PG8_SCHED;
            PG8_LDB(B0, 1, 0); PG8_LDB(B1, 1, 1); PG8_SCHED; PG8_LDA(At, 1, 0); PG8_STAGE(PG8_SA(0, 1), a2 + hstep, voffA);
            PG8_WAIT_V(8); PG8_WAIT_L(0); PG8_BAR; PG8_MMA(0, 0, At, B0); PG8_MMA(0, 1, At, B1); PG8_BAR; PG8_SCHED;
            PG8_LDA(At, 1, 1); PG8_STAGE(PG8_SB(1, 0), b3, voffB); PG8_STAGE(PG8_SB(1, 1), b3 + hstep, voffB); PG8_STAGE(PG8_SA(1, 0), a3, voffA);
            PG8_WAIT_V(8); PG8_WAIT_L(0); PG8_BAR; PG8_MMA(1, 0, At, B0); PG8_MMA(1, 1, At, B1); PG8_BAR; PG8_SCHED;
            } else {
            PG8_LDB(B0, 0, 0); PG8_SCHED; PG8_LDA(At, 0, 0); PG8_STAGE(PG8_SA(1, 1), a1 + hstep, voffA);
            PG8_WAIT_L(8); PG8_BAR; PG8_WAIT_L(0); PG8_MMA(0, 0, At, B0); PG8_BAR; PG8_SCHED;
            PG8_LDB(B1, 0, 1); PG8_STAGE(PG8_SB(0, 0), b2, voffB);
            PG8_BAR; PG8_WAIT_L(0); PG8_MMA(0, 1, At, B1); PG8_BAR;
            PG8_LDA(At, 0, 1); PG8_STAGE(PG8_SA(0, 0), a2, voffA);
            PG8_BAR; PG8_WAIT_L(0); PG8_MMA(1, 0, At, B0); PG8_BAR; PG8_SCHED;
            PG8_STAGE(PG8_SB(0, 1), b2 + hstep, voffB);
            PG8_WAIT_V(6); PG8_BAR; PG8_MMA(1, 1, At, B1); PG8_BAR;
            PG8_LDB(B0, 1, 0); PG8_SCHED; PG8_LDA(At, 1, 0); PG8_STAGE(PG8_SA(0, 1), a2 + hstep, voffA);
            PG8_WAIT_L(8); PG8_BAR; PG8_WAIT_L(0); PG8_MMA(0, 0, At, B0); PG8_BAR; PG8_SCHED;
            PG8_LDB(B1, 1, 1); PG8_STAGE(PG8_SB(1, 0), b3, voffB);
            PG8_BAR; PG8_WAIT_L(0); PG8_MMA(0, 1, At, B1); PG8_BAR;
            PG8_LDA(At, 1, 1); PG8_STAGE(PG8_SA(1, 0), a3, voffA);
            PG8_BAR; PG8_WAIT_L(0); PG8_MMA(1, 0, At, B0); PG8_BAR; PG8_SCHED;
            PG8_STAGE(PG8_SB(1, 1), b3 + hstep, voffB);
            PG8_WAIT_V(6); PG8_BAR; PG8_MMA(1, 1, At, B1); PG8_BAR;
            }
        }
        if constexpr (ALIGN_EPI) { if (wr == 0) PG8_BAR; }
        if constexpr (!Epi::AFTER_DRAIN) { E(acc, cur, wr, wc, fr, fq); S.done(cur); }
        if (!has_next) break;
#pragma unroll
        for (int a = 0; a < 2; ++a)
#pragma unroll
            for (int b = 0; b < 2; ++b)
#pragma unroll
                for (int m = 0; m < 4; ++m)
#pragma unroll
                    for (int n = 0; n < 2; ++n) acc[a][b][m][n] = (f32x4){0.f, 0.f, 0.f, 0.f};
        cur = nxt; cA = nA; cB = nB; ++ui;
        if constexpr (ALIGN_EPI) { if (wr == 1) PG8_BAR; }
    }
    PG8_WAIT_V(0);
    if constexpr (!ALIGN_EPI) { if (wr == 0) PG8_BAR; }
    PG8_BAR;
    if constexpr (Epi::AFTER_DRAIN) { E.fused(acc, cur, wr, wc, fr, fq, lds, wid, lane); S.done(cur); }
#undef PG8_SA
#undef PG8_SB
#undef PG8_STAGE
#undef PG8_LDA
#undef PG8_LDB
#undef PG8_MMA
#undef PG8_WAIT_V
#undef PG8_WAIT_L
#undef PG8_BAR
#undef PG8_SCHED
}
}

#ifndef PG8_SP2
#define PG8_SP2 true
#endif
#ifndef PG8_ALIGN
#define PG8_ALIGN true
#endif
#define XB_TMO      128
#define XB_XCNT(j)  (256  + 64 * (j))
#define XB_XSUB(j)  (1280 + 64 * (j))
#define XB_XGEN(j)  (2304 + 64 * (j))
#define XB_TOP      3328
#define XB_TOPGEN   3392
#define XCD_BAR_WORDS 3456
#define XB_SPIN_CAP (1u << 18)

__device__ __forceinline__ unsigned xb_ld(unsigned* p)              { return __hip_atomic_load(p, __ATOMIC_RELAXED, __HIP_MEMORY_SCOPE_AGENT); }
__device__ __forceinline__ unsigned xb_add(unsigned* p, unsigned v) { return __hip_atomic_fetch_add(p, v, __ATOMIC_RELAXED, __HIP_MEMORY_SCOPE_AGENT); }
__device__ __forceinline__ unsigned xb_xcc_id() { return (unsigned)__builtin_amdgcn_s_getreg((3 << 11) | 20) & 0xFu; }
#define XB_SPIN(cond, bar) do { unsigned _sp = 0; while (cond) { __builtin_amdgcn_s_sleep(1); \
    if ((++_sp & 255u) == 0u) { if (xb_ld(&(bar)[XB_TMO])) break; if (_sp > XB_SPIN_CAP) { atomicAdd(&(bar)[XB_TMO], 1u); break; } } } } while (0)

struct XcdBarrier {
    unsigned* bar; unsigned x;
    volatile LAS unsigned* st;
};

__device__ __forceinline__ XcdBarrier xcd_barrier_post(unsigned* bar, volatile LAS unsigned* st) {
    XcdBarrier b; b.bar = bar; b.x = xb_xcc_id(); b.st = st;
    if (threadIdx.x == 0) (void)xb_add(&bar[XB_XCNT(b.x)], 1u);
    return b;
}
__device__ __forceinline__ void xcd_barrier_complete(unsigned* bar, unsigned x, unsigned& nloc, unsigned& nx) {
    const unsigned G = gridDim.x * gridDim.y * gridDim.z;
    unsigned sum, cnt, mine, sp = 0u;
    for (;;) {
        sum = 0u; cnt = 0u; mine = 0u;
#pragma unroll
        for (unsigned j = 0; j < 16; ++j) { const unsigned c = xb_ld(&bar[XB_XCNT(j)]); sum += c; cnt += (c > 0u) ? 1u : 0u; mine = (j == x) ? c : mine; }
        if (sum == G) break;
        __builtin_amdgcn_s_sleep(1);
        if ((++sp & 255u) == 0u) { if (xb_ld(&bar[XB_TMO])) break; if (sp > XB_SPIN_CAP) { atomicAdd(&bar[XB_TMO], 1u); break; } }
    }
    nloc = mine > 0u ? mine : 1u; nx = cnt > 0u ? cnt : 1u;
}

__device__ __forceinline__ void xcd_barrier(const XcdBarrier& b, const bool is_t0  ) {
    asm volatile("s_waitcnt vmcnt(0)" ::: "memory");
    __syncthreads();
    if (is_t0) {
        unsigned* bar = b.bar;
        __builtin_amdgcn_s_waitcnt(0);
        unsigned nloc = b.st[0], nx = b.st[1];
        if (nloc == 0u) { xcd_barrier_complete(bar, b.x, nloc, nx); b.st[0] = nloc; b.st[1] = nx; }
        const unsigned old = xb_add(&bar[XB_XSUB(b.x)], 1u);
        const unsigned gen = old / nloc;
        if (old + 1u == (gen + 1u) * nloc) {
            __builtin_amdgcn_fence(__ATOMIC_RELEASE, "agent");
            asm volatile("s_waitcnt vmcnt(0)" ::: "memory");
            const unsigned og = xb_add(&bar[XB_TOP], 1u);
            const unsigned tg = og / nx;
            if (og + 1u == (tg + 1u) * nx) xb_add(&bar[XB_TOPGEN], 1u);
            else XB_SPIN(xb_ld(&bar[XB_TOPGEN]) == tg, bar);
            __builtin_amdgcn_fence(__ATOMIC_ACQUIRE, "agent");
            xb_add(&bar[XB_XGEN(b.x)], 1u);
            asm volatile("s_waitcnt vmcnt(0)" ::: "memory");
        } else {
            XB_SPIN(xb_ld(&bar[XB_XGEN(b.x)]) == gen, bar);
            __builtin_amdgcn_fence(__ATOMIC_ACQUIRE, "agent");
            asm volatile("s_waitcnt vmcnt(0)" ::: "memory");
        }
    }
    __syncthreads();
}
struct EpiResF32 {
    static constexpr bool PERM = true, AFTER_DRAIN = false;
    const float* xin; float* yp; float alpha;
    DI void operator()(const pg8::f32x4 (&acc)[2][2][4][2], const pg8::Unit& u, int wr, int wc, int fr, int fq) const {
        const int row0 = u.pm * 256 + wr * 64 + fr, col0 = u.pn * 256 + wc * 32 + 8 * fq;
#pragma unroll
        for (int ai = 0; ai < 2; ++ai)
#pragma unroll
            for (int m = 0; m < 4; ++m) {
                const size_t ro = (size_t)(row0 + ai * 128 + m * 16) * DM;
#pragma unroll
                for (int bj = 0; bj < 2; ++bj) {
                    const size_t o = ro + col0 + bj * 128;
                    const f32x4 x0 = *(const f32x4*)(xin + o), x1 = *(const f32x4*)(xin + o + 4);
                    *(f32x4*)(yp + o) = x0 * alpha + acc[ai][bj][m][0];
                    *(f32x4*)(yp + o + 4) = x1 * alpha + acc[ai][bj][m][1];
                }
            }
    }
};
struct EpiSwiglu {
    static constexpr bool PERM = true, AFTER_DRAIN = false;
    unsigned char* act; const float* bgu;
    DI void operator()(const pg8::f32x4 (&acc)[2][2][4][2], const pg8::Unit& u, int wr, int wc, int fr, int fq) const {
        const int e = u.pn >> 3, pl = u.pn & 7;
        const int row0 = u.pm * 256 + wr * 64 + fr, cih = pl * 128 + wc * 32 + 8 * fq;
        const float* bg = bgu + e * 2048 + cih;
        const f32x4 bg0 = *(const f32x4*)(bg), bg1 = *(const f32x4*)(bg + 4), bu0 = *(const f32x4*)(bg + 1024), bu1 = *(const f32x4*)(bg + 1028);
#pragma unroll
        for (int ai = 0; ai < 2; ++ai)
#pragma unroll
            for (int m = 0; m < 4; ++m) {
                constexpr float RS = 1.f / (F8_SX * F8_SWG);
                const f32x4 g0 = acc[ai][0][m][0] * RS + bg0, g1 = acc[ai][0][m][1] * RS + bg1, u0 = acc[ai][1][m][0] * RS + bu0, u1 = acc[ai][1][m][1] * RS + bu1;
                float r[8];
#pragma unroll
                for (int i = 0; i < 8; ++i) {
                    float g = i < 4 ? g0[i & 3] : g1[i & 3], uu = i < 4 ? u0[i & 3] : u1[i & 3];
                    g = fminf(g, 7.0f); uu = fminf(fmaxf(uu, -7.0f), 7.0f);
                    const float sg = __builtin_amdgcn_rcpf(1.0f + ex2(-1.702f * LOG2E * g));
                    r[i] = (uu + 1.0f) * g * sg * F8_SA;
                }
                v2u w; w.x = pk4_fp8(r[0], r[1], r[2], r[3]); w.y = pk4_fp8(r[4], r[5], r[6], r[7]);
                *(v2u*)(act + (size_t)(row0 + ai * 128 + m * 16) * DM + cih) = w;
            }
    }
};
struct EpiDown {
    static constexpr bool PERM = true, AFTER_DRAIN = false;
    bf16* yr; const float* bdn;
    DI void operator()(const pg8::f32x4 (&acc)[2][2][4][2], const pg8::Unit& u, int wr, int wc, int fr, int fq) const {
        const int e = u.pn >> 2, pl = u.pn & 3;
        const int row0 = u.pm * 256 + wr * 64 + fr, col0 = pl * 256 + wc * 32 + 8 * fq;
        f32x4 bv[2][2];
#pragma unroll
        for (int bj = 0; bj < 2; ++bj) { bv[bj][0] = *(const f32x4*)(bdn + e * 1024 + col0 + bj * 128); bv[bj][1] = *(const f32x4*)(bdn + e * 1024 + col0 + bj * 128 + 4); }
#pragma unroll
        for (int ai = 0; ai < 2; ++ai)
#pragma unroll
            for (int m = 0; m < 4; ++m) {
                bf16* rp = yr + (size_t)(row0 + ai * 128 + m * 16) * DM + col0;
#pragma unroll
                for (int bj = 0; bj < 2; ++bj) {
                    constexpr float RS = 1.f / (F8_SA * F8_SWD);
                    const f32x4 v0 = acc[ai][bj][m][0] * RS + bv[bj][0], v1 = acc[ai][bj][m][1] * RS + bv[bj][1];
                    v4u w; w.x = cvtpk(v0[0], v0[1]); w.y = cvtpk(v0[2], v0[3]); w.z = cvtpk(v1[0], v1[1]); w.w = cvtpk(v1[2], v1[3]);
                    *(v4u*)(rp + bj * 128) = w;
                }
            }
    }
};
struct GroupOrder {
    LAS const unsigned* tile_e; int ntiles, lg, G, c;
    DI bool next(int i, pg8::Unit& u) const {
        int pm, pl;
        if (G == 256) {
            const int x = c & 7, k = c >> 3; pm = i * (256 >> lg) + x * (32 >> lg) + (k >> lg); pl = k & ((1 << lg) - 1); if (pm >= ntiles) return false; }
        else { const long L = (long)i * G + c; if (L >= ((long)ntiles << lg)) return false; pm = (int)(L >> lg); pl = (int)(L & ((1 << lg) - 1)); }
        const int e = __builtin_amdgcn_readfirstlane((int)tile_e[pm]);
        u.pm = pm; u.pn = (e << lg) + pl; return true;
    }
    DI void a_ready(const pg8::Unit&) const {}
    DI void done(const pg8::Unit&) const {}
};
struct Args { const float* in[18]; float* out; unsigned char* ws; int ph_lo, ph_hi; };
struct Fr { LAS unsigned char* lds; unsigned char* ws; unsigned* ctl; int tid, lane, wave, blk, G; };

DI void tr_item(const float* W, int ldw, int K, int k0, int sc0, int nvalid, bf16* WT, int drow0, LAS float* scr, int lane) {
    const int c = lane & 31;
#pragma unroll 8
    for (int i = 0; i < 32; ++i) { const int kk = 2 * i + (lane >> 5); scr[kk * 33 + c] = (c < nvalid) ? W[(size_t)(k0 + kk) * ldw + sc0 + c] : 0.f; }
    LDS_WAIT(); asm volatile("" ::: "memory");
    const int c8 = lane & 7;
#pragma unroll
    for (int j = 0; j < 4; ++j) { const int n = (lane >> 3) + 8 * j; const LAS float* s = scr + (8 * c8) * 33 + n;
        v4u o; o.x = cvtpk(s[0 * 33], s[1 * 33]); o.y = cvtpk(s[2 * 33], s[3 * 33]); o.z = cvtpk(s[4 * 33], s[5 * 33]); o.w = cvtpk(s[6 * 33], s[7 * 33]);
        *(v4u*)(WT + (size_t)(drow0 + n) * K + k0 + 8 * c8) = o; }
    LDS_WAIT(); asm volatile("" ::: "memory");
}
DI void tr_item8(const float* W, int ldw, int K, int k0, int sc0, float scale, unsigned char* WT8, int drow0, LAS float* scr, int lane) {
    const int c = lane & 31;
#pragma unroll 8
    for (int i = 0; i < 32; ++i) { const int kk = 2 * i + (lane >> 5); scr[kk * 33 + c] = W[(size_t)(k0 + kk) * ldw + sc0 + c] * scale; }
    LDS_WAIT(); asm volatile("" ::: "memory");
    const int c16 = lane & 3;
#pragma unroll
    for (int j = 0; j < 2; ++j) { const int n = (lane >> 2) + 16 * j; const LAS float* s = scr + (16 * c16) * 33 + n;
        v4u o; o.x = pk4_fp8(s[0 * 33], s[1 * 33], s[2 * 33], s[3 * 33]); o.y = pk4_fp8(s[4 * 33], s[5 * 33], s[6 * 33], s[7 * 33]);
        o.z = pk4_fp8(s[8 * 33], s[9 * 33], s[10 * 33], s[11 * 33]); o.w = pk4_fp8(s[12 * 33], s[13 * 33], s[14 * 33], s[15 * 33]);
        *(v4u*)(WT8 + (size_t)(drow0 + n) * K + k0 + 16 * c16) = o; }
    LDS_WAIT(); asm volatile("" ::: "memory");
}
DI void ph_prologue(const Args& a, const Fr& F) {
    LAS float* scr = (LAS float*)(F.lds + F.wave * 16384);
    const int gw = F.blk * NWAVES + F.wave, NGW = F.G * NWAVES;
    constexpr int I_EV = 2 * 16 * 80, I_OD = 2 * 16 * 96, I_WO = 4 * 16 * 32, I_GU = 128 * 16 * 64, I_DN = 128 * 16 * 32;
    constexpr int NITEMS = I_EV + I_OD + I_WO + I_GU + I_DN;
    bf16* wev = (bf16*)(F.ws + WS_WEV); bf16* wod = (bf16*)(F.ws + WS_WOD); bf16* wout = (bf16*)(F.ws + WS_WOUT);
    unsigned char* wgu = F.ws + WS_WGU; unsigned char* wdn = F.ws + WS_WDN;
    for (int it = gw; it < NITEMS; it += NGW) {
        int r = it;
        if (r < I_EV) { const int l = r / 1280; r %= 1280; const int kb = r / 80, n0 = (r % 80) * 32; int sc0, nv = 32;
            if (n0 < 512) sc0 = n0; else if (n0 < 1024) sc0 = 964 + (n0 - 512); else if (n0 < 1536) sc0 = 1476 + (n0 - 1024); else if (n0 < 2048) sc0 = 1988 + (n0 - 1536);
            else if (n0 < 2176) sc0 = 512 + (n0 - 2048); else if (n0 < 2432) sc0 = 640 + (n0 - 2176); else if (n0 < 2496) sc0 = 896 + (n0 - 2432);
            else if (n0 < 2528) { sc0 = 960; nv = 4; } else { sc0 = 0; nv = 0; }
            tr_item(a.in[1] + (size_t)l * 1024 * 2500, 2500, 1024, kb * 64, sc0, nv, wev + (size_t)l * EV_N * 1024, n0, scr, F.lane); continue; }
        r -= I_EV;
        if (r < I_OD) { const int l = r / 1536; r %= 1536; const int kb = r / 96, n0 = (r % 96) * 32;
            tr_item(a.in[6] + (size_t)l * 1024 * 3088, 3088, 1024, kb * 64, n0, 32, wod + (size_t)l * OD_N * 1024, n0, scr, F.lane); continue; }
        r -= I_OD;
        if (r < I_WO) { const int l = r / 512; r %= 512; const int kb = r / 32, n0 = (r % 32) * 32;
            const float* src = (l & 1) ? a.in[8] + (size_t)(l >> 1) * 1024 * 1024 : a.in[5] + (size_t)(l >> 1) * 1024 * 1024;
            tr_item(src, 1024, 1024, kb * 64, n0, 32, wout + (size_t)l * 1024 * 1024, n0, scr, F.lane); continue; }
        r -= I_WO;
        if (r < I_GU) { const int le = r / 1024; r %= 1024; const int kb = r / 64, n0 = (r % 64) * 32;
            const int pn = n0 >> 8, bj = (n0 >> 7) & 1, j0 = n0 & 127;
            tr_item8(a.in[14] + (size_t)le * 1024 * 2048, 2048, 1024, kb * 64, bj * 1024 + pn * 128 + j0, F8_SWG, wgu + (size_t)le * 2048 * 1024, n0, scr, F.lane); continue; }
        r -= I_GU;
        { const int le = r / 512; r %= 512; const int kb = r / 32, n0 = (r % 32) * 32;
            tr_item8(a.in[16] + (size_t)le * 1024 * 1024, 1024, 1024, kb * 64, n0, F8_SWD, wdn + (size_t)le * 1024 * 1024, n0, scr, F.lane); }
    }
    bf16* xb = (bf16*)(F.ws + WS_XB);
    for (int m = gw; m < NTOK; m += NGW) {
        const f32x4* xr = (const f32x4*)(a.in[0] + (size_t)m * DM) + F.lane; v2u* o = (v2u*)(xb + (size_t)m * DM) + F.lane;
#pragma unroll
        for (int j = 0; j < 4; ++j) { const f32x4 v = xr[64 * j]; v2u w; w.x = cvtpk(v[0], v[1]); w.y = cvtpk(v[2], v[3]); o[64 * j] = w; }
    }
    bf16* wukt = (bf16*)(F.ws + WS_WUKT); bf16* wuvt = (bf16*)(F.ws + WS_WUVT);
    for (int i = F.blk * NTHR + F.tid; i < 2 * 8 * 128 * 64; i += F.G * NTHR) {
        { const int d = i & 63, c = (i >> 6) & 127, lh = i >> 13; wukt[i] = (bf16)f2bf(a.in[2][((size_t)lh * 64 + d) * 128 + c]); }
        { const int c = i & 127, d = (i >> 7) & 63, lh = i >> 13; wuvt[i] = (bf16)f2bf(a.in[3][((size_t)lh * 128 + c) * 64 + d]); }
    }
}

DI void ln_row(f32x4 (&v)[4], const float* g, const float* b, int lane) {
    float s = 0.f;
#pragma unroll
    for (int j = 0; j < 4; ++j) s += (v[j][0] + v[j][1]) + (v[j][2] + v[j][3]);
    const float mean = wave_sum(s) * (1.f / DM); float s2 = 0.f;
#pragma unroll
    for (int j = 0; j < 4; ++j) { v[j] = v[j] - mean; s2 += (v[j][0] * v[j][0] + v[j][1] * v[j][1]) + (v[j][2] * v[j][2] + v[j][3] * v[j][3]); }
    const float rstd = 1.f / sqrtf(wave_sum(s2) * (1.f / DM) + LN_EPS);
#pragma unroll
    for (int j = 0; j < 4; ++j) { const f32x4 gg = *((const f32x4*)g + lane + 64 * j), bb = *((const f32x4*)b + lane + 64 * j); v[j] = v[j] * rstd * gg + bb; }
}
DI void store_row_f32(float* p, const f32x4 (&v)[4], int lane) {
#pragma unroll
    for (int j = 0; j < 4; ++j) *((f32x4*)p + lane + 64 * j) = v[j];
}
DI void store_row_bf16(bf16* p, const f32x4 (&v)[4], int lane) {
#pragma unroll
    for (int j = 0; j < 4; ++j) { v2u w; w.x = cvtpk(v[j][0], v[j][1]); w.y = cvtpk(v[j][2], v[j][3]); *((v2u*)p + lane + 64 * j) = w; }
}
template <int NL> DI void small_proj(LAS const float* xs, const float* W, int ldw, int lane, float (&acc)[4]) {
    constexpr int PARTS = 64 / NL, DPER = 1024 / PARTS;
    const int n = lane & (NL - 1), part = lane / NL;
    acc[0] = acc[1] = acc[2] = acc[3] = 0.f;
    const float* wp = W + (size_t)(part * DPER) * ldw + n;
    LAS const float* xp = xs + part * DPER;
#pragma unroll 8
    for (int d = 0; d < DPER; ++d) { const float w = wp[(size_t)d * ldw];
        acc[0] += w * xp[d]; acc[1] += w * xp[1024 + d]; acc[2] += w * xp[2048 + d]; acc[3] += w * xp[3072 + d]; }
#pragma unroll
    for (int o = NL; o < 64; o <<= 1) {
#pragma unroll
        for (int k = 0; k < 4; ++k) acc[k] += __shfl_xor(acc[k], o); }
}

DI void ph_even_prep(const Args& a, const Fr& F, int j) {
    const bf16* proj = (const bf16*)(F.ws + WS_PROJ);
    bf16* ckvn = (bf16*)(F.ws + WS_CKVN); bf16* ql = (bf16*)(F.ws + WS_QL); float* kbar = (float*)(F.ws + WS_KBAR);
    const float* kvg = a.in[4] + j * 128;
    const bf16* wukt = (const bf16*)(F.ws + WS_WUKT) + (size_t)j * 8 * 128 * 64;
    const int lane = F.lane, wave = F.wave;
    for (int chunk = F.blk; chunk < 256; chunk += F.G) {
        const int tok0 = chunk * 128;
        for (int i = 0; i < 16; ++i) { const int tok = tok0 + wave * 16 + i;
            const unsigned w = *((const unsigned*)(proj + (size_t)tok * EV_N + EC_CKV) + lane);
            const float v0 = bf2f(w & 0xffffu), v1 = bf2f(w >> 16);
            const float ss = wave_sum(v0 * v0 + v1 * v1);
            const float r = 1.f / sqrtf(ss * (1.f / 128.f) + LN_EPS);
            *((unsigned*)(ckvn + (size_t)tok * 128) + lane) = cvtpk(v0 * r * kvg[2 * lane], v1 * r * kvg[2 * lane + 1]); }
        { bf16* kic = (bf16*)(F.ws + WS_KIC); const int tok = tok0 + wave * 16 + (lane >> 2), c = (lane & 3) * 16;
            const v4u* src = (const v4u*)(proj + (size_t)tok * EV_N + EC_KI + c); v4u* dst = (v4u*)(kic + (size_t)tok * 64 + c); dst[0] = src[0]; dst[1] = src[1]; }
        { const int h = wave, l15 = lane & 15, kg = lane >> 4;
            bf16x8 af[8][2];
#pragma unroll
            for (int ct = 0; ct < 8; ++ct)
#pragma unroll
                for (int ks = 0; ks < 2; ++ks) af[ct][ks] = *(const bf16x8*)(wukt + ((size_t)h * 128 + ct * 16 + l15) * 64 + ks * 32 + kg * 8);
            for (int tg = 0; tg < 8; ++tg) { const int tok = tok0 + tg * 16 + l15;
                bf16x8 qf[2];
#pragma unroll
                for (int ks = 0; ks < 2; ++ks) qf[ks] = *(const bf16x8*)(proj + (size_t)tok * EV_N + EC_QA + h * 64 + ks * 32 + kg * 8);
#pragma unroll
                for (int ct = 0; ct < 8; ++ct) { f32x4 d = {0.f, 0.f, 0.f, 0.f};
                    d = mfma16(af[ct][0], qf[0], d); d = mfma16(af[ct][1], qf[1], d);
                    v2u w; w.x = cvtpk(d[0], d[1]); w.y = cvtpk(d[2], d[3]);
                    *(v2u*)(ql + (size_t)tok * 1024 + h * 128 + ct * 16 + 4 * kg) = w; } } }
        if (chunk < 128) { const int b = chunk >> 5, n = chunk & 31; float s8[8];
#pragma unroll
            for (int k = 0; k < 8; ++k) s8[k] = 0.f;
            const bf16* kp = proj + ((size_t)b * SEQ + n * 256 + wave * 32) * EV_N + EC_KB + lane * 8;
#pragma unroll 8
            for (int r = 0; r < 32; ++r) { const v4u w = *(const v4u*)(kp + (size_t)r * EV_N);
#pragma unroll
                for (int k = 0; k < 4; ++k) { s8[2 * k] += bf2f(w[k] & 0xffffu); s8[2 * k + 1] += bf2f(w[k] >> 16); } }
            LAS float* red = (LAS float*)F.lds;
            __syncthreads();
#pragma unroll
            for (int k = 0; k < 8; ++k) red[wave * 512 + lane * 8 + k] = s8[k];
            __syncthreads();
            float s = 0.f;
#pragma unroll
            for (int w = 0; w < 8; ++w) s += red[w * 512 + F.tid];
            const int h = F.tid >> 6, d = F.tid & 63;
            kbar[(((size_t)b * 8 + h) * 32 + n) * 64 + d] = s * (1.f / 256.f); }
    }
}

DI void moba_gate_chunk(const Fr& F, int chunk) {
    const bf16* proj = (const bf16*)(F.ws + WS_PROJ); const float* kbar = (const float*)(F.ws + WS_KBAR); unsigned* sel3 = (unsigned*)(F.ws + WS_SEL3);
    const int tok0 = chunk * 128, b = tok0 / SEQ, own = (tok0 % SEQ) >> 8, h = F.wave, lane = F.lane;
    float q0[64], q1[64];
    { const v4u* p0 = (const v4u*)(proj + (size_t)(tok0 + lane) * EV_N + EC_QB + h * 64); const v4u* p1 = (const v4u*)(proj + (size_t)(tok0 + 64 + lane) * EV_N + EC_QB + h * 64);
#pragma unroll
        for (int i = 0; i < 8; ++i) { const v4u w0 = p0[i], w1 = p1[i];
#pragma unroll
            for (int k = 0; k < 4; ++k) { q0[8 * i + 2 * k] = bf2f(w0[k] & 0xffffu); q0[8 * i + 2 * k + 1] = bf2f(w0[k] >> 16); q1[8 * i + 2 * k] = bf2f(w1[k] & 0xffffu); q1[8 * i + 2 * k + 1] = bf2f(w1[k] >> 16); } } }
    float a0 = -INFINITY, a1 = -INFINITY, a2 = -INFINITY, c0 = -INFINITY, c1 = -INFINITY, c2 = -INFINITY; int ai0 = 0, ai1 = 0, ai2 = 0, ci0 = 0, ci1 = 0, ci2 = 0;
    const float* kb = kbar + (((size_t)b * 8 + h) * 32) * 64;
    for (int n = 0; n < own; ++n) { float g0 = 0.f, g1 = 0.f;
#pragma unroll
        for (int d = 0; d < 64; d += 4) { const f32x4 kv = *(const f32x4*)(kb + n * 64 + d);
#pragma unroll
            for (int k = 0; k < 4; ++k) { g0 += q0[d + k] * kv[k]; g1 += q1[d + k] * kv[k]; } }
        if (g0 > a2) { if (g0 > a1) { a2 = a1; ai2 = ai1; if (g0 > a0) { a1 = a0; ai1 = ai0; a0 = g0; ai0 = n; } else { a1 = g0; ai1 = n; } } else { a2 = g0; ai2 = n; } }
        if (g1 > c2) { if (g1 > c1) { c2 = c1; ci2 = ci1; if (g1 > c0) { c1 = c0; ci1 = ci0; c0 = g1; ci0 = n; } else { c1 = g1; ci1 = n; } } else { c2 = g1; ci2 = n; } }
    }
    const unsigned nv = own < 3 ? own : 3;
    sel3[(size_t)(tok0 + lane) * 8 + h] = (unsigned)ai0 | ((unsigned)ai1 << 8) | ((unsigned)ai2 << 16) | (nv << 24);
    sel3[(size_t)(tok0 + 64 + lane) * 8 + h] = (unsigned)ci0 | ((unsigned)ci1 << 8) | ((unsigned)ci2 << 16) | (nv << 24);
}

constexpr int HS = 257;
DI float relu1(float x) { const unsigned u = __float_as_uint(x); return __uint_as_float(u & ~(unsigned)((int)u >> 31)); }
template <int MODE, bool DIAG> DI void idx_tile(const bf16x8 (&kf)[4], LAS const char* qb  , const float (&wj)[4], int kt, int q, int hi, unsigned c0, unsigned c1,
                                     LAS unsigned* hist, LAS unsigned* mask, LAS unsigned* cmask, LAS unsigned long long* cand, LAS unsigned* rinfo) {
    f32x2 scp[8];
#pragma unroll
    for (int p = 0; p < 8; ++p) scp[p] = (f32x2){0.f, 0.f};
#pragma unroll
    for (int j = 0; j < 4; ++j) { f32x16 acc;
#pragma unroll
        for (int r = 0; r < 16; ++r) acc[r] = 0.f;
#pragma unroll
        for (int s = 0; s < 4; ++s) acc = mfma32(kf[s], *(LAS const bf16x8*)(qb + (j * 8 + s * 2) * 512), acc);
        const f32x2 w2 = {wj[j], wj[j]};
#pragma unroll
        for (int p = 0; p < 8; ++p) { const f32x2 a = {relu1(acc[2 * p]), relu1(acc[2 * p + 1])};
            scp[p] = a * w2 + scp[p]; } }
    unsigned sel = 0u, cnd = 0u;
    const float F0 = __uint_as_float(c0), F1 = __uint_as_float(c1);
#pragma unroll
    for (int r = 0; r < 16; ++r) { const int kr = crow(r, hi);
        const bool ok = !DIAG || kr <= q;
        const float scv = scp[r >> 1][r & 1]; const unsigned u = __float_as_uint(scv);
        if (MODE == 1) { const unsigned key = u ^ ((unsigned)((int)u >> 31) | 0x80000000u);
            if (ok && (key >> 24) >= c0) __hip_atomic_fetch_add(hist + q * HS + (key >> 24), 1u, __ATOMIC_RELAXED, __HIP_MEMORY_SCOPE_WORKGROUP); }
        else if (MODE == 2) { if (ok && (u >> 24) == c0) __hip_atomic_fetch_add(hist + q * HS + (((u >> 16) & 255u) ^ c1), 1u, __ATOMIC_RELAXED, __HIP_MEMORY_SCOPE_WORKGROUP); }
        else { const bool ge1 = scv >= F1, ge0 = scv >= F0;
            if (ok && ge1) sel |= 1u << kr;
            if (ok && ge0 && !ge1) { cnd |= 1u << kr; const unsigned key = u ^ ((unsigned)((int)u >> 31) | 0x80000000u);
                const unsigned pos = __hip_atomic_fetch_add(rinfo + 128 + q, 1u, __ATOMIC_RELAXED, __HIP_MEMORY_SCOPE_WORKGROUP);
                if (pos < 64u) cand[q * 64 + pos] = ((unsigned long long)key << 32) | (unsigned)(~(unsigned)(kt * 32 + kr)); } } }
    if (MODE == 3) { if (sel) __hip_atomic_fetch_or(mask + q * HS + kt, sel, __ATOMIC_RELAXED, __HIP_MEMORY_SCOPE_WORKGROUP);
        if (cnd) __hip_atomic_fetch_or(cmask + q * HS + kt, cnd, __ATOMIC_RELAXED, __HIP_MEMORY_SCOPE_WORKGROUP); }
}
template <int MODE> DI void idx_pass(const bf16* proj, int rowbase, int qt, LAS const char* qimg, const float (&wj)[4], LAS unsigned* hist, LAS unsigned* mask, LAS unsigned* cmask, LAS unsigned long long* cand, LAS unsigned* rinfo, int wave, int lane) {
    const int q = lane & 31, hi = lane >> 5, nkt = qt + 1;
    const unsigned b1 = MODE == 2 ? rinfo[160 + q] : rinfo[224 + q], thr16 = MODE == 2 ? rinfo[192 + q] : rinfo[256 + q];
    const bf16* kp0 = proj + (size_t)(rowbase + q) * 64 + hi * 8;
    LAS const char* qb = qimg + hi * 512 + q * 16;
    const int n = nkt > wave ? (nkt - wave + 7) >> 3 : 0;
    bf16x8 kfa[4], kfb[4], kfc[4];
#define IDX_LOAD(KF, I) do { const bf16* kp_ = kp0 + (size_t)((wave + 8 * (I)) * 32) * 64; _Pragma("unroll") for (int s_ = 0; s_ < 4; ++s_) KF[s_] = *(const bf16x8*)(kp_ + s_ * 16); } while (0)
#define IDX_TILE(KF, I) do { const int kt_ = wave + 8 * (I); if (kt_ == qt) idx_tile<MODE, true>(KF, qb, wj, kt_, q, hi, b1, thr16, hist, mask, cmask, cand, rinfo); \
        else idx_tile<MODE, false>(KF, qb, wj, kt_, q, hi, b1, thr16, hist, mask, cmask, cand, rinfo); } while (0)
    if (n > 0) IDX_LOAD(kfa, 0);
    if (n > 1) IDX_LOAD(kfb, 1);
    for (int i = 0; i < n; i += 3) {
        if (i + 2 < n) IDX_LOAD(kfc, i + 2);
        IDX_TILE(kfa, i);
        if (i + 1 < n) { if (i + 3 < n) IDX_LOAD(kfa, i + 3); IDX_TILE(kfb, i + 1); }
        if (i + 2 < n) { if (i + 4 < n) IDX_LOAD(kfb, i + 4); IDX_TILE(kfc, i + 2); }
    }
#undef IDX_LOAD
#undef IDX_TILE
}
DI void hist_pick(LAS const unsigned* hrow, unsigned need, int lane, unsigned& bin, unsigned& above) {
    unsigned h4[4];
#pragma unroll
    for (int k = 0; k < 4; ++k) h4[k] = hrow[4 * lane + k];
    const unsigned ssum = h4[0] + h4[1] + h4[2] + h4[3];
    unsigned x = ssum;
#pragma unroll
    for (int o = 1; o < 64; o <<= 1) { const unsigned y = __shfl_down(x, o); if (lane + o < 64) x += y; }
    const unsigned long long m = __ballot(x >= need);
    const int Ls = m ? 63 - __builtin_clzll(m) : 0;
    const unsigned xs = __shfl(x, Ls), ss = __shfl(ssum, Ls);
    const unsigned h0 = __shfl(h4[0], Ls), h1 = __shfl(h4[1], Ls), h2 = __shfl(h4[2], Ls), h3 = __shfl(h4[3], Ls);
    unsigned cum = xs - ss;
    if (cum + h3 >= need) { bin = 4 * Ls + 3; above = cum; return; } cum += h3;
    if (cum + h2 >= need) { bin = 4 * Ls + 2; above = cum; return; } cum += h2;
    if (cum + h1 >= need) { bin = 4 * Ls + 1; above = cum; return; } cum += h1;
    bin = 4 * Ls; above = cum; (void)h0;
}
DI void idx_pass1(const bf16* proj, int rowbase, int qt, LAS const char* qimg, const float (&wj)[4], LAS unsigned* hist, LAS unsigned* mask, LAS unsigned* cmask, LAS unsigned long long* cand, LAS unsigned* rinfo, int wave, int lane) {
    const int q = lane & 31, hi = lane >> 5, nkt = qt + 1, nmax = (nkt + 7) >> 3;
    const bf16* kp0 = proj + (size_t)(rowbase + q) * 64 + hi * 8;
    LAS const char* qb = qimg + hi * 512 + q * 16;
    unsigned lb = 0u;
    bf16x8 kfc[4], kfn[4];
    if (wave < nkt) {
#pragma unroll
        for (int s = 0; s < 4; ++s) kfc[s] = *(const bf16x8*)(kp0 + (size_t)(wave * 32) * 64 + s * 16); }
    for (int i = 0; i < nmax; ++i) { const int kt = wave + 8 * i;
        if (kt + 8 < nkt) {
#pragma unroll
            for (int s = 0; s < 4; ++s) kfn[s] = *(const bf16x8*)(kp0 + (size_t)((kt + 8) * 32) * 64 + s * 16); }
        if (kt < nkt) { if (kt == qt) idx_tile<1, true>(kfc, qb, wj, kt, q, hi, lb, 0u, hist, mask, cmask, cand, rinfo); else idx_tile<1, false>(kfc, qb, wj, kt, q, hi, lb, 0u, hist, mask, cmask, cand, rinfo); }
#pragma unroll
        for (int s = 0; s < 4; ++s) kfc[s] = kfn[s];
        if (((i + 1) & i) == 0 && i + 1 < nmax && i < 16) {
            __syncthreads();
#pragma unroll 1
            for (int rr = 0; rr < 4; ++rr) { const int row = wave * 4 + rr; unsigned bin, above; hist_pick(hist + row * HS, 256u, lane, bin, above);
                if (lane == 0) rinfo[288 + row] = bin; }
            __syncthreads();
            { const unsigned nb = rinfo[288 + q]; lb = nb > lb ? nb : lb; } }
    }
}
DI void idx_unit(const Fr& F, int b, int qt) {
    const bf16* proj = (const bf16*)(F.ws + WS_PROJ); const bf16* kic = (const bf16*)(F.ws + WS_KIC); unsigned short* sel = (unsigned short*)(F.ws + WS_SEL);
    LAS unsigned* hist = (LAS unsigned*)(F.lds); LAS unsigned* mask = hist + 32 * HS; LAS unsigned* cmask = mask + 32 * HS;
    LAS unsigned long long* cand = (LAS unsigned long long*)(F.lds + 99328); LAS unsigned* rinfo = (LAS unsigned*)(F.lds + 115712);
    const int lane = F.lane, wave = F.wave, tid = F.tid, t0 = qt * 32, rowbase = b * SEQ;
    __syncthreads();
    for (int i = tid; i < 3 * 32 * HS; i += NTHR) hist[i] = 0u;
    if (tid < 320) rinfo[tid] = 0u;
    __syncthreads();
    if (t0 + 31 <= 255 || (EXPF & 64)) {
        if (lane < 8) {
#pragma unroll
            for (int rr = 0; rr < 4; ++rr) { const int row = wave * 4 + rr, nv = t0 + row + 1;
                const int nv0 = t0 + row + 1; const int nvc = nv0 < 256 ? nv0 : 256; (void)nv; mask[row * HS + lane] = nvc >= 32 * (lane + 1) ? 0xffffffffu : (nvc > 32 * lane ? ((1u << (nvc - 32 * lane)) - 1u) : 0u); } }
    } else {
        const int q = lane & 31;
        float wj[4];
        { const bf16* qp = proj + (size_t)(rowbase + t0 + q) * EV_N;
#pragma unroll
            for (int j = 0; j < 4; ++j) wj[j] = bf2f(qp[EC_WI + j]); }
        LAS char* qimg = (LAS char*)(F.lds + 117248);
#pragma unroll
        for (int i = 0; i < 2; ++i) { const int p = tid + i * NTHR, row = p & 31, c = p >> 5;
            *(LAS v4u*)(qimg + c * 512 + row * 16) = *(const v4u*)(proj + (size_t)(rowbase + t0 + row) * EV_N + EC_QI + c * 8); }
        __syncthreads();
        idx_pass1(kic, rowbase, qt, qimg, wj, hist, mask, cmask, cand, rinfo, wave, lane);
        __syncthreads();
#pragma unroll 1
        for (int rr = 0; rr < 4; ++rr) { const int row = wave * 4 + rr; unsigned bin, above; hist_pick(hist + row * HS, 256u, lane, bin, above);
            if (lane == 0) { rinfo[row] = bin; rinfo[32 + row] = 256u - above; rinfo[160 + row] = bin >= 128u ? bin - 128u : 255u - bin; rinfo[192 + row] = bin >= 128u ? 0u : 255u; } }
        __syncthreads();
        for (int i = tid; i < 32 * HS; i += NTHR) hist[i] = 0u;
        __syncthreads();
        idx_pass<2>(kic, rowbase, qt, qimg, wj, hist, mask, cmask, cand, rinfo, wave, lane);
        __syncthreads();
#pragma unroll 1
        for (int rr = 0; rr < 4; ++rr) { const int row = wave * 4 + rr; const unsigned need1 = rinfo[32 + row]; unsigned bin, above; hist_pick(hist + row * HS, need1, lane, bin, above);
            if (lane == 0) { const unsigned t16 = (rinfo[row] << 8) | bin, k0 = t16 << 16, k1 = (t16 + 1u) << 16;
                rinfo[64 + row] = t16; rinfo[96 + row] = need1 - above;
                rinfo[224 + row] = (k0 & 0x80000000u) ? (k0 ^ 0x80000000u) : ~k0; rinfo[256 + row] = (t16 == 0xffffu) ? 0x7fc00000u : ((k1 & 0x80000000u) ? (k1 ^ 0x80000000u) : ~k1); } }
        __syncthreads();
        idx_pass<3>(kic, rowbase, qt, qimg, wj, hist, mask, cmask, cand, rinfo, wave, lane);
        __syncthreads();
#pragma unroll 1
        for (int rr = 0; rr < 4; ++rr) { const int row = wave * 4 + rr; const unsigned call = rinfo[128 + row], need2 = rinfo[96 + row];
            if (call <= 64u) { const unsigned c = call;
                const unsigned long long mine = cand[row * 64 + lane]; unsigned rank = 0u;
                for (unsigned k = 0; k < c; ++k) rank += (cand[row * 64 + k] > mine) ? 1u : 0u;
                if ((unsigned)lane < c && rank < need2) { const unsigned s = ~(unsigned)mine;
                    __hip_atomic_fetch_or(mask + row * HS + (s >> 5), 1u << (s & 31), __ATOMIC_RELAXED, __HIP_MEMORY_SCOPE_WORKGROUP); } }
            else { unsigned w4[4];
#pragma unroll
                for (int k = 0; k < 4; ++k) w4[k] = cmask[row * HS + 4 * lane + k];
                const unsigned cnt = __popc(w4[0]) + __popc(w4[1]) + __popc(w4[2]) + __popc(w4[3]);
                unsigned x = cnt;
#pragma unroll
                for (int o = 1; o < 64; o <<= 1) { const unsigned y = __shfl_up(x, o); if (lane >= o) x += y; }
                unsigned before = x - cnt;
#pragma unroll
                for (int k = 0; k < 4; ++k) { unsigned w = w4[k]; const unsigned pc = __popc(w); unsigned take = 0u;
                    if (before < need2) { if (before + pc <= need2) take = w; else { unsigned left = need2 - before; while (left) { const unsigned b = w & (0u - w); take |= b; w ^= b; --left; } } }
                    before += pc;
                    if (take) mask[row * HS + 4 * lane + k] |= take; } }
        }
    }
    __syncthreads();
#pragma unroll 1
    for (int rr = 0; rr < 4; ++rr) { const int row = wave * 4 + rr; unsigned short* out = sel + (size_t)(rowbase + t0 + row) * 256;
        unsigned w4[4];
#pragma unroll
        for (int k = 0; k < 4; ++k) w4[k] = mask[row * HS + 4 * lane + k];
        const unsigned cnt = __popc(w4[0]) + __popc(w4[1]) + __popc(w4[2]) + __popc(w4[3]);
        unsigned x = cnt;
#pragma unroll
        for (int o = 1; o < 64; o <<= 1) { const unsigned y = __shfl_up(x, o); if (lane >= o) x += y; }
        const unsigned total = __shfl(x, 63); unsigned pos = x - cnt;
#pragma unroll
        for (int k = 0; k < 4; ++k) { unsigned w = w4[k]; const unsigned base = (unsigned)(4 * lane + k) * 32u;
            while (w) { const unsigned bit = __builtin_ctz(w); if (pos < 256u) out[pos] = (unsigned short)(base + bit); ++pos; w &= w - 1u; } }
        for (unsigned i = total + lane; i < 256u; i += 64u) out[i] = (unsigned short)0xffffu; }
}

struct AttSt { float m, l; f32x16 o0, o1; };
template <class BF> DI void att_subtile(AttSt& S, const bf16x8 (&qf)[4], LAS const char* Kst, LAS const char* Vb, int vdh, int vrow0, int lane, const BF& bias) {
    const int r32 = lane & 31, hi = lane >> 5;
    f32x16 p;
#pragma unroll
    for (int r = 0; r < 16; ++r) p[r] = 0.f;
    LAS const char* kp = Kst + hi * 512 + r32 * 16;
#pragma unroll
    for (int s = 0; s < 4; ++s) { const bf16x8 kf = *(LAS const bf16x8*)(kp + s * 1024); p = mfma32(kf, qf[s], p); }
    float mx = -INFINITY;
#pragma unroll
    for (int r = 0; r < 16; ++r) { p[r] = bias(p[r], crow(r, hi)); mx = fmaxf(mx, p[r]); }
    mx = fmaxf(mx, __shfl_xor(mx, 32));
    const float mn = fmaxf(S.m, mx), sc = ex2(S.m - mn);
    S.m = mn;
    float ps = 0.f;
#pragma unroll
    for (int r = 0; r < 16; ++r) { p[r] = ex2(p[r] - mn); ps += p[r]; }
    S.l = S.l * sc + ps;
#pragma unroll
    for (int r = 0; r < 16; ++r) { S.o0[r] *= sc; S.o1[r] *= sc; }
    v4u pw0, pw1;
    pw0.x = cvtpk(p[0], p[1]); pw0.y = cvtpk(p[2], p[3]); pw0.z = cvtpk(p[4], p[5]); pw0.w = cvtpk(p[6], p[7]);
    pw1.x = cvtpk(p[8], p[9]); pw1.y = cvtpk(p[10], p[11]); pw1.z = cvtpk(p[12], p[13]); pw1.w = cvtpk(p[14], p[15]);
    const bf16x8 pf0 = __builtin_bit_cast(bf16x8, pw0), pf1 = __builtin_bit_cast(bf16x8, pw1);
    LAS const char* vp = Vb + (vrow0 + 4 * hi + ((lane & 15) >> 2)) * 64 + ((lane >> 4) & 1) * 32 + (lane & 3) * 8;
    { const bf16x8 v00 = cat8(vtr(vp), vtr(vp + 512)), v10 = cat8(vtr(vp + vdh), vtr(vp + vdh + 512));
      const bf16x8 v01 = cat8(vtr(vp + 1024), vtr(vp + 1536)), v11 = cat8(vtr(vp + vdh + 1024), vtr(vp + vdh + 1536));
      S.o0 = mfma32(v00, pf0, S.o0); S.o1 = mfma32(v10, pf0, S.o1);
      S.o0 = mfma32(v01, pf1, S.o0); S.o1 = mfma32(v11, pf1, S.o1); }
}

struct MobaFar { float c; DI float operator()(float p, int) const { return p + c; } };
struct MobaBias { LAS const float* lut; int tq, s0; bool causal;
    DI float operator()(float p, int kvrel) const { const int dist = tq - (s0 + kvrel); const float v = p + lut[dist < 0 ? 0 : (dist > 1023 ? 1023 : dist)]; return (causal && dist < 0) ? -INFINITY : v; } };
DI void moba_tile(const Fr& F, const bf16* proj, int rowbase, int h, int n, int tq, bool valid, int slot, bool own, int wave_tile) {
    LAS const char* Kb = (LAS const char*)F.lds; LAS const char* Vb = (LAS const char*)(F.lds + 32768); LAS const float* lut = (LAS const float*)(F.lds + 98304);
    bf16* po = (bf16*)(F.ws + WS_ACT); float* pml = (float*)(F.ws + WS_PML);
    const int lane = F.lane, hi = lane >> 5;
    bf16x8 qf[4];
    { const bf16* qp = proj + (size_t)(rowbase + tq) * EV_N + EC_QB + h * 64 + hi * 8;
#pragma unroll
        for (int s = 0; s < 4; ++s) qf[s] = *(const bf16x8*)(qp + s * 16); }
    AttSt S; S.m = -1e30f; S.l = 0.f;
#pragma unroll
    for (int r = 0; r < 16; ++r) { S.o0[r] = 0.f; S.o1[r] = 0.f; }
    const int nst = own ? wave_tile + 1 : 8;
    int tmin = tq;
#pragma unroll
    for (int o = 1; o < 64; o <<= 1) { const int y = __shfl_xor(tmin, o); tmin = y < tmin ? y : tmin; }
    const float cfar = lut[1023];
    for (int st = 0; st < nst; ++st) {
        if (!own && tmin - (n * 256 + st * 32 + 31) >= 790) { MobaFar bf{cfar}; att_subtile(S, qf, Kb + st * 4096, Vb, 16384, st * 32, lane, bf); }
        else { MobaBias bf{lut, tq, n * 256 + st * 32, own && st == wave_tile}; att_subtile(S, qf, Kb + st * 4096, Vb, 16384, st * 32, lane, bf); } }
    const float lt = S.l + __shfl_xor(S.l, 32), inv = 1.f / lt;
    if (valid) { const size_t pi = ((size_t)(rowbase + tq) * 8 + h) * 4 + slot; bf16* o = po + pi * 64;
#pragma unroll
        for (int a4 = 0; a4 < 4; ++a4) { v2u w0, w1;
            w0.x = cvtpk(S.o0[4 * a4] * inv, S.o0[4 * a4 + 1] * inv); w0.y = cvtpk(S.o0[4 * a4 + 2] * inv, S.o0[4 * a4 + 3] * inv);
            w1.x = cvtpk(S.o1[4 * a4] * inv, S.o1[4 * a4 + 1] * inv); w1.y = cvtpk(S.o1[4 * a4 + 2] * inv, S.o1[4 * a4 + 3] * inv);
            *(v2u*)(o + 8 * a4 + 4 * hi) = w0; *(v2u*)(o + 32 + 8 * a4 + 4 * hi) = w1; }
        if (hi == 0) { f32x2 ml = {S.m, lt}; *(f32x2*)(pml + pi * 2) = ml; } }
}
DI void moba_unit(const Args& a, const Fr& F, int b, int h, int n) {
    const bf16* proj = (const bf16*)(F.ws + WS_PROJ); const unsigned* sel3 = (const unsigned*)(F.ws + WS_SEL3);
    LAS unsigned char* lds = F.lds; LAS unsigned* list = (LAS unsigned*)(lds + 65536); LAS float* lut = (LAS float*)(lds + 98304); LAS unsigned* misc = (LAS unsigned*)(lds + 102400);
    const int tid = F.tid, lane = F.lane, wave = F.wave, rowbase = b * SEQ;
    __syncthreads();
    { const bf16* kg = proj + (size_t)(rowbase + n * 256) * EV_N + EC_KB + h * 64; const bf16* vg = proj + (size_t)(rowbase + n * 256) * EV_N + EC_VB + h * 64;
#pragma unroll
        for (int i = 0; i < 4; ++i) { const int p = tid + i * NTHR;
            { const int r = p & 31, c = (p >> 5) & 7, st = p >> 8; const v4u v = *(const v4u*)(kg + (size_t)(st * 32 + r) * EV_N + c * 8); *(LAS v4u*)(lds + st * 4096 + c * 512 + r * 16) = v; }
            { const int cc = p & 3, row = (p >> 2) & 255, dh = p >> 10; const v4u v = *(const v4u*)(vg + (size_t)row * EV_N + dh * 32 + cc * 8); *(LAS v4u*)(lds + 32768 + dh * 16384 + row * 64 + cc * 16) = v; } }
        for (int d = tid; d < 1024; d += NTHR) lut[d] = a.in[9][t5_bucket(d) * 16 + 8 + h] * LOG2E; }
    if (tid == 0) misc[16] = 0u;
    __syncthreads();
    for (int tb = (n + 1) * 256; tb < SEQ; tb += NTHR) { const int t = tb + tid; const bool inr = t < SEQ;
        const unsigned s = inr ? sel3[(size_t)(rowbase + t) * 8 + h] : 0u; const unsigned nv = s >> 24; int slot = -1;
        if (nv > 0u && (s & 255u) == (unsigned)n) slot = 0; else if (nv > 1u && ((s >> 8) & 255u) == (unsigned)n) slot = 1; else if (nv > 2u && ((s >> 16) & 255u) == (unsigned)n) slot = 2;
        const unsigned long long bal = __ballot(slot >= 0); const unsigned wcnt = __popcll(bal);
        if (lane == 0) misc[wave] = wcnt;
        __syncthreads();
        unsigned off = misc[16], tot = 0u;
#pragma unroll
        for (int w = 0; w < 8; ++w) { const unsigned c = misc[w]; if (w < wave) off += c; tot += c; }
        if (slot >= 0) list[off + __popcll(bal & ((1ull << lane) - 1ull))] = ((unsigned)t << 2) | (unsigned)slot;
        __syncthreads();
        if (tid == 0) misc[16] += tot; }
    __syncthreads();
    const int nlist = (int)misc[16];
    moba_tile(F, proj, rowbase, h, n, n * 256 + wave * 32 + (lane & 31), true, 3, true, wave);
    const int ntl = (nlist + 31) >> 5;
    for (int tl = wave; tl < ntl; tl += 8) { const int li = tl * 32 + (lane & 31); const bool valid = li < nlist; const unsigned e = list[valid ? li : nlist - 1];
        moba_tile(F, proj, rowbase, h, n, (int)(e >> 2), valid, (int)(e & 3u), false, 0); }
}

DI void dsa_step(const bf16x8 (&af)[2][4], const bf16x8 (&qlf)[4], int ch, LAS const unsigned char* bsel, LAS unsigned char* cbuf, LAS const float* tab,
                 float& m, float& l, f32x4 (&oT)[8], int l15, int kg, int lane) {
    f32x4 acc[2];
#pragma unroll
    for (int mt = 0; mt < 2; ++mt) { acc[mt] = (f32x4){0.f, 0.f, 0.f, 0.f};
#pragma unroll
        for (int ks = 0; ks < 4; ++ks) { acc[mt] = mfma16(af[mt][ks], qlf[ks], acc[mt]); *(LAS bf16x8*)(cbuf + (mt * 16 + l15) * 288 + (ks * 32 + kg * 8) * 2) = af[mt][ks]; } }
    float mx = -INFINITY;
#pragma unroll
    for (int mt = 0; mt < 2; ++mt) { const unsigned b4 = *(LAS const unsigned*)(bsel + ch * 32 + mt * 16 + 4 * kg);
#pragma unroll
        for (int i = 0; i < 4; ++i) { const unsigned bb = (b4 >> (8 * i)) & 255u;
            const float v = bb != 255u ? acc[mt][i] + tab[bb * 8 + (l15 & 7)] : -INFINITY; acc[mt][i] = v; mx = fmaxf(mx, v); } }
    mx = fmaxf(mx, __shfl_xor(mx, 16)); mx = fmaxf(mx, __shfl_xor(mx, 32));
    const float mn = fmaxf(m, mx), sc = ex2(m - mn); m = mn;
    float ps = 0.f;
#pragma unroll
    for (int mt = 0; mt < 2; ++mt)
#pragma unroll
        for (int i = 0; i < 4; ++i) { acc[mt][i] = ex2(acc[mt][i] - mn); ps += acc[mt][i]; }
    l = l * sc + ps;
#pragma unroll
    for (int ct = 0; ct < 8; ++ct) oT[ct] = oT[ct] * sc;
    v4u pw; pw.x = cvtpk(acc[0][0], acc[0][1]); pw.y = cvtpk(acc[0][2], acc[0][3]); pw.z = cvtpk(acc[1][0], acc[1][1]); pw.w = cvtpk(acc[1][2], acc[1][3]);
    const bf16x8 pf = __builtin_bit_cast(bf16x8, pw);
    LDS_WAIT();
    LAS const char* tp = (LAS const char*)cbuf + (4 * kg + (l15 >> 2)) * 288 + (lane & 3) * 8;
#pragma unroll
    for (int ct = 0; ct < 8; ++ct) { const bf16x8 cf = cat8(vtr(tp + ct * 32), vtr(tp + 16 * 288 + ct * 32)); oT[ct] = mfma16(cf, pf, oT[ct]); }
    LDS_WAIT();
}
DI void dsa_gather(bf16x8 (&af)[2][4], const bf16* ckvn, int rowbase, LAS const unsigned short* selb, int ch, int l15, int kg) {
#pragma unroll
    for (int mt = 0; mt < 2; ++mt) { unsigned idx = selb[ch * 32 + mt * 16 + l15]; if (idx == 0xffffu) idx = 0u;
        const bf16* cp = ckvn + (size_t)(rowbase + (int)idx) * 128 + kg * 8;
#pragma unroll
        for (int ks = 0; ks < 4; ++ks) af[mt][ks] = *(const bf16x8*)(cp + ks * 32); }
}
DI void dsa_query(const Fr& F, int tok, LAS unsigned char* wl, LAS const unsigned char* bkt, LAS const float* tab) {
    const bf16* ql = (const bf16*)(F.ws + WS_QL); const bf16* ckvn = (const bf16*)(F.ws + WS_CKVN); const unsigned short* sel = (const unsigned short*)(F.ws + WS_SEL); bf16* ol = (bf16*)(F.ws + WS_OL);
    const int lane = F.lane, l15 = lane & 15, kg = lane >> 4, t = tok % SEQ, rowbase = tok - t;
    LAS unsigned short* selb = (LAS unsigned short*)wl; LAS unsigned char* bsel = wl + 512; LAS unsigned char* cbuf = wl + 1024;
    { const v2u sv = *((const v2u*)(sel + (size_t)tok * 256) + lane); *((LAS v2u*)selb + lane) = sv; unsigned bw = 0u;
#pragma unroll
        for (int i = 0; i < 4; ++i) { const unsigned s = (i < 2 ? (sv.x >> (16 * i)) : (sv.y >> (16 * (i - 2)))) & 0xffffu; const int dist = t - (int)s;
            const unsigned bb = (s != 0xffffu && dist >= 0) ? (unsigned)bkt[dist > 1023 ? 1023 : dist] : 255u; bw |= bb << (8 * i); }
        *((LAS unsigned*)bsel + lane) = bw; }
    bf16x8 qlf[4];
#pragma unroll
    for (int ks = 0; ks < 4; ++ks) { qlf[ks] = *(const bf16x8*)(ql + (size_t)tok * 1024 + (l15 & 7) * 128 + ks * 32 + kg * 8); if (l15 >= 8) qlf[ks] = (bf16x8){0, 0, 0, 0, 0, 0, 0, 0}; }
    float m = -1e30f, l = 0.f; f32x4 oT[8];
#pragma unroll
    for (int ct = 0; ct < 8; ++ct) oT[ct] = (f32x4){0.f, 0.f, 0.f, 0.f};
    const int nvalid = t + 1 < 256 ? t + 1 : 256, nch = (nvalid + 31) >> 5;
    LDS_WAIT();
    bf16x8 afa[2][4], afb[2][4];
    dsa_gather(afa, ckvn, rowbase, selb, 0, l15, kg);
    for (int ch = 0; ch < nch; ch += 2) {
        const bool hb = ch + 1 < nch;
        if (hb) dsa_gather(afb, ckvn, rowbase, selb, ch + 1, l15, kg);
        dsa_step(afa, qlf, ch, bsel, cbuf, tab, m, l, oT, l15, kg, lane);
        if (hb) { if (ch + 2 < nch) dsa_gather(afa, ckvn, rowbase, selb, ch + 2, l15, kg);
            dsa_step(afb, qlf, ch + 1, bsel, cbuf, tab, m, l, oT, l15, kg, lane); }
    }
    l += __shfl_xor(l, 16); l += __shfl_xor(l, 32);
    const float inv = 1.f / l;
    if (l15 < 8) { bf16* o = ol + (size_t)tok * 1024 + l15 * 128 + 4 * kg;
#pragma unroll
        for (int ct = 0; ct < 8; ++ct) { v2u w; w.x = cvtpk(oT[ct][0] * inv, oT[ct][1] * inv); w.y = cvtpk(oT[ct][2] * inv, oT[ct][3] * inv); *(v2u*)(o + ct * 16) = w; } }
}
DI void dsa_chunk(const Args& a, const Fr& F, int c32) {
    LAS unsigned char* bkt = F.lds + 81920; LAS float* tab = (LAS float*)(F.lds + 82944);
    __syncthreads();
    for (int d = F.tid; d < 1024; d += NTHR) bkt[d] = (unsigned char)t5_bucket(d);
    if (F.tid < 256) tab[F.tid] = a.in[9][(F.tid >> 3) * 16 + (F.tid & 7)] * LOG2E;
    __syncthreads();
#pragma unroll 1
    for (int i = 0; i < 4; ++i) dsa_query(F, c32 * 32 + F.wave * 4 + i, F.lds + F.wave * 10240, bkt, tab);
}

DI void ph_even_post(const Fr& F, int j) {
    const bf16* ol = (const bf16*)(F.ws + WS_OL); bf16* ao = (bf16*)(F.ws + WS_AO);
    const bf16* wuvt = (const bf16*)(F.ws + WS_WUVT) + (size_t)j * 8 * 64 * 128;
    const bf16* po = (const bf16*)(F.ws + WS_ACT); const float* pml = (const float*)(F.ws + WS_PML); const unsigned* sel3 = (const unsigned*)(F.ws + WS_SEL3);
    const int lane = F.lane, wave = F.wave, l15 = lane & 15, kg = lane >> 4;
    for (int chunk = F.blk; chunk < 256; chunk += F.G) { const int tok0 = chunk * 128;
        { const int h = wave; bf16x8 af[4][4];
#pragma unroll
            for (int mt = 0; mt < 4; ++mt)
#pragma unroll
                for (int ks = 0; ks < 4; ++ks) af[mt][ks] = *(const bf16x8*)(wuvt + ((size_t)h * 64 + mt * 16 + l15) * 128 + ks * 32 + kg * 8);
            for (int tg = 0; tg < 8; ++tg) { const int tok = tok0 + tg * 16 + l15; bf16x8 bf[4];
#pragma unroll
                for (int ks = 0; ks < 4; ++ks) bf[ks] = *(const bf16x8*)(ol + (size_t)tok * 1024 + h * 128 + ks * 32 + kg * 8);
#pragma unroll
                for (int mt = 0; mt < 4; ++mt) { f32x4 d = {0.f, 0.f, 0.f, 0.f};
#pragma unroll
                    for (int ks = 0; ks < 4; ++ks) d = mfma16(af[mt][ks], bf[ks], d);
                    v2u w; w.x = cvtpk(d[0], d[1]); w.y = cvtpk(d[2], d[3]); *(v2u*)(ao + (size_t)tok * 1024 + h * 64 + mt * 16 + 4 * kg) = w; } } }
        if (!(EXPF & 32)) for (int i = 0; i < 16; ++i) { const int tok = tok0 + wave * 16 + i, h = lane >> 3, d0 = (lane & 7) * 8;
            const unsigned nv = sel3[(size_t)tok * 8 + h] >> 24; const size_t pi = ((size_t)tok * 8 + h) * 4;
            float mj[4], lj[4];
#pragma unroll
            for (int s = 0; s < 4; ++s) { const bool ok = (s == 3) || ((unsigned)s < nv); const f32x2 ml = *(const f32x2*)(pml + (pi + s) * 2); mj[s] = ok ? ml[0] : -1e30f; lj[s] = ok ? ml[1] : 0.f; }
            const float ms = fmaxf(fmaxf(mj[0], mj[1]), fmaxf(mj[2], mj[3])); float wsum = 0.f, acc[8];
#pragma unroll
            for (int k = 0; k < 8; ++k) acc[k] = 0.f;
#pragma unroll
            for (int s = 0; s < 4; ++s) { const float w = lj[s] * ex2(mj[s] - ms); wsum += w;
                if (w > 0.f) { const v4u v = *(const v4u*)(po + (pi + s) * 64 + d0);
#pragma unroll
                    for (int k = 0; k < 4; ++k) { acc[2 * k] += w * bf2f(v[k] & 0xffffu); acc[2 * k + 1] += w * bf2f(v[k] >> 16); } } }
            const float inv = 1.f / wsum; v4u o; o.x = cvtpk(acc[0] * inv, acc[1] * inv); o.y = cvtpk(acc[2] * inv, acc[3] * inv); o.z = cvtpk(acc[4] * inv, acc[5] * inv); o.w = cvtpk(acc[6] * inv, acc[7] * inv);
            *(v4u*)(ao + (size_t)tok * 1024 + 512 + h * 64 + d0) = o; }
    }
}
DI f32x16 proj32_f32(const float* W, int ldw, int ncols, const float* xrow, int d_lo, int lane) {
    const int e = lane & 31, kh = lane >> 5; const bool ev = e < ncols;
    f32x16 D;
#pragma unroll
    for (int r = 0; r < 16; ++r) D[r] = 0.f;
    const float* wp = W + (size_t)(d_lo + 4 * kh) * ldw + (ev ? e : 0);
    const float* xp = xrow + d_lo + 4 * kh;
#pragma unroll 4
    for (int i = 0; i < 64; ++i) { const f32x4 xv = *(const f32x4*)(xp + 8 * i);
        float a0 = wp[(size_t)(8 * i + 0) * ldw], a1 = wp[(size_t)(8 * i + 1) * ldw], a2 = wp[(size_t)(8 * i + 2) * ldw], a3 = wp[(size_t)(8 * i + 3) * ldw];
        if (!ev) { a0 = 0.f; a1 = 0.f; a2 = 0.f; a3 = 0.f; }
        D = __builtin_amdgcn_mfma_f32_32x32x2f32(a0, xv[0], D, 0, 0, 0); D = __builtin_amdgcn_mfma_f32_32x32x2f32(a1, xv[1], D, 0, 0, 0);
        D = __builtin_amdgcn_mfma_f32_32x32x2f32(a2, xv[2], D, 0, 0, 0); D = __builtin_amdgcn_mfma_f32_32x32x2f32(a3, xv[3], D, 0, 0, 0); }
    return D;
}
DI void ph_odd_prep(const Args& a, const Fr& F, int j, int layer) {
    const bf16* proj = (const bf16*)(F.ws + WS_PROJ); const float* x = (const float*)(F.ws + WS_X);
    float* logf = (float*)(F.ws + WS_LOGF); float* cs = (float*)(F.ws + WS_CS);
    const float* wf = a.in[6] + (size_t)j * 1024 * 3088 + 3072; const float* bfv = a.in[7] + j * 16;
    LAS float* red = (LAS float*)(F.lds); LAS float* lfb = (LAS float*)(F.lds + 131072);
    LAS unsigned* kmx = (LAS unsigned*)(F.lds + 131072 + 8192);
    const int lane = F.lane, wave = F.wave, tid = F.tid, l31 = lane & 31, hi = lane >> 5;
    for (int chunk = F.blk; chunk < 256; chunk += F.G) { const int tok0 = chunk * 128, b = tok0 / SEQ, t0 = tok0 % SEQ;
        __syncthreads();
        if (tid < 16) kmx[tid] = 0u;
        const int tl = wave & 3, kr = wave >> 2;
        f32x16 D = proj32_f32(wf, 3088, 16, x + (size_t)(tok0 + tl * 32 + l31) * DM, kr * 512, lane);
        if (kr == 1) {
#pragma unroll
            for (int r = 0; r < 8; ++r) red[(tl * 8 + r) * 64 + lane] = D[r]; }
        __syncthreads();
        if (kr == 0) {
#pragma unroll
            for (int r = 0; r < 8; ++r) { const int h = (r & 3) + 8 * (r >> 2) + 4 * hi; const float z = D[r] + red[(tl * 8 + r) * 64 + lane] + bfv[h];
                const float ls = fminf(z, 0.f) - log1pf(__expf(-fabsf(z)));
                lfb[(tl * 32 + l31) * 16 + h] = ls * LOG2E; } }
#pragma unroll 1
        for (int i = 0; i < 4; ++i) { const int p = tid + i * NTHR, tk = p >> 4, h = p & 15; const v4u* kp = (const v4u*)(proj + (size_t)(tok0 + tk) * OD_N + OC_K + h * 64); float s = 0.f;
#pragma unroll
            for (int c = 0; c < 8; ++c) { const v4u w = kp[c];
#pragma unroll
                for (int k = 0; k < 4; ++k) { const float e0 = bf2f(w[k] & 0xffffu), e1 = bf2f(w[k] >> 16); s += e0 * e0 + e1 * e1; } }
            __hip_atomic_fetch_max(kmx + h, __float_as_uint(s), __ATOMIC_RELAXED, __HIP_MEMORY_SCOPE_WORKGROUP); }
        __syncthreads();
        for (int i = tid; i < 2048; i += NTHR) { const int h = i >> 7, tk = i & 127; logf[((size_t)b * 16 + h) * SEQ + t0 + tk] = lfb[tk * 16 + h]; }
        if (tid < 32) { const int h = tid & 15, c = tid >> 4; float s = 0.f;
            for (int k = 0; k < 64; ++k) s += lfb[(c * 64 + k) * 16 + h];
            cs[((size_t)b * 16 + h) * 128 + (t0 >> 6) + c] = s; }
        if (tid < 16) __hip_atomic_fetch_max(F.ctl + CW_KMAX + layer * 64 + b * 16 + tid, kmx[tid], RLX_AGENT);
    }
}

constexpr float FOX_SKIP_LOG2 = 64.f;
struct FoxBias { LAS const float* ng; int tq, kabs0; bool diag;
    DI float operator()(float p, int kvrel) const { const float v = p + ng[kvrel]; return (diag && (kabs0 + kvrel) > tq) ? -INFINITY : v; } };
DI void fox_unit(const Fr& F, int layer, int b, int h, int qb) {
    const bf16* proj = (const bf16*)(F.ws + WS_PROJ); const float* logf = (const float*)(F.ws + WS_LOGF); const float* cs = (const float*)(F.ws + WS_CS); bf16* ao = (bf16*)(F.ws + WS_AO);
    LAS unsigned char* lds = F.lds; LAS float* ng = (LAS float*)(lds + 32768); LAS float* red = (LAS float*)(lds + 65536 + 1024); LAS int* ibox = (LAS int*)(lds + 65536 + 2048);
    const int tid = F.tid, lane = F.lane, wave = F.wave, r32 = lane & 31, hi = lane >> 5, t0 = qb * 256, rowbase = b * SEQ, tq = t0 + wave * 32 + r32;
    __syncthreads();
    bf16x8 qf[4]; float qs = 0.f;
    { const bf16* qp = proj + (size_t)(rowbase + tq) * OD_N + OC_Q + h * 64 + hi * 8;
#pragma unroll
        for (int s = 0; s < 4; ++s) { qf[s] = *(const bf16x8*)(qp + s * 16);
#pragma unroll
            for (int k = 0; k < 8; ++k) { const float e = bf2f((unsigned short)qf[s][k]); qs += e * e; } } }
    qs += __shfl_xor(qs, 32); qs = wave_max(qs);
    if (lane == 0) red[wave] = qs;
    __syncthreads();
    if (tid == 0) { float qm = red[0];
        for (int w = 1; w < 8; ++w) qm = fmaxf(qm, red[w]);
        const float km = __uint_as_float(ld_u32(F.ctl + CW_KMAX + layer * 64 + b * 16 + h));
        const float B2 = 2.f * (sqrtf(qm * km) * 1.01f + 1.f);
        int kt = t0 / 64 - 1, kts = t0 / 64; float D = 0.f;
        while (kt >= 0 && B2 + D >= -FOX_SKIP_LOG2) { kts = kt; D += cs[((size_t)b * 16 + h) * 128 + kt]; --kt; }
        ibox[0] = kts; }
    __syncthreads();
    const int kts = ibox[0], s_start = kts * 64, nel = t0 + 256 - s_start;
    { const int i0 = tid * 16; float v[16]; const float* lp = logf + ((size_t)b * 16 + h) * SEQ + s_start + i0;
        if (i0 < nel) {
#pragma unroll
            for (int c = 0; c < 4; ++c) { const f32x4 w = *(const f32x4*)(lp + 4 * c); v[4 * c] = w[0]; v[4 * c + 1] = w[1]; v[4 * c + 2] = w[2]; v[4 * c + 3] = w[3]; } }
        else {
#pragma unroll
            for (int c = 0; c < 16; ++c) v[c] = 0.f; }
#pragma unroll
        for (int c = 1; c < 16; ++c) v[c] += v[c - 1];
        float xsum = v[15];
#pragma unroll
        for (int o = 1; o < 64; o <<= 1) { const float y = __shfl_up(xsum, o); if (lane >= o) xsum += y; }
        if (lane == 63) red[16 + wave] = xsum;
        __syncthreads();
        float off = xsum - v[15];
        for (int w = 0; w < wave; ++w) off += red[16 + w];
        if (i0 < nel) {
#pragma unroll
            for (int c = 0; c < 4; ++c) { f32x4 w = {-(off + v[4 * c]), -(off + v[4 * c + 1]), -(off + v[4 * c + 2]), -(off + v[4 * c + 3])}; *(LAS f32x4*)(ng + i0 + 4 * c) = w; } }
    }
    const int ntile = t0 / 64 + 4 - kts;
    const bf16* kg = proj + (size_t)rowbase * OD_N + OC_K + h * 64; const bf16* vg = proj + (size_t)rowbase * OD_N + OC_V + h * 64;
    const int kr = tid & 31, kc = (tid >> 5) & 7, kst = tid >> 8, vcc = tid & 3, vrow = (tid >> 2) & 63, vdh = tid >> 8;
    const int koff = kst * 4096 + kc * 512 + kr * 16, voff = 8192 + vdh * 4096 + vrow * 64 + vcc * 16;
    { const v4u kv = *(const v4u*)(kg + (size_t)(kts * 64 + kst * 32 + kr) * OD_N + kc * 8), vv = *(const v4u*)(vg + (size_t)(kts * 64 + vrow) * OD_N + vdh * 32 + vcc * 8);
        *(LAS v4u*)(lds + koff) = kv; *(LAS v4u*)(lds + voff) = vv; }
    __syncthreads();
    AttSt S; S.m = -1e30f; S.l = 0.f;
#pragma unroll
    for (int r = 0; r < 16; ++r) { S.o0[r] = 0.f; S.o1[r] = 0.f; }
    const int wlast = t0 + wave * 32 + 31, wfirst = t0 + wave * 32;
    for (int i = 0; i < ntile; ++i) { const int kt = kts + i; LAS unsigned char* buf = lds + (i & 1) * 16384; LAS unsigned char* nbuf = lds + ((i + 1) & 1) * 16384;
        v4u kv, vv; const bool more = i + 1 < ntile;
        if (more) { kv = *(const v4u*)(kg + (size_t)((kt + 1) * 64 + kst * 32 + kr) * OD_N + kc * 8); vv = *(const v4u*)(vg + (size_t)((kt + 1) * 64 + vrow) * OD_N + vdh * 32 + vcc * 8); }
#pragma unroll
        for (int sub = 0; sub < 2; ++sub) { const int kv0 = kt * 64 + sub * 32;
            if (kv0 <= wlast) { FoxBias bf{ng + (kv0 - s_start), tq, kv0, kv0 + 31 > wfirst};
                att_subtile(S, qf, (LAS const char*)buf + sub * 4096, (LAS const char*)buf + 8192, 4096, sub * 32, lane, bf); } }
        if (more) { *(LAS v4u*)(nbuf + koff) = kv; *(LAS v4u*)(nbuf + voff - 8192 + 8192) = vv; }
        __syncthreads(); }
    const float lt = S.l + __shfl_xor(S.l, 32), inv = 1.f / lt;
    bf16* o = ao + (size_t)(rowbase + tq) * 1024 + h * 64;
#pragma unroll
    for (int a4 = 0; a4 < 4; ++a4) { v2u w0, w1;
        w0.x = cvtpk(S.o0[4 * a4] * inv, S.o0[4 * a4 + 1] * inv); w0.y = cvtpk(S.o0[4 * a4 + 2] * inv, S.o0[4 * a4 + 3] * inv);
        w1.x = cvtpk(S.o1[4 * a4] * inv, S.o1[4 * a4 + 1] * inv); w1.y = cvtpk(S.o1[4 * a4 + 2] * inv, S.o1[4 * a4 + 3] * inv);
        *(v2u*)(o + 8 * a4 + 4 * hi) = w0; *(v2u*)(o + 32 + 8 * a4 + 4 * hi) = w1; }
}

DI void ph_ln1_router(const Args& a, const Fr& F, int layer) {
    const float* yp = (const float*)(F.ws + WS_YP); float* x1 = (float*)(F.ws + WS_X1); unsigned char* xb8 = F.ws + WS_XB8;
    unsigned* tope = (unsigned*)(F.ws + WS_TOPE); float* gate = (float*)(F.ws + WS_GATE); unsigned* rank = (unsigned*)(F.ws + WS_RANK);
    const float* g = a.in[10] + (size_t)(layer * 2) * DM; const float* bb = a.in[11] + (size_t)(layer * 2) * DM;
    const float* rw = a.in[12] + (size_t)layer * 1024 * 32; const float* rb = a.in[13] + layer * 32;
    LAS float* red = (LAS float*)(F.lds); LAS unsigned* lcnt = (LAS unsigned*)(F.lds + 131072);
    const int lane = F.lane, wave = F.wave, tid = F.tid, l31 = lane & 31, hi = lane >> 5;
    for (int chunk = F.blk; chunk < 256; chunk += F.G) { const int tok0 = chunk * 128;
        __syncthreads();
        if (tid < 32) lcnt[tid] = 0u;
#pragma unroll 1
        for (int k = 0; k < 16; k += 8) { f32x4 v[8][4];
#pragma unroll
            for (int i = 0; i < 8; ++i)
#pragma unroll
                for (int jj = 0; jj < 4; ++jj) v[i][jj] = *((const f32x4*)(yp + (size_t)(tok0 + wave * 16 + k + i) * DM) + lane + 64 * jj);
#pragma unroll
            for (int i = 0; i < 8; ++i) { const int tok = tok0 + wave * 16 + k + i;
                ln_row(v[i], g, bb, lane);
                store_row_f32(x1 + (size_t)tok * DM, v[i], lane);
#pragma unroll
                for (int jj = 0; jj < 4; ++jj) *((unsigned*)(xb8 + (size_t)tok * DM) + lane + 64 * jj) = pk4_fp8(v[i][jj][0] * F8_SX, v[i][jj][1] * F8_SX, v[i][jj][2] * F8_SX, v[i][jj][3] * F8_SX); } }
        asm volatile("s_waitcnt vmcnt(0)" ::: "memory");
        __syncthreads();
        const int tl = wave & 3, kr = wave >> 2, tokl = tok0 + tl * 32 + l31;
        f32x16 D = proj32_f32(rw, 32, 32, x1 + (size_t)tokl * DM, kr * 512, lane);
        if (kr == 1) {
#pragma unroll
            for (int r = 0; r < 16; ++r) red[(tl * 16 + r) * 64 + lane] = D[r]; }
        __syncthreads();
        if (kr == 0) {
            float lv[32];
#pragma unroll
            for (int r = 0; r < 16; ++r) { const float own = D[r] + red[(tl * 16 + r) * 64 + lane] + rb[crow(r, hi)]; const float oth = __shfl_xor(own, 32);
                lv[crow(r, 0)] = hi == 0 ? own : oth; lv[crow(r, 1)] = hi == 0 ? oth : own; }
            float tv[4]; int te[4];
#pragma unroll
            for (int r = 0; r < 4; ++r) { float mx = -INFINITY; int me = 0;
#pragma unroll
                for (int e = 0; e < 32; ++e) { if (lv[e] > mx) { mx = lv[e]; me = e; } }
                tv[r] = mx; te[r] = me;
#pragma unroll
                for (int e = 0; e < 32; ++e) { if (e == me) lv[e] = -INFINITY; } }
            const float e1 = __expf(tv[1] - tv[0]), e2 = __expf(tv[2] - tv[0]), e3 = __expf(tv[3] - tv[0]); const float inv = 1.f / (1.f + e1 + e2 + e3);
            if (hi == 0) { const size_t o = (size_t)tokl * 4;
                const float gv[4] = {inv, e1 * inv, e2 * inv, e3 * inv};
#pragma unroll
                for (int r = 0; r < 4; ++r) { const unsigned rk = __hip_atomic_fetch_add(lcnt + (te[r] & 31), 1u, __ATOMIC_RELAXED, __HIP_MEMORY_SCOPE_WORKGROUP);
                    tope[o + r] = (unsigned)(te[r] & 31); gate[o + r] = gv[r]; rank[o + r] = rk; } } }
        __syncthreads();
        if (tid < 32) __hip_atomic_store(F.ctl + CW_CNT + chunk * 32 + tid, lcnt[tid], RLX_AGENT);
    }
}

DI void ph_route(const Fr& F) {
    const unsigned char* xb8 = F.ws + WS_XB8; unsigned char* xg = F.ws + WS_XG;
    const unsigned* tope = (const unsigned*)(F.ws + WS_TOPE); const unsigned* rank = (const unsigned*)(F.ws + WS_RANK); unsigned* dest = (unsigned*)(F.ws + WS_DEST);
    LAS unsigned* P = (LAS unsigned*)(F.lds); LAS unsigned* pst = P + 512; LAS unsigned* pad = P + 544; LAS unsigned* base = P + 576; LAS unsigned* nt = P + 608;
    const int tid = F.tid, lane = F.lane, wave = F.wave;
    __syncthreads();
    { const int e = tid & 31, part = tid >> 5; unsigned s = 0u;
        for (int c = 0; c < 16; ++c) s += ld_u32(F.ctl + CW_CNT + (part * 16 + c) * 32 + e);
        P[part * 32 + e] = s; }
    __syncthreads();
    if (tid < 32) { unsigned tot = 0u;
        for (int p = 0; p < 16; ++p) tot += P[p * 32 + tid];
        pad[tid] = (tot + 255u) & ~255u; }
    __syncthreads();
    if (tid == 0) { unsigned acc = 0u;
        for (int e = 0; e < 32; ++e) { pst[e] = acc; acc += pad[e]; }
        nt[0] = acc >> 8; }
    __syncthreads();
    for (int chunk = F.blk; chunk < 256; chunk += F.G) {
        __syncthreads();
        if (tid < 32) { unsigned off = 0u; const int pf = chunk >> 4;
            for (int p = 0; p < pf; ++p) off += P[p * 32 + tid];
            for (int c = pf * 16; c < chunk; ++c) off += ld_u32(F.ctl + CW_CNT + c * 32 + tid);
            base[tid] = pst[tid] + off; }
        __syncthreads();
        for (int i = 0; i < 16; ++i) { const int tok = chunk * 128 + wave * 16 + i;
            const v4u src0 = *((const v4u*)(xb8 + (size_t)tok * DM) + lane);
#pragma unroll
            for (int k = 0; k < 4; ++k) { const unsigned e = tope[(size_t)tok * 4 + k], d = base[e] + rank[(size_t)tok * 4 + k];
                if (lane == 0) dest[(size_t)tok * 4 + k] = d;
                *((v4u*)(xg + (size_t)d * DM) + lane) = src0; } }
        if (chunk == 0) { const unsigned ntl = nt[0];
            if (tid == 0) __hip_atomic_store(F.ctl + CW_TILE, ntl, RLX_AGENT);
            for (unsigned i = tid; i < ntl; i += NTHR) { unsigned e = 0u;
                for (unsigned k = 1; k < 32; ++k) if (pst[k] <= i * 256u) e = k;
                __hip_atomic_store(F.ctl + CW_TILE + 64 + i, e, RLX_AGENT); } }
    }
}

DI void ph_combine_ln2(const Args& a, const Fr& F, int layer) {
    const float* x1 = (const float*)(F.ws + WS_X1); const bf16* yr = (const bf16*)(F.ws + WS_XG); float* xo = (float*)(F.ws + WS_X); bf16* xb = (bf16*)(F.ws + WS_XB);
    const float* gate = (const float*)(F.ws + WS_GATE); const unsigned* dest = (const unsigned*)(F.ws + WS_DEST);
    const float* g = a.in[10] + (size_t)(layer * 2 + 1) * DM; const float* bb = a.in[11] + (size_t)(layer * 2 + 1) * DM;
    const int lane = F.lane; const int gw = F.blk * NWAVES + F.wave, NGW = F.G * NWAVES;
    for (int tok = gw; tok < NTOK; tok += 4 * NGW) { f32x4 v[4][4];
#pragma unroll
        for (int i = 0; i < 4; ++i) { const int tk = tok + i * NGW; if (tk < NTOK) {
#pragma unroll
            for (int jj = 0; jj < 4; ++jj) v[i][jj] = *((const f32x4*)(x1 + (size_t)tk * DM) + lane + 64 * jj) * ALPHA;
#pragma unroll
            for (int k = 0; k < 4; ++k) { const float gk = gate[(size_t)tk * 4 + k]; const unsigned d = dest[(size_t)tk * 4 + k];
#pragma unroll
                for (int jj = 0; jj < 4; ++jj) { const v2u w = *((const v2u*)(yr + (size_t)d * DM) + lane + 64 * jj);
                    v[i][jj][0] += gk * bf2f(w.x & 0xffffu); v[i][jj][1] += gk * bf2f(w.x >> 16); v[i][jj][2] += gk * bf2f(w.y & 0xffffu); v[i][jj][3] += gk * bf2f(w.y >> 16); } } } }
#pragma unroll
        for (int i = 0; i < 4; ++i) { const int tk = tok + i * NGW; if (tk < NTOK) {
            ln_row(v[i], g, bb, lane);
            if (layer == DEPTH - 1) store_row_f32(a.out + (size_t)tk * DM, v[i], lane);
            else { store_row_f32(xo + (size_t)tk * DM, v[i], lane); store_row_bf16(xb + (size_t)tk * DM, v[i], lane); } } } }
}
constexpr int LDS_BYTES = 147456;
constexpr int LDS_BARW = 145408, LDS_QSLOT = 145472, LDS_TILE_E = 133632;
constexpr int NPL = 11;
constexpr int NPHASE = 1 + NPL * DEPTH;
#ifndef MK_SINGLE
#define MK_SINGLE 1
#endif
DI int q_next(const Fr& F, unsigned* ctr) {
    LAS int* slot = (LAS int*)(F.lds + LDS_QSLOT);
    __syncthreads();
    if (F.tid == 0) *slot = (int)__hip_atomic_fetch_add(ctr, 1u, RLX_AGENT);
    __syncthreads();
    return *slot;
}
DI int lane_id_fresh() { unsigned m_ = ~0u; asm volatile("" : "+s"(m_)); return (int)__builtin_amdgcn_mbcnt_hi(m_, __builtin_amdgcn_mbcnt_lo(m_, 0u)); }
#define RETID(F) do { int t2_ = F.tid; asm volatile("" : "+v"(t2_)); F.tid = t2_; F.lane = t2_ & 63; F.wave = __builtin_amdgcn_readfirstlane(t2_ >> 6); } while (0)
#ifndef PROBE_DUP
#define PROBE_DUP -1
#endif
#define NREP(q) ((PROBE_DUP == (q)) ? 2 : 1)
#define AS4 __attribute__((address_space(4)))
#define SITE() Args a; Fr F; { const AS4 Args* ap = (const AS4 Args*)__builtin_amdgcn_kernarg_segment_ptr(); asm volatile("" : "+s"(ap)); \
        _Pragma("unroll") for (int i_ = 0; i_ < 18; ++i_) a.in[i_] = ap->in[i_]; a.out = ap->out; a.ws = ap->ws; a.ph_lo = 0; a.ph_hi = 0; \
        int w_ = wv_s; asm volatile("" : "+s"(w_)); int t_ = w_ * 64 + lane_id_fresh(); asm volatile("" : "+v"(t_)); F.tid = t_; F.lane = t_ & 63; F.wave = __builtin_amdgcn_readfirstlane(t_ >> 6); \
        F.lds = (LAS unsigned char*)lds_raw; F.ws = a.ws; F.ctl = (unsigned*)(a.ws + WS_CTL); F.blk = blockIdx.x; F.G = gridDim.x; }
__global__ void __launch_bounds__(NTHR, 2) mega_fwd(Args a0) {
    extern __shared__ __attribute__((aligned(16))) unsigned char lds_raw[];
    const int wv_s = __builtin_amdgcn_readfirstlane((int)(threadIdx.x >> 6));
#if MK_SINGLE
    constexpr int lo = 0, hi = NPHASE; constexpr bool single = true;
#else
    const int lo = a0.ph_lo, hi = a0.ph_hi; constexpr bool single = false;
#endif
    if (threadIdx.x == 0) *(LAS v4u*)((LAS unsigned char*)lds_raw + LDS_BARW) = (v4u){0u, 0u, 0u, 0u};
    __syncthreads();
    if (single) (void)xcd_barrier_post((unsigned*)(a0.ws + WS_CTL) + CW_BAR, (volatile LAS unsigned*)((LAS unsigned char*)lds_raw + LDS_BARW));
#define IN(k) (lo <= (k) && (k) < hi)
#define SEAM() do { if (single) { const AS4 Args* ap_ = (const AS4 Args*)__builtin_amdgcn_kernarg_segment_ptr(); asm volatile("" : "+s"(ap_)); int w_ = wv_s; asm volatile("" : "+s"(w_)); \
        XcdBarrier b_; b_.bar = (unsigned*)(ap_->ws + WS_CTL) + CW_BAR; b_.x = xb_xcc_id(); b_.st = (volatile LAS unsigned*)((LAS unsigned char*)lds_raw + LDS_BARW); \
        xcd_barrier(b_, (w_ == 0) && (lane_id_fresh() == 0)); } } while (0)
    if (IN(0)) { _Pragma("unroll 1") for (int rep = 0; rep < NREP(100); ++rep) { { SITE(); ph_prologue(a, F); } SEAM(); } }
#pragma unroll 1
    for (int L = 0; L < DEPTH; ++L) {
        const int pb = 1 + NPL * L, j = L >> 1; const bool odd = (L & 1) != 0;
        if (IN(pb + 0)) _Pragma("unroll 1") for (int rep = 0; rep < NREP(0); ++rep) {
            { SITE();
            const bf16* w = odd ? (const bf16*)(F.ws + WS_WOD) + (size_t)j * OD_N * 1024 : (const bf16*)(F.ws + WS_WEV) + (size_t)j * EV_N * 1024;
            const int N = odd ? OD_N : EV_N;
            pg8::Gemm g{(const bf16*)(F.ws + WS_XB), w, NTOK, N, 1024}; pg8::StaticOrder S; S.init(NTOK, N, F.G, F.blk);
            pg8::EpiBf16<0> E{(bf16*)(F.ws + WS_PROJ), N, nullptr, 1024, (size_t)1024, C2F};
            pg8::gemm_phase<pg8::EpiBf16<0>, pg8::StaticOrder, true, true>(F.lds, g, S, E, F.tid); }
            SEAM(); }
        if (IN(pb + 1)) _Pragma("unroll 1") for (int rep = 0; rep < NREP(1); ++rep) { { SITE(); if (odd) ph_odd_prep(a, F, j, L); else ph_even_prep(a, F, j); } SEAM(); }
        if (!odd && IN(pb + 2)) _Pragma("unroll 1") for (int rep = 0; rep < ((PROBE_DUP == 2 || PROBE_DUP == 21 || PROBE_DUP == 22) ? 2 : 1); ++rep) {
            { SITE(); unsigned* ctr = F.ctl + CW_Q + 64 * (L * 2) + 1024 * rep;
            for (;;) { const int it = q_next(F, ctr); if (it >= 1280) break; RETID(F);
                if (it < 1024) { if (!(rep == 1 && PROBE_DUP == 22)) idx_unit(F, it & 3, 255 - (it >> 2)); } else { if (!(rep == 1 && PROBE_DUP == 21)) moba_gate_chunk(F, it - 1024); } } }
            SEAM(); }
        if (IN(pb + 3)) _Pragma("unroll 1") for (int rep = 0; rep < ((PROBE_DUP == 3 || (PROBE_DUP == 31 && odd) || ((PROBE_DUP == 32 || PROBE_DUP == 33) && !odd)) ? 2 : 1); ++rep) {
            { SITE(); unsigned* ctr = F.ctl + CW_Q + 64 * (L * 2 + 1) + 1024 * rep;
            if (odd) { for (;;) { const int it = q_next(F, ctr); if (it >= 2048) break; RETID(F); const int bh = it & 63; fox_unit(F, L, bh >> 4, bh & 15, 31 - (it >> 6)); } }
            else { for (;;) { const int it = q_next(F, ctr); if (it >= 2048) break; RETID(F);
                    if (it < 1024) { const int bh = it & 31; if (!(rep == 1 && PROBE_DUP == 33)) moba_unit(a, F, bh >> 3, bh & 7, it >> 5); } else { if (!(rep == 1 && PROBE_DUP == 32)) dsa_chunk(a, F, it - 1024); } } } }
            SEAM(); }
        if (!odd && IN(pb + 4)) _Pragma("unroll 1") for (int rep = 0; rep < NREP(4); ++rep) { { SITE(); ph_even_post(F, j); } SEAM(); }
        if (IN(pb + 5)) _Pragma("unroll 1") for (int rep = 0; rep < NREP(5); ++rep) {
            { SITE();
            const float* xin = (L == 0) ? a.in[0] : (const float*)(F.ws + WS_X);
            pg8::Gemm g{(const bf16*)(F.ws + WS_AO), (const bf16*)(F.ws + WS_WOUT) + (size_t)L * 1024 * 1024, NTOK, 1024, 1024}; pg8::StaticOrder S; S.init(NTOK, 1024, F.G, F.blk);
            EpiResF32 E{xin, (float*)(F.ws + WS_YP), ALPHA};
            pg8::gemm_phase<EpiResF32, pg8::StaticOrder, true, true>(F.lds, g, S, E, F.tid); }
            SEAM(); }
        if (IN(pb + 6)) _Pragma("unroll 1") for (int rep = 0; rep < NREP(6); ++rep) { { SITE(); ph_ln1_router(a, F, L); } SEAM(); }
        if (IN(pb + 7)) _Pragma("unroll 1") for (int rep = 0; rep < NREP(7); ++rep) { { SITE(); ph_route(F); } SEAM(); }
        if (IN(pb + 8)) _Pragma("unroll 1") for (int rep = 0; rep < NREP(8); ++rep) {
            { SITE(); const int ntl = (int)ld_u32(F.ctl + CW_TILE);
            LAS unsigned* tle = (LAS unsigned*)(F.lds + LDS_TILE_E);
            for (int i = F.tid; i < ntl; i += NTHR) tle[i] = ld_u32(F.ctl + CW_TILE + 64 + i);
            __syncthreads();
            pg8::Gemm g{(const bf16*)(F.ws + WS_XG), (const bf16*)(F.ws + WS_WGU + (size_t)L * 32 * 2048 * 1024), NR_MAX, 32 * 2048, 512};
            GroupOrder S{tle, ntl, 3, F.G, F.blk};
            EpiSwiglu E{F.ws + WS_ACT, a.in[15] + (size_t)L * 32 * 2048};
            pg8::gemm_phase<EpiSwiglu, GroupOrder, true, true, true>(F.lds, g, S, E, F.tid); }
            SEAM(); }
        if (IN(pb + 9)) _Pragma("unroll 1") for (int rep = 0; rep < NREP(9); ++rep) {
            { SITE(); const int ntl = (int)ld_u32(F.ctl + CW_TILE);
            LAS unsigned* tle = (LAS unsigned*)(F.lds + LDS_TILE_E);
            for (int i = F.tid; i < ntl; i += NTHR) tle[i] = ld_u32(F.ctl + CW_TILE + 64 + i);
            __syncthreads();
            pg8::Gemm g{(const bf16*)(F.ws + WS_ACT), (const bf16*)(F.ws + WS_WDN + (size_t)L * 32 * 1024 * 1024), NR_MAX, 32 * 1024, 512};
            GroupOrder S{tle, ntl, 2, F.G, F.blk};
            EpiDown E{(bf16*)(F.ws + WS_XG), a.in[17] + (size_t)L * 32 * 1024};
            pg8::gemm_phase<EpiDown, GroupOrder, true, true, true>(F.lds, g, S, E, F.tid); }
            SEAM(); }
        if (IN(pb + 10)) _Pragma("unroll 1") for (int rep = 0; rep < NREP(10); ++rep) { { SITE(); ph_combine_ln2(a, F, L); } if (L + 1 < DEPTH || rep + 1 < NREP(10)) SEAM(); }
    }
#undef IN
#undef SEAM
}

extern "C" void kernel_launch(void* const* d_in, const int* in_sizes, int n_in, void* d_out, int out_size, void* d_ws, size_t ws_size, hipStream_t stream) {
    static int grid = 0;
    if (grid == 0) {
        if (n_in != 18 || out_size != NTOK * DM || ws_size < WS_END) { fprintf(stderr, "kernel_launch: unexpected shapes (n_in %d, out %d, ws %zu); nothing launched\n", n_in, out_size, ws_size); grid = -1; return; }
        int dev = 0, cus = 0, per_cu = 0;
        if (hipGetDevice(&dev) != hipSuccess || hipDeviceGetAttribute(&cus, hipDeviceAttributeMultiprocessorCount, dev) != hipSuccess) { grid = -1; return; }
        if (hipFuncSetAttribute((const void*)mega_fwd, hipFuncAttributeMaxDynamicSharedMemorySize, LDS_BYTES) != hipSuccess) { fprintf(stderr, "kernel_launch: hipFuncSetAttribute failed\n"); grid = -1; return; }
        if (hipOccupancyMaxActiveBlocksPerMultiprocessor(&per_cu, (const void*)mega_fwd, NTHR, LDS_BYTES) != hipSuccess || per_cu < 1) fprintf(stderr, "kernel_launch: occupancy query reports %d\n", per_cu);
        (void)hipGetLastError();
        grid = cus;
    }
    if (grid < 0) return;
    (void)hipMemsetAsync((char*)d_ws + WS_CTL, 0, CTL_ZERO_BYTES, stream);
#ifdef EXP_SKIP
    (void)hipMemsetAsync((char*)d_ws + WS_AO, 0, 64 * MiB, stream);
    (void)hipMemsetAsync((char*)d_ws + WS_OL, 0, 64 * MiB, stream);
    if (EXP_SKIP & 4) { (void)hipMemsetAsync((char*)d_ws + WS_XG, 0, 272 * MiB, stream); (void)hipMemsetAsync((char*)d_ws + WS_DEST, 0, 1 * MiB, stream); }
#endif
    Args a{};
    for (int i = 0; i < 18; ++i) a.in[i] = (const float*)d_in[i];
    a.out = (float*)d_out; a.ws = (unsigned char*)d_ws;
#if MK_SINGLE
    a.ph_lo = 0; a.ph_hi = NPHASE;
    hipLaunchKernelGGL(mega_fwd, dim3(grid), dim3(NTHR), LDS_BYTES, stream, a);
#else
    for (int p = 0; p < NPHASE; ++p) {
        if (p > 0) { const int L = (p - 1) / NPL, q = (p - 1) % NPL; if ((L & 1) && (q == 2 || q == 4)) continue;
#ifdef EXP_SKIP
            if ((EXP_SKIP & 1) && !(L & 1) && q <= 4) continue;
            if ((EXP_SKIP & 2) && (L & 1) && q <= 4) continue;
            if ((EXP_SKIP & 4) && q >= 7 && q <= 9) continue;
#endif
        }
        a.ph_lo = p; a.ph_hi = p + 1;
        hipLaunchKernelGGL(mega_fwd, dim3(grid), dim3(NTHR), LDS_BYTES, stream, a);
    }
#endif
}
```

```cpp
#include <hip/hip_runtime.h>
#include <cstdio>
#include <cstdint>
#ifdef EXP_SKIP
#define EXPF EXP_SKIP
#else
#define EXPF 0
#endif
constexpr int NB = 4, SEQ = 8192, DM = 1024, NTOK = NB * SEQ, DEPTH = 4;
constexpr int EV_N = 2560, OD_N = 3072;
constexpr int EC_QA = 0, EC_QB = 512, EC_KB = 1024, EC_VB = 1536, EC_CKV = 2048, EC_QI = 2176, EC_KI = 2432, EC_WI = 2496;
constexpr int OC_Q = 0, OC_K = 1024, OC_V = 2048;
constexpr float LOG2E = 1.4426950408889634f;
constexpr float C2F = 0.125f * LOG2E;
constexpr float ALPHA = 1.681792830507429f;
constexpr float LN_EPS = 1e-5f;
constexpr int NR_MAX = 131072 + 32 * 256;
constexpr int NWAVES = 8, NTHR = 512;
constexpr size_t MiB = (size_t)1 << 20;
constexpr size_t WS_CTL = 0, CTL_ZERO_BYTES = 4 * MiB;
constexpr size_t WS_WEV = 8 * MiB, WS_WOD = 18 * MiB, WS_WOUT = 30 * MiB, WS_WUKT = 38 * MiB, WS_WUVT = 39 * MiB;
constexpr size_t WS_WGU = 40 * MiB, WS_WDN = 552 * MiB;
constexpr size_t WS_X = 808 * MiB, WS_X1 = 936 * MiB, WS_YP = 1064 * MiB, WS_XB = 1192 * MiB;
constexpr size_t WS_PROJ = 1256 * MiB, WS_AO = 1448 * MiB, WS_XG = 1512 * MiB, WS_ACT = 1784 * MiB;
constexpr size_t WS_QL = 2056 * MiB, WS_OL = 2120 * MiB, WS_CKVN = 2184 * MiB, WS_SEL = 2192 * MiB;
constexpr size_t WS_KBAR = 2208 * MiB, WS_SEL3 = 2209 * MiB, WS_LOGF = 2210 * MiB, WS_CS = 2212 * MiB;
constexpr size_t WS_TOPE = 2213 * MiB, WS_GATE = 2214 * MiB, WS_RANK = 2215 * MiB, WS_DEST = 2216 * MiB, WS_PML = 2217 * MiB;
constexpr size_t WS_XB8 = 2226 * MiB;
constexpr size_t WS_KIC = 2258 * MiB;
constexpr size_t WS_END = 2262 * MiB;
constexpr float F8_SX = 16.f, F8_SWG = 256.f, F8_SA = 4.f, F8_SWD = 512.f;
constexpr int CW_BAR = 4096, CW_Q = 8192, CW_KMAX = 12288, CW_CNT = 16384, CW_TILE = 32768;

#define GAS __attribute__((address_space(1)))
#define LAS __attribute__((address_space(3)))
#define DI __device__ __forceinline__
typedef unsigned short bf16;
typedef unsigned v4u __attribute__((ext_vector_type(4)));
typedef unsigned v2u __attribute__((ext_vector_type(2)));
typedef float f32x4 __attribute__((ext_vector_type(4)));
typedef float f32x2 __attribute__((ext_vector_type(2)));
typedef float f32x16 __attribute__((ext_vector_type(16)));
typedef short bf16x8 __attribute__((ext_vector_type(8)));
typedef short s16x4 __attribute__((ext_vector_type(4)));
typedef __bf16 bf16x2_t __attribute__((ext_vector_type(2)));
typedef GAS unsigned gu32;
#define RLX_AGENT __ATOMIC_RELAXED, __HIP_MEMORY_SCOPE_AGENT
#define LDS_WAIT() asm volatile("s_waitcnt lgkmcnt(0)" ::: "memory")

DI float bf2f(unsigned v) { return __uint_as_float(v << 16); }
DI unsigned cvtpk(float lo, float hi) { f32x2 v = {lo, hi}; bf16x2_t b = __builtin_convertvector(v, bf16x2_t); return __builtin_bit_cast(unsigned, b); }
DI unsigned f2bf(float f) { return cvtpk(f, 0.f) & 0xffffu; }
DI unsigned pk4_fp8(float a, float b, float c, float d) {
    a = fminf(fmaxf(a, -448.f), 448.f); b = fminf(fmaxf(b, -448.f), 448.f); c = fminf(fmaxf(c, -448.f), 448.f); d = fminf(fmaxf(d, -448.f), 448.f);
    int w = 0; w = __builtin_amdgcn_cvt_pk_fp8_f32(a, b, w, false); w = __builtin_amdgcn_cvt_pk_fp8_f32(c, d, w, true); return (unsigned)w; }
DI float ex2(float x) { return __builtin_amdgcn_exp2f(x); }
DI float wave_sum(float v) {
#pragma unroll
    for (int o = 1; o < 64; o <<= 1) v += __shfl_xor(v, o);
    return v;
}
DI float wave_max(float v) {
#pragma unroll
    for (int o = 1; o < 64; o <<= 1) v = fmaxf(v, __shfl_xor(v, o));
    return v;
}
DI unsigned ld_u32(const unsigned* p) { return __hip_atomic_load(p, RLX_AGENT); }
DI int crow(int r, int hi) { return (r & 3) + 8 * (r >> 2) + 4 * hi; }
DI f32x16 mfma32(bf16x8 a, bf16x8 b, f32x16 c) { return __builtin_amdgcn_mfma_f32_32x32x16_bf16(a, b, c, 0, 0, 0); }
DI f32x4 mfma16(bf16x8 a, bf16x8 b, f32x4 c) { return __builtin_amdgcn_mfma_f32_16x16x32_bf16(a, b, c, 0, 0, 0); }
typedef short v4i16_t __attribute__((ext_vector_type(4)));
DI s16x4 vtr(LAS const char* p) { return __builtin_bit_cast(s16x4, __builtin_amdgcn_ds_read_tr16_b64_v4i16((LAS v4i16_t*)p)); }
DI bf16x8 cat8(s16x4 a, s16x4 b) { return (bf16x8){a[0], a[1], a[2], a[3], b[0], b[1], b[2], b[3]}; }
DI int t5_bucket(int n) {
    if (n < 16) return n;
    int bkt = 16;
    bkt += (n >= 21); bkt += (n >= 27); bkt += (n >= 35); bkt += (n >= 46); bkt += (n >= 59); bkt += (n >= 77); bkt += (n >= 99); bkt += (n >= 128);
    bkt += (n >= 166); bkt += (n >= 216); bkt += (n >= 280); bkt += (n >= 363); bkt += (n >= 470); bkt += (n >= 609); bkt += (n >= 790);
    return bkt;
}
namespace pg8 {
#define PG8_LAS __attribute__((address_space(3)))
typedef unsigned short bf16_t;
typedef short bf16x8 __attribute__((ext_vector_type(8)));
typedef float f32x4 __attribute__((ext_vector_type(4)));
typedef unsigned u32x4 __attribute__((ext_vector_type(4)));
constexpr int BM = 256, BK = 64, HALF = 128, HTB = HALF * BK * 2  , STAGE_BYTES = 8 * HTB, NXCD = 8, WGM = 8;

__host__ __device__ __forceinline__ int lds_byte(int r, int c) { const int st = (r >> 4) * 2 + (c >> 5), rr = r & 15, cc = c & 31, ob = rr * 64 + cc * 2; return st * 1024 + (ob ^ (((ob >> 9) & 1) << 5)); }
__host__ __device__ __forceinline__ void stage_rc(int b, int& R, int& C) { const int st = b / 1024, sb = b % 1024, swz = sb ^ (((sb >> 9) & 1) << 5); R = (st >> 1) * 16 + swz / 64; C = (st & 1) * 32 + (swz % 64) / 2; }
__host__ __device__ __forceinline__ int perm32(int rho) { const int n = rho >> 4, i = rho & 15; return 8 * (i >> 2) + 4 * n + (i & 3); }

typedef int i32x8 __attribute__((ext_vector_type(8))); typedef int i32x4v __attribute__((ext_vector_type(4)));
__device__ __forceinline__ i32x8 pg8_cat8(bf16x8 lo, bf16x8 hi) { const i32x4v a = __builtin_bit_cast(i32x4v, lo), b = __builtin_bit_cast(i32x4v, hi); return (i32x8){a[0], a[1], a[2], a[3], b[0], b[1], b[2], b[3]}; }
struct Unit { int pm, pn; };
struct Gemm { const bf16_t* A; const bf16_t* Bt; int M, N, K; };

struct StaticOrder {
    int nM, nN, nwg, G, c;
    __host__ __device__ void init(int M, int N, int G_, int c_) { nM = M / BM; nN = N / BM; nwg = nM * nN; G = G_; c = c_; }
    __host__ __device__ bool next(int i, Unit& u) const {
        const long L = (long)i * G + c; if (L >= nwg) return false;
        int wgid = (int)L; { const int q = nwg / NXCD, r = nwg % NXCD, xcd = wgid % NXCD, off = wgid / NXCD; wgid = (xcd < r ? xcd * (q + 1) : r * (q + 1) + (xcd - r) * q) + off; }
        const int nig = WGM * nN, gid = wgid / nig, fm = gid * WGM, gsz = (nM - fm) < WGM ? (nM - fm) : WGM;
        u.pm = fm + ((wgid % nig) % gsz); u.pn = (wgid % nig) / gsz; return true;
    }
    __device__ __forceinline__ void a_ready(const Unit&) const {}
    __device__ __forceinline__ void done(const Unit&) const {}
};

__device__ __forceinline__ unsigned cvt_pk_bf16(float lo, float hi) { unsigned r; asm volatile("v_cvt_pk_bf16_f32 %0, %1, %2" : "=v"(r) : "v"(lo), "v"(hi)); return r; }
typedef float f32x2 __attribute__((ext_vector_type(2)));
__device__ __forceinline__ f32x2 gelu_pk(f32x2 v) {
    const f32x2 av = __builtin_elementwise_abs(v), d = av * 0.2316418882f + 1.0f;
    f32x2 t; t.x = __builtin_amdgcn_rcpf(d.x); t.y = __builtin_amdgcn_rcpf(d.y);
    f32x2 q = t * 0.5307027145f + (-0.7265760135f); q = q * t + 0.7107068705f; q = q * t + (-0.142248368f); q = q * t + 0.127414796f; q = q * t;
    const f32x2 s = (v * v) * (-0.72134752044f);
    f32x2 e; e.x = __builtin_amdgcn_exp2f(s.x); e.y = __builtin_amdgcn_exp2f(s.y);
    const f32x2 m = v * (q * e), r = v - m;
    f32x2 o; o.x = v.x < 0.f ? m.x : r.x; o.y = v.y < 0.f ? m.y : r.y; return o;
}

template <int ACT  > struct EpiBf16 {
    static constexpr bool PERM = true, AFTER_DRAIN = false; static_assert(ACT == 0 || ACT == 1, "EpiBf16: ACT is 0 (none) or 1 (gelu_pk)");
    bf16_t* O; int ldc; const float* bias; int split_cols; size_t split_stride; float scale0;
    __device__ __forceinline__ void operator()(const f32x4 (&acc)[2][2][4][2], const Unit& u, int wr, int wc, int fr, int fq) const {
        const int row0 = u.pm * BM + wr * 64 + fr; int colt = u.pn * BM; bf16_t* base = O;
        float sc = 1.f; if (split_cols) { const int t = colt / split_cols; base += (size_t)t * split_stride; colt -= t * split_cols; if (t == 0) sc = scale0; }
        const int col0 = colt + wc * 32 + 8 * fq, bcol0 = u.pn * BM + wc * 32 + 8 * fq;
        f32x4 bv[2][2];
#pragma unroll
        for (int bj = 0; bj < 2; ++bj)
#pragma unroll
            for (int n = 0; n < 2; ++n) bv[bj][n] = bias ? *(const f32x4*)(bias + bcol0 + bj * HALF + 4 * n) : (f32x4){0.f, 0.f, 0.f, 0.f};
#pragma unroll
        for (int ai = 0; ai < 2; ++ai)
#pragma unroll
            for (int m = 0; m < 4; ++m) { bf16_t* rowp = base + (size_t)(row0 + ai * HALF + m * 16) * ldc + col0;
#pragma unroll
                for (int bj = 0; bj < 2; ++bj) { f32x4 v0 = acc[ai][bj][m][0] + bv[bj][0], v1 = acc[ai][bj][m][1] + bv[bj][1];
                    if (ACT == 1) { f32x2 a = gelu_pk((f32x2){v0[0], v0[1]}), b = gelu_pk((f32x2){v0[2], v0[3]}), c = gelu_pk((f32x2){v1[0], v1[1]}), d = gelu_pk((f32x2){v1[2], v1[3]});
                        v0 = (f32x4){a.x, a.y, b.x, b.y}; v1 = (f32x4){c.x, c.y, d.x, d.y}; }
                    v0 = v0 * sc; v1 = v1 * sc; u32x4 w; w.x = cvt_pk_bf16(v0[0], v0[1]); w.y = cvt_pk_bf16(v0[2], v0[3]); w.z = cvt_pk_bf16(v1[0], v1[1]); w.w = cvt_pk_bf16(v1[2], v1[3]);
                    *(u32x4*)(rowp + bj * HALF) = w; } }
    }
};

template <class Epi, class Sched, bool ALIGN_EPI = false, bool SP2 = false, bool F8 = false>
__device__ __forceinline__ void gemm_phase(PG8_LAS unsigned char* lds, const Gemm g, const Sched& S, const Epi& E, int tid_in) {
    int tid_l = tid_in; asm volatile("" : "+v"(tid_l));
    const int tid = tid_l, wid = __builtin_amdgcn_readfirstlane(tid >> 6), lane = tid & 63, wr = wid >> 2, wc = wid & 3, fr = lane & 15, fq = lane >> 4;
    const int K = g.K, nt = K / BK;
    unsigned voffA[2], voffB[2];
#pragma unroll
    for (int i = 0; i < 2; ++i) { int R, C; stage_rc(tid * 16 + i * 8192, R, C); const int Rb = Epi::PERM ? ((R & ~31) + perm32(R & 31)) : R;
        voffA[i] = (unsigned)(R * K + C) * 2u; voffB[i] = (unsigned)(Rb * K + C) * 2u; }
    const size_t kstep = (size_t)(BK * 2);
    const size_t hstep = (size_t)HALF * K * 2;
    const size_t tstep = 2 * hstep;
    const unsigned ldsw = (unsigned)wid * 1024u;
    const int aoff = lds_byte(wr * 64 + fr, fq * 8), boff = lds_byte(wc * 32 + fr, fq * 8);
#define PG8_SA(b, h) (((b) * 2 + (h)) * HTB)
#define PG8_SB(b, h) ((4 + (b) * 2 + (h)) * HTB)
#define PG8_STAGE(bufoff, gbase, voff) do { _Pragma("unroll") for (int _i = 0; _i < 2; ++_i) \
        __builtin_amdgcn_global_load_lds((const unsigned*)((const char*)(gbase) + (voff)[_i]), (PG8_LAS unsigned*)(lds + (bufoff) + ldsw + _i * 8192), 16, 0, 0); } while (0)
#define PG8_LDA(dst, b, h) do { _Pragma("unroll") for (int m = 0; m < 4; ++m) _Pragma("unroll") for (int k = 0; k < 2; ++k) dst[m][k] = *(const PG8_LAS bf16x8*)(lds + PG8_SA(b, h) + aoff + m * 2048 + k * 1024); } while (0)
#define PG8_LDB(dst, b, h) do { _Pragma("unroll") for (int n = 0; n < 2; ++n) _Pragma("unroll") for (int k = 0; k < 2; ++k) dst[n][k] = *(const PG8_LAS bf16x8*)(lds + PG8_SB(b, h) + boff + n * 2048 + k * 1024); } while (0)
#define PG8_MMA(ai, bj, At, Bt) do { __builtin_amdgcn_s_setprio(1); if constexpr (!F8) { _Pragma("unroll") for (int m = 0; m < 4; ++m) _Pragma("unroll") for (int n = 0; n < 2; ++n) _Pragma("unroll") for (int k = 0; k < 2; ++k) \
        acc[ai][bj][m][n] = __builtin_amdgcn_mfma_f32_16x16x32_bf16(Bt[n][k], At[m][k], acc[ai][bj][m][n], 0, 0, 0); } else { _Pragma("unroll") for (int m = 0; m < 4; ++m) _Pragma("unroll") for (int n = 0; n < 2; ++n) \
        acc[ai][bj][m][n] = __builtin_amdgcn_mfma_scale_f32_16x16x128_f8f6f4(pg8_cat8(Bt[n][0], Bt[n][1]), pg8_cat8(At[m][0], At[m][1]), acc[ai][bj][m][n], 0, 0, 0, 0x7F7F7F7F, 0, 0x7F7F7F7F); \
        _Pragma("unroll") for (int m = 0; m < 4; ++m) _Pragma("unroll") for (int n = 0; n < 2; ++n) asm volatile("" : "+v"(acc[ai][bj][m][n]));   } __builtin_amdgcn_s_setprio(0); } while (0)
#define PG8_WAIT_V(n) asm volatile("s_waitcnt vmcnt(" #n ")" ::: "memory")
#define PG8_WAIT_L(n) asm volatile("s_waitcnt lgkmcnt(" #n ")" ::: "memory")
#define PG8_BAR __builtin_amdgcn_s_barrier()
#define PG8_SCHED __builtin_amdgcn_sched_barrier(0)
    Unit cur, nxt; int ui = 0;
    if (!S.next(0, cur)) return;
    f32x4 acc[2][2][4][2];
#pragma unroll
    for (int a = 0; a < 2; ++a)
#pragma unroll
        for (int b = 0; b < 2; ++b)
#pragma unroll
            for (int m = 0; m < 4; ++m)
#pragma unroll
                for (int n = 0; n < 2; ++n) acc[a][b][m][n] = (f32x4){0.f, 0.f, 0.f, 0.f};
    bf16x8 At[4][2], B0[2][2], B1[2][2];
    const char* cA = (const char*)g.A + (size_t)cur.pm * tstep; const char* cB = (const char*)g.Bt + (size_t)cur.pn * tstep;
    S.a_ready(cur);
    if constexpr (SP2) {
        PG8_STAGE(PG8_SB(0, 0), cB, voffB); PG8_STAGE(PG8_SB(0, 1), cB + hstep, voffB); PG8_STAGE(PG8_SA(0, 0), cA, voffA); PG8_STAGE(PG8_SA(0, 1), cA + hstep, voffA);
        if (wr == 1) PG8_BAR;
        PG8_WAIT_V(2); PG8_BAR;
        PG8_STAGE(PG8_SB(1, 0), cB + kstep, voffB); PG8_STAGE(PG8_SA(1, 0), cA + kstep, voffA); PG8_STAGE(PG8_SB(1, 1), cB + hstep + kstep, voffB);
        PG8_WAIT_V(6); PG8_BAR;
    } else {
        PG8_STAGE(PG8_SB(0, 0), cB, voffB); PG8_STAGE(PG8_SA(0, 0), cA, voffA); PG8_STAGE(PG8_SB(0, 1), cB + hstep, voffB); PG8_STAGE(PG8_SA(0, 1), cA + hstep, voffA);
        if (wr == 1) PG8_BAR;
        PG8_WAIT_V(4); PG8_BAR;
        PG8_STAGE(PG8_SB(1, 0), cB + kstep, voffB); PG8_STAGE(PG8_SA(1, 0), cA + kstep, voffA); PG8_STAGE(PG8_SB(1, 1), cB + hstep + kstep, voffB);
        PG8_WAIT_V(6); PG8_BAR;
    }
    for (;;) {
        const bool has_next = S.next(ui + 1, nxt);
        const char* nA = has_next ? (const char*)g.A + (size_t)nxt.pm * tstep : cA; const char* nB = has_next ? (const char*)g.Bt + (size_t)nxt.pn * tstep : cB;
        for (int t = 0; t < nt; t += 2) {
            const bool last = (t == nt - 2);
            const char* a1 = cA + (size_t)(t + 1) * kstep;
            const char* a2 = last ? nA : cA + (size_t)(t + 2) * kstep; const char* b2 = last ? nB : cB + (size_t)(t + 2) * kstep;
            const char* a3 = a2 + kstep; const char* b3 = b2 + kstep;
            if (last && has_next) S.a_ready(nxt);
            if constexpr (SP2) {
            PG8_LDB(B0, 0, 0); PG8_LDB(B1, 0, 1); PG8_SCHED; PG8_LDA(At, 0, 0); PG8_STAGE(PG8_SA(1, 1), a1 + hstep, voffA);
            PG8_WAIT_V(8); PG8_WAIT_L(0); PG8_BAR; PG8_MMA(0, 0, At, B0); PG8_MMA(0, 1, At, B1); PG8_BAR; PG8_SCHED;
            PG8_LDA(At, 0, 1); PG8_STAGE(PG8_SB(0, 0), b2, voffB); PG8_STAGE(PG8_SB(0, 1), b2 + hstep, voffB); PG8_STAGE(PG8_SA(0, 0), a2, voffA);
            PG8_WAIT_V(8); PG8_WAIT_L(0); PG8_BAR; PG8_MMA(1, 0, At, B0); PG8_MMA(1, 1, At, B1); PG8_BAR; PG8_SCHED;
            PG8_LDB(B0, 1, 0); PG8_LDB(B1, 1, 1); PG8_SCHED; PG8_LDA(At, 1, 0); PG8_STAGE(PG8_SA(0, 1), a2 + hstep, voffA);
            PG8_WAIT_V(8); PG8_WAIT_L(0); PG8_BAR; PG8_MMA(0, 0, At, B0); PG8_MMA(0, 1, At, B1); PG8_BAR; PG8_SCHED;
            PG8_LDA(At, 1, 1); PG8_STAGE(PG8_SB(1, 0), b3, voffB); PG8_STAGE(PG8_SB(1, 1), b3 + hstep, voffB); PG8_STAGE(PG8_SA(1, 0), a3, voffA);
            PG8_WAIT_V(8); PG8_WAIT_L(0); PG8_BAR; PG8_MMA(1, 0, At, B0); PG8_MMA(1, 1, At, B1); PG8_BAR; PG8_SCHED;
            } else {
            PG8_LDB(B0, 0, 0); PG8_SCHED; PG8_LDA(At, 0, 0); PG8_STAGE(PG8_SA(1, 1), a1 + hstep, voffA);
            PG8_WAIT_L(8); PG8_BAR; PG8_WAIT_L(0); PG8_MMA(0, 0, At, B0); PG8_BAR; PG8_SCHED;
            PG8_LDB(B1, 0, 1); PG8_STAGE(PG8_SB(0, 0), b2, voffB);
            PG8_BAR; PG8_WAIT_L(0); PG8_MMA(0, 1, At, B1); PG8_BAR;
            PG8_LDA(At, 0, 1); PG8_STAGE(PG8_SA(0, 0), a2, voffA);
            PG8_BAR; PG8_WAIT_L(0); PG8_MMA(1, 0, At, B0); PG8_BAR; PG8_SCHED;
            PG8_STAGE(PG8_SB(0, 1), b2 + hstep, voffB);
            PG8_WAIT_V(6); PG8_BAR; PG8_MMA(1, 1, At, B1); PG8_BAR;
            PG8_LDB(B0, 1, 0); PG8_SCHED; PG8_LDA(At, 1, 0); PG8_STAGE(PG8_SA(0, 1), a2 + hstep, voffA);
            PG8_WAIT_L(8); PG8_BAR; PG8_WAIT_L(0); PG8_MMA(0, 0, At, B0); PG8_BAR; PG8_SCHED;
            PG8_LDB(B1, 1, 1); PG8_STAGE(PG8_SB(1, 0), b3, voffB);
            PG8_BAR; PG8_WAIT_L(0); PG8_MMA(0, 1, At, B1); PG8_BAR;
            PG8_LDA(At, 1, 1); PG8_STAGE(PG8_SA(1, 0), a3, voffA);
            PG8_BAR; PG8_WAIT_L(0); PG8_MMA(1, 0, At, B0); PG8_BAR; PG8_SCHED;
            PG8_STAGE(PG8_SB(1, 1), b3 + hstep, voffB);
            PG8_WAIT_V(6); PG8_BAR; PG8_MMA(1, 1, At, B1); PG8_BAR;
            }
        }
        if constexpr (ALIGN_EPI) { if (wr == 0) PG8_BAR; }
        if constexpr (!Epi::AFTER_DRAIN) { E(acc, cur, wr, wc, fr, fq); S.done(cur); }
        if (!has_next) break;
#pragma unroll
        for (int a = 0; a < 2; ++a)
#pragma unroll
            for (int b = 0; b < 2; ++b)
#pragma unroll
                for (int m = 0; m < 4; ++m)
#pragma unroll
                    for (int n = 0; n < 2; ++n) acc[a][b][m][n] = (f32x4){0.f, 0.f, 0.f, 0.f};
        cur = nxt; cA = nA; cB = nB; ++ui;
        if constexpr (ALIGN_EPI) { if (wr == 1) PG8_BAR; }
    }
    PG8_WAIT_V(0);
    if constexpr (!ALIGN_EPI) { if (wr == 0) PG8_BAR; }
    PG8_BAR;
    if constexpr (Epi::AFTER_DRAIN) { E.fused(acc, cur, wr, wc, fr, fq, lds, wid, lane); S.done(cur); }
#undef PG8_SA
#undef PG8_SB
#undef PG8_STAGE
#undef PG8_LDA
#undef PG8_LDB
#undef PG8_MMA
#undef PG8_WAIT_V
#undef PG8_WAIT_L
#undef PG8_BAR
#undef PG8_SCHED
}
}

#ifndef PG8_SP2
#define PG8_SP2 true
#endif
#ifndef PG8_ALIGN
#define PG8_ALIGN true
#endif
#define XB_TMO      128
#define XB_XCNT(j)  (256  + 64 * (j))
#define XB_XSUB(j)  (1280 + 64 * (j))
#define XB_XGEN(j)  (2304 + 64 * (j))
#define XB_TOP      3328
#define XB_TOPGEN   3392
#define XCD_BAR_WORDS 3456
#define XB_SPIN_CAP (1u << 18)

__device__ __forceinline__ unsigned xb_ld(unsigned* p)              { return __hip_atomic_load(p, __ATOMIC_RELAXED, __HIP_MEMORY_SCOPE_AGENT); }
__device__ __forceinline__ unsigned xb_add(unsigned* p, unsigned v) { return __hip_atomic_fetch_add(p, v, __ATOMIC_RELAXED, __HIP_MEMORY_SCOPE_AGENT); }
__device__ __forceinline__ unsigned xb_xcc_id() { return (unsigned)__builtin_amdgcn_s_getreg((3 << 11) | 20) & 0xFu; }
#define XB_SPIN(cond, bar) do { unsigned _sp = 0; while (cond) { __builtin_amdgcn_s_sleep(1); \
    if ((++_sp & 255u) == 0u) { if (xb_ld(&(bar)[XB_TMO])) break; if (_sp > XB_SPIN_CAP) { atomicAdd(&(bar)[XB_TMO], 1u); break; } } } } while (0)

struct XcdBarrier {
    unsigned* bar; unsigned x;
    volatile LAS unsigned* st;
};

__device__ __forceinline__ XcdBarrier xcd_barrier_post(unsigned* bar, volatile LAS unsigned* st) {
    XcdBarrier b; b.bar = bar; b.x = xb_xcc_id(); b.st = st;
    if (threadIdx.x == 0) (void)xb_add(&bar[XB_XCNT(b.x)], 1u);
    return b;
}
__device__ __forceinline__ void xcd_barrier_complete(unsigned* bar, unsigned x, unsigned& nloc, unsigned& nx) {
    const unsigned G = gridDim.x * gridDim.y * gridDim.z;
    unsigned sum, cnt, mine, sp = 0u;
    for (;;) {
        sum = 0u; cnt = 0u; mine = 0u;
#pragma unroll
        for (unsigned j = 0; j < 16; ++j) { const unsigned c = xb_ld(&bar[XB_XCNT(j)]); sum += c; cnt += (c > 0u) ? 1u : 0u; mine = (j == x) ? c : mine; }
        if (sum == G) break;
        __builtin_amdgcn_s_sleep(1);
        if ((++sp & 255u) == 0u) { if (xb_ld(&bar[XB_TMO])) break; if (sp > XB_SPIN_CAP) { atomicAdd(&bar[XB_TMO], 1u); break; } }
    }
    nloc = mine > 0u ? mine : 1u; nx = cnt > 0u ? cnt : 1u;
}

__device__ __forceinline__ void xcd_barrier(const XcdBarrier& b, const bool is_t0  ) {
    asm volatile("s_waitcnt vmcnt(0)" ::: "memory");
    __syncthreads();
    if (is_t0) {
        unsigned* bar = b.bar;
        __builtin_amdgcn_s_waitcnt(0);
        unsigned nloc = b.st[0], nx = b.st[1];
        if (nloc == 0u) { xcd_barrier_complete(bar, b.x, nloc, nx); b.st[0] = nloc; b.st[1] = nx; }
        const unsigned old = xb_add(&bar[XB_XSUB(b.x)], 1u);
        const unsigned gen = old / nloc;
        if (old + 1u == (gen + 1u) * nloc) {
            __builtin_amdgcn_fence(__ATOMIC_RELEASE, "agent");
            asm volatile("s_waitcnt vmcnt(0)" ::: "memory");
            const unsigned og = xb_add(&bar[XB_TOP], 1u);
            const unsigned tg = og / nx;
            if (og + 1u == (tg + 1u) * nx) xb_add(&bar[XB_TOPGEN], 1u);
            else XB_SPIN(xb_ld(&bar[XB_TOPGEN]) == tg, bar);
            __builtin_amdgcn_fence(__ATOMIC_ACQUIRE, "agent");
            xb_add(&bar[XB_XGEN(b.x)], 1u);
            asm volatile("s_waitcnt vmcnt(0)" ::: "memory");
        } else {
            XB_SPIN(xb_ld(&bar[XB_XGEN(b.x)]) == gen, bar);
            __builtin_amdgcn_fence(__ATOMIC_ACQUIRE, "agent");
            asm volatile("s_waitcnt vmcnt(0)" ::: "memory");
        }
    }
    __syncthreads();
}
struct EpiResF32 {
    static constexpr bool PERM = true, AFTER_DRAIN = false;
    const float* xin; float* yp; float alpha;
    DI void operator()(const pg8::f32x4 (&acc)[2][2][4][2], const pg8::Unit& u, int wr, int wc, int fr, int fq) const {
        const int row0 = u.pm * 256 + wr * 64 + fr, col0 = u.pn * 256 + wc * 32 + 8 * fq;
#pragma unroll
        for (int ai = 0; ai < 2; ++ai)
#pragma unroll
            for (int m = 0; m < 4; ++m) {
                const size_t ro = (size_t)(row0 + ai * 128 + m * 16) * DM;
#pragma unroll
                for (int bj = 0; bj < 2; ++bj) {
                    const size_t o = ro + col0 + bj * 128;
                    const f32x4 x0 = *(const f32x4*)(xin + o), x1 = *(const f32x4*)(xin + o + 4);
                    *(f32x4*)(yp + o) = x0 * alpha + acc[ai][bj][m][0];
                    *(f32x4*)(yp + o + 4) = x1 * alpha + acc[ai][bj][m][1];
                }
            }
    }
};
struct EpiSwiglu {
    static constexpr bool PERM = true, AFTER_DRAIN = false;
    unsigned char* act; const float* bgu;
    DI void operator()(const pg8::f32x4 (&acc)[2][2][4][2], const pg8::Unit& u, int wr, int wc, int fr, int fq) const {
        const int e = u.pn >> 3, pl = u.pn & 7;
        const int row0 = u.pm * 256 + wr * 64 + fr, cih = pl * 128 + wc * 32 + 8 * fq;
        const float* bg = bgu + e * 2048 + cih;
        const f32x4 bg0 = *(const f32x4*)(bg), bg1 = *(const f32x4*)(bg + 4), bu0 = *(const f32x4*)(bg + 1024), bu1 = *(const f32x4*)(bg + 1028);
#pragma unroll
        for (int ai = 0; ai < 2; ++ai)
#pragma unroll
            for (int m = 0; m < 4; ++m) {
                constexpr float RS = 1.f / (F8_SX * F8_SWG);
                const f32x4 g0 = acc[ai][0][m][0] * RS + bg0, g1 = acc[ai][0][m][1] * RS + bg1, u0 = acc[ai][1][m][0] * RS + bu0, u1 = acc[ai][1][m][1] * RS + bu1;
                float r[8];
#pragma unroll
                for (int i = 0; i < 8; ++i) {
                    float g = i < 4 ? g0[i & 3] : g1[i & 3], uu = i < 4 ? u0[i & 3] : u1[i & 3];
                    g = fminf(g, 7.0f); uu = fminf(fmaxf(uu, -7.0f), 7.0f);
                    const float sg = __builtin_amdgcn_rcpf(1.0f + ex2(-1.702f * LOG2E * g));
                    r[i] = (uu + 1.0f) * g * sg * F8_SA;
                }
                v2u w; w.x = pk4_fp8(r[0], r[1], r[2], r[3]); w.y = pk4_fp8(r[4], r[5], r[6], r[7]);
                *(v2u*)(act + (size_t)(row0 + ai * 128 + m * 16) * DM + cih) = w;
            }
    }
};
struct EpiDown {
    static constexpr bool PERM = true, AFTER_DRAIN = false;
    bf16* yr; const float* bdn;
    DI void operator()(const pg8::f32x4 (&acc)[2][2][4][2], const pg8::Unit& u, int wr, int wc, int fr, int fq) const {
        const int e = u.pn >> 2, pl = u.pn & 3;
        const int row0 = u.pm * 256 + wr * 64 + fr, col0 = pl * 256 + wc * 32 + 8 * fq;
        f32x4 bv[2][2];
#pragma unroll
        for (int bj = 0; bj < 2; ++bj) { bv[bj][0] = *(const f32x4*)(bdn + e * 1024 + col0 + bj * 128); bv[bj][1] = *(const f32x4*)(bdn + e * 1024 + col0 + bj * 128 + 4); }
#pragma unroll
        for (int ai = 0; ai < 2; ++ai)
#pragma unroll
            for (int m = 0; m < 4; ++m) {
                bf16* rp = yr + (size_t)(row0 + ai * 128 + m * 16) * DM + col0;
#pragma unroll
                for (int bj = 0; bj < 2; ++bj) {
                    constexpr float RS = 1.f / (F8_SA * F8_SWD);
                    const f32x4 v0 = acc[ai][bj][m][0] * RS + bv[bj][0], v1 = acc[ai][bj][m][1] * RS + bv[bj][1];
                    v4u w; w.x = cvtpk(v0[0], v0[1]); w.y = cvtpk(v0[2], v0[3]); w.z = cvtpk(v1[0], v1[1]); w.w = cvtpk(v1[2], v1[3]);
                    *(v4u*)(rp + bj * 128) = w;
                }
            }
    }
};
struct GroupOrder {
    LAS const unsigned* tile_e; int ntiles, lg, G, c;
    DI bool next(int i, pg8::Unit& u) const {
        int pm, pl;
        if (G == 256) {
            const int x = c & 7, k = c >> 3; pm = i * (256 >> lg) + x * (32 >> lg) + (k >> lg); pl = k & ((1 << lg) - 1); if (pm >= ntiles) return false; }
        else { const long L = (long)i * G + c; if (L >= ((long)ntiles << lg)) return false; pm = (int)(L >> lg); pl = (int)(L & ((1 << lg) - 1)); }
        const int e = __builtin_amdgcn_readfirstlane((int)tile_e[pm]);
        u.pm = pm; u.pn = (e << lg) + pl; return true;
    }
    DI void a_ready(const pg8::Unit&) const {}
    DI void done(const pg8::Unit&) const {}
};
struct Args { const float* in[18]; float* out; unsigned char* ws; int ph_lo, ph_hi; };
struct Fr { LAS unsigned char* lds; unsigned char* ws; unsigned* ctl; int tid, lane, wave, blk, G; };

DI void tr_item(const float* W, int ldw, int K, int k0, int sc0, int nvalid, bf16* WT, int drow0, LAS float* scr, int lane) {
    const int c = lane & 31;
#pragma unroll 8
    for (int i = 0; i < 32; ++i) { const int kk = 2 * i + (lane >> 5); scr[kk * 33 + c] = (c < nvalid) ? W[(size_t)(k0 + kk) * ldw + sc0 + c] : 0.f; }
    LDS_WAIT(); asm volatile("" ::: "memory");
    const int c8 = lane & 7;
#pragma unroll
    for (int j = 0; j < 4; ++j) { const int n = (lane >> 3) + 8 * j; const LAS float* s = scr + (8 * c8) * 33 + n;
        v4u o; o.x = cvtpk(s[0 * 33], s[1 * 33]); o.y = cvtpk(s[2 * 33], s[3 * 33]); o.z = cvtpk(s[4 * 33], s[5 * 33]); o.w = cvtpk(s[6 * 33], s[7 * 33]);
        *(v4u*)(WT + (size_t)(drow0 + n) * K + k0 + 8 * c8) = o; }
    LDS_WAIT(); asm volatile("" ::: "memory");
}
DI void tr_item8(const float* W, int ldw, int K, int k0, int sc0, float scale, unsigned char* WT8, int drow0, LAS float* scr, int lane) {
    const int c = lane & 31;
#pragma unroll 8
    for (int i = 0; i < 32; ++i) { const int kk = 2 * i + (lane >> 5); scr[kk * 33 + c] = W[(size_t)(k0 + kk) * ldw + sc0 + c] * scale; }
    LDS_WAIT(); asm volatile("" ::: "memory");
    const int c16 = lane & 3;
#pragma unroll
    for (int j = 0; j < 2; ++j) { const int n = (lane >> 2) + 16 * j; const LAS float* s = scr + (16 * c16) * 33 + n;
        v4u o; o.x = pk4_fp8(s[0 * 33], s[1 * 33], s[2 * 33], s[3 * 33]); o.y = pk4_fp8(s[4 * 33], s[5 * 33], s[6 * 33], s[7 * 33]);
        o.z = pk4_fp8(s[8 * 33], s[9 * 33], s[10 * 33], s[11 * 33]); o.w = pk4_fp8(s[12 * 33], s[13 * 33], s[14 * 33], s[15 * 33]);
        *(v4u*)(WT8 + (size_t)(drow0 + n) * K + k0 + 16 * c16) = o; }
    LDS_WAIT(); asm volatile("" ::: "memory");
}
DI void ph_prologue(const Args& a, const Fr& F) {
    LAS float* scr = (LAS float*)(F.lds + F.wave * 16384);
    const int gw = F.blk * NWAVES + F.wave, NGW = F.G * NWAVES;
    constexpr int I_EV = 2 * 16 * 80, I_OD = 2 * 16 * 96, I_WO = 4 * 16 * 32, I_GU = 128 * 16 * 64, I_DN = 128 * 16 * 32;
    constexpr int NITEMS = I_EV + I_OD + I_WO + I_GU + I_DN;
    bf16* wev = (bf16*)(F.ws + WS_WEV); bf16* wod = (bf16*)(F.ws + WS_WOD); bf16* wout = (bf16*)(F.ws + WS_WOUT);
    unsigned char* wgu = F.ws + WS_WGU; unsigned char* wdn = F.ws + WS_WDN;
    for (int it = gw; it < NITEMS; it += NGW) {
        int r = it;
        if (r < I_EV) { const int l = r / 1280; r %= 1280; const int kb = r / 80, n0 = (r % 80) * 32; int sc0, nv = 32;
            if (n0 < 512) sc0 = n0; else if (n0 < 1024) sc0 = 964 + (n0 - 512); else if (n0 < 1536) sc0 = 1476 + (n0 - 1024); else if (n0 < 2048) sc0 = 1988 + (n0 - 1536);
            else if (n0 < 2176) sc0 = 512 + (n0 - 2048); else if (n0 < 2432) sc0 = 640 + (n0 - 2176); else if (n0 < 2496) sc0 = 896 + (n0 - 2432);
            else if (n0 < 2528) { sc0 = 960; nv = 4; } else { sc0 = 0; nv = 0; }
            tr_item(a.in[1] + (size_t)l * 1024 * 2500, 2500, 1024, kb * 64, sc0, nv, wev + (size_t)l * EV_N * 1024, n0, scr, F.lane); continue; }
        r -= I_EV;
        if (r < I_OD) { const int l = r / 1536; r %= 1536; const int kb = r / 96, n0 = (r % 96) * 32;
            tr_item(a.in[6] + (size_t)l * 1024 * 3088, 3088, 1024, kb * 64, n0, 32, wod + (size_t)l * OD_N * 1024, n0, scr, F.lane); continue; }
        r -= I_OD;
        if (r < I_WO) { const int l = r / 512; r %= 512; const int kb = r / 32, n0 = (r % 32) * 32;
            const float* src = (l & 1) ? a.in[8] + (size_t)(l >> 1) * 1024 * 1024 : a.in[5] + (size_t)(l >> 1) * 1024 * 1024;
            tr_item(src, 1024, 1024, kb * 64, n0, 32, wout + (size_t)l * 1024 * 1024, n0, scr, F.lane); continue; }
        r -= I_WO;
        if (r < I_GU) { const int le = r / 1024; r %= 1024; const int kb = r / 64, n0 = (r % 64) * 32;
            const int pn = n0 >> 8, bj = (n0 >> 7) & 1, j0 = n0 & 127;
            tr_item8(a.in[14] + (size_t)le * 1024 * 2048, 2048, 1024, kb * 64, bj * 1024 + pn * 128 + j0, F8_SWG, wgu + (size_t)le * 2048 * 1024, n0, scr, F.lane); continue; }
        r -= I_GU;
        { const int le = r / 512; r %= 512; const int kb = r / 32, n0 = (r % 32) * 32;
            tr_item8(a.in[16] + (size_t)le * 1024 * 1024, 1024, 1024, kb * 64, n0, F8_SWD, wdn + (size_t)le * 1024 * 1024, n0, scr, F.lane); }
    }
    bf16* xb = (bf16*)(F.ws + WS_XB);
    for (int m = gw; m < NTOK; m += NGW) {
        const f32x4* xr = (const f32x4*)(a.in[0] + (size_t)m * DM) + F.lane; v2u* o = (v2u*)(xb + (size_t)m * DM) + F.lane;
#pragma unroll
        for (int j = 0; j < 4; ++j) { const f32x4 v = xr[64 * j]; v2u w; w.x = cvtpk(v[0], v[1]); w.y = cvtpk(v[2], v[3]); o[64 * j] = w; }
    }
    bf16* wukt = (bf16*)(F.ws + WS_WUKT); bf16* wuvt = (bf16*)(F.ws + WS_WUVT);
    for (int i = F.blk * NTHR + F.tid; i < 2 * 8 * 128 * 64; i += F.G * NTHR) {
        { const int d = i & 63, c = (i >> 6) & 127, lh = i >> 13; wukt[i] = (bf16)f2bf(a.in[2][((size_t)lh * 64 + d) * 128 + c]); }
        { const int c = i & 127, d = (i >> 7) & 63, lh = i >> 13; wuvt[i] = (bf16)f2bf(a.in[3][((size_t)lh * 128 + c) * 64 + d]); }
    }
}

DI void ln_row(f32x4 (&v)[4], const float* g, const float* b, int lane) {
    float s = 0.f;
#pragma unroll
    for (int j = 0; j < 4; ++j) s += (v[j][0] + v[j][1]) + (v[j][2] + v[j][3]);
    const float mean = wave_sum(s) * (1.f / DM); float s2 = 0.f;
#pragma unroll
    for (int j = 0; j < 4; ++j) { v[j] = v[j] - mean; s2 += (v[j][0] * v[j][0] + v[j][1] * v[j][1]) + (v[j][2] * v[j][2] + v[j][3] * v[j][3]); }
    const float rstd = 1.f / sqrtf(wave_sum(s2) * (1.f / DM) + LN_EPS);
#pragma unroll
    for (int j = 0; j < 4; ++j) { const f32x4 gg = *((const f32x4*)g + lane + 64 * j), bb = *((const f32x4*)b + lane + 64 * j); v[j] = v[j] * rstd * gg + bb; }
}
DI void store_row_f32(float* p, const f32x4 (&v)[4], int lane) {
#pragma unroll
    for (int j = 0; j < 4; ++j) *((f32x4*)p + lane + 64 * j) = v[j];
}
DI void store_row_bf16(bf16* p, const f32x4 (&v)[4], int lane) {
#pragma unroll
    for (int j = 0; j < 4; ++j) { v2u w; w.x = cvtpk(v[j][0], v[j][1]); w.y = cvtpk(v[j][2], v[j][3]); *((v2u*)p + lane + 64 * j) = w; }
}
template <int NL> DI void small_proj(LAS const float* xs, const float* W, int ldw, int lane, float (&acc)[4]) {
    constexpr int PARTS = 64 / NL, DPER = 1024 / PARTS;
    const int n = lane & (NL - 1), part = lane / NL;
    acc[0] = acc[1] = acc[2] = acc[3] = 0.f;
    const float* wp = W + (size_t)(part * DPER) * ldw + n;
    LAS const float* xp = xs + part * DPER;
#pragma unroll 8
    for (int d = 0; d < DPER; ++d) { const float w = wp[(size_t)d * ldw];
        acc[0] += w * xp[d]; acc[1] += w * xp[1024 + d]; acc[2] += w * xp[2048 + d]; acc[3] += w * xp[3072 + d]; }
#pragma unroll
    for (int o = NL; o < 64; o <<= 1) {
#pragma unroll
        for (int k = 0; k < 4; ++k) acc[k] += __shfl_xor(acc[k], o); }
}

DI void ph_even_prep(const Args& a, const Fr& F, int j) {
    const bf16* proj = (const bf16*)(F.ws + WS_PROJ);
    bf16* ckvn = (bf16*)(F.ws + WS_CKVN); bf16* ql = (bf16*)(F.ws + WS_QL); float* kbar = (float*)(F.ws + WS_KBAR);
    const float* kvg = a.in[4] + j * 128;
    const bf16* wukt = (const bf16*)(F.ws + WS_WUKT) + (size_t)j * 8 * 128 * 64;
    const int lane = F.lane, wave = F.wave;
    for (int chunk = F.blk; chunk < 256; chunk += F.G) {
        const int tok0 = chunk * 128;
#pragma unroll 1
        for (int i0 = 0; i0 < 16; i0 += 8) { unsigned wv[8];
#pragma unroll
            for (int i = 0; i < 8; ++i) wv[i] = *((const unsigned*)(proj + (size_t)(tok0 + wave * 16 + i0 + i) * EV_N + EC_CKV) + lane);
#pragma unroll
            for (int i = 0; i < 8; ++i) { const int tok = tok0 + wave * 16 + i0 + i; const float v0 = bf2f(wv[i] & 0xffffu), v1 = bf2f(wv[i] >> 16);
                const float ss = wave_sum(v0 * v0 + v1 * v1);
                const float r = 1.f / sqrtf(ss * (1.f / 128.f) + LN_EPS);
                *((unsigned*)(ckvn + (size_t)tok * 128) + lane) = cvtpk(v0 * r * kvg[2 * lane], v1 * r * kvg[2 * lane + 1]); } }
        { bf16* kic = (bf16*)(F.ws + WS_KIC); const int tok = tok0 + wave * 16 + (lane >> 2), c = (lane & 3) * 16;
            const v4u* src = (const v4u*)(proj + (size_t)tok * EV_N + EC_KI + c); v4u* dst = (v4u*)(kic + (size_t)tok * 64 + c); dst[0] = src[0]; dst[1] = src[1]; }
        { const int h = wave, l15 = lane & 15, kg = lane >> 4;
            bf16x8 af[8][2];
#pragma unroll
            for (int ct = 0; ct < 8; ++ct)
#pragma unroll
                for (int ks = 0; ks < 2; ++ks) af[ct][ks] = *(const bf16x8*)(wukt + ((size_t)h * 128 + ct * 16 + l15) * 64 + ks * 32 + kg * 8);
#pragma unroll 1
            for (int tg = 0; tg < 8; tg += 4) { bf16x8 qf[4][2];
#pragma unroll
                for (int u = 0; u < 4; ++u)
#pragma unroll
                    for (int ks = 0; ks < 2; ++ks) qf[u][ks] = *(const bf16x8*)(proj + (size_t)(tok0 + (tg + u) * 16 + l15) * EV_N + EC_QA + h * 64 + ks * 32 + kg * 8);
#pragma unroll
                for (int u = 0; u < 4; ++u) { const int tok = tok0 + (tg + u) * 16 + l15;
#pragma unroll
                    for (int ct = 0; ct < 8; ++ct) { f32x4 d = {0.f, 0.f, 0.f, 0.f};
                        d = mfma16(af[ct][0], qf[u][0], d); d = mfma16(af[ct][1], qf[u][1], d);
                        v2u w; w.x = cvtpk(d[0], d[1]); w.y = cvtpk(d[2], d[3]);
                        *(v2u*)(ql + (size_t)tok * 1024 + h * 128 + ct * 16 + 4 * kg) = w; } } } }
        if (chunk < 128) { const int b = chunk >> 5, n = chunk & 31; float s8[8];
#pragma unroll
            for (int k = 0; k < 8; ++k) s8[k] = 0.f;
            const bf16* kp = proj + ((size_t)b * SEQ + n * 256 + wave * 32) * EV_N + EC_KB + lane * 8;
#pragma unroll 8
            for (int r = 0; r < 32; ++r) { const v4u w = *(const v4u*)(kp + (size_t)r * EV_N);
#pragma unroll
                for (int k = 0; k < 4; ++k) { s8[2 * k] += bf2f(w[k] & 0xffffu); s8[2 * k + 1] += bf2f(w[k] >> 16); } }
            LAS float* red = (LAS float*)F.lds;
            __syncthreads();
#pragma unroll
            for (int k = 0; k < 8; ++k) red[wave * 512 + lane * 8 + k] = s8[k];
            __syncthreads();
            float s = 0.f;
#pragma unroll
            for (int w = 0; w < 8; ++w) s += red[w * 512 + F.tid];
            const int h = F.tid >> 6, d = F.tid & 63;
            kbar[(((size_t)b * 8 + h) * 32 + n) * 64 + d] = s * (1.f / 256.f); }
    }
}

DI void moba_gate_chunk(const Fr& F, int chunk) {
    const bf16* proj = (const bf16*)(F.ws + WS_PROJ); const float* kbar = (const float*)(F.ws + WS_KBAR); unsigned* sel3 = (unsigned*)(F.ws + WS_SEL3);
    const int tok0 = chunk * 128, b = tok0 / SEQ, own = (tok0 % SEQ) >> 8, h = F.wave, lane = F.lane;
    float q0[64], q1[64];
    { const v4u* p0 = (const v4u*)(proj + (size_t)(tok0 + lane) * EV_N + EC_QB + h * 64); const v4u* p1 = (const v4u*)(proj + (size_t)(tok0 + 64 + lane) * EV_N + EC_QB + h * 64);
#pragma unroll
        for (int i = 0; i < 8; ++i) { const v4u w0 = p0[i], w1 = p1[i];
#pragma unroll
            for (int k = 0; k < 4; ++k) { q0[8 * i + 2 * k] = bf2f(w0[k] & 0xffffu); q0[8 * i + 2 * k + 1] = bf2f(w0[k] >> 16); q1[8 * i + 2 * k] = bf2f(w1[k] & 0xffffu); q1[8 * i + 2 * k + 1] = bf2f(w1[k] >> 16); } } }
    float a0 = -INFINITY, a1 = -INFINITY, a2 = -INFINITY, c0 = -INFINITY, c1 = -INFINITY, c2 = -INFINITY; int ai0 = 0, ai1 = 0, ai2 = 0, ci0 = 0, ci1 = 0, ci2 = 0;
    const float* kb = kbar + (((size_t)b * 8 + h) * 32) * 64;
    for (int n = 0; n < own; ++n) { float g0 = 0.f, g1 = 0.f;
#pragma unroll
        for (int d = 0; d < 64; d += 4) { const f32x4 kv = *(const f32x4*)(kb + n * 64 + d);
#pragma unroll
            for (int k = 0; k < 4; ++k) { g0 += q0[d + k] * kv[k]; g1 += q1[d + k] * kv[k]; } }
        if (g0 > a2) { if (g0 > a1) { a2 = a1; ai2 = ai1; if (g0 > a0) { a1 = a0; ai1 = ai0; a0 = g0; ai0 = n; } else { a1 = g0; ai1 = n; } } else { a2 = g0; ai2 = n; } }
        if (g1 > c2) { if (g1 > c1) { c2 = c1; ci2 = ci1; if (g1 > c0) { c1 = c0; ci1 = ci0; c0 = g1; ci0 = n; } else { c1 = g1; ci1 = n; } } else { c2 = g1; ci2 = n; } }
    }
    const unsigned nv = own < 3 ? own : 3;
    sel3[(size_t)(tok0 + lane) * 8 + h] = (unsigned)ai0 | ((unsigned)ai1 << 8) | ((unsigned)ai2 << 16) | (nv << 24);
    sel3[(size_t)(tok0 + 64 + lane) * 8 + h] = (unsigned)ci0 | ((unsigned)ci1 << 8) | ((unsigned)ci2 << 16) | (nv << 24);
}

constexpr int HS = 257;
DI float relu1(float x) { const unsigned u = __float_as_uint(x); return __uint_as_float(u & ~(unsigned)((int)u >> 31)); }
template <int MODE, bool DIAG> DI void idx_tile(const bf16x8 (&kf)[4], LAS const char* qb  , const float (&wj)[4], int kt, int q, int hi, unsigned c0, unsigned c1,
                                     LAS unsigned* hist, LAS unsigned* mask, LAS unsigned* cmask, LAS unsigned long long* cand, LAS unsigned* rinfo) {
    f32x2 scp[8];
#pragma unroll
    for (int p = 0; p < 8; ++p) scp[p] = (f32x2){0.f, 0.f};
#pragma unroll
    for (int j = 0; j < 4; ++j) { f32x16 acc;
#pragma unroll
        for (int r = 0; r < 16; ++r) acc[r] = 0.f;
#pragma unroll
        for (int s = 0; s < 4; ++s) acc = mfma32(kf[s], *(LAS const bf16x8*)(qb + (j * 8 + s * 2) * 512), acc);
        const f32x2 w2 = {wj[j], wj[j]};
#pragma unroll
        for (int p = 0; p < 8; ++p) { const f32x2 a = {relu1(acc[2 * p]), relu1(acc[2 * p + 1])};
            scp[p] = a * w2 + scp[p]; } }
    unsigned sel = 0u, cnd = 0u;
    const float F0 = __uint_as_float(c0), F1 = __uint_as_float(c1);
#pragma unroll
    for (int r = 0; r < 16; ++r) { const int kr = crow(r, hi);
        const bool ok = !DIAG || kr <= q;
        const float scv = scp[r >> 1][r & 1]; const unsigned u = __float_as_uint(scv);
        if (MODE == 1) { const unsigned key = u ^ ((unsigned)((int)u >> 31) | 0x80000000u);
            if (ok && (key >> 24) >= c0) __hip_atomic_fetch_add(hist + q * HS + (key >> 24), 1u, __ATOMIC_RELAXED, __HIP_MEMORY_SCOPE_WORKGROUP); }
        else if (MODE == 2) { if (ok && (u >> 24) == c0) __hip_atomic_fetch_add(hist + q * HS + (((u >> 16) & 255u) ^ c1), 1u, __ATOMIC_RELAXED, __HIP_MEMORY_SCOPE_WORKGROUP); }
        else { const bool ge1 = scv >= F1, ge0 = scv >= F0;
            if (ok && ge1) sel |= 1u << kr;
            if (ok && ge0 && !ge1) { cnd |= 1u << kr; const unsigned key = u ^ ((unsigned)((int)u >> 31) | 0x80000000u);
                const unsigned pos = __hip_atomic_fetch_add(rinfo + 128 + q, 1u, __ATOMIC_RELAXED, __HIP_MEMORY_SCOPE_WORKGROUP);
                if (pos < 64u) cand[q * 64 + pos] = ((unsigned long long)key << 32) | (unsigned)(~(unsigned)(kt * 32 + kr)); } } }
    if (MODE == 3) { if (sel) __hip_atomic_fetch_or(mask + q * HS + kt, sel, __ATOMIC_RELAXED, __HIP_MEMORY_SCOPE_WORKGROUP);
        if (cnd) __hip_atomic_fetch_or(cmask + q * HS + kt, cnd, __ATOMIC_RELAXED, __HIP_MEMORY_SCOPE_WORKGROUP); }
}
template <int MODE> DI void idx_pass(const bf16* proj, int rowbase, int qt, LAS const char* qimg, const float (&wj)[4], LAS unsigned* hist, LAS unsigned* mask, LAS unsigned* cmask, LAS unsigned long long* cand, LAS unsigned* rinfo, int wave, int lane) {
    const int q = lane & 31, hi = lane >> 5, nkt = qt + 1;
    const unsigned b1 = MODE == 2 ? rinfo[160 + q] : rinfo[224 + q], thr16 = MODE == 2 ? rinfo[192 + q] : rinfo[256 + q];
    const bf16* kp0 = proj + (size_t)(rowbase + q) * 64 + hi * 8;
    LAS const char* qb = qimg + hi * 512 + q * 16;
    const int n = nkt > wave ? (nkt - wave + 7) >> 3 : 0;
    bf16x8 kfa[4], kfb[4], kfc[4];
#define IDX_LOAD(KF, I) do { const bf16* kp_ = kp0 + (size_t)((wave + 8 * (I)) * 32) * 64; _Pragma("unroll") for (int s_ = 0; s_ < 4; ++s_) KF[s_] = *(const bf16x8*)(kp_ + s_ * 16); } while (0)
#define IDX_TILE(KF, I) do { const int kt_ = wave + 8 * (I); if (kt_ == qt) idx_tile<MODE, true>(KF, qb, wj, kt_, q, hi, b1, thr16, hist, mask, cmask, cand, rinfo); \
        else idx_tile<MODE, false>(KF, qb, wj, kt_, q, hi, b1, thr16, hist, mask, cmask, cand, rinfo); } while (0)
    if (n > 0) IDX_LOAD(kfa, 0);
    if (n > 1) IDX_LOAD(kfb, 1);
    for (int i = 0; i < n; i += 3) {
        if (i + 2 < n) IDX_LOAD(kfc, i + 2);
        IDX_TILE(kfa, i);
        if (i + 1 < n) { if (i + 3 < n) IDX_LOAD(kfa, i + 3); IDX_TILE(kfb, i + 1); }
        if (i + 2 < n) { if (i + 4 < n) IDX_LOAD(kfb, i + 4); IDX_TILE(kfc, i + 2); }
    }
#undef IDX_LOAD
#undef IDX_TILE
}
DI void hist_pick(LAS const unsigned* hrow, unsigned need, int lane, unsigned& bin, unsigned& above) {
    unsigned h4[4];
#pragma unroll
    for (int k = 0; k < 4; ++k) h4[k] = hrow[4 * lane + k];
    const unsigned ssum = h4[0] + h4[1] + h4[2] + h4[3];
    unsigned x = ssum;
#pragma unroll
    for (int o = 1; o < 64; o <<= 1) { const unsigned y = __shfl_down(x, o); if (lane + o < 64) x += y; }
    const unsigned long long m = __ballot(x >= need);
    const int Ls = m ? 63 - __builtin_clzll(m) : 0;
    const unsigned xs = __shfl(x, Ls), ss = __shfl(ssum, Ls);
    const unsigned h0 = __shfl(h4[0], Ls), h1 = __shfl(h4[1], Ls), h2 = __shfl(h4[2], Ls), h3 = __shfl(h4[3], Ls);
    unsigned cum = xs - ss;
    if (cum + h3 >= need) { bin = 4 * Ls + 3; above = cum; return; } cum += h3;
    if (cum + h2 >= need) { bin = 4 * Ls + 2; above = cum; return; } cum += h2;
    if (cum + h1 >= need) { bin = 4 * Ls + 1; above = cum; return; } cum += h1;
    bin = 4 * Ls; above = cum; (void)h0;
}
DI void idx_pass1(const bf16* proj, int rowbase, int qt, LAS const char* qimg, const float (&wj)[4], LAS unsigned* hist, LAS unsigned* mask, LAS unsigned* cmask, LAS unsigned long long* cand, LAS unsigned* rinfo, int wave, int lane) {
    const int q = lane & 31, hi = lane >> 5, nkt = qt + 1, nmax = (nkt + 7) >> 3;
    const bf16* kp0 = proj + (size_t)(rowbase + q) * 64 + hi * 8;
    LAS const char* qb = qimg + hi * 512 + q * 16;
    unsigned lb = 0u;
    bf16x8 kfc[4], kfn[4];
    if (wave < nkt) {
#pragma unroll
        for (int s = 0; s < 4; ++s) kfc[s] = *(const bf16x8*)(kp0 + (size_t)(wave * 32) * 64 + s * 16); }
    for (int i = 0; i < nmax; ++i) { const int kt = wave + 8 * i;
        if (kt + 8 < nkt) {
#pragma unroll
            for (int s = 0; s < 4; ++s) kfn[s] = *(const bf16x8*)(kp0 + (size_t)((kt + 8) * 32) * 64 + s * 16); }
        if (kt < nkt) { if (kt == qt) idx_tile<1, true>(kfc, qb, wj, kt, q, hi, lb, 0u, hist, mask, cmask, cand, rinfo); else idx_tile<1, false>(kfc, qb, wj, kt, q, hi, lb, 0u, hist, mask, cmask, cand, rinfo); }
#pragma unroll
        for (int s = 0; s < 4; ++s) kfc[s] = kfn[s];
        if (((i + 1) & i) == 0 && i + 1 < nmax && i < 16) {
            __syncthreads();
#pragma unroll 1
            for (int rr = 0; rr < 4; ++rr) { const int row = wave * 4 + rr; unsigned bin, above; hist_pick(hist + row * HS, 256u, lane, bin, above);
                if (lane == 0) rinfo[288 + row] = bin; }
            __syncthreads();
            { const unsigned nb = rinfo[288 + q]; lb = nb > lb ? nb : lb; } }
    }
}
DI void idx_unit(const Fr& F, int b, int qt) {
    const bf16* proj = (const bf16*)(F.ws + WS_PROJ); const bf16* kic = (const bf16*)(F.ws + WS_KIC); unsigned short* sel = (unsigned short*)(F.ws + WS_SEL);
    LAS unsigned* hist = (LAS unsigned*)(F.lds); LAS unsigned* mask = hist + 32 * HS; LAS unsigned* cmask = mask + 32 * HS;
    LAS unsigned long long* cand = (LAS unsigned long long*)(F.lds + 99328); LAS unsigned* rinfo = (LAS unsigned*)(F.lds + 115712);
    const int lane = F.lane, wave = F.wave, tid = F.tid, t0 = qt * 32, rowbase = b * SEQ;
    __syncthreads();
    for (int i = tid; i < 3 * 32 * HS; i += NTHR) hist[i] = 0u;
    if (tid < 320) rinfo[tid] = 0u;
    __syncthreads();
    if (t0 + 31 <= 255 || (EXPF & 64)) {
        if (lane < 8) {
#pragma unroll
            for (int rr = 0; rr < 4; ++rr) { const int row = wave * 4 + rr, nv = t0 + row + 1;
                const int nv0 = t0 + row + 1; const int nvc = nv0 < 256 ? nv0 : 256; (void)nv; mask[row * HS + lane] = nvc >= 32 * (lane + 1) ? 0xffffffffu : (nvc > 32 * lane ? ((1u << (nvc - 32 * lane)) - 1u) : 0u); } }
    } else {
        const int q = lane & 31;
        float wj[4];
        { const bf16* qp = proj + (size_t)(rowbase + t0 + q) * EV_N;
#pragma unroll
            for (int j = 0; j < 4; ++j) wj[j] = bf2f(qp[EC_WI + j]); }
        LAS char* qimg = (LAS char*)(F.lds + 117248);
#pragma unroll
        for (int i = 0; i < 2; ++i) { const int p = tid + i * NTHR, row = p & 31, c = p >> 5;
            *(LAS v4u*)(qimg + c * 512 + row * 16) = *(const v4u*)(proj + (size_t)(rowbase + t0 + row) * EV_N + EC_QI + c * 8); }
        __syncthreads();
        idx_pass1(kic, rowbase, qt, qimg, wj, hist, mask, cmask, cand, rinfo, wave, lane);
        __syncthreads();
#pragma unroll 1
        for (int rr = 0; rr < 4; ++rr) { const int row = wave * 4 + rr; unsigned bin, above; hist_pick(hist + row * HS, 256u, lane, bin, above);
            if (lane == 0) { rinfo[row] = bin; rinfo[32 + row] = 256u - above; rinfo[160 + row] = bin >= 128u ? bin - 128u : 255u - bin; rinfo[192 + row] = bin >= 128u ? 0u : 255u; } }
        __syncthreads();
        for (int i = tid; i < 32 * HS; i += NTHR) hist[i] = 0u;
        __syncthreads();
        idx_pass<2>(kic, rowbase, qt, qimg, wj, hist, mask, cmask, cand, rinfo, wave, lane);
        __syncthreads();
#pragma unroll 1
        for (int rr = 0; rr < 4; ++rr) { const int row = wave * 4 + rr; const unsigned need1 = rinfo[32 + row]; unsigned bin, above; hist_pick(hist + row * HS, need1, lane, bin, above);
            if (lane == 0) { const unsigned t16 = (rinfo[row] << 8) | bin, k0 = t16 << 16, k1 = (t16 + 1u) << 16;
                rinfo[64 + row] = t16; rinfo[96 + row] = need1 - above;
                rinfo[224 + row] = (k0 & 0x80000000u) ? (k0 ^ 0x80000000u) : ~k0; rinfo[256 + row] = (t16 == 0xffffu) ? 0x7fc00000u : ((k1 & 0x80000000u) ? (k1 ^ 0x80000000u) : ~k1); } }
        __syncthreads();
        idx_pass<3>(kic, rowbase, qt, qimg, wj, hist, mask, cmask, cand, rinfo, wave, lane);
        __syncthreads();
#pragma unroll 1
        for (int rr = 0; rr < 4; ++rr) { const int row = wave * 4 + rr; const unsigned call = rinfo[128 + row], need2 = rinfo[96 + row];
            if (call <= 64u) { const unsigned c = call;
                const unsigned long long mine = cand[row * 64 + lane]; unsigned rank = 0u;
                for (unsigned k = 0; k < c; ++k) rank += (cand[row * 64 + k] > mine) ? 1u : 0u;
                if ((unsigned)lane < c && rank < need2) { const unsigned s = ~(unsigned)mine;
                    __hip_atomic_fetch_or(mask + row * HS + (s >> 5), 1u << (s & 31), __ATOMIC_RELAXED, __HIP_MEMORY_SCOPE_WORKGROUP); } }
            else { unsigned w4[4];
#pragma unroll
                for (int k = 0; k < 4; ++k) w4[k] = cmask[row * HS + 4 * lane + k];
                const unsigned cnt = __popc(w4[0]) + __popc(w4[1]) + __popc(w4[2]) + __popc(w4[3]);
                unsigned x = cnt;
#pragma unroll
                for (int o = 1; o < 64; o <<= 1) { const unsigned y = __shfl_up(x, o); if (lane >= o) x += y; }
                unsigned before = x - cnt;
#pragma unroll
                for (int k = 0; k < 4; ++k) { unsigned w = w4[k]; const unsigned pc = __popc(w); unsigned take = 0u;
                    if (before < need2) { if (before + pc <= need2) take = w; else { unsigned left = need2 - before; while (left) { const unsigned b = w & (0u - w); take |= b; w ^= b; --left; } } }
                    before += pc;
                    if (take) mask[row * HS + 4 * lane + k] |= take; } }
        }
    }
    __syncthreads();
#pragma unroll 1
    for (int rr = 0; rr < 4; ++rr) { const int row = wave * 4 + rr; unsigned short* out = sel + (size_t)(rowbase + t0 + row) * 256;
        unsigned w4[4];
#pragma unroll
        for (int k = 0; k < 4; ++k) w4[k] = mask[row * HS + 4 * lane + k];
        const unsigned cnt = __popc(w4[0]) + __popc(w4[1]) + __popc(w4[2]) + __popc(w4[3]);
        unsigned x = cnt;
#pragma unroll
        for (int o = 1; o < 64; o <<= 1) { const unsigned y = __shfl_up(x, o); if (lane >= o) x += y; }
        const unsigned total = __shfl(x, 63); unsigned pos = x - cnt;
#pragma unroll
        for (int k = 0; k < 4; ++k) { unsigned w = w4[k]; const unsigned base = (unsigned)(4 * lane + k) * 32u;
            while (w) { const unsigned bit = __builtin_ctz(w); if (pos < 256u) out[pos] = (unsigned short)(base + bit); ++pos; w &= w - 1u; } }
        for (unsigned i = total + lane; i < 256u; i += 64u) out[i] = (unsigned short)0xffffu; }
}

struct AttSt { float m, l; f32x16 o0, o1; };
template <class BF> DI void att_subtile(AttSt& S, const bf16x8 (&qf)[4], LAS const char* Kst, LAS const char* Vb, int vdh, int vrow0, int lane, const BF& bias) {
    const int r32 = lane & 31, hi = lane >> 5;
    f32x16 p;
#pragma unroll
    for (int r = 0; r < 16; ++r) p[r] = 0.f;
    LAS const char* kp = Kst + hi * 512 + r32 * 16;
#pragma unroll
    for (int s = 0; s < 4; ++s) { const bf16x8 kf = *(LAS const bf16x8*)(kp + s * 1024); p = mfma32(kf, qf[s], p); }
    float mx = -INFINITY;
#pragma unroll
    for (int r = 0; r < 16; ++r) { p[r] = bias(p[r], crow(r, hi)); mx = fmaxf(mx, p[r]); }
    mx = fmaxf(mx, __shfl_xor(mx, 32));
    if (__any(mx > S.m + 16.f)) { const float mn = fmaxf(S.m, mx), sc = ex2(S.m - mn); S.m = mn; S.l *= sc;
#pragma unroll
        for (int r = 0; r < 16; ++r) { S.o0[r] *= sc; S.o1[r] *= sc; } }
    const float mn = S.m;
    float ps = 0.f;
#pragma unroll
    for (int r = 0; r < 16; ++r) { p[r] = ex2(p[r] - mn); ps += p[r]; }
    S.l += ps;
    v4u pw0, pw1;
    pw0.x = cvtpk(p[0], p[1]); pw0.y = cvtpk(p[2], p[3]); pw0.z = cvtpk(p[4], p[5]); pw0.w = cvtpk(p[6], p[7]);
    pw1.x = cvtpk(p[8], p[9]); pw1.y = cvtpk(p[10], p[11]); pw1.z = cvtpk(p[12], p[13]); pw1.w = cvtpk(p[14], p[15]);
    const bf16x8 pf0 = __builtin_bit_cast(bf16x8, pw0), pf1 = __builtin_bit_cast(bf16x8, pw1);
    LAS const char* vp = Vb + (vrow0 + 4 * hi + ((lane & 15) >> 2)) * 64 + ((lane >> 4) & 1) * 32 + (lane & 3) * 8;
    { const bf16x8 v00 = cat8(vtr(vp), vtr(vp + 512)), v10 = cat8(vtr(vp + vdh), vtr(vp + vdh + 512));
      const bf16x8 v01 = cat8(vtr(vp + 1024), vtr(vp + 1536)), v11 = cat8(vtr(vp + vdh + 1024), vtr(vp + vdh + 1536));
      S.o0 = mfma32(v00, pf0, S.o0); S.o1 = mfma32(v10, pf0, S.o1);
      S.o0 = mfma32(v01, pf1, S.o0); S.o1 = mfma32(v11, pf1, S.o1); }
}

struct MobaFar { float c; DI float operator()(float p, int) const { return p + c; } };
struct MobaBias { LAS const float* lut; int tq, s0; bool causal;
    DI float operator()(float p, int kvrel) const { const int dist = tq - (s0 + kvrel); const float v = p + lut[dist < 0 ? 0 : (dist > 1023 ? 1023 : dist)]; return (causal && dist < 0) ? -INFINITY : v; } };
DI void moba_qload(bf16x8 (&qf)[4], const bf16* proj, int rowbase, int h, int tq, int hi) {
    const bf16* qp = proj + (size_t)(rowbase + tq) * EV_N + EC_QB + h * 64 + hi * 8;
#pragma unroll
    for (int s = 0; s < 4; ++s) qf[s] = *(const bf16x8*)(qp + s * 16);
}
DI void moba_tile(const Fr& F, const bf16x8 (&qf)[4], int rowbase, int h, int n, int tq, bool valid, int slot, bool own, int wave_tile) {
    LAS const char* Kb = (LAS const char*)F.lds; LAS const char* Vb = (LAS const char*)(F.lds + 32768); LAS const float* lut = (LAS const float*)(F.lds + 98304);
    bf16* po = (bf16*)(F.ws + WS_ACT); float* pml = (float*)(F.ws + WS_PML);
    const int lane = F.lane, hi = lane >> 5;
    AttSt S; S.m = -1e30f; S.l = 0.f;
#pragma unroll
    for (int r = 0; r < 16; ++r) { S.o0[r] = 0.f; S.o1[r] = 0.f; }
    const int nst = own ? wave_tile + 1 : 8;
    int tmin = tq;
#pragma unroll
    for (int o = 1; o < 64; o <<= 1) { const int y = __shfl_xor(tmin, o); tmin = y < tmin ? y : tmin; }
    const float cfar = lut[1023];
    for (int st = 0; st < nst; ++st) {
        if (!own && tmin - (n * 256 + st * 32 + 31) >= 790) { MobaFar bf{cfar}; att_subtile(S, qf, Kb + st * 4096, Vb, 16384, st * 32, lane, bf); }
        else { MobaBias bf{lut, tq, n * 256 + st * 32, own && st == wave_tile}; att_subtile(S, qf, Kb + st * 4096, Vb, 16384, st * 32, lane, bf); } }
    const float lt = S.l + __shfl_xor(S.l, 32), inv = 1.f / lt;
    if (valid) { const size_t pi = ((size_t)(rowbase + tq) * 8 + h) * 4 + slot; bf16* o = po + pi * 64;
#pragma unroll
        for (int a4 = 0; a4 < 4; ++a4) { v2u w0, w1;
            w0.x = cvtpk(S.o0[4 * a4] * inv, S.o0[4 * a4 + 1] * inv); w0.y = cvtpk(S.o0[4 * a4 + 2] * inv, S.o0[4 * a4 + 3] * inv);
            w1.x = cvtpk(S.o1[4 * a4] * inv, S.o1[4 * a4 + 1] * inv); w1.y = cvtpk(S.o1[4 * a4 + 2] * inv, S.o1[4 * a4 + 3] * inv);
            *(v2u*)(o + 8 * a4 + 4 * hi) = w0; *(v2u*)(o + 32 + 8 * a4 + 4 * hi) = w1; }
        if (hi == 0) { f32x2 ml = {S.m, lt}; *(f32x2*)(pml + pi * 2) = ml; } }
}
DI void moba_unit(const Args& a, const Fr& F, int b, int h, int n) {
    const bf16* proj = (const bf16*)(F.ws + WS_PROJ); const unsigned* sel3 = (const unsigned*)(F.ws + WS_SEL3);
    LAS unsigned char* lds = F.lds; LAS unsigned* list = (LAS unsigned*)(lds + 65536); LAS float* lut = (LAS float*)(lds + 98304); LAS unsigned* misc = (LAS unsigned*)(lds + 102400);
    const int tid = F.tid, lane = F.lane, wave = F.wave, rowbase = b * SEQ;
    __syncthreads();
    { const bf16* kg = proj + (size_t)(rowbase + n * 256) * EV_N + EC_KB + h * 64; const bf16* vg = proj + (size_t)(rowbase + n * 256) * EV_N + EC_VB + h * 64;
#pragma unroll
        for (int i = 0; i < 4; ++i) { const int p = tid + i * NTHR;
            { const int r = p & 31, c = (p >> 5) & 7, st = p >> 8; const v4u v = *(const v4u*)(kg + (size_t)(st * 32 + r) * EV_N + c * 8); *(LAS v4u*)(lds + st * 4096 + c * 512 + r * 16) = v; }
            { const int cc = p & 3, row = (p >> 2) & 255, dh = p >> 10; const v4u v = *(const v4u*)(vg + (size_t)row * EV_N + dh * 32 + cc * 8); *(LAS v4u*)(lds + 32768 + dh * 16384 + row * 64 + cc * 16) = v; } }
        for (int d = tid; d < 1024; d += NTHR) lut[d] = a.in[9][t5_bucket(d) * 16 + 8 + h] * LOG2E; }
    if (tid == 0) misc[16] = 0u;
    __syncthreads();
    for (int tb = (n + 1) * 256; tb < SEQ; tb += NTHR) { const int t = tb + tid; const bool inr = t < SEQ;
        const unsigned s = inr ? sel3[(size_t)(rowbase + t) * 8 + h] : 0u; const unsigned nv = s >> 24; int slot = -1;
        if (nv > 0u && (s & 255u) == (unsigned)n) slot = 0; else if (nv > 1u && ((s >> 8) & 255u) == (unsigned)n) slot = 1; else if (nv > 2u && ((s >> 16) & 255u) == (unsigned)n) slot = 2;
        const unsigned long long bal = __ballot(slot >= 0); const unsigned wcnt = __popcll(bal);
        if (lane == 0) misc[wave] = wcnt;
        __syncthreads();
        unsigned off = misc[16], tot = 0u;
#pragma unroll
        for (int w = 0; w < 8; ++w) { const unsigned c = misc[w]; if (w < wave) off += c; tot += c; }
        if (slot >= 0) list[off + __popcll(bal & ((1ull << lane) - 1ull))] = ((unsigned)t << 2) | (unsigned)slot;
        __syncthreads();
        if (tid == 0) misc[16] += tot; }
    __syncthreads();
    const int nlist = (int)misc[16];
    const int ntl = (nlist + 31) >> 5, hi = lane >> 5;
    bf16x8 qa[4], qb2[4];
    moba_qload(qa, proj, rowbase, h, n * 256 + wave * 32 + (lane & 31), hi);
    unsigned ea = 0u, eb = 0u; bool va = false, vb = false;
    int tl = wave;
    if (tl < ntl) { const int li = tl * 32 + (lane & 31); vb = li < nlist; eb = list[vb ? li : nlist - 1]; moba_qload(qb2, proj, rowbase, h, (int)(eb >> 2), hi); }
    moba_tile(F, qa, rowbase, h, n, n * 256 + wave * 32 + (lane & 31), true, 3, true, wave);
    for (; tl < ntl; tl += 16) {
        const int t2 = tl + 8, t3 = tl + 16;
        if (t2 < ntl) { const int li = t2 * 32 + (lane & 31); va = li < nlist; ea = list[va ? li : nlist - 1]; moba_qload(qa, proj, rowbase, h, (int)(ea >> 2), hi); }
        moba_tile(F, qb2, rowbase, h, n, (int)(eb >> 2), vb, (int)(eb & 3u), false, 0);
        if (t2 < ntl) {
            if (t3 < ntl) { const int li = t3 * 32 + (lane & 31); vb = li < nlist; eb = list[vb ? li : nlist - 1]; moba_qload(qb2, proj, rowbase, h, (int)(eb >> 2), hi); }
            moba_tile(F, qa, rowbase, h, n, (int)(ea >> 2), va, (int)(ea & 3u), false, 0); }
    }
}

DI void dsa_step(const bf16x8 (&af)[2][4], const bf16x8 (&qlf)[4], int ch, LAS const unsigned char* bsel, LAS unsigned char* cbuf, LAS const float* tab,
                 float& m, float& l, f32x4 (&oT)[8], int l15, int kg, int lane) {
    f32x4 acc[2];
#pragma unroll
    for (int mt = 0; mt < 2; ++mt) { acc[mt] = (f32x4){0.f, 0.f, 0.f, 0.f};
#pragma unroll
        for (int ks = 0; ks < 4; ++ks) { acc[mt] = mfma16(af[mt][ks], qlf[ks], acc[mt]); *(LAS bf16x8*)(cbuf + (mt * 16 + l15) * 288 + (ks * 32 + kg * 8) * 2) = af[mt][ks]; } }
    float mx = -INFINITY;
#pragma unroll
    for (int mt = 0; mt < 2; ++mt) { const unsigned b4 = *(LAS const unsigned*)(bsel + ch * 32 + mt * 16 + 4 * kg);
#pragma unroll
        for (int i = 0; i < 4; ++i) { const unsigned bb = (b4 >> (8 * i)) & 255u;
            const float v = bb != 255u ? acc[mt][i] + tab[bb * 8 + (l15 & 7)] : -INFINITY; acc[mt][i] = v; mx = fmaxf(mx, v); } }
    mx = fmaxf(mx, __shfl_xor(mx, 16)); mx = fmaxf(mx, __shfl_xor(mx, 32));
    const float mn = fmaxf(m, mx), sc = ex2(m - mn); m = mn;
    float ps = 0.f;
#pragma unroll
    for (int mt = 0; mt < 2; ++mt)
#pragma unroll
        for (int i = 0; i < 4; ++i) { acc[mt][i] = ex2(acc[mt][i] - mn); ps += acc[mt][i]; }
    l = l * sc + ps;
#pragma unroll
    for (int ct = 0; ct < 8; ++ct) oT[ct] = oT[ct] * sc;
    v4u pw; pw.x = cvtpk(acc[0][0], acc[0][1]); pw.y = cvtpk(acc[0][2], acc[0][3]); pw.z = cvtpk(acc[1][0], acc[1][1]); pw.w = cvtpk(acc[1][2], acc[1][3]);
    const bf16x8 pf = __builtin_bit_cast(bf16x8, pw);
    LDS_WAIT();
    LAS const char* tp = (LAS const char*)cbuf + (4 * kg + (l15 >> 2)) * 288 + (lane & 3) * 8;
#pragma unroll
    for (int ct = 0; ct < 8; ++ct) { const bf16x8 cf = cat8(vtr(tp + ct * 32), vtr(tp + 16 * 288 + ct * 32)); oT[ct] = mfma16(cf, pf, oT[ct]); }
    LDS_WAIT();
}
DI void dsa_gather(bf16x8 (&af)[2][4], const bf16* ckvn, int rowbase, LAS const unsigned short* selb, int ch, int l15, int kg) {
#pragma unroll
    for (int mt = 0; mt < 2; ++mt) { unsigned idx = selb[ch * 32 + mt * 16 + l15]; if (idx == 0xffffu) idx = 0u;
        const bf16* cp = ckvn + (size_t)(rowbase + (int)idx) * 128 + kg * 8;
#pragma unroll
        for (int ks = 0; ks < 4; ++ks) af[mt][ks] = *(const bf16x8*)(cp + ks * 32); }
}
DI void dsa_query(const Fr& F, int tok, LAS unsigned char* wl, LAS const unsigned char* bkt, LAS const float* tab) {
    const bf16* ql = (const bf16*)(F.ws + WS_QL); const bf16* ckvn = (const bf16*)(F.ws + WS_CKVN); const unsigned short* sel = (const unsigned short*)(F.ws + WS_SEL); bf16* ol = (bf16*)(F.ws + WS_OL);
    const int lane = F.lane, l15 = lane & 15, kg = lane >> 4, t = tok % SEQ, rowbase = tok - t;
    LAS unsigned short* selb = (LAS unsigned short*)wl; LAS unsigned char* bsel = wl + 512; LAS unsigned char* cbuf = wl + 1024;
    { const v2u sv = *((const v2u*)(sel + (size_t)tok * 256) + lane); *((LAS v2u*)selb + lane) = sv; unsigned bw = 0u;
#pragma unroll
        for (int i = 0; i < 4; ++i) { const unsigned s = (i < 2 ? (sv.x >> (16 * i)) : (sv.y >> (16 * (i - 2)))) & 0xffffu; const int dist = t - (int)s;
            const unsigned bb = (s != 0xffffu && dist >= 0) ? (unsigned)bkt[dist > 1023 ? 1023 : dist] : 255u; bw |= bb << (8 * i); }
        *((LAS unsigned*)bsel + lane) = bw; }
    bf16x8 qlf[4];
#pragma unroll
    for (int ks = 0; ks < 4; ++ks) { qlf[ks] = *(const bf16x8*)(ql + (size_t)tok * 1024 + (l15 & 7) * 128 + ks * 32 + kg * 8); if (l15 >= 8) qlf[ks] = (bf16x8){0, 0, 0, 0, 0, 0, 0, 0}; }
    float m = -1e30f, l = 0.f; f32x4 oT[8];
#pragma unroll
    for (int ct = 0; ct < 8; ++ct) oT[ct] = (f32x4){0.f, 0.f, 0.f, 0.f};
    const int nvalid = t + 1 < 256 ? t + 1 : 256, nch = (nvalid + 31) >> 5;
    LDS_WAIT();
    bf16x8 afa[2][4], afb[2][4], afc[2][4];
    dsa_gather(afa, ckvn, rowbase, selb, 0, l15, kg);
    if (nch > 1) dsa_gather(afb, ckvn, rowbase, selb, 1, l15, kg);
    for (int ch = 0; ch < nch; ch += 3) {
        if (ch + 2 < nch) dsa_gather(afc, ckvn, rowbase, selb, ch + 2, l15, kg);
        dsa_step(afa, qlf, ch, bsel, cbuf, tab, m, l, oT, l15, kg, lane);
        if (ch + 1 < nch) { if (ch + 3 < nch) dsa_gather(afa, ckvn, rowbase, selb, ch + 3, l15, kg);
            dsa_step(afb, qlf, ch + 1, bsel, cbuf, tab, m, l, oT, l15, kg, lane); }
        if (ch + 2 < nch) { if (ch + 4 < nch) dsa_gather(afb, ckvn, rowbase, selb, ch + 4, l15, kg);
            dsa_step(afc, qlf, ch + 2, bsel, cbuf, tab, m, l, oT, l15, kg, lane); }
    }
    l += __shfl_xor(l, 16); l += __shfl_xor(l, 32);
    const float inv = 1.f / l;
    if (l15 < 8) { bf16* o = ol + (size_t)tok * 1024 + l15 * 128 + 4 * kg;
#pragma unroll
        for (int ct = 0; ct < 8; ++ct) { v2u w; w.x = cvtpk(oT[ct][0] * inv, oT[ct][1] * inv); w.y = cvtpk(oT[ct][2] * inv, oT[ct][3] * inv); *(v2u*)(o + ct * 16) = w; } }
}
DI void dsa_chunk(const Args& a, const Fr& F, int c32) {
    LAS unsigned char* bkt = F.lds + 81920; LAS float* tab = (LAS float*)(F.lds + 82944);
    __syncthreads();
    for (int d = F.tid; d < 1024; d += NTHR) bkt[d] = (unsigned char)t5_bucket(d);
    if (F.tid < 256) tab[F.tid] = a.in[9][(F.tid >> 3) * 16 + (F.tid & 7)] * LOG2E;
    __syncthreads();
#pragma unroll 1
    for (int i = 0; i < 4; ++i) dsa_query(F, c32 * 32 + F.wave * 4 + i, F.lds + F.wave * 10240, bkt, tab);
}

DI void ph_even_post(const Fr& F, int j) {
    const bf16* ol = (const bf16*)(F.ws + WS_OL); bf16* ao = (bf16*)(F.ws + WS_AO);
    const bf16* wuvt = (const bf16*)(F.ws + WS_WUVT) + (size_t)j * 8 * 64 * 128;
    const bf16* po = (const bf16*)(F.ws + WS_ACT); const float* pml = (const float*)(F.ws + WS_PML); const unsigned* sel3 = (const unsigned*)(F.ws + WS_SEL3);
    const int lane = F.lane, wave = F.wave, l15 = lane & 15, kg = lane >> 4;
    for (int chunk = F.blk; chunk < 256; chunk += F.G) { const int tok0 = chunk * 128;
        { const int h = wave; bf16x8 af[4][4];
#pragma unroll
            for (int mt = 0; mt < 4; ++mt)
#pragma unroll
                for (int ks = 0; ks < 4; ++ks) af[mt][ks] = *(const bf16x8*)(wuvt + ((size_t)h * 64 + mt * 16 + l15) * 128 + ks * 32 + kg * 8);
#pragma unroll 1
            for (int tg = 0; tg < 8; tg += 2) { bf16x8 bf[2][4];
#pragma unroll
                for (int u = 0; u < 2; ++u)
#pragma unroll
                    for (int ks = 0; ks < 4; ++ks) bf[u][ks] = *(const bf16x8*)(ol + (size_t)(tok0 + (tg + u) * 16 + l15) * 1024 + h * 128 + ks * 32 + kg * 8);
#pragma unroll
                for (int u = 0; u < 2; ++u) { const int tok = tok0 + (tg + u) * 16 + l15;
#pragma unroll
                    for (int mt = 0; mt < 4; ++mt) { f32x4 d = {0.f, 0.f, 0.f, 0.f};
#pragma unroll
                        for (int ks = 0; ks < 4; ++ks) d = mfma16(af[mt][ks], bf[u][ks], d);
                        v2u w; w.x = cvtpk(d[0], d[1]); w.y = cvtpk(d[2], d[3]); *(v2u*)(ao + (size_t)tok * 1024 + h * 64 + mt * 16 + 4 * kg) = w; } } } }
#pragma unroll 1
        for (int i0 = 0; i0 < 16; i0 += 4) { const int h = lane >> 3, d0 = (lane & 7) * 8; unsigned nvv[4]; f32x2 mlv[4][4];
#pragma unroll
            for (int i = 0; i < 4; ++i) { const int tok = tok0 + wave * 16 + i0 + i; const size_t pi = ((size_t)tok * 8 + h) * 4; nvv[i] = sel3[(size_t)tok * 8 + h] >> 24;
#pragma unroll
                for (int s = 0; s < 4; ++s) mlv[i][s] = *(const f32x2*)(pml + (pi + s) * 2); }
#pragma unroll
            for (int i = 0; i < 4; ++i) { const int tok = tok0 + wave * 16 + i0 + i; const size_t pi = ((size_t)tok * 8 + h) * 4;
                float mj[4], lj[4];
#pragma unroll
                for (int s = 0; s < 4; ++s) { const bool ok = (s == 3) || ((unsigned)s < nvv[i]); mj[s] = ok ? mlv[i][s][0] : -1e30f; lj[s] = ok ? mlv[i][s][1] : 0.f; }
                const float ms = fmaxf(fmaxf(mj[0], mj[1]), fmaxf(mj[2], mj[3])); float wsum = 0.f, acc[8], wv[4]; v4u pv[4];
#pragma unroll
                for (int k = 0; k < 8; ++k) acc[k] = 0.f;
#pragma unroll
                for (int s = 0; s < 4; ++s) { wv[s] = lj[s] * ex2(mj[s] - ms); wsum += wv[s]; pv[s] = (v4u){0u, 0u, 0u, 0u}; if (wv[s] > 0.f) pv[s] = *(const v4u*)(po + (pi + s) * 64 + d0); }
#pragma unroll
                for (int s = 0; s < 4; ++s) { if (wv[s] > 0.f) {
#pragma unroll
                    for (int k = 0; k < 4; ++k) { acc[2 * k] += wv[s] * bf2f(pv[s][k] & 0xffffu); acc[2 * k + 1] += wv[s] * bf2f(pv[s][k] >> 16); } } }
                const float inv = 1.f / wsum; v4u o; o.x = cvtpk(acc[0] * inv, acc[1] * inv); o.y = cvtpk(acc[2] * inv, acc[3] * inv); o.z = cvtpk(acc[4] * inv, acc[5] * inv); o.w = cvtpk(acc[6] * inv, acc[7] * inv);
                *(v4u*)(ao + (size_t)tok * 1024 + 512 + h * 64 + d0) = o; } }
    }
}
DI f32x16 proj32_f32(const float* W, int ldw, int ncols, const float* xrow, int d_lo, int lane) {
    const int e = lane & 31, kh = lane >> 5; const bool ev = e < ncols;
    f32x16 D;
#pragma unroll
    for (int r = 0; r < 16; ++r) D[r] = 0.f;
    const float* wp = W + (size_t)(d_lo + 4 * kh) * ldw + (ev ? e : 0);
    const float* xp = xrow + d_lo + 4 * kh;
#pragma unroll 8
    for (int i = 0; i < 64; ++i) { const f32x4 xv = *(const f32x4*)(xp + 8 * i);
        float a0 = wp[(size_t)(8 * i + 0) * ldw], a1 = wp[(size_t)(8 * i + 1) * ldw], a2 = wp[(size_t)(8 * i + 2) * ldw], a3 = wp[(size_t)(8 * i + 3) * ldw];
        if (!ev) { a0 = 0.f; a1 = 0.f; a2 = 0.f; a3 = 0.f; }
        D = __builtin_amdgcn_mfma_f32_32x32x2f32(a0, xv[0], D, 0, 0, 0); D = __builtin_amdgcn_mfma_f32_32x32x2f32(a1, xv[1], D, 0, 0, 0);
        D = __builtin_amdgcn_mfma_f32_32x32x2f32(a2, xv[2], D, 0, 0, 0); D = __builtin_amdgcn_mfma_f32_32x32x2f32(a3, xv[3], D, 0, 0, 0); }
    return D;
}
DI void ph_odd_prep(const Args& a, const Fr& F, int j, int layer) {
    const bf16* proj = (const bf16*)(F.ws + WS_PROJ); const float* x = (const float*)(F.ws + WS_X);
    float* logf = (float*)(F.ws + WS_LOGF); float* cs = (float*)(F.ws + WS_CS);
    const float* wf = a.in[6] + (size_t)j * 1024 * 3088 + 3072; const float* bfv = a.in[7] + j * 16;
    LAS float* red = (LAS float*)(F.lds); LAS float* lfb = (LAS float*)(F.lds + 131072);
    LAS unsigned* kmx = (LAS unsigned*)(F.lds + 131072 + 8192);
    const int lane = F.lane, wave = F.wave, tid = F.tid, l31 = lane & 31, hi = lane >> 5;
    for (int chunk = F.blk; chunk < 256; chunk += F.G) { const int tok0 = chunk * 128, b = tok0 / SEQ, t0 = tok0 % SEQ;
        __syncthreads();
        if (tid < 16) kmx[tid] = 0u;
        const int tl = wave & 3, kr = wave >> 2;
        f32x16 D = proj32_f32(wf, 3088, 16, x + (size_t)(tok0 + tl * 32 + l31) * DM, kr * 512, lane);
        if (kr == 1) {
#pragma unroll
            for (int r = 0; r < 8; ++r) red[(tl * 8 + r) * 64 + lane] = D[r]; }
        __syncthreads();
        if (kr == 0) {
#pragma unroll
            for (int r = 0; r < 8; ++r) { const int h = (r & 3) + 8 * (r >> 2) + 4 * hi; const float z = D[r] + red[(tl * 8 + r) * 64 + lane] + bfv[h];
                const float ls = fminf(z, 0.f) - log1pf(__expf(-fabsf(z)));
                lfb[(tl * 32 + l31) * 16 + h] = ls * LOG2E; } }
#pragma unroll 1
        for (int i = 0; i < 4; ++i) { const int p = tid + i * NTHR, tk = p >> 4, h = p & 15; const v4u* kp = (const v4u*)(proj + (size_t)(tok0 + tk) * OD_N + OC_K + h * 64); float s = 0.f;
#pragma unroll
            for (int c = 0; c < 8; ++c) { const v4u w = kp[c];
#pragma unroll
                for (int k = 0; k < 4; ++k) { const float e0 = bf2f(w[k] & 0xffffu), e1 = bf2f(w[k] >> 16); s += e0 * e0 + e1 * e1; } }
            __hip_atomic_fetch_max(kmx + h, __float_as_uint(s), __ATOMIC_RELAXED, __HIP_MEMORY_SCOPE_WORKGROUP); }
        __syncthreads();
        for (int i = tid; i < 2048; i += NTHR) { const int h = i >> 7, tk = i & 127; logf[((size_t)b * 16 + h) * SEQ + t0 + tk] = lfb[tk * 16 + h]; }
        if (tid < 32) { const int h = tid & 15, c = tid >> 4; float s = 0.f;
            for (int k = 0; k < 64; ++k) s += lfb[(c * 64 + k) * 16 + h];
            cs[((size_t)b * 16 + h) * 128 + (t0 >> 6) + c] = s; }
        if (tid < 16) __hip_atomic_fetch_max(F.ctl + CW_KMAX + layer * 64 + b * 16 + tid, kmx[tid], RLX_AGENT);
    }
}

constexpr float FOX_SKIP_LOG2 = 64.f;
struct FoxBias { LAS const float* ng; int tq, kabs0; bool diag;
    DI float operator()(float p, int kvrel) const { const float v = p + ng[kvrel]; return (diag && (kabs0 + kvrel) > tq) ? -INFINITY : v; } };
DI void fox_unit(const Fr& F, int layer, int b, int h, int qb) {
    const bf16* proj = (const bf16*)(F.ws + WS_PROJ); const float* logf = (const float*)(F.ws + WS_LOGF); const float* cs = (const float*)(F.ws + WS_CS); bf16* ao = (bf16*)(F.ws + WS_AO);
    LAS unsigned char* lds = F.lds; LAS float* ng = (LAS float*)(lds + 32768); LAS float* red = (LAS float*)(lds + 65536 + 1024); LAS int* ibox = (LAS int*)(lds + 65536 + 2048);
    const int tid = F.tid, lane = F.lane, wave = F.wave, r32 = lane & 31, hi = lane >> 5, t0 = qb * 256, rowbase = b * SEQ, tq = t0 + wave * 32 + r32;
    __syncthreads();
    bf16x8 qf[4]; float qs = 0.f;
    { const bf16* qp = proj + (size_t)(rowbase + tq) * OD_N + OC_Q + h * 64 + hi * 8;
#pragma unroll
        for (int s = 0; s < 4; ++s) { qf[s] = *(const bf16x8*)(qp + s * 16);
#pragma unroll
            for (int k = 0; k < 8; ++k) { const float e = bf2f((unsigned short)qf[s][k]); qs += e * e; } } }
    qs += __shfl_xor(qs, 32); qs = wave_max(qs);
    if (lane == 0) red[wave] = qs;
    __syncthreads();
    if (tid == 0) { float qm = red[0];
        for (int w = 1; w < 8; ++w) qm = fmaxf(qm, red[w]);
        const float km = __uint_as_float(ld_u32(F.ctl + CW_KMAX + layer * 64 + b * 16 + h));
        const float B2 = 2.f * (sqrtf(qm * km) * 1.01f + 1.f);
        int kt = t0 / 64 - 1, kts = t0 / 64; float D = 0.f;
        while (kt >= 0 && B2 + D >= -FOX_SKIP_LOG2) { kts = kt; D += cs[((size_t)b * 16 + h) * 128 + kt]; --kt; }
        ibox[0] = kts; }
    __syncthreads();
    const int kts = ibox[0], s_start = kts * 64, nel = t0 + 256 - s_start;
    { const int i0 = tid * 16; float v[16]; const float* lp = logf + ((size_t)b * 16 + h) * SEQ + s_start + i0;
        if (i0 < nel) {
#pragma unroll
            for (int c = 0; c < 4; ++c) { const f32x4 w = *(const f32x4*)(lp + 4 * c); v[4 * c] = w[0]; v[4 * c + 1] = w[1]; v[4 * c + 2] = w[2]; v[4 * c + 3] = w[3]; } }
        else {
#pragma unroll
            for (int c = 0; c < 16; ++c) v[c] = 0.f; }
#pragma unroll
        for (int c = 1; c < 16; ++c) v[c] += v[c - 1];
        float xsum = v[15];
#pragma unroll
        for (int o = 1; o < 64; o <<= 1) { const float y = __shfl_up(xsum, o); if (lane >= o) xsum += y; }
        if (lane == 63) red[16 + wave] = xsum;
        __syncthreads();
        float off = xsum - v[15];
        for (int w = 0; w < wave; ++w) off += red[16 + w];
        if (i0 < nel) {
#pragma unroll
            for (int c = 0; c < 4; ++c) { f32x4 w = {-(off + v[4 * c]), -(off + v[4 * c + 1]), -(off + v[4 * c + 2]), -(off + v[4 * c + 3])}; *(LAS f32x4*)(ng + i0 + 4 * c) = w; } }
    }
    const int ntile = t0 / 64 + 4 - kts;
    const bf16* kg = proj + (size_t)rowbase * OD_N + OC_K + h * 64; const bf16* vg = proj + (size_t)rowbase * OD_N + OC_V + h * 64;
    const int kr = tid & 31, kc = (tid >> 5) & 7, kst = tid >> 8, vcc = tid & 3, vrow = (tid >> 2) & 63, vdh = tid >> 8;
    const int koff = kst * 4096 + kc * 512 + kr * 16, voff = 8192 + vdh * 4096 + vrow * 64 + vcc * 16;
    { const v4u kv = *(const v4u*)(kg + (size_t)(kts * 64 + kst * 32 + kr) * OD_N + kc * 8), vv = *(const v4u*)(vg + (size_t)(kts * 64 + vrow) * OD_N + vdh * 32 + vcc * 8);
        *(LAS v4u*)(lds + koff) = kv; *(LAS v4u*)(lds + voff) = vv; }
    __syncthreads();
    AttSt S; S.m = -1e30f; S.l = 0.f;
#pragma unroll
    for (int r = 0; r < 16; ++r) { S.o0[r] = 0.f; S.o1[r] = 0.f; }
    const int wlast = t0 + wave * 32 + 31, wfirst = t0 + wave * 32;
    for (int i = 0; i < ntile; ++i) { const int kt = kts + i; LAS unsigned char* buf = lds + (i & 1) * 16384; LAS unsigned char* nbuf = lds + ((i + 1) & 1) * 16384;
        v4u kv, vv; const bool more = i + 1 < ntile;
        if (more) { kv = *(const v4u*)(kg + (size_t)((kt + 1) * 64 + kst * 32 + kr) * OD_N + kc * 8); vv = *(const v4u*)(vg + (size_t)((kt + 1) * 64 + vrow) * OD_N + vdh * 32 + vcc * 8); }
#pragma unroll
        for (int sub = 0; sub < 2; ++sub) { const int kv0 = kt * 64 + sub * 32;
            if (kv0 <= wlast) { FoxBias bf{ng + (kv0 - s_start), tq, kv0, kv0 + 31 > wfirst};
                att_subtile(S, qf, (LAS const char*)buf + sub * 4096, (LAS const char*)buf + 8192, 4096, sub * 32, lane, bf); } }
        if (more) { *(LAS v4u*)(nbuf + koff) = kv; *(LAS v4u*)(nbuf + voff - 8192 + 8192) = vv; }
        __syncthreads(); }
    const float lt = S.l + __shfl_xor(S.l, 32), inv = 1.f / lt;
    bf16* o = ao + (size_t)(rowbase + tq) * 1024 + h * 64;
#pragma unroll
    for (int a4 = 0; a4 < 4; ++a4) { v2u w0, w1;
        w0.x = cvtpk(S.o0[4 * a4] * inv, S.o0[4 * a4 + 1] * inv); w0.y = cvtpk(S.o0[4 * a4 + 2] * inv, S.o0[4 * a4 + 3] * inv);
        w1.x = cvtpk(S.o1[4 * a4] * inv, S.o1[4 * a4 + 1] * inv); w1.y = cvtpk(S.o1[4 * a4 + 2] * inv, S.o1[4 * a4 + 3] * inv);
        *(v2u*)(o + 8 * a4 + 4 * hi) = w0; *(v2u*)(o + 32 + 8 * a4 + 4 * hi) = w1; }
}

DI void ph_ln1_router(const Args& a, const Fr& F, int layer) {
    const float* yp = (const float*)(F.ws + WS_YP); float* x1 = (float*)(F.ws + WS_X1); unsigned char* xb8 = F.ws + WS_XB8;
    unsigned* tope = (unsigned*)(F.ws + WS_TOPE); float* gate = (float*)(F.ws + WS_GATE); unsigned* rank = (unsigned*)(F.ws + WS_RANK);
    const float* g = a.in[10] + (size_t)(layer * 2) * DM; const float* bb = a.in[11] + (size_t)(layer * 2) * DM;
    const float* rw = a.in[12] + (size_t)layer * 1024 * 32; const float* rb = a.in[13] + layer * 32;
    LAS float* red = (LAS float*)(F.lds); LAS unsigned* lcnt = (LAS unsigned*)(F.lds + 131072);
    const int lane = F.lane, wave = F.wave, tid = F.tid, l31 = lane & 31, hi = lane >> 5;
    for (int chunk = F.blk; chunk < 256; chunk += F.G) { const int tok0 = chunk * 128;
        __syncthreads();
        if (tid < 32) lcnt[tid] = 0u;
#pragma unroll 1
        for (int k = 0; k < 16; k += 8) { f32x4 v[8][4];
#pragma unroll
            for (int i = 0; i < 8; ++i)
#pragma unroll
                for (int jj = 0; jj < 4; ++jj) v[i][jj] = *((const f32x4*)(yp + (size_t)(tok0 + wave * 16 + k + i) * DM) + lane + 64 * jj);
#pragma unroll
            for (int i = 0; i < 8; ++i) { const int tok = tok0 + wave * 16 + k + i;
                ln_row(v[i], g, bb, lane);
                store_row_f32(x1 + (size_t)tok * DM, v[i], lane);
#pragma unroll
                for (int jj = 0; jj < 4; ++jj) *((unsigned*)(xb8 + (size_t)tok * DM) + lane + 64 * jj) = pk4_fp8(v[i][jj][0] * F8_SX, v[i][jj][1] * F8_SX, v[i][jj][2] * F8_SX, v[i][jj][3] * F8_SX); } }
        asm volatile("s_waitcnt vmcnt(0)" ::: "memory");
        __syncthreads();
        const int tl = wave & 3, kr = wave >> 2, tokl = tok0 + tl * 32 + l31;
        f32x16 D = proj32_f32(rw, 32, 32, x1 + (size_t)tokl * DM, kr * 512, lane);
        if (kr == 1) {
#pragma unroll
            for (int r = 0; r < 16; ++r) red[(tl * 16 + r) * 64 + lane] = D[r]; }
        __syncthreads();
        if (kr == 0) {
            float lv[32];
#pragma unroll
            for (int r = 0; r < 16; ++r) { const float own = D[r] + red[(tl * 16 + r) * 64 + lane] + rb[crow(r, hi)]; const float oth = __shfl_xor(own, 32);
                lv[crow(r, 0)] = hi == 0 ? own : oth; lv[crow(r, 1)] = hi == 0 ? oth : own; }
            float tv[4]; int te[4];
#pragma unroll
            for (int r = 0; r < 4; ++r) { float mx = -INFINITY; int me = 0;
#pragma unroll
                for (int e = 0; e < 32; ++e) { if (lv[e] > mx) { mx = lv[e]; me = e; } }
                tv[r] = mx; te[r] = me;
#pragma unroll
                for (int e = 0; e < 32; ++e) { if (e == me) lv[e] = -INFINITY; } }
            const float e1 = __expf(tv[1] - tv[0]), e2 = __expf(tv[2] - tv[0]), e3 = __expf(tv[3] - tv[0]); const float inv = 1.f / (1.f + e1 + e2 + e3);
            if (hi == 0) { const size_t o = (size_t)tokl * 4;
                const float gv[4] = {inv, e1 * inv, e2 * inv, e3 * inv};
#pragma unroll
                for (int r = 0; r < 4; ++r) { const unsigned rk = __hip_atomic_fetch_add(lcnt + (te[r] & 31), 1u, __ATOMIC_RELAXED, __HIP_MEMORY_SCOPE_WORKGROUP);
                    tope[o + r] = (unsigned)(te[r] & 31); gate[o + r] = gv[r]; rank[o + r] = rk; } } }
        __syncthreads();
        if (tid < 32) __hip_atomic_store(F.ctl + CW_CNT + chunk * 32 + tid, lcnt[tid], RLX_AGENT);
    }
}

DI void ph_route(const Fr& F) {
    const unsigned char* xb8 = F.ws + WS_XB8; unsigned char* xg = F.ws + WS_XG;
    const unsigned* tope = (const unsigned*)(F.ws + WS_TOPE); const unsigned* rank = (const unsigned*)(F.ws + WS_RANK); unsigned* dest = (unsigned*)(F.ws + WS_DEST);
    LAS unsigned* P = (LAS unsigned*)(F.lds); LAS unsigned* pst = P + 512; LAS unsigned* pad = P + 544; LAS unsigned* base = P + 576; LAS unsigned* nt = P + 608;
    const int tid = F.tid, lane = F.lane, wave = F.wave;
    __syncthreads();
    { const int e = tid & 31, part = tid >> 5; unsigned s = 0u;
        for (int c = 0; c < 16; ++c) s += ld_u32(F.ctl + CW_CNT + (part * 16 + c) * 32 + e);
        P[part * 32 + e] = s; }
    __syncthreads();
    if (tid < 32) { unsigned tot = 0u;
        for (int p = 0; p < 16; ++p) tot += P[p * 32 + tid];
        pad[tid] = (tot + 255u) & ~255u; }
    __syncthreads();
    if (tid == 0) { unsigned acc = 0u;
        for (int e = 0; e < 32; ++e) { pst[e] = acc; acc += pad[e]; }
        nt[0] = acc >> 8; }
    __syncthreads();
    for (int chunk = F.blk; chunk < 256; chunk += F.G) {
        __syncthreads();
        if (tid < 32) { unsigned off = 0u; const int pf = chunk >> 4;
            for (int p = 0; p < pf; ++p) off += P[p * 32 + tid];
            for (int c = pf * 16; c < chunk; ++c) off += ld_u32(F.ctl + CW_CNT + c * 32 + tid);
            base[tid] = pst[tid] + off; }
        __syncthreads();
#pragma unroll 1
        for (int i0 = 0; i0 < 16; i0 += 4) { v4u src[4]; unsigned ee[4][4], rr[4][4];
#pragma unroll
            for (int i = 0; i < 4; ++i) { const int tok = chunk * 128 + wave * 16 + i0 + i; src[i] = *((const v4u*)(xb8 + (size_t)tok * DM) + lane);
#pragma unroll
                for (int k = 0; k < 4; ++k) { ee[i][k] = tope[(size_t)tok * 4 + k]; rr[i][k] = rank[(size_t)tok * 4 + k]; } }
#pragma unroll
            for (int i = 0; i < 4; ++i) { const int tok = chunk * 128 + wave * 16 + i0 + i;
#pragma unroll
                for (int k = 0; k < 4; ++k) { const unsigned d = base[ee[i][k]] + rr[i][k];
                    if (lane == 0) dest[(size_t)tok * 4 + k] = d;
                    *((v4u*)(xg + (size_t)d * DM) + lane) = src[i]; } } }
        if (chunk == 0) { const unsigned ntl = nt[0];
            if (tid == 0) __hip_atomic_store(F.ctl + CW_TILE, ntl, RLX_AGENT);
            for (unsigned i = tid; i < ntl; i += NTHR) { unsigned e = 0u;
                for (unsigned k = 1; k < 32; ++k) if (pst[k] <= i * 256u) e = k;
                __hip_atomic_store(F.ctl + CW_TILE + 64 + i, e, RLX_AGENT); } }
    }
}

DI void ph_combine_ln2(const Args& a, const Fr& F, int layer) {
    const float* x1 = (const float*)(F.ws + WS_X1); const bf16* yr = (const bf16*)(F.ws + WS_XG); float* xo = (float*)(F.ws + WS_X); bf16* xb = (bf16*)(F.ws + WS_XB);
    const float* gate = (const float*)(F.ws + WS_GATE); const unsigned* dest = (const unsigned*)(F.ws + WS_DEST);
    const float* g = a.in[10] + (size_t)(layer * 2 + 1) * DM; const float* bb = a.in[11] + (size_t)(layer * 2 + 1) * DM;
    const int lane = F.lane; const int gw = F.blk * NWAVES + F.wave, NGW = F.G * NWAVES;
    for (int tok = gw; tok < NTOK; tok += 4 * NGW) { f32x4 v[4][4];
#pragma unroll
        for (int i = 0; i < 4; ++i) { const int tk = tok + i * NGW; if (tk < NTOK) {
#pragma unroll
            for (int jj = 0; jj < 4; ++jj) v[i][jj] = *((const f32x4*)(x1 + (size_t)tk * DM) + lane + 64 * jj) * ALPHA;
#pragma unroll
            for (int k = 0; k < 4; ++k) { const float gk = gate[(size_t)tk * 4 + k]; const unsigned d = dest[(size_t)tk * 4 + k];
#pragma unroll
                for (int jj = 0; jj < 4; ++jj) { const v2u w = *((const v2u*)(yr + (size_t)d * DM) + lane + 64 * jj);
                    v[i][jj][0] += gk * bf2f(w.x & 0xffffu); v[i][jj][1] += gk * bf2f(w.x >> 16); v[i][jj][2] += gk * bf2f(w.y & 0xffffu); v[i][jj][3] += gk * bf2f(w.y >> 16); } } } }
#pragma unroll
        for (int i = 0; i < 4; ++i) { const int tk = tok + i * NGW; if (tk < NTOK) {
            ln_row(v[i], g, bb, lane);
            if (layer == DEPTH - 1) store_row_f32(a.out + (size_t)tk * DM, v[i], lane);
            else { store_row_f32(xo + (size_t)tk * DM, v[i], lane); store_row_bf16(xb + (size_t)tk * DM, v[i], lane); } } } }
}
constexpr int LDS_BYTES = 147456;
constexpr int LDS_BARW = 145408, LDS_QSLOT = 145472, LDS_TILE_E = 133632;
constexpr int NPL = 11;
constexpr int NPHASE = 1 + NPL * DEPTH;
#ifndef MK_SINGLE
#define MK_SINGLE 1
#endif
DI int q_next(const Fr& F, unsigned* ctr) {
    LAS int* slot = (LAS int*)(F.lds + LDS_QSLOT);
    __syncthreads();
    if (F.tid == 0) *slot = (int)__hip_atomic_fetch_add(ctr, 1u, RLX_AGENT);
    __syncthreads();
    return *slot;
}
DI int lane_id_fresh() { unsigned m_ = ~0u; asm volatile("" : "+s"(m_)); return (int)__builtin_amdgcn_mbcnt_hi(m_, __builtin_amdgcn_mbcnt_lo(m_, 0u)); }
#define RETID(F) do { int t2_ = F.tid; asm volatile("" : "+v"(t2_)); F.tid = t2_; F.lane = t2_ & 63; F.wave = __builtin_amdgcn_readfirstlane(t2_ >> 6); } while (0)
#ifndef PROBE_DUP
#define PROBE_DUP -1
#endif
#define NREP(q) ((PROBE_DUP == (q)) ? 2 : 1)
#define AS4 __attribute__((address_space(4)))
#define SITE() Args a; Fr F; { const AS4 Args* ap = (const AS4 Args*)__builtin_amdgcn_kernarg_segment_ptr(); asm volatile("" : "+s"(ap)); \
        _Pragma("unroll") for (int i_ = 0; i_ < 18; ++i_) a.in[i_] = ap->in[i_]; a.out = ap->out; a.ws = ap->ws; a.ph_lo = 0; a.ph_hi = 0; \
        int w_ = wv_s; asm volatile("" : "+s"(w_)); int t_ = w_ * 64 + lane_id_fresh(); asm volatile("" : "+v"(t_)); F.tid = t_; F.lane = t_ & 63; F.wave = __builtin_amdgcn_readfirstlane(t_ >> 6); \
        F.lds = (LAS unsigned char*)lds_raw; F.ws = a.ws; F.ctl = (unsigned*)(a.ws + WS_CTL); F.blk = blockIdx.x; F.G = gridDim.x; }
__global__ void __launch_bounds__(NTHR, 2) mega_fwd(Args a0) {
    extern __shared__ __attribute__((aligned(16))) unsigned char lds_raw[];
    const int wv_s = __builtin_amdgcn_readfirstlane((int)(threadIdx.x >> 6));
#if MK_SINGLE
    constexpr int lo = 0, hi = NPHASE; constexpr bool single = true;
#else
    const int lo = a0.ph_lo, hi = a0.ph_hi; constexpr bool single = false;
#endif
    if (threadIdx.x == 0) *(LAS v4u*)((LAS unsigned char*)lds_raw + LDS_BARW) = (v4u){0u, 0u, 0u, 0u};
    __syncthreads();
    if (single) (void)xcd_barrier_post((unsigned*)(a0.ws + WS_CTL) + CW_BAR, (volatile LAS unsigned*)((LAS unsigned char*)lds_raw + LDS_BARW));
#define IN(k) (lo <= (k) && (k) < hi)
#define SEAM() do { if (single) { const AS4 Args* ap_ = (const AS4 Args*)__builtin_amdgcn_kernarg_segment_ptr(); asm volatile("" : "+s"(ap_)); int w_ = wv_s; asm volatile("" : "+s"(w_)); \
        XcdBarrier b_; b_.bar = (unsigned*)(ap_->ws + WS_CTL) + CW_BAR; b_.x = xb_xcc_id(); b_.st = (volatile LAS unsigned*)((LAS unsigned char*)lds_raw + LDS_BARW); \
        xcd_barrier(b_, (w_ == 0) && (lane_id_fresh() == 0)); } } while (0)
    if (IN(0)) { _Pragma("unroll 1") for (int rep = 0; rep < NREP(100); ++rep) { { SITE(); ph_prologue(a, F); } SEAM(); } }
#pragma unroll 1
    for (int L = 0; L < DEPTH; ++L) {
        const int pb = 1 + NPL * L, j = L >> 1; const bool odd = (L & 1) != 0;
        if (IN(pb + 0)) _Pragma("unroll 1") for (int rep = 0; rep < NREP(0); ++rep) {
            { SITE();
            const bf16* w = odd ? (const bf16*)(F.ws + WS_WOD) + (size_t)j * OD_N * 1024 : (const bf16*)(F.ws + WS_WEV) + (size_t)j * EV_N * 1024;
            const int N = odd ? OD_N : EV_N;
            pg8::Gemm g{(const bf16*)(F.ws + WS_XB), w, NTOK, N, 1024}; pg8::StaticOrder S; S.init(NTOK, N, F.G, F.blk);
            pg8::EpiBf16<0> E{(bf16*)(F.ws + WS_PROJ), N, nullptr, 1024, (size_t)1024, C2F};
            pg8::gemm_phase<pg8::EpiBf16<0>, pg8::StaticOrder, true, true>(F.lds, g, S, E, F.tid); }
            SEAM(); }
        if (IN(pb + 1)) _Pragma("unroll 1") for (int rep = 0; rep < NREP(1); ++rep) { { SITE(); if (odd) ph_odd_prep(a, F, j, L); else ph_even_prep(a, F, j); } SEAM(); }
        if (!odd && IN(pb + 2)) _Pragma("unroll 1") for (int rep = 0; rep < ((PROBE_DUP == 2 || PROBE_DUP == 21 || PROBE_DUP == 22) ? 2 : 1); ++rep) {
            { SITE(); unsigned* ctr = F.ctl + CW_Q + 64 * (L * 2) + 1024 * rep;
            for (;;) { const int it = q_next(F, ctr); if (it >= 1280) break; RETID(F);
                if (it < 1024) { if (!(rep == 1 && PROBE_DUP == 22)) idx_unit(F, it & 3, 255 - (it >> 2)); } else { if (!(rep == 1 && PROBE_DUP == 21)) moba_gate_chunk(F, it - 1024); } } }
            SEAM(); }
        if (IN(pb + 3)) _Pragma("unroll 1") for (int rep = 0; rep < ((PROBE_DUP == 3 || (PROBE_DUP == 31 && odd) || ((PROBE_DUP == 32 || PROBE_DUP == 33) && !odd)) ? 2 : 1); ++rep) {
            { SITE(); unsigned* ctr = F.ctl + CW_Q + 64 * (L * 2 + 1) + 1024 * rep;
            if (odd) { for (;;) { const int it = q_next(F, ctr); if (it >= 2048) break; RETID(F); const int bh = it & 63; fox_unit(F, L, bh >> 4, bh & 15, 31 - (it >> 6)); } }
            else { for (;;) { const int it = q_next(F, ctr); if (it >= 2048) break; RETID(F);
                    if (it < 1024) { const int bh = it & 31; if (!(rep == 1 && PROBE_DUP == 33)) moba_unit(a, F, bh >> 3, bh & 7, it >> 5); } else { if (!(rep == 1 && PROBE_DUP == 32)) dsa_chunk(a, F, it - 1024); } } } }
            SEAM(); }
        if (!odd && IN(pb + 4)) _Pragma("unroll 1") for (int rep = 0; rep < NREP(4); ++rep) { { SITE(); ph_even_post(F, j); } SEAM(); }
        if (IN(pb + 5)) _Pragma("unroll 1") for (int rep = 0; rep < NREP(5); ++rep) {
            { SITE();
            const float* xin = (L == 0) ? a.in[0] : (const float*)(F.ws + WS_X);
            pg8::Gemm g{(const bf16*)(F.ws + WS_AO), (const bf16*)(F.ws + WS_WOUT) + (size_t)L * 1024 * 1024, NTOK, 1024, 1024}; pg8::StaticOrder S; S.init(NTOK, 1024, F.G, F.blk);
            EpiResF32 E{xin, (float*)(F.ws + WS_YP), ALPHA};
            pg8::gemm_phase<EpiResF32, pg8::StaticOrder, true, true>(F.lds, g, S, E, F.tid); }
            SEAM(); }
        if (IN(pb + 6)) _Pragma("unroll 1") for (int rep = 0; rep < NREP(6); ++rep) { { SITE(); ph_ln1_router(a, F, L); } SEAM(); }
        if (IN(pb + 7)) _Pragma("unroll 1") for (int rep = 0; rep < NREP(7); ++rep) { { SITE(); ph_route(F); } SEAM(); }
        if (IN(pb + 8)) _Pragma("unroll 1") for (int rep = 0; rep < NREP(8); ++rep) {
            { SITE(); const int ntl = (int)ld_u32(F.ctl + CW_TILE);
            LAS unsigned* tle = (LAS unsigned*)(F.lds + LDS_TILE_E);
            for (int i = F.tid; i < ntl; i += NTHR) tle[i] = ld_u32(F.ctl + CW_TILE + 64 + i);
            __syncthreads();
            pg8::Gemm g{(const bf16*)(F.ws + WS_XG), (const bf16*)(F.ws + WS_WGU + (size_t)L * 32 * 2048 * 1024), NR_MAX, 32 * 2048, 512};
            GroupOrder S{tle, ntl, 3, F.G, F.blk};
            EpiSwiglu E{F.ws + WS_ACT, a.in[15] + (size_t)L * 32 * 2048};
            pg8::gemm_phase<EpiSwiglu, GroupOrder, true, true, true>(F.lds, g, S, E, F.tid); }
            SEAM(); }
        if (IN(pb + 9)) _Pragma("unroll 1") for (int rep = 0; rep < NREP(9); ++rep) {
            { SITE(); const int ntl = (int)ld_u32(F.ctl + CW_TILE);
            LAS unsigned* tle = (LAS unsigned*)(F.lds + LDS_TILE_E);
            for (int i = F.tid; i < ntl; i += NTHR) tle[i] = ld_u32(F.ctl + CW_TILE + 64 + i);
            __syncthreads();
            pg8::Gemm g{(const bf16*)(F.ws + WS_ACT), (const bf16*)(F.ws + WS_WDN + (size_t)L * 32 * 1024 * 1024), NR_MAX, 32 * 1024, 512};
            GroupOrder S{tle, ntl, 2, F.G, F.blk};
            EpiDown E{(bf16*)(F.ws + WS_XG), a.in[17] + (size_t)L * 32 * 1024};
            pg8::gemm_phase<EpiDown, GroupOrder, true, true, true>(F.lds, g, S, E, F.tid); }
            SEAM(); }
        if (IN(pb + 10)) _Pragma("unroll 1") for (int rep = 0; rep < NREP(10); ++rep) { { SITE(); ph_combine_ln2(a, F, L); } if (L + 1 < DEPTH || rep + 1 < NREP(10)) SEAM(); }
    }
#undef IN
#undef SEAM
}

extern "C" void kernel_launch(void* const* d_in, const int* in_sizes, int n_in, void* d_out, int out_size, void* d_ws, size_t ws_size, hipStream_t stream) {
    static int grid = 0;
    if (grid == 0) {
        if (n_in != 18 || out_size != NTOK * DM || ws_size < WS_END) { fprintf(stderr, "kernel_launch: unexpected shapes (n_in %d, out %d, ws %zu); nothing launched\n", n_in, out_size, ws_size); grid = -1; return; }
        int dev = 0, cus = 0, per_cu = 0;
        if (hipGetDevice(&dev) != hipSuccess || hipDeviceGetAttribute(&cus, hipDeviceAttributeMultiprocessorCount, dev) != hipSuccess) { grid = -1; return; }
        if (hipFuncSetAttribute((const void*)mega_fwd, hipFuncAttributeMaxDynamicSharedMemorySize, LDS_BYTES) != hipSuccess) { fprintf(stderr, "kernel_launch: hipFuncSetAttribute failed\n"); grid = -1; return; }
        if (hipOccupancyMaxActiveBlocksPerMultiprocessor(&per_cu, (const void*)mega_fwd, NTHR, LDS_BYTES) != hipSuccess || per_cu < 1) fprintf(stderr, "kernel_launch: occupancy query reports %d\n", per_cu);
        (void)hipGetLastError();
        grid = cus;
    }
    if (grid < 0) return;
    (void)hipMemsetAsync((char*)d_ws + WS_CTL, 0, CTL_ZERO_BYTES, stream);
#ifdef EXP_SKIP
    (void)hipMemsetAsync((char*)d_ws + WS_AO, 0, 64 * MiB, stream);
    (void)hipMemsetAsync((char*)d_ws + WS_OL, 0, 64 * MiB, stream);
    if (EXP_SKIP & 4) { (void)hipMemsetAsync((char*)d_ws + WS_XG, 0, 272 * MiB, stream); (void)hipMemsetAsync((char*)d_ws + WS_DEST, 0, 1 * MiB, stream); }
#endif
    Args a{};
    for (int i = 0; i < 18; ++i) a.in[i] = (const float*)d_in[i];
    a.out = (float*)d_out; a.ws = (unsigned char*)d_ws;
#if MK_SINGLE
    a.ph_lo = 0; a.ph_hi = NPHASE;
    hipLaunchKernelGGL(mega_fwd, dim3(grid), dim3(NTHR), LDS_BYTES, stream, a);
#else
    for (int p = 0; p < NPHASE; ++p) {
        if (p > 0) { const int L = (p - 1) / NPL, q = (p - 1) % NPL; if ((L & 1) && (q == 2 || q == 4)) continue;
#ifdef EXP_SKIP
            if ((EXP_SKIP & 1) && !(L & 1) && q <= 4) continue;
            if ((EXP_SKIP & 2) && (L & 1) && q <= 4) continue;
            if ((EXP_SKIP & 4) && q >= 7 && q <= 9) continue;
#endif
        }
        a.ph_lo = p; a.ph_hi = p + 1;
        hipLaunchKernelGGL(mega_fwd, dim3(grid), dim3(NTHR), LDS_BYTES, stream, a);
    }
#endif
}
```

```cpp
#include <hip/hip_runtime.h>
#include <cstdio>
#include <cstdint>
#ifdef EXP_SKIP
#define EXPF EXP_SKIP
#else
#define EXPF 0
#endif
constexpr int NB = 4, SEQ = 8192, DM = 1024, NTOK = NB * SEQ, DEPTH = 4;
constexpr int EV_N = 2560, OD_N = 3072;
constexpr int EC_QA = 0, EC_QB = 512, EC_KB = 1024, EC_VB = 1536, EC_CKV = 2048, EC_QI = 2176, EC_KI = 2432, EC_WI = 2496;
constexpr int OC_Q = 0, OC_K = 1024, OC_V = 2048;
constexpr float LOG2E = 1.4426950408889634f;
constexpr float C2F = 0.125f * LOG2E;
constexpr float ALPHA = 1.681792830507429f;
constexpr float LN_EPS = 1e-5f;
constexpr int NR_MAX = 131072 + 32 * 256;
constexpr int NWAVES = 8, NTHR = 512;
constexpr size_t MiB = (size_t)1 << 20;
constexpr size_t WS_CTL = 0, CTL_ZERO_BYTES = 4 * MiB;
constexpr size_t WS_WEV = 8 * MiB, WS_WOD = 18 * MiB, WS_WOUT = 30 * MiB, WS_WUKT = 38 * MiB, WS_WUVT = 39 * MiB;
constexpr size_t WS_WGU = 40 * MiB, WS_WDN = 552 * MiB;
constexpr size_t WS_X = 808 * MiB, WS_X1 = 936 * MiB, WS_YP = 1064 * MiB, WS_XB = 1192 * MiB;
constexpr size_t WS_PROJ = 1256 * MiB, WS_AO = 1448 * MiB, WS_XG = 1512 * MiB, WS_ACT = 1784 * MiB;
constexpr size_t WS_QL = 2056 * MiB, WS_OL = 2120 * MiB, WS_CKVN = 2184 * MiB, WS_SEL = 2192 * MiB;
constexpr size_t WS_KBAR = 2208 * MiB, WS_SEL3 = 2209 * MiB, WS_LOGF = 2210 * MiB, WS_CS = 2212 * MiB;
constexpr size_t WS_TOPE = 2213 * MiB, WS_GATE = 2214 * MiB, WS_RANK = 2215 * MiB, WS_DEST = 2216 * MiB, WS_PML = 2217 * MiB;
constexpr size_t WS_XB8 = 2226 * MiB;
constexpr size_t WS_KIC = 2258 * MiB;
constexpr size_t WS_END = 2262 * MiB;
constexpr float F8_SX = 16.f, F8_SWG = 256.f, F8_SA = 4.f, F8_SWD = 512.f;
constexpr int CW_BAR = 4096, CW_Q = 8192, CW_KMAX = 12288, CW_CNT = 16384, CW_TILE = 32768;

#define GAS __attribute__((address_space(1)))
#define LAS __attribute__((address_space(3)))
#define DI __device__ __forceinline__
typedef unsigned short bf16;
typedef unsigned v4u __attribute__((ext_vector_type(4)));
typedef unsigned v2u __attribute__((ext_vector_type(2)));
typedef float f32x4 __attribute__((ext_vector_type(4)));
typedef float f32x2 __attribute__((ext_vector_type(2)));
typedef float f32x16 __attribute__((ext_vector_type(16)));
typedef short bf16x8 __attribute__((ext_vector_type(8)));
typedef short s16x4 __attribute__((ext_vector_type(4)));
typedef __bf16 bf16x2_t __attribute__((ext_vector_type(2)));
typedef GAS unsigned gu32;
#define RLX_AGENT __ATOMIC_RELAXED, __HIP_MEMORY_SCOPE_AGENT
#define LDS_WAIT() asm volatile("s_waitcnt lgkmcnt(0)" ::: "memory")

DI float bf2f(unsigned v) { return __uint_as_float(v << 16); }
DI unsigned cvtpk(float lo, float hi) { f32x2 v = {lo, hi}; bf16x2_t b = __builtin_convertvector(v, bf16x2_t); return __builtin_bit_cast(unsigned, b); }
DI unsigned f2bf(float f) { return cvtpk(f, 0.f) & 0xffffu; }
DI unsigned pk4_fp8(float a, float b, float c, float d) {
    a = fminf(fmaxf(a, -448.f), 448.f); b = fminf(fmaxf(b, -448.f), 448.f); c = fminf(fmaxf(c, -448.f), 448.f); d = fminf(fmaxf(d, -448.f), 448.f);
    int w = 0; w = __builtin_amdgcn_cvt_pk_fp8_f32(a, b, w, false); w = __builtin_amdgcn_cvt_pk_fp8_f32(c, d, w, true); return (unsigned)w; }
DI float ex2(float x) { return __builtin_amdgcn_exp2f(x); }
DI float wave_sum(float v) {
#pragma unroll
    for (int o = 1; o < 64; o <<= 1) v += __shfl_xor(v, o);
    return v;
}
DI float wave_max(float v) {
#pragma unroll
    for (int o = 1; o < 64; o <<= 1) v = fmaxf(v, __shfl_xor(v, o));
    return v;
}
DI unsigned ld_u32(const unsigned* p) { return __hip_atomic_load(p, RLX_AGENT); }
DI int crow(int r, int hi) { return (r & 3) + 8 * (r >> 2) + 4 * hi; }
DI f32x16 mfma32(bf16x8 a, bf16x8 b, f32x16 c) { return __builtin_amdgcn_mfma_f32_32x32x16_bf16(a, b, c, 0, 0, 0); }
DI f32x4 mfma16(bf16x8 a, bf16x8 b, f32x4 c) { return __builtin_amdgcn_mfma_f32_16x16x32_bf16(a, b, c, 0, 0, 0); }
typedef short v4i16_t __attribute__((ext_vector_type(4)));
DI s16x4 vtr(LAS const char* p) { return __builtin_bit_cast(s16x4, __builtin_amdgcn_ds_read_tr16_b64_v4i16((LAS v4i16_t*)p)); }
DI bf16x8 cat8(s16x4 a, s16x4 b) { return (bf16x8){a[0], a[1], a[2], a[3], b[0], b[1], b[2], b[3]}; }
DI int t5_bucket(int n) {
    if (n < 16) return n;
    int bkt = 16;
    bkt += (n >= 21); bkt += (n >= 27); bkt += (n >= 35); bkt += (n >= 46); bkt += (n >= 59); bkt += (n >= 77); bkt += (n >= 99); bkt += (n >= 128);
    bkt += (n >= 166); bkt += (n >= 216); bkt += (n >= 280); bkt += (n >= 363); bkt += (n >= 470); bkt += (n >= 609); bkt += (n >= 790);
    return bkt;
}
namespace pg8 {
#define PG8_LAS __attribute__((address_space(3)))
typedef unsigned short bf16_t;
typedef short bf16x8 __attribute__((ext_vector_type(8)));
typedef float f32x4 __attribute__((ext_vector_type(4)));
typedef unsigned u32x4 __attribute__((ext_vector_type(4)));
constexpr int BM = 256, BK = 64, HALF = 128, HTB = HALF * BK * 2  , STAGE_BYTES = 8 * HTB, NXCD = 8, WGM = 8;

__host__ __device__ __forceinline__ int lds_byte(int r, int c) { const int st = (r >> 4) * 2 + (c >> 5), rr = r & 15, cc = c & 31, ob = rr * 64 + cc * 2; return st * 1024 + (ob ^ (((ob >> 9) & 1) << 5)); }
__host__ __device__ __forceinline__ void stage_rc(int b, int& R, int& C) { const int st = b / 1024, sb = b % 1024, swz = sb ^ (((sb >> 9) & 1) << 5); R = (st >> 1) * 16 + swz / 64; C = (st & 1) * 32 + (swz % 64) / 2; }
__host__ __device__ __forceinline__ int perm32(int rho) { const int n = rho >> 4, i = rho & 15; return 8 * (i >> 2) + 4 * n + (i & 3); }

typedef int i32x8 __attribute__((ext_vector_type(8))); typedef int i32x4v __attribute__((ext_vector_type(4)));
__device__ __forceinline__ i32x8 pg8_cat8(bf16x8 lo, bf16x8 hi) { const i32x4v a = __builtin_bit_cast(i32x4v, lo), b = __builtin_bit_cast(i32x4v, hi); return (i32x8){a[0], a[1], a[2], a[3], b[0], b[1], b[2], b[3]}; }
struct Unit { int pm, pn; };
struct Gemm { const bf16_t* A; const bf16_t* Bt; int M, N, K; };

struct StaticOrder {
    int nM, nN, nwg, G, c;
    __host__ __device__ void init(int M, int N, int G_, int c_) { nM = M / BM; nN = N / BM; nwg = nM * nN; G = G_; c = c_; }
    __host__ __device__ bool next(int i, Unit& u) const {
        const long L = (long)i * G + c; if (L >= nwg) return false;
        int wgid = (int)L; { const int q = nwg / NXCD, r = nwg % NXCD, xcd = wgid % NXCD, off = wgid / NXCD; wgid = (xcd < r ? xcd * (q + 1) : r * (q + 1) + (xcd - r) * q) + off; }
        const int nig = WGM * nN, gid = wgid / nig, fm = gid * WGM, gsz = (nM - fm) < WGM ? (nM - fm) : WGM;
        u.pm = fm + ((wgid % nig) % gsz); u.pn = (wgid % nig) / gsz; return true;
    }
    __device__ __forceinline__ void a_ready(const Unit&) const {}
    __device__ __forceinline__ void done(const Unit&) const {}
};

__device__ __forceinline__ unsigned cvt_pk_bf16(float lo, float hi) { unsigned r; asm volatile("v_cvt_pk_bf16_f32 %0, %1, %2" : "=v"(r) : "v"(lo), "v"(hi)); return r; }
typedef float f32x2 __attribute__((ext_vector_type(2)));
__device__ __forceinline__ f32x2 gelu_pk(f32x2 v) {
    const f32x2 av = __builtin_elementwise_abs(v), d = av * 0.2316418882f + 1.0f;
    f32x2 t; t.x = __builtin_amdgcn_rcpf(d.x); t.y = __builtin_amdgcn_rcpf(d.y);
    f32x2 q = t * 0.5307027145f + (-0.7265760135f); q = q * t + 0.7107068705f; q = q * t + (-0.142248368f); q = q * t + 0.127414796f; q = q * t;
    const f32x2 s = (v * v) * (-0.72134752044f);
    f32x2 e; e.x = __builtin_amdgcn_exp2f(s.x); e.y = __builtin_amdgcn_exp2f(s.y);
    const f32x2 m = v * (q * e), r = v - m;
    f32x2 o; o.x = v.x < 0.f ? m.x : r.x; o.y = v.y < 0.f ? m.y : r.y; return o;
}

template <int ACT  > struct EpiBf16 {
    static constexpr bool PERM = true, AFTER_DRAIN = false; static_assert(ACT == 0 || ACT == 1, "EpiBf16: ACT is 0 (none) or 1 (gelu_pk)");
    bf16_t* O; int ldc; const float* bias; int split_cols; size_t split_stride; float scale0;
    __device__ __forceinline__ void operator()(const f32x4 (&acc)[2][2][4][2], const Unit& u, int wr, int wc, int fr, int fq) const {
        const int row0 = u.pm * BM + wr * 64 + fr; int colt = u.pn * BM; bf16_t* base = O;
        float sc = 1.f; if (split_cols) { const int t = colt / split_cols; base += (size_t)t * split_stride; colt -= t * split_cols; if (t == 0) sc = scale0; }
        const int col0 = colt + wc * 32 + 8 * fq, bcol0 = u.pn * BM + wc * 32 + 8 * fq;
        f32x4 bv[2][2];
#pragma unroll
        for (int bj = 0; bj < 2; ++bj)
#pragma unroll
            for (int n = 0; n < 2; ++n) bv[bj][n] = bias ? *(const f32x4*)(bias + bcol0 + bj * HALF + 4 * n) : (f32x4){0.f, 0.f, 0.f, 0.f};
#pragma unroll
        for (int ai = 0; ai < 2; ++ai)
#pragma unroll
            for (int m = 0; m < 4; ++m) { bf16_t* rowp = base + (size_t)(row0 + ai * HALF + m * 16) * ldc + col0;
#pragma unroll
                for (int bj = 0; bj < 2; ++bj) { f32x4 v0 = acc[ai][bj][m][0] + bv[bj][0], v1 = acc[ai][bj][m][1] + bv[bj][1];
                    if (ACT == 1) { f32x2 a = gelu_pk((f32x2){v0[0], v0[1]}), b = gelu_pk((f32x2){v0[2], v0[3]}), c = gelu_pk((f32x2){v1[0], v1[1]}), d = gelu_pk((f32x2){v1[2], v1[3]});
                        v0 = (f32x4){a.x, a.y, b.x, b.y}; v1 = (f32x4){c.x, c.y, d.x, d.y}; }
                    v0 = v0 * sc; v1 = v1 * sc; u32x4 w; w.x = cvt_pk_bf16(v0[0], v0[1]); w.y = cvt_pk_bf16(v0[2], v0[3]); w.z = cvt_pk_bf16(v1[0], v1[1]); w.w = cvt_pk_bf16(v1[2], v1[3]);
                    *(u32x4*)(rowp + bj * HALF) = w; } }
    }
};

template <class Epi, class Sched, bool ALIGN_EPI = false, bool SP2 = false, bool F8 = false>
__device__ __forceinline__ void gemm_phase(PG8_LAS unsigned char* lds, const Gemm g, const Sched& S, const Epi& E, int tid_in) {
    int tid_l = tid_in; asm volatile("" : "+v"(tid_l));
    const int tid = tid_l, wid = __builtin_amdgcn_readfirstlane(tid >> 6), lane = tid & 63, wr = wid >> 2, wc = wid & 3, fr = lane & 15, fq = lane >> 4;
    const int K = g.K, nt = K / BK;
    unsigned voffA[2], voffB[2];
#pragma unroll
    for (int i = 0; i < 2; ++i) { int R, C; stage_rc(tid * 16 + i * 8192, R, C); const int Rb = Epi::PERM ? ((R & ~31) + perm32(R & 31)) : R;
        voffA[i] = (unsigned)(R * K + C) * 2u; voffB[i] = (unsigned)(Rb * K + C) * 2u; }
    const size_t kstep = (size_t)(BK * 2);
    const size_t hstep = (size_t)HALF * K * 2;
    const size_t tstep = 2 * hstep;
    const unsigned ldsw = (unsigned)wid * 1024u;
    const int aoff = lds_byte(wr * 64 + fr, fq * 8), boff = lds_byte(wc * 32 + fr, fq * 8);
#define PG8_SA(b, h) (((b) * 2 + (h)) * HTB)
#define PG8_SB(b, h) ((4 + (b) * 2 + (h)) * HTB)
#define PG8_STAGE(bufoff, gbase, voff) do { _Pragma("unroll") for (int _i = 0; _i < 2; ++_i) \
        __builtin_amdgcn_global_load_lds((const unsigned*)((const char*)(gbase) + (voff)[_i]), (PG8_LAS unsigned*)(lds + (bufoff) + ldsw + _i * 8192), 16, 0, 0); } while (0)
#define PG8_LDA(dst, b, h) do { _Pragma("unroll") for (int m = 0; m < 4; ++m) _Pragma("unroll") for (int k = 0; k < 2; ++k) dst[m][k] = *(const PG8_LAS bf16x8*)(lds + PG8_SA(b, h) + aoff + m * 2048 + k * 1024); } while (0)
#define PG8_LDB(dst, b, h) do { _Pragma("unroll") for (int n = 0; n < 2; ++n) _Pragma("unroll") for (int k = 0; k < 2; ++k) dst[n][k] = *(const PG8_LAS bf16x8*)(lds + PG8_SB(b, h) + boff + n * 2048 + k * 1024); } while (0)
#define PG8_MMA(ai, bj, At, Bt) do { __builtin_amdgcn_s_setprio(1); if constexpr (!F8) { _Pragma("unroll") for (int m = 0; m < 4; ++m) _Pragma("unroll") for (int n = 0; n < 2; ++n) _Pragma("unroll") for (int k = 0; k < 2; ++k) \
        acc[ai][bj][m][n] = __builtin_amdgcn_mfma_f32_16x16x32_bf16(Bt[n][k], At[m][k], acc[ai][bj][m][n], 0, 0, 0); } else { _Pragma("unroll") for (int m = 0; m < 4; ++m) _Pragma("unroll") for (int n = 0; n < 2; ++n) \
        acc[ai][bj][m][n] = __builtin_amdgcn_mfma_scale_f32_16x16x128_f8f6f4(pg8_cat8(Bt[n][0], Bt[n][1]), pg8_cat8(At[m][0], At[m][1]), acc[ai][bj][m][n], 0, 0, 0, 0x7F7F7F7F, 0, 0x7F7F7F7F); \
        _Pragma("unroll") for (int m = 0; m < 4; ++m) _Pragma("unroll") for (int n = 0; n < 2; ++n) asm volatile("" : "+v"(acc[ai][bj][m][n]));   } __builtin_amdgcn_s_setprio(0); } while (0)
#define PG8_WAIT_V(n) asm volatile("s_waitcnt vmcnt(" #n ")" ::: "memory")
#define PG8_WAIT_L(n) asm volatile("s_waitcnt lgkmcnt(" #n ")" ::: "memory")
#define PG8_BAR __builtin_amdgcn_s_barrier()
#define PG8_SCHED __builtin_amdgcn_sched_barrier(0)
    Unit cur, nxt; int ui = 0;
    if (!S.next(0, cur)) return;
    f32x4 acc[2][2][4][2];
#pragma unroll
    for (int a = 0; a < 2; ++a)
#pragma unroll
        for (int b = 0; b < 2; ++b)
#pragma unroll
            for (int m = 0; m < 4; ++m)
#pragma unroll
                for (int n = 0; n < 2; ++n) acc[a][b][m][n] = (f32x4){0.f, 0.f, 0.f, 0.f};
    bf16x8 At[4][2], B0[2][2], B1[2][2];
    const char* cA = (const char*)g.A + (size_t)cur.pm * tstep; const char* cB = (const char*)g.Bt + (size_t)cur.pn * tstep;
    S.a_ready(cur);
    if constexpr (SP2) {
        PG8_STAGE(PG8_SB(0, 0), cB, voffB); PG8_STAGE(PG8_SB(0, 1), cB + hstep, voffB); PG8_STAGE(PG8_SA(0, 0), cA, voffA); PG8_STAGE(PG8_SA(0, 1), cA + hstep, voffA);
        if (wr == 1) PG8_BAR;
        PG8_WAIT_V(2); PG8_BAR;
        PG8_STAGE(PG8_SB(1, 0), cB + kstep, voffB); PG8_STAGE(PG8_SA(1, 0), cA + kstep, voffA); PG8_STAGE(PG8_SB(1, 1), cB + hstep + kstep, voffB);
        PG8_WAIT_V(6); PG8_BAR;
    } else {
        PG8_STAGE(PG8_SB(0, 0), cB, voffB); PG8_STAGE(PG8_SA(0, 0), cA, voffA); PG8_STAGE(PG8_SB(0, 1), cB + hstep, voffB); PG8_STAGE(PG8_SA(0, 1), cA + hstep, voffA);
        if (wr == 1) PG8_BAR;
        PG8_WAIT_V(4); PG8_BAR;
        PG8_STAGE(PG8_SB(1, 0), cB + kstep, voffB); PG8_STAGE(PG8_SA(1, 0), cA + kstep, voffA); PG8_STAGE(PG8_SB(1, 1), cB + hstep + kstep, voffB);
        PG8_WAIT_V(6); PG8_BAR;
    }
    for (;;) {
        const bool has_next = S.next(ui + 1, nxt);
        const char* nA = has_next ? (const char*)g.A + (size_t)nxt.pm * tstep : cA; const char* nB = has_next ? (const char*)g.Bt + (size_t)nxt.pn * tstep : cB;
        for (int t = 0; t < nt; t += 2) {
            const bool last = (t == nt - 2);
            const char* a1 = cA + (size_t)(t + 1) * kstep;
            const char* a2 = last ? nA : cA + (size_t)(t + 2) * kstep; const char* b2 = last ? nB : cB + (size_t)(t + 2) * kstep;
            const char* a3 = a2 + kstep; const char* b3 = b2 + kstep;
            if (last && has_next) S.a_ready(nxt);
            if constexpr (SP2) {
            PG8_LDB(B0, 0, 0); PG8_LDB(B1, 0, 1); PG8_SCHED; PG8_LDA(At, 0, 0); PG8_STAGE(PG8_SA(1, 1), a1 + hstep, voffA);
            PG8_WAIT_V(8); PG8_WAIT_L(0); PG8_BAR; PG8_MMA(0, 0, At, B0); PG8_MMA(0, 1, At, B1); PG8_BAR; PG8_SCHED;
            PG8_LDA(At, 0, 1); PG8_STAGE(PG8_SB(0, 0), b2, voffB); PG8_STAGE(PG8_SB(0, 1), b2 + hstep, voffB); PG8_STAGE(PG8_SA(0, 0), a2, voffA);
            PG8_WAIT_V(8); PG8_WAIT_L(0); PG8_BAR; PG8_MMA(1, 0, At, B0); PG8_MMA(1, 1, At, B1); PG8_BAR; PG8_SCHED;
            PG8_LDB(B0, 1, 0); PG8_LDB(B1, 1, 1); PG8_SCHED; PG8_LDA(At, 1, 0); PG8_STAGE(PG8_SA(0, 1), a2 + hstep, voffA);
            PG8_WAIT_V(8); PG8_WAIT_L(0); PG8_BAR; PG8_MMA(0, 0, At, B0); PG8_MMA(0, 1, At, B1); PG8_BAR; PG8_SCHED;
            PG8_LDA(At, 1, 1); PG8_STAGE(PG8_SB(1, 0), b3, voffB); PG8_STAGE(PG8_SB(1, 1), b3 + hstep, voffB); PG8_STAGE(PG8_SA(1, 0), a3, voffA);
            PG8_WAIT_V(8); PG8_WAIT_L(0); PG8_BAR; PG8_MMA(1, 0, At, B0); PG8_MMA(1, 1, At, B1); PG8_BAR; PG8_SCHED;
            } else {
            PG8_LDB(B0, 0, 0); PG8_SCHED; PG8_LDA(At, 0, 0); PG8_STAGE(PG8_SA(1, 1), a1 + hstep, voffA);
            PG8_WAIT_L(8); PG8_BAR; PG8_WAIT_L(0); PG8_MMA(0, 0, At, B0); PG8_BAR; PG8_SCHED;
            PG8_LDB(B1, 0, 1); PG8_STAGE(PG8_SB(0, 0), b2, voffB);
            PG8_BAR; PG8_WAIT_L(0); PG8_MMA(0, 1, At, B1); PG8_BAR;
            PG8_LDA(At, 0, 1); PG8_STAGE(PG8_SA(0, 0), a2, voffA);
            PG8_BAR; PG8_WAIT_L(0); PG8_MMA(1, 0, At, B0); PG8_BAR; PG8_SCHED;
            PG8_STAGE(PG8_SB(0, 1), b2 + hstep, voffB);
            PG8_WAIT_V(6); PG8_BAR; PG8_MMA(1, 1, At, B1); PG8_BAR;
            PG8_LDB(B0, 1, 0); PG8_SCHED; PG8_LDA(At, 1, 0); PG8_STAGE(PG8_SA(0, 1), a2 + hstep, voffA);
            PG8_WAIT_L(8); PG8_BAR; PG8_WAIT_L(0); PG8_MMA(0, 0, At, B0); PG8_BAR; PG8_SCHED;
            PG8_LDB(B1, 1, 1); PG8_STAGE(PG8_SB(1, 0), b3, voffB);
            PG8_BAR; PG8_WAIT_L(0); PG8_MMA(0, 1, At, B1); PG8_BAR;
            PG8_LDA(At, 1, 1); PG8_STAGE(PG8_SA(1, 0), a3, voffA);
            PG8_BAR; PG8_WAIT_L(0); PG8_MMA(1, 0, At, B0); PG8_BAR; PG8_SCHED;
            PG8_STAGE(PG8_SB(1, 1), b3 + hstep, voffB);
            PG8_WAIT_V(6); PG8_BAR; PG8_MMA(1, 1, At, B1); PG8_BAR;
            }
        }
        if constexpr (ALIGN_EPI) { if (wr == 0) PG8_BAR; }
        if constexpr (!Epi::AFTER_DRAIN) { E(acc, cur, wr, wc, fr, fq); S.done(cur); }
        if (!has_next) break;
#pragma unroll
        for (int a = 0; a < 2; ++a)
#pragma unroll
            for (int b = 0; b < 2; ++b)
#pragma unroll
                for (int m = 0; m < 4; ++m)
#pragma unroll
                    for (int n = 0; n < 2; ++n) acc[a][b][m][n] = (f32x4){0.f, 0.f, 0.f, 0.f};
        cur = nxt; cA = nA; cB = nB; ++ui;
        if constexpr (ALIGN_EPI) { if (wr == 1) PG8_BAR; }
    }
    PG8_WAIT_V(0);
    if constexpr (!ALIGN_EPI) { if (wr == 0) PG8_BAR; }
    PG8_BAR;
    if constexpr (Epi::AFTER_DRAIN) { E.fused(acc, cur, wr, wc, fr, fq, lds, wid, lane); S.done(cur); }
#undef PG8_SA
#undef PG8_SB
#undef PG8_STAGE
#undef PG8_LDA
#undef PG8_LDB
#undef PG8_MMA
#undef PG8_WAIT_V
#undef PG8_WAIT_L
#undef PG8_BAR
#undef PG8_SCHED
}
}

#ifndef PG8_SP2
#define PG8_SP2 true
#endif
#ifndef PG8_ALIGN
#define PG8_ALIGN true
#endif
#define XB_TMO      128
#define XB_XCNT(j)  (256  + 64 * (j))
#define XB_XSUB(j)  (1280 + 64 * (j))
#define XB_XGEN(j)  (2304 + 64 * (j))
#define XB_TOP      3328
#define XB_TOPGEN   3392
#define XCD_BAR_WORDS 3456
#define XB_SPIN_CAP (1u << 18)

__device__ __forceinline__ unsigned xb_ld(unsigned* p)              { return __hip_atomic_load(p, __ATOMIC_RELAXED, __HIP_MEMORY_SCOPE_AGENT); }
__device__ __forceinline__ unsigned xb_add(unsigned* p, unsigned v) { return __hip_atomic_fetch_add(p, v, __ATOMIC_RELAXED, __HIP_MEMORY_SCOPE_AGENT); }
__device__ __forceinline__ unsigned xb_xcc_id() { return (unsigned)__builtin_amdgcn_s_getreg((3 << 11) | 20) & 0xFu; }
#define XB_SPIN(cond, bar) do { unsigned _sp = 0; while (cond) { __builtin_amdgcn_s_sleep(1); \
    if ((++_sp & 255u) == 0u) { if (xb_ld(&(bar)[XB_TMO])) break; if (_sp > XB_SPIN_CAP) { atomicAdd(&(bar)[XB_TMO], 1u); break; } } } } while (0)

struct XcdBarrier {
    unsigned* bar; unsigned x;
    volatile LAS unsigned* st;
};

__device__ __forceinline__ XcdBarrier xcd_barrier_post(unsigned* bar, volatile LAS unsigned* st) {
    XcdBarrier b; b.bar = bar; b.x = xb_xcc_id(); b.st = st;
    if (threadIdx.x == 0) (void)xb_add(&bar[XB_XCNT(b.x)], 1u);
    return b;
}
__device__ __forceinline__ void xcd_barrier_complete(unsigned* bar, unsigned x, unsigned& nloc, unsigned& nx) {
    const unsigned G = gridDim.x * gridDim.y * gridDim.z;
    unsigned sum, cnt, mine, sp = 0u;
    for (;;) {
        sum = 0u; cnt = 0u; mine = 0u;
#pragma unroll
        for (unsigned j = 0; j < 16; ++j) { const unsigned c = xb_ld(&bar[XB_XCNT(j)]); sum += c; cnt += (c > 0u) ? 1u : 0u; mine = (j == x) ? c : mine; }
        if (sum == G) break;
        __builtin_amdgcn_s_sleep(1);
        if ((++sp & 255u) == 0u) { if (xb_ld(&bar[XB_TMO])) break; if (sp > XB_SPIN_CAP) { atomicAdd(&bar[XB_TMO], 1u); break; } }
    }
    nloc = mine > 0u ? mine : 1u; nx = cnt > 0u ? cnt : 1u;
}

__device__ __forceinline__ void xcd_barrier(const XcdBarrier& b, const bool is_t0  ) {
    asm volatile("s_waitcnt vmcnt(0)" ::: "memory");
    __syncthreads();
    if (is_t0) {
        unsigned* bar = b.bar;
        __builtin_amdgcn_s_waitcnt(0);
        unsigned nloc = b.st[0], nx = b.st[1];
        if (nloc == 0u) { xcd_barrier_complete(bar, b.x, nloc, nx); b.st[0] = nloc; b.st[1] = nx; }
        const unsigned old = xb_add(&bar[XB_XSUB(b.x)], 1u);
        const unsigned gen = old / nloc;
        if (old + 1u == (gen + 1u) * nloc) {
            __builtin_amdgcn_fence(__ATOMIC_RELEASE, "agent");
            asm volatile("s_waitcnt vmcnt(0)" ::: "memory");
            const unsigned og = xb_add(&bar[XB_TOP], 1u);
            const unsigned tg = og / nx;
            if (og + 1u == (tg + 1u) * nx) xb_add(&bar[XB_TOPGEN], 1u);
            else XB_SPIN(xb_ld(&bar[XB_TOPGEN]) == tg, bar);
            __builtin_amdgcn_fence(__ATOMIC_ACQUIRE, "agent");
            xb_add(&bar[XB_XGEN(b.x)], 1u);
            asm volatile("s_waitcnt vmcnt(0)" ::: "memory");
        } else {
            XB_SPIN(xb_ld(&bar[XB_XGEN(b.x)]) == gen, bar);
            __builtin_amdgcn_fence(__ATOMIC_ACQUIRE, "agent");
            asm volatile("s_waitcnt vmcnt(0)" ::: "memory");
        }
    }
    __syncthreads();
}
struct EpiResF32 {
    static constexpr bool PERM = true, AFTER_DRAIN = false;
    const float* xin; float* yp; float alpha;
    DI void operator()(const pg8::f32x4 (&acc)[2][2][4][2], const pg8::Unit& u, int wr, int wc, int fr, int fq) const {
        const int row0 = u.pm * 256 + wr * 64 + fr, col0 = u.pn * 256 + wc * 32 + 8 * fq;
#pragma unroll
        for (int ai = 0; ai < 2; ++ai)
#pragma unroll
            for (int m = 0; m < 4; ++m) {
                const size_t ro = (size_t)(row0 + ai * 128 + m * 16) * DM;
#pragma unroll
                for (int bj = 0; bj < 2; ++bj) {
                    const size_t o = ro + col0 + bj * 128;
                    const f32x4 x0 = *(const f32x4*)(xin + o), x1 = *(const f32x4*)(xin + o + 4);
                    *(f32x4*)(yp + o) = x0 * alpha + acc[ai][bj][m][0];
                    *(f32x4*)(yp + o + 4) = x1 * alpha + acc[ai][bj][m][1];
                }
            }
    }
};
struct EpiSwiglu {
    static constexpr bool PERM = true, AFTER_DRAIN = false;
    unsigned char* act; const float* bgu;
    DI void operator()(const pg8::f32x4 (&acc)[2][2][4][2], const pg8::Unit& u, int wr, int wc, int fr, int fq) const {
        const int e = u.pn >> 3, pl = u.pn & 7;
        const int row0 = u.pm * 256 + wr * 64 + fr, cih = pl * 128 + wc * 32 + 8 * fq;
        const float* bg = bgu + e * 2048 + cih;
        const f32x4 bg0 = *(const f32x4*)(bg), bg1 = *(const f32x4*)(bg + 4), bu0 = *(const f32x4*)(bg + 1024), bu1 = *(const f32x4*)(bg + 1028);
#pragma unroll
        for (int ai = 0; ai < 2; ++ai)
#pragma unroll
            for (int m = 0; m < 4; ++m) {
                constexpr float RS = 1.f / (F8_SX * F8_SWG);
                const f32x4 g0 = acc[ai][0][m][0] * RS + bg0, g1 = acc[ai][0][m][1] * RS + bg1, u0 = acc[ai][1][m][0] * RS + bu0, u1 = acc[ai][1][m][1] * RS + bu1;
                float r[8];
#pragma unroll
                for (int i = 0; i < 8; ++i) {
                    float g = i < 4 ? g0[i & 3] : g1[i & 3], uu = i < 4 ? u0[i & 3] : u1[i & 3];
                    g = fminf(g, 7.0f); uu = fminf(fmaxf(uu, -7.0f), 7.0f);
                    const float sg = __builtin_amdgcn_rcpf(1.0f + ex2(-1.702f * LOG2E * g));
                    r[i] = (uu + 1.0f) * g * sg * F8_SA;
                }
                v2u w; w.x = pk4_fp8(r[0], r[1], r[2], r[3]); w.y = pk4_fp8(r[4], r[5], r[6], r[7]);
                *(v2u*)(act + (size_t)(row0 + ai * 128 + m * 16) * DM + cih) = w;
            }
    }
};
struct EpiDown {
    static constexpr bool PERM = true, AFTER_DRAIN = false;
    bf16* yr; const float* bdn;
    DI void operator()(const pg8::f32x4 (&acc)[2][2][4][2], const pg8::Unit& u, int wr, int wc, int fr, int fq) const {
        const int e = u.pn >> 2, pl = u.pn & 3;
        const int row0 = u.pm * 256 + wr * 64 + fr, col0 = pl * 256 + wc * 32 + 8 * fq;
        f32x4 bv[2][2];
#pragma unroll
        for (int bj = 0; bj < 2; ++bj) { bv[bj][0] = *(const f32x4*)(bdn + e * 1024 + col0 + bj * 128); bv[bj][1] = *(const f32x4*)(bdn + e * 1024 + col0 + bj * 128 + 4); }
#pragma unroll
        for (int ai = 0; ai < 2; ++ai)
#pragma unroll
            for (int m = 0; m < 4; ++m) {
                bf16* rp = yr + (size_t)(row0 + ai * 128 + m * 16) * DM + col0;
#pragma unroll
                for (int bj = 0; bj < 2; ++bj) {
                    constexpr float RS = 1.f / (F8_SA * F8_SWD);
                    const f32x4 v0 = acc[ai][bj][m][0] * RS + bv[bj][0], v1 = acc[ai][bj][m][1] * RS + bv[bj][1];
                    v4u w; w.x = cvtpk(v0[0], v0[1]); w.y = cvtpk(v0[2], v0[3]); w.z = cvtpk(v1[0], v1[1]); w.w = cvtpk(v1[2], v1[3]);
                    *(v4u*)(rp + bj * 128) = w;
                }
            }
    }
};
struct GroupOrder {
    LAS const unsigned* tile_e; int ntiles, lg, G, c;
    DI bool next(int i, pg8::Unit& u) const {
        int pm, pl;
        if (G == 256) {
            const int x = c & 7, k = c >> 3; pm = i * (256 >> lg) + x * (32 >> lg) + (k >> lg); pl = k & ((1 << lg) - 1); if (pm >= ntiles) return false; }
        else { const long L = (long)i * G + c; if (L >= ((long)ntiles << lg)) return false; pm = (int)(L >> lg); pl = (int)(L & ((1 << lg) - 1)); }
        const int e = __builtin_amdgcn_readfirstlane((int)tile_e[pm]);
        u.pm = pm; u.pn = (e << lg) + pl; return true;
    }
    DI void a_ready(const pg8::Unit&) const {}
    DI void done(const pg8::Unit&) const {}
};
struct Args { const float* in[18]; float* out; unsigned char* ws; int ph_lo, ph_hi; };
struct Fr { LAS unsigned char* lds; unsigned char* ws; unsigned* ctl; int tid, lane, wave, blk, G; };

DI void tr_item(const float* W, int ldw, int K, int k0, int sc0, int nvalid, bf16* WT, int drow0, LAS float* scr, int lane) {
    const int c = lane & 31;
    float v[32];
#pragma unroll
    for (int i = 0; i < 32; ++i) v[i] = (c < nvalid) ? W[(size_t)(k0 + 2 * i + (lane >> 5)) * ldw + sc0 + c] : 0.f;
#pragma unroll
    for (int i = 0; i < 32; ++i) scr[(2 * i + (lane >> 5)) * 33 + c] = v[i];
    LDS_WAIT(); asm volatile("" ::: "memory");
    const int c8 = lane & 7;
#pragma unroll
    for (int j = 0; j < 4; ++j) { const int n = (lane >> 3) + 8 * j; const LAS float* s = scr + (8 * c8) * 33 + n;
        v4u o; o.x = cvtpk(s[0 * 33], s[1 * 33]); o.y = cvtpk(s[2 * 33], s[3 * 33]); o.z = cvtpk(s[4 * 33], s[5 * 33]); o.w = cvtpk(s[6 * 33], s[7 * 33]);
        *(v4u*)(WT + (size_t)(drow0 + n) * K + k0 + 8 * c8) = o; }
    LDS_WAIT(); asm volatile("" ::: "memory");
}
DI void tr_item8(const float* W, int ldw, int K, int k0, int sc0, float scale, unsigned char* WT8, int drow0, LAS float* scr, int lane) {
    const int c = lane & 31;
    float v[32];
#pragma unroll
    for (int i = 0; i < 32; ++i) v[i] = W[(size_t)(k0 + 2 * i + (lane >> 5)) * ldw + sc0 + c];
#pragma unroll
    for (int i = 0; i < 32; ++i) scr[(2 * i + (lane >> 5)) * 33 + c] = v[i] * scale;
    LDS_WAIT(); asm volatile("" ::: "memory");
    const int c16 = lane & 3;
#pragma unroll
    for (int j = 0; j < 2; ++j) { const int n = (lane >> 2) + 16 * j; const LAS float* s = scr + (16 * c16) * 33 + n;
        v4u o; o.x = pk4_fp8(s[0 * 33], s[1 * 33], s[2 * 33], s[3 * 33]); o.y = pk4_fp8(s[4 * 33], s[5 * 33], s[6 * 33], s[7 * 33]);
        o.z = pk4_fp8(s[8 * 33], s[9 * 33], s[10 * 33], s[11 * 33]); o.w = pk4_fp8(s[12 * 33], s[13 * 33], s[14 * 33], s[15 * 33]);
        *(v4u*)(WT8 + (size_t)(drow0 + n) * K + k0 + 16 * c16) = o; }
    LDS_WAIT(); asm volatile("" ::: "memory");
}
DI void ph_prologue(const Args& a, const Fr& F) {
    LAS float* scr = (LAS float*)(F.lds + F.wave * 16384);
    const int gw = F.blk * NWAVES + F.wave, NGW = F.G * NWAVES;
    constexpr int I_EV = 2 * 16 * 80, I_OD = 2 * 16 * 96, I_WO = 4 * 16 * 32, I_GU = 128 * 16 * 64, I_DN = 128 * 16 * 32;
    constexpr int NITEMS = I_EV + I_OD + I_WO + I_GU + I_DN;
    bf16* wev = (bf16*)(F.ws + WS_WEV); bf16* wod = (bf16*)(F.ws + WS_WOD); bf16* wout = (bf16*)(F.ws + WS_WOUT);
    unsigned char* wgu = F.ws + WS_WGU; unsigned char* wdn = F.ws + WS_WDN;
    for (int it = gw; it < NITEMS; it += NGW) {
        int r = it;
        if (r < I_EV) { const int l = r / 1280; r %= 1280; const int kb = r / 80, n0 = (r % 80) * 32; int sc0, nv = 32;
            if (n0 < 512) sc0 = n0; else if (n0 < 1024) sc0 = 964 + (n0 - 512); else if (n0 < 1536) sc0 = 1476 + (n0 - 1024); else if (n0 < 2048) sc0 = 1988 + (n0 - 1536);
            else if (n0 < 2176) sc0 = 512 + (n0 - 2048); else if (n0 < 2432) sc0 = 640 + (n0 - 2176); else if (n0 < 2496) sc0 = 896 + (n0 - 2432);
            else if (n0 < 2528) { sc0 = 960; nv = 4; } else { sc0 = 0; nv = 0; }
            tr_item(a.in[1] + (size_t)l * 1024 * 2500, 2500, 1024, kb * 64, sc0, nv, wev + (size_t)l * EV_N * 1024, n0, scr, F.lane); continue; }
        r -= I_EV;
        if (r < I_OD) { const int l = r / 1536; r %= 1536; const int kb = r / 96, n0 = (r % 96) * 32;
            tr_item(a.in[6] + (size_t)l * 1024 * 3088, 3088, 1024, kb * 64, n0, 32, wod + (size_t)l * OD_N * 1024, n0, scr, F.lane); continue; }
        r -= I_OD;
        if (r < I_WO) { const int l = r / 512; r %= 512; const int kb = r / 32, n0 = (r % 32) * 32;
            const float* src = (l & 1) ? a.in[8] + (size_t)(l >> 1) * 1024 * 1024 : a.in[5] + (size_t)(l >> 1) * 1024 * 1024;
            tr_item(src, 1024, 1024, kb * 64, n0, 32, wout + (size_t)l * 1024 * 1024, n0, scr, F.lane); continue; }
        r -= I_WO;
        if (r < I_GU) { const int le = r / 1024; r %= 1024; const int kb = r / 64, n0 = (r % 64) * 32;
            const int pn = n0 >> 8, bj = (n0 >> 7) & 1, j0 = n0 & 127;
            tr_item8(a.in[14] + (size_t)le * 1024 * 2048, 2048, 1024, kb * 64, bj * 1024 + pn * 128 + j0, F8_SWG, wgu + (size_t)le * 2048 * 1024, n0, scr, F.lane); continue; }
        r -= I_GU;
        { const int le = r / 512; r %= 512; const int kb = r / 32, n0 = (r % 32) * 32;
            tr_item8(a.in[16] + (size_t)le * 1024 * 1024, 1024, 1024, kb * 64, n0, F8_SWD, wdn + (size_t)le * 1024 * 1024, n0, scr, F.lane); }
    }
    bf16* xb = (bf16*)(F.ws + WS_XB);
    for (int m = gw; m < NTOK; m += NGW) {
        const f32x4* xr = (const f32x4*)(a.in[0] + (size_t)m * DM) + F.lane; v2u* o = (v2u*)(xb + (size_t)m * DM) + F.lane;
#pragma unroll
        for (int j = 0; j < 4; ++j) { const f32x4 v = xr[64 * j]; v2u w; w.x = cvtpk(v[0], v[1]); w.y = cvtpk(v[2], v[3]); o[64 * j] = w; }
    }
    bf16* wukt = (bf16*)(F.ws + WS_WUKT); bf16* wuvt = (bf16*)(F.ws + WS_WUVT);
    for (int i = F.blk * NTHR + F.tid; i < 2 * 8 * 128 * 64; i += F.G * NTHR) {
        { const int d = i & 63, c = (i >> 6) & 127, lh = i >> 13; wukt[i] = (bf16)f2bf(a.in[2][((size_t)lh * 64 + d) * 128 + c]); }
        { const int c = i & 127, d = (i >> 7) & 63, lh = i >> 13; wuvt[i] = (bf16)f2bf(a.in[3][((size_t)lh * 128 + c) * 64 + d]); }
    }
}

DI void ln_row(f32x4 (&v)[4], const float* g, const float* b, int lane) {
    float s = 0.f;
#pragma unroll
    for (int j = 0; j < 4; ++j) s += (v[j][0] + v[j][1]) + (v[j][2] + v[j][3]);
    const float mean = wave_sum(s) * (1.f / DM); float s2 = 0.f;
#pragma unroll
    for (int j = 0; j < 4; ++j) { v[j] = v[j] - mean; s2 += (v[j][0] * v[j][0] + v[j][1] * v[j][1]) + (v[j][2] * v[j][2] + v[j][3] * v[j][3]); }
    const float rstd = 1.f / sqrtf(wave_sum(s2) * (1.f / DM) + LN_EPS);
#pragma unroll
    for (int j = 0; j < 4; ++j) { const f32x4 gg = *((const f32x4*)g + lane + 64 * j), bb = *((const f32x4*)b + lane + 64 * j); v[j] = v[j] * rstd * gg + bb; }
}
DI void store_row_f32(float* p, const f32x4 (&v)[4], int lane) {
#pragma unroll
    for (int j = 0; j < 4; ++j) *((f32x4*)p + lane + 64 * j) = v[j];
}
DI void store_row_bf16(bf16* p, const f32x4 (&v)[4], int lane) {
#pragma unroll
    for (int j = 0; j < 4; ++j) { v2u w; w.x = cvtpk(v[j][0], v[j][1]); w.y = cvtpk(v[j][2], v[j][3]); *((v2u*)p + lane + 64 * j) = w; }
}
template <int NL> DI void small_proj(LAS const float* xs, const float* W, int ldw, int lane, float (&acc)[4]) {
    constexpr int PARTS = 64 / NL, DPER = 1024 / PARTS;
    const int n = lane & (NL - 1), part = lane / NL;
    acc[0] = acc[1] = acc[2] = acc[3] = 0.f;
    const float* wp = W + (size_t)(part * DPER) * ldw + n;
    LAS const float* xp = xs + part * DPER;
#pragma unroll 8
    for (int d = 0; d < DPER; ++d) { const float w = wp[(size_t)d * ldw];
        acc[0] += w * xp[d]; acc[1] += w * xp[1024 + d]; acc[2] += w * xp[2048 + d]; acc[3] += w * xp[3072 + d]; }
#pragma unroll
    for (int o = NL; o < 64; o <<= 1) {
#pragma unroll
        for (int k = 0; k < 4; ++k) acc[k] += __shfl_xor(acc[k], o); }
}

DI void ph_even_prep(const Args& a, const Fr& F, int j) {
    const bf16* proj = (const bf16*)(F.ws + WS_PROJ);
    bf16* ckvn = (bf16*)(F.ws + WS_CKVN); bf16* ql = (bf16*)(F.ws + WS_QL); float* kbar = (float*)(F.ws + WS_KBAR);
    const float* kvg = a.in[4] + j * 128;
    const bf16* wukt = (const bf16*)(F.ws + WS_WUKT) + (size_t)j * 8 * 128 * 64;
    const int lane = F.lane, wave = F.wave;
    for (int chunk = F.blk; chunk < 256; chunk += F.G) {
        const int tok0 = chunk * 128;
#pragma unroll 1
        for (int i0 = 0; i0 < 16; i0 += 8) { unsigned wv[8];
#pragma unroll
            for (int i = 0; i < 8; ++i) wv[i] = *((const unsigned*)(proj + (size_t)(tok0 + wave * 16 + i0 + i) * EV_N + EC_CKV) + lane);
#pragma unroll
            for (int i = 0; i < 8; ++i) { const int tok = tok0 + wave * 16 + i0 + i; const float v0 = bf2f(wv[i] & 0xffffu), v1 = bf2f(wv[i] >> 16);
                const float ss = wave_sum(v0 * v0 + v1 * v1);
                const float r = 1.f / sqrtf(ss * (1.f / 128.f) + LN_EPS);
                *((unsigned*)(ckvn + (size_t)tok * 128) + lane) = cvtpk(v0 * r * kvg[2 * lane], v1 * r * kvg[2 * lane + 1]); } }
        { bf16* kic = (bf16*)(F.ws + WS_KIC); const int tok = tok0 + wave * 16 + (lane >> 2), c = (lane & 3) * 16;
            const v4u* src = (const v4u*)(proj + (size_t)tok * EV_N + EC_KI + c); v4u* dst = (v4u*)(kic + (size_t)tok * 64 + c); dst[0] = src[0]; dst[1] = src[1]; }
        { const int h = wave, l15 = lane & 15, kg = lane >> 4;
            bf16x8 af[8][2];
#pragma unroll
            for (int ct = 0; ct < 8; ++ct)
#pragma unroll
                for (int ks = 0; ks < 2; ++ks) af[ct][ks] = *(const bf16x8*)(wukt + ((size_t)h * 128 + ct * 16 + l15) * 64 + ks * 32 + kg * 8);
#pragma unroll 1
            for (int tg = 0; tg < 8; tg += 4) { bf16x8 qf[4][2];
#pragma unroll
                for (int u = 0; u < 4; ++u)
#pragma unroll
                    for (int ks = 0; ks < 2; ++ks) qf[u][ks] = *(const bf16x8*)(proj + (size_t)(tok0 + (tg + u) * 16 + l15) * EV_N + EC_QA + h * 64 + ks * 32 + kg * 8);
#pragma unroll
                for (int u = 0; u < 4; ++u) { const int tok = tok0 + (tg + u) * 16 + l15;
#pragma unroll
                    for (int ct = 0; ct < 8; ++ct) { f32x4 d = {0.f, 0.f, 0.f, 0.f};
                        d = mfma16(af[ct][0], qf[u][0], d); d = mfma16(af[ct][1], qf[u][1], d);
                        v2u w; w.x = cvtpk(d[0], d[1]); w.y = cvtpk(d[2], d[3]);
                        *(v2u*)(ql + (size_t)tok * 1024 + h * 128 + ct * 16 + 4 * kg) = w; } } } }
        if (chunk < 128) { const int b = chunk >> 5, n = chunk & 31; float s8[8];
#pragma unroll
            for (int k = 0; k < 8; ++k) s8[k] = 0.f;
            const bf16* kp = proj + ((size_t)b * SEQ + n * 256 + wave * 32) * EV_N + EC_KB + lane * 8;
#pragma unroll 8
            for (int r = 0; r < 32; ++r) { const v4u w = *(const v4u*)(kp + (size_t)r * EV_N);
#pragma unroll
                for (int k = 0; k < 4; ++k) { s8[2 * k] += bf2f(w[k] & 0xffffu); s8[2 * k + 1] += bf2f(w[k] >> 16); } }
            LAS float* red = (LAS float*)F.lds;
            __syncthreads();
#pragma unroll
            for (int k = 0; k < 8; ++k) red[wave * 512 + lane * 8 + k] = s8[k];
            __syncthreads();
            float s = 0.f;
#pragma unroll
            for (int w = 0; w < 8; ++w) s += red[w * 512 + F.tid];
            const int h = F.tid >> 6, d = F.tid & 63;
            kbar[(((size_t)b * 8 + h) * 32 + n) * 64 + d] = s * (1.f / 256.f); }
    }
}

DI void moba_gate_chunk(const Fr& F, int chunk) {
    const bf16* proj = (const bf16*)(F.ws + WS_PROJ); const float* kbar = (const float*)(F.ws + WS_KBAR); unsigned* sel3 = (unsigned*)(F.ws + WS_SEL3);
    const int tok0 = chunk * 128, b = tok0 / SEQ, own = (tok0 % SEQ) >> 8, h = F.wave, lane = F.lane;
    float q0[64], q1[64];
    { const v4u* p0 = (const v4u*)(proj + (size_t)(tok0 + lane) * EV_N + EC_QB + h * 64); const v4u* p1 = (const v4u*)(proj + (size_t)(tok0 + 64 + lane) * EV_N + EC_QB + h * 64);
#pragma unroll
        for (int i = 0; i < 8; ++i) { const v4u w0 = p0[i], w1 = p1[i];
#pragma unroll
            for (int k = 0; k < 4; ++k) { q0[8 * i + 2 * k] = bf2f(w0[k] & 0xffffu); q0[8 * i + 2 * k + 1] = bf2f(w0[k] >> 16); q1[8 * i + 2 * k] = bf2f(w1[k] & 0xffffu); q1[8 * i + 2 * k + 1] = bf2f(w1[k] >> 16); } } }
    float a0 = -INFINITY, a1 = -INFINITY, a2 = -INFINITY, c0 = -INFINITY, c1 = -INFINITY, c2 = -INFINITY; int ai0 = 0, ai1 = 0, ai2 = 0, ci0 = 0, ci1 = 0, ci2 = 0;
    const float* kb = kbar + (((size_t)b * 8 + h) * 32) * 64;
    for (int n = 0; n < own; ++n) { float g0 = 0.f, g1 = 0.f;
#pragma unroll
        for (int d = 0; d < 64; d += 4) { const f32x4 kv = *(const f32x4*)(kb + n * 64 + d);
#pragma unroll
            for (int k = 0; k < 4; ++k) { g0 += q0[d + k] * kv[k]; g1 += q1[d + k] * kv[k]; } }
        if (g0 > a2) { if (g0 > a1) { a2 = a1; ai2 = ai1; if (g0 > a0) { a1 = a0; ai1 = ai0; a0 = g0; ai0 = n; } else { a1 = g0; ai1 = n; } } else { a2 = g0; ai2 = n; } }
        if (g1 > c2) { if (g1 > c1) { c2 = c1; ci2 = ci1; if (g1 > c0) { c1 = c0; ci1 = ci0; c0 = g1; ci0 = n; } else { c1 = g1; ci1 = n; } } else { c2 = g1; ci2 = n; } }
    }
    const unsigned nv = own < 3 ? own : 3;
    sel3[(size_t)(tok0 + lane) * 8 + h] = (unsigned)ai0 | ((unsigned)ai1 << 8) | ((unsigned)ai2 << 16) | (nv << 24);
    sel3[(size_t)(tok0 + 64 + lane) * 8 + h] = (unsigned)ci0 | ((unsigned)ci1 << 8) | ((unsigned)ci2 << 16) | (nv << 24);
}

constexpr int HS = 257;
DI float relu1(float x) { const unsigned u = __float_as_uint(x); return __uint_as_float(u & ~(unsigned)((int)u >> 31)); }
template <int MODE, bool DIAG> DI void idx_tile(const bf16x8 (&kf)[4], LAS const char* qb  , const float (&wj)[4], int kt, int q, int hi, unsigned c0, unsigned c1,
                                     LAS unsigned* hist, LAS unsigned* mask, LAS unsigned* cmask, LAS unsigned long long* cand, LAS unsigned* rinfo) {
    f32x2 scp[8];
#pragma unroll
    for (int p = 0; p < 8; ++p) scp[p] = (f32x2){0.f, 0.f};
#pragma unroll
    for (int j = 0; j < 4; ++j) { f32x16 acc;
#pragma unroll
        for (int r = 0; r < 16; ++r) acc[r] = 0.f;
#pragma unroll
        for (int s = 0; s < 4; ++s) acc = mfma32(kf[s], *(LAS const bf16x8*)(qb + (j * 8 + s * 2) * 512), acc);
        const f32x2 w2 = {wj[j], wj[j]};
#pragma unroll
        for (int p = 0; p < 8; ++p) { const f32x2 a = {relu1(acc[2 * p]), relu1(acc[2 * p + 1])};
            scp[p] = a * w2 + scp[p]; } }
    unsigned sel = 0u, cnd = 0u;
    const float F0 = __uint_as_float(c0), F1 = __uint_as_float(c1);
#pragma unroll
    for (int r = 0; r < 16; ++r) { const int kr = crow(r, hi);
        const bool ok = !DIAG || kr <= q;
        const float scv = scp[r >> 1][r & 1]; const unsigned u = __float_as_uint(scv);
        if (MODE == 1) { const unsigned key = u ^ ((unsigned)((int)u >> 31) | 0x80000000u);
            if (ok && (key >> 24) >= c0) __hip_atomic_fetch_add(hist + q * HS + (key >> 24), 1u, __ATOMIC_RELAXED, __HIP_MEMORY_SCOPE_WORKGROUP); }
        else if (MODE == 2) { if (ok && (u >> 24) == c0) __hip_atomic_fetch_add(hist + q * HS + (((u >> 16) & 255u) ^ c1), 1u, __ATOMIC_RELAXED, __HIP_MEMORY_SCOPE_WORKGROUP); }
        else { const bool ge1 = scv >= F1, ge0 = scv >= F0;
            if (ok && ge1) sel |= 1u << kr;
            if (ok && ge0 && !ge1) { cnd |= 1u << kr; const unsigned key = u ^ ((unsigned)((int)u >> 31) | 0x80000000u);
                const unsigned pos = __hip_atomic_fetch_add(rinfo + 128 + q, 1u, __ATOMIC_RELAXED, __HIP_MEMORY_SCOPE_WORKGROUP);
                if (pos < 64u) cand[q * 64 + pos] = ((unsigned long long)key << 32) | (unsigned)(~(unsigned)(kt * 32 + kr)); } } }
    if (MODE == 3) { if (sel) __hip_atomic_fetch_or(mask + q * HS + kt, sel, __ATOMIC_RELAXED, __HIP_MEMORY_SCOPE_WORKGROUP);
        if (cnd) __hip_atomic_fetch_or(cmask + q * HS + kt, cnd, __ATOMIC_RELAXED, __HIP_MEMORY_SCOPE_WORKGROUP); }
}
template <int MODE> DI void idx_pass(const bf16* proj, int rowbase, int qt, LAS const char* qimg, const float (&wj)[4], LAS unsigned* hist, LAS unsigned* mask, LAS unsigned* cmask, LAS unsigned long long* cand, LAS unsigned* rinfo, int wave, int lane) {
    const int q = lane & 31, hi = lane >> 5, nkt = qt + 1;
    const unsigned b1 = MODE == 2 ? rinfo[160 + q] : rinfo[224 + q], thr16 = MODE == 2 ? rinfo[192 + q] : rinfo[256 + q];
    const bf16* kp0 = proj + (size_t)(rowbase + q) * 64 + hi * 8;
    LAS const char* qb = qimg + hi * 512 + q * 16;
    const int n = nkt > wave ? (nkt - wave + 7) >> 3 : 0;
    bf16x8 kfa[4], kfb[4], kfc[4];
#define IDX_LOAD(KF, I) do { const bf16* kp_ = kp0 + (size_t)((wave + 8 * (I)) * 32) * 64; _Pragma("unroll") for (int s_ = 0; s_ < 4; ++s_) KF[s_] = *(const bf16x8*)(kp_ + s_ * 16); } while (0)
#define IDX_TILE(KF, I) do { const int kt_ = wave + 8 * (I); if (kt_ == qt) idx_tile<MODE, true>(KF, qb, wj, kt_, q, hi, b1, thr16, hist, mask, cmask, cand, rinfo); \
        else idx_tile<MODE, false>(KF, qb, wj, kt_, q, hi, b1, thr16, hist, mask, cmask, cand, rinfo); } while (0)
    if (n > 0) IDX_LOAD(kfa, 0);
    if (n > 1) IDX_LOAD(kfb, 1);
    for (int i = 0; i < n; i += 3) {
        if (i + 2 < n) IDX_LOAD(kfc, i + 2);
        IDX_TILE(kfa, i);
        if (i + 1 < n) { if (i + 3 < n) IDX_LOAD(kfa, i + 3); IDX_TILE(kfb, i + 1); }
        if (i + 2 < n) { if (i + 4 < n) IDX_LOAD(kfb, i + 4); IDX_TILE(kfc, i + 2); }
    }
#undef IDX_LOAD
#undef IDX_TILE
}
DI void hist_pick(LAS const unsigned* hrow, unsigned need, int lane, unsigned& bin, unsigned& above) {
    unsigned h4[4];
#pragma unroll
    for (int k = 0; k < 4; ++k) h4[k] = hrow[4 * lane + k];
    const unsigned ssum = h4[0] + h4[1] + h4[2] + h4[3];
    unsigned x = ssum;
#pragma unroll
    for (int o = 1; o < 64; o <<= 1) { const unsigned y = __shfl_down(x, o); if (lane + o < 64) x += y; }
    const unsigned long long m = __ballot(x >= need);
    const int Ls = m ? 63 - __builtin_clzll(m) : 0;
    const unsigned xs = __shfl(x, Ls), ss = __shfl(ssum, Ls);
    const unsigned h0 = __shfl(h4[0], Ls), h1 = __shfl(h4[1], Ls), h2 = __shfl(h4[2], Ls), h3 = __shfl(h4[3], Ls);
    unsigned cum = xs - ss;
    if (cum + h3 >= need) { bin = 4 * Ls + 3; above = cum; return; } cum += h3;
    if (cum + h2 >= need) { bin = 4 * Ls + 2; above = cum; return; } cum += h2;
    if (cum + h1 >= need) { bin = 4 * Ls + 1; above = cum; return; } cum += h1;
    bin = 4 * Ls; above = cum; (void)h0;
}
DI void idx_pass1(const bf16* proj, int rowbase, int qt, LAS const char* qimg, const float (&wj)[4], LAS unsigned* hist, LAS unsigned* mask, LAS unsigned* cmask, LAS unsigned long long* cand, LAS unsigned* rinfo, int wave, int lane) {
    const int q = lane & 31, hi = lane >> 5, nkt = qt + 1, nmax = (nkt + 7) >> 3;
    const bf16* kp0 = proj + (size_t)(rowbase + q) * 64 + hi * 8;
    LAS const char* qb = qimg + hi * 512 + q * 16;
    unsigned lb = 0u;
    bf16x8 kfc[4], kfn[4];
    if (wave < nkt) {
#pragma unroll
        for (int s = 0; s < 4; ++s) kfc[s] = *(const bf16x8*)(kp0 + (size_t)(wave * 32) * 64 + s * 16); }
    for (int i = 0; i < nmax; ++i) { const int kt = wave + 8 * i;
        if (kt + 8 < nkt) {
#pragma unroll
            for (int s = 0; s < 4; ++s) kfn[s] = *(const bf16x8*)(kp0 + (size_t)((kt + 8) * 32) * 64 + s * 16); }
        if (kt < nkt) { if (kt == qt) idx_tile<1, true>(kfc, qb, wj, kt, q, hi, lb, 0u, hist, mask, cmask, cand, rinfo); else idx_tile<1, false>(kfc, qb, wj, kt, q, hi, lb, 0u, hist, mask, cmask, cand, rinfo); }
#pragma unroll
        for (int s = 0; s < 4; ++s) kfc[s] = kfn[s];
        if (((i + 1) & i) == 0 && i + 1 < nmax && i < 16) {
            __syncthreads();
#pragma unroll 1
            for (int rr = 0; rr < 4; ++rr) { const int row = wave * 4 + rr; unsigned bin, above; hist_pick(hist + row * HS, 256u, lane, bin, above);
                if (lane == 0) rinfo[288 + row] = bin; }
            __syncthreads();
            { const unsigned nb = rinfo[288 + q]; lb = nb > lb ? nb : lb; } }
    }
}
DI void idx_unit(const Fr& F, int b, int qt) {
    const bf16* proj = (const bf16*)(F.ws + WS_PROJ); const bf16* kic = (const bf16*)(F.ws + WS_KIC); unsigned short* sel = (unsigned short*)(F.ws + WS_SEL);
    LAS unsigned* hist = (LAS unsigned*)(F.lds); LAS unsigned* mask = hist + 32 * HS; LAS unsigned* cmask = mask + 32 * HS;
    LAS unsigned long long* cand = (LAS unsigned long long*)(F.lds + 99328); LAS unsigned* rinfo = (LAS unsigned*)(F.lds + 115712);
    const int lane = F.lane, wave = F.wave, tid = F.tid, t0 = qt * 32, rowbase = b * SEQ;
    __syncthreads();
    for (int i = tid; i < 3 * 32 * HS; i += NTHR) hist[i] = 0u;
    if (tid < 320) rinfo[tid] = 0u;
    __syncthreads();
    if (t0 + 31 <= 255 || (EXPF & 64)) {
        if (lane < 8) {
#pragma unroll
            for (int rr = 0; rr < 4; ++rr) { const int row = wave * 4 + rr, nv = t0 + row + 1;
                const int nv0 = t0 + row + 1; const int nvc = nv0 < 256 ? nv0 : 256; (void)nv; mask[row * HS + lane] = nvc >= 32 * (lane + 1) ? 0xffffffffu : (nvc > 32 * lane ? ((1u << (nvc - 32 * lane)) - 1u) : 0u); } }
    } else {
        const int q = lane & 31;
        float wj[4];
        { const bf16* qp = proj + (size_t)(rowbase + t0 + q) * EV_N;
#pragma unroll
            for (int j = 0; j < 4; ++j) wj[j] = bf2f(qp[EC_WI + j]); }
        LAS char* qimg = (LAS char*)(F.lds + 117248);
#pragma unroll
        for (int i = 0; i < 2; ++i) { const int p = tid + i * NTHR, row = p & 31, c = p >> 5;
            *(LAS v4u*)(qimg + c * 512 + row * 16) = *(const v4u*)(proj + (size_t)(rowbase + t0 + row) * EV_N + EC_QI + c * 8); }
        __syncthreads();
        idx_pass1(kic, rowbase, qt, qimg, wj, hist, mask, cmask, cand, rinfo, wave, lane);
        __syncthreads();
#pragma unroll 1
        for (int rr = 0; rr < 4; ++rr) { const int row = wave * 4 + rr; unsigned bin, above; hist_pick(hist + row * HS, 256u, lane, bin, above);
            if (lane == 0) { rinfo[row] = bin; rinfo[32 + row] = 256u - above; rinfo[160 + row] = bin >= 128u ? bin - 128u : 255u - bin; rinfo[192 + row] = bin >= 128u ? 0u : 255u; } }
        __syncthreads();
        for (int i = tid; i < 32 * HS; i += NTHR) hist[i] = 0u;
        __syncthreads();
        idx_pass<2>(kic, rowbase, qt, qimg, wj, hist, mask, cmask, cand, rinfo, wave, lane);
        __syncthreads();
#pragma unroll 1
        for (int rr = 0; rr < 4; ++rr) { const int row = wave * 4 + rr; const unsigned need1 = rinfo[32 + row]; unsigned bin, above; hist_pick(hist + row * HS, need1, lane, bin, above);
            if (lane == 0) { const unsigned t16 = (rinfo[row] << 8) | bin, k0 = t16 << 16, k1 = (t16 + 1u) << 16;
                rinfo[64 + row] = t16; rinfo[96 + row] = need1 - above;
                rinfo[224 + row] = (k0 & 0x80000000u) ? (k0 ^ 0x80000000u) : ~k0; rinfo[256 + row] = (t16 == 0xffffu) ? 0x7fc00000u : ((k1 & 0x80000000u) ? (k1 ^ 0x80000000u) : ~k1); } }
        __syncthreads();
        idx_pass<3>(kic, rowbase, qt, qimg, wj, hist, mask, cmask, cand, rinfo, wave, lane);
        __syncthreads();
#pragma unroll 1
        for (int rr = 0; rr < 4; ++rr) { const int row = wave * 4 + rr; const unsigned call = rinfo[128 + row], need2 = rinfo[96 + row];
            if (call <= 64u) { const unsigned c = call;
                const unsigned long long mine = cand[row * 64 + lane]; unsigned rank = 0u;
                for (unsigned k = 0; k < c; ++k) rank += (cand[row * 64 + k] > mine) ? 1u : 0u;
                if ((unsigned)lane < c && rank < need2) { const unsigned s = ~(unsigned)mine;
                    __hip_atomic_fetch_or(mask + row * HS + (s >> 5), 1u << (s & 31), __ATOMIC_RELAXED, __HIP_MEMORY_SCOPE_WORKGROUP); } }
            else { unsigned w4[4];
#pragma unroll
                for (int k = 0; k < 4; ++k) w4[k] = cmask[row * HS + 4 * lane + k];
                const unsigned cnt = __popc(w4[0]) + __popc(w4[1]) + __popc(w4[2]) + __popc(w4[3]);
                unsigned x = cnt;
#pragma unroll
                for (int o = 1; o < 64; o <<= 1) { const unsigned y = __shfl_up(x, o); if (lane >= o) x += y; }
                unsigned before = x - cnt;
#pragma unroll
                for (int k = 0; k < 4; ++k) { unsigned w = w4[k]; const unsigned pc = __popc(w); unsigned take = 0u;
                    if (before < need2) { if (before + pc <= need2) take = w; else { unsigned left = need2 - before; while (left) { const unsigned b = w & (0u - w); take |= b; w ^= b; --left; } } }
                    before += pc;
                    if (take) mask[row * HS + 4 * lane + k] |= take; } }
        }
    }
    __syncthreads();
#pragma unroll 1
    for (int rr = 0; rr < 4; ++rr) { const int row = wave * 4 + rr; unsigned short* out = sel + (size_t)(rowbase + t0 + row) * 256;
        unsigned w4[4];
#pragma unroll
        for (int k = 0; k < 4; ++k) w4[k] = mask[row * HS + 4 * lane + k];
        const unsigned cnt = __popc(w4[0]) + __popc(w4[1]) + __popc(w4[2]) + __popc(w4[3]);
        unsigned x = cnt;
#pragma unroll
        for (int o = 1; o < 64; o <<= 1) { const unsigned y = __shfl_up(x, o); if (lane >= o) x += y; }
        const unsigned total = __shfl(x, 63); unsigned pos = x - cnt;
#pragma unroll
        for (int k = 0; k < 4; ++k) { unsigned w = w4[k]; const unsigned base = (unsigned)(4 * lane + k) * 32u;
            while (w) { const unsigned bit = __builtin_ctz(w); if (pos < 256u) out[pos] = (unsigned short)(base + bit); ++pos; w &= w - 1u; } }
        for (unsigned i = total + lane; i < 256u; i += 64u) out[i] = (unsigned short)0xffffu; }
}

struct AttSt { float m, l; f32x16 o0, o1; };
template <class BF> DI void att_subtile(AttSt& S, const bf16x8 (&qf)[4], LAS const char* Kst, LAS const char* Vb, int vdh, int vrow0, int lane, const BF& bias) {
    const int r32 = lane & 31, hi = lane >> 5;
    f32x16 p;
#pragma unroll
    for (int r = 0; r < 16; ++r) p[r] = 0.f;
    LAS const char* kp = Kst + hi * 512 + r32 * 16;
#pragma unroll
    for (int s = 0; s < 4; ++s) { const bf16x8 kf = *(LAS const bf16x8*)(kp + s * 1024); p = mfma32(kf, qf[s], p); }
    float mxa[4] = {-INFINITY, -INFINITY, -INFINITY, -INFINITY};
#pragma unroll
    for (int r = 0; r < 16; ++r) { p[r] = bias(p[r], crow(r, hi)); mxa[r & 3] = fmaxf(mxa[r & 3], p[r]); }
    float mx = fmaxf(fmaxf(mxa[0], mxa[1]), fmaxf(mxa[2], mxa[3]));
    mx = fmaxf(mx, __shfl_xor(mx, 32));
    if (__any(mx > S.m + 16.f)) { const float mn = fmaxf(S.m, mx), sc = ex2(S.m - mn); S.m = mn; S.l *= sc;
#pragma unroll
        for (int r = 0; r < 16; ++r) { S.o0[r] *= sc; S.o1[r] *= sc; } }
    const float mn = S.m;
    float psa[4] = {0.f, 0.f, 0.f, 0.f};
#pragma unroll
    for (int r = 0; r < 16; ++r) { p[r] = ex2(p[r] - mn); psa[r & 3] += p[r]; }
    S.l += (psa[0] + psa[1]) + (psa[2] + psa[3]);
    v4u pw0, pw1;
    pw0.x = cvtpk(p[0], p[1]); pw0.y = cvtpk(p[2], p[3]); pw0.z = cvtpk(p[4], p[5]); pw0.w = cvtpk(p[6], p[7]);
    pw1.x = cvtpk(p[8], p[9]); pw1.y = cvtpk(p[10], p[11]); pw1.z = cvtpk(p[12], p[13]); pw1.w = cvtpk(p[14], p[15]);
    const bf16x8 pf0 = __builtin_bit_cast(bf16x8, pw0), pf1 = __builtin_bit_cast(bf16x8, pw1);
    LAS const char* vp = Vb + (vrow0 + 4 * hi + ((lane & 15) >> 2)) * 64 + ((lane >> 4) & 1) * 32 + (lane & 3) * 8;
    { const bf16x8 v00 = cat8(vtr(vp), vtr(vp + 512)), v10 = cat8(vtr(vp + vdh), vtr(vp + vdh + 512));
      const bf16x8 v01 = cat8(vtr(vp + 1024), vtr(vp + 1536)), v11 = cat8(vtr(vp + vdh + 1024), vtr(vp + vdh + 1536));
      S.o0 = mfma32(v00, pf0, S.o0); S.o1 = mfma32(v10, pf0, S.o1);
      S.o0 = mfma32(v01, pf1, S.o0); S.o1 = mfma32(v11, pf1, S.o1); }
}

struct MobaFar { float c; DI float operator()(float p, int) const { return p + c; } };
struct MobaBias { LAS const float* lut; int tq, s0; bool causal;
    DI float operator()(float p, int kvrel) const { const int dist = tq - (s0 + kvrel); const float v = p + lut[dist < 0 ? 0 : (dist > 1023 ? 1023 : dist)]; return (causal && dist < 0) ? -INFINITY : v; } };
DI void moba_qload(bf16x8 (&qf)[4], const bf16* proj, int rowbase, int h, int tq, int hi) {
    const bf16* qp = proj + (size_t)(rowbase + tq) * EV_N + EC_QB + h * 64 + hi * 8;
#pragma unroll
    for (int s = 0; s < 4; ++s) qf[s] = *(const bf16x8*)(qp + s * 16);
}
DI void moba_tile(const Fr& F, const bf16x8 (&qf)[4], int rowbase, int h, int n, int tq, bool valid, int slot, bool own, int wave_tile) {
    LAS const char* Kb = (LAS const char*)F.lds; LAS const char* Vb = (LAS const char*)(F.lds + 32768); LAS const float* lut = (LAS const float*)(F.lds + 98304);
    bf16* po = (bf16*)(F.ws + WS_ACT); float* pml = (float*)(F.ws + WS_PML);
    const int lane = F.lane, hi = lane >> 5;
    AttSt S; S.m = -1e30f; S.l = 0.f;
#pragma unroll
    for (int r = 0; r < 16; ++r) { S.o0[r] = 0.f; S.o1[r] = 0.f; }
    const int nst = own ? wave_tile + 1 : 8;
    int tmin = tq;
#pragma unroll
    for (int o = 1; o < 64; o <<= 1) { const int y = __shfl_xor(tmin, o); tmin = y < tmin ? y : tmin; }
    const float cfar = lut[1023];
    for (int st = 0; st < nst; ++st) {
        if (!own && tmin - (n * 256 + st * 32 + 31) >= 790) { MobaFar bf{cfar}; att_subtile(S, qf, Kb + st * 4096, Vb, 16384, st * 32, lane, bf); }
        else { MobaBias bf{lut, tq, n * 256 + st * 32, own && st == wave_tile}; att_subtile(S, qf, Kb + st * 4096, Vb, 16384, st * 32, lane, bf); } }
    const float lt = S.l + __shfl_xor(S.l, 32), inv = 1.f / lt;
    if (valid) { const size_t pi = ((size_t)(rowbase + tq) * 8 + h) * 4 + slot; bf16* o = po + pi * 64;
#pragma unroll
        for (int a4 = 0; a4 < 4; ++a4) { v2u w0, w1;
            w0.x = cvtpk(S.o0[4 * a4] * inv, S.o0[4 * a4 + 1] * inv); w0.y = cvtpk(S.o0[4 * a4 + 2] * inv, S.o0[4 * a4 + 3] * inv);
            w1.x = cvtpk(S.o1[4 * a4] * inv, S.o1[4 * a4 + 1] * inv); w1.y = cvtpk(S.o1[4 * a4 + 2] * inv, S.o1[4 * a4 + 3] * inv);
            *(v2u*)(o + 8 * a4 + 4 * hi) = w0; *(v2u*)(o + 32 + 8 * a4 + 4 * hi) = w1; }
        if (hi == 0) { f32x2 ml = {S.m, lt}; *(f32x2*)(pml + pi * 2) = ml; } }
}
DI void moba_unit(const Args& a, const Fr& F, int b, int h, int n) {
    const bf16* proj = (const bf16*)(F.ws + WS_PROJ); const unsigned* sel3 = (const unsigned*)(F.ws + WS_SEL3);
    LAS unsigned char* lds = F.lds; LAS unsigned* list = (LAS unsigned*)(lds + 65536); LAS float* lut = (LAS float*)(lds + 98304); LAS unsigned* misc = (LAS unsigned*)(lds + 102400);
    const int tid = F.tid, lane = F.lane, wave = F.wave, rowbase = b * SEQ;
    __syncthreads();
    { const bf16* kg = proj + (size_t)(rowbase + n * 256) * EV_N + EC_KB + h * 64; const bf16* vg = proj + (size_t)(rowbase + n * 256) * EV_N + EC_VB + h * 64;
#pragma unroll
        for (int i = 0; i < 4; ++i) { const int p = tid + i * NTHR;
            { const int r = p & 31, c = (p >> 5) & 7, st = p >> 8; const v4u v = *(const v4u*)(kg + (size_t)(st * 32 + r) * EV_N + c * 8); *(LAS v4u*)(lds + st * 4096 + c * 512 + r * 16) = v; }
            { const int cc = p & 3, row = (p >> 2) & 255, dh = p >> 10; const v4u v = *(const v4u*)(vg + (size_t)row * EV_N + dh * 32 + cc * 8); *(LAS v4u*)(lds + 32768 + dh * 16384 + row * 64 + cc * 16) = v; } }
        for (int d = tid; d < 1024; d += NTHR) lut[d] = a.in[9][t5_bucket(d) * 16 + 8 + h] * LOG2E; }
    if (tid == 0) misc[16] = 0u;
    __syncthreads();
    unsigned sv[16];
#pragma unroll
    for (int k = 0; k < 16; ++k) { const int t = (n + 1) * 256 + k * NTHR + tid; sv[k] = t < SEQ ? sel3[(size_t)(rowbase + t) * 8 + h] : 0u; }
#pragma unroll
    for (int k = 0; k < 16; ++k) { const int tb = (n + 1) * 256 + k * NTHR; if (tb < SEQ) { const int t = tb + tid;
        const unsigned s = sv[k]; const unsigned nv = s >> 24; int slot = -1;
        if (nv > 0u && (s & 255u) == (unsigned)n) slot = 0; else if (nv > 1u && ((s >> 8) & 255u) == (unsigned)n) slot = 1; else if (nv > 2u && ((s >> 16) & 255u) == (unsigned)n) slot = 2;
        const unsigned long long bal = __ballot(slot >= 0); const unsigned wcnt = __popcll(bal);
        if (lane == 0) misc[wave] = wcnt;
        __syncthreads();
        unsigned off = misc[16], tot = 0u;
#pragma unroll
        for (int w = 0; w < 8; ++w) { const unsigned c = misc[w]; if (w < wave) off += c; tot += c; }
        if (slot >= 0) list[off + __popcll(bal & ((1ull << lane) - 1ull))] = ((unsigned)t << 2) | (unsigned)slot;
        __syncthreads();
        if (tid == 0) misc[16] += tot; } }
    __syncthreads();
    const int nlist = (int)misc[16];
    const int ntl = (nlist + 31) >> 5, hi = lane >> 5;
    bf16x8 qa[4], qb2[4];
    moba_qload(qa, proj, rowbase, h, n * 256 + wave * 32 + (lane & 31), hi);
    unsigned ea = 0u, eb = 0u; bool va = false, vb = false;
    int tl = wave;
    if (tl < ntl) { const int li = tl * 32 + (lane & 31); vb = li < nlist; eb = list[vb ? li : nlist - 1]; moba_qload(qb2, proj, rowbase, h, (int)(eb >> 2), hi); }
    moba_tile(F, qa, rowbase, h, n, n * 256 + wave * 32 + (lane & 31), true, 3, true, wave);
    for (; tl < ntl; tl += 16) {
        const int t2 = tl + 8, t3 = tl + 16;
        if (t2 < ntl) { const int li = t2 * 32 + (lane & 31); va = li < nlist; ea = list[va ? li : nlist - 1]; moba_qload(qa, proj, rowbase, h, (int)(ea >> 2), hi); }
        moba_tile(F, qb2, rowbase, h, n, (int)(eb >> 2), vb, (int)(eb & 3u), false, 0);
        if (t2 < ntl) {
            if (t3 < ntl) { const int li = t3 * 32 + (lane & 31); vb = li < nlist; eb = list[vb ? li : nlist - 1]; moba_qload(qb2, proj, rowbase, h, (int)(eb >> 2), hi); }
            moba_tile(F, qa, rowbase, h, n, (int)(ea >> 2), va, (int)(ea & 3u), false, 0); }
    }
}

DI void dsa_step(const bf16x8 (&af)[2][4], const bf16x8 (&qlf)[4], int ch, LAS const unsigned char* bsel, LAS unsigned char* cbuf, LAS const float* tab,
                 float& m, float& l, f32x4 (&oT)[8], int l15, int kg, int lane) {
    f32x4 acc[2];
#pragma unroll
    for (int mt = 0; mt < 2; ++mt) { acc[mt] = (f32x4){0.f, 0.f, 0.f, 0.f};
#pragma unroll
        for (int ks = 0; ks < 4; ++ks) { acc[mt] = mfma16(af[mt][ks], qlf[ks], acc[mt]); *(LAS bf16x8*)(cbuf + (mt * 16 + l15) * 288 + (ks * 32 + kg * 8) * 2) = af[mt][ks]; } }
    float mx = -INFINITY;
#pragma unroll
    for (int mt = 0; mt < 2; ++mt) { const unsigned b4 = *(LAS const unsigned*)(bsel + ch * 32 + mt * 16 + 4 * kg);
#pragma unroll
        for (int i = 0; i < 4; ++i) { const unsigned bb = (b4 >> (8 * i)) & 255u;
            const float v = bb != 255u ? acc[mt][i] + tab[bb * 8 + (l15 & 7)] : -INFINITY; acc[mt][i] = v; mx = fmaxf(mx, v); } }
    mx = fmaxf(mx, __shfl_xor(mx, 16)); mx = fmaxf(mx, __shfl_xor(mx, 32));
    const float mn = fmaxf(m, mx), sc = ex2(m - mn); m = mn;
    float ps = 0.f;
#pragma unroll
    for (int mt = 0; mt < 2; ++mt)
#pragma unroll
        for (int i = 0; i < 4; ++i) { acc[mt][i] = ex2(acc[mt][i] - mn); ps += acc[mt][i]; }
    l = l * sc + ps;
#pragma unroll
    for (int ct = 0; ct < 8; ++ct) oT[ct] = oT[ct] * sc;
    v4u pw; pw.x = cvtpk(acc[0][0], acc[0][1]); pw.y = cvtpk(acc[0][2], acc[0][3]); pw.z = cvtpk(acc[1][0], acc[1][1]); pw.w = cvtpk(acc[1][2], acc[1][3]);
    const bf16x8 pf = __builtin_bit_cast(bf16x8, pw);
    LDS_WAIT();
    LAS const char* tp = (LAS const char*)cbuf + (4 * kg + (l15 >> 2)) * 288 + (lane & 3) * 8;
#pragma unroll
    for (int ct = 0; ct < 8; ++ct) { const bf16x8 cf = cat8(vtr(tp + ct * 32), vtr(tp + 16 * 288 + ct * 32)); oT[ct] = mfma16(cf, pf, oT[ct]); }
    LDS_WAIT();
}
DI void dsa_gather(bf16x8 (&af)[2][4], const bf16* ckvn, int rowbase, LAS const unsigned short* selb, int ch, int l15, int kg) {
#pragma unroll
    for (int mt = 0; mt < 2; ++mt) { unsigned idx = selb[ch * 32 + mt * 16 + l15]; if (idx == 0xffffu) idx = 0u;
        const bf16* cp = ckvn + (size_t)(rowbase + (int)idx) * 128 + kg * 8;
#pragma unroll
        for (int ks = 0; ks < 4; ++ks) af[mt][ks] = *(const bf16x8*)(cp + ks * 32); }
}
DI void dsa_query(const Fr& F, int tok, const v2u sv, LAS unsigned char* wl, LAS const unsigned char* bkt, LAS const float* tab) {
    const bf16* ql = (const bf16*)(F.ws + WS_QL); const bf16* ckvn = (const bf16*)(F.ws + WS_CKVN); const unsigned short* sel = (const unsigned short*)(F.ws + WS_SEL); bf16* ol = (bf16*)(F.ws + WS_OL);
    const int lane = F.lane, l15 = lane & 15, kg = lane >> 4, t = tok % SEQ, rowbase = tok - t;
    LAS unsigned short* selb = (LAS unsigned short*)wl; LAS unsigned char* bsel = wl + 512; LAS unsigned char* cbuf = wl + 1024;
    { *((LAS v2u*)selb + lane) = sv; unsigned bw = 0u;
#pragma unroll
        for (int i = 0; i < 4; ++i) { const unsigned s = (i < 2 ? (sv.x >> (16 * i)) : (sv.y >> (16 * (i - 2)))) & 0xffffu; const int dist = t - (int)s;
            const unsigned bb = (s != 0xffffu && dist >= 0) ? (unsigned)bkt[dist > 1023 ? 1023 : dist] : 255u; bw |= bb << (8 * i); }
        *((LAS unsigned*)bsel + lane) = bw; }
    bf16x8 qlf[4];
#pragma unroll
    for (int ks = 0; ks < 4; ++ks) { qlf[ks] = *(const bf16x8*)(ql + (size_t)tok * 1024 + (l15 & 7) * 128 + ks * 32 + kg * 8); if (l15 >= 8) qlf[ks] = (bf16x8){0, 0, 0, 0, 0, 0, 0, 0}; }
    float m = -1e30f, l = 0.f; f32x4 oT[8];
#pragma unroll
    for (int ct = 0; ct < 8; ++ct) oT[ct] = (f32x4){0.f, 0.f, 0.f, 0.f};
    const int nvalid = t + 1 < 256 ? t + 1 : 256, nch = (nvalid + 31) >> 5;
    LDS_WAIT();
    bf16x8 afa[2][4], afb[2][4], afc[2][4];
    dsa_gather(afa, ckvn, rowbase, selb, 0, l15, kg);
    if (nch > 1) dsa_gather(afb, ckvn, rowbase, selb, 1, l15, kg);
    for (int ch = 0; ch < nch; ch += 3) {
        if (ch + 2 < nch) dsa_gather(afc, ckvn, rowbase, selb, ch + 2, l15, kg);
        dsa_step(afa, qlf, ch, bsel, cbuf, tab, m, l, oT, l15, kg, lane);
        if (ch + 1 < nch) { if (ch + 3 < nch) dsa_gather(afa, ckvn, rowbase, selb, ch + 3, l15, kg);
            dsa_step(afb, qlf, ch + 1, bsel, cbuf, tab, m, l, oT, l15, kg, lane); }
        if (ch + 2 < nch) { if (ch + 4 < nch) dsa_gather(afb, ckvn, rowbase, selb, ch + 4, l15, kg);
            dsa_step(afc, qlf, ch + 2, bsel, cbuf, tab, m, l, oT, l15, kg, lane); }
    }
    l += __shfl_xor(l, 16); l += __shfl_xor(l, 32);
    const float inv = 1.f / l;
    if (l15 < 8) { bf16* o = ol + (size_t)tok * 1024 + l15 * 128 + 4 * kg;
#pragma unroll
        for (int ct = 0; ct < 8; ++ct) { v2u w; w.x = cvtpk(oT[ct][0] * inv, oT[ct][1] * inv); w.y = cvtpk(oT[ct][2] * inv, oT[ct][3] * inv); *(v2u*)(o + ct * 16) = w; } }
}
DI void dsa_chunk(const Args& a, const Fr& F, int c32) {
    LAS unsigned char* bkt = F.lds + 81920; LAS float* tab = (LAS float*)(F.lds + 82944);
    __syncthreads();
    for (int d = F.tid; d < 1024; d += NTHR) bkt[d] = (unsigned char)t5_bucket(d);
    if (F.tid < 256) tab[F.tid] = a.in[9][(F.tid >> 3) * 16 + (F.tid & 7)] * LOG2E;
    __syncthreads();
    const unsigned short* selg = (const unsigned short*)(F.ws + WS_SEL); v2u svq[4];
#pragma unroll
    for (int i = 0; i < 4; ++i) svq[i] = *((const v2u*)(selg + (size_t)(c32 * 32 + F.wave * 4 + i) * 256) + F.lane);
#pragma unroll
    for (int i = 0; i < 4; ++i) dsa_query(F, c32 * 32 + F.wave * 4 + i, svq[i], F.lds + F.wave * 10240, bkt, tab);
}

DI void ph_even_post(const Fr& F, int j) {
    const bf16* ol = (const bf16*)(F.ws + WS_OL); bf16* ao = (bf16*)(F.ws + WS_AO);
    const bf16* wuvt = (const bf16*)(F.ws + WS_WUVT) + (size_t)j * 8 * 64 * 128;
    const bf16* po = (const bf16*)(F.ws + WS_ACT); const float* pml = (const float*)(F.ws + WS_PML); const unsigned* sel3 = (const unsigned*)(F.ws + WS_SEL3);
    const int lane = F.lane, wave = F.wave, l15 = lane & 15, kg = lane >> 4;
    for (int chunk = F.blk; chunk < 256; chunk += F.G) { const int tok0 = chunk * 128;
        { const int h = wave; bf16x8 af[4][4];
#pragma unroll
            for (int mt = 0; mt < 4; ++mt)
#pragma unroll
                for (int ks = 0; ks < 4; ++ks) af[mt][ks] = *(const bf16x8*)(wuvt + ((size_t)h * 64 + mt * 16 + l15) * 128 + ks * 32 + kg * 8);
#pragma unroll 1
            for (int tg = 0; tg < 8; tg += 2) { bf16x8 bf[2][4];
#pragma unroll
                for (int u = 0; u < 2; ++u)
#pragma unroll
                    for (int ks = 0; ks < 4; ++ks) bf[u][ks] = *(const bf16x8*)(ol + (size_t)(tok0 + (tg + u) * 16 + l15) * 1024 + h * 128 + ks * 32 + kg * 8);
#pragma unroll
                for (int u = 0; u < 2; ++u) { const int tok = tok0 + (tg + u) * 16 + l15;
#pragma unroll
                    for (int mt = 0; mt < 4; ++mt) { f32x4 d = {0.f, 0.f, 0.f, 0.f};
#pragma unroll
                        for (int ks = 0; ks < 4; ++ks) d = mfma16(af[mt][ks], bf[u][ks], d);
                        v2u w; w.x = cvtpk(d[0], d[1]); w.y = cvtpk(d[2], d[3]); *(v2u*)(ao + (size_t)tok * 1024 + h * 64 + mt * 16 + 4 * kg) = w; } } } }
#pragma unroll 1
        for (int i0 = 0; i0 < 16; i0 += 4) { const int h = lane >> 3, d0 = (lane & 7) * 8; unsigned nvv[4]; f32x2 mlv[4][4];
#pragma unroll
            for (int i = 0; i < 4; ++i) { const int tok = tok0 + wave * 16 + i0 + i; const size_t pi = ((size_t)tok * 8 + h) * 4; nvv[i] = sel3[(size_t)tok * 8 + h] >> 24;
#pragma unroll
                for (int s = 0; s < 4; ++s) mlv[i][s] = *(const f32x2*)(pml + (pi + s) * 2); }
#pragma unroll
            for (int i = 0; i < 4; ++i) { const int tok = tok0 + wave * 16 + i0 + i; const size_t pi = ((size_t)tok * 8 + h) * 4;
                float mj[4], lj[4];
#pragma unroll
                for (int s = 0; s < 4; ++s) { const bool ok = (s == 3) || ((unsigned)s < nvv[i]); mj[s] = ok ? mlv[i][s][0] : -1e30f; lj[s] = ok ? mlv[i][s][1] : 0.f; }
                const float ms = fmaxf(fmaxf(mj[0], mj[1]), fmaxf(mj[2], mj[3])); float wsum = 0.f, acc[8], wv[4]; v4u pv[4];
#pragma unroll
                for (int k = 0; k < 8; ++k) acc[k] = 0.f;
#pragma unroll
                for (int s = 0; s < 4; ++s) { wv[s] = lj[s] * ex2(mj[s] - ms); wsum += wv[s]; pv[s] = (v4u){0u, 0u, 0u, 0u}; if (wv[s] > 0.f) pv[s] = *(const v4u*)(po + (pi + s) * 64 + d0); }
#pragma unroll
                for (int s = 0; s < 4; ++s) { if (wv[s] > 0.f) {
#pragma unroll
                    for (int k = 0; k < 4; ++k) { acc[2 * k] += wv[s] * bf2f(pv[s][k] & 0xffffu); acc[2 * k + 1] += wv[s] * bf2f(pv[s][k] >> 16); } } }
                const float inv = 1.f / wsum; v4u o; o.x = cvtpk(acc[0] * inv, acc[1] * inv); o.y = cvtpk(acc[2] * inv, acc[3] * inv); o.z = cvtpk(acc[4] * inv, acc[5] * inv); o.w = cvtpk(acc[6] * inv, acc[7] * inv);
                *(v4u*)(ao + (size_t)tok * 1024 + 512 + h * 64 + d0) = o; } }
    }
}
DI f32x16 proj32_f32(const float* W, int ldw, int ncols, const float* xrow, int d_lo, int lane) {
    const int e = lane & 31, kh = lane >> 5; const bool ev = e < ncols;
    f32x16 D;
#pragma unroll
    for (int r = 0; r < 16; ++r) D[r] = 0.f;
    const float* wp = W + (size_t)(d_lo + 4 * kh) * ldw + (ev ? e : 0);
    const float* xp = xrow + d_lo + 4 * kh;
#pragma unroll 8
    for (int i = 0; i < 64; ++i) { const f32x4 xv = *(const f32x4*)(xp + 8 * i);
        float a0 = wp[(size_t)(8 * i + 0) * ldw], a1 = wp[(size_t)(8 * i + 1) * ldw], a2 = wp[(size_t)(8 * i + 2) * ldw], a3 = wp[(size_t)(8 * i + 3) * ldw];
        if (!ev) { a0 = 0.f; a1 = 0.f; a2 = 0.f; a3 = 0.f; }
        D = __builtin_amdgcn_mfma_f32_32x32x2f32(a0, xv[0], D, 0, 0, 0); D = __builtin_amdgcn_mfma_f32_32x32x2f32(a1, xv[1], D, 0, 0, 0);
        D = __builtin_amdgcn_mfma_f32_32x32x2f32(a2, xv[2], D, 0, 0, 0); D = __builtin_amdgcn_mfma_f32_32x32x2f32(a3, xv[3], D, 0, 0, 0); }
    return D;
}
DI void ph_odd_prep(const Args& a, const Fr& F, int j, int layer) {
    const bf16* proj = (const bf16*)(F.ws + WS_PROJ); const float* x = (const float*)(F.ws + WS_X);
    float* logf = (float*)(F.ws + WS_LOGF); float* cs = (float*)(F.ws + WS_CS);
    const float* wf = a.in[6] + (size_t)j * 1024 * 3088 + 3072; const float* bfv = a.in[7] + j * 16;
    LAS float* red = (LAS float*)(F.lds); LAS float* lfb = (LAS float*)(F.lds + 131072);
    LAS unsigned* kmx = (LAS unsigned*)(F.lds + 131072 + 8192);
    const int lane = F.lane, wave = F.wave, tid = F.tid, l31 = lane & 31, hi = lane >> 5;
    for (int chunk = F.blk; chunk < 256; chunk += F.G) { const int tok0 = chunk * 128, b = tok0 / SEQ, t0 = tok0 % SEQ;
        __syncthreads();
        if (tid < 16) kmx[tid] = 0u;
        const int tl = wave & 3, kr = wave >> 2;
        f32x16 D = proj32_f32(wf, 3088, 16, x + (size_t)(tok0 + tl * 32 + l31) * DM, kr * 512, lane);
        if (kr == 1) {
#pragma unroll
            for (int r = 0; r < 8; ++r) red[(tl * 8 + r) * 64 + lane] = D[r]; }
        __syncthreads();
        if (kr == 0) {
#pragma unroll
            for (int r = 0; r < 8; ++r) { const int h = (r & 3) + 8 * (r >> 2) + 4 * hi; const float z = D[r] + red[(tl * 8 + r) * 64 + lane] + bfv[h];
                const float ls = fminf(z, 0.f) - log1pf(__expf(-fabsf(z)));
                lfb[(tl * 32 + l31) * 16 + h] = ls * LOG2E; } }
#pragma unroll 1
        for (int i = 0; i < 4; ++i) { const int p = tid + i * NTHR, tk = p >> 4, h = p & 15; const v4u* kp = (const v4u*)(proj + (size_t)(tok0 + tk) * OD_N + OC_K + h * 64); float s = 0.f;
#pragma unroll
            for (int c = 0; c < 8; ++c) { const v4u w = kp[c];
#pragma unroll
                for (int k = 0; k < 4; ++k) { const float e0 = bf2f(w[k] & 0xffffu), e1 = bf2f(w[k] >> 16); s += e0 * e0 + e1 * e1; } }
            __hip_atomic_fetch_max(kmx + h, __float_as_uint(s), __ATOMIC_RELAXED, __HIP_MEMORY_SCOPE_WORKGROUP); }
        __syncthreads();
        for (int i = tid; i < 2048; i += NTHR) { const int h = i >> 7, tk = i & 127; logf[((size_t)b * 16 + h) * SEQ + t0 + tk] = lfb[tk * 16 + h]; }
        if (tid < 32) { const int h = tid & 15, c = tid >> 4; float s = 0.f;
            for (int k = 0; k < 64; ++k) s += lfb[(c * 64 + k) * 16 + h];
            cs[((size_t)b * 16 + h) * 128 + (t0 >> 6) + c] = s; }
        if (tid < 16) __hip_atomic_fetch_max(F.ctl + CW_KMAX + layer * 64 + b * 16 + tid, kmx[tid], RLX_AGENT);
    }
}

constexpr float FOX_SKIP_LOG2 = 64.f;
struct FoxBias { LAS const float* ng; int tq, kabs0; bool diag;
    DI float operator()(float p, int kvrel) const { const float v = p + ng[kvrel]; return (diag && (kabs0 + kvrel) > tq) ? -INFINITY : v; } };
DI void fox_unit(const Fr& F, int layer, int b, int h, int qb) {
    const bf16* proj = (const bf16*)(F.ws + WS_PROJ); const float* logf = (const float*)(F.ws + WS_LOGF); const float* cs = (const float*)(F.ws + WS_CS); bf16* ao = (bf16*)(F.ws + WS_AO);
    LAS unsigned char* lds = F.lds; LAS float* ng = (LAS float*)(lds + 32768); LAS float* red = (LAS float*)(lds + 65536 + 1024); LAS int* ibox = (LAS int*)(lds + 65536 + 2048);
    const int tid = F.tid, lane = F.lane, wave = F.wave, r32 = lane & 31, hi = lane >> 5, t0 = qb * 256, rowbase = b * SEQ, tq = t0 + wave * 32 + r32;
    __syncthreads();
    bf16x8 qf[4]; float qs = 0.f;
    { const bf16* qp = proj + (size_t)(rowbase + tq) * OD_N + OC_Q + h * 64 + hi * 8;
#pragma unroll
        for (int s = 0; s < 4; ++s) { qf[s] = *(const bf16x8*)(qp + s * 16);
#pragma unroll
            for (int k = 0; k < 8; ++k) { const float e = bf2f((unsigned short)qf[s][k]); qs += e * e; } } }
    qs += __shfl_xor(qs, 32); qs = wave_max(qs);
    if (lane == 0) red[wave] = qs;
    if (tid < 128) red[32 + tid] = (tid < t0 / 64) ? cs[((size_t)b * 16 + h) * 128 + tid] : 0.f;
    __syncthreads();
    if (tid == 0) { float qm = red[0];
        for (int w = 1; w < 8; ++w) qm = fmaxf(qm, red[w]);
        const float km = __uint_as_float(ld_u32(F.ctl + CW_KMAX + layer * 64 + b * 16 + h));
        const float B2 = 2.f * (sqrtf(qm * km) * 1.01f + 1.f);
        int kt = t0 / 64 - 1, kts = t0 / 64; float D = 0.f;
        while (kt >= 0 && B2 + D >= -FOX_SKIP_LOG2) { kts = kt; D += red[32 + kt]; --kt; }
        ibox[0] = kts; }
    __syncthreads();
    const int kts = ibox[0], s_start = kts * 64, nel = t0 + 256 - s_start;
    { const int i0 = tid * 16; float v[16]; const float* lp = logf + ((size_t)b * 16 + h) * SEQ + s_start + i0;
        if (i0 < nel) {
#pragma unroll
            for (int c = 0; c < 4; ++c) { const f32x4 w = *(const f32x4*)(lp + 4 * c); v[4 * c] = w[0]; v[4 * c + 1] = w[1]; v[4 * c + 2] = w[2]; v[4 * c + 3] = w[3]; } }
        else {
#pragma unroll
            for (int c = 0; c < 16; ++c) v[c] = 0.f; }
#pragma unroll
        for (int c = 1; c < 16; ++c) v[c] += v[c - 1];
        float xsum = v[15];
#pragma unroll
        for (int o = 1; o < 64; o <<= 1) { const float y = __shfl_up(xsum, o); if (lane >= o) xsum += y; }
        if (lane == 63) red[16 + wave] = xsum;
        __syncthreads();
        float off = xsum - v[15];
        for (int w = 0; w < wave; ++w) off += red[16 + w];
        if (i0 < nel) {
#pragma unroll
            for (int c = 0; c < 4; ++c) { f32x4 w = {-(off + v[4 * c]), -(off + v[4 * c + 1]), -(off + v[4 * c + 2]), -(off + v[4 * c + 3])}; *(LAS f32x4*)(ng + i0 + 4 * c) = w; } }
    }
    const int ntile = t0 / 64 + 4 - kts;
    const bf16* kg = proj + (size_t)rowbase * OD_N + OC_K + h * 64; const bf16* vg = proj + (size_t)rowbase * OD_N + OC_V + h * 64;
    const int kr = tid & 31, kc = (tid >> 5) & 7, kst = tid >> 8, vcc = tid & 3, vrow = (tid >> 2) & 63, vdh = tid >> 8;
    const int koff = kst * 4096 + kc * 512 + kr * 16, voff = 8192 + vdh * 4096 + vrow * 64 + vcc * 16;
    { const v4u kv = *(const v4u*)(kg + (size_t)(kts * 64 + kst * 32 + kr) * OD_N + kc * 8), vv = *(const v4u*)(vg + (size_t)(kts * 64 + vrow) * OD_N + vdh * 32 + vcc * 8);
        *(LAS v4u*)(lds + koff) = kv; *(LAS v4u*)(lds + voff) = vv; }
    __syncthreads();
    AttSt S; S.m = -1e30f; S.l = 0.f;
#pragma unroll
    for (int r = 0; r < 16; ++r) { S.o0[r] = 0.f; S.o1[r] = 0.f; }
    const int wlast = t0 + wave * 32 + 31, wfirst = t0 + wave * 32;
    for (int i = 0; i < ntile; ++i) { const int kt = kts + i; LAS unsigned char* buf = lds + (i & 1) * 16384; LAS unsigned char* nbuf = lds + ((i + 1) & 1) * 16384;
        v4u kv, vv; const bool more = i + 1 < ntile;
        if (more) { kv = *(const v4u*)(kg + (size_t)((kt + 1) * 64 + kst * 32 + kr) * OD_N + kc * 8); vv = *(const v4u*)(vg + (size_t)((kt + 1) * 64 + vrow) * OD_N + vdh * 32 + vcc * 8); }
#pragma unroll
        for (int sub = 0; sub < 2; ++sub) { const int kv0 = kt * 64 + sub * 32;
            if (kv0 <= wlast) { FoxBias bf{ng + (kv0 - s_start), tq, kv0, kv0 + 31 > wfirst};
                att_subtile(S, qf, (LAS const char*)buf + sub * 4096, (LAS const char*)buf + 8192, 4096, sub * 32, lane, bf); } }
        if (more) { *(LAS v4u*)(nbuf + koff) = kv; *(LAS v4u*)(nbuf + voff - 8192 + 8192) = vv; }
        __syncthreads(); }
    const float lt = S.l + __shfl_xor(S.l, 32), inv = 1.f / lt;
    bf16* o = ao + (size_t)(rowbase + tq) * 1024 + h * 64;
#pragma unroll
    for (int a4 = 0; a4 < 4; ++a4) { v2u w0, w1;
        w0.x = cvtpk(S.o0[4 * a4] * inv, S.o0[4 * a4 + 1] * inv); w0.y = cvtpk(S.o0[4 * a4 + 2] * inv, S.o0[4 * a4 + 3] * inv);
        w1.x = cvtpk(S.o1[4 * a4] * inv, S.o1[4 * a4 + 1] * inv); w1.y = cvtpk(S.o1[4 * a4 + 2] * inv, S.o1[4 * a4 + 3] * inv);
        *(v2u*)(o + 8 * a4 + 4 * hi) = w0; *(v2u*)(o + 32 + 8 * a4 + 4 * hi) = w1; }
}

DI void ph_ln1_router(const Args& a, const Fr& F, int layer) {
    const float* yp = (const float*)(F.ws + WS_YP); float* x1 = (float*)(F.ws + WS_X1); unsigned char* xb8 = F.ws + WS_XB8;
    unsigned* tope = (unsigned*)(F.ws + WS_TOPE); float* gate = (float*)(F.ws + WS_GATE); unsigned* rank = (unsigned*)(F.ws + WS_RANK);
    const float* g = a.in[10] + (size_t)(layer * 2) * DM; const float* bb = a.in[11] + (size_t)(layer * 2) * DM;
    const float* rw = a.in[12] + (size_t)layer * 1024 * 32; const float* rb = a.in[13] + layer * 32;
    LAS float* red = (LAS float*)(F.lds); LAS unsigned* lcnt = (LAS unsigned*)(F.lds + 131072);
    const int lane = F.lane, wave = F.wave, tid = F.tid, l31 = lane & 31, hi = lane >> 5;
    for (int chunk = F.blk; chunk < 256; chunk += F.G) { const int tok0 = chunk * 128;
        __syncthreads();
        if (tid < 32) lcnt[tid] = 0u;
#pragma unroll 1
        for (int k = 0; k < 16; k += 8) { f32x4 v[8][4];
#pragma unroll
            for (int i = 0; i < 8; ++i)
#pragma unroll
                for (int jj = 0; jj < 4; ++jj) v[i][jj] = *((const f32x4*)(yp + (size_t)(tok0 + wave * 16 + k + i) * DM) + lane + 64 * jj);
#pragma unroll
            for (int i = 0; i < 8; ++i) { const int tok = tok0 + wave * 16 + k + i;
                ln_row(v[i], g, bb, lane);
                store_row_f32(x1 + (size_t)tok * DM, v[i], lane);
#pragma unroll
                for (int jj = 0; jj < 4; ++jj) *((unsigned*)(xb8 + (size_t)tok * DM) + lane + 64 * jj) = pk4_fp8(v[i][jj][0] * F8_SX, v[i][jj][1] * F8_SX, v[i][jj][2] * F8_SX, v[i][jj][3] * F8_SX); } }
        asm volatile("s_waitcnt vmcnt(0)" ::: "memory");
        __syncthreads();
        const int tl = wave & 3, kr = wave >> 2, tokl = tok0 + tl * 32 + l31;
        f32x16 D = proj32_f32(rw, 32, 32, x1 + (size_t)tokl * DM, kr * 512, lane);
        if (kr == 1) {
#pragma unroll
            for (int r = 0; r < 16; ++r) red[(tl * 16 + r) * 64 + lane] = D[r]; }
        __syncthreads();
        if (kr == 0) {
            float lv[32];
#pragma unroll
            for (int r = 0; r < 16; ++r) { const float own = D[r] + red[(tl * 16 + r) * 64 + lane] + rb[crow(r, hi)]; const float oth = __shfl_xor(own, 32);
                lv[crow(r, 0)] = hi == 0 ? own : oth; lv[crow(r, 1)] = hi == 0 ? oth : own; }
            float tv[4]; int te[4];
#pragma unroll
            for (int r = 0; r < 4; ++r) { float mx = -INFINITY; int me = 0;
#pragma unroll
                for (int e = 0; e < 32; ++e) { if (lv[e] > mx) { mx = lv[e]; me = e; } }
                tv[r] = mx; te[r] = me;
#pragma unroll
                for (int e = 0; e < 32; ++e) { if (e == me) lv[e] = -INFINITY; } }
            const float e1 = __expf(tv[1] - tv[0]), e2 = __expf(tv[2] - tv[0]), e3 = __expf(tv[3] - tv[0]); const float inv = 1.f / (1.f + e1 + e2 + e3);
            if (hi == 0) { const size_t o = (size_t)tokl * 4;
                const float gv[4] = {inv, e1 * inv, e2 * inv, e3 * inv};
#pragma unroll
                for (int r = 0; r < 4; ++r) { const unsigned rk = __hip_atomic_fetch_add(lcnt + (te[r] & 31), 1u, __ATOMIC_RELAXED, __HIP_MEMORY_SCOPE_WORKGROUP);
                    tope[o + r] = (unsigned)(te[r] & 31); gate[o + r] = gv[r]; rank[o + r] = rk; } } }
        __syncthreads();
        if (tid < 32) __hip_atomic_store(F.ctl + CW_CNT + chunk * 32 + tid, lcnt[tid], RLX_AGENT);
    }
}

DI void ph_route(const Fr& F) {
    const unsigned char* xb8 = F.ws + WS_XB8; unsigned char* xg = F.ws + WS_XG;
    const unsigned* tope = (const unsigned*)(F.ws + WS_TOPE); const unsigned* rank = (const unsigned*)(F.ws + WS_RANK); unsigned* dest = (unsigned*)(F.ws + WS_DEST);
    LAS unsigned* P = (LAS unsigned*)(F.lds); LAS unsigned* pst = P + 512; LAS unsigned* pad = P + 544; LAS unsigned* base = P + 576; LAS unsigned* nt = P + 608;
    const int tid = F.tid, lane = F.lane, wave = F.wave;
    __syncthreads();
    { const int e = tid & 31, part = tid >> 5; unsigned s = 0u;
        for (int c = 0; c < 16; ++c) s += ld_u32(F.ctl + CW_CNT + (part * 16 + c) * 32 + e);
        P[part * 32 + e] = s; }
    __syncthreads();
    if (tid < 32) { unsigned tot = 0u;
        for (int p = 0; p < 16; ++p) tot += P[p * 32 + tid];
        pad[tid] = (tot + 255u) & ~255u; }
    __syncthreads();
    if (tid == 0) { unsigned acc = 0u;
        for (int e = 0; e < 32; ++e) { pst[e] = acc; acc += pad[e]; }
        nt[0] = acc >> 8; }
    __syncthreads();
    for (int chunk = F.blk; chunk < 256; chunk += F.G) {
        __syncthreads();
        if (tid < 32) { unsigned off = 0u; const int pf = chunk >> 4;
            for (int p = 0; p < pf; ++p) off += P[p * 32 + tid];
            for (int c = pf * 16; c < chunk; ++c) off += ld_u32(F.ctl + CW_CNT + c * 32 + tid);
            base[tid] = pst[tid] + off; }
        __syncthreads();
#pragma unroll 1
        for (int i0 = 0; i0 < 16; i0 += 4) { v4u src[4]; unsigned ee[4][4], rr[4][4];
#pragma unroll
            for (int i = 0; i < 4; ++i) { const int tok = chunk * 128 + wave * 16 + i0 + i; src[i] = *((const v4u*)(xb8 + (size_t)tok * DM) + lane);
#pragma unroll
                for (int k = 0; k < 4; ++k) { ee[i][k] = tope[(size_t)tok * 4 + k]; rr[i][k] = rank[(size_t)tok * 4 + k]; } }
#pragma unroll
            for (int i = 0; i < 4; ++i) { const int tok = chunk * 128 + wave * 16 + i0 + i;
#pragma unroll
                for (int k = 0; k < 4; ++k) { const unsigned d = base[ee[i][k]] + rr[i][k];
                    if (lane == 0) dest[(size_t)tok * 4 + k] = d;
                    *((v4u*)(xg + (size_t)d * DM) + lane) = src[i]; } } }
        if (chunk == 0) { const unsigned ntl = nt[0];
            if (tid == 0) __hip_atomic_store(F.ctl + CW_TILE, ntl, RLX_AGENT);
            for (unsigned i = tid; i < ntl; i += NTHR) { unsigned e = 0u;
                for (unsigned k = 1; k < 32; ++k) if (pst[k] <= i * 256u) e = k;
                __hip_atomic_store(F.ctl + CW_TILE + 64 + i, e, RLX_AGENT); } }
    }
}

DI void ph_combine_ln2(const Args& a, const Fr& F, int layer) {
    const float* x1 = (const float*)(F.ws + WS_X1); const bf16* yr = (const bf16*)(F.ws + WS_XG); float* xo = (float*)(F.ws + WS_X); bf16* xb = (bf16*)(F.ws + WS_XB);
    const float* gate = (const float*)(F.ws + WS_GATE); const unsigned* dest = (const unsigned*)(F.ws + WS_DEST);
    const float* g = a.in[10] + (size_t)(layer * 2 + 1) * DM; const float* bb = a.in[11] + (size_t)(layer * 2 + 1) * DM;
    const int lane = F.lane; const int gw = F.blk * NWAVES + F.wave, NGW = F.G * NWAVES;
    for (int tok = gw; tok < NTOK; tok += 4 * NGW) { f32x4 v[4][4];
#pragma unroll
        for (int i = 0; i < 4; ++i) { const int tk = tok + i * NGW; if (tk < NTOK) {
#pragma unroll
            for (int jj = 0; jj < 4; ++jj) v[i][jj] = *((const f32x4*)(x1 + (size_t)tk * DM) + lane + 64 * jj) * ALPHA;
#pragma unroll
            for (int k = 0; k < 4; ++k) { const float gk = gate[(size_t)tk * 4 + k]; const unsigned d = dest[(size_t)tk * 4 + k];
#pragma unroll
                for (int jj = 0; jj < 4; ++jj) { const v2u w = *((const v2u*)(yr + (size_t)d * DM) + lane + 64 * jj);
                    v[i][jj][0] += gk * bf2f(w.x & 0xffffu); v[i][jj][1] += gk * bf2f(w.x >> 16); v[i][jj][2] += gk * bf2f(w.y & 0xffffu); v[i][jj][3] += gk * bf2f(w.y >> 16); } } } }
#pragma unroll
        for (int i = 0; i < 4; ++i) { const int tk = tok + i * NGW; if (tk < NTOK) {
            ln_row(v[i], g, bb, lane);
            if (layer == DEPTH - 1) store_row_f32(a.out + (size_t)tk * DM, v[i], lane);
            else { store_row_f32(xo + (size_t)tk * DM, v[i], lane); store_row_bf16(xb + (size_t)tk * DM, v[i], lane); } } } }
}
constexpr int LDS_BYTES = 147456;
constexpr int LDS_BARW = 145408, LDS_QSLOT = 145472, LDS_TILE_E = 133632;
constexpr int NPL = 11;
constexpr int NPHASE = 1 + NPL * DEPTH;
#ifndef MK_SINGLE
#define MK_SINGLE 1
#endif
DI int q_next(const Fr& F, unsigned* ctr) {
    LAS int* slot = (LAS int*)(F.lds + LDS_QSLOT);
    __syncthreads();
    if (F.tid == 0) *slot = (int)__hip_atomic_fetch_add(ctr, 1u, RLX_AGENT);
    __syncthreads();
    return *slot;
}
DI int lane_id_fresh() { unsigned m_ = ~0u; asm volatile("" : "+s"(m_)); return (int)__builtin_amdgcn_mbcnt_hi(m_, __builtin_amdgcn_mbcnt_lo(m_, 0u)); }
#define RETID(F) do { int t2_ = F.tid; asm volatile("" : "+v"(t2_)); F.tid = t2_; F.lane = t2_ & 63; F.wave = __builtin_amdgcn_readfirstlane(t2_ >> 6); } while (0)
#ifndef PROBE_DUP
#define PROBE_DUP -1
#endif
#define NREP(q) ((PROBE_DUP == (q)) ? 2 : 1)
#define AS4 __attribute__((address_space(4)))
#define SITE() Args a; Fr F; { const AS4 Args* ap = (const AS4 Args*)__builtin_amdgcn_kernarg_segment_ptr(); asm volatile("" : "+s"(ap)); \
        _Pragma("unroll") for (int i_ = 0; i_ < 18; ++i_) a.in[i_] = ap->in[i_]; a.out = ap->out; a.ws = ap->ws; a.ph_lo = 0; a.ph_hi = 0; \
        int w_ = wv_s; asm volatile("" : "+s"(w_)); int t_ = w_ * 64 + lane_id_fresh(); asm volatile("" : "+v"(t_)); F.tid = t_; F.lane = t_ & 63; F.wave = __builtin_amdgcn_readfirstlane(t_ >> 6); \
        F.lds = (LAS unsigned char*)lds_raw; F.ws = a.ws; F.ctl = (unsigned*)(a.ws + WS_CTL); F.blk = blockIdx.x; F.G = gridDim.x; }
__global__ void __launch_bounds__(NTHR, 2) mega_fwd(Args a0) {
    extern __shared__ __attribute__((aligned(16))) unsigned char lds_raw[];
    const int wv_s = __builtin_amdgcn_readfirstlane((int)(threadIdx.x >> 6));
#if MK_SINGLE
    constexpr int lo = 0, hi = NPHASE; constexpr bool single = true;
#else
    const int lo = a0.ph_lo, hi = a0.ph_hi; constexpr bool single = false;
#endif
    if (threadIdx.x == 0) *(LAS v4u*)((LAS unsigned char*)lds_raw + LDS_BARW) = (v4u){0u, 0u, 0u, 0u};
    __syncthreads();
    if (single) (void)xcd_barrier_post((unsigned*)(a0.ws + WS_CTL) + CW_BAR, (volatile LAS unsigned*)((LAS unsigned char*)lds_raw + LDS_BARW));
#define IN(k) (lo <= (k) && (k) < hi)
#define SEAM() do { if (single) { const AS4 Args* ap_ = (const AS4 Args*)__builtin_amdgcn_kernarg_segment_ptr(); asm volatile("" : "+s"(ap_)); int w_ = wv_s; asm volatile("" : "+s"(w_)); \
        XcdBarrier b_; b_.bar = (unsigned*)(ap_->ws + WS_CTL) + CW_BAR; b_.x = xb_xcc_id(); b_.st = (volatile LAS unsigned*)((LAS unsigned char*)lds_raw + LDS_BARW); \
        xcd_barrier(b_, (w_ == 0) && (lane_id_fresh() == 0)); } } while (0)
    if (IN(0)) { _Pragma("unroll 1") for (int rep = 0; rep < NREP(100); ++rep) { { SITE(); ph_prologue(a, F); } SEAM(); } }
#pragma unroll 1
    for (int L = 0; L < DEPTH; ++L) {
        const int pb = 1 + NPL * L, j = L >> 1; const bool odd = (L & 1) != 0;
        if (IN(pb + 0)) _Pragma("unroll 1") for (int rep = 0; rep < NREP(0); ++rep) {
            { SITE();
            const bf16* w = odd ? (const bf16*)(F.ws + WS_WOD) + (size_t)j * OD_N * 1024 : (const bf16*)(F.ws + WS_WEV) + (size_t)j * EV_N * 1024;
            const int N = odd ? OD_N : EV_N;
            pg8::Gemm g{(const bf16*)(F.ws + WS_XB), w, NTOK, N, 1024}; pg8::StaticOrder S; S.init(NTOK, N, F.G, F.blk);
            pg8::EpiBf16<0> E{(bf16*)(F.ws + WS_PROJ), N, nullptr, 1024, (size_t)1024, C2F};
            pg8::gemm_phase<pg8::EpiBf16<0>, pg8::StaticOrder, true, true>(F.lds, g, S, E, F.tid); }
            SEAM(); }
        if (IN(pb + 1)) _Pragma("unroll 1") for (int rep = 0; rep < NREP(1); ++rep) { { SITE(); if (odd) ph_odd_prep(a, F, j, L); else ph_even_prep(a, F, j); } SEAM(); }
        if (!odd && IN(pb + 2)) _Pragma("unroll 1") for (int rep = 0; rep < ((PROBE_DUP == 2 || PROBE_DUP == 21 || PROBE_DUP == 22) ? 2 : 1); ++rep) {
            { SITE(); unsigned* ctr = F.ctl + CW_Q + 64 * (L * 2) + 1024 * rep;
            for (;;) { const int it = q_next(F, ctr); if (it >= 1280) break; RETID(F);
                if (it < 1024) { if (!(rep == 1 && PROBE_DUP == 22)) idx_unit(F, it & 3, 255 - (it >> 2)); } else { if (!(rep == 1 && PROBE_DUP == 21)) moba_gate_chunk(F, it - 1024); } } }
            SEAM(); }
        if (IN(pb + 3)) _Pragma("unroll 1") for (int rep = 0; rep < ((PROBE_DUP == 3 || (PROBE_DUP == 31 && odd) || ((PROBE_DUP == 32 || PROBE_DUP == 33) && !odd)) ? 2 : 1); ++rep) {
            { SITE(); unsigned* ctr = F.ctl + CW_Q + 64 * (L * 2 + 1) + 1024 * rep;
            if (odd) { for (;;) { const int it = q_next(F, ctr); if (it >= 2048) break; RETID(F); const int bh = it & 63; fox_unit(F, L, bh >> 4, bh & 15, 31 - (it >> 6)); } }
            else { for (;;) { const int it = q_next(F, ctr); if (it >= 2048) break; RETID(F);
                    if (it < 1024) { const int bh = it & 31; if (!(rep == 1 && PROBE_DUP == 33)) moba_unit(a, F, bh >> 3, bh & 7, it >> 5); } else { if (!(rep == 1 && PROBE_DUP == 32)) dsa_chunk(a, F, it - 1024); } } } }
            SEAM(); }
        if (!odd && IN(pb + 4)) _Pragma("unroll 1") for (int rep = 0; rep < NREP(4); ++rep) { { SITE(); ph_even_post(F, j); } SEAM(); }
        if (IN(pb + 5)) _Pragma("unroll 1") for (int rep = 0; rep < NREP(5); ++rep) {
            { SITE();
            const float* xin = (L == 0) ? a.in[0] : (const float*)(F.ws + WS_X);
            pg8::Gemm g{(const bf16*)(F.ws + WS_AO), (const bf16*)(F.ws + WS_WOUT) + (size_t)L * 1024 * 1024, NTOK, 1024, 1024}; pg8::StaticOrder S; S.init(NTOK, 1024, F.G, F.blk);
            EpiResF32 E{xin, (float*)(F.ws + WS_YP), ALPHA};
            pg8::gemm_phase<EpiResF32, pg8::StaticOrder, true, true>(F.lds, g, S, E, F.tid); }
            SEAM(); }
        if (IN(pb + 6)) _Pragma("unroll 1") for (int rep = 0; rep < NREP(6); ++rep) { { SITE(); ph_ln1_router(a, F, L); } SEAM(); }
        if (IN(pb + 7)) _Pragma("unroll 1") for (int rep = 0; rep < NREP(7); ++rep) { { SITE(); ph_route(F); } SEAM(); }
        if (IN(pb + 8)) _Pragma("unroll 1") for (int rep = 0; rep < NREP(8); ++rep) {
            { SITE(); const int ntl = (int)ld_u32(F.ctl + CW_TILE);
            LAS unsigned* tle = (LAS unsigned*)(F.lds + LDS_TILE_E);
            for (int i = F.tid; i < ntl; i += NTHR) tle[i] = ld_u32(F.ctl + CW_TILE + 64 + i);
            __syncthreads();
            pg8::Gemm g{(const bf16*)(F.ws + WS_XG), (const bf16*)(F.ws + WS_WGU + (size_t)L * 32 * 2048 * 1024), NR_MAX, 32 * 2048, 512};
            GroupOrder S{tle, ntl, 3, F.G, F.blk};
            EpiSwiglu E{F.ws + WS_ACT, a.in[15] + (size_t)L * 32 * 2048};
            pg8::gemm_phase<EpiSwiglu, GroupOrder, true, true, true>(F.lds, g, S, E, F.tid); }
            SEAM(); }
        if (IN(pb + 9)) _Pragma("unroll 1") for (int rep = 0; rep < NREP(9); ++rep) {
            { SITE(); const int ntl = (int)ld_u32(F.ctl + CW_TILE);
            LAS unsigned* tle = (LAS unsigned*)(F.lds + LDS_TILE_E);
            for (int i = F.tid; i < ntl; i += NTHR) tle[i] = ld_u32(F.ctl + CW_TILE + 64 + i);
            __syncthreads();
            pg8::Gemm g{(const bf16*)(F.ws + WS_ACT), (const bf16*)(F.ws + WS_WDN + (size_t)L * 32 * 1024 * 1024), NR_MAX, 32 * 1024, 512};
            GroupOrder S{tle, ntl, 2, F.G, F.blk};
            EpiDown E{(bf16*)(F.ws + WS_XG), a.in[17] + (size_t)L * 32 * 1024};
            pg8::gemm_phase<EpiDown, GroupOrder, true, true, true>(F.lds, g, S, E, F.tid); }
            SEAM(); }
        if (IN(pb + 10)) _Pragma("unroll 1") for (int rep = 0; rep < NREP(10); ++rep) { { SITE(); ph_combine_ln2(a, F, L); } if (L + 1 < DEPTH || rep + 1 < NREP(10)) SEAM(); }
    }
#undef IN
#undef SEAM
}

extern "C" void kernel_launch(void* const* d_in, const int* in_sizes, int n_in, void* d_out, int out_size, void* d_ws, size_t ws_size, hipStream_t stream) {
    static int grid = 0;
    if (grid == 0) {
        if (n_in != 18 || out_size != NTOK * DM || ws_size < WS_END) { fprintf(stderr, "kernel_launch: unexpected shapes (n_in %d, out %d, ws %zu); nothing launched\n", n_in, out_size, ws_size); grid = -1; return; }
        int dev = 0, cus = 0, per_cu = 0;
        if (hipGetDevice(&dev) != hipSuccess || hipDeviceGetAttribute(&cus, hipDeviceAttributeMultiprocessorCount, dev) != hipSuccess) { grid = -1; return; }
        if (hipFuncSetAttribute((const void*)mega_fwd, hipFuncAttributeMaxDynamicSharedMemorySize, LDS_BYTES) != hipSuccess) { fprintf(stderr, "kernel_launch: hipFuncSetAttribute failed\n"); grid = -1; return; }
        if (hipOccupancyMaxActiveBlocksPerMultiprocessor(&per_cu, (const void*)mega_fwd, NTHR, LDS_BYTES) != hipSuccess || per_cu < 1) fprintf(stderr, "kernel_launch: occupancy query reports %d\n", per_cu);
        (void)hipGetLastError();
        grid = cus;
    }
    if (grid < 0) return;
    (void)hipMemsetAsync((char*)d_ws + WS_CTL, 0, CTL_ZERO_BYTES, stream);
#ifdef EXP_SKIP
    (void)hipMemsetAsync((char*)d_ws + WS_AO, 0, 64 * MiB, stream);
    (void)hipMemsetAsync((char*)d_ws + WS_OL, 0, 64 * MiB, stream);
    if (EXP_SKIP & 4) { (void)hipMemsetAsync((char*)d_ws + WS_XG, 0, 272 * MiB, stream); (void)hipMemsetAsync((char*)d_ws + WS_DEST, 0, 1 * MiB, stream); }
#endif
    Args a{};
    for (int i = 0; i < 18; ++i) a.in[i] = (const float*)d_in[i];
    a.out = (float*)d_out; a.ws = (unsigned char*)d_ws;
#if MK_SINGLE
    a.ph_lo = 0; a.ph_hi = NPHASE;
    hipLaunchKernelGGL(mega_fwd, dim3(grid), dim3(NTHR), LDS_BYTES, stream, a);
#else
    for (int p = 0; p < NPHASE; ++p) {
        if (p > 0) { const int L = (p - 1) / NPL, q = (p - 1) % NPL; if ((L & 1) && (q == 2 || q == 4)) continue;
#ifdef EXP_SKIP
            if ((EXP_SKIP & 1) && !(L & 1) && q <= 4) continue;
            if ((EXP_SKIP & 2) && (L & 1) && q <= 4) continue;
            if ((EXP_SKIP & 4) && q >= 7 && q <= 9) continue;
#endif
        }
        a.ph_lo = p; a.ph_hi = p + 1;
        hipLaunchKernelGGL(mega_fwd, dim3(grid), dim3(NTHR), LDS_BYTES, stream, a);
    }
#endif
}
```

```cpp
#include <hip/hip_runtime.h>
#include <cstdio>
#include <cstdint>
#ifdef EXP_SKIP
#define EXPF EXP_SKIP
#else
#define EXPF 0
#endif
constexpr int NB = 4, SEQ = 8192, DM = 1024, NTOK = NB * SEQ, DEPTH = 4;
constexpr int EV_N = 2560, OD_N = 3072;
constexpr int EC_QA = 0, EC_QB = 512, EC_KB = 1024, EC_VB = 1536, EC_CKV = 2048, EC_QI = 2176, EC_KI = 2432, EC_WI = 2496;
constexpr int OC_Q = 0, OC_K = 1024, OC_V = 2048;
constexpr float LOG2E = 1.4426950408889634f;
constexpr float C2F = 0.125f * LOG2E;
constexpr float ALPHA = 1.681792830507429f;
constexpr float LN_EPS = 1e-5f;
constexpr int NR_MAX = 131072 + 32 * 256;
constexpr int NWAVES = 8, NTHR = 512;
constexpr size_t MiB = (size_t)1 << 20;
constexpr size_t WS_CTL = 0, CTL_ZERO_BYTES = 4 * MiB;
constexpr size_t WS_WEV = 8 * MiB, WS_WOD = 18 * MiB, WS_WOUT = 30 * MiB, WS_WUKT = 38 * MiB, WS_WUVT = 39 * MiB;
constexpr size_t WS_WGU = 40 * MiB, WS_WDN = 552 * MiB;
constexpr size_t WS_X = 808 * MiB, WS_X1 = 936 * MiB, WS_YP = 1064 * MiB, WS_XB = 1192 * MiB;
constexpr size_t WS_PROJ = 1256 * MiB, WS_AO = 1448 * MiB, WS_XG = 1512 * MiB, WS_ACT = 1784 * MiB;
constexpr size_t WS_QL = 2056 * MiB, WS_OL = 2120 * MiB, WS_CKVN = 2184 * MiB, WS_SEL = 2192 * MiB;
constexpr size_t WS_KBAR = 2208 * MiB, WS_SEL3 = 2209 * MiB, WS_LOGF = 2210 * MiB, WS_CS = 2212 * MiB;
constexpr size_t WS_TOPE = 2213 * MiB, WS_GATE = 2214 * MiB, WS_RANK = 2215 * MiB, WS_DEST = 2216 * MiB, WS_PML = 2217 * MiB;
constexpr size_t WS_XB8 = 2226 * MiB;
constexpr size_t WS_KIC = 2258 * MiB;
constexpr size_t WS_END = 2262 * MiB;
constexpr float F8_SX = 16.f, F8_SWG = 256.f, F8_SA = 4.f, F8_SWD = 512.f;
constexpr int CW_BAR = 4096, CW_Q = 8192, CW_KMAX = 12288, CW_CNT = 16384, CW_TILE = 32768;

#define GAS __attribute__((address_space(1)))
#define LAS __attribute__((address_space(3)))
#define DI __device__ __forceinline__
typedef unsigned short bf16;
typedef unsigned v4u __attribute__((ext_vector_type(4)));
typedef unsigned v2u __attribute__((ext_vector_type(2)));
typedef float f32x4 __attribute__((ext_vector_type(4)));
typedef float f32x2 __attribute__((ext_vector_type(2)));
typedef float f32x16 __attribute__((ext_vector_type(16)));
typedef short bf16x8 __attribute__((ext_vector_type(8)));
typedef short s16x4 __attribute__((ext_vector_type(4)));
typedef __bf16 bf16x2_t __attribute__((ext_vector_type(2)));
typedef GAS unsigned gu32;
#define RLX_AGENT __ATOMIC_RELAXED, __HIP_MEMORY_SCOPE_AGENT
#define LDS_WAIT() asm volatile("s_waitcnt lgkmcnt(0)" ::: "memory")

DI float bf2f(unsigned v) { return __uint_as_float(v << 16); }
DI unsigned cvtpk(float lo, float hi) { f32x2 v = {lo, hi}; bf16x2_t b = __builtin_convertvector(v, bf16x2_t); return __builtin_bit_cast(unsigned, b); }
DI unsigned f2bf(float f) { return cvtpk(f, 0.f) & 0xffffu; }
DI unsigned pk4_fp8(float a, float b, float c, float d) {
    a = fminf(fmaxf(a, -448.f), 448.f); b = fminf(fmaxf(b, -448.f), 448.f); c = fminf(fmaxf(c, -448.f), 448.f); d = fminf(fmaxf(d, -448.f), 448.f);
    int w = 0; w = __builtin_amdgcn_cvt_pk_fp8_f32(a, b, w, false); w = __builtin_amdgcn_cvt_pk_fp8_f32(c, d, w, true); return (unsigned)w; }
DI float ex2(float x) { return __builtin_amdgcn_exp2f(x); }
DI float wave_sum(float v) {
#pragma unroll
    for (int o = 1; o < 64; o <<= 1) v += __shfl_xor(v, o);
    return v;
}
DI float wave_max(float v) {
#pragma unroll
    for (int o = 1; o < 64; o <<= 1) v = fmaxf(v, __shfl_xor(v, o));
    return v;
}
DI unsigned ld_u32(const unsigned* p) { return __hip_atomic_load(p, RLX_AGENT); }
DI int crow(int r, int hi) { return (r & 3) + 8 * (r >> 2) + 4 * hi; }
DI f32x16 mfma32(bf16x8 a, bf16x8 b, f32x16 c) { return __builtin_amdgcn_mfma_f32_32x32x16_bf16(a, b, c, 0, 0, 0); }
DI f32x4 mfma16(bf16x8 a, bf16x8 b, f32x4 c) { return __builtin_amdgcn_mfma_f32_16x16x32_bf16(a, b, c, 0, 0, 0); }
typedef short v4i16_t __attribute__((ext_vector_type(4)));
DI s16x4 vtr(LAS const char* p) { return __builtin_bit_cast(s16x4, __builtin_amdgcn_ds_read_tr16_b64_v4i16((LAS v4i16_t*)p)); }
DI bf16x8 cat8(s16x4 a, s16x4 b) { return (bf16x8){a[0], a[1], a[2], a[3], b[0], b[1], b[2], b[3]}; }
DI int t5_bucket(int n) {
    if (n < 16) return n;
    int bkt = 16;
    bkt += (n >= 21); bkt += (n >= 27); bkt += (n >= 35); bkt += (n >= 46); bkt += (n >= 59); bkt += (n >= 77); bkt += (n >= 99); bkt += (n >= 128);
    bkt += (n >= 166); bkt += (n >= 216); bkt += (n >= 280); bkt += (n >= 363); bkt += (n >= 470); bkt += (n >= 609); bkt += (n >= 790);
    return bkt;
}
namespace pg8 {
#define PG8_LAS __attribute__((address_space(3)))
typedef unsigned short bf16_t;
typedef short bf16x8 __attribute__((ext_vector_type(8)));
typedef float f32x4 __attribute__((ext_vector_type(4)));
typedef unsigned u32x4 __attribute__((ext_vector_type(4)));
constexpr int BM = 256, BK = 64, HALF = 128, HTB = HALF * BK * 2  , STAGE_BYTES = 8 * HTB, NXCD = 8, WGM = 8;

__host__ __device__ __forceinline__ int lds_byte(int r, int c) { const int st = (r >> 4) * 2 + (c >> 5), rr = r & 15, cc = c & 31, ob = rr * 64 + cc * 2; return st * 1024 + (ob ^ (((ob >> 9) & 1) << 5)); }
__host__ __device__ __forceinline__ void stage_rc(int b, int& R, int& C) { const int st = b / 1024, sb = b % 1024, swz = sb ^ (((sb >> 9) & 1) << 5); R = (st >> 1) * 16 + swz / 64; C = (st & 1) * 32 + (swz % 64) / 2; }
__host__ __device__ __forceinline__ int perm32(int rho) { const int n = rho >> 4, i = rho & 15; return 8 * (i >> 2) + 4 * n + (i & 3); }

typedef int i32x8 __attribute__((ext_vector_type(8))); typedef int i32x4v __attribute__((ext_vector_type(4)));
__device__ __forceinline__ i32x8 pg8_cat8(bf16x8 lo, bf16x8 hi) { const i32x4v a = __builtin_bit_cast(i32x4v, lo), b = __builtin_bit_cast(i32x4v, hi); return (i32x8){a[0], a[1], a[2], a[3], b[0], b[1], b[2], b[3]}; }
struct Unit { int pm, pn; };
struct Gemm { const bf16_t* A; const bf16_t* Bt; int M, N, K; };

struct StaticOrder {
    int nM, nN, nwg, G, c;
    __host__ __device__ void init(int M, int N, int G_, int c_) { nM = M / BM; nN = N / BM; nwg = nM * nN; G = G_; c = c_; }
    __host__ __device__ bool next(int i, Unit& u) const {
        const long L = (long)i * G + c; if (L >= nwg) return false;
        int wgid = (int)L; { const int q = nwg / NXCD, r = nwg % NXCD, xcd = wgid % NXCD, off = wgid / NXCD; wgid = (xcd < r ? xcd * (q + 1) : r * (q + 1) + (xcd - r) * q) + off; }
        const int nig = WGM * nN, gid = wgid / nig, fm = gid * WGM, gsz = (nM - fm) < WGM ? (nM - fm) : WGM;
        u.pm = fm + ((wgid % nig) % gsz); u.pn = (wgid % nig) / gsz; return true;
    }
    __device__ __forceinline__ void a_ready(const Unit&) const {}
    __device__ __forceinline__ void done(const Unit&) const {}
};

__device__ __forceinline__ unsigned cvt_pk_bf16(float lo, float hi) { unsigned r; asm volatile("v_cvt_pk_bf16_f32 %0, %1, %2" : "=v"(r) : "v"(lo), "v"(hi)); return r; }
typedef float f32x2 __attribute__((ext_vector_type(2)));
__device__ __forceinline__ f32x2 gelu_pk(f32x2 v) {
    const f32x2 av = __builtin_elementwise_abs(v), d = av * 0.2316418882f + 1.0f;
    f32x2 t; t.x = __builtin_amdgcn_rcpf(d.x); t.y = __builtin_amdgcn_rcpf(d.y);
    f32x2 q = t * 0.5307027145f + (-0.7265760135f); q = q * t + 0.7107068705f; q = q * t + (-0.142248368f); q = q * t + 0.127414796f; q = q * t;
    const f32x2 s = (v * v) * (-0.72134752044f);
    f32x2 e; e.x = __builtin_amdgcn_exp2f(s.x); e.y = __builtin_amdgcn_exp2f(s.y);
    const f32x2 m = v * (q * e), r = v - m;
    f32x2 o; o.x = v.x < 0.f ? m.x : r.x; o.y = v.y < 0.f ? m.y : r.y; return o;
}

template <int ACT  > struct EpiBf16 {
    static constexpr bool PERM = true, AFTER_DRAIN = false; static_assert(ACT == 0 || ACT == 1, "EpiBf16: ACT is 0 (none) or 1 (gelu_pk)");
    bf16_t* O; int ldc; const float* bias; int split_cols; size_t split_stride; float scale0;
    __device__ __forceinline__ void operator()(const f32x4 (&acc)[2][2][4][2], const Unit& u, int wr, int wc, int fr, int fq) const {
        const int row0 = u.pm * BM + wr * 64 + fr; int colt = u.pn * BM; bf16_t* base = O;
        float sc = 1.f; if (split_cols) { const int t = colt / split_cols; base += (size_t)t * split_stride; colt -= t * split_cols; if (t == 0) sc = scale0; }
        const int col0 = colt + wc * 32 + 8 * fq, bcol0 = u.pn * BM + wc * 32 + 8 * fq;
        f32x4 bv[2][2];
#pragma unroll
        for (int bj = 0; bj < 2; ++bj)
#pragma unroll
            for (int n = 0; n < 2; ++n) bv[bj][n] = bias ? *(const f32x4*)(bias + bcol0 + bj * HALF + 4 * n) : (f32x4){0.f, 0.f, 0.f, 0.f};
#pragma unroll
        for (int ai = 0; ai < 2; ++ai)
#pragma unroll
            for (int m = 0; m < 4; ++m) { bf16_t* rowp = base + (size_t)(row0 + ai * HALF + m * 16) * ldc + col0;
#pragma unroll
                for (int bj = 0; bj < 2; ++bj) { f32x4 v0 = acc[ai][bj][m][0] + bv[bj][0], v1 = acc[ai][bj][m][1] + bv[bj][1];
                    if (ACT == 1) { f32x2 a = gelu_pk((f32x2){v0[0], v0[1]}), b = gelu_pk((f32x2){v0[2], v0[3]}), c = gelu_pk((f32x2){v1[0], v1[1]}), d = gelu_pk((f32x2){v1[2], v1[3]});
                        v0 = (f32x4){a.x, a.y, b.x, b.y}; v1 = (f32x4){c.x, c.y, d.x, d.y}; }
                    v0 = v0 * sc; v1 = v1 * sc; u32x4 w; w.x = cvt_pk_bf16(v0[0], v0[1]); w.y = cvt_pk_bf16(v0[2], v0[3]); w.z = cvt_pk_bf16(v1[0], v1[1]); w.w = cvt_pk_bf16(v1[2], v1[3]);
                    *(u32x4*)(rowp + bj * HALF) = w; } }
    }
};

template <class Epi, class Sched, bool ALIGN_EPI = false, bool SP2 = false, bool F8 = false>
__device__ __forceinline__ void gemm_phase(PG8_LAS unsigned char* lds, const Gemm g, const Sched& S, const Epi& E, int tid_in) {
    int tid_l = tid_in; asm volatile("" : "+v"(tid_l));
    const int tid = tid_l, wid = __builtin_amdgcn_readfirstlane(tid >> 6), lane = tid & 63, wr = wid >> 2, wc = wid & 3, fr = lane & 15, fq = lane >> 4;
    const int K = g.K, nt = K / BK;
    unsigned voffA[2], voffB[2];
#pragma unroll
    for (int i = 0; i < 2; ++i) { int R, C; stage_rc(tid * 16 + i * 8192, R, C); const int Rb = Epi::PERM ? ((R & ~31) + perm32(R & 31)) : R;
        voffA[i] = (unsigned)(R * K + C) * 2u; voffB[i] = (unsigned)(Rb * K + C) * 2u; }
    const size_t kstep = (size_t)(BK * 2);
    const size_t hstep = (size_t)HALF * K * 2;
    const size_t tstep = 2 * hstep;
    const unsigned ldsw = (unsigned)wid * 1024u;
    const int aoff = lds_byte(wr * 64 + fr, fq * 8), boff = lds_byte(wc * 32 + fr, fq * 8);
#define PG8_SA(b, h) (((b) * 2 + (h)) * HTB)
#define PG8_SB(b, h) ((4 + (b) * 2 + (h)) * HTB)
#define PG8_STAGE(bufoff, gbase, voff) do { _Pragma("unroll") for (int _i = 0; _i < 2; ++_i) \
        __builtin_amdgcn_global_load_lds((const unsigned*)((const char*)(gbase) + (voff)[_i]), (PG8_LAS unsigned*)(lds + (bufoff) + ldsw + _i * 8192), 16, 0, 0); } while (0)
#define PG8_LDA(dst, b, h) do { _Pragma("unroll") for (int m = 0; m < 4; ++m) _Pragma("unroll") for (int k = 0; k < 2; ++k) dst[m][k] = *(const PG8_LAS bf16x8*)(lds + PG8_SA(b, h) + aoff + m * 2048 + k * 1024); } while (0)
#define PG8_LDB(dst, b, h) do { _Pragma("unroll") for (int n = 0; n < 2; ++n) _Pragma("unroll") for (int k = 0; k < 2; ++k) dst[n][k] = *(const PG8_LAS bf16x8*)(lds + PG8_SB(b, h) + boff + n * 2048 + k * 1024); } while (0)
#define PG8_MMA(ai, bj, At, Bt) do { __builtin_amdgcn_s_setprio(1); if constexpr (!F8) { _Pragma("unroll") for (int m = 0; m < 4; ++m) _Pragma("unroll") for (int n = 0; n < 2; ++n) _Pragma("unroll") for (int k = 0; k < 2; ++k) \
        acc[ai][bj][m][n] = __builtin_amdgcn_mfma_f32_16x16x32_bf16(Bt[n][k], At[m][k], acc[ai][bj][m][n], 0, 0, 0); } else { _Pragma("unroll") for (int m = 0; m < 4; ++m) _Pragma("unroll") for (int n = 0; n < 2; ++n) \
        acc[ai][bj][m][n] = __builtin_amdgcn_mfma_scale_f32_16x16x128_f8f6f4(pg8_cat8(Bt[n][0], Bt[n][1]), pg8_cat8(At[m][0], At[m][1]), acc[ai][bj][m][n], 0, 0, 0, 0x7F7F7F7F, 0, 0x7F7F7F7F); \
        _Pragma("unroll") for (int m = 0; m < 4; ++m) _Pragma("unroll") for (int n = 0; n < 2; ++n) asm volatile("" : "+v"(acc[ai][bj][m][n]));   } __builtin_amdgcn_s_setprio(0); } while (0)
#define PG8_WAIT_V(n) asm volatile("s_waitcnt vmcnt(" #n ")" ::: "memory")
#define PG8_WAIT_L(n) asm volatile("s_waitcnt lgkmcnt(" #n ")" ::: "memory")
#define PG8_BAR __builtin_amdgcn_s_barrier()
#define PG8_SCHED __builtin_amdgcn_sched_barrier(0)
    Unit cur, nxt; int ui = 0;
    if (!S.next(0, cur)) return;
    f32x4 acc[2][2][4][2];
#pragma unroll
    for (int a = 0; a < 2; ++a)
#pragma unroll
        for (int b = 0; b < 2; ++b)
#pragma unroll
            for (int m = 0; m < 4; ++m)
#pragma unroll
                for (int n = 0; n < 2; ++n) acc[a][b][m][n] = (f32x4){0.f, 0.f, 0.f, 0.f};
    bf16x8 At[4][2], B0[2][2], B1[2][2];
    const char* cA = (const char*)g.A + (size_t)cur.pm * tstep; const char* cB = (const char*)g.Bt + (size_t)cur.pn * tstep;
    S.a_ready(cur);
    if constexpr (SP2) {
        PG8_STAGE(PG8_SB(0, 0), cB, voffB); PG8_STAGE(PG8_SB(0, 1), cB + hstep, voffB); PG8_STAGE(PG8_SA(0, 0), cA, voffA); PG8_STAGE(PG8_SA(0, 1), cA + hstep, voffA);
        if (wr == 1) PG8_BAR;
        PG8_WAIT_V(2); PG8_BAR;
        PG8_STAGE(PG8_SB(1, 0), cB + kstep, voffB); PG8_STAGE(PG8_SA(1, 0), cA + kstep, voffA); PG8_STAGE(PG8_SB(1, 1), cB + hstep + kstep, voffB);
        PG8_WAIT_V(6); PG8_BAR;
    } else {
        PG8_STAGE(PG8_SB(0, 0), cB, voffB); PG8_STAGE(PG8_SA(0, 0), cA, voffA); PG8_STAGE(PG8_SB(0, 1), cB + hstep, voffB); PG8_STAGE(PG8_SA(0, 1), cA + hstep, voffA);
        if (wr == 1) PG8_BAR;
        PG8_WAIT_V(4); PG8_BAR;
        PG8_STAGE(PG8_SB(1, 0), cB + kstep, voffB); PG8_STAGE(PG8_SA(1, 0), cA + kstep, voffA); PG8_STAGE(PG8_SB(1, 1), cB + hstep + kstep, voffB);
        PG8_WAIT_V(6); PG8_BAR;
    }
    for (;;) {
        const bool has_next = S.next(ui + 1, nxt);
        const char* nA = has_next ? (const char*)g.A + (size_t)nxt.pm * tstep : cA; const char* nB = has_next ? (const char*)g.Bt + (size_t)nxt.pn * tstep : cB;
        for (int t = 0; t < nt; t += 2) {
            const bool last = (t == nt - 2);
            const char* a1 = cA + (size_t)(t + 1) * kstep;
            const char* a2 = last ? nA : cA + (size_t)(t + 2) * kstep; const char* b2 = last ? nB : cB + (size_t)(t + 2) * kstep;
            const char* a3 = a2 + kstep; const char* b3 = b2 + kstep;
            if (last && has_next) S.a_ready(nxt);
            if constexpr (SP2) {
            PG8_LDB(B0, 0, 0); PG8_LDB(B1, 0, 1); PG8_SCHED; PG8_LDA(At, 0, 0); PG8_STAGE(PG8_SA(1, 1), a1 + hstep, voffA);
            PG8_WAIT_V(8); PG8_WAIT_L(0); PG8_BAR; PG8_MMA(0, 0, At, B0); PG8_MMA(0, 1, At, B1); PG8_BAR; PG8_SCHED;
            PG8_LDA(At, 0, 1); PG8_STAGE(PG8_SB(0, 0), b2, voffB); PG8_STAGE(PG8_SB(0, 1), b2 + hstep, voffB); PG8_STAGE(PG8_SA(0, 0), a2, voffA);
            PG8_WAIT_V(8); PG8_WAIT_L(0); PG8_BAR; PG8_MMA(1, 0, At, B0); PG8_MMA(1, 1, At, B1); PG8_BAR; PG8_SCHED;
            PG8_LDB(B0, 1, 0); PG8_LDB(B1, 1, 1); PG8_SCHED; PG8_LDA(At, 1, 0); PG8_STAGE(PG8_SA(0, 1), a2 + hstep, voffA);
            PG8_WAIT_V(8); PG8_WAIT_L(0); PG8_BAR; PG8_MMA(0, 0, At, B0); PG8_MMA(0, 1, At, B1); PG8_BAR; PG8_SCHED;
            PG8_LDA(At, 1, 1); PG8_STAGE(PG8_SB(1, 0), b3, voffB); PG8_STAGE(PG8_SB(1, 1), b3 + hstep, voffB); PG8_STAGE(PG8_SA(1, 0), a3, voffA);
            PG8_WAIT_V(8); PG8_WAIT_L(0); PG8_BAR; PG8_MMA(1, 0, At, B0); PG8_MMA(1, 1, At, B1); PG8_BAR; PG8_SCHED;
            } else {
            PG8_LDB(B0, 0, 0); PG8_SCHED; PG8_LDA(At, 0, 0); PG8_STAGE(PG8_SA(1, 1), a1 + hstep, voffA);
            PG8_WAIT_L(8); PG8_BAR; PG8_WAIT_L(0); PG8_MMA(0, 0, At, B0); PG8_BAR; PG8_SCHED;
            PG8_LDB(B1, 0, 1); PG8_STAGE(PG8_SB(0, 0), b2, voffB);
            PG8_BAR; PG8_WAIT_L(0); PG8_MMA(0, 1, At, B1); PG8_BAR;
            PG8_LDA(At, 0, 1); PG8_STAGE(PG8_SA(0, 0), a2, voffA);
            PG8_BAR; PG8_WAIT_L(0); PG8_MMA(1, 0, At, B0); PG8_BAR; PG8_SCHED;
            PG8_STAGE(PG8_SB(0, 1), b2 + hstep, voffB);
            PG8_WAIT_V(6); PG8_BAR; PG8_MMA(1, 1, At, B1); PG8_BAR;
            PG8_LDB(B0, 1, 0); PG8_SCHED; PG8_LDA(At, 1, 0); PG8_STAGE(PG8_SA(0, 1), a2 + hstep, voffA);
            PG8_WAIT_L(8); PG8_BAR; PG8_WAIT_L(0); PG8_MMA(0, 0, At, B0); PG8_BAR; PG8_SCHED;
            PG8_LDB(B1, 1, 1); PG8_STAGE(PG8_SB(1, 0), b3, voffB);
            PG8_BAR; PG8_WAIT_L(0); PG8_MMA(0, 1, At, B1); PG8_BAR;
            PG8_LDA(At, 1, 1); PG8_STAGE(PG8_SA(1, 0), a3, voffA);
            PG8_BAR; PG8_WAIT_L(0); PG8_MMA(1, 0, At, B0); PG8_BAR; PG8_SCHED;
            PG8_STAGE(PG8_SB(1, 1), b3 + hstep, voffB);
            PG8_WAIT_V(6); PG8_BAR; PG8_MMA(1, 1, At, B1); PG8_BAR;
            }
        }
        if constexpr (ALIGN_EPI) { if (wr == 0) PG8_BAR; }
        if constexpr (!Epi::AFTER_DRAIN) { E(acc, cur, wr, wc, fr, fq); S.done(cur); }
        if (!has_next) break;
#pragma unroll
        for (int a = 0; a < 2; ++a)
#pragma unroll
            for (int b = 0; b < 2; ++b)
#pragma unroll
                for (int m = 0; m < 4; ++m)
#pragma unroll
                    for (int n = 0; n < 2; ++n) acc[a][b][m][n] = (f32x4){0.f, 0.f, 0.f, 0.f};
        cur = nxt; cA = nA; cB = nB; ++ui;
        if constexpr (ALIGN_EPI) { if (wr == 1) PG8_BAR; }
    }
    PG8_WAIT_V(0);
    if constexpr (!ALIGN_EPI) { if (wr == 0) PG8_BAR; }
    PG8_BAR;
    if constexpr (Epi::AFTER_DRAIN) { E.fused(acc, cur, wr, wc, fr, fq, lds, wid, lane); S.done(cur); }
#undef PG8_SA
#undef PG8_SB
#undef PG8_STAGE
#undef PG8_LDA
#undef PG8_LDB
#undef PG8_MMA
#undef PG8_WAIT_V
#undef PG8_WAIT_L
#undef PG8_BAR
#undef PG8_SCHED
}
}

#ifndef PG8_SP2
#define PG8_SP2 true
#endif
#ifndef PG8_ALIGN
#define PG8_ALIGN true
#endif
#define XB_TMO      128
#define XB_XCNT(j)  (256  + 64 * (j))
#define XB_XSUB(j)  (1280 + 64 * (j))
#define XB_XGEN(j)  (2304 + 64 * (j))
#define XB_TOP      3328
#define XB_TOPGEN   3392
#define XCD_BAR_WORDS 3456
#define XB_SPIN_CAP (1u << 18)

__device__ __forceinline__ unsigned xb_ld(unsigned* p)              { return __hip_atomic_load(p, __ATOMIC_RELAXED, __HIP_MEMORY_SCOPE_AGENT); }
__device__ __forceinline__ unsigned xb_add(unsigned* p, unsigned v) { return __hip_atomic_fetch_add(p, v, __ATOMIC_RELAXED, __HIP_MEMORY_SCOPE_AGENT); }
__device__ __forceinline__ unsigned xb_xcc_id() { return (unsigned)__builtin_amdgcn_s_getreg((3 << 11) | 20) & 0xFu; }
#define XB_SPIN(cond, bar) do { unsigned _sp = 0; while (cond) { __builtin_amdgcn_s_sleep(1); \
    if ((++_sp & 255u) == 0u) { if (xb_ld(&(bar)[XB_TMO])) break; if (_sp > XB_SPIN_CAP) { atomicAdd(&(bar)[XB_TMO], 1u); break; } } } } while (0)

struct XcdBarrier {
    unsigned* bar; unsigned x;
    volatile LAS unsigned* st;
};

__device__ __forceinline__ XcdBarrier xcd_barrier_post(unsigned* bar, volatile LAS unsigned* st) {
    XcdBarrier b; b.bar = bar; b.x = xb_xcc_id(); b.st = st;
    if (threadIdx.x == 0) (void)xb_add(&bar[XB_XCNT(b.x)], 1u);
    return b;
}
__device__ __forceinline__ void xcd_barrier_complete(unsigned* bar, unsigned x, unsigned& nloc, unsigned& nx) {
    const unsigned G = gridDim.x * gridDim.y * gridDim.z;
    unsigned sum, cnt, mine, sp = 0u;
    for (;;) {
        sum = 0u; cnt = 0u; mine = 0u;
#pragma unroll
        for (unsigned j = 0; j < 16; ++j) { const unsigned c = xb_ld(&bar[XB_XCNT(j)]); sum += c; cnt += (c > 0u) ? 1u : 0u; mine = (j == x) ? c : mine; }
        if (sum == G) break;
        __builtin_amdgcn_s_sleep(1);
        if ((++sp & 255u) == 0u) { if (xb_ld(&bar[XB_TMO])) break; if (sp > XB_SPIN_CAP) { atomicAdd(&bar[XB_TMO], 1u); break; } }
    }
    nloc = mine > 0u ? mine : 1u; nx = cnt > 0u ? cnt : 1u;
}

__device__ __forceinline__ void xcd_barrier(const XcdBarrier& b, const bool is_t0  ) {
    asm volatile("s_waitcnt vmcnt(0)" ::: "memory");
    __syncthreads();
    if (is_t0) {
        unsigned* bar = b.bar;
        __builtin_amdgcn_s_waitcnt(0);
        unsigned nloc = b.st[0], nx = b.st[1];
        if (nloc == 0u) { xcd_barrier_complete(bar, b.x, nloc, nx); b.st[0] = nloc; b.st[1] = nx; }
        const unsigned old = xb_add(&bar[XB_XSUB(b.x)], 1u);
        const unsigned gen = old / nloc;
        if (old + 1u == (gen + 1u) * nloc) {
            __builtin_amdgcn_fence(__ATOMIC_RELEASE, "agent");
            asm volatile("s_waitcnt vmcnt(0)" ::: "memory");
            const unsigned og = xb_add(&bar[XB_TOP], 1u);
            const unsigned tg = og / nx;
            if (og + 1u == (tg + 1u) * nx) xb_add(&bar[XB_TOPGEN], 1u);
            else XB_SPIN(xb_ld(&bar[XB_TOPGEN]) == tg, bar);
            __builtin_amdgcn_fence(__ATOMIC_ACQUIRE, "agent");
            xb_add(&bar[XB_XGEN(b.x)], 1u);
            asm volatile("s_waitcnt vmcnt(0)" ::: "memory");
        } else {
            XB_SPIN(xb_ld(&bar[XB_XGEN(b.x)]) == gen, bar);
            __builtin_amdgcn_fence(__ATOMIC_ACQUIRE, "agent");
            asm volatile("s_waitcnt vmcnt(0)" ::: "memory");
        }
    }
    __syncthreads();
}
struct EpiResF32 {
    static constexpr bool PERM = true, AFTER_DRAIN = false;
    const float* xin; float* yp; float alpha;
    DI void operator()(const pg8::f32x4 (&acc)[2][2][4][2], const pg8::Unit& u, int wr, int wc, int fr, int fq) const {
        const int row0 = u.pm * 256 + wr * 64 + fr, col0 = u.pn * 256 + wc * 32 + 8 * fq;
#pragma unroll
        for (int ai = 0; ai < 2; ++ai)
#pragma unroll
            for (int m = 0; m < 4; ++m) {
                const size_t ro = (size_t)(row0 + ai * 128 + m * 16) * DM;
#pragma unroll
                for (int bj = 0; bj < 2; ++bj) {
                    const size_t o = ro + col0 + bj * 128;
                    const f32x4 x0 = *(const f32x4*)(xin + o), x1 = *(const f32x4*)(xin + o + 4);
                    *(f32x4*)(yp + o) = x0 * alpha + acc[ai][bj][m][0];
                    *(f32x4*)(yp + o + 4) = x1 * alpha + acc[ai][bj][m][1];
                }
            }
    }
};
struct EpiSwiglu {
    static constexpr bool PERM = true, AFTER_DRAIN = false;
    unsigned char* act; const float* bgu;
    DI void operator()(const pg8::f32x4 (&acc)[2][2][4][2], const pg8::Unit& u, int wr, int wc, int fr, int fq) const {
        const int e = u.pn >> 3, pl = u.pn & 7;
        const int row0 = u.pm * 256 + wr * 64 + fr, cih = pl * 128 + wc * 32 + 8 * fq;
        const float* bg = bgu + e * 2048 + cih;
        const f32x4 bg0 = *(const f32x4*)(bg), bg1 = *(const f32x4*)(bg + 4), bu0 = *(const f32x4*)(bg + 1024), bu1 = *(const f32x4*)(bg + 1028);
#pragma unroll
        for (int ai = 0; ai < 2; ++ai)
#pragma unroll
            for (int m = 0; m < 4; ++m) {
                constexpr float RS = 1.f / (F8_SX * F8_SWG);
                const f32x4 g0 = acc[ai][0][m][0] * RS + bg0, g1 = acc[ai][0][m][1] * RS + bg1, u0 = acc[ai][1][m][0] * RS + bu0, u1 = acc[ai][1][m][1] * RS + bu1;
                float r[8];
#pragma unroll
                for (int i = 0; i < 8; ++i) {
                    float g = i < 4 ? g0[i & 3] : g1[i & 3], uu = i < 4 ? u0[i & 3] : u1[i & 3];
                    g = fminf(g, 7.0f); uu = fminf(fmaxf(uu, -7.0f), 7.0f);
                    const float sg = __builtin_amdgcn_rcpf(1.0f + ex2(-1.702f * LOG2E * g));
                    r[i] = (uu + 1.0f) * g * sg * F8_SA;
                }
                v2u w; w.x = pk4_fp8(r[0], r[1], r[2], r[3]); w.y = pk4_fp8(r[4], r[5], r[6], r[7]);
                *(v2u*)(act + (size_t)(row0 + ai * 128 + m * 16) * DM + cih) = w;
            }
    }
};
struct EpiDown {
    static constexpr bool PERM = true, AFTER_DRAIN = false;
    bf16* yr; const float* bdn;
    DI void operator()(const pg8::f32x4 (&acc)[2][2][4][2], const pg8::Unit& u, int wr, int wc, int fr, int fq) const {
        const int e = u.pn >> 2, pl = u.pn & 3;
        const int row0 = u.pm * 256 + wr * 64 + fr, col0 = pl * 256 + wc * 32 + 8 * fq;
        f32x4 bv[2][2];
#pragma unroll
        for (int bj = 0; bj < 2; ++bj) { bv[bj][0] = *(const f32x4*)(bdn + e * 1024 + col0 + bj * 128); bv[bj][1] = *(const f32x4*)(bdn + e * 1024 + col0 + bj * 128 + 4); }
#pragma unroll
        for (int ai = 0; ai < 2; ++ai)
#pragma unroll
            for (int m = 0; m < 4; ++m) {
                bf16* rp = yr + (size_t)(row0 + ai * 128 + m * 16) * DM + col0;
#pragma unroll
                for (int bj = 0; bj < 2; ++bj) {
                    constexpr float RS = 1.f / (F8_SA * F8_SWD);
                    const f32x4 v0 = acc[ai][bj][m][0] * RS + bv[bj][0], v1 = acc[ai][bj][m][1] * RS + bv[bj][1];
                    v4u w; w.x = cvtpk(v0[0], v0[1]); w.y = cvtpk(v0[2], v0[3]); w.z = cvtpk(v1[0], v1[1]); w.w = cvtpk(v1[2], v1[3]);
                    *(v4u*)(rp + bj * 128) = w;
                }
            }
    }
};
struct GroupOrder {
    LAS const unsigned* tile_e; int ntiles, lg, G, c;
    DI bool next(int i, pg8::Unit& u) const {
        int pm, pl;
        if (G == 256) {
            const int x = c & 7, k = c >> 3; pm = i * (256 >> lg) + x * (32 >> lg) + (k >> lg); pl = k & ((1 << lg) - 1); if (pm >= ntiles) return false; }
        else { const long L = (long)i * G + c; if (L >= ((long)ntiles << lg)) return false; pm = (int)(L >> lg); pl = (int)(L & ((1 << lg) - 1)); }
        const int e = __builtin_amdgcn_readfirstlane((int)tile_e[pm]);
        u.pm = pm; u.pn = (e << lg) + pl; return true;
    }
    DI void a_ready(const pg8::Unit&) const {}
    DI void done(const pg8::Unit&) const {}
};
struct Args { const float* in[18]; float* out; unsigned char* ws; int ph_lo, ph_hi; };
struct Fr { LAS unsigned char* lds; unsigned char* ws; unsigned* ctl; int tid, lane, wave, blk, G; };

DI void tr_item(const float* W, int ldw, int K, int k0, int sc0, int nvalid, bf16* WT, int drow0, LAS float* scr, int lane) {
    const int c = lane & 31;
    float v[32];
#pragma unroll
    for (int i = 0; i < 32; ++i) v[i] = (c < nvalid) ? W[(size_t)(k0 + 2 * i + (lane >> 5)) * ldw + sc0 + c] : 0.f;
#pragma unroll
    for (int i = 0; i < 32; ++i) scr[(2 * i + (lane >> 5)) * 33 + c] = v[i];
    LDS_WAIT(); asm volatile("" ::: "memory");
    const int c8 = lane & 7;
#pragma unroll
    for (int j = 0; j < 4; ++j) { const int n = (lane >> 3) + 8 * j; const LAS float* s = scr + (8 * c8) * 33 + n;
        v4u o; o.x = cvtpk(s[0 * 33], s[1 * 33]); o.y = cvtpk(s[2 * 33], s[3 * 33]); o.z = cvtpk(s[4 * 33], s[5 * 33]); o.w = cvtpk(s[6 * 33], s[7 * 33]);
        *(v4u*)(WT + (size_t)(drow0 + n) * K + k0 + 8 * c8) = o; }
    LDS_WAIT(); asm volatile("" ::: "memory");
}
DI void tr_item8(const float* W, int ldw, int K, int k0, int sc0, float scale, unsigned char* WT8, int drow0, LAS float* scr, int lane) {
    const int c = lane & 31;
    float v[32];
#pragma unroll
    for (int i = 0; i < 32; ++i) v[i] = W[(size_t)(k0 + 2 * i + (lane >> 5)) * ldw + sc0 + c];
#pragma unroll
    for (int i = 0; i < 32; ++i) scr[(2 * i + (lane >> 5)) * 33 + c] = v[i] * scale;
    LDS_WAIT(); asm volatile("" ::: "memory");
    const int c16 = lane & 3;
#pragma unroll
    for (int j = 0; j < 2; ++j) { const int n = (lane >> 2) + 16 * j; const LAS float* s = scr + (16 * c16) * 33 + n;
        v4u o; o.x = pk4_fp8(s[0 * 33], s[1 * 33], s[2 * 33], s[3 * 33]); o.y = pk4_fp8(s[4 * 33], s[5 * 33], s[6 * 33], s[7 * 33]);
        o.z = pk4_fp8(s[8 * 33], s[9 * 33], s[10 * 33], s[11 * 33]); o.w = pk4_fp8(s[12 * 33], s[13 * 33], s[14 * 33], s[15 * 33]);
        *(v4u*)(WT8 + (size_t)(drow0 + n) * K + k0 + 16 * c16) = o; }
    LDS_WAIT(); asm volatile("" ::: "memory");
}
DI void ph_prologue(const Args& a, const Fr& F) {
    LAS float* scr = (LAS float*)(F.lds + F.wave * 16384);
    const int gw = F.blk * NWAVES + F.wave, NGW = F.G * NWAVES;
    constexpr int I_EV = 2 * 16 * 80, I_OD = 2 * 16 * 96, I_WO = 4 * 16 * 32;
    constexpr int NITEMS = I_EV + I_OD + I_WO;
    bf16* wev = (bf16*)(F.ws + WS_WEV); bf16* wod = (bf16*)(F.ws + WS_WOD); bf16* wout = (bf16*)(F.ws + WS_WOUT);
    unsigned char* wgu = F.ws + WS_WGU; unsigned char* wdn = F.ws + WS_WDN;
    for (int it = gw; it < NITEMS; it += NGW) {
        int r = it;
        if (r < I_EV) { const int l = r / 1280; r %= 1280; const int kb = r / 80, n0 = (r % 80) * 32; int sc0, nv = 32;
            if (n0 < 512) sc0 = n0; else if (n0 < 1024) sc0 = 964 + (n0 - 512); else if (n0 < 1536) sc0 = 1476 + (n0 - 1024); else if (n0 < 2048) sc0 = 1988 + (n0 - 1536);
            else if (n0 < 2176) sc0 = 512 + (n0 - 2048); else if (n0 < 2432) sc0 = 640 + (n0 - 2176); else if (n0 < 2496) sc0 = 896 + (n0 - 2432);
            else if (n0 < 2528) { sc0 = 960; nv = 4; } else { sc0 = 0; nv = 0; }
            tr_item(a.in[1] + (size_t)l * 1024 * 2500, 2500, 1024, kb * 64, sc0, nv, wev + (size_t)l * EV_N * 1024, n0, scr, F.lane); continue; }
        r -= I_EV;
        if (r < I_OD) { const int l = r / 1536; r %= 1536; const int kb = r / 96, n0 = (r % 96) * 32;
            tr_item(a.in[6] + (size_t)l * 1024 * 3088, 3088, 1024, kb * 64, n0, 32, wod + (size_t)l * OD_N * 1024, n0, scr, F.lane); continue; }
        r -= I_OD;
        if (r < I_WO) { const int l = r / 512; r %= 512; const int kb = r / 32, n0 = (r % 32) * 32;
            const float* src = (l & 1) ? a.in[8] + (size_t)(l >> 1) * 1024 * 1024 : a.in[5] + (size_t)(l >> 1) * 1024 * 1024;
            tr_item(src, 1024, 1024, kb * 64, n0, 32, wout + (size_t)l * 1024 * 1024, n0, scr, F.lane); continue; }
    }
    { __syncthreads();
        LAS float* tile = (LAS float*)F.lds; unsigned char* wgu8 = F.ws + WS_WGU; unsigned char* wdn8 = F.ws + WS_WDN;
        constexpr int T_GU = 128 * 8 * 16, T_DN = 128 * 8 * 8, T_ALL = T_GU + T_DN;
        const int tid = F.tid, c4 = tid & 31, r0 = tid >> 5;
        f32x4 v[8];
        auto locate = [&](int t, const float*& src, int& ldw, unsigned char*& dst, float& scale) {
            if (t < T_GU) { const int le = t >> 7, r = t & 127, kb = r >> 4, nb = r & 15, n0 = nb * 128; const int pn = n0 >> 8, bj = (n0 >> 7) & 1;
                src = a.in[14] + (size_t)le * 1024 * 2048 + (size_t)(kb * 128) * 2048 + bj * 1024 + pn * 128; ldw = 2048; dst = wgu8 + (size_t)le * 2048 * 1024 + (size_t)n0 * 1024 + kb * 128; scale = F8_SWG; }
            else { const int u = t - T_GU, le = u >> 6, r = u & 63, kb = r >> 3, nb = r & 7;
                src = a.in[16] + (size_t)le * 1024 * 1024 + (size_t)(kb * 128) * 1024 + nb * 128; ldw = 1024; dst = wdn8 + (size_t)le * 1024 * 1024 + (size_t)(nb * 128) * 1024 + kb * 128; scale = F8_SWD; } };
        int t = F.blk;
        if (t < T_ALL) { const float* src; int ldw; unsigned char* dst; float sc; locate(t, src, ldw, dst, sc);
#pragma unroll
            for (int i = 0; i < 8; ++i) v[i] = *(const f32x4*)(src + (size_t)(r0 + 16 * i) * ldw + 4 * c4); }
        for (; t < T_ALL; t += F.G) {
            const float* src; int ldw; unsigned char* dst; float sc; locate(t, src, ldw, dst, sc);
#pragma unroll
            for (int i = 0; i < 8; ++i) { LAS float* tp = tile + (r0 + 16 * i) * 129 + 4 * c4; tp[0] = v[i][0] * sc; tp[1] = v[i][1] * sc; tp[2] = v[i][2] * sc; tp[3] = v[i][3] * sc; }
            __syncthreads();
            if (t + F.G < T_ALL) { const float* s2; int l2; unsigned char* d2; float c2; locate(t + F.G, s2, l2, d2, c2);
#pragma unroll
                for (int i = 0; i < 8; ++i) v[i] = *(const f32x4*)(s2 + (size_t)(r0 + 16 * i) * l2 + 4 * c4); }
#pragma unroll
            for (int j = 0; j < 2; ++j) { const int p = tid + 512 * j, kc = p & 7, n = p >> 3; const LAS float* sp = tile + (kc * 16) * 129 + n;
                v4u o; o.x = pk4_fp8(sp[0], sp[129], sp[2 * 129], sp[3 * 129]); o.y = pk4_fp8(sp[4 * 129], sp[5 * 129], sp[6 * 129], sp[7 * 129]);
                o.z = pk4_fp8(sp[8 * 129], sp[9 * 129], sp[10 * 129], sp[11 * 129]); o.w = pk4_fp8(sp[12 * 129], sp[13 * 129], sp[14 * 129], sp[15 * 129]);
                *(v4u*)(dst + (size_t)n * 1024 + kc * 16) = o; }
            __syncthreads();
        }
    }
    bf16* xb = (bf16*)(F.ws + WS_XB);
    for (int m = gw; m < NTOK; m += NGW) {
        const f32x4* xr = (const f32x4*)(a.in[0] + (size_t)m * DM) + F.lane; v2u* o = (v2u*)(xb + (size_t)m * DM) + F.lane;
#pragma unroll
        for (int j = 0; j < 4; ++j) { const f32x4 v = xr[64 * j]; v2u w; w.x = cvtpk(v[0], v[1]); w.y = cvtpk(v[2], v[3]); o[64 * j] = w; }
    }
    bf16* wukt = (bf16*)(F.ws + WS_WUKT); bf16* wuvt = (bf16*)(F.ws + WS_WUVT);
    for (int i = F.blk * NTHR + F.tid; i < 2 * 8 * 128 * 64; i += F.G * NTHR) {
        { const int d = i & 63, c = (i >> 6) & 127, lh = i >> 13; wukt[i] = (bf16)f2bf(a.in[2][((size_t)lh * 64 + d) * 128 + c]); }
        { const int c = i & 127, d = (i >> 7) & 63, lh = i >> 13; wuvt[i] = (bf16)f2bf(a.in[3][((size_t)lh * 128 + c) * 64 + d]); }
    }
}

DI void ln_row(f32x4 (&v)[4], const float* g, const float* b, int lane) {
    float s = 0.f;
#pragma unroll
    for (int j = 0; j < 4; ++j) s += (v[j][0] + v[j][1]) + (v[j][2] + v[j][3]);
    const float mean = wave_sum(s) * (1.f / DM); float s2 = 0.f;
#pragma unroll
    for (int j = 0; j < 4; ++j) { v[j] = v[j] - mean; s2 += (v[j][0] * v[j][0] + v[j][1] * v[j][1]) + (v[j][2] * v[j][2] + v[j][3] * v[j][3]); }
    const float rstd = 1.f / sqrtf(wave_sum(s2) * (1.f / DM) + LN_EPS);
#pragma unroll
    for (int j = 0; j < 4; ++j) { const f32x4 gg = *((const f32x4*)g + lane + 64 * j), bb = *((const f32x4*)b + lane + 64 * j); v[j] = v[j] * rstd * gg + bb; }
}
DI void store_row_f32(float* p, const f32x4 (&v)[4], int lane) {
#pragma unroll
    for (int j = 0; j < 4; ++j) *((f32x4*)p + lane + 64 * j) = v[j];
}
DI void store_row_bf16(bf16* p, const f32x4 (&v)[4], int lane) {
#pragma unroll
    for (int j = 0; j < 4; ++j) { v2u w; w.x = cvtpk(v[j][0], v[j][1]); w.y = cvtpk(v[j][2], v[j][3]); *((v2u*)p + lane + 64 * j) = w; }
}
template <int NL> DI void small_proj(LAS const float* xs, const float* W, int ldw, int lane, float (&acc)[4]) {
    constexpr int PARTS = 64 / NL, DPER = 1024 / PARTS;
    const int n = lane & (NL - 1), part = lane / NL;
    acc[0] = acc[1] = acc[2] = acc[3] = 0.f;
    const float* wp = W + (size_t)(part * DPER) * ldw + n;
    LAS const float* xp = xs + part * DPER;
#pragma unroll 8
    for (int d = 0; d < DPER; ++d) { const float w = wp[(size_t)d * ldw];
        acc[0] += w * xp[d]; acc[1] += w * xp[1024 + d]; acc[2] += w * xp[2048 + d]; acc[3] += w * xp[3072 + d]; }
#pragma unroll
    for (int o = NL; o < 64; o <<= 1) {
#pragma unroll
        for (int k = 0; k < 4; ++k) acc[k] += __shfl_xor(acc[k], o); }
}

DI void ph_even_prep(const Args& a, const Fr& F, int j) {
    const bf16* proj = (const bf16*)(F.ws + WS_PROJ);
    bf16* ckvn = (bf16*)(F.ws + WS_CKVN); bf16* ql = (bf16*)(F.ws + WS_QL); float* kbar = (float*)(F.ws + WS_KBAR);
    const float* kvg = a.in[4] + j * 128;
    const bf16* wukt = (const bf16*)(F.ws + WS_WUKT) + (size_t)j * 8 * 128 * 64;
    const int lane = F.lane, wave = F.wave;
    for (int chunk = F.blk; chunk < 256; chunk += F.G) {
        const int tok0 = chunk * 128;
#pragma unroll 1
        for (int i0 = 0; i0 < 16; i0 += 8) { unsigned wv[8];
#pragma unroll
            for (int i = 0; i < 8; ++i) wv[i] = *((const unsigned*)(proj + (size_t)(tok0 + wave * 16 + i0 + i) * EV_N + EC_CKV) + lane);
#pragma unroll
            for (int i = 0; i < 8; ++i) { const int tok = tok0 + wave * 16 + i0 + i; const float v0 = bf2f(wv[i] & 0xffffu), v1 = bf2f(wv[i] >> 16);
                const float ss = wave_sum(v0 * v0 + v1 * v1);
                const float r = 1.f / sqrtf(ss * (1.f / 128.f) + LN_EPS);
                *((unsigned*)(ckvn + (size_t)tok * 128) + lane) = cvtpk(v0 * r * kvg[2 * lane], v1 * r * kvg[2 * lane + 1]); } }
        { bf16* kic = (bf16*)(F.ws + WS_KIC); const int tok = tok0 + wave * 16 + (lane >> 2), c = (lane & 3) * 16;
            const v4u* src = (const v4u*)(proj + (size_t)tok * EV_N + EC_KI + c); v4u* dst = (v4u*)(kic + (size_t)tok * 64 + c); dst[0] = src[0]; dst[1] = src[1]; }
        { const int h = wave, l15 = lane & 15, kg = lane >> 4;
            bf16x8 af[8][2];
#pragma unroll
            for (int ct = 0; ct < 8; ++ct)
#pragma unroll
                for (int ks = 0; ks < 2; ++ks) af[ct][ks] = *(const bf16x8*)(wukt + ((size_t)h * 128 + ct * 16 + l15) * 64 + ks * 32 + kg * 8);
#pragma unroll 1
            for (int tg = 0; tg < 8; tg += 4) { bf16x8 qf[4][2];
#pragma unroll
                for (int u = 0; u < 4; ++u)
#pragma unroll
                    for (int ks = 0; ks < 2; ++ks) qf[u][ks] = *(const bf16x8*)(proj + (size_t)(tok0 + (tg + u) * 16 + l15) * EV_N + EC_QA + h * 64 + ks * 32 + kg * 8);
#pragma unroll
                for (int u = 0; u < 4; ++u) { const int tok = tok0 + (tg + u) * 16 + l15;
#pragma unroll
                    for (int ct = 0; ct < 8; ++ct) { f32x4 d = {0.f, 0.f, 0.f, 0.f};
                        d = mfma16(af[ct][0], qf[u][0], d); d = mfma16(af[ct][1], qf[u][1], d);
                        v2u w; w.x = cvtpk(d[0], d[1]); w.y = cvtpk(d[2], d[3]);
                        *(v2u*)(ql + (size_t)tok * 1024 + h * 128 + ct * 16 + 4 * kg) = w; } } } }
        if (chunk < 128) { const int b = chunk >> 5, n = chunk & 31; float s8[8];
#pragma unroll
            for (int k = 0; k < 8; ++k) s8[k] = 0.f;
            const bf16* kp = proj + ((size_t)b * SEQ + n * 256 + wave * 32) * EV_N + EC_KB + lane * 8;
#pragma unroll 8
            for (int r = 0; r < 32; ++r) { const v4u w = *(const v4u*)(kp + (size_t)r * EV_N);
#pragma unroll
                for (int k = 0; k < 4; ++k) { s8[2 * k] += bf2f(w[k] & 0xffffu); s8[2 * k + 1] += bf2f(w[k] >> 16); } }
            LAS float* red = (LAS float*)F.lds;
            __syncthreads();
#pragma unroll
            for (int k = 0; k < 8; ++k) red[wave * 512 + lane * 8 + k] = s8[k];
            __syncthreads();
            float s = 0.f;
#pragma unroll
            for (int w = 0; w < 8; ++w) s += red[w * 512 + F.tid];
            const int h = F.tid >> 6, d = F.tid & 63;
            kbar[(((size_t)b * 8 + h) * 32 + n) * 64 + d] = s * (1.f / 256.f); }
    }
}

DI void moba_gate_chunk(const Fr& F, int chunk) {
    const bf16* proj = (const bf16*)(F.ws + WS_PROJ); const float* kbar = (const float*)(F.ws + WS_KBAR); unsigned* sel3 = (unsigned*)(F.ws + WS_SEL3);
    const int tok0 = chunk * 128, b = tok0 / SEQ, own = (tok0 % SEQ) >> 8, h = F.wave, lane = F.lane;
    float q0[64], q1[64];
    { const v4u* p0 = (const v4u*)(proj + (size_t)(tok0 + lane) * EV_N + EC_QB + h * 64); const v4u* p1 = (const v4u*)(proj + (size_t)(tok0 + 64 + lane) * EV_N + EC_QB + h * 64);
#pragma unroll
        for (int i = 0; i < 8; ++i) { const v4u w0 = p0[i], w1 = p1[i];
#pragma unroll
            for (int k = 0; k < 4; ++k) { q0[8 * i + 2 * k] = bf2f(w0[k] & 0xffffu); q0[8 * i + 2 * k + 1] = bf2f(w0[k] >> 16); q1[8 * i + 2 * k] = bf2f(w1[k] & 0xffffu); q1[8 * i + 2 * k + 1] = bf2f(w1[k] >> 16); } } }
    float a0 = -INFINITY, a1 = -INFINITY, a2 = -INFINITY, c0 = -INFINITY, c1 = -INFINITY, c2 = -INFINITY; int ai0 = 0, ai1 = 0, ai2 = 0, ci0 = 0, ci1 = 0, ci2 = 0;
    const float* kb = kbar + (((size_t)b * 8 + h) * 32) * 64;
    for (int n = 0; n < own; ++n) { float g0 = 0.f, g1 = 0.f;
#pragma unroll
        for (int d = 0; d < 64; d += 4) { const f32x4 kv = *(const f32x4*)(kb + n * 64 + d);
#pragma unroll
            for (int k = 0; k < 4; ++k) { g0 += q0[d + k] * kv[k]; g1 += q1[d + k] * kv[k]; } }
        if (g0 > a2) { if (g0 > a1) { a2 = a1; ai2 = ai1; if (g0 > a0) { a1 = a0; ai1 = ai0; a0 = g0; ai0 = n; } else { a1 = g0; ai1 = n; } } else { a2 = g0; ai2 = n; } }
        if (g1 > c2) { if (g1 > c1) { c2 = c1; ci2 = ci1; if (g1 > c0) { c1 = c0; ci1 = ci0; c0 = g1; ci0 = n; } else { c1 = g1; ci1 = n; } } else { c2 = g1; ci2 = n; } }
    }
    const unsigned nv = own < 3 ? own : 3;
    sel3[(size_t)(tok0 + lane) * 8 + h] = (unsigned)ai0 | ((unsigned)ai1 << 8) | ((unsigned)ai2 << 16) | (nv << 24);
    sel3[(size_t)(tok0 + 64 + lane) * 8 + h] = (unsigned)ci0 | ((unsigned)ci1 << 8) | ((unsigned)ci2 << 16) | (nv << 24);
}

constexpr int HS = 257;
DI float relu1(float x) { const unsigned u = __float_as_uint(x); return __uint_as_float(u & ~(unsigned)((int)u >> 31)); }
template <int MODE, bool DIAG> DI void idx_tile(const bf16x8 (&kf)[4], LAS const char* qb  , const float (&wj)[4], int kt, int q, int hi, unsigned c0, unsigned c1,
                                     LAS unsigned* hist, LAS unsigned* mask, LAS unsigned* cmask, LAS unsigned long long* cand, LAS unsigned* rinfo) {
    f32x2 scp[8];
#pragma unroll
    for (int p = 0; p < 8; ++p) scp[p] = (f32x2){0.f, 0.f};
#pragma unroll
    for (int g = 0; g < 2; ++g) { f32x16 acc[2];
#pragma unroll
        for (int j = 0; j < 2; ++j)
#pragma unroll
            for (int r = 0; r < 16; ++r) acc[j][r] = 0.f;
#pragma unroll
        for (int s = 0; s < 4; ++s)
#pragma unroll
            for (int j = 0; j < 2; ++j) acc[j] = mfma32(kf[s], *(LAS const bf16x8*)(qb + ((2 * g + j) * 8 + s * 2) * 512), acc[j]);
#pragma unroll
        for (int p = 0; p < 8; ++p)
#pragma unroll
            for (int j = 0; j < 2; ++j) { const f32x2 a = {relu1(acc[j][2 * p]), relu1(acc[j][2 * p + 1])}; const f32x2 w2 = {wj[2 * g + j], wj[2 * g + j]}; scp[p] = a * w2 + scp[p]; } }
    unsigned sel = 0u, cnd = 0u;
    const float F0 = __uint_as_float(c0), F1 = __uint_as_float(c1);
#pragma unroll
    for (int r = 0; r < 16; ++r) { const int kr = crow(r, hi);
        const bool ok = !DIAG || kr <= q;
        const float scv = scp[r >> 1][r & 1]; const unsigned u = __float_as_uint(scv);
        if (MODE == 1) { const unsigned key = u ^ ((unsigned)((int)u >> 31) | 0x80000000u);
            if (ok && (key >> 24) >= c0) __hip_atomic_fetch_add(hist + q * HS + (key >> 24), 1u, __ATOMIC_RELAXED, __HIP_MEMORY_SCOPE_WORKGROUP); }
        else if (MODE == 2) { if (ok && (u >> 24) == c0) __hip_atomic_fetch_add(hist + q * HS + (((u >> 16) & 255u) ^ c1), 1u, __ATOMIC_RELAXED, __HIP_MEMORY_SCOPE_WORKGROUP); }
        else { const bool ge1 = scv >= F1, ge0 = scv >= F0;
            if (ok && ge1) sel |= 1u << kr;
            if (ok && ge0 && !ge1) { cnd |= 1u << kr; const unsigned key = u ^ ((unsigned)((int)u >> 31) | 0x80000000u);
                const unsigned pos = __hip_atomic_fetch_add(rinfo + 128 + q, 1u, __ATOMIC_RELAXED, __HIP_MEMORY_SCOPE_WORKGROUP);
                if (pos < 64u) cand[q * 64 + pos] = ((unsigned long long)key << 32) | (unsigned)(~(unsigned)(kt * 32 + kr)); } } }
    if (MODE == 3) { if (sel) __hip_atomic_fetch_or(mask + q * HS + kt, sel, __ATOMIC_RELAXED, __HIP_MEMORY_SCOPE_WORKGROUP);
        if (cnd) __hip_atomic_fetch_or(cmask + q * HS + kt, cnd, __ATOMIC_RELAXED, __HIP_MEMORY_SCOPE_WORKGROUP); }
}
template <int MODE> DI void idx_pass(const bf16* proj, int rowbase, int qt, LAS const char* qimg, const float (&wj)[4], LAS unsigned* hist, LAS unsigned* mask, LAS unsigned* cmask, LAS unsigned long long* cand, LAS unsigned* rinfo, int wave, int lane) {
    const int q = lane & 31, hi = lane >> 5, nkt = qt + 1;
    const unsigned b1 = MODE == 2 ? rinfo[160 + q] : rinfo[224 + q], thr16 = MODE == 2 ? rinfo[192 + q] : rinfo[256 + q];
    const bf16* kp0 = proj + (size_t)(rowbase + q) * 64 + hi * 8;
    LAS const char* qb = qimg + hi * 512 + q * 16;
    const int n = nkt > wave ? (nkt - wave + 7) >> 3 : 0;
    bf16x8 kfa[4], kfb[4], kfc[4];
#define IDX_LOAD(KF, I) do { const bf16* kp_ = kp0 + (size_t)((wave + 8 * (I)) * 32) * 64; _Pragma("unroll") for (int s_ = 0; s_ < 4; ++s_) KF[s_] = *(const bf16x8*)(kp_ + s_ * 16); } while (0)
#define IDX_TILE(KF, I) do { const int kt_ = wave + 8 * (I); if (kt_ == qt) idx_tile<MODE, true>(KF, qb, wj, kt_, q, hi, b1, thr16, hist, mask, cmask, cand, rinfo); \
        else idx_tile<MODE, false>(KF, qb, wj, kt_, q, hi, b1, thr16, hist, mask, cmask, cand, rinfo); } while (0)
    if (n > 0) IDX_LOAD(kfa, 0);
    if (n > 1) IDX_LOAD(kfb, 1);
    for (int i = 0; i < n; i += 3) {
        if (i + 2 < n) IDX_LOAD(kfc, i + 2);
        IDX_TILE(kfa, i);
        if (i + 1 < n) { if (i + 3 < n) IDX_LOAD(kfa, i + 3); IDX_TILE(kfb, i + 1); }
        if (i + 2 < n) { if (i + 4 < n) IDX_LOAD(kfb, i + 4); IDX_TILE(kfc, i + 2); }
    }
#undef IDX_LOAD
#undef IDX_TILE
}
DI void hist_pick(LAS const unsigned* hrow, unsigned need, int lane, unsigned& bin, unsigned& above) {
    unsigned h4[4];
#pragma unroll
    for (int k = 0; k < 4; ++k) h4[k] = hrow[4 * lane + k];
    const unsigned ssum = h4[0] + h4[1] + h4[2] + h4[3];
    unsigned x = ssum;
#pragma unroll
    for (int o = 1; o < 64; o <<= 1) { const unsigned y = __shfl_down(x, o); if (lane + o < 64) x += y; }
    const unsigned long long m = __ballot(x >= need);
    const int Ls = m ? 63 - __builtin_clzll(m) : 0;
    const unsigned xs = __shfl(x, Ls), ss = __shfl(ssum, Ls);
    const unsigned h0 = __shfl(h4[0], Ls), h1 = __shfl(h4[1], Ls), h2 = __shfl(h4[2], Ls), h3 = __shfl(h4[3], Ls);
    unsigned cum = xs - ss;
    if (cum + h3 >= need) { bin = 4 * Ls + 3; above = cum; return; } cum += h3;
    if (cum + h2 >= need) { bin = 4 * Ls + 2; above = cum; return; } cum += h2;
    if (cum + h1 >= need) { bin = 4 * Ls + 1; above = cum; return; } cum += h1;
    bin = 4 * Ls; above = cum; (void)h0;
}
DI void idx_pass1(const bf16* proj, int rowbase, int qt, LAS const char* qimg, const float (&wj)[4], LAS unsigned* hist, LAS unsigned* mask, LAS unsigned* cmask, LAS unsigned long long* cand, LAS unsigned* rinfo, int wave, int lane) {
    const int q = lane & 31, hi = lane >> 5, nkt = qt + 1, nmax = (nkt + 7) >> 3;
    const bf16* kp0 = proj + (size_t)(rowbase + q) * 64 + hi * 8;
    LAS const char* qb = qimg + hi * 512 + q * 16;
    unsigned lb = 0u;
    bf16x8 kfc[4], kfn[4];
    if (wave < nkt) {
#pragma unroll
        for (int s = 0; s < 4; ++s) kfc[s] = *(const bf16x8*)(kp0 + (size_t)(wave * 32) * 64 + s * 16); }
    for (int i = 0; i < nmax; ++i) { const int kt = wave + 8 * i;
        if (kt + 8 < nkt) {
#pragma unroll
            for (int s = 0; s < 4; ++s) kfn[s] = *(const bf16x8*)(kp0 + (size_t)((kt + 8) * 32) * 64 + s * 16); }
        if (kt < nkt) { if (kt == qt) idx_tile<1, true>(kfc, qb, wj, kt, q, hi, lb, 0u, hist, mask, cmask, cand, rinfo); else idx_tile<1, false>(kfc, qb, wj, kt, q, hi, lb, 0u, hist, mask, cmask, cand, rinfo); }
#pragma unroll
        for (int s = 0; s < 4; ++s) kfc[s] = kfn[s];
        if (((i + 1) & i) == 0 && i + 1 < nmax && i < 16) {
            __syncthreads();
#pragma unroll 1
            for (int rr = 0; rr < 4; ++rr) { const int row = wave * 4 + rr; unsigned bin, above; hist_pick(hist + row * HS, 256u, lane, bin, above);
                if (lane == 0) rinfo[288 + row] = bin; }
            __syncthreads();
            { const unsigned nb = rinfo[288 + q]; lb = nb > lb ? nb : lb; } }
    }
}
DI void idx_unit(const Fr& F, int b, int qt, int stop = 0  ) {
    const bf16* proj = (const bf16*)(F.ws + WS_PROJ); const bf16* kic = (const bf16*)(F.ws + WS_KIC); unsigned short* sel = (unsigned short*)(F.ws + WS_SEL);
    LAS unsigned* hist = (LAS unsigned*)(F.lds); LAS unsigned* mask = hist + 32 * HS; LAS unsigned* cmask = mask + 32 * HS;
    LAS unsigned long long* cand = (LAS unsigned long long*)(F.lds + 99328); LAS unsigned* rinfo = (LAS unsigned*)(F.lds + 115712);
    const int lane = F.lane, wave = F.wave, tid = F.tid, t0 = qt * 32, rowbase = b * SEQ;
    __syncthreads();
    for (int i = tid; i < 3 * 32 * HS; i += NTHR) hist[i] = 0u;
    if (tid < 320) rinfo[tid] = 0u;
    __syncthreads();
    if (t0 + 31 <= 255 || (EXPF & 64)) {
        if (lane < 8) {
#pragma unroll
            for (int rr = 0; rr < 4; ++rr) { const int row = wave * 4 + rr, nv = t0 + row + 1;
                const int nv0 = t0 + row + 1; const int nvc = nv0 < 256 ? nv0 : 256; (void)nv; mask[row * HS + lane] = nvc >= 32 * (lane + 1) ? 0xffffffffu : (nvc > 32 * lane ? ((1u << (nvc - 32 * lane)) - 1u) : 0u); } }
    } else {
        const int q = lane & 31;
        float wj[4];
        { const bf16* qp = proj + (size_t)(rowbase + t0 + q) * EV_N;
#pragma unroll
            for (int j = 0; j < 4; ++j) wj[j] = bf2f(qp[EC_WI + j]); }
        LAS char* qimg = (LAS char*)(F.lds + 117248);
#pragma unroll
        for (int i = 0; i < 2; ++i) { const int p = tid + i * NTHR, row = p & 31, c = p >> 5;
            *(LAS v4u*)(qimg + c * 512 + row * 16) = *(const v4u*)(proj + (size_t)(rowbase + t0 + row) * EV_N + EC_QI + c * 8); }
        __syncthreads();
        idx_pass1(kic, rowbase, qt, qimg, wj, hist, mask, cmask, cand, rinfo, wave, lane);
        __syncthreads();
#pragma unroll 1
        for (int rr = 0; rr < 4; ++rr) { const int row = wave * 4 + rr; unsigned bin, above; hist_pick(hist + row * HS, 256u, lane, bin, above);
            if (lane == 0) { rinfo[row] = bin; rinfo[32 + row] = 256u - above; rinfo[160 + row] = bin >= 128u ? bin - 128u : 255u - bin; rinfo[192 + row] = bin >= 128u ? 0u : 255u; } }
        __syncthreads();
        if (stop == 1) return;
        for (int i = tid; i < 32 * HS; i += NTHR) hist[i] = 0u;
        __syncthreads();
        idx_pass<2>(kic, rowbase, qt, qimg, wj, hist, mask, cmask, cand, rinfo, wave, lane);
        __syncthreads();
#pragma unroll 1
        for (int rr = 0; rr < 4; ++rr) { const int row = wave * 4 + rr; const unsigned need1 = rinfo[32 + row]; unsigned bin, above; hist_pick(hist + row * HS, need1, lane, bin, above);
            if (lane == 0) { const unsigned t16 = (rinfo[row] << 8) | bin, k0 = t16 << 16, k1 = (t16 + 1u) << 16;
                rinfo[64 + row] = t16; rinfo[96 + row] = need1 - above;
                rinfo[224 + row] = (k0 & 0x80000000u) ? (k0 ^ 0x80000000u) : ~k0; rinfo[256 + row] = (t16 == 0xffffu) ? 0x7fc00000u : ((k1 & 0x80000000u) ? (k1 ^ 0x80000000u) : ~k1); } }
        __syncthreads();
        if (stop == 2) return;
        idx_pass<3>(kic, rowbase, qt, qimg, wj, hist, mask, cmask, cand, rinfo, wave, lane);
        __syncthreads();
        if (stop == 3) return;
#pragma unroll 1
        for (int rr = 0; rr < 4; ++rr) { const int row = wave * 4 + rr; const unsigned call = rinfo[128 + row], need2 = rinfo[96 + row];
            if (call <= 64u) { const unsigned c = call;
                const unsigned long long mine = cand[row * 64 + lane]; unsigned rank = 0u;
                for (unsigned k = 0; k < c; ++k) rank += (cand[row * 64 + k] > mine) ? 1u : 0u;
                if ((unsigned)lane < c && rank < need2) { const unsigned s = ~(unsigned)mine;
                    __hip_atomic_fetch_or(mask + row * HS + (s >> 5), 1u << (s & 31), __ATOMIC_RELAXED, __HIP_MEMORY_SCOPE_WORKGROUP); } }
            else { unsigned w4[4];
#pragma unroll
                for (int k = 0; k < 4; ++k) w4[k] = cmask[row * HS + 4 * lane + k];
                const unsigned cnt = __popc(w4[0]) + __popc(w4[1]) + __popc(w4[2]) + __popc(w4[3]);
                unsigned x = cnt;
#pragma unroll
                for (int o = 1; o < 64; o <<= 1) { const unsigned y = __shfl_up(x, o); if (lane >= o) x += y; }
                unsigned before = x - cnt;
#pragma unroll
                for (int k = 0; k < 4; ++k) { unsigned w = w4[k]; const unsigned pc = __popc(w); unsigned take = 0u;
                    if (before < need2) { if (before + pc <= need2) take = w; else { unsigned left = need2 - before; while (left) { const unsigned b = w & (0u - w); take |= b; w ^= b; --left; } } }
                    before += pc;
                    if (take) mask[row * HS + 4 * lane + k] |= take; } }
        }
    }
    __syncthreads();
#pragma unroll 1
    for (int rr = 0; rr < 4; ++rr) { const int row = wave * 4 + rr; unsigned short* out = sel + (size_t)(rowbase + t0 + row) * 256;
        unsigned w4[4];
#pragma unroll
        for (int k = 0; k < 4; ++k) w4[k] = mask[row * HS + 4 * lane + k];
        const unsigned cnt = __popc(w4[0]) + __popc(w4[1]) + __popc(w4[2]) + __popc(w4[3]);
        unsigned x = cnt;
#pragma unroll
        for (int o = 1; o < 64; o <<= 1) { const unsigned y = __shfl_up(x, o); if (lane >= o) x += y; }
        const unsigned total = __shfl(x, 63); unsigned pos = x - cnt;
#pragma unroll
        for (int k = 0; k < 4; ++k) { unsigned w = w4[k]; const unsigned base = (unsigned)(4 * lane + k) * 32u;
            while (w) { const unsigned bit = __builtin_ctz(w); if (pos < 256u) out[pos] = (unsigned short)(base + bit); ++pos; w &= w - 1u; } }
        for (unsigned i = total + lane; i < 256u; i += 64u) out[i] = (unsigned short)0xffffu; }
}

struct AttSt { float m, l; f32x16 o0, o1; };
template <class BF> DI void att_subtile(AttSt& S, const bf16x8 (&qf)[4], LAS const char* Kst, LAS const char* Vb, int vdh, int vrow0, int lane, const BF& bias) {
    const int r32 = lane & 31, hi = lane >> 5;
    f32x16 p;
#pragma unroll
    for (int r = 0; r < 16; ++r) p[r] = 0.f;
    LAS const char* kp = Kst + hi * 512 + r32 * 16;
#pragma unroll
    for (int s = 0; s < 4; ++s) { const bf16x8 kf = *(LAS const bf16x8*)(kp + s * 1024); p = mfma32(kf, qf[s], p); }
    float mxa[4] = {-INFINITY, -INFINITY, -INFINITY, -INFINITY};
#pragma unroll
    for (int r = 0; r < 16; ++r) { p[r] = bias(p[r], crow(r, hi)); mxa[r & 3] = fmaxf(mxa[r & 3], p[r]); }
    float mx = fmaxf(fmaxf(mxa[0], mxa[1]), fmaxf(mxa[2], mxa[3]));
    mx = fmaxf(mx, __shfl_xor(mx, 32));
    if (__any(mx > S.m + 16.f)) { const float mn = fmaxf(S.m, mx), sc = ex2(S.m - mn); S.m = mn; S.l *= sc;
#pragma unroll
        for (int r = 0; r < 16; ++r) { S.o0[r] *= sc; S.o1[r] *= sc; } }
    const float mn = S.m;
    float psa[4] = {0.f, 0.f, 0.f, 0.f};
#pragma unroll
    for (int r = 0; r < 16; ++r) { p[r] = ex2(p[r] - mn); psa[r & 3] += p[r]; }
    S.l += (psa[0] + psa[1]) + (psa[2] + psa[3]);
    v4u pw0, pw1;
    pw0.x = cvtpk(p[0], p[1]); pw0.y = cvtpk(p[2], p[3]); pw0.z = cvtpk(p[4], p[5]); pw0.w = cvtpk(p[6], p[7]);
    pw1.x = cvtpk(p[8], p[9]); pw1.y = cvtpk(p[10], p[11]); pw1.z = cvtpk(p[12], p[13]); pw1.w = cvtpk(p[14], p[15]);
    const bf16x8 pf0 = __builtin_bit_cast(bf16x8, pw0), pf1 = __builtin_bit_cast(bf16x8, pw1);
    LAS const char* vp = Vb + (vrow0 + 4 * hi + ((lane & 15) >> 2)) * 64 + ((lane >> 4) & 1) * 32 + (lane & 3) * 8;
    { const bf16x8 v00 = cat8(vtr(vp), vtr(vp + 512)), v10 = cat8(vtr(vp + vdh), vtr(vp + vdh + 512));
      const bf16x8 v01 = cat8(vtr(vp + 1024), vtr(vp + 1536)), v11 = cat8(vtr(vp + vdh + 1024), vtr(vp + vdh + 1536));
      S.o0 = mfma32(v00, pf0, S.o0); S.o1 = mfma32(v10, pf0, S.o1);
      S.o0 = mfma32(v01, pf1, S.o0); S.o1 = mfma32(v11, pf1, S.o1); }
}

struct MobaFar { float c; DI float operator()(float p, int) const { return p + c; } };
struct MobaBias { LAS const float* lut; int tq, s0; bool causal;
    DI float operator()(float p, int kvrel) const { const int dist = tq - (s0 + kvrel); const float v = p + lut[dist < 0 ? 0 : (dist > 1023 ? 1023 : dist)]; return (causal && dist < 0) ? -INFINITY : v; } };
DI void moba_qload(bf16x8 (&qf)[4], const bf16* proj, int rowbase, int h, int tq, int hi) {
    const bf16* qp = proj + (size_t)(rowbase + tq) * EV_N + EC_QB + h * 64 + hi * 8;
#pragma unroll
    for (int s = 0; s < 4; ++s) qf[s] = *(const bf16x8*)(qp + s * 16);
}
DI void moba_tile(const Fr& F, const bf16x8 (&qf)[4], int rowbase, int h, int n, int tq, bool valid, int slot, bool own, int wave_tile) {
    LAS const char* Kb = (LAS const char*)F.lds; LAS const char* Vb = (LAS const char*)(F.lds + 32768); LAS const float* lut = (LAS const float*)(F.lds + 98304);
    bf16* po = (bf16*)(F.ws + WS_ACT); float* pml = (float*)(F.ws + WS_PML);
    const int lane = F.lane, hi = lane >> 5;
    AttSt S; S.m = -1e30f; S.l = 0.f;
#pragma unroll
    for (int r = 0; r < 16; ++r) { S.o0[r] = 0.f; S.o1[r] = 0.f; }
    const int nst = own ? wave_tile + 1 : 8;
    int tmin = tq;
#pragma unroll
    for (int o = 1; o < 64; o <<= 1) { const int y = __shfl_xor(tmin, o); tmin = y < tmin ? y : tmin; }
    const float cfar = lut[1023];
    for (int st = 0; st < nst; ++st) {
        if (!own && tmin - (n * 256 + st * 32 + 31) >= 790) { MobaFar bf{cfar}; att_subtile(S, qf, Kb + st * 4096, Vb, 16384, st * 32, lane, bf); }
        else { MobaBias bf{lut, tq, n * 256 + st * 32, own && st == wave_tile}; att_subtile(S, qf, Kb + st * 4096, Vb, 16384, st * 32, lane, bf); } }
    const float lt = S.l + __shfl_xor(S.l, 32), inv = 1.f / lt;
    if (valid) { const size_t pi = ((size_t)(rowbase + tq) * 8 + h) * 4 + slot; bf16* o = po + pi * 64;
#pragma unroll
        for (int a4 = 0; a4 < 4; ++a4) { v2u w0, w1;
            w0.x = cvtpk(S.o0[4 * a4] * inv, S.o0[4 * a4 + 1] * inv); w0.y = cvtpk(S.o0[4 * a4 + 2] * inv, S.o0[4 * a4 + 3] * inv);
            w1.x = cvtpk(S.o1[4 * a4] * inv, S.o1[4 * a4 + 1] * inv); w1.y = cvtpk(S.o1[4 * a4 + 2] * inv, S.o1[4 * a4 + 3] * inv);
            *(v2u*)(o + 8 * a4 + 4 * hi) = w0; *(v2u*)(o + 32 + 8 * a4 + 4 * hi) = w1; }
        if (hi == 0) { f32x2 ml = {S.m, lt}; *(f32x2*)(pml + pi * 2) = ml; } }
}
DI void moba_unit(const Args& a, const Fr& F, int b, int h, int n) {
    const bf16* proj = (const bf16*)(F.ws + WS_PROJ); const unsigned* sel3 = (const unsigned*)(F.ws + WS_SEL3);
    LAS unsigned char* lds = F.lds; LAS unsigned* list = (LAS unsigned*)(lds + 65536); LAS float* lut = (LAS float*)(lds + 98304); LAS unsigned* misc = (LAS unsigned*)(lds + 102400);
    const int tid = F.tid, lane = F.lane, wave = F.wave, rowbase = b * SEQ;
    __syncthreads();
    { const bf16* kg = proj + (size_t)(rowbase + n * 256) * EV_N + EC_KB + h * 64; const bf16* vg = proj + (size_t)(rowbase + n * 256) * EV_N + EC_VB + h * 64;
#pragma unroll
        for (int i = 0; i < 4; ++i) { const int p = tid + i * NTHR;
            { const int r = p & 31, c = (p >> 5) & 7, st = p >> 8; const v4u v = *(const v4u*)(kg + (size_t)(st * 32 + r) * EV_N + c * 8); *(LAS v4u*)(lds + st * 4096 + c * 512 + r * 16) = v; }
            { const int cc = p & 3, row = (p >> 2) & 255, dh = p >> 10; const v4u v = *(const v4u*)(vg + (size_t)row * EV_N + dh * 32 + cc * 8); *(LAS v4u*)(lds + 32768 + dh * 16384 + row * 64 + cc * 16) = v; } }
        for (int d = tid; d < 1024; d += NTHR) lut[d] = a.in[9][t5_bucket(d) * 16 + 8 + h] * LOG2E; }
    if (tid == 0) misc[16] = 0u;
    __syncthreads();
    unsigned sv[16];
#pragma unroll
    for (int k = 0; k < 16; ++k) { const int t = (n + 1) * 256 + k * NTHR + tid; sv[k] = t < SEQ ? sel3[(size_t)(rowbase + t) * 8 + h] : 0u; }
#pragma unroll
    for (int k = 0; k < 16; ++k) { const int tb = (n + 1) * 256 + k * NTHR; if (tb < SEQ) { const int t = tb + tid;
        const unsigned s = sv[k]; const unsigned nv = s >> 24; int slot = -1;
        if (nv > 0u && (s & 255u) == (unsigned)n) slot = 0; else if (nv > 1u && ((s >> 8) & 255u) == (unsigned)n) slot = 1; else if (nv > 2u && ((s >> 16) & 255u) == (unsigned)n) slot = 2;
        const unsigned long long bal = __ballot(slot >= 0); const unsigned wcnt = __popcll(bal);
        if (lane == 0) misc[wave] = wcnt;
        __syncthreads();
        unsigned off = misc[16], tot = 0u;
#pragma unroll
        for (int w = 0; w < 8; ++w) { const unsigned c = misc[w]; if (w < wave) off += c; tot += c; }
        if (slot >= 0) list[off + __popcll(bal & ((1ull << lane) - 1ull))] = ((unsigned)t << 2) | (unsigned)slot;
        __syncthreads();
        if (tid == 0) misc[16] += tot; } }
    __syncthreads();
    const int nlist = (int)misc[16];
    const int ntl = (nlist + 31) >> 5, hi = lane >> 5;
    bf16x8 qa[4], qb2[4];
    moba_qload(qa, proj, rowbase, h, n * 256 + wave * 32 + (lane & 31), hi);
    unsigned ea = 0u, eb = 0u; bool va = false, vb = false;
    int tl = wave;
    if (tl < ntl) { const int li = tl * 32 + (lane & 31); vb = li < nlist; eb = list[vb ? li : nlist - 1]; moba_qload(qb2, proj, rowbase, h, (int)(eb >> 2), hi); }
    moba_tile(F, qa, rowbase, h, n, n * 256 + wave * 32 + (lane & 31), true, 3, true, wave);
    for (; tl < ntl; tl += 16) {
        const int t2 = tl + 8, t3 = tl + 16;
        if (t2 < ntl) { const int li = t2 * 32 + (lane & 31); va = li < nlist; ea = list[va ? li : nlist - 1]; moba_qload(qa, proj, rowbase, h, (int)(ea >> 2), hi); }
        moba_tile(F, qb2, rowbase, h, n, (int)(eb >> 2), vb, (int)(eb & 3u), false, 0);
        if (t2 < ntl) {
            if (t3 < ntl) { const int li = t3 * 32 + (lane & 31); vb = li < nlist; eb = list[vb ? li : nlist - 1]; moba_qload(qb2, proj, rowbase, h, (int)(eb >> 2), hi); }
            moba_tile(F, qa, rowbase, h, n, (int)(ea >> 2), va, (int)(ea & 3u), false, 0); }
    }
}

DI void dsa_step(const bf16x8 (&af)[2][4], const bf16x8 (&qlf)[4], int ch, LAS const unsigned char* bsel, LAS unsigned char* cbuf, LAS const float* tab,
                 float& m, float& l, f32x4 (&oT)[8], int l15, int kg, int lane) {
    f32x4 acc[2];
#pragma unroll
    for (int mt = 0; mt < 2; ++mt) { acc[mt] = (f32x4){0.f, 0.f, 0.f, 0.f};
#pragma unroll
        for (int ks = 0; ks < 4; ++ks) { acc[mt] = mfma16(af[mt][ks], qlf[ks], acc[mt]); *(LAS bf16x8*)(cbuf + (mt * 16 + l15) * 288 + (ks * 32 + kg * 8) * 2) = af[mt][ks]; } }
    float mx = -INFINITY;
#pragma unroll
    for (int mt = 0; mt < 2; ++mt) { const unsigned b4 = *(LAS const unsigned*)(bsel + ch * 32 + mt * 16 + 4 * kg);
#pragma unroll
        for (int i = 0; i < 4; ++i) { const unsigned bb = (b4 >> (8 * i)) & 255u;
            const float v = bb != 255u ? acc[mt][i] + tab[bb * 8 + (l15 & 7)] : -INFINITY; acc[mt][i] = v; mx = fmaxf(mx, v); } }
    mx = fmaxf(mx, __shfl_xor(mx, 16)); mx = fmaxf(mx, __shfl_xor(mx, 32));
    const float mn = fmaxf(m, mx), sc = ex2(m - mn); m = mn;
    float ps = 0.f;
#pragma unroll
    for (int mt = 0; mt < 2; ++mt)
#pragma unroll
        for (int i = 0; i < 4; ++i) { acc[mt][i] = ex2(acc[mt][i] - mn); ps += acc[mt][i]; }
    l = l * sc + ps;
#pragma unroll
    for (int ct = 0; ct < 8; ++ct) oT[ct] = oT[ct] * sc;
    v4u pw; pw.x = cvtpk(acc[0][0], acc[0][1]); pw.y = cvtpk(acc[0][2], acc[0][3]); pw.z = cvtpk(acc[1][0], acc[1][1]); pw.w = cvtpk(acc[1][2], acc[1][3]);
    const bf16x8 pf = __builtin_bit_cast(bf16x8, pw);
    LDS_WAIT();
    LAS const char* tp = (LAS const char*)cbuf + (4 * kg + (l15 >> 2)) * 288 + (lane & 3) * 8;
#pragma unroll
    for (int ct = 0; ct < 8; ++ct) { const bf16x8 cf = cat8(vtr(tp + ct * 32), vtr(tp + 16 * 288 + ct * 32)); oT[ct] = mfma16(cf, pf, oT[ct]); }
    LDS_WAIT();
}
DI void dsa_gather(bf16x8 (&af)[2][4], const bf16* ckvn, int rowbase, LAS const unsigned short* selb, int ch, int l15, int kg) {
#pragma unroll
    for (int mt = 0; mt < 2; ++mt) { unsigned idx = selb[ch * 32 + mt * 16 + l15]; if (idx == 0xffffu) idx = 0u;
        const bf16* cp = ckvn + (size_t)(rowbase + (int)idx) * 128 + kg * 8;
#pragma unroll
        for (int ks = 0; ks < 4; ++ks) af[mt][ks] = *(const bf16x8*)(cp + ks * 32); }
}
DI void dsa_query(const Fr& F, int tok, const v2u sv, LAS unsigned char* wl, LAS const unsigned char* bkt, LAS const float* tab) {
    const bf16* ql = (const bf16*)(F.ws + WS_QL); const bf16* ckvn = (const bf16*)(F.ws + WS_CKVN); const unsigned short* sel = (const unsigned short*)(F.ws + WS_SEL); bf16* ol = (bf16*)(F.ws + WS_OL);
    const int lane = F.lane, l15 = lane & 15, kg = lane >> 4, t = tok % SEQ, rowbase = tok - t;
    LAS unsigned short* selb = (LAS unsigned short*)wl; LAS unsigned char* bsel = wl + 512; LAS unsigned char* cbuf = wl + 1024;
    { *((LAS v2u*)selb + lane) = sv; unsigned bw = 0u;
#pragma unroll
        for (int i = 0; i < 4; ++i) { const unsigned s = (i < 2 ? (sv.x >> (16 * i)) : (sv.y >> (16 * (i - 2)))) & 0xffffu; const int dist = t - (int)s;
            const unsigned bb = (s != 0xffffu && dist >= 0) ? (unsigned)bkt[dist > 1023 ? 1023 : dist] : 255u; bw |= bb << (8 * i); }
        *((LAS unsigned*)bsel + lane) = bw; }
    bf16x8 qlf[4];
#pragma unroll
    for (int ks = 0; ks < 4; ++ks) { qlf[ks] = *(const bf16x8*)(ql + (size_t)tok * 1024 + (l15 & 7) * 128 + ks * 32 + kg * 8); if (l15 >= 8) qlf[ks] = (bf16x8){0, 0, 0, 0, 0, 0, 0, 0}; }
    float m = -1e30f, l = 0.f; f32x4 oT[8];
#pragma unroll
    for (int ct = 0; ct < 8; ++ct) oT[ct] = (f32x4){0.f, 0.f, 0.f, 0.f};
    const int nvalid = t + 1 < 256 ? t + 1 : 256, nch = (nvalid + 31) >> 5;
    LDS_WAIT();
    bf16x8 afa[2][4], afb[2][4], afc[2][4];
    dsa_gather(afa, ckvn, rowbase, selb, 0, l15, kg);
    if (nch > 1) dsa_gather(afb, ckvn, rowbase, selb, 1, l15, kg);
    for (int ch = 0; ch < nch; ch += 3) {
        if (ch + 2 < nch) dsa_gather(afc, ckvn, rowbase, selb, ch + 2, l15, kg);
        dsa_step(afa, qlf, ch, bsel, cbuf, tab, m, l, oT, l15, kg, lane);
        if (ch + 1 < nch) { if (ch + 3 < nch) dsa_gather(afa, ckvn, rowbase, selb, ch + 3, l15, kg);
            dsa_step(afb, qlf, ch + 1, bsel, cbuf, tab, m, l, oT, l15, kg, lane); }
        if (ch + 2 < nch) { if (ch + 4 < nch) dsa_gather(afb, ckvn, rowbase, selb, ch + 4, l15, kg);
            dsa_step(afc, qlf, ch + 2, bsel, cbuf, tab, m, l, oT, l15, kg, lane); }
    }
    l += __shfl_xor(l, 16); l += __shfl_xor(l, 32);
    const float inv = 1.f / l;
    if (l15 < 8) { bf16* o = ol + (size_t)tok * 1024 + l15 * 128 + 4 * kg;
#pragma unroll
        for (int ct = 0; ct < 8; ++ct) { v2u w; w.x = cvtpk(oT[ct][0] * inv, oT[ct][1] * inv); w.y = cvtpk(oT[ct][2] * inv, oT[ct][3] * inv); *(v2u*)(o + ct * 16) = w; } }
}
DI void dsa_chunk(const Args& a, const Fr& F, int c32) {
    LAS unsigned char* bkt = F.lds + 81920; LAS float* tab = (LAS float*)(F.lds + 82944);
    __syncthreads();
    for (int d = F.tid; d < 1024; d += NTHR) bkt[d] = (unsigned char)t5_bucket(d);
    if (F.tid < 256) tab[F.tid] = a.in[9][(F.tid >> 3) * 16 + (F.tid & 7)] * LOG2E;
    __syncthreads();
    const unsigned short* selg = (const unsigned short*)(F.ws + WS_SEL); v2u svq[4];
#pragma unroll
    for (int i = 0; i < 4; ++i) svq[i] = *((const v2u*)(selg + (size_t)(c32 * 32 + F.wave * 4 + i) * 256) + F.lane);
#pragma unroll
    for (int i = 0; i < 4; ++i) dsa_query(F, c32 * 32 + F.wave * 4 + i, svq[i], F.lds + F.wave * 10240, bkt, tab);
}

DI void ph_even_post(const Fr& F, int j) {
    const bf16* ol = (const bf16*)(F.ws + WS_OL); bf16* ao = (bf16*)(F.ws + WS_AO);
    const bf16* wuvt = (const bf16*)(F.ws + WS_WUVT) + (size_t)j * 8 * 64 * 128;
    const bf16* po = (const bf16*)(F.ws + WS_ACT); const float* pml = (const float*)(F.ws + WS_PML); const unsigned* sel3 = (const unsigned*)(F.ws + WS_SEL3);
    const int lane = F.lane, wave = F.wave, l15 = lane & 15, kg = lane >> 4;
    for (int chunk = F.blk; chunk < 256; chunk += F.G) { const int tok0 = chunk * 128;
        { const int h = wave; bf16x8 af[4][4];
#pragma unroll
            for (int mt = 0; mt < 4; ++mt)
#pragma unroll
                for (int ks = 0; ks < 4; ++ks) af[mt][ks] = *(const bf16x8*)(wuvt + ((size_t)h * 64 + mt * 16 + l15) * 128 + ks * 32 + kg * 8);
#pragma unroll 1
            for (int tg = 0; tg < 8; tg += 2) { bf16x8 bf[2][4];
#pragma unroll
                for (int u = 0; u < 2; ++u)
#pragma unroll
                    for (int ks = 0; ks < 4; ++ks) bf[u][ks] = *(const bf16x8*)(ol + (size_t)(tok0 + (tg + u) * 16 + l15) * 1024 + h * 128 + ks * 32 + kg * 8);
#pragma unroll
                for (int u = 0; u < 2; ++u) { const int tok = tok0 + (tg + u) * 16 + l15;
#pragma unroll
                    for (int mt = 0; mt < 4; ++mt) { f32x4 d = {0.f, 0.f, 0.f, 0.f};
#pragma unroll
                        for (int ks = 0; ks < 4; ++ks) d = mfma16(af[mt][ks], bf[u][ks], d);
                        v2u w; w.x = cvtpk(d[0], d[1]); w.y = cvtpk(d[2], d[3]); *(v2u*)(ao + (size_t)tok * 1024 + h * 64 + mt * 16 + 4 * kg) = w; } } } }
#pragma unroll 1
        for (int i0 = 0; i0 < 16; i0 += 4) { const int h = lane >> 3, d0 = (lane & 7) * 8; unsigned nvv[4]; f32x2 mlv[4][4];
#pragma unroll
            for (int i = 0; i < 4; ++i) { const int tok = tok0 + wave * 16 + i0 + i; const size_t pi = ((size_t)tok * 8 + h) * 4; nvv[i] = sel3[(size_t)tok * 8 + h] >> 24;
#pragma unroll
                for (int s = 0; s < 4; ++s) mlv[i][s] = *(const f32x2*)(pml + (pi + s) * 2); }
#pragma unroll
            for (int i = 0; i < 4; ++i) { const int tok = tok0 + wave * 16 + i0 + i; const size_t pi = ((size_t)tok * 8 + h) * 4;
                float mj[4], lj[4];
#pragma unroll
                for (int s = 0; s < 4; ++s) { const bool ok = (s == 3) || ((unsigned)s < nvv[i]); mj[s] = ok ? mlv[i][s][0] : -1e30f; lj[s] = ok ? mlv[i][s][1] : 0.f; }
                const float ms = fmaxf(fmaxf(mj[0], mj[1]), fmaxf(mj[2], mj[3])); float wsum = 0.f, acc[8], wv[4]; v4u pv[4];
#pragma unroll
                for (int k = 0; k < 8; ++k) acc[k] = 0.f;
#pragma unroll
                for (int s = 0; s < 4; ++s) { wv[s] = lj[s] * ex2(mj[s] - ms); wsum += wv[s]; pv[s] = (v4u){0u, 0u, 0u, 0u}; if (wv[s] > 0.f) pv[s] = *(const v4u*)(po + (pi + s) * 64 + d0); }
#pragma unroll
                for (int s = 0; s < 4; ++s) { if (wv[s] > 0.f) {
#pragma unroll
                    for (int k = 0; k < 4; ++k) { acc[2 * k] += wv[s] * bf2f(pv[s][k] & 0xffffu); acc[2 * k + 1] += wv[s] * bf2f(pv[s][k] >> 16); } } }
                const float inv = 1.f / wsum; v4u o; o.x = cvtpk(acc[0] * inv, acc[1] * inv); o.y = cvtpk(acc[2] * inv, acc[3] * inv); o.z = cvtpk(acc[4] * inv, acc[5] * inv); o.w = cvtpk(acc[6] * inv, acc[7] * inv);
                *(v4u*)(ao + (size_t)tok * 1024 + 512 + h * 64 + d0) = o; } }
    }
}
DI f32x16 proj32_f32(const float* W, int ldw, int ncols, const float* xrow, int d_lo, int lane) {
    const int e = lane & 31, kh = lane >> 5; const bool ev = e < ncols;
    f32x16 D;
#pragma unroll
    for (int r = 0; r < 16; ++r) D[r] = 0.f;
    const float* wp = W + (size_t)(d_lo + 4 * kh) * ldw + (ev ? e : 0);
    const float* xp = xrow + d_lo + 4 * kh;
#pragma unroll 8
    for (int i = 0; i < 64; ++i) { const f32x4 xv = *(const f32x4*)(xp + 8 * i);
        float a0 = wp[(size_t)(8 * i + 0) * ldw], a1 = wp[(size_t)(8 * i + 1) * ldw], a2 = wp[(size_t)(8 * i + 2) * ldw], a3 = wp[(size_t)(8 * i + 3) * ldw];
        if (!ev) { a0 = 0.f; a1 = 0.f; a2 = 0.f; a3 = 0.f; }
        D = __builtin_amdgcn_mfma_f32_32x32x2f32(a0, xv[0], D, 0, 0, 0); D = __builtin_amdgcn_mfma_f32_32x32x2f32(a1, xv[1], D, 0, 0, 0);
        D = __builtin_amdgcn_mfma_f32_32x32x2f32(a2, xv[2], D, 0, 0, 0); D = __builtin_amdgcn_mfma_f32_32x32x2f32(a3, xv[3], D, 0, 0, 0); }
    return D;
}
DI void ph_odd_prep(const Args& a, const Fr& F, int j, int layer) {
    const bf16* proj = (const bf16*)(F.ws + WS_PROJ); const float* x = (const float*)(F.ws + WS_X);
    float* logf = (float*)(F.ws + WS_LOGF); float* cs = (float*)(F.ws + WS_CS);
    const float* wf = a.in[6] + (size_t)j * 1024 * 3088 + 3072; const float* bfv = a.in[7] + j * 16;
    LAS float* red = (LAS float*)(F.lds); LAS float* lfb = (LAS float*)(F.lds + 131072);
    LAS unsigned* kmx = (LAS unsigned*)(F.lds + 131072 + 8192);
    const int lane = F.lane, wave = F.wave, tid = F.tid, l31 = lane & 31, hi = lane >> 5;
    for (int chunk = F.blk; chunk < 256; chunk += F.G) { const int tok0 = chunk * 128, b = tok0 / SEQ, t0 = tok0 % SEQ;
        __syncthreads();
        if (tid < 16) kmx[tid] = 0u;
        const int tl = wave & 3, kr = wave >> 2;
        f32x16 D = proj32_f32(wf, 3088, 16, x + (size_t)(tok0 + tl * 32 + l31) * DM, kr * 512, lane);
        if (kr == 1) {
#pragma unroll
            for (int r = 0; r < 8; ++r) red[(tl * 8 + r) * 64 + lane] = D[r]; }
        __syncthreads();
        if (kr == 0) {
#pragma unroll
            for (int r = 0; r < 8; ++r) { const int h = (r & 3) + 8 * (r >> 2) + 4 * hi; const float z = D[r] + red[(tl * 8 + r) * 64 + lane] + bfv[h];
                const float ls = fminf(z, 0.f) - log1pf(__expf(-fabsf(z)));
                lfb[(tl * 32 + l31) * 16 + h] = ls * LOG2E; } }
#pragma unroll 1
        for (int i = 0; i < 4; ++i) { const int p = tid + i * NTHR, tk = p >> 4, h = p & 15; const v4u* kp = (const v4u*)(proj + (size_t)(tok0 + tk) * OD_N + OC_K + h * 64); float s = 0.f;
#pragma unroll
            for (int c = 0; c < 8; ++c) { const v4u w = kp[c];
#pragma unroll
                for (int k = 0; k < 4; ++k) { const float e0 = bf2f(w[k] & 0xffffu), e1 = bf2f(w[k] >> 16); s += e0 * e0 + e1 * e1; } }
            __hip_atomic_fetch_max(kmx + h, __float_as_uint(s), __ATOMIC_RELAXED, __HIP_MEMORY_SCOPE_WORKGROUP); }
        __syncthreads();
        for (int i = tid; i < 2048; i += NTHR) { const int h = i >> 7, tk = i & 127; logf[((size_t)b * 16 + h) * SEQ + t0 + tk] = lfb[tk * 16 + h]; }
        if (tid < 32) { const int h = tid & 15, c = tid >> 4; float s = 0.f;
            for (int k = 0; k < 64; ++k) s += lfb[(c * 64 + k) * 16 + h];
            cs[((size_t)b * 16 + h) * 128 + (t0 >> 6) + c] = s; }
        if (tid < 16) __hip_atomic_fetch_max(F.ctl + CW_KMAX + layer * 64 + b * 16 + tid, kmx[tid], RLX_AGENT);
    }
}

constexpr float FOX_SKIP_LOG2 = 64.f;
struct FoxBias { LAS const float* ng; int tq, kabs0; bool diag;
    DI float operator()(float p, int kvrel) const { const float v = p + ng[kvrel]; return (diag && (kabs0 + kvrel) > tq) ? -INFINITY : v; } };
DI void fox_unit(const Fr& F, int layer, int b, int h, int qb) {
    const bf16* proj = (const bf16*)(F.ws + WS_PROJ); const float* logf = (const float*)(F.ws + WS_LOGF); const float* cs = (const float*)(F.ws + WS_CS); bf16* ao = (bf16*)(F.ws + WS_AO);
    LAS unsigned char* lds = F.lds; LAS float* ng = (LAS float*)(lds + 32768); LAS float* red = (LAS float*)(lds + 65536 + 1024); LAS int* ibox = (LAS int*)(lds + 65536 + 2048);
    const int tid = F.tid, lane = F.lane, wave = F.wave, r32 = lane & 31, hi = lane >> 5, t0 = qb * 256, rowbase = b * SEQ, tq = t0 + wave * 32 + r32;
    __syncthreads();
    bf16x8 qf[4]; float qs = 0.f;
    { const bf16* qp = proj + (size_t)(rowbase + tq) * OD_N + OC_Q + h * 64 + hi * 8;
#pragma unroll
        for (int s = 0; s < 4; ++s) { qf[s] = *(const bf16x8*)(qp + s * 16);
#pragma unroll
            for (int k = 0; k < 8; ++k) { const float e = bf2f((unsigned short)qf[s][k]); qs += e * e; } } }
    qs += __shfl_xor(qs, 32); qs = wave_max(qs);
    if (lane == 0) red[wave] = qs;
    if (tid < 128) red[32 + tid] = (tid < t0 / 64) ? cs[((size_t)b * 16 + h) * 128 + tid] : 0.f;
    __syncthreads();
    if (tid == 0) { float qm = red[0];
        for (int w = 1; w < 8; ++w) qm = fmaxf(qm, red[w]);
        const float km = __uint_as_float(ld_u32(F.ctl + CW_KMAX + layer * 64 + b * 16 + h));
        const float B2 = 2.f * (sqrtf(qm * km) * 1.01f + 1.f);
        int kt = t0 / 64 - 1, kts = t0 / 64; float D = 0.f;
        while (kt >= 0 && B2 + D >= -FOX_SKIP_LOG2) { kts = kt; D += red[32 + kt]; --kt; }
        ibox[0] = kts; }
    __syncthreads();
    const int kts = ibox[0], s_start = kts * 64, nel = t0 + 256 - s_start;
    { const int i0 = tid * 16; float v[16]; const float* lp = logf + ((size_t)b * 16 + h) * SEQ + s_start + i0;
        if (i0 < nel) {
#pragma unroll
            for (int c = 0; c < 4; ++c) { const f32x4 w = *(const f32x4*)(lp + 4 * c); v[4 * c] = w[0]; v[4 * c + 1] = w[1]; v[4 * c + 2] = w[2]; v[4 * c + 3] = w[3]; } }
        else {
#pragma unroll
            for (int c = 0; c < 16; ++c) v[c] = 0.f; }
#pragma unroll
        for (int c = 1; c < 16; ++c) v[c] += v[c - 1];
        float xsum = v[15];
#pragma unroll
        for (int o = 1; o < 64; o <<= 1) { const float y = __shfl_up(xsum, o); if (lane >= o) xsum += y; }
        if (lane == 63) red[16 + wave] = xsum;
        __syncthreads();
        float off = xsum - v[15];
        for (int w = 0; w < wave; ++w) off += red[16 + w];
        if (i0 < nel) {
#pragma unroll
            for (int c = 0; c < 4; ++c) { f32x4 w = {-(off + v[4 * c]), -(off + v[4 * c + 1]), -(off + v[4 * c + 2]), -(off + v[4 * c + 3])}; *(LAS f32x4*)(ng + i0 + 4 * c) = w; } }
    }
    const int ntile = t0 / 64 + 4 - kts;
    const bf16* kg = proj + (size_t)rowbase * OD_N + OC_K + h * 64; const bf16* vg = proj + (size_t)rowbase * OD_N + OC_V + h * 64;
    const int kr = tid & 31, kc = (tid >> 5) & 7, kst = tid >> 8, vcc = tid & 3, vrow = (tid >> 2) & 63, vdh = tid >> 8;
    const int koff = kst * 4096 + kc * 512 + kr * 16, voff = 8192 + vdh * 4096 + vrow * 64 + vcc * 16;
    { const v4u kv = *(const v4u*)(kg + (size_t)(kts * 64 + kst * 32 + kr) * OD_N + kc * 8), vv = *(const v4u*)(vg + (size_t)(kts * 64 + vrow) * OD_N + vdh * 32 + vcc * 8);
        *(LAS v4u*)(lds + koff) = kv; *(LAS v4u*)(lds + voff) = vv; }
    __syncthreads();
    AttSt S; S.m = -1e30f; S.l = 0.f;
#pragma unroll
    for (int r = 0; r < 16; ++r) { S.o0[r] = 0.f; S.o1[r] = 0.f; }
    const int wlast = t0 + wave * 32 + 31, wfirst = t0 + wave * 32;
    for (int i = 0; i < ntile; ++i) { const int kt = kts + i; LAS unsigned char* buf = lds + (i & 1) * 16384; LAS unsigned char* nbuf = lds + ((i + 1) & 1) * 16384;
        v4u kv, vv; const bool more = i + 1 < ntile;
        if (more) { kv = *(const v4u*)(kg + (size_t)((kt + 1) * 64 + kst * 32 + kr) * OD_N + kc * 8); vv = *(const v4u*)(vg + (size_t)((kt + 1) * 64 + vrow) * OD_N + vdh * 32 + vcc * 8); }
#pragma unroll
        for (int sub = 0; sub < 2; ++sub) { const int kv0 = kt * 64 + sub * 32;
            if (kv0 <= wlast) { FoxBias bf{ng + (kv0 - s_start), tq, kv0, kv0 + 31 > wfirst};
                att_subtile(S, qf, (LAS const char*)buf + sub * 4096, (LAS const char*)buf + 8192, 4096, sub * 32, lane, bf); } }
        if (more) { *(LAS v4u*)(nbuf + koff) = kv; *(LAS v4u*)(nbuf + voff - 8192 + 8192) = vv; }
        __syncthreads(); }
    const float lt = S.l + __shfl_xor(S.l, 32), inv = 1.f / lt;
    bf16* o = ao + (size_t)(rowbase + tq) * 1024 + h * 64;
#pragma unroll
    for (int a4 = 0; a4 < 4; ++a4) { v2u w0, w1;
        w0.x = cvtpk(S.o0[4 * a4] * inv, S.o0[4 * a4 + 1] * inv); w0.y = cvtpk(S.o0[4 * a4 + 2] * inv, S.o0[4 * a4 + 3] * inv);
        w1.x = cvtpk(S.o1[4 * a4] * inv, S.o1[4 * a4 + 1] * inv); w1.y = cvtpk(S.o1[4 * a4 + 2] * inv, S.o1[4 * a4 + 3] * inv);
        *(v2u*)(o + 8 * a4 + 4 * hi) = w0; *(v2u*)(o + 32 + 8 * a4 + 4 * hi) = w1; }
}

DI void ph_ln1_router(const Args& a, const Fr& F, int layer) {
    const float* yp = (const float*)(F.ws + WS_YP); float* x1 = (float*)(F.ws + WS_X1); unsigned char* xb8 = F.ws + WS_XB8;
    unsigned* tope = (unsigned*)(F.ws + WS_TOPE); float* gate = (float*)(F.ws + WS_GATE); unsigned* rank = (unsigned*)(F.ws + WS_RANK);
    const float* g = a.in[10] + (size_t)(layer * 2) * DM; const float* bb = a.in[11] + (size_t)(layer * 2) * DM;
    const float* rw = a.in[12] + (size_t)layer * 1024 * 32; const float* rb = a.in[13] + layer * 32;
    LAS float* red = (LAS float*)(F.lds); LAS unsigned* lcnt = (LAS unsigned*)(F.lds + 131072);
    const int lane = F.lane, wave = F.wave, tid = F.tid, l31 = lane & 31, hi = lane >> 5;
    for (int chunk = F.blk; chunk < 256; chunk += F.G) { const int tok0 = chunk * 128;
        __syncthreads();
        if (tid < 32) lcnt[tid] = 0u;
#pragma unroll 1
        for (int k = 0; k < 16; k += 8) { f32x4 v[8][4];
#pragma unroll
            for (int i = 0; i < 8; ++i)
#pragma unroll
                for (int jj = 0; jj < 4; ++jj) v[i][jj] = *((const f32x4*)(yp + (size_t)(tok0 + wave * 16 + k + i) * DM) + lane + 64 * jj);
#pragma unroll
            for (int i = 0; i < 8; ++i) { const int tok = tok0 + wave * 16 + k + i;
                ln_row(v[i], g, bb, lane);
                store_row_f32(x1 + (size_t)tok * DM, v[i], lane);
#pragma unroll
                for (int jj = 0; jj < 4; ++jj) *((unsigned*)(xb8 + (size_t)tok * DM) + lane + 64 * jj) = pk4_fp8(v[i][jj][0] * F8_SX, v[i][jj][1] * F8_SX, v[i][jj][2] * F8_SX, v[i][jj][3] * F8_SX); } }
        asm volatile("s_waitcnt vmcnt(0)" ::: "memory");
        __syncthreads();
        const int tl = wave & 3, kr = wave >> 2, tokl = tok0 + tl * 32 + l31;
        f32x16 D = proj32_f32(rw, 32, 32, x1 + (size_t)tokl * DM, kr * 512, lane);
        if (kr == 1) {
#pragma unroll
            for (int r = 0; r < 16; ++r) red[(tl * 16 + r) * 64 + lane] = D[r]; }
        __syncthreads();
        if (kr == 0) {
            float lv[32];
#pragma unroll
            for (int r = 0; r < 16; ++r) { const float own = D[r] + red[(tl * 16 + r) * 64 + lane] + rb[crow(r, hi)]; const float oth = __shfl_xor(own, 32);
                lv[crow(r, 0)] = hi == 0 ? own : oth; lv[crow(r, 1)] = hi == 0 ? oth : own; }
            float tv[4]; int te[4];
#pragma unroll
            for (int r = 0; r < 4; ++r) { float mx = -INFINITY; int me = 0;
#pragma unroll
                for (int e = 0; e < 32; ++e) { if (lv[e] > mx) { mx = lv[e]; me = e; } }
                tv[r] = mx; te[r] = me;
#pragma unroll
                for (int e = 0; e < 32; ++e) { if (e == me) lv[e] = -INFINITY; } }
            const float e1 = __expf(tv[1] - tv[0]), e2 = __expf(tv[2] - tv[0]), e3 = __expf(tv[3] - tv[0]); const float inv = 1.f / (1.f + e1 + e2 + e3);
            if (hi == 0) { const size_t o = (size_t)tokl * 4;
                const float gv[4] = {inv, e1 * inv, e2 * inv, e3 * inv};
#pragma unroll
                for (int r = 0; r < 4; ++r) { const unsigned rk = __hip_atomic_fetch_add(lcnt + (te[r] & 31), 1u, __ATOMIC_RELAXED, __HIP_MEMORY_SCOPE_WORKGROUP);
                    tope[o + r] = (unsigned)(te[r] & 31); gate[o + r] = gv[r]; rank[o + r] = rk; } } }
        __syncthreads();
        if (tid < 32) __hip_atomic_store(F.ctl + CW_CNT + chunk * 32 + tid, lcnt[tid], RLX_AGENT);
    }
}

DI void ph_route(const Fr& F) {
    const unsigned char* xb8 = F.ws + WS_XB8; unsigned char* xg = F.ws + WS_XG;
    const unsigned* tope = (const unsigned*)(F.ws + WS_TOPE); const unsigned* rank = (const unsigned*)(F.ws + WS_RANK); unsigned* dest = (unsigned*)(F.ws + WS_DEST);
    LAS unsigned* P = (LAS unsigned*)(F.lds); LAS unsigned* pst = P + 512; LAS unsigned* pad = P + 544; LAS unsigned* base = P + 576; LAS unsigned* nt = P + 608;
    const int tid = F.tid, lane = F.lane, wave = F.wave;
    __syncthreads();
    { const int e = tid & 31, part = tid >> 5; unsigned s = 0u;
        for (int c = 0; c < 16; ++c) s += ld_u32(F.ctl + CW_CNT + (part * 16 + c) * 32 + e);
        P[part * 32 + e] = s; }
    __syncthreads();
    if (tid < 32) { unsigned tot = 0u;
        for (int p = 0; p < 16; ++p) tot += P[p * 32 + tid];
        pad[tid] = (tot + 255u) & ~255u; }
    __syncthreads();
    if (tid == 0) { unsigned acc = 0u;
        for (int e = 0; e < 32; ++e) { pst[e] = acc; acc += pad[e]; }
        nt[0] = acc >> 8; }
    __syncthreads();
    for (int chunk = F.blk; chunk < 256; chunk += F.G) {
        __syncthreads();
        if (tid < 32) { unsigned off = 0u; const int pf = chunk >> 4;
            for (int p = 0; p < pf; ++p) off += P[p * 32 + tid];
            for (int c = pf * 16; c < chunk; ++c) off += ld_u32(F.ctl + CW_CNT + c * 32 + tid);
            base[tid] = pst[tid] + off; }
        __syncthreads();
#pragma unroll 1
        for (int i0 = 0; i0 < 16; i0 += 4) { v4u src[4]; unsigned ee[4][4], rr[4][4];
#pragma unroll
            for (int i = 0; i < 4; ++i) { const int tok = chunk * 128 + wave * 16 + i0 + i; src[i] = *((const v4u*)(xb8 + (size_t)tok * DM) + lane);
#pragma unroll
                for (int k = 0; k < 4; ++k) { ee[i][k] = tope[(size_t)tok * 4 + k]; rr[i][k] = rank[(size_t)tok * 4 + k]; } }
#pragma unroll
            for (int i = 0; i < 4; ++i) { const int tok = chunk * 128 + wave * 16 + i0 + i;
#pragma unroll
                for (int k = 0; k < 4; ++k) { const unsigned d = base[ee[i][k]] + rr[i][k];
                    if (lane == 0) dest[(size_t)tok * 4 + k] = d;
                    *((v4u*)(xg + (size_t)d * DM) + lane) = src[i]; } } }
        if (chunk == 0) { const unsigned ntl = nt[0];
            if (tid == 0) __hip_atomic_store(F.ctl + CW_TILE, ntl, RLX_AGENT);
            for (unsigned i = tid; i < ntl; i += NTHR) { unsigned e = 0u;
                for (unsigned k = 1; k < 32; ++k) if (pst[k] <= i * 256u) e = k;
                __hip_atomic_store(F.ctl + CW_TILE + 64 + i, e, RLX_AGENT); } }
    }
}

DI void ph_combine_ln2(const Args& a, const Fr& F, int layer) {
    const float* x1 = (const float*)(F.ws + WS_X1); const bf16* yr = (const bf16*)(F.ws + WS_XG); float* xo = (float*)(F.ws + WS_X); bf16* xb = (bf16*)(F.ws + WS_XB);
    const float* gate = (const float*)(F.ws + WS_GATE); const unsigned* dest = (const unsigned*)(F.ws + WS_DEST);
    const float* g = a.in[10] + (size_t)(layer * 2 + 1) * DM; const float* bb = a.in[11] + (size_t)(layer * 2 + 1) * DM;
    const int lane = F.lane; const int gw = F.blk * NWAVES + F.wave, NGW = F.G * NWAVES;
    for (int tok = gw; tok < NTOK; tok += 4 * NGW) { f32x4 v[4][4];
#pragma unroll
        for (int i = 0; i < 4; ++i) { const int tk = tok + i * NGW; if (tk < NTOK) {
#pragma unroll
            for (int jj = 0; jj < 4; ++jj) v[i][jj] = *((const f32x4*)(x1 + (size_t)tk * DM) + lane + 64 * jj) * ALPHA;
#pragma unroll
            for (int k = 0; k < 4; ++k) { const float gk = gate[(size_t)tk * 4 + k]; const unsigned d = dest[(size_t)tk * 4 + k];
#pragma unroll
                for (int jj = 0; jj < 4; ++jj) { const v2u w = *((const v2u*)(yr + (size_t)d * DM) + lane + 64 * jj);
                    v[i][jj][0] += gk * bf2f(w.x & 0xffffu); v[i][jj][1] += gk * bf2f(w.x >> 16); v[i][jj][2] += gk * bf2f(w.y & 0xffffu); v[i][jj][3] += gk * bf2f(w.y >> 16); } } } }
#pragma unroll
        for (int i = 0; i < 4; ++i) { const int tk = tok + i * NGW; if (tk < NTOK) {
            ln_row(v[i], g, bb, lane);
            if (layer == DEPTH - 1) store_row_f32(a.out + (size_t)tk * DM, v[i], lane);
            else { store_row_f32(xo + (size_t)tk * DM, v[i], lane); store_row_bf16(xb + (size_t)tk * DM, v[i], lane); } } } }
}
constexpr int LDS_BYTES = 147456;
constexpr int LDS_BARW = 145408, LDS_QSLOT = 145472, LDS_TILE_E = 133632;
constexpr int NPL = 11;
constexpr int NPHASE = 1 + NPL * DEPTH;
#ifndef MK_SINGLE
#define MK_SINGLE 1
#endif
DI int q_next(const Fr& F, unsigned* ctr) {
    LAS int* slot = (LAS int*)(F.lds + LDS_QSLOT);
    __syncthreads();
    if (F.tid == 0) *slot = (int)__hip_atomic_fetch_add(ctr, 1u, RLX_AGENT);
    __syncthreads();
    return *slot;
}
DI int lane_id_fresh() { unsigned m_ = ~0u; asm volatile("" : "+s"(m_)); return (int)__builtin_amdgcn_mbcnt_hi(m_, __builtin_amdgcn_mbcnt_lo(m_, 0u)); }
#define RETID(F) do { int t2_ = F.tid; asm volatile("" : "+v"(t2_)); F.tid = t2_; F.lane = t2_ & 63; F.wave = __builtin_amdgcn_readfirstlane(t2_ >> 6); } while (0)
#ifndef PROBE_DUP
#define PROBE_DUP -1
#endif
#define NREP(q) ((PROBE_DUP == (q)) ? 2 : 1)
#define AS4 __attribute__((address_space(4)))
#define SITE() Args a; Fr F; { const AS4 Args* ap = (const AS4 Args*)__builtin_amdgcn_kernarg_segment_ptr(); asm volatile("" : "+s"(ap)); \
        _Pragma("unroll") for (int i_ = 0; i_ < 18; ++i_) a.in[i_] = ap->in[i_]; a.out = ap->out; a.ws = ap->ws; a.ph_lo = 0; a.ph_hi = 0; \
        int w_ = wv_s; asm volatile("" : "+s"(w_)); int t_ = w_ * 64 + lane_id_fresh(); asm volatile("" : "+v"(t_)); F.tid = t_; F.lane = t_ & 63; F.wave = __builtin_amdgcn_readfirstlane(t_ >> 6); \
        F.lds = (LAS unsigned char*)lds_raw; F.ws = a.ws; F.ctl = (unsigned*)(a.ws + WS_CTL); F.blk = blockIdx.x; F.G = gridDim.x; }
__global__ void __launch_bounds__(NTHR, 2) mega_fwd(Args a0) {
    extern __shared__ __attribute__((aligned(16))) unsigned char lds_raw[];
    const int wv_s = __builtin_amdgcn_readfirstlane((int)(threadIdx.x >> 6));
#if MK_SINGLE
    constexpr int lo = 0, hi = NPHASE; constexpr bool single = true;
#else
    const int lo = a0.ph_lo, hi = a0.ph_hi; constexpr bool single = false;
#endif
    if (threadIdx.x == 0) *(LAS v4u*)((LAS unsigned char*)lds_raw + LDS_BARW) = (v4u){0u, 0u, 0u, 0u};
    __syncthreads();
    if (single) (void)xcd_barrier_post((unsigned*)(a0.ws + WS_CTL) + CW_BAR, (volatile LAS unsigned*)((LAS unsigned char*)lds_raw + LDS_BARW));
#define IN(k) (lo <= (k) && (k) < hi)
#define SEAM() do { if (single) { const AS4 Args* ap_ = (const AS4 Args*)__builtin_amdgcn_kernarg_segment_ptr(); asm volatile("" : "+s"(ap_)); int w_ = wv_s; asm volatile("" : "+s"(w_)); \
        XcdBarrier b_; b_.bar = (unsigned*)(ap_->ws + WS_CTL) + CW_BAR; b_.x = xb_xcc_id(); b_.st = (volatile LAS unsigned*)((LAS unsigned char*)lds_raw + LDS_BARW); \
        xcd_barrier(b_, (w_ == 0) && (lane_id_fresh() == 0)); } } while (0)
    if (IN(0)) { _Pragma("unroll 1") for (int rep = 0; rep < NREP(100); ++rep) { { SITE(); ph_prologue(a, F); } SEAM(); } }
#pragma unroll 1
    for (int L = 0; L < DEPTH; ++L) {
        const int pb = 1 + NPL * L, j = L >> 1; const bool odd = (L & 1) != 0;
        if (IN(pb + 0)) _Pragma("unroll 1") for (int rep = 0; rep < NREP(0); ++rep) {
            { SITE();
            const bf16* w = odd ? (const bf16*)(F.ws + WS_WOD) + (size_t)j * OD_N * 1024 : (const bf16*)(F.ws + WS_WEV) + (size_t)j * EV_N * 1024;
            const int N = odd ? OD_N : EV_N;
            pg8::Gemm g{(const bf16*)(F.ws + WS_XB), w, NTOK, N, 1024}; pg8::StaticOrder S; S.init(NTOK, N, F.G, F.blk);
            pg8::EpiBf16<0> E{(bf16*)(F.ws + WS_PROJ), N, nullptr, 1024, (size_t)1024, C2F};
            pg8::gemm_phase<pg8::EpiBf16<0>, pg8::StaticOrder, true, true>(F.lds, g, S, E, F.tid); }
            SEAM(); }
        if (IN(pb + 1)) _Pragma("unroll 1") for (int rep = 0; rep < NREP(1); ++rep) { { SITE(); if (odd) ph_odd_prep(a, F, j, L); else ph_even_prep(a, F, j); } SEAM(); }
        if (!odd && IN(pb + 2)) _Pragma("unroll 1") for (int rep = 0; rep < ((PROBE_DUP == 2 || (PROBE_DUP >= 21 && PROBE_DUP <= 22) || (PROBE_DUP >= 211 && PROBE_DUP <= 213)) ? 2 : 1); ++rep) {
            { SITE(); unsigned* ctr = F.ctl + CW_Q + 64 * (L * 2) + 1024 * rep;
            for (;;) { const int it = q_next(F, ctr); if (it >= 1280) break; RETID(F);
                if (it < 1024) { if (!(rep == 1 && PROBE_DUP == 22)) idx_unit(F, it & 3, 255 - (it >> 2), (rep == 1 && PROBE_DUP >= 211) ? PROBE_DUP - 210 : 0); } else { if (!(rep == 1 && (PROBE_DUP == 21 || PROBE_DUP >= 211))) moba_gate_chunk(F, it - 1024); } } }
            SEAM(); }
        if (IN(pb + 3)) _Pragma("unroll 1") for (int rep = 0; rep < ((PROBE_DUP == 3 || (PROBE_DUP == 31 && odd) || ((PROBE_DUP == 32 || PROBE_DUP == 33) && !odd)) ? 2 : 1); ++rep) {
            { SITE(); unsigned* ctr = F.ctl + CW_Q + 64 * (L * 2 + 1) + 1024 * rep;
            if (odd) { for (;;) { const int it = q_next(F, ctr); if (it >= 2048) break; RETID(F); const int bh = it & 63; fox_unit(F, L, bh >> 4, bh & 15, 31 - (it >> 6)); } }
            else { for (;;) { const int it = q_next(F, ctr); if (it >= 2048) break; RETID(F);
                    if (it < 1024) { const int bh = it & 31; if (!(rep == 1 && PROBE_DUP == 33)) moba_unit(a, F, bh >> 3, bh & 7, it >> 5); } else { if (!(rep == 1 && PROBE_DUP == 32)) dsa_chunk(a, F, it - 1024); } } } }
            SEAM(); }
        if (!odd && IN(pb + 4)) _Pragma("unroll 1") for (int rep = 0; rep < NREP(4); ++rep) { { SITE(); ph_even_post(F, j); } SEAM(); }
        if (IN(pb + 5)) _Pragma("unroll 1") for (int rep = 0; rep < NREP(5); ++rep) {
            { SITE();
            const float* xin = (L == 0) ? a.in[0] : (const float*)(F.ws + WS_X);
            pg8::Gemm g{(const bf16*)(F.ws + WS_AO), (const bf16*)(F.ws + WS_WOUT) + (size_t)L * 1024 * 1024, NTOK, 1024, 1024}; pg8::StaticOrder S; S.init(NTOK, 1024, F.G, F.blk);
            EpiResF32 E{xin, (float*)(F.ws + WS_YP), ALPHA};
            pg8::gemm_phase<EpiResF32, pg8::StaticOrder, true, true>(F.lds, g, S, E, F.tid); }
            SEAM(); }
        if (IN(pb + 6)) _Pragma("unroll 1") for (int rep = 0; rep < NREP(6); ++rep) { { SITE(); ph_ln1_router(a, F, L); } SEAM(); }
        if (IN(pb + 7)) _Pragma("unroll 1") for (int rep = 0; rep < NREP(7); ++rep) { { SITE(); ph_route(F); } SEAM(); }
        if (IN(pb + 8)) _Pragma("unroll 1") for (int rep = 0; rep < NREP(8); ++rep) {
            { SITE(); const int ntl = (int)ld_u32(F.ctl + CW_TILE);
            LAS unsigned* tle = (LAS unsigned*)(F.lds + LDS_TILE_E);
            for (int i = F.tid; i < ntl; i += NTHR) tle[i] = ld_u32(F.ctl + CW_TILE + 64 + i);
            __syncthreads();
            pg8::Gemm g{(const bf16*)(F.ws + WS_XG), (const bf16*)(F.ws + WS_WGU + (size_t)L * 32 * 2048 * 1024), NR_MAX, 32 * 2048, 512};
            GroupOrder S{tle, ntl, 3, F.G, F.blk};
            EpiSwiglu E{F.ws + WS_ACT, a.in[15] + (size_t)L * 32 * 2048};
            pg8::gemm_phase<EpiSwiglu, GroupOrder, true, true, true>(F.lds, g, S, E, F.tid); }
            SEAM(); }
        if (IN(pb + 9)) _Pragma("unroll 1") for (int rep = 0; rep < NREP(9); ++rep) {
            { SITE(); const int ntl = (int)ld_u32(F.ctl + CW_TILE);
            LAS unsigned* tle = (LAS unsigned*)(F.lds + LDS_TILE_E);
            for (int i = F.tid; i < ntl; i += NTHR) tle[i] = ld_u32(F.ctl + CW_TILE + 64 + i);
            __syncthreads();
            pg8::Gemm g{(const bf16*)(F.ws + WS_ACT), (const bf16*)(F.ws + WS_WDN + (size_t)L * 32 * 1024 * 1024), NR_MAX, 32 * 1024, 512};
            GroupOrder S{tle, ntl, 2, F.G, F.blk};
            EpiDown E{(bf16*)(F.ws + WS_XG), a.in[17] + (size_t)L * 32 * 1024};
            pg8::gemm_phase<EpiDown, GroupOrder, true, true, true>(F.lds, g, S, E, F.tid); }
            SEAM(); }
        if (IN(pb + 10)) _Pragma("unroll 1") for (int rep = 0; rep < NREP(10); ++rep) { { SITE(); ph_combine_ln2(a, F, L); } if (L + 1 < DEPTH || rep + 1 < NREP(10)) SEAM(); }
    }
#undef IN
#undef SEAM
}

extern "C" void kernel_launch(void* const* d_in, const int* in_sizes, int n_in, void* d_out, int out_size, void* d_ws, size_t ws_size, hipStream_t stream) {
    static int grid = 0;
    if (grid == 0) {
        if (n_in != 18 || out_size != NTOK * DM || ws_size < WS_END) { fprintf(stderr, "kernel_launch: unexpected shapes (n_in %d, out %d, ws %zu); nothing launched\n", n_in, out_size, ws_size); grid = -1; return; }
        int dev = 0, cus = 0, per_cu = 0;
        if (hipGetDevice(&dev) != hipSuccess || hipDeviceGetAttribute(&cus, hipDeviceAttributeMultiprocessorCount, dev) != hipSuccess) { grid = -1; return; }
        if (hipFuncSetAttribute((const void*)mega_fwd, hipFuncAttributeMaxDynamicSharedMemorySize, LDS_BYTES) != hipSuccess) { fprintf(stderr, "kernel_launch: hipFuncSetAttribute failed\n"); grid = -1; return; }
        if (hipOccupancyMaxActiveBlocksPerMultiprocessor(&per_cu, (const void*)mega_fwd, NTHR, LDS_BYTES) != hipSuccess || per_cu < 1) fprintf(stderr, "kernel_launch: occupancy query reports %d\n", per_cu);
        (void)hipGetLastError();
        grid = cus;
    }
    if (grid < 0) return;
    (void)hipMemsetAsync((char*)d_ws + WS_CTL, 0, CTL_ZERO_BYTES, stream);
#ifdef EXP_SKIP
    (void)hipMemsetAsync((char*)d_ws + WS_AO, 0, 64 * MiB, stream);
    (void)hipMemsetAsync((char*)d_ws + WS_OL, 0, 64 * MiB, stream);
    if (EXP_SKIP & 4) { (void)hipMemsetAsync((char*)d_ws + WS_XG, 0, 272 * MiB, stream); (void)hipMemsetAsync((char*)d_ws + WS_DEST, 0, 1 * MiB, stream); }
#endif
    Args a{};
    for (int i = 0; i < 18; ++i) a.in[i] = (const float*)d_in[i];
    a.out = (float*)d_out; a.ws = (unsigned char*)d_ws;
#if MK_SINGLE
    a.ph_lo = 0; a.ph_hi = NPHASE;
    hipLaunchKernelGGL(mega_fwd, dim3(grid), dim3(NTHR), LDS_BYTES, stream, a);
#else
    for (int p = 0; p < NPHASE; ++p) {
        if (p > 0) { const int L = (p - 1) / NPL, q = (p - 1) % NPL; if ((L & 1) && (q == 2 || q == 4)) continue;
#ifdef EXP_SKIP
            if ((EXP_SKIP & 1) && !(L & 1) && q <= 4) continue;
            if ((EXP_SKIP & 2) && (L & 1) && q <= 4) continue;
            if ((EXP_SKIP & 4) && q >= 7 && q <= 9) continue;
#endif
        }
        a.ph_lo = p; a.ph_hi = p + 1;
        hipLaunchKernelGGL(mega_fwd, dim3(grid), dim3(NTHR), LDS_BYTES, stream, a);
    }
#endif
}
```

```cpp
#include <hip/hip_runtime.h>
#include <cstdio>
#include <cstdint>
#ifdef EXP_SKIP
#define EXPF EXP_SKIP
#else
#define EXPF 0
#endif
constexpr int NB = 4, SEQ = 8192, DM = 1024, NTOK = NB * SEQ, DEPTH = 4;
constexpr int EV_N = 2560, OD_N = 3072;
constexpr int EC_QA = 0, EC_QB = 512, EC_KB = 1024, EC_VB = 1536, EC_CKV = 2048, EC_QI = 2176, EC_KI = 2432, EC_WI = 2496;
constexpr int OC_Q = 0, OC_K = 1024, OC_V = 2048;
constexpr float LOG2E = 1.4426950408889634f;
constexpr float C2F = 0.125f * LOG2E;
constexpr float ALPHA = 1.681792830507429f;
constexpr float LN_EPS = 1e-5f;
constexpr int NR_MAX = 131072 + 32 * 256;
constexpr int NWAVES = 8, NTHR = 512;
constexpr size_t MiB = (size_t)1 << 20;
constexpr size_t WS_CTL = 0, CTL_ZERO_BYTES = 4 * MiB;
constexpr size_t WS_WEV = 8 * MiB, WS_WOD = 18 * MiB, WS_WOUT = 30 * MiB, WS_WUKT = 38 * MiB, WS_WUVT = 39 * MiB;
constexpr size_t WS_WGU = 40 * MiB, WS_WDN = 552 * MiB;
constexpr size_t WS_X = 808 * MiB, WS_X1 = 936 * MiB, WS_YP = 1064 * MiB, WS_XB = 1192 * MiB;
constexpr size_t WS_PROJ = 1256 * MiB, WS_AO = 1448 * MiB, WS_XG = 1512 * MiB, WS_ACT = 1784 * MiB;
constexpr size_t WS_QL = 2056 * MiB, WS_OL = 2120 * MiB, WS_CKVN = 2184 * MiB, WS_SEL = 2192 * MiB;
constexpr size_t WS_KBAR = 2208 * MiB, WS_SEL3 = 2209 * MiB, WS_LOGF = 2210 * MiB, WS_CS = 2212 * MiB;
constexpr size_t WS_TOPE = 2213 * MiB, WS_GATE = 2214 * MiB, WS_RANK = 2215 * MiB, WS_DEST = 2216 * MiB, WS_PML = 2217 * MiB;
constexpr size_t WS_XB8 = 2226 * MiB;
constexpr size_t WS_KIC = 2258 * MiB;
constexpr size_t WS_END = 2262 * MiB;
constexpr float F8_SX = 16.f, F8_SWG = 256.f, F8_SA = 4.f, F8_SWD = 512.f;
constexpr int CW_BAR = 4096, CW_Q = 8192, CW_KMAX = 12288, CW_CNT = 16384, CW_TILE = 32768;

#define GAS __attribute__((address_space(1)))
#define LAS __attribute__((address_space(3)))
#define DI __device__ __forceinline__
typedef unsigned short bf16;
typedef unsigned v4u __attribute__((ext_vector_type(4)));
typedef unsigned v2u __attribute__((ext_vector_type(2)));
typedef float f32x4 __attribute__((ext_vector_type(4)));
typedef float f32x2 __attribute__((ext_vector_type(2)));
typedef float f32x16 __attribute__((ext_vector_type(16)));
typedef short bf16x8 __attribute__((ext_vector_type(8)));
typedef short s16x4 __attribute__((ext_vector_type(4)));
typedef __bf16 bf16x2_t __attribute__((ext_vector_type(2)));
typedef GAS unsigned gu32;
#define RLX_AGENT __ATOMIC_RELAXED, __HIP_MEMORY_SCOPE_AGENT
#define LDS_WAIT() asm volatile("s_waitcnt lgkmcnt(0)" ::: "memory")

DI float bf2f(unsigned v) { return __uint_as_float(v << 16); }
DI unsigned cvtpk(float lo, float hi) { f32x2 v = {lo, hi}; bf16x2_t b = __builtin_convertvector(v, bf16x2_t); return __builtin_bit_cast(unsigned, b); }
DI unsigned f2bf(float f) { return cvtpk(f, 0.f) & 0xffffu; }
DI unsigned pk4_fp8(float a, float b, float c, float d) {
    a = fminf(fmaxf(a, -448.f), 448.f); b = fminf(fmaxf(b, -448.f), 448.f); c = fminf(fmaxf(c, -448.f), 448.f); d = fminf(fmaxf(d, -448.f), 448.f);
    int w = 0; w = __builtin_amdgcn_cvt_pk_fp8_f32(a, b, w, false); w = __builtin_amdgcn_cvt_pk_fp8_f32(c, d, w, true); return (unsigned)w; }
DI float ex2(float x) { return __builtin_amdgcn_exp2f(x); }
DI float wave_sum(float v) {
#pragma unroll
    for (int o = 1; o < 64; o <<= 1) v += __shfl_xor(v, o);
    return v;
}
DI float wave_max(float v) {
#pragma unroll
    for (int o = 1; o < 64; o <<= 1) v = fmaxf(v, __shfl_xor(v, o));
    return v;
}
DI unsigned ld_u32(const unsigned* p) { return __hip_atomic_load(p, RLX_AGENT); }
DI int crow(int r, int hi) { return (r & 3) + 8 * (r >> 2) + 4 * hi; }
DI f32x16 mfma32(bf16x8 a, bf16x8 b, f32x16 c) { return __builtin_amdgcn_mfma_f32_32x32x16_bf16(a, b, c, 0, 0, 0); }
DI f32x4 mfma16(bf16x8 a, bf16x8 b, f32x4 c) { return __builtin_amdgcn_mfma_f32_16x16x32_bf16(a, b, c, 0, 0, 0); }
typedef short v4i16_t __attribute__((ext_vector_type(4)));
DI s16x4 vtr(LAS const char* p) { return __builtin_bit_cast(s16x4, __builtin_amdgcn_ds_read_tr16_b64_v4i16((LAS v4i16_t*)p)); }
DI bf16x8 cat8(s16x4 a, s16x4 b) { return (bf16x8){a[0], a[1], a[2], a[3], b[0], b[1], b[2], b[3]}; }
DI int t5_bucket(int n) {
    if (n < 16) return n;
    int bkt = 16;
    bkt += (n >= 21); bkt += (n >= 27); bkt += (n >= 35); bkt += (n >= 46); bkt += (n >= 59); bkt += (n >= 77); bkt += (n >= 99); bkt += (n >= 128);
    bkt += (n >= 166); bkt += (n >= 216); bkt += (n >= 280); bkt += (n >= 363); bkt += (n >= 470); bkt += (n >= 609); bkt += (n >= 790);
    return bkt;
}
namespace pg8 {
#define PG8_LAS __attribute__((address_space(3)))
typedef unsigned short bf16_t;
typedef short bf16x8 __attribute__((ext_vector_type(8)));
typedef float f32x4 __attribute__((ext_vector_type(4)));
typedef unsigned u32x4 __attribute__((ext_vector_type(4)));
constexpr int BM = 256, BK = 64, HALF = 128, HTB = HALF * BK * 2  , STAGE_BYTES = 8 * HTB, NXCD = 8, WGM = 8;

__host__ __device__ __forceinline__ int lds_byte(int r, int c) { const int st = (r >> 4) * 2 + (c >> 5), rr = r & 15, cc = c & 31, ob = rr * 64 + cc * 2; return st * 1024 + (ob ^ (((ob >> 9) & 1) << 5)); }
__host__ __device__ __forceinline__ void stage_rc(int b, int& R, int& C) { const int st = b / 1024, sb = b % 1024, swz = sb ^ (((sb >> 9) & 1) << 5); R = (st >> 1) * 16 + swz / 64; C = (st & 1) * 32 + (swz % 64) / 2; }
__host__ __device__ __forceinline__ int perm32(int rho) { const int n = rho >> 4, i = rho & 15; return 8 * (i >> 2) + 4 * n + (i & 3); }

typedef int i32x8 __attribute__((ext_vector_type(8))); typedef int i32x4v __attribute__((ext_vector_type(4)));
__device__ __forceinline__ i32x8 pg8_cat8(bf16x8 lo, bf16x8 hi) { const i32x4v a = __builtin_bit_cast(i32x4v, lo), b = __builtin_bit_cast(i32x4v, hi); return (i32x8){a[0], a[1], a[2], a[3], b[0], b[1], b[2], b[3]}; }
struct Unit { int pm, pn; };
struct Gemm { const bf16_t* A; const bf16_t* Bt; int M, N, K; };

struct StaticOrder {
    int nM, nN, nwg, G, c;
    __host__ __device__ void init(int M, int N, int G_, int c_) { nM = M / BM; nN = N / BM; nwg = nM * nN; G = G_; c = c_; }
    __host__ __device__ bool next(int i, Unit& u) const {
        const long L = (long)i * G + c; if (L >= nwg) return false;
        int wgid = (int)L; { const int q = nwg / NXCD, r = nwg % NXCD, xcd = wgid % NXCD, off = wgid / NXCD; wgid = (xcd < r ? xcd * (q + 1) : r * (q + 1) + (xcd - r) * q) + off; }
        const int nig = WGM * nN, gid = wgid / nig, fm = gid * WGM, gsz = (nM - fm) < WGM ? (nM - fm) : WGM;
        u.pm = fm + ((wgid % nig) % gsz); u.pn = (wgid % nig) / gsz; return true;
    }
    __device__ __forceinline__ void a_ready(const Unit&) const {}
    __device__ __forceinline__ void done(const Unit&) const {}
};

__device__ __forceinline__ unsigned cvt_pk_bf16(float lo, float hi) { unsigned r; asm volatile("v_cvt_pk_bf16_f32 %0, %1, %2" : "=v"(r) : "v"(lo), "v"(hi)); return r; }
typedef float f32x2 __attribute__((ext_vector_type(2)));
__device__ __forceinline__ f32x2 gelu_pk(f32x2 v) {
    const f32x2 av = __builtin_elementwise_abs(v), d = av * 0.2316418882f + 1.0f;
    f32x2 t; t.x = __builtin_amdgcn_rcpf(d.x); t.y = __builtin_amdgcn_rcpf(d.y);
    f32x2 q = t * 0.5307027145f + (-0.7265760135f); q = q * t + 0.7107068705f; q = q * t + (-0.142248368f); q = q * t + 0.127414796f; q = q * t;
    const f32x2 s = (v * v) * (-0.72134752044f);
    f32x2 e; e.x = __builtin_amdgcn_exp2f(s.x); e.y = __builtin_amdgcn_exp2f(s.y);
    const f32x2 m = v * (q * e), r = v - m;
    f32x2 o; o.x = v.x < 0.f ? m.x : r.x; o.y = v.y < 0.f ? m.y : r.y; return o;
}

template <int ACT  > struct EpiBf16 {
    static constexpr bool PERM = true, AFTER_DRAIN = false; static_assert(ACT == 0 || ACT == 1, "EpiBf16: ACT is 0 (none) or 1 (gelu_pk)");
    bf16_t* O; int ldc; const float* bias; int split_cols; size_t split_stride; float scale0;
    __device__ __forceinline__ void operator()(const f32x4 (&acc)[2][2][4][2], const Unit& u, int wr, int wc, int fr, int fq) const {
        const int row0 = u.pm * BM + wr * 64 + fr; int colt = u.pn * BM; bf16_t* base = O;
        float sc = 1.f; if (split_cols) { const int t = colt / split_cols; base += (size_t)t * split_stride; colt -= t * split_cols; if (t == 0) sc = scale0; }
        const int col0 = colt + wc * 32 + 8 * fq, bcol0 = u.pn * BM + wc * 32 + 8 * fq;
        f32x4 bv[2][2];
#pragma unroll
        for (int bj = 0; bj < 2; ++bj)
#pragma unroll
            for (int n = 0; n < 2; ++n) bv[bj][n] = bias ? *(const f32x4*)(bias + bcol0 + bj * HALF + 4 * n) : (f32x4){0.f, 0.f, 0.f, 0.f};
#pragma unroll
        for (int ai = 0; ai < 2; ++ai)
#pragma unroll
            for (int m = 0; m < 4; ++m) { bf16_t* rowp = base + (size_t)(row0 + ai * HALF + m * 16) * ldc + col0;
#pragma unroll
                for (int bj = 0; bj < 2; ++bj) { f32x4 v0 = acc[ai][bj][m][0] + bv[bj][0], v1 = acc[ai][bj][m][1] + bv[bj][1];
                    if (ACT == 1) { f32x2 a = gelu_pk((f32x2){v0[0], v0[1]}), b = gelu_pk((f32x2){v0[2], v0[3]}), c = gelu_pk((f32x2){v1[0], v1[1]}), d = gelu_pk((f32x2){v1[2], v1[3]});
                        v0 = (f32x4){a.x, a.y, b.x, b.y}; v1 = (f32x4){c.x, c.y, d.x, d.y}; }
                    v0 = v0 * sc; v1 = v1 * sc; u32x4 w; w.x = cvt_pk_bf16(v0[0], v0[1]); w.y = cvt_pk_bf16(v0[2], v0[3]); w.z = cvt_pk_bf16(v1[0], v1[1]); w.w = cvt_pk_bf16(v1[2], v1[3]);
                    *(u32x4*)(rowp + bj * HALF) = w; } }
    }
};

template <class Epi, class Sched, bool ALIGN_EPI = false, bool SP2 = false, bool F8 = false>
__device__ __forceinline__ void gemm_phase(PG8_LAS unsigned char* lds, const Gemm g, const Sched& S, const Epi& E, int tid_in) {
    int tid_l = tid_in; asm volatile("" : "+v"(tid_l));
    const int tid = tid_l, wid = __builtin_amdgcn_readfirstlane(tid >> 6), lane = tid & 63, wr = wid >> 2, wc = wid & 3, fr = lane & 15, fq = lane >> 4;
    const int K = g.K, nt = K / BK;
    unsigned voffA[2], voffB[2];
#pragma unroll
    for (int i = 0; i < 2; ++i) { int R, C; stage_rc(tid * 16 + i * 8192, R, C); const int Rb = Epi::PERM ? ((R & ~31) + perm32(R & 31)) : R;
        voffA[i] = (unsigned)(R * K + C) * 2u; voffB[i] = (unsigned)(Rb * K + C) * 2u; }
    const size_t kstep = (size_t)(BK * 2);
    const size_t hstep = (size_t)HALF * K * 2;
    const size_t tstep = 2 * hstep;
    const unsigned ldsw = (unsigned)wid * 1024u;
    const int aoff = lds_byte(wr * 64 + fr, fq * 8), boff = lds_byte(wc * 32 + fr, fq * 8);
#define PG8_SA(b, h) (((b) * 2 + (h)) * HTB)
#define PG8_SB(b, h) ((4 + (b) * 2 + (h)) * HTB)
#define PG8_STAGE(bufoff, gbase, voff) do { _Pragma("unroll") for (int _i = 0; _i < 2; ++_i) \
        __builtin_amdgcn_global_load_lds((const unsigned*)((const char*)(gbase) + (voff)[_i]), (PG8_LAS unsigned*)(lds + (bufoff) + ldsw + _i * 8192), 16, 0, 0); } while (0)
#define PG8_LDA(dst, b, h) do { _Pragma("unroll") for (int m = 0; m < 4; ++m) _Pragma("unroll") for (int k = 0; k < 2; ++k) dst[m][k] = *(const PG8_LAS bf16x8*)(lds + PG8_SA(b, h) + aoff + m * 2048 + k * 1024); } while (0)
#define PG8_LDB(dst, b, h) do { _Pragma("unroll") for (int n = 0; n < 2; ++n) _Pragma("unroll") for (int k = 0; k < 2; ++k) dst[n][k] = *(const PG8_LAS bf16x8*)(lds + PG8_SB(b, h) + boff + n * 2048 + k * 1024); } while (0)
#define PG8_MMA(ai, bj, At, Bt) do { __builtin_amdgcn_s_setprio(1); if constexpr (!F8) { _Pragma("unroll") for (int m = 0; m < 4; ++m) _Pragma("unroll") for (int n = 0; n < 2; ++n) _Pragma("unroll") for (int k = 0; k < 2; ++k) \
        acc[ai][bj][m][n] = __builtin_amdgcn_mfma_f32_16x16x32_bf16(Bt[n][k], At[m][k], acc[ai][bj][m][n], 0, 0, 0); } else { _Pragma("unroll") for (int m = 0; m < 4; ++m) _Pragma("unroll") for (int n = 0; n < 2; ++n) \
        acc[ai][bj][m][n] = __builtin_amdgcn_mfma_scale_f32_16x16x128_f8f6f4(pg8_cat8(Bt[n][0], Bt[n][1]), pg8_cat8(At[m][0], At[m][1]), acc[ai][bj][m][n], 0, 0, 0, 0x7F7F7F7F, 0, 0x7F7F7F7F); \
        _Pragma("unroll") for (int m = 0; m < 4; ++m) _Pragma("unroll") for (int n = 0; n < 2; ++n) asm volatile("" : "+v"(acc[ai][bj][m][n]));   } __builtin_amdgcn_s_setprio(0); } while (0)
#define PG8_WAIT_V(n) asm volatile("s_waitcnt vmcnt(" #n ")" ::: "memory")
#define PG8_WAIT_L(n) asm volatile("s_waitcnt lgkmcnt(" #n ")" ::: "memory")
#define PG8_BAR __builtin_amdgcn_s_barrier()
#define PG8_SCHED __builtin_amdgcn_sched_barrier(0)
    Unit cur, nxt; int ui = 0;
    if (!S.next(0, cur)) return;
    f32x4 acc[2][2][4][2];
#pragma unroll
    for (int a = 0; a < 2; ++a)
#pragma unroll
        for (int b = 0; b < 2; ++b)
#pragma unroll
            for (int m = 0; m < 4; ++m)
#pragma unroll
                for (int n = 0; n < 2; ++n) acc[a][b][m][n] = (f32x4){0.f, 0.f, 0.f, 0.f};
    bf16x8 At[4][2], B0[2][2], B1[2][2];
    const char* cA = (const char*)g.A + (size_t)cur.pm * tstep; const char* cB = (const char*)g.Bt + (size_t)cur.pn * tstep;
    S.a_ready(cur);
    if constexpr (SP2) {
        PG8_STAGE(PG8_SB(0, 0), cB, voffB); PG8_STAGE(PG8_SB(0, 1), cB + hstep, voffB); PG8_STAGE(PG8_SA(0, 0), cA, voffA); PG8_STAGE(PG8_SA(0, 1), cA + hstep, voffA);
        if (wr == 1) PG8_BAR;
        PG8_WAIT_V(2); PG8_BAR;
        PG8_STAGE(PG8_SB(1, 0), cB + kstep, voffB); PG8_STAGE(PG8_SA(1, 0), cA + kstep, voffA); PG8_STAGE(PG8_SB(1, 1), cB + hstep + kstep, voffB);
        PG8_WAIT_V(6); PG8_BAR;
    } else {
        PG8_STAGE(PG8_SB(0, 0), cB, voffB); PG8_STAGE(PG8_SA(0, 0), cA, voffA); PG8_STAGE(PG8_SB(0, 1), cB + hstep, voffB); PG8_STAGE(PG8_SA(0, 1), cA + hstep, voffA);
        if (wr == 1) PG8_BAR;
        PG8_WAIT_V(4); PG8_BAR;
        PG8_STAGE(PG8_SB(1, 0), cB + kstep, voffB); PG8_STAGE(PG8_SA(1, 0), cA + kstep, voffA); PG8_STAGE(PG8_SB(1, 1), cB + hstep + kstep, voffB);
        PG8_WAIT_V(6); PG8_BAR;
    }
    for (;;) {
        const bool has_next = S.next(ui + 1, nxt);
        const char* nA = has_next ? (const char*)g.A + (size_t)nxt.pm * tstep : cA; const char* nB = has_next ? (const char*)g.Bt + (size_t)nxt.pn * tstep : cB;
        for (int t = 0; t < nt; t += 2) {
            const bool last = (t == nt - 2);
            const char* a1 = cA + (size_t)(t + 1) * kstep;
            const char* a2 = last ? nA : cA + (size_t)(t + 2) * kstep; const char* b2 = last ? nB : cB + (size_t)(t + 2) * kstep;
            const char* a3 = a2 + kstep; const char* b3 = b2 + kstep;
            if (last && has_next) S.a_ready(nxt);
            if constexpr (SP2) {
            PG8_LDB(B0, 0, 0); PG8_LDB(B1, 0, 1); PG8_SCHED; PG8_LDA(At, 0, 0); PG8_STAGE(PG8_SA(1, 1), a1 + hstep, voffA);
            PG8_WAIT_V(8); PG8_WAIT_L(0); PG8_BAR; PG8_MMA(0, 0, At, B0); PG8_MMA(0, 1, At, B1); PG8_BAR; PG8_SCHED;
            PG8_LDA(At, 0, 1); PG8_STAGE(PG8_SB(0, 0), b2, voffB); PG8_STAGE(PG8_SB(0, 1), b2 + hstep, voffB); PG8_STAGE(PG8_SA(0, 0), a2, voffA);
            PG8_WAIT_V(8); PG8_WAIT_L(0); PG8_BAR; PG8_MMA(1, 0, At, B0); PG8_MMA(1, 1, At, B1); PG8_BAR; PG8_SCHED;
            PG8_LDB(B0, 1, 0); PG8_LDB(B1, 1, 1); PG8_SCHED; PG8_LDA(At, 1, 0); PG8_STAGE(PG8_SA(0, 1), a2 + hstep, voffA);
            PG8_WAIT_V(8); PG8_WAIT_L(0); PG8_BAR; PG8_MMA(0, 0, At, B0); PG8_MMA(0, 1, At, B1); PG8_BAR; PG8_SCHED;
            PG8_LDA(At, 1, 1); PG8_STAGE(PG8_SB(1, 0), b3, voffB); PG8_STAGE(PG8_SB(1, 1), b3 + hstep, voffB); PG8_STAGE(PG8_SA(1, 0), a3, voffA);
            PG8_WAIT_V(8); PG8_WAIT_L(0); PG8_BAR; PG8_MMA(1, 0, At, B0); PG8_MMA(1, 1, At, B1); PG8_BAR; PG8_SCHED;
            } else {
            PG8_LDB(B0, 0, 0); PG8_SCHED; PG8_LDA(At, 0, 0); PG8_STAGE(PG8_SA(1, 1), a1 + hstep, voffA);
            PG8_WAIT_L(8); PG8_BAR; PG8_WAIT_L(0); PG8_MMA(0, 0, At, B0); PG8_BAR; PG8_SCHED;
            PG8_LDB(B1, 0, 1); PG8_STAGE(PG8_SB(0, 0), b2, voffB);
            PG8_BAR; PG8_WAIT_L(0); PG8_MMA(0, 1, At, B1); PG8_BAR;
            PG8_LDA(At, 0, 1); PG8_STAGE(PG8_SA(0, 0), a2, voffA);
            PG8_BAR; PG8_WAIT_L(0); PG8_MMA(1, 0, At, B0); PG8_BAR; PG8_SCHED;
            PG8_STAGE(PG8_SB(0, 1), b2 + hstep, voffB);
            PG8_WAIT_V(6); PG8_BAR; PG8_MMA(1, 1, At, B1); PG8_BAR;
            PG8_LDB(B0, 1, 0); PG8_SCHED; PG8_LDA(At, 1, 0); PG8_STAGE(PG8_SA(0, 1), a2 + hstep, voffA);
            PG8_WAIT_L(8); PG8_BAR; PG8_WAIT_L(0); PG8_MMA(0, 0, At, B0); PG8_BAR; PG8_SCHED;
            PG8_LDB(B1, 1, 1); PG8_STAGE(PG8_SB(1, 0), b3, voffB);
            PG8_BAR; PG8_WAIT_L(0); PG8_MMA(0, 1, At, B1); PG8_BAR;
            PG8_LDA(At, 1, 1); PG8_STAGE(PG8_SA(1, 0), a3, voffA);
            PG8_BAR; PG8_WAIT_L(0); PG8_MMA(1, 0, At, B0); PG8_BAR; PG8_SCHED;
            PG8_STAGE(PG8_SB(1, 1), b3 + hstep, voffB);
            PG8_WAIT_V(6); PG8_BAR; PG8_MMA(1, 1, At, B1); PG8_BAR;
            }
        }
        if constexpr (ALIGN_EPI) { if (wr == 0) PG8_BAR; }
        if constexpr (!Epi::AFTER_DRAIN) { E(acc, cur, wr, wc, fr, fq); S.done(cur); }
        if (!has_next) break;
#pragma unroll
        for (int a = 0; a < 2; ++a)
#pragma unroll
            for (int b = 0; b < 2; ++b)
#pragma unroll
                for (int m = 0; m < 4; ++m)
#pragma unroll
                    for (int n = 0; n < 2; ++n) acc[a][b][m][n] = (f32x4){0.f, 0.f, 0.f, 0.f};
        cur = nxt; cA = nA; cB = nB; ++ui;
        if constexpr (ALIGN_EPI) { if (wr == 1) PG8_BAR; }
    }
    PG8_WAIT_V(0);
    if constexpr (!ALIGN_EPI) { if (wr == 0) PG8_BAR; }
    PG8_BAR;
    if constexpr (Epi::AFTER_DRAIN) { E.fused(acc, cur, wr, wc, fr, fq, lds, wid, lane); S.done(cur); }
#undef PG8_SA
#undef PG8_SB
#undef PG8_STAGE
#undef PG8_LDA
#undef PG8_LDB
#undef PG8_MMA
#undef PG8_WAIT_V
#undef PG8_WAIT_L
#undef PG8_BAR
#undef PG8_SCHED
}
}

#ifndef PG8_SP2
#define PG8_SP2 true
#endif
#ifndef PG8_ALIGN
#define PG8_ALIGN true
#endif
#define XB_TMO      128
#define XB_XCNT(j)  (256  + 64 * (j))
#define XB_XSUB(j)  (1280 + 64 * (j))
#define XB_XGEN(j)  (2304 + 64 * (j))
#define XB_TOP      3328
#define XB_TOPGEN   3392
#define XCD_BAR_WORDS 3456
#define XB_SPIN_CAP (1u << 18)

__device__ __forceinline__ unsigned xb_ld(unsigned* p)              { return __hip_atomic_load(p, __ATOMIC_RELAXED, __HIP_MEMORY_SCOPE_AGENT); }
__device__ __forceinline__ unsigned xb_add(unsigned* p, unsigned v) { return __hip_atomic_fetch_add(p, v, __ATOMIC_RELAXED, __HIP_MEMORY_SCOPE_AGENT); }
__device__ __forceinline__ unsigned xb_xcc_id() { return (unsigned)__builtin_amdgcn_s_getreg((3 << 11) | 20) & 0xFu; }
#define XB_SPIN(cond, bar) do { unsigned _sp = 0; while (cond) { __builtin_amdgcn_s_sleep(1); \
    if ((++_sp & 255u) == 0u) { if (xb_ld(&(bar)[XB_TMO])) break; if (_sp > XB_SPIN_CAP) { atomicAdd(&(bar)[XB_TMO], 1u); break; } } } } while (0)

struct XcdBarrier {
    unsigned* bar; unsigned x;
    volatile LAS unsigned* st;
};

__device__ __forceinline__ XcdBarrier xcd_barrier_post(unsigned* bar, volatile LAS unsigned* st) {
    XcdBarrier b; b.bar = bar; b.x = xb_xcc_id(); b.st = st;
    if (threadIdx.x == 0) (void)xb_add(&bar[XB_XCNT(b.x)], 1u);
    return b;
}
__device__ __forceinline__ void xcd_barrier_complete(unsigned* bar, unsigned x, unsigned& nloc, unsigned& nx) {
    const unsigned G = gridDim.x * gridDim.y * gridDim.z;
    unsigned sum, cnt, mine, sp = 0u;
    for (;;) {
        sum = 0u; cnt = 0u; mine = 0u;
#pragma unroll
        for (unsigned j = 0; j < 16; ++j) { const unsigned c = xb_ld(&bar[XB_XCNT(j)]); sum += c; cnt += (c > 0u) ? 1u : 0u; mine = (j == x) ? c : mine; }
        if (sum == G) break;
        __builtin_amdgcn_s_sleep(1);
        if ((++sp & 255u) == 0u) { if (xb_ld(&bar[XB_TMO])) break; if (sp > XB_SPIN_CAP) { atomicAdd(&bar[XB_TMO], 1u); break; } }
    }
    nloc = mine > 0u ? mine : 1u; nx = cnt > 0u ? cnt : 1u;
}

__device__ __forceinline__ void xcd_barrier(const XcdBarrier& b, const bool is_t0  ) {
    asm volatile("s_waitcnt vmcnt(0)" ::: "memory");
    __syncthreads();
    if (is_t0) {
        unsigned* bar = b.bar;
        __builtin_amdgcn_s_waitcnt(0);
        unsigned nloc = b.st[0], nx = b.st[1];
        if (nloc == 0u) { xcd_barrier_complete(bar, b.x, nloc, nx); b.st[0] = nloc; b.st[1] = nx; }
        const unsigned old = xb_add(&bar[XB_XSUB(b.x)], 1u);
        const unsigned gen = old / nloc;
        if (old + 1u == (gen + 1u) * nloc) {
            __builtin_amdgcn_fence(__ATOMIC_RELEASE, "agent");
            asm volatile("s_waitcnt vmcnt(0)" ::: "memory");
            const unsigned og = xb_add(&bar[XB_TOP], 1u);
            const unsigned tg = og / nx;
            if (og + 1u == (tg + 1u) * nx) xb_add(&bar[XB_TOPGEN], 1u);
            else XB_SPIN(xb_ld(&bar[XB_TOPGEN]) == tg, bar);
            __builtin_amdgcn_fence(__ATOMIC_ACQUIRE, "agent");
            xb_add(&bar[XB_XGEN(b.x)], 1u);
            asm volatile("s_waitcnt vmcnt(0)" ::: "memory");
        } else {
            XB_SPIN(xb_ld(&bar[XB_XGEN(b.x)]) == gen, bar);
            __builtin_amdgcn_fence(__ATOMIC_ACQUIRE, "agent");
            asm volatile("s_waitcnt vmcnt(0)" ::: "memory");
        }
    }
    __syncthreads();
}
struct EpiResF32 {
    static constexpr bool PERM = true, AFTER_DRAIN = false;
    const float* xin; float* yp; float alpha;
    DI void operator()(const pg8::f32x4 (&acc)[2][2][4][2], const pg8::Unit& u, int wr, int wc, int fr, int fq) const {
        const int row0 = u.pm * 256 + wr * 64 + fr, col0 = u.pn * 256 + wc * 32 + 8 * fq;
#pragma unroll
        for (int ai = 0; ai < 2; ++ai)
#pragma unroll
            for (int m = 0; m < 4; ++m) {
                const size_t ro = (size_t)(row0 + ai * 128 + m * 16) * DM;
#pragma unroll
                for (int bj = 0; bj < 2; ++bj) {
                    const size_t o = ro + col0 + bj * 128;
                    const f32x4 x0 = *(const f32x4*)(xin + o), x1 = *(const f32x4*)(xin + o + 4);
                    *(f32x4*)(yp + o) = x0 * alpha + acc[ai][bj][m][0];
                    *(f32x4*)(yp + o + 4) = x1 * alpha + acc[ai][bj][m][1];
                }
            }
    }
};
struct EpiSwiglu {
    static constexpr bool PERM = true, AFTER_DRAIN = false;
    unsigned char* act; const float* bgu;
    DI void operator()(const pg8::f32x4 (&acc)[2][2][4][2], const pg8::Unit& u, int wr, int wc, int fr, int fq) const {
        const int e = u.pn >> 3, pl = u.pn & 7;
        const int row0 = u.pm * 256 + wr * 64 + fr, cih = pl * 128 + wc * 32 + 8 * fq;
        const float* bg = bgu + e * 2048 + cih;
        const f32x4 bg0 = *(const f32x4*)(bg), bg1 = *(const f32x4*)(bg + 4), bu0 = *(const f32x4*)(bg + 1024), bu1 = *(const f32x4*)(bg + 1028);
#pragma unroll
        for (int ai = 0; ai < 2; ++ai)
#pragma unroll
            for (int m = 0; m < 4; ++m) {
                constexpr float RS = 1.f / (F8_SX * F8_SWG);
                const f32x4 g0 = acc[ai][0][m][0] * RS + bg0, g1 = acc[ai][0][m][1] * RS + bg1, u0 = acc[ai][1][m][0] * RS + bu0, u1 = acc[ai][1][m][1] * RS + bu1;
                float r[8];
#pragma unroll
                for (int i = 0; i < 8; ++i) {
                    float g = i < 4 ? g0[i & 3] : g1[i & 3], uu = i < 4 ? u0[i & 3] : u1[i & 3];
                    g = fminf(g, 7.0f); uu = fminf(fmaxf(uu, -7.0f), 7.0f);
                    const float sg = __builtin_amdgcn_rcpf(1.0f + ex2(-1.702f * LOG2E * g));
                    r[i] = (uu + 1.0f) * g * sg * F8_SA;
                }
                v2u w; w.x = pk4_fp8(r[0], r[1], r[2], r[3]); w.y = pk4_fp8(r[4], r[5], r[6], r[7]);
                *(v2u*)(act + (size_t)(row0 + ai * 128 + m * 16) * DM + cih) = w;
            }
    }
};
struct EpiDown {
    static constexpr bool PERM = true, AFTER_DRAIN = false;
    bf16* yr; const float* bdn;
    DI void operator()(const pg8::f32x4 (&acc)[2][2][4][2], const pg8::Unit& u, int wr, int wc, int fr, int fq) const {
        const int e = u.pn >> 2, pl = u.pn & 3;
        const int row0 = u.pm * 256 + wr * 64 + fr, col0 = pl * 256 + wc * 32 + 8 * fq;
        f32x4 bv[2][2];
#pragma unroll
        for (int bj = 0; bj < 2; ++bj) { bv[bj][0] = *(const f32x4*)(bdn + e * 1024 + col0 + bj * 128); bv[bj][1] = *(const f32x4*)(bdn + e * 1024 + col0 + bj * 128 + 4); }
#pragma unroll
        for (int ai = 0; ai < 2; ++ai)
#pragma unroll
            for (int m = 0; m < 4; ++m) {
                bf16* rp = yr + (size_t)(row0 + ai * 128 + m * 16) * DM + col0;
#pragma unroll
                for (int bj = 0; bj < 2; ++bj) {
                    constexpr float RS = 1.f / (F8_SA * F8_SWD);
                    const f32x4 v0 = acc[ai][bj][m][0] * RS + bv[bj][0], v1 = acc[ai][bj][m][1] * RS + bv[bj][1];
                    v4u w; w.x = cvtpk(v0[0], v0[1]); w.y = cvtpk(v0[2], v0[3]); w.z = cvtpk(v1[0], v1[1]); w.w = cvtpk(v1[2], v1[3]);
                    *(v4u*)(rp + bj * 128) = w;
                }
            }
    }
};
struct GroupOrder {
    LAS const unsigned* tile_e; int ntiles, lg, G, c;
    DI bool next(int i, pg8::Unit& u) const {
        int pm, pl;
        if (G == 256) {
            const int x = c & 7, k = c >> 3; pm = i * (256 >> lg) + x * (32 >> lg) + (k >> lg); pl = k & ((1 << lg) - 1); if (pm >= ntiles) return false; }
        else { const long L = (long)i * G + c; if (L >= ((long)ntiles << lg)) return false; pm = (int)(L >> lg); pl = (int)(L & ((1 << lg) - 1)); }
        const int e = __builtin_amdgcn_readfirstlane((int)tile_e[pm]);
        u.pm = pm; u.pn = (e << lg) + pl; return true;
    }
    DI void a_ready(const pg8::Unit&) const {}
    DI void done(const pg8::Unit&) const {}
};
struct Args { const float* in[18]; float* out; unsigned char* ws; int ph_lo, ph_hi; };
struct Fr { LAS unsigned char* lds; unsigned char* ws; unsigned* ctl; int tid, lane, wave, blk, G; };

DI void tr_item(const float* W, int ldw, int K, int k0, int sc0, int nvalid, bf16* WT, int drow0, LAS float* scr, int lane) {
    const int c = lane & 31;
    float v[32];
#pragma unroll
    for (int i = 0; i < 32; ++i) v[i] = (c < nvalid) ? W[(size_t)(k0 + 2 * i + (lane >> 5)) * ldw + sc0 + c] : 0.f;
#pragma unroll
    for (int i = 0; i < 32; ++i) scr[(2 * i + (lane >> 5)) * 33 + c] = v[i];
    LDS_WAIT(); asm volatile("" ::: "memory");
    const int c8 = lane & 7;
#pragma unroll
    for (int j = 0; j < 4; ++j) { const int n = (lane >> 3) + 8 * j; const LAS float* s = scr + (8 * c8) * 33 + n;
        v4u o; o.x = cvtpk(s[0 * 33], s[1 * 33]); o.y = cvtpk(s[2 * 33], s[3 * 33]); o.z = cvtpk(s[4 * 33], s[5 * 33]); o.w = cvtpk(s[6 * 33], s[7 * 33]);
        *(v4u*)(WT + (size_t)(drow0 + n) * K + k0 + 8 * c8) = o; }
    LDS_WAIT(); asm volatile("" ::: "memory");
}
DI void tr_item8(const float* W, int ldw, int K, int k0, int sc0, float scale, unsigned char* WT8, int drow0, LAS float* scr, int lane) {
    const int c = lane & 31;
    float v[32];
#pragma unroll
    for (int i = 0; i < 32; ++i) v[i] = W[(size_t)(k0 + 2 * i + (lane >> 5)) * ldw + sc0 + c];
#pragma unroll
    for (int i = 0; i < 32; ++i) scr[(2 * i + (lane >> 5)) * 33 + c] = v[i] * scale;
    LDS_WAIT(); asm volatile("" ::: "memory");
    const int c16 = lane & 3;
#pragma unroll
    for (int j = 0; j < 2; ++j) { const int n = (lane >> 2) + 16 * j; const LAS float* s = scr + (16 * c16) * 33 + n;
        v4u o; o.x = pk4_fp8(s[0 * 33], s[1 * 33], s[2 * 33], s[3 * 33]); o.y = pk4_fp8(s[4 * 33], s[5 * 33], s[6 * 33], s[7 * 33]);
        o.z = pk4_fp8(s[8 * 33], s[9 * 33], s[10 * 33], s[11 * 33]); o.w = pk4_fp8(s[12 * 33], s[13 * 33], s[14 * 33], s[15 * 33]);
        *(v4u*)(WT8 + (size_t)(drow0 + n) * K + k0 + 16 * c16) = o; }
    LDS_WAIT(); asm volatile("" ::: "memory");
}
DI void ph_prologue(const Args& a, const Fr& F) {
    LAS float* scr = (LAS float*)(F.lds + F.wave * 16384);
    const int gw = F.blk * NWAVES + F.wave, NGW = F.G * NWAVES;
    constexpr int I_EV = 2 * 16 * 80, I_OD = 2 * 16 * 96, I_WO = 4 * 16 * 32;
    constexpr int NITEMS = I_EV + I_OD + I_WO;
    bf16* wev = (bf16*)(F.ws + WS_WEV); bf16* wod = (bf16*)(F.ws + WS_WOD); bf16* wout = (bf16*)(F.ws + WS_WOUT);
    unsigned char* wgu = F.ws + WS_WGU; unsigned char* wdn = F.ws + WS_WDN;
    for (int it = gw; it < NITEMS; it += NGW) {
        int r = it;
        if (r < I_EV) { const int l = r / 1280; r %= 1280; const int kb = r / 80, n0 = (r % 80) * 32; int sc0, nv = 32;
            if (n0 < 512) sc0 = n0; else if (n0 < 1024) sc0 = 964 + (n0 - 512); else if (n0 < 1536) sc0 = 1476 + (n0 - 1024); else if (n0 < 2048) sc0 = 1988 + (n0 - 1536);
            else if (n0 < 2176) sc0 = 512 + (n0 - 2048); else if (n0 < 2432) sc0 = 640 + (n0 - 2176); else if (n0 < 2496) sc0 = 896 + (n0 - 2432);
            else if (n0 < 2528) { sc0 = 960; nv = 4; } else { sc0 = 0; nv = 0; }
            tr_item(a.in[1] + (size_t)l * 1024 * 2500, 2500, 1024, kb * 64, sc0, nv, wev + (size_t)l * EV_N * 1024, n0, scr, F.lane); continue; }
        r -= I_EV;
        if (r < I_OD) { const int l = r / 1536; r %= 1536; const int kb = r / 96, n0 = (r % 96) * 32;
            tr_item(a.in[6] + (size_t)l * 1024 * 3088, 3088, 1024, kb * 64, n0, 32, wod + (size_t)l * OD_N * 1024, n0, scr, F.lane); continue; }
        r -= I_OD;
        if (r < I_WO) { const int l = r / 512; r %= 512; const int kb = r / 32, n0 = (r % 32) * 32;
            const float* src = (l & 1) ? a.in[8] + (size_t)(l >> 1) * 1024 * 1024 : a.in[5] + (size_t)(l >> 1) * 1024 * 1024;
            tr_item(src, 1024, 1024, kb * 64, n0, 32, wout + (size_t)l * 1024 * 1024, n0, scr, F.lane); continue; }
    }
    { __syncthreads();
        LAS float* tile = (LAS float*)F.lds; unsigned char* wgu8 = F.ws + WS_WGU; unsigned char* wdn8 = F.ws + WS_WDN;
        constexpr int T_GU = 128 * 8 * 16, T_DN = 128 * 8 * 8, T_ALL = T_GU + T_DN;
        const int tid = F.tid, c4 = tid & 31, r0 = tid >> 5;
        f32x4 v[8];
        auto locate = [&](int t, const float*& src, int& ldw, unsigned char*& dst, float& scale) {
            if (t < T_GU) { const int le = t >> 7, r = t & 127, kb = r >> 4, nb = r & 15, n0 = nb * 128; const int pn = n0 >> 8, bj = (n0 >> 7) & 1;
                src = a.in[14] + (size_t)le * 1024 * 2048 + (size_t)(kb * 128) * 2048 + bj * 1024 + pn * 128; ldw = 2048; dst = wgu8 + (size_t)le * 2048 * 1024 + (size_t)n0 * 1024 + kb * 128; scale = F8_SWG; }
            else { const int u = t - T_GU, le = u >> 6, r = u & 63, kb = r >> 3, nb = r & 7;
                src = a.in[16] + (size_t)le * 1024 * 1024 + (size_t)(kb * 128) * 1024 + nb * 128; ldw = 1024; dst = wdn8 + (size_t)le * 1024 * 1024 + (size_t)(nb * 128) * 1024 + kb * 128; scale = F8_SWD; } };
        int t = F.blk;
        if (t < T_ALL) { const float* src; int ldw; unsigned char* dst; float sc; locate(t, src, ldw, dst, sc);
#pragma unroll
            for (int i = 0; i < 8; ++i) v[i] = *(const f32x4*)(src + (size_t)(r0 + 16 * i) * ldw + 4 * c4); }
        for (; t < T_ALL; t += F.G) {
            const float* src; int ldw; unsigned char* dst; float sc; locate(t, src, ldw, dst, sc);
#pragma unroll
            for (int i = 0; i < 8; ++i) { LAS float* tp = tile + (r0 + 16 * i) * 129 + 4 * c4; tp[0] = v[i][0] * sc; tp[1] = v[i][1] * sc; tp[2] = v[i][2] * sc; tp[3] = v[i][3] * sc; }
            __syncthreads();
            if (t + F.G < T_ALL) { const float* s2; int l2; unsigned char* d2; float c2; locate(t + F.G, s2, l2, d2, c2);
#pragma unroll
                for (int i = 0; i < 8; ++i) v[i] = *(const f32x4*)(s2 + (size_t)(r0 + 16 * i) * l2 + 4 * c4); }
#pragma unroll
            for (int j = 0; j < 2; ++j) { const int p = tid + 512 * j, kc = p & 7, n = p >> 3; const LAS float* sp = tile + (kc * 16) * 129 + n;
                v4u o; o.x = pk4_fp8(sp[0], sp[129], sp[2 * 129], sp[3 * 129]); o.y = pk4_fp8(sp[4 * 129], sp[5 * 129], sp[6 * 129], sp[7 * 129]);
                o.z = pk4_fp8(sp[8 * 129], sp[9 * 129], sp[10 * 129], sp[11 * 129]); o.w = pk4_fp8(sp[12 * 129], sp[13 * 129], sp[14 * 129], sp[15 * 129]);
                *(v4u*)(dst + (size_t)n * 1024 + kc * 16) = o; }
            __syncthreads();
        }
    }
    bf16* xb = (bf16*)(F.ws + WS_XB);
    for (int m = gw; m < NTOK; m += NGW) {
        const f32x4* xr = (const f32x4*)(a.in[0] + (size_t)m * DM) + F.lane; v2u* o = (v2u*)(xb + (size_t)m * DM) + F.lane;
#pragma unroll
        for (int j = 0; j < 4; ++j) { const f32x4 v = xr[64 * j]; v2u w; w.x = cvtpk(v[0], v[1]); w.y = cvtpk(v[2], v[3]); o[64 * j] = w; }
    }
    bf16* wukt = (bf16*)(F.ws + WS_WUKT); bf16* wuvt = (bf16*)(F.ws + WS_WUVT);
    for (int i = F.blk * NTHR + F.tid; i < 2 * 8 * 128 * 64; i += F.G * NTHR) {
        { const int d = i & 63, c = (i >> 6) & 127, lh = i >> 13; wukt[i] = (bf16)f2bf(a.in[2][((size_t)lh * 64 + d) * 128 + c]); }
        { const int c = i & 127, d = (i >> 7) & 63, lh = i >> 13; wuvt[i] = (bf16)f2bf(a.in[3][((size_t)lh * 128 + c) * 64 + d]); }
    }
}

DI void ln_row(f32x4 (&v)[4], const float* g, const float* b, int lane) {
    float s = 0.f;
#pragma unroll
    for (int j = 0; j < 4; ++j) s += (v[j][0] + v[j][1]) + (v[j][2] + v[j][3]);
    const float mean = wave_sum(s) * (1.f / DM); float s2 = 0.f;
#pragma unroll
    for (int j = 0; j < 4; ++j) { v[j] = v[j] - mean; s2 += (v[j][0] * v[j][0] + v[j][1] * v[j][1]) + (v[j][2] * v[j][2] + v[j][3] * v[j][3]); }
    const float rstd = 1.f / sqrtf(wave_sum(s2) * (1.f / DM) + LN_EPS);
#pragma unroll
    for (int j = 0; j < 4; ++j) { const f32x4 gg = *((const f32x4*)g + lane + 64 * j), bb = *((const f32x4*)b + lane + 64 * j); v[j] = v[j] * rstd * gg + bb; }
}
DI void store_row_f32(float* p, const f32x4 (&v)[4], int lane) {
#pragma unroll
    for (int j = 0; j < 4; ++j) *((f32x4*)p + lane + 64 * j) = v[j];
}
DI void store_row_bf16(bf16* p, const f32x4 (&v)[4], int lane) {
#pragma unroll
    for (int j = 0; j < 4; ++j) { v2u w; w.x = cvtpk(v[j][0], v[j][1]); w.y = cvtpk(v[j][2], v[j][3]); *((v2u*)p + lane + 64 * j) = w; }
}
template <int NL> DI void small_proj(LAS const float* xs, const float* W, int ldw, int lane, float (&acc)[4]) {
    constexpr int PARTS = 64 / NL, DPER = 1024 / PARTS;
    const int n = lane & (NL - 1), part = lane / NL;
    acc[0] = acc[1] = acc[2] = acc[3] = 0.f;
    const float* wp = W + (size_t)(part * DPER) * ldw + n;
    LAS const float* xp = xs + part * DPER;
#pragma unroll 8
    for (int d = 0; d < DPER; ++d) { const float w = wp[(size_t)d * ldw];
        acc[0] += w * xp[d]; acc[1] += w * xp[1024 + d]; acc[2] += w * xp[2048 + d]; acc[3] += w * xp[3072 + d]; }
#pragma unroll
    for (int o = NL; o < 64; o <<= 1) {
#pragma unroll
        for (int k = 0; k < 4; ++k) acc[k] += __shfl_xor(acc[k], o); }
}

DI void ph_even_prep(const Args& a, const Fr& F, int j) {
    const bf16* proj = (const bf16*)(F.ws + WS_PROJ);
    bf16* ckvn = (bf16*)(F.ws + WS_CKVN); bf16* ql = (bf16*)(F.ws + WS_QL); float* kbar = (float*)(F.ws + WS_KBAR);
    const float* kvg = a.in[4] + j * 128;
    const bf16* wukt = (const bf16*)(F.ws + WS_WUKT) + (size_t)j * 8 * 128 * 64;
    const int lane = F.lane, wave = F.wave;
    for (int chunk = F.blk; chunk < 256; chunk += F.G) {
        const int tok0 = chunk * 128;
#pragma unroll 1
        for (int i0 = 0; i0 < 16; i0 += 8) { unsigned wv[8];
#pragma unroll
            for (int i = 0; i < 8; ++i) wv[i] = *((const unsigned*)(proj + (size_t)(tok0 + wave * 16 + i0 + i) * EV_N + EC_CKV) + lane);
#pragma unroll
            for (int i = 0; i < 8; ++i) { const int tok = tok0 + wave * 16 + i0 + i; const float v0 = bf2f(wv[i] & 0xffffu), v1 = bf2f(wv[i] >> 16);
                const float ss = wave_sum(v0 * v0 + v1 * v1);
                const float r = 1.f / sqrtf(ss * (1.f / 128.f) + LN_EPS);
                *((unsigned*)(ckvn + (size_t)tok * 128) + lane) = cvtpk(v0 * r * kvg[2 * lane], v1 * r * kvg[2 * lane + 1]); } }
        { bf16* kic = (bf16*)(F.ws + WS_KIC); const int tok = tok0 + wave * 16 + (lane >> 2), c = (lane & 3) * 16;
            const v4u* src = (const v4u*)(proj + (size_t)tok * EV_N + EC_KI + c); v4u* dst = (v4u*)(kic + (size_t)tok * 64 + c); dst[0] = src[0]; dst[1] = src[1]; }
        { const int h = wave, l15 = lane & 15, kg = lane >> 4;
            bf16x8 af[8][2];
#pragma unroll
            for (int ct = 0; ct < 8; ++ct)
#pragma unroll
                for (int ks = 0; ks < 2; ++ks) af[ct][ks] = *(const bf16x8*)(wukt + ((size_t)h * 128 + ct * 16 + l15) * 64 + ks * 32 + kg * 8);
#pragma unroll 1
            for (int tg = 0; tg < 8; tg += 4) { bf16x8 qf[4][2];
#pragma unroll
                for (int u = 0; u < 4; ++u)
#pragma unroll
                    for (int ks = 0; ks < 2; ++ks) qf[u][ks] = *(const bf16x8*)(proj + (size_t)(tok0 + (tg + u) * 16 + l15) * EV_N + EC_QA + h * 64 + ks * 32 + kg * 8);
#pragma unroll
                for (int u = 0; u < 4; ++u) { const int tok = tok0 + (tg + u) * 16 + l15;
#pragma unroll
                    for (int ct = 0; ct < 8; ++ct) { f32x4 d = {0.f, 0.f, 0.f, 0.f};
                        d = mfma16(af[ct][0], qf[u][0], d); d = mfma16(af[ct][1], qf[u][1], d);
                        v2u w; w.x = cvtpk(d[0], d[1]); w.y = cvtpk(d[2], d[3]);
                        *(v2u*)(ql + (size_t)tok * 1024 + h * 128 + ct * 16 + 4 * kg) = w; } } } }
        if (chunk < 128) { const int b = chunk >> 5, n = chunk & 31; float s8[8];
#pragma unroll
            for (int k = 0; k < 8; ++k) s8[k] = 0.f;
            const bf16* kp = proj + ((size_t)b * SEQ + n * 256 + wave * 32) * EV_N + EC_KB + lane * 8;
#pragma unroll 8
            for (int r = 0; r < 32; ++r) { const v4u w = *(const v4u*)(kp + (size_t)r * EV_N);
#pragma unroll
                for (int k = 0; k < 4; ++k) { s8[2 * k] += bf2f(w[k] & 0xffffu); s8[2 * k + 1] += bf2f(w[k] >> 16); } }
            LAS float* red = (LAS float*)F.lds;
            __syncthreads();
#pragma unroll
            for (int k = 0; k < 8; ++k) red[wave * 512 + lane * 8 + k] = s8[k];
            __syncthreads();
            float s = 0.f;
#pragma unroll
            for (int w = 0; w < 8; ++w) s += red[w * 512 + F.tid];
            const int h = F.tid >> 6, d = F.tid & 63;
            kbar[(((size_t)b * 8 + h) * 32 + n) * 64 + d] = s * (1.f / 256.f); }
    }
}

DI void moba_gate_chunk(const Fr& F, int chunk) {
    const bf16* proj = (const bf16*)(F.ws + WS_PROJ); const float* kbar = (const float*)(F.ws + WS_KBAR); unsigned* sel3 = (unsigned*)(F.ws + WS_SEL3);
    const int tok0 = chunk * 128, b = tok0 / SEQ, own = (tok0 % SEQ) >> 8, h = F.wave, lane = F.lane;
    float q0[64], q1[64];
    { const v4u* p0 = (const v4u*)(proj + (size_t)(tok0 + lane) * EV_N + EC_QB + h * 64); const v4u* p1 = (const v4u*)(proj + (size_t)(tok0 + 64 + lane) * EV_N + EC_QB + h * 64);
#pragma unroll
        for (int i = 0; i < 8; ++i) { const v4u w0 = p0[i], w1 = p1[i];
#pragma unroll
            for (int k = 0; k < 4; ++k) { q0[8 * i + 2 * k] = bf2f(w0[k] & 0xffffu); q0[8 * i + 2 * k + 1] = bf2f(w0[k] >> 16); q1[8 * i + 2 * k] = bf2f(w1[k] & 0xffffu); q1[8 * i + 2 * k + 1] = bf2f(w1[k] >> 16); } } }
    float a0 = -INFINITY, a1 = -INFINITY, a2 = -INFINITY, c0 = -INFINITY, c1 = -INFINITY, c2 = -INFINITY; int ai0 = 0, ai1 = 0, ai2 = 0, ci0 = 0, ci1 = 0, ci2 = 0;
    const float* kb = kbar + (((size_t)b * 8 + h) * 32) * 64;
    for (int n = 0; n < own; ++n) { float g0 = 0.f, g1 = 0.f;
#pragma unroll
        for (int d = 0; d < 64; d += 4) { const f32x4 kv = *(const f32x4*)(kb + n * 64 + d);
#pragma unroll
            for (int k = 0; k < 4; ++k) { g0 += q0[d + k] * kv[k]; g1 += q1[d + k] * kv[k]; } }
        if (g0 > a2) { if (g0 > a1) { a2 = a1; ai2 = ai1; if (g0 > a0) { a1 = a0; ai1 = ai0; a0 = g0; ai0 = n; } else { a1 = g0; ai1 = n; } } else { a2 = g0; ai2 = n; } }
        if (g1 > c2) { if (g1 > c1) { c2 = c1; ci2 = ci1; if (g1 > c0) { c1 = c0; ci1 = ci0; c0 = g1; ci0 = n; } else { c1 = g1; ci1 = n; } } else { c2 = g1; ci2 = n; } }
    }
    const unsigned nv = own < 3 ? own : 3;
    sel3[(size_t)(tok0 + lane) * 8 + h] = (unsigned)ai0 | ((unsigned)ai1 << 8) | ((unsigned)ai2 << 16) | (nv << 24);
    sel3[(size_t)(tok0 + 64 + lane) * 8 + h] = (unsigned)ci0 | ((unsigned)ci1 << 8) | ((unsigned)ci2 << 16) | (nv << 24);
}

constexpr int HS = 257;
DI float relu1(float x) { const unsigned u = __float_as_uint(x); return __uint_as_float(u & ~(unsigned)((int)u >> 31)); }
template <int MODE, bool DIAG> DI void idx_tile(const bf16x8 (&kf)[4], LAS const char* qb  , const float (&wj)[4], int kt, int q, int hi, unsigned c0, unsigned c1,
                                     LAS unsigned* hist, LAS unsigned* mask, LAS unsigned* cmask, LAS unsigned long long* cand, LAS unsigned* rinfo) {
    f32x2 scp[8];
#pragma unroll
    for (int p = 0; p < 8; ++p) scp[p] = (f32x2){0.f, 0.f};
#pragma unroll
    for (int g = 0; g < 2; ++g) { f32x16 acc[2];
#pragma unroll
        for (int j = 0; j < 2; ++j)
#pragma unroll
            for (int r = 0; r < 16; ++r) acc[j][r] = 0.f;
#pragma unroll
        for (int s = 0; s < 4; ++s)
#pragma unroll
            for (int j = 0; j < 2; ++j) acc[j] = mfma32(kf[s], *(LAS const bf16x8*)(qb + ((2 * g + j) * 8 + s * 2) * 512), acc[j]);
#pragma unroll
        for (int p = 0; p < 8; ++p)
#pragma unroll
            for (int j = 0; j < 2; ++j) { const f32x2 a = {relu1(acc[j][2 * p]), relu1(acc[j][2 * p + 1])}; const f32x2 w2 = {wj[2 * g + j], wj[2 * g + j]}; scp[p] = a * w2 + scp[p]; } }
    unsigned sel = 0u, cnd = 0u;
    const float F0 = __uint_as_float(c0), F1 = __uint_as_float(c1);
#pragma unroll
    for (int r = 0; r < 16; ++r) { const int kr = crow(r, hi);
        const bool ok = !DIAG || kr <= q;
        const float scv = scp[r >> 1][r & 1]; const unsigned u = __float_as_uint(scv);
        if (MODE == 1) { const unsigned key = u ^ ((unsigned)((int)u >> 31) | 0x80000000u);
            if (ok && (key >> 24) >= c0) __hip_atomic_fetch_add(hist + q * HS + (key >> 24), 1u, __ATOMIC_RELAXED, __HIP_MEMORY_SCOPE_WORKGROUP); }
        else if (MODE == 2) { if (ok && (u >> 24) == c0) __hip_atomic_fetch_add(hist + q * HS + (((u >> 16) & 255u) ^ c1), 1u, __ATOMIC_RELAXED, __HIP_MEMORY_SCOPE_WORKGROUP); }
        else { const bool ge1 = scv >= F1, ge0 = scv >= F0;
            if (ok && ge1) sel |= 1u << kr;
            if (ok && ge0 && !ge1) { cnd |= 1u << kr; const unsigned key = u ^ ((unsigned)((int)u >> 31) | 0x80000000u);
                const unsigned pos = __hip_atomic_fetch_add(rinfo + 128 + q, 1u, __ATOMIC_RELAXED, __HIP_MEMORY_SCOPE_WORKGROUP);
                if (pos < 64u) cand[q * 64 + pos] = ((unsigned long long)key << 32) | (unsigned)(~(unsigned)(kt * 32 + kr)); } } }
    if (MODE == 3) { if (sel) __hip_atomic_fetch_or(mask + q * HS + kt, sel, __ATOMIC_RELAXED, __HIP_MEMORY_SCOPE_WORKGROUP);
        if (cnd) __hip_atomic_fetch_or(cmask + q * HS + kt, cnd, __ATOMIC_RELAXED, __HIP_MEMORY_SCOPE_WORKGROUP); }
}
template <int MODE> DI void idx_pass(const bf16* proj, int rowbase, int qt, LAS const char* qimg, const float (&wj)[4], LAS unsigned* hist, LAS unsigned* mask, LAS unsigned* cmask, LAS unsigned long long* cand, LAS unsigned* rinfo, int wave, int lane) {
    const int q = lane & 31, hi = lane >> 5, nkt = qt + 1;
    const unsigned b1 = MODE == 2 ? rinfo[160 + q] : rinfo[224 + q], thr16 = MODE == 2 ? rinfo[192 + q] : rinfo[256 + q];
    const bf16* kp0 = proj + (size_t)(rowbase + q) * 64 + hi * 8;
    LAS const char* qb = qimg + hi * 512 + q * 16;
    const int n = nkt > wave ? (nkt - wave + 7) >> 3 : 0;
    bf16x8 kfa[4], kfb[4], kfc[4];
#define IDX_LOAD(KF, I) do { const bf16* kp_ = kp0 + (size_t)((wave + 8 * (I)) * 32) * 64; _Pragma("unroll") for (int s_ = 0; s_ < 4; ++s_) KF[s_] = *(const bf16x8*)(kp_ + s_ * 16); } while (0)
#define IDX_TILE(KF, I) do { const int kt_ = wave + 8 * (I); if (kt_ == qt) idx_tile<MODE, true>(KF, qb, wj, kt_, q, hi, b1, thr16, hist, mask, cmask, cand, rinfo); \
        else idx_tile<MODE, false>(KF, qb, wj, kt_, q, hi, b1, thr16, hist, mask, cmask, cand, rinfo); } while (0)
    if (n > 0) IDX_LOAD(kfa, 0);
    if (n > 1) IDX_LOAD(kfb, 1);
    for (int i = 0; i < n; i += 3) {
        if (i + 2 < n) IDX_LOAD(kfc, i + 2);
        IDX_TILE(kfa, i);
        if (i + 1 < n) { if (i + 3 < n) IDX_LOAD(kfa, i + 3); IDX_TILE(kfb, i + 1); }
        if (i + 2 < n) { if (i + 4 < n) IDX_LOAD(kfb, i + 4); IDX_TILE(kfc, i + 2); }
    }
#undef IDX_LOAD
#undef IDX_TILE
}
DI void hist_pick(LAS const unsigned* hrow, unsigned need, int lane, unsigned& bin, unsigned& above) {
    unsigned h4[4];
#pragma unroll
    for (int k = 0; k < 4; ++k) h4[k] = hrow[4 * lane + k];
    const unsigned ssum = h4[0] + h4[1] + h4[2] + h4[3];
    unsigned x = ssum;
#pragma unroll
    for (int o = 1; o < 64; o <<= 1) { const unsigned y = __shfl_down(x, o); if (lane + o < 64) x += y; }
    const unsigned long long m = __ballot(x >= need);
    const int Ls = m ? 63 - __builtin_clzll(m) : 0;
    const unsigned xs = __shfl(x, Ls), ss = __shfl(ssum, Ls);
    const unsigned h0 = __shfl(h4[0], Ls), h1 = __shfl(h4[1], Ls), h2 = __shfl(h4[2], Ls), h3 = __shfl(h4[3], Ls);
    unsigned cum = xs - ss;
    if (cum + h3 >= need) { bin = 4 * Ls + 3; above = cum; return; } cum += h3;
    if (cum + h2 >= need) { bin = 4 * Ls + 2; above = cum; return; } cum += h2;
    if (cum + h1 >= need) { bin = 4 * Ls + 1; above = cum; return; } cum += h1;
    bin = 4 * Ls; above = cum; (void)h0;
}
DI void idx_pass1(const bf16* proj, int rowbase, int qt, LAS const char* qimg, const float (&wj)[4], LAS unsigned* hist, LAS unsigned* mask, LAS unsigned* cmask, LAS unsigned long long* cand, LAS unsigned* rinfo, int wave, int lane) {
    const int q = lane & 31, hi = lane >> 5, nkt = qt + 1, nmax = (nkt + 7) >> 3;
    const bf16* kp0 = proj + (size_t)(rowbase + q) * 64 + hi * 8;
    LAS const char* qb = qimg + hi * 512 + q * 16;
    unsigned lb = 0u;
    bf16x8 kfc[4], kfn[4];
    if (wave < nkt) {
#pragma unroll
        for (int s = 0; s < 4; ++s) kfc[s] = *(const bf16x8*)(kp0 + (size_t)(wave * 32) * 64 + s * 16); }
    for (int i = 0; i < nmax; ++i) { const int kt = wave + 8 * i;
        if (kt + 8 < nkt) {
#pragma unroll
            for (int s = 0; s < 4; ++s) kfn[s] = *(const bf16x8*)(kp0 + (size_t)((kt + 8) * 32) * 64 + s * 16); }
        if (kt < nkt) { if (kt == qt) idx_tile<1, true>(kfc, qb, wj, kt, q, hi, lb, 0u, hist, mask, cmask, cand, rinfo); else idx_tile<1, false>(kfc, qb, wj, kt, q, hi, lb, 0u, hist, mask, cmask, cand, rinfo); }
#pragma unroll
        for (int s = 0; s < 4; ++s) kfc[s] = kfn[s];
        if (((i + 1) & i) == 0 && i + 1 < nmax && i < 16) {
            __syncthreads();
#pragma unroll 1
            for (int rr = 0; rr < 4; ++rr) { const int row = wave * 4 + rr; unsigned bin, above; hist_pick(hist + row * HS, 256u, lane, bin, above);
                if (lane == 0) rinfo[288 + row] = bin; }
            __syncthreads();
            { const unsigned nb = rinfo[288 + q]; lb = nb > lb ? nb : lb; } }
    }
}
DI void idx_unit(const Fr& F, int b, int qt, int stop = 0  ) {
    const bf16* proj = (const bf16*)(F.ws + WS_PROJ); const bf16* kic = (const bf16*)(F.ws + WS_KIC); unsigned short* sel = (unsigned short*)(F.ws + WS_SEL);
    LAS unsigned* hist = (LAS unsigned*)(F.lds); LAS unsigned* mask = hist + 32 * HS; LAS unsigned* cmask = mask + 32 * HS;
    LAS unsigned long long* cand = (LAS unsigned long long*)(F.lds + 99328); LAS unsigned* rinfo = (LAS unsigned*)(F.lds + 115712);
    const int lane = F.lane, wave = F.wave, tid = F.tid, t0 = qt * 32, rowbase = b * SEQ;
    __syncthreads();
    for (int i = tid; i < 3 * 32 * HS; i += NTHR) hist[i] = 0u;
    if (tid < 320) rinfo[tid] = 0u;
    __syncthreads();
    if (t0 + 31 <= 255 || (EXPF & 64)) {
        if (lane < 8) {
#pragma unroll
            for (int rr = 0; rr < 4; ++rr) { const int row = wave * 4 + rr, nv = t0 + row + 1;
                const int nv0 = t0 + row + 1; const int nvc = nv0 < 256 ? nv0 : 256; (void)nv; mask[row * HS + lane] = nvc >= 32 * (lane + 1) ? 0xffffffffu : (nvc > 32 * lane ? ((1u << (nvc - 32 * lane)) - 1u) : 0u); } }
    } else {
        const int q = lane & 31;
        float wj[4];
        { const bf16* qp = proj + (size_t)(rowbase + t0 + q) * EV_N;
#pragma unroll
            for (int j = 0; j < 4; ++j) wj[j] = bf2f(qp[EC_WI + j]); }
        LAS char* qimg = (LAS char*)(F.lds + 117248);
#pragma unroll
        for (int i = 0; i < 2; ++i) { const int p = tid + i * NTHR, row = p & 31, c = p >> 5;
            *(LAS v4u*)(qimg + c * 512 + row * 16) = *(const v4u*)(proj + (size_t)(rowbase + t0 + row) * EV_N + EC_QI + c * 8); }
        __syncthreads();
        idx_pass1(kic, rowbase, qt, qimg, wj, hist, mask, cmask, cand, rinfo, wave, lane);
        __syncthreads();
#pragma unroll 1
        for (int rr = 0; rr < 4; ++rr) { const int row = wave * 4 + rr; unsigned bin, above; hist_pick(hist + row * HS, 256u, lane, bin, above);
            if (lane == 0) { rinfo[row] = bin; rinfo[32 + row] = 256u - above; rinfo[160 + row] = bin >= 128u ? bin - 128u : 255u - bin; rinfo[192 + row] = bin >= 128u ? 0u : 255u; } }
        __syncthreads();
        if (stop == 1) return;
        for (int i = tid; i < 32 * HS; i += NTHR) hist[i] = 0u;
        __syncthreads();
        idx_pass<2>(kic, rowbase, qt, qimg, wj, hist, mask, cmask, cand, rinfo, wave, lane);
        __syncthreads();
#pragma unroll 1
        for (int rr = 0; rr < 4; ++rr) { const int row = wave * 4 + rr; const unsigned need1 = rinfo[32 + row]; unsigned bin, above; hist_pick(hist + row * HS, need1, lane, bin, above);
            if (lane == 0) { const unsigned t16 = (rinfo[row] << 8) | bin, k0 = t16 << 16, k1 = (t16 + 1u) << 16;
                rinfo[64 + row] = t16; rinfo[96 + row] = need1 - above;
                rinfo[224 + row] = (k0 & 0x80000000u) ? (k0 ^ 0x80000000u) : ~k0; rinfo[256 + row] = (t16 == 0xffffu) ? 0x7fc00000u : ((k1 & 0x80000000u) ? (k1 ^ 0x80000000u) : ~k1); } }
        __syncthreads();
        if (stop == 2) return;
        idx_pass<3>(kic, rowbase, qt, qimg, wj, hist, mask, cmask, cand, rinfo, wave, lane);
        __syncthreads();
        if (stop == 3) return;
#pragma unroll 1
        for (int rr = 0; rr < 4; ++rr) { const int row = wave * 4 + rr; const unsigned call = rinfo[128 + row], need2 = rinfo[96 + row];
            if (call <= 64u) { const unsigned c = call;
                const unsigned long long mine = cand[row * 64 + lane]; unsigned rank = 0u;
                for (unsigned k = 0; k < c; ++k) rank += (cand[row * 64 + k] > mine) ? 1u : 0u;
                if ((unsigned)lane < c && rank < need2) { const unsigned s = ~(unsigned)mine;
                    __hip_atomic_fetch_or(mask + row * HS + (s >> 5), 1u << (s & 31), __ATOMIC_RELAXED, __HIP_MEMORY_SCOPE_WORKGROUP); } }
            else { unsigned w4[4];
#pragma unroll
                for (int k = 0; k < 4; ++k) w4[k] = cmask[row * HS + 4 * lane + k];
                const unsigned cnt = __popc(w4[0]) + __popc(w4[1]) + __popc(w4[2]) + __popc(w4[3]);
                unsigned x = cnt;
#pragma unroll
                for (int o = 1; o < 64; o <<= 1) { const unsigned y = __shfl_up(x, o); if (lane >= o) x += y; }
                unsigned before = x - cnt;
#pragma unroll
                for (int k = 0; k < 4; ++k) { unsigned w = w4[k]; const unsigned pc = __popc(w); unsigned take = 0u;
                    if (before < need2) { if (before + pc <= need2) take = w; else { unsigned left = need2 - before; while (left) { const unsigned b = w & (0u - w); take |= b; w ^= b; --left; } } }
                    before += pc;
                    if (take) mask[row * HS + 4 * lane + k] |= take; } }
        }
    }
    __syncthreads();
#pragma unroll 1
    for (int rr = 0; rr < 4; ++rr) { const int row = wave * 4 + rr; unsigned short* out = sel + (size_t)(rowbase + t0 + row) * 256;
        unsigned w4[4];
#pragma unroll
        for (int k = 0; k < 4; ++k) w4[k] = mask[row * HS + 4 * lane + k];
        const unsigned cnt = __popc(w4[0]) + __popc(w4[1]) + __popc(w4[2]) + __popc(w4[3]);
        unsigned x = cnt;
#pragma unroll
        for (int o = 1; o < 64; o <<= 1) { const unsigned y = __shfl_up(x, o); if (lane >= o) x += y; }
        const unsigned total = __shfl(x, 63); unsigned pos = x - cnt;
#pragma unroll
        for (int k = 0; k < 4; ++k) { unsigned w = w4[k]; const unsigned base = (unsigned)(4 * lane + k) * 32u;
            while (w) { const unsigned bit = __builtin_ctz(w); if (pos < 256u) out[pos] = (unsigned short)(base + bit); ++pos; w &= w - 1u; } }
        for (unsigned i = total + lane; i < 256u; i += 64u) out[i] = (unsigned short)0xffffu; }
}

struct AttSt { float m, l; f32x16 o0, o1; };
template <class BF> DI void att_subtile(AttSt& S, const bf16x8 (&qf)[4], LAS const char* Kst, LAS const char* Vb, int vdh, int vrow0, int lane, const BF& bias) {
    const int r32 = lane & 31, hi = lane >> 5;
    f32x16 p;
#pragma unroll
    for (int r = 0; r < 16; ++r) p[r] = bias.b(crow(r, hi)) - S.m;
    LAS const char* kp = Kst + hi * 512 + r32 * 16;
#pragma unroll
    for (int s = 0; s < 4; ++s) { const bf16x8 kf = *(LAS const bf16x8*)(kp + s * 1024); p = mfma32(kf, qf[s], p); }
    if (bias.any) {
#pragma unroll
        for (int r = 0; r < 16; ++r) p[r] = bias.msk(crow(r, hi)) ? -INFINITY : p[r]; }
    float mxa[4] = {-INFINITY, -INFINITY, -INFINITY, -INFINITY};
#pragma unroll
    for (int r = 0; r < 16; ++r) mxa[r & 3] = fmaxf(mxa[r & 3], p[r]);
    float mx = fmaxf(fmaxf(mxa[0], mxa[1]), fmaxf(mxa[2], mxa[3]));
    mx = fmaxf(mx, __shfl_xor(mx, 32));
    if (__any(mx > 16.f)) { const float dl = fmaxf(mx, 0.f), sc = ex2(-dl); S.m += dl; S.l *= sc;
#pragma unroll
        for (int r = 0; r < 16; ++r) { p[r] -= dl; S.o0[r] *= sc; S.o1[r] *= sc; } }
    float psa[4] = {0.f, 0.f, 0.f, 0.f};
#pragma unroll
    for (int r = 0; r < 16; ++r) { p[r] = ex2(p[r]); psa[r & 3] += p[r]; }
    S.l += (psa[0] + psa[1]) + (psa[2] + psa[3]);
    v4u pw0, pw1;
    pw0.x = cvtpk(p[0], p[1]); pw0.y = cvtpk(p[2], p[3]); pw0.z = cvtpk(p[4], p[5]); pw0.w = cvtpk(p[6], p[7]);
    pw1.x = cvtpk(p[8], p[9]); pw1.y = cvtpk(p[10], p[11]); pw1.z = cvtpk(p[12], p[13]); pw1.w = cvtpk(p[14], p[15]);
    const bf16x8 pf0 = __builtin_bit_cast(bf16x8, pw0), pf1 = __builtin_bit_cast(bf16x8, pw1);
    LAS const char* vp = Vb + (vrow0 + 4 * hi + ((lane & 15) >> 2)) * 64 + ((lane >> 4) & 1) * 32 + (lane & 3) * 8;
    { const bf16x8 v00 = cat8(vtr(vp), vtr(vp + 512)), v10 = cat8(vtr(vp + vdh), vtr(vp + vdh + 512));
      const bf16x8 v01 = cat8(vtr(vp + 1024), vtr(vp + 1536)), v11 = cat8(vtr(vp + vdh + 1024), vtr(vp + vdh + 1536));
      S.o0 = mfma32(v00, pf0, S.o0); S.o1 = mfma32(v10, pf0, S.o1);
      S.o0 = mfma32(v01, pf1, S.o0); S.o1 = mfma32(v11, pf1, S.o1); }
}
template <class BF0, class BF1> DI void att_tile64(AttSt& S, const bf16x8 (&qf)[4], LAS const char* Kst, LAS const char* Vb, int vdh, int vrow0, int lane, const BF0& bias0, const BF1& bias1) {
    const int r32 = lane & 31, hi = lane >> 5;
    f32x16 p0, p1;
#pragma unroll
    for (int r = 0; r < 16; ++r) { p0[r] = bias0.b(crow(r, hi)) - S.m; p1[r] = bias1.b(crow(r, hi)) - S.m; }
    LAS const char* kp = Kst + hi * 512 + r32 * 16;
#pragma unroll
    for (int s = 0; s < 4; ++s) { const bf16x8 k0 = *(LAS const bf16x8*)(kp + s * 1024), k1 = *(LAS const bf16x8*)(kp + 4096 + s * 1024); p0 = mfma32(k0, qf[s], p0); p1 = mfma32(k1, qf[s], p1); }
    if (bias0.any) {
#pragma unroll
        for (int r = 0; r < 16; ++r) p0[r] = bias0.msk(crow(r, hi)) ? -INFINITY : p0[r]; }
    if (bias1.any) {
#pragma unroll
        for (int r = 0; r < 16; ++r) p1[r] = bias1.msk(crow(r, hi)) ? -INFINITY : p1[r]; }
    float mxa[4] = {-INFINITY, -INFINITY, -INFINITY, -INFINITY};
#pragma unroll
    for (int r = 0; r < 16; ++r) mxa[r & 3] = fmaxf(mxa[r & 3], fmaxf(p0[r], p1[r]));
    float mx = fmaxf(fmaxf(mxa[0], mxa[1]), fmaxf(mxa[2], mxa[3]));
    mx = fmaxf(mx, __shfl_xor(mx, 32));
    if (__any(mx > 16.f)) { const float dl = fmaxf(mx, 0.f), sc = ex2(-dl); S.m += dl; S.l *= sc;
#pragma unroll
        for (int r = 0; r < 16; ++r) { p0[r] -= dl; p1[r] -= dl; S.o0[r] *= sc; S.o1[r] *= sc; } }
    float psa[4] = {0.f, 0.f, 0.f, 0.f};
#pragma unroll
    for (int r = 0; r < 16; ++r) { p0[r] = ex2(p0[r]); p1[r] = ex2(p1[r]); psa[r & 3] += p0[r] + p1[r]; }
    S.l += (psa[0] + psa[1]) + (psa[2] + psa[3]);
    v4u a0, a1, b0, b1;
    a0.x = cvtpk(p0[0], p0[1]); a0.y = cvtpk(p0[2], p0[3]); a0.z = cvtpk(p0[4], p0[5]); a0.w = cvtpk(p0[6], p0[7]);
    a1.x = cvtpk(p0[8], p0[9]); a1.y = cvtpk(p0[10], p0[11]); a1.z = cvtpk(p0[12], p0[13]); a1.w = cvtpk(p0[14], p0[15]);
    b0.x = cvtpk(p1[0], p1[1]); b0.y = cvtpk(p1[2], p1[3]); b0.z = cvtpk(p1[4], p1[5]); b0.w = cvtpk(p1[6], p1[7]);
    b1.x = cvtpk(p1[8], p1[9]); b1.y = cvtpk(p1[10], p1[11]); b1.z = cvtpk(p1[12], p1[13]); b1.w = cvtpk(p1[14], p1[15]);
    LAS const char* vp = Vb + (vrow0 + 4 * hi + ((lane & 15) >> 2)) * 64 + ((lane >> 4) & 1) * 32 + (lane & 3) * 8;
#pragma unroll
    for (int k16 = 0; k16 < 4; ++k16) { const bf16x8 pf = __builtin_bit_cast(bf16x8, k16 == 0 ? a0 : k16 == 1 ? a1 : k16 == 2 ? b0 : b1);
        const bf16x8 v0 = cat8(vtr(vp + k16 * 1024), vtr(vp + k16 * 1024 + 512)), v1 = cat8(vtr(vp + vdh + k16 * 1024), vtr(vp + vdh + k16 * 1024 + 512));
        S.o0 = mfma32(v0, pf, S.o0); S.o1 = mfma32(v1, pf, S.o1); }
}

struct MobaFar { float c; bool any; DI float b(int) const { return c; } DI bool msk(int) const { return false; } };
struct MobaBias { LAS const float* lut; int tq, s0; bool any;
    DI float b(int kvrel) const { const int dist = tq - (s0 + kvrel); return lut[dist < 0 ? 0 : (dist > 1023 ? 1023 : dist)]; }
    DI bool msk(int kvrel) const { return tq - (s0 + kvrel) < 0; } };
DI void moba_qload(bf16x8 (&qf)[4], const bf16* proj, int rowbase, int h, int tq, int hi) {
    const bf16* qp = proj + (size_t)(rowbase + tq) * EV_N + EC_QB + h * 64 + hi * 8;
#pragma unroll
    for (int s = 0; s < 4; ++s) qf[s] = *(const bf16x8*)(qp + s * 16);
}
DI void moba_tile(const Fr& F, const bf16x8 (&qf)[4], int rowbase, int h, int n, int tq, bool valid, int slot, bool own, int wave_tile) {
    LAS const char* Kb = (LAS const char*)F.lds; LAS const char* Vb = (LAS const char*)(F.lds + 32768); LAS const float* lut = (LAS const float*)(F.lds + 98304);
    bf16* po = (bf16*)(F.ws + WS_ACT); float* pml = (float*)(F.ws + WS_PML);
    const int lane = F.lane, hi = lane >> 5;
    AttSt S; S.m = 0.f; S.l = 0.f;
#pragma unroll
    for (int r = 0; r < 16; ++r) { S.o0[r] = 0.f; S.o1[r] = 0.f; }
    const int nst = own ? wave_tile + 1 : 8;
    int tmin = tq;
#pragma unroll
    for (int o = 1; o < 64; o <<= 1) { const int y = __shfl_xor(tmin, o); tmin = y < tmin ? y : tmin; }
    const float cfar = lut[1023];
    int st = 0;
    for (; st + 1 < nst; st += 2) {
        if (!own && tmin - (n * 256 + st * 32 + 63) >= 790) { MobaFar bf{cfar, false}; att_tile64(S, qf, Kb + st * 4096, Vb, 16384, st * 32, lane, bf, bf); }
        else { MobaBias bf0{lut, tq, n * 256 + st * 32, false}, bf1{lut, tq, n * 256 + st * 32 + 32, own && st + 1 == wave_tile}; att_tile64(S, qf, Kb + st * 4096, Vb, 16384, st * 32, lane, bf0, bf1); } }
    if (st < nst) { MobaBias bf{lut, tq, n * 256 + st * 32, own && st == wave_tile}; att_subtile(S, qf, Kb + st * 4096, Vb, 16384, st * 32, lane, bf); }
    const float lt = S.l + __shfl_xor(S.l, 32), inv = 1.f / lt;
    if (valid) { const size_t pi = ((size_t)(rowbase + tq) * 8 + h) * 4 + slot; bf16* o = po + pi * 64;
#pragma unroll
        for (int a4 = 0; a4 < 4; ++a4) { v2u w0, w1;
            w0.x = cvtpk(S.o0[4 * a4] * inv, S.o0[4 * a4 + 1] * inv); w0.y = cvtpk(S.o0[4 * a4 + 2] * inv, S.o0[4 * a4 + 3] * inv);
            w1.x = cvtpk(S.o1[4 * a4] * inv, S.o1[4 * a4 + 1] * inv); w1.y = cvtpk(S.o1[4 * a4 + 2] * inv, S.o1[4 * a4 + 3] * inv);
            *(v2u*)(o + 8 * a4 + 4 * hi) = w0; *(v2u*)(o + 32 + 8 * a4 + 4 * hi) = w1; }
        if (hi == 0) { f32x2 ml = {S.m, lt}; *(f32x2*)(pml + pi * 2) = ml; } }
}
DI void moba_unit(const Args& a, const Fr& F, int b, int h, int n) {
    const bf16* proj = (const bf16*)(F.ws + WS_PROJ); const unsigned* sel3 = (const unsigned*)(F.ws + WS_SEL3);
    LAS unsigned char* lds = F.lds; LAS unsigned* list = (LAS unsigned*)(lds + 65536); LAS float* lut = (LAS float*)(lds + 98304); LAS unsigned* misc = (LAS unsigned*)(lds + 102400);
    const int tid = F.tid, lane = F.lane, wave = F.wave, rowbase = b * SEQ;
    __syncthreads();
    { const bf16* kg = proj + (size_t)(rowbase + n * 256) * EV_N + EC_KB + h * 64; const bf16* vg = proj + (size_t)(rowbase + n * 256) * EV_N + EC_VB + h * 64;
#pragma unroll
        for (int i = 0; i < 4; ++i) { const int p = tid + i * NTHR;
            { const int r = p & 31, c = (p >> 5) & 7, st = p >> 8; const v4u v = *(const v4u*)(kg + (size_t)(st * 32 + r) * EV_N + c * 8); *(LAS v4u*)(lds + st * 4096 + c * 512 + r * 16) = v; }
            { const int cc = p & 3, row = (p >> 2) & 255, dh = p >> 10; const v4u v = *(const v4u*)(vg + (size_t)row * EV_N + dh * 32 + cc * 8); *(LAS v4u*)(lds + 32768 + dh * 16384 + row * 64 + cc * 16) = v; } }
        for (int d = tid; d < 1024; d += NTHR) lut[d] = a.in[9][t5_bucket(d) * 16 + 8 + h] * LOG2E; }
    if (tid == 0) misc[16] = 0u;
    __syncthreads();
    unsigned sv[16];
#pragma unroll
    for (int k = 0; k < 16; ++k) { const int t = (n + 1) * 256 + k * NTHR + tid; sv[k] = t < SEQ ? sel3[(size_t)(rowbase + t) * 8 + h] : 0u; }
#pragma unroll
    for (int k = 0; k < 16; ++k) { const int tb = (n + 1) * 256 + k * NTHR; if (tb < SEQ) { const int t = tb + tid;
        const unsigned s = sv[k]; const unsigned nv = s >> 24; int slot = -1;
        if (nv > 0u && (s & 255u) == (unsigned)n) slot = 0; else if (nv > 1u && ((s >> 8) & 255u) == (unsigned)n) slot = 1; else if (nv > 2u && ((s >> 16) & 255u) == (unsigned)n) slot = 2;
        const unsigned long long bal = __ballot(slot >= 0); const unsigned wcnt = __popcll(bal);
        if (lane == 0) misc[wave] = wcnt;
        __syncthreads();
        unsigned off = misc[16], tot = 0u;
#pragma unroll
        for (int w = 0; w < 8; ++w) { const unsigned c = misc[w]; if (w < wave) off += c; tot += c; }
        if (slot >= 0) list[off + __popcll(bal & ((1ull << lane) - 1ull))] = ((unsigned)t << 2) | (unsigned)slot;
        __syncthreads();
        if (tid == 0) misc[16] += tot; } }
    __syncthreads();
    const int nlist = (int)misc[16];
    const int ntl = (nlist + 31) >> 5, hi = lane >> 5;
    bf16x8 qa[4], qb2[4];
    moba_qload(qa, proj, rowbase, h, n * 256 + wave * 32 + (lane & 31), hi);
    unsigned ea = 0u, eb = 0u; bool va = false, vb = false;
    int tl = wave;
    if (tl < ntl) { const int li = tl * 32 + (lane & 31); vb = li < nlist; eb = list[vb ? li : nlist - 1]; moba_qload(qb2, proj, rowbase, h, (int)(eb >> 2), hi); }
    moba_tile(F, qa, rowbase, h, n, n * 256 + wave * 32 + (lane & 31), true, 3, true, wave);
    for (; tl < ntl; tl += 16) {
        const int t2 = tl + 8, t3 = tl + 16;
        if (t2 < ntl) { const int li = t2 * 32 + (lane & 31); va = li < nlist; ea = list[va ? li : nlist - 1]; moba_qload(qa, proj, rowbase, h, (int)(ea >> 2), hi); }
        moba_tile(F, qb2, rowbase, h, n, (int)(eb >> 2), vb, (int)(eb & 3u), false, 0);
        if (t2 < ntl) {
            if (t3 < ntl) { const int li = t3 * 32 + (lane & 31); vb = li < nlist; eb = list[vb ? li : nlist - 1]; moba_qload(qb2, proj, rowbase, h, (int)(eb >> 2), hi); }
            moba_tile(F, qa, rowbase, h, n, (int)(ea >> 2), va, (int)(ea & 3u), false, 0); }
    }
}

DI void dsa_step(const bf16x8 (&af)[2][4], const bf16x8 (&qlf)[4], int ch, LAS const unsigned char* bsel, LAS unsigned char* cbuf, LAS const float* tab,
                 float& m, float& l, f32x4 (&oT)[8], int l15, int kg, int lane) {
    f32x4 acc[2];
#pragma unroll
    for (int mt = 0; mt < 2; ++mt) { acc[mt] = (f32x4){0.f, 0.f, 0.f, 0.f};
#pragma unroll
        for (int ks = 0; ks < 4; ++ks) { acc[mt] = mfma16(af[mt][ks], qlf[ks], acc[mt]); *(LAS bf16x8*)(cbuf + (mt * 16 + l15) * 288 + (ks * 32 + kg * 8) * 2) = af[mt][ks]; } }
    float mx = -INFINITY;
#pragma unroll
    for (int mt = 0; mt < 2; ++mt) { const unsigned b4 = *(LAS const unsigned*)(bsel + ch * 32 + mt * 16 + 4 * kg);
#pragma unroll
        for (int i = 0; i < 4; ++i) { const unsigned bb = (b4 >> (8 * i)) & 255u;
            const float v = bb != 255u ? acc[mt][i] + tab[bb * 8 + (l15 & 7)] : -INFINITY; acc[mt][i] = v; mx = fmaxf(mx, v); } }
    mx = fmaxf(mx, __shfl_xor(mx, 16)); mx = fmaxf(mx, __shfl_xor(mx, 32));
    const float mn = fmaxf(m, mx), sc = ex2(m - mn); m = mn;
    float ps = 0.f;
#pragma unroll
    for (int mt = 0; mt < 2; ++mt)
#pragma unroll
        for (int i = 0; i < 4; ++i) { acc[mt][i] = ex2(acc[mt][i] - mn); ps += acc[mt][i]; }
    l = l * sc + ps;
#pragma unroll
    for (int ct = 0; ct < 8; ++ct) oT[ct] = oT[ct] * sc;
    v4u pw; pw.x = cvtpk(acc[0][0], acc[0][1]); pw.y = cvtpk(acc[0][2], acc[0][3]); pw.z = cvtpk(acc[1][0], acc[1][1]); pw.w = cvtpk(acc[1][2], acc[1][3]);
    const bf16x8 pf = __builtin_bit_cast(bf16x8, pw);
    LDS_WAIT();
    LAS const char* tp = (LAS const char*)cbuf + (4 * kg + (l15 >> 2)) * 288 + (lane & 3) * 8;
#pragma unroll
    for (int ct = 0; ct < 8; ++ct) { const bf16x8 cf = cat8(vtr(tp + ct * 32), vtr(tp + 16 * 288 + ct * 32)); oT[ct] = mfma16(cf, pf, oT[ct]); }
    LDS_WAIT();
}
DI void dsa_gather(bf16x8 (&af)[2][4], const bf16* ckvn, int rowbase, LAS const unsigned short* selb, int ch, int l15, int kg) {
#pragma unroll
    for (int mt = 0; mt < 2; ++mt) { unsigned idx = selb[ch * 32 + mt * 16 + l15]; if (idx == 0xffffu) idx = 0u;
        const bf16* cp = ckvn + (size_t)(rowbase + (int)idx) * 128 + kg * 8;
#pragma unroll
        for (int ks = 0; ks < 4; ++ks) af[mt][ks] = *(const bf16x8*)(cp + ks * 32); }
}
DI void dsa_query(const Fr& F, int tok, const v2u sv, LAS unsigned char* wl, LAS const unsigned char* bkt, LAS const float* tab) {
    const bf16* ql = (const bf16*)(F.ws + WS_QL); const bf16* ckvn = (const bf16*)(F.ws + WS_CKVN); const unsigned short* sel = (const unsigned short*)(F.ws + WS_SEL); bf16* ol = (bf16*)(F.ws + WS_OL);
    const int lane = F.lane, l15 = lane & 15, kg = lane >> 4, t = tok % SEQ, rowbase = tok - t;
    LAS unsigned short* selb = (LAS unsigned short*)wl; LAS unsigned char* bsel = wl + 512; LAS unsigned char* cbuf = wl + 1024;
    { *((LAS v2u*)selb + lane) = sv; unsigned bw = 0u;
#pragma unroll
        for (int i = 0; i < 4; ++i) { const unsigned s = (i < 2 ? (sv.x >> (16 * i)) : (sv.y >> (16 * (i - 2)))) & 0xffffu; const int dist = t - (int)s;
            const unsigned bb = (s != 0xffffu && dist >= 0) ? (unsigned)bkt[dist > 1023 ? 1023 : dist] : 255u; bw |= bb << (8 * i); }
        *((LAS unsigned*)bsel + lane) = bw; }
    bf16x8 qlf[4];
#pragma unroll
    for (int ks = 0; ks < 4; ++ks) { qlf[ks] = *(const bf16x8*)(ql + (size_t)tok * 1024 + (l15 & 7) * 128 + ks * 32 + kg * 8); if (l15 >= 8) qlf[ks] = (bf16x8){0, 0, 0, 0, 0, 0, 0, 0}; }
    float m = -1e30f, l = 0.f; f32x4 oT[8];
#pragma unroll
    for (int ct = 0; ct < 8; ++ct) oT[ct] = (f32x4){0.f, 0.f, 0.f, 0.f};
    const int nvalid = t + 1 < 256 ? t + 1 : 256, nch = (nvalid + 31) >> 5;
    LDS_WAIT();
    bf16x8 afa[2][4], afb[2][4], afc[2][4];
    dsa_gather(afa, ckvn, rowbase, selb, 0, l15, kg);
    if (nch > 1) dsa_gather(afb, ckvn, rowbase, selb, 1, l15, kg);
    for (int ch = 0; ch < nch; ch += 3) {
        if (ch + 2 < nch) dsa_gather(afc, ckvn, rowbase, selb, ch + 2, l15, kg);
        dsa_step(afa, qlf, ch, bsel, cbuf, tab, m, l, oT, l15, kg, lane);
        if (ch + 1 < nch) { if (ch + 3 < nch) dsa_gather(afa, ckvn, rowbase, selb, ch + 3, l15, kg);
            dsa_step(afb, qlf, ch + 1, bsel, cbuf, tab, m, l, oT, l15, kg, lane); }
        if (ch + 2 < nch) { if (ch + 4 < nch) dsa_gather(afb, ckvn, rowbase, selb, ch + 4, l15, kg);
            dsa_step(afc, qlf, ch + 2, bsel, cbuf, tab, m, l, oT, l15, kg, lane); }
    }
    l += __shfl_xor(l, 16); l += __shfl_xor(l, 32);
    const float inv = 1.f / l;
    if (l15 < 8) { bf16* o = ol + (size_t)tok * 1024 + l15 * 128 + 4 * kg;
#pragma unroll
        for (int ct = 0; ct < 8; ++ct) { v2u w; w.x = cvtpk(oT[ct][0] * inv, oT[ct][1] * inv); w.y = cvtpk(oT[ct][2] * inv, oT[ct][3] * inv); *(v2u*)(o + ct * 16) = w; } }
}
DI void dsa_chunk(const Args& a, const Fr& F, int c32) {
    LAS unsigned char* bkt = F.lds + 81920; LAS float* tab = (LAS float*)(F.lds + 82944);
    __syncthreads();
    for (int d = F.tid; d < 1024; d += NTHR) bkt[d] = (unsigned char)t5_bucket(d);
    if (F.tid < 256) tab[F.tid] = a.in[9][(F.tid >> 3) * 16 + (F.tid & 7)] * LOG2E;
    __syncthreads();
    const unsigned short* selg = (const unsigned short*)(F.ws + WS_SEL); v2u svq[4];
#pragma unroll
    for (int i = 0; i < 4; ++i) svq[i] = *((const v2u*)(selg + (size_t)(c32 * 32 + F.wave * 4 + i) * 256) + F.lane);
#pragma unroll
    for (int i = 0; i < 4; ++i) dsa_query(F, c32 * 32 + F.wave * 4 + i, svq[i], F.lds + F.wave * 10240, bkt, tab);
}

DI void ph_even_post(const Fr& F, int j) {
    const bf16* ol = (const bf16*)(F.ws + WS_OL); bf16* ao = (bf16*)(F.ws + WS_AO);
    const bf16* wuvt = (const bf16*)(F.ws + WS_WUVT) + (size_t)j * 8 * 64 * 128;
    const bf16* po = (const bf16*)(F.ws + WS_ACT); const float* pml = (const float*)(F.ws + WS_PML); const unsigned* sel3 = (const unsigned*)(F.ws + WS_SEL3);
    const int lane = F.lane, wave = F.wave, l15 = lane & 15, kg = lane >> 4;
    for (int chunk = F.blk; chunk < 256; chunk += F.G) { const int tok0 = chunk * 128;
        { const int h = wave; bf16x8 af[4][4];
#pragma unroll
            for (int mt = 0; mt < 4; ++mt)
#pragma unroll
                for (int ks = 0; ks < 4; ++ks) af[mt][ks] = *(const bf16x8*)(wuvt + ((size_t)h * 64 + mt * 16 + l15) * 128 + ks * 32 + kg * 8);
#pragma unroll 1
            for (int tg = 0; tg < 8; tg += 2) { bf16x8 bf[2][4];
#pragma unroll
                for (int u = 0; u < 2; ++u)
#pragma unroll
                    for (int ks = 0; ks < 4; ++ks) bf[u][ks] = *(const bf16x8*)(ol + (size_t)(tok0 + (tg + u) * 16 + l15) * 1024 + h * 128 + ks * 32 + kg * 8);
#pragma unroll
                for (int u = 0; u < 2; ++u) { const int tok = tok0 + (tg + u) * 16 + l15;
#pragma unroll
                    for (int mt = 0; mt < 4; ++mt) { f32x4 d = {0.f, 0.f, 0.f, 0.f};
#pragma unroll
                        for (int ks = 0; ks < 4; ++ks) d = mfma16(af[mt][ks], bf[u][ks], d);
                        v2u w; w.x = cvtpk(d[0], d[1]); w.y = cvtpk(d[2], d[3]); *(v2u*)(ao + (size_t)tok * 1024 + h * 64 + mt * 16 + 4 * kg) = w; } } } }
#pragma unroll 1
        for (int i0 = 0; i0 < 16; i0 += 4) { const int h = lane >> 3, d0 = (lane & 7) * 8; unsigned nvv[4]; f32x2 mlv[4][4];
#pragma unroll
            for (int i = 0; i < 4; ++i) { const int tok = tok0 + wave * 16 + i0 + i; const size_t pi = ((size_t)tok * 8 + h) * 4; nvv[i] = sel3[(size_t)tok * 8 + h] >> 24;
#pragma unroll
                for (int s = 0; s < 4; ++s) mlv[i][s] = *(const f32x2*)(pml + (pi + s) * 2); }
#pragma unroll
            for (int i = 0; i < 4; ++i) { const int tok = tok0 + wave * 16 + i0 + i; const size_t pi = ((size_t)tok * 8 + h) * 4;
                float mj[4], lj[4];
#pragma unroll
                for (int s = 0; s < 4; ++s) { const bool ok = (s == 3) || ((unsigned)s < nvv[i]); mj[s] = ok ? mlv[i][s][0] : -1e30f; lj[s] = ok ? mlv[i][s][1] : 0.f; }
                const float ms = fmaxf(fmaxf(mj[0], mj[1]), fmaxf(mj[2], mj[3])); float wsum = 0.f, acc[8], wv[4]; v4u pv[4];
#pragma unroll
                for (int k = 0; k < 8; ++k) acc[k] = 0.f;
#pragma unroll
                for (int s = 0; s < 4; ++s) { wv[s] = lj[s] * ex2(mj[s] - ms); wsum += wv[s]; pv[s] = (v4u){0u, 0u, 0u, 0u}; if (wv[s] > 0.f) pv[s] = *(const v4u*)(po + (pi + s) * 64 + d0); }
#pragma unroll
                for (int s = 0; s < 4; ++s) { if (wv[s] > 0.f) {
#pragma unroll
                    for (int k = 0; k < 4; ++k) { acc[2 * k] += wv[s] * bf2f(pv[s][k] & 0xffffu); acc[2 * k + 1] += wv[s] * bf2f(pv[s][k] >> 16); } } }
                const float inv = 1.f / wsum; v4u o; o.x = cvtpk(acc[0] * inv, acc[1] * inv); o.y = cvtpk(acc[2] * inv, acc[3] * inv); o.z = cvtpk(acc[4] * inv, acc[5] * inv); o.w = cvtpk(acc[6] * inv, acc[7] * inv);
                *(v4u*)(ao + (size_t)tok * 1024 + 512 + h * 64 + d0) = o; } }
    }
}
DI f32x16 proj32_f32(const float* W, int ldw, int ncols, const float* xrow, int d_lo, int lane) {
    const int e = lane & 31, kh = lane >> 5; const bool ev = e < ncols;
    f32x16 D;
#pragma unroll
    for (int r = 0; r < 16; ++r) D[r] = 0.f;
    const float* wp = W + (size_t)(d_lo + 4 * kh) * ldw + (ev ? e : 0);
    const float* xp = xrow + d_lo + 4 * kh;
#pragma unroll 8
    for (int i = 0; i < 64; ++i) { const f32x4 xv = *(const f32x4*)(xp + 8 * i);
        float a0 = wp[(size_t)(8 * i + 0) * ldw], a1 = wp[(size_t)(8 * i + 1) * ldw], a2 = wp[(size_t)(8 * i + 2) * ldw], a3 = wp[(size_t)(8 * i + 3) * ldw];
        if (!ev) { a0 = 0.f; a1 = 0.f; a2 = 0.f; a3 = 0.f; }
        D = __builtin_amdgcn_mfma_f32_32x32x2f32(a0, xv[0], D, 0, 0, 0); D = __builtin_amdgcn_mfma_f32_32x32x2f32(a1, xv[1], D, 0, 0, 0);
        D = __builtin_amdgcn_mfma_f32_32x32x2f32(a2, xv[2], D, 0, 0, 0); D = __builtin_amdgcn_mfma_f32_32x32x2f32(a3, xv[3], D, 0, 0, 0); }
    return D;
}
DI void ph_odd_prep(const Args& a, const Fr& F, int j, int layer) {
    const bf16* proj = (const bf16*)(F.ws + WS_PROJ); const float* x = (const float*)(F.ws + WS_X);
    float* logf = (float*)(F.ws + WS_LOGF); float* cs = (float*)(F.ws + WS_CS);
    const float* wf = a.in[6] + (size_t)j * 1024 * 3088 + 3072; const float* bfv = a.in[7] + j * 16;
    LAS float* red = (LAS float*)(F.lds); LAS float* lfb = (LAS float*)(F.lds + 131072);
    LAS unsigned* kmx = (LAS unsigned*)(F.lds + 131072 + 8192);
    const int lane = F.lane, wave = F.wave, tid = F.tid, l31 = lane & 31, hi = lane >> 5;
    for (int chunk = F.blk; chunk < 256; chunk += F.G) { const int tok0 = chunk * 128, b = tok0 / SEQ, t0 = tok0 % SEQ;
        __syncthreads();
        if (tid < 16) kmx[tid] = 0u;
        const int tl = wave & 3, kr = wave >> 2;
        f32x16 D = proj32_f32(wf, 3088, 16, x + (size_t)(tok0 + tl * 32 + l31) * DM, kr * 512, lane);
        if (kr == 1) {
#pragma unroll
            for (int r = 0; r < 8; ++r) red[(tl * 8 + r) * 64 + lane] = D[r]; }
        __syncthreads();
        if (kr == 0) {
#pragma unroll
            for (int r = 0; r < 8; ++r) { const int h = (r & 3) + 8 * (r >> 2) + 4 * hi; const float z = D[r] + red[(tl * 8 + r) * 64 + lane] + bfv[h];
                const float ls = fminf(z, 0.f) - log1pf(__expf(-fabsf(z)));
                lfb[(tl * 32 + l31) * 16 + h] = ls * LOG2E; } }
#pragma unroll 1
        for (int i = 0; i < 4; ++i) { const int p = tid + i * NTHR, tk = p >> 4, h = p & 15; const v4u* kp = (const v4u*)(proj + (size_t)(tok0 + tk) * OD_N + OC_K + h * 64); float s = 0.f;
#pragma unroll
            for (int c = 0; c < 8; ++c) { const v4u w = kp[c];
#pragma unroll
                for (int k = 0; k < 4; ++k) { const float e0 = bf2f(w[k] & 0xffffu), e1 = bf2f(w[k] >> 16); s += e0 * e0 + e1 * e1; } }
            __hip_atomic_fetch_max(kmx + h, __float_as_uint(s), __ATOMIC_RELAXED, __HIP_MEMORY_SCOPE_WORKGROUP); }
        __syncthreads();
        for (int i = tid; i < 2048; i += NTHR) { const int h = i >> 7, tk = i & 127; logf[((size_t)b * 16 + h) * SEQ + t0 + tk] = lfb[tk * 16 + h]; }
        if (tid < 32) { const int h = tid & 15, c = tid >> 4; float s = 0.f;
            for (int k = 0; k < 64; ++k) s += lfb[(c * 64 + k) * 16 + h];
            cs[((size_t)b * 16 + h) * 128 + (t0 >> 6) + c] = s; }
        if (tid < 16) __hip_atomic_fetch_max(F.ctl + CW_KMAX + layer * 64 + b * 16 + tid, kmx[tid], RLX_AGENT);
    }
}

constexpr float FOX_SKIP_LOG2 = 64.f;
struct FoxBias { LAS const float* ng; int tq, kabs0; bool any;
    DI float b(int kvrel) const { return ng[kvrel]; }
    DI bool msk(int kvrel) const { return (kabs0 + kvrel) > tq; } };
DI void fox_unit(const Fr& F, int layer, int b, int h, int qb) {
    const bf16* proj = (const bf16*)(F.ws + WS_PROJ); const float* logf = (const float*)(F.ws + WS_LOGF); const float* cs = (const float*)(F.ws + WS_CS); bf16* ao = (bf16*)(F.ws + WS_AO);
    LAS unsigned char* lds = F.lds; LAS float* ng = (LAS float*)(lds + 32768); LAS float* red = (LAS float*)(lds + 65536 + 1024); LAS int* ibox = (LAS int*)(lds + 65536 + 2048);
    const int tid = F.tid, lane = F.lane, wave = F.wave, r32 = lane & 31, hi = lane >> 5, t0 = qb * 256, rowbase = b * SEQ, tq = t0 + wave * 32 + r32;
    __syncthreads();
    bf16x8 qf[4]; float qs = 0.f;
    { const bf16* qp = proj + (size_t)(rowbase + tq) * OD_N + OC_Q + h * 64 + hi * 8;
#pragma unroll
        for (int s = 0; s < 4; ++s) { qf[s] = *(const bf16x8*)(qp + s * 16);
#pragma unroll
            for (int k = 0; k < 8; ++k) { const float e = bf2f((unsigned short)qf[s][k]); qs += e * e; } } }
    qs += __shfl_xor(qs, 32); qs = wave_max(qs);
    if (lane == 0) red[wave] = qs;
    if (tid < 128) red[32 + tid] = (tid < t0 / 64) ? cs[((size_t)b * 16 + h) * 128 + tid] : 0.f;
    __syncthreads();
    if (tid == 0) { float qm = red[0];
        for (int w = 1; w < 8; ++w) qm = fmaxf(qm, red[w]);
        const float km = __uint_as_float(ld_u32(F.ctl + CW_KMAX + layer * 64 + b * 16 + h));
        const float B2 = 2.f * (sqrtf(qm * km) * 1.01f + 1.f);
        int kt = t0 / 64 - 1, kts = t0 / 64; float D = 0.f;
        while (kt >= 0 && B2 + D >= -FOX_SKIP_LOG2) { kts = kt; D += red[32 + kt]; --kt; }
        ibox[0] = kts; }
    __syncthreads();
    const int kts = ibox[0], s_start = kts * 64, nel = t0 + 256 - s_start;
    { const int i0 = tid * 16; float v[16]; const float* lp = logf + ((size_t)b * 16 + h) * SEQ + s_start + i0;
        if (i0 < nel) {
#pragma unroll
            for (int c = 0; c < 4; ++c) { const f32x4 w = *(const f32x4*)(lp + 4 * c); v[4 * c] = w[0]; v[4 * c + 1] = w[1]; v[4 * c + 2] = w[2]; v[4 * c + 3] = w[3]; } }
        else {
#pragma unroll
            for (int c = 0; c < 16; ++c) v[c] = 0.f; }
#pragma unroll
        for (int c = 1; c < 16; ++c) v[c] += v[c - 1];
        float xsum = v[15];
#pragma unroll
        for (int o = 1; o < 64; o <<= 1) { const float y = __shfl_up(xsum, o); if (lane >= o) xsum += y; }
        if (lane == 63) red[16 + wave] = xsum;
        __syncthreads();
        float off = xsum - v[15];
        for (int w = 0; w < wave; ++w) off += red[16 + w];
        if (i0 < nel) {
#pragma unroll
            for (int c = 0; c < 4; ++c) { f32x4 w = {-(off + v[4 * c]), -(off + v[4 * c + 1]), -(off + v[4 * c + 2]), -(off + v[4 * c + 3])}; *(LAS f32x4*)(ng + i0 + 4 * c) = w; } }
    }
    const int ntile = t0 / 64 + 4 - kts;
    const bf16* kg = proj + (size_t)rowbase * OD_N + OC_K + h * 64; const bf16* vg = proj + (size_t)rowbase * OD_N + OC_V + h * 64;
    const int kr = tid & 31, kc = (tid >> 5) & 7, kst = tid >> 8, vcc = tid & 3, vrow = (tid >> 2) & 63, vdh = tid >> 8;
    const int koff = kst * 4096 + kc * 512 + kr * 16, voff = 8192 + vdh * 4096 + vrow * 64 + vcc * 16;
    { const v4u kv = *(const v4u*)(kg + (size_t)(kts * 64 + kst * 32 + kr) * OD_N + kc * 8), vv = *(const v4u*)(vg + (size_t)(kts * 64 + vrow) * OD_N + vdh * 32 + vcc * 8);
        *(LAS v4u*)(lds + koff) = kv; *(LAS v4u*)(lds + voff) = vv; }
    __syncthreads();
    AttSt S; S.m = 0.f; S.l = 0.f;
#pragma unroll
    for (int r = 0; r < 16; ++r) { S.o0[r] = 0.f; S.o1[r] = 0.f; }
    const int wlast = t0 + wave * 32 + 31, wfirst = t0 + wave * 32;
    for (int i = 0; i < ntile; ++i) { const int kt = kts + i; LAS unsigned char* buf = lds + (i & 1) * 16384; LAS unsigned char* nbuf = lds + ((i + 1) & 1) * 16384;
        v4u kv, vv; const bool more = i + 1 < ntile;
        if (more) { kv = *(const v4u*)(kg + (size_t)((kt + 1) * 64 + kst * 32 + kr) * OD_N + kc * 8); vv = *(const v4u*)(vg + (size_t)((kt + 1) * 64 + vrow) * OD_N + vdh * 32 + vcc * 8); }
        { const int kv0 = kt * 64;
            if (kv0 + 32 <= wlast) { FoxBias bf0{ng + (kv0 - s_start), tq, kv0, kv0 + 31 > wfirst}, bf1{ng + (kv0 + 32 - s_start), tq, kv0 + 32, kv0 + 63 > wfirst};
                att_tile64(S, qf, (LAS const char*)buf, (LAS const char*)buf + 8192, 4096, 0, lane, bf0, bf1); }
            else if (kv0 <= wlast) { FoxBias bf{ng + (kv0 - s_start), tq, kv0, kv0 + 31 > wfirst};
                att_subtile(S, qf, (LAS const char*)buf, (LAS const char*)buf + 8192, 4096, 0, lane, bf); } }
        if (more) { *(LAS v4u*)(nbuf + koff) = kv; *(LAS v4u*)(nbuf + voff - 8192 + 8192) = vv; }
        __syncthreads(); }
    const float lt = S.l + __shfl_xor(S.l, 32), inv = 1.f / lt;
    bf16* o = ao + (size_t)(rowbase + tq) * 1024 + h * 64;
#pragma unroll
    for (int a4 = 0; a4 < 4; ++a4) { v2u w0, w1;
        w0.x = cvtpk(S.o0[4 * a4] * inv, S.o0[4 * a4 + 1] * inv); w0.y = cvtpk(S.o0[4 * a4 + 2] * inv, S.o0[4 * a4 + 3] * inv);
        w1.x = cvtpk(S.o1[4 * a4] * inv, S.o1[4 * a4 + 1] * inv); w1.y = cvtpk(S.o1[4 * a4 + 2] * inv, S.o1[4 * a4 + 3] * inv);
        *(v2u*)(o + 8 * a4 + 4 * hi) = w0; *(v2u*)(o + 32 + 8 * a4 + 4 * hi) = w1; }
}

DI void ph_ln1_router(const Args& a, const Fr& F, int layer) {
    const float* yp = (const float*)(F.ws + WS_YP); float* x1 = (float*)(F.ws + WS_X1); unsigned char* xb8 = F.ws + WS_XB8;
    unsigned* tope = (unsigned*)(F.ws + WS_TOPE); float* gate = (float*)(F.ws + WS_GATE); unsigned* rank = (unsigned*)(F.ws + WS_RANK);
    const float* g = a.in[10] + (size_t)(layer * 2) * DM; const float* bb = a.in[11] + (size_t)(layer * 2) * DM;
    const float* rw = a.in[12] + (size_t)layer * 1024 * 32; const float* rb = a.in[13] + layer * 32;
    LAS float* red = (LAS float*)(F.lds); LAS unsigned* lcnt = (LAS unsigned*)(F.lds + 131072);
    const int lane = F.lane, wave = F.wave, tid = F.tid, l31 = lane & 31, hi = lane >> 5;
    for (int chunk = F.blk; chunk < 256; chunk += F.G) { const int tok0 = chunk * 128;
        __syncthreads();
        if (tid < 32) lcnt[tid] = 0u;
#pragma unroll 1
        for (int k = 0; k < 16; k += 8) { f32x4 v[8][4];
#pragma unroll
            for (int i = 0; i < 8; ++i)
#pragma unroll
                for (int jj = 0; jj < 4; ++jj) v[i][jj] = *((const f32x4*)(yp + (size_t)(tok0 + wave * 16 + k + i) * DM) + lane + 64 * jj);
#pragma unroll
            for (int i = 0; i < 8; ++i) { const int tok = tok0 + wave * 16 + k + i;
                ln_row(v[i], g, bb, lane);
                store_row_f32(x1 + (size_t)tok * DM, v[i], lane);
#pragma unroll
                for (int jj = 0; jj < 4; ++jj) *((unsigned*)(xb8 + (size_t)tok * DM) + lane + 64 * jj) = pk4_fp8(v[i][jj][0] * F8_SX, v[i][jj][1] * F8_SX, v[i][jj][2] * F8_SX, v[i][jj][3] * F8_SX); } }
        asm volatile("s_waitcnt vmcnt(0)" ::: "memory");
        __syncthreads();
        const int tl = wave & 3, kr = wave >> 2, tokl = tok0 + tl * 32 + l31;
        f32x16 D = proj32_f32(rw, 32, 32, x1 + (size_t)tokl * DM, kr * 512, lane);
        if (kr == 1) {
#pragma unroll
            for (int r = 0; r < 16; ++r) red[(tl * 16 + r) * 64 + lane] = D[r]; }
        __syncthreads();
        if (kr == 0) {
            float lv[32];
#pragma unroll
            for (int r = 0; r < 16; ++r) { const float own = D[r] + red[(tl * 16 + r) * 64 + lane] + rb[crow(r, hi)]; const float oth = __shfl_xor(own, 32);
                lv[crow(r, 0)] = hi == 0 ? own : oth; lv[crow(r, 1)] = hi == 0 ? oth : own; }
            float tv[4]; int te[4];
#pragma unroll
            for (int r = 0; r < 4; ++r) { float mx = -INFINITY; int me = 0;
#pragma unroll
                for (int e = 0; e < 32; ++e) { if (lv[e] > mx) { mx = lv[e]; me = e; } }
                tv[r] = mx; te[r] = me;
#pragma unroll
                for (int e = 0; e < 32; ++e) { if (e == me) lv[e] = -INFINITY; } }
            const float e1 = __expf(tv[1] - tv[0]), e2 = __expf(tv[2] - tv[0]), e3 = __expf(tv[3] - tv[0]); const float inv = 1.f / (1.f + e1 + e2 + e3);
            if (hi == 0) { const size_t o = (size_t)tokl * 4;
                const float gv[4] = {inv, e1 * inv, e2 * inv, e3 * inv};
#pragma unroll
                for (int r = 0; r < 4; ++r) { const unsigned rk = __hip_atomic_fetch_add(lcnt + (te[r] & 31), 1u, __ATOMIC_RELAXED, __HIP_MEMORY_SCOPE_WORKGROUP);
                    tope[o + r] = (unsigned)(te[r] & 31); gate[o + r] = gv[r]; rank[o + r] = rk; } } }
        __syncthreads();
        if (tid < 32) __hip_atomic_store(F.ctl + CW_CNT + chunk * 32 + tid, lcnt[tid], RLX_AGENT);
    }
}

DI void ph_route(const Fr& F) {
    const unsigned char* xb8 = F.ws + WS_XB8; unsigned char* xg = F.ws + WS_XG;
    const unsigned* tope = (const unsigned*)(F.ws + WS_TOPE); const unsigned* rank = (const unsigned*)(F.ws + WS_RANK); unsigned* dest = (unsigned*)(F.ws + WS_DEST);
    LAS unsigned* P = (LAS unsigned*)(F.lds); LAS unsigned* pst = P + 512; LAS unsigned* pad = P + 544; LAS unsigned* base = P + 576; LAS unsigned* nt = P + 608;
    const int tid = F.tid, lane = F.lane, wave = F.wave;
    __syncthreads();
    { const int e = tid & 31, part = tid >> 5; unsigned s = 0u;
        for (int c = 0; c < 16; ++c) s += ld_u32(F.ctl + CW_CNT + (part * 16 + c) * 32 + e);
        P[part * 32 + e] = s; }
    __syncthreads();
    if (tid < 32) { unsigned tot = 0u;
        for (int p = 0; p < 16; ++p) tot += P[p * 32 + tid];
        pad[tid] = (tot + 255u) & ~255u; }
    __syncthreads();
    if (tid == 0) { unsigned acc = 0u;
        for (int e = 0; e < 32; ++e) { pst[e] = acc; acc += pad[e]; }
        nt[0] = acc >> 8; }
    __syncthreads();
    for (int chunk = F.blk; chunk < 256; chunk += F.G) {
        __syncthreads();
        if (tid < 32) { unsigned off = 0u; const int pf = chunk >> 4;
            for (int p = 0; p < pf; ++p) off += P[p * 32 + tid];
            for (int c = pf * 16; c < chunk; ++c) off += ld_u32(F.ctl + CW_CNT + c * 32 + tid);
            base[tid] = pst[tid] + off; }
        __syncthreads();
#pragma unroll 1
        for (int i0 = 0; i0 < 16; i0 += 4) { v4u src[4]; unsigned ee[4][4], rr[4][4];
#pragma unroll
            for (int i = 0; i < 4; ++i) { const int tok = chunk * 128 + wave * 16 + i0 + i; src[i] = *((const v4u*)(xb8 + (size_t)tok * DM) + lane);
#pragma unroll
                for (int k = 0; k < 4; ++k) { ee[i][k] = tope[(size_t)tok * 4 + k]; rr[i][k] = rank[(size_t)tok * 4 + k]; } }
#pragma unroll
            for (int i = 0; i < 4; ++i) { const int tok = chunk * 128 + wave * 16 + i0 + i;
#pragma unroll
                for (int k = 0; k < 4; ++k) { const unsigned d = base[ee[i][k]] + rr[i][k];
                    if (lane == 0) dest[(size_t)tok * 4 + k] = d;
                    *((v4u*)(xg + (size_t)d * DM) + lane) = src[i]; } } }
        if (chunk == 0) { const unsigned ntl = nt[0];
            if (tid == 0) __hip_atomic_store(F.ctl + CW_TILE, ntl, RLX_AGENT);
            for (unsigned i = tid; i < ntl; i += NTHR) { unsigned e = 0u;
                for (unsigned k = 1; k < 32; ++k) if (pst[k] <= i * 256u) e = k;
                __hip_atomic_store(F.ctl + CW_TILE + 64 + i, e, RLX_AGENT); } }
    }
}

DI void ph_combine_ln2(const Args& a, const Fr& F, int layer) {
    const float* x1 = (const float*)(F.ws + WS_X1); const bf16* yr = (const bf16*)(F.ws + WS_XG); float* xo = (float*)(F.ws + WS_X); bf16* xb = (bf16*)(F.ws + WS_XB);
    const float* gate = (const float*)(F.ws + WS_GATE); const unsigned* dest = (const unsigned*)(F.ws + WS_DEST);
    const float* g = a.in[10] + (size_t)(layer * 2 + 1) * DM; const float* bb = a.in[11] + (size_t)(layer * 2 + 1) * DM;
    const int lane = F.lane; const int gw = F.blk * NWAVES + F.wave, NGW = F.G * NWAVES;
    for (int tok = gw; tok < NTOK; tok += 4 * NGW) { f32x4 v[4][4];
#pragma unroll
        for (int i = 0; i < 4; ++i) { const int tk = tok + i * NGW; if (tk < NTOK) {
#pragma unroll
            for (int jj = 0; jj < 4; ++jj) v[i][jj] = *((const f32x4*)(x1 + (size_t)tk * DM) + lane + 64 * jj) * ALPHA;
#pragma unroll
            for (int k = 0; k < 4; ++k) { const float gk = gate[(size_t)tk * 4 + k]; const unsigned d = dest[(size_t)tk * 4 + k];
#pragma unroll
                for (int jj = 0; jj < 4; ++jj) { const v2u w = *((const v2u*)(yr + (size_t)d * DM) + lane + 64 * jj);
                    v[i][jj][0] += gk * bf2f(w.x & 0xffffu); v[i][jj][1] += gk * bf2f(w.x >> 16); v[i][jj][2] += gk * bf2f(w.y & 0xffffu); v[i][jj][3] += gk * bf2f(w.y >> 16); } } } }
#pragma unroll
        for (int i = 0; i < 4; ++i) { const int tk = tok + i * NGW; if (tk < NTOK) {
            ln_row(v[i], g, bb, lane);
            if (layer == DEPTH - 1) store_row_f32(a.out + (size_t)tk * DM, v[i], lane);
            else { store_row_f32(xo + (size_t)tk * DM, v[i], lane); store_row_bf16(xb + (size_t)tk * DM, v[i], lane); } } } }
}
constexpr int LDS_BYTES = 147456;
constexpr int LDS_BARW = 145408, LDS_QSLOT = 145472, LDS_TILE_E = 133632;
constexpr int NPL = 11;
constexpr int NPHASE = 1 + NPL * DEPTH;
#ifndef MK_SINGLE
#define MK_SINGLE 1
#endif
DI int q_next(const Fr& F, unsigned* ctr) {
    LAS int* slot = (LAS int*)(F.lds + LDS_QSLOT);
    __syncthreads();
    if (F.tid == 0) *slot = (int)__hip_atomic_fetch_add(ctr, 1u, RLX_AGENT);
    __syncthreads();
    return *slot;
}
DI int lane_id_fresh() { unsigned m_ = ~0u; asm volatile("" : "+s"(m_)); return (int)__builtin_amdgcn_mbcnt_hi(m_, __builtin_amdgcn_mbcnt_lo(m_, 0u)); }
#define RETID(F) do { int t2_ = F.tid; asm volatile("" : "+v"(t2_)); F.tid = t2_; F.lane = t2_ & 63; F.wave = __builtin_amdgcn_readfirstlane(t2_ >> 6); } while (0)
#ifndef PROBE_DUP
#define PROBE_DUP -1
#endif
#define NREP(q) ((PROBE_DUP == (q)) ? 2 : 1)
#define AS4 __attribute__((address_space(4)))
#define SITE() Args a; Fr F; { const AS4 Args* ap = (const AS4 Args*)__builtin_amdgcn_kernarg_segment_ptr(); asm volatile("" : "+s"(ap)); \
        _Pragma("unroll") for (int i_ = 0; i_ < 18; ++i_) a.in[i_] = ap->in[i_]; a.out = ap->out; a.ws = ap->ws; a.ph_lo = 0; a.ph_hi = 0; \
        int w_ = wv_s; asm volatile("" : "+s"(w_)); int t_ = w_ * 64 + lane_id_fresh(); asm volatile("" : "+v"(t_)); F.tid = t_; F.lane = t_ & 63; F.wave = __builtin_amdgcn_readfirstlane(t_ >> 6); \
        F.lds = (LAS unsigned char*)lds_raw; F.ws = a.ws; F.ctl = (unsigned*)(a.ws + WS_CTL); F.blk = blockIdx.x; F.G = gridDim.x; }
__global__ void __launch_bounds__(NTHR, 2) mega_fwd(Args a0) {
    extern __shared__ __attribute__((aligned(16))) unsigned char lds_raw[];
    const int wv_s = __builtin_amdgcn_readfirstlane((int)(threadIdx.x >> 6));
#if MK_SINGLE
    constexpr int lo = 0, hi = NPHASE; constexpr bool single = true;
#else
    const int lo = a0.ph_lo, hi = a0.ph_hi; constexpr bool single = false;
#endif
    if (threadIdx.x == 0) *(LAS v4u*)((LAS unsigned char*)lds_raw + LDS_BARW) = (v4u){0u, 0u, 0u, 0u};
    __syncthreads();
    if (single) (void)xcd_barrier_post((unsigned*)(a0.ws + WS_CTL) + CW_BAR, (volatile LAS unsigned*)((LAS unsigned char*)lds_raw + LDS_BARW));
#define IN(k) (lo <= (k) && (k) < hi)
#define SEAM() do { if (single) { const AS4 Args* ap_ = (const AS4 Args*)__builtin_amdgcn_kernarg_segment_ptr(); asm volatile("" : "+s"(ap_)); int w_ = wv_s; asm volatile("" : "+s"(w_)); \
        XcdBarrier b_; b_.bar = (unsigned*)(ap_->ws + WS_CTL) + CW_BAR; b_.x = xb_xcc_id(); b_.st = (volatile LAS unsigned*)((LAS unsigned char*)lds_raw + LDS_BARW); \
        xcd_barrier(b_, (w_ == 0) && (lane_id_fresh() == 0)); } } while (0)
    if (IN(0)) { _Pragma("unroll 1") for (int rep = 0; rep < NREP(100); ++rep) { { SITE(); ph_prologue(a, F); } SEAM(); } }
#pragma unroll 1
    for (int L = 0; L < DEPTH; ++L) {
        const int pb = 1 + NPL * L, j = L >> 1; const bool odd = (L & 1) != 0;
        if (IN(pb + 0)) _Pragma("unroll 1") for (int rep = 0; rep < NREP(0); ++rep) {
            { SITE();
            const bf16* w = odd ? (const bf16*)(F.ws + WS_WOD) + (size_t)j * OD_N * 1024 : (const bf16*)(F.ws + WS_WEV) + (size_t)j * EV_N * 1024;
            const int N = odd ? OD_N : EV_N;
            pg8::Gemm g{(const bf16*)(F.ws + WS_XB), w, NTOK, N, 1024}; pg8::StaticOrder S; S.init(NTOK, N, F.G, F.blk);
            pg8::EpiBf16<0> E{(bf16*)(F.ws + WS_PROJ), N, nullptr, 1024, (size_t)1024, C2F};
            pg8::gemm_phase<pg8::EpiBf16<0>, pg8::StaticOrder, true, true>(F.lds, g, S, E, F.tid); }
            SEAM(); }
        if (IN(pb + 1)) _Pragma("unroll 1") for (int rep = 0; rep < NREP(1); ++rep) { { SITE(); if (odd) ph_odd_prep(a, F, j, L); else ph_even_prep(a, F, j); } SEAM(); }
        if (!odd && IN(pb + 2)) _Pragma("unroll 1") for (int rep = 0; rep < ((PROBE_DUP == 2 || (PROBE_DUP >= 21 && PROBE_DUP <= 22) || (PROBE_DUP >= 211 && PROBE_DUP <= 213)) ? 2 : 1); ++rep) {
            { SITE(); unsigned* ctr = F.ctl + CW_Q + 64 * (L * 2) + 1024 * rep;
            for (;;) { const int it = q_next(F, ctr); if (it >= 1280) break; RETID(F);
                if (it < 1024) { if (!(rep == 1 && PROBE_DUP == 22)) idx_unit(F, it & 3, 255 - (it >> 2), (rep == 1 && PROBE_DUP >= 211) ? PROBE_DUP - 210 : 0); } else { if (!(rep == 1 && (PROBE_DUP == 21 || PROBE_DUP >= 211))) moba_gate_chunk(F, it - 1024); } } }
            SEAM(); }
        if (IN(pb + 3)) _Pragma("unroll 1") for (int rep = 0; rep < ((PROBE_DUP == 3 || (PROBE_DUP == 31 && odd) || ((PROBE_DUP == 32 || PROBE_DUP == 33) && !odd)) ? 2 : 1); ++rep) {
            { SITE(); unsigned* ctr = F.ctl + CW_Q + 64 * (L * 2 + 1) + 1024 * rep;
            if (odd) { for (;;) { const int it = q_next(F, ctr); if (it >= 2048) break; RETID(F); const int bh = it & 63; fox_unit(F, L, bh >> 4, bh & 15, 31 - (it >> 6)); } }
            else { for (;;) { const int it = q_next(F, ctr); if (it >= 2048) break; RETID(F);
                    if (it < 1024) { const int bh = it & 31; if (!(rep == 1 && PROBE_DUP == 33)) moba_unit(a, F, bh >> 3, bh & 7, it >> 5); } else { if (!(rep == 1 && PROBE_DUP == 32)) dsa_chunk(a, F, it - 1024); } } } }
            SEAM(); }
        if (!odd && IN(pb + 4)) _Pragma("unroll 1") for (int rep = 0; rep < NREP(4); ++rep) { { SITE(); ph_even_post(F, j); } SEAM(); }
        if (IN(pb + 5)) _Pragma("unroll 1") for (int rep = 0; rep < NREP(5); ++rep) {
            { SITE();
            const float* xin = (L == 0) ? a.in[0] : (const float*)(F.ws + WS_X);
            pg8::Gemm g{(const bf16*)(F.ws + WS_AO), (const bf16*)(F.ws + WS_WOUT) + (size_t)L * 1024 * 1024, NTOK, 1024, 1024}; pg8::StaticOrder S; S.init(NTOK, 1024, F.G, F.blk);
            EpiResF32 E{xin, (float*)(F.ws + WS_YP), ALPHA};
            pg8::gemm_phase<EpiResF32, pg8::StaticOrder, true, true>(F.lds, g, S, E, F.tid); }
            SEAM(); }
        if (IN(pb + 6)) _Pragma("unroll 1") for (int rep = 0; rep < NREP(6); ++rep) { { SITE(); ph_ln1_router(a, F, L); } SEAM(); }
        if (IN(pb + 7)) _Pragma("unroll 1") for (int rep = 0; rep < NREP(7); ++rep) { { SITE(); ph_route(F); } SEAM(); }
        if (IN(pb + 8)) _Pragma("unroll 1") for (int rep = 0; rep < NREP(8); ++rep) {
            { SITE(); const int ntl = (int)ld_u32(F.ctl + CW_TILE);
            LAS unsigned* tle = (LAS unsigned*)(F.lds + LDS_TILE_E);
            for (int i = F.tid; i < ntl; i += NTHR) tle[i] = ld_u32(F.ctl + CW_TILE + 64 + i);
            __syncthreads();
            pg8::Gemm g{(const bf16*)(F.ws + WS_XG), (const bf16*)(F.ws + WS_WGU + (size_t)L * 32 * 2048 * 1024), NR_MAX, 32 * 2048, 512};
            GroupOrder S{tle, ntl, 3, F.G, F.blk};
            EpiSwiglu E{F.ws + WS_ACT, a.in[15] + (size_t)L * 32 * 2048};
            pg8::gemm_phase<EpiSwiglu, GroupOrder, true, true, true>(F.lds, g, S, E, F.tid); }
            SEAM(); }
        if (IN(pb + 9)) _Pragma("unroll 1") for (int rep = 0; rep < NREP(9); ++rep) {
            { SITE(); const int ntl = (int)ld_u32(F.ctl + CW_TILE);
            LAS unsigned* tle = (LAS unsigned*)(F.lds + LDS_TILE_E);
            for (int i = F.tid; i < ntl; i += NTHR) tle[i] = ld_u32(F.ctl + CW_TILE + 64 + i);
            __syncthreads();
            pg8::Gemm g{(const bf16*)(F.ws + WS_ACT), (const bf16*)(F.ws + WS_WDN + (size_t)L * 32 * 1024 * 1024), NR_MAX, 32 * 1024, 512};
            GroupOrder S{tle, ntl, 2, F.G, F.blk};
            EpiDown E{(bf16*)(F.ws + WS_XG), a.in[17] + (size_t)L * 32 * 1024};
            pg8::gemm_phase<EpiDown, GroupOrder, true, true, true>(F.lds, g, S, E, F.tid); }
            SEAM(); }
        if (IN(pb + 10)) _Pragma("unroll 1") for (int rep = 0; rep < NREP(10); ++rep) { { SITE(); ph_combine_ln2(a, F, L); } if (L + 1 < DEPTH || rep + 1 < NREP(10)) SEAM(); }
    }
#undef IN
#undef SEAM
}

extern "C" void kernel_launch(void* const* d_in, const int* in_sizes, int n_in, void* d_out, int out_size, void* d_ws, size_t ws_size, hipStream_t stream) {
    static int grid = 0;
    if (grid == 0) {
        if (n_in != 18 || out_size != NTOK * DM || ws_size < WS_END) { fprintf(stderr, "kernel_launch: unexpected shapes (n_in %d, out %d, ws %zu); nothing launched\n", n_in, out_size, ws_size); grid = -1; return; }
        int dev = 0, cus = 0, per_cu = 0;
        if (hipGetDevice(&dev) != hipSuccess || hipDeviceGetAttribute(&cus, hipDeviceAttributeMultiprocessorCount, dev) != hipSuccess) { grid = -1; return; }
        if (hipFuncSetAttribute((const void*)mega_fwd, hipFuncAttributeMaxDynamicSharedMemorySize, LDS_BYTES) != hipSuccess) { fprintf(stderr, "kernel_launch: hipFuncSetAttribute failed\n"); grid = -1; return; }
        if (hipOccupancyMaxActiveBlocksPerMultiprocessor(&per_cu, (const void*)mega_fwd, NTHR, LDS_BYTES) != hipSuccess || per_cu < 1) fprintf(stderr, "kernel_launch: occupancy query reports %d\n", per_cu);
        (void)hipGetLastError();
        grid = cus;
    }
    if (grid < 0) return;
    (void)hipMemsetAsync((char*)d_ws + WS_CTL, 0, CTL_ZERO_BYTES, stream);
#ifdef EXP_SKIP
    (void)hipMemsetAsync((char*)d_ws + WS_AO, 0, 64 * MiB, stream);
    (void)hipMemsetAsync((char*)d_ws + WS_OL, 0, 64 * MiB, stream);
    if (EXP_SKIP & 4) { (void)hipMemsetAsync((char*)d_ws + WS_XG, 0, 272 * MiB, stream); (void)hipMemsetAsync((char*)d_ws + WS_DEST, 0, 1 * MiB, stream); }
#endif
    Args a{};
    for (int i = 0; i < 18; ++i) a.in[i] = (const float*)d_in[i];
    a.out = (float*)d_out; a.ws = (unsigned char*)d_ws;
#if MK_SINGLE
    a.ph_lo = 0; a.ph_hi = NPHASE;
    hipLaunchKernelGGL(mega_fwd, dim3(grid), dim3(NTHR), LDS_BYTES, stream, a);
#else
    for (int p = 0; p < NPHASE; ++p) {
        if (p > 0) { const int L = (p - 1) / NPL, q = (p - 1) % NPL; if ((L & 1) && (q == 2 || q == 4)) continue;
#ifdef EXP_SKIP
            if ((EXP_SKIP & 1) && !(L & 1) && q <= 4) continue;
            if ((EXP_SKIP & 2) && (L & 1) && q <= 4) continue;
            if ((EXP_SKIP & 4) && q >= 7 && q <= 9) continue;
#endif
        }
        a.ph_lo = p; a.ph_hi = p + 1;
        hipLaunchKernelGGL(mega_fwd, dim3(grid), dim3(NTHR), LDS_BYTES, stream, a);
    }
#endif
}
```

```cpp
#include <hip/hip_runtime.h>
#include <cstdio>
#include <cstdint>
#ifdef EXP_SKIP
#define EXPF EXP_SKIP
#else
#define EXPF 0
#endif
constexpr int NB = 4, SEQ = 8192, DM = 1024, NTOK = NB * SEQ, DEPTH = 4;
constexpr int EV_N = 2560, OD_N = 3072;
constexpr int EC_QA = 0, EC_QB = 512, EC_KB = 1024, EC_VB = 1536, EC_CKV = 2048, EC_QI = 2176, EC_KI = 2432, EC_WI = 2496;
constexpr int OC_Q = 0, OC_K = 1024, OC_V = 2048;
constexpr float LOG2E = 1.4426950408889634f;
constexpr float C2F = 0.125f * LOG2E;
constexpr float ALPHA = 1.681792830507429f;
constexpr float LN_EPS = 1e-5f;
constexpr int NR_MAX = 131072 + 32 * 256;
constexpr int NWAVES = 8, NTHR = 512;
constexpr size_t MiB = (size_t)1 << 20;
constexpr size_t WS_CTL = 0, CTL_ZERO_BYTES = 4 * MiB;
constexpr size_t WS_WEV = 8 * MiB, WS_WOD = 18 * MiB, WS_WOUT = 30 * MiB, WS_WUKT = 38 * MiB, WS_WUVT = 39 * MiB;
constexpr size_t WS_WGU = 40 * MiB, WS_WDN = 552 * MiB;
constexpr size_t WS_X = 808 * MiB, WS_X1 = 936 * MiB, WS_YP = 1064 * MiB, WS_XB = 1192 * MiB;
constexpr size_t WS_PROJ = 1256 * MiB, WS_AO = 1448 * MiB, WS_XG = 1512 * MiB, WS_ACT = 1784 * MiB;
constexpr size_t WS_QL = 2056 * MiB, WS_OL = 2120 * MiB, WS_CKVN = 2184 * MiB, WS_SEL = 2192 * MiB;
constexpr size_t WS_KBAR = 2208 * MiB, WS_SEL3 = 2209 * MiB, WS_LOGF = 2210 * MiB, WS_CS = 2212 * MiB;
constexpr size_t WS_TOPE = 2213 * MiB, WS_GATE = 2214 * MiB, WS_RANK = 2215 * MiB, WS_DEST = 2216 * MiB, WS_PML = 2217 * MiB;
constexpr size_t WS_XB8 = 2226 * MiB;
constexpr size_t WS_KIC = 2258 * MiB;
constexpr size_t WS_END = 2262 * MiB;
constexpr float F8_SX = 16.f, F8_SWG = 256.f, F8_SA = 4.f, F8_SWD = 512.f;
constexpr int CW_BAR = 4096, CW_Q = 8192, CW_KMAX = 12288, CW_CNT = 16384, CW_TILE = 32768;

#define GAS __attribute__((address_space(1)))
#define LAS __attribute__((address_space(3)))
#define DI __device__ __forceinline__
typedef unsigned short bf16;
typedef unsigned v4u __attribute__((ext_vector_type(4)));
typedef unsigned v2u __attribute__((ext_vector_type(2)));
typedef float f32x4 __attribute__((ext_vector_type(4)));
typedef float f32x2 __attribute__((ext_vector_type(2)));
typedef float f32x16 __attribute__((ext_vector_type(16)));
typedef short bf16x8 __attribute__((ext_vector_type(8)));
typedef short s16x4 __attribute__((ext_vector_type(4)));
typedef __bf16 bf16x2_t __attribute__((ext_vector_type(2)));
typedef GAS unsigned gu32;
#define RLX_AGENT __ATOMIC_RELAXED, __HIP_MEMORY_SCOPE_AGENT
#define LDS_WAIT() asm volatile("s_waitcnt lgkmcnt(0)" ::: "memory")

DI float bf2f(unsigned v) { return __uint_as_float(v << 16); }
DI unsigned cvtpk(float lo, float hi) { f32x2 v = {lo, hi}; bf16x2_t b = __builtin_convertvector(v, bf16x2_t); return __builtin_bit_cast(unsigned, b); }
DI unsigned f2bf(float f) { return cvtpk(f, 0.f) & 0xffffu; }
DI unsigned pk4_fp8(float a, float b, float c, float d) {
    a = fminf(fmaxf(a, -448.f), 448.f); b = fminf(fmaxf(b, -448.f), 448.f); c = fminf(fmaxf(c, -448.f), 448.f); d = fminf(fmaxf(d, -448.f), 448.f);
    int w = 0; w = __builtin_amdgcn_cvt_pk_fp8_f32(a, b, w, false); w = __builtin_amdgcn_cvt_pk_fp8_f32(c, d, w, true); return (unsigned)w; }
DI float ex2(float x) { return __builtin_amdgcn_exp2f(x); }
DI float wave_sum(float v) {
#pragma unroll
    for (int o = 1; o < 64; o <<= 1) v += __shfl_xor(v, o);
    return v;
}
DI float wave_max(float v) {
#pragma unroll
    for (int o = 1; o < 64; o <<= 1) v = fmaxf(v, __shfl_xor(v, o));
    return v;
}
DI unsigned ld_u32(const unsigned* p) { return __hip_atomic_load(p, RLX_AGENT); }
DI int crow(int r, int hi) { return (r & 3) + 8 * (r >> 2) + 4 * hi; }
DI f32x16 mfma32(bf16x8 a, bf16x8 b, f32x16 c) { return __builtin_amdgcn_mfma_f32_32x32x16_bf16(a, b, c, 0, 0, 0); }
DI f32x4 mfma16(bf16x8 a, bf16x8 b, f32x4 c) { return __builtin_amdgcn_mfma_f32_16x16x32_bf16(a, b, c, 0, 0, 0); }
typedef short v4i16_t __attribute__((ext_vector_type(4)));
DI s16x4 vtr(LAS const char* p) { return __builtin_bit_cast(s16x4, __builtin_amdgcn_ds_read_tr16_b64_v4i16((LAS v4i16_t*)p)); }
DI bf16x8 cat8(s16x4 a, s16x4 b) { return (bf16x8){a[0], a[1], a[2], a[3], b[0], b[1], b[2], b[3]}; }
DI int t5_bucket(int n) {
    if (n < 16) return n;
    int bkt = 16;
    bkt += (n >= 21); bkt += (n >= 27); bkt += (n >= 35); bkt += (n >= 46); bkt += (n >= 59); bkt += (n >= 77); bkt += (n >= 99); bkt += (n >= 128);
    bkt += (n >= 166); bkt += (n >= 216); bkt += (n >= 280); bkt += (n >= 363); bkt += (n >= 470); bkt += (n >= 609); bkt += (n >= 790);
    return bkt;
}
namespace pg8 {
#define PG8_LAS __attribute__((address_space(3)))
typedef unsigned short bf16_t;
typedef short bf16x8 __attribute__((ext_vector_type(8)));
typedef float f32x4 __attribute__((ext_vector_type(4)));
typedef unsigned u32x4 __attribute__((ext_vector_type(4)));
constexpr int BM = 256, BK = 64, HALF = 128, HTB = HALF * BK * 2  , STAGE_BYTES = 8 * HTB, NXCD = 8, WGM = 8;

__host__ __device__ __forceinline__ int lds_byte(int r, int c) { const int st = (r >> 4) * 2 + (c >> 5), rr = r & 15, cc = c & 31, ob = rr * 64 + cc * 2; return st * 1024 + (ob ^ (((ob >> 9) & 1) << 5)); }
__host__ __device__ __forceinline__ void stage_rc(int b, int& R, int& C) { const int st = b / 1024, sb = b % 1024, swz = sb ^ (((sb >> 9) & 1) << 5); R = (st >> 1) * 16 + swz / 64; C = (st & 1) * 32 + (swz % 64) / 2; }
__host__ __device__ __forceinline__ int perm32(int rho) { const int n = rho >> 4, i = rho & 15; return 8 * (i >> 2) + 4 * n + (i & 3); }

typedef int i32x8 __attribute__((ext_vector_type(8))); typedef int i32x4v __attribute__((ext_vector_type(4)));
__device__ __forceinline__ i32x8 pg8_cat8(bf16x8 lo, bf16x8 hi) { const i32x4v a = __builtin_bit_cast(i32x4v, lo), b = __builtin_bit_cast(i32x4v, hi); return (i32x8){a[0], a[1], a[2], a[3], b[0], b[1], b[2], b[3]}; }
struct Unit { int pm, pn; };
struct Gemm { const bf16_t* A; const bf16_t* Bt; int M, N, K; };

struct StaticOrder {
    int nM, nN, nwg, G, c;
    __host__ __device__ void init(int M, int N, int G_, int c_) { nM = M / BM; nN = N / BM; nwg = nM * nN; G = G_; c = c_; }
    __host__ __device__ bool next(int i, Unit& u) const {
        const long L = (long)i * G + c; if (L >= nwg) return false;
        int wgid = (int)L; { const int q = nwg / NXCD, r = nwg % NXCD, xcd = wgid % NXCD, off = wgid / NXCD; wgid = (xcd < r ? xcd * (q + 1) : r * (q + 1) + (xcd - r) * q) + off; }
        const int nig = WGM * nN, gid = wgid / nig, fm = gid * WGM, gsz = (nM - fm) < WGM ? (nM - fm) : WGM;
        u.pm = fm + ((wgid % nig) % gsz); u.pn = (wgid % nig) / gsz; return true;
    }
    __device__ __forceinline__ void a_ready(const Unit&) const {}
    __device__ __forceinline__ void done(const Unit&) const {}
};

__device__ __forceinline__ unsigned cvt_pk_bf16(float lo, float hi) { unsigned r; asm volatile("v_cvt_pk_bf16_f32 %0, %1, %2" : "=v"(r) : "v"(lo), "v"(hi)); return r; }
typedef float f32x2 __attribute__((ext_vector_type(2)));
__device__ __forceinline__ f32x2 gelu_pk(f32x2 v) {
    const f32x2 av = __builtin_elementwise_abs(v), d = av * 0.2316418882f + 1.0f;
    f32x2 t; t.x = __builtin_amdgcn_rcpf(d.x); t.y = __builtin_amdgcn_rcpf(d.y);
    f32x2 q = t * 0.5307027145f + (-0.7265760135f); q = q * t + 0.7107068705f; q = q * t + (-0.142248368f); q = q * t + 0.127414796f; q = q * t;
    const f32x2 s = (v * v) * (-0.72134752044f);
    f32x2 e; e.x = __builtin_amdgcn_exp2f(s.x); e.y = __builtin_amdgcn_exp2f(s.y);
    const f32x2 m = v * (q * e), r = v - m;
    f32x2 o; o.x = v.x < 0.f ? m.x : r.x; o.y = v.y < 0.f ? m.y : r.y; return o;
}

template <int ACT  > struct EpiBf16 {
    static constexpr bool PERM = true, AFTER_DRAIN = false; static_assert(ACT == 0 || ACT == 1, "EpiBf16: ACT is 0 (none) or 1 (gelu_pk)");
    bf16_t* O; int ldc; const float* bias; int split_cols; size_t split_stride; float scale0;
    __device__ __forceinline__ void operator()(const f32x4 (&acc)[2][2][4][2], const Unit& u, int wr, int wc, int fr, int fq) const {
        const int row0 = u.pm * BM + wr * 64 + fr; int colt = u.pn * BM; bf16_t* base = O;
        float sc = 1.f; if (split_cols) { const int t = colt / split_cols; base += (size_t)t * split_stride; colt -= t * split_cols; if (t == 0) sc = scale0; }
        const int col0 = colt + wc * 32 + 8 * fq, bcol0 = u.pn * BM + wc * 32 + 8 * fq;
        f32x4 bv[2][2];
#pragma unroll
        for (int bj = 0; bj < 2; ++bj)
#pragma unroll
            for (int n = 0; n < 2; ++n) bv[bj][n] = bias ? *(const f32x4*)(bias + bcol0 + bj * HALF + 4 * n) : (f32x4){0.f, 0.f, 0.f, 0.f};
#pragma unroll
        for (int ai = 0; ai < 2; ++ai)
#pragma unroll
            for (int m = 0; m < 4; ++m) { bf16_t* rowp = base + (size_t)(row0 + ai * HALF + m * 16) * ldc + col0;
#pragma unroll
                for (int bj = 0; bj < 2; ++bj) { f32x4 v0 = acc[ai][bj][m][0] + bv[bj][0], v1 = acc[ai][bj][m][1] + bv[bj][1];
                    if (ACT == 1) { f32x2 a = gelu_pk((f32x2){v0[0], v0[1]}), b = gelu_pk((f32x2){v0[2], v0[3]}), c = gelu_pk((f32x2){v1[0], v1[1]}), d = gelu_pk((f32x2){v1[2], v1[3]});
                        v0 = (f32x4){a.x, a.y, b.x, b.y}; v1 = (f32x4){c.x, c.y, d.x, d.y}; }
                    v0 = v0 * sc; v1 = v1 * sc; u32x4 w; w.x = cvt_pk_bf16(v0[0], v0[1]); w.y = cvt_pk_bf16(v0[2], v0[3]); w.z = cvt_pk_bf16(v1[0], v1[1]); w.w = cvt_pk_bf16(v1[2], v1[3]);
                    *(u32x4*)(rowp + bj * HALF) = w; } }
    }
};

template <class Epi, class Sched, bool ALIGN_EPI = false, bool SP2 = false, bool F8 = false>
__device__ __forceinline__ void gemm_phase(PG8_LAS unsigned char* lds, const Gemm g, const Sched& S, const Epi& E, int tid_in) {
    int tid_l = tid_in; asm volatile("" : "+v"(tid_l));
    const int tid = tid_l, wid = __builtin_amdgcn_readfirstlane(tid >> 6), lane = tid & 63, wr = wid >> 2, wc = wid & 3, fr = lane & 15, fq = lane >> 4;
    const int K = g.K, nt = K / BK;
    unsigned voffA[2], voffB[2];
#pragma unroll
    for (int i = 0; i < 2; ++i) { int R, C; stage_rc(tid * 16 + i * 8192, R, C); const int Rb = Epi::PERM ? ((R & ~31) + perm32(R & 31)) : R;
        voffA[i] = (unsigned)(R * K + C) * 2u; voffB[i] = (unsigned)(Rb * K + C) * 2u; }
    const size_t kstep = (size_t)(BK * 2);
    const size_t hstep = (size_t)HALF * K * 2;
    const size_t tstep = 2 * hstep;
    const unsigned ldsw = (unsigned)wid * 1024u;
    const int aoff = lds_byte(wr * 64 + fr, fq * 8), boff = lds_byte(wc * 32 + fr, fq * 8);
#define PG8_SA(b, h) (((b) * 2 + (h)) * HTB)
#define PG8_SB(b, h) ((4 + (b) * 2 + (h)) * HTB)
#define PG8_STAGE(bufoff, gbase, voff) do { _Pragma("unroll") for (int _i = 0; _i < 2; ++_i) \
        __builtin_amdgcn_global_load_lds((const unsigned*)((const char*)(gbase) + (voff)[_i]), (PG8_LAS unsigned*)(lds + (bufoff) + ldsw + _i * 8192), 16, 0, 0); } while (0)
#define PG8_LDA(dst, b, h) do { _Pragma("unroll") for (int m = 0; m < 4; ++m) _Pragma("unroll") for (int k = 0; k < 2; ++k) dst[m][k] = *(const PG8_LAS bf16x8*)(lds + PG8_SA(b, h) + aoff + m * 2048 + k * 1024); } while (0)
#define PG8_LDB(dst, b, h) do { _Pragma("unroll") for (int n = 0; n < 2; ++n) _Pragma("unroll") for (int k = 0; k < 2; ++k) dst[n][k] = *(const PG8_LAS bf16x8*)(lds + PG8_SB(b, h) + boff + n * 2048 + k * 1024); } while (0)
#define PG8_MMA(ai, bj, At, Bt) do { __builtin_amdgcn_s_setprio(1); if constexpr (!F8) { _Pragma("unroll") for (int m = 0; m < 4; ++m) _Pragma("unroll") for (int n = 0; n < 2; ++n) _Pragma("unroll") for (int k = 0; k < 2; ++k) \
        acc[ai][bj][m][n] = __builtin_amdgcn_mfma_f32_16x16x32_bf16(Bt[n][k], At[m][k], acc[ai][bj][m][n], 0, 0, 0); } else { _Pragma("unroll") for (int m = 0; m < 4; ++m) _Pragma("unroll") for (int n = 0; n < 2; ++n) \
        acc[ai][bj][m][n] = __builtin_amdgcn_mfma_scale_f32_16x16x128_f8f6f4(pg8_cat8(Bt[n][0], Bt[n][1]), pg8_cat8(At[m][0], At[m][1]), acc[ai][bj][m][n], 0, 0, 0, 0x7F7F7F7F, 0, 0x7F7F7F7F); \
        _Pragma("unroll") for (int m = 0; m < 4; ++m) _Pragma("unroll") for (int n = 0; n < 2; ++n) asm volatile("" : "+v"(acc[ai][bj][m][n]));   } __builtin_amdgcn_s_setprio(0); } while (0)
#define PG8_WAIT_V(n) asm volatile("s_waitcnt vmcnt(" #n ")" ::: "memory")
#define PG8_WAIT_L(n) asm volatile("s_waitcnt lgkmcnt(" #n ")" ::: "memory")
#define PG8_BAR __builtin_amdgcn_s_barrier()
#define PG8_SCHED __builtin_amdgcn_sched_barrier(0)
    Unit cur, nxt; int ui = 0;
    if (!S.next(0, cur)) return;
    f32x4 acc[2][2][4][2];
#pragma unroll
    for (int a = 0; a < 2; ++a)
#pragma unroll
        for (int b = 0; b < 2; ++b)
#pragma unroll
            for (int m = 0; m < 4; ++m)
#pragma unroll
                for (int n = 0; n < 2; ++n) acc[a][b][m][n] = (f32x4){0.f, 0.f, 0.f, 0.f};
    bf16x8 At[4][2], B0[2][2], B1[2][2];
    const char* cA = (const char*)g.A + (size_t)cur.pm * tstep; const char* cB = (const char*)g.Bt + (size_t)cur.pn * tstep;
    S.a_ready(cur);
    if constexpr (SP2) {
        PG8_STAGE(PG8_SB(0, 0), cB, voffB); PG8_STAGE(PG8_SB(0, 1), cB + hstep, voffB); PG8_STAGE(PG8_SA(0, 0), cA, voffA); PG8_STAGE(PG8_SA(0, 1), cA + hstep, voffA);
        if (wr == 1) PG8_BAR;
        PG8_WAIT_V(2); PG8_BAR;
        PG8_STAGE(PG8_SB(1, 0), cB + kstep, voffB); PG8_STAGE(PG8_SA(1, 0), cA + kstep, voffA); PG8_STAGE(PG8_SB(1, 1), cB + hstep + kstep, voffB);
        PG8_WAIT_V(6); PG8_BAR;
    } else {
        PG8_STAGE(PG8_SB(0, 0), cB, voffB); PG8_STAGE(PG8_SA(0, 0), cA, voffA); PG8_STAGE(PG8_SB(0, 1), cB + hstep, voffB); PG8_STAGE(PG8_SA(0, 1), cA + hstep, voffA);
        if (wr == 1) PG8_BAR;
        PG8_WAIT_V(4); PG8_BAR;
        PG8_STAGE(PG8_SB(1, 0), cB + kstep, voffB); PG8_STAGE(PG8_SA(1, 0), cA + kstep, voffA); PG8_STAGE(PG8_SB(1, 1), cB + hstep + kstep, voffB);
        PG8_WAIT_V(6); PG8_BAR;
    }
    for (;;) {
        const bool has_next = S.next(ui + 1, nxt);
        const char* nA = has_next ? (const char*)g.A + (size_t)nxt.pm * tstep : cA; const char* nB = has_next ? (const char*)g.Bt + (size_t)nxt.pn * tstep : cB;
        for (int t = 0; t < nt; t += 2) {
            const bool last = (t == nt - 2);
            const char* a1 = cA + (size_t)(t + 1) * kstep;
            const char* a2 = last ? nA : cA + (size_t)(t + 2) * kstep; const char* b2 = last ? nB : cB + (size_t)(t + 2) * kstep;
            const char* a3 = a2 + kstep; const char* b3 = b2 + kstep;
            if (last && has_next) S.a_ready(nxt);
            if constexpr (SP2) {
            PG8_LDB(B0, 0, 0); PG8_LDB(B1, 0, 1); PG8_SCHED; PG8_LDA(At, 0, 0); PG8_STAGE(PG8_SA(1, 1), a1 + hstep, voffA);
            PG8_WAIT_V(8); PG8_WAIT_L(0); PG8_BAR; PG8_MMA(0, 0, At, B0); PG8_MMA(0, 1, At, B1); PG8_BAR; PG8_SCHED;
            PG8_LDA(At, 0, 1); PG8_STAGE(PG8_SB(0, 0), b2, voffB); PG8_STAGE(PG8_SB(0, 1), b2 + hstep, voffB); PG8_STAGE(PG8_SA(0, 0), a2, voffA);
            PG8_WAIT_V(8); PG8_WAIT_L(0); PG8_BAR; PG8_MMA(1, 0, At, B0); PG8_MMA(1, 1, At, B1); PG8_BAR; PG8_SCHED;
            PG8_LDB(B0, 1, 0); PG8_LDB(B1, 1, 1); PG8_SCHED; PG8_LDA(At, 1, 0); PG8_STAGE(PG8_SA(0, 1), a2 + hstep, voffA);
            PG8_WAIT_V(8); PG8_WAIT_L(0); PG8_BAR; PG8_MMA(0, 0, At, B0); PG8_MMA(0, 1, At, B1); PG8_BAR; PG8_SCHED;
            PG8_LDA(At, 1, 1); PG8_STAGE(PG8_SB(1, 0), b3, voffB); PG8_STAGE(PG8_SB(1, 1), b3 + hstep, voffB); PG8_STAGE(PG8_SA(1, 0), a3, voffA);
            PG8_WAIT_V(8); PG8_WAIT_L(0); PG8_BAR; PG8_MMA(1, 0, At, B0); PG8_MMA(1, 1, At, B1); PG8_BAR; PG8_SCHED;
            } else {
            PG8_LDB(B0, 0, 0); PG8_SCHED; PG8_LDA(At, 0, 0); PG8_STAGE(PG8_SA(1, 1), a1 + hstep, voffA);
            PG8_WAIT_L(8); PG8_BAR; PG8_WAIT_L(0); PG8_MMA(0, 0, At, B0); PG8_BAR; PG8_SCHED;
            PG8_LDB(B1, 0, 1); PG8_STAGE(PG8_SB(0, 0), b2, voffB);
            PG8_BAR; PG8_WAIT_L(0); PG8_MMA(0, 1, At, B1); PG8_BAR;
            PG8_LDA(At, 0, 1); PG8_STAGE(PG8_SA(0, 0), a2, voffA);
            PG8_BAR; PG8_WAIT_L(0); PG8_MMA(1, 0, At, B0); PG8_BAR; PG8_SCHED;
            PG8_STAGE(PG8_SB(0, 1), b2 + hstep, voffB);
            PG8_WAIT_V(6); PG8_BAR; PG8_MMA(1, 1, At, B1); PG8_BAR;
            PG8_LDB(B0, 1, 0); PG8_SCHED; PG8_LDA(At, 1, 0); PG8_STAGE(PG8_SA(0, 1), a2 + hstep, voffA);
            PG8_WAIT_L(8); PG8_BAR; PG8_WAIT_L(0); PG8_MMA(0, 0, At, B0); PG8_BAR; PG8_SCHED;
            PG8_LDB(B1, 1, 1); PG8_STAGE(PG8_SB(1, 0), b3, voffB);
            PG8_BAR; PG8_WAIT_L(0); PG8_MMA(0, 1, At, B1); PG8_BAR;
            PG8_LDA(At, 1, 1); PG8_STAGE(PG8_SA(1, 0), a3, voffA);
            PG8_BAR; PG8_WAIT_L(0); PG8_MMA(1, 0, At, B0); PG8_BAR; PG8_SCHED;
            PG8_STAGE(PG8_SB(1, 1), b3 + hstep, voffB);
            PG8_WAIT_V(6); PG8_BAR; PG8_MMA(1, 1, At, B1); PG8_BAR;
            }
        }
        if constexpr (ALIGN_EPI) { if (wr == 0) PG8_BAR; }
        if constexpr (!Epi::AFTER_DRAIN) { E(acc, cur, wr, wc, fr, fq); S.done(cur); }
        if (!has_next) break;
#pragma unroll
        for (int a = 0; a < 2; ++a)
#pragma unroll
            for (int b = 0; b < 2; ++b)
#pragma unroll
                for (int m = 0; m < 4; ++m)
#pragma unroll
                    for (int n = 0; n < 2; ++n) acc[a][b][m][n] = (f32x4){0.f, 0.f, 0.f, 0.f};
        cur = nxt; cA = nA; cB = nB; ++ui;
        if constexpr (ALIGN_EPI) { if (wr == 1) PG8_BAR; }
    }
    PG8_WAIT_V(0);
    if constexpr (!ALIGN_EPI) { if (wr == 0) PG8_BAR; }
    PG8_BAR;
    if constexpr (Epi::AFTER_DRAIN) { E.fused(acc, cur, wr, wc, fr, fq, lds, wid, lane); S.done(cur); }
#undef PG8_SA
#undef PG8_SB
#undef PG8_STAGE
#undef PG8_LDA
#undef PG8_LDB
#undef PG8_MMA
#undef PG8_WAIT_V
#undef PG8_WAIT_L
#undef PG8_BAR
#undef PG8_SCHED
}
}

#ifndef PG8_SP2
#define PG8_SP2 true
#endif
#ifndef PG8_ALIGN
#define PG8_ALIGN true
#endif
#define XB_TMO      128
#define XB_XCNT(j)  (256  + 64 * (j))
#define XB_XSUB(j)  (1280 + 64 * (j))
#define XB_XGEN(j)  (2304 + 64 * (j))
#define XB_TOP      3328
#define XB_TOPGEN   3392
#define XCD_BAR_WORDS 3456
#define XB_SPIN_CAP (1u << 18)

__device__ __forceinline__ unsigned xb_ld(unsigned* p)              { return __hip_atomic_load(p, __ATOMIC_RELAXED, __HIP_MEMORY_SCOPE_AGENT); }
__device__ __forceinline__ unsigned xb_add(unsigned* p, unsigned v) { return __hip_atomic_fetch_add(p, v, __ATOMIC_RELAXED, __HIP_MEMORY_SCOPE_AGENT); }
__device__ __forceinline__ unsigned xb_xcc_id() { return (unsigned)__builtin_amdgcn_s_getreg((3 << 11) | 20) & 0xFu; }
#define XB_SPIN(cond, bar) do { unsigned _sp = 0; while (cond) { __builtin_amdgcn_s_sleep(1); \
    if ((++_sp & 255u) == 0u) { if (xb_ld(&(bar)[XB_TMO])) break; if (_sp > XB_SPIN_CAP) { atomicAdd(&(bar)[XB_TMO], 1u); break; } } } } while (0)

struct XcdBarrier {
    unsigned* bar; unsigned x;
    volatile LAS unsigned* st;
};

__device__ __forceinline__ XcdBarrier xcd_barrier_post(unsigned* bar, volatile LAS unsigned* st) {
    XcdBarrier b; b.bar = bar; b.x = xb_xcc_id(); b.st = st;
    if (threadIdx.x == 0) (void)xb_add(&bar[XB_XCNT(b.x)], 1u);
    return b;
}
__device__ __forceinline__ void xcd_barrier_complete(unsigned* bar, unsigned x, unsigned& nloc, unsigned& nx) {
    const unsigned G = gridDim.x * gridDim.y * gridDim.z;
    unsigned sum, cnt, mine, sp = 0u;
    for (;;) {
        sum = 0u; cnt = 0u; mine = 0u;
#pragma unroll
        for (unsigned j = 0; j < 16; ++j) { const unsigned c = xb_ld(&bar[XB_XCNT(j)]); sum += c; cnt += (c > 0u) ? 1u : 0u; mine = (j == x) ? c : mine; }
        if (sum == G) break;
        __builtin_amdgcn_s_sleep(1);
        if ((++sp & 255u) == 0u) { if (xb_ld(&bar[XB_TMO])) break; if (sp > XB_SPIN_CAP) { atomicAdd(&bar[XB_TMO], 1u); break; } }
    }
    nloc = mine > 0u ? mine : 1u; nx = cnt > 0u ? cnt : 1u;
}

__device__ __forceinline__ void xcd_barrier(const XcdBarrier& b, const bool is_t0  ) {
    asm volatile("s_waitcnt vmcnt(0)" ::: "memory");
    __syncthreads();
    if (is_t0) {
        unsigned* bar = b.bar;
        __builtin_amdgcn_s_waitcnt(0);
        unsigned nloc = b.st[0], nx = b.st[1];
        if (nloc == 0u) { xcd_barrier_complete(bar, b.x, nloc, nx); b.st[0] = nloc; b.st[1] = nx; }
        const unsigned old = xb_add(&bar[XB_XSUB(b.x)], 1u);
        const unsigned gen = old / nloc;
        if (old + 1u == (gen + 1u) * nloc) {
            __builtin_amdgcn_fence(__ATOMIC_RELEASE, "agent");
            asm volatile("s_waitcnt vmcnt(0)" ::: "memory");
            const unsigned og = xb_add(&bar[XB_TOP], 1u);
            const unsigned tg = og / nx;
            if (og + 1u == (tg + 1u) * nx) xb_add(&bar[XB_TOPGEN], 1u);
            else XB_SPIN(xb_ld(&bar[XB_TOPGEN]) == tg, bar);
            __builtin_amdgcn_fence(__ATOMIC_ACQUIRE, "agent");
            xb_add(&bar[XB_XGEN(b.x)], 1u);
            asm volatile("s_waitcnt vmcnt(0)" ::: "memory");
        } else {
            XB_SPIN(xb_ld(&bar[XB_XGEN(b.x)]) == gen, bar);
            __builtin_amdgcn_fence(__ATOMIC_ACQUIRE, "agent");
            asm volatile("s_waitcnt vmcnt(0)" ::: "memory");
        }
    }
    __syncthreads();
}
struct EpiResF32 {
    static constexpr bool PERM = true, AFTER_DRAIN = false;
    const float* xin; float* yp; float alpha;
    DI void operator()(const pg8::f32x4 (&acc)[2][2][4][2], const pg8::Unit& u, int wr, int wc, int fr, int fq) const {
        const int row0 = u.pm * 256 + wr * 64 + fr, col0 = u.pn * 256 + wc * 32 + 8 * fq;
#pragma unroll
        for (int ai = 0; ai < 2; ++ai)
#pragma unroll
            for (int m = 0; m < 4; ++m) {
                const size_t ro = (size_t)(row0 + ai * 128 + m * 16) * DM;
#pragma unroll
                for (int bj = 0; bj < 2; ++bj) {
                    const size_t o = ro + col0 + bj * 128;
                    const f32x4 x0 = *(const f32x4*)(xin + o), x1 = *(const f32x4*)(xin + o + 4);
                    *(f32x4*)(yp + o) = x0 * alpha + acc[ai][bj][m][0];
                    *(f32x4*)(yp + o + 4) = x1 * alpha + acc[ai][bj][m][1];
                }
            }
    }
};
struct EpiSwiglu {
    static constexpr bool PERM = true, AFTER_DRAIN = false;
    unsigned char* act; const float* bgu;
    DI void operator()(const pg8::f32x4 (&acc)[2][2][4][2], const pg8::Unit& u, int wr, int wc, int fr, int fq) const {
        const int e = u.pn >> 3, pl = u.pn & 7;
        const int row0 = u.pm * 256 + wr * 64 + fr, cih = pl * 128 + wc * 32 + 8 * fq;
        const float* bg = bgu + e * 2048 + cih;
        const f32x4 bg0 = *(const f32x4*)(bg), bg1 = *(const f32x4*)(bg + 4), bu0 = *(const f32x4*)(bg + 1024), bu1 = *(const f32x4*)(bg + 1028);
#pragma unroll
        for (int ai = 0; ai < 2; ++ai)
#pragma unroll
            for (int m = 0; m < 4; ++m) {
                constexpr float RS = 1.f / (F8_SX * F8_SWG);
                const f32x4 g0 = acc[ai][0][m][0] * RS + bg0, g1 = acc[ai][0][m][1] * RS + bg1, u0 = acc[ai][1][m][0] * RS + bu0, u1 = acc[ai][1][m][1] * RS + bu1;
                float r[8];
#pragma unroll
                for (int i = 0; i < 8; ++i) {
                    float g = i < 4 ? g0[i & 3] : g1[i & 3], uu = i < 4 ? u0[i & 3] : u1[i & 3];
                    g = fminf(g, 7.0f); uu = fminf(fmaxf(uu, -7.0f), 7.0f);
                    const float sg = __builtin_amdgcn_rcpf(1.0f + ex2(-1.702f * LOG2E * g));
                    r[i] = (uu + 1.0f) * g * sg * F8_SA;
                }
                v2u w; w.x = pk4_fp8(r[0], r[1], r[2], r[3]); w.y = pk4_fp8(r[4], r[5], r[6], r[7]);
                *(v2u*)(act + (size_t)(row0 + ai * 128 + m * 16) * DM + cih) = w;
            }
    }
};
struct EpiDown {
    static constexpr bool PERM = true, AFTER_DRAIN = false;
    bf16* yr; const float* bdn;
    DI void operator()(const pg8::f32x4 (&acc)[2][2][4][2], const pg8::Unit& u, int wr, int wc, int fr, int fq) const {
        const int e = u.pn >> 2, pl = u.pn & 3;
        const int row0 = u.pm * 256 + wr * 64 + fr, col0 = pl * 256 + wc * 32 + 8 * fq;
        f32x4 bv[2][2];
#pragma unroll
        for (int bj = 0; bj < 2; ++bj) { bv[bj][0] = *(const f32x4*)(bdn + e * 1024 + col0 + bj * 128); bv[bj][1] = *(const f32x4*)(bdn + e * 1024 + col0 + bj * 128 + 4); }
#pragma unroll
        for (int ai = 0; ai < 2; ++ai)
#pragma unroll
            for (int m = 0; m < 4; ++m) {
                bf16* rp = yr + (size_t)(row0 + ai * 128 + m * 16) * DM + col0;
#pragma unroll
                for (int bj = 0; bj < 2; ++bj) {
                    constexpr float RS = 1.f / (F8_SA * F8_SWD);
                    const f32x4 v0 = acc[ai][bj][m][0] * RS + bv[bj][0], v1 = acc[ai][bj][m][1] * RS + bv[bj][1];
                    v4u w; w.x = cvtpk(v0[0], v0[1]); w.y = cvtpk(v0[2], v0[3]); w.z = cvtpk(v1[0], v1[1]); w.w = cvtpk(v1[2], v1[3]);
                    *(v4u*)(rp + bj * 128) = w;
                }
            }
    }
};
struct GroupOrder {
    LAS const unsigned* tile_e; int ntiles, lg, G, c;
    DI bool next(int i, pg8::Unit& u) const {
        int pm, pl;
        if (G == 256) {
            const int x = c & 7, k = c >> 3; pm = i * (256 >> lg) + x * (32 >> lg) + (k >> lg); pl = k & ((1 << lg) - 1); if (pm >= ntiles) return false; }
        else { const long L = (long)i * G + c; if (L >= ((long)ntiles << lg)) return false; pm = (int)(L >> lg); pl = (int)(L & ((1 << lg) - 1)); }
        const int e = __builtin_amdgcn_readfirstlane((int)tile_e[pm]);
        u.pm = pm; u.pn = (e << lg) + pl; return true;
    }
    DI void a_ready(const pg8::Unit&) const {}
    DI void done(const pg8::Unit&) const {}
};
struct Args { const float* in[18]; float* out; unsigned char* ws; int ph_lo, ph_hi; };
struct Fr { LAS unsigned char* lds; unsigned char* ws; unsigned* ctl; int tid, lane, wave, blk, G; };

DI void tr_item(const float* W, int ldw, int K, int k0, int sc0, int nvalid, bf16* WT, int drow0, LAS float* scr, int lane) {
    const int c = lane & 31;
    float v[32];
#pragma unroll
    for (int i = 0; i < 32; ++i) v[i] = (c < nvalid) ? W[(size_t)(k0 + 2 * i + (lane >> 5)) * ldw + sc0 + c] : 0.f;
#pragma unroll
    for (int i = 0; i < 32; ++i) scr[(2 * i + (lane >> 5)) * 33 + c] = v[i];
    LDS_WAIT(); asm volatile("" ::: "memory");
    const int c8 = lane & 7;
#pragma unroll
    for (int j = 0; j < 4; ++j) { const int n = (lane >> 3) + 8 * j; const LAS float* s = scr + (8 * c8) * 33 + n;
        v4u o; o.x = cvtpk(s[0 * 33], s[1 * 33]); o.y = cvtpk(s[2 * 33], s[3 * 33]); o.z = cvtpk(s[4 * 33], s[5 * 33]); o.w = cvtpk(s[6 * 33], s[7 * 33]);
        *(v4u*)(WT + (size_t)(drow0 + n) * K + k0 + 8 * c8) = o; }
    LDS_WAIT(); asm volatile("" ::: "memory");
}
DI void tr_item8(const float* W, int ldw, int K, int k0, int sc0, float scale, unsigned char* WT8, int drow0, LAS float* scr, int lane) {
    const int c = lane & 31;
    float v[32];
#pragma unroll
    for (int i = 0; i < 32; ++i) v[i] = W[(size_t)(k0 + 2 * i + (lane >> 5)) * ldw + sc0 + c];
#pragma unroll
    for (int i = 0; i < 32; ++i) scr[(2 * i + (lane >> 5)) * 33 + c] = v[i] * scale;
    LDS_WAIT(); asm volatile("" ::: "memory");
    const int c16 = lane & 3;
#pragma unroll
    for (int j = 0; j < 2; ++j) { const int n = (lane >> 2) + 16 * j; const LAS float* s = scr + (16 * c16) * 33 + n;
        v4u o; o.x = pk4_fp8(s[0 * 33], s[1 * 33], s[2 * 33], s[3 * 33]); o.y = pk4_fp8(s[4 * 33], s[5 * 33], s[6 * 33], s[7 * 33]);
        o.z = pk4_fp8(s[8 * 33], s[9 * 33], s[10 * 33], s[11 * 33]); o.w = pk4_fp8(s[12 * 33], s[13 * 33], s[14 * 33], s[15 * 33]);
        *(v4u*)(WT8 + (size_t)(drow0 + n) * K + k0 + 16 * c16) = o; }
    LDS_WAIT(); asm volatile("" ::: "memory");
}
DI void ph_prologue(const Args& a, const Fr& F) {
    LAS float* scr = (LAS float*)(F.lds + F.wave * 16384);
    const int gw = F.blk * NWAVES + F.wave, NGW = F.G * NWAVES;
    constexpr int I_EV = 2 * 16 * 80, I_OD = 2 * 16 * 96, I_WO = 4 * 16 * 32;
    constexpr int NITEMS = I_EV + I_OD + I_WO;
    bf16* wev = (bf16*)(F.ws + WS_WEV); bf16* wod = (bf16*)(F.ws + WS_WOD); bf16* wout = (bf16*)(F.ws + WS_WOUT);
    unsigned char* wgu = F.ws + WS_WGU; unsigned char* wdn = F.ws + WS_WDN;
    for (int it = gw; it < NITEMS; it += NGW) {
        int r = it;
        if (r < I_EV) { const int l = r / 1280; r %= 1280; const int kb = r / 80, n0 = (r % 80) * 32; int sc0, nv = 32;
            if (n0 < 512) sc0 = n0; else if (n0 < 1024) sc0 = 964 + (n0 - 512); else if (n0 < 1536) sc0 = 1476 + (n0 - 1024); else if (n0 < 2048) sc0 = 1988 + (n0 - 1536);
            else if (n0 < 2176) sc0 = 512 + (n0 - 2048); else if (n0 < 2432) sc0 = 640 + (n0 - 2176); else if (n0 < 2496) sc0 = 896 + (n0 - 2432);
            else if (n0 < 2528) { sc0 = 960; nv = 4; } else { sc0 = 0; nv = 0; }
            tr_item(a.in[1] + (size_t)l * 1024 * 2500, 2500, 1024, kb * 64, sc0, nv, wev + (size_t)l * EV_N * 1024, n0, scr, F.lane); continue; }
        r -= I_EV;
        if (r < I_OD) { const int l = r / 1536; r %= 1536; const int kb = r / 96, n0 = (r % 96) * 32;
            tr_item(a.in[6] + (size_t)l * 1024 * 3088, 3088, 1024, kb * 64, n0, 32, wod + (size_t)l * OD_N * 1024, n0, scr, F.lane); continue; }
        r -= I_OD;
        if (r < I_WO) { const int l = r / 512; r %= 512; const int kb = r / 32, n0 = (r % 32) * 32;
            const float* src = (l & 1) ? a.in[8] + (size_t)(l >> 1) * 1024 * 1024 : a.in[5] + (size_t)(l >> 1) * 1024 * 1024;
            tr_item(src, 1024, 1024, kb * 64, n0, 32, wout + (size_t)l * 1024 * 1024, n0, scr, F.lane); continue; }
    }
    { __syncthreads();
        LAS float* tile = (LAS float*)F.lds; unsigned char* wgu8 = F.ws + WS_WGU; unsigned char* wdn8 = F.ws + WS_WDN;
        constexpr int T_GU = 128 * 8 * 16, T_DN = 128 * 8 * 8, T_ALL = T_GU + T_DN;
        const int tid = F.tid, c4 = tid & 31, r0 = tid >> 5;
        f32x4 v[8];
        auto locate = [&](int t, const float*& src, int& ldw, unsigned char*& dst, float& scale) {
            if (t < T_GU) { const int le = t >> 7, r = t & 127, kb = r >> 4, nb = r & 15, n0 = nb * 128; const int pn = n0 >> 8, bj = (n0 >> 7) & 1;
                src = a.in[14] + (size_t)le * 1024 * 2048 + (size_t)(kb * 128) * 2048 + bj * 1024 + pn * 128; ldw = 2048; dst = wgu8 + (size_t)le * 2048 * 1024 + (size_t)n0 * 1024 + kb * 128; scale = F8_SWG; }
            else { const int u = t - T_GU, le = u >> 6, r = u & 63, kb = r >> 3, nb = r & 7;
                src = a.in[16] + (size_t)le * 1024 * 1024 + (size_t)(kb * 128) * 1024 + nb * 128; ldw = 1024; dst = wdn8 + (size_t)le * 1024 * 1024 + (size_t)(nb * 128) * 1024 + kb * 128; scale = F8_SWD; } };
        int t = F.blk;
        if (t < T_ALL) { const float* src; int ldw; unsigned char* dst; float sc; locate(t, src, ldw, dst, sc);
#pragma unroll
            for (int i = 0; i < 8; ++i) v[i] = *(const f32x4*)(src + (size_t)(r0 + 16 * i) * ldw + 4 * c4); }
        for (; t < T_ALL; t += F.G) {
            const float* src; int ldw; unsigned char* dst; float sc; locate(t, src, ldw, dst, sc);
#pragma unroll
            for (int i = 0; i < 8; ++i) { LAS float* tp = tile + (r0 + 16 * i) * 129 + 4 * c4; tp[0] = v[i][0] * sc; tp[1] = v[i][1] * sc; tp[2] = v[i][2] * sc; tp[3] = v[i][3] * sc; }
            __syncthreads();
            if (t + F.G < T_ALL) { const float* s2; int l2; unsigned char* d2; float c2; locate(t + F.G, s2, l2, d2, c2);
#pragma unroll
                for (int i = 0; i < 8; ++i) v[i] = *(const f32x4*)(s2 + (size_t)(r0 + 16 * i) * l2 + 4 * c4); }
#pragma unroll
            for (int j = 0; j < 2; ++j) { const int p = tid + 512 * j, kc = p & 7, n = p >> 3; const LAS float* sp = tile + (kc * 16) * 129 + n;
                v4u o; o.x = pk4_fp8(sp[0], sp[129], sp[2 * 129], sp[3 * 129]); o.y = pk4_fp8(sp[4 * 129], sp[5 * 129], sp[6 * 129], sp[7 * 129]);
                o.z = pk4_fp8(sp[8 * 129], sp[9 * 129], sp[10 * 129], sp[11 * 129]); o.w = pk4_fp8(sp[12 * 129], sp[13 * 129], sp[14 * 129], sp[15 * 129]);
                *(v4u*)(dst + (size_t)n * 1024 + kc * 16) = o; }
            __syncthreads();
        }
    }
    bf16* xb = (bf16*)(F.ws + WS_XB);
    for (int m = gw; m < NTOK; m += NGW) {
        const f32x4* xr = (const f32x4*)(a.in[0] + (size_t)m * DM) + F.lane; v2u* o = (v2u*)(xb + (size_t)m * DM) + F.lane;
#pragma unroll
        for (int j = 0; j < 4; ++j) { const f32x4 v = xr[64 * j]; v2u w; w.x = cvtpk(v[0], v[1]); w.y = cvtpk(v[2], v[3]); o[64 * j] = w; }
    }
    bf16* wukt = (bf16*)(F.ws + WS_WUKT); bf16* wuvt = (bf16*)(F.ws + WS_WUVT);
    for (int i = F.blk * NTHR + F.tid; i < 2 * 8 * 128 * 64; i += F.G * NTHR) {
        { const int d = i & 63, c = (i >> 6) & 127, lh = i >> 13; wukt[i] = (bf16)f2bf(a.in[2][((size_t)lh * 64 + d) * 128 + c]); }
        { const int c = i & 127, d = (i >> 7) & 63, lh = i >> 13; wuvt[i] = (bf16)f2bf(a.in[3][((size_t)lh * 128 + c) * 64 + d]); }
    }
}

DI void ln_row(f32x4 (&v)[4], const float* g, const float* b, int lane) {
    float s = 0.f;
#pragma unroll
    for (int j = 0; j < 4; ++j) s += (v[j][0] + v[j][1]) + (v[j][2] + v[j][3]);
    const float mean = wave_sum(s) * (1.f / DM); float s2 = 0.f;
#pragma unroll
    for (int j = 0; j < 4; ++j) { v[j] = v[j] - mean; s2 += (v[j][0] * v[j][0] + v[j][1] * v[j][1]) + (v[j][2] * v[j][2] + v[j][3] * v[j][3]); }
    const float rstd = 1.f / sqrtf(wave_sum(s2) * (1.f / DM) + LN_EPS);
#pragma unroll
    for (int j = 0; j < 4; ++j) { const f32x4 gg = *((const f32x4*)g + lane + 64 * j), bb = *((const f32x4*)b + lane + 64 * j); v[j] = v[j] * rstd * gg + bb; }
}
DI void store_row_f32(float* p, const f32x4 (&v)[4], int lane) {
#pragma unroll
    for (int j = 0; j < 4; ++j) *((f32x4*)p + lane + 64 * j) = v[j];
}
DI void store_row_bf16(bf16* p, const f32x4 (&v)[4], int lane) {
#pragma unroll
    for (int j = 0; j < 4; ++j) { v2u w; w.x = cvtpk(v[j][0], v[j][1]); w.y = cvtpk(v[j][2], v[j][3]); *((v2u*)p + lane + 64 * j) = w; }
}
template <int NL> DI void small_proj(LAS const float* xs, const float* W, int ldw, int lane, float (&acc)[4]) {
    constexpr int PARTS = 64 / NL, DPER = 1024 / PARTS;
    const int n = lane & (NL - 1), part = lane / NL;
    acc[0] = acc[1] = acc[2] = acc[3] = 0.f;
    const float* wp = W + (size_t)(part * DPER) * ldw + n;
    LAS const float* xp = xs + part * DPER;
#pragma unroll 8
    for (int d = 0; d < DPER; ++d) { const float w = wp[(size_t)d * ldw];
        acc[0] += w * xp[d]; acc[1] += w * xp[1024 + d]; acc[2] += w * xp[2048 + d]; acc[3] += w * xp[3072 + d]; }
#pragma unroll
    for (int o = NL; o < 64; o <<= 1) {
#pragma unroll
        for (int k = 0; k < 4; ++k) acc[k] += __shfl_xor(acc[k], o); }
}

DI void ph_even_prep(const Args& a, const Fr& F, int j) {
    const bf16* proj = (const bf16*)(F.ws + WS_PROJ);
    bf16* ckvn = (bf16*)(F.ws + WS_CKVN); bf16* ql = (bf16*)(F.ws + WS_QL); float* kbar = (float*)(F.ws + WS_KBAR);
    const float* kvg = a.in[4] + j * 128;
    const bf16* wukt = (const bf16*)(F.ws + WS_WUKT) + (size_t)j * 8 * 128 * 64;
    const int lane = F.lane, wave = F.wave;
    for (int chunk = F.blk; chunk < 256; chunk += F.G) {
        const int tok0 = chunk * 128;
#pragma unroll 1
        for (int i0 = 0; i0 < 16; i0 += 8) { unsigned wv[8];
#pragma unroll
            for (int i = 0; i < 8; ++i) wv[i] = *((const unsigned*)(proj + (size_t)(tok0 + wave * 16 + i0 + i) * EV_N + EC_CKV) + lane);
#pragma unroll
            for (int i = 0; i < 8; ++i) { const int tok = tok0 + wave * 16 + i0 + i; const float v0 = bf2f(wv[i] & 0xffffu), v1 = bf2f(wv[i] >> 16);
                const float ss = wave_sum(v0 * v0 + v1 * v1);
                const float r = 1.f / sqrtf(ss * (1.f / 128.f) + LN_EPS);
                *((unsigned*)(ckvn + (size_t)tok * 128) + lane) = cvtpk(v0 * r * kvg[2 * lane], v1 * r * kvg[2 * lane + 1]); } }
        { bf16* kic = (bf16*)(F.ws + WS_KIC); const int tok = tok0 + wave * 16 + (lane >> 2), c = (lane & 3) * 16;
            const v4u* src = (const v4u*)(proj + (size_t)tok * EV_N + EC_KI + c); v4u* dst = (v4u*)(kic + (size_t)tok * 64 + c); dst[0] = src[0]; dst[1] = src[1]; }
        { const int h = wave, l15 = lane & 15, kg = lane >> 4;
            bf16x8 af[8][2];
#pragma unroll
            for (int ct = 0; ct < 8; ++ct)
#pragma unroll
                for (int ks = 0; ks < 2; ++ks) af[ct][ks] = *(const bf16x8*)(wukt + ((size_t)h * 128 + ct * 16 + l15) * 64 + ks * 32 + kg * 8);
#pragma unroll 1
            for (int tg = 0; tg < 8; tg += 4) { bf16x8 qf[4][2];
#pragma unroll
                for (int u = 0; u < 4; ++u)
#pragma unroll
                    for (int ks = 0; ks < 2; ++ks) qf[u][ks] = *(const bf16x8*)(proj + (size_t)(tok0 + (tg + u) * 16 + l15) * EV_N + EC_QA + h * 64 + ks * 32 + kg * 8);
#pragma unroll
                for (int u = 0; u < 4; ++u) { const int tok = tok0 + (tg + u) * 16 + l15;
#pragma unroll
                    for (int ct = 0; ct < 8; ++ct) { f32x4 d = {0.f, 0.f, 0.f, 0.f};
                        d = mfma16(af[ct][0], qf[u][0], d); d = mfma16(af[ct][1], qf[u][1], d);
                        v2u w; w.x = cvtpk(d[0], d[1]); w.y = cvtpk(d[2], d[3]);
                        *(v2u*)(ql + (size_t)tok * 1024 + h * 128 + ct * 16 + 4 * kg) = w; } } } }
        if (chunk < 128) { const int b = chunk >> 5, n = chunk & 31; float s8[8];
#pragma unroll
            for (int k = 0; k < 8; ++k) s8[k] = 0.f;
            const bf16* kp = proj + ((size_t)b * SEQ + n * 256 + wave * 32) * EV_N + EC_KB + lane * 8;
#pragma unroll 8
            for (int r = 0; r < 32; ++r) { const v4u w = *(const v4u*)(kp + (size_t)r * EV_N);
#pragma unroll
                for (int k = 0; k < 4; ++k) { s8[2 * k] += bf2f(w[k] & 0xffffu); s8[2 * k + 1] += bf2f(w[k] >> 16); } }
            LAS float* red = (LAS float*)F.lds;
            __syncthreads();
#pragma unroll
            for (int k = 0; k < 8; ++k) red[wave * 512 + lane * 8 + k] = s8[k];
            __syncthreads();
            float s = 0.f;
#pragma unroll
            for (int w = 0; w < 8; ++w) s += red[w * 512 + F.tid];
            const int h = F.tid >> 6, d = F.tid & 63;
            kbar[(((size_t)b * 8 + h) * 32 + n) * 64 + d] = s * (1.f / 256.f); }
    }
}

DI void moba_gate_chunk(const Fr& F, int chunk) {
    const bf16* proj = (const bf16*)(F.ws + WS_PROJ); const float* kbar = (const float*)(F.ws + WS_KBAR); unsigned* sel3 = (unsigned*)(F.ws + WS_SEL3);
    const int tok0 = chunk * 128, b = tok0 / SEQ, own = (tok0 % SEQ) >> 8, h = F.wave, lane = F.lane;
    float q0[64], q1[64];
    { const v4u* p0 = (const v4u*)(proj + (size_t)(tok0 + lane) * EV_N + EC_QB + h * 64); const v4u* p1 = (const v4u*)(proj + (size_t)(tok0 + 64 + lane) * EV_N + EC_QB + h * 64);
#pragma unroll
        for (int i = 0; i < 8; ++i) { const v4u w0 = p0[i], w1 = p1[i];
#pragma unroll
            for (int k = 0; k < 4; ++k) { q0[8 * i + 2 * k] = bf2f(w0[k] & 0xffffu); q0[8 * i + 2 * k + 1] = bf2f(w0[k] >> 16); q1[8 * i + 2 * k] = bf2f(w1[k] & 0xffffu); q1[8 * i + 2 * k + 1] = bf2f(w1[k] >> 16); } } }
    float a0 = -INFINITY, a1 = -INFINITY, a2 = -INFINITY, c0 = -INFINITY, c1 = -INFINITY, c2 = -INFINITY; int ai0 = 0, ai1 = 0, ai2 = 0, ci0 = 0, ci1 = 0, ci2 = 0;
    const float* kb = kbar + (((size_t)b * 8 + h) * 32) * 64;
    for (int n = 0; n < own; ++n) { float g0 = 0.f, g1 = 0.f;
#pragma unroll
        for (int d = 0; d < 64; d += 4) { const f32x4 kv = *(const f32x4*)(kb + n * 64 + d);
#pragma unroll
            for (int k = 0; k < 4; ++k) { g0 += q0[d + k] * kv[k]; g1 += q1[d + k] * kv[k]; } }
        if (g0 > a2) { if (g0 > a1) { a2 = a1; ai2 = ai1; if (g0 > a0) { a1 = a0; ai1 = ai0; a0 = g0; ai0 = n; } else { a1 = g0; ai1 = n; } } else { a2 = g0; ai2 = n; } }
        if (g1 > c2) { if (g1 > c1) { c2 = c1; ci2 = ci1; if (g1 > c0) { c1 = c0; ci1 = ci0; c0 = g1; ci0 = n; } else { c1 = g1; ci1 = n; } } else { c2 = g1; ci2 = n; } }
    }
    const unsigned nv = own < 3 ? own : 3;
    sel3[(size_t)(tok0 + lane) * 8 + h] = (unsigned)ai0 | ((unsigned)ai1 << 8) | ((unsigned)ai2 << 16) | (nv << 24);
    sel3[(size_t)(tok0 + 64 + lane) * 8 + h] = (unsigned)ci0 | ((unsigned)ci1 << 8) | ((unsigned)ci2 << 16) | (nv << 24);
}

constexpr int HS = 257;
DI float relu1(float x) { const unsigned u = __float_as_uint(x); return __uint_as_float(u & ~(unsigned)((int)u >> 31)); }
template <int MODE, bool DIAG> DI void idx_tile(const bf16x8 (&kf)[4], LAS const char* qb  , const float (&wj)[4], int kt, int q, int hi, unsigned c0, unsigned c1,
                                     LAS unsigned* hist, LAS unsigned* mask, LAS unsigned* cmask, LAS unsigned long long* cand, LAS unsigned* rinfo) {
    f32x2 scp[8];
#pragma unroll
    for (int p = 0; p < 8; ++p) scp[p] = (f32x2){0.f, 0.f};
    bf16x8 qv0[2][4], qv1[2][4];
#pragma unroll
    for (int j = 0; j < 2; ++j)
#pragma unroll
        for (int s = 0; s < 4; ++s) qv0[j][s] = *(LAS const bf16x8*)(qb + (j * 8 + s * 2) * 512);
#pragma unroll
    for (int j = 0; j < 2; ++j)
#pragma unroll
        for (int s = 0; s < 4; ++s) qv1[j][s] = *(LAS const bf16x8*)(qb + ((2 + j) * 8 + s * 2) * 512);
    __builtin_amdgcn_sched_barrier(0);
#pragma unroll
    for (int g = 0; g < 2; ++g) { f32x16 acc[2];
#pragma unroll
        for (int j = 0; j < 2; ++j)
#pragma unroll
            for (int r = 0; r < 16; ++r) acc[j][r] = 0.f;
#pragma unroll
        for (int s = 0; s < 4; ++s)
#pragma unroll
            for (int j = 0; j < 2; ++j) acc[j] = mfma32(kf[s], g == 0 ? qv0[j][s] : qv1[j][s], acc[j]);
#pragma unroll
        for (int p = 0; p < 8; ++p)
#pragma unroll
            for (int j = 0; j < 2; ++j) { const f32x2 a = {relu1(acc[j][2 * p]), relu1(acc[j][2 * p + 1])}; const f32x2 w2 = {wj[2 * g + j], wj[2 * g + j]}; scp[p] = a * w2 + scp[p]; } }
    unsigned sel = 0u, cnd = 0u;
    if (MODE == 0) { float t = 0.f;
#pragma unroll
        for (int p = 0; p < 8; ++p) t += scp[p][0] + scp[p][1];
        if (t == 12345.678f) __hip_atomic_fetch_or(mask + q * HS + kt, 1u, __ATOMIC_RELAXED, __HIP_MEMORY_SCOPE_WORKGROUP);
        return; }
    const float F0 = __uint_as_float(c0), F1 = __uint_as_float(c1);
#pragma unroll
    for (int r = 0; r < 16; ++r) { const int kr = crow(r, hi);
        const bool ok = !DIAG || kr <= q;
        const float scv = scp[r >> 1][r & 1]; const unsigned u = __float_as_uint(scv);
        if (MODE == 1) { const unsigned key = u ^ ((unsigned)((int)u >> 31) | 0x80000000u);
            if (ok && (key >> 24) >= c0) __hip_atomic_fetch_add(hist + q * HS + (key >> 24), 1u, __ATOMIC_RELAXED, __HIP_MEMORY_SCOPE_WORKGROUP); }
        else if (MODE == 2) { if (ok && (u >> 24) == c0) __hip_atomic_fetch_add(hist + q * HS + (((u >> 16) & 255u) ^ c1), 1u, __ATOMIC_RELAXED, __HIP_MEMORY_SCOPE_WORKGROUP); }
        else { const bool ge1 = scv >= F1, ge0 = scv >= F0;
            if (ok && ge1) sel |= 1u << kr;
            if (ok && ge0 && !ge1) { cnd |= 1u << kr; const unsigned key = u ^ ((unsigned)((int)u >> 31) | 0x80000000u);
                const unsigned pos = __hip_atomic_fetch_add(rinfo + 128 + q, 1u, __ATOMIC_RELAXED, __HIP_MEMORY_SCOPE_WORKGROUP);
                if (pos < 64u) cand[q * 64 + pos] = ((unsigned long long)key << 32) | (unsigned)(~(unsigned)(kt * 32 + kr)); } } }
    if (MODE == 3) { if (sel) __hip_atomic_fetch_or(mask + q * HS + kt, sel, __ATOMIC_RELAXED, __HIP_MEMORY_SCOPE_WORKGROUP);
        if (cnd) __hip_atomic_fetch_or(cmask + q * HS + kt, cnd, __ATOMIC_RELAXED, __HIP_MEMORY_SCOPE_WORKGROUP); }
}
template <int MODE> DI void idx_pass(const bf16* proj, int rowbase, int qt, LAS const char* qimg, const float (&wj)[4], LAS unsigned* hist, LAS unsigned* mask, LAS unsigned* cmask, LAS unsigned long long* cand, LAS unsigned* rinfo, int wave, int lane) {
    const int q = lane & 31, hi = lane >> 5, nkt = qt + 1;
    const unsigned b1 = MODE == 2 ? rinfo[160 + q] : rinfo[224 + q], thr16 = MODE == 2 ? rinfo[192 + q] : rinfo[256 + q];
    const bf16* kp0 = proj + (size_t)(rowbase + q) * 64 + hi * 8;
    LAS const char* qb = qimg + hi * 512 + q * 16;
    const int n = nkt > wave ? (nkt - wave + 7) >> 3 : 0;
    bf16x8 kfa[4], kfb[4];
#define IDX_LOAD(KF, I) do { const bf16* kp_ = kp0 + (size_t)((wave + 8 * (I)) * 32) * 64; _Pragma("unroll") for (int s_ = 0; s_ < 4; ++s_) KF[s_] = *(const bf16x8*)(kp_ + s_ * 16); } while (0)
#define IDX_TILE(KF, I) do { const int kt_ = wave + 8 * (I); if (kt_ == qt) idx_tile<MODE, true>(KF, qb, wj, kt_, q, hi, b1, thr16, hist, mask, cmask, cand, rinfo); \
        else idx_tile<MODE, false>(KF, qb, wj, kt_, q, hi, b1, thr16, hist, mask, cmask, cand, rinfo); } while (0)
    if (n > 0) IDX_LOAD(kfa, 0);
    for (int i = 0; i < n; i += 2) {
        if (i + 1 < n) IDX_LOAD(kfb, i + 1);
        IDX_TILE(kfa, i);
        if (i + 1 < n) { if (i + 2 < n) IDX_LOAD(kfa, i + 2); IDX_TILE(kfb, i + 1); }
    }
#undef IDX_LOAD
#undef IDX_TILE
}
DI void hist_pick(LAS const unsigned* hrow, unsigned need, int lane, unsigned& bin, unsigned& above) {
    unsigned h4[4];
#pragma unroll
    for (int k = 0; k < 4; ++k) h4[k] = hrow[4 * lane + k];
    const unsigned ssum = h4[0] + h4[1] + h4[2] + h4[3];
    unsigned x = ssum;
#pragma unroll
    for (int o = 1; o < 64; o <<= 1) { const unsigned y = __shfl_down(x, o); if (lane + o < 64) x += y; }
    const unsigned long long m = __ballot(x >= need);
    const int Ls = m ? 63 - __builtin_clzll(m) : 0;
    const unsigned xs = __shfl(x, Ls), ss = __shfl(ssum, Ls);
    const unsigned h0 = __shfl(h4[0], Ls), h1 = __shfl(h4[1], Ls), h2 = __shfl(h4[2], Ls), h3 = __shfl(h4[3], Ls);
    unsigned cum = xs - ss;
    if (cum + h3 >= need) { bin = 4 * Ls + 3; above = cum; return; } cum += h3;
    if (cum + h2 >= need) { bin = 4 * Ls + 2; above = cum; return; } cum += h2;
    if (cum + h1 >= need) { bin = 4 * Ls + 1; above = cum; return; } cum += h1;
    bin = 4 * Ls; above = cum; (void)h0;
}
DI void idx_pass1(const bf16* proj, int rowbase, int qt, LAS const char* qimg, const float (&wj)[4], LAS unsigned* hist, LAS unsigned* mask, LAS unsigned* cmask, LAS unsigned long long* cand, LAS unsigned* rinfo, int wave, int lane) {
    const int q = lane & 31, hi = lane >> 5, nkt = qt + 1, nmax = (nkt + 7) >> 3;
    const bf16* kp0 = proj + (size_t)(rowbase + q) * 64 + hi * 8;
    LAS const char* qb = qimg + hi * 512 + q * 16;
    unsigned lb = 0u;
    bf16x8 kfc[4], kfn[4];
    if (wave < nkt) {
#pragma unroll
        for (int s = 0; s < 4; ++s) kfc[s] = *(const bf16x8*)(kp0 + (size_t)(wave * 32) * 64 + s * 16); }
    for (int i = 0; i < nmax; ++i) { const int kt = wave + 8 * i;
        if (kt + 8 < nkt) {
#pragma unroll
            for (int s = 0; s < 4; ++s) kfn[s] = *(const bf16x8*)(kp0 + (size_t)((kt + 8) * 32) * 64 + s * 16); }
        if (kt < nkt) { if (kt == qt) idx_tile<1, true>(kfc, qb, wj, kt, q, hi, lb, 0u, hist, mask, cmask, cand, rinfo); else idx_tile<1, false>(kfc, qb, wj, kt, q, hi, lb, 0u, hist, mask, cmask, cand, rinfo); }
#pragma unroll
        for (int s = 0; s < 4; ++s) kfc[s] = kfn[s];
        if (((i + 1) & i) == 0 && i + 1 < nmax && i < 16) {
            __syncthreads();
#pragma unroll 1
            for (int rr = 0; rr < 4; ++rr) { const int row = wave * 4 + rr; unsigned bin, above; hist_pick(hist + row * HS, 256u, lane, bin, above);
                if (lane == 0) rinfo[288 + row] = bin; }
            __syncthreads();
            { const unsigned nb = rinfo[288 + q]; lb = nb > lb ? nb : lb; } }
    }
}
DI void idx_unit(const Fr& F, int b, int qt, int stop = 0  ) {
    const bf16* proj = (const bf16*)(F.ws + WS_PROJ); const bf16* kic = (const bf16*)(F.ws + WS_KIC); unsigned short* sel = (unsigned short*)(F.ws + WS_SEL);
    LAS unsigned* hist = (LAS unsigned*)(F.lds); LAS unsigned* mask = hist + 32 * HS; LAS unsigned* cmask = mask + 32 * HS;
    LAS unsigned long long* cand = (LAS unsigned long long*)(F.lds + 99328); LAS unsigned* rinfo = (LAS unsigned*)(F.lds + 115712);
    const int lane = F.lane, wave = F.wave, tid = F.tid, t0 = qt * 32, rowbase = b * SEQ;
    __syncthreads();
    for (int i = tid; i < 3 * 32 * HS; i += NTHR) hist[i] = 0u;
    if (tid < 320) rinfo[tid] = 0u;
    __syncthreads();
    if (t0 + 31 <= 255 || (EXPF & 64)) {
        if (lane < 8) {
#pragma unroll
            for (int rr = 0; rr < 4; ++rr) { const int row = wave * 4 + rr, nv = t0 + row + 1;
                const int nv0 = t0 + row + 1; const int nvc = nv0 < 256 ? nv0 : 256; (void)nv; mask[row * HS + lane] = nvc >= 32 * (lane + 1) ? 0xffffffffu : (nvc > 32 * lane ? ((1u << (nvc - 32 * lane)) - 1u) : 0u); } }
    } else {
        const int q = lane & 31;
        float wj[4];
        { const bf16* qp = proj + (size_t)(rowbase + t0 + q) * EV_N;
#pragma unroll
            for (int j = 0; j < 4; ++j) wj[j] = bf2f(qp[EC_WI + j]); }
        LAS char* qimg = (LAS char*)(F.lds + 117248);
#pragma unroll
        for (int i = 0; i < 2; ++i) { const int p = tid + i * NTHR, row = p & 31, c = p >> 5;
            *(LAS v4u*)(qimg + c * 512 + row * 16) = *(const v4u*)(proj + (size_t)(rowbase + t0 + row) * EV_N + EC_QI + c * 8); }
        __syncthreads();
        if (stop == 4) { idx_pass<0>(kic, rowbase, qt, qimg, wj, hist, mask, cmask, cand, rinfo, wave, lane); return; }
        idx_pass1(kic, rowbase, qt, qimg, wj, hist, mask, cmask, cand, rinfo, wave, lane);
        __syncthreads();
#pragma unroll 1
        for (int rr = 0; rr < 4; ++rr) { const int row = wave * 4 + rr; unsigned bin, above; hist_pick(hist + row * HS, 256u, lane, bin, above);
            if (lane == 0) { rinfo[row] = bin; rinfo[32 + row] = 256u - above; rinfo[160 + row] = bin >= 128u ? bin - 128u : 255u - bin; rinfo[192 + row] = bin >= 128u ? 0u : 255u; } }
        __syncthreads();
        if (stop == 1) return;
        for (int i = tid; i < 32 * HS; i += NTHR) hist[i] = 0u;
        __syncthreads();
        idx_pass<2>(kic, rowbase, qt, qimg, wj, hist, mask, cmask, cand, rinfo, wave, lane);
        __syncthreads();
#pragma unroll 1
        for (int rr = 0; rr < 4; ++rr) { const int row = wave * 4 + rr; const unsigned need1 = rinfo[32 + row]; unsigned bin, above; hist_pick(hist + row * HS, need1, lane, bin, above);
            if (lane == 0) { const unsigned t16 = (rinfo[row] << 8) | bin, k0 = t16 << 16, k1 = (t16 + 1u) << 16;
                rinfo[64 + row] = t16; rinfo[96 + row] = need1 - above;
                rinfo[224 + row] = (k0 & 0x80000000u) ? (k0 ^ 0x80000000u) : ~k0; rinfo[256 + row] = (t16 == 0xffffu) ? 0x7fc00000u : ((k1 & 0x80000000u) ? (k1 ^ 0x80000000u) : ~k1); } }
        __syncthreads();
        if (stop == 2) return;
        idx_pass<3>(kic, rowbase, qt, qimg, wj, hist, mask, cmask, cand, rinfo, wave, lane);
        __syncthreads();
        if (stop == 3) return;
#pragma unroll 1
        for (int rr = 0; rr < 4; ++rr) { const int row = wave * 4 + rr; const unsigned call = rinfo[128 + row], need2 = rinfo[96 + row];
            if (call <= 64u) { const unsigned c = call;
                const unsigned long long mine = cand[row * 64 + lane]; unsigned rank = 0u;
                for (unsigned k = 0; k < c; ++k) rank += (cand[row * 64 + k] > mine) ? 1u : 0u;
                if ((unsigned)lane < c && rank < need2) { const unsigned s = ~(unsigned)mine;
                    __hip_atomic_fetch_or(mask + row * HS + (s >> 5), 1u << (s & 31), __ATOMIC_RELAXED, __HIP_MEMORY_SCOPE_WORKGROUP); } }
            else { unsigned w4[4];
#pragma unroll
                for (int k = 0; k < 4; ++k) w4[k] = cmask[row * HS + 4 * lane + k];
                const unsigned cnt = __popc(w4[0]) + __popc(w4[1]) + __popc(w4[2]) + __popc(w4[3]);
                unsigned x = cnt;
#pragma unroll
                for (int o = 1; o < 64; o <<= 1) { const unsigned y = __shfl_up(x, o); if (lane >= o) x += y; }
                unsigned before = x - cnt;
#pragma unroll
                for (int k = 0; k < 4; ++k) { unsigned w = w4[k]; const unsigned pc = __popc(w); unsigned take = 0u;
                    if (before < need2) { if (before + pc <= need2) take = w; else { unsigned left = need2 - before; while (left) { const unsigned b = w & (0u - w); take |= b; w ^= b; --left; } } }
                    before += pc;
                    if (take) mask[row * HS + 4 * lane + k] |= take; } }
        }
    }
    __syncthreads();
#pragma unroll 1
    for (int rr = 0; rr < 4; ++rr) { const int row = wave * 4 + rr; unsigned short* out = sel + (size_t)(rowbase + t0 + row) * 256;
        unsigned w4[4];
#pragma unroll
        for (int k = 0; k < 4; ++k) w4[k] = mask[row * HS + 4 * lane + k];
        const unsigned cnt = __popc(w4[0]) + __popc(w4[1]) + __popc(w4[2]) + __popc(w4[3]);
        unsigned x = cnt;
#pragma unroll
        for (int o = 1; o < 64; o <<= 1) { const unsigned y = __shfl_up(x, o); if (lane >= o) x += y; }
        const unsigned total = __shfl(x, 63); unsigned pos = x - cnt;
#pragma unroll
        for (int k = 0; k < 4; ++k) { unsigned w = w4[k]; const unsigned base = (unsigned)(4 * lane + k) * 32u;
            while (w) { const unsigned bit = __builtin_ctz(w); if (pos < 256u) out[pos] = (unsigned short)(base + bit); ++pos; w &= w - 1u; } }
        for (unsigned i = total + lane; i < 256u; i += 64u) out[i] = (unsigned short)0xffffu; }
}

struct AttSt { float m, l; f32x16 o0, o1; };
template <class BF> DI void att_subtile(AttSt& S, const bf16x8 (&qf)[4], LAS const char* Kst, LAS const char* Vb, int vdh, int vrow0, int lane, const BF& bias) {
    const int r32 = lane & 31, hi = lane >> 5;
    f32x16 p;
#pragma unroll
    for (int r = 0; r < 16; ++r) p[r] = bias.b(crow(r, hi)) - S.m;
    LAS const char* kp = Kst + hi * 512 + r32 * 16;
#pragma unroll
    for (int s = 0; s < 4; ++s) { const bf16x8 kf = *(LAS const bf16x8*)(kp + s * 1024); p = mfma32(kf, qf[s], p); }
    if (bias.any) {
#pragma unroll
        for (int r = 0; r < 16; ++r) p[r] = bias.msk(crow(r, hi)) ? -INFINITY : p[r]; }
    float mxa[4] = {-INFINITY, -INFINITY, -INFINITY, -INFINITY};
#pragma unroll
    for (int r = 0; r < 16; ++r) mxa[r & 3] = fmaxf(mxa[r & 3], p[r]);
    float mx = fmaxf(fmaxf(mxa[0], mxa[1]), fmaxf(mxa[2], mxa[3]));
    mx = fmaxf(mx, __shfl_xor(mx, 32));
    if (__any(mx > 16.f)) { const float dl = fmaxf(mx, 0.f), sc = ex2(-dl); S.m += dl; S.l *= sc;
#pragma unroll
        for (int r = 0; r < 16; ++r) { p[r] -= dl; S.o0[r] *= sc; S.o1[r] *= sc; } }
    float psa[4] = {0.f, 0.f, 0.f, 0.f};
#pragma unroll
    for (int r = 0; r < 16; ++r) { p[r] = ex2(p[r]); psa[r & 3] += p[r]; }
    S.l += (psa[0] + psa[1]) + (psa[2] + psa[3]);
    v4u pw0, pw1;
    pw0.x = cvtpk(p[0], p[1]); pw0.y = cvtpk(p[2], p[3]); pw0.z = cvtpk(p[4], p[5]); pw0.w = cvtpk(p[6], p[7]);
    pw1.x = cvtpk(p[8], p[9]); pw1.y = cvtpk(p[10], p[11]); pw1.z = cvtpk(p[12], p[13]); pw1.w = cvtpk(p[14], p[15]);
    const bf16x8 pf0 = __builtin_bit_cast(bf16x8, pw0), pf1 = __builtin_bit_cast(bf16x8, pw1);
    LAS const char* vp = Vb + (vrow0 + 4 * hi + ((lane & 15) >> 2)) * 64 + ((lane >> 4) & 1) * 32 + (lane & 3) * 8;
    { const bf16x8 v00 = cat8(vtr(vp), vtr(vp + 512)), v10 = cat8(vtr(vp + vdh), vtr(vp + vdh + 512));
      const bf16x8 v01 = cat8(vtr(vp + 1024), vtr(vp + 1536)), v11 = cat8(vtr(vp + vdh + 1024), vtr(vp + vdh + 1536));
      S.o0 = mfma32(v00, pf0, S.o0); S.o1 = mfma32(v10, pf0, S.o1);
      S.o0 = mfma32(v01, pf1, S.o0); S.o1 = mfma32(v11, pf1, S.o1); }
}
template <class BF0, class BF1> DI void att_tile64(AttSt& S, const bf16x8 (&qf)[4], LAS const char* Kst, LAS const char* Vb, int vdh, int vrow0, int lane, const BF0& bias0, const BF1& bias1) {
    const int r32 = lane & 31, hi = lane >> 5;
    f32x16 p0, p1;
#pragma unroll
    for (int r = 0; r < 16; ++r) { p0[r] = bias0.b(crow(r, hi)) - S.m; p1[r] = bias1.b(crow(r, hi)) - S.m; }
    LAS const char* kp = Kst + hi * 512 + r32 * 16;
#pragma unroll
    for (int s = 0; s < 4; ++s) { const bf16x8 k0 = *(LAS const bf16x8*)(kp + s * 1024), k1 = *(LAS const bf16x8*)(kp + 4096 + s * 1024); p0 = mfma32(k0, qf[s], p0); p1 = mfma32(k1, qf[s], p1); }
    if (bias0.any) {
#pragma unroll
        for (int r = 0; r < 16; ++r) p0[r] = bias0.msk(crow(r, hi)) ? -INFINITY : p0[r]; }
    if (bias1.any) {
#pragma unroll
        for (int r = 0; r < 16; ++r) p1[r] = bias1.msk(crow(r, hi)) ? -INFINITY : p1[r]; }
    float mxa[4] = {-INFINITY, -INFINITY, -INFINITY, -INFINITY};
#pragma unroll
    for (int r = 0; r < 16; ++r) mxa[r & 3] = fmaxf(mxa[r & 3], fmaxf(p0[r], p1[r]));
    float mx = fmaxf(fmaxf(mxa[0], mxa[1]), fmaxf(mxa[2], mxa[3]));
    mx = fmaxf(mx, __shfl_xor(mx, 32));
    if (__any(mx > 16.f)) { const float dl = fmaxf(mx, 0.f), sc = ex2(-dl); S.m += dl; S.l *= sc;
#pragma unroll
        for (int r = 0; r < 16; ++r) { p0[r] -= dl; p1[r] -= dl; S.o0[r] *= sc; S.o1[r] *= sc; } }
    float psa[4] = {0.f, 0.f, 0.f, 0.f};
#pragma unroll
    for (int r = 0; r < 16; ++r) { p0[r] = ex2(p0[r]); p1[r] = ex2(p1[r]); psa[r & 3] += p0[r] + p1[r]; }
    S.l += (psa[0] + psa[1]) + (psa[2] + psa[3]);
    v4u a0, a1, b0, b1;
    a0.x = cvtpk(p0[0], p0[1]); a0.y = cvtpk(p0[2], p0[3]); a0.z = cvtpk(p0[4], p0[5]); a0.w = cvtpk(p0[6], p0[7]);
    a1.x = cvtpk(p0[8], p0[9]); a1.y = cvtpk(p0[10], p0[11]); a1.z = cvtpk(p0[12], p0[13]); a1.w = cvtpk(p0[14], p0[15]);
    b0.x = cvtpk(p1[0], p1[1]); b0.y = cvtpk(p1[2], p1[3]); b0.z = cvtpk(p1[4], p1[5]); b0.w = cvtpk(p1[6], p1[7]);
    b1.x = cvtpk(p1[8], p1[9]); b1.y = cvtpk(p1[10], p1[11]); b1.z = cvtpk(p1[12], p1[13]); b1.w = cvtpk(p1[14], p1[15]);
    LAS const char* vp = Vb + (vrow0 + 4 * hi + ((lane & 15) >> 2)) * 64 + ((lane >> 4) & 1) * 32 + (lane & 3) * 8;
#pragma unroll
    for (int k16 = 0; k16 < 4; ++k16) { const bf16x8 pf = __builtin_bit_cast(bf16x8, k16 == 0 ? a0 : k16 == 1 ? a1 : k16 == 2 ? b0 : b1);
        const bf16x8 v0 = cat8(vtr(vp + k16 * 1024), vtr(vp + k16 * 1024 + 512)), v1 = cat8(vtr(vp + vdh + k16 * 1024), vtr(vp + vdh + k16 * 1024 + 512));
        S.o0 = mfma32(v0, pf, S.o0); S.o1 = mfma32(v1, pf, S.o1); }
}

struct MobaFar { float c; bool any; DI float b(int) const { return c; } DI bool msk(int) const { return false; } };
struct MobaBias { LAS const float* lut; int tq, s0; bool any;
    DI float b(int kvrel) const { const int dist = tq - (s0 + kvrel); return lut[dist < 0 ? 0 : (dist > 1023 ? 1023 : dist)]; }
    DI bool msk(int kvrel) const { return tq - (s0 + kvrel) < 0; } };
DI void moba_qload(bf16x8 (&qf)[4], const bf16* proj, int rowbase, int h, int tq, int hi) {
    const bf16* qp = proj + (size_t)(rowbase + tq) * EV_N + EC_QB + h * 64 + hi * 8;
#pragma unroll
    for (int s = 0; s < 4; ++s) qf[s] = *(const bf16x8*)(qp + s * 16);
}
DI void moba_tile(const Fr& F, const bf16x8 (&qf)[4], int rowbase, int h, int n, int tq, bool valid, int slot, bool own, int wave_tile) {
    LAS const char* Kb = (LAS const char*)F.lds; LAS const char* Vb = (LAS const char*)(F.lds + 32768); LAS const float* lut = (LAS const float*)(F.lds + 98304);
    bf16* po = (bf16*)(F.ws + WS_ACT); float* pml = (float*)(F.ws + WS_PML);
    const int lane = F.lane, hi = lane >> 5;
    AttSt S; S.m = 0.f; S.l = 0.f;
#pragma unroll
    for (int r = 0; r < 16; ++r) { S.o0[r] = 0.f; S.o1[r] = 0.f; }
    const int nst = own ? wave_tile + 1 : 8;
    int tmin = tq;
#pragma unroll
    for (int o = 1; o < 64; o <<= 1) { const int y = __shfl_xor(tmin, o); tmin = y < tmin ? y : tmin; }
    const float cfar = lut[1023];
    int st = 0;
    for (; st + 1 < nst; st += 2) {
        if (!own && tmin - (n * 256 + st * 32 + 63) >= 790) { MobaFar bf{cfar, false}; att_tile64(S, qf, Kb + st * 4096, Vb, 16384, st * 32, lane, bf, bf); }
        else { MobaBias bf0{lut, tq, n * 256 + st * 32, false}, bf1{lut, tq, n * 256 + st * 32 + 32, own && st + 1 == wave_tile}; att_tile64(S, qf, Kb + st * 4096, Vb, 16384, st * 32, lane, bf0, bf1); } }
    if (st < nst) { MobaBias bf{lut, tq, n * 256 + st * 32, own && st == wave_tile}; att_subtile(S, qf, Kb + st * 4096, Vb, 16384, st * 32, lane, bf); }
    const float lt = S.l + __shfl_xor(S.l, 32), inv = 1.f / lt;
    if (valid) { const size_t pi = ((size_t)(rowbase + tq) * 8 + h) * 4 + slot; bf16* o = po + pi * 64;
#pragma unroll
        for (int a4 = 0; a4 < 4; ++a4) { v2u w0, w1;
            w0.x = cvtpk(S.o0[4 * a4] * inv, S.o0[4 * a4 + 1] * inv); w0.y = cvtpk(S.o0[4 * a4 + 2] * inv, S.o0[4 * a4 + 3] * inv);
            w1.x = cvtpk(S.o1[4 * a4] * inv, S.o1[4 * a4 + 1] * inv); w1.y = cvtpk(S.o1[4 * a4 + 2] * inv, S.o1[4 * a4 + 3] * inv);
            *(v2u*)(o + 8 * a4 + 4 * hi) = w0; *(v2u*)(o + 32 + 8 * a4 + 4 * hi) = w1; }
        if (hi == 0) { f32x2 ml = {S.m, lt}; *(f32x2*)(pml + pi * 2) = ml; } }
}
DI void moba_unit(const Args& a, const Fr& F, int b, int h, int n) {
    const bf16* proj = (const bf16*)(F.ws + WS_PROJ); const unsigned* sel3 = (const unsigned*)(F.ws + WS_SEL3);
    LAS unsigned char* lds = F.lds; LAS unsigned* list = (LAS unsigned*)(lds + 65536); LAS float* lut = (LAS float*)(lds + 98304); LAS unsigned* misc = (LAS unsigned*)(lds + 102400);
    const int tid = F.tid, lane = F.lane, wave = F.wave, rowbase = b * SEQ;
    __syncthreads();
    { const bf16* kg = proj + (size_t)(rowbase + n * 256) * EV_N + EC_KB + h * 64; const bf16* vg = proj + (size_t)(rowbase + n * 256) * EV_N + EC_VB + h * 64;
#pragma unroll
        for (int i = 0; i < 4; ++i) { const int p = tid + i * NTHR;
            { const int r = p & 31, c = (p >> 5) & 7, st = p >> 8; const v4u v = *(const v4u*)(kg + (size_t)(st * 32 + r) * EV_N + c * 8); *(LAS v4u*)(lds + st * 4096 + c * 512 + r * 16) = v; }
            { const int cc = p & 3, row = (p >> 2) & 255, dh = p >> 10; const v4u v = *(const v4u*)(vg + (size_t)row * EV_N + dh * 32 + cc * 8); *(LAS v4u*)(lds + 32768 + dh * 16384 + row * 64 + cc * 16) = v; } }
        for (int d = tid; d < 1024; d += NTHR) lut[d] = a.in[9][t5_bucket(d) * 16 + 8 + h] * LOG2E; }
    if (tid == 0) misc[16] = 0u;
    __syncthreads();
    unsigned sv[16];
#pragma unroll
    for (int k = 0; k < 16; ++k) { const int t = (n + 1) * 256 + k * NTHR + tid; sv[k] = t < SEQ ? sel3[(size_t)(rowbase + t) * 8 + h] : 0u; }
#pragma unroll
    for (int k = 0; k < 16; ++k) { const int tb = (n + 1) * 256 + k * NTHR; if (tb < SEQ) { const int t = tb + tid;
        const unsigned s = sv[k]; const unsigned nv = s >> 24; int slot = -1;
        if (nv > 0u && (s & 255u) == (unsigned)n) slot = 0; else if (nv > 1u && ((s >> 8) & 255u) == (unsigned)n) slot = 1; else if (nv > 2u && ((s >> 16) & 255u) == (unsigned)n) slot = 2;
        const unsigned long long bal = __ballot(slot >= 0); const unsigned wcnt = __popcll(bal);
        if (lane == 0) misc[wave] = wcnt;
        __syncthreads();
        unsigned off = misc[16], tot = 0u;
#pragma unroll
        for (int w = 0; w < 8; ++w) { const unsigned c = misc[w]; if (w < wave) off += c; tot += c; }
        if (slot >= 0) list[off + __popcll(bal & ((1ull << lane) - 1ull))] = ((unsigned)t << 2) | (unsigned)slot;
        __syncthreads();
        if (tid == 0) misc[16] += tot; } }
    __syncthreads();
    const int nlist = (int)misc[16];
    const int ntl = (nlist + 31) >> 5, hi = lane >> 5;
    bf16x8 qa[4], qb2[4];
    moba_qload(qa, proj, rowbase, h, n * 256 + wave * 32 + (lane & 31), hi);
    unsigned ea = 0u, eb = 0u; bool va = false, vb = false;
    int tl = wave;
    if (tl < ntl) { const int li = tl * 32 + (lane & 31); vb = li < nlist; eb = list[vb ? li : nlist - 1]; moba_qload(qb2, proj, rowbase, h, (int)(eb >> 2), hi); }
    moba_tile(F, qa, rowbase, h, n, n * 256 + wave * 32 + (lane & 31), true, 3, true, wave);
    for (; tl < ntl; tl += 16) {
        const int t2 = tl + 8, t3 = tl + 16;
        if (t2 < ntl) { const int li = t2 * 32 + (lane & 31); va = li < nlist; ea = list[va ? li : nlist - 1]; moba_qload(qa, proj, rowbase, h, (int)(ea >> 2), hi); }
        moba_tile(F, qb2, rowbase, h, n, (int)(eb >> 2), vb, (int)(eb & 3u), false, 0);
        if (t2 < ntl) {
            if (t3 < ntl) { const int li = t3 * 32 + (lane & 31); vb = li < nlist; eb = list[vb ? li : nlist - 1]; moba_qload(qb2, proj, rowbase, h, (int)(eb >> 2), hi); }
            moba_tile(F, qa, rowbase, h, n, (int)(ea >> 2), va, (int)(ea & 3u), false, 0); }
    }
}

DI void dsa_step(const bf16x8 (&af)[2][4], const bf16x8 (&qlf)[4], int ch, LAS const unsigned char* bsel, LAS unsigned char* cbuf, LAS const float* tab,
                 float& m, float& l, f32x4 (&oT)[8], int l15, int kg, int lane) {
    f32x4 acc[2];
#pragma unroll
    for (int mt = 0; mt < 2; ++mt) { const unsigned b4 = *(LAS const unsigned*)(bsel + ch * 32 + mt * 16 + 4 * kg);
#pragma unroll
        for (int i = 0; i < 4; ++i) { const unsigned bb = (b4 >> (8 * i)) & 255u; acc[mt][i] = bb != 255u ? tab[bb * 8 + (l15 & 7)] - m : -INFINITY; } }
#pragma unroll
    for (int mt = 0; mt < 2; ++mt)
#pragma unroll
        for (int ks = 0; ks < 4; ++ks) { acc[mt] = mfma16(af[mt][ks], qlf[ks], acc[mt]); *(LAS bf16x8*)(cbuf + (mt * 16 + l15) * 288 + (ks * 32 + kg * 8) * 2) = af[mt][ks]; }
    float mx = fmaxf(fmaxf(fmaxf(acc[0][0], acc[0][1]), fmaxf(acc[0][2], acc[0][3])), fmaxf(fmaxf(acc[1][0], acc[1][1]), fmaxf(acc[1][2], acc[1][3])));
    mx = fmaxf(mx, __shfl_xor(mx, 16)); mx = fmaxf(mx, __shfl_xor(mx, 32));
    if (__any(mx > 16.f)) { const float dl = fmaxf(mx, 0.f), sc = ex2(-dl); m += dl; l *= sc;
#pragma unroll
        for (int mt = 0; mt < 2; ++mt) acc[mt] = acc[mt] - dl;
#pragma unroll
        for (int ct = 0; ct < 8; ++ct) oT[ct] = oT[ct] * sc; }
    float ps = 0.f;
#pragma unroll
    for (int mt = 0; mt < 2; ++mt)
#pragma unroll
        for (int i = 0; i < 4; ++i) { acc[mt][i] = ex2(acc[mt][i]); ps += acc[mt][i]; }
    l += ps;
    v4u pw; pw.x = cvtpk(acc[0][0], acc[0][1]); pw.y = cvtpk(acc[0][2], acc[0][3]); pw.z = cvtpk(acc[1][0], acc[1][1]); pw.w = cvtpk(acc[1][2], acc[1][3]);
    const bf16x8 pf = __builtin_bit_cast(bf16x8, pw);
    LDS_WAIT();
    LAS const char* tp = (LAS const char*)cbuf + (4 * kg + (l15 >> 2)) * 288 + (lane & 3) * 8;
#pragma unroll
    for (int ct = 0; ct < 8; ++ct) { const bf16x8 cf = cat8(vtr(tp + ct * 32), vtr(tp + 16 * 288 + ct * 32)); oT[ct] = mfma16(cf, pf, oT[ct]); }
    LDS_WAIT();
}
DI void dsa_gather(bf16x8 (&af)[2][4], const bf16* ckvn, int rowbase, LAS const unsigned short* selb, int ch, int l15, int kg) {
#pragma unroll
    for (int mt = 0; mt < 2; ++mt) { unsigned idx = selb[ch * 32 + mt * 16 + l15]; if (idx == 0xffffu) idx = 0u;
        const bf16* cp = ckvn + (size_t)(rowbase + (int)idx) * 128 + kg * 8;
#pragma unroll
        for (int ks = 0; ks < 4; ++ks) af[mt][ks] = *(const bf16x8*)(cp + ks * 32); }
}
DI void dsa_query(const Fr& F, int tok, const v2u sv, LAS unsigned char* wl, LAS const unsigned char* bkt, LAS const float* tab) {
    const bf16* ql = (const bf16*)(F.ws + WS_QL); const bf16* ckvn = (const bf16*)(F.ws + WS_CKVN); const unsigned short* sel = (const unsigned short*)(F.ws + WS_SEL); bf16* ol = (bf16*)(F.ws + WS_OL);
    const int lane = F.lane, l15 = lane & 15, kg = lane >> 4, t = tok % SEQ, rowbase = tok - t;
    LAS unsigned short* selb = (LAS unsigned short*)wl; LAS unsigned char* bsel = wl + 512; LAS unsigned char* cbuf = wl + 1024;
    { *((LAS v2u*)selb + lane) = sv; unsigned bw = 0u;
#pragma unroll
        for (int i = 0; i < 4; ++i) { const unsigned s = (i < 2 ? (sv.x >> (16 * i)) : (sv.y >> (16 * (i - 2)))) & 0xffffu; const int dist = t - (int)s;
            const unsigned bb = (s != 0xffffu && dist >= 0) ? (unsigned)bkt[dist > 1023 ? 1023 : dist] : 255u; bw |= bb << (8 * i); }
        *((LAS unsigned*)bsel + lane) = bw; }
    bf16x8 qlf[4];
#pragma unroll
    for (int ks = 0; ks < 4; ++ks) { qlf[ks] = *(const bf16x8*)(ql + (size_t)tok * 1024 + (l15 & 7) * 128 + ks * 32 + kg * 8); if (l15 >= 8) qlf[ks] = (bf16x8){0, 0, 0, 0, 0, 0, 0, 0}; }
    float m = 0.f, l = 0.f; f32x4 oT[8];
#pragma unroll
    for (int ct = 0; ct < 8; ++ct) oT[ct] = (f32x4){0.f, 0.f, 0.f, 0.f};
    const int nvalid = t + 1 < 256 ? t + 1 : 256, nch = (nvalid + 31) >> 5;
    LDS_WAIT();
    bf16x8 afa[2][4], afb[2][4], afc[2][4];
    dsa_gather(afa, ckvn, rowbase, selb, 0, l15, kg);
    if (nch > 1) dsa_gather(afb, ckvn, rowbase, selb, 1, l15, kg);
    for (int ch = 0; ch < nch; ch += 3) {
        if (ch + 2 < nch) dsa_gather(afc, ckvn, rowbase, selb, ch + 2, l15, kg);
        dsa_step(afa, qlf, ch, bsel, cbuf, tab, m, l, oT, l15, kg, lane);
        if (ch + 1 < nch) { if (ch + 3 < nch) dsa_gather(afa, ckvn, rowbase, selb, ch + 3, l15, kg);
            dsa_step(afb, qlf, ch + 1, bsel, cbuf, tab, m, l, oT, l15, kg, lane); }
        if (ch + 2 < nch) { if (ch + 4 < nch) dsa_gather(afb, ckvn, rowbase, selb, ch + 4, l15, kg);
            dsa_step(afc, qlf, ch + 2, bsel, cbuf, tab, m, l, oT, l15, kg, lane); }
    }
    l += __shfl_xor(l, 16); l += __shfl_xor(l, 32);
    const float inv = 1.f / l;
    if (l15 < 8) { bf16* o = ol + (size_t)tok * 1024 + l15 * 128 + 4 * kg;
#pragma unroll
        for (int ct = 0; ct < 8; ++ct) { v2u w; w.x = cvtpk(oT[ct][0] * inv, oT[ct][1] * inv); w.y = cvtpk(oT[ct][2] * inv, oT[ct][3] * inv); *(v2u*)(o + ct * 16) = w; } }
}
DI void dsa_chunk(const Args& a, const Fr& F, int c32) {
    LAS unsigned char* bkt = F.lds + 81920; LAS float* tab = (LAS float*)(F.lds + 82944);
    __syncthreads();
    for (int d = F.tid; d < 1024; d += NTHR) bkt[d] = (unsigned char)t5_bucket(d);
    if (F.tid < 256) tab[F.tid] = a.in[9][(F.tid >> 3) * 16 + (F.tid & 7)] * LOG2E;
    __syncthreads();
    const unsigned short* selg = (const unsigned short*)(F.ws + WS_SEL); v2u svq[4];
#pragma unroll
    for (int i = 0; i < 4; ++i) svq[i] = *((const v2u*)(selg + (size_t)(c32 * 32 + F.wave * 4 + i) * 256) + F.lane);
#pragma unroll
    for (int i = 0; i < 4; ++i) dsa_query(F, c32 * 32 + F.wave * 4 + i, svq[i], F.lds + F.wave * 10240, bkt, tab);
}

DI void ph_even_post(const Fr& F, int j) {
    const bf16* ol = (const bf16*)(F.ws + WS_OL); bf16* ao = (bf16*)(F.ws + WS_AO);
    const bf16* wuvt = (const bf16*)(F.ws + WS_WUVT) + (size_t)j * 8 * 64 * 128;
    const bf16* po = (const bf16*)(F.ws + WS_ACT); const float* pml = (const float*)(F.ws + WS_PML); const unsigned* sel3 = (const unsigned*)(F.ws + WS_SEL3);
    const int lane = F.lane, wave = F.wave, l15 = lane & 15, kg = lane >> 4;
    for (int chunk = F.blk; chunk < 256; chunk += F.G) { const int tok0 = chunk * 128;
        { const int h = wave; bf16x8 af[4][4];
#pragma unroll
            for (int mt = 0; mt < 4; ++mt)
#pragma unroll
                for (int ks = 0; ks < 4; ++ks) af[mt][ks] = *(const bf16x8*)(wuvt + ((size_t)h * 64 + mt * 16 + l15) * 128 + ks * 32 + kg * 8);
#pragma unroll 1
            for (int tg = 0; tg < 8; tg += 2) { bf16x8 bf[2][4];
#pragma unroll
                for (int u = 0; u < 2; ++u)
#pragma unroll
                    for (int ks = 0; ks < 4; ++ks) bf[u][ks] = *(const bf16x8*)(ol + (size_t)(tok0 + (tg + u) * 16 + l15) * 1024 + h * 128 + ks * 32 + kg * 8);
#pragma unroll
                for (int u = 0; u < 2; ++u) { const int tok = tok0 + (tg + u) * 16 + l15;
#pragma unroll
                    for (int mt = 0; mt < 4; ++mt) { f32x4 d = {0.f, 0.f, 0.f, 0.f};
#pragma unroll
                        for (int ks = 0; ks < 4; ++ks) d = mfma16(af[mt][ks], bf[u][ks], d);
                        v2u w; w.x = cvtpk(d[0], d[1]); w.y = cvtpk(d[2], d[3]); *(v2u*)(ao + (size_t)tok * 1024 + h * 64 + mt * 16 + 4 * kg) = w; } } } }
#pragma unroll 1
        for (int i0 = 0; i0 < 16; i0 += 4) { const int h = lane >> 3, d0 = (lane & 7) * 8; unsigned nvv[4]; f32x2 mlv[4][4];
#pragma unroll
            for (int i = 0; i < 4; ++i) { const int tok = tok0 + wave * 16 + i0 + i; const size_t pi = ((size_t)tok * 8 + h) * 4; nvv[i] = sel3[(size_t)tok * 8 + h] >> 24;
#pragma unroll
                for (int s = 0; s < 4; ++s) mlv[i][s] = *(const f32x2*)(pml + (pi + s) * 2); }
#pragma unroll
            for (int i = 0; i < 4; ++i) { const int tok = tok0 + wave * 16 + i0 + i; const size_t pi = ((size_t)tok * 8 + h) * 4;
                float mj[4], lj[4];
#pragma unroll
                for (int s = 0; s < 4; ++s) { const bool ok = (s == 3) || ((unsigned)s < nvv[i]); mj[s] = ok ? mlv[i][s][0] : -1e30f; lj[s] = ok ? mlv[i][s][1] : 0.f; }
                const float ms = fmaxf(fmaxf(mj[0], mj[1]), fmaxf(mj[2], mj[3])); float wsum = 0.f, acc[8], wv[4]; v4u pv[4];
#pragma unroll
                for (int k = 0; k < 8; ++k) acc[k] = 0.f;
#pragma unroll
                for (int s = 0; s < 4; ++s) { wv[s] = lj[s] * ex2(mj[s] - ms); wsum += wv[s]; pv[s] = (v4u){0u, 0u, 0u, 0u}; if (wv[s] > 0.f) pv[s] = *(const v4u*)(po + (pi + s) * 64 + d0); }
#pragma unroll
                for (int s = 0; s < 4; ++s) { if (wv[s] > 0.f) {
#pragma unroll
                    for (int k = 0; k < 4; ++k) { acc[2 * k] += wv[s] * bf2f(pv[s][k] & 0xffffu); acc[2 * k + 1] += wv[s] * bf2f(pv[s][k] >> 16); } } }
                const float inv = 1.f / wsum; v4u o; o.x = cvtpk(acc[0] * inv, acc[1] * inv); o.y = cvtpk(acc[2] * inv, acc[3] * inv); o.z = cvtpk(acc[4] * inv, acc[5] * inv); o.w = cvtpk(acc[6] * inv, acc[7] * inv);
                *(v4u*)(ao + (size_t)tok * 1024 + 512 + h * 64 + d0) = o; } }
    }
}
DI f32x16 proj32_f32(const float* W, int ldw, int ncols, const float* xrow, int d_lo, int lane) {
    const int e = lane & 31, kh = lane >> 5; const bool ev = e < ncols;
    f32x16 D;
#pragma unroll
    for (int r = 0; r < 16; ++r) D[r] = 0.f;
    const float* wp = W + (size_t)(d_lo + 4 * kh) * ldw + (ev ? e : 0);
    const float* xp = xrow + d_lo + 4 * kh;
#pragma unroll 8
    for (int i = 0; i < 64; ++i) { const f32x4 xv = *(const f32x4*)(xp + 8 * i);
        float a0 = wp[(size_t)(8 * i + 0) * ldw], a1 = wp[(size_t)(8 * i + 1) * ldw], a2 = wp[(size_t)(8 * i + 2) * ldw], a3 = wp[(size_t)(8 * i + 3) * ldw];
        if (!ev) { a0 = 0.f; a1 = 0.f; a2 = 0.f; a3 = 0.f; }
        D = __builtin_amdgcn_mfma_f32_32x32x2f32(a0, xv[0], D, 0, 0, 0); D = __builtin_amdgcn_mfma_f32_32x32x2f32(a1, xv[1], D, 0, 0, 0);
        D = __builtin_amdgcn_mfma_f32_32x32x2f32(a2, xv[2], D, 0, 0, 0); D = __builtin_amdgcn_mfma_f32_32x32x2f32(a3, xv[3], D, 0, 0, 0); }
    return D;
}
DI void ph_odd_prep(const Args& a, const Fr& F, int j, int layer) {
    const bf16* proj = (const bf16*)(F.ws + WS_PROJ); const float* x = (const float*)(F.ws + WS_X);
    float* logf = (float*)(F.ws + WS_LOGF); float* cs = (float*)(F.ws + WS_CS);
    const float* wf = a.in[6] + (size_t)j * 1024 * 3088 + 3072; const float* bfv = a.in[7] + j * 16;
    LAS float* red = (LAS float*)(F.lds); LAS float* lfb = (LAS float*)(F.lds + 131072);
    LAS unsigned* kmx = (LAS unsigned*)(F.lds + 131072 + 8192);
    const int lane = F.lane, wave = F.wave, tid = F.tid, l31 = lane & 31, hi = lane >> 5;
    for (int chunk = F.blk; chunk < 256; chunk += F.G) { const int tok0 = chunk * 128, b = tok0 / SEQ, t0 = tok0 % SEQ;
        __syncthreads();
        if (tid < 16) kmx[tid] = 0u;
        const int tl = wave & 3, kr = wave >> 2;
        f32x16 D = proj32_f32(wf, 3088, 16, x + (size_t)(tok0 + tl * 32 + l31) * DM, kr * 512, lane);
        if (kr == 1) {
#pragma unroll
            for (int r = 0; r < 8; ++r) red[(tl * 8 + r) * 64 + lane] = D[r]; }
        __syncthreads();
        if (kr == 0) {
#pragma unroll
            for (int r = 0; r < 8; ++r) { const int h = (r & 3) + 8 * (r >> 2) + 4 * hi; const float z = D[r] + red[(tl * 8 + r) * 64 + lane] + bfv[h];
                const float ls = fminf(z, 0.f) - log1pf(__expf(-fabsf(z)));
                lfb[(tl * 32 + l31) * 16 + h] = ls * LOG2E; } }
#pragma unroll 1
        for (int i = 0; i < 4; ++i) { const int p = tid + i * NTHR, tk = p >> 4, h = p & 15; const v4u* kp = (const v4u*)(proj + (size_t)(tok0 + tk) * OD_N + OC_K + h * 64); float s = 0.f;
#pragma unroll
            for (int c = 0; c < 8; ++c) { const v4u w = kp[c];
#pragma unroll
                for (int k = 0; k < 4; ++k) { const float e0 = bf2f(w[k] & 0xffffu), e1 = bf2f(w[k] >> 16); s += e0 * e0 + e1 * e1; } }
            __hip_atomic_fetch_max(kmx + h, __float_as_uint(s), __ATOMIC_RELAXED, __HIP_MEMORY_SCOPE_WORKGROUP); }
        __syncthreads();
        for (int i = tid; i < 2048; i += NTHR) { const int h = i >> 7, tk = i & 127; logf[((size_t)b * 16 + h) * SEQ + t0 + tk] = lfb[tk * 16 + h]; }
        if (tid < 32) { const int h = tid & 15, c = tid >> 4; float s = 0.f;
            for (int k = 0; k < 64; ++k) s += lfb[(c * 64 + k) * 16 + h];
            cs[((size_t)b * 16 + h) * 128 + (t0 >> 6) + c] = s; }
        if (tid < 16) __hip_atomic_fetch_max(F.ctl + CW_KMAX + layer * 64 + b * 16 + tid, kmx[tid], RLX_AGENT);
    }
}

constexpr float FOX_SKIP_LOG2 = 64.f;
struct FoxBias { LAS const float* ng; int tq, kabs0; bool any;
    DI float b(int kvrel) const { return ng[kvrel]; }
    DI bool msk(int kvrel) const { return (kabs0 + kvrel) > tq; } };
DI void fox_unit(const Fr& F, int layer, int b, int h, int qb) {
    const bf16* proj = (const bf16*)(F.ws + WS_PROJ); const float* logf = (const float*)(F.ws + WS_LOGF); const float* cs = (const float*)(F.ws + WS_CS); bf16* ao = (bf16*)(F.ws + WS_AO);
    LAS unsigned char* lds = F.lds; LAS float* ng = (LAS float*)(lds + 32768); LAS float* red = (LAS float*)(lds + 65536 + 1024); LAS int* ibox = (LAS int*)(lds + 65536 + 2048);
    const int tid = F.tid, lane = F.lane, wave = F.wave, r32 = lane & 31, hi = lane >> 5, t0 = qb * 256, rowbase = b * SEQ, tq = t0 + wave * 32 + r32;
    __syncthreads();
    bf16x8 qf[4]; float qs = 0.f;
    { const bf16* qp = proj + (size_t)(rowbase + tq) * OD_N + OC_Q + h * 64 + hi * 8;
#pragma unroll
        for (int s = 0; s < 4; ++s) { qf[s] = *(const bf16x8*)(qp + s * 16);
#pragma unroll
            for (int k = 0; k < 8; ++k) { const float e = bf2f((unsigned short)qf[s][k]); qs += e * e; } } }
    qs += __shfl_xor(qs, 32); qs = wave_max(qs);
    if (lane == 0) red[wave] = qs;
    if (tid < 128) red[32 + tid] = (tid < t0 / 64) ? cs[((size_t)b * 16 + h) * 128 + tid] : 0.f;
    __syncthreads();
    if (tid == 0) { float qm = red[0];
        for (int w = 1; w < 8; ++w) qm = fmaxf(qm, red[w]);
        const float km = __uint_as_float(ld_u32(F.ctl + CW_KMAX + layer * 64 + b * 16 + h));
        const float B2 = 2.f * (sqrtf(qm * km) * 1.01f + 1.f);
        int kt = t0 / 64 - 1, kts = t0 / 64; float D = 0.f;
        while (kt >= 0 && B2 + D >= -FOX_SKIP_LOG2) { kts = kt; D += red[32 + kt]; --kt; }
        ibox[0] = kts; }
    __syncthreads();
    const int kts = ibox[0], s_start = kts * 64, nel = t0 + 256 - s_start;
    { const int i0 = tid * 16; float v[16]; const float* lp = logf + ((size_t)b * 16 + h) * SEQ + s_start + i0;
        if (i0 < nel) {
#pragma unroll
            for (int c = 0; c < 4; ++c) { const f32x4 w = *(const f32x4*)(lp + 4 * c); v[4 * c] = w[0]; v[4 * c + 1] = w[1]; v[4 * c + 2] = w[2]; v[4 * c + 3] = w[3]; } }
        else {
#pragma unroll
            for (int c = 0; c < 16; ++c) v[c] = 0.f; }
#pragma unroll
        for (int c = 1; c < 16; ++c) v[c] += v[c - 1];
        float xsum = v[15];
#pragma unroll
        for (int o = 1; o < 64; o <<= 1) { const float y = __shfl_up(xsum, o); if (lane >= o) xsum += y; }
        if (lane == 63) red[16 + wave] = xsum;
        __syncthreads();
        float off = xsum - v[15];
        for (int w = 0; w < wave; ++w) off += red[16 + w];
        if (i0 < nel) {
#pragma unroll
            for (int c = 0; c < 4; ++c) { f32x4 w = {-(off + v[4 * c]), -(off + v[4 * c + 1]), -(off + v[4 * c + 2]), -(off + v[4 * c + 3])}; *(LAS f32x4*)(ng + i0 + 4 * c) = w; } }
    }
    const int ntile = t0 / 64 + 4 - kts;
    const bf16* kg = proj + (size_t)rowbase * OD_N + OC_K + h * 64; const bf16* vg = proj + (size_t)rowbase * OD_N + OC_V + h * 64;
    const int kr = tid & 31, kc = (tid >> 5) & 7, kst = tid >> 8, vcc = tid & 3, vrow = (tid >> 2) & 63, vdh = tid >> 8;
    const int koff = kst * 4096 + kc * 512 + kr * 16, voff = 8192 + vdh * 4096 + vrow * 64 + vcc * 16;
    { const v4u kv = *(const v4u*)(kg + (size_t)(kts * 64 + kst * 32 + kr) * OD_N + kc * 8), vv = *(const v4u*)(vg + (size_t)(kts * 64 + vrow) * OD_N + vdh * 32 + vcc * 8);
        *(LAS v4u*)(lds + koff) = kv; *(LAS v4u*)(lds + voff) = vv; }
    __syncthreads();
    AttSt S; S.m = 0.f; S.l = 0.f;
#pragma unroll
    for (int r = 0; r < 16; ++r) { S.o0[r] = 0.f; S.o1[r] = 0.f; }
    const int wlast = t0 + wave * 32 + 31, wfirst = t0 + wave * 32;
    for (int i = 0; i < ntile; ++i) { const int kt = kts + i; LAS unsigned char* buf = lds + (i & 1) * 16384; LAS unsigned char* nbuf = lds + ((i + 1) & 1) * 16384;
        v4u kv, vv; const bool more = i + 1 < ntile;
        if (more) { kv = *(const v4u*)(kg + (size_t)((kt + 1) * 64 + kst * 32 + kr) * OD_N + kc * 8); vv = *(const v4u*)(vg + (size_t)((kt + 1) * 64 + vrow) * OD_N + vdh * 32 + vcc * 8); }
        { const int kv0 = kt * 64;
            if (kv0 + 32 <= wlast) { FoxBias bf0{ng + (kv0 - s_start), tq, kv0, kv0 + 31 > wfirst}, bf1{ng + (kv0 + 32 - s_start), tq, kv0 + 32, kv0 + 63 > wfirst};
                att_tile64(S, qf, (LAS const char*)buf, (LAS const char*)buf + 8192, 4096, 0, lane, bf0, bf1); }
            else if (kv0 <= wlast) { FoxBias bf{ng + (kv0 - s_start), tq, kv0, kv0 + 31 > wfirst};
                att_subtile(S, qf, (LAS const char*)buf, (LAS const char*)buf + 8192, 4096, 0, lane, bf); } }
        if (more) { *(LAS v4u*)(nbuf + koff) = kv; *(LAS v4u*)(nbuf + voff - 8192 + 8192) = vv; }
        __syncthreads(); }
    const float lt = S.l + __shfl_xor(S.l, 32), inv = 1.f / lt;
    bf16* o = ao + (size_t)(rowbase + tq) * 1024 + h * 64;
#pragma unroll
    for (int a4 = 0; a4 < 4; ++a4) { v2u w0, w1;
        w0.x = cvtpk(S.o0[4 * a4] * inv, S.o0[4 * a4 + 1] * inv); w0.y = cvtpk(S.o0[4 * a4 + 2] * inv, S.o0[4 * a4 + 3] * inv);
        w1.x = cvtpk(S.o1[4 * a4] * inv, S.o1[4 * a4 + 1] * inv); w1.y = cvtpk(S.o1[4 * a4 + 2] * inv, S.o1[4 * a4 + 3] * inv);
        *(v2u*)(o + 8 * a4 + 4 * hi) = w0; *(v2u*)(o + 32 + 8 * a4 + 4 * hi) = w1; }
}

DI void ph_ln1_router(const Args& a, const Fr& F, int layer) {
    const float* yp = (const float*)(F.ws + WS_YP); float* x1 = (float*)(F.ws + WS_X1); unsigned char* xb8 = F.ws + WS_XB8;
    unsigned* tope = (unsigned*)(F.ws + WS_TOPE); float* gate = (float*)(F.ws + WS_GATE); unsigned* rank = (unsigned*)(F.ws + WS_RANK);
    const float* g = a.in[10] + (size_t)(layer * 2) * DM; const float* bb = a.in[11] + (size_t)(layer * 2) * DM;
    const float* rw = a.in[12] + (size_t)layer * 1024 * 32; const float* rb = a.in[13] + layer * 32;
    LAS float* red = (LAS float*)(F.lds); LAS unsigned* lcnt = (LAS unsigned*)(F.lds + 131072);
    const int lane = F.lane, wave = F.wave, tid = F.tid, l31 = lane & 31, hi = lane >> 5;
    for (int chunk = F.blk; chunk < 256; chunk += F.G) { const int tok0 = chunk * 128;
        __syncthreads();
        if (tid < 32) lcnt[tid] = 0u;
#pragma unroll 1
        for (int k = 0; k < 16; k += 8) { f32x4 v[8][4];
#pragma unroll
            for (int i = 0; i < 8; ++i)
#pragma unroll
                for (int jj = 0; jj < 4; ++jj) v[i][jj] = *((const f32x4*)(yp + (size_t)(tok0 + wave * 16 + k + i) * DM) + lane + 64 * jj);
#pragma unroll
            for (int i = 0; i < 8; ++i) { const int tok = tok0 + wave * 16 + k + i;
                ln_row(v[i], g, bb, lane);
                store_row_f32(x1 + (size_t)tok * DM, v[i], lane);
#pragma unroll
                for (int jj = 0; jj < 4; ++jj) *((unsigned*)(xb8 + (size_t)tok * DM) + lane + 64 * jj) = pk4_fp8(v[i][jj][0] * F8_SX, v[i][jj][1] * F8_SX, v[i][jj][2] * F8_SX, v[i][jj][3] * F8_SX); } }
        asm volatile("s_waitcnt vmcnt(0)" ::: "memory");
        __syncthreads();
        const int tl = wave & 3, kr = wave >> 2, tokl = tok0 + tl * 32 + l31;
        f32x16 D = proj32_f32(rw, 32, 32, x1 + (size_t)tokl * DM, kr * 512, lane);
        if (kr == 1) {
#pragma unroll
            for (int r = 0; r < 16; ++r) red[(tl * 16 + r) * 64 + lane] = D[r]; }
        __syncthreads();
        if (kr == 0) {
            float lv[32];
#pragma unroll
            for (int r = 0; r < 16; ++r) { const float own = D[r] + red[(tl * 16 + r) * 64 + lane] + rb[crow(r, hi)]; const float oth = __shfl_xor(own, 32);
                lv[crow(r, 0)] = hi == 0 ? own : oth; lv[crow(r, 1)] = hi == 0 ? oth : own; }
            float tv[4]; int te[4];
#pragma unroll
            for (int r = 0; r < 4; ++r) { float mx = -INFINITY; int me = 0;
#pragma unroll
                for (int e = 0; e < 32; ++e) { if (lv[e] > mx) { mx = lv[e]; me = e; } }
                tv[r] = mx; te[r] = me;
#pragma unroll
                for (int e = 0; e < 32; ++e) { if (e == me) lv[e] = -INFINITY; } }
            const float e1 = __expf(tv[1] - tv[0]), e2 = __expf(tv[2] - tv[0]), e3 = __expf(tv[3] - tv[0]); const float inv = 1.f / (1.f + e1 + e2 + e3);
            if (hi == 0) { const size_t o = (size_t)tokl * 4;
                const float gv[4] = {inv, e1 * inv, e2 * inv, e3 * inv};
#pragma unroll
                for (int r = 0; r < 4; ++r) { const unsigned rk = __hip_atomic_fetch_add(lcnt + (te[r] & 31), 1u, __ATOMIC_RELAXED, __HIP_MEMORY_SCOPE_WORKGROUP);
                    tope[o + r] = (unsigned)(te[r] & 31); gate[o + r] = gv[r]; rank[o + r] = rk; } } }
        __syncthreads();
        if (tid < 32) __hip_atomic_store(F.ctl + CW_CNT + chunk * 32 + tid, lcnt[tid], RLX_AGENT);
    }
}

DI void ph_route(const Fr& F) {
    const unsigned char* xb8 = F.ws + WS_XB8; unsigned char* xg = F.ws + WS_XG;
    const unsigned* tope = (const unsigned*)(F.ws + WS_TOPE); const unsigned* rank = (const unsigned*)(F.ws + WS_RANK); unsigned* dest = (unsigned*)(F.ws + WS_DEST);
    LAS unsigned* P = (LAS unsigned*)(F.lds); LAS unsigned* pst = P + 512; LAS unsigned* pad = P + 544; LAS unsigned* base = P + 576; LAS unsigned* nt = P + 608;
    const int tid = F.tid, lane = F.lane, wave = F.wave;
    __syncthreads();
    { const int e = tid & 31, part = tid >> 5; unsigned s = 0u;
        for (int c = 0; c < 16; ++c) s += ld_u32(F.ctl + CW_CNT + (part * 16 + c) * 32 + e);
        P[part * 32 + e] = s; }
    __syncthreads();
    if (tid < 32) { unsigned tot = 0u;
        for (int p = 0; p < 16; ++p) tot += P[p * 32 + tid];
        pad[tid] = (tot + 255u) & ~255u; }
    __syncthreads();
    if (tid == 0) { unsigned acc = 0u;
        for (int e = 0; e < 32; ++e) { pst[e] = acc; acc += pad[e]; }
        nt[0] = acc >> 8; }
    __syncthreads();
    for (int chunk = F.blk; chunk < 256; chunk += F.G) {
        __syncthreads();
        if (tid < 32) { unsigned off = 0u; const int pf = chunk >> 4;
            for (int p = 0; p < pf; ++p) off += P[p * 32 + tid];
            for (int c = pf * 16; c < chunk; ++c) off += ld_u32(F.ctl + CW_CNT + c * 32 + tid);
            base[tid] = pst[tid] + off; }
        __syncthreads();
#pragma unroll 1
        for (int i0 = 0; i0 < 16; i0 += 4) { v4u src[4]; unsigned ee[4][4], rr[4][4];
#pragma unroll
            for (int i = 0; i < 4; ++i) { const int tok = chunk * 128 + wave * 16 + i0 + i; src[i] = *((const v4u*)(xb8 + (size_t)tok * DM) + lane);
#pragma unroll
                for (int k = 0; k < 4; ++k) { ee[i][k] = tope[(size_t)tok * 4 + k]; rr[i][k] = rank[(size_t)tok * 4 + k]; } }
#pragma unroll
            for (int i = 0; i < 4; ++i) { const int tok = chunk * 128 + wave * 16 + i0 + i;
#pragma unroll
                for (int k = 0; k < 4; ++k) { const unsigned d = base[ee[i][k]] + rr[i][k];
                    if (lane == 0) dest[(size_t)tok * 4 + k] = d;
                    *((v4u*)(xg + (size_t)d * DM) + lane) = src[i]; } } }
        if (chunk == 0) { const unsigned ntl = nt[0];
            if (tid == 0) __hip_atomic_store(F.ctl + CW_TILE, ntl, RLX_AGENT);
            for (unsigned i = tid; i < ntl; i += NTHR) { unsigned e = 0u;
                for (unsigned k = 1; k < 32; ++k) if (pst[k] <= i * 256u) e = k;
                __hip_atomic_store(F.ctl + CW_TILE + 64 + i, e, RLX_AGENT); } }
    }
}

DI void ph_combine_ln2(const Args& a, const Fr& F, int layer) {
    const float* x1 = (const float*)(F.ws + WS_X1); const bf16* yr = (const bf16*)(F.ws + WS_XG); float* xo = (float*)(F.ws + WS_X); bf16* xb = (bf16*)(F.ws + WS_XB);
    const float* gate = (const float*)(F.ws + WS_GATE); const unsigned* dest = (const unsigned*)(F.ws + WS_DEST);
    const float* g = a.in[10] + (size_t)(layer * 2 + 1) * DM; const float* bb = a.in[11] + (size_t)(layer * 2 + 1) * DM;
    const int lane = F.lane; const int gw = F.blk * NWAVES + F.wave, NGW = F.G * NWAVES;
    for (int tok = gw; tok < NTOK; tok += 4 * NGW) { f32x4 v[4][4];
#pragma unroll
        for (int i = 0; i < 4; ++i) { const int tk = tok + i * NGW; if (tk < NTOK) {
#pragma unroll
            for (int jj = 0; jj < 4; ++jj) v[i][jj] = *((const f32x4*)(x1 + (size_t)tk * DM) + lane + 64 * jj) * ALPHA;
#pragma unroll
            for (int k = 0; k < 4; ++k) { const float gk = gate[(size_t)tk * 4 + k]; const unsigned d = dest[(size_t)tk * 4 + k];
#pragma unroll
                for (int jj = 0; jj < 4; ++jj) { const v2u w = *((const v2u*)(yr + (size_t)d * DM) + lane + 64 * jj);
                    v[i][jj][0] += gk * bf2f(w.x & 0xffffu); v[i][jj][1] += gk * bf2f(w.x >> 16); v[i][jj][2] += gk * bf2f(w.y & 0xffffu); v[i][jj][3] += gk * bf2f(w.y >> 16); } } } }
#pragma unroll
        for (int i = 0; i < 4; ++i) { const int tk = tok + i * NGW; if (tk < NTOK) {
            ln_row(v[i], g, bb, lane);
            if (layer == DEPTH - 1) store_row_f32(a.out + (size_t)tk * DM, v[i], lane);
            else { store_row_f32(xo + (size_t)tk * DM, v[i], lane); store_row_bf16(xb + (size_t)tk * DM, v[i], lane); } } } }
}
constexpr int LDS_BYTES = 147456;
constexpr int LDS_BARW = 145408, LDS_QSLOT = 145472, LDS_TILE_E = 133632;
constexpr int NPL = 11;
constexpr int NPHASE = 1 + NPL * DEPTH;
#ifndef MK_SINGLE
#define MK_SINGLE 1
#endif
DI int q_next(const Fr& F, unsigned* ctr) {
    LAS int* slot = (LAS int*)(F.lds + LDS_QSLOT);
    __syncthreads();
    if (F.tid == 0) *slot = (int)__hip_atomic_fetch_add(ctr, 1u, RLX_AGENT);
    __syncthreads();
    return *slot;
}
DI int lane_id_fresh() { unsigned m_ = ~0u; asm volatile("" : "+s"(m_)); return (int)__builtin_amdgcn_mbcnt_hi(m_, __builtin_amdgcn_mbcnt_lo(m_, 0u)); }
#define RETID(F) do { int t2_ = F.tid; asm volatile("" : "+v"(t2_)); F.tid = t2_; F.lane = t2_ & 63; F.wave = __builtin_amdgcn_readfirstlane(t2_ >> 6); } while (0)
#ifndef PROBE_DUP
#define PROBE_DUP -1
#endif
#define NREP(q) ((PROBE_DUP == (q)) ? 2 : 1)
#define AS4 __attribute__((address_space(4)))
#define SITE() Args a; Fr F; { const AS4 Args* ap = (const AS4 Args*)__builtin_amdgcn_kernarg_segment_ptr(); asm volatile("" : "+s"(ap)); \
        _Pragma("unroll") for (int i_ = 0; i_ < 18; ++i_) a.in[i_] = ap->in[i_]; a.out = ap->out; a.ws = ap->ws; a.ph_lo = 0; a.ph_hi = 0; \
        int w_ = wv_s; asm volatile("" : "+s"(w_)); int t_ = w_ * 64 + lane_id_fresh(); asm volatile("" : "+v"(t_)); F.tid = t_; F.lane = t_ & 63; F.wave = __builtin_amdgcn_readfirstlane(t_ >> 6); \
        F.lds = (LAS unsigned char*)lds_raw; F.ws = a.ws; F.ctl = (unsigned*)(a.ws + WS_CTL); F.blk = blockIdx.x; F.G = gridDim.x; }
__global__ void __launch_bounds__(NTHR, 2) mega_fwd(Args a0) {
    extern __shared__ __attribute__((aligned(16))) unsigned char lds_raw[];
    const int wv_s = __builtin_amdgcn_readfirstlane((int)(threadIdx.x >> 6));
#if MK_SINGLE
    constexpr int lo = 0, hi = NPHASE; constexpr bool single = true;
#else
    const int lo = a0.ph_lo, hi = a0.ph_hi; constexpr bool single = false;
#endif
    if (threadIdx.x == 0) *(LAS v4u*)((LAS unsigned char*)lds_raw + LDS_BARW) = (v4u){0u, 0u, 0u, 0u};
    __syncthreads();
    if (single) (void)xcd_barrier_post((unsigned*)(a0.ws + WS_CTL) + CW_BAR, (volatile LAS unsigned*)((LAS unsigned char*)lds_raw + LDS_BARW));
#define IN(k) (lo <= (k) && (k) < hi)
#define SEAM() do { if (single) { const AS4 Args* ap_ = (const AS4 Args*)__builtin_amdgcn_kernarg_segment_ptr(); asm volatile("" : "+s"(ap_)); int w_ = wv_s; asm volatile("" : "+s"(w_)); \
        XcdBarrier b_; b_.bar = (unsigned*)(ap_->ws + WS_CTL) + CW_BAR; b_.x = xb_xcc_id(); b_.st = (volatile LAS unsigned*)((LAS unsigned char*)lds_raw + LDS_BARW); \
        xcd_barrier(b_, (w_ == 0) && (lane_id_fresh() == 0)); } } while (0)
    if (IN(0)) { _Pragma("unroll 1") for (int rep = 0; rep < NREP(100); ++rep) { { SITE(); ph_prologue(a, F); } SEAM(); } }
#pragma unroll 1
    for (int L = 0; L < DEPTH; ++L) {
        const int pb = 1 + NPL * L, j = L >> 1; const bool odd = (L & 1) != 0;
        if (IN(pb + 0)) _Pragma("unroll 1") for (int rep = 0; rep < NREP(0); ++rep) {
            { SITE();
            const bf16* w = odd ? (const bf16*)(F.ws + WS_WOD) + (size_t)j * OD_N * 1024 : (const bf16*)(F.ws + WS_WEV) + (size_t)j * EV_N * 1024;
            const int N = odd ? OD_N : EV_N;
            pg8::Gemm g{(const bf16*)(F.ws + WS_XB), w, NTOK, N, 1024}; pg8::StaticOrder S; S.init(NTOK, N, F.G, F.blk);
            pg8::EpiBf16<0> E{(bf16*)(F.ws + WS_PROJ), N, nullptr, 1024, (size_t)1024, C2F};
            pg8::gemm_phase<pg8::EpiBf16<0>, pg8::StaticOrder, true, true>(F.lds, g, S, E, F.tid); }
            SEAM(); }
        if (IN(pb + 1)) _Pragma("unroll 1") for (int rep = 0; rep < NREP(1); ++rep) { { SITE(); if (odd) ph_odd_prep(a, F, j, L); else ph_even_prep(a, F, j); } SEAM(); }
        if (!odd && IN(pb + 2)) _Pragma("unroll 1") for (int rep = 0; rep < ((PROBE_DUP == 2 || (PROBE_DUP >= 21 && PROBE_DUP <= 22) || (PROBE_DUP >= 211 && PROBE_DUP <= 214)) ? 2 : 1); ++rep) {
            { SITE(); unsigned* ctr = F.ctl + CW_Q + 64 * (L * 2) + 1024 * rep;
            for (;;) { const int it = q_next(F, ctr); if (it >= 1280) break; RETID(F);
                if (it < 1024) { if (!(rep == 1 && PROBE_DUP == 22)) idx_unit(F, it & 3, 255 - (it >> 2), (rep == 1 && PROBE_DUP >= 211) ? PROBE_DUP - 210 : 0); } else { if (!(rep == 1 && (PROBE_DUP == 21 || PROBE_DUP >= 211))) moba_gate_chunk(F, it - 1024); } } }
            SEAM(); }
        if (IN(pb + 3)) _Pragma("unroll 1") for (int rep = 0; rep < ((PROBE_DUP == 3 || (PROBE_DUP == 31 && odd) || ((PROBE_DUP == 32 || PROBE_DUP == 33) && !odd)) ? 2 : 1); ++rep) {
            { SITE(); unsigned* ctr = F.ctl + CW_Q + 64 * (L * 2 + 1) + 1024 * rep;
            if (odd) { for (;;) { const int it = q_next(F, ctr); if (it >= 2048) break; RETID(F); const int bh = it & 63; fox_unit(F, L, bh >> 4, bh & 15, 31 - (it >> 6)); } }
            else { for (;;) { const int it = q_next(F, ctr); if (it >= 2048) break; RETID(F);
                    if (it < 1024) { const int bh = it & 31; if (!(rep == 1 && PROBE_DUP == 33)) moba_unit(a, F, bh >> 3, bh & 7, it >> 5); } else { if (!(rep == 1 && PROBE_DUP == 32)) dsa_chunk(a, F, it - 1024); } } } }
            SEAM(); }
        if (!odd && IN(pb + 4)) _Pragma("unroll 1") for (int rep = 0; rep < NREP(4); ++rep) { { SITE(); ph_even_post(F, j); } SEAM(); }
        if (IN(pb + 5)) _Pragma("unroll 1") for (int rep = 0; rep < NREP(5); ++rep) {
            { SITE();
            const float* xin = (L == 0) ? a.in[0] : (const float*)(F.ws + WS_X);
            pg8::Gemm g{(const bf16*)(F.ws + WS_AO), (const bf16*)(F.ws + WS_WOUT) + (size_t)L * 1024 * 1024, NTOK, 1024, 1024}; pg8::StaticOrder S; S.init(NTOK, 1024, F.G, F.blk);
            EpiResF32 E{xin, (float*)(F.ws + WS_YP), ALPHA};
            pg8::gemm_phase<EpiResF32, pg8::StaticOrder, true, true>(F.lds, g, S, E, F.tid); }
            SEAM(); }
        if (IN(pb + 6)) _Pragma("unroll 1") for (int rep = 0; rep < NREP(6); ++rep) { { SITE(); ph_ln1_router(a, F, L); } SEAM(); }
        if (IN(pb + 7)) _Pragma("unroll 1") for (int rep = 0; rep < NREP(7); ++rep) { { SITE(); ph_route(F); } SEAM(); }
        if (IN(pb + 8)) _Pragma("unroll 1") for (int rep = 0; rep < NREP(8); ++rep) {
            { SITE(); const int ntl = (int)ld_u32(F.ctl + CW_TILE);
            LAS unsigned* tle = (LAS unsigned*)(F.lds + LDS_TILE_E);
            for (int i = F.tid; i < ntl; i += NTHR) tle[i] = ld_u32(F.ctl + CW_TILE + 64 + i);
            __syncthreads();
            pg8::Gemm g{(const bf16*)(F.ws + WS_XG), (const bf16*)(F.ws + WS_WGU + (size_t)L * 32 * 2048 * 1024), NR_MAX, 32 * 2048, 512};
            GroupOrder S{tle, ntl, 3, F.G, F.blk};
            EpiSwiglu E{F.ws + WS_ACT, a.in[15] + (size_t)L * 32 * 2048};
            pg8::gemm_phase<EpiSwiglu, GroupOrder, true, true, true>(F.lds, g, S, E, F.tid); }
            SEAM(); }
        if (IN(pb + 9)) _Pragma("unroll 1") for (int rep = 0; rep < NREP(9); ++rep) {
            { SITE(); const int ntl = (int)ld_u32(F.ctl + CW_TILE);
            LAS unsigned* tle = (LAS unsigned*)(F.lds + LDS_TILE_E);
            for (int i = F.tid; i < ntl; i += NTHR) tle[i] = ld_u32(F.ctl + CW_TILE + 64 + i);
            __syncthreads();
            pg8::Gemm g{(const bf16*)(F.ws + WS_ACT), (const bf16*)(F.ws + WS_WDN + (size_t)L * 32 * 1024 * 1024), NR_MAX, 32 * 1024, 512};
            GroupOrder S{tle, ntl, 2, F.G, F.blk};
            EpiDown E{(bf16*)(F.ws + WS_XG), a.in[17] + (size_t)L * 32 * 1024};
            pg8::gemm_phase<EpiDown, GroupOrder, true, true, true>(F.lds, g, S, E, F.tid); }
            SEAM(); }
        if (IN(pb + 10)) _Pragma("unroll 1") for (int rep = 0; rep < NREP(10); ++rep) { { SITE(); ph_combine_ln2(a, F, L); } if (L + 1 < DEPTH || rep + 1 < NREP(10)) SEAM(); }
    }
#undef IN
#undef SEAM
}

extern "C" void kernel_launch(void* const* d_in, const int* in_sizes, int n_in, void* d_out, int out_size, void* d_ws, size_t ws_size, hipStream_t stream) {
    static int grid = 0;
    if (grid == 0) {
        if (n_in != 18 || out_size != NTOK * DM || ws_size < WS_END) { fprintf(stderr, "kernel_launch: unexpected shapes (n_in %d, out %d, ws %zu); nothing launched\n", n_in, out_size, ws_size); grid = -1; return; }
        int dev = 0, cus = 0, per_cu = 0;
        if (hipGetDevice(&dev) != hipSuccess || hipDeviceGetAttribute(&cus, hipDeviceAttributeMultiprocessorCount, dev) != hipSuccess) { grid = -1; return; }
        if (hipFuncSetAttribute((const void*)mega_fwd, hipFuncAttributeMaxDynamicSharedMemorySize, LDS_BYTES) != hipSuccess) { fprintf(stderr, "kernel_launch: hipFuncSetAttribute failed\n"); grid = -1; return; }
        if (hipOccupancyMaxActiveBlocksPerMultiprocessor(&per_cu, (const void*)mega_fwd, NTHR, LDS_BYTES) != hipSuccess || per_cu < 1) fprintf(stderr, "kernel_launch: occupancy query reports %d\n", per_cu);
        (void)hipGetLastError();
        grid = cus;
    }
    if (grid < 0) return;
    (void)hipMemsetAsync((char*)d_ws + WS_CTL, 0, CTL_ZERO_BYTES, stream);
#ifdef EXP_SKIP
    (void)hipMemsetAsync((char*)d_ws + WS_AO, 0, 64 * MiB, stream);
    (void)hipMemsetAsync((char*)d_ws + WS_OL, 0, 64 * MiB, stream);
    if (EXP_SKIP & 4) { (void)hipMemsetAsync((char*)d_ws + WS_XG, 0, 272 * MiB, stream); (void)hipMemsetAsync((char*)d_ws + WS_DEST, 0, 1 * MiB, stream); }
#endif
    Args a{};
    for (int i = 0; i < 18; ++i) a.in[i] = (const float*)d_in[i];
    a.out = (float*)d_out; a.ws = (unsigned char*)d_ws;
#if MK_SINGLE
    a.ph_lo = 0; a.ph_hi = NPHASE;
    hipLaunchKernelGGL(mega_fwd, dim3(grid), dim3(NTHR), LDS_BYTES, stream, a);
#else
    for (int p = 0; p < NPHASE; ++p) {
        if (p > 0) { const int L = (p - 1) / NPL, q = (p - 1) % NPL; if ((L & 1) && (q == 2 || q == 4)) continue;
#ifdef EXP_SKIP
            if ((EXP_SKIP & 1) && !(L & 1) && q <= 4) continue;
            if ((EXP_SKIP & 2) && (L & 1) && q <= 4) continue;
            if ((EXP_SKIP & 4) && q >= 7 && q <= 9) continue;
#endif
        }
        a.ph_lo = p; a.ph_hi = p + 1;
        hipLaunchKernelGGL(mega_fwd, dim3(grid), dim3(NTHR), LDS_BYTES, stream, a);
    }
#endif
}
```

```cpp
#include <hip/hip_runtime.h>
#include <cstdio>
#include <cstdint>
#ifdef EXP_SKIP
#define EXPF EXP_SKIP
#else
#define EXPF 0
#endif
constexpr int NB = 4, SEQ = 8192, DM = 1024, NTOK = NB * SEQ, DEPTH = 4;
constexpr int EV_N = 2560, OD_N = 3072;
constexpr int EC_QA = 0, EC_QB = 512, EC_KB = 1024, EC_VB = 1536, EC_CKV = 2048, EC_QI = 2176, EC_KI = 2432, EC_WI = 2496;
constexpr int OC_Q = 0, OC_K = 1024, OC_V = 2048;
constexpr float LOG2E = 1.4426950408889634f;
constexpr float C2F = 0.125f * LOG2E;
constexpr float ALPHA = 1.681792830507429f;
constexpr float LN_EPS = 1e-5f;
constexpr int NR_MAX = 131072 + 32 * 256;
constexpr int NWAVES = 8, NTHR = 512;
constexpr size_t MiB = (size_t)1 << 20;
constexpr size_t WS_CTL = 0, CTL_ZERO_BYTES = 4 * MiB;
constexpr size_t WS_WEV = 8 * MiB, WS_WOD = 18 * MiB, WS_WOUT = 30 * MiB, WS_WUKT = 38 * MiB, WS_WUVT = 39 * MiB;
constexpr size_t WS_WGU = 40 * MiB, WS_WDN = 552 * MiB;
constexpr size_t WS_X = 808 * MiB, WS_X1 = 936 * MiB, WS_YP = 1064 * MiB, WS_XB = 1192 * MiB;
constexpr size_t WS_PROJ = 1256 * MiB, WS_AO = 1448 * MiB, WS_XG = 1512 * MiB, WS_ACT = 1784 * MiB;
constexpr size_t WS_QL = 2056 * MiB, WS_OL = 2120 * MiB, WS_CKVN = 2184 * MiB, WS_SEL = 2192 * MiB;
constexpr size_t WS_KBAR = 2208 * MiB, WS_SEL3 = 2209 * MiB, WS_LOGF = 2210 * MiB, WS_CS = 2212 * MiB;
constexpr size_t WS_TOPE = 2213 * MiB, WS_GATE = 2214 * MiB, WS_RANK = 2215 * MiB, WS_DEST = 2216 * MiB, WS_PML = 2217 * MiB;
constexpr size_t WS_XB8 = 2226 * MiB;
constexpr size_t WS_KIC = 2258 * MiB;
constexpr size_t WS_END = 2262 * MiB;
constexpr float F8_SX = 16.f, F8_SWG = 256.f, F8_SA = 4.f, F8_SWD = 512.f;
constexpr int CW_BAR = 4096, CW_Q = 8192, CW_KMAX = 12288, CW_CNT = 16384, CW_TILE = 32768;

#define GAS __attribute__((address_space(1)))
#define LAS __attribute__((address_space(3)))
#define DI __device__ __forceinline__
typedef unsigned short bf16;
typedef unsigned v4u __attribute__((ext_vector_type(4)));
typedef unsigned v2u __attribute__((ext_vector_type(2)));
typedef float f32x4 __attribute__((ext_vector_type(4)));
typedef float f32x2 __attribute__((ext_vector_type(2)));
typedef float f32x16 __attribute__((ext_vector_type(16)));
typedef short bf16x8 __attribute__((ext_vector_type(8)));
typedef short s16x4 __attribute__((ext_vector_type(4)));
typedef __bf16 bf16x2_t __attribute__((ext_vector_type(2)));
typedef GAS unsigned gu32;
#define RLX_AGENT __ATOMIC_RELAXED, __HIP_MEMORY_SCOPE_AGENT
#define LDS_WAIT() asm volatile("s_waitcnt lgkmcnt(0)" ::: "memory")

DI float bf2f(unsigned v) { return __uint_as_float(v << 16); }
DI unsigned cvtpk(float lo, float hi) { f32x2 v = {lo, hi}; bf16x2_t b = __builtin_convertvector(v, bf16x2_t); return __builtin_bit_cast(unsigned, b); }
DI unsigned f2bf(float f) { return cvtpk(f, 0.f) & 0xffffu; }
DI unsigned pk4_fp8(float a, float b, float c, float d) {
    a = fminf(fmaxf(a, -448.f), 448.f); b = fminf(fmaxf(b, -448.f), 448.f); c = fminf(fmaxf(c, -448.f), 448.f); d = fminf(fmaxf(d, -448.f), 448.f);
    int w = 0; w = __builtin_amdgcn_cvt_pk_fp8_f32(a, b, w, false); w = __builtin_amdgcn_cvt_pk_fp8_f32(c, d, w, true); return (unsigned)w; }
DI float ex2(float x) { return __builtin_amdgcn_exp2f(x); }
DI float wave_sum(float v) {
#pragma unroll
    for (int o = 1; o < 64; o <<= 1) v += __shfl_xor(v, o);
    return v;
}
DI float wave_max(float v) {
#pragma unroll
    for (int o = 1; o < 64; o <<= 1) v = fmaxf(v, __shfl_xor(v, o));
    return v;
}
DI unsigned ld_u32(const unsigned* p) { return __hip_atomic_load(p, RLX_AGENT); }
DI int crow(int r, int hi) { return (r & 3) + 8 * (r >> 2) + 4 * hi; }
DI f32x16 mfma32(bf16x8 a, bf16x8 b, f32x16 c) { return __builtin_amdgcn_mfma_f32_32x32x16_bf16(a, b, c, 0, 0, 0); }
DI f32x4 mfma16(bf16x8 a, bf16x8 b, f32x4 c) { return __builtin_amdgcn_mfma_f32_16x16x32_bf16(a, b, c, 0, 0, 0); }
typedef short v4i16_t __attribute__((ext_vector_type(4)));
DI s16x4 vtr(LAS const char* p) { return __builtin_bit_cast(s16x4, __builtin_amdgcn_ds_read_tr16_b64_v4i16((LAS v4i16_t*)p)); }
DI bf16x8 cat8(s16x4 a, s16x4 b) { return (bf16x8){a[0], a[1], a[2], a[3], b[0], b[1], b[2], b[3]}; }
DI int t5_bucket(int n) {
    if (n < 16) return n;
    int bkt = 16;
    bkt += (n >= 21); bkt += (n >= 27); bkt += (n >= 35); bkt += (n >= 46); bkt += (n >= 59); bkt += (n >= 77); bkt += (n >= 99); bkt += (n >= 128);
    bkt += (n >= 166); bkt += (n >= 216); bkt += (n >= 280); bkt += (n >= 363); bkt += (n >= 470); bkt += (n >= 609); bkt += (n >= 790);
    return bkt;
}
namespace pg8 {
#define PG8_LAS __attribute__((address_space(3)))
typedef unsigned short bf16_t;
typedef short bf16x8 __attribute__((ext_vector_type(8)));
typedef float f32x4 __attribute__((ext_vector_type(4)));
typedef unsigned u32x4 __attribute__((ext_vector_type(4)));
constexpr int BM = 256, BK = 64, HALF = 128, HTB = HALF * BK * 2  , STAGE_BYTES = 8 * HTB, NXCD = 8, WGM = 8;

__host__ __device__ __forceinline__ int lds_byte(int r, int c) { const int st = (r >> 4) * 2 + (c >> 5), rr = r & 15, cc = c & 31, ob = rr * 64 + cc * 2; return st * 1024 + (ob ^ (((ob >> 9) & 1) << 5)); }
__host__ __device__ __forceinline__ void stage_rc(int b, int& R, int& C) { const int st = b / 1024, sb = b % 1024, swz = sb ^ (((sb >> 9) & 1) << 5); R = (st >> 1) * 16 + swz / 64; C = (st & 1) * 32 + (swz % 64) / 2; }
__host__ __device__ __forceinline__ int perm32(int rho) { const int n = rho >> 4, i = rho & 15; return 8 * (i >> 2) + 4 * n + (i & 3); }

typedef int i32x8 __attribute__((ext_vector_type(8))); typedef int i32x4v __attribute__((ext_vector_type(4)));
__device__ __forceinline__ i32x8 pg8_cat8(bf16x8 lo, bf16x8 hi) { const i32x4v a = __builtin_bit_cast(i32x4v, lo), b = __builtin_bit_cast(i32x4v, hi); return (i32x8){a[0], a[1], a[2], a[3], b[0], b[1], b[2], b[3]}; }
struct Unit { int pm, pn; };
struct Gemm { const bf16_t* A; const bf16_t* Bt; int M, N, K; };

struct StaticOrder {
    int nM, nN, nwg, G, c;
    __host__ __device__ void init(int M, int N, int G_, int c_) { nM = M / BM; nN = N / BM; nwg = nM * nN; G = G_; c = c_; }
    __host__ __device__ bool next(int i, Unit& u) const {
        const long L = (long)i * G + c; if (L >= nwg) return false;
        int wgid = (int)L; { const int q = nwg / NXCD, r = nwg % NXCD, xcd = wgid % NXCD, off = wgid / NXCD; wgid = (xcd < r ? xcd * (q + 1) : r * (q + 1) + (xcd - r) * q) + off; }
        const int nig = WGM * nN, gid = wgid / nig, fm = gid * WGM, gsz = (nM - fm) < WGM ? (nM - fm) : WGM;
        u.pm = fm + ((wgid % nig) % gsz); u.pn = (wgid % nig) / gsz; return true;
    }
    __device__ __forceinline__ void a_ready(const Unit&) const {}
    __device__ __forceinline__ void done(const Unit&) const {}
};

__device__ __forceinline__ unsigned cvt_pk_bf16(float lo, float hi) { unsigned r; asm volatile("v_cvt_pk_bf16_f32 %0, %1, %2" : "=v"(r) : "v"(lo), "v"(hi)); return r; }
typedef float f32x2 __attribute__((ext_vector_type(2)));
__device__ __forceinline__ f32x2 gelu_pk(f32x2 v) {
    const f32x2 av = __builtin_elementwise_abs(v), d = av * 0.2316418882f + 1.0f;
    f32x2 t; t.x = __builtin_amdgcn_rcpf(d.x); t.y = __builtin_amdgcn_rcpf(d.y);
    f32x2 q = t * 0.5307027145f + (-0.7265760135f); q = q * t + 0.7107068705f; q = q * t + (-0.142248368f); q = q * t + 0.127414796f; q = q * t;
    const f32x2 s = (v * v) * (-0.72134752044f);
    f32x2 e; e.x = __builtin_amdgcn_exp2f(s.x); e.y = __builtin_amdgcn_exp2f(s.y);
    const f32x2 m = v * (q * e), r = v - m;
    f32x2 o; o.x = v.x < 0.f ? m.x : r.x; o.y = v.y < 0.f ? m.y : r.y; return o;
}

template <int ACT  > struct EpiBf16 {
    static constexpr bool PERM = true, AFTER_DRAIN = false; static_assert(ACT == 0 || ACT == 1, "EpiBf16: ACT is 0 (none) or 1 (gelu_pk)");
    bf16_t* O; int ldc; const float* bias; int split_cols; size_t split_stride; float scale0;
    __device__ __forceinline__ void operator()(const f32x4 (&acc)[2][2][4][2], const Unit& u, int wr, int wc, int fr, int fq) const {
        const int row0 = u.pm * BM + wr * 64 + fr; int colt = u.pn * BM; bf16_t* base = O;
        float sc = 1.f; if (split_cols) { const int t = colt / split_cols; base += (size_t)t * split_stride; colt -= t * split_cols; if (t == 0) sc = scale0; }
        const int col0 = colt + wc * 32 + 8 * fq, bcol0 = u.pn * BM + wc * 32 + 8 * fq;
        f32x4 bv[2][2];
#pragma unroll
        for (int bj = 0; bj < 2; ++bj)
#pragma unroll
            for (int n = 0; n < 2; ++n) bv[bj][n] = bias ? *(const f32x4*)(bias + bcol0 + bj * HALF + 4 * n) : (f32x4){0.f, 0.f, 0.f, 0.f};
#pragma unroll
        for (int ai = 0; ai < 2; ++ai)
#pragma unroll
            for (int m = 0; m < 4; ++m) { bf16_t* rowp = base + (size_t)(row0 + ai * HALF + m * 16) * ldc + col0;
#pragma unroll
                for (int bj = 0; bj < 2; ++bj) { f32x4 v0 = acc[ai][bj][m][0] + bv[bj][0], v1 = acc[ai][bj][m][1] + bv[bj][1];
                    if (ACT == 1) { f32x2 a = gelu_pk((f32x2){v0[0], v0[1]}), b = gelu_pk((f32x2){v0[2], v0[3]}), c = gelu_pk((f32x2){v1[0], v1[1]}), d = gelu_pk((f32x2){v1[2], v1[3]});
                        v0 = (f32x4){a.x, a.y, b.x, b.y}; v1 = (f32x4){c.x, c.y, d.x, d.y}; }
                    v0 = v0 * sc; v1 = v1 * sc; u32x4 w; w.x = cvt_pk_bf16(v0[0], v0[1]); w.y = cvt_pk_bf16(v0[2], v0[3]); w.z = cvt_pk_bf16(v1[0], v1[1]); w.w = cvt_pk_bf16(v1[2], v1[3]);
                    *(u32x4*)(rowp + bj * HALF) = w; } }
    }
};

template <class Epi, class Sched, bool ALIGN_EPI = false, bool SP2 = false, bool F8 = false>
__device__ __forceinline__ void gemm_phase(PG8_LAS unsigned char* lds, const Gemm g, const Sched& S, const Epi& E, int tid_in) {
    int tid_l = tid_in; asm volatile("" : "+v"(tid_l));
    const int tid = tid_l, wid = __builtin_amdgcn_readfirstlane(tid >> 6), lane = tid & 63, wr = wid >> 2, wc = wid & 3, fr = lane & 15, fq = lane >> 4;
    const int K = g.K, nt = K / BK;
    unsigned voffA[2], voffB[2];
#pragma unroll
    for (int i = 0; i < 2; ++i) { int R, C; stage_rc(tid * 16 + i * 8192, R, C); const int Rb = Epi::PERM ? ((R & ~31) + perm32(R & 31)) : R;
        voffA[i] = (unsigned)(R * K + C) * 2u; voffB[i] = (unsigned)(Rb * K + C) * 2u; }
    const size_t kstep = (size_t)(BK * 2);
    const size_t hstep = (size_t)HALF * K * 2;
    const size_t tstep = 2 * hstep;
    const unsigned ldsw = (unsigned)wid * 1024u;
    const int aoff = lds_byte(wr * 64 + fr, fq * 8), boff = lds_byte(wc * 32 + fr, fq * 8);
#define PG8_SA(b, h) (((b) * 2 + (h)) * HTB)
#define PG8_SB(b, h) ((4 + (b) * 2 + (h)) * HTB)
#define PG8_STAGE(bufoff, gbase, voff) do { _Pragma("unroll") for (int _i = 0; _i < 2; ++_i) \
        __builtin_amdgcn_global_load_lds((const unsigned*)((const char*)(gbase) + (voff)[_i]), (PG8_LAS unsigned*)(lds + (bufoff) + ldsw + _i * 8192), 16, 0, 0); } while (0)
#define PG8_LDA(dst, b, h) do { _Pragma("unroll") for (int m = 0; m < 4; ++m) _Pragma("unroll") for (int k = 0; k < 2; ++k) dst[m][k] = *(const PG8_LAS bf16x8*)(lds + PG8_SA(b, h) + aoff + m * 2048 + k * 1024); } while (0)
#define PG8_LDB(dst, b, h) do { _Pragma("unroll") for (int n = 0; n < 2; ++n) _Pragma("unroll") for (int k = 0; k < 2; ++k) dst[n][k] = *(const PG8_LAS bf16x8*)(lds + PG8_SB(b, h) + boff + n * 2048 + k * 1024); } while (0)
#define PG8_MMA(ai, bj, At, Bt) do { __builtin_amdgcn_s_setprio(1); if constexpr (!F8) { _Pragma("unroll") for (int m = 0; m < 4; ++m) _Pragma("unroll") for (int n = 0; n < 2; ++n) _Pragma("unroll") for (int k = 0; k < 2; ++k) \
        acc[ai][bj][m][n] = __builtin_amdgcn_mfma_f32_16x16x32_bf16(Bt[n][k], At[m][k], acc[ai][bj][m][n], 0, 0, 0); } else { _Pragma("unroll") for (int m = 0; m < 4; ++m) _Pragma("unroll") for (int n = 0; n < 2; ++n) \
        acc[ai][bj][m][n] = __builtin_amdgcn_mfma_scale_f32_16x16x128_f8f6f4(pg8_cat8(Bt[n][0], Bt[n][1]), pg8_cat8(At[m][0], At[m][1]), acc[ai][bj][m][n], 0, 0, 0, 0x7F7F7F7F, 0, 0x7F7F7F7F); \
        _Pragma("unroll") for (int m = 0; m < 4; ++m) _Pragma("unroll") for (int n = 0; n < 2; ++n) asm volatile("" : "+v"(acc[ai][bj][m][n]));   } __builtin_amdgcn_s_setprio(0); } while (0)
#define PG8_WAIT_V(n) asm volatile("s_waitcnt vmcnt(" #n ")" ::: "memory")
#define PG8_WAIT_L(n) asm volatile("s_waitcnt lgkmcnt(" #n ")" ::: "memory")
#define PG8_BAR __builtin_amdgcn_s_barrier()
#define PG8_SCHED __builtin_amdgcn_sched_barrier(0)
    Unit cur, nxt; int ui = 0;
    if (!S.next(0, cur)) return;
    f32x4 acc[2][2][4][2];
#pragma unroll
    for (int a = 0; a < 2; ++a)
#pragma unroll
        for (int b = 0; b < 2; ++b)
#pragma unroll
            for (int m = 0; m < 4; ++m)
#pragma unroll
                for (int n = 0; n < 2; ++n) acc[a][b][m][n] = (f32x4){0.f, 0.f, 0.f, 0.f};
    bf16x8 At[4][2], B0[2][2], B1[2][2];
    const char* cA = (const char*)g.A + (size_t)cur.pm * tstep; const char* cB = (const char*)g.Bt + (size_t)cur.pn * tstep;
    S.a_ready(cur);
    if constexpr (SP2) {
        PG8_STAGE(PG8_SB(0, 0), cB, voffB); PG8_STAGE(PG8_SB(0, 1), cB + hstep, voffB); PG8_STAGE(PG8_SA(0, 0), cA, voffA); PG8_STAGE(PG8_SA(0, 1), cA + hstep, voffA);
        if (wr == 1) PG8_BAR;
        PG8_WAIT_V(2); PG8_BAR;
        PG8_STAGE(PG8_SB(1, 0), cB + kstep, voffB); PG8_STAGE(PG8_SA(1, 0), cA + kstep, voffA); PG8_STAGE(PG8_SB(1, 1), cB + hstep + kstep, voffB);
        PG8_WAIT_V(6); PG8_BAR;
    } else {
        PG8_STAGE(PG8_SB(0, 0), cB, voffB); PG8_STAGE(PG8_SA(0, 0), cA, voffA); PG8_STAGE(PG8_SB(0, 1), cB + hstep, voffB); PG8_STAGE(PG8_SA(0, 1), cA + hstep, voffA);
        if (wr == 1) PG8_BAR;
        PG8_WAIT_V(4); PG8_BAR;
        PG8_STAGE(PG8_SB(1, 0), cB + kstep, voffB); PG8_STAGE(PG8_SA(1, 0), cA + kstep, voffA); PG8_STAGE(PG8_SB(1, 1), cB + hstep + kstep, voffB);
        PG8_WAIT_V(6); PG8_BAR;
    }
    for (;;) {
        const bool has_next = S.next(ui + 1, nxt);
        const char* nA = has_next ? (const char*)g.A + (size_t)nxt.pm * tstep : cA; const char* nB = has_next ? (const char*)g.Bt + (size_t)nxt.pn * tstep : cB;
        for (int t = 0; t < nt; t += 2) {
            const bool last = (t == nt - 2);
            const char* a1 = cA + (size_t)(t + 1) * kstep;
            const char* a2 = last ? nA : cA + (size_t)(t + 2) * kstep; const char* b2 = last ? nB : cB + (size_t)(t + 2) * kstep;
            const char* a3 = a2 + kstep; const char* b3 = b2 + kstep;
            if (last && has_next) S.a_ready(nxt);
            if constexpr (SP2) {
            PG8_LDB(B0, 0, 0); PG8_LDB(B1, 0, 1); PG8_SCHED; PG8_LDA(At, 0, 0); PG8_STAGE(PG8_SA(1, 1), a1 + hstep, voffA);
            PG8_WAIT_V(8); PG8_WAIT_L(0); PG8_BAR; PG8_MMA(0, 0, At, B0); PG8_MMA(0, 1, At, B1); PG8_BAR; PG8_SCHED;
            PG8_LDA(At, 0, 1); PG8_STAGE(PG8_SB(0, 0), b2, voffB); PG8_STAGE(PG8_SB(0, 1), b2 + hstep, voffB); PG8_STAGE(PG8_SA(0, 0), a2, voffA);
            PG8_WAIT_V(8); PG8_WAIT_L(0); PG8_BAR; PG8_MMA(1, 0, At, B0); PG8_MMA(1, 1, At, B1); PG8_BAR; PG8_SCHED;
            PG8_LDB(B0, 1, 0); PG8_LDB(B1, 1, 1); PG8_SCHED; PG8_LDA(At, 1, 0); PG8_STAGE(PG8_SA(0, 1), a2 + hstep, voffA);
            PG8_WAIT_V(8); PG8_WAIT_L(0); PG8_BAR; PG8_MMA(0, 0, At, B0); PG8_MMA(0, 1, At, B1); PG8_BAR; PG8_SCHED;
            PG8_LDA(At, 1, 1); PG8_STAGE(PG8_SB(1, 0), b3, voffB); PG8_STAGE(PG8_SB(1, 1), b3 + hstep, voffB); PG8_STAGE(PG8_SA(1, 0), a3, voffA);
            PG8_WAIT_V(8); PG8_WAIT_L(0); PG8_BAR; PG8_MMA(1, 0, At, B0); PG8_MMA(1, 1, At, B1); PG8_BAR; PG8_SCHED;
            } else {
            PG8_LDB(B0, 0, 0); PG8_SCHED; PG8_LDA(At, 0, 0); PG8_STAGE(PG8_SA(1, 1), a1 + hstep, voffA);
            PG8_WAIT_L(8); PG8_BAR; PG8_WAIT_L(0); PG8_MMA(0, 0, At, B0); PG8_BAR; PG8_SCHED;
            PG8_LDB(B1, 0, 1); PG8_STAGE(PG8_SB(0, 0), b2, voffB);
            PG8_BAR; PG8_WAIT_L(0); PG8_MMA(0, 1, At, B1); PG8_BAR;
            PG8_LDA(At, 0, 1); PG8_STAGE(PG8_SA(0, 0), a2, voffA);
            PG8_BAR; PG8_WAIT_L(0); PG8_MMA(1, 0, At, B0); PG8_BAR; PG8_SCHED;
            PG8_STAGE(PG8_SB(0, 1), b2 + hstep, voffB);
            PG8_WAIT_V(6); PG8_BAR; PG8_MMA(1, 1, At, B1); PG8_BAR;
            PG8_LDB(B0, 1, 0); PG8_SCHED; PG8_LDA(At, 1, 0); PG8_STAGE(PG8_SA(0, 1), a2 + hstep, voffA);
            PG8_WAIT_L(8); PG8_BAR; PG8_WAIT_L(0); PG8_MMA(0, 0, At, B0); PG8_BAR; PG8_SCHED;
            PG8_LDB(B1, 1, 1); PG8_STAGE(PG8_SB(1, 0), b3, voffB);
            PG8_BAR; PG8_WAIT_L(0); PG8_MMA(0, 1, At, B1); PG8_BAR;
            PG8_LDA(At, 1, 1); PG8_STAGE(PG8_SA(1, 0), a3, voffA);
            PG8_BAR; PG8_WAIT_L(0); PG8_MMA(1, 0, At, B0); PG8_BAR; PG8_SCHED;
            PG8_STAGE(PG8_SB(1, 1), b3 + hstep, voffB);
            PG8_WAIT_V(6); PG8_BAR; PG8_MMA(1, 1, At, B1); PG8_BAR;
            }
        }
        if constexpr (ALIGN_EPI) { if (wr == 0) PG8_BAR; }
        if constexpr (!Epi::AFTER_DRAIN) { E(acc, cur, wr, wc, fr, fq); S.done(cur); }
        if (!has_next) break;
#pragma unroll
        for (int a = 0; a < 2; ++a)
#pragma unroll
            for (int b = 0; b < 2; ++b)
#pragma unroll
                for (int m = 0; m < 4; ++m)
#pragma unroll
                    for (int n = 0; n < 2; ++n) acc[a][b][m][n] = (f32x4){0.f, 0.f, 0.f, 0.f};
        cur = nxt; cA = nA; cB = nB; ++ui;
        if constexpr (ALIGN_EPI) { if (wr == 1) PG8_BAR; }
    }
    PG8_WAIT_V(0);
    if constexpr (!ALIGN_EPI) { if (wr == 0) PG8_BAR; }
    PG8_BAR;
    if constexpr (Epi::AFTER_DRAIN) { E.fused(acc, cur, wr, wc, fr, fq, lds, wid, lane); S.done(cur); }
#undef PG8_SA
#undef PG8_SB
#undef PG8_STAGE
#undef PG8_LDA
#undef PG8_LDB
#undef PG8_MMA
#undef PG8_WAIT_V
#undef PG8_WAIT_L
#undef PG8_BAR
#undef PG8_SCHED
}
}

#ifndef PG8_SP2
#define PG8_SP2 true
#endif
#ifndef PG8_ALIGN
#define PG8_ALIGN true
#endif
#define XB_TMO      128
#define XB_XCNT(j)  (256  + 64 * (j))
#define XB_XSUB(j)  (1280 + 64 * (j))
#define XB_XGEN(j)  (2304 + 64 * (j))
#define XB_TOP      3328
#define XB_TOPGEN   3392
#define XCD_BAR_WORDS 3456
#define XB_SPIN_CAP (1u << 18)

__device__ __forceinline__ unsigned xb_ld(unsigned* p)              { return __hip_atomic_load(p, __ATOMIC_RELAXED, __HIP_MEMORY_SCOPE_AGENT); }
__device__ __forceinline__ unsigned xb_add(unsigned* p, unsigned v) { return __hip_atomic_fetch_add(p, v, __ATOMIC_RELAXED, __HIP_MEMORY_SCOPE_AGENT); }
__device__ __forceinline__ unsigned xb_xcc_id() { return (unsigned)__builtin_amdgcn_s_getreg((3 << 11) | 20) & 0xFu; }
#define XB_SPIN(cond, bar) do { unsigned _sp = 0; while (cond) { __builtin_amdgcn_s_sleep(1); \
    if ((++_sp & 255u) == 0u) { if (xb_ld(&(bar)[XB_TMO])) break; if (_sp > XB_SPIN_CAP) { atomicAdd(&(bar)[XB_TMO], 1u); break; } } } } while (0)

struct XcdBarrier {
    unsigned* bar; unsigned x;
    volatile LAS unsigned* st;
};

__device__ __forceinline__ XcdBarrier xcd_barrier_post(unsigned* bar, volatile LAS unsigned* st) {
    XcdBarrier b; b.bar = bar; b.x = xb_xcc_id(); b.st = st;
    if (threadIdx.x == 0) (void)xb_add(&bar[XB_XCNT(b.x)], 1u);
    return b;
}
__device__ __forceinline__ void xcd_barrier_complete(unsigned* bar, unsigned x, unsigned& nloc, unsigned& nx) {
    const unsigned G = gridDim.x * gridDim.y * gridDim.z;
    unsigned sum, cnt, mine, sp = 0u;
    for (;;) {
        sum = 0u; cnt = 0u; mine = 0u;
#pragma unroll
        for (unsigned j = 0; j < 16; ++j) { const unsigned c = xb_ld(&bar[XB_XCNT(j)]); sum += c; cnt += (c > 0u) ? 1u : 0u; mine = (j == x) ? c : mine; }
        if (sum == G) break;
        __builtin_amdgcn_s_sleep(1);
        if ((++sp & 255u) == 0u) { if (xb_ld(&bar[XB_TMO])) break; if (sp > XB_SPIN_CAP) { atomicAdd(&bar[XB_TMO], 1u); break; } }
    }
    nloc = mine > 0u ? mine : 1u; nx = cnt > 0u ? cnt : 1u;
}

__device__ __forceinline__ void xcd_barrier(const XcdBarrier& b, const bool is_t0  ) {
    asm volatile("s_waitcnt vmcnt(0)" ::: "memory");
    __syncthreads();
    if (is_t0) {
        unsigned* bar = b.bar;
        __builtin_amdgcn_s_waitcnt(0);
        unsigned nloc = b.st[0], nx = b.st[1];
        if (nloc == 0u) { xcd_barrier_complete(bar, b.x, nloc, nx); b.st[0] = nloc; b.st[1] = nx; }
        const unsigned old = xb_add(&bar[XB_XSUB(b.x)], 1u);
        const unsigned gen = old / nloc;
        if (old + 1u == (gen + 1u) * nloc) {
            __builtin_amdgcn_fence(__ATOMIC_RELEASE, "agent");
            asm volatile("s_waitcnt vmcnt(0)" ::: "memory");
            const unsigned og = xb_add(&bar[XB_TOP], 1u);
            const unsigned tg = og / nx;
            if (og + 1u == (tg + 1u) * nx) xb_add(&bar[XB_TOPGEN], 1u);
            else XB_SPIN(xb_ld(&bar[XB_TOPGEN]) == tg, bar);
            __builtin_amdgcn_fence(__ATOMIC_ACQUIRE, "agent");
            xb_add(&bar[XB_XGEN(b.x)], 1u);
            asm volatile("s_waitcnt vmcnt(0)" ::: "memory");
        } else {
            XB_SPIN(xb_ld(&bar[XB_XGEN(b.x)]) == gen, bar);
            __builtin_amdgcn_fence(__ATOMIC_ACQUIRE, "agent");
            asm volatile("s_waitcnt vmcnt(0)" ::: "memory");
        }
    }
    __syncthreads();
}
struct EpiResF32 {
    static constexpr bool PERM = true, AFTER_DRAIN = false;
    const float* xin; float* yp; float alpha;
    DI void operator()(const pg8::f32x4 (&acc)[2][2][4][2], const pg8::Unit& u, int wr, int wc, int fr, int fq) const {
        const int row0 = u.pm * 256 + wr * 64 + fr, col0 = u.pn * 256 + wc * 32 + 8 * fq;
#pragma unroll
        for (int ai = 0; ai < 2; ++ai)
#pragma unroll
            for (int m = 0; m < 4; ++m) {
                const size_t ro = (size_t)(row0 + ai * 128 + m * 16) * DM;
#pragma unroll
                for (int bj = 0; bj < 2; ++bj) {
                    const size_t o = ro + col0 + bj * 128;
                    const f32x4 x0 = *(const f32x4*)(xin + o), x1 = *(const f32x4*)(xin + o + 4);
                    *(f32x4*)(yp + o) = x0 * alpha + acc[ai][bj][m][0];
                    *(f32x4*)(yp + o + 4) = x1 * alpha + acc[ai][bj][m][1];
                }
            }
    }
};
struct EpiSwiglu {
    static constexpr bool PERM = true, AFTER_DRAIN = false;
    unsigned char* act; const float* bgu;
    DI void operator()(const pg8::f32x4 (&acc)[2][2][4][2], const pg8::Unit& u, int wr, int wc, int fr, int fq) const {
        const int e = u.pn >> 3, pl = u.pn & 7;
        const int row0 = u.pm * 256 + wr * 64 + fr, cih = pl * 128 + wc * 32 + 8 * fq;
        const float* bg = bgu + e * 2048 + cih;
        const f32x4 bg0 = *(const f32x4*)(bg), bg1 = *(const f32x4*)(bg + 4), bu0 = *(const f32x4*)(bg + 1024), bu1 = *(const f32x4*)(bg + 1028);
#pragma unroll
        for (int ai = 0; ai < 2; ++ai)
#pragma unroll
            for (int m = 0; m < 4; ++m) {
                constexpr float RS = 1.f / (F8_SX * F8_SWG);
                const f32x4 g0 = acc[ai][0][m][0] * RS + bg0, g1 = acc[ai][0][m][1] * RS + bg1, u0 = acc[ai][1][m][0] * RS + bu0, u1 = acc[ai][1][m][1] * RS + bu1;
                float r[8];
#pragma unroll
                for (int i = 0; i < 8; ++i) {
                    float g = i < 4 ? g0[i & 3] : g1[i & 3], uu = i < 4 ? u0[i & 3] : u1[i & 3];
                    g = fminf(g, 7.0f); uu = fminf(fmaxf(uu, -7.0f), 7.0f);
                    const float sg = __builtin_amdgcn_rcpf(1.0f + ex2(-1.702f * LOG2E * g));
                    r[i] = (uu + 1.0f) * g * sg * F8_SA;
                }
                v2u w; w.x = pk4_fp8(r[0], r[1], r[2], r[3]); w.y = pk4_fp8(r[4], r[5], r[6], r[7]);
                *(v2u*)(act + (size_t)(row0 + ai * 128 + m * 16) * DM + cih) = w;
            }
    }
};
struct EpiDown {
    static constexpr bool PERM = true, AFTER_DRAIN = false;
    bf16* yr; const float* bdn;
    DI void operator()(const pg8::f32x4 (&acc)[2][2][4][2], const pg8::Unit& u, int wr, int wc, int fr, int fq) const {
        const int e = u.pn >> 2, pl = u.pn & 3;
        const int row0 = u.pm * 256 + wr * 64 + fr, col0 = pl * 256 + wc * 32 + 8 * fq;
        f32x4 bv[2][2];
#pragma unroll
        for (int bj = 0; bj < 2; ++bj) { bv[bj][0] = *(const f32x4*)(bdn + e * 1024 + col0 + bj * 128); bv[bj][1] = *(const f32x4*)(bdn + e * 1024 + col0 + bj * 128 + 4); }
#pragma unroll
        for (int ai = 0; ai < 2; ++ai)
#pragma unroll
            for (int m = 0; m < 4; ++m) {
                bf16* rp = yr + (size_t)(row0 + ai * 128 + m * 16) * DM + col0;
#pragma unroll
                for (int bj = 0; bj < 2; ++bj) {
                    constexpr float RS = 1.f / (F8_SA * F8_SWD);
                    const f32x4 v0 = acc[ai][bj][m][0] * RS + bv[bj][0], v1 = acc[ai][bj][m][1] * RS + bv[bj][1];
                    v4u w; w.x = cvtpk(v0[0], v0[1]); w.y = cvtpk(v0[2], v0[3]); w.z = cvtpk(v1[0], v1[1]); w.w = cvtpk(v1[2], v1[3]);
                    *(v4u*)(rp + bj * 128) = w;
                }
            }
    }
};
struct GroupOrder {
    LAS const unsigned* tile_e; int ntiles, lg, G, c;
    DI bool next(int i, pg8::Unit& u) const {
        int pm, pl;
        if (G == 256) {
            const int x = c & 7, k = c >> 3; pm = i * (256 >> lg) + x * (32 >> lg) + (k >> lg); pl = k & ((1 << lg) - 1); if (pm >= ntiles) return false; }
        else { const long L = (long)i * G + c; if (L >= ((long)ntiles << lg)) return false; pm = (int)(L >> lg); pl = (int)(L & ((1 << lg) - 1)); }
        const int e = __builtin_amdgcn_readfirstlane((int)tile_e[pm]);
        u.pm = pm; u.pn = (e << lg) + pl; return true;
    }
    DI void a_ready(const pg8::Unit&) const {}
    DI void done(const pg8::Unit&) const {}
};
struct Args { const float* in[18]; float* out; unsigned char* ws; int ph_lo, ph_hi; };
struct Fr { LAS unsigned char* lds; unsigned char* ws; unsigned* ctl; int tid, lane, wave, blk, G; };

DI void tr_item(const float* W, int ldw, int K, int k0, int sc0, int nvalid, bf16* WT, int drow0, LAS float* scr, int lane) {
    const int c = lane & 31;
    float v[32];
#pragma unroll
    for (int i = 0; i < 32; ++i) v[i] = (c < nvalid) ? W[(size_t)(k0 + 2 * i + (lane >> 5)) * ldw + sc0 + c] : 0.f;
#pragma unroll
    for (int i = 0; i < 32; ++i) scr[(2 * i + (lane >> 5)) * 33 + c] = v[i];
    LDS_WAIT(); asm volatile("" ::: "memory");
    const int c8 = lane & 7;
#pragma unroll
    for (int j = 0; j < 4; ++j) { const int n = (lane >> 3) + 8 * j; const LAS float* s = scr + (8 * c8) * 33 + n;
        v4u o; o.x = cvtpk(s[0 * 33], s[1 * 33]); o.y = cvtpk(s[2 * 33], s[3 * 33]); o.z = cvtpk(s[4 * 33], s[5 * 33]); o.w = cvtpk(s[6 * 33], s[7 * 33]);
        *(v4u*)(WT + (size_t)(drow0 + n) * K + k0 + 8 * c8) = o; }
    LDS_WAIT(); asm volatile("" ::: "memory");
}
DI void tr_item8(const float* W, int ldw, int K, int k0, int sc0, float scale, unsigned char* WT8, int drow0, LAS float* scr, int lane) {
    const int c = lane & 31;
    float v[32];
#pragma unroll
    for (int i = 0; i < 32; ++i) v[i] = W[(size_t)(k0 + 2 * i + (lane >> 5)) * ldw + sc0 + c];
#pragma unroll
    for (int i = 0; i < 32; ++i) scr[(2 * i + (lane >> 5)) * 33 + c] = v[i] * scale;
    LDS_WAIT(); asm volatile("" ::: "memory");
    const int c16 = lane & 3;
#pragma unroll
    for (int j = 0; j < 2; ++j) { const int n = (lane >> 2) + 16 * j; const LAS float* s = scr + (16 * c16) * 33 + n;
        v4u o; o.x = pk4_fp8(s[0 * 33], s[1 * 33], s[2 * 33], s[3 * 33]); o.y = pk4_fp8(s[4 * 33], s[5 * 33], s[6 * 33], s[7 * 33]);
        o.z = pk4_fp8(s[8 * 33], s[9 * 33], s[10 * 33], s[11 * 33]); o.w = pk4_fp8(s[12 * 33], s[13 * 33], s[14 * 33], s[15 * 33]);
        *(v4u*)(WT8 + (size_t)(drow0 + n) * K + k0 + 16 * c16) = o; }
    LDS_WAIT(); asm volatile("" ::: "memory");
}
DI void ph_prologue(const Args& a, const Fr& F) {
    LAS float* scr = (LAS float*)(F.lds + F.wave * 16384);
    const int gw = F.blk * NWAVES + F.wave, NGW = F.G * NWAVES;
    constexpr int I_EV = 2 * 16 * 80, I_OD = 2 * 16 * 96, I_WO = 4 * 16 * 32;
    constexpr int NITEMS = I_EV + I_OD + I_WO;
    bf16* wev = (bf16*)(F.ws + WS_WEV); bf16* wod = (bf16*)(F.ws + WS_WOD); bf16* wout = (bf16*)(F.ws + WS_WOUT);
    unsigned char* wgu = F.ws + WS_WGU; unsigned char* wdn = F.ws + WS_WDN;
    for (int it = gw; it < NITEMS; it += NGW) {
        int r = it;
        if (r < I_EV) { const int l = r / 1280; r %= 1280; const int kb = r / 80, n0 = (r % 80) * 32; int sc0, nv = 32;
            if (n0 < 512) sc0 = n0; else if (n0 < 1024) sc0 = 964 + (n0 - 512); else if (n0 < 1536) sc0 = 1476 + (n0 - 1024); else if (n0 < 2048) sc0 = 1988 + (n0 - 1536);
            else if (n0 < 2176) sc0 = 512 + (n0 - 2048); else if (n0 < 2432) sc0 = 640 + (n0 - 2176); else if (n0 < 2496) sc0 = 896 + (n0 - 2432);
            else if (n0 < 2528) { sc0 = 960; nv = 4; } else { sc0 = 0; nv = 0; }
            tr_item(a.in[1] + (size_t)l * 1024 * 2500, 2500, 1024, kb * 64, sc0, nv, wev + (size_t)l * EV_N * 1024, n0, scr, F.lane); continue; }
        r -= I_EV;
        if (r < I_OD) { const int l = r / 1536; r %= 1536; const int kb = r / 96, n0 = (r % 96) * 32;
            tr_item(a.in[6] + (size_t)l * 1024 * 3088, 3088, 1024, kb * 64, n0, 32, wod + (size_t)l * OD_N * 1024, n0, scr, F.lane); continue; }
        r -= I_OD;
        if (r < I_WO) { const int l = r / 512; r %= 512; const int kb = r / 32, n0 = (r % 32) * 32;
            const float* src = (l & 1) ? a.in[8] + (size_t)(l >> 1) * 1024 * 1024 : a.in[5] + (size_t)(l >> 1) * 1024 * 1024;
            tr_item(src, 1024, 1024, kb * 64, n0, 32, wout + (size_t)l * 1024 * 1024, n0, scr, F.lane); continue; }
    }
    { __syncthreads();
        LAS float* tile = (LAS float*)F.lds; unsigned char* wgu8 = F.ws + WS_WGU; unsigned char* wdn8 = F.ws + WS_WDN;
        constexpr int T_GU = 128 * 8 * 16, T_DN = 128 * 8 * 8, T_ALL = T_GU + T_DN;
        const int tid = F.tid, c4 = tid & 31, r0 = tid >> 5;
        f32x4 v[8];
        auto locate = [&](int t, const float*& src, int& ldw, unsigned char*& dst, float& scale) {
            if (t < T_GU) { const int le = t >> 7, r = t & 127, kb = r >> 4, nb = r & 15, n0 = nb * 128; const int pn = n0 >> 8, bj = (n0 >> 7) & 1;
                src = a.in[14] + (size_t)le * 1024 * 2048 + (size_t)(kb * 128) * 2048 + bj * 1024 + pn * 128; ldw = 2048; dst = wgu8 + (size_t)le * 2048 * 1024 + (size_t)n0 * 1024 + kb * 128; scale = F8_SWG; }
            else { const int u = t - T_GU, le = u >> 6, r = u & 63, kb = r >> 3, nb = r & 7;
                src = a.in[16] + (size_t)le * 1024 * 1024 + (size_t)(kb * 128) * 1024 + nb * 128; ldw = 1024; dst = wdn8 + (size_t)le * 1024 * 1024 + (size_t)(nb * 128) * 1024 + kb * 128; scale = F8_SWD; } };
        int t = F.blk;
        if (t < T_ALL) { const float* src; int ldw; unsigned char* dst; float sc; locate(t, src, ldw, dst, sc);
#pragma unroll
            for (int i = 0; i < 8; ++i) v[i] = *(const f32x4*)(src + (size_t)(r0 + 16 * i) * ldw + 4 * c4); }
        for (; t < T_ALL; t += F.G) {
            const float* src; int ldw; unsigned char* dst; float sc; locate(t, src, ldw, dst, sc);
#pragma unroll
            for (int i = 0; i < 8; ++i) { LAS float* tp = tile + (r0 + 16 * i) * 129 + 4 * c4; tp[0] = v[i][0] * sc; tp[1] = v[i][1] * sc; tp[2] = v[i][2] * sc; tp[3] = v[i][3] * sc; }
            __syncthreads();
            if (t + F.G < T_ALL) { const float* s2; int l2; unsigned char* d2; float c2; locate(t + F.G, s2, l2, d2, c2);
#pragma unroll
                for (int i = 0; i < 8; ++i) v[i] = *(const f32x4*)(s2 + (size_t)(r0 + 16 * i) * l2 + 4 * c4); }
#pragma unroll
            for (int j = 0; j < 2; ++j) { const int p = tid + 512 * j, kc = p & 7, n = p >> 3; const LAS float* sp = tile + (kc * 16) * 129 + n;
                v4u o; o.x = pk4_fp8(sp[0], sp[129], sp[2 * 129], sp[3 * 129]); o.y = pk4_fp8(sp[4 * 129], sp[5 * 129], sp[6 * 129], sp[7 * 129]);
                o.z = pk4_fp8(sp[8 * 129], sp[9 * 129], sp[10 * 129], sp[11 * 129]); o.w = pk4_fp8(sp[12 * 129], sp[13 * 129], sp[14 * 129], sp[15 * 129]);
                *(v4u*)(dst + (size_t)n * 1024 + kc * 16) = o; }
            __syncthreads();
        }
    }
    bf16* xb = (bf16*)(F.ws + WS_XB);
    for (int m = gw; m < NTOK; m += NGW) {
        const f32x4* xr = (const f32x4*)(a.in[0] + (size_t)m * DM) + F.lane; v2u* o = (v2u*)(xb + (size_t)m * DM) + F.lane;
#pragma unroll
        for (int j = 0; j < 4; ++j) { const f32x4 v = xr[64 * j]; v2u w; w.x = cvtpk(v[0], v[1]); w.y = cvtpk(v[2], v[3]); o[64 * j] = w; }
    }
    bf16* wukt = (bf16*)(F.ws + WS_WUKT); bf16* wuvt = (bf16*)(F.ws + WS_WUVT);
    for (int i = F.blk * NTHR + F.tid; i < 2 * 8 * 128 * 64; i += F.G * NTHR) {
        { const int d = i & 63, c = (i >> 6) & 127, lh = i >> 13; wukt[i] = (bf16)f2bf(a.in[2][((size_t)lh * 64 + d) * 128 + c]); }
        { const int c = i & 127, d = (i >> 7) & 63, lh = i >> 13; wuvt[i] = (bf16)f2bf(a.in[3][((size_t)lh * 128 + c) * 64 + d]); }
    }
}

DI void ln_row(f32x4 (&v)[4], const float* g, const float* b, int lane) {
    float s = 0.f;
#pragma unroll
    for (int j = 0; j < 4; ++j) s += (v[j][0] + v[j][1]) + (v[j][2] + v[j][3]);
    const float mean = wave_sum(s) * (1.f / DM); float s2 = 0.f;
#pragma unroll
    for (int j = 0; j < 4; ++j) { v[j] = v[j] - mean; s2 += (v[j][0] * v[j][0] + v[j][1] * v[j][1]) + (v[j][2] * v[j][2] + v[j][3] * v[j][3]); }
    const float rstd = 1.f / sqrtf(wave_sum(s2) * (1.f / DM) + LN_EPS);
#pragma unroll
    for (int j = 0; j < 4; ++j) { const f32x4 gg = *((const f32x4*)g + lane + 64 * j), bb = *((const f32x4*)b + lane + 64 * j); v[j] = v[j] * rstd * gg + bb; }
}
DI void store_row_f32(float* p, const f32x4 (&v)[4], int lane) {
#pragma unroll
    for (int j = 0; j < 4; ++j) *((f32x4*)p + lane + 64 * j) = v[j];
}
DI void store_row_bf16(bf16* p, const f32x4 (&v)[4], int lane) {
#pragma unroll
    for (int j = 0; j < 4; ++j) { v2u w; w.x = cvtpk(v[j][0], v[j][1]); w.y = cvtpk(v[j][2], v[j][3]); *((v2u*)p + lane + 64 * j) = w; }
}
template <int NL> DI void small_proj(LAS const float* xs, const float* W, int ldw, int lane, float (&acc)[4]) {
    constexpr int PARTS = 64 / NL, DPER = 1024 / PARTS;
    const int n = lane & (NL - 1), part = lane / NL;
    acc[0] = acc[1] = acc[2] = acc[3] = 0.f;
    const float* wp = W + (size_t)(part * DPER) * ldw + n;
    LAS const float* xp = xs + part * DPER;
#pragma unroll 8
    for (int d = 0; d < DPER; ++d) { const float w = wp[(size_t)d * ldw];
        acc[0] += w * xp[d]; acc[1] += w * xp[1024 + d]; acc[2] += w * xp[2048 + d]; acc[3] += w * xp[3072 + d]; }
#pragma unroll
    for (int o = NL; o < 64; o <<= 1) {
#pragma unroll
        for (int k = 0; k < 4; ++k) acc[k] += __shfl_xor(acc[k], o); }
}

DI void ph_even_prep(const Args& a, const Fr& F, int j) {
    const bf16* proj = (const bf16*)(F.ws + WS_PROJ);
    bf16* ckvn = (bf16*)(F.ws + WS_CKVN); bf16* ql = (bf16*)(F.ws + WS_QL); float* kbar = (float*)(F.ws + WS_KBAR);
    const float* kvg = a.in[4] + j * 128;
    const bf16* wukt = (const bf16*)(F.ws + WS_WUKT) + (size_t)j * 8 * 128 * 64;
    const int lane = F.lane, wave = F.wave;
    for (int chunk = F.blk; chunk < 256; chunk += F.G) {
        const int tok0 = chunk * 128;
#pragma unroll 1
        for (int i0 = 0; i0 < 16; i0 += 8) { unsigned wv[8];
#pragma unroll
            for (int i = 0; i < 8; ++i) wv[i] = *((const unsigned*)(proj + (size_t)(tok0 + wave * 16 + i0 + i) * EV_N + EC_CKV) + lane);
#pragma unroll
            for (int i = 0; i < 8; ++i) { const int tok = tok0 + wave * 16 + i0 + i; const float v0 = bf2f(wv[i] & 0xffffu), v1 = bf2f(wv[i] >> 16);
                const float ss = wave_sum(v0 * v0 + v1 * v1);
                const float r = 1.f / sqrtf(ss * (1.f / 128.f) + LN_EPS);
                *((unsigned*)(ckvn + (size_t)tok * 128) + lane) = cvtpk(v0 * r * kvg[2 * lane], v1 * r * kvg[2 * lane + 1]); } }
        { bf16* kic = (bf16*)(F.ws + WS_KIC); const int tok = tok0 + wave * 16 + (lane >> 2), c = (lane & 3) * 16;
            const v4u* src = (const v4u*)(proj + (size_t)tok * EV_N + EC_KI + c); v4u* dst = (v4u*)(kic + (size_t)tok * 64 + c); dst[0] = src[0]; dst[1] = src[1]; }
        { const int h = wave, l15 = lane & 15, kg = lane >> 4;
            bf16x8 af[8][2];
#pragma unroll
            for (int ct = 0; ct < 8; ++ct)
#pragma unroll
                for (int ks = 0; ks < 2; ++ks) af[ct][ks] = *(const bf16x8*)(wukt + ((size_t)h * 128 + ct * 16 + l15) * 64 + ks * 32 + kg * 8);
#pragma unroll 1
            for (int tg = 0; tg < 8; tg += 4) { bf16x8 qf[4][2];
#pragma unroll
                for (int u = 0; u < 4; ++u)
#pragma unroll
                    for (int ks = 0; ks < 2; ++ks) qf[u][ks] = *(const bf16x8*)(proj + (size_t)(tok0 + (tg + u) * 16 + l15) * EV_N + EC_QA + h * 64 + ks * 32 + kg * 8);
#pragma unroll
                for (int u = 0; u < 4; ++u) { const int tok = tok0 + (tg + u) * 16 + l15;
#pragma unroll
                    for (int ct = 0; ct < 8; ++ct) { f32x4 d = {0.f, 0.f, 0.f, 0.f};
                        d = mfma16(af[ct][0], qf[u][0], d); d = mfma16(af[ct][1], qf[u][1], d);
                        v2u w; w.x = cvtpk(d[0], d[1]); w.y = cvtpk(d[2], d[3]);
                        *(v2u*)(ql + (size_t)tok * 1024 + h * 128 + ct * 16 + 4 * kg) = w; } } } }
        if (chunk < 128) { const int b = chunk >> 5, n = chunk & 31; float s8[8];
#pragma unroll
            for (int k = 0; k < 8; ++k) s8[k] = 0.f;
            const bf16* kp = proj + ((size_t)b * SEQ + n * 256 + wave * 32) * EV_N + EC_KB + lane * 8;
#pragma unroll 8
            for (int r = 0; r < 32; ++r) { const v4u w = *(const v4u*)(kp + (size_t)r * EV_N);
#pragma unroll
                for (int k = 0; k < 4; ++k) { s8[2 * k] += bf2f(w[k] & 0xffffu); s8[2 * k + 1] += bf2f(w[k] >> 16); } }
            LAS float* red = (LAS float*)F.lds;
            __syncthreads();
#pragma unroll
            for (int k = 0; k < 8; ++k) red[wave * 512 + lane * 8 + k] = s8[k];
            __syncthreads();
            float s = 0.f;
#pragma unroll
            for (int w = 0; w < 8; ++w) s += red[w * 512 + F.tid];
            const int h = F.tid >> 6, d = F.tid & 63;
            kbar[(((size_t)b * 8 + h) * 32 + n) * 64 + d] = s * (1.f / 256.f); }
    }
}

DI void moba_gate_chunk(const Fr& F, int chunk) {
    const bf16* proj = (const bf16*)(F.ws + WS_PROJ); const float* kbar = (const float*)(F.ws + WS_KBAR); unsigned* sel3 = (unsigned*)(F.ws + WS_SEL3);
    const int tok0 = chunk * 128, b = tok0 / SEQ, own = (tok0 % SEQ) >> 8, h = F.wave, lane = F.lane;
    float q0[64], q1[64];
    { const v4u* p0 = (const v4u*)(proj + (size_t)(tok0 + lane) * EV_N + EC_QB + h * 64); const v4u* p1 = (const v4u*)(proj + (size_t)(tok0 + 64 + lane) * EV_N + EC_QB + h * 64);
#pragma unroll
        for (int i = 0; i < 8; ++i) { const v4u w0 = p0[i], w1 = p1[i];
#pragma unroll
            for (int k = 0; k < 4; ++k) { q0[8 * i + 2 * k] = bf2f(w0[k] & 0xffffu); q0[8 * i + 2 * k + 1] = bf2f(w0[k] >> 16); q1[8 * i + 2 * k] = bf2f(w1[k] & 0xffffu); q1[8 * i + 2 * k + 1] = bf2f(w1[k] >> 16); } } }
    float a0 = -INFINITY, a1 = -INFINITY, a2 = -INFINITY, c0 = -INFINITY, c1 = -INFINITY, c2 = -INFINITY; int ai0 = 0, ai1 = 0, ai2 = 0, ci0 = 0, ci1 = 0, ci2 = 0;
    const float* kb = kbar + (((size_t)b * 8 + h) * 32) * 64;
    for (int n = 0; n < own; ++n) { float g0 = 0.f, g1 = 0.f;
#pragma unroll
        for (int d = 0; d < 64; d += 4) { const f32x4 kv = *(const f32x4*)(kb + n * 64 + d);
#pragma unroll
            for (int k = 0; k < 4; ++k) { g0 += q0[d + k] * kv[k]; g1 += q1[d + k] * kv[k]; } }
        if (g0 > a2) { if (g0 > a1) { a2 = a1; ai2 = ai1; if (g0 > a0) { a1 = a0; ai1 = ai0; a0 = g0; ai0 = n; } else { a1 = g0; ai1 = n; } } else { a2 = g0; ai2 = n; } }
        if (g1 > c2) { if (g1 > c1) { c2 = c1; ci2 = ci1; if (g1 > c0) { c1 = c0; ci1 = ci0; c0 = g1; ci0 = n; } else { c1 = g1; ci1 = n; } } else { c2 = g1; ci2 = n; } }
    }
    const unsigned nv = own < 3 ? own : 3;
    sel3[(size_t)(tok0 + lane) * 8 + h] = (unsigned)ai0 | ((unsigned)ai1 << 8) | ((unsigned)ai2 << 16) | (nv << 24);
    sel3[(size_t)(tok0 + 64 + lane) * 8 + h] = (unsigned)ci0 | ((unsigned)ci1 << 8) | ((unsigned)ci2 << 16) | (nv << 24);
}

constexpr int HS = 257;
DI float relu1(float x) { const unsigned u = __float_as_uint(x); return __uint_as_float(u & ~(unsigned)((int)u >> 31)); }
template <int MODE, bool DIAG> DI void idx_tile(const bf16x8 (&kf)[4], LAS const char* qb  , const float (&wj)[4], int kt, int q, int hi, unsigned c0, unsigned c1,
                                     LAS unsigned* hist, LAS unsigned* mask, LAS unsigned* cmask, LAS unsigned long long* cand, LAS unsigned* rinfo) {
    f32x2 scp[8];
#pragma unroll
    for (int p = 0; p < 8; ++p) scp[p] = (f32x2){0.f, 0.f};
    bf16x8 qv0[2][4], qv1[2][4];
#pragma unroll
    for (int j = 0; j < 2; ++j)
#pragma unroll
        for (int s = 0; s < 4; ++s) qv0[j][s] = *(LAS const bf16x8*)(qb + (j * 8 + s * 2) * 512);
#pragma unroll
    for (int j = 0; j < 2; ++j)
#pragma unroll
        for (int s = 0; s < 4; ++s) qv1[j][s] = *(LAS const bf16x8*)(qb + ((2 + j) * 8 + s * 2) * 512);
    __builtin_amdgcn_sched_barrier(0);
#pragma unroll
    for (int g = 0; g < 2; ++g) { f32x16 acc[2];
#pragma unroll
        for (int j = 0; j < 2; ++j)
#pragma unroll
            for (int r = 0; r < 16; ++r) acc[j][r] = 0.f;
#pragma unroll
        for (int s = 0; s < 4; ++s)
#pragma unroll
            for (int j = 0; j < 2; ++j) acc[j] = mfma32(kf[s], g == 0 ? qv0[j][s] : qv1[j][s], acc[j]);
#pragma unroll
        for (int p = 0; p < 8; ++p)
#pragma unroll
            for (int j = 0; j < 2; ++j) { const f32x2 a = {relu1(acc[j][2 * p]), relu1(acc[j][2 * p + 1])}; const f32x2 w2 = {wj[2 * g + j], wj[2 * g + j]}; scp[p] = a * w2 + scp[p]; } }
    unsigned sel = 0u, cnd = 0u;
    if (MODE == 0) { float t = 0.f;
#pragma unroll
        for (int p = 0; p < 8; ++p) t += scp[p][0] + scp[p][1];
        if (t == 12345.678f) __hip_atomic_fetch_or(mask + q * HS + kt, 1u, __ATOMIC_RELAXED, __HIP_MEMORY_SCOPE_WORKGROUP);
        return; }
    const float F0 = __uint_as_float(c0), F1 = __uint_as_float(c1);
#pragma unroll
    for (int r = 0; r < 16; ++r) { const int kr = crow(r, hi);
        const bool ok = !DIAG || kr <= q;
        const float scv = scp[r >> 1][r & 1]; const unsigned u = __float_as_uint(scv);
        if (MODE == 1) { const unsigned key = u ^ ((unsigned)((int)u >> 31) | 0x80000000u);
            if (ok && (key >> 24) >= c0) __hip_atomic_fetch_add(hist + q * HS + (key >> 24), 1u, __ATOMIC_RELAXED, __HIP_MEMORY_SCOPE_WORKGROUP); }
        else if (MODE == 2) { if (ok && (u >> 24) == c0) __hip_atomic_fetch_add(hist + q * HS + (((u >> 16) & 255u) ^ c1), 1u, __ATOMIC_RELAXED, __HIP_MEMORY_SCOPE_WORKGROUP); }
        else { const bool ge1 = scv >= F1, ge0 = scv >= F0;
            if (ok && ge1) sel |= 1u << kr;
            if (ok && ge0 && !ge1) { cnd |= 1u << kr; const unsigned key = u ^ ((unsigned)((int)u >> 31) | 0x80000000u);
                const unsigned pos = __hip_atomic_fetch_add(rinfo + 128 + q, 1u, __ATOMIC_RELAXED, __HIP_MEMORY_SCOPE_WORKGROUP);
                if (pos < 64u) cand[q * 64 + pos] = ((unsigned long long)key << 32) | (unsigned)(~(unsigned)(kt * 32 + kr)); } } }
    if (MODE == 3) { if (sel) __hip_atomic_fetch_or(mask + q * HS + kt, sel, __ATOMIC_RELAXED, __HIP_MEMORY_SCOPE_WORKGROUP);
        if (cnd) __hip_atomic_fetch_or(cmask + q * HS + kt, cnd, __ATOMIC_RELAXED, __HIP_MEMORY_SCOPE_WORKGROUP); }
}
template <int MODE> DI void idx_pass(const bf16* proj, int rowbase, int qt, LAS const char* qimg, const float (&wj)[4], LAS unsigned* hist, LAS unsigned* mask, LAS unsigned* cmask, LAS unsigned long long* cand, LAS unsigned* rinfo, int wave, int lane) {
    const int q = lane & 31, hi = lane >> 5, nkt = qt + 1;
    const unsigned b1 = MODE == 2 ? rinfo[160 + q] : rinfo[224 + q], thr16 = MODE == 2 ? rinfo[192 + q] : rinfo[256 + q];
    const bf16* kp0 = proj + (size_t)(rowbase + q) * 64 + hi * 8;
    LAS const char* qb = qimg + hi * 512 + q * 16;
    const int n = nkt > wave ? (nkt - wave + 7) >> 3 : 0;
    bf16x8 kfa[4], kfb[4];
#define IDX_LOAD(KF, I) do { const bf16* kp_ = kp0 + (size_t)((wave + 8 * (I)) * 32) * 64; _Pragma("unroll") for (int s_ = 0; s_ < 4; ++s_) KF[s_] = *(const bf16x8*)(kp_ + s_ * 16); } while (0)
#define IDX_TILE(KF, I) do { const int kt_ = wave + 8 * (I); if (kt_ == qt) idx_tile<MODE, true>(KF, qb, wj, kt_, q, hi, b1, thr16, hist, mask, cmask, cand, rinfo); \
        else idx_tile<MODE, false>(KF, qb, wj, kt_, q, hi, b1, thr16, hist, mask, cmask, cand, rinfo); } while (0)
    if (n > 0) IDX_LOAD(kfa, 0);
    for (int i = 0; i < n; i += 2) {
        if (i + 1 < n) IDX_LOAD(kfb, i + 1);
        IDX_TILE(kfa, i);
        if (i + 1 < n) { if (i + 2 < n) IDX_LOAD(kfa, i + 2); IDX_TILE(kfb, i + 1); }
    }
#undef IDX_LOAD
#undef IDX_TILE
}
DI void hist_pick(LAS const unsigned* hrow, unsigned need, int lane, unsigned& bin, unsigned& above) {
    unsigned h4[4];
#pragma unroll
    for (int k = 0; k < 4; ++k) h4[k] = hrow[4 * lane + k];
    const unsigned ssum = h4[0] + h4[1] + h4[2] + h4[3];
    unsigned x = ssum;
#pragma unroll
    for (int o = 1; o < 64; o <<= 1) { const unsigned y = __shfl_down(x, o); if (lane + o < 64) x += y; }
    const unsigned long long m = __ballot(x >= need);
    const int Ls = m ? 63 - __builtin_clzll(m) : 0;
    const unsigned xs = __shfl(x, Ls), ss = __shfl(ssum, Ls);
    const unsigned h0 = __shfl(h4[0], Ls), h1 = __shfl(h4[1], Ls), h2 = __shfl(h4[2], Ls), h3 = __shfl(h4[3], Ls);
    unsigned cum = xs - ss;
    if (cum + h3 >= need) { bin = 4 * Ls + 3; above = cum; return; } cum += h3;
    if (cum + h2 >= need) { bin = 4 * Ls + 2; above = cum; return; } cum += h2;
    if (cum + h1 >= need) { bin = 4 * Ls + 1; above = cum; return; } cum += h1;
    bin = 4 * Ls; above = cum; (void)h0;
}
DI void idx_pass1(const bf16* proj, int rowbase, int qt, LAS const char* qimg, const float (&wj)[4], LAS unsigned* hist, LAS unsigned* mask, LAS unsigned* cmask, LAS unsigned long long* cand, LAS unsigned* rinfo, int wave, int lane) {
    const int q = lane & 31, hi = lane >> 5, nkt = qt + 1, nmax = (nkt + 7) >> 3;
    const bf16* kp0 = proj + (size_t)(rowbase + q) * 64 + hi * 8;
    LAS const char* qb = qimg + hi * 512 + q * 16;
    unsigned lb = 0u;
    bf16x8 kfc[4], kfn[4];
    if (wave < nkt) {
#pragma unroll
        for (int s = 0; s < 4; ++s) kfc[s] = *(const bf16x8*)(kp0 + (size_t)(wave * 32) * 64 + s * 16); }
    for (int i = 0; i < nmax; ++i) { const int kt = wave + 8 * i;
        if (kt + 8 < nkt) {
#pragma unroll
            for (int s = 0; s < 4; ++s) kfn[s] = *(const bf16x8*)(kp0 + (size_t)((kt + 8) * 32) * 64 + s * 16); }
        if (kt < nkt) { if (kt == qt) idx_tile<1, true>(kfc, qb, wj, kt, q, hi, lb, 0u, hist, mask, cmask, cand, rinfo); else idx_tile<1, false>(kfc, qb, wj, kt, q, hi, lb, 0u, hist, mask, cmask, cand, rinfo); }
#pragma unroll
        for (int s = 0; s < 4; ++s) kfc[s] = kfn[s];
        if (((i + 1) & i) == 0 && i + 1 < nmax && i < 16) {
            __syncthreads();
#pragma unroll 1
            for (int rr = 0; rr < 4; ++rr) { const int row = wave * 4 + rr; unsigned bin, above; hist_pick(hist + row * HS, 256u, lane, bin, above);
                if (lane == 0) rinfo[288 + row] = bin; }
            __syncthreads();
            { const unsigned nb = rinfo[288 + q]; lb = nb > lb ? nb : lb; } }
    }
}
DI void idx_unit(const Fr& F, int b, int qt, int stop = 0  ) {
    const bf16* proj = (const bf16*)(F.ws + WS_PROJ); const bf16* kic = (const bf16*)(F.ws + WS_KIC); unsigned short* sel = (unsigned short*)(F.ws + WS_SEL);
    LAS unsigned* hist = (LAS unsigned*)(F.lds); LAS unsigned* mask = hist + 32 * HS; LAS unsigned* cmask = mask + 32 * HS;
    LAS unsigned long long* cand = (LAS unsigned long long*)(F.lds + 99328); LAS unsigned* rinfo = (LAS unsigned*)(F.lds + 115712);
    const int lane = F.lane, wave = F.wave, tid = F.tid, t0 = qt * 32, rowbase = b * SEQ;
    __syncthreads();
    for (int i = tid; i < 3 * 32 * HS; i += NTHR) hist[i] = 0u;
    if (tid < 320) rinfo[tid] = 0u;
    __syncthreads();
    if (t0 + 31 <= 255 || (EXPF & 64)) {
        if (lane < 8) {
#pragma unroll
            for (int rr = 0; rr < 4; ++rr) { const int row = wave * 4 + rr, nv = t0 + row + 1;
                const int nv0 = t0 + row + 1; const int nvc = nv0 < 256 ? nv0 : 256; (void)nv; mask[row * HS + lane] = nvc >= 32 * (lane + 1) ? 0xffffffffu : (nvc > 32 * lane ? ((1u << (nvc - 32 * lane)) - 1u) : 0u); } }
    } else {
        const int q = lane & 31;
        float wj[4];
        { const bf16* qp = proj + (size_t)(rowbase + t0 + q) * EV_N;
#pragma unroll
            for (int j = 0; j < 4; ++j) wj[j] = bf2f(qp[EC_WI + j]); }
        LAS char* qimg = (LAS char*)(F.lds + 117248);
#pragma unroll
        for (int i = 0; i < 2; ++i) { const int p = tid + i * NTHR, row = p & 31, c = p >> 5;
            *(LAS v4u*)(qimg + c * 512 + row * 16) = *(const v4u*)(proj + (size_t)(rowbase + t0 + row) * EV_N + EC_QI + c * 8); }
        __syncthreads();
        if (stop == 4) { idx_pass<0>(kic, rowbase, qt, qimg, wj, hist, mask, cmask, cand, rinfo, wave, lane); return; }
        idx_pass1(kic, rowbase, qt, qimg, wj, hist, mask, cmask, cand, rinfo, wave, lane);
        __syncthreads();
#pragma unroll 1
        for (int rr = 0; rr < 4; ++rr) { const int row = wave * 4 + rr; unsigned bin, above; hist_pick(hist + row * HS, 256u, lane, bin, above);
            if (lane == 0) { rinfo[row] = bin; rinfo[32 + row] = 256u - above; rinfo[160 + row] = bin >= 128u ? bin - 128u : 255u - bin; rinfo[192 + row] = bin >= 128u ? 0u : 255u; } }
        __syncthreads();
        if (stop == 1) return;
        for (int i = tid; i < 32 * HS; i += NTHR) hist[i] = 0u;
        __syncthreads();
        idx_pass<2>(kic, rowbase, qt, qimg, wj, hist, mask, cmask, cand, rinfo, wave, lane);
        __syncthreads();
#pragma unroll 1
        for (int rr = 0; rr < 4; ++rr) { const int row = wave * 4 + rr; const unsigned need1 = rinfo[32 + row]; unsigned bin, above; hist_pick(hist + row * HS, need1, lane, bin, above);
            if (lane == 0) { const unsigned t16 = (rinfo[row] << 8) | bin, k0 = t16 << 16, k1 = (t16 + 1u) << 16;
                rinfo[64 + row] = t16; rinfo[96 + row] = need1 - above;
                rinfo[224 + row] = (k0 & 0x80000000u) ? (k0 ^ 0x80000000u) : ~k0; rinfo[256 + row] = (t16 == 0xffffu) ? 0x7fc00000u : ((k1 & 0x80000000u) ? (k1 ^ 0x80000000u) : ~k1); } }
        __syncthreads();
        if (stop == 2) return;
        idx_pass<3>(kic, rowbase, qt, qimg, wj, hist, mask, cmask, cand, rinfo, wave, lane);
        __syncthreads();
        if (stop == 3) return;
#pragma unroll 1
        for (int rr = 0; rr < 4; ++rr) { const int row = wave * 4 + rr; const unsigned call = rinfo[128 + row], need2 = rinfo[96 + row];
            if (call <= 64u) { const unsigned c = call;
                const unsigned long long mine = cand[row * 64 + lane]; unsigned rank = 0u;
                for (unsigned k = 0; k < c; ++k) rank += (cand[row * 64 + k] > mine) ? 1u : 0u;
                if ((unsigned)lane < c && rank < need2) { const unsigned s = ~(unsigned)mine;
                    __hip_atomic_fetch_or(mask + row * HS + (s >> 5), 1u << (s & 31), __ATOMIC_RELAXED, __HIP_MEMORY_SCOPE_WORKGROUP); } }
            else { unsigned w4[4];
#pragma unroll
                for (int k = 0; k < 4; ++k) w4[k] = cmask[row * HS + 4 * lane + k];
                const unsigned cnt = __popc(w4[0]) + __popc(w4[1]) + __popc(w4[2]) + __popc(w4[3]);
                unsigned x = cnt;
#pragma unroll
                for (int o = 1; o < 64; o <<= 1) { const unsigned y = __shfl_up(x, o); if (lane >= o) x += y; }
                unsigned before = x - cnt;
#pragma unroll
                for (int k = 0; k < 4; ++k) { unsigned w = w4[k]; const unsigned pc = __popc(w); unsigned take = 0u;
                    if (before < need2) { if (before + pc <= need2) take = w; else { unsigned left = need2 - before; while (left) { const unsigned b = w & (0u - w); take |= b; w ^= b; --left; } } }
                    before += pc;
                    if (take) mask[row * HS + 4 * lane + k] |= take; } }
        }
    }
    __syncthreads();
#pragma unroll 1
    for (int rr = 0; rr < 4; ++rr) { const int row = wave * 4 + rr; unsigned short* out = sel + (size_t)(rowbase + t0 + row) * 256;
        unsigned w4[4];
#pragma unroll
        for (int k = 0; k < 4; ++k) w4[k] = mask[row * HS + 4 * lane + k];
        const unsigned cnt = __popc(w4[0]) + __popc(w4[1]) + __popc(w4[2]) + __popc(w4[3]);
        unsigned x = cnt;
#pragma unroll
        for (int o = 1; o < 64; o <<= 1) { const unsigned y = __shfl_up(x, o); if (lane >= o) x += y; }
        const unsigned total = __shfl(x, 63); unsigned pos = x - cnt;
#pragma unroll
        for (int k = 0; k < 4; ++k) { unsigned w = w4[k]; const unsigned base = (unsigned)(4 * lane + k) * 32u;
            while (w) { const unsigned bit = __builtin_ctz(w); if (pos < 256u) out[pos] = (unsigned short)(base + bit); ++pos; w &= w - 1u; } }
        for (unsigned i = total + lane; i < 256u; i += 64u) out[i] = (unsigned short)0xffffu; }
}

struct AttSt { float m, l; f32x16 o0, o1; };
template <class BF> DI void att_subtile(AttSt& S, const bf16x8 (&qf)[4], LAS const char* Kst, LAS const char* Vb, int vdh, int vrow0, int lane, const BF& bias) {
    const int r32 = lane & 31, hi = lane >> 5;
    f32x16 p;
#pragma unroll
    for (int r = 0; r < 16; ++r) p[r] = bias.b(crow(r, hi)) - S.m;
    LAS const char* kp = Kst + hi * 512 + r32 * 16;
#pragma unroll
    for (int s = 0; s < 4; ++s) { const bf16x8 kf = *(LAS const bf16x8*)(kp + s * 1024); p = mfma32(kf, qf[s], p); }
    if (bias.any) {
#pragma unroll
        for (int r = 0; r < 16; ++r) p[r] = bias.msk(crow(r, hi)) ? -INFINITY : p[r]; }
    float mxa[4] = {-INFINITY, -INFINITY, -INFINITY, -INFINITY};
#pragma unroll
    for (int r = 0; r < 16; ++r) mxa[r & 3] = fmaxf(mxa[r & 3], p[r]);
    float mx = fmaxf(fmaxf(mxa[0], mxa[1]), fmaxf(mxa[2], mxa[3]));
    mx = fmaxf(mx, __shfl_xor(mx, 32));
    if (__any(mx > 16.f)) { const float dl = fmaxf(mx, 0.f), sc = ex2(-dl); S.m += dl; S.l *= sc;
#pragma unroll
        for (int r = 0; r < 16; ++r) { p[r] -= dl; S.o0[r] *= sc; S.o1[r] *= sc; } }
    float psa[4] = {0.f, 0.f, 0.f, 0.f};
#pragma unroll
    for (int r = 0; r < 16; ++r) { p[r] = ex2(p[r]); psa[r & 3] += p[r]; }
    S.l += (psa[0] + psa[1]) + (psa[2] + psa[3]);
    v4u pw0, pw1;
    pw0.x = cvtpk(p[0], p[1]); pw0.y = cvtpk(p[2], p[3]); pw0.z = cvtpk(p[4], p[5]); pw0.w = cvtpk(p[6], p[7]);
    pw1.x = cvtpk(p[8], p[9]); pw1.y = cvtpk(p[10], p[11]); pw1.z = cvtpk(p[12], p[13]); pw1.w = cvtpk(p[14], p[15]);
    const bf16x8 pf0 = __builtin_bit_cast(bf16x8, pw0), pf1 = __builtin_bit_cast(bf16x8, pw1);
    LAS const char* vp = Vb + (vrow0 + 4 * hi + ((lane & 15) >> 2)) * 64 + ((lane >> 4) & 1) * 32 + (lane & 3) * 8;
    { const bf16x8 v00 = cat8(vtr(vp), vtr(vp + 512)), v10 = cat8(vtr(vp + vdh), vtr(vp + vdh + 512));
      const bf16x8 v01 = cat8(vtr(vp + 1024), vtr(vp + 1536)), v11 = cat8(vtr(vp + vdh + 1024), vtr(vp + vdh + 1536));
      S.o0 = mfma32(v00, pf0, S.o0); S.o1 = mfma32(v10, pf0, S.o1);
      S.o0 = mfma32(v01, pf1, S.o0); S.o1 = mfma32(v11, pf1, S.o1); }
}
template <class BF0, class BF1> DI void att_tile64(AttSt& S, const bf16x8 (&qf)[4], LAS const char* Kst, LAS const char* Vb, int vdh, int vrow0, int lane, const BF0& bias0, const BF1& bias1) {
    const int r32 = lane & 31, hi = lane >> 5;
    f32x16 p0, p1;
#pragma unroll
    for (int r = 0; r < 16; ++r) { p0[r] = bias0.b(crow(r, hi)) - S.m; p1[r] = bias1.b(crow(r, hi)) - S.m; }
    LAS const char* kp = Kst + hi * 512 + r32 * 16;
#pragma unroll
    for (int s = 0; s < 4; ++s) { const bf16x8 k0 = *(LAS const bf16x8*)(kp + s * 1024), k1 = *(LAS const bf16x8*)(kp + 4096 + s * 1024); p0 = mfma32(k0, qf[s], p0); p1 = mfma32(k1, qf[s], p1); }
    if (bias0.any) {
#pragma unroll
        for (int r = 0; r < 16; ++r) p0[r] = bias0.msk(crow(r, hi)) ? -INFINITY : p0[r]; }
    if (bias1.any) {
#pragma unroll
        for (int r = 0; r < 16; ++r) p1[r] = bias1.msk(crow(r, hi)) ? -INFINITY : p1[r]; }
    float mxa[4] = {-INFINITY, -INFINITY, -INFINITY, -INFINITY};
#pragma unroll
    for (int r = 0; r < 16; ++r) mxa[r & 3] = fmaxf(mxa[r & 3], fmaxf(p0[r], p1[r]));
    float mx = fmaxf(fmaxf(mxa[0], mxa[1]), fmaxf(mxa[2], mxa[3]));
    mx = fmaxf(mx, __shfl_xor(mx, 32));
    if (__any(mx > 16.f)) { const float dl = fmaxf(mx, 0.f), sc = ex2(-dl); S.m += dl; S.l *= sc;
#pragma unroll
        for (int r = 0; r < 16; ++r) { p0[r] -= dl; p1[r] -= dl; S.o0[r] *= sc; S.o1[r] *= sc; } }
    float psa[4] = {0.f, 0.f, 0.f, 0.f};
#pragma unroll
    for (int r = 0; r < 16; ++r) { p0[r] = ex2(p0[r]); p1[r] = ex2(p1[r]); psa[r & 3] += p0[r] + p1[r]; }
    S.l += (psa[0] + psa[1]) + (psa[2] + psa[3]);
    v4u a0, a1, b0, b1;
    a0.x = cvtpk(p0[0], p0[1]); a0.y = cvtpk(p0[2], p0[3]); a0.z = cvtpk(p0[4], p0[5]); a0.w = cvtpk(p0[6], p0[7]);
    a1.x = cvtpk(p0[8], p0[9]); a1.y = cvtpk(p0[10], p0[11]); a1.z = cvtpk(p0[12], p0[13]); a1.w = cvtpk(p0[14], p0[15]);
    b0.x = cvtpk(p1[0], p1[1]); b0.y = cvtpk(p1[2], p1[3]); b0.z = cvtpk(p1[4], p1[5]); b0.w = cvtpk(p1[6], p1[7]);
    b1.x = cvtpk(p1[8], p1[9]); b1.y = cvtpk(p1[10], p1[11]); b1.z = cvtpk(p1[12], p1[13]); b1.w = cvtpk(p1[14], p1[15]);
    LAS const char* vp = Vb + (vrow0 + 4 * hi + ((lane & 15) >> 2)) * 64 + ((lane >> 4) & 1) * 32 + (lane & 3) * 8;
#pragma unroll
    for (int k16 = 0; k16 < 4; ++k16) { const bf16x8 pf = __builtin_bit_cast(bf16x8, k16 == 0 ? a0 : k16 == 1 ? a1 : k16 == 2 ? b0 : b1);
        const bf16x8 v0 = cat8(vtr(vp + k16 * 1024), vtr(vp + k16 * 1024 + 512)), v1 = cat8(vtr(vp + vdh + k16 * 1024), vtr(vp + vdh + k16 * 1024 + 512));
        S.o0 = mfma32(v0, pf, S.o0); S.o1 = mfma32(v1, pf, S.o1); }
}

struct MobaFar { float c; bool any; DI float b(int) const { return c; } DI bool msk(int) const { return false; } };
struct MobaBias { LAS const float* lut; int tq, s0; bool any;
    DI float b(int kvrel) const { const int dist = tq - (s0 + kvrel); return lut[dist < 0 ? 0 : (dist > 1023 ? 1023 : dist)]; }
    DI bool msk(int kvrel) const { return tq - (s0 + kvrel) < 0; } };
DI void moba_qload(bf16x8 (&qf)[4], const bf16* proj, int rowbase, int h, int tq, int hi) {
    const bf16* qp = proj + (size_t)(rowbase + tq) * EV_N + EC_QB + h * 64 + hi * 8;
#pragma unroll
    for (int s = 0; s < 4; ++s) qf[s] = *(const bf16x8*)(qp + s * 16);
}
DI void moba_tile(const Fr& F, const bf16x8 (&qf)[4], int rowbase, int h, int n, int tq, bool valid, int slot, bool own, int wave_tile) {
    LAS const char* Kb = (LAS const char*)F.lds; LAS const char* Vb = (LAS const char*)(F.lds + 32768); LAS const float* lut = (LAS const float*)(F.lds + 98304);
    bf16* po = (bf16*)(F.ws + WS_ACT); float* pml = (float*)(F.ws + WS_PML);
    const int lane = F.lane, hi = lane >> 5;
    AttSt S; S.m = 0.f; S.l = 0.f;
#pragma unroll
    for (int r = 0; r < 16; ++r) { S.o0[r] = 0.f; S.o1[r] = 0.f; }
    const int nst = own ? wave_tile + 1 : 8;
    int tmin = tq;
#pragma unroll
    for (int o = 1; o < 64; o <<= 1) { const int y = __shfl_xor(tmin, o); tmin = y < tmin ? y : tmin; }
    const float cfar = lut[1023];
    int st = 0;
    for (; st + 1 < nst; st += 2) {
        if (!own && tmin - (n * 256 + st * 32 + 63) >= 790) { MobaFar bf{cfar, false}; att_tile64(S, qf, Kb + st * 4096, Vb, 16384, st * 32, lane, bf, bf); }
        else { MobaBias bf0{lut, tq, n * 256 + st * 32, false}, bf1{lut, tq, n * 256 + st * 32 + 32, own && st + 1 == wave_tile}; att_tile64(S, qf, Kb + st * 4096, Vb, 16384, st * 32, lane, bf0, bf1); } }
    if (st < nst) { MobaBias bf{lut, tq, n * 256 + st * 32, own && st == wave_tile}; att_subtile(S, qf, Kb + st * 4096, Vb, 16384, st * 32, lane, bf); }
    const float lt = S.l + __shfl_xor(S.l, 32), inv = 1.f / lt;
    if (valid) { const size_t pi = ((size_t)(rowbase + tq) * 8 + h) * 4 + slot; bf16* o = po + pi * 64;
#pragma unroll
        for (int a4 = 0; a4 < 4; ++a4) { v2u w0, w1;
            w0.x = cvtpk(S.o0[4 * a4] * inv, S.o0[4 * a4 + 1] * inv); w0.y = cvtpk(S.o0[4 * a4 + 2] * inv, S.o0[4 * a4 + 3] * inv);
            w1.x = cvtpk(S.o1[4 * a4] * inv, S.o1[4 * a4 + 1] * inv); w1.y = cvtpk(S.o1[4 * a4 + 2] * inv, S.o1[4 * a4 + 3] * inv);
            *(v2u*)(o + 8 * a4 + 4 * hi) = w0; *(v2u*)(o + 32 + 8 * a4 + 4 * hi) = w1; }
        if (hi == 0) { f32x2 ml = {S.m, lt}; *(f32x2*)(pml + pi * 2) = ml; } }
}
DI void moba_unit(const Args& a, const Fr& F, int b, int h, int n) {
    const bf16* proj = (const bf16*)(F.ws + WS_PROJ); const unsigned* sel3 = (const unsigned*)(F.ws + WS_SEL3);
    LAS unsigned char* lds = F.lds; LAS unsigned* list = (LAS unsigned*)(lds + 65536); LAS float* lut = (LAS float*)(lds + 98304); LAS unsigned* misc = (LAS unsigned*)(lds + 102400);
    const int tid = F.tid, lane = F.lane, wave = F.wave, rowbase = b * SEQ;
    __syncthreads();
    { const bf16* kg = proj + (size_t)(rowbase + n * 256) * EV_N + EC_KB + h * 64; const bf16* vg = proj + (size_t)(rowbase + n * 256) * EV_N + EC_VB + h * 64;
#pragma unroll
        for (int i = 0; i < 4; ++i) { const int p = tid + i * NTHR;
            { const int r = p & 31, c = (p >> 5) & 7, st = p >> 8; const v4u v = *(const v4u*)(kg + (size_t)(st * 32 + r) * EV_N + c * 8); *(LAS v4u*)(lds + st * 4096 + c * 512 + r * 16) = v; }
            { const int cc = p & 3, row = (p >> 2) & 255, dh = p >> 10; const v4u v = *(const v4u*)(vg + (size_t)row * EV_N + dh * 32 + cc * 8); *(LAS v4u*)(lds + 32768 + dh * 16384 + row * 64 + cc * 16) = v; } }
        for (int d = tid; d < 1024; d += NTHR) lut[d] = a.in[9][t5_bucket(d) * 16 + 8 + h] * LOG2E; }
    if (tid == 0) misc[16] = 0u;
    __syncthreads();
    unsigned sv[16];
#pragma unroll
    for (int k = 0; k < 16; ++k) { const int t = (n + 1) * 256 + k * NTHR + tid; sv[k] = t < SEQ ? sel3[(size_t)(rowbase + t) * 8 + h] : 0u; }
#pragma unroll
    for (int k = 0; k < 16; ++k) { const int tb = (n + 1) * 256 + k * NTHR; if (tb < SEQ) { const int t = tb + tid;
        const unsigned s = sv[k]; const unsigned nv = s >> 24; int slot = -1;
        if (nv > 0u && (s & 255u) == (unsigned)n) slot = 0; else if (nv > 1u && ((s >> 8) & 255u) == (unsigned)n) slot = 1; else if (nv > 2u && ((s >> 16) & 255u) == (unsigned)n) slot = 2;
        const unsigned long long bal = __ballot(slot >= 0); const unsigned wcnt = __popcll(bal);
        if (lane == 0) misc[wave] = wcnt;
        __syncthreads();
        unsigned off = misc[16], tot = 0u;
#pragma unroll
        for (int w = 0; w < 8; ++w) { const unsigned c = misc[w]; if (w < wave) off += c; tot += c; }
        if (slot >= 0) list[off + __popcll(bal & ((1ull << lane) - 1ull))] = ((unsigned)t << 2) | (unsigned)slot;
        __syncthreads();
        if (tid == 0) misc[16] += tot; } }
    __syncthreads();
    const int nlist = (int)misc[16];
    const int ntl = (nlist + 31) >> 5, hi = lane >> 5;
    bf16x8 qa[4], qb2[4];
    moba_qload(qa, proj, rowbase, h, n * 256 + wave * 32 + (lane & 31), hi);
    unsigned ea = 0u, eb = 0u; bool va = false, vb = false;
    int tl = wave;
    if (tl < ntl) { const int li = tl * 32 + (lane & 31); vb = li < nlist; eb = list[vb ? li : nlist - 1]; moba_qload(qb2, proj, rowbase, h, (int)(eb >> 2), hi); }
    moba_tile(F, qa, rowbase, h, n, n * 256 + wave * 32 + (lane & 31), true, 3, true, wave);
    for (; tl < ntl; tl += 16) {
        const int t2 = tl + 8, t3 = tl + 16;
        if (t2 < ntl) { const int li = t2 * 32 + (lane & 31); va = li < nlist; ea = list[va ? li : nlist - 1]; moba_qload(qa, proj, rowbase, h, (int)(ea >> 2), hi); }
        moba_tile(F, qb2, rowbase, h, n, (int)(eb >> 2), vb, (int)(eb & 3u), false, 0);
        if (t2 < ntl) {
            if (t3 < ntl) { const int li = t3 * 32 + (lane & 31); vb = li < nlist; eb = list[vb ? li : nlist - 1]; moba_qload(qb2, proj, rowbase, h, (int)(eb >> 2), hi); }
            moba_tile(F, qa, rowbase, h, n, (int)(ea >> 2), va, (int)(ea & 3u), false, 0); }
    }
}

DI void dsa_step(const bf16x8 (&af)[2][4], const bf16x8 (&qlf)[4], int ch, LAS const unsigned char* bsel, LAS unsigned char* cbuf, LAS const float* tab,
                 float& m, float& l, f32x4 (&oT)[8], int l15, int kg, int lane) {
    f32x4 acc[2];
#pragma unroll
    for (int mt = 0; mt < 2; ++mt) { const unsigned b4 = *(LAS const unsigned*)(bsel + ch * 32 + mt * 16 + 4 * kg);
#pragma unroll
        for (int i = 0; i < 4; ++i) { const unsigned bb = (b4 >> (8 * i)) & 255u; acc[mt][i] = bb != 255u ? tab[bb * 8 + (l15 & 7)] - m : -INFINITY; } }
#pragma unroll
    for (int mt = 0; mt < 2; ++mt)
#pragma unroll
        for (int ks = 0; ks < 4; ++ks) { acc[mt] = mfma16(af[mt][ks], qlf[ks], acc[mt]); *(LAS bf16x8*)(cbuf + (mt * 16 + l15) * 288 + (ks * 32 + kg * 8) * 2) = af[mt][ks]; }
    float mx = fmaxf(fmaxf(fmaxf(acc[0][0], acc[0][1]), fmaxf(acc[0][2], acc[0][3])), fmaxf(fmaxf(acc[1][0], acc[1][1]), fmaxf(acc[1][2], acc[1][3])));
    mx = fmaxf(mx, __shfl_xor(mx, 16)); mx = fmaxf(mx, __shfl_xor(mx, 32));
    if (__any(mx > 16.f)) { const float dl = fmaxf(mx, 0.f), sc = ex2(-dl); m += dl; l *= sc;
#pragma unroll
        for (int mt = 0; mt < 2; ++mt) acc[mt] = acc[mt] - dl;
#pragma unroll
        for (int ct = 0; ct < 8; ++ct) oT[ct] = oT[ct] * sc; }
    float ps = 0.f;
#pragma unroll
    for (int mt = 0; mt < 2; ++mt)
#pragma unroll
        for (int i = 0; i < 4; ++i) { acc[mt][i] = ex2(acc[mt][i]); ps += acc[mt][i]; }
    l += ps;
    v4u pw; pw.x = cvtpk(acc[0][0], acc[0][1]); pw.y = cvtpk(acc[0][2], acc[0][3]); pw.z = cvtpk(acc[1][0], acc[1][1]); pw.w = cvtpk(acc[1][2], acc[1][3]);
    const bf16x8 pf = __builtin_bit_cast(bf16x8, pw);
    LDS_WAIT();
    LAS const char* tp = (LAS const char*)cbuf + (4 * kg + (l15 >> 2)) * 288 + (lane & 3) * 8;
#pragma unroll
    for (int ct = 0; ct < 8; ++ct) { const bf16x8 cf = cat8(vtr(tp + ct * 32), vtr(tp + 16 * 288 + ct * 32)); oT[ct] = mfma16(cf, pf, oT[ct]); }
    LDS_WAIT();
}
DI void dsa_gather(bf16x8 (&af)[2][4], const bf16* ckvn, int rowbase, LAS const unsigned short* selb, int ch, int l15, int kg) {
#pragma unroll
    for (int mt = 0; mt < 2; ++mt) { unsigned idx = selb[ch * 32 + mt * 16 + l15]; if (idx == 0xffffu) idx = 0u;
        const bf16* cp = ckvn + (size_t)(rowbase + (int)idx) * 128 + kg * 8;
#pragma unroll
        for (int ks = 0; ks < 4; ++ks) af[mt][ks] = *(const bf16x8*)(cp + ks * 32); }
}
DI void dsa_query(const Fr& F, int tok, const v2u sv, LAS unsigned char* wl, LAS const unsigned char* bkt, LAS const float* tab) {
    const bf16* ql = (const bf16*)(F.ws + WS_QL); const bf16* ckvn = (const bf16*)(F.ws + WS_CKVN); const unsigned short* sel = (const unsigned short*)(F.ws + WS_SEL); bf16* ol = (bf16*)(F.ws + WS_OL);
    const int lane = F.lane, l15 = lane & 15, kg = lane >> 4, t = tok % SEQ, rowbase = tok - t;
    LAS unsigned short* selb = (LAS unsigned short*)wl; LAS unsigned char* bsel = wl + 512; LAS unsigned char* cbuf = wl + 1024;
    { *((LAS v2u*)selb + lane) = sv; unsigned bw = 0u;
#pragma unroll
        for (int i = 0; i < 4; ++i) { const unsigned s = (i < 2 ? (sv.x >> (16 * i)) : (sv.y >> (16 * (i - 2)))) & 0xffffu; const int dist = t - (int)s;
            const unsigned bb = (s != 0xffffu && dist >= 0) ? (unsigned)bkt[dist > 1023 ? 1023 : dist] : 255u; bw |= bb << (8 * i); }
        *((LAS unsigned*)bsel + lane) = bw; }
    bf16x8 qlf[4];
#pragma unroll
    for (int ks = 0; ks < 4; ++ks) { qlf[ks] = *(const bf16x8*)(ql + (size_t)tok * 1024 + (l15 & 7) * 128 + ks * 32 + kg * 8); if (l15 >= 8) qlf[ks] = (bf16x8){0, 0, 0, 0, 0, 0, 0, 0}; }
    float m = 0.f, l = 0.f; f32x4 oT[8];
#pragma unroll
    for (int ct = 0; ct < 8; ++ct) oT[ct] = (f32x4){0.f, 0.f, 0.f, 0.f};
    const int nvalid = t + 1 < 256 ? t + 1 : 256, nch = (nvalid + 31) >> 5;
    LDS_WAIT();
    bf16x8 afa[2][4], afb[2][4], afc[2][4];
    dsa_gather(afa, ckvn, rowbase, selb, 0, l15, kg);
    if (nch > 1) dsa_gather(afb, ckvn, rowbase, selb, 1, l15, kg);
    for (int ch = 0; ch < nch; ch += 3) {
        if (ch + 2 < nch) dsa_gather(afc, ckvn, rowbase, selb, ch + 2, l15, kg);
        dsa_step(afa, qlf, ch, bsel, cbuf, tab, m, l, oT, l15, kg, lane);
        if (ch + 1 < nch) { if (ch + 3 < nch) dsa_gather(afa, ckvn, rowbase, selb, ch + 3, l15, kg);
            dsa_step(afb, qlf, ch + 1, bsel, cbuf, tab, m, l, oT, l15, kg, lane); }
        if (ch + 2 < nch) { if (ch + 4 < nch) dsa_gather(afb, ckvn, rowbase, selb, ch + 4, l15, kg);
            dsa_step(afc, qlf, ch + 2, bsel, cbuf, tab, m, l, oT, l15, kg, lane); }
    }
    l += __shfl_xor(l, 16); l += __shfl_xor(l, 32);
    const float inv = 1.f / l;
    if (l15 < 8) { bf16* o = ol + (size_t)tok * 1024 + l15 * 128 + 4 * kg;
#pragma unroll
        for (int ct = 0; ct < 8; ++ct) { v2u w; w.x = cvtpk(oT[ct][0] * inv, oT[ct][1] * inv); w.y = cvtpk(oT[ct][2] * inv, oT[ct][3] * inv); *(v2u*)(o + ct * 16) = w; } }
}
DI void dsa_chunk(const Args& a, const Fr& F, int c32) {
    LAS unsigned char* bkt = F.lds + 81920; LAS float* tab = (LAS float*)(F.lds + 82944);
    __syncthreads();
    for (int d = F.tid; d < 1024; d += NTHR) bkt[d] = (unsigned char)t5_bucket(d);
    if (F.tid < 256) tab[F.tid] = a.in[9][(F.tid >> 3) * 16 + (F.tid & 7)] * LOG2E;
    __syncthreads();
    const unsigned short* selg = (const unsigned short*)(F.ws + WS_SEL); v2u svq[4];
#pragma unroll
    for (int i = 0; i < 4; ++i) svq[i] = *((const v2u*)(selg + (size_t)(c32 * 32 + F.wave * 4 + i) * 256) + F.lane);
#pragma unroll
    for (int i = 0; i < 4; ++i) dsa_query(F, c32 * 32 + F.wave * 4 + i, svq[i], F.lds + F.wave * 10240, bkt, tab);
}

DI void ph_even_post(const Fr& F, int j) {
    const bf16* ol = (const bf16*)(F.ws + WS_OL); bf16* ao = (bf16*)(F.ws + WS_AO);
    const bf16* wuvt = (const bf16*)(F.ws + WS_WUVT) + (size_t)j * 8 * 64 * 128;
    const bf16* po = (const bf16*)(F.ws + WS_ACT); const float* pml = (const float*)(F.ws + WS_PML); const unsigned* sel3 = (const unsigned*)(F.ws + WS_SEL3);
    const int lane = F.lane, wave = F.wave, l15 = lane & 15, kg = lane >> 4;
    for (int chunk = F.blk; chunk < 256; chunk += F.G) { const int tok0 = chunk * 128;
        { const int h = wave; bf16x8 af[4][4];
#pragma unroll
            for (int mt = 0; mt < 4; ++mt)
#pragma unroll
                for (int ks = 0; ks < 4; ++ks) af[mt][ks] = *(const bf16x8*)(wuvt + ((size_t)h * 64 + mt * 16 + l15) * 128 + ks * 32 + kg * 8);
#pragma unroll 1
            for (int tg = 0; tg < 8; tg += 2) { bf16x8 bf[2][4];
#pragma unroll
                for (int u = 0; u < 2; ++u)
#pragma unroll
                    for (int ks = 0; ks < 4; ++ks) bf[u][ks] = *(const bf16x8*)(ol + (size_t)(tok0 + (tg + u) * 16 + l15) * 1024 + h * 128 + ks * 32 + kg * 8);
#pragma unroll
                for (int u = 0; u < 2; ++u) { const int tok = tok0 + (tg + u) * 16 + l15;
#pragma unroll
                    for (int mt = 0; mt < 4; ++mt) { f32x4 d = {0.f, 0.f, 0.f, 0.f};
#pragma unroll
                        for (int ks = 0; ks < 4; ++ks) d = mfma16(af[mt][ks], bf[u][ks], d);
                        v2u w; w.x = cvtpk(d[0], d[1]); w.y = cvtpk(d[2], d[3]); *(v2u*)(ao + (size_t)tok * 1024 + h * 64 + mt * 16 + 4 * kg) = w; } } } }
#pragma unroll 1
        for (int i0 = 0; i0 < 16; i0 += 4) { const int h = lane >> 3, d0 = (lane & 7) * 8; unsigned nvv[4]; f32x2 mlv[4][4];
#pragma unroll
            for (int i = 0; i < 4; ++i) { const int tok = tok0 + wave * 16 + i0 + i; const size_t pi = ((size_t)tok * 8 + h) * 4; nvv[i] = sel3[(size_t)tok * 8 + h] >> 24;
#pragma unroll
                for (int s = 0; s < 4; ++s) mlv[i][s] = *(const f32x2*)(pml + (pi + s) * 2); }
#pragma unroll
            for (int i = 0; i < 4; ++i) { const int tok = tok0 + wave * 16 + i0 + i; const size_t pi = ((size_t)tok * 8 + h) * 4;
                float mj[4], lj[4];
#pragma unroll
                for (int s = 0; s < 4; ++s) { const bool ok = (s == 3) || ((unsigned)s < nvv[i]); mj[s] = ok ? mlv[i][s][0] : -1e30f; lj[s] = ok ? mlv[i][s][1] : 0.f; }
                const float ms = fmaxf(fmaxf(mj[0], mj[1]), fmaxf(mj[2], mj[3])); float wsum = 0.f, acc[8], wv[4]; v4u pv[4];
#pragma unroll
                for (int k = 0; k < 8; ++k) acc[k] = 0.f;
#pragma unroll
                for (int s = 0; s < 4; ++s) { wv[s] = lj[s] * ex2(mj[s] - ms); wsum += wv[s]; pv[s] = (v4u){0u, 0u, 0u, 0u}; if (wv[s] > 0.f) pv[s] = *(const v4u*)(po + (pi + s) * 64 + d0); }
#pragma unroll
                for (int s = 0; s < 4; ++s) { if (wv[s] > 0.f) {
#pragma unroll
                    for (int k = 0; k < 4; ++k) { acc[2 * k] += wv[s] * bf2f(pv[s][k] & 0xffffu); acc[2 * k + 1] += wv[s] * bf2f(pv[s][k] >> 16); } } }
                const float inv = 1.f / wsum; v4u o; o.x = cvtpk(acc[0] * inv, acc[1] * inv); o.y = cvtpk(acc[2] * inv, acc[3] * inv); o.z = cvtpk(acc[4] * inv, acc[5] * inv); o.w = cvtpk(acc[6] * inv, acc[7] * inv);
                *(v4u*)(ao + (size_t)tok * 1024 + 512 + h * 64 + d0) = o; } }
    }
}
DI f32x16 proj32_f32(const float* W, int ldw, int ncols, const float* xrow, int d_lo, int lane) {
    const int e = lane & 31, kh = lane >> 5; const bool ev = e < ncols;
    f32x16 D;
#pragma unroll
    for (int r = 0; r < 16; ++r) D[r] = 0.f;
    const float* wp = W + (size_t)(d_lo + 4 * kh) * ldw + (ev ? e : 0);
    const float* xp = xrow + d_lo + 4 * kh;
#pragma unroll 8
    for (int i = 0; i < 64; ++i) { const f32x4 xv = *(const f32x4*)(xp + 8 * i);
        float a0 = wp[(size_t)(8 * i + 0) * ldw], a1 = wp[(size_t)(8 * i + 1) * ldw], a2 = wp[(size_t)(8 * i + 2) * ldw], a3 = wp[(size_t)(8 * i + 3) * ldw];
        if (!ev) { a0 = 0.f; a1 = 0.f; a2 = 0.f; a3 = 0.f; }
        D = __builtin_amdgcn_mfma_f32_32x32x2f32(a0, xv[0], D, 0, 0, 0); D = __builtin_amdgcn_mfma_f32_32x32x2f32(a1, xv[1], D, 0, 0, 0);
        D = __builtin_amdgcn_mfma_f32_32x32x2f32(a2, xv[2], D, 0, 0, 0); D = __builtin_amdgcn_mfma_f32_32x32x2f32(a3, xv[3], D, 0, 0, 0); }
    return D;
}
DI void ph_odd_prep(const Args& a, const Fr& F, int j, int layer) {
    const bf16* proj = (const bf16*)(F.ws + WS_PROJ); const float* x = (const float*)(F.ws + WS_X);
    float* logf = (float*)(F.ws + WS_LOGF); float* cs = (float*)(F.ws + WS_CS);
    const float* wf = a.in[6] + (size_t)j * 1024 * 3088 + 3072; const float* bfv = a.in[7] + j * 16;
    LAS float* red = (LAS float*)(F.lds); LAS float* lfb = (LAS float*)(F.lds + 131072);
    LAS unsigned* kmx = (LAS unsigned*)(F.lds + 131072 + 8192);
    const int lane = F.lane, wave = F.wave, tid = F.tid, l31 = lane & 31, hi = lane >> 5;
    for (int chunk = F.blk; chunk < 256; chunk += F.G) { const int tok0 = chunk * 128, b = tok0 / SEQ, t0 = tok0 % SEQ;
        __syncthreads();
        if (tid < 16) kmx[tid] = 0u;
        const int tl = wave & 3, kr = wave >> 2;
        f32x16 D = proj32_f32(wf, 3088, 16, x + (size_t)(tok0 + tl * 32 + l31) * DM, kr * 512, lane);
        if (kr == 1) {
#pragma unroll
            for (int r = 0; r < 8; ++r) red[(tl * 8 + r) * 64 + lane] = D[r]; }
        __syncthreads();
        if (kr == 0) {
#pragma unroll
            for (int r = 0; r < 8; ++r) { const int h = (r & 3) + 8 * (r >> 2) + 4 * hi; const float z = D[r] + red[(tl * 8 + r) * 64 + lane] + bfv[h];
                const float ls = fminf(z, 0.f) - log1pf(__expf(-fabsf(z)));
                lfb[(tl * 32 + l31) * 16 + h] = ls * LOG2E; } }
#pragma unroll 1
        for (int i = 0; i < 4; ++i) { const int p = tid + i * NTHR, tk = p >> 4, h = p & 15; const v4u* kp = (const v4u*)(proj + (size_t)(tok0 + tk) * OD_N + OC_K + h * 64); float s = 0.f;
#pragma unroll
            for (int c = 0; c < 8; ++c) { const v4u w = kp[c];
#pragma unroll
                for (int k = 0; k < 4; ++k) { const float e0 = bf2f(w[k] & 0xffffu), e1 = bf2f(w[k] >> 16); s += e0 * e0 + e1 * e1; } }
            __hip_atomic_fetch_max(kmx + h, __float_as_uint(s), __ATOMIC_RELAXED, __HIP_MEMORY_SCOPE_WORKGROUP); }
        __syncthreads();
        for (int i = tid; i < 2048; i += NTHR) { const int h = i >> 7, tk = i & 127; logf[((size_t)b * 16 + h) * SEQ + t0 + tk] = lfb[tk * 16 + h]; }
        if (tid < 32) { const int h = tid & 15, c = tid >> 4; float s = 0.f;
            for (int k = 0; k < 64; ++k) s += lfb[(c * 64 + k) * 16 + h];
            cs[((size_t)b * 16 + h) * 128 + (t0 >> 6) + c] = s; }
        if (tid < 16) __hip_atomic_fetch_max(F.ctl + CW_KMAX + layer * 64 + b * 16 + tid, kmx[tid], RLX_AGENT);
    }
}

constexpr float FOX_SKIP_LOG2 = 64.f;
struct FoxBias { LAS const float* ng; int tq, kabs0; bool any;
    DI float b(int kvrel) const { return ng[kvrel]; }
    DI bool msk(int kvrel) const { return (kabs0 + kvrel) > tq; } };
DI void fox_unit(const Fr& F, int layer, int b, int h, int qb) {
    const bf16* proj = (const bf16*)(F.ws + WS_PROJ); const float* logf = (const float*)(F.ws + WS_LOGF); const float* cs = (const float*)(F.ws + WS_CS); bf16* ao = (bf16*)(F.ws + WS_AO);
    LAS unsigned char* lds = F.lds; LAS float* ng = (LAS float*)(lds + 32768); LAS float* red = (LAS float*)(lds + 65536 + 1024); LAS int* ibox = (LAS int*)(lds + 65536 + 2048);
    const int tid = F.tid, lane = F.lane, wave = F.wave, r32 = lane & 31, hi = lane >> 5, t0 = qb * 256, rowbase = b * SEQ, tq = t0 + wave * 32 + r32;
    __syncthreads();
    bf16x8 qf[4]; float qs = 0.f;
    { const bf16* qp = proj + (size_t)(rowbase + tq) * OD_N + OC_Q + h * 64 + hi * 8;
#pragma unroll
        for (int s = 0; s < 4; ++s) { qf[s] = *(const bf16x8*)(qp + s * 16);
#pragma unroll
            for (int k = 0; k < 8; ++k) { const float e = bf2f((unsigned short)qf[s][k]); qs += e * e; } } }
    qs += __shfl_xor(qs, 32); qs = wave_max(qs);
    if (lane == 0) red[wave] = qs;
    if (tid < 128) red[32 + tid] = (tid < t0 / 64) ? cs[((size_t)b * 16 + h) * 128 + tid] : 0.f;
    __syncthreads();
    if (tid == 0) { float qm = red[0];
        for (int w = 1; w < 8; ++w) qm = fmaxf(qm, red[w]);
        const float km = __uint_as_float(ld_u32(F.ctl + CW_KMAX + layer * 64 + b * 16 + h));
        const float B2 = 2.f * (sqrtf(qm * km) * 1.01f + 1.f);
        int kt = t0 / 64 - 1, kts = t0 / 64; float D = 0.f;
        while (kt >= 0 && B2 + D >= -FOX_SKIP_LOG2) { kts = kt; D += red[32 + kt]; --kt; }
        ibox[0] = kts; }
    __syncthreads();
    const int kts = ibox[0], s_start = kts * 64, nel = t0 + 256 - s_start;
    { const int i0 = tid * 16; float v[16]; const float* lp = logf + ((size_t)b * 16 + h) * SEQ + s_start + i0;
        if (i0 < nel) {
#pragma unroll
            for (int c = 0; c < 4; ++c) { const f32x4 w = *(const f32x4*)(lp + 4 * c); v[4 * c] = w[0]; v[4 * c + 1] = w[1]; v[4 * c + 2] = w[2]; v[4 * c + 3] = w[3]; } }
        else {
#pragma unroll
            for (int c = 0; c < 16; ++c) v[c] = 0.f; }
#pragma unroll
        for (int c = 1; c < 16; ++c) v[c] += v[c - 1];
        float xsum = v[15];
#pragma unroll
        for (int o = 1; o < 64; o <<= 1) { const float y = __shfl_up(xsum, o); if (lane >= o) xsum += y; }
        if (lane == 63) red[16 + wave] = xsum;
        __syncthreads();
        float off = xsum - v[15];
        for (int w = 0; w < wave; ++w) off += red[16 + w];
        if (i0 < nel) {
#pragma unroll
            for (int c = 0; c < 4; ++c) { f32x4 w = {-(off + v[4 * c]), -(off + v[4 * c + 1]), -(off + v[4 * c + 2]), -(off + v[4 * c + 3])}; *(LAS f32x4*)(ng + i0 + 4 * c) = w; } }
    }
    const int ntile = t0 / 64 + 4 - kts;
    const bf16* kg = proj + (size_t)rowbase * OD_N + OC_K + h * 64; const bf16* vg = proj + (size_t)rowbase * OD_N + OC_V + h * 64;
    const int kr = tid & 31, kc = (tid >> 5) & 7, kst = tid >> 8, vcc = tid & 3, vrow = (tid >> 2) & 63, vdh = tid >> 8;
    const int koff = kst * 4096 + kc * 512 + kr * 16, voff = 8192 + vdh * 4096 + vrow * 64 + vcc * 16;
    { const v4u kv = *(const v4u*)(kg + (size_t)(kts * 64 + kst * 32 + kr) * OD_N + kc * 8), vv = *(const v4u*)(vg + (size_t)(kts * 64 + vrow) * OD_N + vdh * 32 + vcc * 8);
        *(LAS v4u*)(lds + koff) = kv; *(LAS v4u*)(lds + voff) = vv; }
    __syncthreads();
    AttSt S; S.m = 0.f; S.l = 0.f;
#pragma unroll
    for (int r = 0; r < 16; ++r) { S.o0[r] = 0.f; S.o1[r] = 0.f; }
    const int wlast = t0 + wave * 32 + 31, wfirst = t0 + wave * 32;
    for (int i = 0; i < ntile; ++i) { const int kt = kts + i; LAS unsigned char* buf = lds + (i & 1) * 16384; LAS unsigned char* nbuf = lds + ((i + 1) & 1) * 16384;
        v4u kv, vv; const bool more = i + 1 < ntile;
        if (more) { kv = *(const v4u*)(kg + (size_t)((kt + 1) * 64 + kst * 32 + kr) * OD_N + kc * 8); vv = *(const v4u*)(vg + (size_t)((kt + 1) * 64 + vrow) * OD_N + vdh * 32 + vcc * 8); }
        { const int kv0 = kt * 64;
            if (kv0 + 32 <= wlast) { FoxBias bf0{ng + (kv0 - s_start), tq, kv0, kv0 + 31 > wfirst}, bf1{ng + (kv0 + 32 - s_start), tq, kv0 + 32, kv0 + 63 > wfirst};
                att_tile64(S, qf, (LAS const char*)buf, (LAS const char*)buf + 8192, 4096, 0, lane, bf0, bf1); }
            else if (kv0 <= wlast) { FoxBias bf{ng + (kv0 - s_start), tq, kv0, kv0 + 31 > wfirst};
                att_subtile(S, qf, (LAS const char*)buf, (LAS const char*)buf + 8192, 4096, 0, lane, bf); } }
        if (more) { *(LAS v4u*)(nbuf + koff) = kv; *(LAS v4u*)(nbuf + voff - 8192 + 8192) = vv; }
        __syncthreads(); }
    const float lt = S.l + __shfl_xor(S.l, 32), inv = 1.f / lt;
    bf16* o = ao + (size_t)(rowbase + tq) * 1024 + h * 64;
#pragma unroll
    for (int a4 = 0; a4 < 4; ++a4) { v2u w0, w1;
        w0.x = cvtpk(S.o0[4 * a4] * inv, S.o0[4 * a4 + 1] * inv); w0.y = cvtpk(S.o0[4 * a4 + 2] * inv, S.o0[4 * a4 + 3] * inv);
        w1.x = cvtpk(S.o1[4 * a4] * inv, S.o1[4 * a4 + 1] * inv); w1.y = cvtpk(S.o1[4 * a4 + 2] * inv, S.o1[4 * a4 + 3] * inv);
        *(v2u*)(o + 8 * a4 + 4 * hi) = w0; *(v2u*)(o + 32 + 8 * a4 + 4 * hi) = w1; }
}

DI void ph_ln1_router(const Args& a, const Fr& F, int layer) {
    const float* yp = (const float*)(F.ws + WS_YP); float* x1 = (float*)(F.ws + WS_X1); unsigned char* xb8 = F.ws + WS_XB8;
    unsigned* tope = (unsigned*)(F.ws + WS_TOPE); float* gate = (float*)(F.ws + WS_GATE); unsigned* rank = (unsigned*)(F.ws + WS_RANK);
    const float* g = a.in[10] + (size_t)(layer * 2) * DM; const float* bb = a.in[11] + (size_t)(layer * 2) * DM;
    const float* rw = a.in[12] + (size_t)layer * 1024 * 32; const float* rb = a.in[13] + layer * 32;
    LAS float* red = (LAS float*)(F.lds); LAS unsigned* lcnt = (LAS unsigned*)(F.lds + 131072);
    const int lane = F.lane, wave = F.wave, tid = F.tid, l31 = lane & 31, hi = lane >> 5;
    for (int chunk = F.blk; chunk < 256; chunk += F.G) { const int tok0 = chunk * 128;
        __syncthreads();
        if (tid < 32) lcnt[tid] = 0u;
#pragma unroll 1
        for (int k = 0; k < 16; k += 8) { f32x4 v[8][4];
#pragma unroll
            for (int i = 0; i < 8; ++i)
#pragma unroll
                for (int jj = 0; jj < 4; ++jj) v[i][jj] = *((const f32x4*)(yp + (size_t)(tok0 + wave * 16 + k + i) * DM) + lane + 64 * jj);
#pragma unroll
            for (int i = 0; i < 8; ++i) { const int tok = tok0 + wave * 16 + k + i;
                ln_row(v[i], g, bb, lane);
                store_row_f32(x1 + (size_t)tok * DM, v[i], lane);
#pragma unroll
                for (int jj = 0; jj < 4; ++jj) *((unsigned*)(xb8 + (size_t)tok * DM) + lane + 64 * jj) = pk4_fp8(v[i][jj][0] * F8_SX, v[i][jj][1] * F8_SX, v[i][jj][2] * F8_SX, v[i][jj][3] * F8_SX); } }
        asm volatile("s_waitcnt vmcnt(0)" ::: "memory");
        __syncthreads();
        const int tl = wave & 3, kr = wave >> 2, tokl = tok0 + tl * 32 + l31;
        f32x16 D = proj32_f32(rw, 32, 32, x1 + (size_t)tokl * DM, kr * 512, lane);
        if (kr == 1) {
#pragma unroll
            for (int r = 0; r < 16; ++r) red[(tl * 16 + r) * 64 + lane] = D[r]; }
        __syncthreads();
        if (kr == 0) {
            float lv[32];
#pragma unroll
            for (int r = 0; r < 16; ++r) { const float own = D[r] + red[(tl * 16 + r) * 64 + lane] + rb[crow(r, hi)]; const float oth = __shfl_xor(own, 32);
                lv[crow(r, 0)] = hi == 0 ? own : oth; lv[crow(r, 1)] = hi == 0 ? oth : own; }
            float tv[4]; int te[4];
#pragma unroll
            for (int r = 0; r < 4; ++r) { float mx = -INFINITY; int me = 0;
#pragma unroll
                for (int e = 0; e < 32; ++e) { if (lv[e] > mx) { mx = lv[e]; me = e; } }
                tv[r] = mx; te[r] = me;
#pragma unroll
                for (int e = 0; e < 32; ++e) { if (e == me) lv[e] = -INFINITY; } }
            const float e1 = __expf(tv[1] - tv[0]), e2 = __expf(tv[2] - tv[0]), e3 = __expf(tv[3] - tv[0]); const float inv = 1.f / (1.f + e1 + e2 + e3);
            if (hi == 0) { const size_t o = (size_t)tokl * 4;
                const float gv[4] = {inv, e1 * inv, e2 * inv, e3 * inv};
#pragma unroll
                for (int r = 0; r < 4; ++r) { const unsigned rk = __hip_atomic_fetch_add(lcnt + (te[r] & 31), 1u, __ATOMIC_RELAXED, __HIP_MEMORY_SCOPE_WORKGROUP);
                    tope[o + r] = (unsigned)(te[r] & 31); gate[o + r] = gv[r]; rank[o + r] = rk; } } }
        __syncthreads();
        if (tid < 32) __hip_atomic_store(F.ctl + CW_CNT + chunk * 32 + tid, lcnt[tid], RLX_AGENT);
    }
}

DI void ph_route(const Fr& F) {
    const unsigned char* xb8 = F.ws + WS_XB8; unsigned char* xg = F.ws + WS_XG;
    const unsigned* tope = (const unsigned*)(F.ws + WS_TOPE); const unsigned* rank = (const unsigned*)(F.ws + WS_RANK); unsigned* dest = (unsigned*)(F.ws + WS_DEST);
    LAS unsigned* P = (LAS unsigned*)(F.lds); LAS unsigned* pst = P + 512; LAS unsigned* pad = P + 544; LAS unsigned* base = P + 576; LAS unsigned* nt = P + 608;
    const int tid = F.tid, lane = F.lane, wave = F.wave;
    __syncthreads();
    { const int e = tid & 31, part = tid >> 5; unsigned s = 0u;
        for (int c = 0; c < 16; ++c) s += ld_u32(F.ctl + CW_CNT + (part * 16 + c) * 32 + e);
        P[part * 32 + e] = s; }
    __syncthreads();
    if (tid < 32) { unsigned tot = 0u;
        for (int p = 0; p < 16; ++p) tot += P[p * 32 + tid];
        pad[tid] = (tot + 255u) & ~255u; }
    __syncthreads();
    if (tid == 0) { unsigned acc = 0u;
        for (int e = 0; e < 32; ++e) { pst[e] = acc; acc += pad[e]; }
        nt[0] = acc >> 8; }
    __syncthreads();
    for (int chunk = F.blk; chunk < 256; chunk += F.G) {
        __syncthreads();
        if (tid < 32) { unsigned off = 0u; const int pf = chunk >> 4;
            for (int p = 0; p < pf; ++p) off += P[p * 32 + tid];
            for (int c = pf * 16; c < chunk; ++c) off += ld_u32(F.ctl + CW_CNT + c * 32 + tid);
            base[tid] = pst[tid] + off; }
        __syncthreads();
#pragma unroll 1
        for (int i0 = 0; i0 < 16; i0 += 4) { v4u src[4]; unsigned ee[4][4], rr[4][4];
#pragma unroll
            for (int i = 0; i < 4; ++i) { const int tok = chunk * 128 + wave * 16 + i0 + i; src[i] = *((const v4u*)(xb8 + (size_t)tok * DM) + lane);
#pragma unroll
                for (int k = 0; k < 4; ++k) { ee[i][k] = tope[(size_t)tok * 4 + k]; rr[i][k] = rank[(size_t)tok * 4 + k]; } }
#pragma unroll
            for (int i = 0; i < 4; ++i) { const int tok = chunk * 128 + wave * 16 + i0 + i;
#pragma unroll
                for (int k = 0; k < 4; ++k) { const unsigned d = base[ee[i][k]] + rr[i][k];
                    if (lane == 0) dest[(size_t)tok * 4 + k] = d;
                    *((v4u*)(xg + (size_t)d * DM) + lane) = src[i]; } } }
        if (chunk == 0) { const unsigned ntl = nt[0];
            if (tid == 0) __hip_atomic_store(F.ctl + CW_TILE, ntl, RLX_AGENT);
            for (unsigned i = tid; i < ntl; i += NTHR) { unsigned e = 0u;
                for (unsigned k = 1; k < 32; ++k) if (pst[k] <= i * 256u) e = k;
                __hip_atomic_store(F.ctl + CW_TILE + 64 + i, e, RLX_AGENT); } }
    }
}

DI void ph_combine_ln2(const Args& a, const Fr& F, int layer) {
    const float* x1 = (const float*)(F.ws + WS_X1); const bf16* yr = (const bf16*)(F.ws + WS_XG); float* xo = (float*)(F.ws + WS_X); bf16* xb = (bf16*)(F.ws + WS_XB);
    const float* gate = (const float*)(F.ws + WS_GATE); const unsigned* dest = (const unsigned*)(F.ws + WS_DEST);
    const float* g = a.in[10] + (size_t)(layer * 2 + 1) * DM; const float* bb = a.in[11] + (size_t)(layer * 2 + 1) * DM;
    const int lane = F.lane; const int gw = F.blk * NWAVES + F.wave, NGW = F.G * NWAVES;
    for (int tok = gw; tok < NTOK; tok += 4 * NGW) { f32x4 v[4][4];
#pragma unroll
        for (int i = 0; i < 4; ++i) { const int tk = tok + i * NGW; if (tk < NTOK) {
#pragma unroll
            for (int jj = 0; jj < 4; ++jj) v[i][jj] = *((const f32x4*)(x1 + (size_t)tk * DM) + lane + 64 * jj) * ALPHA;
#pragma unroll
            for (int k = 0; k < 4; ++k) { const float gk = gate[(size_t)tk * 4 + k]; const unsigned d = dest[(size_t)tk * 4 + k];
#pragma unroll
                for (int jj = 0; jj < 4; ++jj) { const v2u w = *((const v2u*)(yr + (size_t)d * DM) + lane + 64 * jj);
                    v[i][jj][0] += gk * bf2f(w.x & 0xffffu); v[i][jj][1] += gk * bf2f(w.x >> 16); v[i][jj][2] += gk * bf2f(w.y & 0xffffu); v[i][jj][3] += gk * bf2f(w.y >> 16); } } } }
#pragma unroll
        for (int i = 0; i < 4; ++i) { const int tk = tok + i * NGW; if (tk < NTOK) {
            ln_row(v[i], g, bb, lane);
            if (layer == DEPTH - 1) store_row_f32(a.out + (size_t)tk * DM, v[i], lane);
            else { store_row_f32(xo + (size_t)tk * DM, v[i], lane); store_row_bf16(xb + (size_t)tk * DM, v[i], lane); } } } }
}
constexpr int LDS_BYTES = 147456;
constexpr int LDS_BARW = 145408, LDS_QSLOT = 145472, LDS_TILE_E = 133632;
constexpr int NPL = 11;
constexpr int NPHASE = 1 + NPL * DEPTH;
#ifndef MK_SINGLE
#define MK_SINGLE 1
#endif
DI int q_next(const Fr& F, unsigned* ctr) {
    LAS int* slot = (LAS int*)(F.lds + LDS_QSLOT);
    __syncthreads();
    if (F.tid == 0) *slot = (int)__hip_atomic_fetch_add(ctr, 1u, RLX_AGENT);
    __syncthreads();
    return *slot;
}
DI int lane_id_fresh() { unsigned m_ = ~0u; asm volatile("" : "+s"(m_)); return (int)__builtin_amdgcn_mbcnt_hi(m_, __builtin_amdgcn_mbcnt_lo(m_, 0u)); }
#define RETID(F) do { int t2_ = F.tid; asm volatile("" : "+v"(t2_)); F.tid = t2_; F.lane = t2_ & 63; F.wave = __builtin_amdgcn_readfirstlane(t2_ >> 6); } while (0)
#ifndef PROBE_DUP
#define PROBE_DUP -1
#endif
#define NREP(q) ((PROBE_DUP == (q)) ? 2 : 1)
#define AS4 __attribute__((address_space(4)))
#define SITE() Args a; Fr F; { const AS4 Args* ap = (const AS4 Args*)__builtin_amdgcn_kernarg_segment_ptr(); asm volatile("" : "+s"(ap)); \
        _Pragma("unroll") for (int i_ = 0; i_ < 18; ++i_) a.in[i_] = ap->in[i_]; a.out = ap->out; a.ws = ap->ws; a.ph_lo = 0; a.ph_hi = 0; \
        int w_ = wv_s; asm volatile("" : "+s"(w_)); int t_ = w_ * 64 + lane_id_fresh(); asm volatile("" : "+v"(t_)); F.tid = t_; F.lane = t_ & 63; F.wave = __builtin_amdgcn_readfirstlane(t_ >> 6); \
        F.lds = (LAS unsigned char*)lds_raw; F.ws = a.ws; F.ctl = (unsigned*)(a.ws + WS_CTL); F.blk = blockIdx.x; F.G = gridDim.x; }
__global__ void __launch_bounds__(NTHR, 2) mega_fwd(Args a0) {
    extern __shared__ __attribute__((aligned(16))) unsigned char lds_raw[];
    const int wv_s = __builtin_amdgcn_readfirstlane((int)(threadIdx.x >> 6));
#if MK_SINGLE
    constexpr int lo = 0, hi = NPHASE; constexpr bool single = true;
#else
    const int lo = a0.ph_lo, hi = a0.ph_hi; constexpr bool single = false;
#endif
    if (threadIdx.x == 0) *(LAS v4u*)((LAS unsigned char*)lds_raw + LDS_BARW) = (v4u){0u, 0u, 0u, 0u};
    __syncthreads();
    if (single) (void)xcd_barrier_post((unsigned*)(a0.ws + WS_CTL) + CW_BAR, (volatile LAS unsigned*)((LAS unsigned char*)lds_raw + LDS_BARW));
#define IN(k) (lo <= (k) && (k) < hi)
#define SEAM() do { if (single) { const AS4 Args* ap_ = (const AS4 Args*)__builtin_amdgcn_kernarg_segment_ptr(); asm volatile("" : "+s"(ap_)); int w_ = wv_s; asm volatile("" : "+s"(w_)); \
        XcdBarrier b_; b_.bar = (unsigned*)(ap_->ws + WS_CTL) + CW_BAR; b_.x = xb_xcc_id(); b_.st = (volatile LAS unsigned*)((LAS unsigned char*)lds_raw + LDS_BARW); \
        xcd_barrier(b_, (w_ == 0) && (lane_id_fresh() == 0)); } } while (0)
    if (IN(0)) { _Pragma("unroll 1") for (int rep = 0; rep < NREP(100); ++rep) { { SITE(); ph_prologue(a, F); } SEAM(); } }
#pragma clang loop unroll(full)
    for (int L = 0; L < DEPTH; ++L) {
        const int pb = 1 + NPL * L, j = L >> 1; const bool odd = (L & 1) != 0;
        if (IN(pb + 0)) _Pragma("unroll 1") for (int rep = 0; rep < NREP(0); ++rep) {
            { SITE();
            const bf16* w = odd ? (const bf16*)(F.ws + WS_WOD) + (size_t)j * OD_N * 1024 : (const bf16*)(F.ws + WS_WEV) + (size_t)j * EV_N * 1024;
            const int N = odd ? OD_N : EV_N;
            pg8::Gemm g{(const bf16*)(F.ws + WS_XB), w, NTOK, N, 1024}; pg8::StaticOrder S; S.init(NTOK, N, F.G, F.blk);
            pg8::EpiBf16<0> E{(bf16*)(F.ws + WS_PROJ), N, nullptr, 1024, (size_t)1024, C2F};
            pg8::gemm_phase<pg8::EpiBf16<0>, pg8::StaticOrder, true, true>(F.lds, g, S, E, F.tid); }
            SEAM(); }
        if (IN(pb + 1)) _Pragma("unroll 1") for (int rep = 0; rep < NREP(1); ++rep) { { SITE(); if (odd) ph_odd_prep(a, F, j, L); else ph_even_prep(a, F, j); } SEAM(); }
        if (!odd && IN(pb + 2)) _Pragma("unroll 1") for (int rep = 0; rep < ((PROBE_DUP == 2 || (PROBE_DUP >= 21 && PROBE_DUP <= 22) || (PROBE_DUP >= 211 && PROBE_DUP <= 214)) ? 2 : 1); ++rep) {
            { SITE(); unsigned* ctr = F.ctl + CW_Q + 64 * (L * 2) + 1024 * rep;
            for (;;) { const int it = q_next(F, ctr); if (it >= 1280) break; RETID(F);
                if (it < 1024) { if (!(rep == 1 && PROBE_DUP == 22)) idx_unit(F, it & 3, 255 - (it >> 2), (rep == 1 && PROBE_DUP >= 211) ? PROBE_DUP - 210 : 0); } else { if (!(rep == 1 && (PROBE_DUP == 21 || PROBE_DUP >= 211))) moba_gate_chunk(F, it - 1024); } } }
            SEAM(); }
        if (IN(pb + 3)) _Pragma("unroll 1") for (int rep = 0; rep < ((PROBE_DUP == 3 || (PROBE_DUP == 31 && odd) || ((PROBE_DUP == 32 || PROBE_DUP == 33) && !odd)) ? 2 : 1); ++rep) {
            { SITE(); unsigned* ctr = F.ctl + CW_Q + 64 * (L * 2 + 1) + 1024 * rep;
            if (odd) { for (;;) { const int it = q_next(F, ctr); if (it >= 2048) break; RETID(F); const int bh = it & 63; fox_unit(F, L, bh >> 4, bh & 15, 31 - (it >> 6)); } }
            else { for (;;) { const int it = q_next(F, ctr); if (it >= 2048) break; RETID(F);
                    if (it < 1024) { const int bh = it & 31; if (!(rep == 1 && PROBE_DUP == 33)) moba_unit(a, F, bh >> 3, bh & 7, it >> 5); } else { if (!(rep == 1 && PROBE_DUP == 32)) dsa_chunk(a, F, it - 1024); } } } }
            SEAM(); }
        if (!odd && IN(pb + 4)) _Pragma("unroll 1") for (int rep = 0; rep < NREP(4); ++rep) { { SITE(); ph_even_post(F, j); } SEAM(); }
        if (IN(pb + 5)) _Pragma("unroll 1") for (int rep = 0; rep < NREP(5); ++rep) {
            { SITE();
            const float* xin = (L == 0) ? a.in[0] : (const float*)(F.ws + WS_X);
            pg8::Gemm g{(const bf16*)(F.ws + WS_AO), (const bf16*)(F.ws + WS_WOUT) + (size_t)L * 1024 * 1024, NTOK, 1024, 1024}; pg8::StaticOrder S; S.init(NTOK, 1024, F.G, F.blk);
            EpiResF32 E{xin, (float*)(F.ws + WS_YP), ALPHA};
            pg8::gemm_phase<EpiResF32, pg8::StaticOrder, true, true>(F.lds, g, S, E, F.tid); }
            SEAM(); }
        if (IN(pb + 6)) _Pragma("unroll 1") for (int rep = 0; rep < NREP(6); ++rep) { { SITE(); ph_ln1_router(a, F, L); } SEAM(); }
        if (IN(pb + 7)) _Pragma("unroll 1") for (int rep = 0; rep < NREP(7); ++rep) { { SITE(); ph_route(F); } SEAM(); }
        if (IN(pb + 8)) _Pragma("unroll 1") for (int rep = 0; rep < NREP(8); ++rep) {
            { SITE(); const int ntl = (int)ld_u32(F.ctl + CW_TILE);
            LAS unsigned* tle = (LAS unsigned*)(F.lds + LDS_TILE_E);
            for (int i = F.tid; i < ntl; i += NTHR) tle[i] = ld_u32(F.ctl + CW_TILE + 64 + i);
            __syncthreads();
            pg8::Gemm g{(const bf16*)(F.ws + WS_XG), (const bf16*)(F.ws + WS_WGU + (size_t)L * 32 * 2048 * 1024), NR_MAX, 32 * 2048, 512};
            GroupOrder S{tle, ntl, 3, F.G, F.blk};
            EpiSwiglu E{F.ws + WS_ACT, a.in[15] + (size_t)L * 32 * 2048};
            pg8::gemm_phase<EpiSwiglu, GroupOrder, true, true, true>(F.lds, g, S, E, F.tid); }
            SEAM(); }
        if (IN(pb + 9)) _Pragma("unroll 1") for (int rep = 0; rep < NREP(9); ++rep) {
            { SITE(); const int ntl = (int)ld_u32(F.ctl + CW_TILE);
            LAS unsigned* tle = (LAS unsigned*)(F.lds + LDS_TILE_E);
            for (int i = F.tid; i < ntl; i += NTHR) tle[i] = ld_u32(F.ctl + CW_TILE + 64 + i);
            __syncthreads();
            pg8::Gemm g{(const bf16*)(F.ws + WS_ACT), (const bf16*)(F.ws + WS_WDN + (size_t)L * 32 * 1024 * 1024), NR_MAX, 32 * 1024, 512};
            GroupOrder S{tle, ntl, 2, F.G, F.blk};
            EpiDown E{(bf16*)(F.ws + WS_XG), a.in[17] + (size_t)L * 32 * 1024};
            pg8::gemm_phase<EpiDown, GroupOrder, true, true, true>(F.lds, g, S, E, F.tid); }
            SEAM(); }
        if (IN(pb + 10)) _Pragma("unroll 1") for (int rep = 0; rep < NREP(10); ++rep) { { SITE(); ph_combine_ln2(a, F, L); } if (L + 1 < DEPTH || rep + 1 < NREP(10)) SEAM(); }
        if (PROBE_DUP == 900 && L + 1 < DEPTH) { _Pragma("unroll 1") for (int xb = 0; xb < 10; ++xb) SEAM(); }
    }
#undef IN
#undef SEAM
}

extern "C" void kernel_launch(void* const* d_in, const int* in_sizes, int n_in, void* d_out, int out_size, void* d_ws, size_t ws_size, hipStream_t stream) {
    static int grid = 0;
    if (grid == 0) {
        if (n_in != 18 || out_size != NTOK * DM || ws_size < WS_END) { fprintf(stderr, "kernel_launch: unexpected shapes (n_in %d, out %d, ws %zu); nothing launched\n", n_in, out_size, ws_size); grid = -1; return; }
        int dev = 0, cus = 0, per_cu = 0;
        if (hipGetDevice(&dev) != hipSuccess || hipDeviceGetAttribute(&cus, hipDeviceAttributeMultiprocessorCount, dev) != hipSuccess) { grid = -1; return; }
        if (hipFuncSetAttribute((const void*)mega_fwd, hipFuncAttributeMaxDynamicSharedMemorySize, LDS_BYTES) != hipSuccess) { fprintf(stderr, "kernel_launch: hipFuncSetAttribute failed\n"); grid = -1; return; }
        if (hipOccupancyMaxActiveBlocksPerMultiprocessor(&per_cu, (const void*)mega_fwd, NTHR, LDS_BYTES) != hipSuccess || per_cu < 1) fprintf(stderr, "kernel_launch: occupancy query reports %d\n", per_cu);
        (void)hipGetLastError();
        grid = cus;
    }
    if (grid < 0) return;
    (void)hipMemsetAsync((char*)d_ws + WS_CTL, 0, CTL_ZERO_BYTES, stream);
#ifdef EXP_SKIP
    (void)hipMemsetAsync((char*)d_ws + WS_AO, 0, 64 * MiB, stream);
    (void)hipMemsetAsync((char*)d_ws + WS_OL, 0, 64 * MiB, stream);
    if (EXP_SKIP & 4) { (void)hipMemsetAsync((char*)d_ws + WS_XG, 0, 272 * MiB, stream); (void)hipMemsetAsync((char*)d_ws + WS_DEST, 0, 1 * MiB, stream); }
#endif
    Args a{};
    for (int i = 0; i < 18; ++i) a.in[i] = (const float*)d_in[i];
    a.out = (float*)d_out; a.ws = (unsigned char*)d_ws;
#if MK_SINGLE
    a.ph_lo = 0; a.ph_hi = NPHASE;
    hipLaunchKernelGGL(mega_fwd, dim3(grid), dim3(NTHR), LDS_BYTES, stream, a);
#else
    for (int p = 0; p < NPHASE; ++p) {
        if (p > 0) { const int L = (p - 1) / NPL, q = (p - 1) % NPL; if ((L & 1) && (q == 2 || q == 4)) continue;
#ifdef EXP_SKIP
            if ((EXP_SKIP & 1) && !(L & 1) && q <= 4) continue;
            if ((EXP_SKIP & 2) && (L & 1) && q <= 4) continue;
            if ((EXP_SKIP & 4) && q >= 7 && q <= 9) continue;
#endif
        }
        a.ph_lo = p; a.ph_hi = p + 1;
        hipLaunchKernelGGL(mega_fwd, dim3(grid), dim3(NTHR), LDS_BYTES, stream, a);
    }
#endif
}
```

```cpp
#include <hip/hip_runtime.h>
#include <cstdio>
#include <cstdint>
#ifdef EXP_SKIP
#define EXPF EXP_SKIP
#else
#define EXPF 0
#endif
constexpr int NB = 4, SEQ = 8192, DM = 1024, NTOK = NB * SEQ, DEPTH = 4;
constexpr int EV_N = 2560, OD_N = 3072;
constexpr int EC_QA = 0, EC_QB = 512, EC_KB = 1024, EC_VB = 1536, EC_CKV = 2048, EC_QI = 2176, EC_KI = 2432, EC_WI = 2496;
constexpr int OC_Q = 0, OC_K = 1024, OC_V = 2048;
constexpr float LOG2E = 1.4426950408889634f;
constexpr float C2F = 0.125f * LOG2E;
constexpr float ALPHA = 1.681792830507429f;
constexpr float LN_EPS = 1e-5f;
constexpr int NR_MAX = 131072 + 32 * 256;
constexpr int NWAVES = 8, NTHR = 512;
constexpr size_t MiB = (size_t)1 << 20;
constexpr size_t WS_CTL = 0, CTL_ZERO_BYTES = 4 * MiB;
constexpr size_t WS_WEV = 8 * MiB, WS_WOD = 18 * MiB, WS_WOUT = 30 * MiB, WS_WUKT = 38 * MiB, WS_WUVT = 39 * MiB;
constexpr size_t WS_WGU = 40 * MiB, WS_WDN = 552 * MiB;
constexpr size_t WS_X = 808 * MiB, WS_X1 = 936 * MiB, WS_YP = 1064 * MiB, WS_XB = 1192 * MiB;
constexpr size_t WS_PROJ = 1256 * MiB, WS_AO = 1448 * MiB, WS_XG = 1512 * MiB, WS_ACT = 1784 * MiB;
constexpr size_t WS_QL = 2056 * MiB, WS_OL = 2120 * MiB, WS_CKVN = 2184 * MiB, WS_SEL = 2192 * MiB;
constexpr size_t WS_KBAR = 2208 * MiB, WS_SEL3 = 2209 * MiB, WS_LOGF = 2210 * MiB, WS_CS = 2212 * MiB;
constexpr size_t WS_TOPE = 2213 * MiB, WS_GATE = 2214 * MiB, WS_RANK = 2215 * MiB, WS_DEST = 2216 * MiB, WS_PML = 2217 * MiB;
constexpr size_t WS_XB8 = 2226 * MiB;
constexpr size_t WS_KIC = 2258 * MiB;
constexpr size_t WS_END = 2262 * MiB;
constexpr float F8_SX = 16.f, F8_SWG = 256.f, F8_SA = 4.f, F8_SWD = 512.f;
constexpr int CW_BAR = 4096, CW_Q = 8192, CW_KMAX = 12288, CW_CNT = 16384, CW_TILE = 32768;

#define GAS __attribute__((address_space(1)))
#define LAS __attribute__((address_space(3)))
#define DI __device__ __forceinline__
typedef unsigned short bf16;
typedef unsigned v4u __attribute__((ext_vector_type(4)));
typedef unsigned v2u __attribute__((ext_vector_type(2)));
typedef float f32x4 __attribute__((ext_vector_type(4)));
typedef float f32x2 __attribute__((ext_vector_type(2)));
typedef float f32x16 __attribute__((ext_vector_type(16)));
typedef short bf16x8 __attribute__((ext_vector_type(8)));
typedef short s16x4 __attribute__((ext_vector_type(4)));
typedef __bf16 bf16x2_t __attribute__((ext_vector_type(2)));
typedef GAS unsigned gu32;
#define RLX_AGENT __ATOMIC_RELAXED, __HIP_MEMORY_SCOPE_AGENT
#define LDS_WAIT() asm volatile("s_waitcnt lgkmcnt(0)" ::: "memory")

DI float bf2f(unsigned v) { return __uint_as_float(v << 16); }
DI unsigned cvtpk(float lo, float hi) { f32x2 v = {lo, hi}; bf16x2_t b = __builtin_convertvector(v, bf16x2_t); return __builtin_bit_cast(unsigned, b); }
DI unsigned f2bf(float f) { return cvtpk(f, 0.f) & 0xffffu; }
DI unsigned pk4_fp8(float a, float b, float c, float d) {
    a = fminf(fmaxf(a, -448.f), 448.f); b = fminf(fmaxf(b, -448.f), 448.f); c = fminf(fmaxf(c, -448.f), 448.f); d = fminf(fmaxf(d, -448.f), 448.f);
    int w = 0; w = __builtin_amdgcn_cvt_pk_fp8_f32(a, b, w, false); w = __builtin_amdgcn_cvt_pk_fp8_f32(c, d, w, true); return (unsigned)w; }
DI float ex2(float x) { return __builtin_amdgcn_exp2f(x); }
DI float wave_sum(float v) {
#pragma unroll
    for (int o = 1; o < 64; o <<= 1) v += __shfl_xor(v, o);
    return v;
}
DI float wave_max(float v) {
#pragma unroll
    for (int o = 1; o < 64; o <<= 1) v = fmaxf(v, __shfl_xor(v, o));
    return v;
}
DI unsigned ld_u32(const unsigned* p) { return __hip_atomic_load(p, RLX_AGENT); }
DI int crow(int r, int hi) { return (r & 3) + 8 * (r >> 2) + 4 * hi; }
DI f32x16 mfma32(bf16x8 a, bf16x8 b, f32x16 c) { return __builtin_amdgcn_mfma_f32_32x32x16_bf16(a, b, c, 0, 0, 0); }
DI f32x4 mfma16(bf16x8 a, bf16x8 b, f32x4 c) { return __builtin_amdgcn_mfma_f32_16x16x32_bf16(a, b, c, 0, 0, 0); }
typedef short v4i16_t __attribute__((ext_vector_type(4)));
DI s16x4 vtr(LAS const char* p) { return __builtin_bit_cast(s16x4, __builtin_amdgcn_ds_read_tr16_b64_v4i16((LAS v4i16_t*)p)); }
DI bf16x8 cat8(s16x4 a, s16x4 b) { return (bf16x8){a[0], a[1], a[2], a[3], b[0], b[1], b[2], b[3]}; }
DI int t5_bucket(int n) {
    if (n < 16) return n;
    int bkt = 16;
    bkt += (n >= 21); bkt += (n >= 27); bkt += (n >= 35); bkt += (n >= 46); bkt += (n >= 59); bkt += (n >= 77); bkt += (n >= 99); bkt += (n >= 128);
    bkt += (n >= 166); bkt += (n >= 216); bkt += (n >= 280); bkt += (n >= 363); bkt += (n >= 470); bkt += (n >= 609); bkt += (n >= 790);
    return bkt;
}
namespace pg8 {
#define PG8_LAS __attribute__((address_space(3)))
typedef unsigned short bf16_t;
typedef short bf16x8 __attribute__((ext_vector_type(8)));
typedef float f32x4 __attribute__((ext_vector_type(4)));
typedef unsigned u32x4 __attribute__((ext_vector_type(4)));
constexpr int BM = 256, BK = 64, HALF = 128, HTB = HALF * BK * 2  , STAGE_BYTES = 8 * HTB, NXCD = 8, WGM = 8;

__host__ __device__ __forceinline__ int lds_byte(int r, int c) { const int st = (r >> 4) * 2 + (c >> 5), rr = r & 15, cc = c & 31, ob = rr * 64 + cc * 2; return st * 1024 + (ob ^ (((ob >> 9) & 1) << 5)); }
__host__ __device__ __forceinline__ void stage_rc(int b, int& R, int& C) { const int st = b / 1024, sb = b % 1024, swz = sb ^ (((sb >> 9) & 1) << 5); R = (st >> 1) * 16 + swz / 64; C = (st & 1) * 32 + (swz % 64) / 2; }
__host__ __device__ __forceinline__ int perm32(int rho) { const int n = rho >> 4, i = rho & 15; return 8 * (i >> 2) + 4 * n + (i & 3); }

typedef int i32x8 __attribute__((ext_vector_type(8))); typedef int i32x4v __attribute__((ext_vector_type(4)));
__device__ __forceinline__ i32x8 pg8_cat8(bf16x8 lo, bf16x8 hi) { const i32x4v a = __builtin_bit_cast(i32x4v, lo), b = __builtin_bit_cast(i32x4v, hi); return (i32x8){a[0], a[1], a[2], a[3], b[0], b[1], b[2], b[3]}; }
struct Unit { int pm, pn; };
struct Gemm { const bf16_t* A; const bf16_t* Bt; int M, N, K; };

struct StaticOrder {
    int nM, nN, nwg, G, c;
    __host__ __device__ void init(int M, int N, int G_, int c_) { nM = M / BM; nN = N / BM; nwg = nM * nN; G = G_; c = c_; }
    __host__ __device__ bool next(int i, Unit& u) const {
        const long L = (long)i * G + c; if (L >= nwg) return false;
        int wgid = (int)L; { const int q = nwg / NXCD, r = nwg % NXCD, xcd = wgid % NXCD, off = wgid / NXCD; wgid = (xcd < r ? xcd * (q + 1) : r * (q + 1) + (xcd - r) * q) + off; }
        const int nig = WGM * nN, gid = wgid / nig, fm = gid * WGM, gsz = (nM - fm) < WGM ? (nM - fm) : WGM;
        u.pm = fm + ((wgid % nig) % gsz); u.pn = (wgid % nig) / gsz; return true;
    }
    __device__ __forceinline__ void a_ready(const Unit&) const {}
    __device__ __forceinline__ void done(const Unit&) const {}
};

__device__ __forceinline__ unsigned cvt_pk_bf16(float lo, float hi) { unsigned r; asm volatile("v_cvt_pk_bf16_f32 %0, %1, %2" : "=v"(r) : "v"(lo), "v"(hi)); return r; }
typedef float f32x2 __attribute__((ext_vector_type(2)));
__device__ __forceinline__ f32x2 gelu_pk(f32x2 v) {
    const f32x2 av = __builtin_elementwise_abs(v), d = av * 0.2316418882f + 1.0f;
    f32x2 t; t.x = __builtin_amdgcn_rcpf(d.x); t.y = __builtin_amdgcn_rcpf(d.y);
    f32x2 q = t * 0.5307027145f + (-0.7265760135f); q = q * t + 0.7107068705f; q = q * t + (-0.142248368f); q = q * t + 0.127414796f; q = q * t;
    const f32x2 s = (v * v) * (-0.72134752044f);
    f32x2 e; e.x = __builtin_amdgcn_exp2f(s.x); e.y = __builtin_amdgcn_exp2f(s.y);
    const f32x2 m = v * (q * e), r = v - m;
    f32x2 o; o.x = v.x < 0.f ? m.x : r.x; o.y = v.y < 0.f ? m.y : r.y; return o;
}

template <int ACT  > struct EpiBf16 {
    static constexpr bool PERM = true, AFTER_DRAIN = false; static_assert(ACT == 0 || ACT == 1, "EpiBf16: ACT is 0 (none) or 1 (gelu_pk)");
    bf16_t* O; int ldc; const float* bias; int split_cols; size_t split_stride; float scale0;
    __device__ __forceinline__ void operator()(const f32x4 (&acc)[2][2][4][2], const Unit& u, int wr, int wc, int fr, int fq) const {
        const int row0 = u.pm * BM + wr * 64 + fr; int colt = u.pn * BM; bf16_t* base = O;
        float sc = 1.f; if (split_cols) { const int t = colt / split_cols; base += (size_t)t * split_stride; colt -= t * split_cols; if (t == 0) sc = scale0; }
        const int col0 = colt + wc * 32 + 8 * fq, bcol0 = u.pn * BM + wc * 32 + 8 * fq;
        f32x4 bv[2][2];
#pragma unroll
        for (int bj = 0; bj < 2; ++bj)
#pragma unroll
            for (int n = 0; n < 2; ++n) bv[bj][n] = bias ? *(const f32x4*)(bias + bcol0 + bj * HALF + 4 * n) : (f32x4){0.f, 0.f, 0.f, 0.f};
#pragma unroll
        for (int ai = 0; ai < 2; ++ai)
#pragma unroll
            for (int m = 0; m < 4; ++m) { bf16_t* rowp = base + (size_t)(row0 + ai * HALF + m * 16) * ldc + col0;
#pragma unroll
                for (int bj = 0; bj < 2; ++bj) { f32x4 v0 = acc[ai][bj][m][0] + bv[bj][0], v1 = acc[ai][bj][m][1] + bv[bj][1];
                    if (ACT == 1) { f32x2 a = gelu_pk((f32x2){v0[0], v0[1]}), b = gelu_pk((f32x2){v0[2], v0[3]}), c = gelu_pk((f32x2){v1[0], v1[1]}), d = gelu_pk((f32x2){v1[2], v1[3]});
                        v0 = (f32x4){a.x, a.y, b.x, b.y}; v1 = (f32x4){c.x, c.y, d.x, d.y}; }
                    v0 = v0 * sc; v1 = v1 * sc; u32x4 w; w.x = cvt_pk_bf16(v0[0], v0[1]); w.y = cvt_pk_bf16(v0[2], v0[3]); w.z = cvt_pk_bf16(v1[0], v1[1]); w.w = cvt_pk_bf16(v1[2], v1[3]);
                    *(u32x4*)(rowp + bj * HALF) = w; } }
    }
};

template <class Epi, class Sched, bool ALIGN_EPI = false, bool SP2 = false, bool F8 = false>
__device__ __forceinline__ void gemm_phase(PG8_LAS unsigned char* lds, const Gemm g, const Sched& S, const Epi& E, int tid_in) {
    int tid_l = tid_in; asm volatile("" : "+v"(tid_l));
    const int tid = tid_l, wid = __builtin_amdgcn_readfirstlane(tid >> 6), lane = tid & 63, wr = wid >> 2, wc = wid & 3, fr = lane & 15, fq = lane >> 4;
    const int K = g.K, nt = K / BK;
    unsigned voffA[2], voffB[2];
#pragma unroll
    for (int i = 0; i < 2; ++i) { int R, C; stage_rc(tid * 16 + i * 8192, R, C); const int Rb = Epi::PERM ? ((R & ~31) + perm32(R & 31)) : R;
        voffA[i] = (unsigned)(R * K + C) * 2u; voffB[i] = (unsigned)(Rb * K + C) * 2u; }
    const size_t kstep = (size_t)(BK * 2);
    const size_t hstep = (size_t)HALF * K * 2;
    const size_t tstep = 2 * hstep;
    const unsigned ldsw = (unsigned)wid * 1024u;
    const int aoff = lds_byte(wr * 64 + fr, fq * 8), boff = lds_byte(wc * 32 + fr, fq * 8);
#define PG8_SA(b, h) (((b) * 2 + (h)) * HTB)
#define PG8_SB(b, h) ((4 + (b) * 2 + (h)) * HTB)
#define PG8_STAGE(bufoff, gbase, voff) do { _Pragma("unroll") for (int _i = 0; _i < 2; ++_i) \
        __builtin_amdgcn_global_load_lds((const unsigned*)((const char*)(gbase) + (voff)[_i]), (PG8_LAS unsigned*)(lds + (bufoff) + ldsw + _i * 8192), 16, 0, 0); } while (0)
#define PG8_LDA(dst, b, h) do { _Pragma("unroll") for (int m = 0; m < 4; ++m) _Pragma("unroll") for (int k = 0; k < 2; ++k) dst[m][k] = *(const PG8_LAS bf16x8*)(lds + PG8_SA(b, h) + aoff + m * 2048 + k * 1024); } while (0)
#define PG8_LDB(dst, b, h) do { _Pragma("unroll") for (int n = 0; n < 2; ++n) _Pragma("unroll") for (int k = 0; k < 2; ++k) dst[n][k] = *(const PG8_LAS bf16x8*)(lds + PG8_SB(b, h) + boff + n * 2048 + k * 1024); } while (0)
#define PG8_MMA(ai, bj, At, Bt) do { __builtin_amdgcn_s_setprio(1); if constexpr (!F8) { _Pragma("unroll") for (int m = 0; m < 4; ++m) _Pragma("unroll") for (int n = 0; n < 2; ++n) _Pragma("unroll") for (int k = 0; k < 2; ++k) \
        acc[ai][bj][m][n] = __builtin_amdgcn_mfma_f32_16x16x32_bf16(Bt[n][k], At[m][k], acc[ai][bj][m][n], 0, 0, 0); } else { _Pragma("unroll") for (int m = 0; m < 4; ++m) _Pragma("unroll") for (int n = 0; n < 2; ++n) \
        acc[ai][bj][m][n] = __builtin_amdgcn_mfma_scale_f32_16x16x128_f8f6f4(pg8_cat8(Bt[n][0], Bt[n][1]), pg8_cat8(At[m][0], At[m][1]), acc[ai][bj][m][n], 0, 0, 0, 0x7F7F7F7F, 0, 0x7F7F7F7F); \
        _Pragma("unroll") for (int m = 0; m < 4; ++m) _Pragma("unroll") for (int n = 0; n < 2; ++n) asm volatile("" : "+v"(acc[ai][bj][m][n]));   } __builtin_amdgcn_s_setprio(0); } while (0)
#define PG8_WAIT_V(n) asm volatile("s_waitcnt vmcnt(" #n ")" ::: "memory")
#define PG8_WAIT_L(n) asm volatile("s_waitcnt lgkmcnt(" #n ")" ::: "memory")
#define PG8_BAR __builtin_amdgcn_s_barrier()
#define PG8_SCHED __builtin_amdgcn_sched_barrier(0)
    Unit cur, nxt; int ui = 0;
    if (!S.next(0, cur)) return;
    f32x4 acc[2][2][4][2];
#pragma unroll
    for (int a = 0; a < 2; ++a)
#pragma unroll
        for (int b = 0; b < 2; ++b)
#pragma unroll
            for (int m = 0; m < 4; ++m)
#pragma unroll
                for (int n = 0; n < 2; ++n) acc[a][b][m][n] = (f32x4){0.f, 0.f, 0.f, 0.f};
    bf16x8 At[4][2], B0[2][2], B1[2][2];
    const char* cA = (const char*)g.A + (size_t)cur.pm * tstep; const char* cB = (const char*)g.Bt + (size_t)cur.pn * tstep;
    S.a_ready(cur);
    if constexpr (SP2) {
        PG8_STAGE(PG8_SB(0, 0), cB, voffB); PG8_STAGE(PG8_SB(0, 1), cB + hstep, voffB); PG8_STAGE(PG8_SA(0, 0), cA, voffA); PG8_STAGE(PG8_SA(0, 1), cA + hstep, voffA);
        if (wr == 1) PG8_BAR;
        PG8_WAIT_V(2); PG8_BAR;
        PG8_STAGE(PG8_SB(1, 0), cB + kstep, voffB); PG8_STAGE(PG8_SA(1, 0), cA + kstep, voffA); PG8_STAGE(PG8_SB(1, 1), cB + hstep + kstep, voffB);
        PG8_WAIT_V(6); PG8_BAR;
    } else {
        PG8_STAGE(PG8_SB(0, 0), cB, voffB); PG8_STAGE(PG8_SA(0, 0), cA, voffA); PG8_STAGE(PG8_SB(0, 1), cB + hstep, voffB); PG8_STAGE(PG8_SA(0, 1), cA + hstep, voffA);
        if (wr == 1) PG8_BAR;
        PG8_WAIT_V(4); PG8_BAR;
        PG8_STAGE(PG8_SB(1, 0), cB + kstep, voffB); PG8_STAGE(PG8_SA(1, 0), cA + kstep, voffA); PG8_STAGE(PG8_SB(1, 1), cB + hstep + kstep, voffB);
        PG8_WAIT_V(6); PG8_BAR;
    }
    for (;;) {
        const bool has_next = S.next(ui + 1, nxt);
        const char* nA = has_next ? (const char*)g.A + (size_t)nxt.pm * tstep : cA; const char* nB = has_next ? (const char*)g.Bt + (size_t)nxt.pn * tstep : cB;
        for (int t = 0; t < nt; t += 2) {
            const bool last = (t == nt - 2);
            const char* a1 = cA + (size_t)(t + 1) * kstep;
            const char* a2 = last ? nA : cA + (size_t)(t + 2) * kstep; const char* b2 = last ? nB : cB + (size_t)(t + 2) * kstep;
            const char* a3 = a2 + kstep; const char* b3 = b2 + kstep;
            if (last && has_next) S.a_ready(nxt);
            if constexpr (SP2) {
            PG8_LDB(B0, 0, 0); PG8_LDB(B1, 0, 1); PG8_SCHED; PG8_LDA(At, 0, 0); PG8_STAGE(PG8_SA(1, 1), a1 + hstep, voffA);
            PG8_WAIT_V(8); PG8_WAIT_L(0); PG8_BAR; PG8_MMA(0, 0, At, B0); PG8_MMA(0, 1, At, B1); PG8_BAR; PG8_SCHED;
            PG8_LDA(At, 0, 1); PG8_STAGE(PG8_SB(0, 0), b2, voffB); PG8_STAGE(PG8_SB(0, 1), b2 + hstep, voffB); PG8_STAGE(PG8_SA(0, 0), a2, voffA);
            PG8_WAIT_V(8); PG8_WAIT_L(0); PG8_BAR; PG8_MMA(1, 0, At, B0); PG8_MMA(1, 1, At, B1); PG8_BAR; PG8_SCHED;
            PG8_LDB(B0, 1, 0); PG8_LDB(B1, 1, 1); PG8_SCHED; PG8_LDA(At, 1, 0); PG8_STAGE(PG8_SA(0, 1), a2 + hstep, voffA);
            PG8_WAIT_V(8); PG8_WAIT_L(0); PG8_BAR; PG8_MMA(0, 0, At, B0); PG8_MMA(0, 1, At, B1); PG8_BAR; PG8_SCHED;
            PG8_LDA(At, 1, 1); PG8_STAGE(PG8_SB(1, 0), b3, voffB); PG8_STAGE(PG8_SB(1, 1), b3 + hstep, voffB); PG8_STAGE(PG8_SA(1, 0), a3, voffA);
            PG8_WAIT_V(8); PG8_WAIT_L(0); PG8_BAR; PG8_MMA(1, 0, At, B0); PG8_MMA(1, 1, At, B1); PG8_BAR; PG8_SCHED;
            } else {
            PG8_LDB(B0, 0, 0); PG8_SCHED; PG8_LDA(At, 0, 0); PG8_STAGE(PG8_SA(1, 1), a1 + hstep, voffA);
            PG8_WAIT_L(8); PG8_BAR; PG8_WAIT_L(0); PG8_MMA(0, 0, At, B0); PG8_BAR; PG8_SCHED;
            PG8_LDB(B1, 0, 1); PG8_STAGE(PG8_SB(0, 0), b2, voffB);
            PG8_BAR; PG8_WAIT_L(0); PG8_MMA(0, 1, At, B1); PG8_BAR;
            PG8_LDA(At, 0, 1); PG8_STAGE(PG8_SA(0, 0), a2, voffA);
            PG8_BAR; PG8_WAIT_L(0); PG8_MMA(1, 0, At, B0); PG8_BAR; PG8_SCHED;
            PG8_STAGE(PG8_SB(0, 1), b2 + hstep, voffB);
            PG8_WAIT_V(6); PG8_BAR; PG8_MMA(1, 1, At, B1); PG8_BAR;
            PG8_LDB(B0, 1, 0); PG8_SCHED; PG8_LDA(At, 1, 0); PG8_STAGE(PG8_SA(0, 1), a2 + hstep, voffA);
            PG8_WAIT_L(8); PG8_BAR; PG8_WAIT_L(0); PG8_MMA(0, 0, At, B0); PG8_BAR; PG8_SCHED;
            PG8_LDB(B1, 1, 1); PG8_STAGE(PG8_SB(1, 0), b3, voffB);
            PG8_BAR; PG8_WAIT_L(0); PG8_MMA(0, 1, At, B1); PG8_BAR;
            PG8_LDA(At, 1, 1); PG8_STAGE(PG8_SA(1, 0), a3, voffA);
            PG8_BAR; PG8_WAIT_L(0); PG8_MMA(1, 0, At, B0); PG8_BAR; PG8_SCHED;
            PG8_STAGE(PG8_SB(1, 1), b3 + hstep, voffB);
            PG8_WAIT_V(6); PG8_BAR; PG8_MMA(1, 1, At, B1); PG8_BAR;
            }
        }
        if constexpr (ALIGN_EPI) { if (wr == 0) PG8_BAR; }
        if constexpr (!Epi::AFTER_DRAIN) { E(acc, cur, wr, wc, fr, fq); S.done(cur); }
        if (!has_next) break;
#pragma unroll
        for (int a = 0; a < 2; ++a)
#pragma unroll
            for (int b = 0; b < 2; ++b)
#pragma unroll
                for (int m = 0; m < 4; ++m)
#pragma unroll
                    for (int n = 0; n < 2; ++n) acc[a][b][m][n] = (f32x4){0.f, 0.f, 0.f, 0.f};
        cur = nxt; cA = nA; cB = nB; ++ui;
        if constexpr (ALIGN_EPI) { if (wr == 1) PG8_BAR; }
    }
    PG8_WAIT_V(0);
    if constexpr (!ALIGN_EPI) { if (wr == 0) PG8_BAR; }
    PG8_BAR;
    if constexpr (Epi::AFTER_DRAIN) { E.fused(acc, cur, wr, wc, fr, fq, lds, wid, lane); S.done(cur); }
#undef PG8_SA
#undef PG8_SB
#undef PG8_STAGE
#undef PG8_LDA
#undef PG8_LDB
#undef PG8_MMA
#undef PG8_WAIT_V
#undef PG8_WAIT_L
#undef PG8_BAR
#undef PG8_SCHED
}
}

#ifndef PG8_SP2
#define PG8_SP2 true
#endif
#ifndef PG8_ALIGN
#define PG8_ALIGN true
#endif
#define XB_TMO      128
#define XB_XCNT(j)  (256  + 64 * (j))
#define XB_XSUB(j)  (1280 + 64 * (j))
#define XB_XGEN(j)  (2304 + 64 * (j))
#define XB_TOP      3328
#define XB_TOPGEN   3392
#define XCD_BAR_WORDS 3456
#define XB_SPIN_CAP (1u << 18)

__device__ __forceinline__ unsigned xb_ld(unsigned* p)              { return __hip_atomic_load(p, __ATOMIC_RELAXED, __HIP_MEMORY_SCOPE_AGENT); }
__device__ __forceinline__ unsigned xb_add(unsigned* p, unsigned v) { return __hip_atomic_fetch_add(p, v, __ATOMIC_RELAXED, __HIP_MEMORY_SCOPE_AGENT); }
__device__ __forceinline__ unsigned xb_xcc_id() { return (unsigned)__builtin_amdgcn_s_getreg((3 << 11) | 20) & 0xFu; }
#define XB_SPIN(cond, bar) do { unsigned _sp = 0; while (cond) { __builtin_amdgcn_s_sleep(1); \
    if ((++_sp & 255u) == 0u) { if (xb_ld(&(bar)[XB_TMO])) break; if (_sp > XB_SPIN_CAP) { atomicAdd(&(bar)[XB_TMO], 1u); break; } } } } while (0)

struct XcdBarrier {
    unsigned* bar; unsigned x;
    volatile LAS unsigned* st;
};

__device__ __forceinline__ XcdBarrier xcd_barrier_post(unsigned* bar, volatile LAS unsigned* st) {
    XcdBarrier b; b.bar = bar; b.x = xb_xcc_id(); b.st = st;
    if (threadIdx.x == 0) (void)xb_add(&bar[XB_XCNT(b.x)], 1u);
    return b;
}
__device__ __forceinline__ void xcd_barrier_complete(unsigned* bar, unsigned x, unsigned& nloc, unsigned& nx) {
    const unsigned G = gridDim.x * gridDim.y * gridDim.z;
    unsigned sum, cnt, mine, sp = 0u;
    for (;;) {
        sum = 0u; cnt = 0u; mine = 0u;
#pragma unroll
        for (unsigned j = 0; j < 16; ++j) { const unsigned c = xb_ld(&bar[XB_XCNT(j)]); sum += c; cnt += (c > 0u) ? 1u : 0u; mine = (j == x) ? c : mine; }
        if (sum == G) break;
        __builtin_amdgcn_s_sleep(1);
        if ((++sp & 255u) == 0u) { if (xb_ld(&bar[XB_TMO])) break; if (sp > XB_SPIN_CAP) { atomicAdd(&bar[XB_TMO], 1u); break; } }
    }
    nloc = mine > 0u ? mine : 1u; nx = cnt > 0u ? cnt : 1u;
}

__device__ __forceinline__ void xcd_barrier(const XcdBarrier& b, const bool is_t0  ) {
    asm volatile("s_waitcnt vmcnt(0)" ::: "memory");
    __syncthreads();
    if (is_t0) {
        unsigned* bar = b.bar;
        __builtin_amdgcn_s_waitcnt(0);
        unsigned nloc = b.st[0], nx = b.st[1];
        if (nloc == 0u) { xcd_barrier_complete(bar, b.x, nloc, nx); b.st[0] = nloc; b.st[1] = nx; }
        const unsigned old = xb_add(&bar[XB_XSUB(b.x)], 1u);
        const unsigned gen = old / nloc;
        if (old + 1u == (gen + 1u) * nloc) {
            __builtin_amdgcn_fence(__ATOMIC_RELEASE, "agent");
            asm volatile("s_waitcnt vmcnt(0)" ::: "memory");
            const unsigned og = xb_add(&bar[XB_TOP], 1u);
            const unsigned tg = og / nx;
            if (og + 1u == (tg + 1u) * nx) xb_add(&bar[XB_TOPGEN], 1u);
            else XB_SPIN(xb_ld(&bar[XB_TOPGEN]) == tg, bar);
            __builtin_amdgcn_fence(__ATOMIC_ACQUIRE, "agent");
            xb_add(&bar[XB_XGEN(b.x)], 1u);
            asm volatile("s_waitcnt vmcnt(0)" ::: "memory");
        } else {
            XB_SPIN(xb_ld(&bar[XB_XGEN(b.x)]) == gen, bar);
            __builtin_amdgcn_fence(__ATOMIC_ACQUIRE, "agent");
            asm volatile("s_waitcnt vmcnt(0)" ::: "memory");
        }
    }
    __syncthreads();
}
struct EpiResF32 {
    static constexpr bool PERM = true, AFTER_DRAIN = false;
    const float* xin; float* yp; float alpha;
    DI void operator()(const pg8::f32x4 (&acc)[2][2][4][2], const pg8::Unit& u, int wr, int wc, int fr, int fq) const {
        const int row0 = u.pm * 256 + wr * 64 + fr, col0 = u.pn * 256 + wc * 32 + 8 * fq;
#pragma unroll
        for (int ai = 0; ai < 2; ++ai)
#pragma unroll
            for (int m = 0; m < 4; ++m) {
                const size_t ro = (size_t)(row0 + ai * 128 + m * 16) * DM;
#pragma unroll
                for (int bj = 0; bj < 2; ++bj) {
                    const size_t o = ro + col0 + bj * 128;
                    const f32x4 x0 = *(const f32x4*)(xin + o), x1 = *(const f32x4*)(xin + o + 4);
                    *(f32x4*)(yp + o) = x0 * alpha + acc[ai][bj][m][0];
                    *(f32x4*)(yp + o + 4) = x1 * alpha + acc[ai][bj][m][1];
                }
            }
    }
};
struct EpiSwiglu {
    static constexpr bool PERM = true, AFTER_DRAIN = false;
    unsigned char* act; const float* bgu;
    DI void operator()(const pg8::f32x4 (&acc)[2][2][4][2], const pg8::Unit& u, int wr, int wc, int fr, int fq) const {
        const int e = u.pn >> 3, pl = u.pn & 7;
        const int row0 = u.pm * 256 + wr * 64 + fr, cih = pl * 128 + wc * 32 + 8 * fq;
        const float* bg = bgu + e * 2048 + cih;
        const f32x4 bg0 = *(const f32x4*)(bg), bg1 = *(const f32x4*)(bg + 4), bu0 = *(const f32x4*)(bg + 1024), bu1 = *(const f32x4*)(bg + 1028);
#pragma unroll
        for (int ai = 0; ai < 2; ++ai)
#pragma unroll
            for (int m = 0; m < 4; ++m) {
                constexpr float RS = 1.f / (F8_SX * F8_SWG);
                const f32x4 g0 = acc[ai][0][m][0] * RS + bg0, g1 = acc[ai][0][m][1] * RS + bg1, u0 = acc[ai][1][m][0] * RS + bu0, u1 = acc[ai][1][m][1] * RS + bu1;
                float r[8];
#pragma unroll
                for (int i = 0; i < 8; ++i) {
                    float g = i < 4 ? g0[i & 3] : g1[i & 3], uu = i < 4 ? u0[i & 3] : u1[i & 3];
                    g = fminf(g, 7.0f); uu = fminf(fmaxf(uu, -7.0f), 7.0f);
                    const float sg = __builtin_amdgcn_rcpf(1.0f + ex2(-1.702f * LOG2E * g));
                    r[i] = (uu + 1.0f) * g * sg * F8_SA;
                }
                v2u w; w.x = pk4_fp8(r[0], r[1], r[2], r[3]); w.y = pk4_fp8(r[4], r[5], r[6], r[7]);
                *(v2u*)(act + (size_t)(row0 + ai * 128 + m * 16) * DM + cih) = w;
            }
    }
};
struct EpiDown {
    static constexpr bool PERM = true, AFTER_DRAIN = false;
    bf16* yr; const float* bdn;
    DI void operator()(const pg8::f32x4 (&acc)[2][2][4][2], const pg8::Unit& u, int wr, int wc, int fr, int fq) const {
        const int e = u.pn >> 2, pl = u.pn & 3;
        const int row0 = u.pm * 256 + wr * 64 + fr, col0 = pl * 256 + wc * 32 + 8 * fq;
        f32x4 bv[2][2];
#pragma unroll
        for (int bj = 0; bj < 2; ++bj) { bv[bj][0] = *(const f32x4*)(bdn + e * 1024 + col0 + bj * 128); bv[bj][1] = *(const f32x4*)(bdn + e * 1024 + col0 + bj * 128 + 4); }
#pragma unroll
        for (int ai = 0; ai < 2; ++ai)
#pragma unroll
            for (int m = 0; m < 4; ++m) {
                bf16* rp = yr + (size_t)(row0 + ai * 128 + m * 16) * DM + col0;
#pragma unroll
                for (int bj = 0; bj < 2; ++bj) {
                    constexpr float RS = 1.f / (F8_SA * F8_SWD);
                    const f32x4 v0 = acc[ai][bj][m][0] * RS + bv[bj][0], v1 = acc[ai][bj][m][1] * RS + bv[bj][1];
                    v4u w; w.x = cvtpk(v0[0], v0[1]); w.y = cvtpk(v0[2], v0[3]); w.z = cvtpk(v1[0], v1[1]); w.w = cvtpk(v1[2], v1[3]);
                    *(v4u*)(rp + bj * 128) = w;
                }
            }
    }
};
struct GroupOrder {
    LAS const unsigned* tile_e; int ntiles, lg, G, c;
    DI bool next(int i, pg8::Unit& u) const {
        int pm, pl;
        if (G == 256) {
            const int x = c & 7, k = c >> 3; pm = i * (256 >> lg) + x * (32 >> lg) + (k >> lg); pl = k & ((1 << lg) - 1); if (pm >= ntiles) return false; }
        else { const long L = (long)i * G + c; if (L >= ((long)ntiles << lg)) return false; pm = (int)(L >> lg); pl = (int)(L & ((1 << lg) - 1)); }
        const int e = __builtin_amdgcn_readfirstlane((int)tile_e[pm]);
        u.pm = pm; u.pn = (e << lg) + pl; return true;
    }
    DI void a_ready(const pg8::Unit&) const {}
    DI void done(const pg8::Unit&) const {}
};
struct Args { const float* in[18]; float* out; unsigned char* ws; int ph_lo, ph_hi; };
struct Fr { LAS unsigned char* lds; unsigned char* ws; unsigned* ctl; int tid, lane, wave, blk, G; };

DI void tr_item(const float* W, int ldw, int K, int k0, int sc0, int nvalid, bf16* WT, int drow0, LAS float* scr, int lane) {
    const int c = lane & 31;
    float v[32];
#pragma unroll
    for (int i = 0; i < 32; ++i) v[i] = (c < nvalid) ? W[(size_t)(k0 + 2 * i + (lane >> 5)) * ldw + sc0 + c] : 0.f;
#pragma unroll
    for (int i = 0; i < 32; ++i) scr[(2 * i + (lane >> 5)) * 33 + c] = v[i];
    LDS_WAIT(); asm volatile("" ::: "memory");
    const int c8 = lane & 7;
#pragma unroll
    for (int j = 0; j < 4; ++j) { const int n = (lane >> 3) + 8 * j; const LAS float* s = scr + (8 * c8) * 33 + n;
        v4u o; o.x = cvtpk(s[0 * 33], s[1 * 33]); o.y = cvtpk(s[2 * 33], s[3 * 33]); o.z = cvtpk(s[4 * 33], s[5 * 33]); o.w = cvtpk(s[6 * 33], s[7 * 33]);
        *(v4u*)(WT + (size_t)(drow0 + n) * K + k0 + 8 * c8) = o; }
    LDS_WAIT(); asm volatile("" ::: "memory");
}
DI void tr_item8(const float* W, int ldw, int K, int k0, int sc0, float scale, unsigned char* WT8, int drow0, LAS float* scr, int lane) {
    const int c = lane & 31;
    float v[32];
#pragma unroll
    for (int i = 0; i < 32; ++i) v[i] = W[(size_t)(k0 + 2 * i + (lane >> 5)) * ldw + sc0 + c];
#pragma unroll
    for (int i = 0; i < 32; ++i) scr[(2 * i + (lane >> 5)) * 33 + c] = v[i] * scale;
    LDS_WAIT(); asm volatile("" ::: "memory");
    const int c16 = lane & 3;
#pragma unroll
    for (int j = 0; j < 2; ++j) { const int n = (lane >> 2) + 16 * j; const LAS float* s = scr + (16 * c16) * 33 + n;
        v4u o; o.x = pk4_fp8(s[0 * 33], s[1 * 33], s[2 * 33], s[3 * 33]); o.y = pk4_fp8(s[4 * 33], s[5 * 33], s[6 * 33], s[7 * 33]);
        o.z = pk4_fp8(s[8 * 33], s[9 * 33], s[10 * 33], s[11 * 33]); o.w = pk4_fp8(s[12 * 33], s[13 * 33], s[14 * 33], s[15 * 33]);
        *(v4u*)(WT8 + (size_t)(drow0 + n) * K + k0 + 16 * c16) = o; }
    LDS_WAIT(); asm volatile("" ::: "memory");
}
DI void ph_prologue(const Args& a, const Fr& F) {
    LAS float* scr = (LAS float*)(F.lds + F.wave * 16384);
    const int gw = F.blk * NWAVES + F.wave, NGW = F.G * NWAVES;
    constexpr int I_EV = 2 * 16 * 80, I_OD = 2 * 16 * 96, I_WO = 4 * 16 * 32;
    constexpr int NITEMS = I_EV + I_OD + I_WO;
    bf16* wev = (bf16*)(F.ws + WS_WEV); bf16* wod = (bf16*)(F.ws + WS_WOD); bf16* wout = (bf16*)(F.ws + WS_WOUT);
    unsigned char* wgu = F.ws + WS_WGU; unsigned char* wdn = F.ws + WS_WDN;
    for (int it = gw; it < NITEMS; it += NGW) {
        int r = it;
        if (r < I_EV) { const int l = r / 1280; r %= 1280; const int kb = r / 80, n0 = (r % 80) * 32; int sc0, nv = 32;
            if (n0 < 512) sc0 = n0; else if (n0 < 1024) sc0 = 964 + (n0 - 512); else if (n0 < 1536) sc0 = 1476 + (n0 - 1024); else if (n0 < 2048) sc0 = 1988 + (n0 - 1536);
            else if (n0 < 2176) sc0 = 512 + (n0 - 2048); else if (n0 < 2432) sc0 = 640 + (n0 - 2176); else if (n0 < 2496) sc0 = 896 + (n0 - 2432);
            else if (n0 < 2528) { sc0 = 960; nv = 4; } else { sc0 = 0; nv = 0; }
            tr_item(a.in[1] + (size_t)l * 1024 * 2500, 2500, 1024, kb * 64, sc0, nv, wev + (size_t)l * EV_N * 1024, n0, scr, F.lane); continue; }
        r -= I_EV;
        if (r < I_OD) { const int l = r / 1536; r %= 1536; const int kb = r / 96, n0 = (r % 96) * 32;
            tr_item(a.in[6] + (size_t)l * 1024 * 3088, 3088, 1024, kb * 64, n0, 32, wod + (size_t)l * OD_N * 1024, n0, scr, F.lane); continue; }
        r -= I_OD;
        if (r < I_WO) { const int l = r / 512; r %= 512; const int kb = r / 32, n0 = (r % 32) * 32;
            const float* src = (l & 1) ? a.in[8] + (size_t)(l >> 1) * 1024 * 1024 : a.in[5] + (size_t)(l >> 1) * 1024 * 1024;
            tr_item(src, 1024, 1024, kb * 64, n0, 32, wout + (size_t)l * 1024 * 1024, n0, scr, F.lane); continue; }
    }
    { __syncthreads();
        LAS float* tile = (LAS float*)F.lds; unsigned char* wgu8 = F.ws + WS_WGU; unsigned char* wdn8 = F.ws + WS_WDN;
        constexpr int T_GU = 128 * 8 * 16, T_DN = 128 * 8 * 8, T_ALL = T_GU + T_DN;
        const int tid = F.tid, c4 = tid & 31, r0 = tid >> 5;
        f32x4 v[8];
        auto locate = [&](int t, const float*& src, int& ldw, unsigned char*& dst, float& scale) {
            if (t < T_GU) { const int le = t >> 7, r = t & 127, kb = r >> 4, nb = r & 15, n0 = nb * 128; const int pn = n0 >> 8, bj = (n0 >> 7) & 1;
                src = a.in[14] + (size_t)le * 1024 * 2048 + (size_t)(kb * 128) * 2048 + bj * 1024 + pn * 128; ldw = 2048; dst = wgu8 + (size_t)le * 2048 * 1024 + (size_t)n0 * 1024 + kb * 128; scale = F8_SWG; }
            else { const int u = t - T_GU, le = u >> 6, r = u & 63, kb = r >> 3, nb = r & 7;
                src = a.in[16] + (size_t)le * 1024 * 1024 + (size_t)(kb * 128) * 1024 + nb * 128; ldw = 1024; dst = wdn8 + (size_t)le * 1024 * 1024 + (size_t)(nb * 128) * 1024 + kb * 128; scale = F8_SWD; } };
        int t = F.blk;
        if (t < T_ALL) { const float* src; int ldw; unsigned char* dst; float sc; locate(t, src, ldw, dst, sc);
#pragma unroll
            for (int i = 0; i < 8; ++i) v[i] = *(const f32x4*)(src + (size_t)(r0 + 16 * i) * ldw + 4 * c4); }
        for (; t < T_ALL; t += F.G) {
            const float* src; int ldw; unsigned char* dst; float sc; locate(t, src, ldw, dst, sc);
#pragma unroll
            for (int i = 0; i < 8; ++i) { LAS float* tp = tile + (r0 + 16 * i) * 129 + 4 * c4; tp[0] = v[i][0] * sc; tp[1] = v[i][1] * sc; tp[2] = v[i][2] * sc; tp[3] = v[i][3] * sc; }
            __syncthreads();
            if (t + F.G < T_ALL) { const float* s2; int l2; unsigned char* d2; float c2; locate(t + F.G, s2, l2, d2, c2);
#pragma unroll
                for (int i = 0; i < 8; ++i) v[i] = *(const f32x4*)(s2 + (size_t)(r0 + 16 * i) * l2 + 4 * c4); }
#pragma unroll
            for (int j = 0; j < 2; ++j) { const int p = tid + 512 * j, kc = p & 7, n = p >> 3; const LAS float* sp = tile + (kc * 16) * 129 + n;
                v4u o; o.x = pk4_fp8(sp[0], sp[129], sp[2 * 129], sp[3 * 129]); o.y = pk4_fp8(sp[4 * 129], sp[5 * 129], sp[6 * 129], sp[7 * 129]);
                o.z = pk4_fp8(sp[8 * 129], sp[9 * 129], sp[10 * 129], sp[11 * 129]); o.w = pk4_fp8(sp[12 * 129], sp[13 * 129], sp[14 * 129], sp[15 * 129]);
                *(v4u*)(dst + (size_t)n * 1024 + kc * 16) = o; }
            __syncthreads();
        }
    }
    bf16* xb = (bf16*)(F.ws + WS_XB);
    for (int m = gw; m < NTOK; m += NGW) {
        const f32x4* xr = (const f32x4*)(a.in[0] + (size_t)m * DM) + F.lane; v2u* o = (v2u*)(xb + (size_t)m * DM) + F.lane;
#pragma unroll
        for (int j = 0; j < 4; ++j) { const f32x4 v = xr[64 * j]; v2u w; w.x = cvtpk(v[0], v[1]); w.y = cvtpk(v[2], v[3]); o[64 * j] = w; }
    }
    bf16* wukt = (bf16*)(F.ws + WS_WUKT); bf16* wuvt = (bf16*)(F.ws + WS_WUVT);
    for (int i = F.blk * NTHR + F.tid; i < 2 * 8 * 128 * 64; i += F.G * NTHR) {
        { const int d = i & 63, c = (i >> 6) & 127, lh = i >> 13; wukt[i] = (bf16)f2bf(a.in[2][((size_t)lh * 64 + d) * 128 + c]); }
        { const int c = i & 127, d = (i >> 7) & 63, lh = i >> 13; wuvt[i] = (bf16)f2bf(a.in[3][((size_t)lh * 128 + c) * 64 + d]); }
    }
}

DI void ln_row(f32x4 (&v)[4], const float* g, const float* b, int lane) {
    float s = 0.f;
#pragma unroll
    for (int j = 0; j < 4; ++j) s += (v[j][0] + v[j][1]) + (v[j][2] + v[j][3]);
    const float mean = wave_sum(s) * (1.f / DM); float s2 = 0.f;
#pragma unroll
    for (int j = 0; j < 4; ++j) { v[j] = v[j] - mean; s2 += (v[j][0] * v[j][0] + v[j][1] * v[j][1]) + (v[j][2] * v[j][2] + v[j][3] * v[j][3]); }
    const float rstd = 1.f / sqrtf(wave_sum(s2) * (1.f / DM) + LN_EPS);
#pragma unroll
    for (int j = 0; j < 4; ++j) { const f32x4 gg = *((const f32x4*)g + lane + 64 * j), bb = *((const f32x4*)b + lane + 64 * j); v[j] = v[j] * rstd * gg + bb; }
}
DI void store_row_f32(float* p, const f32x4 (&v)[4], int lane) {
#pragma unroll
    for (int j = 0; j < 4; ++j) *((f32x4*)p + lane + 64 * j) = v[j];
}
DI void store_row_bf16(bf16* p, const f32x4 (&v)[4], int lane) {
#pragma unroll
    for (int j = 0; j < 4; ++j) { v2u w; w.x = cvtpk(v[j][0], v[j][1]); w.y = cvtpk(v[j][2], v[j][3]); *((v2u*)p + lane + 64 * j) = w; }
}
template <int NL> DI void small_proj(LAS const float* xs, const float* W, int ldw, int lane, float (&acc)[4]) {
    constexpr int PARTS = 64 / NL, DPER = 1024 / PARTS;
    const int n = lane & (NL - 1), part = lane / NL;
    acc[0] = acc[1] = acc[2] = acc[3] = 0.f;
    const float* wp = W + (size_t)(part * DPER) * ldw + n;
    LAS const float* xp = xs + part * DPER;
#pragma unroll 8
    for (int d = 0; d < DPER; ++d) { const float w = wp[(size_t)d * ldw];
        acc[0] += w * xp[d]; acc[1] += w * xp[1024 + d]; acc[2] += w * xp[2048 + d]; acc[3] += w * xp[3072 + d]; }
#pragma unroll
    for (int o = NL; o < 64; o <<= 1) {
#pragma unroll
        for (int k = 0; k < 4; ++k) acc[k] += __shfl_xor(acc[k], o); }
}

DI void ph_even_prep(const Args& a, const Fr& F, int j) {
    const bf16* proj = (const bf16*)(F.ws + WS_PROJ);
    bf16* ckvn = (bf16*)(F.ws + WS_CKVN); bf16* ql = (bf16*)(F.ws + WS_QL); float* kbar = (float*)(F.ws + WS_KBAR);
    const float* kvg = a.in[4] + j * 128;
    const bf16* wukt = (const bf16*)(F.ws + WS_WUKT) + (size_t)j * 8 * 128 * 64;
    const int lane = F.lane, wave = F.wave;
    for (int chunk = F.blk; chunk < 256; chunk += F.G) {
        const int tok0 = chunk * 128;
#pragma unroll 1
        for (int i0 = 0; i0 < 16; i0 += 8) { unsigned wv[8];
#pragma unroll
            for (int i = 0; i < 8; ++i) wv[i] = *((const unsigned*)(proj + (size_t)(tok0 + wave * 16 + i0 + i) * EV_N + EC_CKV) + lane);
#pragma unroll
            for (int i = 0; i < 8; ++i) { const int tok = tok0 + wave * 16 + i0 + i; const float v0 = bf2f(wv[i] & 0xffffu), v1 = bf2f(wv[i] >> 16);
                const float ss = wave_sum(v0 * v0 + v1 * v1);
                const float r = 1.f / sqrtf(ss * (1.f / 128.f) + LN_EPS);
                *((unsigned*)(ckvn + (size_t)tok * 128) + lane) = cvtpk(v0 * r * kvg[2 * lane], v1 * r * kvg[2 * lane + 1]); } }
        { bf16* kic = (bf16*)(F.ws + WS_KIC); const int tok = tok0 + wave * 16 + (lane >> 2), c = (lane & 3) * 16;
            const v4u* src = (const v4u*)(proj + (size_t)tok * EV_N + EC_KI + c); v4u* dst = (v4u*)(kic + (size_t)tok * 64 + c); dst[0] = src[0]; dst[1] = src[1]; }
        { const int h = wave, l15 = lane & 15, kg = lane >> 4;
            bf16x8 af[8][2];
#pragma unroll
            for (int ct = 0; ct < 8; ++ct)
#pragma unroll
                for (int ks = 0; ks < 2; ++ks) af[ct][ks] = *(const bf16x8*)(wukt + ((size_t)h * 128 + ct * 16 + l15) * 64 + ks * 32 + kg * 8);
#pragma unroll 1
            for (int tg = 0; tg < 8; tg += 4) { bf16x8 qf[4][2];
#pragma unroll
                for (int u = 0; u < 4; ++u)
#pragma unroll
                    for (int ks = 0; ks < 2; ++ks) qf[u][ks] = *(const bf16x8*)(proj + (size_t)(tok0 + (tg + u) * 16 + l15) * EV_N + EC_QA + h * 64 + ks * 32 + kg * 8);
#pragma unroll
                for (int u = 0; u < 4; ++u) { const int tok = tok0 + (tg + u) * 16 + l15;
#pragma unroll
                    for (int ct = 0; ct < 8; ++ct) { f32x4 d = {0.f, 0.f, 0.f, 0.f};
                        d = mfma16(af[ct][0], qf[u][0], d); d = mfma16(af[ct][1], qf[u][1], d);
                        v2u w; w.x = cvtpk(d[0], d[1]); w.y = cvtpk(d[2], d[3]);
                        *(v2u*)(ql + (size_t)tok * 1024 + h * 128 + ct * 16 + 4 * kg) = w; } } } }
        if (chunk < 128) { const int b = chunk >> 5, n = chunk & 31; float s8[8];
#pragma unroll
            for (int k = 0; k < 8; ++k) s8[k] = 0.f;
            const bf16* kp = proj + ((size_t)b * SEQ + n * 256 + wave * 32) * EV_N + EC_KB + lane * 8;
#pragma unroll 8
            for (int r = 0; r < 32; ++r) { const v4u w = *(const v4u*)(kp + (size_t)r * EV_N);
#pragma unroll
                for (int k = 0; k < 4; ++k) { s8[2 * k] += bf2f(w[k] & 0xffffu); s8[2 * k + 1] += bf2f(w[k] >> 16); } }
            LAS float* red = (LAS float*)F.lds;
            __syncthreads();
#pragma unroll
            for (int k = 0; k < 8; ++k) red[wave * 512 + lane * 8 + k] = s8[k];
            __syncthreads();
            float s = 0.f;
#pragma unroll
            for (int w = 0; w < 8; ++w) s += red[w * 512 + F.tid];
            const int h = F.tid >> 6, d = F.tid & 63;
            kbar[(((size_t)b * 8 + h) * 32 + n) * 64 + d] = s * (1.f / 256.f); }
    }
}

DI void moba_gate_chunk(const Fr& F, int chunk) {
    const bf16* proj = (const bf16*)(F.ws + WS_PROJ); const float* kbar = (const float*)(F.ws + WS_KBAR); unsigned* sel3 = (unsigned*)(F.ws + WS_SEL3);
    const int tok0 = chunk * 128, b = tok0 / SEQ, own = (tok0 % SEQ) >> 8, h = F.wave, lane = F.lane;
    float q0[64], q1[64];
    { const v4u* p0 = (const v4u*)(proj + (size_t)(tok0 + lane) * EV_N + EC_QB + h * 64); const v4u* p1 = (const v4u*)(proj + (size_t)(tok0 + 64 + lane) * EV_N + EC_QB + h * 64);
#pragma unroll
        for (int i = 0; i < 8; ++i) { const v4u w0 = p0[i], w1 = p1[i];
#pragma unroll
            for (int k = 0; k < 4; ++k) { q0[8 * i + 2 * k] = bf2f(w0[k] & 0xffffu); q0[8 * i + 2 * k + 1] = bf2f(w0[k] >> 16); q1[8 * i + 2 * k] = bf2f(w1[k] & 0xffffu); q1[8 * i + 2 * k + 1] = bf2f(w1[k] >> 16); } } }
    float a0 = -INFINITY, a1 = -INFINITY, a2 = -INFINITY, c0 = -INFINITY, c1 = -INFINITY, c2 = -INFINITY; int ai0 = 0, ai1 = 0, ai2 = 0, ci0 = 0, ci1 = 0, ci2 = 0;
    const float* kb = kbar + (((size_t)b * 8 + h) * 32) * 64;
    for (int n = 0; n < own; ++n) { float g0 = 0.f, g1 = 0.f;
#pragma unroll
        for (int d = 0; d < 64; d += 4) { const f32x4 kv = *(const f32x4*)(kb + n * 64 + d);
#pragma unroll
            for (int k = 0; k < 4; ++k) { g0 += q0[d + k] * kv[k]; g1 += q1[d + k] * kv[k]; } }
        if (g0 > a2) { if (g0 > a1) { a2 = a1; ai2 = ai1; if (g0 > a0) { a1 = a0; ai1 = ai0; a0 = g0; ai0 = n; } else { a1 = g0; ai1 = n; } } else { a2 = g0; ai2 = n; } }
        if (g1 > c2) { if (g1 > c1) { c2 = c1; ci2 = ci1; if (g1 > c0) { c1 = c0; ci1 = ci0; c0 = g1; ci0 = n; } else { c1 = g1; ci1 = n; } } else { c2 = g1; ci2 = n; } }
    }
    const unsigned nv = own < 3 ? own : 3;
    sel3[(size_t)(tok0 + lane) * 8 + h] = (unsigned)ai0 | ((unsigned)ai1 << 8) | ((unsigned)ai2 << 16) | (nv << 24);
    sel3[(size_t)(tok0 + 64 + lane) * 8 + h] = (unsigned)ci0 | ((unsigned)ci1 << 8) | ((unsigned)ci2 << 16) | (nv << 24);
}

constexpr int HS = 257;
DI float relu1(float x) { const unsigned u = __float_as_uint(x); return __uint_as_float(u & ~(unsigned)((int)u >> 31)); }
template <int MODE, bool DIAG> DI void idx_tile(const bf16x8 (&kf)[4], LAS const char* qb  , const float (&wj)[4], int kt, int q, int hi, unsigned c0, unsigned c1,
                                     LAS unsigned* hist, LAS unsigned* mask, LAS unsigned* cmask, LAS unsigned long long* cand, LAS unsigned* rinfo) {
    f32x2 scp[8];
#pragma unroll
    for (int p = 0; p < 8; ++p) scp[p] = (f32x2){0.f, 0.f};
    bf16x8 qv0[2][4], qv1[2][4];
#pragma unroll
    for (int j = 0; j < 2; ++j)
#pragma unroll
        for (int s = 0; s < 4; ++s) qv0[j][s] = *(LAS const bf16x8*)(qb + (j * 8 + s * 2) * 512);
#pragma unroll
    for (int j = 0; j < 2; ++j)
#pragma unroll
        for (int s = 0; s < 4; ++s) qv1[j][s] = *(LAS const bf16x8*)(qb + ((2 + j) * 8 + s * 2) * 512);
    __builtin_amdgcn_sched_barrier(0);
#pragma unroll
    for (int g = 0; g < 2; ++g) { f32x16 acc[2];
#pragma unroll
        for (int j = 0; j < 2; ++j)
#pragma unroll
            for (int r = 0; r < 16; ++r) acc[j][r] = 0.f;
#pragma unroll
        for (int s = 0; s < 4; ++s)
#pragma unroll
            for (int j = 0; j < 2; ++j) { if (MODE != -2) acc[j] = mfma32(kf[s], g == 0 ? qv0[j][s] : qv1[j][s], acc[j]); else acc[j][s] += __builtin_bit_cast(float, (unsigned)(kf[s][0] ^ (g == 0 ? qv0[j][s][0] : qv1[j][s][0]))); }
#pragma unroll
        for (int p = 0; p < 8; ++p)
#pragma unroll
            for (int j = 0; j < 2; ++j) { const f32x2 a = {relu1(acc[j][2 * p]), relu1(acc[j][2 * p + 1])}; const f32x2 w2 = {wj[2 * g + j], wj[2 * g + j]}; scp[p] = a * w2 + scp[p]; } }
    unsigned sel = 0u, cnd = 0u;
    if (MODE <= 0) { float t = 0.f;
#pragma unroll
        for (int p = 0; p < 8; ++p) t += scp[p][0] + scp[p][1];
        if (t == 12345.678f) __hip_atomic_fetch_or(mask + q * HS + kt, 1u, __ATOMIC_RELAXED, __HIP_MEMORY_SCOPE_WORKGROUP);
        return; }
    const float F0 = __uint_as_float(c0), F1 = __uint_as_float(c1);
#pragma unroll
    for (int r = 0; r < 16; ++r) { const int kr = crow(r, hi);
        const bool ok = !DIAG || kr <= q;
        const float scv = scp[r >> 1][r & 1]; const unsigned u = __float_as_uint(scv);
        if (MODE == 1) { const unsigned key = u ^ ((unsigned)((int)u >> 31) | 0x80000000u);
            if (ok && (key >> 24) >= c0) __hip_atomic_fetch_add(hist + q * HS + (key >> 24), 1u, __ATOMIC_RELAXED, __HIP_MEMORY_SCOPE_WORKGROUP); }
        else if (MODE == 2) { if (ok && (u >> 24) == c0) __hip_atomic_fetch_add(hist + q * HS + (((u >> 16) & 255u) ^ c1), 1u, __ATOMIC_RELAXED, __HIP_MEMORY_SCOPE_WORKGROUP); }
        else { const bool ge1 = scv >= F1, ge0 = scv >= F0;
            if (ok && ge1) sel |= 1u << kr;
            if (ok && ge0 && !ge1) { cnd |= 1u << kr; const unsigned key = u ^ ((unsigned)((int)u >> 31) | 0x80000000u);
                const unsigned pos = __hip_atomic_fetch_add(rinfo + 128 + q, 1u, __ATOMIC_RELAXED, __HIP_MEMORY_SCOPE_WORKGROUP);
                if (pos < 64u) cand[q * 64 + pos] = ((unsigned long long)key << 32) | (unsigned)(~(unsigned)(kt * 32 + kr)); } } }
    if (MODE == 3) { if (sel) __hip_atomic_fetch_or(mask + q * HS + kt, sel, __ATOMIC_RELAXED, __HIP_MEMORY_SCOPE_WORKGROUP);
        if (cnd) __hip_atomic_fetch_or(cmask + q * HS + kt, cnd, __ATOMIC_RELAXED, __HIP_MEMORY_SCOPE_WORKGROUP); }
}
template <int MODE> DI void idx_pass(const bf16* proj, int rowbase, int qt, LAS const char* qimg, const float (&wj)[4], LAS unsigned* hist, LAS unsigned* mask, LAS unsigned* cmask, LAS unsigned long long* cand, LAS unsigned* rinfo, int wave, int lane) {
    const int q = lane & 31, hi = lane >> 5, nkt = qt + 1;
    const unsigned b1 = MODE == 2 ? rinfo[160 + q] : rinfo[224 + q], thr16 = MODE == 2 ? rinfo[192 + q] : rinfo[256 + q];
    const bf16* kp0 = proj + (size_t)(rowbase + q) * 64 + hi * 8;
    LAS const char* qb = qimg + hi * 512 + q * 16;
    const int n = nkt > wave ? (nkt - wave + 7) >> 3 : 0;
    bf16x8 kfa[4], kfb[4];
#define IDX_LOAD(KF, I) do { const bf16* kp_ = kp0 + (size_t)((wave + 8 * (I)) * 32) * 64; _Pragma("unroll") for (int s_ = 0; s_ < 4; ++s_) KF[s_] = *(const bf16x8*)(kp_ + s_ * 16); } while (0)
#define IDX_TILE(KF, I) do { const int kt_ = wave + 8 * (I); if (kt_ == qt) idx_tile<MODE, true>(KF, qb, wj, kt_, q, hi, b1, thr16, hist, mask, cmask, cand, rinfo); \
        else idx_tile<MODE, false>(KF, qb, wj, kt_, q, hi, b1, thr16, hist, mask, cmask, cand, rinfo); } while (0)
    if (n > 0) IDX_LOAD(kfa, 0);
    for (int i = 0; i < n; i += 2) {
        if (i + 1 < n) { if (MODE == -1) { _Pragma("unroll") for (int s_ = 0; s_ < 4; ++s_) kfb[s_] = kfa[s_]; } else IDX_LOAD(kfb, i + 1); }
        IDX_TILE(kfa, i);
        if (i + 1 < n) { if (i + 2 < n && MODE != -1) IDX_LOAD(kfa, i + 2); IDX_TILE(kfb, i + 1); }
    }
#undef IDX_LOAD
#undef IDX_TILE
}
DI void hist_pick(LAS const unsigned* hrow, unsigned need, int lane, unsigned& bin, unsigned& above) {
    unsigned h4[4];
#pragma unroll
    for (int k = 0; k < 4; ++k) h4[k] = hrow[4 * lane + k];
    const unsigned ssum = h4[0] + h4[1] + h4[2] + h4[3];
    unsigned x = ssum;
#pragma unroll
    for (int o = 1; o < 64; o <<= 1) { const unsigned y = __shfl_down(x, o); if (lane + o < 64) x += y; }
    const unsigned long long m = __ballot(x >= need);
    const int Ls = m ? 63 - __builtin_clzll(m) : 0;
    const unsigned xs = __shfl(x, Ls), ss = __shfl(ssum, Ls);
    const unsigned h0 = __shfl(h4[0], Ls), h1 = __shfl(h4[1], Ls), h2 = __shfl(h4[2], Ls), h3 = __shfl(h4[3], Ls);
    unsigned cum = xs - ss;
    if (cum + h3 >= need) { bin = 4 * Ls + 3; above = cum; return; } cum += h3;
    if (cum + h2 >= need) { bin = 4 * Ls + 2; above = cum; return; } cum += h2;
    if (cum + h1 >= need) { bin = 4 * Ls + 1; above = cum; return; } cum += h1;
    bin = 4 * Ls; above = cum; (void)h0;
}
DI void idx_pass1(const bf16* proj, int rowbase, int qt, LAS const char* qimg, const float (&wj)[4], LAS unsigned* hist, LAS unsigned* mask, LAS unsigned* cmask, LAS unsigned long long* cand, LAS unsigned* rinfo, int wave, int lane) {
    const int q = lane & 31, hi = lane >> 5, nkt = qt + 1, nmax = (nkt + 7) >> 3;
    const bf16* kp0 = proj + (size_t)(rowbase + q) * 64 + hi * 8;
    LAS const char* qb = qimg + hi * 512 + q * 16;
    unsigned lb = 0u;
    bf16x8 kfc[4], kfn[4];
    if (wave < nkt) {
#pragma unroll
        for (int s = 0; s < 4; ++s) kfc[s] = *(const bf16x8*)(kp0 + (size_t)(wave * 32) * 64 + s * 16); }
    for (int i = 0; i < nmax; ++i) { const int kt = wave + 8 * i;
        if (kt + 8 < nkt) {
#pragma unroll
            for (int s = 0; s < 4; ++s) kfn[s] = *(const bf16x8*)(kp0 + (size_t)((kt + 8) * 32) * 64 + s * 16); }
        if (kt < nkt) { if (kt == qt) idx_tile<1, true>(kfc, qb, wj, kt, q, hi, lb, 0u, hist, mask, cmask, cand, rinfo); else idx_tile<1, false>(kfc, qb, wj, kt, q, hi, lb, 0u, hist, mask, cmask, cand, rinfo); }
#pragma unroll
        for (int s = 0; s < 4; ++s) kfc[s] = kfn[s];
        if (((i + 1) & i) == 0 && i + 1 < nmax && i < 16) {
            __syncthreads();
#pragma unroll 1
            for (int rr = 0; rr < 4; ++rr) { const int row = wave * 4 + rr; unsigned bin, above; hist_pick(hist + row * HS, 256u, lane, bin, above);
                if (lane == 0) rinfo[288 + row] = bin; }
            __syncthreads();
            { const unsigned nb = rinfo[288 + q]; lb = nb > lb ? nb : lb; } }
    }
}
DI void idx_unit(const Fr& F, int b, int qt, int stop = 0  ) {
    const bf16* proj = (const bf16*)(F.ws + WS_PROJ); const bf16* kic = (const bf16*)(F.ws + WS_KIC); unsigned short* sel = (unsigned short*)(F.ws + WS_SEL);
    LAS unsigned* hist = (LAS unsigned*)(F.lds); LAS unsigned* mask = hist + 32 * HS; LAS unsigned* cmask = mask + 32 * HS;
    LAS unsigned long long* cand = (LAS unsigned long long*)(F.lds + 99328); LAS unsigned* rinfo = (LAS unsigned*)(F.lds + 115712);
    const int lane = F.lane, wave = F.wave, tid = F.tid, t0 = qt * 32, rowbase = b * SEQ;
    __syncthreads();
    for (int i = tid; i < 3 * 32 * HS; i += NTHR) hist[i] = 0u;
    if (tid < 320) rinfo[tid] = 0u;
    __syncthreads();
    if (t0 + 31 <= 255 || (EXPF & 64)) {
        if (lane < 8) {
#pragma unroll
            for (int rr = 0; rr < 4; ++rr) { const int row = wave * 4 + rr, nv = t0 + row + 1;
                const int nv0 = t0 + row + 1; const int nvc = nv0 < 256 ? nv0 : 256; (void)nv; mask[row * HS + lane] = nvc >= 32 * (lane + 1) ? 0xffffffffu : (nvc > 32 * lane ? ((1u << (nvc - 32 * lane)) - 1u) : 0u); } }
    } else {
        const int q = lane & 31;
        float wj[4];
        { const bf16* qp = proj + (size_t)(rowbase + t0 + q) * EV_N;
#pragma unroll
            for (int j = 0; j < 4; ++j) wj[j] = bf2f(qp[EC_WI + j]); }
        LAS char* qimg = (LAS char*)(F.lds + 117248);
#pragma unroll
        for (int i = 0; i < 2; ++i) { const int p = tid + i * NTHR, row = p & 31, c = p >> 5;
            *(LAS v4u*)(qimg + c * 512 + row * 16) = *(const v4u*)(proj + (size_t)(rowbase + t0 + row) * EV_N + EC_QI + c * 8); }
        __syncthreads();
        if (stop == 7) return;
        if (stop == 4) { idx_pass<0>(kic, rowbase, qt, qimg, wj, hist, mask, cmask, cand, rinfo, wave, lane); return; }
        if (stop == 5) { idx_pass<-1>(kic, rowbase, qt, qimg, wj, hist, mask, cmask, cand, rinfo, wave, lane); return; }
        if (stop == 6) { idx_pass<-2>(kic, rowbase, qt, qimg, wj, hist, mask, cmask, cand, rinfo, wave, lane); return; }
        idx_pass1(kic, rowbase, qt, qimg, wj, hist, mask, cmask, cand, rinfo, wave, lane);
        __syncthreads();
#pragma unroll 1
        for (int rr = 0; rr < 4; ++rr) { const int row = wave * 4 + rr; unsigned bin, above; hist_pick(hist + row * HS, 256u, lane, bin, above);
            if (lane == 0) { rinfo[row] = bin; rinfo[32 + row] = 256u - above; rinfo[160 + row] = bin >= 128u ? bin - 128u : 255u - bin; rinfo[192 + row] = bin >= 128u ? 0u : 255u; } }
        __syncthreads();
        if (stop == 1) return;
        for (int i = tid; i < 32 * HS; i += NTHR) hist[i] = 0u;
        __syncthreads();
        idx_pass<2>(kic, rowbase, qt, qimg, wj, hist, mask, cmask, cand, rinfo, wave, lane);
        __syncthreads();
#pragma unroll 1
        for (int rr = 0; rr < 4; ++rr) { const int row = wave * 4 + rr; const unsigned need1 = rinfo[32 + row]; unsigned bin, above; hist_pick(hist + row * HS, need1, lane, bin, above);
            if (lane == 0) { const unsigned t16 = (rinfo[row] << 8) | bin, k0 = t16 << 16, k1 = (t16 + 1u) << 16;
                rinfo[64 + row] = t16; rinfo[96 + row] = need1 - above;
                rinfo[224 + row] = (k0 & 0x80000000u) ? (k0 ^ 0x80000000u) : ~k0; rinfo[256 + row] = (t16 == 0xffffu) ? 0x7fc00000u : ((k1 & 0x80000000u) ? (k1 ^ 0x80000000u) : ~k1); } }
        __syncthreads();
        if (stop == 2) return;
        idx_pass<3>(kic, rowbase, qt, qimg, wj, hist, mask, cmask, cand, rinfo, wave, lane);
        __syncthreads();
        if (stop == 3) return;
#pragma unroll 1
        for (int rr = 0; rr < 4; ++rr) { const int row = wave * 4 + rr; const unsigned call = rinfo[128 + row], need2 = rinfo[96 + row];
            if (call <= 64u) { const unsigned c = call;
                const unsigned long long mine = cand[row * 64 + lane]; unsigned rank = 0u;
                for (unsigned k = 0; k < c; ++k) rank += (cand[row * 64 + k] > mine) ? 1u : 0u;
                if ((unsigned)lane < c && rank < need2) { const unsigned s = ~(unsigned)mine;
                    __hip_atomic_fetch_or(mask + row * HS + (s >> 5), 1u << (s & 31), __ATOMIC_RELAXED, __HIP_MEMORY_SCOPE_WORKGROUP); } }
            else { unsigned w4[4];
#pragma unroll
                for (int k = 0; k < 4; ++k) w4[k] = cmask[row * HS + 4 * lane + k];
                const unsigned cnt = __popc(w4[0]) + __popc(w4[1]) + __popc(w4[2]) + __popc(w4[3]);
                unsigned x = cnt;
#pragma unroll
                for (int o = 1; o < 64; o <<= 1) { const unsigned y = __shfl_up(x, o); if (lane >= o) x += y; }
                unsigned before = x - cnt;
#pragma unroll
                for (int k = 0; k < 4; ++k) { unsigned w = w4[k]; const unsigned pc = __popc(w); unsigned take = 0u;
                    if (before < need2) { if (before + pc <= need2) take = w; else { unsigned left = need2 - before; while (left) { const unsigned b = w & (0u - w); take |= b; w ^= b; --left; } } }
                    before += pc;
                    if (take) mask[row * HS + 4 * lane + k] |= take; } }
        }
    }
    __syncthreads();
#pragma unroll 1
    for (int rr = 0; rr < 4; ++rr) { const int row = wave * 4 + rr; unsigned short* out = sel + (size_t)(rowbase + t0 + row) * 256;
        unsigned w4[4];
#pragma unroll
        for (int k = 0; k < 4; ++k) w4[k] = mask[row * HS + 4 * lane + k];
        const unsigned cnt = __popc(w4[0]) + __popc(w4[1]) + __popc(w4[2]) + __popc(w4[3]);
        unsigned x = cnt;
#pragma unroll
        for (int o = 1; o < 64; o <<= 1) { const unsigned y = __shfl_up(x, o); if (lane >= o) x += y; }
        const unsigned total = __shfl(x, 63); unsigned pos = x - cnt;
#pragma unroll
        for (int k = 0; k < 4; ++k) { unsigned w = w4[k]; const unsigned base = (unsigned)(4 * lane + k) * 32u;
            while (w) { const unsigned bit = __builtin_ctz(w); if (pos < 256u) out[pos] = (unsigned short)(base + bit); ++pos; w &= w - 1u; } }
        for (unsigned i = total + lane; i < 256u; i += 64u) out[i] = (unsigned short)0xffffu; }
}

struct AttSt { float m, l; f32x16 o0, o1; };
template <class BF> DI void att_subtile(AttSt& S, const bf16x8 (&qf)[4], LAS const char* Kst, LAS const char* Vb, int vdh, int vrow0, int lane, const BF& bias) {
    const int r32 = lane & 31, hi = lane >> 5;
    f32x16 p;
#pragma unroll
    for (int r = 0; r < 16; ++r) p[r] = bias.b(crow(r, hi)) - S.m;
    LAS const char* kp = Kst + hi * 512 + r32 * 16;
#pragma unroll
    for (int s = 0; s < 4; ++s) { const bf16x8 kf = *(LAS const bf16x8*)(kp + s * 1024); p = mfma32(kf, qf[s], p); }
    if (bias.any) {
#pragma unroll
        for (int r = 0; r < 16; ++r) p[r] = bias.msk(crow(r, hi)) ? -INFINITY : p[r]; }
    float mxa[4] = {-INFINITY, -INFINITY, -INFINITY, -INFINITY};
#pragma unroll
    for (int r = 0; r < 16; ++r) mxa[r & 3] = fmaxf(mxa[r & 3], p[r]);
    float mx = fmaxf(fmaxf(mxa[0], mxa[1]), fmaxf(mxa[2], mxa[3]));
    mx = fmaxf(mx, __shfl_xor(mx, 32));
    if (__any(mx > 16.f)) { const float dl = fmaxf(mx, 0.f), sc = ex2(-dl); S.m += dl; S.l *= sc;
#pragma unroll
        for (int r = 0; r < 16; ++r) { p[r] -= dl; S.o0[r] *= sc; S.o1[r] *= sc; } }
    float psa[4] = {0.f, 0.f, 0.f, 0.f};
#pragma unroll
    for (int r = 0; r < 16; ++r) { p[r] = ex2(p[r]); psa[r & 3] += p[r]; }
    S.l += (psa[0] + psa[1]) + (psa[2] + psa[3]);
    v4u pw0, pw1;
    pw0.x = cvtpk(p[0], p[1]); pw0.y = cvtpk(p[2], p[3]); pw0.z = cvtpk(p[4], p[5]); pw0.w = cvtpk(p[6], p[7]);
    pw1.x = cvtpk(p[8], p[9]); pw1.y = cvtpk(p[10], p[11]); pw1.z = cvtpk(p[12], p[13]); pw1.w = cvtpk(p[14], p[15]);
    const bf16x8 pf0 = __builtin_bit_cast(bf16x8, pw0), pf1 = __builtin_bit_cast(bf16x8, pw1);
    LAS const char* vp = Vb + (vrow0 + 4 * hi + ((lane & 15) >> 2)) * 64 + ((lane >> 4) & 1) * 32 + (lane & 3) * 8;
    { const bf16x8 v00 = cat8(vtr(vp), vtr(vp + 512)), v10 = cat8(vtr(vp + vdh), vtr(vp + vdh + 512));
      const bf16x8 v01 = cat8(vtr(vp + 1024), vtr(vp + 1536)), v11 = cat8(vtr(vp + vdh + 1024), vtr(vp + vdh + 1536));
      S.o0 = mfma32(v00, pf0, S.o0); S.o1 = mfma32(v10, pf0, S.o1);
      S.o0 = mfma32(v01, pf1, S.o0); S.o1 = mfma32(v11, pf1, S.o1); }
}
template <class BF0, class BF1> DI void att_tile64(AttSt& S, const bf16x8 (&qf)[4], LAS const char* Kst, LAS const char* Vb, int vdh, int vrow0, int lane, const BF0& bias0, const BF1& bias1) {
    const int r32 = lane & 31, hi = lane >> 5;
    f32x16 p0, p1;
#pragma unroll
    for (int r = 0; r < 16; ++r) { p0[r] = bias0.b(crow(r, hi)) - S.m; p1[r] = bias1.b(crow(r, hi)) - S.m; }
    LAS const char* kp = Kst + hi * 512 + r32 * 16;
#pragma unroll
    for (int s = 0; s < 4; ++s) { const bf16x8 k0 = *(LAS const bf16x8*)(kp + s * 1024), k1 = *(LAS const bf16x8*)(kp + 4096 + s * 1024); p0 = mfma32(k0, qf[s], p0); p1 = mfma32(k1, qf[s], p1); }
    if (bias0.any) {
#pragma unroll
        for (int r = 0; r < 16; ++r) p0[r] = bias0.msk(crow(r, hi)) ? -INFINITY : p0[r]; }
    if (bias1.any) {
#pragma unroll
        for (int r = 0; r < 16; ++r) p1[r] = bias1.msk(crow(r, hi)) ? -INFINITY : p1[r]; }
    float mxa[4] = {-INFINITY, -INFINITY, -INFINITY, -INFINITY};
#pragma unroll
    for (int r = 0; r < 16; ++r) mxa[r & 3] = fmaxf(mxa[r & 3], fmaxf(p0[r], p1[r]));
    float mx = fmaxf(fmaxf(mxa[0], mxa[1]), fmaxf(mxa[2], mxa[3]));
    mx = fmaxf(mx, __shfl_xor(mx, 32));
    if (__any(mx > 16.f)) { const float dl = fmaxf(mx, 0.f), sc = ex2(-dl); S.m += dl; S.l *= sc;
#pragma unroll
        for (int r = 0; r < 16; ++r) { p0[r] -= dl; p1[r] -= dl; S.o0[r] *= sc; S.o1[r] *= sc; } }
    float psa[4] = {0.f, 0.f, 0.f, 0.f};
#pragma unroll
    for (int r = 0; r < 16; ++r) { p0[r] = ex2(p0[r]); p1[r] = ex2(p1[r]); psa[r & 3] += p0[r] + p1[r]; }
    S.l += (psa[0] + psa[1]) + (psa[2] + psa[3]);
    v4u a0, a1, b0, b1;
    a0.x = cvtpk(p0[0], p0[1]); a0.y = cvtpk(p0[2], p0[3]); a0.z = cvtpk(p0[4], p0[5]); a0.w = cvtpk(p0[6], p0[7]);
    a1.x = cvtpk(p0[8], p0[9]); a1.y = cvtpk(p0[10], p0[11]); a1.z = cvtpk(p0[12], p0[13]); a1.w = cvtpk(p0[14], p0[15]);
    b0.x = cvtpk(p1[0], p1[1]); b0.y = cvtpk(p1[2], p1[3]); b0.z = cvtpk(p1[4], p1[5]); b0.w = cvtpk(p1[6], p1[7]);
    b1.x = cvtpk(p1[8], p1[9]); b1.y = cvtpk(p1[10], p1[11]); b1.z = cvtpk(p1[12], p1[13]); b1.w = cvtpk(p1[14], p1[15]);
    LAS const char* vp = Vb + (vrow0 + 4 * hi + ((lane & 15) >> 2)) * 64 + ((lane >> 4) & 1) * 32 + (lane & 3) * 8;
#pragma unroll
    for (int k16 = 0; k16 < 4; ++k16) { const bf16x8 pf = __builtin_bit_cast(bf16x8, k16 == 0 ? a0 : k16 == 1 ? a1 : k16 == 2 ? b0 : b1);
        const bf16x8 v0 = cat8(vtr(vp + k16 * 1024), vtr(vp + k16 * 1024 + 512)), v1 = cat8(vtr(vp + vdh + k16 * 1024), vtr(vp + vdh + k16 * 1024 + 512));
        S.o0 = mfma32(v0, pf, S.o0); S.o1 = mfma32(v1, pf, S.o1); }
}

struct MobaFar { float c; bool any; DI float b(int) const { return c; } DI bool msk(int) const { return false; } };
struct MobaBias { LAS const float* lut; int tq, s0; bool any;
    DI float b(int kvrel) const { const int dist = tq - (s0 + kvrel); return lut[dist < 0 ? 0 : (dist > 1023 ? 1023 : dist)]; }
    DI bool msk(int kvrel) const { return tq - (s0 + kvrel) < 0; } };
DI void moba_qload(bf16x8 (&qf)[4], const bf16* proj, int rowbase, int h, int tq, int hi) {
    const bf16* qp = proj + (size_t)(rowbase + tq) * EV_N + EC_QB + h * 64 + hi * 8;
#pragma unroll
    for (int s = 0; s < 4; ++s) qf[s] = *(const bf16x8*)(qp + s * 16);
}
DI void moba_tile(const Fr& F, const bf16x8 (&qf)[4], int rowbase, int h, int n, int tq, bool valid, int slot, bool own, int wave_tile) {
    LAS const char* Kb = (LAS const char*)F.lds; LAS const char* Vb = (LAS const char*)(F.lds + 32768); LAS const float* lut = (LAS const float*)(F.lds + 98304);
    bf16* po = (bf16*)(F.ws + WS_ACT); float* pml = (float*)(F.ws + WS_PML);
    const int lane = F.lane, hi = lane >> 5;
    AttSt S; S.m = 0.f; S.l = 0.f;
#pragma unroll
    for (int r = 0; r < 16; ++r) { S.o0[r] = 0.f; S.o1[r] = 0.f; }
    const int nst = own ? wave_tile + 1 : 8;
    int tmin = tq;
#pragma unroll
    for (int o = 1; o < 64; o <<= 1) { const int y = __shfl_xor(tmin, o); tmin = y < tmin ? y : tmin; }
    const float cfar = lut[1023];
    int st = 0;
    for (; st + 1 < nst; st += 2) {
        if (!own && tmin - (n * 256 + st * 32 + 63) >= 790) { MobaFar bf{cfar, false}; att_tile64(S, qf, Kb + st * 4096, Vb, 16384, st * 32, lane, bf, bf); }
        else { MobaBias bf0{lut, tq, n * 256 + st * 32, false}, bf1{lut, tq, n * 256 + st * 32 + 32, own && st + 1 == wave_tile}; att_tile64(S, qf, Kb + st * 4096, Vb, 16384, st * 32, lane, bf0, bf1); } }
    if (st < nst) { MobaBias bf{lut, tq, n * 256 + st * 32, own && st == wave_tile}; att_subtile(S, qf, Kb + st * 4096, Vb, 16384, st * 32, lane, bf); }
    const float lt = S.l + __shfl_xor(S.l, 32), inv = 1.f / lt;
    if (valid) { const size_t pi = ((size_t)(rowbase + tq) * 8 + h) * 4 + slot; bf16* o = po + pi * 64;
#pragma unroll
        for (int a4 = 0; a4 < 4; ++a4) { v2u w0, w1;
            w0.x = cvtpk(S.o0[4 * a4] * inv, S.o0[4 * a4 + 1] * inv); w0.y = cvtpk(S.o0[4 * a4 + 2] * inv, S.o0[4 * a4 + 3] * inv);
            w1.x = cvtpk(S.o1[4 * a4] * inv, S.o1[4 * a4 + 1] * inv); w1.y = cvtpk(S.o1[4 * a4 + 2] * inv, S.o1[4 * a4 + 3] * inv);
            *(v2u*)(o + 8 * a4 + 4 * hi) = w0; *(v2u*)(o + 32 + 8 * a4 + 4 * hi) = w1; }
        if (hi == 0) { f32x2 ml = {S.m, lt}; *(f32x2*)(pml + pi * 2) = ml; } }
}
DI void moba_unit(const Args& a, const Fr& F, int b, int h, int n) {
    const bf16* proj = (const bf16*)(F.ws + WS_PROJ); const unsigned* sel3 = (const unsigned*)(F.ws + WS_SEL3);
    LAS unsigned char* lds = F.lds; LAS unsigned* list = (LAS unsigned*)(lds + 65536); LAS float* lut = (LAS float*)(lds + 98304); LAS unsigned* misc = (LAS unsigned*)(lds + 102400);
    const int tid = F.tid, lane = F.lane, wave = F.wave, rowbase = b * SEQ;
    __syncthreads();
    { const bf16* kg = proj + (size_t)(rowbase + n * 256) * EV_N + EC_KB + h * 64; const bf16* vg = proj + (size_t)(rowbase + n * 256) * EV_N + EC_VB + h * 64;
#pragma unroll
        for (int i = 0; i < 4; ++i) { const int p = tid + i * NTHR;
            { const int r = p & 31, c = (p >> 5) & 7, st = p >> 8; const v4u v = *(const v4u*)(kg + (size_t)(st * 32 + r) * EV_N + c * 8); *(LAS v4u*)(lds + st * 4096 + c * 512 + r * 16) = v; }
            { const int cc = p & 3, row = (p >> 2) & 255, dh = p >> 10; const v4u v = *(const v4u*)(vg + (size_t)row * EV_N + dh * 32 + cc * 8); *(LAS v4u*)(lds + 32768 + dh * 16384 + row * 64 + cc * 16) = v; } }
        for (int d = tid; d < 1024; d += NTHR) lut[d] = a.in[9][t5_bucket(d) * 16 + 8 + h] * LOG2E; }
    if (tid == 0) misc[16] = 0u;
    __syncthreads();
    unsigned sv[16];
#pragma unroll
    for (int k = 0; k < 16; ++k) { const int t = (n + 1) * 256 + k * NTHR + tid; sv[k] = t < SEQ ? sel3[(size_t)(rowbase + t) * 8 + h] : 0u; }
#pragma unroll
    for (int k = 0; k < 16; ++k) { const int tb = (n + 1) * 256 + k * NTHR; if (tb < SEQ) { const int t = tb + tid;
        const unsigned s = sv[k]; const unsigned nv = s >> 24; int slot = -1;
        if (nv > 0u && (s & 255u) == (unsigned)n) slot = 0; else if (nv > 1u && ((s >> 8) & 255u) == (unsigned)n) slot = 1; else if (nv > 2u && ((s >> 16) & 255u) == (unsigned)n) slot = 2;
        const unsigned long long bal = __ballot(slot >= 0); const unsigned wcnt = __popcll(bal);
        if (lane == 0) misc[wave] = wcnt;
        __syncthreads();
        unsigned off = misc[16], tot = 0u;
#pragma unroll
        for (int w = 0; w < 8; ++w) { const unsigned c = misc[w]; if (w < wave) off += c; tot += c; }
        if (slot >= 0) list[off + __popcll(bal & ((1ull << lane) - 1ull))] = ((unsigned)t << 2) | (unsigned)slot;
        __syncthreads();
        if (tid == 0) misc[16] += tot; } }
    __syncthreads();
    const int nlist = (int)misc[16];
    const int ntl = (nlist + 31) >> 5, hi = lane >> 5;
    bf16x8 qa[4], qb2[4];
    moba_qload(qa, proj, rowbase, h, n * 256 + wave * 32 + (lane & 31), hi);
    unsigned ea = 0u, eb = 0u; bool va = false, vb = false;
    int tl = wave;
    if (tl < ntl) { const int li = tl * 32 + (lane & 31); vb = li < nlist; eb = list[vb ? li : nlist - 1]; moba_qload(qb2, proj, rowbase, h, (int)(eb >> 2), hi); }
    moba_tile(F, qa, rowbase, h, n, n * 256 + wave * 32 + (lane & 31), true, 3, true, wave);
    for (; tl < ntl; tl += 16) {
        const int t2 = tl + 8, t3 = tl + 16;
        if (t2 < ntl) { const int li = t2 * 32 + (lane & 31); va = li < nlist; ea = list[va ? li : nlist - 1]; moba_qload(qa, proj, rowbase, h, (int)(ea >> 2), hi); }
        moba_tile(F, qb2, rowbase, h, n, (int)(eb >> 2), vb, (int)(eb & 3u), false, 0);
        if (t2 < ntl) {
            if (t3 < ntl) { const int li = t3 * 32 + (lane & 31); vb = li < nlist; eb = list[vb ? li : nlist - 1]; moba_qload(qb2, proj, rowbase, h, (int)(eb >> 2), hi); }
            moba_tile(F, qa, rowbase, h, n, (int)(ea >> 2), va, (int)(ea & 3u), false, 0); }
    }
}

DI void dsa_step(const bf16x8 (&af)[2][4], const bf16x8 (&qlf)[4], int ch, LAS const unsigned char* bsel, LAS unsigned char* cbuf, LAS const float* tab,
                 float& m, float& l, f32x4 (&oT)[8], int l15, int kg, int lane) {
    f32x4 acc[2];
#pragma unroll
    for (int mt = 0; mt < 2; ++mt) { const unsigned b4 = *(LAS const unsigned*)(bsel + ch * 32 + mt * 16 + 4 * kg);
#pragma unroll
        for (int i = 0; i < 4; ++i) { const unsigned bb = (b4 >> (8 * i)) & 255u; const float tb = tab[(bb & 31u) * 8 + (l15 & 7)];
            acc[mt][i] = (tb - m) + (bb != 255u ? 0.f : -INFINITY); } }
#pragma unroll
    for (int mt = 0; mt < 2; ++mt)
#pragma unroll
        for (int ks = 0; ks < 4; ++ks) { acc[mt] = mfma16(af[mt][ks], qlf[ks], acc[mt]); *(LAS bf16x8*)(cbuf + (mt * 16 + l15) * 288 + (ks * 32 + kg * 8) * 2) = af[mt][ks]; }
    float mx = fmaxf(fmaxf(fmaxf(acc[0][0], acc[0][1]), fmaxf(acc[0][2], acc[0][3])), fmaxf(fmaxf(acc[1][0], acc[1][1]), fmaxf(acc[1][2], acc[1][3])));
    mx = fmaxf(mx, __shfl_xor(mx, 16)); mx = fmaxf(mx, __shfl_xor(mx, 32));
    if (__any(mx > 16.f)) { const float dl = fmaxf(mx, 0.f), sc = ex2(-dl); m += dl; l *= sc;
#pragma unroll
        for (int mt = 0; mt < 2; ++mt) acc[mt] = acc[mt] - dl;
#pragma unroll
        for (int ct = 0; ct < 8; ++ct) oT[ct] = oT[ct] * sc; }
    float ps = 0.f;
#pragma unroll
    for (int mt = 0; mt < 2; ++mt)
#pragma unroll
        for (int i = 0; i < 4; ++i) { acc[mt][i] = ex2(acc[mt][i]); ps += acc[mt][i]; }
    l += ps;
    v4u pw; pw.x = cvtpk(acc[0][0], acc[0][1]); pw.y = cvtpk(acc[0][2], acc[0][3]); pw.z = cvtpk(acc[1][0], acc[1][1]); pw.w = cvtpk(acc[1][2], acc[1][3]);
    const bf16x8 pf = __builtin_bit_cast(bf16x8, pw);
    LDS_WAIT();
    LAS const char* tp = (LAS const char*)cbuf + (4 * kg + (l15 >> 2)) * 288 + (lane & 3) * 8;
#pragma unroll
    for (int ct = 0; ct < 8; ++ct) { const bf16x8 cf = cat8(vtr(tp + ct * 32), vtr(tp + 16 * 288 + ct * 32)); oT[ct] = mfma16(cf, pf, oT[ct]); }
    LDS_WAIT();
}
DI void dsa_gather(bf16x8 (&af)[2][4], const bf16* ckvn, int rowbase, LAS const unsigned short* selb, int ch, int l15, int kg) {
#pragma unroll
    for (int mt = 0; mt < 2; ++mt) { unsigned idx = selb[ch * 32 + mt * 16 + l15]; if (idx == 0xffffu) idx = 0u;
        const bf16* cp = ckvn + (size_t)(rowbase + (int)idx) * 128 + kg * 8;
#pragma unroll
        for (int ks = 0; ks < 4; ++ks) af[mt][ks] = *(const bf16x8*)(cp + ks * 32); }
}
DI void dsa_query(const Fr& F, int tok, const v2u sv, LAS unsigned char* wl, LAS const unsigned char* bkt, LAS const float* tab) {
    const bf16* ql = (const bf16*)(F.ws + WS_QL); const bf16* ckvn = (const bf16*)(F.ws + WS_CKVN); const unsigned short* sel = (const unsigned short*)(F.ws + WS_SEL); bf16* ol = (bf16*)(F.ws + WS_OL);
    const int lane = F.lane, l15 = lane & 15, kg = lane >> 4, t = tok % SEQ, rowbase = tok - t;
    LAS unsigned short* selb = (LAS unsigned short*)wl; LAS unsigned char* bsel = wl + 512; LAS unsigned char* cbuf = wl + 1024;
    { *((LAS v2u*)selb + lane) = sv; unsigned bw = 0u;
#pragma unroll
        for (int i = 0; i < 4; ++i) { const unsigned s = (i < 2 ? (sv.x >> (16 * i)) : (sv.y >> (16 * (i - 2)))) & 0xffffu; const int dist = t - (int)s;
            const unsigned bb = (s != 0xffffu && dist >= 0) ? (unsigned)bkt[dist > 1023 ? 1023 : dist] : 255u; bw |= bb << (8 * i); }
        *((LAS unsigned*)bsel + lane) = bw; }
    bf16x8 qlf[4];
#pragma unroll
    for (int ks = 0; ks < 4; ++ks) { qlf[ks] = *(const bf16x8*)(ql + (size_t)tok * 1024 + (l15 & 7) * 128 + ks * 32 + kg * 8); if (l15 >= 8) qlf[ks] = (bf16x8){0, 0, 0, 0, 0, 0, 0, 0}; }
    float m = 0.f, l = 0.f; f32x4 oT[8];
#pragma unroll
    for (int ct = 0; ct < 8; ++ct) oT[ct] = (f32x4){0.f, 0.f, 0.f, 0.f};
    const int nvalid = t + 1 < 256 ? t + 1 : 256, nch = (nvalid + 31) >> 5;
    LDS_WAIT();
    bf16x8 afa[2][4], afb[2][4], afc[2][4];
    dsa_gather(afa, ckvn, rowbase, selb, 0, l15, kg);
    if (nch > 1) dsa_gather(afb, ckvn, rowbase, selb, 1, l15, kg);
    for (int ch = 0; ch < nch; ch += 3) {
        if (ch + 2 < nch) dsa_gather(afc, ckvn, rowbase, selb, ch + 2, l15, kg);
        dsa_step(afa, qlf, ch, bsel, cbuf, tab, m, l, oT, l15, kg, lane);
        if (ch + 1 < nch) { if (ch + 3 < nch) dsa_gather(afa, ckvn, rowbase, selb, ch + 3, l15, kg);
            dsa_step(afb, qlf, ch + 1, bsel, cbuf, tab, m, l, oT, l15, kg, lane); }
        if (ch + 2 < nch) { if (ch + 4 < nch) dsa_gather(afb, ckvn, rowbase, selb, ch + 4, l15, kg);
            dsa_step(afc, qlf, ch + 2, bsel, cbuf, tab, m, l, oT, l15, kg, lane); }
    }
    l += __shfl_xor(l, 16); l += __shfl_xor(l, 32);
    const float inv = 1.f / l;
    if (l15 < 8) { bf16* o = ol + (size_t)tok * 1024 + l15 * 128 + 4 * kg;
#pragma unroll
        for (int ct = 0; ct < 8; ++ct) { v2u w; w.x = cvtpk(oT[ct][0] * inv, oT[ct][1] * inv); w.y = cvtpk(oT[ct][2] * inv, oT[ct][3] * inv); *(v2u*)(o + ct * 16) = w; } }
}
DI void dsa_chunk(const Args& a, const Fr& F, int c32) {
    LAS unsigned char* bkt = F.lds + 81920; LAS float* tab = (LAS float*)(F.lds + 82944);
    __syncthreads();
    for (int d = F.tid; d < 1024; d += NTHR) bkt[d] = (unsigned char)t5_bucket(d);
    if (F.tid < 256) tab[F.tid] = a.in[9][(F.tid >> 3) * 16 + (F.tid & 7)] * LOG2E;
    __syncthreads();
    const unsigned short* selg = (const unsigned short*)(F.ws + WS_SEL); v2u svq[4];
#pragma unroll
    for (int i = 0; i < 4; ++i) svq[i] = *((const v2u*)(selg + (size_t)(c32 * 32 + F.wave * 4 + i) * 256) + F.lane);
#pragma unroll
    for (int i = 0; i < 4; ++i) dsa_query(F, c32 * 32 + F.wave * 4 + i, svq[i], F.lds + F.wave * 10240, bkt, tab);
}

DI void ph_even_post(const Fr& F, int j) {
    const bf16* ol = (const bf16*)(F.ws + WS_OL); bf16* ao = (bf16*)(F.ws + WS_AO);
    const bf16* wuvt = (const bf16*)(F.ws + WS_WUVT) + (size_t)j * 8 * 64 * 128;
    const bf16* po = (const bf16*)(F.ws + WS_ACT); const float* pml = (const float*)(F.ws + WS_PML); const unsigned* sel3 = (const unsigned*)(F.ws + WS_SEL3);
    const int lane = F.lane, wave = F.wave, l15 = lane & 15, kg = lane >> 4;
    for (int chunk = F.blk; chunk < 256; chunk += F.G) { const int tok0 = chunk * 128;
        { const int h = wave; bf16x8 af[4][4];
#pragma unroll
            for (int mt = 0; mt < 4; ++mt)
#pragma unroll
                for (int ks = 0; ks < 4; ++ks) af[mt][ks] = *(const bf16x8*)(wuvt + ((size_t)h * 64 + mt * 16 + l15) * 128 + ks * 32 + kg * 8);
#pragma unroll 1
            for (int tg = 0; tg < 8; tg += 2) { bf16x8 bf[2][4];
#pragma unroll
                for (int u = 0; u < 2; ++u)
#pragma unroll
                    for (int ks = 0; ks < 4; ++ks) bf[u][ks] = *(const bf16x8*)(ol + (size_t)(tok0 + (tg + u) * 16 + l15) * 1024 + h * 128 + ks * 32 + kg * 8);
#pragma unroll
                for (int u = 0; u < 2; ++u) { const int tok = tok0 + (tg + u) * 16 + l15;
#pragma unroll
                    for (int mt = 0; mt < 4; ++mt) { f32x4 d = {0.f, 0.f, 0.f, 0.f};
#pragma unroll
                        for (int ks = 0; ks < 4; ++ks) d = mfma16(af[mt][ks], bf[u][ks], d);
                        v2u w; w.x = cvtpk(d[0], d[1]); w.y = cvtpk(d[2], d[3]); *(v2u*)(ao + (size_t)tok * 1024 + h * 64 + mt * 16 + 4 * kg) = w; } } } }
#pragma unroll 1
        for (int i0 = 0; i0 < 16; i0 += 4) { const int h = lane >> 3, d0 = (lane & 7) * 8; unsigned nvv[4]; f32x2 mlv[4][4];
#pragma unroll
            for (int i = 0; i < 4; ++i) { const int tok = tok0 + wave * 16 + i0 + i; const size_t pi = ((size_t)tok * 8 + h) * 4; nvv[i] = sel3[(size_t)tok * 8 + h] >> 24;
#pragma unroll
                for (int s = 0; s < 4; ++s) mlv[i][s] = *(const f32x2*)(pml + (pi + s) * 2); }
#pragma unroll
            for (int i = 0; i < 4; ++i) { const int tok = tok0 + wave * 16 + i0 + i; const size_t pi = ((size_t)tok * 8 + h) * 4;
                float mj[4], lj[4];
#pragma unroll
                for (int s = 0; s < 4; ++s) { const bool ok = (s == 3) || ((unsigned)s < nvv[i]); mj[s] = ok ? mlv[i][s][0] : -1e30f; lj[s] = ok ? mlv[i][s][1] : 0.f; }
                const float ms = fmaxf(fmaxf(mj[0], mj[1]), fmaxf(mj[2], mj[3])); float wsum = 0.f, acc[8], wv[4]; v4u pv[4];
#pragma unroll
                for (int k = 0; k < 8; ++k) acc[k] = 0.f;
#pragma unroll
                for (int s = 0; s < 4; ++s) { wv[s] = lj[s] * ex2(mj[s] - ms); wsum += wv[s]; pv[s] = (v4u){0u, 0u, 0u, 0u}; if (wv[s] > 0.f) pv[s] = *(const v4u*)(po + (pi + s) * 64 + d0); }
#pragma unroll
                for (int s = 0; s < 4; ++s) { if (wv[s] > 0.f) {
#pragma unroll
                    for (int k = 0; k < 4; ++k) { acc[2 * k] += wv[s] * bf2f(pv[s][k] & 0xffffu); acc[2 * k + 1] += wv[s] * bf2f(pv[s][k] >> 16); } } }
                const float inv = 1.f / wsum; v4u o; o.x = cvtpk(acc[0] * inv, acc[1] * inv); o.y = cvtpk(acc[2] * inv, acc[3] * inv); o.z = cvtpk(acc[4] * inv, acc[5] * inv); o.w = cvtpk(acc[6] * inv, acc[7] * inv);
                *(v4u*)(ao + (size_t)tok * 1024 + 512 + h * 64 + d0) = o; } }
    }
}
DI f32x16 proj32_f32(const float* W, int ldw, int ncols, const float* xrow, int d_lo, int lane) {
    const int e = lane & 31, kh = lane >> 5; const bool ev = e < ncols;
    f32x16 D;
#pragma unroll
    for (int r = 0; r < 16; ++r) D[r] = 0.f;
    const float* wp = W + (size_t)(d_lo + 4 * kh) * ldw + (ev ? e : 0);
    const float* xp = xrow + d_lo + 4 * kh;
#pragma unroll 8
    for (int i = 0; i < 64; ++i) { const f32x4 xv = *(const f32x4*)(xp + 8 * i);
        float a0 = wp[(size_t)(8 * i + 0) * ldw], a1 = wp[(size_t)(8 * i + 1) * ldw], a2 = wp[(size_t)(8 * i + 2) * ldw], a3 = wp[(size_t)(8 * i + 3) * ldw];
        if (!ev) { a0 = 0.f; a1 = 0.f; a2 = 0.f; a3 = 0.f; }
        D = __builtin_amdgcn_mfma_f32_32x32x2f32(a0, xv[0], D, 0, 0, 0); D = __builtin_amdgcn_mfma_f32_32x32x2f32(a1, xv[1], D, 0, 0, 0);
        D = __builtin_amdgcn_mfma_f32_32x32x2f32(a2, xv[2], D, 0, 0, 0); D = __builtin_amdgcn_mfma_f32_32x32x2f32(a3, xv[3], D, 0, 0, 0); }
    return D;
}
DI void ph_odd_prep(const Args& a, const Fr& F, int j, int layer) {
    const bf16* proj = (const bf16*)(F.ws + WS_PROJ); const float* x = (const float*)(F.ws + WS_X);
    float* logf = (float*)(F.ws + WS_LOGF); float* cs = (float*)(F.ws + WS_CS);
    const float* wf = a.in[6] + (size_t)j * 1024 * 3088 + 3072; const float* bfv = a.in[7] + j * 16;
    LAS float* red = (LAS float*)(F.lds); LAS float* lfb = (LAS float*)(F.lds + 131072);
    LAS unsigned* kmx = (LAS unsigned*)(F.lds + 131072 + 8192);
    const int lane = F.lane, wave = F.wave, tid = F.tid, l31 = lane & 31, hi = lane >> 5;
    for (int chunk = F.blk; chunk < 256; chunk += F.G) { const int tok0 = chunk * 128, b = tok0 / SEQ, t0 = tok0 % SEQ;
        __syncthreads();
        if (tid < 16) kmx[tid] = 0u;
        const int tl = wave & 3, kr = wave >> 2;
        f32x16 D = proj32_f32(wf, 3088, 16, x + (size_t)(tok0 + tl * 32 + l31) * DM, kr * 512, lane);
        if (kr == 1) {
#pragma unroll
            for (int r = 0; r < 8; ++r) red[(tl * 8 + r) * 64 + lane] = D[r]; }
        __syncthreads();
        if (kr == 0) {
#pragma unroll
            for (int r = 0; r < 8; ++r) { const int h = (r & 3) + 8 * (r >> 2) + 4 * hi; const float z = D[r] + red[(tl * 8 + r) * 64 + lane] + bfv[h];
                const float ls = fminf(z, 0.f) - log1pf(__expf(-fabsf(z)));
                lfb[(tl * 32 + l31) * 16 + h] = ls * LOG2E; } }
#pragma unroll 1
        for (int i = 0; i < 4; ++i) { const int p = tid + i * NTHR, tk = p >> 4, h = p & 15; const v4u* kp = (const v4u*)(proj + (size_t)(tok0 + tk) * OD_N + OC_K + h * 64); float s = 0.f;
#pragma unroll
            for (int c = 0; c < 8; ++c) { const v4u w = kp[c];
#pragma unroll
                for (int k = 0; k < 4; ++k) { const float e0 = bf2f(w[k] & 0xffffu), e1 = bf2f(w[k] >> 16); s += e0 * e0 + e1 * e1; } }
            __hip_atomic_fetch_max(kmx + h, __float_as_uint(s), __ATOMIC_RELAXED, __HIP_MEMORY_SCOPE_WORKGROUP); }
        __syncthreads();
        for (int i = tid; i < 2048; i += NTHR) { const int h = i >> 7, tk = i & 127; logf[((size_t)b * 16 + h) * SEQ + t0 + tk] = lfb[tk * 16 + h]; }
        if (tid < 32) { const int h = tid & 15, c = tid >> 4; float s = 0.f;
            for (int k = 0; k < 64; ++k) s += lfb[(c * 64 + k) * 16 + h];
            cs[((size_t)b * 16 + h) * 128 + (t0 >> 6) + c] = s; }
        if (tid < 16) __hip_atomic_fetch_max(F.ctl + CW_KMAX + layer * 64 + b * 16 + tid, kmx[tid], RLX_AGENT);
    }
}

constexpr float FOX_SKIP_LOG2 = 64.f;
struct FoxBias { LAS const float* ng; int tq, kabs0; bool any;
    DI float b(int kvrel) const { return ng[kvrel]; }
    DI bool msk(int kvrel) const { return (kabs0 + kvrel) > tq; } };
DI void fox_unit(const Fr& F, int layer, int b, int h, int qb) {
    const bf16* proj = (const bf16*)(F.ws + WS_PROJ); const float* logf = (const float*)(F.ws + WS_LOGF); const float* cs = (const float*)(F.ws + WS_CS); bf16* ao = (bf16*)(F.ws + WS_AO);
    LAS unsigned char* lds = F.lds; LAS float* ng = (LAS float*)(lds + 32768); LAS float* red = (LAS float*)(lds + 65536 + 1024); LAS int* ibox = (LAS int*)(lds + 65536 + 2048);
    const int tid = F.tid, lane = F.lane, wave = F.wave, r32 = lane & 31, hi = lane >> 5, t0 = qb * 256, rowbase = b * SEQ, tq = t0 + wave * 32 + r32;
    __syncthreads();
    bf16x8 qf[4]; float qs = 0.f;
    { const bf16* qp = proj + (size_t)(rowbase + tq) * OD_N + OC_Q + h * 64 + hi * 8;
#pragma unroll
        for (int s = 0; s < 4; ++s) { qf[s] = *(const bf16x8*)(qp + s * 16);
#pragma unroll
            for (int k = 0; k < 8; ++k) { const float e = bf2f((unsigned short)qf[s][k]); qs += e * e; } } }
    qs += __shfl_xor(qs, 32); qs = wave_max(qs);
    if (lane == 0) red[wave] = qs;
    if (tid < 128) red[32 + tid] = (tid < t0 / 64) ? cs[((size_t)b * 16 + h) * 128 + tid] : 0.f;
    __syncthreads();
    if (tid == 0) { float qm = red[0];
        for (int w = 1; w < 8; ++w) qm = fmaxf(qm, red[w]);
        const float km = __uint_as_float(ld_u32(F.ctl + CW_KMAX + layer * 64 + b * 16 + h));
        const float B2 = 2.f * (sqrtf(qm * km) * 1.01f + 1.f);
        int kt = t0 / 64 - 1, kts = t0 / 64; float D = 0.f;
        while (kt >= 0 && B2 + D >= -FOX_SKIP_LOG2) { kts = kt; D += red[32 + kt]; --kt; }
        ibox[0] = kts; }
    __syncthreads();
    const int kts = ibox[0], s_start = kts * 64, nel = t0 + 256 - s_start;
    { const int i0 = tid * 16; float v[16]; const float* lp = logf + ((size_t)b * 16 + h) * SEQ + s_start + i0;
        if (i0 < nel) {
#pragma unroll
            for (int c = 0; c < 4; ++c) { const f32x4 w = *(const f32x4*)(lp + 4 * c); v[4 * c] = w[0]; v[4 * c + 1] = w[1]; v[4 * c + 2] = w[2]; v[4 * c + 3] = w[3]; } }
        else {
#pragma unroll
            for (int c = 0; c < 16; ++c) v[c] = 0.f; }
#pragma unroll
        for (int c = 1; c < 16; ++c) v[c] += v[c - 1];
        float xsum = v[15];
#pragma unroll
        for (int o = 1; o < 64; o <<= 1) { const float y = __shfl_up(xsum, o); if (lane >= o) xsum += y; }
        if (lane == 63) red[16 + wave] = xsum;
        __syncthreads();
        float off = xsum - v[15];
        for (int w = 0; w < wave; ++w) off += red[16 + w];
        if (i0 < nel) {
#pragma unroll
            for (int c = 0; c < 4; ++c) { f32x4 w = {-(off + v[4 * c]), -(off + v[4 * c + 1]), -(off + v[4 * c + 2]), -(off + v[4 * c + 3])}; *(LAS f32x4*)(ng + i0 + 4 * c) = w; } }
    }
    const int ntile = t0 / 64 + 4 - kts;
    const bf16* kg = proj + (size_t)rowbase * OD_N + OC_K + h * 64; const bf16* vg = proj + (size_t)rowbase * OD_N + OC_V + h * 64;
    const int kr = tid & 31, kc = (tid >> 5) & 7, kst = tid >> 8, vcc = tid & 3, vrow = (tid >> 2) & 63, vdh = tid >> 8;
    const int koff = kst * 4096 + kc * 512 + kr * 16, voff = 8192 + vdh * 4096 + vrow * 64 + vcc * 16;
    { const v4u kv = *(const v4u*)(kg + (size_t)(kts * 64 + kst * 32 + kr) * OD_N + kc * 8), vv = *(const v4u*)(vg + (size_t)(kts * 64 + vrow) * OD_N + vdh * 32 + vcc * 8);
        *(LAS v4u*)(lds + koff) = kv; *(LAS v4u*)(lds + voff) = vv; }
    __syncthreads();
    AttSt S; S.m = 0.f; S.l = 0.f;
#pragma unroll
    for (int r = 0; r < 16; ++r) { S.o0[r] = 0.f; S.o1[r] = 0.f; }
    const int wlast = t0 + wave * 32 + 31, wfirst = t0 + wave * 32;
    for (int i = 0; i < ntile; ++i) { const int kt = kts + i; LAS unsigned char* buf = lds + (i & 1) * 16384; LAS unsigned char* nbuf = lds + ((i + 1) & 1) * 16384;
        v4u kv, vv; const bool more = i + 1 < ntile;
        if (more) { kv = *(const v4u*)(kg + (size_t)((kt + 1) * 64 + kst * 32 + kr) * OD_N + kc * 8); vv = *(const v4u*)(vg + (size_t)((kt + 1) * 64 + vrow) * OD_N + vdh * 32 + vcc * 8); }
        { const int kv0 = kt * 64;
            if (kv0 + 32 <= wlast) { FoxBias bf0{ng + (kv0 - s_start), tq, kv0, kv0 + 31 > wfirst}, bf1{ng + (kv0 + 32 - s_start), tq, kv0 + 32, kv0 + 63 > wfirst};
                att_tile64(S, qf, (LAS const char*)buf, (LAS const char*)buf + 8192, 4096, 0, lane, bf0, bf1); }
            else if (kv0 <= wlast) { FoxBias bf{ng + (kv0 - s_start), tq, kv0, kv0 + 31 > wfirst};
                att_subtile(S, qf, (LAS const char*)buf, (LAS const char*)buf + 8192, 4096, 0, lane, bf); } }
        if (more) { *(LAS v4u*)(nbuf + koff) = kv; *(LAS v4u*)(nbuf + voff - 8192 + 8192) = vv; }
        __syncthreads(); }
    const float lt = S.l + __shfl_xor(S.l, 32), inv = 1.f / lt;
    bf16* o = ao + (size_t)(rowbase + tq) * 1024 + h * 64;
#pragma unroll
    for (int a4 = 0; a4 < 4; ++a4) { v2u w0, w1;
        w0.x = cvtpk(S.o0[4 * a4] * inv, S.o0[4 * a4 + 1] * inv); w0.y = cvtpk(S.o0[4 * a4 + 2] * inv, S.o0[4 * a4 + 3] * inv);
        w1.x = cvtpk(S.o1[4 * a4] * inv, S.o1[4 * a4 + 1] * inv); w1.y = cvtpk(S.o1[4 * a4 + 2] * inv, S.o1[4 * a4 + 3] * inv);
        *(v2u*)(o + 8 * a4 + 4 * hi) = w0; *(v2u*)(o + 32 + 8 * a4 + 4 * hi) = w1; }
}

DI void ph_ln1_router(const Args& a, const Fr& F, int layer) {
    const float* yp = (const float*)(F.ws + WS_YP); float* x1 = (float*)(F.ws + WS_X1); unsigned char* xb8 = F.ws + WS_XB8;
    unsigned* tope = (unsigned*)(F.ws + WS_TOPE); float* gate = (float*)(F.ws + WS_GATE); unsigned* rank = (unsigned*)(F.ws + WS_RANK);
    const float* g = a.in[10] + (size_t)(layer * 2) * DM; const float* bb = a.in[11] + (size_t)(layer * 2) * DM;
    const float* rw = a.in[12] + (size_t)layer * 1024 * 32; const float* rb = a.in[13] + layer * 32;
    LAS float* red = (LAS float*)(F.lds); LAS unsigned* lcnt = (LAS unsigned*)(F.lds + 131072);
    const int lane = F.lane, wave = F.wave, tid = F.tid, l31 = lane & 31, hi = lane >> 5;
    for (int chunk = F.blk; chunk < 256; chunk += F.G) { const int tok0 = chunk * 128;
        __syncthreads();
        if (tid < 32) lcnt[tid] = 0u;
#pragma unroll 1
        for (int k = 0; k < 16; k += 8) { f32x4 v[8][4];
#pragma unroll
            for (int i = 0; i < 8; ++i)
#pragma unroll
                for (int jj = 0; jj < 4; ++jj) v[i][jj] = *((const f32x4*)(yp + (size_t)(tok0 + wave * 16 + k + i) * DM) + lane + 64 * jj);
#pragma unroll
            for (int i = 0; i < 8; ++i) { const int tok = tok0 + wave * 16 + k + i;
                ln_row(v[i], g, bb, lane);
                store_row_f32(x1 + (size_t)tok * DM, v[i], lane);
#pragma unroll
                for (int jj = 0; jj < 4; ++jj) *((unsigned*)(xb8 + (size_t)tok * DM) + lane + 64 * jj) = pk4_fp8(v[i][jj][0] * F8_SX, v[i][jj][1] * F8_SX, v[i][jj][2] * F8_SX, v[i][jj][3] * F8_SX); } }
        asm volatile("s_waitcnt vmcnt(0)" ::: "memory");
        __syncthreads();
        const int tl = wave & 3, kr = wave >> 2, tokl = tok0 + tl * 32 + l31;
        f32x16 D = proj32_f32(rw, 32, 32, x1 + (size_t)tokl * DM, kr * 512, lane);
        if (kr == 1) {
#pragma unroll
            for (int r = 0; r < 16; ++r) red[(tl * 16 + r) * 64 + lane] = D[r]; }
        __syncthreads();
        if (kr == 0) {
            float lv[32];
#pragma unroll
            for (int r = 0; r < 16; ++r) { const float own = D[r] + red[(tl * 16 + r) * 64 + lane] + rb[crow(r, hi)]; const float oth = __shfl_xor(own, 32);
                lv[crow(r, 0)] = hi == 0 ? own : oth; lv[crow(r, 1)] = hi == 0 ? oth : own; }
            float tv[4]; int te[4];
#pragma unroll
            for (int r = 0; r < 4; ++r) { float mx = -INFINITY; int me = 0;
#pragma unroll
                for (int e = 0; e < 32; ++e) { if (lv[e] > mx) { mx = lv[e]; me = e; } }
                tv[r] = mx; te[r] = me;
#pragma unroll
                for (int e = 0; e < 32; ++e) { if (e == me) lv[e] = -INFINITY; } }
            const float e1 = __expf(tv[1] - tv[0]), e2 = __expf(tv[2] - tv[0]), e3 = __expf(tv[3] - tv[0]); const float inv = 1.f / (1.f + e1 + e2 + e3);
            if (hi == 0) { const size_t o = (size_t)tokl * 4;
                const float gv[4] = {inv, e1 * inv, e2 * inv, e3 * inv};
#pragma unroll
                for (int r = 0; r < 4; ++r) { const unsigned rk = __hip_atomic_fetch_add(lcnt + (te[r] & 31), 1u, __ATOMIC_RELAXED, __HIP_MEMORY_SCOPE_WORKGROUP);
                    tope[o + r] = (unsigned)(te[r] & 31); gate[o + r] = gv[r]; rank[o + r] = rk; } } }
        __syncthreads();
        if (tid < 32) __hip_atomic_store(F.ctl + CW_CNT + chunk * 32 + tid, lcnt[tid], RLX_AGENT);
    }
}

DI void ph_route(const Fr& F) {
    const unsigned char* xb8 = F.ws + WS_XB8; unsigned char* xg = F.ws + WS_XG;
    const unsigned* tope = (const unsigned*)(F.ws + WS_TOPE); const unsigned* rank = (const unsigned*)(F.ws + WS_RANK); unsigned* dest = (unsigned*)(F.ws + WS_DEST);
    LAS unsigned* P = (LAS unsigned*)(F.lds); LAS unsigned* pst = P + 512; LAS unsigned* pad = P + 544; LAS unsigned* base = P + 576; LAS unsigned* nt = P + 608;
    const int tid = F.tid, lane = F.lane, wave = F.wave;
    __syncthreads();
    { const int e = tid & 31, part = tid >> 5; unsigned s = 0u;
        for (int c = 0; c < 16; ++c) s += ld_u32(F.ctl + CW_CNT + (part * 16 + c) * 32 + e);
        P[part * 32 + e] = s; }
    __syncthreads();
    if (tid < 32) { unsigned tot = 0u;
        for (int p = 0; p < 16; ++p) tot += P[p * 32 + tid];
        pad[tid] = (tot + 255u) & ~255u; }
    __syncthreads();
    if (tid == 0) { unsigned acc = 0u;
        for (int e = 0; e < 32; ++e) { pst[e] = acc; acc += pad[e]; }
        nt[0] = acc >> 8; }
    __syncthreads();
    for (int chunk = F.blk; chunk < 256; chunk += F.G) {
        __syncthreads();
        if (tid < 32) { unsigned off = 0u; const int pf = chunk >> 4;
            for (int p = 0; p < pf; ++p) off += P[p * 32 + tid];
            for (int c = pf * 16; c < chunk; ++c) off += ld_u32(F.ctl + CW_CNT + c * 32 + tid);
            base[tid] = pst[tid] + off; }
        __syncthreads();
#pragma unroll 1
        for (int i0 = 0; i0 < 16; i0 += 4) { v4u src[4]; unsigned ee[4][4], rr[4][4];
#pragma unroll
            for (int i = 0; i < 4; ++i) { const int tok = chunk * 128 + wave * 16 + i0 + i; src[i] = *((const v4u*)(xb8 + (size_t)tok * DM) + lane);
#pragma unroll
                for (int k = 0; k < 4; ++k) { ee[i][k] = tope[(size_t)tok * 4 + k]; rr[i][k] = rank[(size_t)tok * 4 + k]; } }
#pragma unroll
            for (int i = 0; i < 4; ++i) { const int tok = chunk * 128 + wave * 16 + i0 + i;
#pragma unroll
                for (int k = 0; k < 4; ++k) { const unsigned d = base[ee[i][k]] + rr[i][k];
                    if (lane == 0) dest[(size_t)tok * 4 + k] = d;
                    *((v4u*)(xg + (size_t)d * DM) + lane) = src[i]; } } }
        if (chunk == 0) { const unsigned ntl = nt[0];
            if (tid == 0) __hip_atomic_store(F.ctl + CW_TILE, ntl, RLX_AGENT);
            for (unsigned i = tid; i < ntl; i += NTHR) { unsigned e = 0u;
                for (unsigned k = 1; k < 32; ++k) if (pst[k] <= i * 256u) e = k;
                __hip_atomic_store(F.ctl + CW_TILE + 64 + i, e, RLX_AGENT); } }
    }
}

DI void ph_combine_ln2(const Args& a, const Fr& F, int layer) {
    const float* x1 = (const float*)(F.ws + WS_X1); const bf16* yr = (const bf16*)(F.ws + WS_XG); float* xo = (float*)(F.ws + WS_X); bf16* xb = (bf16*)(F.ws + WS_XB);
    const float* gate = (const float*)(F.ws + WS_GATE); const unsigned* dest = (const unsigned*)(F.ws + WS_DEST);
    const float* g = a.in[10] + (size_t)(layer * 2 + 1) * DM; const float* bb = a.in[11] + (size_t)(layer * 2 + 1) * DM;
    const int lane = F.lane; const int gw = F.blk * NWAVES + F.wave, NGW = F.G * NWAVES;
    for (int tok = gw; tok < NTOK; tok += 4 * NGW) { f32x4 v[4][4];
#pragma unroll
        for (int i = 0; i < 4; ++i) { const int tk = tok + i * NGW; if (tk < NTOK) {
#pragma unroll
            for (int jj = 0; jj < 4; ++jj) v[i][jj] = *((const f32x4*)(x1 + (size_t)tk * DM) + lane + 64 * jj) * ALPHA;
#pragma unroll
            for (int k = 0; k < 4; ++k) { const float gk = gate[(size_t)tk * 4 + k]; const unsigned d = dest[(size_t)tk * 4 + k];
#pragma unroll
                for (int jj = 0; jj < 4; ++jj) { const v2u w = *((const v2u*)(yr + (size_t)d * DM) + lane + 64 * jj);
                    v[i][jj][0] += gk * bf2f(w.x & 0xffffu); v[i][jj][1] += gk * bf2f(w.x >> 16); v[i][jj][2] += gk * bf2f(w.y & 0xffffu); v[i][jj][3] += gk * bf2f(w.y >> 16); } } } }
#pragma unroll
        for (int i = 0; i < 4; ++i) { const int tk = tok + i * NGW; if (tk < NTOK) {
            ln_row(v[i], g, bb, lane);
            if (layer == DEPTH - 1) store_row_f32(a.out + (size_t)tk * DM, v[i], lane);
            else { store_row_f32(xo + (size_t)tk * DM, v[i], lane); store_row_bf16(xb + (size_t)tk * DM, v[i], lane); } } } }
}
constexpr int LDS_BYTES = 147456;
constexpr int LDS_BARW = 145408, LDS_QSLOT = 145472, LDS_TILE_E = 133632;
constexpr int NPL = 11;
constexpr int NPHASE = 1 + NPL * DEPTH;
#ifndef MK_SINGLE
#define MK_SINGLE 1
#endif
DI int q_next(const Fr& F, unsigned* ctr) {
    LAS int* slot = (LAS int*)(F.lds + LDS_QSLOT);
    __syncthreads();
    if (F.tid == 0) *slot = (int)__hip_atomic_fetch_add(ctr, 1u, RLX_AGENT);
    __syncthreads();
    return *slot;
}
DI int lane_id_fresh() { unsigned m_ = ~0u; asm volatile("" : "+s"(m_)); return (int)__builtin_amdgcn_mbcnt_hi(m_, __builtin_amdgcn_mbcnt_lo(m_, 0u)); }
#define RETID(F) do { int t2_ = F.tid; asm volatile("" : "+v"(t2_)); F.tid = t2_; F.lane = t2_ & 63; F.wave = __builtin_amdgcn_readfirstlane(t2_ >> 6); } while (0)
#ifndef PROBE_DUP
#define PROBE_DUP -1
#endif
#define NREP(q) ((PROBE_DUP == (q)) ? 2 : 1)
#define AS4 __attribute__((address_space(4)))
#define SITE() Args a; Fr F; { const AS4 Args* ap = (const AS4 Args*)__builtin_amdgcn_kernarg_segment_ptr(); asm volatile("" : "+s"(ap)); \
        _Pragma("unroll") for (int i_ = 0; i_ < 18; ++i_) a.in[i_] = ap->in[i_]; a.out = ap->out; a.ws = ap->ws; a.ph_lo = 0; a.ph_hi = 0; \
        int w_ = wv_s; asm volatile("" : "+s"(w_)); int t_ = w_ * 64 + lane_id_fresh(); asm volatile("" : "+v"(t_)); F.tid = t_; F.lane = t_ & 63; F.wave = __builtin_amdgcn_readfirstlane(t_ >> 6); \
        F.lds = (LAS unsigned char*)lds_raw; F.ws = a.ws; F.ctl = (unsigned*)(a.ws + WS_CTL); F.blk = blockIdx.x; F.G = gridDim.x; }
__global__ void __launch_bounds__(NTHR, 2) mega_fwd(Args a0) {
    extern __shared__ __attribute__((aligned(16))) unsigned char lds_raw[];
    const int wv_s = __builtin_amdgcn_readfirstlane((int)(threadIdx.x >> 6));
#if MK_SINGLE
    constexpr int lo = 0, hi = NPHASE; constexpr bool single = true;
#else
    const int lo = a0.ph_lo, hi = a0.ph_hi; constexpr bool single = false;
#endif
    if (threadIdx.x == 0) *(LAS v4u*)((LAS unsigned char*)lds_raw + LDS_BARW) = (v4u){0u, 0u, 0u, 0u};
    __syncthreads();
    if (single) (void)xcd_barrier_post((unsigned*)(a0.ws + WS_CTL) + CW_BAR, (volatile LAS unsigned*)((LAS unsigned char*)lds_raw + LDS_BARW));
#define IN(k) (lo <= (k) && (k) < hi)
#define SEAM() do { if (single) { const AS4 Args* ap_ = (const AS4 Args*)__builtin_amdgcn_kernarg_segment_ptr(); asm volatile("" : "+s"(ap_)); int w_ = wv_s; asm volatile("" : "+s"(w_)); \
        XcdBarrier b_; b_.bar = (unsigned*)(ap_->ws + WS_CTL) + CW_BAR; b_.x = xb_xcc_id(); b_.st = (volatile LAS unsigned*)((LAS unsigned char*)lds_raw + LDS_BARW); \
        xcd_barrier(b_, (w_ == 0) && (lane_id_fresh() == 0)); } } while (0)
    if (IN(0)) { _Pragma("unroll 1") for (int rep = 0; rep < NREP(100); ++rep) { { SITE(); ph_prologue(a, F); } SEAM(); } }
#pragma clang loop unroll(full)
    for (int L = 0; L < DEPTH; ++L) {
        const int pb = 1 + NPL * L, j = L >> 1; const bool odd = (L & 1) != 0;
        if (IN(pb + 0)) _Pragma("unroll 1") for (int rep = 0; rep < NREP(0); ++rep) {
            { SITE();
            const bf16* w = odd ? (const bf16*)(F.ws + WS_WOD) + (size_t)j * OD_N * 1024 : (const bf16*)(F.ws + WS_WEV) + (size_t)j * EV_N * 1024;
            const int N = odd ? OD_N : EV_N;
            pg8::Gemm g{(const bf16*)(F.ws + WS_XB), w, NTOK, N, 1024}; pg8::StaticOrder S; S.init(NTOK, N, F.G, F.blk);
            pg8::EpiBf16<0> E{(bf16*)(F.ws + WS_PROJ), N, nullptr, 1024, (size_t)1024, C2F};
            pg8::gemm_phase<pg8::EpiBf16<0>, pg8::StaticOrder, true, true>(F.lds, g, S, E, F.tid); }
            SEAM(); }
        if (IN(pb + 1)) _Pragma("unroll 1") for (int rep = 0; rep < NREP(1); ++rep) { { SITE(); if (odd) ph_odd_prep(a, F, j, L); else ph_even_prep(a, F, j); } SEAM(); }
        if (!odd && IN(pb + 2)) _Pragma("unroll 1") for (int rep = 0; rep < ((PROBE_DUP == 2 || (PROBE_DUP >= 21 && PROBE_DUP <= 22) || (PROBE_DUP >= 211 && PROBE_DUP <= 217)) ? 2 : 1); ++rep) {
            { SITE(); unsigned* ctr = F.ctl + CW_Q + 64 * (L * 2) + 1024 * rep;
            for (;;) { const int it = q_next(F, ctr); if (it >= 1280) break; RETID(F);
                if (it < 1024) { if (!(rep == 1 && PROBE_DUP == 22)) idx_unit(F, it & 3, 255 - (it >> 2), (rep == 1 && PROBE_DUP >= 211) ? PROBE_DUP - 210 : 0); } else { if (!(rep == 1 && (PROBE_DUP == 21 || PROBE_DUP >= 211))) moba_gate_chunk(F, it - 1024); } } }
            SEAM(); }
        if (IN(pb + 3)) _Pragma("unroll 1") for (int rep = 0; rep < ((PROBE_DUP == 3 || (PROBE_DUP == 31 && odd) || ((PROBE_DUP == 32 || PROBE_DUP == 33) && !odd)) ? 2 : 1); ++rep) {
            { SITE(); unsigned* ctr = F.ctl + CW_Q + 64 * (L * 2 + 1) + 1024 * rep;
            if (odd) { for (;;) { const int it = q_next(F, ctr); if (it >= 2048) break; RETID(F); const int bh = it & 63; fox_unit(F, L, bh >> 4, bh & 15, 31 - (it >> 6)); } }
            else { for (;;) { const int it = q_next(F, ctr); if (it >= 2048) break; RETID(F);
                    if (it < 1024) { const int bh = it & 31; if (!(rep == 1 && PROBE_DUP == 33)) moba_unit(a, F, bh >> 3, bh & 7, it >> 5); } else { if (!(rep == 1 && PROBE_DUP == 32)) dsa_chunk(a, F, it - 1024); } } } }
            SEAM(); }
        if (!odd && IN(pb + 4)) _Pragma("unroll 1") for (int rep = 0; rep < NREP(4); ++rep) { { SITE(); ph_even_post(F, j); } SEAM(); }
        if (IN(pb + 5)) _Pragma("unroll 1") for (int rep = 0; rep < NREP(5); ++rep) {
            { SITE();
            const float* xin = (L == 0) ? a.in[0] : (const float*)(F.ws + WS_X);
            pg8::Gemm g{(const bf16*)(F.ws + WS_AO), (const bf16*)(F.ws + WS_WOUT) + (size_t)L * 1024 * 1024, NTOK, 1024, 1024}; pg8::StaticOrder S; S.init(NTOK, 1024, F.G, F.blk);
            EpiResF32 E{xin, (float*)(F.ws + WS_YP), ALPHA};
            pg8::gemm_phase<EpiResF32, pg8::StaticOrder, true, true>(F.lds, g, S, E, F.tid); }
            SEAM(); }
        if (IN(pb + 6)) _Pragma("unroll 1") for (int rep = 0; rep < NREP(6); ++rep) { { SITE(); ph_ln1_router(a, F, L); } SEAM(); }
        if (IN(pb + 7)) _Pragma("unroll 1") for (int rep = 0; rep < NREP(7); ++rep) { { SITE(); ph_route(F); } SEAM(); }
        if (IN(pb + 8)) _Pragma("unroll 1") for (int rep = 0; rep < NREP(8); ++rep) {
            { SITE(); const int ntl = (int)ld_u32(F.ctl + CW_TILE);
            LAS unsigned* tle = (LAS unsigned*)(F.lds + LDS_TILE_E);
            for (int i = F.tid; i < ntl; i += NTHR) tle[i] = ld_u32(F.ctl + CW_TILE + 64 + i);
            __syncthreads();
            pg8::Gemm g{(const bf16*)(F.ws + WS_XG), (const bf16*)(F.ws + WS_WGU + (size_t)L * 32 * 2048 * 1024), NR_MAX, 32 * 2048, 512};
            GroupOrder S{tle, ntl, 3, F.G, F.blk};
            EpiSwiglu E{F.ws + WS_ACT, a.in[15] + (size_t)L * 32 * 2048};
            pg8::gemm_phase<EpiSwiglu, GroupOrder, true, true, true>(F.lds, g, S, E, F.tid); }
            SEAM(); }
        if (IN(pb + 9)) _Pragma("unroll 1") for (int rep = 0; rep < NREP(9); ++rep) {
            { SITE(); const int ntl = (int)ld_u32(F.ctl + CW_TILE);
            LAS unsigned* tle = (LAS unsigned*)(F.lds + LDS_TILE_E);
            for (int i = F.tid; i < ntl; i += NTHR) tle[i] = ld_u32(F.ctl + CW_TILE + 64 + i);
            __syncthreads();
            pg8::Gemm g{(const bf16*)(F.ws + WS_ACT), (const bf16*)(F.ws + WS_WDN + (size_t)L * 32 * 1024 * 1024), NR_MAX, 32 * 1024, 512};
            GroupOrder S{tle, ntl, 2, F.G, F.blk};
            EpiDown E{(bf16*)(F.ws + WS_XG), a.in[17] + (size_t)L * 32 * 1024};
            pg8::gemm_phase<EpiDown, GroupOrder, true, true, true>(F.lds, g, S, E, F.tid); }
            SEAM(); }
        if (IN(pb + 10)) _Pragma("unroll 1") for (int rep = 0; rep < NREP(10); ++rep) { { SITE(); ph_combine_ln2(a, F, L); } if (L + 1 < DEPTH || rep + 1 < NREP(10)) SEAM(); }
        if (PROBE_DUP == 900 && L + 1 < DEPTH) { _Pragma("unroll 1") for (int xb = 0; xb < 10; ++xb) SEAM(); }
    }
#undef IN
#undef SEAM
}

extern "C" void kernel_launch(void* const* d_in, const int* in_sizes, int n_in, void* d_out, int out_size, void* d_ws, size_t ws_size, hipStream_t stream) {
    static int grid = 0;
    if (grid == 0) {
        if (n_in != 18 || out_size != NTOK * DM || ws_size < WS_END) { fprintf(stderr, "kernel_launch: unexpected shapes (n_in %d, out %d, ws %zu); nothing launched\n", n_in, out_size, ws_size); grid = -1; return; }
        int dev = 0, cus = 0, per_cu = 0;
        if (hipGetDevice(&dev) != hipSuccess || hipDeviceGetAttribute(&cus, hipDeviceAttributeMultiprocessorCount, dev) != hipSuccess) { grid = -1; return; }
        if (hipFuncSetAttribute((const void*)mega_fwd, hipFuncAttributeMaxDynamicSharedMemorySize, LDS_BYTES) != hipSuccess) { fprintf(stderr, "kernel_launch: hipFuncSetAttribute failed\n"); grid = -1; return; }
        if (hipOccupancyMaxActiveBlocksPerMultiprocessor(&per_cu, (const void*)mega_fwd, NTHR, LDS_BYTES) != hipSuccess || per_cu < 1) fprintf(stderr, "kernel_launch: occupancy query reports %d\n", per_cu);
        (void)hipGetLastError();
        grid = cus;
    }
    if (grid < 0) return;
    (void)hipMemsetAsync((char*)d_ws + WS_CTL, 0, CTL_ZERO_BYTES, stream);
#ifdef EXP_SKIP
    (void)hipMemsetAsync((char*)d_ws + WS_AO, 0, 64 * MiB, stream);
    (void)hipMemsetAsync((char*)d_ws + WS_OL, 0, 64 * MiB, stream);
    if (EXP_SKIP & 4) { (void)hipMemsetAsync((char*)d_ws + WS_XG, 0, 272 * MiB, stream); (void)hipMemsetAsync((char*)d_ws + WS_DEST, 0, 1 * MiB, stream); }
#endif
    Args a{};
    for (int i = 0; i < 18; ++i) a.in[i] = (const float*)d_in[i];
    a.out = (float*)d_out; a.ws = (unsigned char*)d_ws;
#if MK_SINGLE
    a.ph_lo = 0; a.ph_hi = NPHASE;
    hipLaunchKernelGGL(mega_fwd, dim3(grid), dim3(NTHR), LDS_BYTES, stream, a);
#else
    for (int p = 0; p < NPHASE; ++p) {
        if (p > 0) { const int L = (p - 1) / NPL, q = (p - 1) % NPL; if ((L & 1) && (q == 2 || q == 4)) continue;
#ifdef EXP_SKIP
            if ((EXP_SKIP & 1) && !(L & 1) && q <= 4) continue;
            if ((EXP_SKIP & 2) && (L & 1) && q <= 4) continue;
            if ((EXP_SKIP & 4) && q >= 7 && q <= 9) continue;
#endif
        }
        a.ph_lo = p; a.ph_hi = p + 1;
        hipLaunchKernelGGL(mega_fwd, dim3(grid), dim3(NTHR), LDS_BYTES, stream, a);
    }
#endif
}
```

```cpp
#include <hip/hip_runtime.h>
#include <cstdio>
#include <cstdint>
#ifdef EXP_SKIP
#define EXPF EXP_SKIP
#else
#define EXPF 0
#endif
constexpr int NB = 4, SEQ = 8192, DM = 1024, NTOK = NB * SEQ, DEPTH = 4;
constexpr int EV_N = 2560, OD_N = 3072;
constexpr int EC_QA = 0, EC_QB = 512, EC_KB = 1024, EC_VB = 1536, EC_CKV = 2048, EC_QI = 2176, EC_KI = 2432, EC_WI = 2496;
constexpr int OC_Q = 0, OC_K = 1024, OC_V = 2048;
constexpr float LOG2E = 1.4426950408889634f;
constexpr float C2F = 0.125f * LOG2E;
constexpr float ALPHA = 1.681792830507429f;
constexpr float LN_EPS = 1e-5f;
constexpr int NR_MAX = 131072 + 32 * 256;
constexpr int NWAVES = 8, NTHR = 512;
constexpr size_t MiB = (size_t)1 << 20;
constexpr size_t WS_CTL = 0, CTL_ZERO_BYTES = 4 * MiB;
constexpr size_t WS_WEV = 8 * MiB, WS_WOD = 18 * MiB, WS_WOUT = 30 * MiB, WS_WUKT = 38 * MiB, WS_WUVT = 39 * MiB;
constexpr size_t WS_WGU = 40 * MiB, WS_WDN = 552 * MiB;
constexpr size_t WS_X = 808 * MiB, WS_X1 = 936 * MiB, WS_YP = 1064 * MiB, WS_XB = 1192 * MiB;
constexpr size_t WS_PROJ = 1256 * MiB, WS_AO = 1448 * MiB, WS_XG = 1512 * MiB, WS_ACT = 1784 * MiB;
constexpr size_t WS_QL = 2056 * MiB, WS_OL = 2120 * MiB, WS_CKVN = 2184 * MiB, WS_SEL = 2192 * MiB;
constexpr size_t WS_KBAR = 2208 * MiB, WS_SEL3 = 2209 * MiB, WS_LOGF = 2210 * MiB, WS_CS = 2212 * MiB;
constexpr size_t WS_TOPE = 2213 * MiB, WS_GATE = 2214 * MiB, WS_RANK = 2215 * MiB, WS_DEST = 2216 * MiB, WS_PML = 2217 * MiB;
constexpr size_t WS_XB8 = 2226 * MiB;
constexpr size_t WS_KIC = 2258 * MiB;
constexpr size_t WS_END = 2262 * MiB;
constexpr float F8_SX = 16.f, F8_SWG = 256.f, F8_SA = 4.f, F8_SWD = 512.f;
constexpr int CW_BAR = 4096, CW_Q = 8192, CW_KMAX = 12288, CW_CNT = 16384, CW_TILE = 32768;

#define GAS __attribute__((address_space(1)))
#define LAS __attribute__((address_space(3)))
#define DI __device__ __forceinline__
typedef unsigned short bf16;
typedef unsigned v4u __attribute__((ext_vector_type(4)));
typedef unsigned v2u __attribute__((ext_vector_type(2)));
typedef float f32x4 __attribute__((ext_vector_type(4)));
typedef float f32x2 __attribute__((ext_vector_type(2)));
typedef float f32x16 __attribute__((ext_vector_type(16)));
typedef short bf16x8 __attribute__((ext_vector_type(8)));
typedef short s16x4 __attribute__((ext_vector_type(4)));
typedef __bf16 bf16x2_t __attribute__((ext_vector_type(2)));
typedef GAS unsigned gu32;
#define RLX_AGENT __ATOMIC_RELAXED, __HIP_MEMORY_SCOPE_AGENT
#define LDS_WAIT() asm volatile("s_waitcnt lgkmcnt(0)" ::: "memory")

DI float bf2f(unsigned v) { return __uint_as_float(v << 16); }
DI unsigned cvtpk(float lo, float hi) { f32x2 v = {lo, hi}; bf16x2_t b = __builtin_convertvector(v, bf16x2_t); return __builtin_bit_cast(unsigned, b); }
DI unsigned f2bf(float f) { return cvtpk(f, 0.f) & 0xffffu; }
DI unsigned pk4_fp8(float a, float b, float c, float d) {
    a = fminf(fmaxf(a, -448.f), 448.f); b = fminf(fmaxf(b, -448.f), 448.f); c = fminf(fmaxf(c, -448.f), 448.f); d = fminf(fmaxf(d, -448.f), 448.f);
    int w = 0; w = __builtin_amdgcn_cvt_pk_fp8_f32(a, b, w, false); w = __builtin_amdgcn_cvt_pk_fp8_f32(c, d, w, true); return (unsigned)w; }
DI float ex2(float x) { return __builtin_amdgcn_exp2f(x); }
DI float wave_sum(float v) {
#pragma unroll
    for (int o = 1; o < 64; o <<= 1) v += __shfl_xor(v, o);
    return v;
}
DI float wave_max(float v) {
#pragma unroll
    for (int o = 1; o < 64; o <<= 1) v = fmaxf(v, __shfl_xor(v, o));
    return v;
}
DI unsigned ld_u32(const unsigned* p) { return __hip_atomic_load(p, RLX_AGENT); }
DI int crow(int r, int hi) { return (r & 3) + 8 * (r >> 2) + 4 * hi; }
DI f32x16 mfma32(bf16x8 a, bf16x8 b, f32x16 c) { return __builtin_amdgcn_mfma_f32_32x32x16_bf16(a, b, c, 0, 0, 0); }
DI f32x4 mfma16(bf16x8 a, bf16x8 b, f32x4 c) { return __builtin_amdgcn_mfma_f32_16x16x32_bf16(a, b, c, 0, 0, 0); }
typedef short v4i16_t __attribute__((ext_vector_type(4)));
DI s16x4 vtr(LAS const char* p) { return __builtin_bit_cast(s16x4, __builtin_amdgcn_ds_read_tr16_b64_v4i16((LAS v4i16_t*)p)); }
DI bf16x8 cat8(s16x4 a, s16x4 b) { return (bf16x8){a[0], a[1], a[2], a[3], b[0], b[1], b[2], b[3]}; }
DI int t5_bucket(int n) {
    if (n < 16) return n;
    int bkt = 16;
    bkt += (n >= 21); bkt += (n >= 27); bkt += (n >= 35); bkt += (n >= 46); bkt += (n >= 59); bkt += (n >= 77); bkt += (n >= 99); bkt += (n >= 128);
    bkt += (n >= 166); bkt += (n >= 216); bkt += (n >= 280); bkt += (n >= 363); bkt += (n >= 470); bkt += (n >= 609); bkt += (n >= 790);
    return bkt;
}
namespace pg8 {
#define PG8_LAS __attribute__((address_space(3)))
typedef unsigned short bf16_t;
typedef short bf16x8 __attribute__((ext_vector_type(8)));
typedef float f32x4 __attribute__((ext_vector_type(4)));
typedef unsigned u32x4 __attribute__((ext_vector_type(4)));
constexpr int BM = 256, BK = 64, HALF = 128, HTB = HALF * BK * 2  , STAGE_BYTES = 8 * HTB, NXCD = 8, WGM = 8;

__host__ __device__ __forceinline__ int lds_byte(int r, int c) { const int st = (r >> 4) * 2 + (c >> 5), rr = r & 15, cc = c & 31, ob = rr * 64 + cc * 2; return st * 1024 + (ob ^ (((ob >> 9) & 1) << 5)); }
__host__ __device__ __forceinline__ void stage_rc(int b, int& R, int& C) { const int st = b / 1024, sb = b % 1024, swz = sb ^ (((sb >> 9) & 1) << 5); R = (st >> 1) * 16 + swz / 64; C = (st & 1) * 32 + (swz % 64) / 2; }
__host__ __device__ __forceinline__ int perm32(int rho) { const int n = rho >> 4, i = rho & 15; return 8 * (i >> 2) + 4 * n + (i & 3); }

typedef int i32x8 __attribute__((ext_vector_type(8))); typedef int i32x4v __attribute__((ext_vector_type(4)));
__device__ __forceinline__ i32x8 pg8_cat8(bf16x8 lo, bf16x8 hi) { const i32x4v a = __builtin_bit_cast(i32x4v, lo), b = __builtin_bit_cast(i32x4v, hi); return (i32x8){a[0], a[1], a[2], a[3], b[0], b[1], b[2], b[3]}; }
struct Unit { int pm, pn; };
struct Gemm { const bf16_t* A; const bf16_t* Bt; int M, N, K; };

struct StaticOrder {
    int nM, nN, nwg, G, c;
    __host__ __device__ void init(int M, int N, int G_, int c_) { nM = M / BM; nN = N / BM; nwg = nM * nN; G = G_; c = c_; }
    __host__ __device__ bool next(int i, Unit& u) const {
        const long L = (long)i * G + c; if (L >= nwg) return false;
        int wgid = (int)L; { const int q = nwg / NXCD, r = nwg % NXCD, xcd = wgid % NXCD, off = wgid / NXCD; wgid = (xcd < r ? xcd * (q + 1) : r * (q + 1) + (xcd - r) * q) + off; }
        const int nig = WGM * nN, gid = wgid / nig, fm = gid * WGM, gsz = (nM - fm) < WGM ? (nM - fm) : WGM;
        u.pm = fm + ((wgid % nig) % gsz); u.pn = (wgid % nig) / gsz; return true;
    }
    __device__ __forceinline__ void a_ready(const Unit&) const {}
    __device__ __forceinline__ void done(const Unit&) const {}
};

__device__ __forceinline__ unsigned cvt_pk_bf16(float lo, float hi) { unsigned r; asm volatile("v_cvt_pk_bf16_f32 %0, %1, %2" : "=v"(r) : "v"(lo), "v"(hi)); return r; }
typedef float f32x2 __attribute__((ext_vector_type(2)));
__device__ __forceinline__ f32x2 gelu_pk(f32x2 v) {
    const f32x2 av = __builtin_elementwise_abs(v), d = av * 0.2316418882f + 1.0f;
    f32x2 t; t.x = __builtin_amdgcn_rcpf(d.x); t.y = __builtin_amdgcn_rcpf(d.y);
    f32x2 q = t * 0.5307027145f + (-0.7265760135f); q = q * t + 0.7107068705f; q = q * t + (-0.142248368f); q = q * t + 0.127414796f; q = q * t;
    const f32x2 s = (v * v) * (-0.72134752044f);
    f32x2 e; e.x = __builtin_amdgcn_exp2f(s.x); e.y = __builtin_amdgcn_exp2f(s.y);
    const f32x2 m = v * (q * e), r = v - m;
    f32x2 o; o.x = v.x < 0.f ? m.x : r.x; o.y = v.y < 0.f ? m.y : r.y; return o;
}

template <int ACT  > struct EpiBf16 {
    static constexpr bool PERM = true, AFTER_DRAIN = false; static_assert(ACT == 0 || ACT == 1, "EpiBf16: ACT is 0 (none) or 1 (gelu_pk)");
    bf16_t* O; int ldc; const float* bias; int split_cols; size_t split_stride; float scale0;
    __device__ __forceinline__ void operator()(const f32x4 (&acc)[2][2][4][2], const Unit& u, int wr, int wc, int fr, int fq) const {
        const int row0 = u.pm * BM + wr * 64 + fr; int colt = u.pn * BM; bf16_t* base = O;
        float sc = 1.f; if (split_cols) { const int t = colt / split_cols; base += (size_t)t * split_stride; colt -= t * split_cols; if (t == 0) sc = scale0; }
        const int col0 = colt + wc * 32 + 8 * fq, bcol0 = u.pn * BM + wc * 32 + 8 * fq;
        f32x4 bv[2][2];
#pragma unroll
        for (int bj = 0; bj < 2; ++bj)
#pragma unroll
            for (int n = 0; n < 2; ++n) bv[bj][n] = bias ? *(const f32x4*)(bias + bcol0 + bj * HALF + 4 * n) : (f32x4){0.f, 0.f, 0.f, 0.f};
#pragma unroll
        for (int ai = 0; ai < 2; ++ai)
#pragma unroll
            for (int m = 0; m < 4; ++m) { bf16_t* rowp = base + (size_t)(row0 + ai * HALF + m * 16) * ldc + col0;
#pragma unroll
                for (int bj = 0; bj < 2; ++bj) { f32x4 v0 = acc[ai][bj][m][0] + bv[bj][0], v1 = acc[ai][bj][m][1] + bv[bj][1];
                    if (ACT == 1) { f32x2 a = gelu_pk((f32x2){v0[0], v0[1]}), b = gelu_pk((f32x2){v0[2], v0[3]}), c = gelu_pk((f32x2){v1[0], v1[1]}), d = gelu_pk((f32x2){v1[2], v1[3]});
                        v0 = (f32x4){a.x, a.y, b.x, b.y}; v1 = (f32x4){c.x, c.y, d.x, d.y}; }
                    v0 = v0 * sc; v1 = v1 * sc; u32x4 w; w.x = cvt_pk_bf16(v0[0], v0[1]); w.y = cvt_pk_bf16(v0[2], v0[3]); w.z = cvt_pk_bf16(v1[0], v1[1]); w.w = cvt_pk_bf16(v1[2], v1[3]);
                    *(u32x4*)(rowp + bj * HALF) = w; } }
    }
};

template <class Epi, class Sched, bool ALIGN_EPI = false, bool SP2 = false, bool F8 = false>
__device__ __forceinline__ void gemm_phase(PG8_LAS unsigned char* lds, const Gemm g, const Sched& S, const Epi& E, int tid_in) {
    int tid_l = tid_in; asm volatile("" : "+v"(tid_l));
    const int tid = tid_l, wid = __builtin_amdgcn_readfirstlane(tid >> 6), lane = tid & 63, wr = wid >> 2, wc = wid & 3, fr = lane & 15, fq = lane >> 4;
    const int K = g.K, nt = K / BK;
    unsigned voffA[2], voffB[2];
#pragma unroll
    for (int i = 0; i < 2; ++i) { int R, C; stage_rc(tid * 16 + i * 8192, R, C); const int Rb = Epi::PERM ? ((R & ~31) + perm32(R & 31)) : R;
        voffA[i] = (unsigned)(R * K + C) * 2u; voffB[i] = (unsigned)(Rb * K + C) * 2u; }
    const size_t kstep = (size_t)(BK * 2);
    const size_t hstep = (size_t)HALF * K * 2;
    const size_t tstep = 2 * hstep;
    const unsigned ldsw = (unsigned)wid * 1024u;
    const int aoff = lds_byte(wr * 64 + fr, fq * 8), boff = lds_byte(wc * 32 + fr, fq * 8);
#define PG8_SA(b, h) (((b) * 2 + (h)) * HTB)
#define PG8_SB(b, h) ((4 + (b) * 2 + (h)) * HTB)
#define PG8_STAGE(bufoff, gbase, voff) do { _Pragma("unroll") for (int _i = 0; _i < 2; ++_i) \
        __builtin_amdgcn_global_load_lds((const unsigned*)((const char*)(gbase) + (voff)[_i]), (PG8_LAS unsigned*)(lds + (bufoff) + ldsw + _i * 8192), 16, 0, 0); } while (0)
#define PG8_LDA(dst, b, h) do { _Pragma("unroll") for (int m = 0; m < 4; ++m) _Pragma("unroll") for (int k = 0; k < 2; ++k) dst[m][k] = *(const PG8_LAS bf16x8*)(lds + PG8_SA(b, h) + aoff + m * 2048 + k * 1024); } while (0)
#define PG8_LDB(dst, b, h) do { _Pragma("unroll") for (int n = 0; n < 2; ++n) _Pragma("unroll") for (int k = 0; k < 2; ++k) dst[n][k] = *(const PG8_LAS bf16x8*)(lds + PG8_SB(b, h) + boff + n * 2048 + k * 1024); } while (0)
#define PG8_MMA(ai, bj, At, Bt) do { __builtin_amdgcn_s_setprio(1); if constexpr (!F8) { _Pragma("unroll") for (int m = 0; m < 4; ++m) _Pragma("unroll") for (int n = 0; n < 2; ++n) _Pragma("unroll") for (int k = 0; k < 2; ++k) \
        acc[ai][bj][m][n] = __builtin_amdgcn_mfma_f32_16x16x32_bf16(Bt[n][k], At[m][k], acc[ai][bj][m][n], 0, 0, 0); } else { _Pragma("unroll") for (int m = 0; m < 4; ++m) _Pragma("unroll") for (int n = 0; n < 2; ++n) \
        acc[ai][bj][m][n] = __builtin_amdgcn_mfma_scale_f32_16x16x128_f8f6f4(pg8_cat8(Bt[n][0], Bt[n][1]), pg8_cat8(At[m][0], At[m][1]), acc[ai][bj][m][n], 0, 0, 0, 0x7F7F7F7F, 0, 0x7F7F7F7F); \
        _Pragma("unroll") for (int m = 0; m < 4; ++m) _Pragma("unroll") for (int n = 0; n < 2; ++n) asm volatile("" : "+v"(acc[ai][bj][m][n]));   } __builtin_amdgcn_s_setprio(0); } while (0)
#define PG8_WAIT_V(n) asm volatile("s_waitcnt vmcnt(" #n ")" ::: "memory")
#define PG8_WAIT_L(n) asm volatile("s_waitcnt lgkmcnt(" #n ")" ::: "memory")
#define PG8_BAR __builtin_amdgcn_s_barrier()
#define PG8_SCHED __builtin_amdgcn_sched_barrier(0)
    Unit cur, nxt; int ui = 0;
    if (!S.next(0, cur)) return;
    f32x4 acc[2][2][4][2];
#pragma unroll
    for (int a = 0; a < 2; ++a)
#pragma unroll
        for (int b = 0; b < 2; ++b)
#pragma unroll
            for (int m = 0; m < 4; ++m)
#pragma unroll
                for (int n = 0; n < 2; ++n) acc[a][b][m][n] = (f32x4){0.f, 0.f, 0.f, 0.f};
    bf16x8 At[4][2], B0[2][2], B1[2][2];
    const char* cA = (const char*)g.A + (size_t)cur.pm * tstep; const char* cB = (const char*)g.Bt + (size_t)cur.pn * tstep;
    S.a_ready(cur);
    if constexpr (SP2) {
        PG8_STAGE(PG8_SB(0, 0), cB, voffB); PG8_STAGE(PG8_SB(0, 1), cB + hstep, voffB); PG8_STAGE(PG8_SA(0, 0), cA, voffA); PG8_STAGE(PG8_SA(0, 1), cA + hstep, voffA);
        if (wr == 1) PG8_BAR;
        PG8_WAIT_V(2); PG8_BAR;
        PG8_STAGE(PG8_SB(1, 0), cB + kstep, voffB); PG8_STAGE(PG8_SA(1, 0), cA + kstep, voffA); PG8_STAGE(PG8_SB(1, 1), cB + hstep + kstep, voffB);
        PG8_WAIT_V(6); PG8_BAR;
    } else {
        PG8_STAGE(PG8_SB(0, 0), cB, voffB); PG8_STAGE(PG8_SA(0, 0), cA, voffA); PG8_STAGE(PG8_SB(0, 1), cB + hstep, voffB); PG8_STAGE(PG8_SA(0, 1), cA + hstep, voffA);
        if (wr == 1) PG8_BAR;
        PG8_WAIT_V(4); PG8_BAR;
        PG8_STAGE(PG8_SB(1, 0), cB + kstep, voffB); PG8_STAGE(PG8_SA(1, 0), cA + kstep, voffA); PG8_STAGE(PG8_SB(1, 1), cB + hstep + kstep, voffB);
        PG8_WAIT_V(6); PG8_BAR;
    }
    for (;;) {
        const bool has_next = S.next(ui + 1, nxt);
        const char* nA = has_next ? (const char*)g.A + (size_t)nxt.pm * tstep : cA; const char* nB = has_next ? (const char*)g.Bt + (size_t)nxt.pn * tstep : cB;
        for (int t = 0; t < nt; t += 2) {
            const bool last = (t == nt - 2);
            const char* a1 = cA + (size_t)(t + 1) * kstep;
            const char* a2 = last ? nA : cA + (size_t)(t + 2) * kstep; const char* b2 = last ? nB : cB + (size_t)(t + 2) * kstep;
            const char* a3 = a2 + kstep; const char* b3 = b2 + kstep;
            if (last && has_next) S.a_ready(nxt);
            if constexpr (SP2) {
            PG8_LDB(B0, 0, 0); PG8_LDB(B1, 0, 1); PG8_SCHED; PG8_LDA(At, 0, 0); PG8_STAGE(PG8_SA(1, 1), a1 + hstep, voffA);
            PG8_WAIT_V(8); PG8_WAIT_L(0); PG8_BAR; PG8_MMA(0, 0, At, B0); PG8_MMA(0, 1, At, B1); PG8_BAR; PG8_SCHED;
            PG8_LDA(At, 0, 1); PG8_STAGE(PG8_SB(0, 0), b2, voffB); PG8_STAGE(PG8_SB(0, 1), b2 + hstep, voffB); PG8_STAGE(PG8_SA(0, 0), a2, voffA);
            PG8_WAIT_V(8); PG8_WAIT_L(0); PG8_BAR; PG8_MMA(1, 0, At, B0); PG8_MMA(1, 1, At, B1); PG8_BAR; PG8_SCHED;
            PG8_LDB(B0, 1, 0); PG8_LDB(B1, 1, 1); PG8_SCHED; PG8_LDA(At, 1, 0); PG8_STAGE(PG8_SA(0, 1), a2 + hstep, voffA);
            PG8_WAIT_V(8); PG8_WAIT_L(0); PG8_BAR; PG8_MMA(0, 0, At, B0); PG8_MMA(0, 1, At, B1); PG8_BAR; PG8_SCHED;
            PG8_LDA(At, 1, 1); PG8_STAGE(PG8_SB(1, 0), b3, voffB); PG8_STAGE(PG8_SB(1, 1), b3 + hstep, voffB); PG8_STAGE(PG8_SA(1, 0), a3, voffA);
            PG8_WAIT_V(8); PG8_WAIT_L(0); PG8_BAR; PG8_MMA(1, 0, At, B0); PG8_MMA(1, 1, At, B1); PG8_BAR; PG8_SCHED;
            } else {
            PG8_LDB(B0, 0, 0); PG8_SCHED; PG8_LDA(At, 0, 0); PG8_STAGE(PG8_SA(1, 1), a1 + hstep, voffA);
            PG8_WAIT_L(8); PG8_BAR; PG8_WAIT_L(0); PG8_MMA(0, 0, At, B0); PG8_BAR; PG8_SCHED;
            PG8_LDB(B1, 0, 1); PG8_STAGE(PG8_SB(0, 0), b2, voffB);
            PG8_BAR; PG8_WAIT_L(0); PG8_MMA(0, 1, At, B1); PG8_BAR;
            PG8_LDA(At, 0, 1); PG8_STAGE(PG8_SA(0, 0), a2, voffA);
            PG8_BAR; PG8_WAIT_L(0); PG8_MMA(1, 0, At, B0); PG8_BAR; PG8_SCHED;
            PG8_STAGE(PG8_SB(0, 1), b2 + hstep, voffB);
            PG8_WAIT_V(6); PG8_BAR; PG8_MMA(1, 1, At, B1); PG8_BAR;
            PG8_LDB(B0, 1, 0); PG8_SCHED; PG8_LDA(At, 1, 0); PG8_STAGE(PG8_SA(0, 1), a2 + hstep, voffA);
            PG8_WAIT_L(8); PG8_BAR; PG8_WAIT_L(0); PG8_MMA(0, 0, At, B0); PG8_BAR; PG8_SCHED;
            PG8_LDB(B1, 1, 1); PG8_STAGE(PG8_SB(1, 0), b3, voffB);
            PG8_BAR; PG8_WAIT_L(0); PG8_MMA(0, 1, At, B1); PG8_BAR;
            PG8_LDA(At, 1, 1); PG8_STAGE(PG8_SA(1, 0), a3, voffA);
            PG8_BAR; PG8_WAIT_L(0); PG8_MMA(1, 0, At, B0); PG8_BAR; PG8_SCHED;
            PG8_STAGE(PG8_SB(1, 1), b3 + hstep, voffB);
            PG8_WAIT_V(6); PG8_BAR; PG8_MMA(1, 1, At, B1); PG8_BAR;
            }
        }
        if constexpr (ALIGN_EPI) { if (wr == 0) PG8_BAR; }
        if constexpr (!Epi::AFTER_DRAIN) { E(acc, cur, wr, wc, fr, fq); S.done(cur); }
        if (!has_next) break;
#pragma unroll
        for (int a = 0; a < 2; ++a)
#pragma unroll
            for (int b = 0; b < 2; ++b)
#pragma unroll
                for (int m = 0; m < 4; ++m)
#pragma unroll
                    for (int n = 0; n < 2; ++n) acc[a][b][m][n] = (f32x4){0.f, 0.f, 0.f, 0.f};
        cur = nxt; cA = nA; cB = nB; ++ui;
        if constexpr (ALIGN_EPI) { if (wr == 1) PG8_BAR; }
    }
    PG8_WAIT_V(0);
    if constexpr (!ALIGN_EPI) { if (wr == 0) PG8_BAR; }
    PG8_BAR;
    if constexpr (Epi::AFTER_DRAIN) { E.fused(acc, cur, wr, wc, fr, fq, lds, wid, lane); S.done(cur); }
#undef PG8_SA
#undef PG8_SB
#undef PG8_STAGE
#undef PG8_LDA
#undef PG8_LDB
#undef PG8_MMA
#undef PG8_WAIT_V
#undef PG8_WAIT_L
#undef PG8_BAR
#undef PG8_SCHED
}
}

#ifndef PG8_SP2
#define PG8_SP2 true
#endif
#ifndef PG8_ALIGN
#define PG8_ALIGN true
#endif
#define XB_TMO      128
#define XB_XCNT(j)  (256  + 64 * (j))
#define XB_XSUB(j)  (1280 + 64 * (j))
#define XB_XGEN(j)  (2304 + 64 * (j))
#define XB_TOP      3328
#define XB_TOPGEN   3392
#define XCD_BAR_WORDS 3456
#define XB_SPIN_CAP (1u << 18)

__device__ __forceinline__ unsigned xb_ld(unsigned* p)              { return __hip_atomic_load(p, __ATOMIC_RELAXED, __HIP_MEMORY_SCOPE_AGENT); }
__device__ __forceinline__ unsigned xb_add(unsigned* p, unsigned v) { return __hip_atomic_fetch_add(p, v, __ATOMIC_RELAXED, __HIP_MEMORY_SCOPE_AGENT); }
__device__ __forceinline__ unsigned xb_xcc_id() { return (unsigned)__builtin_amdgcn_s_getreg((3 << 11) | 20) & 0xFu; }
#define XB_SPIN(cond, bar) do { unsigned _sp = 0; while (cond) { __builtin_amdgcn_s_sleep(1); \
    if ((++_sp & 255u) == 0u) { if (xb_ld(&(bar)[XB_TMO])) break; if (_sp > XB_SPIN_CAP) { atomicAdd(&(bar)[XB_TMO], 1u); break; } } } } while (0)

struct XcdBarrier {
    unsigned* bar; unsigned x;
    volatile LAS unsigned* st;
};

__device__ __forceinline__ XcdBarrier xcd_barrier_post(unsigned* bar, volatile LAS unsigned* st) {
    XcdBarrier b; b.bar = bar; b.x = xb_xcc_id(); b.st = st;
    if (threadIdx.x == 0) (void)xb_add(&bar[XB_XCNT(b.x)], 1u);
    return b;
}
__device__ __forceinline__ void xcd_barrier_complete(unsigned* bar, unsigned x, unsigned& nloc, unsigned& nx) {
    const unsigned G = gridDim.x * gridDim.y * gridDim.z;
    unsigned sum, cnt, mine, sp = 0u;
    for (;;) {
        sum = 0u; cnt = 0u; mine = 0u;
#pragma unroll
        for (unsigned j = 0; j < 16; ++j) { const unsigned c = xb_ld(&bar[XB_XCNT(j)]); sum += c; cnt += (c > 0u) ? 1u : 0u; mine = (j == x) ? c : mine; }
        if (sum == G) break;
        __builtin_amdgcn_s_sleep(1);
        if ((++sp & 255u) == 0u) { if (xb_ld(&bar[XB_TMO])) break; if (sp > XB_SPIN_CAP) { atomicAdd(&bar[XB_TMO], 1u); break; } }
    }
    nloc = mine > 0u ? mine : 1u; nx = cnt > 0u ? cnt : 1u;
}

__device__ __forceinline__ void xcd_barrier(const XcdBarrier& b, const bool is_t0  ) {
    asm volatile("s_waitcnt vmcnt(0)" ::: "memory");
    __syncthreads();
    if (is_t0) {
        unsigned* bar = b.bar;
        __builtin_amdgcn_s_waitcnt(0);
        unsigned nloc = b.st[0], nx = b.st[1];
        if (nloc == 0u) { xcd_barrier_complete(bar, b.x, nloc, nx); b.st[0] = nloc; b.st[1] = nx; }
        const unsigned old = xb_add(&bar[XB_XSUB(b.x)], 1u);
        const unsigned gen = old / nloc;
        if (old + 1u == (gen + 1u) * nloc) {
            __builtin_amdgcn_fence(__ATOMIC_RELEASE, "agent");
            asm volatile("s_waitcnt vmcnt(0)" ::: "memory");
            const unsigned og = xb_add(&bar[XB_TOP], 1u);
            const unsigned tg = og / nx;
            if (og + 1u == (tg + 1u) * nx) xb_add(&bar[XB_TOPGEN], 1u);
            else XB_SPIN(xb_ld(&bar[XB_TOPGEN]) == tg, bar);
            __builtin_amdgcn_fence(__ATOMIC_ACQUIRE, "agent");
            xb_add(&bar[XB_XGEN(b.x)], 1u);
            asm volatile("s_waitcnt vmcnt(0)" ::: "memory");
        } else {
            XB_SPIN(xb_ld(&bar[XB_XGEN(b.x)]) == gen, bar);
            __builtin_amdgcn_fence(__ATOMIC_ACQUIRE, "agent");
            asm volatile("s_waitcnt vmcnt(0)" ::: "memory");
        }
    }
    __syncthreads();
}
struct EpiResBf16 {
    static constexpr bool PERM = true, AFTER_DRAIN = false;
    const bf16* xin; bf16* yp; float alpha;
    DI void operator()(const pg8::f32x4 (&acc)[2][2][4][2], const pg8::Unit& u, int wr, int wc, int fr, int fq) const {
        const int row0 = u.pm * 256 + wr * 64 + fr, col0 = u.pn * 256 + wc * 32 + 8 * fq;
#pragma unroll
        for (int ai = 0; ai < 2; ++ai)
#pragma unroll
            for (int m = 0; m < 4; ++m) {
                const size_t ro = (size_t)(row0 + ai * 128 + m * 16) * DM;
#pragma unroll
                for (int bj = 0; bj < 2; ++bj) {
                    const size_t o = ro + col0 + bj * 128;
                    const v4u xv = *(const v4u*)(xin + o);
                    const f32x4 a0 = acc[ai][bj][m][0], a1 = acc[ai][bj][m][1];
                    v4u w;
                    w.x = cvtpk(bf2f(xv.x & 0xffffu) * alpha + a0[0], bf2f(xv.x >> 16) * alpha + a0[1]); w.y = cvtpk(bf2f(xv.y & 0xffffu) * alpha + a0[2], bf2f(xv.y >> 16) * alpha + a0[3]);
                    w.z = cvtpk(bf2f(xv.z & 0xffffu) * alpha + a1[0], bf2f(xv.z >> 16) * alpha + a1[1]); w.w = cvtpk(bf2f(xv.w & 0xffffu) * alpha + a1[2], bf2f(xv.w >> 16) * alpha + a1[3]);
                    *(v4u*)(yp + o) = w;
                }
            }
    }
};
struct EpiSwiglu {
    static constexpr bool PERM = true, AFTER_DRAIN = false;
    unsigned char* act; const float* bgu;
    DI void operator()(const pg8::f32x4 (&acc)[2][2][4][2], const pg8::Unit& u, int wr, int wc, int fr, int fq) const {
        const int e = u.pn >> 3, pl = u.pn & 7;
        const int row0 = u.pm * 256 + wr * 64 + fr, cih = pl * 128 + wc * 32 + 8 * fq;
        const float* bg = bgu + e * 2048 + cih;
        const f32x4 bg0 = *(const f32x4*)(bg), bg1 = *(const f32x4*)(bg + 4), bu0 = *(const f32x4*)(bg + 1024), bu1 = *(const f32x4*)(bg + 1028);
#pragma unroll
        for (int ai = 0; ai < 2; ++ai)
#pragma unroll
            for (int m = 0; m < 4; ++m) {
                constexpr float RS = 1.f / (F8_SX * F8_SWG);
                const f32x4 g0 = acc[ai][0][m][0] * RS + bg0, g1 = acc[ai][0][m][1] * RS + bg1, u0 = acc[ai][1][m][0] * RS + bu0, u1 = acc[ai][1][m][1] * RS + bu1;
                float r[8];
#pragma unroll
                for (int i = 0; i < 8; ++i) {
                    float g = i < 4 ? g0[i & 3] : g1[i & 3], uu = i < 4 ? u0[i & 3] : u1[i & 3];
                    g = fminf(g, 7.0f); uu = fminf(fmaxf(uu, -7.0f), 7.0f);
                    const float sg = __builtin_amdgcn_rcpf(1.0f + ex2(-1.702f * LOG2E * g));
                    r[i] = (uu + 1.0f) * g * sg * F8_SA;
                }
                v2u w; w.x = pk4_fp8(r[0], r[1], r[2], r[3]); w.y = pk4_fp8(r[4], r[5], r[6], r[7]);
                *(v2u*)(act + (size_t)(row0 + ai * 128 + m * 16) * DM + cih) = w;
            }
    }
};
struct EpiDown {
    static constexpr bool PERM = true, AFTER_DRAIN = false;
    bf16* yr; const float* bdn;
    DI void operator()(const pg8::f32x4 (&acc)[2][2][4][2], const pg8::Unit& u, int wr, int wc, int fr, int fq) const {
        const int e = u.pn >> 2, pl = u.pn & 3;
        const int row0 = u.pm * 256 + wr * 64 + fr, col0 = pl * 256 + wc * 32 + 8 * fq;
        f32x4 bv[2][2];
#pragma unroll
        for (int bj = 0; bj < 2; ++bj) { bv[bj][0] = *(const f32x4*)(bdn + e * 1024 + col0 + bj * 128); bv[bj][1] = *(const f32x4*)(bdn + e * 1024 + col0 + bj * 128 + 4); }
#pragma unroll
        for (int ai = 0; ai < 2; ++ai)
#pragma unroll
            for (int m = 0; m < 4; ++m) {
                bf16* rp = yr + (size_t)(row0 + ai * 128 + m * 16) * DM + col0;
#pragma unroll
                for (int bj = 0; bj < 2; ++bj) {
                    constexpr float RS = 1.f / (F8_SA * F8_SWD);
                    const f32x4 v0 = acc[ai][bj][m][0] * RS + bv[bj][0], v1 = acc[ai][bj][m][1] * RS + bv[bj][1];
                    v4u w; w.x = cvtpk(v0[0], v0[1]); w.y = cvtpk(v0[2], v0[3]); w.z = cvtpk(v1[0], v1[1]); w.w = cvtpk(v1[2], v1[3]);
                    *(v4u*)(rp + bj * 128) = w;
                }
            }
    }
};
struct GroupOrder {
    LAS const unsigned* tile_e; int ntiles, lg, G, c;
    DI bool next(int i, pg8::Unit& u) const {
        int pm, pl;
        if (G == 256) {
            const int x = c & 7, k = c >> 3; pm = i * (256 >> lg) + x * (32 >> lg) + (k >> lg); pl = k & ((1 << lg) - 1); if (pm >= ntiles) return false; }
        else { const long L = (long)i * G + c; if (L >= ((long)ntiles << lg)) return false; pm = (int)(L >> lg); pl = (int)(L & ((1 << lg) - 1)); }
        const int e = __builtin_amdgcn_readfirstlane((int)tile_e[pm]);
        u.pm = pm; u.pn = (e << lg) + pl; return true;
    }
    DI void a_ready(const pg8::Unit&) const {}
    DI void done(const pg8::Unit&) const {}
};
struct Args { const float* in[18]; float* out; unsigned char* ws; int ph_lo, ph_hi; };
struct Fr { LAS unsigned char* lds; unsigned char* ws; unsigned* ctl; int tid, lane, wave, blk, G; };

DI void tr_item(const float* W, int ldw, int K, int k0, int sc0, int nvalid, bf16* WT, int drow0, LAS float* scr, int lane) {
    const int c = lane & 31;
    float v[32];
#pragma unroll
    for (int i = 0; i < 32; ++i) v[i] = (c < nvalid) ? W[(size_t)(k0 + 2 * i + (lane >> 5)) * ldw + sc0 + c] : 0.f;
#pragma unroll
    for (int i = 0; i < 32; ++i) scr[(2 * i + (lane >> 5)) * 33 + c] = v[i];
    LDS_WAIT(); asm volatile("" ::: "memory");
    const int c8 = lane & 7;
#pragma unroll
    for (int j = 0; j < 4; ++j) { const int n = (lane >> 3) + 8 * j; const LAS float* s = scr + (8 * c8) * 33 + n;
        v4u o; o.x = cvtpk(s[0 * 33], s[1 * 33]); o.y = cvtpk(s[2 * 33], s[3 * 33]); o.z = cvtpk(s[4 * 33], s[5 * 33]); o.w = cvtpk(s[6 * 33], s[7 * 33]);
        *(v4u*)(WT + (size_t)(drow0 + n) * K + k0 + 8 * c8) = o; }
    LDS_WAIT(); asm volatile("" ::: "memory");
}
DI void tr_item8(const float* W, int ldw, int K, int k0, int sc0, float scale, unsigned char* WT8, int drow0, LAS float* scr, int lane) {
    const int c = lane & 31;
    float v[32];
#pragma unroll
    for (int i = 0; i < 32; ++i) v[i] = W[(size_t)(k0 + 2 * i + (lane >> 5)) * ldw + sc0 + c];
#pragma unroll
    for (int i = 0; i < 32; ++i) scr[(2 * i + (lane >> 5)) * 33 + c] = v[i] * scale;
    LDS_WAIT(); asm volatile("" ::: "memory");
    const int c16 = lane & 3;
#pragma unroll
    for (int j = 0; j < 2; ++j) { const int n = (lane >> 2) + 16 * j; const LAS float* s = scr + (16 * c16) * 33 + n;
        v4u o; o.x = pk4_fp8(s[0 * 33], s[1 * 33], s[2 * 33], s[3 * 33]); o.y = pk4_fp8(s[4 * 33], s[5 * 33], s[6 * 33], s[7 * 33]);
        o.z = pk4_fp8(s[8 * 33], s[9 * 33], s[10 * 33], s[11 * 33]); o.w = pk4_fp8(s[12 * 33], s[13 * 33], s[14 * 33], s[15 * 33]);
        *(v4u*)(WT8 + (size_t)(drow0 + n) * K + k0 + 16 * c16) = o; }
    LDS_WAIT(); asm volatile("" ::: "memory");
}
DI void ph_prologue(const Args& a, const Fr& F) {
    LAS float* scr = (LAS float*)(F.lds + F.wave * 16384);
    const int gw = F.blk * NWAVES + F.wave, NGW = F.G * NWAVES;
    constexpr int I_EV = 2 * 16 * 80, I_OD = 2 * 16 * 96, I_WO = 4 * 16 * 32;
    constexpr int NITEMS = I_EV + I_OD + I_WO;
    bf16* wev = (bf16*)(F.ws + WS_WEV); bf16* wod = (bf16*)(F.ws + WS_WOD); bf16* wout = (bf16*)(F.ws + WS_WOUT);
    unsigned char* wgu = F.ws + WS_WGU; unsigned char* wdn = F.ws + WS_WDN;
    for (int it = gw; it < NITEMS; it += NGW) {
        int r = it;
        if (r < I_EV) { const int l = r / 1280; r %= 1280; const int kb = r / 80, n0 = (r % 80) * 32; int sc0, nv = 32;
            if (n0 < 512) sc0 = n0; else if (n0 < 1024) sc0 = 964 + (n0 - 512); else if (n0 < 1536) sc0 = 1476 + (n0 - 1024); else if (n0 < 2048) sc0 = 1988 + (n0 - 1536);
            else if (n0 < 2176) sc0 = 512 + (n0 - 2048); else if (n0 < 2432) sc0 = 640 + (n0 - 2176); else if (n0 < 2496) sc0 = 896 + (n0 - 2432);
            else if (n0 < 2528) { sc0 = 960; nv = 4; } else { sc0 = 0; nv = 0; }
            tr_item(a.in[1] + (size_t)l * 1024 * 2500, 2500, 1024, kb * 64, sc0, nv, wev + (size_t)l * EV_N * 1024, n0, scr, F.lane); continue; }
        r -= I_EV;
        if (r < I_OD) { const int l = r / 1536; r %= 1536; const int kb = r / 96, n0 = (r % 96) * 32;
            tr_item(a.in[6] + (size_t)l * 1024 * 3088, 3088, 1024, kb * 64, n0, 32, wod + (size_t)l * OD_N * 1024, n0, scr, F.lane); continue; }
        r -= I_OD;
        if (r < I_WO) { const int l = r / 512; r %= 512; const int kb = r / 32, n0 = (r % 32) * 32;
            const float* src = (l & 1) ? a.in[8] + (size_t)(l >> 1) * 1024 * 1024 : a.in[5] + (size_t)(l >> 1) * 1024 * 1024;
            tr_item(src, 1024, 1024, kb * 64, n0, 32, wout + (size_t)l * 1024 * 1024, n0, scr, F.lane); continue; }
    }
    { __syncthreads();
        LAS float* tile = (LAS float*)F.lds; unsigned char* wgu8 = F.ws + WS_WGU; unsigned char* wdn8 = F.ws + WS_WDN;
        constexpr int T_GU = 128 * 8 * 16, T_DN = 128 * 8 * 8, T_ALL = T_GU + T_DN;
        const int tid = F.tid, c4 = tid & 31, r0 = tid >> 5;
        f32x4 v[8];
        auto locate = [&](int t, const float*& src, int& ldw, unsigned char*& dst, float& scale) {
            if (t < T_GU) { const int le = t >> 7, r = t & 127, kb = r >> 4, nb = r & 15, n0 = nb * 128; const int pn = n0 >> 8, bj = (n0 >> 7) & 1;
                src = a.in[14] + (size_t)le * 1024 * 2048 + (size_t)(kb * 128) * 2048 + bj * 1024 + pn * 128; ldw = 2048; dst = wgu8 + (size_t)le * 2048 * 1024 + (size_t)n0 * 1024 + kb * 128; scale = F8_SWG; }
            else { const int u = t - T_GU, le = u >> 6, r = u & 63, kb = r >> 3, nb = r & 7;
                src = a.in[16] + (size_t)le * 1024 * 1024 + (size_t)(kb * 128) * 1024 + nb * 128; ldw = 1024; dst = wdn8 + (size_t)le * 1024 * 1024 + (size_t)(nb * 128) * 1024 + kb * 128; scale = F8_SWD; } };
        int t = F.blk;
        if (t < T_ALL) { const float* src; int ldw; unsigned char* dst; float sc; locate(t, src, ldw, dst, sc);
#pragma unroll
            for (int i = 0; i < 8; ++i) v[i] = *(const f32x4*)(src + (size_t)(r0 + 16 * i) * ldw + 4 * c4); }
        for (; t < T_ALL; t += F.G) {
            const float* src; int ldw; unsigned char* dst; float sc; locate(t, src, ldw, dst, sc);
#pragma unroll
            for (int i = 0; i < 8; ++i) { LAS float* tp = tile + (r0 + 16 * i) * 129 + 4 * c4; tp[0] = v[i][0] * sc; tp[1] = v[i][1] * sc; tp[2] = v[i][2] * sc; tp[3] = v[i][3] * sc; }
            __syncthreads();
            if (t + F.G < T_ALL) { const float* s2; int l2; unsigned char* d2; float c2; locate(t + F.G, s2, l2, d2, c2);
#pragma unroll
                for (int i = 0; i < 8; ++i) v[i] = *(const f32x4*)(s2 + (size_t)(r0 + 16 * i) * l2 + 4 * c4); }
#pragma unroll
            for (int j = 0; j < 2; ++j) { const int p = tid + 512 * j, kc = p & 7, n = p >> 3; const LAS float* sp = tile + (kc * 16) * 129 + n;
                v4u o; o.x = pk4_fp8(sp[0], sp[129], sp[2 * 129], sp[3 * 129]); o.y = pk4_fp8(sp[4 * 129], sp[5 * 129], sp[6 * 129], sp[7 * 129]);
                o.z = pk4_fp8(sp[8 * 129], sp[9 * 129], sp[10 * 129], sp[11 * 129]); o.w = pk4_fp8(sp[12 * 129], sp[13 * 129], sp[14 * 129], sp[15 * 129]);
                *(v4u*)(dst + (size_t)n * 1024 + kc * 16) = o; }
            __syncthreads();
        }
    }
    bf16* xb = (bf16*)(F.ws + WS_XB);
    for (int m = gw; m < NTOK; m += NGW) {
        const f32x4* xr = (const f32x4*)(a.in[0] + (size_t)m * DM) + F.lane; v2u* o = (v2u*)(xb + (size_t)m * DM) + F.lane;
#pragma unroll
        for (int j = 0; j < 4; ++j) { const f32x4 v = xr[64 * j]; v2u w; w.x = cvtpk(v[0], v[1]); w.y = cvtpk(v[2], v[3]); o[64 * j] = w; }
    }
    bf16* wukt = (bf16*)(F.ws + WS_WUKT); bf16* wuvt = (bf16*)(F.ws + WS_WUVT);
    for (int i = F.blk * NTHR + F.tid; i < 2 * 8 * 128 * 64; i += F.G * NTHR) {
        { const int d = i & 63, c = (i >> 6) & 127, lh = i >> 13; wukt[i] = (bf16)f2bf(a.in[2][((size_t)lh * 64 + d) * 128 + c]); }
        { const int c = i & 127, d = (i >> 7) & 63, lh = i >> 13; wuvt[i] = (bf16)f2bf(a.in[3][((size_t)lh * 128 + c) * 64 + d]); }
    }
}

DI void ln_row(f32x4 (&v)[4], const float* g, const float* b, int lane) {
    float s = 0.f;
#pragma unroll
    for (int j = 0; j < 4; ++j) s += (v[j][0] + v[j][1]) + (v[j][2] + v[j][3]);
    const float mean = wave_sum(s) * (1.f / DM); float s2 = 0.f;
#pragma unroll
    for (int j = 0; j < 4; ++j) { v[j] = v[j] - mean; s2 += (v[j][0] * v[j][0] + v[j][1] * v[j][1]) + (v[j][2] * v[j][2] + v[j][3] * v[j][3]); }
    const float rstd = 1.f / sqrtf(wave_sum(s2) * (1.f / DM) + LN_EPS);
#pragma unroll
    for (int j = 0; j < 4; ++j) { const f32x4 gg = *((const f32x4*)g + lane + 64 * j), bb = *((const f32x4*)b + lane + 64 * j); v[j] = v[j] * rstd * gg + bb; }
}
DI void store_row_f32(float* p, const f32x4 (&v)[4], int lane) {
#pragma unroll
    for (int j = 0; j < 4; ++j) *((f32x4*)p + lane + 64 * j) = v[j];
}
DI void store_row_bf16(bf16* p, const f32x4 (&v)[4], int lane) {
#pragma unroll
    for (int j = 0; j < 4; ++j) { v2u w; w.x = cvtpk(v[j][0], v[j][1]); w.y = cvtpk(v[j][2], v[j][3]); *((v2u*)p + lane + 64 * j) = w; }
}
template <int NL> DI void small_proj(LAS const float* xs, const float* W, int ldw, int lane, float (&acc)[4]) {
    constexpr int PARTS = 64 / NL, DPER = 1024 / PARTS;
    const int n = lane & (NL - 1), part = lane / NL;
    acc[0] = acc[1] = acc[2] = acc[3] = 0.f;
    const float* wp = W + (size_t)(part * DPER) * ldw + n;
    LAS const float* xp = xs + part * DPER;
#pragma unroll 8
    for (int d = 0; d < DPER; ++d) { const float w = wp[(size_t)d * ldw];
        acc[0] += w * xp[d]; acc[1] += w * xp[1024 + d]; acc[2] += w * xp[2048 + d]; acc[3] += w * xp[3072 + d]; }
#pragma unroll
    for (int o = NL; o < 64; o <<= 1) {
#pragma unroll
        for (int k = 0; k < 4; ++k) acc[k] += __shfl_xor(acc[k], o); }
}

DI void ph_even_prep(const Args& a, const Fr& F, int j) {
    const bf16* proj = (const bf16*)(F.ws + WS_PROJ);
    bf16* ckvn = (bf16*)(F.ws + WS_CKVN); bf16* ql = (bf16*)(F.ws + WS_QL); float* kbar = (float*)(F.ws + WS_KBAR);
    const float* kvg = a.in[4] + j * 128;
    const bf16* wukt = (const bf16*)(F.ws + WS_WUKT) + (size_t)j * 8 * 128 * 64;
    const int lane = F.lane, wave = F.wave;
    for (int chunk = F.blk; chunk < 256; chunk += F.G) {
        const int tok0 = chunk * 128;
#pragma unroll 1
        for (int i0 = 0; i0 < 16; i0 += 8) { unsigned wv[8];
#pragma unroll
            for (int i = 0; i < 8; ++i) wv[i] = *((const unsigned*)(proj + (size_t)(tok0 + wave * 16 + i0 + i) * EV_N + EC_CKV) + lane);
#pragma unroll
            for (int i = 0; i < 8; ++i) { const int tok = tok0 + wave * 16 + i0 + i; const float v0 = bf2f(wv[i] & 0xffffu), v1 = bf2f(wv[i] >> 16);
                const float ss = wave_sum(v0 * v0 + v1 * v1);
                const float r = 1.f / sqrtf(ss * (1.f / 128.f) + LN_EPS);
                *((unsigned*)(ckvn + (size_t)tok * 128) + lane) = cvtpk(v0 * r * kvg[2 * lane], v1 * r * kvg[2 * lane + 1]); } }
        { bf16* kic = (bf16*)(F.ws + WS_KIC); const int tok = tok0 + wave * 16 + (lane >> 2), c = (lane & 3) * 16;
            const v4u* src = (const v4u*)(proj + (size_t)tok * EV_N + EC_KI + c); v4u* dst = (v4u*)(kic + (size_t)tok * 64 + c); dst[0] = src[0]; dst[1] = src[1]; }
        { const int h = wave, l15 = lane & 15, kg = lane >> 4;
            bf16x8 af[8][2];
#pragma unroll
            for (int ct = 0; ct < 8; ++ct)
#pragma unroll
                for (int ks = 0; ks < 2; ++ks) af[ct][ks] = *(const bf16x8*)(wukt + ((size_t)h * 128 + ct * 16 + l15) * 64 + ks * 32 + kg * 8);
#pragma unroll 1
            for (int tg = 0; tg < 8; tg += 4) { bf16x8 qf[4][2];
#pragma unroll
                for (int u = 0; u < 4; ++u)
#pragma unroll
                    for (int ks = 0; ks < 2; ++ks) qf[u][ks] = *(const bf16x8*)(proj + (size_t)(tok0 + (tg + u) * 16 + l15) * EV_N + EC_QA + h * 64 + ks * 32 + kg * 8);
#pragma unroll
                for (int u = 0; u < 4; ++u) { const int tok = tok0 + (tg + u) * 16 + l15;
#pragma unroll
                    for (int ct = 0; ct < 8; ++ct) { f32x4 d = {0.f, 0.f, 0.f, 0.f};
                        d = mfma16(af[ct][0], qf[u][0], d); d = mfma16(af[ct][1], qf[u][1], d);
                        v2u w; w.x = cvtpk(d[0], d[1]); w.y = cvtpk(d[2], d[3]);
                        *(v2u*)(ql + (size_t)tok * 1024 + h * 128 + ct * 16 + 4 * kg) = w; } } } }
        if (chunk < 128) { const int b = chunk >> 5, n = chunk & 31; float s8[8];
#pragma unroll
            for (int k = 0; k < 8; ++k) s8[k] = 0.f;
            const bf16* kp = proj + ((size_t)b * SEQ + n * 256 + wave * 32) * EV_N + EC_KB + lane * 8;
#pragma unroll 8
            for (int r = 0; r < 32; ++r) { const v4u w = *(const v4u*)(kp + (size_t)r * EV_N);
#pragma unroll
                for (int k = 0; k < 4; ++k) { s8[2 * k] += bf2f(w[k] & 0xffffu); s8[2 * k + 1] += bf2f(w[k] >> 16); } }
            LAS float* red = (LAS float*)F.lds;
            __syncthreads();
#pragma unroll
            for (int k = 0; k < 8; ++k) red[wave * 512 + lane * 8 + k] = s8[k];
            __syncthreads();
            float s = 0.f;
#pragma unroll
            for (int w = 0; w < 8; ++w) s += red[w * 512 + F.tid];
            const int h = F.tid >> 6, d = F.tid & 63;
            kbar[(((size_t)b * 8 + h) * 32 + n) * 64 + d] = s * (1.f / 256.f); }
    }
}

DI void moba_gate_chunk(const Fr& F, int chunk) {
    const bf16* proj = (const bf16*)(F.ws + WS_PROJ); const float* kbar = (const float*)(F.ws + WS_KBAR); unsigned* sel3 = (unsigned*)(F.ws + WS_SEL3);
    const int tok0 = chunk * 128, b = tok0 / SEQ, own = (tok0 % SEQ) >> 8, h = F.wave, lane = F.lane;
    float q0[64], q1[64];
    { const v4u* p0 = (const v4u*)(proj + (size_t)(tok0 + lane) * EV_N + EC_QB + h * 64); const v4u* p1 = (const v4u*)(proj + (size_t)(tok0 + 64 + lane) * EV_N + EC_QB + h * 64);
#pragma unroll
        for (int i = 0; i < 8; ++i) { const v4u w0 = p0[i], w1 = p1[i];
#pragma unroll
            for (int k = 0; k < 4; ++k) { q0[8 * i + 2 * k] = bf2f(w0[k] & 0xffffu); q0[8 * i + 2 * k + 1] = bf2f(w0[k] >> 16); q1[8 * i + 2 * k] = bf2f(w1[k] & 0xffffu); q1[8 * i + 2 * k + 1] = bf2f(w1[k] >> 16); } } }
    float a0 = -INFINITY, a1 = -INFINITY, a2 = -INFINITY, c0 = -INFINITY, c1 = -INFINITY, c2 = -INFINITY; int ai0 = 0, ai1 = 0, ai2 = 0, ci0 = 0, ci1 = 0, ci2 = 0;
    const float* kb = kbar + (((size_t)b * 8 + h) * 32) * 64;
    for (int n = 0; n < own; ++n) { float g0 = 0.f, g1 = 0.f;
#pragma unroll
        for (int d = 0; d < 64; d += 4) { const f32x4 kv = *(const f32x4*)(kb + n * 64 + d);
#pragma unroll
            for (int k = 0; k < 4; ++k) { g0 += q0[d + k] * kv[k]; g1 += q1[d + k] * kv[k]; } }
        if (g0 > a2) { if (g0 > a1) { a2 = a1; ai2 = ai1; if (g0 > a0) { a1 = a0; ai1 = ai0; a0 = g0; ai0 = n; } else { a1 = g0; ai1 = n; } } else { a2 = g0; ai2 = n; } }
        if (g1 > c2) { if (g1 > c1) { c2 = c1; ci2 = ci1; if (g1 > c0) { c1 = c0; ci1 = ci0; c0 = g1; ci0 = n; } else { c1 = g1; ci1 = n; } } else { c2 = g1; ci2 = n; } }
    }
    const unsigned nv = own < 3 ? own : 3;
    sel3[(size_t)(tok0 + lane) * 8 + h] = (unsigned)ai0 | ((unsigned)ai1 << 8) | ((unsigned)ai2 << 16) | (nv << 24);
    sel3[(size_t)(tok0 + 64 + lane) * 8 + h] = (unsigned)ci0 | ((unsigned)ci1 << 8) | ((unsigned)ci2 << 16) | (nv << 24);
}

constexpr int HS = 257;
DI float relu1(float x) { const unsigned u = __float_as_uint(x); return __uint_as_float(u & ~(unsigned)((int)u >> 31)); }
template <int MODE, bool DIAG> DI void idx_tile(const bf16x8 (&kf)[4], LAS const char* qb  , const float (&wj)[4], int kt, int q, int hi, unsigned c0, unsigned c1,
                                     LAS unsigned* hist, LAS unsigned* mask, LAS unsigned* cmask, LAS unsigned long long* cand, LAS unsigned* rinfo) {
    f32x2 scp[8];
#pragma unroll
    for (int p = 0; p < 8; ++p) scp[p] = (f32x2){0.f, 0.f};
    bf16x8 qv0[2][4], qv1[2][4];
#pragma unroll
    for (int j = 0; j < 2; ++j)
#pragma unroll
        for (int s = 0; s < 4; ++s) qv0[j][s] = *(LAS const bf16x8*)(qb + (j * 8 + s * 2) * 512);
#pragma unroll
    for (int j = 0; j < 2; ++j)
#pragma unroll
        for (int s = 0; s < 4; ++s) qv1[j][s] = *(LAS const bf16x8*)(qb + ((2 + j) * 8 + s * 2) * 512);
    __builtin_amdgcn_sched_barrier(0);
#pragma unroll
    for (int g = 0; g < 2; ++g) { f32x16 acc[2];
#pragma unroll
        for (int j = 0; j < 2; ++j)
#pragma unroll
            for (int r = 0; r < 16; ++r) acc[j][r] = 0.f;
#pragma unroll
        for (int s = 0; s < 4; ++s)
#pragma unroll
            for (int j = 0; j < 2; ++j) { if (MODE != -2) acc[j] = mfma32(kf[s], g == 0 ? qv0[j][s] : qv1[j][s], acc[j]); else acc[j][s] += __builtin_bit_cast(float, (unsigned)(kf[s][0] ^ (g == 0 ? qv0[j][s][0] : qv1[j][s][0]))); }
#pragma unroll
        for (int p = 0; p < 8; ++p)
#pragma unroll
            for (int j = 0; j < 2; ++j) { const f32x2 a = {relu1(acc[j][2 * p]), relu1(acc[j][2 * p + 1])}; const f32x2 w2 = {wj[2 * g + j], wj[2 * g + j]}; scp[p] = a * w2 + scp[p]; } }
    unsigned sel = 0u, cnd = 0u;
    if (MODE <= 0) { float t = 0.f;
#pragma unroll
        for (int p = 0; p < 8; ++p) t += scp[p][0] + scp[p][1];
        if (t == 12345.678f) __hip_atomic_fetch_or(mask + q * HS + kt, 1u, __ATOMIC_RELAXED, __HIP_MEMORY_SCOPE_WORKGROUP);
        return; }
    const float F0 = __uint_as_float(c0), F1 = __uint_as_float(c1);
#pragma unroll
    for (int r = 0; r < 16; ++r) { const int kr = crow(r, hi);
        const bool ok = !DIAG || kr <= q;
        const float scv = scp[r >> 1][r & 1]; const unsigned u = __float_as_uint(scv);
        if (MODE == 1) { const unsigned key = u ^ ((unsigned)((int)u >> 31) | 0x80000000u);
            if (ok && (key >> 24) >= c0) __hip_atomic_fetch_add(hist + q * HS + (key >> 24), 1u, __ATOMIC_RELAXED, __HIP_MEMORY_SCOPE_WORKGROUP); }
        else if (MODE == 2) { if (ok && (u >> 24) == c0) __hip_atomic_fetch_add(hist + q * HS + (((u >> 16) & 255u) ^ c1), 1u, __ATOMIC_RELAXED, __HIP_MEMORY_SCOPE_WORKGROUP); }
        else { const bool ge1 = scv >= F1, ge0 = scv >= F0;
            if (ok && ge1) sel |= 1u << kr;
            if (ok && ge0 && !ge1) { cnd |= 1u << kr; const unsigned key = u ^ ((unsigned)((int)u >> 31) | 0x80000000u);
                const unsigned pos = __hip_atomic_fetch_add(rinfo + 128 + q, 1u, __ATOMIC_RELAXED, __HIP_MEMORY_SCOPE_WORKGROUP);
                if (pos < 64u) cand[q * 64 + pos] = ((unsigned long long)key << 32) | (unsigned)(~(unsigned)(kt * 32 + kr)); } } }
    if (MODE == 3) { if (sel) __hip_atomic_fetch_or(mask + q * HS + kt, sel, __ATOMIC_RELAXED, __HIP_MEMORY_SCOPE_WORKGROUP);
        if (cnd) __hip_atomic_fetch_or(cmask + q * HS + kt, cnd, __ATOMIC_RELAXED, __HIP_MEMORY_SCOPE_WORKGROUP); }
}
template <int MODE> DI void idx_pass(const bf16* proj, int rowbase, int qt, LAS const char* qimg, const float (&wj)[4], LAS unsigned* hist, LAS unsigned* mask, LAS unsigned* cmask, LAS unsigned long long* cand, LAS unsigned* rinfo, int wave, int lane) {
    const int q = lane & 31, hi = lane >> 5, nkt = qt + 1;
    const unsigned b1 = MODE == 2 ? rinfo[160 + q] : rinfo[224 + q], thr16 = MODE == 2 ? rinfo[192 + q] : rinfo[256 + q];
    const bf16* kp0 = proj + (size_t)(rowbase + q) * 64 + hi * 8;
    LAS const char* qb = qimg + hi * 512 + q * 16;
    const int n = nkt > wave ? (nkt - wave + 7) >> 3 : 0;
    bf16x8 kfa[4], kfb[4];
#define IDX_LOAD(KF, I) do { const bf16* kp_ = kp0 + (size_t)((wave + 8 * (I)) * 32) * 64; _Pragma("unroll") for (int s_ = 0; s_ < 4; ++s_) KF[s_] = *(const bf16x8*)(kp_ + s_ * 16); } while (0)
#define IDX_TILE(KF, I) do { const int kt_ = wave + 8 * (I); if (kt_ == qt) idx_tile<MODE, true>(KF, qb, wj, kt_, q, hi, b1, thr16, hist, mask, cmask, cand, rinfo); \
        else idx_tile<MODE, false>(KF, qb, wj, kt_, q, hi, b1, thr16, hist, mask, cmask, cand, rinfo); } while (0)
    if (n > 0) IDX_LOAD(kfa, 0);
    for (int i = 0; i < n; i += 2) {
        if (i + 1 < n) { if (MODE == -1) { _Pragma("unroll") for (int s_ = 0; s_ < 4; ++s_) kfb[s_] = kfa[s_]; } else IDX_LOAD(kfb, i + 1); }
        IDX_TILE(kfa, i);
        if (i + 1 < n) { if (i + 2 < n && MODE != -1) IDX_LOAD(kfa, i + 2); IDX_TILE(kfb, i + 1); }
    }
#undef IDX_LOAD
#undef IDX_TILE
}
DI void hist_pick(LAS const unsigned* hrow, unsigned need, int lane, unsigned& bin, unsigned& above) {
    unsigned h4[4];
#pragma unroll
    for (int k = 0; k < 4; ++k) h4[k] = hrow[4 * lane + k];
    const unsigned ssum = h4[0] + h4[1] + h4[2] + h4[3];
    unsigned x = ssum;
#pragma unroll
    for (int o = 1; o < 64; o <<= 1) { const unsigned y = __shfl_down(x, o); if (lane + o < 64) x += y; }
    const unsigned long long m = __ballot(x >= need);
    const int Ls = m ? 63 - __builtin_clzll(m) : 0;
    const unsigned xs = __shfl(x, Ls), ss = __shfl(ssum, Ls);
    const unsigned h0 = __shfl(h4[0], Ls), h1 = __shfl(h4[1], Ls), h2 = __shfl(h4[2], Ls), h3 = __shfl(h4[3], Ls);
    unsigned cum = xs - ss;
    if (cum + h3 >= need) { bin = 4 * Ls + 3; above = cum; return; } cum += h3;
    if (cum + h2 >= need) { bin = 4 * Ls + 2; above = cum; return; } cum += h2;
    if (cum + h1 >= need) { bin = 4 * Ls + 1; above = cum; return; } cum += h1;
    bin = 4 * Ls; above = cum; (void)h0;
}
DI void idx_pass1(const bf16* proj, int rowbase, int qt, LAS const char* qimg, const float (&wj)[4], LAS unsigned* hist, LAS unsigned* mask, LAS unsigned* cmask, LAS unsigned long long* cand, LAS unsigned* rinfo, int wave, int lane) {
    const int q = lane & 31, hi = lane >> 5, nkt = qt + 1, nmax = (nkt + 7) >> 3;
    const bf16* kp0 = proj + (size_t)(rowbase + q) * 64 + hi * 8;
    LAS const char* qb = qimg + hi * 512 + q * 16;
    unsigned lb = 0u;
    bf16x8 kfc[4], kfn[4];
    if (wave < nkt) {
#pragma unroll
        for (int s = 0; s < 4; ++s) kfc[s] = *(const bf16x8*)(kp0 + (size_t)(wave * 32) * 64 + s * 16); }
    for (int i = 0; i < nmax; ++i) { const int kt = wave + 8 * i;
        if (kt + 8 < nkt) {
#pragma unroll
            for (int s = 0; s < 4; ++s) kfn[s] = *(const bf16x8*)(kp0 + (size_t)((kt + 8) * 32) * 64 + s * 16); }
        if (kt < nkt) { if (kt == qt) idx_tile<1, true>(kfc, qb, wj, kt, q, hi, lb, 0u, hist, mask, cmask, cand, rinfo); else idx_tile<1, false>(kfc, qb, wj, kt, q, hi, lb, 0u, hist, mask, cmask, cand, rinfo); }
#pragma unroll
        for (int s = 0; s < 4; ++s) kfc[s] = kfn[s];
        if (((i + 1) & i) == 0 && i + 1 < nmax && i < 16) {
            __syncthreads();
#pragma unroll 1
            for (int rr = 0; rr < 4; ++rr) { const int row = wave * 4 + rr; unsigned bin, above; hist_pick(hist + row * HS, 256u, lane, bin, above);
                if (lane == 0) rinfo[288 + row] = bin; }
            __syncthreads();
            { const unsigned nb = rinfo[288 + q]; lb = nb > lb ? nb : lb; } }
    }
}
DI void idx_unit(const Fr& F, int b, int qt, int stop = 0  ) {
    const bf16* proj = (const bf16*)(F.ws + WS_PROJ); const bf16* kic = (const bf16*)(F.ws + WS_KIC); unsigned short* sel = (unsigned short*)(F.ws + WS_SEL);
    LAS unsigned* hist = (LAS unsigned*)(F.lds); LAS unsigned* mask = hist + 32 * HS; LAS unsigned* cmask = mask + 32 * HS;
    LAS unsigned long long* cand = (LAS unsigned long long*)(F.lds + 99328); LAS unsigned* rinfo = (LAS unsigned*)(F.lds + 115712);
    const int lane = F.lane, wave = F.wave, tid = F.tid, t0 = qt * 32, rowbase = b * SEQ;
    __syncthreads();
    for (int i = tid; i < 3 * 32 * HS; i += NTHR) hist[i] = 0u;
    if (tid < 320) rinfo[tid] = 0u;
    __syncthreads();
    if (t0 + 31 <= 255 || (EXPF & 64)) {
        if (lane < 8) {
#pragma unroll
            for (int rr = 0; rr < 4; ++rr) { const int row = wave * 4 + rr, nv = t0 + row + 1;
                const int nv0 = t0 + row + 1; const int nvc = nv0 < 256 ? nv0 : 256; (void)nv; mask[row * HS + lane] = nvc >= 32 * (lane + 1) ? 0xffffffffu : (nvc > 32 * lane ? ((1u << (nvc - 32 * lane)) - 1u) : 0u); } }
    } else {
        const int q = lane & 31;
        float wj[4];
        { const bf16* qp = proj + (size_t)(rowbase + t0 + q) * EV_N;
#pragma unroll
            for (int j = 0; j < 4; ++j) wj[j] = bf2f(qp[EC_WI + j]); }
        LAS char* qimg = (LAS char*)(F.lds + 117248);
#pragma unroll
        for (int i = 0; i < 2; ++i) { const int p = tid + i * NTHR, row = p & 31, c = p >> 5;
            *(LAS v4u*)(qimg + c * 512 + row * 16) = *(const v4u*)(proj + (size_t)(rowbase + t0 + row) * EV_N + EC_QI + c * 8); }
        __syncthreads();
        if (stop == 7) return;
        if (stop == 4) { idx_pass<0>(kic, rowbase, qt, qimg, wj, hist, mask, cmask, cand, rinfo, wave, lane); return; }
        if (stop == 5) { idx_pass<-1>(kic, rowbase, qt, qimg, wj, hist, mask, cmask, cand, rinfo, wave, lane); return; }
        if (stop == 6) { idx_pass<-2>(kic, rowbase, qt, qimg, wj, hist, mask, cmask, cand, rinfo, wave, lane); return; }
        idx_pass1(kic, rowbase, qt, qimg, wj, hist, mask, cmask, cand, rinfo, wave, lane);
        __syncthreads();
#pragma unroll 1
        for (int rr = 0; rr < 4; ++rr) { const int row = wave * 4 + rr; unsigned bin, above; hist_pick(hist + row * HS, 256u, lane, bin, above);
            if (lane == 0) { rinfo[row] = bin; rinfo[32 + row] = 256u - above; rinfo[160 + row] = bin >= 128u ? bin - 128u : 255u - bin; rinfo[192 + row] = bin >= 128u ? 0u : 255u; } }
        __syncthreads();
        if (stop == 1) return;
        for (int i = tid; i < 32 * HS; i += NTHR) hist[i] = 0u;
        __syncthreads();
        idx_pass<2>(kic, rowbase, qt, qimg, wj, hist, mask, cmask, cand, rinfo, wave, lane);
        __syncthreads();
#pragma unroll 1
        for (int rr = 0; rr < 4; ++rr) { const int row = wave * 4 + rr; const unsigned need1 = rinfo[32 + row]; unsigned bin, above; hist_pick(hist + row * HS, need1, lane, bin, above);
            if (lane == 0) { const unsigned t16 = (rinfo[row] << 8) | bin, k0 = t16 << 16, k1 = (t16 + 1u) << 16;
                rinfo[64 + row] = t16; rinfo[96 + row] = need1 - above;
                rinfo[224 + row] = (k0 & 0x80000000u) ? (k0 ^ 0x80000000u) : ~k0; rinfo[256 + row] = (t16 == 0xffffu) ? 0x7fc00000u : ((k1 & 0x80000000u) ? (k1 ^ 0x80000000u) : ~k1); } }
        __syncthreads();
        if (stop == 2) return;
        idx_pass<3>(kic, rowbase, qt, qimg, wj, hist, mask, cmask, cand, rinfo, wave, lane);
        __syncthreads();
        if (stop == 3) return;
#pragma unroll 1
        for (int rr = 0; rr < 4; ++rr) { const int row = wave * 4 + rr; const unsigned call = rinfo[128 + row], need2 = rinfo[96 + row];
            if (call <= 64u) { const unsigned c = call;
                const unsigned long long mine = cand[row * 64 + lane]; unsigned rank = 0u;
                for (unsigned k = 0; k < c; ++k) rank += (cand[row * 64 + k] > mine) ? 1u : 0u;
                if ((unsigned)lane < c && rank < need2) { const unsigned s = ~(unsigned)mine;
                    __hip_atomic_fetch_or(mask + row * HS + (s >> 5), 1u << (s & 31), __ATOMIC_RELAXED, __HIP_MEMORY_SCOPE_WORKGROUP); } }
            else { unsigned w4[4];
#pragma unroll
                for (int k = 0; k < 4; ++k) w4[k] = cmask[row * HS + 4 * lane + k];
                const unsigned cnt = __popc(w4[0]) + __popc(w4[1]) + __popc(w4[2]) + __popc(w4[3]);
                unsigned x = cnt;
#pragma unroll
                for (int o = 1; o < 64; o <<= 1) { const unsigned y = __shfl_up(x, o); if (lane >= o) x += y; }
                unsigned before = x - cnt;
#pragma unroll
                for (int k = 0; k < 4; ++k) { unsigned w = w4[k]; const unsigned pc = __popc(w); unsigned take = 0u;
                    if (before < need2) { if (before + pc <= need2) take = w; else { unsigned left = need2 - before; while (left) { const unsigned b = w & (0u - w); take |= b; w ^= b; --left; } } }
                    before += pc;
                    if (take) mask[row * HS + 4 * lane + k] |= take; } }
        }
    }
    __syncthreads();
#pragma unroll 1
    for (int rr = 0; rr < 4; ++rr) { const int row = wave * 4 + rr; unsigned short* out = sel + (size_t)(rowbase + t0 + row) * 256;
        unsigned w4[4];
#pragma unroll
        for (int k = 0; k < 4; ++k) w4[k] = mask[row * HS + 4 * lane + k];
        const unsigned cnt = __popc(w4[0]) + __popc(w4[1]) + __popc(w4[2]) + __popc(w4[3]);
        unsigned x = cnt;
#pragma unroll
        for (int o = 1; o < 64; o <<= 1) { const unsigned y = __shfl_up(x, o); if (lane >= o) x += y; }
        const unsigned total = __shfl(x, 63); unsigned pos = x - cnt;
#pragma unroll
        for (int k = 0; k < 4; ++k) { unsigned w = w4[k]; const unsigned base = (unsigned)(4 * lane + k) * 32u;
            while (w) { const unsigned bit = __builtin_ctz(w); if (pos < 256u) out[pos] = (unsigned short)(base + bit); ++pos; w &= w - 1u; } }
        for (unsigned i = total + lane; i < 256u; i += 64u) out[i] = (unsigned short)0xffffu; }
}

struct AttSt { float m, l; f32x16 o0, o1; };
template <class BF> DI void att_subtile(AttSt& S, const bf16x8 (&qf)[4], LAS const char* Kst, LAS const char* Vb, int vdh, int vrow0, int lane, const BF& bias) {
    const int r32 = lane & 31, hi = lane >> 5;
    f32x16 p;
#pragma unroll
    for (int r = 0; r < 16; ++r) p[r] = bias.b(crow(r, hi)) - S.m;
    LAS const char* kp = Kst + hi * 512 + r32 * 16;
#pragma unroll
    for (int s = 0; s < 4; ++s) { const bf16x8 kf = *(LAS const bf16x8*)(kp + s * 1024); p = mfma32(kf, qf[s], p); }
    if (bias.any) {
#pragma unroll
        for (int r = 0; r < 16; ++r) p[r] = bias.msk(crow(r, hi)) ? -INFINITY : p[r]; }
    float mxa[4] = {-INFINITY, -INFINITY, -INFINITY, -INFINITY};
#pragma unroll
    for (int r = 0; r < 16; ++r) mxa[r & 3] = fmaxf(mxa[r & 3], p[r]);
    float mx = fmaxf(fmaxf(mxa[0], mxa[1]), fmaxf(mxa[2], mxa[3]));
    mx = fmaxf(mx, __shfl_xor(mx, 32));
    if (__any(mx > 16.f)) { const float dl = fmaxf(mx, 0.f), sc = ex2(-dl); S.m += dl; S.l *= sc;
#pragma unroll
        for (int r = 0; r < 16; ++r) { p[r] -= dl; S.o0[r] *= sc; S.o1[r] *= sc; } }
    float psa[4] = {0.f, 0.f, 0.f, 0.f};
#pragma unroll
    for (int r = 0; r < 16; ++r) { p[r] = ex2(p[r]); psa[r & 3] += p[r]; }
    S.l += (psa[0] + psa[1]) + (psa[2] + psa[3]);
    v4u pw0, pw1;
    pw0.x = cvtpk(p[0], p[1]); pw0.y = cvtpk(p[2], p[3]); pw0.z = cvtpk(p[4], p[5]); pw0.w = cvtpk(p[6], p[7]);
    pw1.x = cvtpk(p[8], p[9]); pw1.y = cvtpk(p[10], p[11]); pw1.z = cvtpk(p[12], p[13]); pw1.w = cvtpk(p[14], p[15]);
    const bf16x8 pf0 = __builtin_bit_cast(bf16x8, pw0), pf1 = __builtin_bit_cast(bf16x8, pw1);
    LAS const char* vp = Vb + (vrow0 + 4 * hi + ((lane & 15) >> 2)) * 64 + ((lane >> 4) & 1) * 32 + (lane & 3) * 8;
    { const bf16x8 v00 = cat8(vtr(vp), vtr(vp + 512)), v10 = cat8(vtr(vp + vdh), vtr(vp + vdh + 512));
      const bf16x8 v01 = cat8(vtr(vp + 1024), vtr(vp + 1536)), v11 = cat8(vtr(vp + vdh + 1024), vtr(vp + vdh + 1536));
      S.o0 = mfma32(v00, pf0, S.o0); S.o1 = mfma32(v10, pf0, S.o1);
      S.o0 = mfma32(v01, pf1, S.o0); S.o1 = mfma32(v11, pf1, S.o1); }
}
template <class BF0, class BF1> DI void att_tile64(AttSt& S, const bf16x8 (&qf)[4], LAS const char* Kst, LAS const char* Vb, int vdh, int vrow0, int lane, const BF0& bias0, const BF1& bias1) {
    const int r32 = lane & 31, hi = lane >> 5;
    f32x16 p0, p1;
#pragma unroll
    for (int r = 0; r < 16; ++r) { p0[r] = bias0.b(crow(r, hi)) - S.m; p1[r] = bias1.b(crow(r, hi)) - S.m; }
    LAS const char* kp = Kst + hi * 512 + r32 * 16;
#pragma unroll
    for (int s = 0; s < 4; ++s) { const bf16x8 k0 = *(LAS const bf16x8*)(kp + s * 1024), k1 = *(LAS const bf16x8*)(kp + 4096 + s * 1024); p0 = mfma32(k0, qf[s], p0); p1 = mfma32(k1, qf[s], p1); }
    if (bias0.any) {
#pragma unroll
        for (int r = 0; r < 16; ++r) p0[r] = bias0.msk(crow(r, hi)) ? -INFINITY : p0[r]; }
    if (bias1.any) {
#pragma unroll
        for (int r = 0; r < 16; ++r) p1[r] = bias1.msk(crow(r, hi)) ? -INFINITY : p1[r]; }
    float mxa[4] = {-INFINITY, -INFINITY, -INFINITY, -INFINITY};
#pragma unroll
    for (int r = 0; r < 16; ++r) mxa[r & 3] = fmaxf(mxa[r & 3], fmaxf(p0[r], p1[r]));
    float mx = fmaxf(fmaxf(mxa[0], mxa[1]), fmaxf(mxa[2], mxa[3]));
    mx = fmaxf(mx, __shfl_xor(mx, 32));
    if (__any(mx > 16.f)) { const float dl = fmaxf(mx, 0.f), sc = ex2(-dl); S.m += dl; S.l *= sc;
#pragma unroll
        for (int r = 0; r < 16; ++r) { p0[r] -= dl; p1[r] -= dl; S.o0[r] *= sc; S.o1[r] *= sc; } }
    float psa[4] = {0.f, 0.f, 0.f, 0.f};
#pragma unroll
    for (int r = 0; r < 16; ++r) { p0[r] = ex2(p0[r]); p1[r] = ex2(p1[r]); psa[r & 3] += p0[r] + p1[r]; }
    S.l += (psa[0] + psa[1]) + (psa[2] + psa[3]);
    v4u a0, a1, b0, b1;
    a0.x = cvtpk(p0[0], p0[1]); a0.y = cvtpk(p0[2], p0[3]); a0.z = cvtpk(p0[4], p0[5]); a0.w = cvtpk(p0[6], p0[7]);
    a1.x = cvtpk(p0[8], p0[9]); a1.y = cvtpk(p0[10], p0[11]); a1.z = cvtpk(p0[12], p0[13]); a1.w = cvtpk(p0[14], p0[15]);
    b0.x = cvtpk(p1[0], p1[1]); b0.y = cvtpk(p1[2], p1[3]); b0.z = cvtpk(p1[4], p1[5]); b0.w = cvtpk(p1[6], p1[7]);
    b1.x = cvtpk(p1[8], p1[9]); b1.y = cvtpk(p1[10], p1[11]); b1.z = cvtpk(p1[12], p1[13]); b1.w = cvtpk(p1[14], p1[15]);
    LAS const char* vp = Vb + (vrow0 + 4 * hi + ((lane & 15) >> 2)) * 64 + ((lane >> 4) & 1) * 32 + (lane & 3) * 8;
#pragma unroll
    for (int k16 = 0; k16 < 4; ++k16) { const bf16x8 pf = __builtin_bit_cast(bf16x8, k16 == 0 ? a0 : k16 == 1 ? a1 : k16 == 2 ? b0 : b1);
        const bf16x8 v0 = cat8(vtr(vp + k16 * 1024), vtr(vp + k16 * 1024 + 512)), v1 = cat8(vtr(vp + vdh + k16 * 1024), vtr(vp + vdh + k16 * 1024 + 512));
        S.o0 = mfma32(v0, pf, S.o0); S.o1 = mfma32(v1, pf, S.o1); }
}

struct MobaFar { float c; bool any; DI float b(int) const { return c; } DI bool msk(int) const { return false; } };
struct MobaBias { LAS const float* lut; int tq, s0; bool any;
    DI float b(int kvrel) const { const int dist = tq - (s0 + kvrel); return lut[dist < 0 ? 0 : (dist > 1023 ? 1023 : dist)]; }
    DI bool msk(int kvrel) const { return tq - (s0 + kvrel) < 0; } };
DI void moba_qload(bf16x8 (&qf)[4], const bf16* proj, int rowbase, int h, int tq, int hi) {
    const bf16* qp = proj + (size_t)(rowbase + tq) * EV_N + EC_QB + h * 64 + hi * 8;
#pragma unroll
    for (int s = 0; s < 4; ++s) qf[s] = *(const bf16x8*)(qp + s * 16);
}
DI void moba_tile(const Fr& F, const bf16x8 (&qf)[4], int rowbase, int h, int n, int tq, bool valid, int slot, bool own, int wave_tile) {
    LAS const char* Kb = (LAS const char*)F.lds; LAS const char* Vb = (LAS const char*)(F.lds + 32768); LAS const float* lut = (LAS const float*)(F.lds + 98304);
    bf16* po = (bf16*)(F.ws + WS_ACT); float* pml = (float*)(F.ws + WS_PML);
    const int lane = F.lane, hi = lane >> 5;
    AttSt S; S.m = 0.f; S.l = 0.f;
#pragma unroll
    for (int r = 0; r < 16; ++r) { S.o0[r] = 0.f; S.o1[r] = 0.f; }
    const int nst = own ? wave_tile + 1 : 8;
    int tmin = tq;
#pragma unroll
    for (int o = 1; o < 64; o <<= 1) { const int y = __shfl_xor(tmin, o); tmin = y < tmin ? y : tmin; }
    const float cfar = lut[1023];
    int st = 0;
    for (; st + 1 < nst; st += 2) {
        if (!own && tmin - (n * 256 + st * 32 + 63) >= 790) { MobaFar bf{cfar, false}; att_tile64(S, qf, Kb + st * 4096, Vb, 16384, st * 32, lane, bf, bf); }
        else { MobaBias bf0{lut, tq, n * 256 + st * 32, false}, bf1{lut, tq, n * 256 + st * 32 + 32, own && st + 1 == wave_tile}; att_tile64(S, qf, Kb + st * 4096, Vb, 16384, st * 32, lane, bf0, bf1); } }
    if (st < nst) { MobaBias bf{lut, tq, n * 256 + st * 32, own && st == wave_tile}; att_subtile(S, qf, Kb + st * 4096, Vb, 16384, st * 32, lane, bf); }
    const float lt = S.l + __shfl_xor(S.l, 32), inv = 1.f / lt;
    if (valid) { const size_t pi = ((size_t)(rowbase + tq) * 8 + h) * 4 + slot; bf16* o = po + pi * 64;
#pragma unroll
        for (int a4 = 0; a4 < 4; ++a4) { v2u w0, w1;
            w0.x = cvtpk(S.o0[4 * a4] * inv, S.o0[4 * a4 + 1] * inv); w0.y = cvtpk(S.o0[4 * a4 + 2] * inv, S.o0[4 * a4 + 3] * inv);
            w1.x = cvtpk(S.o1[4 * a4] * inv, S.o1[4 * a4 + 1] * inv); w1.y = cvtpk(S.o1[4 * a4 + 2] * inv, S.o1[4 * a4 + 3] * inv);
            *(v2u*)(o + 8 * a4 + 4 * hi) = w0; *(v2u*)(o + 32 + 8 * a4 + 4 * hi) = w1; }
        if (hi == 0) { f32x2 ml = {S.m, lt}; *(f32x2*)(pml + pi * 2) = ml; } }
}
DI void moba_unit(const Args& a, const Fr& F, int b, int h, int n) {
    const bf16* proj = (const bf16*)(F.ws + WS_PROJ); const unsigned* sel3 = (const unsigned*)(F.ws + WS_SEL3);
    LAS unsigned char* lds = F.lds; LAS unsigned* list = (LAS unsigned*)(lds + 65536); LAS float* lut = (LAS float*)(lds + 98304); LAS unsigned* misc = (LAS unsigned*)(lds + 102400);
    const int tid = F.tid, lane = F.lane, wave = F.wave, rowbase = b * SEQ;
    __syncthreads();
    { const bf16* kg = proj + (size_t)(rowbase + n * 256) * EV_N + EC_KB + h * 64; const bf16* vg = proj + (size_t)(rowbase + n * 256) * EV_N + EC_VB + h * 64;
#pragma unroll
        for (int i = 0; i < 4; ++i) { const int p = tid + i * NTHR;
            { const int r = p & 31, c = (p >> 5) & 7, st = p >> 8; const v4u v = *(const v4u*)(kg + (size_t)(st * 32 + r) * EV_N + c * 8); *(LAS v4u*)(lds + st * 4096 + c * 512 + r * 16) = v; }
            { const int cc = p & 3, row = (p >> 2) & 255, dh = p >> 10; const v4u v = *(const v4u*)(vg + (size_t)row * EV_N + dh * 32 + cc * 8); *(LAS v4u*)(lds + 32768 + dh * 16384 + row * 64 + cc * 16) = v; } }
        for (int d = tid; d < 1024; d += NTHR) lut[d] = a.in[9][t5_bucket(d) * 16 + 8 + h] * LOG2E; }
    if (tid == 0) misc[16] = 0u;
    __syncthreads();
    unsigned sv[16];
#pragma unroll
    for (int k = 0; k < 16; ++k) { const int t = (n + 1) * 256 + k * NTHR + tid; sv[k] = t < SEQ ? sel3[(size_t)(rowbase + t) * 8 + h] : 0u; }
#pragma unroll
    for (int k = 0; k < 16; ++k) { const int tb = (n + 1) * 256 + k * NTHR; if (tb < SEQ) { const int t = tb + tid;
        const unsigned s = sv[k]; const unsigned nv = s >> 24; int slot = -1;
        if (nv > 0u && (s & 255u) == (unsigned)n) slot = 0; else if (nv > 1u && ((s >> 8) & 255u) == (unsigned)n) slot = 1; else if (nv > 2u && ((s >> 16) & 255u) == (unsigned)n) slot = 2;
        const unsigned long long bal = __ballot(slot >= 0); const unsigned wcnt = __popcll(bal);
        if (lane == 0) misc[wave] = wcnt;
        __syncthreads();
        unsigned off = misc[16], tot = 0u;
#pragma unroll
        for (int w = 0; w < 8; ++w) { const unsigned c = misc[w]; if (w < wave) off += c; tot += c; }
        if (slot >= 0) list[off + __popcll(bal & ((1ull << lane) - 1ull))] = ((unsigned)t << 2) | (unsigned)slot;
        __syncthreads();
        if (tid == 0) misc[16] += tot; } }
    __syncthreads();
    const int nlist = (int)misc[16];
    const int ntl = (nlist + 31) >> 5, hi = lane >> 5;
    bf16x8 qa[4], qb2[4];
    moba_qload(qa, proj, rowbase, h, n * 256 + wave * 32 + (lane & 31), hi);
    unsigned ea = 0u, eb = 0u; bool va = false, vb = false;
    int tl = wave;
    if (tl < ntl) { const int li = tl * 32 + (lane & 31); vb = li < nlist; eb = list[vb ? li : nlist - 1]; moba_qload(qb2, proj, rowbase, h, (int)(eb >> 2), hi); }
    moba_tile(F, qa, rowbase, h, n, n * 256 + wave * 32 + (lane & 31), true, 3, true, wave);
    for (; tl < ntl; tl += 16) {
        const int t2 = tl + 8, t3 = tl + 16;
        if (t2 < ntl) { const int li = t2 * 32 + (lane & 31); va = li < nlist; ea = list[va ? li : nlist - 1]; moba_qload(qa, proj, rowbase, h, (int)(ea >> 2), hi); }
        moba_tile(F, qb2, rowbase, h, n, (int)(eb >> 2), vb, (int)(eb & 3u), false, 0);
        if (t2 < ntl) {
            if (t3 < ntl) { const int li = t3 * 32 + (lane & 31); vb = li < nlist; eb = list[vb ? li : nlist - 1]; moba_qload(qb2, proj, rowbase, h, (int)(eb >> 2), hi); }
            moba_tile(F, qa, rowbase, h, n, (int)(ea >> 2), va, (int)(ea & 3u), false, 0); }
    }
}

DI void dsa_step(const bf16x8 (&af)[2][4], const bf16x8 (&qlf)[4], int ch, LAS const unsigned char* bsel, LAS unsigned char* cbuf, LAS const float* tab,
                 float& m, float& l, f32x4 (&oT)[8], int l15, int kg, int lane) {
    f32x4 acc[2];
#pragma unroll
    for (int mt = 0; mt < 2; ++mt) { const unsigned b4 = *(LAS const unsigned*)(bsel + ch * 32 + mt * 16 + 4 * kg);
#pragma unroll
        for (int i = 0; i < 4; ++i) { const unsigned bb = (b4 >> (8 * i)) & 255u; const float tb = tab[(bb & 31u) * 8 + (l15 & 7)];
            acc[mt][i] = (tb - m) + (bb != 255u ? 0.f : -INFINITY); } }
#pragma unroll
    for (int mt = 0; mt < 2; ++mt)
#pragma unroll
        for (int ks = 0; ks < 4; ++ks) { acc[mt] = mfma16(af[mt][ks], qlf[ks], acc[mt]); *(LAS bf16x8*)(cbuf + (mt * 16 + l15) * 288 + (ks * 32 + kg * 8) * 2) = af[mt][ks]; }
    float mx = fmaxf(fmaxf(fmaxf(acc[0][0], acc[0][1]), fmaxf(acc[0][2], acc[0][3])), fmaxf(fmaxf(acc[1][0], acc[1][1]), fmaxf(acc[1][2], acc[1][3])));
    mx = fmaxf(mx, __shfl_xor(mx, 16)); mx = fmaxf(mx, __shfl_xor(mx, 32));
    if (__any(mx > 16.f)) { const float dl = fmaxf(mx, 0.f), sc = ex2(-dl); m += dl; l *= sc;
#pragma unroll
        for (int mt = 0; mt < 2; ++mt) acc[mt] = acc[mt] - dl;
#pragma unroll
        for (int ct = 0; ct < 8; ++ct) oT[ct] = oT[ct] * sc; }
    float ps = 0.f;
#pragma unroll
    for (int mt = 0; mt < 2; ++mt)
#pragma unroll
        for (int i = 0; i < 4; ++i) { acc[mt][i] = ex2(acc[mt][i]); ps += acc[mt][i]; }
    l += ps;
    v4u pw; pw.x = cvtpk(acc[0][0], acc[0][1]); pw.y = cvtpk(acc[0][2], acc[0][3]); pw.z = cvtpk(acc[1][0], acc[1][1]); pw.w = cvtpk(acc[1][2], acc[1][3]);
    const bf16x8 pf = __builtin_bit_cast(bf16x8, pw);
    LDS_WAIT();
    LAS const char* tp = (LAS const char*)cbuf + (4 * kg + (l15 >> 2)) * 288 + (lane & 3) * 8;
#pragma unroll
    for (int ct = 0; ct < 8; ++ct) { const bf16x8 cf = cat8(vtr(tp + ct * 32), vtr(tp + 16 * 288 + ct * 32)); oT[ct] = mfma16(cf, pf, oT[ct]); }
    LDS_WAIT();
}
DI void dsa_gather(bf16x8 (&af)[2][4], const bf16* ckvn, int rowbase, LAS const unsigned short* selb, int ch, int l15, int kg) {
#pragma unroll
    for (int mt = 0; mt < 2; ++mt) { unsigned idx = selb[ch * 32 + mt * 16 + l15]; if (idx == 0xffffu) idx = 0u;
        const bf16* cp = ckvn + (size_t)(rowbase + (int)idx) * 128 + kg * 8;
#pragma unroll
        for (int ks = 0; ks < 4; ++ks) af[mt][ks] = *(const bf16x8*)(cp + ks * 32); }
}
DI void dsa_query(const Fr& F, int tok, const v2u sv, LAS unsigned char* wl, LAS const unsigned char* bkt, LAS const float* tab) {
    const bf16* ql = (const bf16*)(F.ws + WS_QL); const bf16* ckvn = (const bf16*)(F.ws + WS_CKVN); const unsigned short* sel = (const unsigned short*)(F.ws + WS_SEL); bf16* ol = (bf16*)(F.ws + WS_OL);
    const int lane = F.lane, l15 = lane & 15, kg = lane >> 4, t = tok % SEQ, rowbase = tok - t;
    LAS unsigned short* selb = (LAS unsigned short*)wl; LAS unsigned char* bsel = wl + 512; LAS unsigned char* cbuf = wl + 1024;
    { *((LAS v2u*)selb + lane) = sv; unsigned bw = 0u;
#pragma unroll
        for (int i = 0; i < 4; ++i) { const unsigned s = (i < 2 ? (sv.x >> (16 * i)) : (sv.y >> (16 * (i - 2)))) & 0xffffu; const int dist = t - (int)s;
            const unsigned bb = (s != 0xffffu && dist >= 0) ? (unsigned)bkt[dist > 1023 ? 1023 : dist] : 255u; bw |= bb << (8 * i); }
        *((LAS unsigned*)bsel + lane) = bw; }
    bf16x8 qlf[4];
#pragma unroll
    for (int ks = 0; ks < 4; ++ks) { qlf[ks] = *(const bf16x8*)(ql + (size_t)tok * 1024 + (l15 & 7) * 128 + ks * 32 + kg * 8); if (l15 >= 8) qlf[ks] = (bf16x8){0, 0, 0, 0, 0, 0, 0, 0}; }
    float m = 0.f, l = 0.f; f32x4 oT[8];
#pragma unroll
    for (int ct = 0; ct < 8; ++ct) oT[ct] = (f32x4){0.f, 0.f, 0.f, 0.f};
    const int nvalid = t + 1 < 256 ? t + 1 : 256, nch = (nvalid + 31) >> 5;
    LDS_WAIT();
    bf16x8 afa[2][4], afb[2][4], afc[2][4];
    dsa_gather(afa, ckvn, rowbase, selb, 0, l15, kg);
    if (nch > 1) dsa_gather(afb, ckvn, rowbase, selb, 1, l15, kg);
    for (int ch = 0; ch < nch; ch += 3) {
        if (ch + 2 < nch) dsa_gather(afc, ckvn, rowbase, selb, ch + 2, l15, kg);
        dsa_step(afa, qlf, ch, bsel, cbuf, tab, m, l, oT, l15, kg, lane);
        if (ch + 1 < nch) { if (ch + 3 < nch) dsa_gather(afa, ckvn, rowbase, selb, ch + 3, l15, kg);
            dsa_step(afb, qlf, ch + 1, bsel, cbuf, tab, m, l, oT, l15, kg, lane); }
        if (ch + 2 < nch) { if (ch + 4 < nch) dsa_gather(afb, ckvn, rowbase, selb, ch + 4, l15, kg);
            dsa_step(afc, qlf, ch + 2, bsel, cbuf, tab, m, l, oT, l15, kg, lane); }
    }
    l += __shfl_xor(l, 16); l += __shfl_xor(l, 32);
    const float inv = 1.f / l;
    if (l15 < 8) { bf16* o = ol + (size_t)tok * 1024 + l15 * 128 + 4 * kg;
#pragma unroll
        for (int ct = 0; ct < 8; ++ct) { v2u w; w.x = cvtpk(oT[ct][0] * inv, oT[ct][1] * inv); w.y = cvtpk(oT[ct][2] * inv, oT[ct][3] * inv); *(v2u*)(o + ct * 16) = w; } }
}
DI void dsa_chunk(const Args& a, const Fr& F, int c32) {
    LAS unsigned char* bkt = F.lds + 81920; LAS float* tab = (LAS float*)(F.lds + 82944);
    __syncthreads();
    for (int d = F.tid; d < 1024; d += NTHR) bkt[d] = (unsigned char)t5_bucket(d);
    if (F.tid < 256) tab[F.tid] = a.in[9][(F.tid >> 3) * 16 + (F.tid & 7)] * LOG2E;
    __syncthreads();
    const unsigned short* selg = (const unsigned short*)(F.ws + WS_SEL); v2u svq[4];
#pragma unroll
    for (int i = 0; i < 4; ++i) svq[i] = *((const v2u*)(selg + (size_t)(c32 * 32 + F.wave * 4 + i) * 256) + F.lane);
#pragma unroll
    for (int i = 0; i < 4; ++i) dsa_query(F, c32 * 32 + F.wave * 4 + i, svq[i], F.lds + F.wave * 10240, bkt, tab);
}

DI void ph_even_post(const Fr& F, int j) {
    const bf16* ol = (const bf16*)(F.ws + WS_OL); bf16* ao = (bf16*)(F.ws + WS_AO);
    const bf16* wuvt = (const bf16*)(F.ws + WS_WUVT) + (size_t)j * 8 * 64 * 128;
    const bf16* po = (const bf16*)(F.ws + WS_ACT); const float* pml = (const float*)(F.ws + WS_PML); const unsigned* sel3 = (const unsigned*)(F.ws + WS_SEL3);
    const int lane = F.lane, wave = F.wave, l15 = lane & 15, kg = lane >> 4;
    for (int chunk = F.blk; chunk < 256; chunk += F.G) { const int tok0 = chunk * 128;
        { const int h = wave; bf16x8 af[4][4];
#pragma unroll
            for (int mt = 0; mt < 4; ++mt)
#pragma unroll
                for (int ks = 0; ks < 4; ++ks) af[mt][ks] = *(const bf16x8*)(wuvt + ((size_t)h * 64 + mt * 16 + l15) * 128 + ks * 32 + kg * 8);
#pragma unroll 1
            for (int tg = 0; tg < 8; tg += 2) { bf16x8 bf[2][4];
#pragma unroll
                for (int u = 0; u < 2; ++u)
#pragma unroll
                    for (int ks = 0; ks < 4; ++ks) bf[u][ks] = *(const bf16x8*)(ol + (size_t)(tok0 + (tg + u) * 16 + l15) * 1024 + h * 128 + ks * 32 + kg * 8);
#pragma unroll
                for (int u = 0; u < 2; ++u) { const int tok = tok0 + (tg + u) * 16 + l15;
#pragma unroll
                    for (int mt = 0; mt < 4; ++mt) { f32x4 d = {0.f, 0.f, 0.f, 0.f};
#pragma unroll
                        for (int ks = 0; ks < 4; ++ks) d = mfma16(af[mt][ks], bf[u][ks], d);
                        v2u w; w.x = cvtpk(d[0], d[1]); w.y = cvtpk(d[2], d[3]); *(v2u*)(ao + (size_t)tok * 1024 + h * 64 + mt * 16 + 4 * kg) = w; } } } }
#pragma unroll 1
        for (int i0 = 0; i0 < 16; i0 += 4) { const int h = lane >> 3, d0 = (lane & 7) * 8; unsigned nvv[4]; f32x2 mlv[4][4];
#pragma unroll
            for (int i = 0; i < 4; ++i) { const int tok = tok0 + wave * 16 + i0 + i; const size_t pi = ((size_t)tok * 8 + h) * 4; nvv[i] = sel3[(size_t)tok * 8 + h] >> 24;
#pragma unroll
                for (int s = 0; s < 4; ++s) mlv[i][s] = *(const f32x2*)(pml + (pi + s) * 2); }
#pragma unroll
            for (int i = 0; i < 4; ++i) { const int tok = tok0 + wave * 16 + i0 + i; const size_t pi = ((size_t)tok * 8 + h) * 4;
                float mj[4], lj[4];
#pragma unroll
                for (int s = 0; s < 4; ++s) { const bool ok = (s == 3) || ((unsigned)s < nvv[i]); mj[s] = ok ? mlv[i][s][0] : -1e30f; lj[s] = ok ? mlv[i][s][1] : 0.f; }
                const float ms = fmaxf(fmaxf(mj[0], mj[1]), fmaxf(mj[2], mj[3])); float wsum = 0.f, acc[8], wv[4]; v4u pv[4];
#pragma unroll
                for (int k = 0; k < 8; ++k) acc[k] = 0.f;
#pragma unroll
                for (int s = 0; s < 4; ++s) { wv[s] = lj[s] * ex2(mj[s] - ms); wsum += wv[s]; pv[s] = (v4u){0u, 0u, 0u, 0u}; if (wv[s] > 0.f) pv[s] = *(const v4u*)(po + (pi + s) * 64 + d0); }
#pragma unroll
                for (int s = 0; s < 4; ++s) { if (wv[s] > 0.f) {
#pragma unroll
                    for (int k = 0; k < 4; ++k) { acc[2 * k] += wv[s] * bf2f(pv[s][k] & 0xffffu); acc[2 * k + 1] += wv[s] * bf2f(pv[s][k] >> 16); } } }
                const float inv = 1.f / wsum; v4u o; o.x = cvtpk(acc[0] * inv, acc[1] * inv); o.y = cvtpk(acc[2] * inv, acc[3] * inv); o.z = cvtpk(acc[4] * inv, acc[5] * inv); o.w = cvtpk(acc[6] * inv, acc[7] * inv);
                *(v4u*)(ao + (size_t)tok * 1024 + 512 + h * 64 + d0) = o; } }
    }
}
DI f32x16 proj32_f32(const float* W, int ldw, int ncols, const float* xrow, int d_lo, int lane) {
    const int e = lane & 31, kh = lane >> 5; const bool ev = e < ncols;
    f32x16 D;
#pragma unroll
    for (int r = 0; r < 16; ++r) D[r] = 0.f;
    const float* wp = W + (size_t)(d_lo + 4 * kh) * ldw + (ev ? e : 0);
    const float* xp = xrow + d_lo + 4 * kh;
#pragma unroll 8
    for (int i = 0; i < 64; ++i) { const f32x4 xv = *(const f32x4*)(xp + 8 * i);
        float a0 = wp[(size_t)(8 * i + 0) * ldw], a1 = wp[(size_t)(8 * i + 1) * ldw], a2 = wp[(size_t)(8 * i + 2) * ldw], a3 = wp[(size_t)(8 * i + 3) * ldw];
        if (!ev) { a0 = 0.f; a1 = 0.f; a2 = 0.f; a3 = 0.f; }
        D = __builtin_amdgcn_mfma_f32_32x32x2f32(a0, xv[0], D, 0, 0, 0); D = __builtin_amdgcn_mfma_f32_32x32x2f32(a1, xv[1], D, 0, 0, 0);
        D = __builtin_amdgcn_mfma_f32_32x32x2f32(a2, xv[2], D, 0, 0, 0); D = __builtin_amdgcn_mfma_f32_32x32x2f32(a3, xv[3], D, 0, 0, 0); }
    return D;
}
DI void ph_odd_prep(const Args& a, const Fr& F, int j, int layer) {
    const bf16* proj = (const bf16*)(F.ws + WS_PROJ); const float* x = (const float*)(F.ws + WS_X);
    float* logf = (float*)(F.ws + WS_LOGF); float* cs = (float*)(F.ws + WS_CS);
    const float* wf = a.in[6] + (size_t)j * 1024 * 3088 + 3072; const float* bfv = a.in[7] + j * 16;
    LAS float* red = (LAS float*)(F.lds); LAS float* lfb = (LAS float*)(F.lds + 131072);
    LAS unsigned* kmx = (LAS unsigned*)(F.lds + 131072 + 8192);
    const int lane = F.lane, wave = F.wave, tid = F.tid, l31 = lane & 31, hi = lane >> 5;
    for (int chunk = F.blk; chunk < 256; chunk += F.G) { const int tok0 = chunk * 128, b = tok0 / SEQ, t0 = tok0 % SEQ;
        __syncthreads();
        if (tid < 16) kmx[tid] = 0u;
        const int tl = wave & 3, kr = wave >> 2;
        f32x16 D = proj32_f32(wf, 3088, 16, x + (size_t)(tok0 + tl * 32 + l31) * DM, kr * 512, lane);
        if (kr == 1) {
#pragma unroll
            for (int r = 0; r < 8; ++r) red[(tl * 8 + r) * 64 + lane] = D[r]; }
        __syncthreads();
        if (kr == 0) {
#pragma unroll
            for (int r = 0; r < 8; ++r) { const int h = (r & 3) + 8 * (r >> 2) + 4 * hi; const float z = D[r] + red[(tl * 8 + r) * 64 + lane] + bfv[h];
                const float ls = fminf(z, 0.f) - log1pf(__expf(-fabsf(z)));
                lfb[(tl * 32 + l31) * 16 + h] = ls * LOG2E; } }
#pragma unroll 1
        for (int i = 0; i < 4; ++i) { const int p = tid + i * NTHR, tk = p >> 4, h = p & 15; const v4u* kp = (const v4u*)(proj + (size_t)(tok0 + tk) * OD_N + OC_K + h * 64); float s = 0.f;
#pragma unroll
            for (int c = 0; c < 8; ++c) { const v4u w = kp[c];
#pragma unroll
                for (int k = 0; k < 4; ++k) { const float e0 = bf2f(w[k] & 0xffffu), e1 = bf2f(w[k] >> 16); s += e0 * e0 + e1 * e1; } }
            __hip_atomic_fetch_max(kmx + h, __float_as_uint(s), __ATOMIC_RELAXED, __HIP_MEMORY_SCOPE_WORKGROUP); }
        __syncthreads();
        for (int i = tid; i < 2048; i += NTHR) { const int h = i >> 7, tk = i & 127; logf[((size_t)b * 16 + h) * SEQ + t0 + tk] = lfb[tk * 16 + h]; }
        if (tid < 32) { const int h = tid & 15, c = tid >> 4; float s = 0.f;
            for (int k = 0; k < 64; ++k) s += lfb[(c * 64 + k) * 16 + h];
            cs[((size_t)b * 16 + h) * 128 + (t0 >> 6) + c] = s; }
        if (tid < 16) __hip_atomic_fetch_max(F.ctl + CW_KMAX + layer * 64 + b * 16 + tid, kmx[tid], RLX_AGENT);
    }
}

constexpr float FOX_SKIP_LOG2 = 64.f;
struct FoxBias { LAS const float* ng; int tq, kabs0; bool any;
    DI float b(int kvrel) const { return ng[kvrel]; }
    DI bool msk(int kvrel) const { return (kabs0 + kvrel) > tq; } };
DI void fox_unit(const Fr& F, int layer, int b, int h, int qb) {
    const bf16* proj = (const bf16*)(F.ws + WS_PROJ); const float* logf = (const float*)(F.ws + WS_LOGF); const float* cs = (const float*)(F.ws + WS_CS); bf16* ao = (bf16*)(F.ws + WS_AO);
    LAS unsigned char* lds = F.lds; LAS float* ng = (LAS float*)(lds + 32768); LAS float* red = (LAS float*)(lds + 65536 + 1024); LAS int* ibox = (LAS int*)(lds + 65536 + 2048);
    const int tid = F.tid, lane = F.lane, wave = F.wave, r32 = lane & 31, hi = lane >> 5, t0 = qb * 256, rowbase = b * SEQ, tq = t0 + wave * 32 + r32;
    __syncthreads();
    bf16x8 qf[4]; float qs = 0.f;
    { const bf16* qp = proj + (size_t)(rowbase + tq) * OD_N + OC_Q + h * 64 + hi * 8;
#pragma unroll
        for (int s = 0; s < 4; ++s) { qf[s] = *(const bf16x8*)(qp + s * 16);
#pragma unroll
            for (int k = 0; k < 8; ++k) { const float e = bf2f((unsigned short)qf[s][k]); qs += e * e; } } }
    qs += __shfl_xor(qs, 32); qs = wave_max(qs);
    if (lane == 0) red[wave] = qs;
    if (tid < 128) red[32 + tid] = (tid < t0 / 64) ? cs[((size_t)b * 16 + h) * 128 + tid] : 0.f;
    __syncthreads();
    if (tid == 0) { float qm = red[0];
        for (int w = 1; w < 8; ++w) qm = fmaxf(qm, red[w]);
        const float km = __uint_as_float(ld_u32(F.ctl + CW_KMAX + layer * 64 + b * 16 + h));
        const float B2 = 2.f * (sqrtf(qm * km) * 1.01f + 1.f);
        int kt = t0 / 64 - 1, kts = t0 / 64; float D = 0.f;
        while (kt >= 0 && B2 + D >= -FOX_SKIP_LOG2) { kts = kt; D += red[32 + kt]; --kt; }
        ibox[0] = kts; }
    __syncthreads();
    const int kts = ibox[0], s_start = kts * 64, nel = t0 + 256 - s_start;
    { const int i0 = tid * 16; float v[16]; const float* lp = logf + ((size_t)b * 16 + h) * SEQ + s_start + i0;
        if (i0 < nel) {
#pragma unroll
            for (int c = 0; c < 4; ++c) { const f32x4 w = *(const f32x4*)(lp + 4 * c); v[4 * c] = w[0]; v[4 * c + 1] = w[1]; v[4 * c + 2] = w[2]; v[4 * c + 3] = w[3]; } }
        else {
#pragma unroll
            for (int c = 0; c < 16; ++c) v[c] = 0.f; }
#pragma unroll
        for (int c = 1; c < 16; ++c) v[c] += v[c - 1];
        float xsum = v[15];
#pragma unroll
        for (int o = 1; o < 64; o <<= 1) { const float y = __shfl_up(xsum, o); if (lane >= o) xsum += y; }
        if (lane == 63) red[16 + wave] = xsum;
        __syncthreads();
        float off = xsum - v[15];
        for (int w = 0; w < wave; ++w) off += red[16 + w];
        if (i0 < nel) {
#pragma unroll
            for (int c = 0; c < 4; ++c) { f32x4 w = {-(off + v[4 * c]), -(off + v[4 * c + 1]), -(off + v[4 * c + 2]), -(off + v[4 * c + 3])}; *(LAS f32x4*)(ng + i0 + 4 * c) = w; } }
    }
    const int ntile = t0 / 64 + 4 - kts;
    const bf16* kg = proj + (size_t)rowbase * OD_N + OC_K + h * 64; const bf16* vg = proj + (size_t)rowbase * OD_N + OC_V + h * 64;
    const int kr = tid & 31, kc = (tid >> 5) & 7, kst = tid >> 8, vcc = tid & 3, vrow = (tid >> 2) & 63, vdh = tid >> 8;
    const int koff = kst * 4096 + kc * 512 + kr * 16, voff = 8192 + vdh * 4096 + vrow * 64 + vcc * 16;
    { const v4u kv = *(const v4u*)(kg + (size_t)(kts * 64 + kst * 32 + kr) * OD_N + kc * 8), vv = *(const v4u*)(vg + (size_t)(kts * 64 + vrow) * OD_N + vdh * 32 + vcc * 8);
        *(LAS v4u*)(lds + koff) = kv; *(LAS v4u*)(lds + voff) = vv; }
    __syncthreads();
    AttSt S; S.m = 0.f; S.l = 0.f;
#pragma unroll
    for (int r = 0; r < 16; ++r) { S.o0[r] = 0.f; S.o1[r] = 0.f; }
    const int wlast = t0 + wave * 32 + 31, wfirst = t0 + wave * 32;
    for (int i = 0; i < ntile; ++i) { const int kt = kts + i; LAS unsigned char* buf = lds + (i & 1) * 16384; LAS unsigned char* nbuf = lds + ((i + 1) & 1) * 16384;
        v4u kv, vv; const bool more = i + 1 < ntile;
        if (more) { kv = *(const v4u*)(kg + (size_t)((kt + 1) * 64 + kst * 32 + kr) * OD_N + kc * 8); vv = *(const v4u*)(vg + (size_t)((kt + 1) * 64 + vrow) * OD_N + vdh * 32 + vcc * 8); }
        { const int kv0 = kt * 64;
            if (kv0 + 32 <= wlast) { FoxBias bf0{ng + (kv0 - s_start), tq, kv0, kv0 + 31 > wfirst}, bf1{ng + (kv0 + 32 - s_start), tq, kv0 + 32, kv0 + 63 > wfirst};
                att_tile64(S, qf, (LAS const char*)buf, (LAS const char*)buf + 8192, 4096, 0, lane, bf0, bf1); }
            else if (kv0 <= wlast) { FoxBias bf{ng + (kv0 - s_start), tq, kv0, kv0 + 31 > wfirst};
                att_subtile(S, qf, (LAS const char*)buf, (LAS const char*)buf + 8192, 4096, 0, lane, bf); } }
        if (more) { *(LAS v4u*)(nbuf + koff) = kv; *(LAS v4u*)(nbuf + voff - 8192 + 8192) = vv; }
        __syncthreads(); }
    const float lt = S.l + __shfl_xor(S.l, 32), inv = 1.f / lt;
    bf16* o = ao + (size_t)(rowbase + tq) * 1024 + h * 64;
#pragma unroll
    for (int a4 = 0; a4 < 4; ++a4) { v2u w0, w1;
        w0.x = cvtpk(S.o0[4 * a4] * inv, S.o0[4 * a4 + 1] * inv); w0.y = cvtpk(S.o0[4 * a4 + 2] * inv, S.o0[4 * a4 + 3] * inv);
        w1.x = cvtpk(S.o1[4 * a4] * inv, S.o1[4 * a4 + 1] * inv); w1.y = cvtpk(S.o1[4 * a4 + 2] * inv, S.o1[4 * a4 + 3] * inv);
        *(v2u*)(o + 8 * a4 + 4 * hi) = w0; *(v2u*)(o + 32 + 8 * a4 + 4 * hi) = w1; }
}

DI void ph_ln1_router(const Args& a, const Fr& F, int layer) {
    const bf16* yp = (const bf16*)(F.ws + WS_YP); float* x1 = (float*)(F.ws + WS_X1); unsigned char* xb8 = F.ws + WS_XB8;
    unsigned* tope = (unsigned*)(F.ws + WS_TOPE); float* gate = (float*)(F.ws + WS_GATE); unsigned* rank = (unsigned*)(F.ws + WS_RANK);
    const float* g = a.in[10] + (size_t)(layer * 2) * DM; const float* bb = a.in[11] + (size_t)(layer * 2) * DM;
    const float* rw = a.in[12] + (size_t)layer * 1024 * 32; const float* rb = a.in[13] + layer * 32;
    LAS float* red = (LAS float*)(F.lds); LAS unsigned* lcnt = (LAS unsigned*)(F.lds + 131072);
    const int lane = F.lane, wave = F.wave, tid = F.tid, l31 = lane & 31, hi = lane >> 5;
    for (int chunk = F.blk; chunk < 256; chunk += F.G) { const int tok0 = chunk * 128;
        __syncthreads();
        if (tid < 32) lcnt[tid] = 0u;
#pragma unroll 1
        for (int k = 0; k < 16; k += 8) { f32x4 v[8][4];
#pragma unroll
            for (int i = 0; i < 8; ++i)
#pragma unroll
                for (int jj = 0; jj < 4; ++jj) { const v2u w = *((const v2u*)(yp + (size_t)(tok0 + wave * 16 + k + i) * DM) + lane + 64 * jj);
                    v[i][jj] = (f32x4){bf2f(w.x & 0xffffu), bf2f(w.x >> 16), bf2f(w.y & 0xffffu), bf2f(w.y >> 16)}; }
#pragma unroll
            for (int i = 0; i < 8; ++i) { const int tok = tok0 + wave * 16 + k + i;
                ln_row(v[i], g, bb, lane);
                store_row_f32(x1 + (size_t)tok * DM, v[i], lane);
#pragma unroll
                for (int jj = 0; jj < 4; ++jj) *((unsigned*)(xb8 + (size_t)tok * DM) + lane + 64 * jj) = pk4_fp8(v[i][jj][0] * F8_SX, v[i][jj][1] * F8_SX, v[i][jj][2] * F8_SX, v[i][jj][3] * F8_SX); } }
        asm volatile("s_waitcnt vmcnt(0)" ::: "memory");
        __syncthreads();
        const int tl = wave & 3, kr = wave >> 2, tokl = tok0 + tl * 32 + l31;
        f32x16 D = proj32_f32(rw, 32, 32, x1 + (size_t)tokl * DM, kr * 512, lane);
        if (kr == 1) {
#pragma unroll
            for (int r = 0; r < 16; ++r) red[(tl * 16 + r) * 64 + lane] = D[r]; }
        __syncthreads();
        if (kr == 0) {
            float lv[32];
#pragma unroll
            for (int r = 0; r < 16; ++r) { const float own = D[r] + red[(tl * 16 + r) * 64 + lane] + rb[crow(r, hi)]; const float oth = __shfl_xor(own, 32);
                lv[crow(r, 0)] = hi == 0 ? own : oth; lv[crow(r, 1)] = hi == 0 ? oth : own; }
            float tv[4]; int te[4];
#pragma unroll
            for (int r = 0; r < 4; ++r) { float mx = -INFINITY; int me = 0;
#pragma unroll
                for (int e = 0; e < 32; ++e) { if (lv[e] > mx) { mx = lv[e]; me = e; } }
                tv[r] = mx; te[r] = me;
#pragma unroll
                for (int e = 0; e < 32; ++e) { if (e == me) lv[e] = -INFINITY; } }
            const float e1 = __expf(tv[1] - tv[0]), e2 = __expf(tv[2] - tv[0]), e3 = __expf(tv[3] - tv[0]); const float inv = 1.f / (1.f + e1 + e2 + e3);
            if (hi == 0) { const size_t o = (size_t)tokl * 4;
                const float gv[4] = {inv, e1 * inv, e2 * inv, e3 * inv};
#pragma unroll
                for (int r = 0; r < 4; ++r) { const unsigned rk = __hip_atomic_fetch_add(lcnt + (te[r] & 31), 1u, __ATOMIC_RELAXED, __HIP_MEMORY_SCOPE_WORKGROUP);
                    tope[o + r] = (unsigned)(te[r] & 31); gate[o + r] = gv[r]; rank[o + r] = rk; } } }
        __syncthreads();
        if (tid < 32) __hip_atomic_store(F.ctl + CW_CNT + chunk * 32 + tid, lcnt[tid], RLX_AGENT);
    }
}

DI void ph_route(const Fr& F) {
    const unsigned char* xb8 = F.ws + WS_XB8; unsigned char* xg = F.ws + WS_XG;
    const unsigned* tope = (const unsigned*)(F.ws + WS_TOPE); const unsigned* rank = (const unsigned*)(F.ws + WS_RANK); unsigned* dest = (unsigned*)(F.ws + WS_DEST);
    LAS unsigned* P = (LAS unsigned*)(F.lds); LAS unsigned* pst = P + 512; LAS unsigned* pad = P + 544; LAS unsigned* base = P + 576; LAS unsigned* nt = P + 608;
    const int tid = F.tid, lane = F.lane, wave = F.wave;
    __syncthreads();
    { const int e = tid & 31, part = tid >> 5; unsigned s = 0u;
        for (int c = 0; c < 16; ++c) s += ld_u32(F.ctl + CW_CNT + (part * 16 + c) * 32 + e);
        P[part * 32 + e] = s; }
    __syncthreads();
    if (tid < 32) { unsigned tot = 0u;
        for (int p = 0; p < 16; ++p) tot += P[p * 32 + tid];
        pad[tid] = (tot + 255u) & ~255u; }
    __syncthreads();
    if (tid == 0) { unsigned acc = 0u;
        for (int e = 0; e < 32; ++e) { pst[e] = acc; acc += pad[e]; }
        nt[0] = acc >> 8; }
    __syncthreads();
    for (int chunk = F.blk; chunk < 256; chunk += F.G) {
        __syncthreads();
        if (tid < 32) { unsigned off = 0u; const int pf = chunk >> 4;
            for (int p = 0; p < pf; ++p) off += P[p * 32 + tid];
            for (int c = pf * 16; c < chunk; ++c) off += ld_u32(F.ctl + CW_CNT + c * 32 + tid);
            base[tid] = pst[tid] + off; }
        __syncthreads();
#pragma unroll 1
        for (int i0 = 0; i0 < 16; i0 += 4) { v4u src[4]; unsigned ee[4][4], rr[4][4];
#pragma unroll
            for (int i = 0; i < 4; ++i) { const int tok = chunk * 128 + wave * 16 + i0 + i; src[i] = *((const v4u*)(xb8 + (size_t)tok * DM) + lane);
#pragma unroll
                for (int k = 0; k < 4; ++k) { ee[i][k] = tope[(size_t)tok * 4 + k]; rr[i][k] = rank[(size_t)tok * 4 + k]; } }
#pragma unroll
            for (int i = 0; i < 4; ++i) { const int tok = chunk * 128 + wave * 16 + i0 + i;
#pragma unroll
                for (int k = 0; k < 4; ++k) { const unsigned d = base[ee[i][k]] + rr[i][k];
                    if (lane == 0) dest[(size_t)tok * 4 + k] = d;
                    *((v4u*)(xg + (size_t)d * DM) + lane) = src[i]; } } }
        if (chunk == 0) { const unsigned ntl = nt[0];
            if (tid == 0) __hip_atomic_store(F.ctl + CW_TILE, ntl, RLX_AGENT);
            for (unsigned i = tid; i < ntl; i += NTHR) { unsigned e = 0u;
                for (unsigned k = 1; k < 32; ++k) if (pst[k] <= i * 256u) e = k;
                __hip_atomic_store(F.ctl + CW_TILE + 64 + i, e, RLX_AGENT); } }
    }
}

DI void ph_combine_ln2(const Args& a, const Fr& F, int layer) {
    const float* x1 = (const float*)(F.ws + WS_X1); const bf16* yr = (const bf16*)(F.ws + WS_XG); float* xo = (float*)(F.ws + WS_X); bf16* xb = (bf16*)(F.ws + WS_XB);
    const float* gate = (const float*)(F.ws + WS_GATE); const unsigned* dest = (const unsigned*)(F.ws + WS_DEST);
    const float* g = a.in[10] + (size_t)(layer * 2 + 1) * DM; const float* bb = a.in[11] + (size_t)(layer * 2 + 1) * DM;
    const int lane = F.lane; const int gw = F.blk * NWAVES + F.wave, NGW = F.G * NWAVES;
    for (int tok = gw; tok < NTOK; tok += 4 * NGW) { f32x4 v[4][4];
#pragma unroll
        for (int i = 0; i < 4; ++i) { const int tk = tok + i * NGW; if (tk < NTOK) {
#pragma unroll
            for (int jj = 0; jj < 4; ++jj) v[i][jj] = *((const f32x4*)(x1 + (size_t)tk * DM) + lane + 64 * jj) * ALPHA;
#pragma unroll
            for (int k = 0; k < 4; ++k) { const float gk = gate[(size_t)tk * 4 + k]; const unsigned d = dest[(size_t)tk * 4 + k];
#pragma unroll
                for (int jj = 0; jj < 4; ++jj) { const v2u w = *((const v2u*)(yr + (size_t)d * DM) + lane + 64 * jj);
                    v[i][jj][0] += gk * bf2f(w.x & 0xffffu); v[i][jj][1] += gk * bf2f(w.x >> 16); v[i][jj][2] += gk * bf2f(w.y & 0xffffu); v[i][jj][3] += gk * bf2f(w.y >> 16); } } } }
#pragma unroll
        for (int i = 0; i < 4; ++i) { const int tk = tok + i * NGW; if (tk < NTOK) {
            ln_row(v[i], g, bb, lane);
            if (layer == DEPTH - 1) store_row_f32(a.out + (size_t)tk * DM, v[i], lane);
            else { if ((layer & 1) == 0) store_row_f32(xo + (size_t)tk * DM, v[i], lane);
                store_row_bf16(xb + (size_t)tk * DM, v[i], lane); } } } }
}
constexpr int LDS_BYTES = 147456;
constexpr int LDS_BARW = 145408, LDS_QSLOT = 145472, LDS_TILE_E = 133632;
constexpr int NPL = 11;
constexpr int NPHASE = 1 + NPL * DEPTH;
#ifndef MK_SINGLE
#define MK_SINGLE 1
#endif
DI int q_next(const Fr& F, unsigned* ctr) {
    LAS int* slot = (LAS int*)(F.lds + LDS_QSLOT);
    __syncthreads();
    if (F.tid == 0) *slot = (int)__hip_atomic_fetch_add(ctr, 1u, RLX_AGENT);
    __syncthreads();
    return *slot;
}
DI int lane_id_fresh() { unsigned m_ = ~0u; asm volatile("" : "+s"(m_)); return (int)__builtin_amdgcn_mbcnt_hi(m_, __builtin_amdgcn_mbcnt_lo(m_, 0u)); }
#define RETID(F) do { int t2_ = F.tid; asm volatile("" : "+v"(t2_)); F.tid = t2_; F.lane = t2_ & 63; F.wave = __builtin_amdgcn_readfirstlane(t2_ >> 6); } while (0)
#ifndef PROBE_DUP
#define PROBE_DUP -1
#endif
#define NREP(q) ((PROBE_DUP == (q)) ? 2 : 1)
#define AS4 __attribute__((address_space(4)))
#define SITE() Args a; Fr F; { const AS4 Args* ap = (const AS4 Args*)__builtin_amdgcn_kernarg_segment_ptr(); asm volatile("" : "+s"(ap)); \
        _Pragma("unroll") for (int i_ = 0; i_ < 18; ++i_) a.in[i_] = ap->in[i_]; a.out = ap->out; a.ws = ap->ws; a.ph_lo = 0; a.ph_hi = 0; \
        int w_ = wv_s; asm volatile("" : "+s"(w_)); int t_ = w_ * 64 + lane_id_fresh(); asm volatile("" : "+v"(t_)); F.tid = t_; F.lane = t_ & 63; F.wave = __builtin_amdgcn_readfirstlane(t_ >> 6); \
        F.lds = (LAS unsigned char*)lds_raw; F.ws = a.ws; F.ctl = (unsigned*)(a.ws + WS_CTL); F.blk = blockIdx.x; F.G = gridDim.x; }
__global__ void __launch_bounds__(NTHR, 2) mega_fwd(Args a0) {
    extern __shared__ __attribute__((aligned(16))) unsigned char lds_raw[];
    const int wv_s = __builtin_amdgcn_readfirstlane((int)(threadIdx.x >> 6));
#if MK_SINGLE
    constexpr int lo = 0, hi = NPHASE; constexpr bool single = true;
#else
    const int lo = a0.ph_lo, hi = a0.ph_hi; constexpr bool single = false;
#endif
    if (threadIdx.x == 0) *(LAS v4u*)((LAS unsigned char*)lds_raw + LDS_BARW) = (v4u){0u, 0u, 0u, 0u};
    __syncthreads();
    if (single) (void)xcd_barrier_post((unsigned*)(a0.ws + WS_CTL) + CW_BAR, (volatile LAS unsigned*)((LAS unsigned char*)lds_raw + LDS_BARW));
#define IN(k) (lo <= (k) && (k) < hi)
#define SEAM() do { if (single) { const AS4 Args* ap_ = (const AS4 Args*)__builtin_amdgcn_kernarg_segment_ptr(); asm volatile("" : "+s"(ap_)); int w_ = wv_s; asm volatile("" : "+s"(w_)); \
        XcdBarrier b_; b_.bar = (unsigned*)(ap_->ws + WS_CTL) + CW_BAR; b_.x = xb_xcc_id(); b_.st = (volatile LAS unsigned*)((LAS unsigned char*)lds_raw + LDS_BARW); \
        xcd_barrier(b_, (w_ == 0) && (lane_id_fresh() == 0)); } } while (0)
    if (IN(0)) { _Pragma("unroll 1") for (int rep = 0; rep < NREP(100); ++rep) { { SITE(); ph_prologue(a, F); } SEAM(); } }
#pragma clang loop unroll(full)
    for (int L = 0; L < DEPTH; ++L) {
        const int pb = 1 + NPL * L, j = L >> 1; const bool odd = (L & 1) != 0;
        if (IN(pb + 0)) _Pragma("unroll 1") for (int rep = 0; rep < NREP(0); ++rep) {
            { SITE();
            const bf16* w = odd ? (const bf16*)(F.ws + WS_WOD) + (size_t)j * OD_N * 1024 : (const bf16*)(F.ws + WS_WEV) + (size_t)j * EV_N * 1024;
            const int N = odd ? OD_N : EV_N;
            pg8::Gemm g{(const bf16*)(F.ws + WS_XB), w, NTOK, N, 1024}; pg8::StaticOrder S; S.init(NTOK, N, F.G, F.blk);
            pg8::EpiBf16<0> E{(bf16*)(F.ws + WS_PROJ), N, nullptr, 1024, (size_t)1024, C2F};
            pg8::gemm_phase<pg8::EpiBf16<0>, pg8::StaticOrder, true, true>(F.lds, g, S, E, F.tid); }
            SEAM(); }
        if (IN(pb + 1)) _Pragma("unroll 1") for (int rep = 0; rep < NREP(1); ++rep) { { SITE(); if (odd) ph_odd_prep(a, F, j, L); else ph_even_prep(a, F, j); } SEAM(); }
        if (!odd && IN(pb + 2)) _Pragma("unroll 1") for (int rep = 0; rep < ((PROBE_DUP == 2 || (PROBE_DUP >= 21 && PROBE_DUP <= 22) || (PROBE_DUP >= 211 && PROBE_DUP <= 217)) ? 2 : 1); ++rep) {
            { SITE(); unsigned* ctr = F.ctl + CW_Q + 64 * (L * 2) + 1024 * rep;
            for (;;) { const int it = q_next(F, ctr); if (it >= 1280) break; RETID(F);
                if (it < 1024) { if (!(rep == 1 && PROBE_DUP == 22)) idx_unit(F, it & 3, 255 - (it >> 2), (rep == 1 && PROBE_DUP >= 211) ? PROBE_DUP - 210 : 0); } else { if (!(rep == 1 && (PROBE_DUP == 21 || PROBE_DUP >= 211))) moba_gate_chunk(F, it - 1024); } } }
            SEAM(); }
        if (IN(pb + 3)) _Pragma("unroll 1") for (int rep = 0; rep < ((PROBE_DUP == 3 || (PROBE_DUP == 31 && odd) || ((PROBE_DUP == 32 || PROBE_DUP == 33) && !odd)) ? 2 : 1); ++rep) {
            { SITE(); unsigned* ctr = F.ctl + CW_Q + 64 * (L * 2 + 1) + 1024 * rep;
            if (odd) { for (;;) { const int it = q_next(F, ctr); if (it >= 2048) break; RETID(F); const int bh = it & 63; fox_unit(F, L, bh >> 4, bh & 15, 31 - (it >> 6)); } }
            else { for (;;) { const int it = q_next(F, ctr); if (it >= 2048) break; RETID(F);
                    if (it < 1024) { const int bh = it & 31; if (!(rep == 1 && PROBE_DUP == 33)) moba_unit(a, F, bh >> 3, bh & 7, it >> 5); } else { if (!(rep == 1 && PROBE_DUP == 32)) dsa_chunk(a, F, it - 1024); } } } }
            SEAM(); }
        if (!odd && IN(pb + 4)) _Pragma("unroll 1") for (int rep = 0; rep < NREP(4); ++rep) { { SITE(); ph_even_post(F, j); } SEAM(); }
        if (IN(pb + 5)) _Pragma("unroll 1") for (int rep = 0; rep < NREP(5); ++rep) {
            { SITE();
            pg8::Gemm g{(const bf16*)(F.ws + WS_AO), (const bf16*)(F.ws + WS_WOUT) + (size_t)L * 1024 * 1024, NTOK, 1024, 1024}; pg8::StaticOrder S; S.init(NTOK, 1024, F.G, F.blk);
            EpiResBf16 E{(const bf16*)(F.ws + WS_XB), (bf16*)(F.ws + WS_YP), ALPHA};
            pg8::gemm_phase<EpiResBf16, pg8::StaticOrder, true, true>(F.lds, g, S, E, F.tid); }
            SEAM(); }
        if (IN(pb + 6)) _Pragma("unroll 1") for (int rep = 0; rep < NREP(6); ++rep) { { SITE(); ph_ln1_router(a, F, L); } SEAM(); }
        if (IN(pb + 7)) _Pragma("unroll 1") for (int rep = 0; rep < NREP(7); ++rep) { { SITE(); ph_route(F); } SEAM(); }
        if (IN(pb + 8)) _Pragma("unroll 1") for (int rep = 0; rep < NREP(8); ++rep) {
            { SITE(); const int ntl = (int)ld_u32(F.ctl + CW_TILE);
            LAS unsigned* tle = (LAS unsigned*)(F.lds + LDS_TILE_E);
            for (int i = F.tid; i < ntl; i += NTHR) tle[i] = ld_u32(F.ctl + CW_TILE + 64 + i);
            __syncthreads();
            pg8::Gemm g{(const bf16*)(F.ws + WS_XG), (const bf16*)(F.ws + WS_WGU + (size_t)L * 32 * 2048 * 1024), NR_MAX, 32 * 2048, 512};
            GroupOrder S{tle, ntl, 3, F.G, F.blk};
            EpiSwiglu E{F.ws + WS_ACT, a.in[15] + (size_t)L * 32 * 2048};
            pg8::gemm_phase<EpiSwiglu, GroupOrder, true, true, true>(F.lds, g, S, E, F.tid); }
            SEAM(); }
        if (IN(pb + 9)) _Pragma("unroll 1") for (int rep = 0; rep < NREP(9); ++rep) {
            { SITE(); const int ntl = (int)ld_u32(F.ctl + CW_TILE);
            LAS unsigned* tle = (LAS unsigned*)(F.lds + LDS_TILE_E);
            for (int i = F.tid; i < ntl; i += NTHR) tle[i] = ld_u32(F.ctl + CW_TILE + 64 + i);
            __syncthreads();
            pg8::Gemm g{(const bf16*)(F.ws + WS_ACT), (const bf16*)(F.ws + WS_WDN + (size_t)L * 32 * 1024 * 1024), NR_MAX, 32 * 1024, 512};
            GroupOrder S{tle, ntl, 2, F.G, F.blk};
            EpiDown E{(bf16*)(F.ws + WS_XG), a.in[17] + (size_t)L * 32 * 1024};
            pg8::gemm_phase<EpiDown, GroupOrder, true, true, true>(F.lds, g, S, E, F.tid); }
            SEAM(); }
        if (IN(pb + 10)) _Pragma("unroll 1") for (int rep = 0; rep < NREP(10); ++rep) { { SITE(); ph_combine_ln2(a, F, L); } if (L + 1 < DEPTH || rep + 1 < NREP(10)) SEAM(); }
        if (PROBE_DUP == 900 && L + 1 < DEPTH) { _Pragma("unroll 1") for (int xb = 0; xb < 10; ++xb) SEAM(); }
    }
#undef IN
#undef SEAM
}

extern "C" void kernel_launch(void* const* d_in, const int* in_sizes, int n_in, void* d_out, int out_size, void* d_ws, size_t ws_size, hipStream_t stream) {
    static int grid = 0;
    if (grid == 0) {
        if (n_in != 18 || out_size != NTOK * DM || ws_size < WS_END) { fprintf(stderr, "kernel_launch: unexpected shapes (n_in %d, out %d, ws %zu); nothing launched\n", n_in, out_size, ws_size); grid = -1; return; }
        int dev = 0, cus = 0, per_cu = 0;
        if (hipGetDevice(&dev) != hipSuccess || hipDeviceGetAttribute(&cus, hipDeviceAttributeMultiprocessorCount, dev) != hipSuccess) { grid = -1; return; }
        if (hipFuncSetAttribute((const void*)mega_fwd, hipFuncAttributeMaxDynamicSharedMemorySize, LDS_BYTES) != hipSuccess) { fprintf(stderr, "kernel_launch: hipFuncSetAttribute failed\n"); grid = -1; return; }
        if (hipOccupancyMaxActiveBlocksPerMultiprocessor(&per_cu, (const void*)mega_fwd, NTHR, LDS_BYTES) != hipSuccess || per_cu < 1) fprintf(stderr, "kernel_launch: occupancy query reports %d\n", per_cu);
        (void)hipGetLastError();
        grid = cus;
    }
    if (grid < 0) return;
    (void)hipMemsetAsync((char*)d_ws + WS_CTL, 0, CTL_ZERO_BYTES, stream);
#ifdef EXP_SKIP
    (void)hipMemsetAsync((char*)d_ws + WS_AO, 0, 64 * MiB, stream);
    (void)hipMemsetAsync((char*)d_ws + WS_OL, 0, 64 * MiB, stream);
    if (EXP_SKIP & 4) { (void)hipMemsetAsync((char*)d_ws + WS_XG, 0, 272 * MiB, stream); (void)hipMemsetAsync((char*)d_ws + WS_DEST, 0, 1 * MiB, stream); }
#endif
    Args a{};
    for (int i = 0; i < 18; ++i) a.in[i] = (const float*)d_in[i];
    a.out = (float*)d_out; a.ws = (unsigned char*)d_ws;
#if MK_SINGLE
    a.ph_lo = 0; a.ph_hi = NPHASE;
    hipLaunchKernelGGL(mega_fwd, dim3(grid), dim3(NTHR), LDS_BYTES, stream, a);
#else
    for (int p = 0; p < NPHASE; ++p) {
        if (p > 0) { const int L = (p - 1) / NPL, q = (p - 1) % NPL; if ((L & 1) && (q == 2 || q == 4)) continue;
#ifdef EXP_SKIP
            if ((EXP_SKIP & 1) && !(L & 1) && q <= 4) continue;
            if ((EXP_SKIP & 2) && (L & 1) && q <= 4) continue;
            if ((EXP_SKIP & 4) && q >= 7 && q <= 9) continue;
#endif
        }
        a.ph_lo = p; a.ph_hi = p + 1;
        hipLaunchKernelGGL(mega_fwd, dim3(grid), dim3(NTHR), LDS_BYTES, stream, a);
    }
#endif
}
```

```cpp
#include <hip/hip_runtime.h>
#include <cstdio>
#include <cstdint>
#ifdef EXP_SKIP
#define EXPF EXP_SKIP
#else
#define EXPF 0
#endif
constexpr int NB = 4, SEQ = 8192, DM = 1024, NTOK = NB * SEQ, DEPTH = 4;
constexpr int EV_N = 2560, OD_N = 3072;
constexpr int EC_QA = 0, EC_QB = 512, EC_KB = 1024, EC_VB = 1536, EC_CKV = 2048, EC_QI = 2176, EC_KI = 2432, EC_WI = 2496;
constexpr int OC_Q = 0, OC_K = 1024, OC_V = 2048;
constexpr float LOG2E = 1.4426950408889634f;
constexpr float C2F = 0.125f * LOG2E;
constexpr float ALPHA = 1.681792830507429f;
constexpr float LN_EPS = 1e-5f;
constexpr int NR_MAX = 131072 + 32 * 256;
constexpr int NWAVES = 8, NTHR = 512;
constexpr size_t MiB = (size_t)1 << 20;
constexpr size_t WS_CTL = 0, CTL_ZERO_BYTES = 4 * MiB;
constexpr size_t WS_WEV = 8 * MiB, WS_WOD = 18 * MiB, WS_WOUT = 30 * MiB, WS_WUKT = 38 * MiB, WS_WUVT = 39 * MiB;
constexpr size_t WS_WGU = 40 * MiB, WS_WDN = 552 * MiB;
constexpr size_t WS_X = 808 * MiB, WS_X1 = 936 * MiB, WS_YP = 1064 * MiB, WS_XB = 1192 * MiB;
constexpr size_t WS_PROJ = 1256 * MiB, WS_AO = 1448 * MiB, WS_XG = 1512 * MiB, WS_ACT = 1784 * MiB;
constexpr size_t WS_QL = 2056 * MiB, WS_OL = 2120 * MiB, WS_CKVN = 2184 * MiB, WS_SEL = 2192 * MiB;
constexpr size_t WS_KBAR = 2208 * MiB, WS_SEL3 = 2209 * MiB, WS_LOGF = 2210 * MiB, WS_CS = 2212 * MiB;
constexpr size_t WS_TOPE = 2213 * MiB, WS_GATE = 2214 * MiB, WS_RANK = 2215 * MiB, WS_DEST = 2216 * MiB, WS_PML = 2217 * MiB;
constexpr size_t WS_XB8 = 2226 * MiB;
constexpr size_t WS_KIC = 2258 * MiB;
constexpr size_t WS_END = 2262 * MiB;
constexpr float F8_SX = 16.f, F8_SWG = 256.f, F8_SA = 4.f, F8_SWD = 512.f;
constexpr int CW_BAR = 4096, CW_Q = 8192, CW_KMAX = 12288, CW_CNT = 16384, CW_TILE = 32768;

#define GAS __attribute__((address_space(1)))
#define LAS __attribute__((address_space(3)))
#define DI __device__ __forceinline__
typedef unsigned short bf16;
typedef unsigned v4u __attribute__((ext_vector_type(4)));
typedef unsigned v2u __attribute__((ext_vector_type(2)));
typedef float f32x4 __attribute__((ext_vector_type(4)));
typedef float f32x2 __attribute__((ext_vector_type(2)));
typedef float f32x16 __attribute__((ext_vector_type(16)));
typedef short bf16x8 __attribute__((ext_vector_type(8)));
typedef short s16x4 __attribute__((ext_vector_type(4)));
typedef __bf16 bf16x2_t __attribute__((ext_vector_type(2)));
typedef GAS unsigned gu32;
#define RLX_AGENT __ATOMIC_RELAXED, __HIP_MEMORY_SCOPE_AGENT
#define LDS_WAIT() asm volatile("s_waitcnt lgkmcnt(0)" ::: "memory")

DI float bf2f(unsigned v) { return __uint_as_float(v << 16); }
DI unsigned cvtpk(float lo, float hi) { f32x2 v = {lo, hi}; bf16x2_t b = __builtin_convertvector(v, bf16x2_t); return __builtin_bit_cast(unsigned, b); }
DI unsigned f2bf(float f) { return cvtpk(f, 0.f) & 0xffffu; }
DI unsigned pk4_fp8(float a, float b, float c, float d) {
    a = fminf(fmaxf(a, -448.f), 448.f); b = fminf(fmaxf(b, -448.f), 448.f); c = fminf(fmaxf(c, -448.f), 448.f); d = fminf(fmaxf(d, -448.f), 448.f);
    int w = 0; w = __builtin_amdgcn_cvt_pk_fp8_f32(a, b, w, false); w = __builtin_amdgcn_cvt_pk_fp8_f32(c, d, w, true); return (unsigned)w; }
DI float ex2(float x) { return __builtin_amdgcn_exp2f(x); }
DI float wave_sum(float v) {
#pragma unroll
    for (int o = 1; o < 64; o <<= 1) v += __shfl_xor(v, o);
    return v;
}
DI float wave_max(float v) {
#pragma unroll
    for (int o = 1; o < 64; o <<= 1) v = fmaxf(v, __shfl_xor(v, o));
    return v;
}
DI unsigned ld_u32(const unsigned* p) { return __hip_atomic_load(p, RLX_AGENT); }
DI int crow(int r, int hi) { return (r & 3) + 8 * (r >> 2) + 4 * hi; }
DI f32x16 mfma32(bf16x8 a, bf16x8 b, f32x16 c) { return __builtin_amdgcn_mfma_f32_32x32x16_bf16(a, b, c, 0, 0, 0); }
DI f32x4 mfma16(bf16x8 a, bf16x8 b, f32x4 c) { return __builtin_amdgcn_mfma_f32_16x16x32_bf16(a, b, c, 0, 0, 0); }
typedef short v4i16_t __attribute__((ext_vector_type(4)));
DI s16x4 vtr(LAS const char* p) { return __builtin_bit_cast(s16x4, __builtin_amdgcn_ds_read_tr16_b64_v4i16((LAS v4i16_t*)p)); }
DI bf16x8 cat8(s16x4 a, s16x4 b) { return (bf16x8){a[0], a[1], a[2], a[3], b[0], b[1], b[2], b[3]}; }
DI int t5_bucket(int n) {
    if (n < 16) return n;
    int bkt = 16;
    bkt += (n >= 21); bkt += (n >= 27); bkt += (n >= 35); bkt += (n >= 46); bkt += (n >= 59); bkt += (n >= 77); bkt += (n >= 99); bkt += (n >= 128);
    bkt += (n >= 166); bkt += (n >= 216); bkt += (n >= 280); bkt += (n >= 363); bkt += (n >= 470); bkt += (n >= 609); bkt += (n >= 790);
    return bkt;
}
namespace pg8 {
#define PG8_LAS __attribute__((address_space(3)))
typedef unsigned short bf16_t;
typedef short bf16x8 __attribute__((ext_vector_type(8)));
typedef float f32x4 __attribute__((ext_vector_type(4)));
typedef unsigned u32x4 __attribute__((ext_vector_type(4)));
constexpr int BM = 256, BK = 64, HALF = 128, HTB = HALF * BK * 2  , STAGE_BYTES = 8 * HTB, NXCD = 8, WGM = 8;

__host__ __device__ __forceinline__ int lds_byte(int r, int c) { const int st = (r >> 4) * 2 + (c >> 5), rr = r & 15, cc = c & 31, ob = rr * 64 + cc * 2; return st * 1024 + (ob ^ (((ob >> 9) & 1) << 5)); }
__host__ __device__ __forceinline__ void stage_rc(int b, int& R, int& C) { const int st = b / 1024, sb = b % 1024, swz = sb ^ (((sb >> 9) & 1) << 5); R = (st >> 1) * 16 + swz / 64; C = (st & 1) * 32 + (swz % 64) / 2; }
__host__ __device__ __forceinline__ int perm32(int rho) { const int n = rho >> 4, i = rho & 15; return 8 * (i >> 2) + 4 * n + (i & 3); }

typedef int i32x8 __attribute__((ext_vector_type(8))); typedef int i32x4v __attribute__((ext_vector_type(4)));
__device__ __forceinline__ i32x8 pg8_cat8(bf16x8 lo, bf16x8 hi) { const i32x4v a = __builtin_bit_cast(i32x4v, lo), b = __builtin_bit_cast(i32x4v, hi); return (i32x8){a[0], a[1], a[2], a[3], b[0], b[1], b[2], b[3]}; }
struct Unit { int pm, pn; };
struct Gemm { const bf16_t* A; const bf16_t* Bt; int M, N, K; };

struct StaticOrder {
    int nM, nN, nwg, G, c;
    __host__ __device__ void init(int M, int N, int G_, int c_) { nM = M / BM; nN = N / BM; nwg = nM * nN; G = G_; c = c_; }
    __host__ __device__ bool next(int i, Unit& u) const {
        const long L = (long)i * G + c; if (L >= nwg) return false;
        int wgid = (int)L; { const int q = nwg / NXCD, r = nwg % NXCD, xcd = wgid % NXCD, off = wgid / NXCD; wgid = (xcd < r ? xcd * (q + 1) : r * (q + 1) + (xcd - r) * q) + off; }
        const int nig = WGM * nN, gid = wgid / nig, fm = gid * WGM, gsz = (nM - fm) < WGM ? (nM - fm) : WGM;
        u.pm = fm + ((wgid % nig) % gsz); u.pn = (wgid % nig) / gsz; return true;
    }
    __device__ __forceinline__ void a_ready(const Unit&) const {}
    __device__ __forceinline__ void done(const Unit&) const {}
};

__device__ __forceinline__ unsigned cvt_pk_bf16(float lo, float hi) { unsigned r; asm volatile("v_cvt_pk_bf16_f32 %0, %1, %2" : "=v"(r) : "v"(lo), "v"(hi)); return r; }
typedef float f32x2 __attribute__((ext_vector_type(2)));
__device__ __forceinline__ f32x2 gelu_pk(f32x2 v) {
    const f32x2 av = __builtin_elementwise_abs(v), d = av * 0.2316418882f + 1.0f;
    f32x2 t; t.x = __builtin_amdgcn_rcpf(d.x); t.y = __builtin_amdgcn_rcpf(d.y);
    f32x2 q = t * 0.5307027145f + (-0.7265760135f); q = q * t + 0.7107068705f; q = q * t + (-0.142248368f); q = q * t + 0.127414796f; q = q * t;
    const f32x2 s = (v * v) * (-0.72134752044f);
    f32x2 e; e.x = __builtin_amdgcn_exp2f(s.x); e.y = __builtin_amdgcn_exp2f(s.y);
    const f32x2 m = v * (q * e), r = v - m;
    f32x2 o; o.x = v.x < 0.f ? m.x : r.x; o.y = v.y < 0.f ? m.y : r.y; return o;
}

template <int ACT  > struct EpiBf16 {
    static constexpr bool PERM = true, AFTER_DRAIN = false; static_assert(ACT == 0 || ACT == 1, "EpiBf16: ACT is 0 (none) or 1 (gelu_pk)");
    bf16_t* O; int ldc; const float* bias; int split_cols; size_t split_stride; float scale0;
    __device__ __forceinline__ void operator()(const f32x4 (&acc)[2][2][4][2], const Unit& u, int wr, int wc, int fr, int fq) const {
        const int row0 = u.pm * BM + wr * 64 + fr; int colt = u.pn * BM; bf16_t* base = O;
        float sc = 1.f; if (split_cols) { const int t = colt / split_cols; base += (size_t)t * split_stride; colt -= t * split_cols; if (t == 0) sc = scale0; }
        const int col0 = colt + wc * 32 + 8 * fq, bcol0 = u.pn * BM + wc * 32 + 8 * fq;
        f32x4 bv[2][2];
#pragma unroll
        for (int bj = 0; bj < 2; ++bj)
#pragma unroll
            for (int n = 0; n < 2; ++n) bv[bj][n] = bias ? *(const f32x4*)(bias + bcol0 + bj * HALF + 4 * n) : (f32x4){0.f, 0.f, 0.f, 0.f};
#pragma unroll
        for (int ai = 0; ai < 2; ++ai)
#pragma unroll
            for (int m = 0; m < 4; ++m) { bf16_t* rowp = base + (size_t)(row0 + ai * HALF + m * 16) * ldc + col0;
#pragma unroll
                for (int bj = 0; bj < 2; ++bj) { f32x4 v0 = acc[ai][bj][m][0] + bv[bj][0], v1 = acc[ai][bj][m][1] + bv[bj][1];
                    if (ACT == 1) { f32x2 a = gelu_pk((f32x2){v0[0], v0[1]}), b = gelu_pk((f32x2){v0[2], v0[3]}), c = gelu_pk((f32x2){v1[0], v1[1]}), d = gelu_pk((f32x2){v1[2], v1[3]});
                        v0 = (f32x4){a.x, a.y, b.x, b.y}; v1 = (f32x4){c.x, c.y, d.x, d.y}; }
                    v0 = v0 * sc; v1 = v1 * sc; u32x4 w; w.x = cvt_pk_bf16(v0[0], v0[1]); w.y = cvt_pk_bf16(v0[2], v0[3]); w.z = cvt_pk_bf16(v1[0], v1[1]); w.w = cvt_pk_bf16(v1[2], v1[3]);
                    *(u32x4*)(rowp + bj * HALF) = w; } }
    }
};

template <class Epi, class Sched, bool ALIGN_EPI = false, bool SP2 = false, bool F8 = false>
__device__ __forceinline__ void gemm_phase(PG8_LAS unsigned char* lds, const Gemm g, const Sched& S, const Epi& E, int tid_in) {
    int tid_l = tid_in; asm volatile("" : "+v"(tid_l));
    const int tid = tid_l, wid = __builtin_amdgcn_readfirstlane(tid >> 6), lane = tid & 63, wr = wid >> 2, wc = wid & 3, fr = lane & 15, fq = lane >> 4;
    const int K = g.K, nt = K / BK;
    unsigned voffA[2], voffB[2];
#pragma unroll
    for (int i = 0; i < 2; ++i) { int R, C; stage_rc(tid * 16 + i * 8192, R, C); const int Rb = Epi::PERM ? ((R & ~31) + perm32(R & 31)) : R;
        voffA[i] = (unsigned)(R * K + C) * 2u; voffB[i] = (unsigned)(Rb * K + C) * 2u; }
    const size_t kstep = (size_t)(BK * 2);
    const size_t hstep = (size_t)HALF * K * 2;
    const size_t tstep = 2 * hstep;
    const unsigned ldsw = (unsigned)wid * 1024u;
    const int aoff = lds_byte(wr * 64 + fr, fq * 8), boff = lds_byte(wc * 32 + fr, fq * 8);
#define PG8_SA(b, h) (((b) * 2 + (h)) * HTB)
#define PG8_SB(b, h) ((4 + (b) * 2 + (h)) * HTB)
#define PG8_STAGE(bufoff, gbase, voff) do { _Pragma("unroll") for (int _i = 0; _i < 2; ++_i) \
        __builtin_amdgcn_global_load_lds((const unsigned*)((const char*)(gbase) + (voff)[_i]), (PG8_LAS unsigned*)(lds + (bufoff) + ldsw + _i * 8192), 16, 0, 0); } while (0)
#define PG8_LDA(dst, b, h) do { _Pragma("unroll") for (int m = 0; m < 4; ++m) _Pragma("unroll") for (int k = 0; k < 2; ++k) dst[m][k] = *(const PG8_LAS bf16x8*)(lds + PG8_SA(b, h) + aoff + m * 2048 + k * 1024); } while (0)
#define PG8_LDB(dst, b, h) do { _Pragma("unroll") for (int n = 0; n < 2; ++n) _Pragma("unroll") for (int k = 0; k < 2; ++k) dst[n][k] = *(const PG8_LAS bf16x8*)(lds + PG8_SB(b, h) + boff + n * 2048 + k * 1024); } while (0)
#define PG8_MMA(ai, bj, At, Bt) do { __builtin_amdgcn_s_setprio(1); if constexpr (!F8) { _Pragma("unroll") for (int m = 0; m < 4; ++m) _Pragma("unroll") for (int n = 0; n < 2; ++n) _Pragma("unroll") for (int k = 0; k < 2; ++k) \
        acc[ai][bj][m][n] = __builtin_amdgcn_mfma_f32_16x16x32_bf16(Bt[n][k], At[m][k], acc[ai][bj][m][n], 0, 0, 0); } else { _Pragma("unroll") for (int m = 0; m < 4; ++m) _Pragma("unroll") for (int n = 0; n < 2; ++n) \
        acc[ai][bj][m][n] = __builtin_amdgcn_mfma_scale_f32_16x16x128_f8f6f4(pg8_cat8(Bt[n][0], Bt[n][1]), pg8_cat8(At[m][0], At[m][1]), acc[ai][bj][m][n], 0, 0, 0, 0x7F7F7F7F, 0, 0x7F7F7F7F); \
        _Pragma("unroll") for (int m = 0; m < 4; ++m) _Pragma("unroll") for (int n = 0; n < 2; ++n) asm volatile("" : "+v"(acc[ai][bj][m][n]));   } __builtin_amdgcn_s_setprio(0); } while (0)
#define PG8_WAIT_V(n) asm volatile("s_waitcnt vmcnt(" #n ")" ::: "memory")
#define PG8_WAIT_L(n) asm volatile("s_waitcnt lgkmcnt(" #n ")" ::: "memory")
#define PG8_BAR __builtin_amdgcn_s_barrier()
#define PG8_SCHED __builtin_amdgcn_sched_barrier(0)
    Unit cur, nxt; int ui = 0;
    if (!S.next(0, cur)) return;
    f32x4 acc[2][2][4][2];
#pragma unroll
    for (int a = 0; a < 2; ++a)
#pragma unroll
        for (int b = 0; b < 2; ++b)
#pragma unroll
            for (int m = 0; m < 4; ++m)
#pragma unroll
                for (int n = 0; n < 2; ++n) acc[a][b][m][n] = (f32x4){0.f, 0.f, 0.f, 0.f};
    bf16x8 At[4][2], B0[2][2], B1[2][2];
    const char* cA = (const char*)g.A + (size_t)cur.pm * tstep; const char* cB = (const char*)g.Bt + (size_t)cur.pn * tstep;
    S.a_ready(cur);
    if constexpr (SP2) {
        PG8_STAGE(PG8_SB(0, 0), cB, voffB); PG8_STAGE(PG8_SB(0, 1), cB + hstep, voffB); PG8_STAGE(PG8_SA(0, 0), cA, voffA); PG8_STAGE(PG8_SA(0, 1), cA + hstep, voffA);
        if (wr == 1) PG8_BAR;
        PG8_WAIT_V(2); PG8_BAR;
        PG8_STAGE(PG8_SB(1, 0), cB + kstep, voffB); PG8_STAGE(PG8_SA(1, 0), cA + kstep, voffA); PG8_STAGE(PG8_SB(1, 1), cB + hstep + kstep, voffB);
        PG8_WAIT_V(6); PG8_BAR;
    } else {
        PG8_STAGE(PG8_SB(0, 0), cB, voffB); PG8_STAGE(PG8_SA(0, 0), cA, voffA); PG8_STAGE(PG8_SB(0, 1), cB + hstep, voffB); PG8_STAGE(PG8_SA(0, 1), cA + hstep, voffA);
        if (wr == 1) PG8_BAR;
        PG8_WAIT_V(4); PG8_BAR;
        PG8_STAGE(PG8_SB(1, 0), cB + kstep, voffB); PG8_STAGE(PG8_SA(1, 0), cA + kstep, voffA); PG8_STAGE(PG8_SB(1, 1), cB + hstep + kstep, voffB);
        PG8_WAIT_V(6); PG8_BAR;
    }
    for (;;) {
        const bool has_next = S.next(ui + 1, nxt);
        const char* nA = has_next ? (const char*)g.A + (size_t)nxt.pm * tstep : cA; const char* nB = has_next ? (const char*)g.Bt + (size_t)nxt.pn * tstep : cB;
        for (int t = 0; t < nt; t += 2) {
            const bool last = (t == nt - 2);
            const char* a1 = cA + (size_t)(t + 1) * kstep;
            const char* a2 = last ? nA : cA + (size_t)(t + 2) * kstep; const char* b2 = last ? nB : cB + (size_t)(t + 2) * kstep;
            const char* a3 = a2 + kstep; const char* b3 = b2 + kstep;
            if (last && has_next) S.a_ready(nxt);
            if constexpr (SP2) {
            PG8_LDB(B0, 0, 0); PG8_LDB(B1, 0, 1); PG8_SCHED; PG8_LDA(At, 0, 0); PG8_STAGE(PG8_SA(1, 1), a1 + hstep, voffA);
            PG8_WAIT_V(8); PG8_WAIT_L(0); PG8_BAR; PG8_MMA(0, 0, At, B0); PG8_MMA(0, 1, At, B1); PG8_BAR; PG8_SCHED;
            PG8_LDA(At, 0, 1); PG8_STAGE(PG8_SB(0, 0), b2, voffB); PG8_STAGE(PG8_SB(0, 1), b2 + hstep, voffB); PG8_STAGE(PG8_SA(0, 0), a2, voffA);
            PG8_WAIT_V(8); PG8_WAIT_L(0); PG8_BAR; PG8_MMA(1, 0, At, B0); PG8_MMA(1, 1, At, B1); PG8_BAR; PG8_SCHED;
            PG8_LDB(B0, 1, 0); PG8_LDB(B1, 1, 1); PG8_SCHED; PG8_LDA(At, 1, 0); PG8_STAGE(PG8_SA(0, 1), a2 + hstep, voffA);
            PG8_WAIT_V(8); PG8_WAIT_L(0); PG8_BAR; PG8_MMA(0, 0, At, B0); PG8_MMA(0, 1, At, B1); PG8_BAR; PG8_SCHED;
            PG8_LDA(At, 1, 1); PG8_STAGE(PG8_SB(1, 0), b3, voffB); PG8_STAGE(PG8_SB(1, 1), b3 + hstep, voffB); PG8_STAGE(PG8_SA(1, 0), a3, voffA);
            PG8_WAIT_V(8); PG8_WAIT_L(0); PG8_BAR; PG8_MMA(1, 0, At, B0); PG8_MMA(1, 1, At, B1); PG8_BAR; PG8_SCHED;
            } else {
            PG8_LDB(B0, 0, 0); PG8_SCHED; PG8_LDA(At, 0, 0); PG8_STAGE(PG8_SA(1, 1), a1 + hstep, voffA);
            PG8_WAIT_L(8); PG8_BAR; PG8_WAIT_L(0); PG8_MMA(0, 0, At, B0); PG8_BAR; PG8_SCHED;
            PG8_LDB(B1, 0, 1); PG8_STAGE(PG8_SB(0, 0), b2, voffB);
            PG8_BAR; PG8_WAIT_L(0); PG8_MMA(0, 1, At, B1); PG8_BAR;
            PG8_LDA(At, 0, 1); PG8_STAGE(PG8_SA(0, 0), a2, voffA);
            PG8_BAR; PG8_WAIT_L(0); PG8_MMA(1, 0, At, B0); PG8_BAR; PG8_SCHED;
            PG8_STAGE(PG8_SB(0, 1), b2 + hstep, voffB);
            PG8_WAIT_V(6); PG8_BAR; PG8_MMA(1, 1, At, B1); PG8_BAR;
            PG8_LDB(B0, 1, 0); PG8_SCHED; PG8_LDA(At, 1, 0); PG8_STAGE(PG8_SA(0, 1), a2 + hstep, voffA);
            PG8_WAIT_L(8); PG8_BAR; PG8_WAIT_L(0); PG8_MMA(0, 0, At, B0); PG8_BAR; PG8_SCHED;
            PG8_LDB(B1, 1, 1); PG8_STAGE(PG8_SB(1, 0), b3, voffB);
            PG8_BAR; PG8_WAIT_L(0); PG8_MMA(0, 1, At, B1); PG8_BAR;
            PG8_LDA(At, 1, 1); PG8_STAGE(PG8_SA(1, 0), a3, voffA);
            PG8_BAR; PG8_WAIT_L(0); PG8_MMA(1, 0, At, B0); PG8_BAR; PG8_SCHED;
            PG8_STAGE(PG8_SB(1, 1), b3 + hstep, voffB);
            PG8_WAIT_V(6); PG8_BAR; PG8_MMA(1, 1, At, B1); PG8_BAR;
            }
        }
        if constexpr (ALIGN_EPI) { if (wr == 0) PG8_BAR; }
        if constexpr (!Epi::AFTER_DRAIN) { E(acc, cur, wr, wc, fr, fq); S.done(cur); }
        if (!has_next) break;
#pragma unroll
        for (int a = 0; a < 2; ++a)
#pragma unroll
            for (int b = 0; b < 2; ++b)
#pragma unroll
                for (int m = 0; m < 4; ++m)
#pragma unroll
                    for (int n = 0; n < 2; ++n) acc[a][b][m][n] = (f32x4){0.f, 0.f, 0.f, 0.f};
        cur = nxt; cA = nA; cB = nB; ++ui;
        if constexpr (ALIGN_EPI) { if (wr == 1) PG8_BAR; }
    }
    PG8_WAIT_V(0);
    if constexpr (!ALIGN_EPI) { if (wr == 0) PG8_BAR; }
    PG8_BAR;
    if constexpr (Epi::AFTER_DRAIN) { E.fused(acc, cur, wr, wc, fr, fq, lds, wid, lane); S.done(cur); }
#undef PG8_SA
#undef PG8_SB
#undef PG8_STAGE
#undef PG8_LDA
#undef PG8_LDB
#undef PG8_MMA
#undef PG8_WAIT_V
#undef PG8_WAIT_L
#undef PG8_BAR
#undef PG8_SCHED
}
}

#ifndef PG8_SP2
#define PG8_SP2 true
#endif
#ifndef PG8_ALIGN
#define PG8_ALIGN true
#endif
#define XB_TMO      128
#define XB_XCNT(j)  (256  + 64 * (j))
#define XB_XSUB(j)  (1280 + 64 * (j))
#define XB_XGEN(j)  (2304 + 64 * (j))
#define XB_TOP      3328
#define XB_TOPGEN   3392
#define XCD_BAR_WORDS 3456
#define XB_SPIN_CAP (1u << 18)

__device__ __forceinline__ unsigned xb_ld(unsigned* p)              { return __hip_atomic_load(p, __ATOMIC_RELAXED, __HIP_MEMORY_SCOPE_AGENT); }
__device__ __forceinline__ unsigned xb_add(unsigned* p, unsigned v) { return __hip_atomic_fetch_add(p, v, __ATOMIC_RELAXED, __HIP_MEMORY_SCOPE_AGENT); }
__device__ __forceinline__ unsigned xb_xcc_id() { return (unsigned)__builtin_amdgcn_s_getreg((3 << 11) | 20) & 0xFu; }
#define XB_SPIN(cond, bar) do { unsigned _sp = 0; while (cond) { __builtin_amdgcn_s_sleep(1); \
    if ((++_sp & 255u) == 0u) { if (xb_ld(&(bar)[XB_TMO])) break; if (_sp > XB_SPIN_CAP) { atomicAdd(&(bar)[XB_TMO], 1u); break; } } } } while (0)

struct XcdBarrier {
    unsigned* bar; unsigned x;
    volatile LAS unsigned* st;
};

__device__ __forceinline__ XcdBarrier xcd_barrier_post(unsigned* bar, volatile LAS unsigned* st) {
    XcdBarrier b; b.bar = bar; b.x = xb_xcc_id(); b.st = st;
    if (threadIdx.x == 0) (void)xb_add(&bar[XB_XCNT(b.x)], 1u);
    return b;
}
__device__ __forceinline__ void xcd_barrier_complete(unsigned* bar, unsigned x, unsigned& nloc, unsigned& nx) {
    const unsigned G = gridDim.x * gridDim.y * gridDim.z;
    unsigned sum, cnt, mine, sp = 0u;
    for (;;) {
        sum = 0u; cnt = 0u; mine = 0u;
#pragma unroll
        for (unsigned j = 0; j < 16; ++j) { const unsigned c = xb_ld(&bar[XB_XCNT(j)]); sum += c; cnt += (c > 0u) ? 1u : 0u; mine = (j == x) ? c : mine; }
        if (sum == G) break;
        __builtin_amdgcn_s_sleep(1);
        if ((++sp & 255u) == 0u) { if (xb_ld(&bar[XB_TMO])) break; if (sp > XB_SPIN_CAP) { atomicAdd(&bar[XB_TMO], 1u); break; } }
    }
    nloc = mine > 0u ? mine : 1u; nx = cnt > 0u ? cnt : 1u;
}

__device__ __forceinline__ void xcd_barrier(const XcdBarrier& b, const bool is_t0  ) {
    asm volatile("s_waitcnt vmcnt(0)" ::: "memory");
    __syncthreads();
    if (is_t0) {
        unsigned* bar = b.bar;
        __builtin_amdgcn_s_waitcnt(0);
        unsigned nloc = b.st[0], nx = b.st[1];
        if (nloc == 0u) { xcd_barrier_complete(bar, b.x, nloc, nx); b.st[0] = nloc; b.st[1] = nx; }
        const unsigned old = xb_add(&bar[XB_XSUB(b.x)], 1u);
        const unsigned gen = old / nloc;
        if (old + 1u == (gen + 1u) * nloc) {
            __builtin_amdgcn_fence(__ATOMIC_RELEASE, "agent");
            asm volatile("s_waitcnt vmcnt(0)" ::: "memory");
            const unsigned og = xb_add(&bar[XB_TOP], 1u);
            const unsigned tg = og / nx;
            if (og + 1u == (tg + 1u) * nx) xb_add(&bar[XB_TOPGEN], 1u);
            else XB_SPIN(xb_ld(&bar[XB_TOPGEN]) == tg, bar);
            __builtin_amdgcn_fence(__ATOMIC_ACQUIRE, "agent");
            xb_add(&bar[XB_XGEN(b.x)], 1u);
            asm volatile("s_waitcnt vmcnt(0)" ::: "memory");
        } else {
            XB_SPIN(xb_ld(&bar[XB_XGEN(b.x)]) == gen, bar);
            __builtin_amdgcn_fence(__ATOMIC_ACQUIRE, "agent");
            asm volatile("s_waitcnt vmcnt(0)" ::: "memory");
        }
    }
    __syncthreads();
}
struct EpiResBf16 {
    static constexpr bool PERM = true, AFTER_DRAIN = false;
    const bf16* xin; bf16* yp; float alpha;
    DI void operator()(const pg8::f32x4 (&acc)[2][2][4][2], const pg8::Unit& u, int wr, int wc, int fr, int fq) const {
        const int row0 = u.pm * 256 + wr * 64 + fr, col0 = u.pn * 256 + wc * 32 + 8 * fq;
#pragma unroll
        for (int ai = 0; ai < 2; ++ai)
#pragma unroll
            for (int m = 0; m < 4; ++m) {
                const size_t ro = (size_t)(row0 + ai * 128 + m * 16) * DM;
#pragma unroll
                for (int bj = 0; bj < 2; ++bj) {
                    const size_t o = ro + col0 + bj * 128;
                    const v4u xv = *(const v4u*)(xin + o);
                    const f32x4 a0 = acc[ai][bj][m][0], a1 = acc[ai][bj][m][1];
                    v4u w;
                    w.x = cvtpk(bf2f(xv.x & 0xffffu) * alpha + a0[0], bf2f(xv.x >> 16) * alpha + a0[1]); w.y = cvtpk(bf2f(xv.y & 0xffffu) * alpha + a0[2], bf2f(xv.y >> 16) * alpha + a0[3]);
                    w.z = cvtpk(bf2f(xv.z & 0xffffu) * alpha + a1[0], bf2f(xv.z >> 16) * alpha + a1[1]); w.w = cvtpk(bf2f(xv.w & 0xffffu) * alpha + a1[2], bf2f(xv.w >> 16) * alpha + a1[3]);
                    *(v4u*)(yp + o) = w;
                }
            }
    }
};
struct EpiSwiglu {
    static constexpr bool PERM = true, AFTER_DRAIN = false;
    unsigned char* act; const float* bgu;
    DI void operator()(const pg8::f32x4 (&acc)[2][2][4][2], const pg8::Unit& u, int wr, int wc, int fr, int fq) const {
        const int e = u.pn >> 3, pl = u.pn & 7;
        const int row0 = u.pm * 256 + wr * 64 + fr, cih = pl * 128 + wc * 32 + 8 * fq;
        const float* bg = bgu + e * 2048 + cih;
        const f32x4 bg0 = *(const f32x4*)(bg), bg1 = *(const f32x4*)(bg + 4), bu0 = *(const f32x4*)(bg + 1024), bu1 = *(const f32x4*)(bg + 1028);
#pragma unroll
        for (int ai = 0; ai < 2; ++ai)
#pragma unroll
            for (int m = 0; m < 4; ++m) {
                constexpr float RS = 1.f / (F8_SX * F8_SWG);
                const f32x4 g0 = acc[ai][0][m][0] * RS + bg0, g1 = acc[ai][0][m][1] * RS + bg1, u0 = acc[ai][1][m][0] * RS + bu0, u1 = acc[ai][1][m][1] * RS + bu1;
                float r[8];
#pragma unroll
                for (int i = 0; i < 8; ++i) {
                    float g = i < 4 ? g0[i & 3] : g1[i & 3], uu = i < 4 ? u0[i & 3] : u1[i & 3];
                    g = fminf(g, 7.0f); uu = fminf(fmaxf(uu, -7.0f), 7.0f);
                    const float sg = __builtin_amdgcn_rcpf(1.0f + ex2(-1.702f * LOG2E * g));
                    r[i] = (uu + 1.0f) * g * sg * F8_SA;
                }
                v2u w; w.x = pk4_fp8(r[0], r[1], r[2], r[3]); w.y = pk4_fp8(r[4], r[5], r[6], r[7]);
                *(v2u*)(act + (size_t)(row0 + ai * 128 + m * 16) * DM + cih) = w;
            }
    }
};
struct EpiDown {
    static constexpr bool PERM = true, AFTER_DRAIN = false;
    bf16* yr; const float* bdn;
    DI void operator()(const pg8::f32x4 (&acc)[2][2][4][2], const pg8::Unit& u, int wr, int wc, int fr, int fq) const {
        const int e = u.pn >> 2, pl = u.pn & 3;
        const int row0 = u.pm * 256 + wr * 64 + fr, col0 = pl * 256 + wc * 32 + 8 * fq;
        f32x4 bv[2][2];
#pragma unroll
        for (int bj = 0; bj < 2; ++bj) { bv[bj][0] = *(const f32x4*)(bdn + e * 1024 + col0 + bj * 128); bv[bj][1] = *(const f32x4*)(bdn + e * 1024 + col0 + bj * 128 + 4); }
#pragma unroll
        for (int ai = 0; ai < 2; ++ai)
#pragma unroll
            for (int m = 0; m < 4; ++m) {
                bf16* rp = yr + (size_t)(row0 + ai * 128 + m * 16) * DM + col0;
#pragma unroll
                for (int bj = 0; bj < 2; ++bj) {
                    constexpr float RS = 1.f / (F8_SA * F8_SWD);
                    const f32x4 v0 = acc[ai][bj][m][0] * RS + bv[bj][0], v1 = acc[ai][bj][m][1] * RS + bv[bj][1];
                    v4u w; w.x = cvtpk(v0[0], v0[1]); w.y = cvtpk(v0[2], v0[3]); w.z = cvtpk(v1[0], v1[1]); w.w = cvtpk(v1[2], v1[3]);
                    *(v4u*)(rp + bj * 128) = w;
                }
            }
    }
};
struct GroupOrder {
    LAS const unsigned* tile_e; int ntiles, lg, G, c;
    DI bool next(int i, pg8::Unit& u) const {
        int pm, pl;
        if (G == 256) {
            const int x = c & 7, k = c >> 3; pm = i * (256 >> lg) + x * (32 >> lg) + (k >> lg); pl = k & ((1 << lg) - 1); if (pm >= ntiles) return false; }
        else { const long L = (long)i * G + c; if (L >= ((long)ntiles << lg)) return false; pm = (int)(L >> lg); pl = (int)(L & ((1 << lg) - 1)); }
        const int e = __builtin_amdgcn_readfirstlane((int)tile_e[pm]);
        u.pm = pm; u.pn = (e << lg) + pl; return true;
    }
    DI void a_ready(const pg8::Unit&) const {}
    DI void done(const pg8::Unit&) const {}
};
struct Args { const float* in[18]; float* out; unsigned char* ws; int ph_lo, ph_hi; };
struct Fr { LAS unsigned char* lds; unsigned char* ws; unsigned* ctl; int tid, lane, wave, blk, G; };

DI void tr_item(const float* W, int ldw, int K, int k0, int sc0, int nvalid, bf16* WT, int drow0, LAS float* scr, int lane) {
    const int c = lane & 31;
    float v[32];
#pragma unroll
    for (int i = 0; i < 32; ++i) v[i] = (c < nvalid) ? W[(size_t)(k0 + 2 * i + (lane >> 5)) * ldw + sc0 + c] : 0.f;
#pragma unroll
    for (int i = 0; i < 32; ++i) scr[(2 * i + (lane >> 5)) * 33 + c] = v[i];
    LDS_WAIT(); asm volatile("" ::: "memory");
    const int c8 = lane & 7;
#pragma unroll
    for (int j = 0; j < 4; ++j) { const int n = (lane >> 3) + 8 * j; const LAS float* s = scr + (8 * c8) * 33 + n;
        v4u o; o.x = cvtpk(s[0 * 33], s[1 * 33]); o.y = cvtpk(s[2 * 33], s[3 * 33]); o.z = cvtpk(s[4 * 33], s[5 * 33]); o.w = cvtpk(s[6 * 33], s[7 * 33]);
        *(v4u*)(WT + (size_t)(drow0 + n) * K + k0 + 8 * c8) = o; }
    LDS_WAIT(); asm volatile("" ::: "memory");
}
DI void tr_item8(const float* W, int ldw, int K, int k0, int sc0, float scale, unsigned char* WT8, int drow0, LAS float* scr, int lane) {
    const int c = lane & 31;
    float v[32];
#pragma unroll
    for (int i = 0; i < 32; ++i) v[i] = W[(size_t)(k0 + 2 * i + (lane >> 5)) * ldw + sc0 + c];
#pragma unroll
    for (int i = 0; i < 32; ++i) scr[(2 * i + (lane >> 5)) * 33 + c] = v[i] * scale;
    LDS_WAIT(); asm volatile("" ::: "memory");
    const int c16 = lane & 3;
#pragma unroll
    for (int j = 0; j < 2; ++j) { const int n = (lane >> 2) + 16 * j; const LAS float* s = scr + (16 * c16) * 33 + n;
        v4u o; o.x = pk4_fp8(s[0 * 33], s[1 * 33], s[2 * 33], s[3 * 33]); o.y = pk4_fp8(s[4 * 33], s[5 * 33], s[6 * 33], s[7 * 33]);
        o.z = pk4_fp8(s[8 * 33], s[9 * 33], s[10 * 33], s[11 * 33]); o.w = pk4_fp8(s[12 * 33], s[13 * 33], s[14 * 33], s[15 * 33]);
        *(v4u*)(WT8 + (size_t)(drow0 + n) * K + k0 + 16 * c16) = o; }
    LDS_WAIT(); asm volatile("" ::: "memory");
}
DI void ph_prologue(const Args& a, const Fr& F) {
    LAS float* scr = (LAS float*)(F.lds + F.wave * 16384);
    const int gw = F.blk * NWAVES + F.wave, NGW = F.G * NWAVES;
    constexpr int I_EV = 2 * 16 * 80, I_OD = 2 * 16 * 96, I_WO = 4 * 16 * 32;
    constexpr int NITEMS = I_EV + I_OD + I_WO;
    bf16* wev = (bf16*)(F.ws + WS_WEV); bf16* wod = (bf16*)(F.ws + WS_WOD); bf16* wout = (bf16*)(F.ws + WS_WOUT);
    unsigned char* wgu = F.ws + WS_WGU; unsigned char* wdn = F.ws + WS_WDN;
    for (int it = gw; it < NITEMS; it += NGW) {
        int r = it;
        if (r < I_EV) { const int l = r / 1280; r %= 1280; const int kb = r / 80, n0 = (r % 80) * 32; int sc0, nv = 32;
            if (n0 < 512) sc0 = n0; else if (n0 < 1024) sc0 = 964 + (n0 - 512); else if (n0 < 1536) sc0 = 1476 + (n0 - 1024); else if (n0 < 2048) sc0 = 1988 + (n0 - 1536);
            else if (n0 < 2176) sc0 = 512 + (n0 - 2048); else if (n0 < 2432) sc0 = 640 + (n0 - 2176); else if (n0 < 2496) sc0 = 896 + (n0 - 2432);
            else if (n0 < 2528) { sc0 = 960; nv = 4; } else { sc0 = 0; nv = 0; }
            tr_item(a.in[1] + (size_t)l * 1024 * 2500, 2500, 1024, kb * 64, sc0, nv, wev + (size_t)l * EV_N * 1024, n0, scr, F.lane); continue; }
        r -= I_EV;
        if (r < I_OD) { const int l = r / 1536; r %= 1536; const int kb = r / 96, n0 = (r % 96) * 32;
            tr_item(a.in[6] + (size_t)l * 1024 * 3088, 3088, 1024, kb * 64, n0, 32, wod + (size_t)l * OD_N * 1024, n0, scr, F.lane); continue; }
        r -= I_OD;
        if (r < I_WO) { const int l = r / 512; r %= 512; const int kb = r / 32, n0 = (r % 32) * 32;
            const float* src = (l & 1) ? a.in[8] + (size_t)(l >> 1) * 1024 * 1024 : a.in[5] + (size_t)(l >> 1) * 1024 * 1024;
            tr_item(src, 1024, 1024, kb * 64, n0, 32, wout + (size_t)l * 1024 * 1024, n0, scr, F.lane); continue; }
    }
    { __syncthreads();
        LAS float* tile = (LAS float*)F.lds; unsigned char* wgu8 = F.ws + WS_WGU; unsigned char* wdn8 = F.ws + WS_WDN;
        constexpr int T_GU = 128 * 8 * 16, T_DN = 128 * 8 * 8, T_ALL = T_GU + T_DN;
        const int tid = F.tid, c4 = tid & 31, r0 = tid >> 5;
        f32x4 v[8];
        auto locate = [&](int t, const float*& src, int& ldw, unsigned char*& dst, float& scale) {
            if (t < T_GU) { const int le = t >> 7, r = t & 127, kb = r >> 4, nb = r & 15, n0 = nb * 128; const int pn = n0 >> 8, bj = (n0 >> 7) & 1;
                src = a.in[14] + (size_t)le * 1024 * 2048 + (size_t)(kb * 128) * 2048 + bj * 1024 + pn * 128; ldw = 2048; dst = wgu8 + (size_t)le * 2048 * 1024 + (size_t)n0 * 1024 + kb * 128; scale = F8_SWG; }
            else { const int u = t - T_GU, le = u >> 6, r = u & 63, kb = r >> 3, nb = r & 7;
                src = a.in[16] + (size_t)le * 1024 * 1024 + (size_t)(kb * 128) * 1024 + nb * 128; ldw = 1024; dst = wdn8 + (size_t)le * 1024 * 1024 + (size_t)(nb * 128) * 1024 + kb * 128; scale = F8_SWD; } };
        int t = F.blk;
        if (t < T_ALL) { const float* src; int ldw; unsigned char* dst; float sc; locate(t, src, ldw, dst, sc);
#pragma unroll
            for (int i = 0; i < 8; ++i) v[i] = *(const f32x4*)(src + (size_t)(r0 + 16 * i) * ldw + 4 * c4); }
        for (; t < T_ALL; t += F.G) {
            const float* src; int ldw; unsigned char* dst; float sc; locate(t, src, ldw, dst, sc);
#pragma unroll
            for (int i = 0; i < 8; ++i) { LAS float* tp = tile + (r0 + 16 * i) * 129 + 4 * c4; tp[0] = v[i][0] * sc; tp[1] = v[i][1] * sc; tp[2] = v[i][2] * sc; tp[3] = v[i][3] * sc; }
            __syncthreads();
            if (t + F.G < T_ALL) { const float* s2; int l2; unsigned char* d2; float c2; locate(t + F.G, s2, l2, d2, c2);
#pragma unroll
                for (int i = 0; i < 8; ++i) v[i] = *(const f32x4*)(s2 + (size_t)(r0 + 16 * i) * l2 + 4 * c4); }
#pragma unroll
            for (int j = 0; j < 2; ++j) { const int p = tid + 512 * j, kc = p & 7, n = p >> 3; const LAS float* sp = tile + (kc * 16) * 129 + n;
                v4u o; o.x = pk4_fp8(sp[0], sp[129], sp[2 * 129], sp[3 * 129]); o.y = pk4_fp8(sp[4 * 129], sp[5 * 129], sp[6 * 129], sp[7 * 129]);
                o.z = pk4_fp8(sp[8 * 129], sp[9 * 129], sp[10 * 129], sp[11 * 129]); o.w = pk4_fp8(sp[12 * 129], sp[13 * 129], sp[14 * 129], sp[15 * 129]);
                *(v4u*)(dst + (size_t)n * 1024 + kc * 16) = o; }
            __syncthreads();
        }
    }
    bf16* xb = (bf16*)(F.ws + WS_XB);
    for (int m = gw; m < NTOK; m += NGW) {
        const f32x4* xr = (const f32x4*)(a.in[0] + (size_t)m * DM) + F.lane; v2u* o = (v2u*)(xb + (size_t)m * DM) + F.lane;
#pragma unroll
        for (int j = 0; j < 4; ++j) { const f32x4 v = xr[64 * j]; v2u w; w.x = cvtpk(v[0], v[1]); w.y = cvtpk(v[2], v[3]); o[64 * j] = w; }
    }
    bf16* wukt = (bf16*)(F.ws + WS_WUKT); bf16* wuvt = (bf16*)(F.ws + WS_WUVT);
    for (int i = F.blk * NTHR + F.tid; i < 2 * 8 * 128 * 64; i += F.G * NTHR) {
        { const int d = i & 63, c = (i >> 6) & 127, lh = i >> 13; wukt[i] = (bf16)f2bf(a.in[2][((size_t)lh * 64 + d) * 128 + c]); }
        { const int c = i & 127, d = (i >> 7) & 63, lh = i >> 13; wuvt[i] = (bf16)f2bf(a.in[3][((size_t)lh * 128 + c) * 64 + d]); }
    }
}

DI void ln_row(f32x4 (&v)[4], const float* g, const float* b, int lane) {
    float s = 0.f;
#pragma unroll
    for (int j = 0; j < 4; ++j) s += (v[j][0] + v[j][1]) + (v[j][2] + v[j][3]);
    const float mean = wave_sum(s) * (1.f / DM); float s2 = 0.f;
#pragma unroll
    for (int j = 0; j < 4; ++j) { v[j] = v[j] - mean; s2 += (v[j][0] * v[j][0] + v[j][1] * v[j][1]) + (v[j][2] * v[j][2] + v[j][3] * v[j][3]); }
    const float rstd = 1.f / sqrtf(wave_sum(s2) * (1.f / DM) + LN_EPS);
#pragma unroll
    for (int j = 0; j < 4; ++j) { const f32x4 gg = *((const f32x4*)g + lane + 64 * j), bb = *((const f32x4*)b + lane + 64 * j); v[j] = v[j] * rstd * gg + bb; }
}
DI void store_row_f32(float* p, const f32x4 (&v)[4], int lane) {
#pragma unroll
    for (int j = 0; j < 4; ++j) *((f32x4*)p + lane + 64 * j) = v[j];
}
DI void store_row_bf16(bf16* p, const f32x4 (&v)[4], int lane) {
#pragma unroll
    for (int j = 0; j < 4; ++j) { v2u w; w.x = cvtpk(v[j][0], v[j][1]); w.y = cvtpk(v[j][2], v[j][3]); *((v2u*)p + lane + 64 * j) = w; }
}
template <int NL> DI void small_proj(LAS const float* xs, const float* W, int ldw, int lane, float (&acc)[4]) {
    constexpr int PARTS = 64 / NL, DPER = 1024 / PARTS;
    const int n = lane & (NL - 1), part = lane / NL;
    acc[0] = acc[1] = acc[2] = acc[3] = 0.f;
    const float* wp = W + (size_t)(part * DPER) * ldw + n;
    LAS const float* xp = xs + part * DPER;
#pragma unroll 8
    for (int d = 0; d < DPER; ++d) { const float w = wp[(size_t)d * ldw];
        acc[0] += w * xp[d]; acc[1] += w * xp[1024 + d]; acc[2] += w * xp[2048 + d]; acc[3] += w * xp[3072 + d]; }
#pragma unroll
    for (int o = NL; o < 64; o <<= 1) {
#pragma unroll
        for (int k = 0; k < 4; ++k) acc[k] += __shfl_xor(acc[k], o); }
}

DI void ph_even_prep(const Args& a, const Fr& F, int j) {
    const bf16* proj = (const bf16*)(F.ws + WS_PROJ);
    bf16* ckvn = (bf16*)(F.ws + WS_CKVN); bf16* ql = (bf16*)(F.ws + WS_QL); float* kbar = (float*)(F.ws + WS_KBAR);
    const float* kvg = a.in[4] + j * 128;
    const bf16* wukt = (const bf16*)(F.ws + WS_WUKT) + (size_t)j * 8 * 128 * 64;
    const int lane = F.lane, wave = F.wave;
    for (int chunk = F.blk; chunk < 256; chunk += F.G) {
        const int tok0 = chunk * 128;
#pragma unroll 1
        for (int i0 = 0; i0 < 16; i0 += 8) { unsigned wv[8];
#pragma unroll
            for (int i = 0; i < 8; ++i) wv[i] = *((const unsigned*)(proj + (size_t)(tok0 + wave * 16 + i0 + i) * EV_N + EC_CKV) + lane);
#pragma unroll
            for (int i = 0; i < 8; ++i) { const int tok = tok0 + wave * 16 + i0 + i; const float v0 = bf2f(wv[i] & 0xffffu), v1 = bf2f(wv[i] >> 16);
                const float ss = wave_sum(v0 * v0 + v1 * v1);
                const float r = 1.f / sqrtf(ss * (1.f / 128.f) + LN_EPS);
                *((unsigned*)(ckvn + (size_t)tok * 128) + lane) = cvtpk(v0 * r * kvg[2 * lane], v1 * r * kvg[2 * lane + 1]); } }
        { bf16* kic = (bf16*)(F.ws + WS_KIC); const int tok = tok0 + wave * 16 + (lane >> 2), c = (lane & 3) * 16;
            const v4u* src = (const v4u*)(proj + (size_t)tok * EV_N + EC_KI + c); v4u* dst = (v4u*)(kic + (size_t)tok * 64 + c); dst[0] = src[0]; dst[1] = src[1]; }
        { const int h = wave, l15 = lane & 15, kg = lane >> 4;
            bf16x8 af[8][2];
#pragma unroll
            for (int ct = 0; ct < 8; ++ct)
#pragma unroll
                for (int ks = 0; ks < 2; ++ks) af[ct][ks] = *(const bf16x8*)(wukt + ((size_t)h * 128 + ct * 16 + l15) * 64 + ks * 32 + kg * 8);
#pragma unroll 1
            for (int tg = 0; tg < 8; tg += 4) { bf16x8 qf[4][2];
#pragma unroll
                for (int u = 0; u < 4; ++u)
#pragma unroll
                    for (int ks = 0; ks < 2; ++ks) qf[u][ks] = *(const bf16x8*)(proj + (size_t)(tok0 + (tg + u) * 16 + l15) * EV_N + EC_QA + h * 64 + ks * 32 + kg * 8);
#pragma unroll
                for (int u = 0; u < 4; ++u) { const int tok = tok0 + (tg + u) * 16 + l15;
#pragma unroll
                    for (int ct = 0; ct < 8; ++ct) { f32x4 d = {0.f, 0.f, 0.f, 0.f};
                        d = mfma16(af[ct][0], qf[u][0], d); d = mfma16(af[ct][1], qf[u][1], d);
                        v2u w; w.x = cvtpk(d[0], d[1]); w.y = cvtpk(d[2], d[3]);
                        *(v2u*)(ql + (size_t)tok * 1024 + h * 128 + ct * 16 + 4 * kg) = w; } } } }
        if (chunk < 128) { const int b = chunk >> 5, n = chunk & 31; float s8[8];
#pragma unroll
            for (int k = 0; k < 8; ++k) s8[k] = 0.f;
            const bf16* kp = proj + ((size_t)b * SEQ + n * 256 + wave * 32) * EV_N + EC_KB + lane * 8;
#pragma unroll 8
            for (int r = 0; r < 32; ++r) { const v4u w = *(const v4u*)(kp + (size_t)r * EV_N);
#pragma unroll
                for (int k = 0; k < 4; ++k) { s8[2 * k] += bf2f(w[k] & 0xffffu); s8[2 * k + 1] += bf2f(w[k] >> 16); } }
            LAS float* red = (LAS float*)F.lds;
            __syncthreads();
#pragma unroll
            for (int k = 0; k < 8; ++k) red[wave * 512 + lane * 8 + k] = s8[k];
            __syncthreads();
            float s = 0.f;
#pragma unroll
            for (int w = 0; w < 8; ++w) s += red[w * 512 + F.tid];
            const int h = F.tid >> 6, d = F.tid & 63;
            kbar[(((size_t)b * 8 + h) * 32 + n) * 64 + d] = s * (1.f / 256.f); }
    }
}

DI void moba_gate_chunk(const Fr& F, int chunk) {
    const bf16* proj = (const bf16*)(F.ws + WS_PROJ); const float* kbar = (const float*)(F.ws + WS_KBAR); unsigned* sel3 = (unsigned*)(F.ws + WS_SEL3);
    const int tok0 = chunk * 128, b = tok0 / SEQ, own = (tok0 % SEQ) >> 8, h = F.wave, lane = F.lane;
    float q0[64], q1[64];
    { const v4u* p0 = (const v4u*)(proj + (size_t)(tok0 + lane) * EV_N + EC_QB + h * 64); const v4u* p1 = (const v4u*)(proj + (size_t)(tok0 + 64 + lane) * EV_N + EC_QB + h * 64);
#pragma unroll
        for (int i = 0; i < 8; ++i) { const v4u w0 = p0[i], w1 = p1[i];
#pragma unroll
            for (int k = 0; k < 4; ++k) { q0[8 * i + 2 * k] = bf2f(w0[k] & 0xffffu); q0[8 * i + 2 * k + 1] = bf2f(w0[k] >> 16); q1[8 * i + 2 * k] = bf2f(w1[k] & 0xffffu); q1[8 * i + 2 * k + 1] = bf2f(w1[k] >> 16); } } }
    float a0 = -INFINITY, a1 = -INFINITY, a2 = -INFINITY, c0 = -INFINITY, c1 = -INFINITY, c2 = -INFINITY; int ai0 = 0, ai1 = 0, ai2 = 0, ci0 = 0, ci1 = 0, ci2 = 0;
    const float* kb = kbar + (((size_t)b * 8 + h) * 32) * 64;
    for (int n = 0; n < own; ++n) { float g0 = 0.f, g1 = 0.f;
#pragma unroll
        for (int d = 0; d < 64; d += 4) { const f32x4 kv = *(const f32x4*)(kb + n * 64 + d);
#pragma unroll
            for (int k = 0; k < 4; ++k) { g0 += q0[d + k] * kv[k]; g1 += q1[d + k] * kv[k]; } }
        if (g0 > a2) { if (g0 > a1) { a2 = a1; ai2 = ai1; if (g0 > a0) { a1 = a0; ai1 = ai0; a0 = g0; ai0 = n; } else { a1 = g0; ai1 = n; } } else { a2 = g0; ai2 = n; } }
        if (g1 > c2) { if (g1 > c1) { c2 = c1; ci2 = ci1; if (g1 > c0) { c1 = c0; ci1 = ci0; c0 = g1; ci0 = n; } else { c1 = g1; ci1 = n; } } else { c2 = g1; ci2 = n; } }
    }
    const unsigned nv = own < 3 ? own : 3;
    sel3[(size_t)(tok0 + lane) * 8 + h] = (unsigned)ai0 | ((unsigned)ai1 << 8) | ((unsigned)ai2 << 16) | (nv << 24);
    sel3[(size_t)(tok0 + 64 + lane) * 8 + h] = (unsigned)ci0 | ((unsigned)ci1 << 8) | ((unsigned)ci2 << 16) | (nv << 24);
}

constexpr int HS = 257;
DI float relu1(float x) { const unsigned u = __float_as_uint(x); return __uint_as_float(u & ~(unsigned)((int)u >> 31)); }
template <int MODE, bool DIAG> DI void idx_tile(const bf16x8 (&kf)[4], LAS const char* qb  , const float (&wj)[4], int kt, int q, int hi, unsigned c0, unsigned c1,
                                     LAS unsigned* hist, LAS unsigned* mask, LAS unsigned* cmask, LAS unsigned long long* cand, LAS unsigned* rinfo) {
    f32x2 scp[8];
#pragma unroll
    for (int p = 0; p < 8; ++p) scp[p] = (f32x2){0.f, 0.f};
    bf16x8 qv0[2][4], qv1[2][4];
#pragma unroll
    for (int j = 0; j < 2; ++j)
#pragma unroll
        for (int s = 0; s < 4; ++s) qv0[j][s] = *(LAS const bf16x8*)(qb + (j * 8 + s * 2) * 512);
#pragma unroll
    for (int j = 0; j < 2; ++j)
#pragma unroll
        for (int s = 0; s < 4; ++s) qv1[j][s] = *(LAS const bf16x8*)(qb + ((2 + j) * 8 + s * 2) * 512);
    __builtin_amdgcn_sched_barrier(0);
#pragma unroll
    for (int g = 0; g < 2; ++g) { f32x16 acc[2];
#pragma unroll
        for (int j = 0; j < 2; ++j)
#pragma unroll
            for (int r = 0; r < 16; ++r) acc[j][r] = 0.f;
#pragma unroll
        for (int s = 0; s < 4; ++s)
#pragma unroll
            for (int j = 0; j < 2; ++j) { if (MODE != -2) acc[j] = mfma32(kf[s], g == 0 ? qv0[j][s] : qv1[j][s], acc[j]); else acc[j][s] += __builtin_bit_cast(float, (unsigned)(kf[s][0] ^ (g == 0 ? qv0[j][s][0] : qv1[j][s][0]))); }
#pragma unroll
        for (int p = 0; p < 8; ++p)
#pragma unroll
            for (int j = 0; j < 2; ++j) { const f32x2 a = {relu1(acc[j][2 * p]), relu1(acc[j][2 * p + 1])}; const f32x2 w2 = {wj[2 * g + j], wj[2 * g + j]}; scp[p] = a * w2 + scp[p]; } }
    unsigned sel = 0u, cnd = 0u;
    if (MODE <= 0) { float t = 0.f;
#pragma unroll
        for (int p = 0; p < 8; ++p) t += scp[p][0] + scp[p][1];
        if (t == 12345.678f) __hip_atomic_fetch_or(mask + q * HS + kt, 1u, __ATOMIC_RELAXED, __HIP_MEMORY_SCOPE_WORKGROUP);
        return; }
    const float F0 = __uint_as_float(c0), F1 = __uint_as_float(c1);
#pragma unroll
    for (int r = 0; r < 16; ++r) { const int kr = crow(r, hi);
        const bool ok = !DIAG || kr <= q;
        const float scv = scp[r >> 1][r & 1]; const unsigned u = __float_as_uint(scv);
        if (MODE == 1) { const unsigned key = u ^ ((unsigned)((int)u >> 31) | 0x80000000u);
            if (ok && (key >> 24) >= c0) __hip_atomic_fetch_add(hist + q * HS + (key >> 24), 1u, __ATOMIC_RELAXED, __HIP_MEMORY_SCOPE_WORKGROUP); }
        else if (MODE == 2) { if (ok && (u >> 24) == c0) __hip_atomic_fetch_add(hist + q * HS + (((u >> 16) & 255u) ^ c1), 1u, __ATOMIC_RELAXED, __HIP_MEMORY_SCOPE_WORKGROUP); }
        else { const bool ge1 = scv >= F1, ge0 = scv >= F0;
            if (ok && ge1) sel |= 1u << kr;
            if (ok && ge0 && !ge1) { cnd |= 1u << kr; const unsigned key = u ^ ((unsigned)((int)u >> 31) | 0x80000000u);
                const unsigned pos = __hip_atomic_fetch_add(rinfo + 128 + q, 1u, __ATOMIC_RELAXED, __HIP_MEMORY_SCOPE_WORKGROUP);
                if (pos < 64u) cand[q * 64 + pos] = ((unsigned long long)key << 32) | (unsigned)(~(unsigned)(kt * 32 + kr)); } } }
    if (MODE == 3) { if (sel) __hip_atomic_fetch_or(mask + q * HS + kt, sel, __ATOMIC_RELAXED, __HIP_MEMORY_SCOPE_WORKGROUP);
        if (cnd) __hip_atomic_fetch_or(cmask + q * HS + kt, cnd, __ATOMIC_RELAXED, __HIP_MEMORY_SCOPE_WORKGROUP); }
}
template <int MODE> DI void idx_pass(const bf16* proj, int rowbase, int qt, LAS const char* qimg, const float (&wj)[4], LAS unsigned* hist, LAS unsigned* mask, LAS unsigned* cmask, LAS unsigned long long* cand, LAS unsigned* rinfo, int wave, int lane) {
    const int q = lane & 31, hi = lane >> 5, nkt = qt + 1;
    const unsigned b1 = MODE == 2 ? rinfo[160 + q] : rinfo[224 + q], thr16 = MODE == 2 ? rinfo[192 + q] : rinfo[256 + q];
    const bf16* kp0 = proj + (size_t)(rowbase + q) * 64 + hi * 8;
    LAS const char* qb = qimg + hi * 512 + q * 16;
    const int n = nkt > wave ? (nkt - wave + 7) >> 3 : 0;
    bf16x8 kfa[4], kfb[4];
#define IDX_LOAD(KF, I) do { const bf16* kp_ = kp0 + (size_t)((wave + 8 * (I)) * 32) * 64; _Pragma("unroll") for (int s_ = 0; s_ < 4; ++s_) KF[s_] = *(const bf16x8*)(kp_ + s_ * 16); } while (0)
#define IDX_TILE(KF, I) do { const int kt_ = wave + 8 * (I); if (kt_ == qt) idx_tile<MODE, true>(KF, qb, wj, kt_, q, hi, b1, thr16, hist, mask, cmask, cand, rinfo); \
        else idx_tile<MODE, false>(KF, qb, wj, kt_, q, hi, b1, thr16, hist, mask, cmask, cand, rinfo); } while (0)
    if (n > 0) IDX_LOAD(kfa, 0);
    for (int i = 0; i < n; i += 2) {
        if (i + 1 < n) { if (MODE == -1) { _Pragma("unroll") for (int s_ = 0; s_ < 4; ++s_) kfb[s_] = kfa[s_]; } else IDX_LOAD(kfb, i + 1); }
        IDX_TILE(kfa, i);
        if (i + 1 < n) { if (i + 2 < n && MODE != -1) IDX_LOAD(kfa, i + 2); IDX_TILE(kfb, i + 1); }
    }
#undef IDX_LOAD
#undef IDX_TILE
}
DI void hist_pick(LAS const unsigned* hrow, unsigned need, int lane, unsigned& bin, unsigned& above) {
    unsigned h4[4];
#pragma unroll
    for (int k = 0; k < 4; ++k) h4[k] = hrow[4 * lane + k];
    const unsigned ssum = h4[0] + h4[1] + h4[2] + h4[3];
    unsigned x = ssum;
#pragma unroll
    for (int o = 1; o < 64; o <<= 1) { const unsigned y = __shfl_down(x, o); if (lane + o < 64) x += y; }
    const unsigned long long m = __ballot(x >= need);
    const int Ls = m ? 63 - __builtin_clzll(m) : 0;
    const unsigned xs = __shfl(x, Ls), ss = __shfl(ssum, Ls);
    const unsigned h0 = __shfl(h4[0], Ls), h1 = __shfl(h4[1], Ls), h2 = __shfl(h4[2], Ls), h3 = __shfl(h4[3], Ls);
    unsigned cum = xs - ss;
    if (cum + h3 >= need) { bin = 4 * Ls + 3; above = cum; return; } cum += h3;
    if (cum + h2 >= need) { bin = 4 * Ls + 2; above = cum; return; } cum += h2;
    if (cum + h1 >= need) { bin = 4 * Ls + 1; above = cum; return; } cum += h1;
    bin = 4 * Ls; above = cum; (void)h0;
}
DI void idx_pass1(const bf16* proj, int rowbase, int qt, LAS const char* qimg, const float (&wj)[4], LAS unsigned* hist, LAS unsigned* mask, LAS unsigned* cmask, LAS unsigned long long* cand, LAS unsigned* rinfo, int wave, int lane) {
    const int q = lane & 31, hi = lane >> 5, nkt = qt + 1, nmax = (nkt + 7) >> 3;
    const bf16* kp0 = proj + (size_t)(rowbase + q) * 64 + hi * 8;
    LAS const char* qb = qimg + hi * 512 + q * 16;
    unsigned lb = 0u;
    bf16x8 kfc[4], kfn[4];
    if (wave < nkt) {
#pragma unroll
        for (int s = 0; s < 4; ++s) kfc[s] = *(const bf16x8*)(kp0 + (size_t)(wave * 32) * 64 + s * 16); }
    for (int i = 0; i < nmax; ++i) { const int kt = wave + 8 * i;
        if (kt + 8 < nkt) {
#pragma unroll
            for (int s = 0; s < 4; ++s) kfn[s] = *(const bf16x8*)(kp0 + (size_t)((kt + 8) * 32) * 64 + s * 16); }
        if (kt < nkt) { if (kt == qt) idx_tile<1, true>(kfc, qb, wj, kt, q, hi, lb, 0u, hist, mask, cmask, cand, rinfo); else idx_tile<1, false>(kfc, qb, wj, kt, q, hi, lb, 0u, hist, mask, cmask, cand, rinfo); }
#pragma unroll
        for (int s = 0; s < 4; ++s) kfc[s] = kfn[s];
        if (((i + 1) & i) == 0 && i + 1 < nmax && i < 16) {
            __syncthreads();
#pragma unroll 1
            for (int rr = 0; rr < 4; ++rr) { const int row = wave * 4 + rr; unsigned bin, above; hist_pick(hist + row * HS, 256u, lane, bin, above);
                if (lane == 0) rinfo[288 + row] = bin; }
            __syncthreads();
            { const unsigned nb = rinfo[288 + q]; lb = nb > lb ? nb : lb; } }
    }
}
DI void idx_unit(const Fr& F, int b, int qt, int stop = 0  ) {
    const bf16* proj = (const bf16*)(F.ws + WS_PROJ); const bf16* kic = (const bf16*)(F.ws + WS_KIC); unsigned short* sel = (unsigned short*)(F.ws + WS_SEL);
    LAS unsigned* hist = (LAS unsigned*)(F.lds); LAS unsigned* mask = hist + 32 * HS; LAS unsigned* cmask = mask + 32 * HS;
    LAS unsigned long long* cand = (LAS unsigned long long*)(F.lds + 99328); LAS unsigned* rinfo = (LAS unsigned*)(F.lds + 115712);
    const int lane = F.lane, wave = F.wave, tid = F.tid, t0 = qt * 32, rowbase = b * SEQ;
    __syncthreads();
    for (int i = tid; i < 3 * 32 * HS; i += NTHR) hist[i] = 0u;
    if (tid < 320) rinfo[tid] = 0u;
    __syncthreads();
    if (t0 + 31 <= 255 || (EXPF & 64)) {
        if (lane < 8) {
#pragma unroll
            for (int rr = 0; rr < 4; ++rr) { const int row = wave * 4 + rr, nv = t0 + row + 1;
                const int nv0 = t0 + row + 1; const int nvc = nv0 < 256 ? nv0 : 256; (void)nv; mask[row * HS + lane] = nvc >= 32 * (lane + 1) ? 0xffffffffu : (nvc > 32 * lane ? ((1u << (nvc - 32 * lane)) - 1u) : 0u); } }
    } else {
        const int q = lane & 31;
        float wj[4];
        { const bf16* qp = proj + (size_t)(rowbase + t0 + q) * EV_N;
#pragma unroll
            for (int j = 0; j < 4; ++j) wj[j] = bf2f(qp[EC_WI + j]); }
        LAS char* qimg = (LAS char*)(F.lds + 117248);
#pragma unroll
        for (int i = 0; i < 2; ++i) { const int p = tid + i * NTHR, row = p & 31, c = p >> 5;
            *(LAS v4u*)(qimg + c * 512 + row * 16) = *(const v4u*)(proj + (size_t)(rowbase + t0 + row) * EV_N + EC_QI + c * 8); }
        __syncthreads();
        if (stop == 7) return;
        if (stop == 4) { idx_pass<0>(kic, rowbase, qt, qimg, wj, hist, mask, cmask, cand, rinfo, wave, lane); return; }
        if (stop == 5) { idx_pass<-1>(kic, rowbase, qt, qimg, wj, hist, mask, cmask, cand, rinfo, wave, lane); return; }
        if (stop == 6) { idx_pass<-2>(kic, rowbase, qt, qimg, wj, hist, mask, cmask, cand, rinfo, wave, lane); return; }
        idx_pass1(kic, rowbase, qt, qimg, wj, hist, mask, cmask, cand, rinfo, wave, lane);
        __syncthreads();
#pragma unroll 1
        for (int rr = 0; rr < 4; ++rr) { const int row = wave * 4 + rr; unsigned bin, above; hist_pick(hist + row * HS, 256u, lane, bin, above);
            if (lane == 0) { rinfo[row] = bin; rinfo[32 + row] = 256u - above; rinfo[160 + row] = bin >= 128u ? bin - 128u : 255u - bin; rinfo[192 + row] = bin >= 128u ? 0u : 255u; } }
        __syncthreads();
        if (stop == 1) return;
        for (int i = tid; i < 32 * HS; i += NTHR) hist[i] = 0u;
        __syncthreads();
        idx_pass<2>(kic, rowbase, qt, qimg, wj, hist, mask, cmask, cand, rinfo, wave, lane);
        __syncthreads();
#pragma unroll 1
        for (int rr = 0; rr < 4; ++rr) { const int row = wave * 4 + rr; const unsigned need1 = rinfo[32 + row]; unsigned bin, above; hist_pick(hist + row * HS, need1, lane, bin, above);
            if (lane == 0) { const unsigned t16 = (rinfo[row] << 8) | bin, k0 = t16 << 16, k1 = (t16 + 1u) << 16;
                rinfo[64 + row] = t16; rinfo[96 + row] = need1 - above;
                rinfo[224 + row] = (k0 & 0x80000000u) ? (k0 ^ 0x80000000u) : ~k0; rinfo[256 + row] = (t16 == 0xffffu) ? 0x7fc00000u : ((k1 & 0x80000000u) ? (k1 ^ 0x80000000u) : ~k1); } }
        __syncthreads();
        if (stop == 2) return;
        idx_pass<3>(kic, rowbase, qt, qimg, wj, hist, mask, cmask, cand, rinfo, wave, lane);
        __syncthreads();
        if (stop == 3) return;
#pragma unroll 1
        for (int rr = 0; rr < 4; ++rr) { const int row = wave * 4 + rr; const unsigned call = rinfo[128 + row], need2 = rinfo[96 + row];
            if (call <= 64u) { const unsigned c = call;
                const unsigned long long mine = cand[row * 64 + lane]; unsigned rank = 0u;
                for (unsigned k = 0; k < c; ++k) rank += (cand[row * 64 + k] > mine) ? 1u : 0u;
                if ((unsigned)lane < c && rank < need2) { const unsigned s = ~(unsigned)mine;
                    __hip_atomic_fetch_or(mask + row * HS + (s >> 5), 1u << (s & 31), __ATOMIC_RELAXED, __HIP_MEMORY_SCOPE_WORKGROUP); } }
            else { unsigned w4[4];
#pragma unroll
                for (int k = 0; k < 4; ++k) w4[k] = cmask[row * HS + 4 * lane + k];
                const unsigned cnt = __popc(w4[0]) + __popc(w4[1]) + __popc(w4[2]) + __popc(w4[3]);
                unsigned x = cnt;
#pragma unroll
                for (int o = 1; o < 64; o <<= 1) { const unsigned y = __shfl_up(x, o); if (lane >= o) x += y; }
                unsigned before = x - cnt;
#pragma unroll
                for (int k = 0; k < 4; ++k) { unsigned w = w4[k]; const unsigned pc = __popc(w); unsigned take = 0u;
                    if (before < need2) { if (before + pc <= need2) take = w; else { unsigned left = need2 - before; while (left) { const unsigned b = w & (0u - w); take |= b; w ^= b; --left; } } }
                    before += pc;
                    if (take) mask[row * HS + 4 * lane + k] |= take; } }
        }
    }
    __syncthreads();
#pragma unroll 1
    for (int rr = 0; rr < 4; ++rr) { const int row = wave * 4 + rr; unsigned short* out = sel + (size_t)(rowbase + t0 + row) * 256;
        unsigned w4[4];
#pragma unroll
        for (int k = 0; k < 4; ++k) w4[k] = mask[row * HS + 4 * lane + k];
        const unsigned cnt = __popc(w4[0]) + __popc(w4[1]) + __popc(w4[2]) + __popc(w4[3]);
        unsigned x = cnt;
#pragma unroll
        for (int o = 1; o < 64; o <<= 1) { const unsigned y = __shfl_up(x, o); if (lane >= o) x += y; }
        const unsigned total = __shfl(x, 63); unsigned pos = x - cnt;
#pragma unroll
        for (int k = 0; k < 4; ++k) { unsigned w = w4[k]; const unsigned base = (unsigned)(4 * lane + k) * 32u;
            while (w) { const unsigned bit = __builtin_ctz(w); if (pos < 256u) out[pos] = (unsigned short)(base + bit); ++pos; w &= w - 1u; } }
        for (unsigned i = total + lane; i < 256u; i += 64u) out[i] = (unsigned short)0xffffu; }
}

struct AttSt { float m, l; f32x16 o0, o1; };
template <class BF> DI void att_subtile(AttSt& S, const bf16x8 (&qf)[4], LAS const char* Kst, LAS const char* Vb, int vdh, int vrow0, int lane, const BF& bias) {
    const int r32 = lane & 31, hi = lane >> 5;
    f32x16 p;
#pragma unroll
    for (int r = 0; r < 16; ++r) p[r] = bias.b(crow(r, hi)) - S.m;
    LAS const char* kp = Kst + hi * 512 + r32 * 16;
#pragma unroll
    for (int s = 0; s < 4; ++s) { const bf16x8 kf = *(LAS const bf16x8*)(kp + s * 1024); p = mfma32(kf, qf[s], p); }
    if (bias.any) {
#pragma unroll
        for (int r = 0; r < 16; ++r) p[r] = bias.msk(crow(r, hi)) ? -INFINITY : p[r]; }
    float mxa[4] = {-INFINITY, -INFINITY, -INFINITY, -INFINITY};
#pragma unroll
    for (int r = 0; r < 16; ++r) mxa[r & 3] = fmaxf(mxa[r & 3], p[r]);
    float mx = fmaxf(fmaxf(mxa[0], mxa[1]), fmaxf(mxa[2], mxa[3]));
    mx = fmaxf(mx, __shfl_xor(mx, 32));
    if (__any(mx > 16.f)) { const float dl = fmaxf(mx, 0.f), sc = ex2(-dl); S.m += dl; S.l *= sc;
#pragma unroll
        for (int r = 0; r < 16; ++r) { p[r] -= dl; S.o0[r] *= sc; S.o1[r] *= sc; } }
    float psa[4] = {0.f, 0.f, 0.f, 0.f};
#pragma unroll
    for (int r = 0; r < 16; ++r) { p[r] = ex2(p[r]); psa[r & 3] += p[r]; }
    S.l += (psa[0] + psa[1]) + (psa[2] + psa[3]);
    v4u pw0, pw1;
    pw0.x = cvtpk(p[0], p[1]); pw0.y = cvtpk(p[2], p[3]); pw0.z = cvtpk(p[4], p[5]); pw0.w = cvtpk(p[6], p[7]);
    pw1.x = cvtpk(p[8], p[9]); pw1.y = cvtpk(p[10], p[11]); pw1.z = cvtpk(p[12], p[13]); pw1.w = cvtpk(p[14], p[15]);
    const bf16x8 pf0 = __builtin_bit_cast(bf16x8, pw0), pf1 = __builtin_bit_cast(bf16x8, pw1);
    LAS const char* vp = Vb + (vrow0 + 4 * hi + ((lane & 15) >> 2)) * 64 + ((lane >> 4) & 1) * 32 + (lane & 3) * 8;
    { const bf16x8 v00 = cat8(vtr(vp), vtr(vp + 512)), v10 = cat8(vtr(vp + vdh), vtr(vp + vdh + 512));
      const bf16x8 v01 = cat8(vtr(vp + 1024), vtr(vp + 1536)), v11 = cat8(vtr(vp + vdh + 1024), vtr(vp + vdh + 1536));
      S.o0 = mfma32(v00, pf0, S.o0); S.o1 = mfma32(v10, pf0, S.o1);
      S.o0 = mfma32(v01, pf1, S.o0); S.o1 = mfma32(v11, pf1, S.o1); }
}
template <class BF0, class BF1> DI void att_tile64(AttSt& S, const bf16x8 (&qf)[4], LAS const char* Kst, LAS const char* Vb, int vdh, int vrow0, int lane, const BF0& bias0, const BF1& bias1) {
    const int r32 = lane & 31, hi = lane >> 5;
    f32x16 p0, p1;
#pragma unroll
    for (int r = 0; r < 16; ++r) { p0[r] = bias0.b(crow(r, hi)) - S.m; p1[r] = bias1.b(crow(r, hi)) - S.m; }
    LAS const char* kp = Kst + hi * 512 + r32 * 16;
#pragma unroll
    for (int s = 0; s < 4; ++s) { const bf16x8 k0 = *(LAS const bf16x8*)(kp + s * 1024), k1 = *(LAS const bf16x8*)(kp + 4096 + s * 1024); p0 = mfma32(k0, qf[s], p0); p1 = mfma32(k1, qf[s], p1); }
    if (bias0.any) {
#pragma unroll
        for (int r = 0; r < 16; ++r) p0[r] = bias0.msk(crow(r, hi)) ? -INFINITY : p0[r]; }
    if (bias1.any) {
#pragma unroll
        for (int r = 0; r < 16; ++r) p1[r] = bias1.msk(crow(r, hi)) ? -INFINITY : p1[r]; }
    float mxa[4] = {-INFINITY, -INFINITY, -INFINITY, -INFINITY};
#pragma unroll
    for (int r = 0; r < 16; ++r) mxa[r & 3] = fmaxf(mxa[r & 3], fmaxf(p0[r], p1[r]));
    float mx = fmaxf(fmaxf(mxa[0], mxa[1]), fmaxf(mxa[2], mxa[3]));
    mx = fmaxf(mx, __shfl_xor(mx, 32));
    if (__any(mx > 16.f)) { const float dl = fmaxf(mx, 0.f), sc = ex2(-dl); S.m += dl; S.l *= sc;
#pragma unroll
        for (int r = 0; r < 16; ++r) { p0[r] -= dl; p1[r] -= dl; S.o0[r] *= sc; S.o1[r] *= sc; } }
    float psa[4] = {0.f, 0.f, 0.f, 0.f};
#pragma unroll
    for (int r = 0; r < 16; ++r) { p0[r] = ex2(p0[r]); p1[r] = ex2(p1[r]); psa[r & 3] += p0[r] + p1[r]; }
    S.l += (psa[0] + psa[1]) + (psa[2] + psa[3]);
    v4u a0, a1, b0, b1;
    a0.x = cvtpk(p0[0], p0[1]); a0.y = cvtpk(p0[2], p0[3]); a0.z = cvtpk(p0[4], p0[5]); a0.w = cvtpk(p0[6], p0[7]);
    a1.x = cvtpk(p0[8], p0[9]); a1.y = cvtpk(p0[10], p0[11]); a1.z = cvtpk(p0[12], p0[13]); a1.w = cvtpk(p0[14], p0[15]);
    b0.x = cvtpk(p1[0], p1[1]); b0.y = cvtpk(p1[2], p1[3]); b0.z = cvtpk(p1[4], p1[5]); b0.w = cvtpk(p1[6], p1[7]);
    b1.x = cvtpk(p1[8], p1[9]); b1.y = cvtpk(p1[10], p1[11]); b1.z = cvtpk(p1[12], p1[13]); b1.w = cvtpk(p1[14], p1[15]);
    LAS const char* vp = Vb + (vrow0 + 4 * hi + ((lane & 15) >> 2)) * 64 + ((lane >> 4) & 1) * 32 + (lane & 3) * 8;
#pragma unroll
    for (int k16 = 0; k16 < 4; ++k16) { const bf16x8 pf = __builtin_bit_cast(bf16x8, k16 == 0 ? a0 : k16 == 1 ? a1 : k16 == 2 ? b0 : b1);
        const bf16x8 v0 = cat8(vtr(vp + k16 * 1024), vtr(vp + k16 * 1024 + 512)), v1 = cat8(vtr(vp + vdh + k16 * 1024), vtr(vp + vdh + k16 * 1024 + 512));
        S.o0 = mfma32(v0, pf, S.o0); S.o1 = mfma32(v1, pf, S.o1); }
}

struct MobaFar { float c; bool any; DI float b(int) const { return c; } DI bool msk(int) const { return false; } };
struct MobaBias { LAS const float* lut; int tq, s0; bool any;
    DI float b(int kvrel) const { const int dist = tq - (s0 + kvrel); return lut[dist < 0 ? 0 : (dist > 1023 ? 1023 : dist)]; }
    DI bool msk(int kvrel) const { return tq - (s0 + kvrel) < 0; } };
DI void moba_qload(bf16x8 (&qf)[4], const bf16* proj, int rowbase, int h, int tq, int hi) {
    const bf16* qp = proj + (size_t)(rowbase + tq) * EV_N + EC_QB + h * 64 + hi * 8;
#pragma unroll
    for (int s = 0; s < 4; ++s) qf[s] = *(const bf16x8*)(qp + s * 16);
}
DI void moba_tile(const Fr& F, const bf16x8 (&qf)[4], int rowbase, int h, int n, int tq, bool valid, int slot, bool own, int wave_tile) {
    LAS const char* Kb = (LAS const char*)F.lds; LAS const char* Vb = (LAS const char*)(F.lds + 32768); LAS const float* lut = (LAS const float*)(F.lds + 98304);
    bf16* po = (bf16*)(F.ws + WS_ACT); float* pml = (float*)(F.ws + WS_PML);
    const int lane = F.lane, hi = lane >> 5;
    AttSt S; S.m = 0.f; S.l = 0.f;
#pragma unroll
    for (int r = 0; r < 16; ++r) { S.o0[r] = 0.f; S.o1[r] = 0.f; }
    const int nst = own ? wave_tile + 1 : 8;
    int tmin = tq;
#pragma unroll
    for (int o = 1; o < 64; o <<= 1) { const int y = __shfl_xor(tmin, o); tmin = y < tmin ? y : tmin; }
    const float cfar = lut[1023];
    int st = 0;
    for (; st + 1 < nst; st += 2) {
        if (!own && tmin - (n * 256 + st * 32 + 63) >= 790) { MobaFar bf{cfar, false}; att_tile64(S, qf, Kb + st * 4096, Vb, 16384, st * 32, lane, bf, bf); }
        else { MobaBias bf0{lut, tq, n * 256 + st * 32, false}, bf1{lut, tq, n * 256 + st * 32 + 32, own && st + 1 == wave_tile}; att_tile64(S, qf, Kb + st * 4096, Vb, 16384, st * 32, lane, bf0, bf1); } }
    if (st < nst) { MobaBias bf{lut, tq, n * 256 + st * 32, own && st == wave_tile}; att_subtile(S, qf, Kb + st * 4096, Vb, 16384, st * 32, lane, bf); }
    const float lt = S.l + __shfl_xor(S.l, 32), inv = 1.f / lt;
    if (valid) { const size_t pi = ((size_t)(rowbase + tq) * 8 + h) * 4 + slot; bf16* o = po + pi * 64;
#pragma unroll
        for (int a4 = 0; a4 < 4; ++a4) { v2u w0, w1;
            w0.x = cvtpk(S.o0[4 * a4] * inv, S.o0[4 * a4 + 1] * inv); w0.y = cvtpk(S.o0[4 * a4 + 2] * inv, S.o0[4 * a4 + 3] * inv);
            w1.x = cvtpk(S.o1[4 * a4] * inv, S.o1[4 * a4 + 1] * inv); w1.y = cvtpk(S.o1[4 * a4 + 2] * inv, S.o1[4 * a4 + 3] * inv);
            *(v2u*)(o + 8 * a4 + 4 * hi) = w0; *(v2u*)(o + 32 + 8 * a4 + 4 * hi) = w1; }
        if (hi == 0) { f32x2 ml = {S.m, lt}; *(f32x2*)(pml + pi * 2) = ml; } }
}
DI void moba_unit(const Args& a, const Fr& F, int b, int h, int n) {
    const bf16* proj = (const bf16*)(F.ws + WS_PROJ); const unsigned* sel3 = (const unsigned*)(F.ws + WS_SEL3);
    LAS unsigned char* lds = F.lds; LAS unsigned* list = (LAS unsigned*)(lds + 65536); LAS float* lut = (LAS float*)(lds + 98304); LAS unsigned* misc = (LAS unsigned*)(lds + 102400);
    const int tid = F.tid, lane = F.lane, wave = F.wave, rowbase = b * SEQ;
    __syncthreads();
    { const bf16* kg = proj + (size_t)(rowbase + n * 256) * EV_N + EC_KB + h * 64; const bf16* vg = proj + (size_t)(rowbase + n * 256) * EV_N + EC_VB + h * 64;
#pragma unroll
        for (int i = 0; i < 4; ++i) { const int p = tid + i * NTHR;
            { const int r = p & 31, c = (p >> 5) & 7, st = p >> 8; const v4u v = *(const v4u*)(kg + (size_t)(st * 32 + r) * EV_N + c * 8); *(LAS v4u*)(lds + st * 4096 + c * 512 + r * 16) = v; }
            { const int cc = p & 3, row = (p >> 2) & 255, dh = p >> 10; const v4u v = *(const v4u*)(vg + (size_t)row * EV_N + dh * 32 + cc * 8); *(LAS v4u*)(lds + 32768 + dh * 16384 + row * 64 + cc * 16) = v; } }
        for (int d = tid; d < 1024; d += NTHR) lut[d] = a.in[9][t5_bucket(d) * 16 + 8 + h] * LOG2E; }
    if (tid == 0) misc[16] = 0u;
    __syncthreads();
    unsigned sv[16];
#pragma unroll
    for (int k = 0; k < 16; ++k) { const int t = (n + 1) * 256 + k * NTHR + tid; sv[k] = t < SEQ ? sel3[(size_t)(rowbase + t) * 8 + h] : 0u; }
#pragma unroll
    for (int k = 0; k < 16; ++k) { const int tb = (n + 1) * 256 + k * NTHR; if (tb < SEQ) { const int t = tb + tid;
        const unsigned s = sv[k]; const unsigned nv = s >> 24; int slot = -1;
        if (nv > 0u && (s & 255u) == (unsigned)n) slot = 0; else if (nv > 1u && ((s >> 8) & 255u) == (unsigned)n) slot = 1; else if (nv > 2u && ((s >> 16) & 255u) == (unsigned)n) slot = 2;
        const unsigned long long bal = __ballot(slot >= 0); const unsigned wcnt = __popcll(bal);
        if (lane == 0) misc[wave] = wcnt;
        __syncthreads();
        unsigned off = misc[16], tot = 0u;
#pragma unroll
        for (int w = 0; w < 8; ++w) { const unsigned c = misc[w]; if (w < wave) off += c; tot += c; }
        if (slot >= 0) list[off + __popcll(bal & ((1ull << lane) - 1ull))] = ((unsigned)t << 2) | (unsigned)slot;
        __syncthreads();
        if (tid == 0) misc[16] += tot; } }
    __syncthreads();
    const int nlist = (int)misc[16];
    const int ntl = (nlist + 31) >> 5, hi = lane >> 5;
    bf16x8 qa[4], qb2[4];
    moba_qload(qa, proj, rowbase, h, n * 256 + wave * 32 + (lane & 31), hi);
    unsigned ea = 0u, eb = 0u; bool va = false, vb = false;
    int tl = wave;
    if (tl < ntl) { const int li = tl * 32 + (lane & 31); vb = li < nlist; eb = list[vb ? li : nlist - 1]; moba_qload(qb2, proj, rowbase, h, (int)(eb >> 2), hi); }
    moba_tile(F, qa, rowbase, h, n, n * 256 + wave * 32 + (lane & 31), true, 3, true, wave);
    for (; tl < ntl; tl += 16) {
        const int t2 = tl + 8, t3 = tl + 16;
        if (t2 < ntl) { const int li = t2 * 32 + (lane & 31); va = li < nlist; ea = list[va ? li : nlist - 1]; moba_qload(qa, proj, rowbase, h, (int)(ea >> 2), hi); }
        moba_tile(F, qb2, rowbase, h, n, (int)(eb >> 2), vb, (int)(eb & 3u), false, 0);
        if (t2 < ntl) {
            if (t3 < ntl) { const int li = t3 * 32 + (lane & 31); vb = li < nlist; eb = list[vb ? li : nlist - 1]; moba_qload(qb2, proj, rowbase, h, (int)(eb >> 2), hi); }
            moba_tile(F, qa, rowbase, h, n, (int)(ea >> 2), va, (int)(ea & 3u), false, 0); }
    }
}

DI void dsa_step(const bf16x8 (&af)[2][4], const bf16x8 (&qlf)[4], int ch, LAS const unsigned char* bsel, LAS unsigned char* cbuf, LAS const float* tab,
                 float& m, float& l, f32x4 (&oT)[8], int l15, int kg, int lane) {
    f32x4 acc[2];
#pragma unroll
    for (int mt = 0; mt < 2; ++mt) { const unsigned b4 = *(LAS const unsigned*)(bsel + ch * 32 + mt * 16 + 4 * kg);
#pragma unroll
        for (int i = 0; i < 4; ++i) { const unsigned bb = (b4 >> (8 * i)) & 255u; const float tb = tab[(bb & 31u) * 8 + (l15 & 7)];
            acc[mt][i] = (tb - m) + (bb != 255u ? 0.f : -INFINITY); } }
#pragma unroll
    for (int mt = 0; mt < 2; ++mt)
#pragma unroll
        for (int ks = 0; ks < 4; ++ks) { acc[mt] = mfma16(af[mt][ks], qlf[ks], acc[mt]); *(LAS bf16x8*)(cbuf + (mt * 16 + l15) * 288 + (ks * 32 + kg * 8) * 2) = af[mt][ks]; }
    float mx = fmaxf(fmaxf(fmaxf(acc[0][0], acc[0][1]), fmaxf(acc[0][2], acc[0][3])), fmaxf(fmaxf(acc[1][0], acc[1][1]), fmaxf(acc[1][2], acc[1][3])));
    mx = fmaxf(mx, __shfl_xor(mx, 16)); mx = fmaxf(mx, __shfl_xor(mx, 32));
    if (__any(mx > 16.f)) { const float dl = fmaxf(mx, 0.f), sc = ex2(-dl); m += dl; l *= sc;
#pragma unroll
        for (int mt = 0; mt < 2; ++mt) acc[mt] = acc[mt] - dl;
#pragma unroll
        for (int ct = 0; ct < 8; ++ct) oT[ct] = oT[ct] * sc; }
    float ps = 0.f;
#pragma unroll
    for (int mt = 0; mt < 2; ++mt)
#pragma unroll
        for (int i = 0; i < 4; ++i) { acc[mt][i] = ex2(acc[mt][i]); ps += acc[mt][i]; }
    l += ps;
    v4u pw; pw.x = cvtpk(acc[0][0], acc[0][1]); pw.y = cvtpk(acc[0][2], acc[0][3]); pw.z = cvtpk(acc[1][0], acc[1][1]); pw.w = cvtpk(acc[1][2], acc[1][3]);
    const bf16x8 pf = __builtin_bit_cast(bf16x8, pw);
    LDS_WAIT();
    LAS const char* tp = (LAS const char*)cbuf + (4 * kg + (l15 >> 2)) * 288 + (lane & 3) * 8;
#pragma unroll
    for (int ct = 0; ct < 8; ++ct) { const bf16x8 cf = cat8(vtr(tp + ct * 32), vtr(tp + 16 * 288 + ct * 32)); oT[ct] = mfma16(cf, pf, oT[ct]); }
    LDS_WAIT();
}
DI void dsa_gather(bf16x8 (&af)[2][4], const bf16* ckvn, int rowbase, LAS const unsigned short* selb, int ch, int l15, int kg) {
#pragma unroll
    for (int mt = 0; mt < 2; ++mt) { unsigned idx = selb[ch * 32 + mt * 16 + l15]; if (idx == 0xffffu) idx = 0u;
        const bf16* cp = ckvn + (size_t)(rowbase + (int)idx) * 128 + kg * 8;
#pragma unroll
        for (int ks = 0; ks < 4; ++ks) af[mt][ks] = *(const bf16x8*)(cp + ks * 32); }
}
DI void dsa_query(const Fr& F, int tok, const v2u sv, LAS unsigned char* wl, LAS const unsigned char* bkt, LAS const float* tab) {
    const bf16* ql = (const bf16*)(F.ws + WS_QL); const bf16* ckvn = (const bf16*)(F.ws + WS_CKVN); const unsigned short* sel = (const unsigned short*)(F.ws + WS_SEL); bf16* ol = (bf16*)(F.ws + WS_OL);
    const int lane = F.lane, l15 = lane & 15, kg = lane >> 4, t = tok % SEQ, rowbase = tok - t;
    LAS unsigned short* selb = (LAS unsigned short*)wl; LAS unsigned char* bsel = wl + 512; LAS unsigned char* cbuf = wl + 1024;
    { *((LAS v2u*)selb + lane) = sv; unsigned bw = 0u;
#pragma unroll
        for (int i = 0; i < 4; ++i) { const unsigned s = (i < 2 ? (sv.x >> (16 * i)) : (sv.y >> (16 * (i - 2)))) & 0xffffu; const int dist = t - (int)s;
            const unsigned bb = (s != 0xffffu && dist >= 0) ? (unsigned)bkt[dist > 1023 ? 1023 : dist] : 255u; bw |= bb << (8 * i); }
        *((LAS unsigned*)bsel + lane) = bw; }
    bf16x8 qlf[4];
#pragma unroll
    for (int ks = 0; ks < 4; ++ks) { qlf[ks] = *(const bf16x8*)(ql + (size_t)tok * 1024 + (l15 & 7) * 128 + ks * 32 + kg * 8); if (l15 >= 8) qlf[ks] = (bf16x8){0, 0, 0, 0, 0, 0, 0, 0}; }
    float m = 0.f, l = 0.f; f32x4 oT[8];
#pragma unroll
    for (int ct = 0; ct < 8; ++ct) oT[ct] = (f32x4){0.f, 0.f, 0.f, 0.f};
    const int nvalid = t + 1 < 256 ? t + 1 : 256, nch = (nvalid + 31) >> 5;
    LDS_WAIT();
    bf16x8 afa[2][4], afb[2][4], afc[2][4];
    dsa_gather(afa, ckvn, rowbase, selb, 0, l15, kg);
    if (nch > 1) dsa_gather(afb, ckvn, rowbase, selb, 1, l15, kg);
    for (int ch = 0; ch < nch; ch += 3) {
        if (ch + 2 < nch) dsa_gather(afc, ckvn, rowbase, selb, ch + 2, l15, kg);
        dsa_step(afa, qlf, ch, bsel, cbuf, tab, m, l, oT, l15, kg, lane);
        if (ch + 1 < nch) { if (ch + 3 < nch) dsa_gather(afa, ckvn, rowbase, selb, ch + 3, l15, kg);
            dsa_step(afb, qlf, ch + 1, bsel, cbuf, tab, m, l, oT, l15, kg, lane); }
        if (ch + 2 < nch) { if (ch + 4 < nch) dsa_gather(afb, ckvn, rowbase, selb, ch + 4, l15, kg);
            dsa_step(afc, qlf, ch + 2, bsel, cbuf, tab, m, l, oT, l15, kg, lane); }
    }
    l += __shfl_xor(l, 16); l += __shfl_xor(l, 32);
    const float inv = 1.f / l;
    if (l15 < 8) { bf16* o = ol + (size_t)tok * 1024 + l15 * 128 + 4 * kg;
#pragma unroll
        for (int ct = 0; ct < 8; ++ct) { v2u w; w.x = cvtpk(oT[ct][0] * inv, oT[ct][1] * inv); w.y = cvtpk(oT[ct][2] * inv, oT[ct][3] * inv); *(v2u*)(o + ct * 16) = w; } }
}
DI void dsa_chunk(const Args& a, const Fr& F, int c32) {
    LAS unsigned char* bkt = F.lds + 81920; LAS float* tab = (LAS float*)(F.lds + 82944);
    __syncthreads();
    for (int d = F.tid; d < 1024; d += NTHR) bkt[d] = (unsigned char)t5_bucket(d);
    if (F.tid < 256) tab[F.tid] = a.in[9][(F.tid >> 3) * 16 + (F.tid & 7)] * LOG2E;
    __syncthreads();
    const unsigned short* selg = (const unsigned short*)(F.ws + WS_SEL); v2u svq[4];
#pragma unroll
    for (int i = 0; i < 4; ++i) svq[i] = *((const v2u*)(selg + (size_t)(c32 * 32 + F.wave * 4 + i) * 256) + F.lane);
#pragma unroll
    for (int i = 0; i < 4; ++i) dsa_query(F, c32 * 32 + F.wave * 4 + i, svq[i], F.lds + F.wave * 10240, bkt, tab);
}

DI void ph_even_post(const Fr& F, int j) {
    const bf16* ol = (const bf16*)(F.ws + WS_OL); bf16* ao = (bf16*)(F.ws + WS_AO);
    const bf16* wuvt = (const bf16*)(F.ws + WS_WUVT) + (size_t)j * 8 * 64 * 128;
    const bf16* po = (const bf16*)(F.ws + WS_ACT); const float* pml = (const float*)(F.ws + WS_PML); const unsigned* sel3 = (const unsigned*)(F.ws + WS_SEL3);
    const int lane = F.lane, wave = F.wave, l15 = lane & 15, kg = lane >> 4;
    for (int chunk = F.blk; chunk < 256; chunk += F.G) { const int tok0 = chunk * 128;
        { const int h = wave; bf16x8 af[4][4];
#pragma unroll
            for (int mt = 0; mt < 4; ++mt)
#pragma unroll
                for (int ks = 0; ks < 4; ++ks) af[mt][ks] = *(const bf16x8*)(wuvt + ((size_t)h * 64 + mt * 16 + l15) * 128 + ks * 32 + kg * 8);
#pragma unroll 1
            for (int tg = 0; tg < 8; tg += 2) { bf16x8 bf[2][4];
#pragma unroll
                for (int u = 0; u < 2; ++u)
#pragma unroll
                    for (int ks = 0; ks < 4; ++ks) bf[u][ks] = *(const bf16x8*)(ol + (size_t)(tok0 + (tg + u) * 16 + l15) * 1024 + h * 128 + ks * 32 + kg * 8);
#pragma unroll
                for (int u = 0; u < 2; ++u) { const int tok = tok0 + (tg + u) * 16 + l15;
#pragma unroll
                    for (int mt = 0; mt < 4; ++mt) { f32x4 d = {0.f, 0.f, 0.f, 0.f};
#pragma unroll
                        for (int ks = 0; ks < 4; ++ks) d = mfma16(af[mt][ks], bf[u][ks], d);
                        v2u w; w.x = cvtpk(d[0], d[1]); w.y = cvtpk(d[2], d[3]); *(v2u*)(ao + (size_t)tok * 1024 + h * 64 + mt * 16 + 4 * kg) = w; } } } }
#pragma unroll 1
        for (int i0 = 0; i0 < 16; i0 += 4) { const int h = lane >> 3, d0 = (lane & 7) * 8; unsigned nvv[4]; f32x2 mlv[4][4];
#pragma unroll
            for (int i = 0; i < 4; ++i) { const int tok = tok0 + wave * 16 + i0 + i; const size_t pi = ((size_t)tok * 8 + h) * 4; nvv[i] = sel3[(size_t)tok * 8 + h] >> 24;
#pragma unroll
                for (int s = 0; s < 4; ++s) mlv[i][s] = *(const f32x2*)(pml + (pi + s) * 2); }
#pragma unroll
            for (int i = 0; i < 4; ++i) { const int tok = tok0 + wave * 16 + i0 + i; const size_t pi = ((size_t)tok * 8 + h) * 4;
                float mj[4], lj[4];
#pragma unroll
                for (int s = 0; s < 4; ++s) { const bool ok = (s == 3) || ((unsigned)s < nvv[i]); mj[s] = ok ? mlv[i][s][0] : -1e30f; lj[s] = ok ? mlv[i][s][1] : 0.f; }
                const float ms = fmaxf(fmaxf(mj[0], mj[1]), fmaxf(mj[2], mj[3])); float wsum = 0.f, acc[8], wv[4]; v4u pv[4];
#pragma unroll
                for (int k = 0; k < 8; ++k) acc[k] = 0.f;
#pragma unroll
                for (int s = 0; s < 4; ++s) { wv[s] = lj[s] * ex2(mj[s] - ms); wsum += wv[s]; pv[s] = (v4u){0u, 0u, 0u, 0u}; if (wv[s] > 0.f) pv[s] = *(const v4u*)(po + (pi + s) * 64 + d0); }
#pragma unroll
                for (int s = 0; s < 4; ++s) { if (wv[s] > 0.f) {
#pragma unroll
                    for (int k = 0; k < 4; ++k) { acc[2 * k] += wv[s] * bf2f(pv[s][k] & 0xffffu); acc[2 * k + 1] += wv[s] * bf2f(pv[s][k] >> 16); } } }
                const float inv = 1.f / wsum; v4u o; o.x = cvtpk(acc[0] * inv, acc[1] * inv); o.y = cvtpk(acc[2] * inv, acc[3] * inv); o.z = cvtpk(acc[4] * inv, acc[5] * inv); o.w = cvtpk(acc[6] * inv, acc[7] * inv);
                *(v4u*)(ao + (size_t)tok * 1024 + 512 + h * 64 + d0) = o; } }
    }
}
template <class XT> DI f32x4 ld_x4(const XT* p);
template <> DI f32x4 ld_x4<float>(const float* p) { return *(const f32x4*)p; }
template <> DI f32x4 ld_x4<bf16>(const bf16* p) { const v2u w = *(const v2u*)p; return (f32x4){bf2f(w.x & 0xffffu), bf2f(w.x >> 16), bf2f(w.y & 0xffffu), bf2f(w.y >> 16)}; }
template <class XT> DI f32x16 proj32_f32(const float* W, int ldw, int ncols, const XT* xrow, int d_lo, int lane) {
    const int e = lane & 31, kh = lane >> 5; const bool ev = e < ncols;
    f32x16 D;
#pragma unroll
    for (int r = 0; r < 16; ++r) D[r] = 0.f;
    const float* wp = W + (size_t)(d_lo + 4 * kh) * ldw + (ev ? e : 0);
    const XT* xp = xrow + d_lo + 4 * kh;
#pragma unroll 8
    for (int i = 0; i < 64; ++i) { const f32x4 xv = ld_x4<XT>(xp + 8 * i);
        float a0 = wp[(size_t)(8 * i + 0) * ldw], a1 = wp[(size_t)(8 * i + 1) * ldw], a2 = wp[(size_t)(8 * i + 2) * ldw], a3 = wp[(size_t)(8 * i + 3) * ldw];
        if (!ev) { a0 = 0.f; a1 = 0.f; a2 = 0.f; a3 = 0.f; }
        D = __builtin_amdgcn_mfma_f32_32x32x2f32(a0, xv[0], D, 0, 0, 0); D = __builtin_amdgcn_mfma_f32_32x32x2f32(a1, xv[1], D, 0, 0, 0);
        D = __builtin_amdgcn_mfma_f32_32x32x2f32(a2, xv[2], D, 0, 0, 0); D = __builtin_amdgcn_mfma_f32_32x32x2f32(a3, xv[3], D, 0, 0, 0); }
    return D;
}
DI void ph_odd_prep(const Args& a, const Fr& F, int j, int layer) {
    const bf16* proj = (const bf16*)(F.ws + WS_PROJ); const bf16* x = (const bf16*)(F.ws + WS_XB);
    float* logf = (float*)(F.ws + WS_LOGF); float* cs = (float*)(F.ws + WS_CS);
    const float* wf = a.in[6] + (size_t)j * 1024 * 3088 + 3072; const float* bfv = a.in[7] + j * 16;
    LAS float* red = (LAS float*)(F.lds); LAS float* lfb = (LAS float*)(F.lds + 131072);
    LAS unsigned* kmx = (LAS unsigned*)(F.lds + 131072 + 8192);
    const int lane = F.lane, wave = F.wave, tid = F.tid, l31 = lane & 31, hi = lane >> 5;
    for (int chunk = F.blk; chunk < 256; chunk += F.G) { const int tok0 = chunk * 128, b = tok0 / SEQ, t0 = tok0 % SEQ;
        __syncthreads();
        if (tid < 16) kmx[tid] = 0u;
        const int tl = wave & 3, kr = wave >> 2;
        f32x16 D = proj32_f32(wf, 3088, 16, x + (size_t)(tok0 + tl * 32 + l31) * DM, kr * 512, lane);
        if (kr == 1) {
#pragma unroll
            for (int r = 0; r < 8; ++r) red[(tl * 8 + r) * 64 + lane] = D[r]; }
        __syncthreads();
        if (kr == 0) {
#pragma unroll
            for (int r = 0; r < 8; ++r) { const int h = (r & 3) + 8 * (r >> 2) + 4 * hi; const float z = D[r] + red[(tl * 8 + r) * 64 + lane] + bfv[h];
                const float ls = fminf(z, 0.f) - log1pf(__expf(-fabsf(z)));
                lfb[(tl * 32 + l31) * 16 + h] = ls * LOG2E; } }
#pragma unroll 1
        for (int i = 0; i < 4; ++i) { const int p = tid + i * NTHR, tk = p >> 4, h = p & 15; const v4u* kp = (const v4u*)(proj + (size_t)(tok0 + tk) * OD_N + OC_K + h * 64); float s = 0.f;
#pragma unroll
            for (int c = 0; c < 8; ++c) { const v4u w = kp[c];
#pragma unroll
                for (int k = 0; k < 4; ++k) { const float e0 = bf2f(w[k] & 0xffffu), e1 = bf2f(w[k] >> 16); s += e0 * e0 + e1 * e1; } }
            __hip_atomic_fetch_max(kmx + h, __float_as_uint(s), __ATOMIC_RELAXED, __HIP_MEMORY_SCOPE_WORKGROUP); }
        __syncthreads();
        for (int i = tid; i < 2048; i += NTHR) { const int h = i >> 7, tk = i & 127; logf[((size_t)b * 16 + h) * SEQ + t0 + tk] = lfb[tk * 16 + h]; }
        if (tid < 32) { const int h = tid & 15, c = tid >> 4; float s = 0.f;
            for (int k = 0; k < 64; ++k) s += lfb[(c * 64 + k) * 16 + h];
            cs[((size_t)b * 16 + h) * 128 + (t0 >> 6) + c] = s; }
        if (tid < 16) __hip_atomic_fetch_max(F.ctl + CW_KMAX + layer * 64 + b * 16 + tid, kmx[tid], RLX_AGENT);
    }
}

constexpr float FOX_SKIP_LOG2 = 64.f;
struct FoxBias { LAS const float* ng; int tq, kabs0; bool any;
    DI float b(int kvrel) const { return ng[kvrel]; }
    DI bool msk(int kvrel) const { return (kabs0 + kvrel) > tq; } };
DI void fox_unit(const Fr& F, int layer, int b, int h, int qb) {
    const bf16* proj = (const bf16*)(F.ws + WS_PROJ); const float* logf = (const float*)(F.ws + WS_LOGF); const float* cs = (const float*)(F.ws + WS_CS); bf16* ao = (bf16*)(F.ws + WS_AO);
    LAS unsigned char* lds = F.lds; LAS float* ng = (LAS float*)(lds + 32768); LAS float* red = (LAS float*)(lds + 65536 + 1024); LAS int* ibox = (LAS int*)(lds + 65536 + 2048);
    const int tid = F.tid, lane = F.lane, wave = F.wave, r32 = lane & 31, hi = lane >> 5, t0 = qb * 256, rowbase = b * SEQ, tq = t0 + wave * 32 + r32;
    __syncthreads();
    bf16x8 qf[4]; float qs = 0.f;
    { const bf16* qp = proj + (size_t)(rowbase + tq) * OD_N + OC_Q + h * 64 + hi * 8;
#pragma unroll
        for (int s = 0; s < 4; ++s) { qf[s] = *(const bf16x8*)(qp + s * 16);
#pragma unroll
            for (int k = 0; k < 8; ++k) { const float e = bf2f((unsigned short)qf[s][k]); qs += e * e; } } }
    qs += __shfl_xor(qs, 32); qs = wave_max(qs);
    if (lane == 0) red[wave] = qs;
    if (tid < 128) red[32 + tid] = (tid < t0 / 64) ? cs[((size_t)b * 16 + h) * 128 + tid] : 0.f;
    __syncthreads();
    if (tid == 0) { float qm = red[0];
        for (int w = 1; w < 8; ++w) qm = fmaxf(qm, red[w]);
        const float km = __uint_as_float(ld_u32(F.ctl + CW_KMAX + layer * 64 + b * 16 + h));
        const float B2 = 2.f * (sqrtf(qm * km) * 1.01f + 1.f);
        int kt = t0 / 64 - 1, kts = t0 / 64; float D = 0.f;
        while (kt >= 0 && B2 + D >= -FOX_SKIP_LOG2) { kts = kt; D += red[32 + kt]; --kt; }
        ibox[0] = kts; }
    __syncthreads();
    const int kts = ibox[0], s_start = kts * 64, nel = t0 + 256 - s_start;
    { const int i0 = tid * 16; float v[16]; const float* lp = logf + ((size_t)b * 16 + h) * SEQ + s_start + i0;
        if (i0 < nel) {
#pragma unroll
            for (int c = 0; c < 4; ++c) { const f32x4 w = *(const f32x4*)(lp + 4 * c); v[4 * c] = w[0]; v[4 * c + 1] = w[1]; v[4 * c + 2] = w[2]; v[4 * c + 3] = w[3]; } }
        else {
#pragma unroll
            for (int c = 0; c < 16; ++c) v[c] = 0.f; }
#pragma unroll
        for (int c = 1; c < 16; ++c) v[c] += v[c - 1];
        float xsum = v[15];
#pragma unroll
        for (int o = 1; o < 64; o <<= 1) { const float y = __shfl_up(xsum, o); if (lane >= o) xsum += y; }
        if (lane == 63) red[16 + wave] = xsum;
        __syncthreads();
        float off = xsum - v[15];
        for (int w = 0; w < wave; ++w) off += red[16 + w];
        if (i0 < nel) {
#pragma unroll
            for (int c = 0; c < 4; ++c) { f32x4 w = {-(off + v[4 * c]), -(off + v[4 * c + 1]), -(off + v[4 * c + 2]), -(off + v[4 * c + 3])}; *(LAS f32x4*)(ng + i0 + 4 * c) = w; } }
    }
    const int ntile = t0 / 64 + 4 - kts;
    const bf16* kg = proj + (size_t)rowbase * OD_N + OC_K + h * 64; const bf16* vg = proj + (size_t)rowbase * OD_N + OC_V + h * 64;
    const int kr = tid & 31, kc = (tid >> 5) & 7, kst = tid >> 8, vcc = tid & 3, vrow = (tid >> 2) & 63, vdh = tid >> 8;
    const int koff = kst * 4096 + kc * 512 + kr * 16, voff = 8192 + vdh * 4096 + vrow * 64 + vcc * 16;
    { const v4u kv = *(const v4u*)(kg + (size_t)(kts * 64 + kst * 32 + kr) * OD_N + kc * 8), vv = *(const v4u*)(vg + (size_t)(kts * 64 + vrow) * OD_N + vdh * 32 + vcc * 8);
        *(LAS v4u*)(lds + koff) = kv; *(LAS v4u*)(lds + voff) = vv; }
    __syncthreads();
    AttSt S; S.m = 0.f; S.l = 0.f;
#pragma unroll
    for (int r = 0; r < 16; ++r) { S.o0[r] = 0.f; S.o1[r] = 0.f; }
    const int wlast = t0 + wave * 32 + 31, wfirst = t0 + wave * 32;
    for (int i = 0; i < ntile; ++i) { const int kt = kts + i; LAS unsigned char* buf = lds + (i & 1) * 16384; LAS unsigned char* nbuf = lds + ((i + 1) & 1) * 16384;
        v4u kv, vv; const bool more = i + 1 < ntile;
        if (more) { kv = *(const v4u*)(kg + (size_t)((kt + 1) * 64 + kst * 32 + kr) * OD_N + kc * 8); vv = *(const v4u*)(vg + (size_t)((kt + 1) * 64 + vrow) * OD_N + vdh * 32 + vcc * 8); }
        { const int kv0 = kt * 64;
            if (kv0 + 32 <= wlast) { FoxBias bf0{ng + (kv0 - s_start), tq, kv0, kv0 + 31 > wfirst}, bf1{ng + (kv0 + 32 - s_start), tq, kv0 + 32, kv0 + 63 > wfirst};
                att_tile64(S, qf, (LAS const char*)buf, (LAS const char*)buf + 8192, 4096, 0, lane, bf0, bf1); }
            else if (kv0 <= wlast) { FoxBias bf{ng + (kv0 - s_start), tq, kv0, kv0 + 31 > wfirst};
                att_subtile(S, qf, (LAS const char*)buf, (LAS const char*)buf + 8192, 4096, 0, lane, bf); } }
        if (more) { *(LAS v4u*)(nbuf + koff) = kv; *(LAS v4u*)(nbuf + voff - 8192 + 8192) = vv; }
        __syncthreads(); }
    const float lt = S.l + __shfl_xor(S.l, 32), inv = 1.f / lt;
    bf16* o = ao + (size_t)(rowbase + tq) * 1024 + h * 64;
#pragma unroll
    for (int a4 = 0; a4 < 4; ++a4) { v2u w0, w1;
        w0.x = cvtpk(S.o0[4 * a4] * inv, S.o0[4 * a4 + 1] * inv); w0.y = cvtpk(S.o0[4 * a4 + 2] * inv, S.o0[4 * a4 + 3] * inv);
        w1.x = cvtpk(S.o1[4 * a4] * inv, S.o1[4 * a4 + 1] * inv); w1.y = cvtpk(S.o1[4 * a4 + 2] * inv, S.o1[4 * a4 + 3] * inv);
        *(v2u*)(o + 8 * a4 + 4 * hi) = w0; *(v2u*)(o + 32 + 8 * a4 + 4 * hi) = w1; }
}

DI void ph_ln1_router(const Args& a, const Fr& F, int layer) {
    const bf16* yp = (const bf16*)(F.ws + WS_YP); float* x1 = (float*)(F.ws + WS_X1); unsigned char* xb8 = F.ws + WS_XB8;
    unsigned* tope = (unsigned*)(F.ws + WS_TOPE); float* gate = (float*)(F.ws + WS_GATE); unsigned* rank = (unsigned*)(F.ws + WS_RANK);
    const float* g = a.in[10] + (size_t)(layer * 2) * DM; const float* bb = a.in[11] + (size_t)(layer * 2) * DM;
    const float* rw = a.in[12] + (size_t)layer * 1024 * 32; const float* rb = a.in[13] + layer * 32;
    LAS float* red = (LAS float*)(F.lds); LAS unsigned* lcnt = (LAS unsigned*)(F.lds + 131072);
    const int lane = F.lane, wave = F.wave, tid = F.tid, l31 = lane & 31, hi = lane >> 5;
    for (int chunk = F.blk; chunk < 256; chunk += F.G) { const int tok0 = chunk * 128;
        __syncthreads();
        if (tid < 32) lcnt[tid] = 0u;
#pragma unroll 1
        for (int k = 0; k < 16; k += 8) { f32x4 v[8][4];
#pragma unroll
            for (int i = 0; i < 8; ++i)
#pragma unroll
                for (int jj = 0; jj < 4; ++jj) { const v2u w = *((const v2u*)(yp + (size_t)(tok0 + wave * 16 + k + i) * DM) + lane + 64 * jj);
                    v[i][jj] = (f32x4){bf2f(w.x & 0xffffu), bf2f(w.x >> 16), bf2f(w.y & 0xffffu), bf2f(w.y >> 16)}; }
#pragma unroll
            for (int i = 0; i < 8; ++i) { const int tok = tok0 + wave * 16 + k + i;
                ln_row(v[i], g, bb, lane);
                store_row_f32(x1 + (size_t)tok * DM, v[i], lane);
#pragma unroll
                for (int jj = 0; jj < 4; ++jj) *((unsigned*)(xb8 + (size_t)tok * DM) + lane + 64 * jj) = pk4_fp8(v[i][jj][0] * F8_SX, v[i][jj][1] * F8_SX, v[i][jj][2] * F8_SX, v[i][jj][3] * F8_SX); } }
        asm volatile("s_waitcnt vmcnt(0)" ::: "memory");
        __syncthreads();
        const int tl = wave & 3, kr = wave >> 2, tokl = tok0 + tl * 32 + l31;
        f32x16 D = proj32_f32(rw, 32, 32, x1 + (size_t)tokl * DM, kr * 512, lane);
        if (kr == 1) {
#pragma unroll
            for (int r = 0; r < 16; ++r) red[(tl * 16 + r) * 64 + lane] = D[r]; }
        __syncthreads();
        if (kr == 0) {
            float lv[32];
#pragma unroll
            for (int r = 0; r < 16; ++r) { const float own = D[r] + red[(tl * 16 + r) * 64 + lane] + rb[crow(r, hi)]; const float oth = __shfl_xor(own, 32);
                lv[crow(r, 0)] = hi == 0 ? own : oth; lv[crow(r, 1)] = hi == 0 ? oth : own; }
            float tv[4]; int te[4];
#pragma unroll
            for (int r = 0; r < 4; ++r) { float mx = -INFINITY; int me = 0;
#pragma unroll
                for (int e = 0; e < 32; ++e) { if (lv[e] > mx) { mx = lv[e]; me = e; } }
                tv[r] = mx; te[r] = me;
#pragma unroll
                for (int e = 0; e < 32; ++e) { if (e == me) lv[e] = -INFINITY; } }
            const float e1 = __expf(tv[1] - tv[0]), e2 = __expf(tv[2] - tv[0]), e3 = __expf(tv[3] - tv[0]); const float inv = 1.f / (1.f + e1 + e2 + e3);
            if (hi == 0) { const size_t o = (size_t)tokl * 4;
                const float gv[4] = {inv, e1 * inv, e2 * inv, e3 * inv};
#pragma unroll
                for (int r = 0; r < 4; ++r) { const unsigned rk = __hip_atomic_fetch_add(lcnt + (te[r] & 31), 1u, __ATOMIC_RELAXED, __HIP_MEMORY_SCOPE_WORKGROUP);
                    tope[o + r] = (unsigned)(te[r] & 31); gate[o + r] = gv[r]; rank[o + r] = rk; } } }
        __syncthreads();
        if (tid < 32) __hip_atomic_store(F.ctl + CW_CNT + chunk * 32 + tid, lcnt[tid], RLX_AGENT);
    }
}

DI void ph_route(const Fr& F) {
    const unsigned char* xb8 = F.ws + WS_XB8; unsigned char* xg = F.ws + WS_XG;
    const unsigned* tope = (const unsigned*)(F.ws + WS_TOPE); const unsigned* rank = (const unsigned*)(F.ws + WS_RANK); unsigned* dest = (unsigned*)(F.ws + WS_DEST);
    LAS unsigned* P = (LAS unsigned*)(F.lds); LAS unsigned* pst = P + 512; LAS unsigned* pad = P + 544; LAS unsigned* base = P + 576; LAS unsigned* nt = P + 608;
    const int tid = F.tid, lane = F.lane, wave = F.wave;
    __syncthreads();
    { const int e = tid & 31, part = tid >> 5; unsigned s = 0u;
        for (int c = 0; c < 16; ++c) s += ld_u32(F.ctl + CW_CNT + (part * 16 + c) * 32 + e);
        P[part * 32 + e] = s; }
    __syncthreads();
    if (tid < 32) { unsigned tot = 0u;
        for (int p = 0; p < 16; ++p) tot += P[p * 32 + tid];
        pad[tid] = (tot + 255u) & ~255u; }
    __syncthreads();
    if (tid == 0) { unsigned acc = 0u;
        for (int e = 0; e < 32; ++e) { pst[e] = acc; acc += pad[e]; }
        nt[0] = acc >> 8; }
    __syncthreads();
    for (int chunk = F.blk; chunk < 256; chunk += F.G) {
        __syncthreads();
        if (tid < 32) { unsigned off = 0u; const int pf = chunk >> 4;
            for (int p = 0; p < pf; ++p) off += P[p * 32 + tid];
            for (int c = pf * 16; c < chunk; ++c) off += ld_u32(F.ctl + CW_CNT + c * 32 + tid);
            base[tid] = pst[tid] + off; }
        __syncthreads();
#pragma unroll 1
        for (int i0 = 0; i0 < 16; i0 += 4) { v4u src[4]; unsigned ee[4][4], rr[4][4];
#pragma unroll
            for (int i = 0; i < 4; ++i) { const int tok = chunk * 128 + wave * 16 + i0 + i; src[i] = *((const v4u*)(xb8 + (size_t)tok * DM) + lane);
#pragma unroll
                for (int k = 0; k < 4; ++k) { ee[i][k] = tope[(size_t)tok * 4 + k]; rr[i][k] = rank[(size_t)tok * 4 + k]; } }
#pragma unroll
            for (int i = 0; i < 4; ++i) { const int tok = chunk * 128 + wave * 16 + i0 + i;
#pragma unroll
                for (int k = 0; k < 4; ++k) { const unsigned d = base[ee[i][k]] + rr[i][k];
                    if (lane == 0) dest[(size_t)tok * 4 + k] = d;
                    *((v4u*)(xg + (size_t)d * DM) + lane) = src[i]; } } }
        if (chunk == 0) { const unsigned ntl = nt[0];
            if (tid == 0) __hip_atomic_store(F.ctl + CW_TILE, ntl, RLX_AGENT);
            for (unsigned i = tid; i < ntl; i += NTHR) { unsigned e = 0u;
                for (unsigned k = 1; k < 32; ++k) if (pst[k] <= i * 256u) e = k;
                __hip_atomic_store(F.ctl + CW_TILE + 64 + i, e, RLX_AGENT); } }
    }
}

DI void ph_combine_ln2(const Args& a, const Fr& F, int layer) {
    const float* x1 = (const float*)(F.ws + WS_X1); const bf16* yr = (const bf16*)(F.ws + WS_XG); bf16* xb = (bf16*)(F.ws + WS_XB);
    const float* gate = (const float*)(F.ws + WS_GATE); const unsigned* dest = (const unsigned*)(F.ws + WS_DEST);
    const float* g = a.in[10] + (size_t)(layer * 2 + 1) * DM; const float* bb = a.in[11] + (size_t)(layer * 2 + 1) * DM;
    const int lane = F.lane; const int gw = F.blk * NWAVES + F.wave, NGW = F.G * NWAVES;
    for (int tok = gw; tok < NTOK; tok += 4 * NGW) { f32x4 v[4][4];
#pragma unroll
        for (int i = 0; i < 4; ++i) { const int tk = tok + i * NGW; if (tk < NTOK) {
#pragma unroll
            for (int jj = 0; jj < 4; ++jj) v[i][jj] = *((const f32x4*)(x1 + (size_t)tk * DM) + lane + 64 * jj) * ALPHA;
#pragma unroll
            for (int k = 0; k < 4; ++k) { const float gk = gate[(size_t)tk * 4 + k]; const unsigned d = dest[(size_t)tk * 4 + k];
#pragma unroll
                for (int jj = 0; jj < 4; ++jj) { const v2u w = *((const v2u*)(yr + (size_t)d * DM) + lane + 64 * jj);
                    v[i][jj][0] += gk * bf2f(w.x & 0xffffu); v[i][jj][1] += gk * bf2f(w.x >> 16); v[i][jj][2] += gk * bf2f(w.y & 0xffffu); v[i][jj][3] += gk * bf2f(w.y >> 16); } } } }
#pragma unroll
        for (int i = 0; i < 4; ++i) { const int tk = tok + i * NGW; if (tk < NTOK) {
            ln_row(v[i], g, bb, lane);
            if (layer == DEPTH - 1) store_row_f32(a.out + (size_t)tk * DM, v[i], lane);
            else store_row_bf16(xb + (size_t)tk * DM, v[i], lane); } } }
}
constexpr int LDS_BYTES = 147456;
constexpr int LDS_BARW = 145408, LDS_QSLOT = 145472, LDS_TILE_E = 133632;
constexpr int NPL = 11;
constexpr int NPHASE = 1 + NPL * DEPTH;
#ifndef MK_SINGLE
#define MK_SINGLE 1
#endif
DI int q_next(const Fr& F, unsigned* ctr) {
    LAS int* slot = (LAS int*)(F.lds + LDS_QSLOT);
    __syncthreads();
    if (F.tid == 0) *slot = (int)__hip_atomic_fetch_add(ctr, 1u, RLX_AGENT);
    __syncthreads();
    return *slot;
}
DI int lane_id_fresh() { unsigned m_ = ~0u; asm volatile("" : "+s"(m_)); return (int)__builtin_amdgcn_mbcnt_hi(m_, __builtin_amdgcn_mbcnt_lo(m_, 0u)); }
#define RETID(F) do { int t2_ = F.tid; asm volatile("" : "+v"(t2_)); F.tid = t2_; F.lane = t2_ & 63; F.wave = __builtin_amdgcn_readfirstlane(t2_ >> 6); } while (0)
#ifndef PROBE_DUP
#define PROBE_DUP -1
#endif
#define NREP(q) ((PROBE_DUP == (q)) ? 2 : 1)
#define AS4 __attribute__((address_space(4)))
#define SITE() Args a; Fr F; { const AS4 Args* ap = (const AS4 Args*)__builtin_amdgcn_kernarg_segment_ptr(); asm volatile("" : "+s"(ap)); \
        _Pragma("unroll") for (int i_ = 0; i_ < 18; ++i_) a.in[i_] = ap->in[i_]; a.out = ap->out; a.ws = ap->ws; a.ph_lo = 0; a.ph_hi = 0; \
        int w_ = wv_s; asm volatile("" : "+s"(w_)); int t_ = w_ * 64 + lane_id_fresh(); asm volatile("" : "+v"(t_)); F.tid = t_; F.lane = t_ & 63; F.wave = __builtin_amdgcn_readfirstlane(t_ >> 6); \
        F.lds = (LAS unsigned char*)lds_raw; F.ws = a.ws; F.ctl = (unsigned*)(a.ws + WS_CTL); F.blk = blockIdx.x; F.G = gridDim.x; }
__global__ void __launch_bounds__(NTHR, 2) mega_fwd(Args a0) {
    extern __shared__ __attribute__((aligned(16))) unsigned char lds_raw[];
    const int wv_s = __builtin_amdgcn_readfirstlane((int)(threadIdx.x >> 6));
#if MK_SINGLE
    constexpr int lo = 0, hi = NPHASE; constexpr bool single = true;
#else
    const int lo = a0.ph_lo, hi = a0.ph_hi; constexpr bool single = false;
#endif
    if (threadIdx.x == 0) *(LAS v4u*)((LAS unsigned char*)lds_raw + LDS_BARW) = (v4u){0u, 0u, 0u, 0u};
    __syncthreads();
    if (single) (void)xcd_barrier_post((unsigned*)(a0.ws + WS_CTL) + CW_BAR, (volatile LAS unsigned*)((LAS unsigned char*)lds_raw + LDS_BARW));
#define IN(k) (lo <= (k) && (k) < hi)
#define SEAM() do { if (single) { const AS4 Args* ap_ = (const AS4 Args*)__builtin_amdgcn_kernarg_segment_ptr(); asm volatile("" : "+s"(ap_)); int w_ = wv_s; asm volatile("" : "+s"(w_)); \
        XcdBarrier b_; b_.bar = (unsigned*)(ap_->ws + WS_CTL) + CW_BAR; b_.x = xb_xcc_id(); b_.st = (volatile LAS unsigned*)((LAS unsigned char*)lds_raw + LDS_BARW); \
        xcd_barrier(b_, (w_ == 0) && (lane_id_fresh() == 0)); } } while (0)
    if (IN(0)) { _Pragma("unroll 1") for (int rep = 0; rep < NREP(100); ++rep) { { SITE(); ph_prologue(a, F); } SEAM(); } }
#pragma clang loop unroll(full)
    for (int L = 0; L < DEPTH; ++L) {
        const int pb = 1 + NPL * L, j = L >> 1; const bool odd = (L & 1) != 0;
        if (IN(pb + 0)) _Pragma("unroll 1") for (int rep = 0; rep < NREP(0); ++rep) {
            { SITE();
            const bf16* w = odd ? (const bf16*)(F.ws + WS_WOD) + (size_t)j * OD_N * 1024 : (const bf16*)(F.ws + WS_WEV) + (size_t)j * EV_N * 1024;
            const int N = odd ? OD_N : EV_N;
            pg8::Gemm g{(const bf16*)(F.ws + WS_XB), w, NTOK, N, 1024}; pg8::StaticOrder S; S.init(NTOK, N, F.G, F.blk);
            pg8::EpiBf16<0> E{(bf16*)(F.ws + WS_PROJ), N, nullptr, 1024, (size_t)1024, C2F};
            pg8::gemm_phase<pg8::EpiBf16<0>, pg8::StaticOrder, true, true>(F.lds, g, S, E, F.tid); }
            SEAM(); }
        if (IN(pb + 1)) _Pragma("unroll 1") for (int rep = 0; rep < NREP(1); ++rep) { { SITE(); if (odd) ph_odd_prep(a, F, j, L); else ph_even_prep(a, F, j); } SEAM(); }
        if (!odd && IN(pb + 2)) _Pragma("unroll 1") for (int rep = 0; rep < ((PROBE_DUP == 2 || (PROBE_DUP >= 21 && PROBE_DUP <= 22) || (PROBE_DUP >= 211 && PROBE_DUP <= 217)) ? 2 : 1); ++rep) {
            { SITE(); unsigned* ctr = F.ctl + CW_Q + 64 * (L * 2) + 1024 * rep;
            for (;;) { const int it = q_next(F, ctr); if (it >= 1280) break; RETID(F);
                if (it < 1024) { if (!(rep == 1 && PROBE_DUP == 22)) idx_unit(F, it & 3, 255 - (it >> 2), (rep == 1 && PROBE_DUP >= 211) ? PROBE_DUP - 210 : 0); } else { if (!(rep == 1 && (PROBE_DUP == 21 || PROBE_DUP >= 211))) moba_gate_chunk(F, it - 1024); } } }
            SEAM(); }
        if (IN(pb + 3)) _Pragma("unroll 1") for (int rep = 0; rep < ((PROBE_DUP == 3 || (PROBE_DUP == 31 && odd) || ((PROBE_DUP == 32 || PROBE_DUP == 33) && !odd)) ? 2 : 1); ++rep) {
            { SITE(); unsigned* ctr = F.ctl + CW_Q + 64 * (L * 2 + 1) + 1024 * rep;
            if (odd) { for (;;) { const int it = q_next(F, ctr); if (it >= 2048) break; RETID(F); const int bh = it & 63; fox_unit(F, L, bh >> 4, bh & 15, 31 - (it >> 6)); } }
            else { for (;;) { const int it = q_next(F, ctr); if (it >= 2048) break; RETID(F);
                    if (it < 1024) { const int bh = it & 31; if (!(rep == 1 && PROBE_DUP == 33)) moba_unit(a, F, bh >> 3, bh & 7, it >> 5); } else { if (!(rep == 1 && PROBE_DUP == 32)) dsa_chunk(a, F, it - 1024); } } } }
            SEAM(); }
        if (!odd && IN(pb + 4)) _Pragma("unroll 1") for (int rep = 0; rep < NREP(4); ++rep) { { SITE(); ph_even_post(F, j); } SEAM(); }
        if (IN(pb + 5)) _Pragma("unroll 1") for (int rep = 0; rep < NREP(5); ++rep) {
            { SITE();
            pg8::Gemm g{(const bf16*)(F.ws + WS_AO), (const bf16*)(F.ws + WS_WOUT) + (size_t)L * 1024 * 1024, NTOK, 1024, 1024}; pg8::StaticOrder S; S.init(NTOK, 1024, F.G, F.blk);
            EpiResBf16 E{(const bf16*)(F.ws + WS_XB), (bf16*)(F.ws + WS_YP), ALPHA};
            pg8::gemm_phase<EpiResBf16, pg8::StaticOrder, true, true>(F.lds, g, S, E, F.tid); }
            SEAM(); }
        if (IN(pb + 6)) _Pragma("unroll 1") for (int rep = 0; rep < NREP(6); ++rep) { { SITE(); ph_ln1_router(a, F, L); } SEAM(); }
        if (IN(pb + 7)) _Pragma("unroll 1") for (int rep = 0; rep < NREP(7); ++rep) { { SITE(); ph_route(F); } SEAM(); }
        if (IN(pb + 8)) _Pragma("unroll 1") for (int rep = 0; rep < NREP(8); ++rep) {
            { SITE(); const int ntl = (int)ld_u32(F.ctl + CW_TILE);
            LAS unsigned* tle = (LAS unsigned*)(F.lds + LDS_TILE_E);
            for (int i = F.tid; i < ntl; i += NTHR) tle[i] = ld_u32(F.ctl + CW_TILE + 64 + i);
            __syncthreads();
            pg8::Gemm g{(const bf16*)(F.ws + WS_XG), (const bf16*)(F.ws + WS_WGU + (size_t)L * 32 * 2048 * 1024), NR_MAX, 32 * 2048, 512};
            GroupOrder S{tle, ntl, 3, F.G, F.blk};
            EpiSwiglu E{F.ws + WS_ACT, a.in[15] + (size_t)L * 32 * 2048};
            pg8::gemm_phase<EpiSwiglu, GroupOrder, true, true, true>(F.lds, g, S, E, F.tid); }
            SEAM(); }
        if (IN(pb + 9)) _Pragma("unroll 1") for (int rep = 0; rep < NREP(9); ++rep) {
            { SITE(); const int ntl = (int)ld_u32(F.ctl + CW_TILE);
            LAS unsigned* tle = (LAS unsigned*)(F.lds + LDS_TILE_E);
            for (int i = F.tid; i < ntl; i += NTHR) tle[i] = ld_u32(F.ctl + CW_TILE + 64 + i);
            __syncthreads();
            pg8::Gemm g{(const bf16*)(F.ws + WS_ACT), (const bf16*)(F.ws + WS_WDN + (size_t)L * 32 * 1024 * 1024), NR_MAX, 32 * 1024, 512};
            GroupOrder S{tle, ntl, 2, F.G, F.blk};
            EpiDown E{(bf16*)(F.ws + WS_XG), a.in[17] + (size_t)L * 32 * 1024};
            pg8::gemm_phase<EpiDown, GroupOrder, true, true, true>(F.lds, g, S, E, F.tid); }
            SEAM(); }
        if (IN(pb + 10)) _Pragma("unroll 1") for (int rep = 0; rep < NREP(10); ++rep) { { SITE(); ph_combine_ln2(a, F, L); } if (L + 1 < DEPTH || rep + 1 < NREP(10)) SEAM(); }
        if (PROBE_DUP == 900 && L + 1 < DEPTH) { _Pragma("unroll 1") for (int xb = 0; xb < 10; ++xb) SEAM(); }
    }
#undef IN
#undef SEAM
}

extern "C" void kernel_launch(void* const* d_in, const int* in_sizes, int n_in, void* d_out, int out_size, void* d_ws, size_t ws_size, hipStream_t stream) {
    static int grid = 0;
    if (grid == 0) {
        if (n_in != 18 || out_size != NTOK * DM || ws_size < WS_END) { fprintf(stderr, "kernel_launch: unexpected shapes (n_in %d, out %d, ws %zu); nothing launched\n", n_in, out_size, ws_size); grid = -1; return; }
        int dev = 0, cus = 0, per_cu = 0;
        if (hipGetDevice(&dev) != hipSuccess || hipDeviceGetAttribute(&cus, hipDeviceAttributeMultiprocessorCount, dev) != hipSuccess) { grid = -1; return; }
        if (hipFuncSetAttribute((const void*)mega_fwd, hipFuncAttributeMaxDynamicSharedMemorySize, LDS_BYTES) != hipSuccess) { fprintf(stderr, "kernel_launch: hipFuncSetAttribute failed\n"); grid = -1; return; }
        if (hipOccupancyMaxActiveBlocksPerMultiprocessor(&per_cu, (const void*)mega_fwd, NTHR, LDS_BYTES) != hipSuccess || per_cu < 1) fprintf(stderr, "kernel_launch: occupancy query reports %d\n", per_cu);
        (void)hipGetLastError();
        grid = cus;
    }
    if (grid < 0) return;
    (void)hipMemsetAsync((char*)d_ws + WS_CTL, 0, CTL_ZERO_BYTES, stream);
#ifdef EXP_SKIP
    (void)hipMemsetAsync((char*)d_ws + WS_AO, 0, 64 * MiB, stream);
    (void)hipMemsetAsync((char*)d_ws + WS_OL, 0, 64 * MiB, stream);
    if (EXP_SKIP & 4) { (void)hipMemsetAsync((char*)d_ws + WS_XG, 0, 272 * MiB, stream); (void)hipMemsetAsync((char*)d_ws + WS_DEST, 0, 1 * MiB, stream); }
#endif
    Args a{};
    for (int i = 0; i < 18; ++i) a.in[i] = (const float*)d_in[i];
    a.out = (float*)d_out; a.ws = (unsigned char*)d_ws;
#if MK_SINGLE
    a.ph_lo = 0; a.ph_hi = NPHASE;
    hipLaunchKernelGGL(mega_fwd, dim3(grid), dim3(NTHR), LDS_BYTES, stream, a);
#else
    for (int p = 0; p < NPHASE; ++p) {
        if (p > 0) { const int L = (p - 1) / NPL, q = (p - 1) % NPL; if ((L & 1) && (q == 2 || q == 4)) continue;
#ifdef EXP_SKIP
            if ((EXP_SKIP & 1) && !(L & 1) && q <= 4) continue;
            if ((EXP_SKIP & 2) && (L & 1) && q <= 4) continue;
            if ((EXP_SKIP & 4) && q >= 7 && q <= 9) continue;
#endif
        }
        a.ph_lo = p; a.ph_hi = p + 1;
        hipLaunchKernelGGL(mega_fwd, dim3(grid), dim3(NTHR), LDS_BYTES, stream, a);
    }
#endif
}
```

```cpp
#include <hip/hip_runtime.h>
#include <cstdio>
#include <cstdint>
#ifdef EXP_SKIP
#define EXPF EXP_SKIP
#else
#define EXPF 0
#endif
constexpr int NB = 4, SEQ = 8192, DM = 1024, NTOK = NB * SEQ, DEPTH = 4;
constexpr int EV_N = 2560, OD_N = 3072;
constexpr int EC_QA = 0, EC_QB = 512, EC_KB = 1024, EC_VB = 1536, EC_CKV = 2048, EC_QI = 2176, EC_KI = 2432, EC_WI = 2496;
constexpr int OC_Q = 0, OC_K = 1024, OC_V = 2048;
constexpr float LOG2E = 1.4426950408889634f;
constexpr float C2F = 0.125f * LOG2E;
constexpr float ALPHA = 1.681792830507429f;
constexpr float LN_EPS = 1e-5f;
constexpr int NR_MAX = 131072 + 32 * 256;
constexpr int NWAVES = 8, NTHR = 512;
constexpr size_t MiB = (size_t)1 << 20;
constexpr size_t WS_CTL = 0, CTL_ZERO_BYTES = 4 * MiB;
constexpr size_t WS_WEV = 8 * MiB, WS_WOD = 18 * MiB, WS_WOUT = 30 * MiB, WS_WUKT = 38 * MiB, WS_WUVT = 39 * MiB;
constexpr size_t WS_WGU = 40 * MiB, WS_WDN = 552 * MiB;
constexpr size_t WS_X = 808 * MiB, WS_X1 = 936 * MiB, WS_YP = 1064 * MiB, WS_XB = 1192 * MiB;
constexpr size_t WS_PROJ = 1256 * MiB, WS_AO = 1448 * MiB, WS_XG = 1512 * MiB, WS_ACT = 1784 * MiB;
constexpr size_t WS_QL = 2056 * MiB, WS_OL = 2120 * MiB, WS_CKVN = 2184 * MiB, WS_SEL = 2192 * MiB;
constexpr size_t WS_KBAR = 2208 * MiB, WS_SEL3 = 2209 * MiB, WS_LOGF = 2210 * MiB, WS_CS = 2212 * MiB;
constexpr size_t WS_TOPE = 2213 * MiB, WS_GATE = 2214 * MiB, WS_RANK = 2215 * MiB, WS_DEST = 2216 * MiB, WS_PML = 2217 * MiB;
constexpr size_t WS_XB8 = 2226 * MiB;
constexpr size_t WS_KIC = 2258 * MiB;
constexpr size_t WS_END = 2262 * MiB;
constexpr float F8_SX = 16.f, F8_SWG = 256.f, F8_SA = 4.f, F8_SWD = 512.f;
constexpr int CW_BAR = 4096, CW_Q = 8192, CW_KMAX = 12288, CW_CNT = 16384, CW_TILE = 32768;

#define GAS __attribute__((address_space(1)))
#define LAS __attribute__((address_space(3)))
#define DI __device__ __forceinline__
typedef unsigned short bf16;
typedef unsigned v4u __attribute__((ext_vector_type(4)));
typedef unsigned v2u __attribute__((ext_vector_type(2)));
typedef float f32x4 __attribute__((ext_vector_type(4)));
typedef float f32x2 __attribute__((ext_vector_type(2)));
typedef float f32x16 __attribute__((ext_vector_type(16)));
typedef short bf16x8 __attribute__((ext_vector_type(8)));
typedef short s16x4 __attribute__((ext_vector_type(4)));
typedef __bf16 bf16x2_t __attribute__((ext_vector_type(2)));
typedef GAS unsigned gu32;
#define RLX_AGENT __ATOMIC_RELAXED, __HIP_MEMORY_SCOPE_AGENT
#define LDS_WAIT() asm volatile("s_waitcnt lgkmcnt(0)" ::: "memory")

DI float bf2f(unsigned v) { return __uint_as_float(v << 16); }
DI unsigned cvtpk(float lo, float hi) { f32x2 v = {lo, hi}; bf16x2_t b = __builtin_convertvector(v, bf16x2_t); return __builtin_bit_cast(unsigned, b); }
DI unsigned f2bf(float f) { return cvtpk(f, 0.f) & 0xffffu; }
DI unsigned pk4_fp8(float a, float b, float c, float d) {
    a = fminf(fmaxf(a, -448.f), 448.f); b = fminf(fmaxf(b, -448.f), 448.f); c = fminf(fmaxf(c, -448.f), 448.f); d = fminf(fmaxf(d, -448.f), 448.f);
    int w = 0; w = __builtin_amdgcn_cvt_pk_fp8_f32(a, b, w, false); w = __builtin_amdgcn_cvt_pk_fp8_f32(c, d, w, true); return (unsigned)w; }
DI float ex2(float x) { return __builtin_amdgcn_exp2f(x); }
DI float wave_sum(float v) {
#pragma unroll
    for (int o = 1; o < 64; o <<= 1) v += __shfl_xor(v, o);
    return v;
}
DI float wave_max(float v) {
#pragma unroll
    for (int o = 1; o < 64; o <<= 1) v = fmaxf(v, __shfl_xor(v, o));
    return v;
}
DI unsigned ld_u32(const unsigned* p) { return __hip_atomic_load(p, RLX_AGENT); }
DI int crow(int r, int hi) { return (r & 3) + 8 * (r >> 2) + 4 * hi; }
DI f32x16 mfma32(bf16x8 a, bf16x8 b, f32x16 c) { return __builtin_amdgcn_mfma_f32_32x32x16_bf16(a, b, c, 0, 0, 0); }
DI f32x4 mfma16(bf16x8 a, bf16x8 b, f32x4 c) { return __builtin_amdgcn_mfma_f32_16x16x32_bf16(a, b, c, 0, 0, 0); }
typedef short v4i16_t __attribute__((ext_vector_type(4)));
DI s16x4 vtr(LAS const char* p) { return __builtin_bit_cast(s16x4, __builtin_amdgcn_ds_read_tr16_b64_v4i16((LAS v4i16_t*)p)); }
DI bf16x8 cat8(s16x4 a, s16x4 b) { return (bf16x8){a[0], a[1], a[2], a[3], b[0], b[1], b[2], b[3]}; }
DI int t5_bucket(int n) {
    if (n < 16) return n;
    int bkt = 16;
    bkt += (n >= 21); bkt += (n >= 27); bkt += (n >= 35); bkt += (n >= 46); bkt += (n >= 59); bkt += (n >= 77); bkt += (n >= 99); bkt += (n >= 128);
    bkt += (n >= 166); bkt += (n >= 216); bkt += (n >= 280); bkt += (n >= 363); bkt += (n >= 470); bkt += (n >= 609); bkt += (n >= 790);
    return bkt;
}
namespace pg8 {
#define PG8_LAS __attribute__((address_space(3)))
typedef unsigned short bf16_t;
typedef short bf16x8 __attribute__((ext_vector_type(8)));
typedef float f32x4 __attribute__((ext_vector_type(4)));
typedef unsigned u32x4 __attribute__((ext_vector_type(4)));
constexpr int BM = 256, BK = 64, HALF = 128, HTB = HALF * BK * 2  , STAGE_BYTES = 8 * HTB, NXCD = 8, WGM = 8;

__host__ __device__ __forceinline__ int lds_byte(int r, int c) { const int st = (r >> 4) * 2 + (c >> 5), rr = r & 15, cc = c & 31, ob = rr * 64 + cc * 2; return st * 1024 + (ob ^ (((ob >> 9) & 1) << 5)); }
__host__ __device__ __forceinline__ void stage_rc(int b, int& R, int& C) { const int st = b / 1024, sb = b % 1024, swz = sb ^ (((sb >> 9) & 1) << 5); R = (st >> 1) * 16 + swz / 64; C = (st & 1) * 32 + (swz % 64) / 2; }
__host__ __device__ __forceinline__ int perm32(int rho) { const int n = rho >> 4, i = rho & 15; return 8 * (i >> 2) + 4 * n + (i & 3); }

typedef int i32x8 __attribute__((ext_vector_type(8))); typedef int i32x4v __attribute__((ext_vector_type(4)));
__device__ __forceinline__ i32x8 pg8_cat8(bf16x8 lo, bf16x8 hi) { const i32x4v a = __builtin_bit_cast(i32x4v, lo), b = __builtin_bit_cast(i32x4v, hi); return (i32x8){a[0], a[1], a[2], a[3], b[0], b[1], b[2], b[3]}; }
struct Unit { int pm, pn; };
struct Gemm { const bf16_t* A; const bf16_t* Bt; int M, N, K; };

struct StaticOrder {
    int nM, nN, nwg, G, c;
    __host__ __device__ void init(int M, int N, int G_, int c_) { nM = M / BM; nN = N / BM; nwg = nM * nN; G = G_; c = c_; }
    __host__ __device__ bool next(int i, Unit& u) const {
        const long L = (long)i * G + c; if (L >= nwg) return false;
        int wgid = (int)L; { const int q = nwg / NXCD, r = nwg % NXCD, xcd = wgid % NXCD, off = wgid / NXCD; wgid = (xcd < r ? xcd * (q + 1) : r * (q + 1) + (xcd - r) * q) + off; }
        const int nig = WGM * nN, gid = wgid / nig, fm = gid * WGM, gsz = (nM - fm) < WGM ? (nM - fm) : WGM;
        u.pm = fm + ((wgid % nig) % gsz); u.pn = (wgid % nig) / gsz; return true;
    }
    __device__ __forceinline__ void a_ready(const Unit&) const {}
    __device__ __forceinline__ void done(const Unit&) const {}
};

__device__ __forceinline__ unsigned cvt_pk_bf16(float lo, float hi) { unsigned r; asm volatile("v_cvt_pk_bf16_f32 %0, %1, %2" : "=v"(r) : "v"(lo), "v"(hi)); return r; }
typedef float f32x2 __attribute__((ext_vector_type(2)));
__device__ __forceinline__ f32x2 gelu_pk(f32x2 v) {
    const f32x2 av = __builtin_elementwise_abs(v), d = av * 0.2316418882f + 1.0f;
    f32x2 t; t.x = __builtin_amdgcn_rcpf(d.x); t.y = __builtin_amdgcn_rcpf(d.y);
    f32x2 q = t * 0.5307027145f + (-0.7265760135f); q = q * t + 0.7107068705f; q = q * t + (-0.142248368f); q = q * t + 0.127414796f; q = q * t;
    const f32x2 s = (v * v) * (-0.72134752044f);
    f32x2 e; e.x = __builtin_amdgcn_exp2f(s.x); e.y = __builtin_amdgcn_exp2f(s.y);
    const f32x2 m = v * (q * e), r = v - m;
    f32x2 o; o.x = v.x < 0.f ? m.x : r.x; o.y = v.y < 0.f ? m.y : r.y; return o;
}

template <int ACT  > struct EpiBf16 {
    static constexpr bool PERM = true, AFTER_DRAIN = false; static_assert(ACT == 0 || ACT == 1, "EpiBf16: ACT is 0 (none) or 1 (gelu_pk)");
    bf16_t* O; int ldc; const float* bias; int split_cols; size_t split_stride; float scale0;
    __device__ __forceinline__ void operator()(const f32x4 (&acc)[2][2][4][2], const Unit& u, int wr, int wc, int fr, int fq) const {
        const int row0 = u.pm * BM + wr * 64 + fr; int colt = u.pn * BM; bf16_t* base = O;
        float sc = 1.f; if (split_cols) { const int t = colt / split_cols; base += (size_t)t * split_stride; colt -= t * split_cols; if (t == 0) sc = scale0; }
        const int col0 = colt + wc * 32 + 8 * fq, bcol0 = u.pn * BM + wc * 32 + 8 * fq;
        f32x4 bv[2][2];
#pragma unroll
        for (int bj = 0; bj < 2; ++bj)
#pragma unroll
            for (int n = 0; n < 2; ++n) bv[bj][n] = bias ? *(const f32x4*)(bias + bcol0 + bj * HALF + 4 * n) : (f32x4){0.f, 0.f, 0.f, 0.f};
#pragma unroll
        for (int ai = 0; ai < 2; ++ai)
#pragma unroll
            for (int m = 0; m < 4; ++m) { bf16_t* rowp = base + (size_t)(row0 + ai * HALF + m * 16) * ldc + col0;
#pragma unroll
                for (int bj = 0; bj < 2; ++bj) { f32x4 v0 = acc[ai][bj][m][0] + bv[bj][0], v1 = acc[ai][bj][m][1] + bv[bj][1];
                    if (ACT == 1) { f32x2 a = gelu_pk((f32x2){v0[0], v0[1]}), b = gelu_pk((f32x2){v0[2], v0[3]}), c = gelu_pk((f32x2){v1[0], v1[1]}), d = gelu_pk((f32x2){v1[2], v1[3]});
                        v0 = (f32x4){a.x, a.y, b.x, b.y}; v1 = (f32x4){c.x, c.y, d.x, d.y}; }
                    v0 = v0 * sc; v1 = v1 * sc; u32x4 w; w.x = cvt_pk_bf16(v0[0], v0[1]); w.y = cvt_pk_bf16(v0[2], v0[3]); w.z = cvt_pk_bf16(v1[0], v1[1]); w.w = cvt_pk_bf16(v1[2], v1[3]);
                    *(u32x4*)(rowp + bj * HALF) = w; } }
    }
};

template <class Epi, class Sched, bool ALIGN_EPI = false, bool SP2 = false, bool F8 = false>
__device__ __forceinline__ void gemm_phase(PG8_LAS unsigned char* lds, const Gemm g, const Sched& S, const Epi& E, int tid_in) {
    int tid_l = tid_in; asm volatile("" : "+v"(tid_l));
    const int tid = tid_l, wid = __builtin_amdgcn_readfirstlane(tid >> 6), lane = tid & 63, wr = wid >> 2, wc = wid & 3, fr = lane & 15, fq = lane >> 4;
    const int K = g.K, nt = K / BK;
    unsigned voffA[2], voffB[2];
#pragma unroll
    for (int i = 0; i < 2; ++i) { int R, C; stage_rc(tid * 16 + i * 8192, R, C); const int Rb = Epi::PERM ? ((R & ~31) + perm32(R & 31)) : R;
        voffA[i] = (unsigned)(R * K + C) * 2u; voffB[i] = (unsigned)(Rb * K + C) * 2u; }
    const size_t kstep = (size_t)(BK * 2);
    const size_t hstep = (size_t)HALF * K * 2;
    const size_t tstep = 2 * hstep;
    const unsigned ldsw = (unsigned)wid * 1024u;
    const int aoff = lds_byte(wr * 64 + fr, fq * 8), boff = lds_byte(wc * 32 + fr, fq * 8);
#define PG8_SA(b, h) (((b) * 2 + (h)) * HTB)
#define PG8_SB(b, h) ((4 + (b) * 2 + (h)) * HTB)
#define PG8_STAGE(bufoff, gbase, voff) do { _Pragma("unroll") for (int _i = 0; _i < 2; ++_i) \
        __builtin_amdgcn_global_load_lds((const unsigned*)((const char*)(gbase) + (voff)[_i]), (PG8_LAS unsigned*)(lds + (bufoff) + ldsw + _i * 8192), 16, 0, 0); } while (0)
#define PG8_LDA(dst, b, h) do { _Pragma("unroll") for (int m = 0; m < 4; ++m) _Pragma("unroll") for (int k = 0; k < 2; ++k) dst[m][k] = *(const PG8_LAS bf16x8*)(lds + PG8_SA(b, h) + aoff + m * 2048 + k * 1024); } while (0)
#define PG8_LDB(dst, b, h) do { _Pragma("unroll") for (int n = 0; n < 2; ++n) _Pragma("unroll") for (int k = 0; k < 2; ++k) dst[n][k] = *(const PG8_LAS bf16x8*)(lds + PG8_SB(b, h) + boff + n * 2048 + k * 1024); } while (0)
#define PG8_MMA(ai, bj, At, Bt) do { __builtin_amdgcn_s_setprio(1); if constexpr (!F8) { _Pragma("unroll") for (int m = 0; m < 4; ++m) _Pragma("unroll") for (int n = 0; n < 2; ++n) _Pragma("unroll") for (int k = 0; k < 2; ++k) \
        acc[ai][bj][m][n] = __builtin_amdgcn_mfma_f32_16x16x32_bf16(Bt[n][k], At[m][k], acc[ai][bj][m][n], 0, 0, 0); } else { _Pragma("unroll") for (int m = 0; m < 4; ++m) _Pragma("unroll") for (int n = 0; n < 2; ++n) \
        acc[ai][bj][m][n] = __builtin_amdgcn_mfma_scale_f32_16x16x128_f8f6f4(pg8_cat8(Bt[n][0], Bt[n][1]), pg8_cat8(At[m][0], At[m][1]), acc[ai][bj][m][n], 0, 0, 0, 0x7F7F7F7F, 0, 0x7F7F7F7F); \
        _Pragma("unroll") for (int m = 0; m < 4; ++m) _Pragma("unroll") for (int n = 0; n < 2; ++n) asm volatile("" : "+v"(acc[ai][bj][m][n]));   } __builtin_amdgcn_s_setprio(0); } while (0)
#define PG8_WAIT_V(n) asm volatile("s_waitcnt vmcnt(" #n ")" ::: "memory")
#define PG8_WAIT_L(n) asm volatile("s_waitcnt lgkmcnt(" #n ")" ::: "memory")
#define PG8_BAR __builtin_amdgcn_s_barrier()
#define PG8_SCHED __builtin_amdgcn_sched_barrier(0)
    Unit cur, nxt; int ui = 0;
    if (!S.next(0, cur)) return;
    f32x4 acc[2][2][4][2];
#pragma unroll
    for (int a = 0; a < 2; ++a)
#pragma unroll
        for (int b = 0; b < 2; ++b)
#pragma unroll
            for (int m = 0; m < 4; ++m)
#pragma unroll
                for (int n = 0; n < 2; ++n) acc[a][b][m][n] = (f32x4){0.f, 0.f, 0.f, 0.f};
    bf16x8 At[4][2], B0[2][2], B1[2][2];
    const char* cA = (const char*)g.A + (size_t)cur.pm * tstep; const char* cB = (const char*)g.Bt + (size_t)cur.pn * tstep;
    S.a_ready(cur);
    if constexpr (SP2) {
        PG8_STAGE(PG8_SB(0, 0), cB, voffB); PG8_STAGE(PG8_SB(0, 1), cB + hstep, voffB); PG8_STAGE(PG8_SA(0, 0), cA, voffA); PG8_STAGE(PG8_SA(0, 1), cA + hstep, voffA);
        if (wr == 1) PG8_BAR;
        PG8_WAIT_V(2); PG8_BAR;
        PG8_STAGE(PG8_SB(1, 0), cB + kstep, voffB); PG8_STAGE(PG8_SA(1, 0), cA + kstep, voffA); PG8_STAGE(PG8_SB(1, 1), cB + hstep + kstep, voffB);
        PG8_WAIT_V(6); PG8_BAR;
    } else {
        PG8_STAGE(PG8_SB(0, 0), cB, voffB); PG8_STAGE(PG8_SA(0, 0), cA, voffA); PG8_STAGE(PG8_SB(0, 1), cB + hstep, voffB); PG8_STAGE(PG8_SA(0, 1), cA + hstep, voffA);
        if (wr == 1) PG8_BAR;
        PG8_WAIT_V(4); PG8_BAR;
        PG8_STAGE(PG8_SB(1, 0), cB + kstep, voffB); PG8_STAGE(PG8_SA(1, 0), cA + kstep, voffA); PG8_STAGE(PG8_SB(1, 1), cB + hstep + kstep, voffB);
        PG8_WAIT_V(6); PG8_BAR;
    }
    for (;;) {
        const bool has_next = S.next(ui + 1, nxt);
        const char* nA = has_next ? (const char*)g.A + (size_t)nxt.pm * tstep : cA; const char* nB = has_next ? (const char*)g.Bt + (size_t)nxt.pn * tstep : cB;
        for (int t = 0; t < nt; t += 2) {
            const bool last = (t == nt - 2);
            const char* a1 = cA + (size_t)(t + 1) * kstep;
            const char* a2 = last ? nA : cA + (size_t)(t + 2) * kstep; const char* b2 = last ? nB : cB + (size_t)(t + 2) * kstep;
            const char* a3 = a2 + kstep; const char* b3 = b2 + kstep;
            if (last && has_next) S.a_ready(nxt);
            if constexpr (SP2) {
            PG8_LDB(B0, 0, 0); PG8_LDB(B1, 0, 1); PG8_SCHED; PG8_LDA(At, 0, 0); PG8_STAGE(PG8_SA(1, 1), a1 + hstep, voffA);
            PG8_WAIT_V(8); PG8_WAIT_L(0); PG8_BAR; PG8_MMA(0, 0, At, B0); PG8_MMA(0, 1, At, B1); PG8_BAR; PG8_SCHED;
            PG8_LDA(At, 0, 1); PG8_STAGE(PG8_SB(0, 0), b2, voffB); PG8_STAGE(PG8_SB(0, 1), b2 + hstep, voffB); PG8_STAGE(PG8_SA(0, 0), a2, voffA);
            PG8_WAIT_V(8); PG8_WAIT_L(0); PG8_BAR; PG8_MMA(1, 0, At, B0); PG8_MMA(1, 1, At, B1); PG8_BAR; PG8_SCHED;
            PG8_LDB(B0, 1, 0); PG8_LDB(B1, 1, 1); PG8_SCHED; PG8_LDA(At, 1, 0); PG8_STAGE(PG8_SA(0, 1), a2 + hstep, voffA);
            PG8_WAIT_V(8); PG8_WAIT_L(0); PG8_BAR; PG8_MMA(0, 0, At, B0); PG8_MMA(0, 1, At, B1); PG8_BAR; PG8_SCHED;
            PG8_LDA(At, 1, 1); PG8_STAGE(PG8_SB(1, 0), b3, voffB); PG8_STAGE(PG8_SB(1, 1), b3 + hstep, voffB); PG8_STAGE(PG8_SA(1, 0), a3, voffA);
            PG8_WAIT_V(8); PG8_WAIT_L(0); PG8_BAR; PG8_MMA(1, 0, At, B0); PG8_MMA(1, 1, At, B1); PG8_BAR; PG8_SCHED;
            } else {
            PG8_LDB(B0, 0, 0); PG8_SCHED; PG8_LDA(At, 0, 0); PG8_STAGE(PG8_SA(1, 1), a1 + hstep, voffA);
            PG8_WAIT_L(8); PG8_BAR; PG8_WAIT_L(0); PG8_MMA(0, 0, At, B0); PG8_BAR; PG8_SCHED;
            PG8_LDB(B1, 0, 1); PG8_STAGE(PG8_SB(0, 0), b2, voffB);
            PG8_BAR; PG8_WAIT_L(0); PG8_MMA(0, 1, At, B1); PG8_BAR;
            PG8_LDA(At, 0, 1); PG8_STAGE(PG8_SA(0, 0), a2, voffA);
            PG8_BAR; PG8_WAIT_L(0); PG8_MMA(1, 0, At, B0); PG8_BAR; PG8_SCHED;
            PG8_STAGE(PG8_SB(0, 1), b2 + hstep, voffB);
            PG8_WAIT_V(6); PG8_BAR; PG8_MMA(1, 1, At, B1); PG8_BAR;
            PG8_LDB(B0, 1, 0); PG8_SCHED; PG8_LDA(At, 1, 0); PG8_STAGE(PG8_SA(0, 1), a2 + hstep, voffA);
            PG8_WAIT_L(8); PG8_BAR; PG8_WAIT_L(0); PG8_MMA(0, 0, At, B0); PG8_BAR; PG8_SCHED;
            PG8_LDB(B1, 1, 1); PG8_STAGE(PG8_SB(1, 0), b3, voffB);
            PG8_BAR; PG8_WAIT_L(0); PG8_MMA(0, 1, At, B1); PG8_BAR;
            PG8_LDA(At, 1, 1); PG8_STAGE(PG8_SA(1, 0), a3, voffA);
            PG8_BAR; PG8_WAIT_L(0); PG8_MMA(1, 0, At, B0); PG8_BAR; PG8_SCHED;
            PG8_STAGE(PG8_SB(1, 1), b3 + hstep, voffB);
            PG8_WAIT_V(6); PG8_BAR; PG8_MMA(1, 1, At, B1); PG8_BAR;
            }
        }
        if constexpr (ALIGN_EPI) { if (wr == 0) PG8_BAR; }
        if constexpr (!Epi::AFTER_DRAIN) { E(acc, cur, wr, wc, fr, fq); S.done(cur); }
        if (!has_next) break;
#pragma unroll
        for (int a = 0; a < 2; ++a)
#pragma unroll
            for (int b = 0; b < 2; ++b)
#pragma unroll
                for (int m = 0; m < 4; ++m)
#pragma unroll
                    for (int n = 0; n < 2; ++n) acc[a][b][m][n] = (f32x4){0.f, 0.f, 0.f, 0.f};
        cur = nxt; cA = nA; cB = nB; ++ui;
        if constexpr (ALIGN_EPI) { if (wr == 1) PG8_BAR; }
    }
    PG8_WAIT_V(0);
    if constexpr (!ALIGN_EPI) { if (wr == 0) PG8_BAR; }
    PG8_BAR;
    if constexpr (Epi::AFTER_DRAIN) { E.fused(acc, cur, wr, wc, fr, fq, lds, wid, lane); S.done(cur); }
#undef PG8_SA
#undef PG8_SB
#undef PG8_STAGE
#undef PG8_LDA
#undef PG8_LDB
#undef PG8_MMA
#undef PG8_WAIT_V
#undef PG8_WAIT_L
#undef PG8_BAR
#undef PG8_SCHED
}
}

#ifndef PG8_SP2
#define PG8_SP2 true
#endif
#ifndef PG8_ALIGN
#define PG8_ALIGN true
#endif
#define XB_TMO      128
#define XB_XCNT(j)  (256  + 64 * (j))
#define XB_XSUB(j)  (1280 + 64 * (j))
#define XB_XGEN(j)  (2304 + 64 * (j))
#define XB_TOP      3328
#define XB_TOPGEN   3392
#define XCD_BAR_WORDS 3456
#define XB_SPIN_CAP (1u << 18)

__device__ __forceinline__ unsigned xb_ld(unsigned* p)              { return __hip_atomic_load(p, __ATOMIC_RELAXED, __HIP_MEMORY_SCOPE_AGENT); }
__device__ __forceinline__ unsigned xb_add(unsigned* p, unsigned v) { return __hip_atomic_fetch_add(p, v, __ATOMIC_RELAXED, __HIP_MEMORY_SCOPE_AGENT); }
__device__ __forceinline__ unsigned xb_xcc_id() { return (unsigned)__builtin_amdgcn_s_getreg((3 << 11) | 20) & 0xFu; }
#define XB_SPIN(cond, bar) do { unsigned _sp = 0; while (cond) { __builtin_amdgcn_s_sleep(1); \
    if ((++_sp & 255u) == 0u) { if (xb_ld(&(bar)[XB_TMO])) break; if (_sp > XB_SPIN_CAP) { atomicAdd(&(bar)[XB_TMO], 1u); break; } } } } while (0)

struct XcdBarrier {
    unsigned* bar; unsigned x;
    volatile LAS unsigned* st;
};

__device__ __forceinline__ XcdBarrier xcd_barrier_post(unsigned* bar, volatile LAS unsigned* st) {
    XcdBarrier b; b.bar = bar; b.x = xb_xcc_id(); b.st = st;
    if (threadIdx.x == 0) (void)xb_add(&bar[XB_XCNT(b.x)], 1u);
    return b;
}
__device__ __forceinline__ void xcd_barrier_complete(unsigned* bar, unsigned x, unsigned& nloc, unsigned& nx) {
    const unsigned G = gridDim.x * gridDim.y * gridDim.z;
    unsigned sum, cnt, mine, sp = 0u;
    for (;;) {
        sum = 0u; cnt = 0u; mine = 0u;
#pragma unroll
        for (unsigned j = 0; j < 16; ++j) { const unsigned c = xb_ld(&bar[XB_XCNT(j)]); sum += c; cnt += (c > 0u) ? 1u : 0u; mine = (j == x) ? c : mine; }
        if (sum == G) break;
        __builtin_amdgcn_s_sleep(1);
        if ((++sp & 255u) == 0u) { if (xb_ld(&bar[XB_TMO])) break; if (sp > XB_SPIN_CAP) { atomicAdd(&bar[XB_TMO], 1u); break; } }
    }
    nloc = mine > 0u ? mine : 1u; nx = cnt > 0u ? cnt : 1u;
}

__device__ __forceinline__ void xcd_barrier(const XcdBarrier& b, const bool is_t0  ) {
    asm volatile("s_waitcnt vmcnt(0)" ::: "memory");
    __syncthreads();
    if (is_t0) {
        unsigned* bar = b.bar;
        __builtin_amdgcn_s_waitcnt(0);
        unsigned nloc = b.st[0], nx = b.st[1];
        if (nloc == 0u) { xcd_barrier_complete(bar, b.x, nloc, nx); b.st[0] = nloc; b.st[1] = nx; }
        const unsigned old = xb_add(&bar[XB_XSUB(b.x)], 1u);
        const unsigned gen = old / nloc;
        if (old + 1u == (gen + 1u) * nloc) {
            __builtin_amdgcn_fence(__ATOMIC_RELEASE, "agent");
            asm volatile("s_waitcnt vmcnt(0)" ::: "memory");
            const unsigned og = xb_add(&bar[XB_TOP], 1u);
            const unsigned tg = og / nx;
            if (og + 1u == (tg + 1u) * nx) xb_add(&bar[XB_TOPGEN], 1u);
            else XB_SPIN(xb_ld(&bar[XB_TOPGEN]) == tg, bar);
            __builtin_amdgcn_fence(__ATOMIC_ACQUIRE, "agent");
            xb_add(&bar[XB_XGEN(b.x)], 1u);
            asm volatile("s_waitcnt vmcnt(0)" ::: "memory");
        } else {
            XB_SPIN(xb_ld(&bar[XB_XGEN(b.x)]) == gen, bar);
            __builtin_amdgcn_fence(__ATOMIC_ACQUIRE, "agent");
            asm volatile("s_waitcnt vmcnt(0)" ::: "memory");
        }
    }
    __syncthreads();
}
struct EpiResBf16 {
    static constexpr bool PERM = true, AFTER_DRAIN = false;
    const bf16* xin; bf16* yp; float alpha;
    DI void operator()(const pg8::f32x4 (&acc)[2][2][4][2], const pg8::Unit& u, int wr, int wc, int fr, int fq) const {
        const int row0 = u.pm * 256 + wr * 64 + fr, col0 = u.pn * 256 + wc * 32 + 8 * fq;
#pragma unroll
        for (int ai = 0; ai < 2; ++ai)
#pragma unroll
            for (int m = 0; m < 4; ++m) {
                const size_t ro = (size_t)(row0 + ai * 128 + m * 16) * DM;
#pragma unroll
                for (int bj = 0; bj < 2; ++bj) {
                    const size_t o = ro + col0 + bj * 128;
                    const v4u xv = *(const v4u*)(xin + o);
                    const f32x4 a0 = acc[ai][bj][m][0], a1 = acc[ai][bj][m][1];
                    v4u w;
                    w.x = cvtpk(bf2f(xv.x & 0xffffu) * alpha + a0[0], bf2f(xv.x >> 16) * alpha + a0[1]); w.y = cvtpk(bf2f(xv.y & 0xffffu) * alpha + a0[2], bf2f(xv.y >> 16) * alpha + a0[3]);
                    w.z = cvtpk(bf2f(xv.z & 0xffffu) * alpha + a1[0], bf2f(xv.z >> 16) * alpha + a1[1]); w.w = cvtpk(bf2f(xv.w & 0xffffu) * alpha + a1[2], bf2f(xv.w >> 16) * alpha + a1[3]);
                    *(v4u*)(yp + o) = w;
                }
            }
    }
};
struct EpiSwiglu {
    static constexpr bool PERM = true, AFTER_DRAIN = false;
    unsigned char* act; const float* bgu;
    DI void operator()(const pg8::f32x4 (&acc)[2][2][4][2], const pg8::Unit& u, int wr, int wc, int fr, int fq) const {
        const int e = u.pn >> 3, pl = u.pn & 7;
        const int row0 = u.pm * 256 + wr * 64 + fr, cih = pl * 128 + wc * 32 + 8 * fq;
        const float* bg = bgu + e * 2048 + cih;
        const f32x4 bg0 = *(const f32x4*)(bg), bg1 = *(const f32x4*)(bg + 4), bu0 = *(const f32x4*)(bg + 1024), bu1 = *(const f32x4*)(bg + 1028);
#pragma unroll
        for (int ai = 0; ai < 2; ++ai)
#pragma unroll
            for (int m = 0; m < 4; ++m) {
                constexpr float RS = 1.f / (F8_SX * F8_SWG);
                const f32x4 g0 = acc[ai][0][m][0] * RS + bg0, g1 = acc[ai][0][m][1] * RS + bg1, u0 = acc[ai][1][m][0] * RS + bu0, u1 = acc[ai][1][m][1] * RS + bu1;
                float r[8];
#pragma unroll
                for (int i = 0; i < 8; ++i) {
                    float g = i < 4 ? g0[i & 3] : g1[i & 3], uu = i < 4 ? u0[i & 3] : u1[i & 3];
                    g = fminf(g, 7.0f); uu = fminf(fmaxf(uu, -7.0f), 7.0f);
                    const float sg = __builtin_amdgcn_rcpf(1.0f + ex2(-1.702f * LOG2E * g));
                    r[i] = (uu + 1.0f) * g * sg * F8_SA;
                }
                v2u w; w.x = pk4_fp8(r[0], r[1], r[2], r[3]); w.y = pk4_fp8(r[4], r[5], r[6], r[7]);
                *(v2u*)(act + (size_t)(row0 + ai * 128 + m * 16) * DM + cih) = w;
            }
    }
};
struct EpiDown {
    static constexpr bool PERM = true, AFTER_DRAIN = false;
    bf16* yr; const float* bdn;
    DI void operator()(const pg8::f32x4 (&acc)[2][2][4][2], const pg8::Unit& u, int wr, int wc, int fr, int fq) const {
        const int e = u.pn >> 2, pl = u.pn & 3;
        const int row0 = u.pm * 256 + wr * 64 + fr, col0 = pl * 256 + wc * 32 + 8 * fq;
        f32x4 bv[2][2];
#pragma unroll
        for (int bj = 0; bj < 2; ++bj) { bv[bj][0] = *(const f32x4*)(bdn + e * 1024 + col0 + bj * 128); bv[bj][1] = *(const f32x4*)(bdn + e * 1024 + col0 + bj * 128 + 4); }
#pragma unroll
        for (int ai = 0; ai < 2; ++ai)
#pragma unroll
            for (int m = 0; m < 4; ++m) {
                bf16* rp = yr + (size_t)(row0 + ai * 128 + m * 16) * DM + col0;
#pragma unroll
                for (int bj = 0; bj < 2; ++bj) {
                    constexpr float RS = 1.f / (F8_SA * F8_SWD);
                    const f32x4 v0 = acc[ai][bj][m][0] * RS + bv[bj][0], v1 = acc[ai][bj][m][1] * RS + bv[bj][1];
                    v4u w; w.x = cvtpk(v0[0], v0[1]); w.y = cvtpk(v0[2], v0[3]); w.z = cvtpk(v1[0], v1[1]); w.w = cvtpk(v1[2], v1[3]);
                    *(v4u*)(rp + bj * 128) = w;
                }
            }
    }
};
struct GroupOrder {
    LAS const unsigned* tile_e; int ntiles, lg, G, c;
    DI bool next(int i, pg8::Unit& u) const {
        int pm, pl;
        if (G == 256) {
            const int x = c & 7, k = c >> 3; pm = i * (256 >> lg) + x * (32 >> lg) + (k >> lg); pl = k & ((1 << lg) - 1); if (pm >= ntiles) return false; }
        else { const long L = (long)i * G + c; if (L >= ((long)ntiles << lg)) return false; pm = (int)(L >> lg); pl = (int)(L & ((1 << lg) - 1)); }
        const int e = __builtin_amdgcn_readfirstlane((int)tile_e[pm]);
        u.pm = pm; u.pn = (e << lg) + pl; return true;
    }
    DI void a_ready(const pg8::Unit&) const {}
    DI void done(const pg8::Unit&) const {}
};
struct Args { const float* in[18]; float* out; unsigned char* ws; int ph_lo, ph_hi; };
struct Fr { LAS unsigned char* lds; unsigned char* ws; unsigned* ctl; int tid, lane, wave, blk, G; };

DI void tr_item(const float* W, int ldw, int K, int k0, int sc0, int nvalid, bf16* WT, int drow0, LAS float* scr, int lane) {
    const int c = lane & 31;
    float v[32];
#pragma unroll
    for (int i = 0; i < 32; ++i) v[i] = (c < nvalid) ? W[(size_t)(k0 + 2 * i + (lane >> 5)) * ldw + sc0 + c] : 0.f;
#pragma unroll
    for (int i = 0; i < 32; ++i) scr[(2 * i + (lane >> 5)) * 33 + c] = v[i];
    LDS_WAIT(); asm volatile("" ::: "memory");
    const int c8 = lane & 7;
#pragma unroll
    for (int j = 0; j < 4; ++j) { const int n = (lane >> 3) + 8 * j; const LAS float* s = scr + (8 * c8) * 33 + n;
        v4u o; o.x = cvtpk(s[0 * 33], s[1 * 33]); o.y = cvtpk(s[2 * 33], s[3 * 33]); o.z = cvtpk(s[4 * 33], s[5 * 33]); o.w = cvtpk(s[6 * 33], s[7 * 33]);
        *(v4u*)(WT + (size_t)(drow0 + n) * K + k0 + 8 * c8) = o; }
    LDS_WAIT(); asm volatile("" ::: "memory");
}
DI void tr_item8(const float* W, int ldw, int K, int k0, int sc0, float scale, unsigned char* WT8, int drow0, LAS float* scr, int lane) {
    const int c = lane & 31;
    float v[32];
#pragma unroll
    for (int i = 0; i < 32; ++i) v[i] = W[(size_t)(k0 + 2 * i + (lane >> 5)) * ldw + sc0 + c];
#pragma unroll
    for (int i = 0; i < 32; ++i) scr[(2 * i + (lane >> 5)) * 33 + c] = v[i] * scale;
    LDS_WAIT(); asm volatile("" ::: "memory");
    const int c16 = lane & 3;
#pragma unroll
    for (int j = 0; j < 2; ++j) { const int n = (lane >> 2) + 16 * j; const LAS float* s = scr + (16 * c16) * 33 + n;
        v4u o; o.x = pk4_fp8(s[0 * 33], s[1 * 33], s[2 * 33], s[3 * 33]); o.y = pk4_fp8(s[4 * 33], s[5 * 33], s[6 * 33], s[7 * 33]);
        o.z = pk4_fp8(s[8 * 33], s[9 * 33], s[10 * 33], s[11 * 33]); o.w = pk4_fp8(s[12 * 33], s[13 * 33], s[14 * 33], s[15 * 33]);
        *(v4u*)(WT8 + (size_t)(drow0 + n) * K + k0 + 16 * c16) = o; }
    LDS_WAIT(); asm volatile("" ::: "memory");
}
DI void ph_prologue(const Args& a, const Fr& F) {
    LAS float* scr = (LAS float*)(F.lds + F.wave * 16384);
    const int gw = F.blk * NWAVES + F.wave, NGW = F.G * NWAVES;
    constexpr int I_EV = 2 * 16 * 80, I_OD = 2 * 16 * 96, I_WO = 4 * 16 * 32;
    constexpr int NITEMS = I_EV + I_OD + I_WO;
    bf16* wev = (bf16*)(F.ws + WS_WEV); bf16* wod = (bf16*)(F.ws + WS_WOD); bf16* wout = (bf16*)(F.ws + WS_WOUT);
    unsigned char* wgu = F.ws + WS_WGU; unsigned char* wdn = F.ws + WS_WDN;
    for (int it = gw; it < NITEMS; it += NGW) {
        int r = it;
        if (r < I_EV) { const int l = r / 1280; r %= 1280; const int kb = r / 80, n0 = (r % 80) * 32; int sc0, nv = 32;
            if (n0 < 512) sc0 = n0; else if (n0 < 1024) sc0 = 964 + (n0 - 512); else if (n0 < 1536) sc0 = 1476 + (n0 - 1024); else if (n0 < 2048) sc0 = 1988 + (n0 - 1536);
            else if (n0 < 2176) sc0 = 512 + (n0 - 2048); else if (n0 < 2432) sc0 = 640 + (n0 - 2176); else if (n0 < 2496) sc0 = 896 + (n0 - 2432);
            else if (n0 < 2528) { sc0 = 960; nv = 4; } else { sc0 = 0; nv = 0; }
            tr_item(a.in[1] + (size_t)l * 1024 * 2500, 2500, 1024, kb * 64, sc0, nv, wev + (size_t)l * EV_N * 1024, n0, scr, F.lane); continue; }
        r -= I_EV;
        if (r < I_OD) { const int l = r / 1536; r %= 1536; const int kb = r / 96, n0 = (r % 96) * 32;
            tr_item(a.in[6] + (size_t)l * 1024 * 3088, 3088, 1024, kb * 64, n0, 32, wod + (size_t)l * OD_N * 1024, n0, scr, F.lane); continue; }
        r -= I_OD;
        if (r < I_WO) { const int l = r / 512; r %= 512; const int kb = r / 32, n0 = (r % 32) * 32;
            const float* src = (l & 1) ? a.in[8] + (size_t)(l >> 1) * 1024 * 1024 : a.in[5] + (size_t)(l >> 1) * 1024 * 1024;
            tr_item(src, 1024, 1024, kb * 64, n0, 32, wout + (size_t)l * 1024 * 1024, n0, scr, F.lane); continue; }
    }
    { __syncthreads();
        LAS float* tile = (LAS float*)F.lds; unsigned char* wgu8 = F.ws + WS_WGU; unsigned char* wdn8 = F.ws + WS_WDN;
        constexpr int T_GU = 128 * 8 * 16, T_DN = 128 * 8 * 8, T_ALL = T_GU + T_DN;
        const int tid = F.tid, c4 = tid & 31, r0 = tid >> 5;
        f32x4 v[8];
        auto locate = [&](int t, const float*& src, int& ldw, unsigned char*& dst, float& scale) {
            if (t < T_GU) { const int le = t >> 7, r = t & 127, kb = r >> 4, nb = r & 15, n0 = nb * 128; const int pn = n0 >> 8, bj = (n0 >> 7) & 1;
                src = a.in[14] + (size_t)le * 1024 * 2048 + (size_t)(kb * 128) * 2048 + bj * 1024 + pn * 128; ldw = 2048; dst = wgu8 + (size_t)le * 2048 * 1024 + (size_t)n0 * 1024 + kb * 128; scale = F8_SWG; }
            else { const int u = t - T_GU, le = u >> 6, r = u & 63, kb = r >> 3, nb = r & 7;
                src = a.in[16] + (size_t)le * 1024 * 1024 + (size_t)(kb * 128) * 1024 + nb * 128; ldw = 1024; dst = wdn8 + (size_t)le * 1024 * 1024 + (size_t)(nb * 128) * 1024 + kb * 128; scale = F8_SWD; } };
        int t = F.blk;
        if (t < T_ALL) { const float* src; int ldw; unsigned char* dst; float sc; locate(t, src, ldw, dst, sc);
#pragma unroll
            for (int i = 0; i < 8; ++i) v[i] = *(const f32x4*)(src + (size_t)(r0 + 16 * i) * ldw + 4 * c4); }
        for (; t < T_ALL; t += F.G) {
            const float* src; int ldw; unsigned char* dst; float sc; locate(t, src, ldw, dst, sc);
#pragma unroll
            for (int i = 0; i < 8; ++i) { LAS float* tp = tile + (r0 + 16 * i) * 129 + 4 * c4; tp[0] = v[i][0] * sc; tp[1] = v[i][1] * sc; tp[2] = v[i][2] * sc; tp[3] = v[i][3] * sc; }
            __syncthreads();
            if (t + F.G < T_ALL) { const float* s2; int l2; unsigned char* d2; float c2; locate(t + F.G, s2, l2, d2, c2);
#pragma unroll
                for (int i = 0; i < 8; ++i) v[i] = *(const f32x4*)(s2 + (size_t)(r0 + 16 * i) * l2 + 4 * c4); }
#pragma unroll
            for (int j = 0; j < 2; ++j) { const int p = tid + 512 * j, kc = p & 7, n = p >> 3; const LAS float* sp = tile + (kc * 16) * 129 + n;
                v4u o; o.x = pk4_fp8(sp[0], sp[129], sp[2 * 129], sp[3 * 129]); o.y = pk4_fp8(sp[4 * 129], sp[5 * 129], sp[6 * 129], sp[7 * 129]);
                o.z = pk4_fp8(sp[8 * 129], sp[9 * 129], sp[10 * 129], sp[11 * 129]); o.w = pk4_fp8(sp[12 * 129], sp[13 * 129], sp[14 * 129], sp[15 * 129]);
                *(v4u*)(dst + (size_t)n * 1024 + kc * 16) = o; }
            __syncthreads();
        }
    }
    bf16* xb = (bf16*)(F.ws + WS_XB);
    for (int m = gw; m < NTOK; m += NGW) {
        const f32x4* xr = (const f32x4*)(a.in[0] + (size_t)m * DM) + F.lane; v2u* o = (v2u*)(xb + (size_t)m * DM) + F.lane;
#pragma unroll
        for (int j = 0; j < 4; ++j) { const f32x4 v = xr[64 * j]; v2u w; w.x = cvtpk(v[0], v[1]); w.y = cvtpk(v[2], v[3]); o[64 * j] = w; }
    }
    bf16* wukt = (bf16*)(F.ws + WS_WUKT); bf16* wuvt = (bf16*)(F.ws + WS_WUVT);
    for (int i = F.blk * NTHR + F.tid; i < 2 * 8 * 128 * 64; i += F.G * NTHR) {
        { const int d = i & 63, c = (i >> 6) & 127, lh = i >> 13; wukt[i] = (bf16)f2bf(a.in[2][((size_t)lh * 64 + d) * 128 + c]); }
        { const int c = i & 127, d = (i >> 7) & 63, lh = i >> 13; wuvt[i] = (bf16)f2bf(a.in[3][((size_t)lh * 128 + c) * 64 + d]); }
    }
}

DI void ln_row(f32x4 (&v)[4], const float* g, const float* b, int lane) {
    float s = 0.f;
#pragma unroll
    for (int j = 0; j < 4; ++j) s += (v[j][0] + v[j][1]) + (v[j][2] + v[j][3]);
    const float mean = wave_sum(s) * (1.f / DM); float s2 = 0.f;
#pragma unroll
    for (int j = 0; j < 4; ++j) { v[j] = v[j] - mean; s2 += (v[j][0] * v[j][0] + v[j][1] * v[j][1]) + (v[j][2] * v[j][2] + v[j][3] * v[j][3]); }
    const float rstd = 1.f / sqrtf(wave_sum(s2) * (1.f / DM) + LN_EPS);
#pragma unroll
    for (int j = 0; j < 4; ++j) { const f32x4 gg = *((const f32x4*)g + lane + 64 * j), bb = *((const f32x4*)b + lane + 64 * j); v[j] = v[j] * rstd * gg + bb; }
}
DI void store_row_f32(float* p, const f32x4 (&v)[4], int lane) {
#pragma unroll
    for (int j = 0; j < 4; ++j) *((f32x4*)p + lane + 64 * j) = v[j];
}
DI void store_row_bf16(bf16* p, const f32x4 (&v)[4], int lane) {
#pragma unroll
    for (int j = 0; j < 4; ++j) { v2u w; w.x = cvtpk(v[j][0], v[j][1]); w.y = cvtpk(v[j][2], v[j][3]); *((v2u*)p + lane + 64 * j) = w; }
}
template <int NL> DI void small_proj(LAS const float* xs, const float* W, int ldw, int lane, float (&acc)[4]) {
    constexpr int PARTS = 64 / NL, DPER = 1024 / PARTS;
    const int n = lane & (NL - 1), part = lane / NL;
    acc[0] = acc[1] = acc[2] = acc[3] = 0.f;
    const float* wp = W + (size_t)(part * DPER) * ldw + n;
    LAS const float* xp = xs + part * DPER;
#pragma unroll 8
    for (int d = 0; d < DPER; ++d) { const float w = wp[(size_t)d * ldw];
        acc[0] += w * xp[d]; acc[1] += w * xp[1024 + d]; acc[2] += w * xp[2048 + d]; acc[3] += w * xp[3072 + d]; }
#pragma unroll
    for (int o = NL; o < 64; o <<= 1) {
#pragma unroll
        for (int k = 0; k < 4; ++k) acc[k] += __shfl_xor(acc[k], o); }
}

DI void ph_even_prep(const Args& a, const Fr& F, int j) {
    const bf16* proj = (const bf16*)(F.ws + WS_PROJ);
    bf16* ckvn = (bf16*)(F.ws + WS_CKVN); bf16* ql = (bf16*)(F.ws + WS_QL); float* kbar = (float*)(F.ws + WS_KBAR);
    const float* kvg = a.in[4] + j * 128;
    const bf16* wukt = (const bf16*)(F.ws + WS_WUKT) + (size_t)j * 8 * 128 * 64;
    const int lane = F.lane, wave = F.wave;
    for (int chunk = F.blk; chunk < 256; chunk += F.G) {
        const int tok0 = chunk * 128;
#pragma unroll 1
        for (int i0 = 0; i0 < 16; i0 += 8) { unsigned wv[8];
#pragma unroll
            for (int i = 0; i < 8; ++i) wv[i] = *((const unsigned*)(proj + (size_t)(tok0 + wave * 16 + i0 + i) * EV_N + EC_CKV) + lane);
#pragma unroll
            for (int i = 0; i < 8; ++i) { const int tok = tok0 + wave * 16 + i0 + i; const float v0 = bf2f(wv[i] & 0xffffu), v1 = bf2f(wv[i] >> 16);
                const float ss = wave_sum(v0 * v0 + v1 * v1);
                const float r = 1.f / sqrtf(ss * (1.f / 128.f) + LN_EPS);
                *((unsigned*)(ckvn + (size_t)tok * 128) + lane) = cvtpk(v0 * r * kvg[2 * lane], v1 * r * kvg[2 * lane + 1]); } }
        { bf16* kic = (bf16*)(F.ws + WS_KIC); const int tok = tok0 + wave * 16 + (lane >> 2), c = (lane & 3) * 16;
            const v4u* src = (const v4u*)(proj + (size_t)tok * EV_N + EC_KI + c); v4u* dst = (v4u*)(kic + (size_t)tok * 64 + c); dst[0] = src[0]; dst[1] = src[1]; }
        { const int h = wave, l15 = lane & 15, kg = lane >> 4;
            bf16x8 af[8][2];
#pragma unroll
            for (int ct = 0; ct < 8; ++ct)
#pragma unroll
                for (int ks = 0; ks < 2; ++ks) af[ct][ks] = *(const bf16x8*)(wukt + ((size_t)h * 128 + ct * 16 + l15) * 64 + ks * 32 + kg * 8);
#pragma unroll 1
            for (int tg = 0; tg < 8; tg += 4) { bf16x8 qf[4][2];
#pragma unroll
                for (int u = 0; u < 4; ++u)
#pragma unroll
                    for (int ks = 0; ks < 2; ++ks) qf[u][ks] = *(const bf16x8*)(proj + (size_t)(tok0 + (tg + u) * 16 + l15) * EV_N + EC_QA + h * 64 + ks * 32 + kg * 8);
#pragma unroll
                for (int u = 0; u < 4; ++u) { const int tok = tok0 + (tg + u) * 16 + l15;
#pragma unroll
                    for (int ct = 0; ct < 8; ++ct) { f32x4 d = {0.f, 0.f, 0.f, 0.f};
                        d = mfma16(af[ct][0], qf[u][0], d); d = mfma16(af[ct][1], qf[u][1], d);
                        v2u w; w.x = cvtpk(d[0], d[1]); w.y = cvtpk(d[2], d[3]);
                        *(v2u*)(ql + (size_t)tok * 1024 + h * 128 + ct * 16 + 4 * kg) = w; } } } }
        if (chunk < 128) { const int b = chunk >> 5, n = chunk & 31; float s8[8];
#pragma unroll
            for (int k = 0; k < 8; ++k) s8[k] = 0.f;
            const bf16* kp = proj + ((size_t)b * SEQ + n * 256 + wave * 32) * EV_N + EC_KB + lane * 8;
#pragma unroll 8
            for (int r = 0; r < 32; ++r) { const v4u w = *(const v4u*)(kp + (size_t)r * EV_N);
#pragma unroll
                for (int k = 0; k < 4; ++k) { s8[2 * k] += bf2f(w[k] & 0xffffu); s8[2 * k + 1] += bf2f(w[k] >> 16); } }
            LAS float* red = (LAS float*)F.lds;
            __syncthreads();
#pragma unroll
            for (int k = 0; k < 8; ++k) red[wave * 512 + lane * 8 + k] = s8[k];
            __syncthreads();
            float s = 0.f;
#pragma unroll
            for (int w = 0; w < 8; ++w) s += red[w * 512 + F.tid];
            const int h = F.tid >> 6, d = F.tid & 63;
            kbar[(((size_t)b * 8 + h) * 32 + n) * 64 + d] = s * (1.f / 256.f); }
    }
}

DI void moba_gate_chunk(const Fr& F, int chunk) {
    const bf16* proj = (const bf16*)(F.ws + WS_PROJ); const float* kbar = (const float*)(F.ws + WS_KBAR); unsigned* sel3 = (unsigned*)(F.ws + WS_SEL3);
    const int tok0 = chunk * 128, b = tok0 / SEQ, own = (tok0 % SEQ) >> 8, h = F.wave, lane = F.lane;
    float q0[64], q1[64];
    { const v4u* p0 = (const v4u*)(proj + (size_t)(tok0 + lane) * EV_N + EC_QB + h * 64); const v4u* p1 = (const v4u*)(proj + (size_t)(tok0 + 64 + lane) * EV_N + EC_QB + h * 64);
#pragma unroll
        for (int i = 0; i < 8; ++i) { const v4u w0 = p0[i], w1 = p1[i];
#pragma unroll
            for (int k = 0; k < 4; ++k) { q0[8 * i + 2 * k] = bf2f(w0[k] & 0xffffu); q0[8 * i + 2 * k + 1] = bf2f(w0[k] >> 16); q1[8 * i + 2 * k] = bf2f(w1[k] & 0xffffu); q1[8 * i + 2 * k + 1] = bf2f(w1[k] >> 16); } } }
    float a0 = -INFINITY, a1 = -INFINITY, a2 = -INFINITY, c0 = -INFINITY, c1 = -INFINITY, c2 = -INFINITY; int ai0 = 0, ai1 = 0, ai2 = 0, ci0 = 0, ci1 = 0, ci2 = 0;
    const float* kb = kbar + (((size_t)b * 8 + h) * 32) * 64;
    for (int n = 0; n < own; ++n) { float g0 = 0.f, g1 = 0.f;
#pragma unroll
        for (int d = 0; d < 64; d += 4) { const f32x4 kv = *(const f32x4*)(kb + n * 64 + d);
#pragma unroll
            for (int k = 0; k < 4; ++k) { g0 += q0[d + k] * kv[k]; g1 += q1[d + k] * kv[k]; } }
        if (g0 > a2) { if (g0 > a1) { a2 = a1; ai2 = ai1; if (g0 > a0) { a1 = a0; ai1 = ai0; a0 = g0; ai0 = n; } else { a1 = g0; ai1 = n; } } else { a2 = g0; ai2 = n; } }
        if (g1 > c2) { if (g1 > c1) { c2 = c1; ci2 = ci1; if (g1 > c0) { c1 = c0; ci1 = ci0; c0 = g1; ci0 = n; } else { c1 = g1; ci1 = n; } } else { c2 = g1; ci2 = n; } }
    }
    const unsigned nv = own < 3 ? own : 3;
    sel3[(size_t)(tok0 + lane) * 8 + h] = (unsigned)ai0 | ((unsigned)ai1 << 8) | ((unsigned)ai2 << 16) | (nv << 24);
    sel3[(size_t)(tok0 + 64 + lane) * 8 + h] = (unsigned)ci0 | ((unsigned)ci1 << 8) | ((unsigned)ci2 << 16) | (nv << 24);
}

constexpr int HS = 257;
DI float relu1(float x) { const unsigned u = __float_as_uint(x); return __uint_as_float(u & ~(unsigned)((int)u >> 31)); }
template <int MODE, bool DIAG> DI void idx_tile(const bf16x8 (&kf)[4], LAS const char* qb  , const float (&wj)[4], int kt, int q, int hi, unsigned c0, unsigned c1,
                                     LAS unsigned* hist, LAS unsigned* mask, LAS unsigned* cmask, LAS unsigned long long* cand, LAS unsigned* rinfo) {
    f32x2 scp[8];
#pragma unroll
    for (int p = 0; p < 8; ++p) scp[p] = (f32x2){0.f, 0.f};
    bf16x8 qv0[2][4], qv1[2][4];
#pragma unroll
    for (int j = 0; j < 2; ++j)
#pragma unroll
        for (int s = 0; s < 4; ++s) qv0[j][s] = *(LAS const bf16x8*)(qb + (j * 8 + s * 2) * 512);
#pragma unroll
    for (int j = 0; j < 2; ++j)
#pragma unroll
        for (int s = 0; s < 4; ++s) qv1[j][s] = *(LAS const bf16x8*)(qb + ((2 + j) * 8 + s * 2) * 512);
    __builtin_amdgcn_sched_barrier(0);
#pragma unroll
    for (int g = 0; g < 2; ++g) { f32x16 acc[2];
#pragma unroll
        for (int j = 0; j < 2; ++j)
#pragma unroll
            for (int r = 0; r < 16; ++r) acc[j][r] = 0.f;
#pragma unroll
        for (int s = 0; s < 4; ++s)
#pragma unroll
            for (int j = 0; j < 2; ++j) { if (MODE != -2) acc[j] = mfma32(kf[s], g == 0 ? qv0[j][s] : qv1[j][s], acc[j]); else acc[j][s] += __builtin_bit_cast(float, (unsigned)(kf[s][0] ^ (g == 0 ? qv0[j][s][0] : qv1[j][s][0]))); }
#pragma unroll
        for (int p = 0; p < 8; ++p)
#pragma unroll
            for (int j = 0; j < 2; ++j) { const f32x2 a = {relu1(acc[j][2 * p]), relu1(acc[j][2 * p + 1])}; const f32x2 w2 = {wj[2 * g + j], wj[2 * g + j]}; scp[p] = a * w2 + scp[p]; } }
    unsigned sel = 0u, cnd = 0u;
    if (MODE <= 0) { float t = 0.f;
#pragma unroll
        for (int p = 0; p < 8; ++p) t += scp[p][0] + scp[p][1];
        if (t == 12345.678f) __hip_atomic_fetch_or(mask + q * HS + kt, 1u, __ATOMIC_RELAXED, __HIP_MEMORY_SCOPE_WORKGROUP);
        return; }
    const float F0 = __uint_as_float(c0), F1 = __uint_as_float(c1);
#pragma unroll
    for (int r = 0; r < 16; ++r) { const int kr = crow(r, hi);
        const bool ok = !DIAG || kr <= q;
        const float scv = scp[r >> 1][r & 1]; const unsigned u = __float_as_uint(scv);
        if (MODE == 1) { const unsigned key = u ^ ((unsigned)((int)u >> 31) | 0x80000000u);
            if (ok && (key >> 24) >= c0) __hip_atomic_fetch_add(hist + q * HS + (key >> 24), 1u, __ATOMIC_RELAXED, __HIP_MEMORY_SCOPE_WORKGROUP); }
        else if (MODE == 2) { if (ok && (u >> 24) == c0) __hip_atomic_fetch_add(hist + q * HS + (((u >> 16) & 255u) ^ c1), 1u, __ATOMIC_RELAXED, __HIP_MEMORY_SCOPE_WORKGROUP); }
        else { const bool ge1 = scv >= F1, ge0 = scv >= F0;
            if (ok && ge1) sel |= 1u << kr;
            if (ok && ge0 && !ge1) { cnd |= 1u << kr; const unsigned key = u ^ ((unsigned)((int)u >> 31) | 0x80000000u);
                const unsigned pos = __hip_atomic_fetch_add(rinfo + 128 + q, 1u, __ATOMIC_RELAXED, __HIP_MEMORY_SCOPE_WORKGROUP);
                if (pos < 64u) cand[q * 64 + pos] = ((unsigned long long)key << 32) | (unsigned)(~(unsigned)(kt * 32 + kr)); } } }
    if (MODE == 3) { if (sel) __hip_atomic_fetch_or(mask + q * HS + kt, sel, __ATOMIC_RELAXED, __HIP_MEMORY_SCOPE_WORKGROUP);
        if (cnd) __hip_atomic_fetch_or(cmask + q * HS + kt, cnd, __ATOMIC_RELAXED, __HIP_MEMORY_SCOPE_WORKGROUP); }
}
template <int MODE> DI void idx_pass(const bf16* proj, int rowbase, int qt, LAS const char* qimg, const float (&wj)[4], LAS unsigned* hist, LAS unsigned* mask, LAS unsigned* cmask, LAS unsigned long long* cand, LAS unsigned* rinfo, int wave, int lane) {
    const int q = lane & 31, hi = lane >> 5, nkt = qt + 1;
    const unsigned b1 = MODE == 2 ? rinfo[160 + q] : rinfo[224 + q], thr16 = MODE == 2 ? rinfo[192 + q] : rinfo[256 + q];
    const bf16* kp0 = proj + (size_t)(rowbase + q) * 64 + hi * 8;
    LAS const char* qb = qimg + hi * 512 + q * 16;
    const int n = nkt > wave ? (nkt - wave + 7) >> 3 : 0;
    bf16x8 kfa[4], kfb[4];
#define IDX_LOAD(KF, I) do { const bf16* kp_ = kp0 + (size_t)((wave + 8 * (I)) * 32) * 64; _Pragma("unroll") for (int s_ = 0; s_ < 4; ++s_) KF[s_] = *(const bf16x8*)(kp_ + s_ * 16); } while (0)
#define IDX_TILE(KF, I) do { const int kt_ = wave + 8 * (I); if (kt_ == qt) idx_tile<MODE, true>(KF, qb, wj, kt_, q, hi, b1, thr16, hist, mask, cmask, cand, rinfo); \
        else idx_tile<MODE, false>(KF, qb, wj, kt_, q, hi, b1, thr16, hist, mask, cmask, cand, rinfo); } while (0)
    if (n > 0) IDX_LOAD(kfa, 0);
    for (int i = 0; i < n; i += 2) {
        if (i + 1 < n) { if (MODE == -1) { _Pragma("unroll") for (int s_ = 0; s_ < 4; ++s_) kfb[s_] = kfa[s_]; } else IDX_LOAD(kfb, i + 1); }
        IDX_TILE(kfa, i);
        if (i + 1 < n) { if (i + 2 < n && MODE != -1) IDX_LOAD(kfa, i + 2); IDX_TILE(kfb, i + 1); }
    }
#undef IDX_LOAD
#undef IDX_TILE
}
DI void hist_pick(LAS const unsigned* hrow, unsigned need, int lane, unsigned& bin, unsigned& above) {
    unsigned h4[4];
#pragma unroll
    for (int k = 0; k < 4; ++k) h4[k] = hrow[4 * lane + k];
    const unsigned ssum = h4[0] + h4[1] + h4[2] + h4[3];
    unsigned x = ssum;
#pragma unroll
    for (int o = 1; o < 64; o <<= 1) { const unsigned y = __shfl_down(x, o); if (lane + o < 64) x += y; }
    const unsigned long long m = __ballot(x >= need);
    const int Ls = m ? 63 - __builtin_clzll(m) : 0;
    const unsigned xs = __shfl(x, Ls), ss = __shfl(ssum, Ls);
    const unsigned h0 = __shfl(h4[0], Ls), h1 = __shfl(h4[1], Ls), h2 = __shfl(h4[2], Ls), h3 = __shfl(h4[3], Ls);
    unsigned cum = xs - ss;
    if (cum + h3 >= need) { bin = 4 * Ls + 3; above = cum; return; } cum += h3;
    if (cum + h2 >= need) { bin = 4 * Ls + 2; above = cum; return; } cum += h2;
    if (cum + h1 >= need) { bin = 4 * Ls + 1; above = cum; return; } cum += h1;
    bin = 4 * Ls; above = cum; (void)h0;
}
DI void idx_pass1(const bf16* proj, int rowbase, int qt, LAS const char* qimg, const float (&wj)[4], LAS unsigned* hist, LAS unsigned* mask, LAS unsigned* cmask, LAS unsigned long long* cand, LAS unsigned* rinfo, int wave, int lane) {
    const int q = lane & 31, hi = lane >> 5, nkt = qt + 1, nmax = (nkt + 7) >> 3;
    const bf16* kp0 = proj + (size_t)(rowbase + q) * 64 + hi * 8;
    LAS const char* qb = qimg + hi * 512 + q * 16;
    unsigned lb = 0u;
    bf16x8 kfc[4], kfn[4];
    if (wave < nkt) {
#pragma unroll
        for (int s = 0; s < 4; ++s) kfc[s] = *(const bf16x8*)(kp0 + (size_t)(wave * 32) * 64 + s * 16); }
    for (int i = 0; i < nmax; ++i) { const int kt = wave + 8 * i;
        if (kt + 8 < nkt) {
#pragma unroll
            for (int s = 0; s < 4; ++s) kfn[s] = *(const bf16x8*)(kp0 + (size_t)((kt + 8) * 32) * 64 + s * 16); }
        if (kt < nkt) { if (kt == qt) idx_tile<1, true>(kfc, qb, wj, kt, q, hi, lb, 0u, hist, mask, cmask, cand, rinfo); else idx_tile<1, false>(kfc, qb, wj, kt, q, hi, lb, 0u, hist, mask, cmask, cand, rinfo); }
#pragma unroll
        for (int s = 0; s < 4; ++s) kfc[s] = kfn[s];
        if (((i + 1) & i) == 0 && i + 1 < nmax && i < 16) {
            __syncthreads();
#pragma unroll 1
            for (int rr = 0; rr < 4; ++rr) { const int row = wave * 4 + rr; unsigned bin, above; hist_pick(hist + row * HS, 256u, lane, bin, above);
                if (lane == 0) rinfo[288 + row] = bin; }
            __syncthreads();
            { const unsigned nb = rinfo[288 + q]; lb = nb > lb ? nb : lb; } }
    }
}
DI void idx_unit(const Fr& F, int b, int qt, int stop = 0  ) {
    const bf16* proj = (const bf16*)(F.ws + WS_PROJ); const bf16* kic = (const bf16*)(F.ws + WS_KIC); unsigned short* sel = (unsigned short*)(F.ws + WS_SEL);
    LAS unsigned* hist = (LAS unsigned*)(F.lds); LAS unsigned* mask = hist + 32 * HS; LAS unsigned* cmask = mask + 32 * HS;
    LAS unsigned long long* cand = (LAS unsigned long long*)(F.lds + 99328); LAS unsigned* rinfo = (LAS unsigned*)(F.lds + 115712);
    const int lane = F.lane, wave = F.wave, tid = F.tid, t0 = qt * 32, rowbase = b * SEQ;
    __syncthreads();
    for (int i = tid; i < 3 * 32 * HS; i += NTHR) hist[i] = 0u;
    if (tid < 320) rinfo[tid] = 0u;
    __syncthreads();
    if (t0 + 31 <= 255 || (EXPF & 64)) {
        if (lane < 8) {
#pragma unroll
            for (int rr = 0; rr < 4; ++rr) { const int row = wave * 4 + rr, nv = t0 + row + 1;
                const int nv0 = t0 + row + 1; const int nvc = nv0 < 256 ? nv0 : 256; (void)nv; mask[row * HS + lane] = nvc >= 32 * (lane + 1) ? 0xffffffffu : (nvc > 32 * lane ? ((1u << (nvc - 32 * lane)) - 1u) : 0u); } }
    } else {
        const int q = lane & 31;
        float wj[4];
        { const bf16* qp = proj + (size_t)(rowbase + t0 + q) * EV_N;
#pragma unroll
            for (int j = 0; j < 4; ++j) wj[j] = bf2f(qp[EC_WI + j]); }
        LAS char* qimg = (LAS char*)(F.lds + 117248);
#pragma unroll
        for (int i = 0; i < 2; ++i) { const int p = tid + i * NTHR, row = p & 31, c = p >> 5;
            *(LAS v4u*)(qimg + c * 512 + row * 16) = *(const v4u*)(proj + (size_t)(rowbase + t0 + row) * EV_N + EC_QI + c * 8); }
        __syncthreads();
        if (stop == 7) return;
        if (stop == 4) { idx_pass<0>(kic, rowbase, qt, qimg, wj, hist, mask, cmask, cand, rinfo, wave, lane); return; }
        if (stop == 5) { idx_pass<-1>(kic, rowbase, qt, qimg, wj, hist, mask, cmask, cand, rinfo, wave, lane); return; }
        if (stop == 6) { idx_pass<-2>(kic, rowbase, qt, qimg, wj, hist, mask, cmask, cand, rinfo, wave, lane); return; }
        idx_pass1(kic, rowbase, qt, qimg, wj, hist, mask, cmask, cand, rinfo, wave, lane);
        __syncthreads();
#pragma unroll 1
        for (int rr = 0; rr < 4; ++rr) { const int row = wave * 4 + rr; unsigned bin, above; hist_pick(hist + row * HS, 256u, lane, bin, above);
            if (lane == 0) { rinfo[row] = bin; rinfo[32 + row] = 256u - above; rinfo[160 + row] = bin >= 128u ? bin - 128u : 255u - bin; rinfo[192 + row] = bin >= 128u ? 0u : 255u; } }
        __syncthreads();
        if (stop == 1) return;
        for (int i = tid; i < 32 * HS; i += NTHR) hist[i] = 0u;
        __syncthreads();
        idx_pass<2>(kic, rowbase, qt, qimg, wj, hist, mask, cmask, cand, rinfo, wave, lane);
        __syncthreads();
#pragma unroll 1
        for (int rr = 0; rr < 4; ++rr) { const int row = wave * 4 + rr; const unsigned need1 = rinfo[32 + row]; unsigned bin, above; hist_pick(hist + row * HS, need1, lane, bin, above);
            if (lane == 0) { const unsigned t16 = (rinfo[row] << 8) | bin, k0 = t16 << 16, k1 = (t16 + 1u) << 16;
                rinfo[64 + row] = t16; rinfo[96 + row] = need1 - above;
                rinfo[224 + row] = (k0 & 0x80000000u) ? (k0 ^ 0x80000000u) : ~k0; rinfo[256 + row] = (t16 == 0xffffu) ? 0x7fc00000u : ((k1 & 0x80000000u) ? (k1 ^ 0x80000000u) : ~k1); } }
        __syncthreads();
        if (stop == 2) return;
        idx_pass<3>(kic, rowbase, qt, qimg, wj, hist, mask, cmask, cand, rinfo, wave, lane);
        __syncthreads();
        if (stop == 3) return;
#pragma unroll 1
        for (int rr = 0; rr < 4; ++rr) { const int row = wave * 4 + rr; const unsigned call = rinfo[128 + row], need2 = rinfo[96 + row];
            if (call <= 64u) { const unsigned c = call;
                const unsigned long long mine = cand[row * 64 + lane]; unsigned rank = 0u;
                for (unsigned k = 0; k < c; ++k) rank += (cand[row * 64 + k] > mine) ? 1u : 0u;
                if ((unsigned)lane < c && rank < need2) { const unsigned s = ~(unsigned)mine;
                    __hip_atomic_fetch_or(mask + row * HS + (s >> 5), 1u << (s & 31), __ATOMIC_RELAXED, __HIP_MEMORY_SCOPE_WORKGROUP); } }
            else { unsigned w4[4];
#pragma unroll
                for (int k = 0; k < 4; ++k) w4[k] = cmask[row * HS + 4 * lane + k];
                const unsigned cnt = __popc(w4[0]) + __popc(w4[1]) + __popc(w4[2]) + __popc(w4[3]);
                unsigned x = cnt;
#pragma unroll
                for (int o = 1; o < 64; o <<= 1) { const unsigned y = __shfl_up(x, o); if (lane >= o) x += y; }
                unsigned before = x - cnt;
#pragma unroll
                for (int k = 0; k < 4; ++k) { unsigned w = w4[k]; const unsigned pc = __popc(w); unsigned take = 0u;
                    if (before < need2) { if (before + pc <= need2) take = w; else { unsigned left = need2 - before; while (left) { const unsigned b = w & (0u - w); take |= b; w ^= b; --left; } } }
                    before += pc;
                    if (take) mask[row * HS + 4 * lane + k] |= take; } }
        }
    }
    __syncthreads();
#pragma unroll 1
    for (int rr = 0; rr < 4; ++rr) { const int row = wave * 4 + rr; unsigned short* out = sel + (size_t)(rowbase + t0 + row) * 256;
        unsigned w4[4];
#pragma unroll
        for (int k = 0; k < 4; ++k) w4[k] = mask[row * HS + 4 * lane + k];
        const unsigned cnt = __popc(w4[0]) + __popc(w4[1]) + __popc(w4[2]) + __popc(w4[3]);
        unsigned x = cnt;
#pragma unroll
        for (int o = 1; o < 64; o <<= 1) { const unsigned y = __shfl_up(x, o); if (lane >= o) x += y; }
        const unsigned total = __shfl(x, 63); unsigned pos = x - cnt;
#pragma unroll
        for (int k = 0; k < 4; ++k) { unsigned w = w4[k]; const unsigned base = (unsigned)(4 * lane + k) * 32u;
            while (w) { const unsigned bit = __builtin_ctz(w); if (pos < 256u) out[pos] = (unsigned short)(base + bit); ++pos; w &= w - 1u; } }
        for (unsigned i = total + lane; i < 256u; i += 64u) out[i] = (unsigned short)0xffffu; }
}

struct AttSt { float m, l; f32x16 o0, o1; };
template <class BF> DI void att_subtile(AttSt& S, const bf16x8 (&qf)[4], LAS const char* Kst, LAS const char* Vb, int vdh, int vrow0, int lane, const BF& bias) {
    const int r32 = lane & 31, hi = lane >> 5;
    f32x16 p;
#pragma unroll
    for (int r = 0; r < 16; ++r) p[r] = bias.b(crow(r, hi)) - S.m;
    LAS const char* kp = Kst + hi * 512 + r32 * 16;
#pragma unroll
    for (int s = 0; s < 4; ++s) { const bf16x8 kf = *(LAS const bf16x8*)(kp + s * 1024); p = mfma32(kf, qf[s], p); }
    if (bias.any) {
#pragma unroll
        for (int r = 0; r < 16; ++r) p[r] = bias.msk(crow(r, hi)) ? -INFINITY : p[r]; }
    float mxa[4] = {-INFINITY, -INFINITY, -INFINITY, -INFINITY};
#pragma unroll
    for (int r = 0; r < 16; ++r) mxa[r & 3] = fmaxf(mxa[r & 3], p[r]);
    float mx = fmaxf(fmaxf(mxa[0], mxa[1]), fmaxf(mxa[2], mxa[3]));
    mx = fmaxf(mx, __shfl_xor(mx, 32));
    if (__any(mx > 16.f)) { const float dl = fmaxf(mx, 0.f), sc = ex2(-dl); S.m += dl; S.l *= sc;
#pragma unroll
        for (int r = 0; r < 16; ++r) { p[r] -= dl; S.o0[r] *= sc; S.o1[r] *= sc; } }
    float psa[4] = {0.f, 0.f, 0.f, 0.f};
#pragma unroll
    for (int r = 0; r < 16; ++r) { p[r] = ex2(p[r]); psa[r & 3] += p[r]; }
    S.l += (psa[0] + psa[1]) + (psa[2] + psa[3]);
    v4u pw0, pw1;
    pw0.x = cvtpk(p[0], p[1]); pw0.y = cvtpk(p[2], p[3]); pw0.z = cvtpk(p[4], p[5]); pw0.w = cvtpk(p[6], p[7]);
    pw1.x = cvtpk(p[8], p[9]); pw1.y = cvtpk(p[10], p[11]); pw1.z = cvtpk(p[12], p[13]); pw1.w = cvtpk(p[14], p[15]);
    const bf16x8 pf0 = __builtin_bit_cast(bf16x8, pw0), pf1 = __builtin_bit_cast(bf16x8, pw1);
    LAS const char* vp = Vb + (vrow0 + 4 * hi + ((lane & 15) >> 2)) * 64 + ((lane >> 4) & 1) * 32 + (lane & 3) * 8;
    { const bf16x8 v00 = cat8(vtr(vp), vtr(vp + 512)), v10 = cat8(vtr(vp + vdh), vtr(vp + vdh + 512));
      const bf16x8 v01 = cat8(vtr(vp + 1024), vtr(vp + 1536)), v11 = cat8(vtr(vp + vdh + 1024), vtr(vp + vdh + 1536));
      S.o0 = mfma32(v00, pf0, S.o0); S.o1 = mfma32(v10, pf0, S.o1);
      S.o0 = mfma32(v01, pf1, S.o0); S.o1 = mfma32(v11, pf1, S.o1); }
}
template <class BF0, class BF1> DI void att_tile64(AttSt& S, const bf16x8 (&qf)[4], LAS const char* Kst, LAS const char* Vb, int vdh, int vrow0, int lane, const BF0& bias0, const BF1& bias1) {
    const int r32 = lane & 31, hi = lane >> 5;
    f32x16 p0, p1;
#pragma unroll
    for (int r = 0; r < 16; ++r) { p0[r] = bias0.b(crow(r, hi)) - S.m; p1[r] = bias1.b(crow(r, hi)) - S.m; }
    LAS const char* kp = Kst + hi * 512 + r32 * 16;
#pragma unroll
    for (int s = 0; s < 4; ++s) { const bf16x8 k0 = *(LAS const bf16x8*)(kp + s * 1024), k1 = *(LAS const bf16x8*)(kp + 4096 + s * 1024); p0 = mfma32(k0, qf[s], p0); p1 = mfma32(k1, qf[s], p1); }
    if (bias0.any) {
#pragma unroll
        for (int r = 0; r < 16; ++r) p0[r] = bias0.msk(crow(r, hi)) ? -INFINITY : p0[r]; }
    if (bias1.any) {
#pragma unroll
        for (int r = 0; r < 16; ++r) p1[r] = bias1.msk(crow(r, hi)) ? -INFINITY : p1[r]; }
    float mxa[4] = {-INFINITY, -INFINITY, -INFINITY, -INFINITY};
#pragma unroll
    for (int r = 0; r < 16; ++r) mxa[r & 3] = fmaxf(mxa[r & 3], fmaxf(p0[r], p1[r]));
    float mx = fmaxf(fmaxf(mxa[0], mxa[1]), fmaxf(mxa[2], mxa[3]));
    mx = fmaxf(mx, __shfl_xor(mx, 32));
    if (__any(mx > 16.f)) { const float dl = fmaxf(mx, 0.f), sc = ex2(-dl); S.m += dl; S.l *= sc;
#pragma unroll
        for (int r = 0; r < 16; ++r) { p0[r] -= dl; p1[r] -= dl; S.o0[r] *= sc; S.o1[r] *= sc; } }
    float psa[4] = {0.f, 0.f, 0.f, 0.f};
#pragma unroll
    for (int r = 0; r < 16; ++r) { p0[r] = ex2(p0[r]); p1[r] = ex2(p1[r]); psa[r & 3] += p0[r] + p1[r]; }
    S.l += (psa[0] + psa[1]) + (psa[2] + psa[3]);
    v4u a0, a1, b0, b1;
    a0.x = cvtpk(p0[0], p0[1]); a0.y = cvtpk(p0[2], p0[3]); a0.z = cvtpk(p0[4], p0[5]); a0.w = cvtpk(p0[6], p0[7]);
    a1.x = cvtpk(p0[8], p0[9]); a1.y = cvtpk(p0[10], p0[11]); a1.z = cvtpk(p0[12], p0[13]); a1.w = cvtpk(p0[14], p0[15]);
    b0.x = cvtpk(p1[0], p1[1]); b0.y = cvtpk(p1[2], p1[3]); b0.z = cvtpk(p1[4], p1[5]); b0.w = cvtpk(p1[6], p1[7]);
    b1.x = cvtpk(p1[8], p1[9]); b1.y = cvtpk(p1[10], p1[11]); b1.z = cvtpk(p1[12], p1[13]); b1.w = cvtpk(p1[14], p1[15]);
    LAS const char* vp = Vb + (vrow0 + 4 * hi + ((lane & 15) >> 2)) * 64 + ((lane >> 4) & 1) * 32 + (lane & 3) * 8;
#pragma unroll
    for (int k16 = 0; k16 < 4; ++k16) { const bf16x8 pf = __builtin_bit_cast(bf16x8, k16 == 0 ? a0 : k16 == 1 ? a1 : k16 == 2 ? b0 : b1);
        const bf16x8 v0 = cat8(vtr(vp + k16 * 1024), vtr(vp + k16 * 1024 + 512)), v1 = cat8(vtr(vp + vdh + k16 * 1024), vtr(vp + vdh + k16 * 1024 + 512));
        S.o0 = mfma32(v0, pf, S.o0); S.o1 = mfma32(v1, pf, S.o1); }
}

struct MobaFar { float c; bool any; DI float b(int) const { return c; } DI bool msk(int) const { return false; } };
struct MobaBias { LAS const float* lut; int tq, s0; bool any;
    DI float b(int kvrel) const { const int dist = tq - (s0 + kvrel); return lut[dist < 0 ? 0 : (dist > 1023 ? 1023 : dist)]; }
    DI bool msk(int kvrel) const { return tq - (s0 + kvrel) < 0; } };
DI void moba_qload(bf16x8 (&qf)[4], const bf16* proj, int rowbase, int h, int tq, int hi) {
    const bf16* qp = proj + (size_t)(rowbase + tq) * EV_N + EC_QB + h * 64 + hi * 8;
#pragma unroll
    for (int s = 0; s < 4; ++s) qf[s] = *(const bf16x8*)(qp + s * 16);
}
DI void moba_tile(const Fr& F, const bf16x8 (&qf)[4], int rowbase, int h, int n, int tq, bool valid, int slot, bool own, int wave_tile) {
    LAS const char* Kb = (LAS const char*)F.lds; LAS const char* Vb = (LAS const char*)(F.lds + 32768); LAS const float* lut = (LAS const float*)(F.lds + 98304);
    bf16* po = (bf16*)(F.ws + WS_ACT); float* pml = (float*)(F.ws + WS_PML);
    const int lane = F.lane, hi = lane >> 5;
    AttSt S; S.m = 0.f; S.l = 0.f;
#pragma unroll
    for (int r = 0; r < 16; ++r) { S.o0[r] = 0.f; S.o1[r] = 0.f; }
    const int nst = own ? wave_tile + 1 : 8;
    int tmin = tq;
#pragma unroll
    for (int o = 1; o < 64; o <<= 1) { const int y = __shfl_xor(tmin, o); tmin = y < tmin ? y : tmin; }
    const float cfar = lut[1023];
    int st = 0;
    for (; st + 1 < nst; st += 2) {
        if (!own && tmin - (n * 256 + st * 32 + 63) >= 790) { MobaFar bf{cfar, false}; att_tile64(S, qf, Kb + st * 4096, Vb, 16384, st * 32, lane, bf, bf); }
        else { MobaBias bf0{lut, tq, n * 256 + st * 32, false}, bf1{lut, tq, n * 256 + st * 32 + 32, own && st + 1 == wave_tile}; att_tile64(S, qf, Kb + st * 4096, Vb, 16384, st * 32, lane, bf0, bf1); } }
    if (st < nst) { MobaBias bf{lut, tq, n * 256 + st * 32, own && st == wave_tile}; att_subtile(S, qf, Kb + st * 4096, Vb, 16384, st * 32, lane, bf); }
    const float lt = S.l + __shfl_xor(S.l, 32), inv = 1.f / lt;
    if (valid) { const size_t pi = ((size_t)(rowbase + tq) * 8 + h) * 4 + slot; bf16* o = po + pi * 64;
#pragma unroll
        for (int a4 = 0; a4 < 4; ++a4) { v2u w0, w1;
            w0.x = cvtpk(S.o0[4 * a4] * inv, S.o0[4 * a4 + 1] * inv); w0.y = cvtpk(S.o0[4 * a4 + 2] * inv, S.o0[4 * a4 + 3] * inv);
            w1.x = cvtpk(S.o1[4 * a4] * inv, S.o1[4 * a4 + 1] * inv); w1.y = cvtpk(S.o1[4 * a4 + 2] * inv, S.o1[4 * a4 + 3] * inv);
            *(v2u*)(o + 8 * a4 + 4 * hi) = w0; *(v2u*)(o + 32 + 8 * a4 + 4 * hi) = w1; }
        if (hi == 0) { f32x2 ml = {S.m, lt}; *(f32x2*)(pml + pi * 2) = ml; } }
}
DI void moba_unit(const Args& a, const Fr& F, int b, int h, int n) {
    const bf16* proj = (const bf16*)(F.ws + WS_PROJ); const unsigned* sel3 = (const unsigned*)(F.ws + WS_SEL3);
    LAS unsigned char* lds = F.lds; LAS unsigned* list = (LAS unsigned*)(lds + 65536); LAS float* lut = (LAS float*)(lds + 98304); LAS unsigned* misc = (LAS unsigned*)(lds + 102400);
    const int tid = F.tid, lane = F.lane, wave = F.wave, rowbase = b * SEQ;
    __syncthreads();
    { const bf16* kg = proj + (size_t)(rowbase + n * 256) * EV_N + EC_KB + h * 64; const bf16* vg = proj + (size_t)(rowbase + n * 256) * EV_N + EC_VB + h * 64;
#pragma unroll
        for (int i = 0; i < 4; ++i) { const int p = tid + i * NTHR;
            { const int r = p & 31, c = (p >> 5) & 7, st = p >> 8; const v4u v = *(const v4u*)(kg + (size_t)(st * 32 + r) * EV_N + c * 8); *(LAS v4u*)(lds + st * 4096 + c * 512 + r * 16) = v; }
            { const int cc = p & 3, row = (p >> 2) & 255, dh = p >> 10; const v4u v = *(const v4u*)(vg + (size_t)row * EV_N + dh * 32 + cc * 8); *(LAS v4u*)(lds + 32768 + dh * 16384 + row * 64 + cc * 16) = v; } }
        for (int d = tid; d < 1024; d += NTHR) lut[d] = a.in[9][t5_bucket(d) * 16 + 8 + h] * LOG2E; }
    if (tid == 0) misc[16] = 0u;
    __syncthreads();
    unsigned sv[16];
#pragma unroll
    for (int k = 0; k < 16; ++k) { const int t = (n + 1) * 256 + k * NTHR + tid; sv[k] = t < SEQ ? sel3[(size_t)(rowbase + t) * 8 + h] : 0u; }
#pragma unroll
    for (int k = 0; k < 16; ++k) { const int tb = (n + 1) * 256 + k * NTHR; if (tb < SEQ) { const int t = tb + tid;
        const unsigned s = sv[k]; const unsigned nv = s >> 24; int slot = -1;
        if (nv > 0u && (s & 255u) == (unsigned)n) slot = 0; else if (nv > 1u && ((s >> 8) & 255u) == (unsigned)n) slot = 1; else if (nv > 2u && ((s >> 16) & 255u) == (unsigned)n) slot = 2;
        const unsigned long long bal = __ballot(slot >= 0); const unsigned wcnt = __popcll(bal);
        if (lane == 0) misc[wave] = wcnt;
        __syncthreads();
        unsigned off = misc[16], tot = 0u;
#pragma unroll
        for (int w = 0; w < 8; ++w) { const unsigned c = misc[w]; if (w < wave) off += c; tot += c; }
        if (slot >= 0) list[off + __popcll(bal & ((1ull << lane) - 1ull))] = ((unsigned)t << 2) | (unsigned)slot;
        __syncthreads();
        if (tid == 0) misc[16] += tot; } }
    __syncthreads();
    const int nlist = (int)misc[16];
    const int ntl = (nlist + 31) >> 5, hi = lane >> 5;
    bf16x8 qa[4], qb2[4];
    moba_qload(qa, proj, rowbase, h, n * 256 + wave * 32 + (lane & 31), hi);
    unsigned ea = 0u, eb = 0u; bool va = false, vb = false;
    int tl = wave;
    if (tl < ntl) { const int li = tl * 32 + (lane & 31); vb = li < nlist; eb = list[vb ? li : nlist - 1]; moba_qload(qb2, proj, rowbase, h, (int)(eb >> 2), hi); }
    moba_tile(F, qa, rowbase, h, n, n * 256 + wave * 32 + (lane & 31), true, 3, true, wave);
    for (; tl < ntl; tl += 16) {
        const int t2 = tl + 8, t3 = tl + 16;
        if (t2 < ntl) { const int li = t2 * 32 + (lane & 31); va = li < nlist; ea = list[va ? li : nlist - 1]; moba_qload(qa, proj, rowbase, h, (int)(ea >> 2), hi); }
        moba_tile(F, qb2, rowbase, h, n, (int)(eb >> 2), vb, (int)(eb & 3u), false, 0);
        if (t2 < ntl) {
            if (t3 < ntl) { const int li = t3 * 32 + (lane & 31); vb = li < nlist; eb = list[vb ? li : nlist - 1]; moba_qload(qb2, proj, rowbase, h, (int)(eb >> 2), hi); }
            moba_tile(F, qa, rowbase, h, n, (int)(ea >> 2), va, (int)(ea & 3u), false, 0); }
    }
}

DI void dsa_step(const bf16x8 (&af)[2][4], const bf16x8 (&qlf)[4], int ch, LAS const unsigned char* bsel, LAS unsigned char* cbuf, LAS const float* tab,
                 float& m, float& l, f32x4 (&oT)[8], int l15, int kg, int lane) {
    f32x4 acc[2];
#pragma unroll
    for (int mt = 0; mt < 2; ++mt) { const unsigned b4 = *(LAS const unsigned*)(bsel + ch * 32 + mt * 16 + 4 * kg);
#pragma unroll
        for (int i = 0; i < 4; ++i) { const unsigned bb = (b4 >> (8 * i)) & 255u; const float tb = tab[(bb & 31u) * 8 + (l15 & 7)];
            acc[mt][i] = (tb - m) + (bb != 255u ? 0.f : -INFINITY); } }
#pragma unroll
    for (int mt = 0; mt < 2; ++mt)
#pragma unroll
        for (int ks = 0; ks < 4; ++ks) { acc[mt] = mfma16(af[mt][ks], qlf[ks], acc[mt]); *(LAS bf16x8*)(cbuf + (mt * 16 + l15) * 288 + (ks * 32 + kg * 8) * 2) = af[mt][ks]; }
    float mx = fmaxf(fmaxf(fmaxf(acc[0][0], acc[0][1]), fmaxf(acc[0][2], acc[0][3])), fmaxf(fmaxf(acc[1][0], acc[1][1]), fmaxf(acc[1][2], acc[1][3])));
    mx = fmaxf(mx, __shfl_xor(mx, 16)); mx = fmaxf(mx, __shfl_xor(mx, 32));
    if (__any(mx > 16.f)) { const float dl = fmaxf(mx, 0.f), sc = ex2(-dl); m += dl; l *= sc;
#pragma unroll
        for (int mt = 0; mt < 2; ++mt) acc[mt] = acc[mt] - dl;
#pragma unroll
        for (int ct = 0; ct < 8; ++ct) oT[ct] = oT[ct] * sc; }
    float ps = 0.f;
#pragma unroll
    for (int mt = 0; mt < 2; ++mt)
#pragma unroll
        for (int i = 0; i < 4; ++i) { acc[mt][i] = ex2(acc[mt][i]); ps += acc[mt][i]; }
    l += ps;
    v4u pw; pw.x = cvtpk(acc[0][0], acc[0][1]); pw.y = cvtpk(acc[0][2], acc[0][3]); pw.z = cvtpk(acc[1][0], acc[1][1]); pw.w = cvtpk(acc[1][2], acc[1][3]);
    const bf16x8 pf = __builtin_bit_cast(bf16x8, pw);
    LDS_WAIT();
    LAS const char* tp = (LAS const char*)cbuf + (4 * kg + (l15 >> 2)) * 288 + (lane & 3) * 8;
#pragma unroll
    for (int ct = 0; ct < 8; ++ct) { const bf16x8 cf = cat8(vtr(tp + ct * 32), vtr(tp + 16 * 288 + ct * 32)); oT[ct] = mfma16(cf, pf, oT[ct]); }
    LDS_WAIT();
}
DI void dsa_gather(bf16x8 (&af)[2][4], const bf16* ckvn, int rowbase, LAS const unsigned short* selb, int ch, int l15, int kg) {
#pragma unroll
    for (int mt = 0; mt < 2; ++mt) { unsigned idx = selb[ch * 32 + mt * 16 + l15]; if (idx == 0xffffu) idx = 0u;
        const bf16* cp = ckvn + (size_t)(rowbase + (int)idx) * 128 + kg * 8;
#pragma unroll
        for (int ks = 0; ks < 4; ++ks) af[mt][ks] = *(const bf16x8*)(cp + ks * 32); }
}
DI void dsa_query(const Fr& F, int tok, const v2u sv, LAS unsigned char* wl, LAS const unsigned char* bkt, LAS const float* tab) {
    const bf16* ql = (const bf16*)(F.ws + WS_QL); const bf16* ckvn = (const bf16*)(F.ws + WS_CKVN); const unsigned short* sel = (const unsigned short*)(F.ws + WS_SEL); bf16* ol = (bf16*)(F.ws + WS_OL);
    const int lane = F.lane, l15 = lane & 15, kg = lane >> 4, t = tok % SEQ, rowbase = tok - t;
    LAS unsigned short* selb = (LAS unsigned short*)wl; LAS unsigned char* bsel = wl + 512; LAS unsigned char* cbuf = wl + 1024;
    { *((LAS v2u*)selb + lane) = sv; unsigned bw = 0u;
#pragma unroll
        for (int i = 0; i < 4; ++i) { const unsigned s = (i < 2 ? (sv.x >> (16 * i)) : (sv.y >> (16 * (i - 2)))) & 0xffffu; const int dist = t - (int)s;
            const unsigned bb = (s != 0xffffu && dist >= 0) ? (unsigned)bkt[dist > 1023 ? 1023 : dist] : 255u; bw |= bb << (8 * i); }
        *((LAS unsigned*)bsel + lane) = bw; }
    bf16x8 qlf[4];
#pragma unroll
    for (int ks = 0; ks < 4; ++ks) { qlf[ks] = *(const bf16x8*)(ql + (size_t)tok * 1024 + (l15 & 7) * 128 + ks * 32 + kg * 8); if (l15 >= 8) qlf[ks] = (bf16x8){0, 0, 0, 0, 0, 0, 0, 0}; }
    float m = 0.f, l = 0.f; f32x4 oT[8];
#pragma unroll
    for (int ct = 0; ct < 8; ++ct) oT[ct] = (f32x4){0.f, 0.f, 0.f, 0.f};
    const int nvalid = t + 1 < 256 ? t + 1 : 256, nch = (nvalid + 31) >> 5;
    LDS_WAIT();
    bf16x8 afa[2][4], afb[2][4], afc[2][4];
    dsa_gather(afa, ckvn, rowbase, selb, 0, l15, kg);
    if (nch > 1) dsa_gather(afb, ckvn, rowbase, selb, 1, l15, kg);
    for (int ch = 0; ch < nch; ch += 3) {
        if (ch + 2 < nch) dsa_gather(afc, ckvn, rowbase, selb, ch + 2, l15, kg);
        dsa_step(afa, qlf, ch, bsel, cbuf, tab, m, l, oT, l15, kg, lane);
        if (ch + 1 < nch) { if (ch + 3 < nch) dsa_gather(afa, ckvn, rowbase, selb, ch + 3, l15, kg);
            dsa_step(afb, qlf, ch + 1, bsel, cbuf, tab, m, l, oT, l15, kg, lane); }
        if (ch + 2 < nch) { if (ch + 4 < nch) dsa_gather(afb, ckvn, rowbase, selb, ch + 4, l15, kg);
            dsa_step(afc, qlf, ch + 2, bsel, cbuf, tab, m, l, oT, l15, kg, lane); }
    }
    l += __shfl_xor(l, 16); l += __shfl_xor(l, 32);
    const float inv = 1.f / l;
    if (l15 < 8) { bf16* o = ol + (size_t)tok * 1024 + l15 * 128 + 4 * kg;
#pragma unroll
        for (int ct = 0; ct < 8; ++ct) { v2u w; w.x = cvtpk(oT[ct][0] * inv, oT[ct][1] * inv); w.y = cvtpk(oT[ct][2] * inv, oT[ct][3] * inv); *(v2u*)(o + ct * 16) = w; } }
}
DI void dsa_chunk(const Args& a, const Fr& F, int c32) {
    LAS unsigned char* bkt = F.lds + 81920; LAS float* tab = (LAS float*)(F.lds + 82944);
    __syncthreads();
    for (int d = F.tid; d < 1024; d += NTHR) bkt[d] = (unsigned char)t5_bucket(d);
    if (F.tid < 256) tab[F.tid] = a.in[9][(F.tid >> 3) * 16 + (F.tid & 7)] * LOG2E;
    __syncthreads();
    const unsigned short* selg = (const unsigned short*)(F.ws + WS_SEL); v2u svq[4];
#pragma unroll
    for (int i = 0; i < 4; ++i) svq[i] = *((const v2u*)(selg + (size_t)(c32 * 32 + F.wave * 4 + i) * 256) + F.lane);
#pragma unroll
    for (int i = 0; i < 4; ++i) dsa_query(F, c32 * 32 + F.wave * 4 + i, svq[i], F.lds + F.wave * 10240, bkt, tab);
}

DI void ph_even_post(const Fr& F, int j) {
    const bf16* ol = (const bf16*)(F.ws + WS_OL); bf16* ao = (bf16*)(F.ws + WS_AO);
    const bf16* wuvt = (const bf16*)(F.ws + WS_WUVT) + (size_t)j * 8 * 64 * 128;
    const bf16* po = (const bf16*)(F.ws + WS_ACT); const float* pml = (const float*)(F.ws + WS_PML); const unsigned* sel3 = (const unsigned*)(F.ws + WS_SEL3);
    const int lane = F.lane, wave = F.wave, l15 = lane & 15, kg = lane >> 4;
    for (int chunk = F.blk; chunk < 256; chunk += F.G) { const int tok0 = chunk * 128;
        { const int h = wave; bf16x8 af[4][4];
#pragma unroll
            for (int mt = 0; mt < 4; ++mt)
#pragma unroll
                for (int ks = 0; ks < 4; ++ks) af[mt][ks] = *(const bf16x8*)(wuvt + ((size_t)h * 64 + mt * 16 + l15) * 128 + ks * 32 + kg * 8);
#pragma unroll 1
            for (int tg = 0; tg < 8; tg += 2) { bf16x8 bf[2][4];
#pragma unroll
                for (int u = 0; u < 2; ++u)
#pragma unroll
                    for (int ks = 0; ks < 4; ++ks) bf[u][ks] = *(const bf16x8*)(ol + (size_t)(tok0 + (tg + u) * 16 + l15) * 1024 + h * 128 + ks * 32 + kg * 8);
#pragma unroll
                for (int u = 0; u < 2; ++u) { const int tok = tok0 + (tg + u) * 16 + l15;
#pragma unroll
                    for (int mt = 0; mt < 4; ++mt) { f32x4 d = {0.f, 0.f, 0.f, 0.f};
#pragma unroll
                        for (int ks = 0; ks < 4; ++ks) d = mfma16(af[mt][ks], bf[u][ks], d);
                        v2u w; w.x = cvtpk(d[0], d[1]); w.y = cvtpk(d[2], d[3]); *(v2u*)(ao + (size_t)tok * 1024 + h * 64 + mt * 16 + 4 * kg) = w; } } } }
#pragma unroll 1
        for (int i0 = 0; i0 < 16; i0 += 4) { const int h = lane >> 3, d0 = (lane & 7) * 8; unsigned nvv[4]; f32x2 mlv[4][4];
#pragma unroll
            for (int i = 0; i < 4; ++i) { const int tok = tok0 + wave * 16 + i0 + i; const size_t pi = ((size_t)tok * 8 + h) * 4; nvv[i] = sel3[(size_t)tok * 8 + h] >> 24;
#pragma unroll
                for (int s = 0; s < 4; ++s) mlv[i][s] = *(const f32x2*)(pml + (pi + s) * 2); }
#pragma unroll
            for (int i = 0; i < 4; ++i) { const int tok = tok0 + wave * 16 + i0 + i; const size_t pi = ((size_t)tok * 8 + h) * 4;
                float mj[4], lj[4];
#pragma unroll
                for (int s = 0; s < 4; ++s) { const bool ok = (s == 3) || ((unsigned)s < nvv[i]); mj[s] = ok ? mlv[i][s][0] : -1e30f; lj[s] = ok ? mlv[i][s][1] : 0.f; }
                const float ms = fmaxf(fmaxf(mj[0], mj[1]), fmaxf(mj[2], mj[3])); float wsum = 0.f, acc[8], wv[4]; v4u pv[4];
#pragma unroll
                for (int k = 0; k < 8; ++k) acc[k] = 0.f;
#pragma unroll
                for (int s = 0; s < 4; ++s) { wv[s] = lj[s] * ex2(mj[s] - ms); wsum += wv[s]; pv[s] = (v4u){0u, 0u, 0u, 0u}; if (wv[s] > 0.f) pv[s] = *(const v4u*)(po + (pi + s) * 64 + d0); }
#pragma unroll
                for (int s = 0; s < 4; ++s) { if (wv[s] > 0.f) {
#pragma unroll
                    for (int k = 0; k < 4; ++k) { acc[2 * k] += wv[s] * bf2f(pv[s][k] & 0xffffu); acc[2 * k + 1] += wv[s] * bf2f(pv[s][k] >> 16); } } }
                const float inv = 1.f / wsum; v4u o; o.x = cvtpk(acc[0] * inv, acc[1] * inv); o.y = cvtpk(acc[2] * inv, acc[3] * inv); o.z = cvtpk(acc[4] * inv, acc[5] * inv); o.w = cvtpk(acc[6] * inv, acc[7] * inv);
                *(v4u*)(ao + (size_t)tok * 1024 + 512 + h * 64 + d0) = o; } }
    }
}
template <class XT> DI f32x4 ld_x4(const XT* p);
template <> DI f32x4 ld_x4<float>(const float* p) { return *(const f32x4*)p; }
template <> DI f32x4 ld_x4<bf16>(const bf16* p) { const v2u w = *(const v2u*)p; return (f32x4){bf2f(w.x & 0xffffu), bf2f(w.x >> 16), bf2f(w.y & 0xffffu), bf2f(w.y >> 16)}; }
template <class XT> DI f32x16 proj32_f32(const float* W, int ldw, int ncols, const XT* xrow, int d_lo, int lane) {
    const int e = lane & 31, kh = lane >> 5; const bool ev = e < ncols;
    f32x16 D;
#pragma unroll
    for (int r = 0; r < 16; ++r) D[r] = 0.f;
    const float* wp = W + (size_t)(d_lo + 4 * kh) * ldw + (ev ? e : 0);
    const XT* xp = xrow + d_lo + 4 * kh;
#pragma unroll 8
    for (int i = 0; i < 64; ++i) { const f32x4 xv = ld_x4<XT>(xp + 8 * i);
        float a0 = wp[(size_t)(8 * i + 0) * ldw], a1 = wp[(size_t)(8 * i + 1) * ldw], a2 = wp[(size_t)(8 * i + 2) * ldw], a3 = wp[(size_t)(8 * i + 3) * ldw];
        if (!ev) { a0 = 0.f; a1 = 0.f; a2 = 0.f; a3 = 0.f; }
        D = __builtin_amdgcn_mfma_f32_32x32x2f32(a0, xv[0], D, 0, 0, 0); D = __builtin_amdgcn_mfma_f32_32x32x2f32(a1, xv[1], D, 0, 0, 0);
        D = __builtin_amdgcn_mfma_f32_32x32x2f32(a2, xv[2], D, 0, 0, 0); D = __builtin_amdgcn_mfma_f32_32x32x2f32(a3, xv[3], D, 0, 0, 0); }
    return D;
}
DI void ph_odd_prep(const Args& a, const Fr& F, int j, int layer) {
    const bf16* proj = (const bf16*)(F.ws + WS_PROJ); const bf16* x = (const bf16*)(F.ws + WS_XB);
    float* logf = (float*)(F.ws + WS_LOGF); float* cs = (float*)(F.ws + WS_CS);
    const float* wf = a.in[6] + (size_t)j * 1024 * 3088 + 3072; const float* bfv = a.in[7] + j * 16;
    LAS float* red = (LAS float*)(F.lds); LAS float* lfb = (LAS float*)(F.lds + 131072);
    LAS unsigned* kmx = (LAS unsigned*)(F.lds + 131072 + 8192);
    const int lane = F.lane, wave = F.wave, tid = F.tid, l31 = lane & 31, hi = lane >> 5;
    for (int chunk = F.blk; chunk < 256; chunk += F.G) { const int tok0 = chunk * 128, b = tok0 / SEQ, t0 = tok0 % SEQ;
        __syncthreads();
        if (tid < 16) kmx[tid] = 0u;
        const int tl = wave & 3, kr = wave >> 2;
        f32x16 D = proj32_f32(wf, 3088, 16, x + (size_t)(tok0 + tl * 32 + l31) * DM, kr * 512, lane);
        if (kr == 1) {
#pragma unroll
            for (int r = 0; r < 8; ++r) red[(tl * 8 + r) * 64 + lane] = D[r]; }
        __syncthreads();
        if (kr == 0) {
#pragma unroll
            for (int r = 0; r < 8; ++r) { const int h = (r & 3) + 8 * (r >> 2) + 4 * hi; const float z = D[r] + red[(tl * 8 + r) * 64 + lane] + bfv[h];
                const float ls = fminf(z, 0.f) - log1pf(__expf(-fabsf(z)));
                lfb[(tl * 32 + l31) * 16 + h] = ls * LOG2E; } }
#pragma unroll 1
        for (int i = 0; i < 4; ++i) { const int p = tid + i * NTHR, tk = p >> 4, h = p & 15; const v4u* kp = (const v4u*)(proj + (size_t)(tok0 + tk) * OD_N + OC_K + h * 64); float s = 0.f;
#pragma unroll
            for (int c = 0; c < 8; ++c) { const v4u w = kp[c];
#pragma unroll
                for (int k = 0; k < 4; ++k) { const float e0 = bf2f(w[k] & 0xffffu), e1 = bf2f(w[k] >> 16); s += e0 * e0 + e1 * e1; } }
            __hip_atomic_fetch_max(kmx + h, __float_as_uint(s), __ATOMIC_RELAXED, __HIP_MEMORY_SCOPE_WORKGROUP); }
        __syncthreads();
        for (int i = tid; i < 2048; i += NTHR) { const int h = i >> 7, tk = i & 127; logf[((size_t)b * 16 + h) * SEQ + t0 + tk] = lfb[tk * 16 + h]; }
        if (tid < 32) { const int h = tid & 15, c = tid >> 4; float s = 0.f;
            for (int k = 0; k < 64; ++k) s += lfb[(c * 64 + k) * 16 + h];
            cs[((size_t)b * 16 + h) * 128 + (t0 >> 6) + c] = s; }
        if (tid < 16) __hip_atomic_fetch_max(F.ctl + CW_KMAX + layer * 64 + b * 16 + tid, kmx[tid], RLX_AGENT);
    }
}

constexpr float FOX_SKIP_LOG2 = 64.f;
struct FoxBias { LAS const float* ng; int tq, kabs0; bool any;
    DI float b(int kvrel) const { return ng[kvrel]; }
    DI bool msk(int kvrel) const { return (kabs0 + kvrel) > tq; } };
DI void fox_unit(const Fr& F, int layer, int b, int h, int qb) {
    const bf16* proj = (const bf16*)(F.ws + WS_PROJ); const float* logf = (const float*)(F.ws + WS_LOGF); const float* cs = (const float*)(F.ws + WS_CS); bf16* ao = (bf16*)(F.ws + WS_AO);
    LAS unsigned char* lds = F.lds; LAS float* ng = (LAS float*)(lds + 32768); LAS float* red = (LAS float*)(lds + 65536 + 1024); LAS int* ibox = (LAS int*)(lds + 65536 + 2048);
    const int tid = F.tid, lane = F.lane, wave = F.wave, r32 = lane & 31, hi = lane >> 5, t0 = qb * 256, rowbase = b * SEQ, tq = t0 + wave * 32 + r32;
    __syncthreads();
    bf16x8 qf[4]; float qs = 0.f;
    { const bf16* qp = proj + (size_t)(rowbase + tq) * OD_N + OC_Q + h * 64 + hi * 8;
#pragma unroll
        for (int s = 0; s < 4; ++s) { qf[s] = *(const bf16x8*)(qp + s * 16);
#pragma unroll
            for (int k = 0; k < 8; ++k) { const float e = bf2f((unsigned short)qf[s][k]); qs += e * e; } } }
    qs += __shfl_xor(qs, 32); qs = wave_max(qs);
    if (lane == 0) red[wave] = qs;
    if (tid < 128) red[32 + tid] = (tid < t0 / 64) ? cs[((size_t)b * 16 + h) * 128 + tid] : 0.f;
    __syncthreads();
    if (tid == 0) { float qm = red[0];
        for (int w = 1; w < 8; ++w) qm = fmaxf(qm, red[w]);
        const float km = __uint_as_float(ld_u32(F.ctl + CW_KMAX + layer * 64 + b * 16 + h));
        const float B2 = 2.f * (sqrtf(qm * km) * 1.01f + 1.f);
        int kt = t0 / 64 - 1, kts = t0 / 64; float D = 0.f;
        while (kt >= 0 && B2 + D >= -FOX_SKIP_LOG2) { kts = kt; D += red[32 + kt]; --kt; }
        ibox[0] = kts; }
    __syncthreads();
    const int kts = ibox[0], s_start = kts * 64, nel = t0 + 256 - s_start;
    { const int i0 = tid * 16; float v[16]; const float* lp = logf + ((size_t)b * 16 + h) * SEQ + s_start + i0;
        if (i0 < nel) {
#pragma unroll
            for (int c = 0; c < 4; ++c) { const f32x4 w = *(const f32x4*)(lp + 4 * c); v[4 * c] = w[0]; v[4 * c + 1] = w[1]; v[4 * c + 2] = w[2]; v[4 * c + 3] = w[3]; } }
        else {
#pragma unroll
            for (int c = 0; c < 16; ++c) v[c] = 0.f; }
#pragma unroll
        for (int c = 1; c < 16; ++c) v[c] += v[c - 1];
        float xsum = v[15];
#pragma unroll
        for (int o = 1; o < 64; o <<= 1) { const float y = __shfl_up(xsum, o); if (lane >= o) xsum += y; }
        if (lane == 63) red[16 + wave] = xsum;
        __syncthreads();
        float off = xsum - v[15];
        for (int w = 0; w < wave; ++w) off += red[16 + w];
        if (i0 < nel) {
#pragma unroll
            for (int c = 0; c < 4; ++c) { f32x4 w = {-(off + v[4 * c]), -(off + v[4 * c + 1]), -(off + v[4 * c + 2]), -(off + v[4 * c + 3])}; *(LAS f32x4*)(ng + i0 + 4 * c) = w; } }
    }
    const int ntile = t0 / 64 + 4 - kts;
    const bf16* kg = proj + (size_t)rowbase * OD_N + OC_K + h * 64; const bf16* vg = proj + (size_t)rowbase * OD_N + OC_V + h * 64;
    const int kr = tid & 31, kc = (tid >> 5) & 7, kst = tid >> 8, vcc = tid & 3, vrow = (tid >> 2) & 63, vdh = tid >> 8;
    const int koff = kst * 4096 + kc * 512 + kr * 16, voff = 8192 + vdh * 4096 + vrow * 64 + vcc * 16;
    { const v4u kv = *(const v4u*)(kg + (size_t)(kts * 64 + kst * 32 + kr) * OD_N + kc * 8), vv = *(const v4u*)(vg + (size_t)(kts * 64 + vrow) * OD_N + vdh * 32 + vcc * 8);
        *(LAS v4u*)(lds + koff) = kv; *(LAS v4u*)(lds + voff) = vv; }
    __syncthreads();
    AttSt S; S.m = 0.f; S.l = 0.f;
#pragma unroll
    for (int r = 0; r < 16; ++r) { S.o0[r] = 0.f; S.o1[r] = 0.f; }
    const int wlast = t0 + wave * 32 + 31, wfirst = t0 + wave * 32;
    for (int i = 0; i < ntile; ++i) { const int kt = kts + i; LAS unsigned char* buf = lds + (i & 1) * 16384; LAS unsigned char* nbuf = lds + ((i + 1) & 1) * 16384;
        v4u kv, vv; const bool more = i + 1 < ntile;
        if (more) { kv = *(const v4u*)(kg + (size_t)((kt + 1) * 64 + kst * 32 + kr) * OD_N + kc * 8); vv = *(const v4u*)(vg + (size_t)((kt + 1) * 64 + vrow) * OD_N + vdh * 32 + vcc * 8); }
        { const int kv0 = kt * 64;
            if (kv0 + 32 <= wlast) { FoxBias bf0{ng + (kv0 - s_start), tq, kv0, kv0 + 31 > wfirst}, bf1{ng + (kv0 + 32 - s_start), tq, kv0 + 32, kv0 + 63 > wfirst};
                att_tile64(S, qf, (LAS const char*)buf, (LAS const char*)buf + 8192, 4096, 0, lane, bf0, bf1); }
            else if (kv0 <= wlast) { FoxBias bf{ng + (kv0 - s_start), tq, kv0, kv0 + 31 > wfirst};
                att_subtile(S, qf, (LAS const char*)buf, (LAS const char*)buf + 8192, 4096, 0, lane, bf); } }
        if (more) { *(LAS v4u*)(nbuf + koff) = kv; *(LAS v4u*)(nbuf + voff - 8192 + 8192) = vv; }
        __syncthreads(); }
    const float lt = S.l + __shfl_xor(S.l, 32), inv = 1.f / lt;
    bf16* o = ao + (size_t)(rowbase + tq) * 1024 + h * 64;
#pragma unroll
    for (int a4 = 0; a4 < 4; ++a4) { v2u w0, w1;
        w0.x = cvtpk(S.o0[4 * a4] * inv, S.o0[4 * a4 + 1] * inv); w0.y = cvtpk(S.o0[4 * a4 + 2] * inv, S.o0[4 * a4 + 3] * inv);
        w1.x = cvtpk(S.o1[4 * a4] * inv, S.o1[4 * a4 + 1] * inv); w1.y = cvtpk(S.o1[4 * a4 + 2] * inv, S.o1[4 * a4 + 3] * inv);
        *(v2u*)(o + 8 * a4 + 4 * hi) = w0; *(v2u*)(o + 32 + 8 * a4 + 4 * hi) = w1; }
}

DI void ph_ln1_router(const Args& a, const Fr& F, int layer) {
    const bf16* yp = (const bf16*)(F.ws + WS_YP); bf16* x1 = (bf16*)(F.ws + WS_X1); unsigned char* xb8 = F.ws + WS_XB8;
    unsigned* tope = (unsigned*)(F.ws + WS_TOPE); float* gate = (float*)(F.ws + WS_GATE); unsigned* rank = (unsigned*)(F.ws + WS_RANK);
    const float* g = a.in[10] + (size_t)(layer * 2) * DM; const float* bb = a.in[11] + (size_t)(layer * 2) * DM;
    const float* rw = a.in[12] + (size_t)layer * 1024 * 32; const float* rb = a.in[13] + layer * 32;
    LAS float* red = (LAS float*)(F.lds); LAS unsigned* lcnt = (LAS unsigned*)(F.lds + 131072);
    const int lane = F.lane, wave = F.wave, tid = F.tid, l31 = lane & 31, hi = lane >> 5;
    for (int chunk = F.blk; chunk < 256; chunk += F.G) { const int tok0 = chunk * 128;
        __syncthreads();
        if (tid < 32) lcnt[tid] = 0u;
#pragma unroll 1
        for (int k = 0; k < 16; k += 8) { f32x4 v[8][4];
#pragma unroll
            for (int i = 0; i < 8; ++i)
#pragma unroll
                for (int jj = 0; jj < 4; ++jj) { const v2u w = *((const v2u*)(yp + (size_t)(tok0 + wave * 16 + k + i) * DM) + lane + 64 * jj);
                    v[i][jj] = (f32x4){bf2f(w.x & 0xffffu), bf2f(w.x >> 16), bf2f(w.y & 0xffffu), bf2f(w.y >> 16)}; }
#pragma unroll
            for (int i = 0; i < 8; ++i) { const int tok = tok0 + wave * 16 + k + i;
                ln_row(v[i], g, bb, lane);
                store_row_bf16(x1 + (size_t)tok * DM, v[i], lane);
#pragma unroll
                for (int jj = 0; jj < 4; ++jj) *((unsigned*)(xb8 + (size_t)tok * DM) + lane + 64 * jj) = pk4_fp8(v[i][jj][0] * F8_SX, v[i][jj][1] * F8_SX, v[i][jj][2] * F8_SX, v[i][jj][3] * F8_SX); } }
        asm volatile("s_waitcnt vmcnt(0)" ::: "memory");
        __syncthreads();
        const int tl = wave & 3, kr = wave >> 2, tokl = tok0 + tl * 32 + l31;
        f32x16 D = proj32_f32(rw, 32, 32, x1 + (size_t)tokl * DM, kr * 512, lane);
        if (kr == 1) {
#pragma unroll
            for (int r = 0; r < 16; ++r) red[(tl * 16 + r) * 64 + lane] = D[r]; }
        __syncthreads();
        if (kr == 0) {
            float lv[32];
#pragma unroll
            for (int r = 0; r < 16; ++r) { const float own = D[r] + red[(tl * 16 + r) * 64 + lane] + rb[crow(r, hi)]; const float oth = __shfl_xor(own, 32);
                lv[crow(r, 0)] = hi == 0 ? own : oth; lv[crow(r, 1)] = hi == 0 ? oth : own; }
            float tv[4]; int te[4];
#pragma unroll
            for (int r = 0; r < 4; ++r) { float mx = -INFINITY; int me = 0;
#pragma unroll
                for (int e = 0; e < 32; ++e) { if (lv[e] > mx) { mx = lv[e]; me = e; } }
                tv[r] = mx; te[r] = me;
#pragma unroll
                for (int e = 0; e < 32; ++e) { if (e == me) lv[e] = -INFINITY; } }
            const float e1 = __expf(tv[1] - tv[0]), e2 = __expf(tv[2] - tv[0]), e3 = __expf(tv[3] - tv[0]); const float inv = 1.f / (1.f + e1 + e2 + e3);
            if (hi == 0) { const size_t o = (size_t)tokl * 4;
                const float gv[4] = {inv, e1 * inv, e2 * inv, e3 * inv};
#pragma unroll
                for (int r = 0; r < 4; ++r) { const unsigned rk = __hip_atomic_fetch_add(lcnt + (te[r] & 31), 1u, __ATOMIC_RELAXED, __HIP_MEMORY_SCOPE_WORKGROUP);
                    tope[o + r] = (unsigned)(te[r] & 31); gate[o + r] = gv[r]; rank[o + r] = rk; } } }
        __syncthreads();
        if (tid < 32) __hip_atomic_store(F.ctl + CW_CNT + chunk * 32 + tid, lcnt[tid], RLX_AGENT);
    }
}

DI void ph_route(const Fr& F) {
    const unsigned char* xb8 = F.ws + WS_XB8; unsigned char* xg = F.ws + WS_XG;
    const unsigned* tope = (const unsigned*)(F.ws + WS_TOPE); const unsigned* rank = (const unsigned*)(F.ws + WS_RANK); unsigned* dest = (unsigned*)(F.ws + WS_DEST);
    LAS unsigned* P = (LAS unsigned*)(F.lds); LAS unsigned* pst = P + 512; LAS unsigned* pad = P + 544; LAS unsigned* base = P + 576; LAS unsigned* nt = P + 608;
    const int tid = F.tid, lane = F.lane, wave = F.wave;
    __syncthreads();
    { const int e = tid & 31, part = tid >> 5; unsigned s = 0u;
        for (int c = 0; c < 16; ++c) s += ld_u32(F.ctl + CW_CNT + (part * 16 + c) * 32 + e);
        P[part * 32 + e] = s; }
    __syncthreads();
    if (tid < 32) { unsigned tot = 0u;
        for (int p = 0; p < 16; ++p) tot += P[p * 32 + tid];
        pad[tid] = (tot + 255u) & ~255u; }
    __syncthreads();
    if (tid == 0) { unsigned acc = 0u;
        for (int e = 0; e < 32; ++e) { pst[e] = acc; acc += pad[e]; }
        nt[0] = acc >> 8; }
    __syncthreads();
    for (int chunk = F.blk; chunk < 256; chunk += F.G) {
        __syncthreads();
        if (tid < 32) { unsigned off = 0u; const int pf = chunk >> 4;
            for (int p = 0; p < pf; ++p) off += P[p * 32 + tid];
            for (int c = pf * 16; c < chunk; ++c) off += ld_u32(F.ctl + CW_CNT + c * 32 + tid);
            base[tid] = pst[tid] + off; }
        __syncthreads();
#pragma unroll 1
        for (int i0 = 0; i0 < 16; i0 += 4) { v4u src[4]; unsigned ee[4][4], rr[4][4];
#pragma unroll
            for (int i = 0; i < 4; ++i) { const int tok = chunk * 128 + wave * 16 + i0 + i; src[i] = *((const v4u*)(xb8 + (size_t)tok * DM) + lane);
#pragma unroll
                for (int k = 0; k < 4; ++k) { ee[i][k] = tope[(size_t)tok * 4 + k]; rr[i][k] = rank[(size_t)tok * 4 + k]; } }
#pragma unroll
            for (int i = 0; i < 4; ++i) { const int tok = chunk * 128 + wave * 16 + i0 + i;
#pragma unroll
                for (int k = 0; k < 4; ++k) { const unsigned d = base[ee[i][k]] + rr[i][k];
                    if (lane == 0) dest[(size_t)tok * 4 + k] = d;
                    *((v4u*)(xg + (size_t)d * DM) + lane) = src[i]; } } }
        if (chunk == 0) { const unsigned ntl = nt[0];
            if (tid == 0) __hip_atomic_store(F.ctl + CW_TILE, ntl, RLX_AGENT);
            for (unsigned i = tid; i < ntl; i += NTHR) { unsigned e = 0u;
                for (unsigned k = 1; k < 32; ++k) if (pst[k] <= i * 256u) e = k;
                __hip_atomic_store(F.ctl + CW_TILE + 64 + i, e, RLX_AGENT); } }
    }
}

DI void ph_combine_ln2(const Args& a, const Fr& F, int layer) {
    const bf16* x1 = (const bf16*)(F.ws + WS_X1); const bf16* yr = (const bf16*)(F.ws + WS_XG); bf16* xb = (bf16*)(F.ws + WS_XB);
    const float* gate = (const float*)(F.ws + WS_GATE); const unsigned* dest = (const unsigned*)(F.ws + WS_DEST);
    const float* g = a.in[10] + (size_t)(layer * 2 + 1) * DM; const float* bb = a.in[11] + (size_t)(layer * 2 + 1) * DM;
    const int lane = F.lane; const int gw = F.blk * NWAVES + F.wave, NGW = F.G * NWAVES;
    for (int tok = gw; tok < NTOK; tok += 4 * NGW) { f32x4 v[4][4];
#pragma unroll
        for (int i = 0; i < 4; ++i) { const int tk = tok + i * NGW; if (tk < NTOK) {
#pragma unroll
            for (int jj = 0; jj < 4; ++jj) { const v2u w = *((const v2u*)(x1 + (size_t)tk * DM) + lane + 64 * jj);
                v[i][jj] = (f32x4){bf2f(w.x & 0xffffu), bf2f(w.x >> 16), bf2f(w.y & 0xffffu), bf2f(w.y >> 16)} * ALPHA; }
#pragma unroll
            for (int k = 0; k < 4; ++k) { const float gk = gate[(size_t)tk * 4 + k]; const unsigned d = dest[(size_t)tk * 4 + k];
#pragma unroll
                for (int jj = 0; jj < 4; ++jj) { const v2u w = *((const v2u*)(yr + (size_t)d * DM) + lane + 64 * jj);
                    v[i][jj][0] += gk * bf2f(w.x & 0xffffu); v[i][jj][1] += gk * bf2f(w.x >> 16); v[i][jj][2] += gk * bf2f(w.y & 0xffffu); v[i][jj][3] += gk * bf2f(w.y >> 16); } } } }
#pragma unroll
        for (int i = 0; i < 4; ++i) { const int tk = tok + i * NGW; if (tk < NTOK) {
            ln_row(v[i], g, bb, lane);
            if (layer == DEPTH - 1) store_row_f32(a.out + (size_t)tk * DM, v[i], lane);
            else store_row_bf16(xb + (size_t)tk * DM, v[i], lane); } } }
}
constexpr int LDS_BYTES = 147456;
constexpr int LDS_BARW = 145408, LDS_QSLOT = 145472, LDS_TILE_E = 133632;
constexpr int NPL = 11;
constexpr int NPHASE = 1 + NPL * DEPTH;
#ifndef MK_SINGLE
#define MK_SINGLE 1
#endif
DI int q_next(const Fr& F, unsigned* ctr) {
    LAS int* slot = (LAS int*)(F.lds + LDS_QSLOT);
    __syncthreads();
    if (F.tid == 0) *slot = (int)__hip_atomic_fetch_add(ctr, 1u, RLX_AGENT);
    __syncthreads();
    return *slot;
}
DI int lane_id_fresh() { unsigned m_ = ~0u; asm volatile("" : "+s"(m_)); return (int)__builtin_amdgcn_mbcnt_hi(m_, __builtin_amdgcn_mbcnt_lo(m_, 0u)); }
#define RETID(F) do { int t2_ = F.tid; asm volatile("" : "+v"(t2_)); F.tid = t2_; F.lane = t2_ & 63; F.wave = __builtin_amdgcn_readfirstlane(t2_ >> 6); } while (0)
#ifndef PROBE_DUP
#define PROBE_DUP -1
#endif
#define NREP(q) ((PROBE_DUP == (q)) ? 2 : 1)
#define AS4 __attribute__((address_space(4)))
#define SITE() Args a; Fr F; { const AS4 Args* ap = (const AS4 Args*)__builtin_amdgcn_kernarg_segment_ptr(); asm volatile("" : "+s"(ap)); \
        _Pragma("unroll") for (int i_ = 0; i_ < 18; ++i_) a.in[i_] = ap->in[i_]; a.out = ap->out; a.ws = ap->ws; a.ph_lo = 0; a.ph_hi = 0; \
        int w_ = wv_s; asm volatile("" : "+s"(w_)); int t_ = w_ * 64 + lane_id_fresh(); asm volatile("" : "+v"(t_)); F.tid = t_; F.lane = t_ & 63; F.wave = __builtin_amdgcn_readfirstlane(t_ >> 6); \
        F.lds = (LAS unsigned char*)lds_raw; F.ws = a.ws; F.ctl = (unsigned*)(a.ws + WS_CTL); F.blk = blockIdx.x; F.G = gridDim.x; }
__global__ void __launch_bounds__(NTHR, 2) mega_fwd(Args a0) {
    extern __shared__ __attribute__((aligned(16))) unsigned char lds_raw[];
    const int wv_s = __builtin_amdgcn_readfirstlane((int)(threadIdx.x >> 6));
#if MK_SINGLE
    constexpr int lo = 0, hi = NPHASE; constexpr bool single = true;
#else
    const int lo = a0.ph_lo, hi = a0.ph_hi; constexpr bool single = false;
#endif
    if (threadIdx.x == 0) *(LAS v4u*)((LAS unsigned char*)lds_raw + LDS_BARW) = (v4u){0u, 0u, 0u, 0u};
    __syncthreads();
    if (single) (void)xcd_barrier_post((unsigned*)(a0.ws + WS_CTL) + CW_BAR, (volatile LAS unsigned*)((LAS unsigned char*)lds_raw + LDS_BARW));
#define IN(k) (lo <= (k) && (k) < hi)
#define SEAM() do { if (single) { const AS4 Args* ap_ = (const AS4 Args*)__builtin_amdgcn_kernarg_segment_ptr(); asm volatile("" : "+s"(ap_)); int w_ = wv_s; asm volatile("" : "+s"(w_)); \
        XcdBarrier b_; b_.bar = (unsigned*)(ap_->ws + WS_CTL) + CW_BAR; b_.x = xb_xcc_id(); b_.st = (volatile LAS unsigned*)((LAS unsigned char*)lds_raw + LDS_BARW); \
        xcd_barrier(b_, (w_ == 0) && (lane_id_fresh() == 0)); } } while (0)
    if (IN(0)) { _Pragma("unroll 1") for (int rep = 0; rep < NREP(100); ++rep) { { SITE(); ph_prologue(a, F); } SEAM(); } }
#pragma clang loop unroll(full)
    for (int L = 0; L < DEPTH; ++L) {
        const int pb = 1 + NPL * L, j = L >> 1; const bool odd = (L & 1) != 0;
        if (IN(pb + 0)) _Pragma("unroll 1") for (int rep = 0; rep < NREP(0); ++rep) {
            { SITE();
            const bf16* w = odd ? (const bf16*)(F.ws + WS_WOD) + (size_t)j * OD_N * 1024 : (const bf16*)(F.ws + WS_WEV) + (size_t)j * EV_N * 1024;
            const int N = odd ? OD_N : EV_N;
            pg8::Gemm g{(const bf16*)(F.ws + WS_XB), w, NTOK, N, 1024}; pg8::StaticOrder S; S.init(NTOK, N, F.G, F.blk);
            pg8::EpiBf16<0> E{(bf16*)(F.ws + WS_PROJ), N, nullptr, 1024, (size_t)1024, C2F};
            pg8::gemm_phase<pg8::EpiBf16<0>, pg8::StaticOrder, true, true>(F.lds, g, S, E, F.tid); }
            SEAM(); }
        if (IN(pb + 1)) _Pragma("unroll 1") for (int rep = 0; rep < NREP(1); ++rep) { { SITE(); if (odd) ph_odd_prep(a, F, j, L); else ph_even_prep(a, F, j); } SEAM(); }
        if (!odd && IN(pb + 2)) _Pragma("unroll 1") for (int rep = 0; rep < ((PROBE_DUP == 2 || (PROBE_DUP >= 21 && PROBE_DUP <= 22) || (PROBE_DUP >= 211 && PROBE_DUP <= 217)) ? 2 : 1); ++rep) {
            { SITE(); unsigned* ctr = F.ctl + CW_Q + 64 * (L * 2) + 1024 * rep;
            for (;;) { const int it = q_next(F, ctr); if (it >= 1280) break; RETID(F);
                if (it < 1024) { if (!(rep == 1 && PROBE_DUP == 22)) idx_unit(F, it & 3, 255 - (it >> 2), (rep == 1 && PROBE_DUP >= 211) ? PROBE_DUP - 210 : 0); } else { if (!(rep == 1 && (PROBE_DUP == 21 || PROBE_DUP >= 211))) moba_gate_chunk(F, it - 1024); } } }
            SEAM(); }
        if (IN(pb + 3)) _Pragma("unroll 1") for (int rep = 0; rep < ((PROBE_DUP == 3 || (PROBE_DUP == 31 && odd) || ((PROBE_DUP == 32 || PROBE_DUP == 33) && !odd)) ? 2 : 1); ++rep) {
            { SITE(); unsigned* ctr = F.ctl + CW_Q + 64 * (L * 2 + 1) + 1024 * rep;
            if (odd) { for (;;) { const int it = q_next(F, ctr); if (it >= 2048) break; RETID(F); const int bh = it & 63; fox_unit(F, L, bh >> 4, bh & 15, 31 - (it >> 6)); } }
            else { for (;;) { const int it = q_next(F, ctr); if (it >= 2048) break; RETID(F);
                    if (it < 1024) { const int bh = it & 31; if (!(rep == 1 && PROBE_DUP == 33)) moba_unit(a, F, bh >> 3, bh & 7, it >> 5); } else { if (!(rep == 1 && PROBE_DUP == 32)) dsa_chunk(a, F, it - 1024); } } } }
            SEAM(); }
        if (!odd && IN(pb + 4)) _Pragma("unroll 1") for (int rep = 0; rep < NREP(4); ++rep) { { SITE(); ph_even_post(F, j); } SEAM(); }
        if (IN(pb + 5)) _Pragma("unroll 1") for (int rep = 0; rep < NREP(5); ++rep) {
            { SITE();
            pg8::Gemm g{(const bf16*)(F.ws + WS_AO), (const bf16*)(F.ws + WS_WOUT) + (size_t)L * 1024 * 1024, NTOK, 1024, 1024}; pg8::StaticOrder S; S.init(NTOK, 1024, F.G, F.blk);
            EpiResBf16 E{(const bf16*)(F.ws + WS_XB), (bf16*)(F.ws + WS_YP), ALPHA};
            pg8::gemm_phase<EpiResBf16, pg8::StaticOrder, true, true>(F.lds, g, S, E, F.tid); }
            SEAM(); }
        if (IN(pb + 6)) _Pragma("unroll 1") for (int rep = 0; rep < NREP(6); ++rep) { { SITE(); ph_ln1_router(a, F, L); } SEAM(); }
        if (IN(pb + 7)) _Pragma("unroll 1") for (int rep = 0; rep < NREP(7); ++rep) { { SITE(); ph_route(F); } SEAM(); }
        if (IN(pb + 8)) _Pragma("unroll 1") for (int rep = 0; rep < NREP(8); ++rep) {
            { SITE(); const int ntl = (int)ld_u32(F.ctl + CW_TILE);
            LAS unsigned* tle = (LAS unsigned*)(F.lds + LDS_TILE_E);
            for (int i = F.tid; i < ntl; i += NTHR) tle[i] = ld_u32(F.ctl + CW_TILE + 64 + i);
            __syncthreads();
            pg8::Gemm g{(const bf16*)(F.ws + WS_XG), (const bf16*)(F.ws + WS_WGU + (size_t)L * 32 * 2048 * 1024), NR_MAX, 32 * 2048, 512};
            GroupOrder S{tle, ntl, 3, F.G, F.blk};
            EpiSwiglu E{F.ws + WS_ACT, a.in[15] + (size_t)L * 32 * 2048};
            pg8::gemm_phase<EpiSwiglu, GroupOrder, true, true, true>(F.lds, g, S, E, F.tid); }
            SEAM(); }
        if (IN(pb + 9)) _Pragma("unroll 1") for (int rep = 0; rep < NREP(9); ++rep) {
            { SITE(); const int ntl = (int)ld_u32(F.ctl + CW_TILE);
            LAS unsigned* tle = (LAS unsigned*)(F.lds + LDS_TILE_E);
            for (int i = F.tid; i < ntl; i += NTHR) tle[i] = ld_u32(F.ctl + CW_TILE + 64 + i);
            __syncthreads();
            pg8::Gemm g{(const bf16*)(F.ws + WS_ACT), (const bf16*)(F.ws + WS_WDN + (size_t)L * 32 * 1024 * 1024), NR_MAX, 32 * 1024, 512};
            GroupOrder S{tle, ntl, 2, F.G, F.blk};
            EpiDown E{(bf16*)(F.ws + WS_XG), a.in[17] + (size_t)L * 32 * 1024};
            pg8::gemm_phase<EpiDown, GroupOrder, true, true, true>(F.lds, g, S, E, F.tid); }
            SEAM(); }
        if (IN(pb + 10)) _Pragma("unroll 1") for (int rep = 0; rep < NREP(10); ++rep) { { SITE(); ph_combine_ln2(a, F, L); } if (L + 1 < DEPTH || rep + 1 < NREP(10)) SEAM(); }
        if (PROBE_DUP == 900 && L + 1 < DEPTH) { _Pragma("unroll 1") for (int xb = 0; xb < 10; ++xb) SEAM(); }
    }
#undef IN
#undef SEAM
}

extern "C" void kernel_launch(void* const* d_in, const int* in_sizes, int n_in, void* d_out, int out_size, void* d_ws, size_t ws_size, hipStream_t stream) {
    static int grid = 0;
    if (grid == 0) {
        if (n_in != 18 || out_size != NTOK * DM || ws_size < WS_END) { fprintf(stderr, "kernel_launch: unexpected shapes (n_in %d, out %d, ws %zu); nothing launched\n", n_in, out_size, ws_size); grid = -1; return; }
        int dev = 0, cus = 0, per_cu = 0;
        if (hipGetDevice(&dev) != hipSuccess || hipDeviceGetAttribute(&cus, hipDeviceAttributeMultiprocessorCount, dev) != hipSuccess) { grid = -1; return; }
        if (hipFuncSetAttribute((const void*)mega_fwd, hipFuncAttributeMaxDynamicSharedMemorySize, LDS_BYTES) != hipSuccess) { fprintf(stderr, "kernel_launch: hipFuncSetAttribute failed\n"); grid = -1; return; }
        if (hipOccupancyMaxActiveBlocksPerMultiprocessor(&per_cu, (const void*)mega_fwd, NTHR, LDS_BYTES) != hipSuccess || per_cu < 1) fprintf(stderr, "kernel_launch: occupancy query reports %d\n", per_cu);
        (void)hipGetLastError();
        grid = cus;
    }
    if (grid < 0) return;
    (void)hipMemsetAsync((char*)d_ws + WS_CTL, 0, CTL_ZERO_BYTES, stream);
#ifdef EXP_SKIP
    (void)hipMemsetAsync((char*)d_ws + WS_AO, 0, 64 * MiB, stream);
    (void)hipMemsetAsync((char*)d_ws + WS_OL, 0, 64 * MiB, stream);
    if (EXP_SKIP & 4) { (void)hipMemsetAsync((char*)d_ws + WS_XG, 0, 272 * MiB, stream); (void)hipMemsetAsync((char*)d_ws + WS_DEST, 0, 1 * MiB, stream); }
#endif
    Args a{};
    for (int i = 0; i < 18; ++i) a.in[i] = (const float*)d_in[i];
    a.out = (float*)d_out; a.ws = (unsigned char*)d_ws;
#if MK_SINGLE
    a.ph_lo = 0; a.ph_hi = NPHASE;
    hipLaunchKernelGGL(mega_fwd, dim3(grid), dim3(NTHR), LDS_BYTES, stream, a);
#else
    for (int p = 0; p < NPHASE; ++p) {
        if (p > 0) { const int L = (p - 1) / NPL, q = (p - 1) % NPL; if ((L & 1) && (q == 2 || q == 4)) continue;
#ifdef EXP_SKIP
            if ((EXP_SKIP & 1) && !(L & 1) && q <= 4) continue;
            if ((EXP_SKIP & 2) && (L & 1) && q <= 4) continue;
            if ((EXP_SKIP & 4) && q >= 7 && q <= 9) continue;
#endif
        }
        a.ph_lo = p; a.ph_hi = p + 1;
        hipLaunchKernelGGL(mega_fwd, dim3(grid), dim3(NTHR), LDS_BYTES, stream, a);
    }
#endif
}
```

```cpp
#include <hip/hip_runtime.h>
#include <cstdio>
#include <cstdint>
#ifdef EXP_SKIP
#define EXPF EXP_SKIP
#else
#define EXPF 0
#endif
constexpr int NB = 4, SEQ = 8192, DM = 1024, NTOK = NB * SEQ, DEPTH = 4;
constexpr int EV_N = 2560, OD_N = 3072;
constexpr int EC_QA = 0, EC_QB = 512, EC_KB = 1024, EC_VB = 1536, EC_CKV = 2048, EC_QI = 2176, EC_KI = 2432, EC_WI = 2496;
constexpr int OC_Q = 0, OC_K = 1024, OC_V = 2048;
constexpr float LOG2E = 1.4426950408889634f;
constexpr float C2F = 0.125f * LOG2E;
constexpr float ALPHA = 1.681792830507429f;
constexpr float LN_EPS = 1e-5f;
constexpr int NR_MAX = 131072 + 32 * 256;
constexpr int NWAVES = 8, NTHR = 512;
constexpr size_t MiB = (size_t)1 << 20;
constexpr size_t WS_CTL = 0, CTL_ZERO_BYTES = 4 * MiB;
constexpr size_t WS_WEV = 8 * MiB, WS_WOD = 18 * MiB, WS_WOUT = 30 * MiB, WS_WUKT = 38 * MiB, WS_WUVT = 39 * MiB;
constexpr size_t WS_WGU = 40 * MiB, WS_WDN = 552 * MiB;
constexpr size_t WS_X = 808 * MiB, WS_X1 = 936 * MiB, WS_YP = 1064 * MiB, WS_XB = 1192 * MiB;
constexpr size_t WS_PROJ = 1256 * MiB, WS_AO = 1448 * MiB, WS_XG = 1512 * MiB, WS_ACT = 1784 * MiB;
constexpr size_t WS_QL = 2056 * MiB, WS_OL = 2120 * MiB, WS_CKVN = 2184 * MiB, WS_SEL = 2192 * MiB;
constexpr size_t WS_KBAR = 2208 * MiB, WS_SEL3 = 2209 * MiB, WS_LOGF = 2210 * MiB, WS_CS = 2212 * MiB;
constexpr size_t WS_TOPE = 2213 * MiB, WS_GATE = 2214 * MiB, WS_RANK = 2215 * MiB, WS_DEST = 2216 * MiB, WS_PML = 2217 * MiB;
constexpr size_t WS_XB8 = 2226 * MiB;
constexpr size_t WS_KIC = 2258 * MiB;
constexpr size_t WS_END = 2262 * MiB;
constexpr float F8_SX = 16.f, F8_SWG = 256.f, F8_SA = 4.f, F8_SWD = 512.f, F8_SY = 32.f;
constexpr int CW_BAR = 4096, CW_Q = 8192, CW_KMAX = 12288, CW_CNT = 16384, CW_TILE = 32768;

#define GAS __attribute__((address_space(1)))
#define LAS __attribute__((address_space(3)))
#define DI __device__ __forceinline__
typedef unsigned short bf16;
typedef unsigned v4u __attribute__((ext_vector_type(4)));
typedef unsigned v2u __attribute__((ext_vector_type(2)));
typedef float f32x4 __attribute__((ext_vector_type(4)));
typedef float f32x2 __attribute__((ext_vector_type(2)));
typedef float f32x16 __attribute__((ext_vector_type(16)));
typedef short bf16x8 __attribute__((ext_vector_type(8)));
typedef short s16x4 __attribute__((ext_vector_type(4)));
typedef __bf16 bf16x2_t __attribute__((ext_vector_type(2)));
typedef GAS unsigned gu32;
#define RLX_AGENT __ATOMIC_RELAXED, __HIP_MEMORY_SCOPE_AGENT
#define LDS_WAIT() asm volatile("s_waitcnt lgkmcnt(0)" ::: "memory")

DI float bf2f(unsigned v) { return __uint_as_float(v << 16); }
DI unsigned cvtpk(float lo, float hi) { f32x2 v = {lo, hi}; bf16x2_t b = __builtin_convertvector(v, bf16x2_t); return __builtin_bit_cast(unsigned, b); }
DI unsigned f2bf(float f) { return cvtpk(f, 0.f) & 0xffffu; }
DI unsigned pk4_fp8(float a, float b, float c, float d) {
    a = fminf(fmaxf(a, -448.f), 448.f); b = fminf(fmaxf(b, -448.f), 448.f); c = fminf(fmaxf(c, -448.f), 448.f); d = fminf(fmaxf(d, -448.f), 448.f);
    int w = 0; w = __builtin_amdgcn_cvt_pk_fp8_f32(a, b, w, false); w = __builtin_amdgcn_cvt_pk_fp8_f32(c, d, w, true); return (unsigned)w; }
DI float ex2(float x) { return __builtin_amdgcn_exp2f(x); }
DI float wave_sum(float v) {
#pragma unroll
    for (int o = 1; o < 64; o <<= 1) v += __shfl_xor(v, o);
    return v;
}
DI float wave_max(float v) {
#pragma unroll
    for (int o = 1; o < 64; o <<= 1) v = fmaxf(v, __shfl_xor(v, o));
    return v;
}
DI unsigned ld_u32(const unsigned* p) { return __hip_atomic_load(p, RLX_AGENT); }
DI int crow(int r, int hi) { return (r & 3) + 8 * (r >> 2) + 4 * hi; }
DI f32x16 mfma32(bf16x8 a, bf16x8 b, f32x16 c) { return __builtin_amdgcn_mfma_f32_32x32x16_bf16(a, b, c, 0, 0, 0); }
DI f32x4 mfma16(bf16x8 a, bf16x8 b, f32x4 c) { return __builtin_amdgcn_mfma_f32_16x16x32_bf16(a, b, c, 0, 0, 0); }
typedef short v4i16_t __attribute__((ext_vector_type(4)));
DI s16x4 vtr(LAS const char* p) { return __builtin_bit_cast(s16x4, __builtin_amdgcn_ds_read_tr16_b64_v4i16((LAS v4i16_t*)p)); }
DI bf16x8 cat8(s16x4 a, s16x4 b) { return (bf16x8){a[0], a[1], a[2], a[3], b[0], b[1], b[2], b[3]}; }
DI int t5_bucket(int n) {
    if (n < 16) return n;
    int bkt = 16;
    bkt += (n >= 21); bkt += (n >= 27); bkt += (n >= 35); bkt += (n >= 46); bkt += (n >= 59); bkt += (n >= 77); bkt += (n >= 99); bkt += (n >= 128);
    bkt += (n >= 166); bkt += (n >= 216); bkt += (n >= 280); bkt += (n >= 363); bkt += (n >= 470); bkt += (n >= 609); bkt += (n >= 790);
    return bkt;
}
namespace pg8 {
#define PG8_LAS __attribute__((address_space(3)))
typedef unsigned short bf16_t;
typedef short bf16x8 __attribute__((ext_vector_type(8)));
typedef float f32x4 __attribute__((ext_vector_type(4)));
typedef unsigned u32x4 __attribute__((ext_vector_type(4)));
constexpr int BM = 256, BK = 64, HALF = 128, HTB = HALF * BK * 2  , STAGE_BYTES = 8 * HTB, NXCD = 8, WGM = 8;

__host__ __device__ __forceinline__ int lds_byte(int r, int c) { const int st = (r >> 4) * 2 + (c >> 5), rr = r & 15, cc = c & 31, ob = rr * 64 + cc * 2; return st * 1024 + (ob ^ (((ob >> 9) & 1) << 5)); }
__host__ __device__ __forceinline__ void stage_rc(int b, int& R, int& C) { const int st = b / 1024, sb = b % 1024, swz = sb ^ (((sb >> 9) & 1) << 5); R = (st >> 1) * 16 + swz / 64; C = (st & 1) * 32 + (swz % 64) / 2; }
__host__ __device__ __forceinline__ int perm32(int rho) { const int n = rho >> 4, i = rho & 15; return 8 * (i >> 2) + 4 * n + (i & 3); }

typedef int i32x8 __attribute__((ext_vector_type(8))); typedef int i32x4v __attribute__((ext_vector_type(4)));
__device__ __forceinline__ i32x8 pg8_cat8(bf16x8 lo, bf16x8 hi) { const i32x4v a = __builtin_bit_cast(i32x4v, lo), b = __builtin_bit_cast(i32x4v, hi); return (i32x8){a[0], a[1], a[2], a[3], b[0], b[1], b[2], b[3]}; }
struct Unit { int pm, pn; };
struct Gemm { const bf16_t* A; const bf16_t* Bt; int M, N, K; };

struct StaticOrder {
    int nM, nN, nwg, G, c;
    __host__ __device__ void init(int M, int N, int G_, int c_) { nM = M / BM; nN = N / BM; nwg = nM * nN; G = G_; c = c_; }
    __host__ __device__ bool next(int i, Unit& u) const {
        const long L = (long)i * G + c; if (L >= nwg) return false;
        int wgid = (int)L; { const int q = nwg / NXCD, r = nwg % NXCD, xcd = wgid % NXCD, off = wgid / NXCD; wgid = (xcd < r ? xcd * (q + 1) : r * (q + 1) + (xcd - r) * q) + off; }
        const int nig = WGM * nN, gid = wgid / nig, fm = gid * WGM, gsz = (nM - fm) < WGM ? (nM - fm) : WGM;
        u.pm = fm + ((wgid % nig) % gsz); u.pn = (wgid % nig) / gsz; return true;
    }
    __device__ __forceinline__ void a_ready(const Unit&) const {}
    __device__ __forceinline__ void done(const Unit&) const {}
};

__device__ __forceinline__ unsigned cvt_pk_bf16(float lo, float hi) { unsigned r; asm volatile("v_cvt_pk_bf16_f32 %0, %1, %2" : "=v"(r) : "v"(lo), "v"(hi)); return r; }
typedef float f32x2 __attribute__((ext_vector_type(2)));
__device__ __forceinline__ f32x2 gelu_pk(f32x2 v) {
    const f32x2 av = __builtin_elementwise_abs(v), d = av * 0.2316418882f + 1.0f;
    f32x2 t; t.x = __builtin_amdgcn_rcpf(d.x); t.y = __builtin_amdgcn_rcpf(d.y);
    f32x2 q = t * 0.5307027145f + (-0.7265760135f); q = q * t + 0.7107068705f; q = q * t + (-0.142248368f); q = q * t + 0.127414796f; q = q * t;
    const f32x2 s = (v * v) * (-0.72134752044f);
    f32x2 e; e.x = __builtin_amdgcn_exp2f(s.x); e.y = __builtin_amdgcn_exp2f(s.y);
    const f32x2 m = v * (q * e), r = v - m;
    f32x2 o; o.x = v.x < 0.f ? m.x : r.x; o.y = v.y < 0.f ? m.y : r.y; return o;
}

template <int ACT  > struct EpiBf16 {
    static constexpr bool PERM = true, AFTER_DRAIN = false; static_assert(ACT == 0 || ACT == 1, "EpiBf16: ACT is 0 (none) or 1 (gelu_pk)");
    bf16_t* O; int ldc; const float* bias; int split_cols; size_t split_stride; float scale0;
    __device__ __forceinline__ void operator()(const f32x4 (&acc)[2][2][4][2], const Unit& u, int wr, int wc, int fr, int fq) const {
        const int row0 = u.pm * BM + wr * 64 + fr; int colt = u.pn * BM; bf16_t* base = O;
        float sc = 1.f; if (split_cols) { const int t = colt / split_cols; base += (size_t)t * split_stride; colt -= t * split_cols; if (t == 0) sc = scale0; }
        const int col0 = colt + wc * 32 + 8 * fq, bcol0 = u.pn * BM + wc * 32 + 8 * fq;
        f32x4 bv[2][2];
#pragma unroll
        for (int bj = 0; bj < 2; ++bj)
#pragma unroll
            for (int n = 0; n < 2; ++n) bv[bj][n] = bias ? *(const f32x4*)(bias + bcol0 + bj * HALF + 4 * n) : (f32x4){0.f, 0.f, 0.f, 0.f};
#pragma unroll
        for (int ai = 0; ai < 2; ++ai)
#pragma unroll
            for (int m = 0; m < 4; ++m) { bf16_t* rowp = base + (size_t)(row0 + ai * HALF + m * 16) * ldc + col0;
#pragma unroll
                for (int bj = 0; bj < 2; ++bj) { f32x4 v0 = acc[ai][bj][m][0] + bv[bj][0], v1 = acc[ai][bj][m][1] + bv[bj][1];
                    if (ACT == 1) { f32x2 a = gelu_pk((f32x2){v0[0], v0[1]}), b = gelu_pk((f32x2){v0[2], v0[3]}), c = gelu_pk((f32x2){v1[0], v1[1]}), d = gelu_pk((f32x2){v1[2], v1[3]});
                        v0 = (f32x4){a.x, a.y, b.x, b.y}; v1 = (f32x4){c.x, c.y, d.x, d.y}; }
                    v0 = v0 * sc; v1 = v1 * sc; u32x4 w; w.x = cvt_pk_bf16(v0[0], v0[1]); w.y = cvt_pk_bf16(v0[2], v0[3]); w.z = cvt_pk_bf16(v1[0], v1[1]); w.w = cvt_pk_bf16(v1[2], v1[3]);
                    *(u32x4*)(rowp + bj * HALF) = w; } }
    }
};

template <class Epi, class Sched, bool ALIGN_EPI = false, bool SP2 = false, bool F8 = false>
__device__ __forceinline__ void gemm_phase(PG8_LAS unsigned char* lds, const Gemm g, const Sched& S, const Epi& E, int tid_in) {
    int tid_l = tid_in; asm volatile("" : "+v"(tid_l));
    const int tid = tid_l, wid = __builtin_amdgcn_readfirstlane(tid >> 6), lane = tid & 63, wr = wid >> 2, wc = wid & 3, fr = lane & 15, fq = lane >> 4;
    const int K = g.K, nt = K / BK;
    unsigned voffA[2], voffB[2];
#pragma unroll
    for (int i = 0; i < 2; ++i) { int R, C; stage_rc(tid * 16 + i * 8192, R, C); const int Rb = Epi::PERM ? ((R & ~31) + perm32(R & 31)) : R;
        voffA[i] = (unsigned)(R * K + C) * 2u; voffB[i] = (unsigned)(Rb * K + C) * 2u; }
    const size_t kstep = (size_t)(BK * 2);
    const size_t hstep = (size_t)HALF * K * 2;
    const size_t tstep = 2 * hstep;
    const unsigned ldsw = (unsigned)wid * 1024u;
    const int aoff = lds_byte(wr * 64 + fr, fq * 8), boff = lds_byte(wc * 32 + fr, fq * 8);
#define PG8_SA(b, h) (((b) * 2 + (h)) * HTB)
#define PG8_SB(b, h) ((4 + (b) * 2 + (h)) * HTB)
#define PG8_STAGE(bufoff, gbase, voff) do { _Pragma("unroll") for (int _i = 0; _i < 2; ++_i) \
        __builtin_amdgcn_global_load_lds((const unsigned*)((const char*)(gbase) + (voff)[_i]), (PG8_LAS unsigned*)(lds + (bufoff) + ldsw + _i * 8192), 16, 0, 0); } while (0)
#define PG8_LDA(dst, b, h) do { _Pragma("unroll") for (int m = 0; m < 4; ++m) _Pragma("unroll") for (int k = 0; k < 2; ++k) dst[m][k] = *(const PG8_LAS bf16x8*)(lds + PG8_SA(b, h) + aoff + m * 2048 + k * 1024); } while (0)
#define PG8_LDB(dst, b, h) do { _Pragma("unroll") for (int n = 0; n < 2; ++n) _Pragma("unroll") for (int k = 0; k < 2; ++k) dst[n][k] = *(const PG8_LAS bf16x8*)(lds + PG8_SB(b, h) + boff + n * 2048 + k * 1024); } while (0)
#define PG8_MMA(ai, bj, At, Bt) do { __builtin_amdgcn_s_setprio(1); if constexpr (!F8) { _Pragma("unroll") for (int m = 0; m < 4; ++m) _Pragma("unroll") for (int n = 0; n < 2; ++n) _Pragma("unroll") for (int k = 0; k < 2; ++k) \
        acc[ai][bj][m][n] = __builtin_amdgcn_mfma_f32_16x16x32_bf16(Bt[n][k], At[m][k], acc[ai][bj][m][n], 0, 0, 0); } else { _Pragma("unroll") for (int m = 0; m < 4; ++m) _Pragma("unroll") for (int n = 0; n < 2; ++n) \
        acc[ai][bj][m][n] = __builtin_amdgcn_mfma_scale_f32_16x16x128_f8f6f4(pg8_cat8(Bt[n][0], Bt[n][1]), pg8_cat8(At[m][0], At[m][1]), acc[ai][bj][m][n], 0, 0, 0, 0x7F7F7F7F, 0, 0x7F7F7F7F); \
        _Pragma("unroll") for (int m = 0; m < 4; ++m) _Pragma("unroll") for (int n = 0; n < 2; ++n) asm volatile("" : "+v"(acc[ai][bj][m][n]));   } __builtin_amdgcn_s_setprio(0); } while (0)
#define PG8_WAIT_V(n) asm volatile("s_waitcnt vmcnt(" #n ")" ::: "memory")
#define PG8_WAIT_L(n) asm volatile("s_waitcnt lgkmcnt(" #n ")" ::: "memory")
#define PG8_BAR __builtin_amdgcn_s_barrier()
#define PG8_SCHED __builtin_amdgcn_sched_barrier(0)
    Unit cur, nxt; int ui = 0;
    if (!S.next(0, cur)) return;
    f32x4 acc[2][2][4][2];
#pragma unroll
    for (int a = 0; a < 2; ++a)
#pragma unroll
        for (int b = 0; b < 2; ++b)
#pragma unroll
            for (int m = 0; m < 4; ++m)
#pragma unroll
                for (int n = 0; n < 2; ++n) acc[a][b][m][n] = (f32x4){0.f, 0.f, 0.f, 0.f};
    bf16x8 At[4][2], B0[2][2], B1[2][2];
    const char* cA = (const char*)g.A + (size_t)cur.pm * tstep; const char* cB = (const char*)g.Bt + (size_t)cur.pn * tstep;
    S.a_ready(cur);
    if constexpr (SP2) {
        PG8_STAGE(PG8_SB(0, 0), cB, voffB); PG8_STAGE(PG8_SB(0, 1), cB + hstep, voffB); PG8_STAGE(PG8_SA(0, 0), cA, voffA); PG8_STAGE(PG8_SA(0, 1), cA + hstep, voffA);
        if (wr == 1) PG8_BAR;
        PG8_WAIT_V(2); PG8_BAR;
        PG8_STAGE(PG8_SB(1, 0), cB + kstep, voffB); PG8_STAGE(PG8_SA(1, 0), cA + kstep, voffA); PG8_STAGE(PG8_SB(1, 1), cB + hstep + kstep, voffB);
        PG8_WAIT_V(6); PG8_BAR;
    } else {
        PG8_STAGE(PG8_SB(0, 0), cB, voffB); PG8_STAGE(PG8_SA(0, 0), cA, voffA); PG8_STAGE(PG8_SB(0, 1), cB + hstep, voffB); PG8_STAGE(PG8_SA(0, 1), cA + hstep, voffA);
        if (wr == 1) PG8_BAR;
        PG8_WAIT_V(4); PG8_BAR;
        PG8_STAGE(PG8_SB(1, 0), cB + kstep, voffB); PG8_STAGE(PG8_SA(1, 0), cA + kstep, voffA); PG8_STAGE(PG8_SB(1, 1), cB + hstep + kstep, voffB);
        PG8_WAIT_V(6); PG8_BAR;
    }
    for (;;) {
        const bool has_next = S.next(ui + 1, nxt);
        const char* nA = has_next ? (const char*)g.A + (size_t)nxt.pm * tstep : cA; const char* nB = has_next ? (const char*)g.Bt + (size_t)nxt.pn * tstep : cB;
        for (int t = 0; t < nt; t += 2) {
            const bool last = (t == nt - 2);
            const char* a1 = cA + (size_t)(t + 1) * kstep;
            const char* a2 = last ? nA : cA + (size_t)(t + 2) * kstep; const char* b2 = last ? nB : cB + (size_t)(t + 2) * kstep;
            const char* a3 = a2 + kstep; const char* b3 = b2 + kstep;
            if (last && has_next) S.a_ready(nxt);
            if constexpr (SP2) {
            PG8_LDB(B0, 0, 0); PG8_LDB(B1, 0, 1); PG8_SCHED; PG8_LDA(At, 0, 0); PG8_STAGE(PG8_SA(1, 1), a1 + hstep, voffA);
            PG8_WAIT_V(8); PG8_WAIT_L(0); PG8_BAR; PG8_MMA(0, 0, At, B0); PG8_MMA(0, 1, At, B1); PG8_BAR; PG8_SCHED;
            PG8_LDA(At, 0, 1); PG8_STAGE(PG8_SB(0, 0), b2, voffB); PG8_STAGE(PG8_SB(0, 1), b2 + hstep, voffB); PG8_STAGE(PG8_SA(0, 0), a2, voffA);
            PG8_WAIT_V(8); PG8_WAIT_L(0); PG8_BAR; PG8_MMA(1, 0, At, B0); PG8_MMA(1, 1, At, B1); PG8_BAR; PG8_SCHED;
            PG8_LDB(B0, 1, 0); PG8_LDB(B1, 1, 1); PG8_SCHED; PG8_LDA(At, 1, 0); PG8_STAGE(PG8_SA(0, 1), a2 + hstep, voffA);
            PG8_WAIT_V(8); PG8_WAIT_L(0); PG8_BAR; PG8_MMA(0, 0, At, B0); PG8_MMA(0, 1, At, B1); PG8_BAR; PG8_SCHED;
            PG8_LDA(At, 1, 1); PG8_STAGE(PG8_SB(1, 0), b3, voffB); PG8_STAGE(PG8_SB(1, 1), b3 + hstep, voffB); PG8_STAGE(PG8_SA(1, 0), a3, voffA);
            PG8_WAIT_V(8); PG8_WAIT_L(0); PG8_BAR; PG8_MMA(1, 0, At, B0); PG8_MMA(1, 1, At, B1); PG8_BAR; PG8_SCHED;
            } else {
            PG8_LDB(B0, 0, 0); PG8_SCHED; PG8_LDA(At, 0, 0); PG8_STAGE(PG8_SA(1, 1), a1 + hstep, voffA);
            PG8_WAIT_L(8); PG8_BAR; PG8_WAIT_L(0); PG8_MMA(0, 0, At, B0); PG8_BAR; PG8_SCHED;
            PG8_LDB(B1, 0, 1); PG8_STAGE(PG8_SB(0, 0), b2, voffB);
            PG8_BAR; PG8_WAIT_L(0); PG8_MMA(0, 1, At, B1); PG8_BAR;
            PG8_LDA(At, 0, 1); PG8_STAGE(PG8_SA(0, 0), a2, voffA);
            PG8_BAR; PG8_WAIT_L(0); PG8_MMA(1, 0, At, B0); PG8_BAR; PG8_SCHED;
            PG8_STAGE(PG8_SB(0, 1), b2 + hstep, voffB);
            PG8_WAIT_V(6); PG8_BAR; PG8_MMA(1, 1, At, B1); PG8_BAR;
            PG8_LDB(B0, 1, 0); PG8_SCHED; PG8_LDA(At, 1, 0); PG8_STAGE(PG8_SA(0, 1), a2 + hstep, voffA);
            PG8_WAIT_L(8); PG8_BAR; PG8_WAIT_L(0); PG8_MMA(0, 0, At, B0); PG8_BAR; PG8_SCHED;
            PG8_LDB(B1, 1, 1); PG8_STAGE(PG8_SB(1, 0), b3, voffB);
            PG8_BAR; PG8_WAIT_L(0); PG8_MMA(0, 1, At, B1); PG8_BAR;
            PG8_LDA(At, 1, 1); PG8_STAGE(PG8_SA(1, 0), a3, voffA);
            PG8_BAR; PG8_WAIT_L(0); PG8_MMA(1, 0, At, B0); PG8_BAR; PG8_SCHED;
            PG8_STAGE(PG8_SB(1, 1), b3 + hstep, voffB);
            PG8_WAIT_V(6); PG8_BAR; PG8_MMA(1, 1, At, B1); PG8_BAR;
            }
        }
        if constexpr (ALIGN_EPI) { if (wr == 0) PG8_BAR; }
        if constexpr (!Epi::AFTER_DRAIN) { E(acc, cur, wr, wc, fr, fq); S.done(cur); }
        if (!has_next) break;
#pragma unroll
        for (int a = 0; a < 2; ++a)
#pragma unroll
            for (int b = 0; b < 2; ++b)
#pragma unroll
                for (int m = 0; m < 4; ++m)
#pragma unroll
                    for (int n = 0; n < 2; ++n) acc[a][b][m][n] = (f32x4){0.f, 0.f, 0.f, 0.f};
        cur = nxt; cA = nA; cB = nB; ++ui;
        if constexpr (ALIGN_EPI) { if (wr == 1) PG8_BAR; }
    }
    PG8_WAIT_V(0);
    if constexpr (!ALIGN_EPI) { if (wr == 0) PG8_BAR; }
    PG8_BAR;
    if constexpr (Epi::AFTER_DRAIN) { E.fused(acc, cur, wr, wc, fr, fq, lds, wid, lane); S.done(cur); }
#undef PG8_SA
#undef PG8_SB
#undef PG8_STAGE
#undef PG8_LDA
#undef PG8_LDB
#undef PG8_MMA
#undef PG8_WAIT_V
#undef PG8_WAIT_L
#undef PG8_BAR
#undef PG8_SCHED
}
}

#ifndef PG8_SP2
#define PG8_SP2 true
#endif
#ifndef PG8_ALIGN
#define PG8_ALIGN true
#endif
#define XB_TMO      128
#define XB_XCNT(j)  (256  + 64 * (j))
#define XB_XSUB(j)  (1280 + 64 * (j))
#define XB_XGEN(j)  (2304 + 64 * (j))
#define XB_TOP      3328
#define XB_TOPGEN   3392
#define XCD_BAR_WORDS 3456
#define XB_SPIN_CAP (1u << 18)

__device__ __forceinline__ unsigned xb_ld(unsigned* p)              { return __hip_atomic_load(p, __ATOMIC_RELAXED, __HIP_MEMORY_SCOPE_AGENT); }
__device__ __forceinline__ unsigned xb_add(unsigned* p, unsigned v) { return __hip_atomic_fetch_add(p, v, __ATOMIC_RELAXED, __HIP_MEMORY_SCOPE_AGENT); }
__device__ __forceinline__ unsigned xb_xcc_id() { return (unsigned)__builtin_amdgcn_s_getreg((3 << 11) | 20) & 0xFu; }
#define XB_SPIN(cond, bar) do { unsigned _sp = 0; while (cond) { __builtin_amdgcn_s_sleep(1); \
    if ((++_sp & 255u) == 0u) { if (xb_ld(&(bar)[XB_TMO])) break; if (_sp > XB_SPIN_CAP) { atomicAdd(&(bar)[XB_TMO], 1u); break; } } } } while (0)

struct XcdBarrier {
    unsigned* bar; unsigned x;
    volatile LAS unsigned* st;
};

__device__ __forceinline__ XcdBarrier xcd_barrier_post(unsigned* bar, volatile LAS unsigned* st) {
    XcdBarrier b; b.bar = bar; b.x = xb_xcc_id(); b.st = st;
    if (threadIdx.x == 0) (void)xb_add(&bar[XB_XCNT(b.x)], 1u);
    return b;
}
__device__ __forceinline__ void xcd_barrier_complete(unsigned* bar, unsigned x, unsigned& nloc, unsigned& nx) {
    const unsigned G = gridDim.x * gridDim.y * gridDim.z;
    unsigned sum, cnt, mine, sp = 0u;
    for (;;) {
        sum = 0u; cnt = 0u; mine = 0u;
#pragma unroll
        for (unsigned j = 0; j < 16; ++j) { const unsigned c = xb_ld(&bar[XB_XCNT(j)]); sum += c; cnt += (c > 0u) ? 1u : 0u; mine = (j == x) ? c : mine; }
        if (sum == G) break;
        __builtin_amdgcn_s_sleep(1);
        if ((++sp & 255u) == 0u) { if (xb_ld(&bar[XB_TMO])) break; if (sp > XB_SPIN_CAP) { atomicAdd(&bar[XB_TMO], 1u); break; } }
    }
    nloc = mine > 0u ? mine : 1u; nx = cnt > 0u ? cnt : 1u;
}

__device__ __forceinline__ void xcd_barrier(const XcdBarrier& b, const bool is_t0  ) {
    asm volatile("s_waitcnt vmcnt(0)" ::: "memory");
    __syncthreads();
    if (is_t0) {
        unsigned* bar = b.bar;
        __builtin_amdgcn_s_waitcnt(0);
        unsigned nloc = b.st[0], nx = b.st[1];
        if (nloc == 0u) { xcd_barrier_complete(bar, b.x, nloc, nx); b.st[0] = nloc; b.st[1] = nx; }
        const unsigned old = xb_add(&bar[XB_XSUB(b.x)], 1u);
        const unsigned gen = old / nloc;
        if (old + 1u == (gen + 1u) * nloc) {
            __builtin_amdgcn_fence(__ATOMIC_RELEASE, "agent");
            asm volatile("s_waitcnt vmcnt(0)" ::: "memory");
            const unsigned og = xb_add(&bar[XB_TOP], 1u);
            const unsigned tg = og / nx;
            if (og + 1u == (tg + 1u) * nx) xb_add(&bar[XB_TOPGEN], 1u);
            else XB_SPIN(xb_ld(&bar[XB_TOPGEN]) == tg, bar);
            __builtin_amdgcn_fence(__ATOMIC_ACQUIRE, "agent");
            xb_add(&bar[XB_XGEN(b.x)], 1u);
            asm volatile("s_waitcnt vmcnt(0)" ::: "memory");
        } else {
            XB_SPIN(xb_ld(&bar[XB_XGEN(b.x)]) == gen, bar);
            __builtin_amdgcn_fence(__ATOMIC_ACQUIRE, "agent");
            asm volatile("s_waitcnt vmcnt(0)" ::: "memory");
        }
    }
    __syncthreads();
}
struct EpiResBf16 {
    static constexpr bool PERM = true, AFTER_DRAIN = false;
    const bf16* xin; bf16* yp; float alpha;
    DI void operator()(const pg8::f32x4 (&acc)[2][2][4][2], const pg8::Unit& u, int wr, int wc, int fr, int fq) const {
        const int row0 = u.pm * 256 + wr * 64 + fr, col0 = u.pn * 256 + wc * 32 + 8 * fq;
#pragma unroll
        for (int ai = 0; ai < 2; ++ai)
#pragma unroll
            for (int m = 0; m < 4; ++m) {
                const size_t ro = (size_t)(row0 + ai * 128 + m * 16) * DM;
#pragma unroll
                for (int bj = 0; bj < 2; ++bj) {
                    const size_t o = ro + col0 + bj * 128;
                    const v4u xv = *(const v4u*)(xin + o);
                    const f32x4 a0 = acc[ai][bj][m][0], a1 = acc[ai][bj][m][1];
                    v4u w;
                    w.x = cvtpk(bf2f(xv.x & 0xffffu) * alpha + a0[0], bf2f(xv.x >> 16) * alpha + a0[1]); w.y = cvtpk(bf2f(xv.y & 0xffffu) * alpha + a0[2], bf2f(xv.y >> 16) * alpha + a0[3]);
                    w.z = cvtpk(bf2f(xv.z & 0xffffu) * alpha + a1[0], bf2f(xv.z >> 16) * alpha + a1[1]); w.w = cvtpk(bf2f(xv.w & 0xffffu) * alpha + a1[2], bf2f(xv.w >> 16) * alpha + a1[3]);
                    *(v4u*)(yp + o) = w;
                }
            }
    }
};
struct EpiSwiglu {
    static constexpr bool PERM = true, AFTER_DRAIN = false;
    unsigned char* act; const float* bgu;
    DI void operator()(const pg8::f32x4 (&acc)[2][2][4][2], const pg8::Unit& u, int wr, int wc, int fr, int fq) const {
        const int e = u.pn >> 3, pl = u.pn & 7;
        const int row0 = u.pm * 256 + wr * 64 + fr, cih = pl * 128 + wc * 32 + 8 * fq;
        const float* bg = bgu + e * 2048 + cih;
        const f32x4 bg0 = *(const f32x4*)(bg), bg1 = *(const f32x4*)(bg + 4), bu0 = *(const f32x4*)(bg + 1024), bu1 = *(const f32x4*)(bg + 1028);
#pragma unroll
        for (int ai = 0; ai < 2; ++ai)
#pragma unroll
            for (int m = 0; m < 4; ++m) {
                constexpr float RS = 1.f / (F8_SX * F8_SWG);
                const f32x4 g0 = acc[ai][0][m][0] * RS + bg0, g1 = acc[ai][0][m][1] * RS + bg1, u0 = acc[ai][1][m][0] * RS + bu0, u1 = acc[ai][1][m][1] * RS + bu1;
                float r[8];
#pragma unroll
                for (int i = 0; i < 8; ++i) {
                    float g = i < 4 ? g0[i & 3] : g1[i & 3], uu = i < 4 ? u0[i & 3] : u1[i & 3];
                    g = fminf(g, 7.0f); uu = fminf(fmaxf(uu, -7.0f), 7.0f);
                    const float sg = __builtin_amdgcn_rcpf(1.0f + ex2(-1.702f * LOG2E * g));
                    r[i] = (uu + 1.0f) * g * sg * F8_SA;
                }
                v2u w; w.x = pk4_fp8(r[0], r[1], r[2], r[3]); w.y = pk4_fp8(r[4], r[5], r[6], r[7]);
                *(v2u*)(act + (size_t)(row0 + ai * 128 + m * 16) * DM + cih) = w;
            }
    }
};
struct EpiDown {
    static constexpr bool PERM = true, AFTER_DRAIN = false;
    unsigned char* yr; const float* bdn;
    DI void operator()(const pg8::f32x4 (&acc)[2][2][4][2], const pg8::Unit& u, int wr, int wc, int fr, int fq) const {
        const int e = u.pn >> 2, pl = u.pn & 3;
        const int row0 = u.pm * 256 + wr * 64 + fr, col0 = pl * 256 + wc * 32 + 8 * fq;
        f32x4 bv[2][2];
#pragma unroll
        for (int bj = 0; bj < 2; ++bj) { bv[bj][0] = *(const f32x4*)(bdn + e * 1024 + col0 + bj * 128) * F8_SY; bv[bj][1] = *(const f32x4*)(bdn + e * 1024 + col0 + bj * 128 + 4) * F8_SY; }
#pragma unroll
        for (int ai = 0; ai < 2; ++ai)
#pragma unroll
            for (int m = 0; m < 4; ++m) {
                unsigned char* rp = yr + (size_t)(row0 + ai * 128 + m * 16) * DM + col0;
#pragma unroll
                for (int bj = 0; bj < 2; ++bj) {
                    constexpr float RS = F8_SY / (F8_SA * F8_SWD);
                    const f32x4 v0 = acc[ai][bj][m][0] * RS + bv[bj][0], v1 = acc[ai][bj][m][1] * RS + bv[bj][1];
                    v2u w; w.x = pk4_fp8(v0[0], v0[1], v0[2], v0[3]); w.y = pk4_fp8(v1[0], v1[1], v1[2], v1[3]);
                    *(v2u*)(rp + bj * 128) = w;
                }
            }
    }
};
struct GroupOrder {
    LAS const unsigned* tile_e; int ntiles, lg, G, c;
    DI bool next(int i, pg8::Unit& u) const {
        int pm, pl;
        if (G == 256) {
            const int x = c & 7, k = c >> 3; pm = i * (256 >> lg) + x * (32 >> lg) + (k >> lg); pl = k & ((1 << lg) - 1); if (pm >= ntiles) return false; }
        else { const long L = (long)i * G + c; if (L >= ((long)ntiles << lg)) return false; pm = (int)(L >> lg); pl = (int)(L & ((1 << lg) - 1)); }
        const int e = __builtin_amdgcn_readfirstlane((int)tile_e[pm]);
        u.pm = pm; u.pn = (e << lg) + pl; return true;
    }
    DI void a_ready(const pg8::Unit&) const {}
    DI void done(const pg8::Unit&) const {}
};
struct Args { const float* in[18]; float* out; unsigned char* ws; int ph_lo, ph_hi; };
struct Fr { LAS unsigned char* lds; unsigned char* ws; unsigned* ctl; int tid, lane, wave, blk, G; };

DI void tr_item(const float* W, int ldw, int K, int k0, int sc0, int nvalid, bf16* WT, int drow0, LAS float* scr, int lane) {
    const int c = lane & 31;
    float v[32];
#pragma unroll
    for (int i = 0; i < 32; ++i) v[i] = (c < nvalid) ? W[(size_t)(k0 + 2 * i + (lane >> 5)) * ldw + sc0 + c] : 0.f;
#pragma unroll
    for (int i = 0; i < 32; ++i) scr[(2 * i + (lane >> 5)) * 33 + c] = v[i];
    LDS_WAIT(); asm volatile("" ::: "memory");
    const int c8 = lane & 7;
#pragma unroll
    for (int j = 0; j < 4; ++j) { const int n = (lane >> 3) + 8 * j; const LAS float* s = scr + (8 * c8) * 33 + n;
        v4u o; o.x = cvtpk(s[0 * 33], s[1 * 33]); o.y = cvtpk(s[2 * 33], s[3 * 33]); o.z = cvtpk(s[4 * 33], s[5 * 33]); o.w = cvtpk(s[6 * 33], s[7 * 33]);
        *(v4u*)(WT + (size_t)(drow0 + n) * K + k0 + 8 * c8) = o; }
    LDS_WAIT(); asm volatile("" ::: "memory");
}
DI void tr_item8(const float* W, int ldw, int K, int k0, int sc0, float scale, unsigned char* WT8, int drow0, LAS float* scr, int lane) {
    const int c = lane & 31;
    float v[32];
#pragma unroll
    for (int i = 0; i < 32; ++i) v[i] = W[(size_t)(k0 + 2 * i + (lane >> 5)) * ldw + sc0 + c];
#pragma unroll
    for (int i = 0; i < 32; ++i) scr[(2 * i + (lane >> 5)) * 33 + c] = v[i] * scale;
    LDS_WAIT(); asm volatile("" ::: "memory");
    const int c16 = lane & 3;
#pragma unroll
    for (int j = 0; j < 2; ++j) { const int n = (lane >> 2) + 16 * j; const LAS float* s = scr + (16 * c16) * 33 + n;
        v4u o; o.x = pk4_fp8(s[0 * 33], s[1 * 33], s[2 * 33], s[3 * 33]); o.y = pk4_fp8(s[4 * 33], s[5 * 33], s[6 * 33], s[7 * 33]);
        o.z = pk4_fp8(s[8 * 33], s[9 * 33], s[10 * 33], s[11 * 33]); o.w = pk4_fp8(s[12 * 33], s[13 * 33], s[14 * 33], s[15 * 33]);
        *(v4u*)(WT8 + (size_t)(drow0 + n) * K + k0 + 16 * c16) = o; }
    LDS_WAIT(); asm volatile("" ::: "memory");
}
DI void ph_prologue(const Args& a, const Fr& F) {
    LAS float* scr = (LAS float*)(F.lds + F.wave * 16384);
    const int gw = F.blk * NWAVES + F.wave, NGW = F.G * NWAVES;
    constexpr int I_EV = 2 * 16 * 80, I_OD = 2 * 16 * 96, I_WO = 4 * 16 * 32;
    constexpr int NITEMS = I_EV + I_OD + I_WO;
    bf16* wev = (bf16*)(F.ws + WS_WEV); bf16* wod = (bf16*)(F.ws + WS_WOD); bf16* wout = (bf16*)(F.ws + WS_WOUT);
    unsigned char* wgu = F.ws + WS_WGU; unsigned char* wdn = F.ws + WS_WDN;
    for (int it = gw; it < NITEMS; it += NGW) {
        int r = it;
        if (r < I_EV) { const int l = r / 1280; r %= 1280; const int kb = r / 80, n0 = (r % 80) * 32; int sc0, nv = 32;
            if (n0 < 512) sc0 = n0; else if (n0 < 1024) sc0 = 964 + (n0 - 512); else if (n0 < 1536) sc0 = 1476 + (n0 - 1024); else if (n0 < 2048) sc0 = 1988 + (n0 - 1536);
            else if (n0 < 2176) sc0 = 512 + (n0 - 2048); else if (n0 < 2432) sc0 = 640 + (n0 - 2176); else if (n0 < 2496) sc0 = 896 + (n0 - 2432);
            else if (n0 < 2528) { sc0 = 960; nv = 4; } else { sc0 = 0; nv = 0; }
            tr_item(a.in[1] + (size_t)l * 1024 * 2500, 2500, 1024, kb * 64, sc0, nv, wev + (size_t)l * EV_N * 1024, n0, scr, F.lane); continue; }
        r -= I_EV;
        if (r < I_OD) { const int l = r / 1536; r %= 1536; const int kb = r / 96, n0 = (r % 96) * 32;
            tr_item(a.in[6] + (size_t)l * 1024 * 3088, 3088, 1024, kb * 64, n0, 32, wod + (size_t)l * OD_N * 1024, n0, scr, F.lane); continue; }
        r -= I_OD;
        if (r < I_WO) { const int l = r / 512; r %= 512; const int kb = r / 32, n0 = (r % 32) * 32;
            const float* src = (l & 1) ? a.in[8] + (size_t)(l >> 1) * 1024 * 1024 : a.in[5] + (size_t)(l >> 1) * 1024 * 1024;
            tr_item(src, 1024, 1024, kb * 64, n0, 32, wout + (size_t)l * 1024 * 1024, n0, scr, F.lane); continue; }
    }
    { __syncthreads();
        LAS float* tile = (LAS float*)F.lds; unsigned char* wgu8 = F.ws + WS_WGU; unsigned char* wdn8 = F.ws + WS_WDN;
        constexpr int T_GU = 128 * 8 * 16, T_DN = 128 * 8 * 8, T_ALL = T_GU + T_DN;
        const int tid = F.tid, c4 = tid & 31, r0 = tid >> 5;
        f32x4 v[8];
        auto locate = [&](int t, const float*& src, int& ldw, unsigned char*& dst, float& scale) {
            if (t < T_GU) { const int le = t >> 7, r = t & 127, kb = r >> 4, nb = r & 15, n0 = nb * 128; const int pn = n0 >> 8, bj = (n0 >> 7) & 1;
                src = a.in[14] + (size_t)le * 1024 * 2048 + (size_t)(kb * 128) * 2048 + bj * 1024 + pn * 128; ldw = 2048; dst = wgu8 + (size_t)le * 2048 * 1024 + (size_t)n0 * 1024 + kb * 128; scale = F8_SWG; }
            else { const int u = t - T_GU, le = u >> 6, r = u & 63, kb = r >> 3, nb = r & 7;
                src = a.in[16] + (size_t)le * 1024 * 1024 + (size_t)(kb * 128) * 1024 + nb * 128; ldw = 1024; dst = wdn8 + (size_t)le * 1024 * 1024 + (size_t)(nb * 128) * 1024 + kb * 128; scale = F8_SWD; } };
        int t = F.blk;
        if (t < T_ALL) { const float* src; int ldw; unsigned char* dst; float sc; locate(t, src, ldw, dst, sc);
#pragma unroll
            for (int i = 0; i < 8; ++i) v[i] = *(const f32x4*)(src + (size_t)(r0 + 16 * i) * ldw + 4 * c4); }
        for (; t < T_ALL; t += F.G) {
            const float* src; int ldw; unsigned char* dst; float sc; locate(t, src, ldw, dst, sc);
#pragma unroll
            for (int i = 0; i < 8; ++i) { LAS float* tp = tile + (r0 + 16 * i) * 129 + 4 * c4; tp[0] = v[i][0] * sc; tp[1] = v[i][1] * sc; tp[2] = v[i][2] * sc; tp[3] = v[i][3] * sc; }
            __syncthreads();
            if (t + F.G < T_ALL) { const float* s2; int l2; unsigned char* d2; float c2; locate(t + F.G, s2, l2, d2, c2);
#pragma unroll
                for (int i = 0; i < 8; ++i) v[i] = *(const f32x4*)(s2 + (size_t)(r0 + 16 * i) * l2 + 4 * c4); }
#pragma unroll
            for (int j = 0; j < 2; ++j) { const int p = tid + 512 * j, kc = p & 7, n = p >> 3; const LAS float* sp = tile + (kc * 16) * 129 + n;
                v4u o; o.x = pk4_fp8(sp[0], sp[129], sp[2 * 129], sp[3 * 129]); o.y = pk4_fp8(sp[4 * 129], sp[5 * 129], sp[6 * 129], sp[7 * 129]);
                o.z = pk4_fp8(sp[8 * 129], sp[9 * 129], sp[10 * 129], sp[11 * 129]); o.w = pk4_fp8(sp[12 * 129], sp[13 * 129], sp[14 * 129], sp[15 * 129]);
                *(v4u*)(dst + (size_t)n * 1024 + kc * 16) = o; }
            __syncthreads();
        }
    }
    bf16* xb = (bf16*)(F.ws + WS_XB);
    for (int m = gw; m < NTOK; m += NGW) {
        const f32x4* xr = (const f32x4*)(a.in[0] + (size_t)m * DM) + F.lane; v2u* o = (v2u*)(xb + (size_t)m * DM) + F.lane;
#pragma unroll
        for (int j = 0; j < 4; ++j) { const f32x4 v = xr[64 * j]; v2u w; w.x = cvtpk(v[0], v[1]); w.y = cvtpk(v[2], v[3]); o[64 * j] = w; }
    }
    bf16* wukt = (bf16*)(F.ws + WS_WUKT); bf16* wuvt = (bf16*)(F.ws + WS_WUVT);
    for (int i = F.blk * NTHR + F.tid; i < 2 * 8 * 128 * 64; i += F.G * NTHR) {
        { const int d = i & 63, c = (i >> 6) & 127, lh = i >> 13; wukt[i] = (bf16)f2bf(a.in[2][((size_t)lh * 64 + d) * 128 + c]); }
        { const int c = i & 127, d = (i >> 7) & 63, lh = i >> 13; wuvt[i] = (bf16)f2bf(a.in[3][((size_t)lh * 128 + c) * 64 + d]); }
    }
}

DI void ln_row(f32x4 (&v)[4], const float* g, const float* b, int lane) {
    float s = 0.f;
#pragma unroll
    for (int j = 0; j < 4; ++j) s += (v[j][0] + v[j][1]) + (v[j][2] + v[j][3]);
    const float mean = wave_sum(s) * (1.f / DM); float s2 = 0.f;
#pragma unroll
    for (int j = 0; j < 4; ++j) { v[j] = v[j] - mean; s2 += (v[j][0] * v[j][0] + v[j][1] * v[j][1]) + (v[j][2] * v[j][2] + v[j][3] * v[j][3]); }
    const float rstd = 1.f / sqrtf(wave_sum(s2) * (1.f / DM) + LN_EPS);
#pragma unroll
    for (int j = 0; j < 4; ++j) { const f32x4 gg = *((const f32x4*)g + lane + 64 * j), bb = *((const f32x4*)b + lane + 64 * j); v[j] = v[j] * rstd * gg + bb; }
}
DI void store_row_f32(float* p, const f32x4 (&v)[4], int lane) {
#pragma unroll
    for (int j = 0; j < 4; ++j) *((f32x4*)p + lane + 64 * j) = v[j];
}
DI void store_row_bf16(bf16* p, const f32x4 (&v)[4], int lane) {
#pragma unroll
    for (int j = 0; j < 4; ++j) { v2u w; w.x = cvtpk(v[j][0], v[j][1]); w.y = cvtpk(v[j][2], v[j][3]); *((v2u*)p + lane + 64 * j) = w; }
}
template <int NL> DI void small_proj(LAS const float* xs, const float* W, int ldw, int lane, float (&acc)[4]) {
    constexpr int PARTS = 64 / NL, DPER = 1024 / PARTS;
    const int n = lane & (NL - 1), part = lane / NL;
    acc[0] = acc[1] = acc[2] = acc[3] = 0.f;
    const float* wp = W + (size_t)(part * DPER) * ldw + n;
    LAS const float* xp = xs + part * DPER;
#pragma unroll 8
    for (int d = 0; d < DPER; ++d) { const float w = wp[(size_t)d * ldw];
        acc[0] += w * xp[d]; acc[1] += w * xp[1024 + d]; acc[2] += w * xp[2048 + d]; acc[3] += w * xp[3072 + d]; }
#pragma unroll
    for (int o = NL; o < 64; o <<= 1) {
#pragma unroll
        for (int k = 0; k < 4; ++k) acc[k] += __shfl_xor(acc[k], o); }
}

DI void ph_even_prep(const Args& a, const Fr& F, int j) {
    const bf16* proj = (const bf16*)(F.ws + WS_PROJ);
    bf16* ckvn = (bf16*)(F.ws + WS_CKVN); bf16* ql = (bf16*)(F.ws + WS_QL); float* kbar = (float*)(F.ws + WS_KBAR);
    const float* kvg = a.in[4] + j * 128;
    const bf16* wukt = (const bf16*)(F.ws + WS_WUKT) + (size_t)j * 8 * 128 * 64;
    const int lane = F.lane, wave = F.wave;
    for (int chunk = F.blk; chunk < 256; chunk += F.G) {
        const int tok0 = chunk * 128;
#pragma unroll 1
        for (int i0 = 0; i0 < 16; i0 += 8) { unsigned wv[8];
#pragma unroll
            for (int i = 0; i < 8; ++i) wv[i] = *((const unsigned*)(proj + (size_t)(tok0 + wave * 16 + i0 + i) * EV_N + EC_CKV) + lane);
#pragma unroll
            for (int i = 0; i < 8; ++i) { const int tok = tok0 + wave * 16 + i0 + i; const float v0 = bf2f(wv[i] & 0xffffu), v1 = bf2f(wv[i] >> 16);
                const float ss = wave_sum(v0 * v0 + v1 * v1);
                const float r = 1.f / sqrtf(ss * (1.f / 128.f) + LN_EPS);
                *((unsigned*)(ckvn + (size_t)tok * 128) + lane) = cvtpk(v0 * r * kvg[2 * lane], v1 * r * kvg[2 * lane + 1]); } }
        { bf16* kic = (bf16*)(F.ws + WS_KIC); const int tok = tok0 + wave * 16 + (lane >> 2), c = (lane & 3) * 16;
            const v4u* src = (const v4u*)(proj + (size_t)tok * EV_N + EC_KI + c); v4u* dst = (v4u*)(kic + (size_t)tok * 64 + c); dst[0] = src[0]; dst[1] = src[1]; }
        { const int h = wave, l15 = lane & 15, kg = lane >> 4;
            bf16x8 af[8][2];
#pragma unroll
            for (int ct = 0; ct < 8; ++ct)
#pragma unroll
                for (int ks = 0; ks < 2; ++ks) af[ct][ks] = *(const bf16x8*)(wukt + ((size_t)h * 128 + ct * 16 + l15) * 64 + ks * 32 + kg * 8);
#pragma unroll 1
            for (int tg = 0; tg < 8; tg += 4) { bf16x8 qf[4][2];
#pragma unroll
                for (int u = 0; u < 4; ++u)
#pragma unroll
                    for (int ks = 0; ks < 2; ++ks) qf[u][ks] = *(const bf16x8*)(proj + (size_t)(tok0 + (tg + u) * 16 + l15) * EV_N + EC_QA + h * 64 + ks * 32 + kg * 8);
#pragma unroll
                for (int u = 0; u < 4; ++u) { const int tok = tok0 + (tg + u) * 16 + l15;
#pragma unroll
                    for (int ct = 0; ct < 8; ++ct) { f32x4 d = {0.f, 0.f, 0.f, 0.f};
                        d = mfma16(af[ct][0], qf[u][0], d); d = mfma16(af[ct][1], qf[u][1], d);
                        v2u w; w.x = cvtpk(d[0], d[1]); w.y = cvtpk(d[2], d[3]);
                        *(v2u*)(ql + (size_t)tok * 1024 + h * 128 + ct * 16 + 4 * kg) = w; } } } }
        if (chunk < 128) { const int b = chunk >> 5, n = chunk & 31; float s8[8];
#pragma unroll
            for (int k = 0; k < 8; ++k) s8[k] = 0.f;
            const bf16* kp = proj + ((size_t)b * SEQ + n * 256 + wave * 32) * EV_N + EC_KB + lane * 8;
#pragma unroll 8
            for (int r = 0; r < 32; ++r) { const v4u w = *(const v4u*)(kp + (size_t)r * EV_N);
#pragma unroll
                for (int k = 0; k < 4; ++k) { s8[2 * k] += bf2f(w[k] & 0xffffu); s8[2 * k + 1] += bf2f(w[k] >> 16); } }
            LAS float* red = (LAS float*)F.lds;
            __syncthreads();
#pragma unroll
            for (int k = 0; k < 8; ++k) red[wave * 512 + lane * 8 + k] = s8[k];
            __syncthreads();
            float s = 0.f;
#pragma unroll
            for (int w = 0; w < 8; ++w) s += red[w * 512 + F.tid];
            const int h = F.tid >> 6, d = F.tid & 63;
            kbar[(((size_t)b * 8 + h) * 32 + n) * 64 + d] = s * (1.f / 256.f); }
    }
}

DI void moba_gate_chunk(const Fr& F, int chunk) {
    const bf16* proj = (const bf16*)(F.ws + WS_PROJ); const float* kbar = (const float*)(F.ws + WS_KBAR); unsigned* sel3 = (unsigned*)(F.ws + WS_SEL3);
    const int tok0 = chunk * 128, b = tok0 / SEQ, own = (tok0 % SEQ) >> 8, h = F.wave, lane = F.lane;
    float q0[64], q1[64];
    { const v4u* p0 = (const v4u*)(proj + (size_t)(tok0 + lane) * EV_N + EC_QB + h * 64); const v4u* p1 = (const v4u*)(proj + (size_t)(tok0 + 64 + lane) * EV_N + EC_QB + h * 64);
#pragma unroll
        for (int i = 0; i < 8; ++i) { const v4u w0 = p0[i], w1 = p1[i];
#pragma unroll
            for (int k = 0; k < 4; ++k) { q0[8 * i + 2 * k] = bf2f(w0[k] & 0xffffu); q0[8 * i + 2 * k + 1] = bf2f(w0[k] >> 16); q1[8 * i + 2 * k] = bf2f(w1[k] & 0xffffu); q1[8 * i + 2 * k + 1] = bf2f(w1[k] >> 16); } } }
    float a0 = -INFINITY, a1 = -INFINITY, a2 = -INFINITY, c0 = -INFINITY, c1 = -INFINITY, c2 = -INFINITY; int ai0 = 0, ai1 = 0, ai2 = 0, ci0 = 0, ci1 = 0, ci2 = 0;
    const float* kb = kbar + (((size_t)b * 8 + h) * 32) * 64;
    for (int n = 0; n < own; ++n) { float g0 = 0.f, g1 = 0.f;
#pragma unroll
        for (int d = 0; d < 64; d += 4) { const f32x4 kv = *(const f32x4*)(kb + n * 64 + d);
#pragma unroll
            for (int k = 0; k < 4; ++k) { g0 += q0[d + k] * kv[k]; g1 += q1[d + k] * kv[k]; } }
        if (g0 > a2) { if (g0 > a1) { a2 = a1; ai2 = ai1; if (g0 > a0) { a1 = a0; ai1 = ai0; a0 = g0; ai0 = n; } else { a1 = g0; ai1 = n; } } else { a2 = g0; ai2 = n; } }
        if (g1 > c2) { if (g1 > c1) { c2 = c1; ci2 = ci1; if (g1 > c0) { c1 = c0; ci1 = ci0; c0 = g1; ci0 = n; } else { c1 = g1; ci1 = n; } } else { c2 = g1; ci2 = n; } }
    }
    const unsigned nv = own < 3 ? own : 3;
    sel3[(size_t)(tok0 + lane) * 8 + h] = (unsigned)ai0 | ((unsigned)ai1 << 8) | ((unsigned)ai2 << 16) | (nv << 24);
    sel3[(size_t)(tok0 + 64 + lane) * 8 + h] = (unsigned)ci0 | ((unsigned)ci1 << 8) | ((unsigned)ci2 << 16) | (nv << 24);
}

constexpr int HS = 257;
DI float relu1(float x) { const unsigned u = __float_as_uint(x); return __uint_as_float(u & ~(unsigned)((int)u >> 31)); }
template <int MODE, bool DIAG> DI void idx_tile(const bf16x8 (&kf)[4], LAS const char* qb  , const float (&wj)[4], int kt, int q, int hi, unsigned c0, unsigned c1,
                                     LAS unsigned* hist, LAS unsigned* mask, LAS unsigned* cmask, LAS unsigned long long* cand, LAS unsigned* rinfo) {
    f32x2 scp[8];
#pragma unroll
    for (int p = 0; p < 8; ++p) scp[p] = (f32x2){0.f, 0.f};
    bf16x8 qv0[2][4], qv1[2][4];
#pragma unroll
    for (int j = 0; j < 2; ++j)
#pragma unroll
        for (int s = 0; s < 4; ++s) qv0[j][s] = *(LAS const bf16x8*)(qb + (j * 8 + s * 2) * 512);
#pragma unroll
    for (int j = 0; j < 2; ++j)
#pragma unroll
        for (int s = 0; s < 4; ++s) qv1[j][s] = *(LAS const bf16x8*)(qb + ((2 + j) * 8 + s * 2) * 512);
    __builtin_amdgcn_sched_barrier(0);
#pragma unroll
    for (int g = 0; g < 2; ++g) { f32x16 acc[2];
#pragma unroll
        for (int j = 0; j < 2; ++j)
#pragma unroll
            for (int r = 0; r < 16; ++r) acc[j][r] = 0.f;
#pragma unroll
        for (int s = 0; s < 4; ++s)
#pragma unroll
            for (int j = 0; j < 2; ++j) { if (MODE != -2) acc[j] = mfma32(kf[s], g == 0 ? qv0[j][s] : qv1[j][s], acc[j]); else acc[j][s] += __builtin_bit_cast(float, (unsigned)(kf[s][0] ^ (g == 0 ? qv0[j][s][0] : qv1[j][s][0]))); }
#pragma unroll
        for (int p = 0; p < 8; ++p)
#pragma unroll
            for (int j = 0; j < 2; ++j) { const f32x2 a = {relu1(acc[j][2 * p]), relu1(acc[j][2 * p + 1])}; const f32x2 w2 = {wj[2 * g + j], wj[2 * g + j]}; scp[p] = a * w2 + scp[p]; } }
    unsigned sel = 0u, cnd = 0u;
    if (MODE <= 0) { float t = 0.f;
#pragma unroll
        for (int p = 0; p < 8; ++p) t += scp[p][0] + scp[p][1];
        if (t == 12345.678f) __hip_atomic_fetch_or(mask + q * HS + kt, 1u, __ATOMIC_RELAXED, __HIP_MEMORY_SCOPE_WORKGROUP);
        return; }
    const float F0 = __uint_as_float(c0), F1 = __uint_as_float(c1);
#pragma unroll
    for (int r = 0; r < 16; ++r) { const int kr = crow(r, hi);
        const bool ok = !DIAG || kr <= q;
        const float scv = scp[r >> 1][r & 1]; const unsigned u = __float_as_uint(scv);
        if (MODE == 1) { const unsigned key = u ^ ((unsigned)((int)u >> 31) | 0x80000000u);
            if (ok && (key >> 24) >= c0) __hip_atomic_fetch_add(hist + q * HS + (key >> 24), 1u, __ATOMIC_RELAXED, __HIP_MEMORY_SCOPE_WORKGROUP); }
        else if (MODE == 2) { if (ok && (u >> 24) == c0) __hip_atomic_fetch_add(hist + q * HS + (((u >> 16) & 255u) ^ c1), 1u, __ATOMIC_RELAXED, __HIP_MEMORY_SCOPE_WORKGROUP); }
        else { const bool ge1 = scv >= F1, ge0 = scv >= F0;
            if (ok && ge1) sel |= 1u << kr;
            if (ok && ge0 && !ge1) { cnd |= 1u << kr; const unsigned key = u ^ ((unsigned)((int)u >> 31) | 0x80000000u);
                const unsigned pos = __hip_atomic_fetch_add(rinfo + 128 + q, 1u, __ATOMIC_RELAXED, __HIP_MEMORY_SCOPE_WORKGROUP);
                if (pos < 64u) cand[q * 64 + pos] = ((unsigned long long)key << 32) | (unsigned)(~(unsigned)(kt * 32 + kr)); } } }
    if (MODE == 3) { if (sel) __hip_atomic_fetch_or(mask + q * HS + kt, sel, __ATOMIC_RELAXED, __HIP_MEMORY_SCOPE_WORKGROUP);
        if (cnd) __hip_atomic_fetch_or(cmask + q * HS + kt, cnd, __ATOMIC_RELAXED, __HIP_MEMORY_SCOPE_WORKGROUP); }
}
template <int MODE> DI void idx_pass(const bf16* proj, int rowbase, int qt, LAS const char* qimg, const float (&wj)[4], LAS unsigned* hist, LAS unsigned* mask, LAS unsigned* cmask, LAS unsigned long long* cand, LAS unsigned* rinfo, int wave, int lane) {
    const int q = lane & 31, hi = lane >> 5, nkt = qt + 1;
    const unsigned b1 = MODE == 2 ? rinfo[160 + q] : rinfo[224 + q], thr16 = MODE == 2 ? rinfo[192 + q] : rinfo[256 + q];
    const bf16* kp0 = proj + (size_t)(rowbase + q) * 64 + hi * 8;
    LAS const char* qb = qimg + hi * 512 + q * 16;
    const int n = nkt > wave ? (nkt - wave + 7) >> 3 : 0;
    bf16x8 kfa[4], kfb[4];
#define IDX_LOAD(KF, I) do { const bf16* kp_ = kp0 + (size_t)((wave + 8 * (I)) * 32) * 64; _Pragma("unroll") for (int s_ = 0; s_ < 4; ++s_) KF[s_] = *(const bf16x8*)(kp_ + s_ * 16); } while (0)
#define IDX_TILE(KF, I) do { const int kt_ = wave + 8 * (I); if (kt_ == qt) idx_tile<MODE, true>(KF, qb, wj, kt_, q, hi, b1, thr16, hist, mask, cmask, cand, rinfo); \
        else idx_tile<MODE, false>(KF, qb, wj, kt_, q, hi, b1, thr16, hist, mask, cmask, cand, rinfo); } while (0)
    if (n > 0) IDX_LOAD(kfa, 0);
    for (int i = 0; i < n; i += 2) {
        if (i + 1 < n) { if (MODE == -1) { _Pragma("unroll") for (int s_ = 0; s_ < 4; ++s_) kfb[s_] = kfa[s_]; } else IDX_LOAD(kfb, i + 1); }
        IDX_TILE(kfa, i);
        if (i + 1 < n) { if (i + 2 < n && MODE != -1) IDX_LOAD(kfa, i + 2); IDX_TILE(kfb, i + 1); }
    }
#undef IDX_LOAD
#undef IDX_TILE
}
DI void hist_pick(LAS const unsigned* hrow, unsigned need, int lane, unsigned& bin, unsigned& above) {
    unsigned h4[4];
#pragma unroll
    for (int k = 0; k < 4; ++k) h4[k] = hrow[4 * lane + k];
    const unsigned ssum = h4[0] + h4[1] + h4[2] + h4[3];
    unsigned x = ssum;
#pragma unroll
    for (int o = 1; o < 64; o <<= 1) { const unsigned y = __shfl_down(x, o); if (lane + o < 64) x += y; }
    const unsigned long long m = __ballot(x >= need);
    const int Ls = m ? 63 - __builtin_clzll(m) : 0;
    const unsigned xs = __shfl(x, Ls), ss = __shfl(ssum, Ls);
    const unsigned h0 = __shfl(h4[0], Ls), h1 = __shfl(h4[1], Ls), h2 = __shfl(h4[2], Ls), h3 = __shfl(h4[3], Ls);
    unsigned cum = xs - ss;
    if (cum + h3 >= need) { bin = 4 * Ls + 3; above = cum; return; } cum += h3;
    if (cum + h2 >= need) { bin = 4 * Ls + 2; above = cum; return; } cum += h2;
    if (cum + h1 >= need) { bin = 4 * Ls + 1; above = cum; return; } cum += h1;
    bin = 4 * Ls; above = cum; (void)h0;
}
DI void idx_pass1(const bf16* proj, int rowbase, int qt, LAS const char* qimg, const float (&wj)[4], LAS unsigned* hist, LAS unsigned* mask, LAS unsigned* cmask, LAS unsigned long long* cand, LAS unsigned* rinfo, int wave, int lane) {
    const int q = lane & 31, hi = lane >> 5, nkt = qt + 1, nmax = (nkt + 7) >> 3;
    const bf16* kp0 = proj + (size_t)(rowbase + q) * 64 + hi * 8;
    LAS const char* qb = qimg + hi * 512 + q * 16;
    unsigned lb = 0u;
    bf16x8 kfc[4], kfn[4];
    if (wave < nkt) {
#pragma unroll
        for (int s = 0; s < 4; ++s) kfc[s] = *(const bf16x8*)(kp0 + (size_t)(wave * 32) * 64 + s * 16); }
    for (int i = 0; i < nmax; ++i) { const int kt = wave + 8 * i;
        if (kt + 8 < nkt) {
#pragma unroll
            for (int s = 0; s < 4; ++s) kfn[s] = *(const bf16x8*)(kp0 + (size_t)((kt + 8) * 32) * 64 + s * 16); }
        if (kt < nkt) { if (kt == qt) idx_tile<1, true>(kfc, qb, wj, kt, q, hi, lb, 0u, hist, mask, cmask, cand, rinfo); else idx_tile<1, false>(kfc, qb, wj, kt, q, hi, lb, 0u, hist, mask, cmask, cand, rinfo); }
#pragma unroll
        for (int s = 0; s < 4; ++s) kfc[s] = kfn[s];
        if (((i + 1) & i) == 0 && i + 1 < nmax && i < 16) {
            __syncthreads();
#pragma unroll 1
            for (int rr = 0; rr < 4; ++rr) { const int row = wave * 4 + rr; unsigned bin, above; hist_pick(hist + row * HS, 256u, lane, bin, above);
                if (lane == 0) rinfo[288 + row] = bin; }
            __syncthreads();
            { const unsigned nb = rinfo[288 + q]; lb = nb > lb ? nb : lb; } }
    }
}
DI void idx_unit(const Fr& F, int b, int qt, int stop = 0  ) {
    const bf16* proj = (const bf16*)(F.ws + WS_PROJ); const bf16* kic = (const bf16*)(F.ws + WS_KIC); unsigned short* sel = (unsigned short*)(F.ws + WS_SEL);
    LAS unsigned* hist = (LAS unsigned*)(F.lds); LAS unsigned* mask = hist + 32 * HS; LAS unsigned* cmask = mask + 32 * HS;
    LAS unsigned long long* cand = (LAS unsigned long long*)(F.lds + 99328); LAS unsigned* rinfo = (LAS unsigned*)(F.lds + 115712);
    const int lane = F.lane, wave = F.wave, tid = F.tid, t0 = qt * 32, rowbase = b * SEQ;
    __syncthreads();
    for (int i = tid; i < 3 * 32 * HS; i += NTHR) hist[i] = 0u;
    if (tid < 320) rinfo[tid] = 0u;
    __syncthreads();
    if (t0 + 31 <= 255 || (EXPF & 64)) {
        if (lane < 8) {
#pragma unroll
            for (int rr = 0; rr < 4; ++rr) { const int row = wave * 4 + rr, nv = t0 + row + 1;
                const int nv0 = t0 + row + 1; const int nvc = nv0 < 256 ? nv0 : 256; (void)nv; mask[row * HS + lane] = nvc >= 32 * (lane + 1) ? 0xffffffffu : (nvc > 32 * lane ? ((1u << (nvc - 32 * lane)) - 1u) : 0u); } }
    } else {
        const int q = lane & 31;
        float wj[4];
        { const bf16* qp = proj + (size_t)(rowbase + t0 + q) * EV_N;
#pragma unroll
            for (int j = 0; j < 4; ++j) wj[j] = bf2f(qp[EC_WI + j]); }
        LAS char* qimg = (LAS char*)(F.lds + 117248);
#pragma unroll
        for (int i = 0; i < 2; ++i) { const int p = tid + i * NTHR, row = p & 31, c = p >> 5;
            *(LAS v4u*)(qimg + c * 512 + row * 16) = *(const v4u*)(proj + (size_t)(rowbase + t0 + row) * EV_N + EC_QI + c * 8); }
        __syncthreads();
        if (stop == 7) return;
        if (stop == 4) { idx_pass<0>(kic, rowbase, qt, qimg, wj, hist, mask, cmask, cand, rinfo, wave, lane); return; }
        if (stop == 5) { idx_pass<-1>(kic, rowbase, qt, qimg, wj, hist, mask, cmask, cand, rinfo, wave, lane); return; }
        if (stop == 6) { idx_pass<-2>(kic, rowbase, qt, qimg, wj, hist, mask, cmask, cand, rinfo, wave, lane); return; }
        idx_pass1(kic, rowbase, qt, qimg, wj, hist, mask, cmask, cand, rinfo, wave, lane);
        __syncthreads();
#pragma unroll 1
        for (int rr = 0; rr < 4; ++rr) { const int row = wave * 4 + rr; unsigned bin, above; hist_pick(hist + row * HS, 256u, lane, bin, above);
            if (lane == 0) { rinfo[row] = bin; rinfo[32 + row] = 256u - above; rinfo[160 + row] = bin >= 128u ? bin - 128u : 255u - bin; rinfo[192 + row] = bin >= 128u ? 0u : 255u; } }
        __syncthreads();
        if (stop == 1) return;
        for (int i = tid; i < 32 * HS; i += NTHR) hist[i] = 0u;
        __syncthreads();
        idx_pass<2>(kic, rowbase, qt, qimg, wj, hist, mask, cmask, cand, rinfo, wave, lane);
        __syncthreads();
#pragma unroll 1
        for (int rr = 0; rr < 4; ++rr) { const int row = wave * 4 + rr; const unsigned need1 = rinfo[32 + row]; unsigned bin, above; hist_pick(hist + row * HS, need1, lane, bin, above);
            if (lane == 0) { const unsigned t16 = (rinfo[row] << 8) | bin, k0 = t16 << 16, k1 = (t16 + 1u) << 16;
                rinfo[64 + row] = t16; rinfo[96 + row] = need1 - above;
                rinfo[224 + row] = (k0 & 0x80000000u) ? (k0 ^ 0x80000000u) : ~k0; rinfo[256 + row] = (t16 == 0xffffu) ? 0x7fc00000u : ((k1 & 0x80000000u) ? (k1 ^ 0x80000000u) : ~k1); } }
        __syncthreads();
        if (stop == 2) return;
        idx_pass<3>(kic, rowbase, qt, qimg, wj, hist, mask, cmask, cand, rinfo, wave, lane);
        __syncthreads();
        if (stop == 3) return;
#pragma unroll 1
        for (int rr = 0; rr < 4; ++rr) { const int row = wave * 4 + rr; const unsigned call = rinfo[128 + row], need2 = rinfo[96 + row];
            if (call <= 64u) { const unsigned c = call;
                const unsigned long long mine = cand[row * 64 + lane]; unsigned rank = 0u;
                for (unsigned k = 0; k < c; ++k) rank += (cand[row * 64 + k] > mine) ? 1u : 0u;
                if ((unsigned)lane < c && rank < need2) { const unsigned s = ~(unsigned)mine;
                    __hip_atomic_fetch_or(mask + row * HS + (s >> 5), 1u << (s & 31), __ATOMIC_RELAXED, __HIP_MEMORY_SCOPE_WORKGROUP); } }
            else { unsigned w4[4];
#pragma unroll
                for (int k = 0; k < 4; ++k) w4[k] = cmask[row * HS + 4 * lane + k];
                const unsigned cnt = __popc(w4[0]) + __popc(w4[1]) + __popc(w4[2]) + __popc(w4[3]);
                unsigned x = cnt;
#pragma unroll
                for (int o = 1; o < 64; o <<= 1) { const unsigned y = __shfl_up(x, o); if (lane >= o) x += y; }
                unsigned before = x - cnt;
#pragma unroll
                for (int k = 0; k < 4; ++k) { unsigned w = w4[k]; const unsigned pc = __popc(w); unsigned take = 0u;
                    if (before < need2) { if (before + pc <= need2) take = w; else { unsigned left = need2 - before; while (left) { const unsigned b = w & (0u - w); take |= b; w ^= b; --left; } } }
                    before += pc;
                    if (take) mask[row * HS + 4 * lane + k] |= take; } }
        }
    }
    __syncthreads();
#pragma unroll 1
    for (int rr = 0; rr < 4; ++rr) { const int row = wave * 4 + rr; unsigned short* out = sel + (size_t)(rowbase + t0 + row) * 256;
        unsigned w4[4];
#pragma unroll
        for (int k = 0; k < 4; ++k) w4[k] = mask[row * HS + 4 * lane + k];
        const unsigned cnt = __popc(w4[0]) + __popc(w4[1]) + __popc(w4[2]) + __popc(w4[3]);
        unsigned x = cnt;
#pragma unroll
        for (int o = 1; o < 64; o <<= 1) { const unsigned y = __shfl_up(x, o); if (lane >= o) x += y; }
        const unsigned total = __shfl(x, 63); unsigned pos = x - cnt;
#pragma unroll
        for (int k = 0; k < 4; ++k) { unsigned w = w4[k]; const unsigned base = (unsigned)(4 * lane + k) * 32u;
            while (w) { const unsigned bit = __builtin_ctz(w); if (pos < 256u) out[pos] = (unsigned short)(base + bit); ++pos; w &= w - 1u; } }
        for (unsigned i = total + lane; i < 256u; i += 64u) out[i] = (unsigned short)0xffffu; }
}

struct AttSt { float m, l; f32x16 o0, o1; };
template <class BF> DI void att_subtile(AttSt& S, const bf16x8 (&qf)[4], LAS const char* Kst, LAS const char* Vb, int vdh, int vrow0, int lane, const BF& bias) {
    const int r32 = lane & 31, hi = lane >> 5;
    f32x16 p;
#pragma unroll
    for (int r = 0; r < 16; ++r) p[r] = bias.b(crow(r, hi)) - S.m;
    LAS const char* kp = Kst + hi * 512 + r32 * 16;
#pragma unroll
    for (int s = 0; s < 4; ++s) { const bf16x8 kf = *(LAS const bf16x8*)(kp + s * 1024); p = mfma32(kf, qf[s], p); }
    if (bias.any) {
#pragma unroll
        for (int r = 0; r < 16; ++r) p[r] = bias.msk(crow(r, hi)) ? -INFINITY : p[r]; }
    float mxa[4] = {-INFINITY, -INFINITY, -INFINITY, -INFINITY};
#pragma unroll
    for (int r = 0; r < 16; ++r) mxa[r & 3] = fmaxf(mxa[r & 3], p[r]);
    float mx = fmaxf(fmaxf(mxa[0], mxa[1]), fmaxf(mxa[2], mxa[3]));
    mx = fmaxf(mx, __shfl_xor(mx, 32));
    if (__any(mx > 16.f)) { const float dl = fmaxf(mx, 0.f), sc = ex2(-dl); S.m += dl; S.l *= sc;
#pragma unroll
        for (int r = 0; r < 16; ++r) { p[r] -= dl; S.o0[r] *= sc; S.o1[r] *= sc; } }
    float psa[4] = {0.f, 0.f, 0.f, 0.f};
#pragma unroll
    for (int r = 0; r < 16; ++r) { p[r] = ex2(p[r]); psa[r & 3] += p[r]; }
    S.l += (psa[0] + psa[1]) + (psa[2] + psa[3]);
    v4u pw0, pw1;
    pw0.x = cvtpk(p[0], p[1]); pw0.y = cvtpk(p[2], p[3]); pw0.z = cvtpk(p[4], p[5]); pw0.w = cvtpk(p[6], p[7]);
    pw1.x = cvtpk(p[8], p[9]); pw1.y = cvtpk(p[10], p[11]); pw1.z = cvtpk(p[12], p[13]); pw1.w = cvtpk(p[14], p[15]);
    const bf16x8 pf0 = __builtin_bit_cast(bf16x8, pw0), pf1 = __builtin_bit_cast(bf16x8, pw1);
    LAS const char* vp = Vb + (vrow0 + 4 * hi + ((lane & 15) >> 2)) * 64 + ((lane >> 4) & 1) * 32 + (lane & 3) * 8;
    { const bf16x8 v00 = cat8(vtr(vp), vtr(vp + 512)), v10 = cat8(vtr(vp + vdh), vtr(vp + vdh + 512));
      const bf16x8 v01 = cat8(vtr(vp + 1024), vtr(vp + 1536)), v11 = cat8(vtr(vp + vdh + 1024), vtr(vp + vdh + 1536));
      S.o0 = mfma32(v00, pf0, S.o0); S.o1 = mfma32(v10, pf0, S.o1);
      S.o0 = mfma32(v01, pf1, S.o0); S.o1 = mfma32(v11, pf1, S.o1); }
}
template <class BF0, class BF1> DI void att_tile64(AttSt& S, const bf16x8 (&qf)[4], LAS const char* Kst, LAS const char* Vb, int vdh, int vrow0, int lane, const BF0& bias0, const BF1& bias1) {
    const int r32 = lane & 31, hi = lane >> 5;
    f32x16 p0, p1;
#pragma unroll
    for (int r = 0; r < 16; ++r) { p0[r] = bias0.b(crow(r, hi)) - S.m; p1[r] = bias1.b(crow(r, hi)) - S.m; }
    LAS const char* kp = Kst + hi * 512 + r32 * 16;
#pragma unroll
    for (int s = 0; s < 4; ++s) { const bf16x8 k0 = *(LAS const bf16x8*)(kp + s * 1024), k1 = *(LAS const bf16x8*)(kp + 4096 + s * 1024); p0 = mfma32(k0, qf[s], p0); p1 = mfma32(k1, qf[s], p1); }
    if (bias0.any) {
#pragma unroll
        for (int r = 0; r < 16; ++r) p0[r] = bias0.msk(crow(r, hi)) ? -INFINITY : p0[r]; }
    if (bias1.any) {
#pragma unroll
        for (int r = 0; r < 16; ++r) p1[r] = bias1.msk(crow(r, hi)) ? -INFINITY : p1[r]; }
    float mxa[4] = {-INFINITY, -INFINITY, -INFINITY, -INFINITY};
#pragma unroll
    for (int r = 0; r < 16; ++r) mxa[r & 3] = fmaxf(mxa[r & 3], fmaxf(p0[r], p1[r]));
    float mx = fmaxf(fmaxf(mxa[0], mxa[1]), fmaxf(mxa[2], mxa[3]));
    mx = fmaxf(mx, __shfl_xor(mx, 32));
    if (__any(mx > 16.f)) { const float dl = fmaxf(mx, 0.f), sc = ex2(-dl); S.m += dl; S.l *= sc;
#pragma unroll
        for (int r = 0; r < 16; ++r) { p0[r] -= dl; p1[r] -= dl; S.o0[r] *= sc; S.o1[r] *= sc; } }
    float psa[4] = {0.f, 0.f, 0.f, 0.f};
#pragma unroll
    for (int r = 0; r < 16; ++r) { p0[r] = ex2(p0[r]); p1[r] = ex2(p1[r]); psa[r & 3] += p0[r] + p1[r]; }
    S.l += (psa[0] + psa[1]) + (psa[2] + psa[3]);
    v4u a0, a1, b0, b1;
    a0.x = cvtpk(p0[0], p0[1]); a0.y = cvtpk(p0[2], p0[3]); a0.z = cvtpk(p0[4], p0[5]); a0.w = cvtpk(p0[6], p0[7]);
    a1.x = cvtpk(p0[8], p0[9]); a1.y = cvtpk(p0[10], p0[11]); a1.z = cvtpk(p0[12], p0[13]); a1.w = cvtpk(p0[14], p0[15]);
    b0.x = cvtpk(p1[0], p1[1]); b0.y = cvtpk(p1[2], p1[3]); b0.z = cvtpk(p1[4], p1[5]); b0.w = cvtpk(p1[6], p1[7]);
    b1.x = cvtpk(p1[8], p1[9]); b1.y = cvtpk(p1[10], p1[11]); b1.z = cvtpk(p1[12], p1[13]); b1.w = cvtpk(p1[14], p1[15]);
    LAS const char* vp = Vb + (vrow0 + 4 * hi + ((lane & 15) >> 2)) * 64 + ((lane >> 4) & 1) * 32 + (lane & 3) * 8;
#pragma unroll
    for (int k16 = 0; k16 < 4; ++k16) { const bf16x8 pf = __builtin_bit_cast(bf16x8, k16 == 0 ? a0 : k16 == 1 ? a1 : k16 == 2 ? b0 : b1);
        const bf16x8 v0 = cat8(vtr(vp + k16 * 1024), vtr(vp + k16 * 1024 + 512)), v1 = cat8(vtr(vp + vdh + k16 * 1024), vtr(vp + vdh + k16 * 1024 + 512));
        S.o0 = mfma32(v0, pf, S.o0); S.o1 = mfma32(v1, pf, S.o1); }
}

struct MobaFar { float c; bool any; DI float b(int) const { return c; } DI bool msk(int) const { return false; } };
struct MobaBias { LAS const float* lut; int tq, s0; bool any;
    DI float b(int kvrel) const { const int dist = tq - (s0 + kvrel); return lut[dist < 0 ? 0 : (dist > 1023 ? 1023 : dist)]; }
    DI bool msk(int kvrel) const { return tq - (s0 + kvrel) < 0; } };
DI void moba_qload(bf16x8 (&qf)[4], const bf16* proj, int rowbase, int h, int tq, int hi) {
    const bf16* qp = proj + (size_t)(rowbase + tq) * EV_N + EC_QB + h * 64 + hi * 8;
#pragma unroll
    for (int s = 0; s < 4; ++s) qf[s] = *(const bf16x8*)(qp + s * 16);
}
DI void moba_tile(const Fr& F, const bf16x8 (&qf)[4], int rowbase, int h, int n, int tq, bool valid, int slot, bool own, int wave_tile) {
    LAS const char* Kb = (LAS const char*)F.lds; LAS const char* Vb = (LAS const char*)(F.lds + 32768); LAS const float* lut = (LAS const float*)(F.lds + 98304);
    bf16* po = (bf16*)(F.ws + WS_ACT); float* pml = (float*)(F.ws + WS_PML);
    const int lane = F.lane, hi = lane >> 5;
    AttSt S; S.m = 0.f; S.l = 0.f;
#pragma unroll
    for (int r = 0; r < 16; ++r) { S.o0[r] = 0.f; S.o1[r] = 0.f; }
    const int nst = own ? wave_tile + 1 : 8;
    int tmin = tq;
#pragma unroll
    for (int o = 1; o < 64; o <<= 1) { const int y = __shfl_xor(tmin, o); tmin = y < tmin ? y : tmin; }
    const float cfar = lut[1023];
    int st = 0;
    for (; st + 1 < nst; st += 2) {
        if (!own && tmin - (n * 256 + st * 32 + 63) >= 790) { MobaFar bf{cfar, false}; att_tile64(S, qf, Kb + st * 4096, Vb, 16384, st * 32, lane, bf, bf); }
        else { MobaBias bf0{lut, tq, n * 256 + st * 32, false}, bf1{lut, tq, n * 256 + st * 32 + 32, own && st + 1 == wave_tile}; att_tile64(S, qf, Kb + st * 4096, Vb, 16384, st * 32, lane, bf0, bf1); } }
    if (st < nst) { MobaBias bf{lut, tq, n * 256 + st * 32, own && st == wave_tile}; att_subtile(S, qf, Kb + st * 4096, Vb, 16384, st * 32, lane, bf); }
    const float lt = S.l + __shfl_xor(S.l, 32), inv = 1.f / lt;
    if (valid) { const size_t pi = ((size_t)(rowbase + tq) * 8 + h) * 4 + slot; bf16* o = po + pi * 64;
#pragma unroll
        for (int a4 = 0; a4 < 4; ++a4) { v2u w0, w1;
            w0.x = cvtpk(S.o0[4 * a4] * inv, S.o0[4 * a4 + 1] * inv); w0.y = cvtpk(S.o0[4 * a4 + 2] * inv, S.o0[4 * a4 + 3] * inv);
            w1.x = cvtpk(S.o1[4 * a4] * inv, S.o1[4 * a4 + 1] * inv); w1.y = cvtpk(S.o1[4 * a4 + 2] * inv, S.o1[4 * a4 + 3] * inv);
            *(v2u*)(o + 8 * a4 + 4 * hi) = w0; *(v2u*)(o + 32 + 8 * a4 + 4 * hi) = w1; }
        if (hi == 0) { f32x2 ml = {S.m, lt}; *(f32x2*)(pml + pi * 2) = ml; } }
}
DI void moba_unit(const Args& a, const Fr& F, int b, int h, int n) {
    const bf16* proj = (const bf16*)(F.ws + WS_PROJ); const unsigned* sel3 = (const unsigned*)(F.ws + WS_SEL3);
    LAS unsigned char* lds = F.lds; LAS unsigned* list = (LAS unsigned*)(lds + 65536); LAS float* lut = (LAS float*)(lds + 98304); LAS unsigned* misc = (LAS unsigned*)(lds + 102400);
    const int tid = F.tid, lane = F.lane, wave = F.wave, rowbase = b * SEQ;
    __syncthreads();
    { const bf16* kg = proj + (size_t)(rowbase + n * 256) * EV_N + EC_KB + h * 64; const bf16* vg = proj + (size_t)(rowbase + n * 256) * EV_N + EC_VB + h * 64;
#pragma unroll
        for (int i = 0; i < 4; ++i) { const int p = tid + i * NTHR;
            { const int r = p & 31, c = (p >> 5) & 7, st = p >> 8; const v4u v = *(const v4u*)(kg + (size_t)(st * 32 + r) * EV_N + c * 8); *(LAS v4u*)(lds + st * 4096 + c * 512 + r * 16) = v; }
            { const int cc = p & 3, row = (p >> 2) & 255, dh = p >> 10; const v4u v = *(const v4u*)(vg + (size_t)row * EV_N + dh * 32 + cc * 8); *(LAS v4u*)(lds + 32768 + dh * 16384 + row * 64 + cc * 16) = v; } }
        for (int d = tid; d < 1024; d += NTHR) lut[d] = a.in[9][t5_bucket(d) * 16 + 8 + h] * LOG2E; }
    if (tid == 0) misc[16] = 0u;
    __syncthreads();
    unsigned sv[16];
#pragma unroll
    for (int k = 0; k < 16; ++k) { const int t = (n + 1) * 256 + k * NTHR + tid; sv[k] = t < SEQ ? sel3[(size_t)(rowbase + t) * 8 + h] : 0u; }
#pragma unroll
    for (int k = 0; k < 16; ++k) { const int tb = (n + 1) * 256 + k * NTHR; if (tb < SEQ) { const int t = tb + tid;
        const unsigned s = sv[k]; const unsigned nv = s >> 24; int slot = -1;
        if (nv > 0u && (s & 255u) == (unsigned)n) slot = 0; else if (nv > 1u && ((s >> 8) & 255u) == (unsigned)n) slot = 1; else if (nv > 2u && ((s >> 16) & 255u) == (unsigned)n) slot = 2;
        const unsigned long long bal = __ballot(slot >= 0); const unsigned wcnt = __popcll(bal);
        if (lane == 0) misc[wave] = wcnt;
        __syncthreads();
        unsigned off = misc[16], tot = 0u;
#pragma unroll
        for (int w = 0; w < 8; ++w) { const unsigned c = misc[w]; if (w < wave) off += c; tot += c; }
        if (slot >= 0) list[off + __popcll(bal & ((1ull << lane) - 1ull))] = ((unsigned)t << 2) | (unsigned)slot;
        __syncthreads();
        if (tid == 0) misc[16] += tot; } }
    __syncthreads();
    const int nlist = (int)misc[16];
    const int ntl = (nlist + 31) >> 5, hi = lane >> 5;
    bf16x8 qa[4], qb2[4];
    moba_qload(qa, proj, rowbase, h, n * 256 + wave * 32 + (lane & 31), hi);
    unsigned ea = 0u, eb = 0u; bool va = false, vb = false;
    int tl = wave;
    if (tl < ntl) { const int li = tl * 32 + (lane & 31); vb = li < nlist; eb = list[vb ? li : nlist - 1]; moba_qload(qb2, proj, rowbase, h, (int)(eb >> 2), hi); }
    moba_tile(F, qa, rowbase, h, n, n * 256 + wave * 32 + (lane & 31), true, 3, true, wave);
    for (; tl < ntl; tl += 16) {
        const int t2 = tl + 8, t3 = tl + 16;
        if (t2 < ntl) { const int li = t2 * 32 + (lane & 31); va = li < nlist; ea = list[va ? li : nlist - 1]; moba_qload(qa, proj, rowbase, h, (int)(ea >> 2), hi); }
        moba_tile(F, qb2, rowbase, h, n, (int)(eb >> 2), vb, (int)(eb & 3u), false, 0);
        if (t2 < ntl) {
            if (t3 < ntl) { const int li = t3 * 32 + (lane & 31); vb = li < nlist; eb = list[vb ? li : nlist - 1]; moba_qload(qb2, proj, rowbase, h, (int)(eb >> 2), hi); }
            moba_tile(F, qa, rowbase, h, n, (int)(ea >> 2), va, (int)(ea & 3u), false, 0); }
    }
}

DI void dsa_step(const bf16x8 (&af)[2][4], const bf16x8 (&qlf)[4], int ch, LAS const unsigned char* bsel, LAS unsigned char* cbuf, LAS const float* tab,
                 float& m, float& l, f32x4 (&oT)[8], int l15, int kg, int lane) {
    f32x4 acc[2];
#pragma unroll
    for (int mt = 0; mt < 2; ++mt) { const unsigned b4 = *(LAS const unsigned*)(bsel + ch * 32 + mt * 16 + 4 * kg);
#pragma unroll
        for (int i = 0; i < 4; ++i) { const unsigned bb = (b4 >> (8 * i)) & 255u; const float tb = tab[(bb & 31u) * 8 + (l15 & 7)];
            acc[mt][i] = (tb - m) + (bb != 255u ? 0.f : -INFINITY); } }
#pragma unroll
    for (int mt = 0; mt < 2; ++mt)
#pragma unroll
        for (int ks = 0; ks < 4; ++ks) { acc[mt] = mfma16(af[mt][ks], qlf[ks], acc[mt]); *(LAS bf16x8*)(cbuf + (mt * 16 + l15) * 288 + (ks * 32 + kg * 8) * 2) = af[mt][ks]; }
    float mx = fmaxf(fmaxf(fmaxf(acc[0][0], acc[0][1]), fmaxf(acc[0][2], acc[0][3])), fmaxf(fmaxf(acc[1][0], acc[1][1]), fmaxf(acc[1][2], acc[1][3])));
    mx = fmaxf(mx, __shfl_xor(mx, 16)); mx = fmaxf(mx, __shfl_xor(mx, 32));
    if (__any(mx > 16.f)) { const float dl = fmaxf(mx, 0.f), sc = ex2(-dl); m += dl; l *= sc;
#pragma unroll
        for (int mt = 0; mt < 2; ++mt) acc[mt] = acc[mt] - dl;
#pragma unroll
        for (int ct = 0; ct < 8; ++ct) oT[ct] = oT[ct] * sc; }
    float ps = 0.f;
#pragma unroll
    for (int mt = 0; mt < 2; ++mt)
#pragma unroll
        for (int i = 0; i < 4; ++i) { acc[mt][i] = ex2(acc[mt][i]); ps += acc[mt][i]; }
    l += ps;
    v4u pw; pw.x = cvtpk(acc[0][0], acc[0][1]); pw.y = cvtpk(acc[0][2], acc[0][3]); pw.z = cvtpk(acc[1][0], acc[1][1]); pw.w = cvtpk(acc[1][2], acc[1][3]);
    const bf16x8 pf = __builtin_bit_cast(bf16x8, pw);
    LDS_WAIT();
    LAS const char* tp = (LAS const char*)cbuf + (4 * kg + (l15 >> 2)) * 288 + (lane & 3) * 8;
#pragma unroll
    for (int ct = 0; ct < 8; ++ct) { const bf16x8 cf = cat8(vtr(tp + ct * 32), vtr(tp + 16 * 288 + ct * 32)); oT[ct] = mfma16(cf, pf, oT[ct]); }
    LDS_WAIT();
}
DI void dsa_gather(bf16x8 (&af)[2][4], const bf16* ckvn, int rowbase, LAS const unsigned short* selb, int ch, int l15, int kg) {
#pragma unroll
    for (int mt = 0; mt < 2; ++mt) { unsigned idx = selb[ch * 32 + mt * 16 + l15]; if (idx == 0xffffu) idx = 0u;
        const bf16* cp = ckvn + (size_t)(rowbase + (int)idx) * 128 + kg * 8;
#pragma unroll
        for (int ks = 0; ks < 4; ++ks) af[mt][ks] = *(const bf16x8*)(cp + ks * 32); }
}
DI void dsa_query(const Fr& F, int tok, const v2u sv, LAS unsigned char* wl, LAS const unsigned char* bkt, LAS const float* tab) {
    const bf16* ql = (const bf16*)(F.ws + WS_QL); const bf16* ckvn = (const bf16*)(F.ws + WS_CKVN); const unsigned short* sel = (const unsigned short*)(F.ws + WS_SEL); bf16* ol = (bf16*)(F.ws + WS_OL);
    const int lane = F.lane, l15 = lane & 15, kg = lane >> 4, t = tok % SEQ, rowbase = tok - t;
    LAS unsigned short* selb = (LAS unsigned short*)wl; LAS unsigned char* bsel = wl + 512; LAS unsigned char* cbuf = wl + 1024;
    { *((LAS v2u*)selb + lane) = sv; unsigned bw = 0u;
#pragma unroll
        for (int i = 0; i < 4; ++i) { const unsigned s = (i < 2 ? (sv.x >> (16 * i)) : (sv.y >> (16 * (i - 2)))) & 0xffffu; const int dist = t - (int)s;
            const unsigned bb = (s != 0xffffu && dist >= 0) ? (unsigned)bkt[dist > 1023 ? 1023 : dist] : 255u; bw |= bb << (8 * i); }
        *((LAS unsigned*)bsel + lane) = bw; }
    bf16x8 qlf[4];
#pragma unroll
    for (int ks = 0; ks < 4; ++ks) { qlf[ks] = *(const bf16x8*)(ql + (size_t)tok * 1024 + (l15 & 7) * 128 + ks * 32 + kg * 8); if (l15 >= 8) qlf[ks] = (bf16x8){0, 0, 0, 0, 0, 0, 0, 0}; }
    float m = 0.f, l = 0.f; f32x4 oT[8];
#pragma unroll
    for (int ct = 0; ct < 8; ++ct) oT[ct] = (f32x4){0.f, 0.f, 0.f, 0.f};
    const int nvalid = t + 1 < 256 ? t + 1 : 256, nch = (nvalid + 31) >> 5;
    LDS_WAIT();
    bf16x8 afa[2][4], afb[2][4], afc[2][4];
    dsa_gather(afa, ckvn, rowbase, selb, 0, l15, kg);
    if (nch > 1) dsa_gather(afb, ckvn, rowbase, selb, 1, l15, kg);
    for (int ch = 0; ch < nch; ch += 3) {
        if (ch + 2 < nch) dsa_gather(afc, ckvn, rowbase, selb, ch + 2, l15, kg);
        dsa_step(afa, qlf, ch, bsel, cbuf, tab, m, l, oT, l15, kg, lane);
        if (ch + 1 < nch) { if (ch + 3 < nch) dsa_gather(afa, ckvn, rowbase, selb, ch + 3, l15, kg);
            dsa_step(afb, qlf, ch + 1, bsel, cbuf, tab, m, l, oT, l15, kg, lane); }
        if (ch + 2 < nch) { if (ch + 4 < nch) dsa_gather(afb, ckvn, rowbase, selb, ch + 4, l15, kg);
            dsa_step(afc, qlf, ch + 2, bsel, cbuf, tab, m, l, oT, l15, kg, lane); }
    }
    l += __shfl_xor(l, 16); l += __shfl_xor(l, 32);
    const float inv = 1.f / l;
    if (l15 < 8) { bf16* o = ol + (size_t)tok * 1024 + l15 * 128 + 4 * kg;
#pragma unroll
        for (int ct = 0; ct < 8; ++ct) { v2u w; w.x = cvtpk(oT[ct][0] * inv, oT[ct][1] * inv); w.y = cvtpk(oT[ct][2] * inv, oT[ct][3] * inv); *(v2u*)(o + ct * 16) = w; } }
}
DI void dsa_chunk(const Args& a, const Fr& F, int c32) {
    LAS unsigned char* bkt = F.lds + 81920; LAS float* tab = (LAS float*)(F.lds + 82944);
    __syncthreads();
    for (int d = F.tid; d < 1024; d += NTHR) bkt[d] = (unsigned char)t5_bucket(d);
    if (F.tid < 256) tab[F.tid] = a.in[9][(F.tid >> 3) * 16 + (F.tid & 7)] * LOG2E;
    __syncthreads();
    const unsigned short* selg = (const unsigned short*)(F.ws + WS_SEL); v2u svq[4];
#pragma unroll
    for (int i = 0; i < 4; ++i) svq[i] = *((const v2u*)(selg + (size_t)(c32 * 32 + F.wave * 4 + i) * 256) + F.lane);
#pragma unroll
    for (int i = 0; i < 4; ++i) dsa_query(F, c32 * 32 + F.wave * 4 + i, svq[i], F.lds + F.wave * 10240, bkt, tab);
}

DI void ph_even_post(const Fr& F, int j) {
    const bf16* ol = (const bf16*)(F.ws + WS_OL); bf16* ao = (bf16*)(F.ws + WS_AO);
    const bf16* wuvt = (const bf16*)(F.ws + WS_WUVT) + (size_t)j * 8 * 64 * 128;
    const bf16* po = (const bf16*)(F.ws + WS_ACT); const float* pml = (const float*)(F.ws + WS_PML); const unsigned* sel3 = (const unsigned*)(F.ws + WS_SEL3);
    const int lane = F.lane, wave = F.wave, l15 = lane & 15, kg = lane >> 4;
    for (int chunk = F.blk; chunk < 256; chunk += F.G) { const int tok0 = chunk * 128;
        { const int h = wave; bf16x8 af[4][4];
#pragma unroll
            for (int mt = 0; mt < 4; ++mt)
#pragma unroll
                for (int ks = 0; ks < 4; ++ks) af[mt][ks] = *(const bf16x8*)(wuvt + ((size_t)h * 64 + mt * 16 + l15) * 128 + ks * 32 + kg * 8);
#pragma unroll 1
            for (int tg = 0; tg < 8; tg += 2) { bf16x8 bf[2][4];
#pragma unroll
                for (int u = 0; u < 2; ++u)
#pragma unroll
                    for (int ks = 0; ks < 4; ++ks) bf[u][ks] = *(const bf16x8*)(ol + (size_t)(tok0 + (tg + u) * 16 + l15) * 1024 + h * 128 + ks * 32 + kg * 8);
#pragma unroll
                for (int u = 0; u < 2; ++u) { const int tok = tok0 + (tg + u) * 16 + l15;
#pragma unroll
                    for (int mt = 0; mt < 4; ++mt) { f32x4 d = {0.f, 0.f, 0.f, 0.f};
#pragma unroll
                        for (int ks = 0; ks < 4; ++ks) d = mfma16(af[mt][ks], bf[u][ks], d);
                        v2u w; w.x = cvtpk(d[0], d[1]); w.y = cvtpk(d[2], d[3]); *(v2u*)(ao + (size_t)tok * 1024 + h * 64 + mt * 16 + 4 * kg) = w; } } } }
#pragma unroll 1
        for (int i0 = 0; i0 < 16; i0 += 4) { const int h = lane >> 3, d0 = (lane & 7) * 8; unsigned nvv[4]; f32x2 mlv[4][4];
#pragma unroll
            for (int i = 0; i < 4; ++i) { const int tok = tok0 + wave * 16 + i0 + i; const size_t pi = ((size_t)tok * 8 + h) * 4; nvv[i] = sel3[(size_t)tok * 8 + h] >> 24;
#pragma unroll
                for (int s = 0; s < 4; ++s) mlv[i][s] = *(const f32x2*)(pml + (pi + s) * 2); }
#pragma unroll
            for (int i = 0; i < 4; ++i) { const int tok = tok0 + wave * 16 + i0 + i; const size_t pi = ((size_t)tok * 8 + h) * 4;
                float mj[4], lj[4];
#pragma unroll
                for (int s = 0; s < 4; ++s) { const bool ok = (s == 3) || ((unsigned)s < nvv[i]); mj[s] = ok ? mlv[i][s][0] : -1e30f; lj[s] = ok ? mlv[i][s][1] : 0.f; }
                const float ms = fmaxf(fmaxf(mj[0], mj[1]), fmaxf(mj[2], mj[3])); float wsum = 0.f, acc[8], wv[4]; v4u pv[4];
#pragma unroll
                for (int k = 0; k < 8; ++k) acc[k] = 0.f;
#pragma unroll
                for (int s = 0; s < 4; ++s) { wv[s] = lj[s] * ex2(mj[s] - ms); wsum += wv[s]; pv[s] = (v4u){0u, 0u, 0u, 0u}; if (wv[s] > 0.f) pv[s] = *(const v4u*)(po + (pi + s) * 64 + d0); }
#pragma unroll
                for (int s = 0; s < 4; ++s) { if (wv[s] > 0.f) {
#pragma unroll
                    for (int k = 0; k < 4; ++k) { acc[2 * k] += wv[s] * bf2f(pv[s][k] & 0xffffu); acc[2 * k + 1] += wv[s] * bf2f(pv[s][k] >> 16); } } }
                const float inv = 1.f / wsum; v4u o; o.x = cvtpk(acc[0] * inv, acc[1] * inv); o.y = cvtpk(acc[2] * inv, acc[3] * inv); o.z = cvtpk(acc[4] * inv, acc[5] * inv); o.w = cvtpk(acc[6] * inv, acc[7] * inv);
                *(v4u*)(ao + (size_t)tok * 1024 + 512 + h * 64 + d0) = o; } }
    }
}
template <class XT> DI f32x4 ld_x4(const XT* p);
template <> DI f32x4 ld_x4<float>(const float* p) { return *(const f32x4*)p; }
template <> DI f32x4 ld_x4<bf16>(const bf16* p) { const v2u w = *(const v2u*)p; return (f32x4){bf2f(w.x & 0xffffu), bf2f(w.x >> 16), bf2f(w.y & 0xffffu), bf2f(w.y >> 16)}; }
template <class XT> DI f32x16 proj32_f32(const float* W, int ldw, int ncols, const XT* xrow, int d_lo, int lane) {
    const int e = lane & 31, kh = lane >> 5; const bool ev = e < ncols;
    f32x16 D;
#pragma unroll
    for (int r = 0; r < 16; ++r) D[r] = 0.f;
    const float* wp = W + (size_t)(d_lo + 4 * kh) * ldw + (ev ? e : 0);
    const XT* xp = xrow + d_lo + 4 * kh;
#pragma unroll 8
    for (int i = 0; i < 64; ++i) { const f32x4 xv = ld_x4<XT>(xp + 8 * i);
        float a0 = wp[(size_t)(8 * i + 0) * ldw], a1 = wp[(size_t)(8 * i + 1) * ldw], a2 = wp[(size_t)(8 * i + 2) * ldw], a3 = wp[(size_t)(8 * i + 3) * ldw];
        if (!ev) { a0 = 0.f; a1 = 0.f; a2 = 0.f; a3 = 0.f; }
        D = __builtin_amdgcn_mfma_f32_32x32x2f32(a0, xv[0], D, 0, 0, 0); D = __builtin_amdgcn_mfma_f32_32x32x2f32(a1, xv[1], D, 0, 0, 0);
        D = __builtin_amdgcn_mfma_f32_32x32x2f32(a2, xv[2], D, 0, 0, 0); D = __builtin_amdgcn_mfma_f32_32x32x2f32(a3, xv[3], D, 0, 0, 0); }
    return D;
}
DI void ph_odd_prep(const Args& a, const Fr& F, int j, int layer) {
    const bf16* proj = (const bf16*)(F.ws + WS_PROJ); const bf16* x = (const bf16*)(F.ws + WS_XB);
    float* logf = (float*)(F.ws + WS_LOGF); float* cs = (float*)(F.ws + WS_CS);
    const float* wf = a.in[6] + (size_t)j * 1024 * 3088 + 3072; const float* bfv = a.in[7] + j * 16;
    LAS float* red = (LAS float*)(F.lds); LAS float* lfb = (LAS float*)(F.lds + 131072);
    LAS unsigned* kmx = (LAS unsigned*)(F.lds + 131072 + 8192);
    const int lane = F.lane, wave = F.wave, tid = F.tid, l31 = lane & 31, hi = lane >> 5;
    for (int chunk = F.blk; chunk < 256; chunk += F.G) { const int tok0 = chunk * 128, b = tok0 / SEQ, t0 = tok0 % SEQ;
        __syncthreads();
        if (tid < 16) kmx[tid] = 0u;
        const int tl = wave & 3, kr = wave >> 2;
        f32x16 D = proj32_f32(wf, 3088, 16, x + (size_t)(tok0 + tl * 32 + l31) * DM, kr * 512, lane);
        if (kr == 1) {
#pragma unroll
            for (int r = 0; r < 8; ++r) red[(tl * 8 + r) * 64 + lane] = D[r]; }
        __syncthreads();
        if (kr == 0) {
#pragma unroll
            for (int r = 0; r < 8; ++r) { const int h = (r & 3) + 8 * (r >> 2) + 4 * hi; const float z = D[r] + red[(tl * 8 + r) * 64 + lane] + bfv[h];
                const float ls = fminf(z, 0.f) - log1pf(__expf(-fabsf(z)));
                lfb[(tl * 32 + l31) * 16 + h] = ls * LOG2E; } }
#pragma unroll 1
        for (int i = 0; i < 4; ++i) { const int p = tid + i * NTHR, tk = p >> 4, h = p & 15; const v4u* kp = (const v4u*)(proj + (size_t)(tok0 + tk) * OD_N + OC_K + h * 64); float s = 0.f;
#pragma unroll
            for (int c = 0; c < 8; ++c) { const v4u w = kp[c];
#pragma unroll
                for (int k = 0; k < 4; ++k) { const float e0 = bf2f(w[k] & 0xffffu), e1 = bf2f(w[k] >> 16); s += e0 * e0 + e1 * e1; } }
            __hip_atomic_fetch_max(kmx + h, __float_as_uint(s), __ATOMIC_RELAXED, __HIP_MEMORY_SCOPE_WORKGROUP); }
        __syncthreads();
        for (int i = tid; i < 2048; i += NTHR) { const int h = i >> 7, tk = i & 127; logf[((size_t)b * 16 + h) * SEQ + t0 + tk] = lfb[tk * 16 + h]; }
        if (tid < 32) { const int h = tid & 15, c = tid >> 4; float s = 0.f;
            for (int k = 0; k < 64; ++k) s += lfb[(c * 64 + k) * 16 + h];
            cs[((size_t)b * 16 + h) * 128 + (t0 >> 6) + c] = s; }
        if (tid < 16) __hip_atomic_fetch_max(F.ctl + CW_KMAX + layer * 64 + b * 16 + tid, kmx[tid], RLX_AGENT);
    }
}

constexpr float FOX_SKIP_LOG2 = 64.f;
struct FoxBias { LAS const float* ng; int tq, kabs0; bool any;
    DI float b(int kvrel) const { return ng[kvrel]; }
    DI bool msk(int kvrel) const { return (kabs0 + kvrel) > tq; } };
DI void fox_unit(const Fr& F, int layer, int b, int h, int qb) {
    const bf16* proj = (const bf16*)(F.ws + WS_PROJ); const float* logf = (const float*)(F.ws + WS_LOGF); const float* cs = (const float*)(F.ws + WS_CS); bf16* ao = (bf16*)(F.ws + WS_AO);
    LAS unsigned char* lds = F.lds; LAS float* ng = (LAS float*)(lds + 32768); LAS float* red = (LAS float*)(lds + 65536 + 1024); LAS int* ibox = (LAS int*)(lds + 65536 + 2048);
    const int tid = F.tid, lane = F.lane, wave = F.wave, r32 = lane & 31, hi = lane >> 5, t0 = qb * 256, rowbase = b * SEQ, tq = t0 + wave * 32 + r32;
    __syncthreads();
    bf16x8 qf[4]; float qs = 0.f;
    { const bf16* qp = proj + (size_t)(rowbase + tq) * OD_N + OC_Q + h * 64 + hi * 8;
#pragma unroll
        for (int s = 0; s < 4; ++s) { qf[s] = *(const bf16x8*)(qp + s * 16);
#pragma unroll
            for (int k = 0; k < 8; ++k) { const float e = bf2f((unsigned short)qf[s][k]); qs += e * e; } } }
    qs += __shfl_xor(qs, 32); qs = wave_max(qs);
    if (lane == 0) red[wave] = qs;
    if (tid < 128) red[32 + tid] = (tid < t0 / 64) ? cs[((size_t)b * 16 + h) * 128 + tid] : 0.f;
    __syncthreads();
    if (tid == 0) { float qm = red[0];
        for (int w = 1; w < 8; ++w) qm = fmaxf(qm, red[w]);
        const float km = __uint_as_float(ld_u32(F.ctl + CW_KMAX + layer * 64 + b * 16 + h));
        const float B2 = 2.f * (sqrtf(qm * km) * 1.01f + 1.f);
        int kt = t0 / 64 - 1, kts = t0 / 64; float D = 0.f;
        while (kt >= 0 && B2 + D >= -FOX_SKIP_LOG2) { kts = kt; D += red[32 + kt]; --kt; }
        ibox[0] = kts; }
    __syncthreads();
    const int kts = ibox[0], s_start = kts * 64, nel = t0 + 256 - s_start;
    { const int i0 = tid * 16; float v[16]; const float* lp = logf + ((size_t)b * 16 + h) * SEQ + s_start + i0;
        if (i0 < nel) {
#pragma unroll
            for (int c = 0; c < 4; ++c) { const f32x4 w = *(const f32x4*)(lp + 4 * c); v[4 * c] = w[0]; v[4 * c + 1] = w[1]; v[4 * c + 2] = w[2]; v[4 * c + 3] = w[3]; } }
        else {
#pragma unroll
            for (int c = 0; c < 16; ++c) v[c] = 0.f; }
#pragma unroll
        for (int c = 1; c < 16; ++c) v[c] += v[c - 1];
        float xsum = v[15];
#pragma unroll
        for (int o = 1; o < 64; o <<= 1) { const float y = __shfl_up(xsum, o); if (lane >= o) xsum += y; }
        if (lane == 63) red[16 + wave] = xsum;
        __syncthreads();
        float off = xsum - v[15];
        for (int w = 0; w < wave; ++w) off += red[16 + w];
        if (i0 < nel) {
#pragma unroll
            for (int c = 0; c < 4; ++c) { f32x4 w = {-(off + v[4 * c]), -(off + v[4 * c + 1]), -(off + v[4 * c + 2]), -(off + v[4 * c + 3])}; *(LAS f32x4*)(ng + i0 + 4 * c) = w; } }
    }
    const int ntile = t0 / 64 + 4 - kts;
    const bf16* kg = proj + (size_t)rowbase * OD_N + OC_K + h * 64; const bf16* vg = proj + (size_t)rowbase * OD_N + OC_V + h * 64;
    const int kr = tid & 31, kc = (tid >> 5) & 7, kst = tid >> 8, vcc = tid & 3, vrow = (tid >> 2) & 63, vdh = tid >> 8;
    const int koff = kst * 4096 + kc * 512 + kr * 16, voff = 8192 + vdh * 4096 + vrow * 64 + vcc * 16;
    { const v4u kv = *(const v4u*)(kg + (size_t)(kts * 64 + kst * 32 + kr) * OD_N + kc * 8), vv = *(const v4u*)(vg + (size_t)(kts * 64 + vrow) * OD_N + vdh * 32 + vcc * 8);
        *(LAS v4u*)(lds + koff) = kv; *(LAS v4u*)(lds + voff) = vv; }
    __syncthreads();
    AttSt S; S.m = 0.f; S.l = 0.f;
#pragma unroll
    for (int r = 0; r < 16; ++r) { S.o0[r] = 0.f; S.o1[r] = 0.f; }
    const int wlast = t0 + wave * 32 + 31, wfirst = t0 + wave * 32;
    for (int i = 0; i < ntile; ++i) { const int kt = kts + i; LAS unsigned char* buf = lds + (i & 1) * 16384; LAS unsigned char* nbuf = lds + ((i + 1) & 1) * 16384;
        v4u kv, vv; const bool more = i + 1 < ntile;
        if (more) { kv = *(const v4u*)(kg + (size_t)((kt + 1) * 64 + kst * 32 + kr) * OD_N + kc * 8); vv = *(const v4u*)(vg + (size_t)((kt + 1) * 64 + vrow) * OD_N + vdh * 32 + vcc * 8); }
        { const int kv0 = kt * 64;
            if (kv0 + 32 <= wlast) { FoxBias bf0{ng + (kv0 - s_start), tq, kv0, kv0 + 31 > wfirst}, bf1{ng + (kv0 + 32 - s_start), tq, kv0 + 32, kv0 + 63 > wfirst};
                att_tile64(S, qf, (LAS const char*)buf, (LAS const char*)buf + 8192, 4096, 0, lane, bf0, bf1); }
            else if (kv0 <= wlast) { FoxBias bf{ng + (kv0 - s_start), tq, kv0, kv0 + 31 > wfirst};
                att_subtile(S, qf, (LAS const char*)buf, (LAS const char*)buf + 8192, 4096, 0, lane, bf); } }
        if (more) { *(LAS v4u*)(nbuf + koff) = kv; *(LAS v4u*)(nbuf + voff - 8192 + 8192) = vv; }
        __syncthreads(); }
    const float lt = S.l + __shfl_xor(S.l, 32), inv = 1.f / lt;
    bf16* o = ao + (size_t)(rowbase + tq) * 1024 + h * 64;
#pragma unroll
    for (int a4 = 0; a4 < 4; ++a4) { v2u w0, w1;
        w0.x = cvtpk(S.o0[4 * a4] * inv, S.o0[4 * a4 + 1] * inv); w0.y = cvtpk(S.o0[4 * a4 + 2] * inv, S.o0[4 * a4 + 3] * inv);
        w1.x = cvtpk(S.o1[4 * a4] * inv, S.o1[4 * a4 + 1] * inv); w1.y = cvtpk(S.o1[4 * a4 + 2] * inv, S.o1[4 * a4 + 3] * inv);
        *(v2u*)(o + 8 * a4 + 4 * hi) = w0; *(v2u*)(o + 32 + 8 * a4 + 4 * hi) = w1; }
}

DI void ph_ln1_router(const Args& a, const Fr& F, int layer) {
    const bf16* yp = (const bf16*)(F.ws + WS_YP); bf16* x1 = (bf16*)(F.ws + WS_X1); unsigned char* xb8 = F.ws + WS_XB8;
    unsigned* tope = (unsigned*)(F.ws + WS_TOPE); float* gate = (float*)(F.ws + WS_GATE); unsigned* rank = (unsigned*)(F.ws + WS_RANK);
    const float* g = a.in[10] + (size_t)(layer * 2) * DM; const float* bb = a.in[11] + (size_t)(layer * 2) * DM;
    const float* rw = a.in[12] + (size_t)layer * 1024 * 32; const float* rb = a.in[13] + layer * 32;
    LAS float* red = (LAS float*)(F.lds); LAS unsigned* lcnt = (LAS unsigned*)(F.lds + 131072);
    const int lane = F.lane, wave = F.wave, tid = F.tid, l31 = lane & 31, hi = lane >> 5;
    for (int chunk = F.blk; chunk < 256; chunk += F.G) { const int tok0 = chunk * 128;
        __syncthreads();
        if (tid < 32) lcnt[tid] = 0u;
#pragma unroll 1
        for (int k = 0; k < 16; k += 8) { f32x4 v[8][4];
#pragma unroll
            for (int i = 0; i < 8; ++i)
#pragma unroll
                for (int jj = 0; jj < 4; ++jj) { const v2u w = *((const v2u*)(yp + (size_t)(tok0 + wave * 16 + k + i) * DM) + lane + 64 * jj);
                    v[i][jj] = (f32x4){bf2f(w.x & 0xffffu), bf2f(w.x >> 16), bf2f(w.y & 0xffffu), bf2f(w.y >> 16)}; }
#pragma unroll
            for (int i = 0; i < 8; ++i) { const int tok = tok0 + wave * 16 + k + i;
                ln_row(v[i], g, bb, lane);
                store_row_bf16(x1 + (size_t)tok * DM, v[i], lane);
#pragma unroll
                for (int jj = 0; jj < 4; ++jj) *((unsigned*)(xb8 + (size_t)tok * DM) + lane + 64 * jj) = pk4_fp8(v[i][jj][0] * F8_SX, v[i][jj][1] * F8_SX, v[i][jj][2] * F8_SX, v[i][jj][3] * F8_SX); } }
        asm volatile("s_waitcnt vmcnt(0)" ::: "memory");
        __syncthreads();
        const int tl = wave & 3, kr = wave >> 2, tokl = tok0 + tl * 32 + l31;
        f32x16 D = proj32_f32(rw, 32, 32, x1 + (size_t)tokl * DM, kr * 512, lane);
        if (kr == 1) {
#pragma unroll
            for (int r = 0; r < 16; ++r) red[(tl * 16 + r) * 64 + lane] = D[r]; }
        __syncthreads();
        if (kr == 0) {
            float lv[32];
#pragma unroll
            for (int r = 0; r < 16; ++r) { const float own = D[r] + red[(tl * 16 + r) * 64 + lane] + rb[crow(r, hi)]; const float oth = __shfl_xor(own, 32);
                lv[crow(r, 0)] = hi == 0 ? own : oth; lv[crow(r, 1)] = hi == 0 ? oth : own; }
            float tv[4]; int te[4];
#pragma unroll
            for (int r = 0; r < 4; ++r) { float mx = -INFINITY; int me = 0;
#pragma unroll
                for (int e = 0; e < 32; ++e) { if (lv[e] > mx) { mx = lv[e]; me = e; } }
                tv[r] = mx; te[r] = me;
#pragma unroll
                for (int e = 0; e < 32; ++e) { if (e == me) lv[e] = -INFINITY; } }
            const float e1 = __expf(tv[1] - tv[0]), e2 = __expf(tv[2] - tv[0]), e3 = __expf(tv[3] - tv[0]); const float inv = 1.f / (1.f + e1 + e2 + e3);
            if (hi == 0) { const size_t o = (size_t)tokl * 4;
                const float gv[4] = {inv, e1 * inv, e2 * inv, e3 * inv};
#pragma unroll
                for (int r = 0; r < 4; ++r) { const unsigned rk = __hip_atomic_fetch_add(lcnt + (te[r] & 31), 1u, __ATOMIC_RELAXED, __HIP_MEMORY_SCOPE_WORKGROUP);
                    tope[o + r] = (unsigned)(te[r] & 31); gate[o + r] = gv[r]; rank[o + r] = rk; } } }
        __syncthreads();
        if (tid < 32) __hip_atomic_store(F.ctl + CW_CNT + chunk * 32 + tid, lcnt[tid], RLX_AGENT);
    }
}

DI void ph_route(const Fr& F) {
    const unsigned char* xb8 = F.ws + WS_XB8; unsigned char* xg = F.ws + WS_XG;
    const unsigned* tope = (const unsigned*)(F.ws + WS_TOPE); const unsigned* rank = (const unsigned*)(F.ws + WS_RANK); unsigned* dest = (unsigned*)(F.ws + WS_DEST);
    LAS unsigned* P = (LAS unsigned*)(F.lds); LAS unsigned* pst = P + 512; LAS unsigned* pad = P + 544; LAS unsigned* base = P + 576; LAS unsigned* nt = P + 608;
    const int tid = F.tid, lane = F.lane, wave = F.wave;
    __syncthreads();
    { const int e = tid & 31, part = tid >> 5; unsigned s = 0u;
        for (int c = 0; c < 16; ++c) s += ld_u32(F.ctl + CW_CNT + (part * 16 + c) * 32 + e);
        P[part * 32 + e] = s; }
    __syncthreads();
    if (tid < 32) { unsigned tot = 0u;
        for (int p = 0; p < 16; ++p) tot += P[p * 32 + tid];
        pad[tid] = (tot + 255u) & ~255u; }
    __syncthreads();
    if (tid == 0) { unsigned acc = 0u;
        for (int e = 0; e < 32; ++e) { pst[e] = acc; acc += pad[e]; }
        nt[0] = acc >> 8; }
    __syncthreads();
    for (int chunk = F.blk; chunk < 256; chunk += F.G) {
        __syncthreads();
        if (tid < 32) { unsigned off = 0u; const int pf = chunk >> 4;
            for (int p = 0; p < pf; ++p) off += P[p * 32 + tid];
            for (int c = pf * 16; c < chunk; ++c) off += ld_u32(F.ctl + CW_CNT + c * 32 + tid);
            base[tid] = pst[tid] + off; }
        __syncthreads();
#pragma unroll 1
        for (int i0 = 0; i0 < 16; i0 += 4) { v4u src[4]; unsigned ee[4][4], rr[4][4];
#pragma unroll
            for (int i = 0; i < 4; ++i) { const int tok = chunk * 128 + wave * 16 + i0 + i; src[i] = *((const v4u*)(xb8 + (size_t)tok * DM) + lane);
#pragma unroll
                for (int k = 0; k < 4; ++k) { ee[i][k] = tope[(size_t)tok * 4 + k]; rr[i][k] = rank[(size_t)tok * 4 + k]; } }
#pragma unroll
            for (int i = 0; i < 4; ++i) { const int tok = chunk * 128 + wave * 16 + i0 + i;
#pragma unroll
                for (int k = 0; k < 4; ++k) { const unsigned d = base[ee[i][k]] + rr[i][k];
                    if (lane == 0) dest[(size_t)tok * 4 + k] = d;
                    *((v4u*)(xg + (size_t)d * DM) + lane) = src[i]; } } }
        if (chunk == 0) { const unsigned ntl = nt[0];
            if (tid == 0) __hip_atomic_store(F.ctl + CW_TILE, ntl, RLX_AGENT);
            for (unsigned i = tid; i < ntl; i += NTHR) { unsigned e = 0u;
                for (unsigned k = 1; k < 32; ++k) if (pst[k] <= i * 256u) e = k;
                __hip_atomic_store(F.ctl + CW_TILE + 64 + i, e, RLX_AGENT); } }
    }
}

DI void ph_combine_ln2(const Args& a, const Fr& F, int layer) {
    const bf16* x1 = (const bf16*)(F.ws + WS_X1); const unsigned char* yr = F.ws + WS_XG; bf16* xb = (bf16*)(F.ws + WS_XB);
    const float* gate = (const float*)(F.ws + WS_GATE); const unsigned* dest = (const unsigned*)(F.ws + WS_DEST);
    const float* g = a.in[10] + (size_t)(layer * 2 + 1) * DM; const float* bb = a.in[11] + (size_t)(layer * 2 + 1) * DM;
    const int lane = F.lane; const int gw = F.blk * NWAVES + F.wave, NGW = F.G * NWAVES;
    for (int tok = gw; tok < NTOK; tok += 4 * NGW) { f32x4 v[4][4];
#pragma unroll
        for (int i = 0; i < 4; ++i) { const int tk = tok + i * NGW; if (tk < NTOK) {
#pragma unroll
            for (int jj = 0; jj < 4; ++jj) { const v2u w = *((const v2u*)(x1 + (size_t)tk * DM) + lane + 64 * jj);
                v[i][jj] = (f32x4){bf2f(w.x & 0xffffu), bf2f(w.x >> 16), bf2f(w.y & 0xffffu), bf2f(w.y >> 16)} * ALPHA; }
#pragma unroll
            for (int k = 0; k < 4; ++k) { const float gk = gate[(size_t)tk * 4 + k] * (1.f / F8_SY); const unsigned d = dest[(size_t)tk * 4 + k];
#pragma unroll
                for (int jj = 0; jj < 4; ++jj) { const int w = (int)*((const unsigned*)(yr + (size_t)d * DM) + lane + 64 * jj);
                    const f32x2 lo = __builtin_amdgcn_cvt_pk_f32_fp8(w, false), hi2 = __builtin_amdgcn_cvt_pk_f32_fp8(w, true);
                    v[i][jj][0] += gk * lo[0]; v[i][jj][1] += gk * lo[1]; v[i][jj][2] += gk * hi2[0]; v[i][jj][3] += gk * hi2[1]; } } } }
#pragma unroll
        for (int i = 0; i < 4; ++i) { const int tk = tok + i * NGW; if (tk < NTOK) {
            ln_row(v[i], g, bb, lane);
            if (layer == DEPTH - 1) store_row_f32(a.out + (size_t)tk * DM, v[i], lane);
            else store_row_bf16(xb + (size_t)tk * DM, v[i], lane); } } }
}
constexpr int LDS_BYTES = 147456;
constexpr int LDS_BARW = 145408, LDS_QSLOT = 145472, LDS_TILE_E = 133632;
constexpr int NPL = 11;
constexpr int NPHASE = 1 + NPL * DEPTH;
#ifndef MK_SINGLE
#define MK_SINGLE 1
#endif
DI int q_next(const Fr& F, unsigned* ctr) {
    LAS int* slot = (LAS int*)(F.lds + LDS_QSLOT);
    __syncthreads();
    if (F.tid == 0) *slot = (int)__hip_atomic_fetch_add(ctr, 1u, RLX_AGENT);
    __syncthreads();
    return *slot;
}
DI int lane_id_fresh() { unsigned m_ = ~0u; asm volatile("" : "+s"(m_)); return (int)__builtin_amdgcn_mbcnt_hi(m_, __builtin_amdgcn_mbcnt_lo(m_, 0u)); }
#define RETID(F) do { int t2_ = F.tid; asm volatile("" : "+v"(t2_)); F.tid = t2_; F.lane = t2_ & 63; F.wave = __builtin_amdgcn_readfirstlane(t2_ >> 6); } while (0)
#ifndef PROBE_DUP
#define PROBE_DUP -1
#endif
#define NREP(q) ((PROBE_DUP == (q)) ? 2 : 1)
#define AS4 __attribute__((address_space(4)))
#define SITE() Args a; Fr F; { const AS4 Args* ap = (const AS4 Args*)__builtin_amdgcn_kernarg_segment_ptr(); asm volatile("" : "+s"(ap)); \
        _Pragma("unroll") for (int i_ = 0; i_ < 18; ++i_) a.in[i_] = ap->in[i_]; a.out = ap->out; a.ws = ap->ws; a.ph_lo = 0; a.ph_hi = 0; \
        int w_ = wv_s; asm volatile("" : "+s"(w_)); int t_ = w_ * 64 + lane_id_fresh(); asm volatile("" : "+v"(t_)); F.tid = t_; F.lane = t_ & 63; F.wave = __builtin_amdgcn_readfirstlane(t_ >> 6); \
        F.lds = (LAS unsigned char*)lds_raw; F.ws = a.ws; F.ctl = (unsigned*)(a.ws + WS_CTL); F.blk = blockIdx.x; F.G = gridDim.x; }
__global__ void __launch_bounds__(NTHR, 2) mega_fwd(Args a0) {
    extern __shared__ __attribute__((aligned(16))) unsigned char lds_raw[];
    const int wv_s = __builtin_amdgcn_readfirstlane((int)(threadIdx.x >> 6));
#if MK_SINGLE
    constexpr int lo = 0, hi = NPHASE; constexpr bool single = true;
#else
    const int lo = a0.ph_lo, hi = a0.ph_hi; constexpr bool single = false;
#endif
    if (threadIdx.x == 0) *(LAS v4u*)((LAS unsigned char*)lds_raw + LDS_BARW) = (v4u){0u, 0u, 0u, 0u};
    __syncthreads();
    if (single) (void)xcd_barrier_post((unsigned*)(a0.ws + WS_CTL) + CW_BAR, (volatile LAS unsigned*)((LAS unsigned char*)lds_raw + LDS_BARW));
#define IN(k) (lo <= (k) && (k) < hi)
#define SEAM() do { if (single) { const AS4 Args* ap_ = (const AS4 Args*)__builtin_amdgcn_kernarg_segment_ptr(); asm volatile("" : "+s"(ap_)); int w_ = wv_s; asm volatile("" : "+s"(w_)); \
        XcdBarrier b_; b_.bar = (unsigned*)(ap_->ws + WS_CTL) + CW_BAR; b_.x = xb_xcc_id(); b_.st = (volatile LAS unsigned*)((LAS unsigned char*)lds_raw + LDS_BARW); \
        xcd_barrier(b_, (w_ == 0) && (lane_id_fresh() == 0)); } } while (0)
    if (IN(0)) { _Pragma("unroll 1") for (int rep = 0; rep < NREP(100); ++rep) { { SITE(); ph_prologue(a, F); } SEAM(); } }
#pragma clang loop unroll(full)
    for (int L = 0; L < DEPTH; ++L) {
        const int pb = 1 + NPL * L, j = L >> 1; const bool odd = (L & 1) != 0;
        if (IN(pb + 0)) _Pragma("unroll 1") for (int rep = 0; rep < NREP(0); ++rep) {
            { SITE();
            const bf16* w = odd ? (const bf16*)(F.ws + WS_WOD) + (size_t)j * OD_N * 1024 : (const bf16*)(F.ws + WS_WEV) + (size_t)j * EV_N * 1024;
            const int N = odd ? OD_N : EV_N;
            pg8::Gemm g{(const bf16*)(F.ws + WS_XB), w, NTOK, N, 1024}; pg8::StaticOrder S; S.init(NTOK, N, F.G, F.blk);
            pg8::EpiBf16<0> E{(bf16*)(F.ws + WS_PROJ), N, nullptr, 1024, (size_t)1024, C2F};
            pg8::gemm_phase<pg8::EpiBf16<0>, pg8::StaticOrder, true, true>(F.lds, g, S, E, F.tid); }
            SEAM(); }
        if (IN(pb + 1)) _Pragma("unroll 1") for (int rep = 0; rep < NREP(1); ++rep) { { SITE(); if (odd) ph_odd_prep(a, F, j, L); else ph_even_prep(a, F, j); } SEAM(); }
        if (!odd && IN(pb + 2)) _Pragma("unroll 1") for (int rep = 0; rep < ((PROBE_DUP == 2 || (PROBE_DUP >= 21 && PROBE_DUP <= 22) || (PROBE_DUP >= 211 && PROBE_DUP <= 217)) ? 2 : 1); ++rep) {
            { SITE(); unsigned* ctr = F.ctl + CW_Q + 64 * (L * 2) + 1024 * rep;
            for (;;) { const int it = q_next(F, ctr); if (it >= 1280) break; RETID(F);
                if (it < 1024) { if (!(rep == 1 && PROBE_DUP == 22)) idx_unit(F, it & 3, 255 - (it >> 2), (rep == 1 && PROBE_DUP >= 211) ? PROBE_DUP - 210 : 0); } else { if (!(rep == 1 && (PROBE_DUP == 21 || PROBE_DUP >= 211))) moba_gate_chunk(F, it - 1024); } } }
            SEAM(); }
        if (IN(pb + 3)) _Pragma("unroll 1") for (int rep = 0; rep < ((PROBE_DUP == 3 || (PROBE_DUP == 31 && odd) || ((PROBE_DUP == 32 || PROBE_DUP == 33) && !odd)) ? 2 : 1); ++rep) {
            { SITE(); unsigned* ctr = F.ctl + CW_Q + 64 * (L * 2 + 1) + 1024 * rep;
            if (odd) { for (;;) { const int it = q_next(F, ctr); if (it >= 2048) break; RETID(F); const int bh = it & 63; fox_unit(F, L, bh >> 4, bh & 15, 31 - (it >> 6)); } }
            else { for (;;) { const int it = q_next(F, ctr); if (it >= 2048) break; RETID(F);
                    if (it < 1024) { const int bh = it & 31; if (!(rep == 1 && PROBE_DUP == 33)) moba_unit(a, F, bh >> 3, bh & 7, it >> 5); } else { if (!(rep == 1 && PROBE_DUP == 32)) dsa_chunk(a, F, it - 1024); } } } }
            SEAM(); }
        if (!odd && IN(pb + 4)) _Pragma("unroll 1") for (int rep = 0; rep < NREP(4); ++rep) { { SITE(); ph_even_post(F, j); } SEAM(); }
        if (IN(pb + 5)) _Pragma("unroll 1") for (int rep = 0; rep < NREP(5); ++rep) {
            { SITE();
            pg8::Gemm g{(const bf16*)(F.ws + WS_AO), (const bf16*)(F.ws + WS_WOUT) + (size_t)L * 1024 * 1024, NTOK, 1024, 1024}; pg8::StaticOrder S; S.init(NTOK, 1024, F.G, F.blk);
            EpiResBf16 E{(const bf16*)(F.ws + WS_XB), (bf16*)(F.ws + WS_YP), ALPHA};
            pg8::gemm_phase<EpiResBf16, pg8::StaticOrder, true, true>(F.lds, g, S, E, F.tid); }
            SEAM(); }
        if (IN(pb + 6)) _Pragma("unroll 1") for (int rep = 0; rep < NREP(6); ++rep) { { SITE(); ph_ln1_router(a, F, L); } SEAM(); }
        if (IN(pb + 7)) _Pragma("unroll 1") for (int rep = 0; rep < NREP(7); ++rep) { { SITE(); ph_route(F); } SEAM(); }
        if (IN(pb + 8)) _Pragma("unroll 1") for (int rep = 0; rep < NREP(8); ++rep) {
            { SITE(); const int ntl = (int)ld_u32(F.ctl + CW_TILE);
            LAS unsigned* tle = (LAS unsigned*)(F.lds + LDS_TILE_E);
            for (int i = F.tid; i < ntl; i += NTHR) tle[i] = ld_u32(F.ctl + CW_TILE + 64 + i);
            __syncthreads();
            pg8::Gemm g{(const bf16*)(F.ws + WS_XG), (const bf16*)(F.ws + WS_WGU + (size_t)L * 32 * 2048 * 1024), NR_MAX, 32 * 2048, 512};
            GroupOrder S{tle, ntl, 3, F.G, F.blk};
            EpiSwiglu E{F.ws + WS_ACT, a.in[15] + (size_t)L * 32 * 2048};
            pg8::gemm_phase<EpiSwiglu, GroupOrder, true, true, true>(F.lds, g, S, E, F.tid); }
            SEAM(); }
        if (IN(pb + 9)) _Pragma("unroll 1") for (int rep = 0; rep < NREP(9); ++rep) {
            { SITE(); const int ntl = (int)ld_u32(F.ctl + CW_TILE);
            LAS unsigned* tle = (LAS unsigned*)(F.lds + LDS_TILE_E);
            for (int i = F.tid; i < ntl; i += NTHR) tle[i] = ld_u32(F.ctl + CW_TILE + 64 + i);
            __syncthreads();
            pg8::Gemm g{(const bf16*)(F.ws + WS_ACT), (const bf16*)(F.ws + WS_WDN + (size_t)L * 32 * 1024 * 1024), NR_MAX, 32 * 1024, 512};
            GroupOrder S{tle, ntl, 2, F.G, F.blk};
            EpiDown E{F.ws + WS_XG, a.in[17] + (size_t)L * 32 * 1024};
            pg8::gemm_phase<EpiDown, GroupOrder, true, true, true>(F.lds, g, S, E, F.tid); }
            SEAM(); }
        if (IN(pb + 10)) _Pragma("unroll 1") for (int rep = 0; rep < NREP(10); ++rep) { { SITE(); ph_combine_ln2(a, F, L); } if (L + 1 < DEPTH || rep + 1 < NREP(10)) SEAM(); }
        if (PROBE_DUP == 900 && L + 1 < DEPTH) { _Pragma("unroll 1") for (int xb = 0; xb < 10; ++xb) SEAM(); }
    }
#undef IN
#undef SEAM
}

extern "C" void kernel_launch(void* const* d_in, const int* in_sizes, int n_in, void* d_out, int out_size, void* d_ws, size_t ws_size, hipStream_t stream) {
    static int grid = 0;
    if (grid == 0) {
        if (n_in != 18 || out_size != NTOK * DM || ws_size < WS_END) { fprintf(stderr, "kernel_launch: unexpected shapes (n_in %d, out %d, ws %zu); nothing launched\n", n_in, out_size, ws_size); grid = -1; return; }
        int dev = 0, cus = 0, per_cu = 0;
        if (hipGetDevice(&dev) != hipSuccess || hipDeviceGetAttribute(&cus, hipDeviceAttributeMultiprocessorCount, dev) != hipSuccess) { grid = -1; return; }
        if (hipFuncSetAttribute((const void*)mega_fwd, hipFuncAttributeMaxDynamicSharedMemorySize, LDS_BYTES) != hipSuccess) { fprintf(stderr, "kernel_launch: hipFuncSetAttribute failed\n"); grid = -1; return; }
        if (hipOccupancyMaxActiveBlocksPerMultiprocessor(&per_cu, (const void*)mega_fwd, NTHR, LDS_BYTES) != hipSuccess || per_cu < 1) fprintf(stderr, "kernel_launch: occupancy query reports %d\n", per_cu);
        (void)hipGetLastError();
        grid = cus;
    }
    if (grid < 0) return;
    (void)hipMemsetAsync((char*)d_ws + WS_CTL, 0, CTL_ZERO_BYTES, stream);
#ifdef EXP_SKIP
    (void)hipMemsetAsync((char*)d_ws + WS_AO, 0, 64 * MiB, stream);
    (void)hipMemsetAsync((char*)d_ws + WS_OL, 0, 64 * MiB, stream);
    if (EXP_SKIP & 4) { (void)hipMemsetAsync((char*)d_ws + WS_XG, 0, 272 * MiB, stream); (void)hipMemsetAsync((char*)d_ws + WS_DEST, 0, 1 * MiB, stream); }
#endif
    Args a{};
    for (int i = 0; i < 18; ++i) a.in[i] = (const float*)d_in[i];
    a.out = (float*)d_out; a.ws = (unsigned char*)d_ws;
#if MK_SINGLE
    a.ph_lo = 0; a.ph_hi = NPHASE;
    hipLaunchKernelGGL(mega_fwd, dim3(grid), dim3(NTHR), LDS_BYTES, stream, a);
#else
    for (int p = 0; p < NPHASE; ++p) {
        if (p > 0) { const int L = (p - 1) / NPL, q = (p - 1) % NPL; if ((L & 1) && (q == 2 || q == 4)) continue;
#ifdef EXP_SKIP
            if ((EXP_SKIP & 1) && !(L & 1) && q <= 4) continue;
            if ((EXP_SKIP & 2) && (L & 1) && q <= 4) continue;
            if ((EXP_SKIP & 4) && q >= 7 && q <= 9) continue;
#endif
        }
        a.ph_lo = p; a.ph_hi = p + 1;
        hipLaunchKernelGGL(mega_fwd, dim3(grid), dim3(NTHR), LDS_BYTES, stream, a);
    }
#endif
}
```

```cpp
#include <hip/hip_runtime.h>
#include <cstdio>
#include <cstdint>
#ifdef EXP_SKIP
#define EXPF EXP_SKIP
#else
#define EXPF 0
#endif
constexpr int NB = 4, SEQ = 8192, DM = 1024, NTOK = NB * SEQ, DEPTH = 4;
constexpr int EV_N = 2560, OD_N = 3072;
constexpr int EC_QA = 0, EC_QB = 512, EC_KB = 1024, EC_VB = 1536, EC_CKV = 2048, EC_QI = 2176, EC_KI = 2432, EC_WI = 2496;
constexpr int OC_Q = 0, OC_K = 1024, OC_V = 2048;
constexpr float LOG2E = 1.4426950408889634f;
constexpr float C2F = 0.125f * LOG2E;
constexpr float ALPHA = 1.681792830507429f;
constexpr float LN_EPS = 1e-5f;
constexpr int NR_MAX = 131072 + 32 * 256;
constexpr int NWAVES = 8, NTHR = 512;
constexpr size_t MiB = (size_t)1 << 20;
constexpr size_t WS_CTL = 0, CTL_ZERO_BYTES = 4 * MiB;
constexpr size_t WS_WEV = 8 * MiB, WS_WOD = 18 * MiB, WS_WOUT = 30 * MiB, WS_WUKT = 38 * MiB, WS_WUVT = 39 * MiB;
constexpr size_t WS_WGU = 40 * MiB, WS_WDN = 552 * MiB;
constexpr size_t WS_X = 808 * MiB, WS_X1 = 936 * MiB, WS_YP = 1064 * MiB, WS_XB = 1192 * MiB;
constexpr size_t WS_PROJ = 1256 * MiB, WS_AO = 1448 * MiB, WS_XG = 1512 * MiB, WS_ACT = 1784 * MiB;
constexpr size_t WS_QL = 2056 * MiB, WS_OL = 2120 * MiB, WS_CKVN = 2184 * MiB, WS_SEL = 2192 * MiB;
constexpr size_t WS_KBAR = 2208 * MiB, WS_SEL3 = 2209 * MiB, WS_LOGF = 2210 * MiB, WS_CS = 2212 * MiB;
constexpr size_t WS_TOPE = 2213 * MiB, WS_GATE = 2214 * MiB, WS_RANK = 2215 * MiB, WS_DEST = 2216 * MiB, WS_PML = 2217 * MiB;
constexpr size_t WS_SRC = WS_DEST + 512 * 1024;
constexpr size_t WS_XB8 = 2226 * MiB;
constexpr size_t WS_KIC = 2258 * MiB;
constexpr size_t WS_END = 2262 * MiB;
constexpr float F8_SX = 16.f, F8_SWG = 256.f, F8_SA = 4.f, F8_SWD = 512.f, F8_SY = 32.f;
constexpr int CW_BAR = 4096, CW_Q = 8192, CW_KMAX = 12288, CW_CNT = 16384, CW_TILE = 32768;

#define GAS __attribute__((address_space(1)))
#define LAS __attribute__((address_space(3)))
#define DI __device__ __forceinline__
typedef unsigned short bf16;
typedef unsigned v4u __attribute__((ext_vector_type(4)));
typedef unsigned v2u __attribute__((ext_vector_type(2)));
typedef float f32x4 __attribute__((ext_vector_type(4)));
typedef float f32x2 __attribute__((ext_vector_type(2)));
typedef float f32x16 __attribute__((ext_vector_type(16)));
typedef short bf16x8 __attribute__((ext_vector_type(8)));
typedef short s16x4 __attribute__((ext_vector_type(4)));
typedef __bf16 bf16x2_t __attribute__((ext_vector_type(2)));
typedef GAS unsigned gu32;
#define RLX_AGENT __ATOMIC_RELAXED, __HIP_MEMORY_SCOPE_AGENT
#define LDS_WAIT() asm volatile("s_waitcnt lgkmcnt(0)" ::: "memory")

DI float bf2f(unsigned v) { return __uint_as_float(v << 16); }
DI unsigned cvtpk(float lo, float hi) { f32x2 v = {lo, hi}; bf16x2_t b = __builtin_convertvector(v, bf16x2_t); return __builtin_bit_cast(unsigned, b); }
DI unsigned f2bf(float f) { return cvtpk(f, 0.f) & 0xffffu; }
DI unsigned pk4_fp8(float a, float b, float c, float d) {
    a = fminf(fmaxf(a, -448.f), 448.f); b = fminf(fmaxf(b, -448.f), 448.f); c = fminf(fmaxf(c, -448.f), 448.f); d = fminf(fmaxf(d, -448.f), 448.f);
    int w = 0; w = __builtin_amdgcn_cvt_pk_fp8_f32(a, b, w, false); w = __builtin_amdgcn_cvt_pk_fp8_f32(c, d, w, true); return (unsigned)w; }
DI float ex2(float x) { return __builtin_amdgcn_exp2f(x); }
DI float wave_sum(float v) {
#pragma unroll
    for (int o = 1; o < 64; o <<= 1) v += __shfl_xor(v, o);
    return v;
}
DI float wave_max(float v) {
#pragma unroll
    for (int o = 1; o < 64; o <<= 1) v = fmaxf(v, __shfl_xor(v, o));
    return v;
}
DI unsigned ld_u32(const unsigned* p) { return __hip_atomic_load(p, RLX_AGENT); }
DI int crow(int r, int hi) { return (r & 3) + 8 * (r >> 2) + 4 * hi; }
DI f32x16 mfma32(bf16x8 a, bf16x8 b, f32x16 c) { return __builtin_amdgcn_mfma_f32_32x32x16_bf16(a, b, c, 0, 0, 0); }
DI f32x4 mfma16(bf16x8 a, bf16x8 b, f32x4 c) { return __builtin_amdgcn_mfma_f32_16x16x32_bf16(a, b, c, 0, 0, 0); }
typedef short v4i16_t __attribute__((ext_vector_type(4)));
DI s16x4 vtr(LAS const char* p) { return __builtin_bit_cast(s16x4, __builtin_amdgcn_ds_read_tr16_b64_v4i16((LAS v4i16_t*)p)); }
DI bf16x8 cat8(s16x4 a, s16x4 b) { return (bf16x8){a[0], a[1], a[2], a[3], b[0], b[1], b[2], b[3]}; }
DI int t5_bucket(int n) {
    if (n < 16) return n;
    int bkt = 16;
    bkt += (n >= 21); bkt += (n >= 27); bkt += (n >= 35); bkt += (n >= 46); bkt += (n >= 59); bkt += (n >= 77); bkt += (n >= 99); bkt += (n >= 128);
    bkt += (n >= 166); bkt += (n >= 216); bkt += (n >= 280); bkt += (n >= 363); bkt += (n >= 470); bkt += (n >= 609); bkt += (n >= 790);
    return bkt;
}
namespace pg8 {
#define PG8_LAS __attribute__((address_space(3)))
typedef unsigned short bf16_t;
typedef short bf16x8 __attribute__((ext_vector_type(8)));
typedef float f32x4 __attribute__((ext_vector_type(4)));
typedef unsigned u32x4 __attribute__((ext_vector_type(4)));
constexpr int BM = 256, BK = 64, HALF = 128, HTB = HALF * BK * 2  , STAGE_BYTES = 8 * HTB, NXCD = 8, WGM = 8;

__host__ __device__ __forceinline__ int lds_byte(int r, int c) { const int st = (r >> 4) * 2 + (c >> 5), rr = r & 15, cc = c & 31, ob = rr * 64 + cc * 2; return st * 1024 + (ob ^ (((ob >> 9) & 1) << 5)); }
__host__ __device__ __forceinline__ void stage_rc(int b, int& R, int& C) { const int st = b / 1024, sb = b % 1024, swz = sb ^ (((sb >> 9) & 1) << 5); R = (st >> 1) * 16 + swz / 64; C = (st & 1) * 32 + (swz % 64) / 2; }
__host__ __device__ __forceinline__ int perm32(int rho) { const int n = rho >> 4, i = rho & 15; return 8 * (i >> 2) + 4 * n + (i & 3); }

typedef int i32x8 __attribute__((ext_vector_type(8))); typedef int i32x4v __attribute__((ext_vector_type(4)));
__device__ __forceinline__ i32x8 pg8_cat8(bf16x8 lo, bf16x8 hi) { const i32x4v a = __builtin_bit_cast(i32x4v, lo), b = __builtin_bit_cast(i32x4v, hi); return (i32x8){a[0], a[1], a[2], a[3], b[0], b[1], b[2], b[3]}; }
struct Unit { int pm, pn; };
struct Gemm { const bf16_t* A; const bf16_t* Bt; int M, N, K; };

struct StaticOrder {
    int nM, nN, nwg, G, c;
    __host__ __device__ void init(int M, int N, int G_, int c_) { nM = M / BM; nN = N / BM; nwg = nM * nN; G = G_; c = c_; }
    __host__ __device__ bool next(int i, Unit& u) const {
        const long L = (long)i * G + c; if (L >= nwg) return false;
        int wgid = (int)L; { const int q = nwg / NXCD, r = nwg % NXCD, xcd = wgid % NXCD, off = wgid / NXCD; wgid = (xcd < r ? xcd * (q + 1) : r * (q + 1) + (xcd - r) * q) + off; }
        const int nig = WGM * nN, gid = wgid / nig, fm = gid * WGM, gsz = (nM - fm) < WGM ? (nM - fm) : WGM;
        u.pm = fm + ((wgid % nig) % gsz); u.pn = (wgid % nig) / gsz; return true;
    }
    __device__ __forceinline__ void a_ready(const Unit&) const {}
    __device__ __forceinline__ void done(const Unit&) const {}
};

__device__ __forceinline__ unsigned cvt_pk_bf16(float lo, float hi) { unsigned r; asm volatile("v_cvt_pk_bf16_f32 %0, %1, %2" : "=v"(r) : "v"(lo), "v"(hi)); return r; }
typedef float f32x2 __attribute__((ext_vector_type(2)));
__device__ __forceinline__ f32x2 gelu_pk(f32x2 v) {
    const f32x2 av = __builtin_elementwise_abs(v), d = av * 0.2316418882f + 1.0f;
    f32x2 t; t.x = __builtin_amdgcn_rcpf(d.x); t.y = __builtin_amdgcn_rcpf(d.y);
    f32x2 q = t * 0.5307027145f + (-0.7265760135f); q = q * t + 0.7107068705f; q = q * t + (-0.142248368f); q = q * t + 0.127414796f; q = q * t;
    const f32x2 s = (v * v) * (-0.72134752044f);
    f32x2 e; e.x = __builtin_amdgcn_exp2f(s.x); e.y = __builtin_amdgcn_exp2f(s.y);
    const f32x2 m = v * (q * e), r = v - m;
    f32x2 o; o.x = v.x < 0.f ? m.x : r.x; o.y = v.y < 0.f ? m.y : r.y; return o;
}

template <int ACT  > struct EpiBf16 {
    static constexpr bool PERM = true, AFTER_DRAIN = false; static_assert(ACT == 0 || ACT == 1, "EpiBf16: ACT is 0 (none) or 1 (gelu_pk)");
    bf16_t* O; int ldc; const float* bias; int split_cols; size_t split_stride; float scale0;
    __device__ __forceinline__ void operator()(const f32x4 (&acc)[2][2][4][2], const Unit& u, int wr, int wc, int fr, int fq) const {
        const int row0 = u.pm * BM + wr * 64 + fr; int colt = u.pn * BM; bf16_t* base = O;
        float sc = 1.f; if (split_cols) { const int t = colt / split_cols; base += (size_t)t * split_stride; colt -= t * split_cols; if (t == 0) sc = scale0; }
        const int col0 = colt + wc * 32 + 8 * fq, bcol0 = u.pn * BM + wc * 32 + 8 * fq;
        f32x4 bv[2][2];
#pragma unroll
        for (int bj = 0; bj < 2; ++bj)
#pragma unroll
            for (int n = 0; n < 2; ++n) bv[bj][n] = bias ? *(const f32x4*)(bias + bcol0 + bj * HALF + 4 * n) : (f32x4){0.f, 0.f, 0.f, 0.f};
#pragma unroll
        for (int ai = 0; ai < 2; ++ai)
#pragma unroll
            for (int m = 0; m < 4; ++m) { bf16_t* rowp = base + (size_t)(row0 + ai * HALF + m * 16) * ldc + col0;
#pragma unroll
                for (int bj = 0; bj < 2; ++bj) { f32x4 v0 = acc[ai][bj][m][0] + bv[bj][0], v1 = acc[ai][bj][m][1] + bv[bj][1];
                    if (ACT == 1) { f32x2 a = gelu_pk((f32x2){v0[0], v0[1]}), b = gelu_pk((f32x2){v0[2], v0[3]}), c = gelu_pk((f32x2){v1[0], v1[1]}), d = gelu_pk((f32x2){v1[2], v1[3]});
                        v0 = (f32x4){a.x, a.y, b.x, b.y}; v1 = (f32x4){c.x, c.y, d.x, d.y}; }
                    v0 = v0 * sc; v1 = v1 * sc; u32x4 w; w.x = cvt_pk_bf16(v0[0], v0[1]); w.y = cvt_pk_bf16(v0[2], v0[3]); w.z = cvt_pk_bf16(v1[0], v1[1]); w.w = cvt_pk_bf16(v1[2], v1[3]);
                    *(u32x4*)(rowp + bj * HALF) = w; } }
    }
};

template <class Epi, class Sched, bool ALIGN_EPI = false, bool SP2 = false, bool F8 = false, bool GATH = false  >
__device__ __forceinline__ void gemm_phase(PG8_LAS unsigned char* lds, const Gemm g, const Sched& S, const Epi& E, int tid_in) {
    int tid_l = tid_in; asm volatile("" : "+v"(tid_l));
    const int tid = tid_l, wid = __builtin_amdgcn_readfirstlane(tid >> 6), lane = tid & 63, wr = wid >> 2, wc = wid & 3, fr = lane & 15, fq = lane >> 4;
    const int K = g.K, nt = K / BK;
    unsigned voffA[2], voffB[2]; int rowA[2]; unsigned colA[2];
#pragma unroll
    for (int i = 0; i < 2; ++i) { int R, C; stage_rc(tid * 16 + i * 8192, R, C); const int Rb = Epi::PERM ? ((R & ~31) + perm32(R & 31)) : R;
        voffA[i] = (unsigned)(R * K + C) * 2u; voffB[i] = (unsigned)(Rb * K + C) * 2u; rowA[i] = R; colA[i] = (unsigned)C * 2u; }
    static_assert(!GATH || SP2, "GATH: SP2 schedule only");
    unsigned cgo[2][2], ngo[2][2];
#define PG8_GOFF(dst, uidx) do { _Pragma("unroll") for (int _h = 0; _h < 2; ++_h) _Pragma("unroll") for (int _i = 0; _i < 2; ++_i) dst[_h][_i] = S.gsrc((uidx), _h * HALF + rowA[_i]) + colA[_i]; } while (0)
#define PG8_STAGE_G(bufoff, kb, o0, o1) do { \
        __builtin_amdgcn_global_load_lds((const unsigned*)((const char*)g.A + (kb) + (o0)), (PG8_LAS unsigned*)(lds + (bufoff) + ldsw), 16, 0, 0); \
        __builtin_amdgcn_global_load_lds((const unsigned*)((const char*)g.A + (kb) + (o1)), (PG8_LAS unsigned*)(lds + (bufoff) + ldsw + 8192), 16, 0, 0); } while (0)
    const size_t kstep = (size_t)(BK * 2);
    const size_t hstep = (size_t)HALF * K * 2;
    const size_t tstep = 2 * hstep;
    const unsigned ldsw = (unsigned)wid * 1024u;
    const int aoff = lds_byte(wr * 64 + fr, fq * 8), boff = lds_byte(wc * 32 + fr, fq * 8);
#define PG8_SA(b, h) (((b) * 2 + (h)) * HTB)
#define PG8_SB(b, h) ((4 + (b) * 2 + (h)) * HTB)
#define PG8_STAGE(bufoff, gbase, voff) do { _Pragma("unroll") for (int _i = 0; _i < 2; ++_i) \
        __builtin_amdgcn_global_load_lds((const unsigned*)((const char*)(gbase) + (voff)[_i]), (PG8_LAS unsigned*)(lds + (bufoff) + ldsw + _i * 8192), 16, 0, 0); } while (0)
#define PG8_LDA(dst, b, h) do { _Pragma("unroll") for (int m = 0; m < 4; ++m) _Pragma("unroll") for (int k = 0; k < 2; ++k) dst[m][k] = *(const PG8_LAS bf16x8*)(lds + PG8_SA(b, h) + aoff + m * 2048 + k * 1024); } while (0)
#define PG8_LDB(dst, b, h) do { _Pragma("unroll") for (int n = 0; n < 2; ++n) _Pragma("unroll") for (int k = 0; k < 2; ++k) dst[n][k] = *(const PG8_LAS bf16x8*)(lds + PG8_SB(b, h) + boff + n * 2048 + k * 1024); } while (0)
#define PG8_MMA(ai, bj, At, Bt) do { __builtin_amdgcn_s_setprio(1); if constexpr (!F8) { _Pragma("unroll") for (int m = 0; m < 4; ++m) _Pragma("unroll") for (int n = 0; n < 2; ++n) _Pragma("unroll") for (int k = 0; k < 2; ++k) \
        acc[ai][bj][m][n] = __builtin_amdgcn_mfma_f32_16x16x32_bf16(Bt[n][k], At[m][k], acc[ai][bj][m][n], 0, 0, 0); } else { _Pragma("unroll") for (int m = 0; m < 4; ++m) _Pragma("unroll") for (int n = 0; n < 2; ++n) \
        acc[ai][bj][m][n] = __builtin_amdgcn_mfma_scale_f32_16x16x128_f8f6f4(pg8_cat8(Bt[n][0], Bt[n][1]), pg8_cat8(At[m][0], At[m][1]), acc[ai][bj][m][n], 0, 0, 0, 0x7F7F7F7F, 0, 0x7F7F7F7F); \
        _Pragma("unroll") for (int m = 0; m < 4; ++m) _Pragma("unroll") for (int n = 0; n < 2; ++n) asm volatile("" : "+v"(acc[ai][bj][m][n]));   } __builtin_amdgcn_s_setprio(0); } while (0)
#define PG8_WAIT_V(n) asm volatile("s_waitcnt vmcnt(" #n ")" ::: "memory")
#define PG8_WAIT_L(n) asm volatile("s_waitcnt lgkmcnt(" #n ")" ::: "memory")
#define PG8_BAR __builtin_amdgcn_s_barrier()
#define PG8_SCHED __builtin_amdgcn_sched_barrier(0)
    Unit cur, nxt; int ui = 0;
    if (!S.next(0, cur)) return;
    f32x4 acc[2][2][4][2];
#pragma unroll
    for (int a = 0; a < 2; ++a)
#pragma unroll
        for (int b = 0; b < 2; ++b)
#pragma unroll
            for (int m = 0; m < 4; ++m)
#pragma unroll
                for (int n = 0; n < 2; ++n) acc[a][b][m][n] = (f32x4){0.f, 0.f, 0.f, 0.f};
    bf16x8 At[4][2], B0[2][2], B1[2][2];
    const char* cA = (const char*)g.A + (size_t)cur.pm * tstep; const char* cB = (const char*)g.Bt + (size_t)cur.pn * tstep;
    S.a_ready(cur);
    if constexpr (SP2) {
        if constexpr (GATH) { PG8_GOFF(cgo, 0); }
        PG8_STAGE(PG8_SB(0, 0), cB, voffB); PG8_STAGE(PG8_SB(0, 1), cB + hstep, voffB);
        if constexpr (GATH) { PG8_STAGE_G(PG8_SA(0, 0), 0, cgo[0][0], cgo[0][1]); PG8_STAGE_G(PG8_SA(0, 1), 0, cgo[1][0], cgo[1][1]); }
        else { PG8_STAGE(PG8_SA(0, 0), cA, voffA); PG8_STAGE(PG8_SA(0, 1), cA + hstep, voffA); }
        if (wr == 1) PG8_BAR;
        PG8_WAIT_V(2); PG8_BAR;
        PG8_STAGE(PG8_SB(1, 0), cB + kstep, voffB);
        if constexpr (GATH) { PG8_STAGE_G(PG8_SA(1, 0), kstep, cgo[0][0], cgo[0][1]); } else { PG8_STAGE(PG8_SA(1, 0), cA + kstep, voffA); }
        PG8_STAGE(PG8_SB(1, 1), cB + hstep + kstep, voffB);
        PG8_WAIT_V(6); PG8_BAR;
    } else {
        PG8_STAGE(PG8_SB(0, 0), cB, voffB); PG8_STAGE(PG8_SA(0, 0), cA, voffA); PG8_STAGE(PG8_SB(0, 1), cB + hstep, voffB); PG8_STAGE(PG8_SA(0, 1), cA + hstep, voffA);
        if (wr == 1) PG8_BAR;
        PG8_WAIT_V(4); PG8_BAR;
        PG8_STAGE(PG8_SB(1, 0), cB + kstep, voffB); PG8_STAGE(PG8_SA(1, 0), cA + kstep, voffA); PG8_STAGE(PG8_SB(1, 1), cB + hstep + kstep, voffB);
        PG8_WAIT_V(6); PG8_BAR;
    }
    for (;;) {
        const bool has_next = S.next(ui + 1, nxt);
        if constexpr (GATH) { if (has_next) { PG8_GOFF(ngo, ui + 1); } else {
            _Pragma("unroll") for (int _h = 0; _h < 2; ++_h) _Pragma("unroll") for (int _i = 0; _i < 2; ++_i) ngo[_h][_i] = cgo[_h][_i]; } }
        const char* nA = has_next ? (const char*)g.A + (size_t)nxt.pm * tstep : cA; const char* nB = has_next ? (const char*)g.Bt + (size_t)nxt.pn * tstep : cB;
        for (int t = 0; t < nt; t += 2) {
            const bool last = (t == nt - 2);
            const char* a1 = cA + (size_t)(t + 1) * kstep;
            const char* a2 = last ? nA : cA + (size_t)(t + 2) * kstep; const char* b2 = last ? nB : cB + (size_t)(t + 2) * kstep;
            const char* a3 = a2 + kstep; const char* b3 = b2 + kstep;
            if (last && has_next) S.a_ready(nxt);
            unsigned g0a = 0, g0b = 0, g1a = 0, g1b = 0; size_t kb2 = 0;
            if constexpr (GATH) { g0a = last ? ngo[0][0] : cgo[0][0]; g0b = last ? ngo[0][1] : cgo[0][1]; g1a = last ? ngo[1][0] : cgo[1][0]; g1b = last ? ngo[1][1] : cgo[1][1]; kb2 = last ? (size_t)0 : (size_t)(t + 2) * kstep; }
            if constexpr (SP2) {
            PG8_LDB(B0, 0, 0); PG8_LDB(B1, 0, 1); PG8_SCHED; PG8_LDA(At, 0, 0);
            if constexpr (GATH) { PG8_STAGE_G(PG8_SA(1, 1), (size_t)(t + 1) * kstep, cgo[1][0], cgo[1][1]); } else { PG8_STAGE(PG8_SA(1, 1), a1 + hstep, voffA); }
            PG8_WAIT_V(8); PG8_WAIT_L(0); PG8_BAR; PG8_MMA(0, 0, At, B0); PG8_MMA(0, 1, At, B1); PG8_BAR; PG8_SCHED;
            PG8_LDA(At, 0, 1); PG8_STAGE(PG8_SB(0, 0), b2, voffB); PG8_STAGE(PG8_SB(0, 1), b2 + hstep, voffB);
            if constexpr (GATH) { PG8_STAGE_G(PG8_SA(0, 0), kb2, g0a, g0b); } else { PG8_STAGE(PG8_SA(0, 0), a2, voffA); }
            PG8_WAIT_V(8); PG8_WAIT_L(0); PG8_BAR; PG8_MMA(1, 0, At, B0); PG8_MMA(1, 1, At, B1); PG8_BAR; PG8_SCHED;
            PG8_LDB(B0, 1, 0); PG8_LDB(B1, 1, 1); PG8_SCHED; PG8_LDA(At, 1, 0);
            if constexpr (GATH) { PG8_STAGE_G(PG8_SA(0, 1), kb2, g1a, g1b); } else { PG8_STAGE(PG8_SA(0, 1), a2 + hstep, voffA); }
            PG8_WAIT_V(8); PG8_WAIT_L(0); PG8_BAR; PG8_MMA(0, 0, At, B0); PG8_MMA(0, 1, At, B1); PG8_BAR; PG8_SCHED;
            PG8_LDA(At, 1, 1); PG8_STAGE(PG8_SB(1, 0), b3, voffB); PG8_STAGE(PG8_SB(1, 1), b3 + hstep, voffB);
            if constexpr (GATH) { PG8_STAGE_G(PG8_SA(1, 0), kb2 + kstep, g0a, g0b); } else { PG8_STAGE(PG8_SA(1, 0), a3, voffA); }
            PG8_WAIT_V(8); PG8_WAIT_L(0); PG8_BAR; PG8_MMA(1, 0, At, B0); PG8_MMA(1, 1, At, B1); PG8_BAR; PG8_SCHED;
            } else {
            PG8_LDB(B0, 0, 0); PG8_SCHED; PG8_LDA(At, 0, 0); PG8_STAGE(PG8_SA(1, 1), a1 + hstep, voffA);
            PG8_WAIT_L(8); PG8_BAR; PG8_WAIT_L(0); PG8_MMA(0, 0, At, B0); PG8_BAR; PG8_SCHED;
            PG8_LDB(B1, 0, 1); PG8_STAGE(PG8_SB(0, 0), b2, voffB);
            PG8_BAR; PG8_WAIT_L(0); PG8_MMA(0, 1, At, B1); PG8_BAR;
            PG8_LDA(At, 0, 1); PG8_STAGE(PG8_SA(0, 0), a2, voffA);
            PG8_BAR; PG8_WAIT_L(0); PG8_MMA(1, 0, At, B0); PG8_BAR; PG8_SCHED;
            PG8_STAGE(PG8_SB(0, 1), b2 + hstep, voffB);
            PG8_WAIT_V(6); PG8_BAR; PG8_MMA(1, 1, At, B1); PG8_BAR;
            PG8_LDB(B0, 1, 0); PG8_SCHED; PG8_LDA(At, 1, 0); PG8_STAGE(PG8_SA(0, 1), a2 + hstep, voffA);
            PG8_WAIT_L(8); PG8_BAR; PG8_WAIT_L(0); PG8_MMA(0, 0, At, B0); PG8_BAR; PG8_SCHED;
            PG8_LDB(B1, 1, 1); PG8_STAGE(PG8_SB(1, 0), b3, voffB);
            PG8_BAR; PG8_WAIT_L(0); PG8_MMA(0, 1, At, B1); PG8_BAR;
            PG8_LDA(At, 1, 1); PG8_STAGE(PG8_SA(1, 0), a3, voffA);
            PG8_BAR; PG8_WAIT_L(0); PG8_MMA(1, 0, At, B0); PG8_BAR; PG8_SCHED;
            PG8_STAGE(PG8_SB(1, 1), b3 + hstep, voffB);
            PG8_WAIT_V(6); PG8_BAR; PG8_MMA(1, 1, At, B1); PG8_BAR;
            }
        }
        if constexpr (ALIGN_EPI) { if (wr == 0) PG8_BAR; }
        if constexpr (!Epi::AFTER_DRAIN) { E(acc, cur, wr, wc, fr, fq); S.done(cur); }
        if (!has_next) break;
#pragma unroll
        for (int a = 0; a < 2; ++a)
#pragma unroll
            for (int b = 0; b < 2; ++b)
#pragma unroll
                for (int m = 0; m < 4; ++m)
#pragma unroll
                    for (int n = 0; n < 2; ++n) acc[a][b][m][n] = (f32x4){0.f, 0.f, 0.f, 0.f};
        cur = nxt; cA = nA; cB = nB; ++ui;
        if constexpr (GATH) { _Pragma("unroll") for (int _h = 0; _h < 2; ++_h) _Pragma("unroll") for (int _i = 0; _i < 2; ++_i) cgo[_h][_i] = ngo[_h][_i]; }
        if constexpr (ALIGN_EPI) { if (wr == 1) PG8_BAR; }
    }
    PG8_WAIT_V(0);
    if constexpr (!ALIGN_EPI) { if (wr == 0) PG8_BAR; }
    PG8_BAR;
    if constexpr (Epi::AFTER_DRAIN) { E.fused(acc, cur, wr, wc, fr, fq, lds, wid, lane); S.done(cur); }
#undef PG8_SA
#undef PG8_SB
#undef PG8_STAGE
#undef PG8_STAGE_G
#undef PG8_GOFF
#undef PG8_LDA
#undef PG8_LDB
#undef PG8_MMA
#undef PG8_WAIT_V
#undef PG8_WAIT_L
#undef PG8_BAR
#undef PG8_SCHED
}
}

#ifndef PG8_SP2
#define PG8_SP2 true
#endif
#ifndef PG8_ALIGN
#define PG8_ALIGN true
#endif
#define XB_TMO      128
#define XB_XCNT(j)  (256  + 64 * (j))
#define XB_XSUB(j)  (1280 + 64 * (j))
#define XB_XGEN(j)  (2304 + 64 * (j))
#define XB_TOP      3328
#define XB_TOPGEN   3392
#define XCD_BAR_WORDS 3456
#define XB_SPIN_CAP (1u << 18)

__device__ __forceinline__ unsigned xb_ld(unsigned* p)              { return __hip_atomic_load(p, __ATOMIC_RELAXED, __HIP_MEMORY_SCOPE_AGENT); }
__device__ __forceinline__ unsigned xb_add(unsigned* p, unsigned v) { return __hip_atomic_fetch_add(p, v, __ATOMIC_RELAXED, __HIP_MEMORY_SCOPE_AGENT); }
__device__ __forceinline__ unsigned xb_xcc_id() { return (unsigned)__builtin_amdgcn_s_getreg((3 << 11) | 20) & 0xFu; }
#define XB_SPIN(cond, bar) do { unsigned _sp = 0; while (cond) { __builtin_amdgcn_s_sleep(1); \
    if ((++_sp & 255u) == 0u) { if (xb_ld(&(bar)[XB_TMO])) break; if (_sp > XB_SPIN_CAP) { atomicAdd(&(bar)[XB_TMO], 1u); break; } } } } while (0)

struct XcdBarrier {
    unsigned* bar; unsigned x;
    volatile LAS unsigned* st;
};

__device__ __forceinline__ XcdBarrier xcd_barrier_post(unsigned* bar, volatile LAS unsigned* st) {
    XcdBarrier b; b.bar = bar; b.x = xb_xcc_id(); b.st = st;
    if (threadIdx.x == 0) (void)xb_add(&bar[XB_XCNT(b.x)], 1u);
    return b;
}
__device__ __forceinline__ void xcd_barrier_complete(unsigned* bar, unsigned x, unsigned& nloc, unsigned& nx) {
    const unsigned G = gridDim.x * gridDim.y * gridDim.z;
    unsigned sum, cnt, mine, sp = 0u;
    for (;;) {
        sum = 0u; cnt = 0u; mine = 0u;
#pragma unroll
        for (unsigned j = 0; j < 16; ++j) { const unsigned c = xb_ld(&bar[XB_XCNT(j)]); sum += c; cnt += (c > 0u) ? 1u : 0u; mine = (j == x) ? c : mine; }
        if (sum == G) break;
        __builtin_amdgcn_s_sleep(1);
        if ((++sp & 255u) == 0u) { if (xb_ld(&bar[XB_TMO])) break; if (sp > XB_SPIN_CAP) { atomicAdd(&bar[XB_TMO], 1u); break; } }
    }
    nloc = mine > 0u ? mine : 1u; nx = cnt > 0u ? cnt : 1u;
}

__device__ __forceinline__ void xcd_barrier(const XcdBarrier& b, const bool is_t0  ) {
    asm volatile("s_waitcnt vmcnt(0)" ::: "memory");
    __syncthreads();
    if (is_t0) {
        unsigned* bar = b.bar;
        __builtin_amdgcn_s_waitcnt(0);
        unsigned nloc = b.st[0], nx = b.st[1];
        if (nloc == 0u) { xcd_barrier_complete(bar, b.x, nloc, nx); b.st[0] = nloc; b.st[1] = nx; }
        const unsigned old = xb_add(&bar[XB_XSUB(b.x)], 1u);
        const unsigned gen = old / nloc;
        if (old + 1u == (gen + 1u) * nloc) {
            __builtin_amdgcn_fence(__ATOMIC_RELEASE, "agent");
            asm volatile("s_waitcnt vmcnt(0)" ::: "memory");
            const unsigned og = xb_add(&bar[XB_TOP], 1u);
            const unsigned tg = og / nx;
            if (og + 1u == (tg + 1u) * nx) xb_add(&bar[XB_TOPGEN], 1u);
            else XB_SPIN(xb_ld(&bar[XB_TOPGEN]) == tg, bar);
            __builtin_amdgcn_fence(__ATOMIC_ACQUIRE, "agent");
            xb_add(&bar[XB_XGEN(b.x)], 1u);
            asm volatile("s_waitcnt vmcnt(0)" ::: "memory");
        } else {
            XB_SPIN(xb_ld(&bar[XB_XGEN(b.x)]) == gen, bar);
            __builtin_amdgcn_fence(__ATOMIC_ACQUIRE, "agent");
            asm volatile("s_waitcnt vmcnt(0)" ::: "memory");
        }
    }
    __syncthreads();
}
struct EpiResBf16 {
    static constexpr bool PERM = true, AFTER_DRAIN = false;
    const bf16* xin; bf16* yp; float alpha;
    DI void operator()(const pg8::f32x4 (&acc)[2][2][4][2], const pg8::Unit& u, int wr, int wc, int fr, int fq) const {
        const int row0 = u.pm * 256 + wr * 64 + fr, col0 = u.pn * 256 + wc * 32 + 8 * fq;
#pragma unroll
        for (int ai = 0; ai < 2; ++ai)
#pragma unroll
            for (int m = 0; m < 4; ++m) {
                const size_t ro = (size_t)(row0 + ai * 128 + m * 16) * DM;
#pragma unroll
                for (int bj = 0; bj < 2; ++bj) {
                    const size_t o = ro + col0 + bj * 128;
                    const v4u xv = *(const v4u*)(xin + o);
                    const f32x4 a0 = acc[ai][bj][m][0], a1 = acc[ai][bj][m][1];
                    v4u w;
                    w.x = cvtpk(bf2f(xv.x & 0xffffu) * alpha + a0[0], bf2f(xv.x >> 16) * alpha + a0[1]); w.y = cvtpk(bf2f(xv.y & 0xffffu) * alpha + a0[2], bf2f(xv.y >> 16) * alpha + a0[3]);
                    w.z = cvtpk(bf2f(xv.z & 0xffffu) * alpha + a1[0], bf2f(xv.z >> 16) * alpha + a1[1]); w.w = cvtpk(bf2f(xv.w & 0xffffu) * alpha + a1[2], bf2f(xv.w >> 16) * alpha + a1[3]);
                    *(v4u*)(yp + o) = w;
                }
            }
    }
};
struct EpiSwiglu {
    static constexpr bool PERM = true, AFTER_DRAIN = false;
    unsigned char* act; const float* bgu;
    DI void operator()(const pg8::f32x4 (&acc)[2][2][4][2], const pg8::Unit& u, int wr, int wc, int fr, int fq) const {
        const int e = u.pn >> 3, pl = u.pn & 7;
        const int row0 = u.pm * 256 + wr * 64 + fr, cih = pl * 128 + wc * 32 + 8 * fq;
        const float* bg = bgu + e * 2048 + cih;
        const f32x4 bg0 = *(const f32x4*)(bg), bg1 = *(const f32x4*)(bg + 4), bu0 = *(const f32x4*)(bg + 1024), bu1 = *(const f32x4*)(bg + 1028);
#pragma unroll
        for (int ai = 0; ai < 2; ++ai)
#pragma unroll
            for (int m = 0; m < 4; ++m) {
                constexpr float RS = 1.f / (F8_SX * F8_SWG);
                const f32x4 g0 = acc[ai][0][m][0] * RS + bg0, g1 = acc[ai][0][m][1] * RS + bg1, u0 = acc[ai][1][m][0] * RS + bu0, u1 = acc[ai][1][m][1] * RS + bu1;
                float r[8];
#pragma unroll
                for (int i = 0; i < 8; ++i) {
                    float g = i < 4 ? g0[i & 3] : g1[i & 3], uu = i < 4 ? u0[i & 3] : u1[i & 3];
                    g = fminf(g, 7.0f); uu = fminf(fmaxf(uu, -7.0f), 7.0f);
                    const float sg = __builtin_amdgcn_rcpf(1.0f + ex2(-1.702f * LOG2E * g));
                    r[i] = (uu + 1.0f) * g * sg * F8_SA;
                }
                v2u w; w.x = pk4_fp8(r[0], r[1], r[2], r[3]); w.y = pk4_fp8(r[4], r[5], r[6], r[7]);
                *(v2u*)(act + (size_t)(row0 + ai * 128 + m * 16) * DM + cih) = w;
            }
    }
};
struct EpiDown {
    static constexpr bool PERM = true, AFTER_DRAIN = false;
    unsigned char* yr; const float* bdn;
    DI void operator()(const pg8::f32x4 (&acc)[2][2][4][2], const pg8::Unit& u, int wr, int wc, int fr, int fq) const {
        const int e = u.pn >> 2, pl = u.pn & 3;
        const int row0 = u.pm * 256 + wr * 64 + fr, col0 = pl * 256 + wc * 32 + 8 * fq;
        f32x4 bv[2][2];
#pragma unroll
        for (int bj = 0; bj < 2; ++bj) { bv[bj][0] = *(const f32x4*)(bdn + e * 1024 + col0 + bj * 128) * F8_SY; bv[bj][1] = *(const f32x4*)(bdn + e * 1024 + col0 + bj * 128 + 4) * F8_SY; }
#pragma unroll
        for (int ai = 0; ai < 2; ++ai)
#pragma unroll
            for (int m = 0; m < 4; ++m) {
                unsigned char* rp = yr + (size_t)(row0 + ai * 128 + m * 16) * DM + col0;
#pragma unroll
                for (int bj = 0; bj < 2; ++bj) {
                    constexpr float RS = F8_SY / (F8_SA * F8_SWD);
                    const f32x4 v0 = acc[ai][bj][m][0] * RS + bv[bj][0], v1 = acc[ai][bj][m][1] * RS + bv[bj][1];
                    v2u w; w.x = pk4_fp8(v0[0], v0[1], v0[2], v0[3]); w.y = pk4_fp8(v1[0], v1[1], v1[2], v1[3]);
                    *(v2u*)(rp + bj * 128) = w;
                }
            }
    }
};
struct GroupOrder {
    LAS const unsigned* tile_e; int ntiles, lg, G, c; LAS const unsigned short* srcl;
    DI bool next(int i, pg8::Unit& u) const {
        int pm, pl;
        if (G == 256) {
            const int x = c & 7, k = c >> 3; pm = i * (256 >> lg) + x * (32 >> lg) + (k >> lg); pl = k & ((1 << lg) - 1); if (pm >= ntiles) return false; }
        else { const long L = (long)i * G + c; if (L >= ((long)ntiles << lg)) return false; pm = (int)(L >> lg); pl = (int)(L & ((1 << lg) - 1)); }
        const int e = __builtin_amdgcn_readfirstlane((int)tile_e[pm]);
        u.pm = pm; u.pn = (e << lg) + pl; return true;
    }
    DI void a_ready(const pg8::Unit&) const {}
    DI void done(const pg8::Unit&) const {}
    DI unsigned gsrc(int ui, int r) const { return (unsigned)srcl[ui * 256 + r] << 10; }
};
struct Args { const float* in[18]; float* out; unsigned char* ws; int ph_lo, ph_hi; };
struct Fr { LAS unsigned char* lds; unsigned char* ws; unsigned* ctl; int tid, lane, wave, blk, G; };

DI void tr_item(const float* W, int ldw, int K, int k0, int sc0, int nvalid, bf16* WT, int drow0, LAS float* scr, int lane) {
    const int c = lane & 31;
    float v[32];
#pragma unroll
    for (int i = 0; i < 32; ++i) v[i] = (c < nvalid) ? W[(size_t)(k0 + 2 * i + (lane >> 5)) * ldw + sc0 + c] : 0.f;
#pragma unroll
    for (int i = 0; i < 32; ++i) scr[(2 * i + (lane >> 5)) * 33 + c] = v[i];
    LDS_WAIT(); asm volatile("" ::: "memory");
    const int c8 = lane & 7;
#pragma unroll
    for (int j = 0; j < 4; ++j) { const int n = (lane >> 3) + 8 * j; const LAS float* s = scr + (8 * c8) * 33 + n;
        v4u o; o.x = cvtpk(s[0 * 33], s[1 * 33]); o.y = cvtpk(s[2 * 33], s[3 * 33]); o.z = cvtpk(s[4 * 33], s[5 * 33]); o.w = cvtpk(s[6 * 33], s[7 * 33]);
        *(v4u*)(WT + (size_t)(drow0 + n) * K + k0 + 8 * c8) = o; }
    LDS_WAIT(); asm volatile("" ::: "memory");
}
DI void tr_item8(const float* W, int ldw, int K, int k0, int sc0, float scale, unsigned char* WT8, int drow0, LAS float* scr, int lane) {
    const int c = lane & 31;
    float v[32];
#pragma unroll
    for (int i = 0; i < 32; ++i) v[i] = W[(size_t)(k0 + 2 * i + (lane >> 5)) * ldw + sc0 + c];
#pragma unroll
    for (int i = 0; i < 32; ++i) scr[(2 * i + (lane >> 5)) * 33 + c] = v[i] * scale;
    LDS_WAIT(); asm volatile("" ::: "memory");
    const int c16 = lane & 3;
#pragma unroll
    for (int j = 0; j < 2; ++j) { const int n = (lane >> 2) + 16 * j; const LAS float* s = scr + (16 * c16) * 33 + n;
        v4u o; o.x = pk4_fp8(s[0 * 33], s[1 * 33], s[2 * 33], s[3 * 33]); o.y = pk4_fp8(s[4 * 33], s[5 * 33], s[6 * 33], s[7 * 33]);
        o.z = pk4_fp8(s[8 * 33], s[9 * 33], s[10 * 33], s[11 * 33]); o.w = pk4_fp8(s[12 * 33], s[13 * 33], s[14 * 33], s[15 * 33]);
        *(v4u*)(WT8 + (size_t)(drow0 + n) * K + k0 + 16 * c16) = o; }
    LDS_WAIT(); asm volatile("" ::: "memory");
}
DI void ph_prologue(const Args& a, const Fr& F) {
    LAS float* scr = (LAS float*)(F.lds + F.wave * 16384);
    const int gw = F.blk * NWAVES + F.wave, NGW = F.G * NWAVES;
    constexpr int I_EV = 2 * 16 * 80, I_OD = 2 * 16 * 96, I_WO = 4 * 16 * 32;
    constexpr int NITEMS = I_EV + I_OD + I_WO;
    bf16* wev = (bf16*)(F.ws + WS_WEV); bf16* wod = (bf16*)(F.ws + WS_WOD); bf16* wout = (bf16*)(F.ws + WS_WOUT);
    unsigned char* wgu = F.ws + WS_WGU; unsigned char* wdn = F.ws + WS_WDN;
    for (int it = gw; it < NITEMS; it += NGW) {
        int r = it;
        if (r < I_EV) { const int l = r / 1280; r %= 1280; const int kb = r / 80, n0 = (r % 80) * 32; int sc0, nv = 32;
            if (n0 < 512) sc0 = n0; else if (n0 < 1024) sc0 = 964 + (n0 - 512); else if (n0 < 1536) sc0 = 1476 + (n0 - 1024); else if (n0 < 2048) sc0 = 1988 + (n0 - 1536);
            else if (n0 < 2176) sc0 = 512 + (n0 - 2048); else if (n0 < 2432) sc0 = 640 + (n0 - 2176); else if (n0 < 2496) sc0 = 896 + (n0 - 2432);
            else if (n0 < 2528) { sc0 = 960; nv = 4; } else { sc0 = 0; nv = 0; }
            tr_item(a.in[1] + (size_t)l * 1024 * 2500, 2500, 1024, kb * 64, sc0, nv, wev + (size_t)l * EV_N * 1024, n0, scr, F.lane); continue; }
        r -= I_EV;
        if (r < I_OD) { const int l = r / 1536; r %= 1536; const int kb = r / 96, n0 = (r % 96) * 32;
            tr_item(a.in[6] + (size_t)l * 1024 * 3088, 3088, 1024, kb * 64, n0, 32, wod + (size_t)l * OD_N * 1024, n0, scr, F.lane); continue; }
        r -= I_OD;
        if (r < I_WO) { const int l = r / 512; r %= 512; const int kb = r / 32, n0 = (r % 32) * 32;
            const float* src = (l & 1) ? a.in[8] + (size_t)(l >> 1) * 1024 * 1024 : a.in[5] + (size_t)(l >> 1) * 1024 * 1024;
            tr_item(src, 1024, 1024, kb * 64, n0, 32, wout + (size_t)l * 1024 * 1024, n0, scr, F.lane); continue; }
    }
    { __syncthreads();
        LAS float* tile = (LAS float*)F.lds; unsigned char* wgu8 = F.ws + WS_WGU; unsigned char* wdn8 = F.ws + WS_WDN;
        constexpr int T_GU = 128 * 8 * 16, T_DN = 128 * 8 * 8, T_ALL = T_GU + T_DN;
        const int tid = F.tid, c4 = tid & 31, r0 = tid >> 5;
        f32x4 v[8];
        auto locate = [&](int t, const float*& src, int& ldw, unsigned char*& dst, float& scale) {
            if (t < T_GU) { const int le = t >> 7, r = t & 127, kb = r >> 4, nb = r & 15, n0 = nb * 128; const int pn = n0 >> 8, bj = (n0 >> 7) & 1;
                src = a.in[14] + (size_t)le * 1024 * 2048 + (size_t)(kb * 128) * 2048 + bj * 1024 + pn * 128; ldw = 2048; dst = wgu8 + (size_t)le * 2048 * 1024 + (size_t)n0 * 1024 + kb * 128; scale = F8_SWG; }
            else { const int u = t - T_GU, le = u >> 6, r = u & 63, kb = r >> 3, nb = r & 7;
                src = a.in[16] + (size_t)le * 1024 * 1024 + (size_t)(kb * 128) * 1024 + nb * 128; ldw = 1024; dst = wdn8 + (size_t)le * 1024 * 1024 + (size_t)(nb * 128) * 1024 + kb * 128; scale = F8_SWD; } };
        int t = F.blk;
        if (t < T_ALL) { const float* src; int ldw; unsigned char* dst; float sc; locate(t, src, ldw, dst, sc);
#pragma unroll
            for (int i = 0; i < 8; ++i) v[i] = *(const f32x4*)(src + (size_t)(r0 + 16 * i) * ldw + 4 * c4); }
        for (; t < T_ALL; t += F.G) {
            const float* src; int ldw; unsigned char* dst; float sc; locate(t, src, ldw, dst, sc);
#pragma unroll
            for (int i = 0; i < 8; ++i) { LAS float* tp = tile + (r0 + 16 * i) * 129 + 4 * c4; tp[0] = v[i][0] * sc; tp[1] = v[i][1] * sc; tp[2] = v[i][2] * sc; tp[3] = v[i][3] * sc; }
            __syncthreads();
            if (t + F.G < T_ALL) { const float* s2; int l2; unsigned char* d2; float c2; locate(t + F.G, s2, l2, d2, c2);
#pragma unroll
                for (int i = 0; i < 8; ++i) v[i] = *(const f32x4*)(s2 + (size_t)(r0 + 16 * i) * l2 + 4 * c4); }
#pragma unroll
            for (int j = 0; j < 2; ++j) { const int p = tid + 512 * j, kc = p & 7, n = p >> 3; const LAS float* sp = tile + (kc * 16) * 129 + n;
                v4u o; o.x = pk4_fp8(sp[0], sp[129], sp[2 * 129], sp[3 * 129]); o.y = pk4_fp8(sp[4 * 129], sp[5 * 129], sp[6 * 129], sp[7 * 129]);
                o.z = pk4_fp8(sp[8 * 129], sp[9 * 129], sp[10 * 129], sp[11 * 129]); o.w = pk4_fp8(sp[12 * 129], sp[13 * 129], sp[14 * 129], sp[15 * 129]);
                *(v4u*)(dst + (size_t)n * 1024 + kc * 16) = o; }
            __syncthreads();
        }
    }
    bf16* xb = (bf16*)(F.ws + WS_XB);
    for (int m = gw; m < NTOK; m += NGW) {
        const f32x4* xr = (const f32x4*)(a.in[0] + (size_t)m * DM) + F.lane; v2u* o = (v2u*)(xb + (size_t)m * DM) + F.lane;
#pragma unroll
        for (int j = 0; j < 4; ++j) { const f32x4 v = xr[64 * j]; v2u w; w.x = cvtpk(v[0], v[1]); w.y = cvtpk(v[2], v[3]); o[64 * j] = w; }
    }
    bf16* wukt = (bf16*)(F.ws + WS_WUKT); bf16* wuvt = (bf16*)(F.ws + WS_WUVT);
    for (int i = F.blk * NTHR + F.tid; i < 2 * 8 * 128 * 64; i += F.G * NTHR) {
        { const int d = i & 63, c = (i >> 6) & 127, lh = i >> 13; wukt[i] = (bf16)f2bf(a.in[2][((size_t)lh * 64 + d) * 128 + c]); }
        { const int c = i & 127, d = (i >> 7) & 63, lh = i >> 13; wuvt[i] = (bf16)f2bf(a.in[3][((size_t)lh * 128 + c) * 64 + d]); }
    }
}

DI void ln_row(f32x4 (&v)[4], const float* g, const float* b, int lane) {
    float s = 0.f;
#pragma unroll
    for (int j = 0; j < 4; ++j) s += (v[j][0] + v[j][1]) + (v[j][2] + v[j][3]);
    const float mean = wave_sum(s) * (1.f / DM); float s2 = 0.f;
#pragma unroll
    for (int j = 0; j < 4; ++j) { v[j] = v[j] - mean; s2 += (v[j][0] * v[j][0] + v[j][1] * v[j][1]) + (v[j][2] * v[j][2] + v[j][3] * v[j][3]); }
    const float rstd = 1.f / sqrtf(wave_sum(s2) * (1.f / DM) + LN_EPS);
#pragma unroll
    for (int j = 0; j < 4; ++j) { const f32x4 gg = *((const f32x4*)g + lane + 64 * j), bb = *((const f32x4*)b + lane + 64 * j); v[j] = v[j] * rstd * gg + bb; }
}
DI void store_row_f32(float* p, const f32x4 (&v)[4], int lane) {
#pragma unroll
    for (int j = 0; j < 4; ++j) *((f32x4*)p + lane + 64 * j) = v[j];
}
DI void store_row_bf16(bf16* p, const f32x4 (&v)[4], int lane) {
#pragma unroll
    for (int j = 0; j < 4; ++j) { v2u w; w.x = cvtpk(v[j][0], v[j][1]); w.y = cvtpk(v[j][2], v[j][3]); *((v2u*)p + lane + 64 * j) = w; }
}
template <int NL> DI void small_proj(LAS const float* xs, const float* W, int ldw, int lane, float (&acc)[4]) {
    constexpr int PARTS = 64 / NL, DPER = 1024 / PARTS;
    const int n = lane & (NL - 1), part = lane / NL;
    acc[0] = acc[1] = acc[2] = acc[3] = 0.f;
    const float* wp = W + (size_t)(part * DPER) * ldw + n;
    LAS const float* xp = xs + part * DPER;
#pragma unroll 8
    for (int d = 0; d < DPER; ++d) { const float w = wp[(size_t)d * ldw];
        acc[0] += w * xp[d]; acc[1] += w * xp[1024 + d]; acc[2] += w * xp[2048 + d]; acc[3] += w * xp[3072 + d]; }
#pragma unroll
    for (int o = NL; o < 64; o <<= 1) {
#pragma unroll
        for (int k = 0; k < 4; ++k) acc[k] += __shfl_xor(acc[k], o); }
}

DI void ph_even_prep(const Args& a, const Fr& F, int j) {
    const bf16* proj = (const bf16*)(F.ws + WS_PROJ);
    bf16* ckvn = (bf16*)(F.ws + WS_CKVN); bf16* ql = (bf16*)(F.ws + WS_QL); float* kbar = (float*)(F.ws + WS_KBAR);
    const float* kvg = a.in[4] + j * 128;
    const bf16* wukt = (const bf16*)(F.ws + WS_WUKT) + (size_t)j * 8 * 128 * 64;
    const int lane = F.lane, wave = F.wave;
    for (int chunk = F.blk; chunk < 256; chunk += F.G) {
        const int tok0 = chunk * 128;
#pragma unroll 1
        for (int i0 = 0; i0 < 16; i0 += 8) { unsigned wv[8];
#pragma unroll
            for (int i = 0; i < 8; ++i) wv[i] = *((const unsigned*)(proj + (size_t)(tok0 + wave * 16 + i0 + i) * EV_N + EC_CKV) + lane);
#pragma unroll
            for (int i = 0; i < 8; ++i) { const int tok = tok0 + wave * 16 + i0 + i; const float v0 = bf2f(wv[i] & 0xffffu), v1 = bf2f(wv[i] >> 16);
                const float ss = wave_sum(v0 * v0 + v1 * v1);
                const float r = 1.f / sqrtf(ss * (1.f / 128.f) + LN_EPS);
                *((unsigned*)(ckvn + (size_t)tok * 128) + lane) = cvtpk(v0 * r * kvg[2 * lane], v1 * r * kvg[2 * lane + 1]); } }
        { bf16* kic = (bf16*)(F.ws + WS_KIC); const int tok = tok0 + wave * 16 + (lane >> 2), c = (lane & 3) * 16;
            const v4u* src = (const v4u*)(proj + (size_t)tok * EV_N + EC_KI + c); v4u* dst = (v4u*)(kic + (size_t)tok * 64 + c); dst[0] = src[0]; dst[1] = src[1]; }
        { const int h = wave, l15 = lane & 15, kg = lane >> 4;
            bf16x8 af[8][2];
#pragma unroll
            for (int ct = 0; ct < 8; ++ct)
#pragma unroll
                for (int ks = 0; ks < 2; ++ks) af[ct][ks] = *(const bf16x8*)(wukt + ((size_t)h * 128 + ct * 16 + l15) * 64 + ks * 32 + kg * 8);
#pragma unroll 1
            for (int tg = 0; tg < 8; tg += 4) { bf16x8 qf[4][2];
#pragma unroll
                for (int u = 0; u < 4; ++u)
#pragma unroll
                    for (int ks = 0; ks < 2; ++ks) qf[u][ks] = *(const bf16x8*)(proj + (size_t)(tok0 + (tg + u) * 16 + l15) * EV_N + EC_QA + h * 64 + ks * 32 + kg * 8);
#pragma unroll
                for (int u = 0; u < 4; ++u) { const int tok = tok0 + (tg + u) * 16 + l15;
#pragma unroll
                    for (int ct = 0; ct < 8; ++ct) { f32x4 d = {0.f, 0.f, 0.f, 0.f};
                        d = mfma16(af[ct][0], qf[u][0], d); d = mfma16(af[ct][1], qf[u][1], d);
                        v2u w; w.x = cvtpk(d[0], d[1]); w.y = cvtpk(d[2], d[3]);
                        *(v2u*)(ql + (size_t)tok * 1024 + h * 128 + ct * 16 + 4 * kg) = w; } } } }
        if (chunk < 128) { const int b = chunk >> 5, n = chunk & 31; float s8[8];
#pragma unroll
            for (int k = 0; k < 8; ++k) s8[k] = 0.f;
            const bf16* kp = proj + ((size_t)b * SEQ + n * 256 + wave * 32) * EV_N + EC_KB + lane * 8;
#pragma unroll 8
            for (int r = 0; r < 32; ++r) { const v4u w = *(const v4u*)(kp + (size_t)r * EV_N);
#pragma unroll
                for (int k = 0; k < 4; ++k) { s8[2 * k] += bf2f(w[k] & 0xffffu); s8[2 * k + 1] += bf2f(w[k] >> 16); } }
            LAS float* red = (LAS float*)F.lds;
            __syncthreads();
#pragma unroll
            for (int k = 0; k < 8; ++k) red[wave * 512 + lane * 8 + k] = s8[k];
            __syncthreads();
            float s = 0.f;
#pragma unroll
            for (int w = 0; w < 8; ++w) s += red[w * 512 + F.tid];
            const int h = F.tid >> 6, d = F.tid & 63;
            kbar[(((size_t)b * 8 + h) * 32 + n) * 64 + d] = s * (1.f / 256.f); }
    }
}

DI void moba_gate_chunk(const Fr& F, int chunk) {
    const bf16* proj = (const bf16*)(F.ws + WS_PROJ); const float* kbar = (const float*)(F.ws + WS_KBAR); unsigned* sel3 = (unsigned*)(F.ws + WS_SEL3);
    const int tok0 = chunk * 128, b = tok0 / SEQ, own = (tok0 % SEQ) >> 8, h = F.wave, lane = F.lane;
    float q0[64], q1[64];
    { const v4u* p0 = (const v4u*)(proj + (size_t)(tok0 + lane) * EV_N + EC_QB + h * 64); const v4u* p1 = (const v4u*)(proj + (size_t)(tok0 + 64 + lane) * EV_N + EC_QB + h * 64);
#pragma unroll
        for (int i = 0; i < 8; ++i) { const v4u w0 = p0[i], w1 = p1[i];
#pragma unroll
            for (int k = 0; k < 4; ++k) { q0[8 * i + 2 * k] = bf2f(w0[k] & 0xffffu); q0[8 * i + 2 * k + 1] = bf2f(w0[k] >> 16); q1[8 * i + 2 * k] = bf2f(w1[k] & 0xffffu); q1[8 * i + 2 * k + 1] = bf2f(w1[k] >> 16); } } }
    float a0 = -INFINITY, a1 = -INFINITY, a2 = -INFINITY, c0 = -INFINITY, c1 = -INFINITY, c2 = -INFINITY; int ai0 = 0, ai1 = 0, ai2 = 0, ci0 = 0, ci1 = 0, ci2 = 0;
    const float* kb = kbar + (((size_t)b * 8 + h) * 32) * 64;
    for (int n = 0; n < own; ++n) { float g0 = 0.f, g1 = 0.f;
#pragma unroll
        for (int d = 0; d < 64; d += 4) { const f32x4 kv = *(const f32x4*)(kb + n * 64 + d);
#pragma unroll
            for (int k = 0; k < 4; ++k) { g0 += q0[d + k] * kv[k]; g1 += q1[d + k] * kv[k]; } }
        if (g0 > a2) { if (g0 > a1) { a2 = a1; ai2 = ai1; if (g0 > a0) { a1 = a0; ai1 = ai0; a0 = g0; ai0 = n; } else { a1 = g0; ai1 = n; } } else { a2 = g0; ai2 = n; } }
        if (g1 > c2) { if (g1 > c1) { c2 = c1; ci2 = ci1; if (g1 > c0) { c1 = c0; ci1 = ci0; c0 = g1; ci0 = n; } else { c1 = g1; ci1 = n; } } else { c2 = g1; ci2 = n; } }
    }
    const unsigned nv = own < 3 ? own : 3;
    sel3[(size_t)(tok0 + lane) * 8 + h] = (unsigned)ai0 | ((unsigned)ai1 << 8) | ((unsigned)ai2 << 16) | (nv << 24);
    sel3[(size_t)(tok0 + 64 + lane) * 8 + h] = (unsigned)ci0 | ((unsigned)ci1 << 8) | ((unsigned)ci2 << 16) | (nv << 24);
}

constexpr int HS = 257;
DI float relu1(float x) { const unsigned u = __float_as_uint(x); return __uint_as_float(u & ~(unsigned)((int)u >> 31)); }
template <int MODE, bool DIAG> DI void idx_tile(const bf16x8 (&kf)[4], LAS const char* qb  , const float (&wj)[4], int kt, int q, int hi, unsigned c0, unsigned c1,
                                     LAS unsigned* hist, LAS unsigned* mask, LAS unsigned* cmask, LAS unsigned long long* cand, LAS unsigned* rinfo) {
    f32x2 scp[8];
#pragma unroll
    for (int p = 0; p < 8; ++p) scp[p] = (f32x2){0.f, 0.f};
    bf16x8 qv0[2][4], qv1[2][4];
#pragma unroll
    for (int j = 0; j < 2; ++j)
#pragma unroll
        for (int s = 0; s < 4; ++s) qv0[j][s] = *(LAS const bf16x8*)(qb + (j * 8 + s * 2) * 512);
#pragma unroll
    for (int j = 0; j < 2; ++j)
#pragma unroll
        for (int s = 0; s < 4; ++s) qv1[j][s] = *(LAS const bf16x8*)(qb + ((2 + j) * 8 + s * 2) * 512);
    __builtin_amdgcn_sched_barrier(0);
#pragma unroll
    for (int g = 0; g < 2; ++g) { f32x16 acc[2];
#pragma unroll
        for (int j = 0; j < 2; ++j)
#pragma unroll
            for (int r = 0; r < 16; ++r) acc[j][r] = 0.f;
#pragma unroll
        for (int s = 0; s < 4; ++s)
#pragma unroll
            for (int j = 0; j < 2; ++j) { if (MODE != -2) acc[j] = mfma32(kf[s], g == 0 ? qv0[j][s] : qv1[j][s], acc[j]); else acc[j][s] += __builtin_bit_cast(float, (unsigned)(kf[s][0] ^ (g == 0 ? qv0[j][s][0] : qv1[j][s][0]))); }
#pragma unroll
        for (int p = 0; p < 8; ++p)
#pragma unroll
            for (int j = 0; j < 2; ++j) { const f32x2 a = {relu1(acc[j][2 * p]), relu1(acc[j][2 * p + 1])}; const f32x2 w2 = {wj[2 * g + j], wj[2 * g + j]}; scp[p] = a * w2 + scp[p]; } }
    unsigned sel = 0u, cnd = 0u;
    if (MODE <= 0) { float t = 0.f;
#pragma unroll
        for (int p = 0; p < 8; ++p) t += scp[p][0] + scp[p][1];
        if (t == 12345.678f) __hip_atomic_fetch_or(mask + q * HS + kt, 1u, __ATOMIC_RELAXED, __HIP_MEMORY_SCOPE_WORKGROUP);
        return; }
    const float F0 = __uint_as_float(c0), F1 = __uint_as_float(c1);
#pragma unroll
    for (int r = 0; r < 16; ++r) { const int kr = crow(r, hi);
        const bool ok = !DIAG || kr <= q;
        const float scv = scp[r >> 1][r & 1]; const unsigned u = __float_as_uint(scv);
        if (MODE == 1) { const unsigned key = u ^ ((unsigned)((int)u >> 31) | 0x80000000u);
            if (ok && (key >> 24) >= c0) __hip_atomic_fetch_add(hist + q * HS + (key >> 24), 1u, __ATOMIC_RELAXED, __HIP_MEMORY_SCOPE_WORKGROUP); }
        else if (MODE == 2) { if (ok && (u >> 24) == c0) __hip_atomic_fetch_add(hist + q * HS + (((u >> 16) & 255u) ^ c1), 1u, __ATOMIC_RELAXED, __HIP_MEMORY_SCOPE_WORKGROUP); }
        else { const bool ge1 = scv >= F1, ge0 = scv >= F0;
            if (ok && ge1) sel |= 1u << kr;
            if (ok && ge0 && !ge1) { cnd |= 1u << kr; const unsigned key = u ^ ((unsigned)((int)u >> 31) | 0x80000000u);
                const unsigned pos = __hip_atomic_fetch_add(rinfo + 128 + q, 1u, __ATOMIC_RELAXED, __HIP_MEMORY_SCOPE_WORKGROUP);
                if (pos < 64u) cand[q * 64 + pos] = ((unsigned long long)key << 32) | (unsigned)(~(unsigned)(kt * 32 + kr)); } } }
    if (MODE == 3) { if (sel) __hip_atomic_fetch_or(mask + q * HS + kt, sel, __ATOMIC_RELAXED, __HIP_MEMORY_SCOPE_WORKGROUP);
        if (cnd) __hip_atomic_fetch_or(cmask + q * HS + kt, cnd, __ATOMIC_RELAXED, __HIP_MEMORY_SCOPE_WORKGROUP); }
}
template <int MODE> DI void idx_pass(const bf16* proj, int rowbase, int qt, LAS const char* qimg, const float (&wj)[4], LAS unsigned* hist, LAS unsigned* mask, LAS unsigned* cmask, LAS unsigned long long* cand, LAS unsigned* rinfo, int wave, int lane) {
    const int q = lane & 31, hi = lane >> 5, nkt = qt + 1;
    const unsigned b1 = MODE == 2 ? rinfo[160 + q] : rinfo[224 + q], thr16 = MODE == 2 ? rinfo[192 + q] : rinfo[256 + q];
    const bf16* kp0 = proj + (size_t)(rowbase + q) * 64 + hi * 8;
    LAS const char* qb = qimg + hi * 512 + q * 16;
    const int n = nkt > wave ? (nkt - wave + 7) >> 3 : 0;
    bf16x8 kfa[4], kfb[4];
#define IDX_LOAD(KF, I) do { const bf16* kp_ = kp0 + (size_t)((wave + 8 * (I)) * 32) * 64; _Pragma("unroll") for (int s_ = 0; s_ < 4; ++s_) KF[s_] = *(const bf16x8*)(kp_ + s_ * 16); } while (0)
#define IDX_TILE(KF, I) do { const int kt_ = wave + 8 * (I); if (kt_ == qt) idx_tile<MODE, true>(KF, qb, wj, kt_, q, hi, b1, thr16, hist, mask, cmask, cand, rinfo); \
        else idx_tile<MODE, false>(KF, qb, wj, kt_, q, hi, b1, thr16, hist, mask, cmask, cand, rinfo); } while (0)
    if (n > 0) IDX_LOAD(kfa, 0);
    for (int i = 0; i < n; i += 2) {
        if (i + 1 < n) { if (MODE == -1) { _Pragma("unroll") for (int s_ = 0; s_ < 4; ++s_) kfb[s_] = kfa[s_]; } else IDX_LOAD(kfb, i + 1); }
        IDX_TILE(kfa, i);
        if (i + 1 < n) { if (i + 2 < n && MODE != -1) IDX_LOAD(kfa, i + 2); IDX_TILE(kfb, i + 1); }
    }
#undef IDX_LOAD
#undef IDX_TILE
}
DI void hist_pick(LAS const unsigned* hrow, unsigned need, int lane, unsigned& bin, unsigned& above) {
    unsigned h4[4];
#pragma unroll
    for (int k = 0; k < 4; ++k) h4[k] = hrow[4 * lane + k];
    const unsigned ssum = h4[0] + h4[1] + h4[2] + h4[3];
    unsigned x = ssum;
#pragma unroll
    for (int o = 1; o < 64; o <<= 1) { const unsigned y = __shfl_down(x, o); if (lane + o < 64) x += y; }
    const unsigned long long m = __ballot(x >= need);
    const int Ls = m ? 63 - __builtin_clzll(m) : 0;
    const unsigned xs = __shfl(x, Ls), ss = __shfl(ssum, Ls);
    const unsigned h0 = __shfl(h4[0], Ls), h1 = __shfl(h4[1], Ls), h2 = __shfl(h4[2], Ls), h3 = __shfl(h4[3], Ls);
    unsigned cum = xs - ss;
    if (cum + h3 >= need) { bin = 4 * Ls + 3; above = cum; return; } cum += h3;
    if (cum + h2 >= need) { bin = 4 * Ls + 2; above = cum; return; } cum += h2;
    if (cum + h1 >= need) { bin = 4 * Ls + 1; above = cum; return; } cum += h1;
    bin = 4 * Ls; above = cum; (void)h0;
}
DI void idx_pass1(const bf16* proj, int rowbase, int qt, LAS const char* qimg, const float (&wj)[4], LAS unsigned* hist, LAS unsigned* mask, LAS unsigned* cmask, LAS unsigned long long* cand, LAS unsigned* rinfo, int wave, int lane) {
    const int q = lane & 31, hi = lane >> 5, nkt = qt + 1, nmax = (nkt + 7) >> 3;
    const bf16* kp0 = proj + (size_t)(rowbase + q) * 64 + hi * 8;
    LAS const char* qb = qimg + hi * 512 + q * 16;
    unsigned lb = 0u;
    bf16x8 kfc[4], kfn[4];
    if (wave < nkt) {
#pragma unroll
        for (int s = 0; s < 4; ++s) kfc[s] = *(const bf16x8*)(kp0 + (size_t)(wave * 32) * 64 + s * 16); }
    for (int i = 0; i < nmax; ++i) { const int kt = wave + 8 * i;
        if (kt + 8 < nkt) {
#pragma unroll
            for (int s = 0; s < 4; ++s) kfn[s] = *(const bf16x8*)(kp0 + (size_t)((kt + 8) * 32) * 64 + s * 16); }
        if (kt < nkt) { if (kt == qt) idx_tile<1, true>(kfc, qb, wj, kt, q, hi, lb, 0u, hist, mask, cmask, cand, rinfo); else idx_tile<1, false>(kfc, qb, wj, kt, q, hi, lb, 0u, hist, mask, cmask, cand, rinfo); }
#pragma unroll
        for (int s = 0; s < 4; ++s) kfc[s] = kfn[s];
        if (((i + 1) & i) == 0 && i + 1 < nmax && i < 16) {
            __syncthreads();
#pragma unroll 1
            for (int rr = 0; rr < 4; ++rr) { const int row = wave * 4 + rr; unsigned bin, above; hist_pick(hist + row * HS, 256u, lane, bin, above);
                if (lane == 0) rinfo[288 + row] = bin; }
            __syncthreads();
            { const unsigned nb = rinfo[288 + q]; lb = nb > lb ? nb : lb; } }
    }
}
DI void idx_unit(const Fr& F, int b, int qt, int stop = 0  ) {
    const bf16* proj = (const bf16*)(F.ws + WS_PROJ); const bf16* kic = (const bf16*)(F.ws + WS_KIC); unsigned short* sel = (unsigned short*)(F.ws + WS_SEL);
    LAS unsigned* hist = (LAS unsigned*)(F.lds); LAS unsigned* mask = hist + 32 * HS; LAS unsigned* cmask = mask + 32 * HS;
    LAS unsigned long long* cand = (LAS unsigned long long*)(F.lds + 99328); LAS unsigned* rinfo = (LAS unsigned*)(F.lds + 115712);
    const int lane = F.lane, wave = F.wave, tid = F.tid, t0 = qt * 32, rowbase = b * SEQ;
    __syncthreads();
    for (int i = tid; i < 3 * 32 * HS; i += NTHR) hist[i] = 0u;
    if (tid < 320) rinfo[tid] = 0u;
    __syncthreads();
    if (t0 + 31 <= 255 || (EXPF & 64)) {
        if (lane < 8) {
#pragma unroll
            for (int rr = 0; rr < 4; ++rr) { const int row = wave * 4 + rr, nv = t0 + row + 1;
                const int nv0 = t0 + row + 1; const int nvc = nv0 < 256 ? nv0 : 256; (void)nv; mask[row * HS + lane] = nvc >= 32 * (lane + 1) ? 0xffffffffu : (nvc > 32 * lane ? ((1u << (nvc - 32 * lane)) - 1u) : 0u); } }
    } else {
        const int q = lane & 31;
        float wj[4];
        { const bf16* qp = proj + (size_t)(rowbase + t0 + q) * EV_N;
#pragma unroll
            for (int j = 0; j < 4; ++j) wj[j] = bf2f(qp[EC_WI + j]); }
        LAS char* qimg = (LAS char*)(F.lds + 117248);
#pragma unroll
        for (int i = 0; i < 2; ++i) { const int p = tid + i * NTHR, row = p & 31, c = p >> 5;
            *(LAS v4u*)(qimg + c * 512 + row * 16) = *(const v4u*)(proj + (size_t)(rowbase + t0 + row) * EV_N + EC_QI + c * 8); }
        __syncthreads();
        if (stop == 7) return;
        if (stop == 4) { idx_pass<0>(kic, rowbase, qt, qimg, wj, hist, mask, cmask, cand, rinfo, wave, lane); return; }
        if (stop == 5) { idx_pass<-1>(kic, rowbase, qt, qimg, wj, hist, mask, cmask, cand, rinfo, wave, lane); return; }
        if (stop == 6) { idx_pass<-2>(kic, rowbase, qt, qimg, wj, hist, mask, cmask, cand, rinfo, wave, lane); return; }
        idx_pass1(kic, rowbase, qt, qimg, wj, hist, mask, cmask, cand, rinfo, wave, lane);
        __syncthreads();
#pragma unroll 1
        for (int rr = 0; rr < 4; ++rr) { const int row = wave * 4 + rr; unsigned bin, above; hist_pick(hist + row * HS, 256u, lane, bin, above);
            if (lane == 0) { rinfo[row] = bin; rinfo[32 + row] = 256u - above; rinfo[160 + row] = bin >= 128u ? bin - 128u : 255u - bin; rinfo[192 + row] = bin >= 128u ? 0u : 255u; } }
        __syncthreads();
        if (stop == 1) return;
        for (int i = tid; i < 32 * HS; i += NTHR) hist[i] = 0u;
        __syncthreads();
        idx_pass<2>(kic, rowbase, qt, qimg, wj, hist, mask, cmask, cand, rinfo, wave, lane);
        __syncthreads();
#pragma unroll 1
        for (int rr = 0; rr < 4; ++rr) { const int row = wave * 4 + rr; const unsigned need1 = rinfo[32 + row]; unsigned bin, above; hist_pick(hist + row * HS, need1, lane, bin, above);
            if (lane == 0) { const unsigned t16 = (rinfo[row] << 8) | bin, k0 = t16 << 16, k1 = (t16 + 1u) << 16;
                rinfo[64 + row] = t16; rinfo[96 + row] = need1 - above;
                rinfo[224 + row] = (k0 & 0x80000000u) ? (k0 ^ 0x80000000u) : ~k0; rinfo[256 + row] = (t16 == 0xffffu) ? 0x7fc00000u : ((k1 & 0x80000000u) ? (k1 ^ 0x80000000u) : ~k1); } }
        __syncthreads();
        if (stop == 2) return;
        idx_pass<3>(kic, rowbase, qt, qimg, wj, hist, mask, cmask, cand, rinfo, wave, lane);
        __syncthreads();
        if (stop == 3) return;
#pragma unroll 1
        for (int rr = 0; rr < 4; ++rr) { const int row = wave * 4 + rr; const unsigned call = rinfo[128 + row], need2 = rinfo[96 + row];
            if (call <= 64u) { const unsigned c = call;
                const unsigned long long mine = cand[row * 64 + lane]; unsigned rank = 0u;
                for (unsigned k = 0; k < c; ++k) rank += (cand[row * 64 + k] > mine) ? 1u : 0u;
                if ((unsigned)lane < c && rank < need2) { const unsigned s = ~(unsigned)mine;
                    __hip_atomic_fetch_or(mask + row * HS + (s >> 5), 1u << (s & 31), __ATOMIC_RELAXED, __HIP_MEMORY_SCOPE_WORKGROUP); } }
            else { unsigned w4[4];
#pragma unroll
                for (int k = 0; k < 4; ++k) w4[k] = cmask[row * HS + 4 * lane + k];
                const unsigned cnt = __popc(w4[0]) + __popc(w4[1]) + __popc(w4[2]) + __popc(w4[3]);
                unsigned x = cnt;
#pragma unroll
                for (int o = 1; o < 64; o <<= 1) { const unsigned y = __shfl_up(x, o); if (lane >= o) x += y; }
                unsigned before = x - cnt;
#pragma unroll
                for (int k = 0; k < 4; ++k) { unsigned w = w4[k]; const unsigned pc = __popc(w); unsigned take = 0u;
                    if (before < need2) { if (before + pc <= need2) take = w; else { unsigned left = need2 - before; while (left) { const unsigned b = w & (0u - w); take |= b; w ^= b; --left; } } }
                    before += pc;
                    if (take) mask[row * HS + 4 * lane + k] |= take; } }
        }
    }
    __syncthreads();
#pragma unroll 1
    for (int rr = 0; rr < 4; ++rr) { const int row = wave * 4 + rr; unsigned short* out = sel + (size_t)(rowbase + t0 + row) * 256;
        unsigned w4[4];
#pragma unroll
        for (int k = 0; k < 4; ++k) w4[k] = mask[row * HS + 4 * lane + k];
        const unsigned cnt = __popc(w4[0]) + __popc(w4[1]) + __popc(w4[2]) + __popc(w4[3]);
        unsigned x = cnt;
#pragma unroll
        for (int o = 1; o < 64; o <<= 1) { const unsigned y = __shfl_up(x, o); if (lane >= o) x += y; }
        const unsigned total = __shfl(x, 63); unsigned pos = x - cnt;
#pragma unroll
        for (int k = 0; k < 4; ++k) { unsigned w = w4[k]; const unsigned base = (unsigned)(4 * lane + k) * 32u;
            while (w) { const unsigned bit = __builtin_ctz(w); if (pos < 256u) out[pos] = (unsigned short)(base + bit); ++pos; w &= w - 1u; } }
        for (unsigned i = total + lane; i < 256u; i += 64u) out[i] = (unsigned short)0xffffu; }
}

struct AttSt { float m, l; f32x16 o0, o1; };
template <class BF> DI void att_subtile(AttSt& S, const bf16x8 (&qf)[4], LAS const char* Kst, LAS const char* Vb, int vdh, int vrow0, int lane, const BF& bias) {
    const int r32 = lane & 31, hi = lane >> 5;
    f32x16 p;
#pragma unroll
    for (int r = 0; r < 16; ++r) p[r] = bias.b(crow(r, hi)) - S.m;
    LAS const char* kp = Kst + hi * 512 + r32 * 16;
#pragma unroll
    for (int s = 0; s < 4; ++s) { const bf16x8 kf = *(LAS const bf16x8*)(kp + s * 1024); p = mfma32(kf, qf[s], p); }
    if (bias.any) {
#pragma unroll
        for (int r = 0; r < 16; ++r) p[r] = bias.msk(crow(r, hi)) ? -INFINITY : p[r]; }
    float mxa[4] = {-INFINITY, -INFINITY, -INFINITY, -INFINITY};
#pragma unroll
    for (int r = 0; r < 16; ++r) mxa[r & 3] = fmaxf(mxa[r & 3], p[r]);
    float mx = fmaxf(fmaxf(mxa[0], mxa[1]), fmaxf(mxa[2], mxa[3]));
    mx = fmaxf(mx, __shfl_xor(mx, 32));
    if (__any(mx > 16.f)) { const float dl = fmaxf(mx, 0.f), sc = ex2(-dl); S.m += dl; S.l *= sc;
#pragma unroll
        for (int r = 0; r < 16; ++r) { p[r] -= dl; S.o0[r] *= sc; S.o1[r] *= sc; } }
    float psa[4] = {0.f, 0.f, 0.f, 0.f};
#pragma unroll
    for (int r = 0; r < 16; ++r) { p[r] = ex2(p[r]); psa[r & 3] += p[r]; }
    S.l += (psa[0] + psa[1]) + (psa[2] + psa[3]);
    v4u pw0, pw1;
    pw0.x = cvtpk(p[0], p[1]); pw0.y = cvtpk(p[2], p[3]); pw0.z = cvtpk(p[4], p[5]); pw0.w = cvtpk(p[6], p[7]);
    pw1.x = cvtpk(p[8], p[9]); pw1.y = cvtpk(p[10], p[11]); pw1.z = cvtpk(p[12], p[13]); pw1.w = cvtpk(p[14], p[15]);
    const bf16x8 pf0 = __builtin_bit_cast(bf16x8, pw0), pf1 = __builtin_bit_cast(bf16x8, pw1);
    LAS const char* vp = Vb + (vrow0 + 4 * hi + ((lane & 15) >> 2)) * 64 + ((lane >> 4) & 1) * 32 + (lane & 3) * 8;
    { const bf16x8 v00 = cat8(vtr(vp), vtr(vp + 512)), v10 = cat8(vtr(vp + vdh), vtr(vp + vdh + 512));
      const bf16x8 v01 = cat8(vtr(vp + 1024), vtr(vp + 1536)), v11 = cat8(vtr(vp + vdh + 1024), vtr(vp + vdh + 1536));
      S.o0 = mfma32(v00, pf0, S.o0); S.o1 = mfma32(v10, pf0, S.o1);
      S.o0 = mfma32(v01, pf1, S.o0); S.o1 = mfma32(v11, pf1, S.o1); }
}
template <class BF0, class BF1> DI void att_tile64(AttSt& S, const bf16x8 (&qf)[4], LAS const char* Kst, LAS const char* Vb, int vdh, int vrow0, int lane, const BF0& bias0, const BF1& bias1) {
    const int r32 = lane & 31, hi = lane >> 5;
    f32x16 p0, p1;
#pragma unroll
    for (int r = 0; r < 16; ++r) { p0[r] = bias0.b(crow(r, hi)) - S.m; p1[r] = bias1.b(crow(r, hi)) - S.m; }
    LAS const char* kp = Kst + hi * 512 + r32 * 16;
#pragma unroll
    for (int s = 0; s < 4; ++s) { const bf16x8 k0 = *(LAS const bf16x8*)(kp + s * 1024), k1 = *(LAS const bf16x8*)(kp + 4096 + s * 1024); p0 = mfma32(k0, qf[s], p0); p1 = mfma32(k1, qf[s], p1); }
    if (bias0.any) {
#pragma unroll
        for (int r = 0; r < 16; ++r) p0[r] = bias0.msk(crow(r, hi)) ? -INFINITY : p0[r]; }
    if (bias1.any) {
#pragma unroll
        for (int r = 0; r < 16; ++r) p1[r] = bias1.msk(crow(r, hi)) ? -INFINITY : p1[r]; }
    float mxa[4] = {-INFINITY, -INFINITY, -INFINITY, -INFINITY};
#pragma unroll
    for (int r = 0; r < 16; ++r) mxa[r & 3] = fmaxf(mxa[r & 3], fmaxf(p0[r], p1[r]));
    float mx = fmaxf(fmaxf(mxa[0], mxa[1]), fmaxf(mxa[2], mxa[3]));
    mx = fmaxf(mx, __shfl_xor(mx, 32));
    if (__any(mx > 16.f)) { const float dl = fmaxf(mx, 0.f), sc = ex2(-dl); S.m += dl; S.l *= sc;
#pragma unroll
        for (int r = 0; r < 16; ++r) { p0[r] -= dl; p1[r] -= dl; S.o0[r] *= sc; S.o1[r] *= sc; } }
    float psa[4] = {0.f, 0.f, 0.f, 0.f};
#pragma unroll
    for (int r = 0; r < 16; ++r) { p0[r] = ex2(p0[r]); p1[r] = ex2(p1[r]); psa[r & 3] += p0[r] + p1[r]; }
    S.l += (psa[0] + psa[1]) + (psa[2] + psa[3]);
    v4u a0, a1, b0, b1;
    a0.x = cvtpk(p0[0], p0[1]); a0.y = cvtpk(p0[2], p0[3]); a0.z = cvtpk(p0[4], p0[5]); a0.w = cvtpk(p0[6], p0[7]);
    a1.x = cvtpk(p0[8], p0[9]); a1.y = cvtpk(p0[10], p0[11]); a1.z = cvtpk(p0[12], p0[13]); a1.w = cvtpk(p0[14], p0[15]);
    b0.x = cvtpk(p1[0], p1[1]); b0.y = cvtpk(p1[2], p1[3]); b0.z = cvtpk(p1[4], p1[5]); b0.w = cvtpk(p1[6], p1[7]);
    b1.x = cvtpk(p1[8], p1[9]); b1.y = cvtpk(p1[10], p1[11]); b1.z = cvtpk(p1[12], p1[13]); b1.w = cvtpk(p1[14], p1[15]);
    LAS const char* vp = Vb + (vrow0 + 4 * hi + ((lane & 15) >> 2)) * 64 + ((lane >> 4) & 1) * 32 + (lane & 3) * 8;
#pragma unroll
    for (int k16 = 0; k16 < 4; ++k16) { const bf16x8 pf = __builtin_bit_cast(bf16x8, k16 == 0 ? a0 : k16 == 1 ? a1 : k16 == 2 ? b0 : b1);
        const bf16x8 v0 = cat8(vtr(vp + k16 * 1024), vtr(vp + k16 * 1024 + 512)), v1 = cat8(vtr(vp + vdh + k16 * 1024), vtr(vp + vdh + k16 * 1024 + 512));
        S.o0 = mfma32(v0, pf, S.o0); S.o1 = mfma32(v1, pf, S.o1); }
}

struct MobaFar { float c; bool any; DI float b(int) const { return c; } DI bool msk(int) const { return false; } };
struct MobaBias { LAS const float* lut; int tq, s0; bool any;
    DI float b(int kvrel) const { const int dist = tq - (s0 + kvrel); return lut[dist < 0 ? 0 : (dist > 1023 ? 1023 : dist)]; }
    DI bool msk(int kvrel) const { return tq - (s0 + kvrel) < 0; } };
DI void moba_qload(bf16x8 (&qf)[4], const bf16* proj, int rowbase, int h, int tq, int hi) {
    const bf16* qp = proj + (size_t)(rowbase + tq) * EV_N + EC_QB + h * 64 + hi * 8;
#pragma unroll
    for (int s = 0; s < 4; ++s) qf[s] = *(const bf16x8*)(qp + s * 16);
}
DI void moba_tile(const Fr& F, const bf16x8 (&qf)[4], int rowbase, int h, int n, int tq, bool valid, int slot, bool own, int wave_tile) {
    LAS const char* Kb = (LAS const char*)F.lds; LAS const char* Vb = (LAS const char*)(F.lds + 32768); LAS const float* lut = (LAS const float*)(F.lds + 98304);
    bf16* po = (bf16*)(F.ws + WS_ACT); float* pml = (float*)(F.ws + WS_PML);
    const int lane = F.lane, hi = lane >> 5;
    AttSt S; S.m = 0.f; S.l = 0.f;
#pragma unroll
    for (int r = 0; r < 16; ++r) { S.o0[r] = 0.f; S.o1[r] = 0.f; }
    const int nst = own ? wave_tile + 1 : 8;
    int tmin = tq;
#pragma unroll
    for (int o = 1; o < 64; o <<= 1) { const int y = __shfl_xor(tmin, o); tmin = y < tmin ? y : tmin; }
    const float cfar = lut[1023];
    int st = 0;
    for (; st + 1 < nst; st += 2) {
        if (!own && tmin - (n * 256 + st * 32 + 63) >= 790) { MobaFar bf{cfar, false}; att_tile64(S, qf, Kb + st * 4096, Vb, 16384, st * 32, lane, bf, bf); }
        else { MobaBias bf0{lut, tq, n * 256 + st * 32, false}, bf1{lut, tq, n * 256 + st * 32 + 32, own && st + 1 == wave_tile}; att_tile64(S, qf, Kb + st * 4096, Vb, 16384, st * 32, lane, bf0, bf1); } }
    if (st < nst) { MobaBias bf{lut, tq, n * 256 + st * 32, own && st == wave_tile}; att_subtile(S, qf, Kb + st * 4096, Vb, 16384, st * 32, lane, bf); }
    const float lt = S.l + __shfl_xor(S.l, 32), inv = 1.f / lt;
    if (valid) { const size_t pi = ((size_t)(rowbase + tq) * 8 + h) * 4 + slot; bf16* o = po + pi * 64;
#pragma unroll
        for (int a4 = 0; a4 < 4; ++a4) { v2u w0, w1;
            w0.x = cvtpk(S.o0[4 * a4] * inv, S.o0[4 * a4 + 1] * inv); w0.y = cvtpk(S.o0[4 * a4 + 2] * inv, S.o0[4 * a4 + 3] * inv);
            w1.x = cvtpk(S.o1[4 * a4] * inv, S.o1[4 * a4 + 1] * inv); w1.y = cvtpk(S.o1[4 * a4 + 2] * inv, S.o1[4 * a4 + 3] * inv);
            *(v2u*)(o + 8 * a4 + 4 * hi) = w0; *(v2u*)(o + 32 + 8 * a4 + 4 * hi) = w1; }
        if (hi == 0) { f32x2 ml = {S.m, lt}; *(f32x2*)(pml + pi * 2) = ml; } }
}
DI void moba_unit(const Args& a, const Fr& F, int b, int h, int n) {
    const bf16* proj = (const bf16*)(F.ws + WS_PROJ); const unsigned* sel3 = (const unsigned*)(F.ws + WS_SEL3);
    LAS unsigned char* lds = F.lds; LAS unsigned* list = (LAS unsigned*)(lds + 65536); LAS float* lut = (LAS float*)(lds + 98304); LAS unsigned* misc = (LAS unsigned*)(lds + 102400);
    const int tid = F.tid, lane = F.lane, wave = F.wave, rowbase = b * SEQ;
    __syncthreads();
    { const bf16* kg = proj + (size_t)(rowbase + n * 256) * EV_N + EC_KB + h * 64; const bf16* vg = proj + (size_t)(rowbase + n * 256) * EV_N + EC_VB + h * 64;
#pragma unroll
        for (int i = 0; i < 4; ++i) { const int p = tid + i * NTHR;
            { const int r = p & 31, c = (p >> 5) & 7, st = p >> 8; const v4u v = *(const v4u*)(kg + (size_t)(st * 32 + r) * EV_N + c * 8); *(LAS v4u*)(lds + st * 4096 + c * 512 + r * 16) = v; }
            { const int cc = p & 3, row = (p >> 2) & 255, dh = p >> 10; const v4u v = *(const v4u*)(vg + (size_t)row * EV_N + dh * 32 + cc * 8); *(LAS v4u*)(lds + 32768 + dh * 16384 + row * 64 + cc * 16) = v; } }
        for (int d = tid; d < 1024; d += NTHR) lut[d] = a.in[9][t5_bucket(d) * 16 + 8 + h] * LOG2E; }
    if (tid == 0) misc[16] = 0u;
    __syncthreads();
    unsigned sv[16];
#pragma unroll
    for (int k = 0; k < 16; ++k) { const int t = (n + 1) * 256 + k * NTHR + tid; sv[k] = t < SEQ ? sel3[(size_t)(rowbase + t) * 8 + h] : 0u; }
#pragma unroll
    for (int k = 0; k < 16; ++k) { const int tb = (n + 1) * 256 + k * NTHR; if (tb < SEQ) { const int t = tb + tid;
        const unsigned s = sv[k]; const unsigned nv = s >> 24; int slot = -1;
        if (nv > 0u && (s & 255u) == (unsigned)n) slot = 0; else if (nv > 1u && ((s >> 8) & 255u) == (unsigned)n) slot = 1; else if (nv > 2u && ((s >> 16) & 255u) == (unsigned)n) slot = 2;
        const unsigned long long bal = __ballot(slot >= 0); const unsigned wcnt = __popcll(bal);
        if (lane == 0) misc[wave] = wcnt;
        __syncthreads();
        unsigned off = misc[16], tot = 0u;
#pragma unroll
        for (int w = 0; w < 8; ++w) { const unsigned c = misc[w]; if (w < wave) off += c; tot += c; }
        if (slot >= 0) list[off + __popcll(bal & ((1ull << lane) - 1ull))] = ((unsigned)t << 2) | (unsigned)slot;
        __syncthreads();
        if (tid == 0) misc[16] += tot; } }
    __syncthreads();
    const int nlist = (int)misc[16];
    const int ntl = (nlist + 31) >> 5, hi = lane >> 5;
    bf16x8 qa[4], qb2[4];
    moba_qload(qa, proj, rowbase, h, n * 256 + wave * 32 + (lane & 31), hi);
    unsigned ea = 0u, eb = 0u; bool va = false, vb = false;
    int tl = wave;
    if (tl < ntl) { const int li = tl * 32 + (lane & 31); vb = li < nlist; eb = list[vb ? li : nlist - 1]; moba_qload(qb2, proj, rowbase, h, (int)(eb >> 2), hi); }
    moba_tile(F, qa, rowbase, h, n, n * 256 + wave * 32 + (lane & 31), true, 3, true, wave);
    for (; tl < ntl; tl += 16) {
        const int t2 = tl + 8, t3 = tl + 16;
        if (t2 < ntl) { const int li = t2 * 32 + (lane & 31); va = li < nlist; ea = list[va ? li : nlist - 1]; moba_qload(qa, proj, rowbase, h, (int)(ea >> 2), hi); }
        moba_tile(F, qb2, rowbase, h, n, (int)(eb >> 2), vb, (int)(eb & 3u), false, 0);
        if (t2 < ntl) {
            if (t3 < ntl) { const int li = t3 * 32 + (lane & 31); vb = li < nlist; eb = list[vb ? li : nlist - 1]; moba_qload(qb2, proj, rowbase, h, (int)(eb >> 2), hi); }
            moba_tile(F, qa, rowbase, h, n, (int)(ea >> 2), va, (int)(ea & 3u), false, 0); }
    }
}

DI void dsa_step(const bf16x8 (&af)[2][4], const bf16x8 (&qlf)[4], int ch, LAS const unsigned char* bsel, LAS unsigned char* cbuf, LAS const float* tab,
                 float& m, float& l, f32x4 (&oT)[8], int l15, int kg, int lane) {
    f32x4 acc[2];
#pragma unroll
    for (int mt = 0; mt < 2; ++mt) { const unsigned b4 = *(LAS const unsigned*)(bsel + ch * 32 + mt * 16 + 4 * kg);
#pragma unroll
        for (int i = 0; i < 4; ++i) { const unsigned bb = (b4 >> (8 * i)) & 255u; const float tb = tab[(bb & 31u) * 8 + (l15 & 7)];
            acc[mt][i] = (tb - m) + (bb != 255u ? 0.f : -INFINITY); } }
#pragma unroll
    for (int mt = 0; mt < 2; ++mt)
#pragma unroll
        for (int ks = 0; ks < 4; ++ks) { acc[mt] = mfma16(af[mt][ks], qlf[ks], acc[mt]); *(LAS bf16x8*)(cbuf + (mt * 16 + l15) * 288 + (ks * 32 + kg * 8) * 2) = af[mt][ks]; }
    float mx = fmaxf(fmaxf(fmaxf(acc[0][0], acc[0][1]), fmaxf(acc[0][2], acc[0][3])), fmaxf(fmaxf(acc[1][0], acc[1][1]), fmaxf(acc[1][2], acc[1][3])));
    mx = fmaxf(mx, __shfl_xor(mx, 16)); mx = fmaxf(mx, __shfl_xor(mx, 32));
    if (__any(mx > 16.f)) { const float dl = fmaxf(mx, 0.f), sc = ex2(-dl); m += dl; l *= sc;
#pragma unroll
        for (int mt = 0; mt < 2; ++mt) acc[mt] = acc[mt] - dl;
#pragma unroll
        for (int ct = 0; ct < 8; ++ct) oT[ct] = oT[ct] * sc; }
    float ps = 0.f;
#pragma unroll
    for (int mt = 0; mt < 2; ++mt)
#pragma unroll
        for (int i = 0; i < 4; ++i) { acc[mt][i] = ex2(acc[mt][i]); ps += acc[mt][i]; }
    l += ps;
    v4u pw; pw.x = cvtpk(acc[0][0], acc[0][1]); pw.y = cvtpk(acc[0][2], acc[0][3]); pw.z = cvtpk(acc[1][0], acc[1][1]); pw.w = cvtpk(acc[1][2], acc[1][3]);
    const bf16x8 pf = __builtin_bit_cast(bf16x8, pw);
    LDS_WAIT();
    LAS const char* tp = (LAS const char*)cbuf + (4 * kg + (l15 >> 2)) * 288 + (lane & 3) * 8;
#pragma unroll
    for (int ct = 0; ct < 8; ++ct) { const bf16x8 cf = cat8(vtr(tp + ct * 32), vtr(tp + 16 * 288 + ct * 32)); oT[ct] = mfma16(cf, pf, oT[ct]); }
    LDS_WAIT();
}
DI void dsa_gather(bf16x8 (&af)[2][4], const bf16* ckvn, int rowbase, LAS const unsigned short* selb, int ch, int l15, int kg) {
#pragma unroll
    for (int mt = 0; mt < 2; ++mt) { unsigned idx = selb[ch * 32 + mt * 16 + l15]; if (idx == 0xffffu) idx = 0u;
        const bf16* cp = ckvn + (size_t)(rowbase + (int)idx) * 128 + kg * 8;
#pragma unroll
        for (int ks = 0; ks < 4; ++ks) af[mt][ks] = *(const bf16x8*)(cp + ks * 32); }
}
DI void dsa_query(const Fr& F, int tok, const v2u sv, LAS unsigned char* wl, LAS const unsigned char* bkt, LAS const float* tab) {
    const bf16* ql = (const bf16*)(F.ws + WS_QL); const bf16* ckvn = (const bf16*)(F.ws + WS_CKVN); const unsigned short* sel = (const unsigned short*)(F.ws + WS_SEL); bf16* ol = (bf16*)(F.ws + WS_OL);
    const int lane = F.lane, l15 = lane & 15, kg = lane >> 4, t = tok % SEQ, rowbase = tok - t;
    LAS unsigned short* selb = (LAS unsigned short*)wl; LAS unsigned char* bsel = wl + 512; LAS unsigned char* cbuf = wl + 1024;
    { *((LAS v2u*)selb + lane) = sv; unsigned bw = 0u;
#pragma unroll
        for (int i = 0; i < 4; ++i) { const unsigned s = (i < 2 ? (sv.x >> (16 * i)) : (sv.y >> (16 * (i - 2)))) & 0xffffu; const int dist = t - (int)s;
            const unsigned bb = (s != 0xffffu && dist >= 0) ? (unsigned)bkt[dist > 1023 ? 1023 : dist] : 255u; bw |= bb << (8 * i); }
        *((LAS unsigned*)bsel + lane) = bw; }
    bf16x8 qlf[4];
#pragma unroll
    for (int ks = 0; ks < 4; ++ks) { qlf[ks] = *(const bf16x8*)(ql + (size_t)tok * 1024 + (l15 & 7) * 128 + ks * 32 + kg * 8); if (l15 >= 8) qlf[ks] = (bf16x8){0, 0, 0, 0, 0, 0, 0, 0}; }
    float m = 0.f, l = 0.f; f32x4 oT[8];
#pragma unroll
    for (int ct = 0; ct < 8; ++ct) oT[ct] = (f32x4){0.f, 0.f, 0.f, 0.f};
    const int nvalid = t + 1 < 256 ? t + 1 : 256, nch = (nvalid + 31) >> 5;
    LDS_WAIT();
    bf16x8 afa[2][4], afb[2][4], afc[2][4];
    dsa_gather(afa, ckvn, rowbase, selb, 0, l15, kg);
    if (nch > 1) dsa_gather(afb, ckvn, rowbase, selb, 1, l15, kg);
    for (int ch = 0; ch < nch; ch += 3) {
        if (ch + 2 < nch) dsa_gather(afc, ckvn, rowbase, selb, ch + 2, l15, kg);
        dsa_step(afa, qlf, ch, bsel, cbuf, tab, m, l, oT, l15, kg, lane);
        if (ch + 1 < nch) { if (ch + 3 < nch) dsa_gather(afa, ckvn, rowbase, selb, ch + 3, l15, kg);
            dsa_step(afb, qlf, ch + 1, bsel, cbuf, tab, m, l, oT, l15, kg, lane); }
        if (ch + 2 < nch) { if (ch + 4 < nch) dsa_gather(afb, ckvn, rowbase, selb, ch + 4, l15, kg);
            dsa_step(afc, qlf, ch + 2, bsel, cbuf, tab, m, l, oT, l15, kg, lane); }
    }
    l += __shfl_xor(l, 16); l += __shfl_xor(l, 32);
    const float inv = 1.f / l;
    if (l15 < 8) { bf16* o = ol + (size_t)tok * 1024 + l15 * 128 + 4 * kg;
#pragma unroll
        for (int ct = 0; ct < 8; ++ct) { v2u w; w.x = cvtpk(oT[ct][0] * inv, oT[ct][1] * inv); w.y = cvtpk(oT[ct][2] * inv, oT[ct][3] * inv); *(v2u*)(o + ct * 16) = w; } }
}
DI void dsa_chunk(const Args& a, const Fr& F, int c32) {
    LAS unsigned char* bkt = F.lds + 81920; LAS float* tab = (LAS float*)(F.lds + 82944);
    __syncthreads();
    for (int d = F.tid; d < 1024; d += NTHR) bkt[d] = (unsigned char)t5_bucket(d);
    if (F.tid < 256) tab[F.tid] = a.in[9][(F.tid >> 3) * 16 + (F.tid & 7)] * LOG2E;
    __syncthreads();
    const unsigned short* selg = (const unsigned short*)(F.ws + WS_SEL); v2u svq[4];
#pragma unroll
    for (int i = 0; i < 4; ++i) svq[i] = *((const v2u*)(selg + (size_t)(c32 * 32 + F.wave * 4 + i) * 256) + F.lane);
#pragma unroll
    for (int i = 0; i < 4; ++i) dsa_query(F, c32 * 32 + F.wave * 4 + i, svq[i], F.lds + F.wave * 10240, bkt, tab);
}

DI void ph_even_post(const Fr& F, int j) {
    const bf16* ol = (const bf16*)(F.ws + WS_OL); bf16* ao = (bf16*)(F.ws + WS_AO);
    const bf16* wuvt = (const bf16*)(F.ws + WS_WUVT) + (size_t)j * 8 * 64 * 128;
    const bf16* po = (const bf16*)(F.ws + WS_ACT); const float* pml = (const float*)(F.ws + WS_PML); const unsigned* sel3 = (const unsigned*)(F.ws + WS_SEL3);
    const int lane = F.lane, wave = F.wave, l15 = lane & 15, kg = lane >> 4;
    for (int chunk = F.blk; chunk < 256; chunk += F.G) { const int tok0 = chunk * 128;
        { const int h = wave; bf16x8 af[4][4];
#pragma unroll
            for (int mt = 0; mt < 4; ++mt)
#pragma unroll
                for (int ks = 0; ks < 4; ++ks) af[mt][ks] = *(const bf16x8*)(wuvt + ((size_t)h * 64 + mt * 16 + l15) * 128 + ks * 32 + kg * 8);
#pragma unroll 1
            for (int tg = 0; tg < 8; tg += 2) { bf16x8 bf[2][4];
#pragma unroll
                for (int u = 0; u < 2; ++u)
#pragma unroll
                    for (int ks = 0; ks < 4; ++ks) bf[u][ks] = *(const bf16x8*)(ol + (size_t)(tok0 + (tg + u) * 16 + l15) * 1024 + h * 128 + ks * 32 + kg * 8);
#pragma unroll
                for (int u = 0; u < 2; ++u) { const int tok = tok0 + (tg + u) * 16 + l15;
#pragma unroll
                    for (int mt = 0; mt < 4; ++mt) { f32x4 d = {0.f, 0.f, 0.f, 0.f};
#pragma unroll
                        for (int ks = 0; ks < 4; ++ks) d = mfma16(af[mt][ks], bf[u][ks], d);
                        v2u w; w.x = cvtpk(d[0], d[1]); w.y = cvtpk(d[2], d[3]); *(v2u*)(ao + (size_t)tok * 1024 + h * 64 + mt * 16 + 4 * kg) = w; } } } }
#pragma unroll 1
        for (int i0 = 0; i0 < 16; i0 += 4) { const int h = lane >> 3, d0 = (lane & 7) * 8; unsigned nvv[4]; f32x2 mlv[4][4];
#pragma unroll
            for (int i = 0; i < 4; ++i) { const int tok = tok0 + wave * 16 + i0 + i; const size_t pi = ((size_t)tok * 8 + h) * 4; nvv[i] = sel3[(size_t)tok * 8 + h] >> 24;
#pragma unroll
                for (int s = 0; s < 4; ++s) mlv[i][s] = *(const f32x2*)(pml + (pi + s) * 2); }
#pragma unroll
            for (int i = 0; i < 4; ++i) { const int tok = tok0 + wave * 16 + i0 + i; const size_t pi = ((size_t)tok * 8 + h) * 4;
                float mj[4], lj[4];
#pragma unroll
                for (int s = 0; s < 4; ++s) { const bool ok = (s == 3) || ((unsigned)s < nvv[i]); mj[s] = ok ? mlv[i][s][0] : -1e30f; lj[s] = ok ? mlv[i][s][1] : 0.f; }
                const float ms = fmaxf(fmaxf(mj[0], mj[1]), fmaxf(mj[2], mj[3])); float wsum = 0.f, acc[8], wv[4]; v4u pv[4];
#pragma unroll
                for (int k = 0; k < 8; ++k) acc[k] = 0.f;
#pragma unroll
                for (int s = 0; s < 4; ++s) { wv[s] = lj[s] * ex2(mj[s] - ms); wsum += wv[s]; pv[s] = (v4u){0u, 0u, 0u, 0u}; if (wv[s] > 0.f) pv[s] = *(const v4u*)(po + (pi + s) * 64 + d0); }
#pragma unroll
                for (int s = 0; s < 4; ++s) { if (wv[s] > 0.f) {
#pragma unroll
                    for (int k = 0; k < 4; ++k) { acc[2 * k] += wv[s] * bf2f(pv[s][k] & 0xffffu); acc[2 * k + 1] += wv[s] * bf2f(pv[s][k] >> 16); } } }
                const float inv = 1.f / wsum; v4u o; o.x = cvtpk(acc[0] * inv, acc[1] * inv); o.y = cvtpk(acc[2] * inv, acc[3] * inv); o.z = cvtpk(acc[4] * inv, acc[5] * inv); o.w = cvtpk(acc[6] * inv, acc[7] * inv);
                *(v4u*)(ao + (size_t)tok * 1024 + 512 + h * 64 + d0) = o; } }
    }
}
template <class XT> DI f32x4 ld_x4(const XT* p);
template <> DI f32x4 ld_x4<float>(const float* p) { return *(const f32x4*)p; }
template <> DI f32x4 ld_x4<bf16>(const bf16* p) { const v2u w = *(const v2u*)p; return (f32x4){bf2f(w.x & 0xffffu), bf2f(w.x >> 16), bf2f(w.y & 0xffffu), bf2f(w.y >> 16)}; }
template <class XT> DI f32x16 proj32_f32(const float* W, int ldw, int ncols, const XT* xrow, int d_lo, int lane) {
    const int e = lane & 31, kh = lane >> 5; const bool ev = e < ncols;
    f32x16 D;
#pragma unroll
    for (int r = 0; r < 16; ++r) D[r] = 0.f;
    const float* wp = W + (size_t)(d_lo + 4 * kh) * ldw + (ev ? e : 0);
    const XT* xp = xrow + d_lo + 4 * kh;
#pragma unroll 8
    for (int i = 0; i < 64; ++i) { const f32x4 xv = ld_x4<XT>(xp + 8 * i);
        float a0 = wp[(size_t)(8 * i + 0) * ldw], a1 = wp[(size_t)(8 * i + 1) * ldw], a2 = wp[(size_t)(8 * i + 2) * ldw], a3 = wp[(size_t)(8 * i + 3) * ldw];
        if (!ev) { a0 = 0.f; a1 = 0.f; a2 = 0.f; a3 = 0.f; }
        D = __builtin_amdgcn_mfma_f32_32x32x2f32(a0, xv[0], D, 0, 0, 0); D = __builtin_amdgcn_mfma_f32_32x32x2f32(a1, xv[1], D, 0, 0, 0);
        D = __builtin_amdgcn_mfma_f32_32x32x2f32(a2, xv[2], D, 0, 0, 0); D = __builtin_amdgcn_mfma_f32_32x32x2f32(a3, xv[3], D, 0, 0, 0); }
    return D;
}
DI void ph_odd_prep(const Args& a, const Fr& F, int j, int layer) {
    const bf16* proj = (const bf16*)(F.ws + WS_PROJ); const bf16* x = (const bf16*)(F.ws + WS_XB);
    float* logf = (float*)(F.ws + WS_LOGF); float* cs = (float*)(F.ws + WS_CS);
    const float* wf = a.in[6] + (size_t)j * 1024 * 3088 + 3072; const float* bfv = a.in[7] + j * 16;
    LAS float* red = (LAS float*)(F.lds); LAS float* lfb = (LAS float*)(F.lds + 131072);
    LAS unsigned* kmx = (LAS unsigned*)(F.lds + 131072 + 8192);
    const int lane = F.lane, wave = F.wave, tid = F.tid, l31 = lane & 31, hi = lane >> 5;
    for (int chunk = F.blk; chunk < 256; chunk += F.G) { const int tok0 = chunk * 128, b = tok0 / SEQ, t0 = tok0 % SEQ;
        __syncthreads();
        if (tid < 16) kmx[tid] = 0u;
        const int tl = wave & 3, kr = wave >> 2;
        f32x16 D = proj32_f32(wf, 3088, 16, x + (size_t)(tok0 + tl * 32 + l31) * DM, kr * 512, lane);
        if (kr == 1) {
#pragma unroll
            for (int r = 0; r < 8; ++r) red[(tl * 8 + r) * 64 + lane] = D[r]; }
        __syncthreads();
        if (kr == 0) {
#pragma unroll
            for (int r = 0; r < 8; ++r) { const int h = (r & 3) + 8 * (r >> 2) + 4 * hi; const float z = D[r] + red[(tl * 8 + r) * 64 + lane] + bfv[h];
                const float ls = fminf(z, 0.f) - log1pf(__expf(-fabsf(z)));
                lfb[(tl * 32 + l31) * 16 + h] = ls * LOG2E; } }
#pragma unroll 1
        for (int i = 0; i < 4; ++i) { const int p = tid + i * NTHR, tk = p >> 4, h = p & 15; const v4u* kp = (const v4u*)(proj + (size_t)(tok0 + tk) * OD_N + OC_K + h * 64); float s = 0.f;
#pragma unroll
            for (int c = 0; c < 8; ++c) { const v4u w = kp[c];
#pragma unroll
                for (int k = 0; k < 4; ++k) { const float e0 = bf2f(w[k] & 0xffffu), e1 = bf2f(w[k] >> 16); s += e0 * e0 + e1 * e1; } }
            __hip_atomic_fetch_max(kmx + h, __float_as_uint(s), __ATOMIC_RELAXED, __HIP_MEMORY_SCOPE_WORKGROUP); }
        __syncthreads();
        for (int i = tid; i < 2048; i += NTHR) { const int h = i >> 7, tk = i & 127; logf[((size_t)b * 16 + h) * SEQ + t0 + tk] = lfb[tk * 16 + h]; }
        if (tid < 32) { const int h = tid & 15, c = tid >> 4; float s = 0.f;
            for (int k = 0; k < 64; ++k) s += lfb[(c * 64 + k) * 16 + h];
            cs[((size_t)b * 16 + h) * 128 + (t0 >> 6) + c] = s; }
        if (tid < 16) __hip_atomic_fetch_max(F.ctl + CW_KMAX + layer * 64 + b * 16 + tid, kmx[tid], RLX_AGENT);
    }
}

constexpr float FOX_SKIP_LOG2 = 64.f;
struct FoxBias { LAS const float* ng; int tq, kabs0; bool any;
    DI float b(int kvrel) const { return ng[kvrel]; }
    DI bool msk(int kvrel) const { return (kabs0 + kvrel) > tq; } };
DI void fox_unit(const Fr& F, int layer, int b, int h, int qb) {
    const bf16* proj = (const bf16*)(F.ws + WS_PROJ); const float* logf = (const float*)(F.ws + WS_LOGF); const float* cs = (const float*)(F.ws + WS_CS); bf16* ao = (bf16*)(F.ws + WS_AO);
    LAS unsigned char* lds = F.lds; LAS float* ng = (LAS float*)(lds + 32768); LAS float* red = (LAS float*)(lds + 65536 + 1024); LAS int* ibox = (LAS int*)(lds + 65536 + 2048);
    const int tid = F.tid, lane = F.lane, wave = F.wave, r32 = lane & 31, hi = lane >> 5, t0 = qb * 256, rowbase = b * SEQ, tq = t0 + wave * 32 + r32;
    __syncthreads();
    bf16x8 qf[4]; float qs = 0.f;
    { const bf16* qp = proj + (size_t)(rowbase + tq) * OD_N + OC_Q + h * 64 + hi * 8;
#pragma unroll
        for (int s = 0; s < 4; ++s) { qf[s] = *(const bf16x8*)(qp + s * 16);
#pragma unroll
            for (int k = 0; k < 8; ++k) { const float e = bf2f((unsigned short)qf[s][k]); qs += e * e; } } }
    qs += __shfl_xor(qs, 32); qs = wave_max(qs);
    if (lane == 0) red[wave] = qs;
    if (tid < 128) red[32 + tid] = (tid < t0 / 64) ? cs[((size_t)b * 16 + h) * 128 + tid] : 0.f;
    __syncthreads();
    if (tid == 0) { float qm = red[0];
        for (int w = 1; w < 8; ++w) qm = fmaxf(qm, red[w]);
        const float km = __uint_as_float(ld_u32(F.ctl + CW_KMAX + layer * 64 + b * 16 + h));
        const float B2 = 2.f * (sqrtf(qm * km) * 1.01f + 1.f);
        int kt = t0 / 64 - 1, kts = t0 / 64; float D = 0.f;
        while (kt >= 0 && B2 + D >= -FOX_SKIP_LOG2) { kts = kt; D += red[32 + kt]; --kt; }
        ibox[0] = kts; }
    __syncthreads();
    const int kts = ibox[0], s_start = kts * 64, nel = t0 + 256 - s_start;
    { const int i0 = tid * 16; float v[16]; const float* lp = logf + ((size_t)b * 16 + h) * SEQ + s_start + i0;
        if (i0 < nel) {
#pragma unroll
            for (int c = 0; c < 4; ++c) { const f32x4 w = *(const f32x4*)(lp + 4 * c); v[4 * c] = w[0]; v[4 * c + 1] = w[1]; v[4 * c + 2] = w[2]; v[4 * c + 3] = w[3]; } }
        else {
#pragma unroll
            for (int c = 0; c < 16; ++c) v[c] = 0.f; }
#pragma unroll
        for (int c = 1; c < 16; ++c) v[c] += v[c - 1];
        float xsum = v[15];
#pragma unroll
        for (int o = 1; o < 64; o <<= 1) { const float y = __shfl_up(xsum, o); if (lane >= o) xsum += y; }
        if (lane == 63) red[16 + wave] = xsum;
        __syncthreads();
        float off = xsum - v[15];
        for (int w = 0; w < wave; ++w) off += red[16 + w];
        if (i0 < nel) {
#pragma unroll
            for (int c = 0; c < 4; ++c) { f32x4 w = {-(off + v[4 * c]), -(off + v[4 * c + 1]), -(off + v[4 * c + 2]), -(off + v[4 * c + 3])}; *(LAS f32x4*)(ng + i0 + 4 * c) = w; } }
    }
    const int ntile = t0 / 64 + 4 - kts;
    const bf16* kg = proj + (size_t)rowbase * OD_N + OC_K + h * 64; const bf16* vg = proj + (size_t)rowbase * OD_N + OC_V + h * 64;
    const int kr = tid & 31, kc = (tid >> 5) & 7, kst = tid >> 8, vcc = tid & 3, vrow = (tid >> 2) & 63, vdh = tid >> 8;
    const int koff = kst * 4096 + kc * 512 + kr * 16, voff = 8192 + vdh * 4096 + vrow * 64 + vcc * 16;
    { const v4u kv = *(const v4u*)(kg + (size_t)(kts * 64 + kst * 32 + kr) * OD_N + kc * 8), vv = *(const v4u*)(vg + (size_t)(kts * 64 + vrow) * OD_N + vdh * 32 + vcc * 8);
        *(LAS v4u*)(lds + koff) = kv; *(LAS v4u*)(lds + voff) = vv; }
    __syncthreads();
    AttSt S; S.m = 0.f; S.l = 0.f;
#pragma unroll
    for (int r = 0; r < 16; ++r) { S.o0[r] = 0.f; S.o1[r] = 0.f; }
    const int wlast = t0 + wave * 32 + 31, wfirst = t0 + wave * 32;
    for (int i = 0; i < ntile; ++i) { const int kt = kts + i; LAS unsigned char* buf = lds + (i & 1) * 16384; LAS unsigned char* nbuf = lds + ((i + 1) & 1) * 16384;
        v4u kv, vv; const bool more = i + 1 < ntile;
        if (more) { kv = *(const v4u*)(kg + (size_t)((kt + 1) * 64 + kst * 32 + kr) * OD_N + kc * 8); vv = *(const v4u*)(vg + (size_t)((kt + 1) * 64 + vrow) * OD_N + vdh * 32 + vcc * 8); }
        { const int kv0 = kt * 64;
            if (kv0 + 32 <= wlast) { FoxBias bf0{ng + (kv0 - s_start), tq, kv0, kv0 + 31 > wfirst}, bf1{ng + (kv0 + 32 - s_start), tq, kv0 + 32, kv0 + 63 > wfirst};
                att_tile64(S, qf, (LAS const char*)buf, (LAS const char*)buf + 8192, 4096, 0, lane, bf0, bf1); }
            else if (kv0 <= wlast) { FoxBias bf{ng + (kv0 - s_start), tq, kv0, kv0 + 31 > wfirst};
                att_subtile(S, qf, (LAS const char*)buf, (LAS const char*)buf + 8192, 4096, 0, lane, bf); } }
        if (more) { *(LAS v4u*)(nbuf + koff) = kv; *(LAS v4u*)(nbuf + voff - 8192 + 8192) = vv; }
        __syncthreads(); }
    const float lt = S.l + __shfl_xor(S.l, 32), inv = 1.f / lt;
    bf16* o = ao + (size_t)(rowbase + tq) * 1024 + h * 64;
#pragma unroll
    for (int a4 = 0; a4 < 4; ++a4) { v2u w0, w1;
        w0.x = cvtpk(S.o0[4 * a4] * inv, S.o0[4 * a4 + 1] * inv); w0.y = cvtpk(S.o0[4 * a4 + 2] * inv, S.o0[4 * a4 + 3] * inv);
        w1.x = cvtpk(S.o1[4 * a4] * inv, S.o1[4 * a4 + 1] * inv); w1.y = cvtpk(S.o1[4 * a4 + 2] * inv, S.o1[4 * a4 + 3] * inv);
        *(v2u*)(o + 8 * a4 + 4 * hi) = w0; *(v2u*)(o + 32 + 8 * a4 + 4 * hi) = w1; }
}

DI void ph_ln1_router(const Args& a, const Fr& F, int layer) {
    const bf16* yp = (const bf16*)(F.ws + WS_YP); bf16* x1 = (bf16*)(F.ws + WS_X1); unsigned char* xb8 = F.ws + WS_XB8;
    unsigned* tope = (unsigned*)(F.ws + WS_TOPE); float* gate = (float*)(F.ws + WS_GATE); unsigned* rank = (unsigned*)(F.ws + WS_RANK);
    const float* g = a.in[10] + (size_t)(layer * 2) * DM; const float* bb = a.in[11] + (size_t)(layer * 2) * DM;
    const float* rw = a.in[12] + (size_t)layer * 1024 * 32; const float* rb = a.in[13] + layer * 32;
    LAS float* red = (LAS float*)(F.lds); LAS unsigned* lcnt = (LAS unsigned*)(F.lds + 131072);
    const int lane = F.lane, wave = F.wave, tid = F.tid, l31 = lane & 31, hi = lane >> 5;
    for (int chunk = F.blk; chunk < 256; chunk += F.G) { const int tok0 = chunk * 128;
        __syncthreads();
        if (tid < 32) lcnt[tid] = 0u;
#pragma unroll 1
        for (int k = 0; k < 16; k += 8) { f32x4 v[8][4];
#pragma unroll
            for (int i = 0; i < 8; ++i)
#pragma unroll
                for (int jj = 0; jj < 4; ++jj) { const v2u w = *((const v2u*)(yp + (size_t)(tok0 + wave * 16 + k + i) * DM) + lane + 64 * jj);
                    v[i][jj] = (f32x4){bf2f(w.x & 0xffffu), bf2f(w.x >> 16), bf2f(w.y & 0xffffu), bf2f(w.y >> 16)}; }
#pragma unroll
            for (int i = 0; i < 8; ++i) { const int tok = tok0 + wave * 16 + k + i;
                ln_row(v[i], g, bb, lane);
                store_row_bf16(x1 + (size_t)tok * DM, v[i], lane);
#pragma unroll
                for (int jj = 0; jj < 4; ++jj) *((unsigned*)(xb8 + (size_t)tok * DM) + lane + 64 * jj) = pk4_fp8(v[i][jj][0] * F8_SX, v[i][jj][1] * F8_SX, v[i][jj][2] * F8_SX, v[i][jj][3] * F8_SX); } }
        asm volatile("s_waitcnt vmcnt(0)" ::: "memory");
        __syncthreads();
        const int tl = wave & 3, kr = wave >> 2, tokl = tok0 + tl * 32 + l31;
        f32x16 D = proj32_f32(rw, 32, 32, x1 + (size_t)tokl * DM, kr * 512, lane);
        if (kr == 1) {
#pragma unroll
            for (int r = 0; r < 16; ++r) red[(tl * 16 + r) * 64 + lane] = D[r]; }
        __syncthreads();
        if (kr == 0) {
            float lv[32];
#pragma unroll
            for (int r = 0; r < 16; ++r) { const float own = D[r] + red[(tl * 16 + r) * 64 + lane] + rb[crow(r, hi)]; const float oth = __shfl_xor(own, 32);
                lv[crow(r, 0)] = hi == 0 ? own : oth; lv[crow(r, 1)] = hi == 0 ? oth : own; }
            float tv[4]; int te[4];
#pragma unroll
            for (int r = 0; r < 4; ++r) { float mx = -INFINITY; int me = 0;
#pragma unroll
                for (int e = 0; e < 32; ++e) { if (lv[e] > mx) { mx = lv[e]; me = e; } }
                tv[r] = mx; te[r] = me;
#pragma unroll
                for (int e = 0; e < 32; ++e) { if (e == me) lv[e] = -INFINITY; } }
            const float e1 = __expf(tv[1] - tv[0]), e2 = __expf(tv[2] - tv[0]), e3 = __expf(tv[3] - tv[0]); const float inv = 1.f / (1.f + e1 + e2 + e3);
            if (hi == 0) { const size_t o = (size_t)tokl * 4;
                const float gv[4] = {inv, e1 * inv, e2 * inv, e3 * inv};
#pragma unroll
                for (int r = 0; r < 4; ++r) { const unsigned rk = __hip_atomic_fetch_add(lcnt + (te[r] & 31), 1u, __ATOMIC_RELAXED, __HIP_MEMORY_SCOPE_WORKGROUP);
                    tope[o + r] = (unsigned)(te[r] & 31); gate[o + r] = gv[r]; rank[o + r] = rk; } } }
        __syncthreads();
        if (tid < 32) __hip_atomic_store(F.ctl + CW_CNT + chunk * 32 + tid, lcnt[tid], RLX_AGENT);
    }
}

DI void ph_route(const Fr& F) {
    unsigned short* srcg = (unsigned short*)(F.ws + WS_SRC);
    const unsigned* tope = (const unsigned*)(F.ws + WS_TOPE); const unsigned* rank = (const unsigned*)(F.ws + WS_RANK); unsigned* dest = (unsigned*)(F.ws + WS_DEST);
    LAS unsigned* P = (LAS unsigned*)(F.lds); LAS unsigned* pst = P + 512; LAS unsigned* pad = P + 544; LAS unsigned* base = P + 576; LAS unsigned* nt = P + 608; LAS unsigned* totl = P + 640;
    const int tid = F.tid;
    __syncthreads();
    { const int e = tid & 31, part = tid >> 5; unsigned s = 0u;
        for (int c = 0; c < 16; ++c) s += ld_u32(F.ctl + CW_CNT + (part * 16 + c) * 32 + e);
        P[part * 32 + e] = s; }
    __syncthreads();
    if (tid < 32) { unsigned tot = 0u;
        for (int p = 0; p < 16; ++p) tot += P[p * 32 + tid];
        totl[tid] = tot; pad[tid] = (tot + 255u) & ~255u; }
    __syncthreads();
    if (tid == 0) { unsigned acc = 0u;
        for (int e = 0; e < 32; ++e) { pst[e] = acc; acc += pad[e]; }
        nt[0] = acc >> 8; }
    __syncthreads();
    if (F.blk < 32) { const int e = F.blk;
        for (unsigned i = totl[e] + tid; i < pad[e]; i += NTHR) srcg[pst[e] + i] = (unsigned short)0; }
    for (int chunk = F.blk; chunk < 256; chunk += F.G) {
        __syncthreads();
        if (tid < 32) { unsigned off = 0u; const int pf = chunk >> 4;
            for (int p = 0; p < pf; ++p) off += P[p * 32 + tid];
            for (int c = pf * 16; c < chunk; ++c) off += ld_u32(F.ctl + CW_CNT + c * 32 + tid);
            base[tid] = pst[tid] + off; }
        __syncthreads();
        { const size_t pi = (size_t)chunk * 512 + tid;
            const unsigned d = base[tope[pi] & 31u] + rank[pi];
            dest[pi] = d; srcg[d] = (unsigned short)(pi >> 2); }
        if (chunk == 0) { const unsigned ntl = nt[0];
            if (tid == 0) __hip_atomic_store(F.ctl + CW_TILE, ntl, RLX_AGENT);
            for (unsigned i = tid; i < ntl; i += NTHR) { unsigned e = 0u;
                for (unsigned k = 1; k < 32; ++k) if (pst[k] <= i * 256u) e = k;
                __hip_atomic_store(F.ctl + CW_TILE + 64 + i, e, RLX_AGENT); } }
    }
}

DI void ph_combine_ln2(const Args& a, const Fr& F, int layer) {
    const bf16* x1 = (const bf16*)(F.ws + WS_X1); const unsigned char* yr = F.ws + WS_XG; bf16* xb = (bf16*)(F.ws + WS_XB);
    const float* gate = (const float*)(F.ws + WS_GATE); const unsigned* dest = (const unsigned*)(F.ws + WS_DEST);
    const float* g = a.in[10] + (size_t)(layer * 2 + 1) * DM; const float* bb = a.in[11] + (size_t)(layer * 2 + 1) * DM;
    const int lane = F.lane; const int gw = F.blk * NWAVES + F.wave, NGW = F.G * NWAVES;
    for (int tok = gw; tok < NTOK; tok += 4 * NGW) { f32x4 v[4][4];
#pragma unroll
        for (int i = 0; i < 4; ++i) { const int tk = tok + i * NGW; if (tk < NTOK) {
#pragma unroll
            for (int jj = 0; jj < 4; ++jj) { const v2u w = *((const v2u*)(x1 + (size_t)tk * DM) + lane + 64 * jj);
                v[i][jj] = (f32x4){bf2f(w.x & 0xffffu), bf2f(w.x >> 16), bf2f(w.y & 0xffffu), bf2f(w.y >> 16)} * ALPHA; }
#pragma unroll
            for (int k = 0; k < 4; ++k) { const float gk = gate[(size_t)tk * 4 + k] * (1.f / F8_SY); const unsigned d = dest[(size_t)tk * 4 + k];
#pragma unroll
                for (int jj = 0; jj < 4; ++jj) { const int w = (int)*((const unsigned*)(yr + (size_t)d * DM) + lane + 64 * jj);
                    const f32x2 lo = __builtin_amdgcn_cvt_pk_f32_fp8(w, false), hi2 = __builtin_amdgcn_cvt_pk_f32_fp8(w, true);
                    v[i][jj][0] += gk * lo[0]; v[i][jj][1] += gk * lo[1]; v[i][jj][2] += gk * hi2[0]; v[i][jj][3] += gk * hi2[1]; } } } }
#pragma unroll
        for (int i = 0; i < 4; ++i) { const int tk = tok + i * NGW; if (tk < NTOK) {
            ln_row(v[i], g, bb, lane);
            if (layer == DEPTH - 1) store_row_f32(a.out + (size_t)tk * DM, v[i], lane);
            else store_row_bf16(xb + (size_t)tk * DM, v[i], lane); } } }
}
constexpr int LDS_BYTES = 147456;
constexpr int LDS_BARW = 145408, LDS_QSLOT = 145472, LDS_TILE_E = 133632, LDS_SRCL = 136192;
constexpr int NPL = 11;
constexpr int NPHASE = 1 + NPL * DEPTH;
#ifndef MK_SINGLE
#define MK_SINGLE 1
#endif
DI int q_next(const Fr& F, unsigned* ctr) {
    LAS int* slot = (LAS int*)(F.lds + LDS_QSLOT);
    __syncthreads();
    if (F.tid == 0) *slot = (int)__hip_atomic_fetch_add(ctr, 1u, RLX_AGENT);
    __syncthreads();
    return *slot;
}
DI int lane_id_fresh() { unsigned m_ = ~0u; asm volatile("" : "+s"(m_)); return (int)__builtin_amdgcn_mbcnt_hi(m_, __builtin_amdgcn_mbcnt_lo(m_, 0u)); }
#define RETID(F) do { int t2_ = F.tid; asm volatile("" : "+v"(t2_)); F.tid = t2_; F.lane = t2_ & 63; F.wave = __builtin_amdgcn_readfirstlane(t2_ >> 6); } while (0)
#ifndef PROBE_DUP
#define PROBE_DUP -1
#endif
#define NREP(q) ((PROBE_DUP == (q)) ? 2 : 1)
#define AS4 __attribute__((address_space(4)))
#define SITE() Args a; Fr F; { const AS4 Args* ap = (const AS4 Args*)__builtin_amdgcn_kernarg_segment_ptr(); asm volatile("" : "+s"(ap)); \
        _Pragma("unroll") for (int i_ = 0; i_ < 18; ++i_) a.in[i_] = ap->in[i_]; a.out = ap->out; a.ws = ap->ws; a.ph_lo = 0; a.ph_hi = 0; \
        int w_ = wv_s; asm volatile("" : "+s"(w_)); int t_ = w_ * 64 + lane_id_fresh(); asm volatile("" : "+v"(t_)); F.tid = t_; F.lane = t_ & 63; F.wave = __builtin_amdgcn_readfirstlane(t_ >> 6); \
        F.lds = (LAS unsigned char*)lds_raw; F.ws = a.ws; F.ctl = (unsigned*)(a.ws + WS_CTL); F.blk = blockIdx.x; F.G = gridDim.x; }
__global__ void __launch_bounds__(NTHR, 2) mega_fwd(Args a0) {
    extern __shared__ __attribute__((aligned(16))) unsigned char lds_raw[];
    const int wv_s = __builtin_amdgcn_readfirstlane((int)(threadIdx.x >> 6));
#if MK_SINGLE
    constexpr int lo = 0, hi = NPHASE; constexpr bool single = true;
#else
    const int lo = a0.ph_lo, hi = a0.ph_hi; constexpr bool single = false;
#endif
    if (threadIdx.x == 0) *(LAS v4u*)((LAS unsigned char*)lds_raw + LDS_BARW) = (v4u){0u, 0u, 0u, 0u};
    __syncthreads();
    if (single) (void)xcd_barrier_post((unsigned*)(a0.ws + WS_CTL) + CW_BAR, (volatile LAS unsigned*)((LAS unsigned char*)lds_raw + LDS_BARW));
#define IN(k) (lo <= (k) && (k) < hi)
#define SEAM() do { if (single) { const AS4 Args* ap_ = (const AS4 Args*)__builtin_amdgcn_kernarg_segment_ptr(); asm volatile("" : "+s"(ap_)); int w_ = wv_s; asm volatile("" : "+s"(w_)); \
        XcdBarrier b_; b_.bar = (unsigned*)(ap_->ws + WS_CTL) + CW_BAR; b_.x = xb_xcc_id(); b_.st = (volatile LAS unsigned*)((LAS unsigned char*)lds_raw + LDS_BARW); \
        xcd_barrier(b_, (w_ == 0) && (lane_id_fresh() == 0)); } } while (0)
    if (IN(0)) { _Pragma("unroll 1") for (int rep = 0; rep < NREP(100); ++rep) { { SITE(); ph_prologue(a, F); } SEAM(); } }
#pragma clang loop unroll(full)
    for (int L = 0; L < DEPTH; ++L) {
        const int pb = 1 + NPL * L, j = L >> 1; const bool odd = (L & 1) != 0;
        if (IN(pb + 0)) _Pragma("unroll 1") for (int rep = 0; rep < NREP(0); ++rep) {
            { SITE();
            const bf16* w = odd ? (const bf16*)(F.ws + WS_WOD) + (size_t)j * OD_N * 1024 : (const bf16*)(F.ws + WS_WEV) + (size_t)j * EV_N * 1024;
            const int N = odd ? OD_N : EV_N;
            pg8::Gemm g{(const bf16*)(F.ws + WS_XB), w, NTOK, N, 1024}; pg8::StaticOrder S; S.init(NTOK, N, F.G, F.blk);
            pg8::EpiBf16<0> E{(bf16*)(F.ws + WS_PROJ), N, nullptr, 1024, (size_t)1024, C2F};
            pg8::gemm_phase<pg8::EpiBf16<0>, pg8::StaticOrder, true, true>(F.lds, g, S, E, F.tid); }
            SEAM(); }
        if (IN(pb + 1)) _Pragma("unroll 1") for (int rep = 0; rep < NREP(1); ++rep) { { SITE(); if (odd) ph_odd_prep(a, F, j, L); else ph_even_prep(a, F, j); } SEAM(); }
        if (!odd && IN(pb + 2)) _Pragma("unroll 1") for (int rep = 0; rep < ((PROBE_DUP == 2 || (PROBE_DUP >= 21 && PROBE_DUP <= 22) || (PROBE_DUP >= 211 && PROBE_DUP <= 217)) ? 2 : 1); ++rep) {
            { SITE(); unsigned* ctr = F.ctl + CW_Q + 64 * (L * 2) + 1024 * rep;
            for (;;) { const int it = q_next(F, ctr); if (it >= 1280) break; RETID(F);
                if (it < 1024) { if (!(rep == 1 && PROBE_DUP == 22)) idx_unit(F, it & 3, 255 - (it >> 2), (rep == 1 && PROBE_DUP >= 211) ? PROBE_DUP - 210 : 0); } else { if (!(rep == 1 && (PROBE_DUP == 21 || PROBE_DUP >= 211))) moba_gate_chunk(F, it - 1024); } } }
            SEAM(); }
        if (IN(pb + 3)) _Pragma("unroll 1") for (int rep = 0; rep < ((PROBE_DUP == 3 || (PROBE_DUP == 31 && odd) || ((PROBE_DUP == 32 || PROBE_DUP == 33) && !odd)) ? 2 : 1); ++rep) {
            { SITE(); unsigned* ctr = F.ctl + CW_Q + 64 * (L * 2 + 1) + 1024 * rep;
            if (odd) { for (;;) { const int it = q_next(F, ctr); if (it >= 2048) break; RETID(F); const int bh = it & 63; fox_unit(F, L, bh >> 4, bh & 15, 31 - (it >> 6)); } }
            else { for (;;) { const int it = q_next(F, ctr); if (it >= 2048) break; RETID(F);
                    if (it < 1024) { const int bh = it & 31; if (!(rep == 1 && PROBE_DUP == 33)) moba_unit(a, F, bh >> 3, bh & 7, it >> 5); } else { if (!(rep == 1 && PROBE_DUP == 32)) dsa_chunk(a, F, it - 1024); } } } }
            SEAM(); }
        if (!odd && IN(pb + 4)) _Pragma("unroll 1") for (int rep = 0; rep < NREP(4); ++rep) { { SITE(); ph_even_post(F, j); } SEAM(); }
        if (IN(pb + 5)) _Pragma("unroll 1") for (int rep = 0; rep < NREP(5); ++rep) {
            { SITE();
            pg8::Gemm g{(const bf16*)(F.ws + WS_AO), (const bf16*)(F.ws + WS_WOUT) + (size_t)L * 1024 * 1024, NTOK, 1024, 1024}; pg8::StaticOrder S; S.init(NTOK, 1024, F.G, F.blk);
            EpiResBf16 E{(const bf16*)(F.ws + WS_XB), (bf16*)(F.ws + WS_YP), ALPHA};
            pg8::gemm_phase<EpiResBf16, pg8::StaticOrder, true, true>(F.lds, g, S, E, F.tid); }
            SEAM(); }
        if (IN(pb + 6)) _Pragma("unroll 1") for (int rep = 0; rep < NREP(6); ++rep) { { SITE(); ph_ln1_router(a, F, L); } SEAM(); }
        if (IN(pb + 7)) _Pragma("unroll 1") for (int rep = 0; rep < NREP(7); ++rep) { { SITE(); ph_route(F); } SEAM(); }
        if (IN(pb + 8)) _Pragma("unroll 1") for (int rep = 0; rep < NREP(8); ++rep) {
            { SITE(); const int ntl = (int)ld_u32(F.ctl + CW_TILE);
            LAS unsigned* tle = (LAS unsigned*)(F.lds + LDS_TILE_E);
            for (int i = F.tid; i < ntl; i += NTHR) tle[i] = ld_u32(F.ctl + CW_TILE + 64 + i);
            LAS unsigned* srcl = (LAS unsigned*)(F.lds + LDS_SRCL); const unsigned* srcg = (const unsigned*)(F.ws + WS_SRC);
            for (int i = F.tid; i < 17 * 128; i += NTHR) { const int pm = (i >> 7) * 32 + (F.blk & 7) * 4 + (F.blk >> 6); if (pm < ntl) srcl[i] = srcg[(size_t)pm * 128 + (i & 127)]; }
            __syncthreads();
            pg8::Gemm g{(const bf16*)(F.ws + WS_XB8), (const bf16*)(F.ws + WS_WGU + (size_t)L * 32 * 2048 * 1024), NR_MAX, 32 * 2048, 512};
            GroupOrder S{tle, ntl, 3, F.G, F.blk, (LAS const unsigned short*)srcl};
            EpiSwiglu E{F.ws + WS_ACT, a.in[15] + (size_t)L * 32 * 2048};
            pg8::gemm_phase<EpiSwiglu, GroupOrder, true, true, true, true>(F.lds, g, S, E, F.tid); }
            SEAM(); }
        if (IN(pb + 9)) _Pragma("unroll 1") for (int rep = 0; rep < NREP(9); ++rep) {
            { SITE(); const int ntl = (int)ld_u32(F.ctl + CW_TILE);
            LAS unsigned* tle = (LAS unsigned*)(F.lds + LDS_TILE_E);
            for (int i = F.tid; i < ntl; i += NTHR) tle[i] = ld_u32(F.ctl + CW_TILE + 64 + i);
            __syncthreads();
            pg8::Gemm g{(const bf16*)(F.ws + WS_ACT), (const bf16*)(F.ws + WS_WDN + (size_t)L * 32 * 1024 * 1024), NR_MAX, 32 * 1024, 512};
            GroupOrder S{tle, ntl, 2, F.G, F.blk, (LAS const unsigned short*)nullptr};
            EpiDown E{F.ws + WS_XG, a.in[17] + (size_t)L * 32 * 1024};
            pg8::gemm_phase<EpiDown, GroupOrder, true, true, true>(F.lds, g, S, E, F.tid); }
            SEAM(); }
        if (IN(pb + 10)) _Pragma("unroll 1") for (int rep = 0; rep < NREP(10); ++rep) { { SITE(); ph_combine_ln2(a, F, L); } if (L + 1 < DEPTH || rep + 1 < NREP(10)) SEAM(); }
        if (PROBE_DUP == 900 && L + 1 < DEPTH) { _Pragma("unroll 1") for (int xb = 0; xb < 10; ++xb) SEAM(); }
    }
#undef IN
#undef SEAM
}

extern "C" void kernel_launch(void* const* d_in, const int* in_sizes, int n_in, void* d_out, int out_size, void* d_ws, size_t ws_size, hipStream_t stream) {
    static int grid = 0;
    if (grid == 0) {
        if (n_in != 18 || out_size != NTOK * DM || ws_size < WS_END) { fprintf(stderr, "kernel_launch: unexpected shapes (n_in %d, out %d, ws %zu); nothing launched\n", n_in, out_size, ws_size); grid = -1; return; }
        int dev = 0, cus = 0, per_cu = 0;
        if (hipGetDevice(&dev) != hipSuccess || hipDeviceGetAttribute(&cus, hipDeviceAttributeMultiprocessorCount, dev) != hipSuccess) { grid = -1; return; }
        if (hipFuncSetAttribute((const void*)mega_fwd, hipFuncAttributeMaxDynamicSharedMemorySize, LDS_BYTES) != hipSuccess) { fprintf(stderr, "kernel_launch: hipFuncSetAttribute failed\n"); grid = -1; return; }
        if (hipOccupancyMaxActiveBlocksPerMultiprocessor(&per_cu, (const void*)mega_fwd, NTHR, LDS_BYTES) != hipSuccess || per_cu < 1) fprintf(stderr, "kernel_launch: occupancy query reports %d\n", per_cu);
        (void)hipGetLastError();
        if (cus < 256) { fprintf(stderr, "kernel_launch: %d CUs (the gathered gate/up GEMM's unit order assumes the MI355X's 256); nothing launched\n", cus); grid = -1; return; }
        grid = 256;
    }
    if (grid < 0) return;
    (void)hipMemsetAsync((char*)d_ws + WS_CTL, 0, CTL_ZERO_BYTES, stream);
#ifdef EXP_SKIP
    (void)hipMemsetAsync((char*)d_ws + WS_AO, 0, 64 * MiB, stream);
    (void)hipMemsetAsync((char*)d_ws + WS_OL, 0, 64 * MiB, stream);
    if (EXP_SKIP & 4) { (void)hipMemsetAsync((char*)d_ws + WS_XG, 0, 272 * MiB, stream); (void)hipMemsetAsync((char*)d_ws + WS_DEST, 0, 1 * MiB, stream); }
#endif
    Args a{};
    for (int i = 0; i < 18; ++i) a.in[i] = (const float*)d_in[i];
    a.out = (float*)d_out; a.ws = (unsigned char*)d_ws;
#if MK_SINGLE
    a.ph_lo = 0; a.ph_hi = NPHASE;
    hipLaunchKernelGGL(mega_fwd, dim3(grid), dim3(NTHR), LDS_BYTES, stream, a);
#else
    for (int p = 0; p < NPHASE; ++p) {
        if (p > 0) { const int L = (p - 1) / NPL, q = (p - 1) % NPL; if ((L & 1) && (q == 2 || q == 4)) continue;
#ifdef EXP_SKIP
            if ((EXP_SKIP & 1) && !(L & 1) && q <= 4) continue;
            if ((EXP_SKIP & 2) && (L & 1) && q <= 4) continue;
            if ((EXP_SKIP & 4) && q >= 7 && q <= 9) continue;
#endif
        }
        a.ph_lo = p; a.ph_hi = p + 1;
        hipLaunchKernelGGL(mega_fwd, dim3(grid), dim3(NTHR), LDS_BYTES, stream, a);
    }
#endif
}
```

```cpp
#include <hip/hip_runtime.h>
#include <cstdio>
#include <cstdint>
#ifdef EXP_SKIP
#define EXPF EXP_SKIP
#else
#define EXPF 0
#endif
constexpr int NB = 4, SEQ = 8192, DM = 1024, NTOK = NB * SEQ, DEPTH = 4;
constexpr int EV_N = 2560, OD_N = 3072;
constexpr int EC_QA = 0, EC_QB = 512, EC_KB = 1024, EC_VB = 1536, EC_CKV = 2048, EC_QI = 2176, EC_KI = 2432, EC_WI = 2496;
constexpr int OC_Q = 0, OC_K = 1024, OC_V = 2048;
constexpr float LOG2E = 1.4426950408889634f;
constexpr float C2F = 0.125f * LOG2E;
constexpr float ALPHA = 1.681792830507429f;
constexpr float LN_EPS = 1e-5f;
constexpr int NR_MAX = 131072 + 32 * 256;
constexpr int NWAVES = 8, NTHR = 512;
constexpr size_t MiB = (size_t)1 << 20;
constexpr size_t WS_CTL = 0, CTL_ZERO_BYTES = 4 * MiB;
constexpr size_t WS_WEV = 8 * MiB, WS_WOD = 18 * MiB, WS_WOUT = 30 * MiB, WS_WUKT = 38 * MiB, WS_WUVT = 39 * MiB;
constexpr size_t WS_WGU = 40 * MiB, WS_WDN = 552 * MiB;
constexpr size_t WS_X = 808 * MiB, WS_X1 = 936 * MiB, WS_YP = 1064 * MiB, WS_XB = 1192 * MiB;
constexpr size_t WS_PROJ = 1256 * MiB, WS_AO = 1448 * MiB, WS_XG = 1512 * MiB, WS_ACT = 1784 * MiB;
constexpr size_t WS_QL = 2056 * MiB, WS_OL = 2120 * MiB, WS_CKVN = 2184 * MiB, WS_SEL = 2192 * MiB;
constexpr size_t WS_KBAR = 2208 * MiB, WS_SEL3 = 2209 * MiB, WS_LOGF = 2210 * MiB, WS_CS = 2212 * MiB;
constexpr size_t WS_TOPE = 2213 * MiB, WS_GATE = 2214 * MiB, WS_RANK = 2215 * MiB, WS_DEST = 2216 * MiB, WS_PML = 2217 * MiB;
constexpr size_t WS_SRC = WS_DEST + 512 * 1024;
constexpr size_t WS_XB8 = 2226 * MiB;
constexpr size_t WS_KIC = 2258 * MiB;
constexpr size_t WS_END = 2262 * MiB;
constexpr float F8_SX = 16.f, F8_SWG = 256.f, F8_SA = 4.f, F8_SWD = 512.f, F8_SY = 32.f;
constexpr int CW_BAR = 4096, CW_Q = 8192, CW_KMAX = 12288, CW_CNT = 16384, CW_TILE = 32768;

#define GAS __attribute__((address_space(1)))
#define LAS __attribute__((address_space(3)))
#define DI __device__ __forceinline__
typedef unsigned short bf16;
typedef unsigned v4u __attribute__((ext_vector_type(4)));
typedef unsigned v2u __attribute__((ext_vector_type(2)));
typedef float f32x4 __attribute__((ext_vector_type(4)));
typedef float f32x2 __attribute__((ext_vector_type(2)));
typedef float f32x16 __attribute__((ext_vector_type(16)));
typedef short bf16x8 __attribute__((ext_vector_type(8)));
typedef short s16x4 __attribute__((ext_vector_type(4)));
typedef __bf16 bf16x2_t __attribute__((ext_vector_type(2)));
typedef GAS unsigned gu32;
#define RLX_AGENT __ATOMIC_RELAXED, __HIP_MEMORY_SCOPE_AGENT
#define LDS_WAIT() asm volatile("s_waitcnt lgkmcnt(0)" ::: "memory")

DI float bf2f(unsigned v) { return __uint_as_float(v << 16); }
DI unsigned cvtpk(float lo, float hi) { f32x2 v = {lo, hi}; bf16x2_t b = __builtin_convertvector(v, bf16x2_t); return __builtin_bit_cast(unsigned, b); }
DI unsigned f2bf(float f) { return cvtpk(f, 0.f) & 0xffffu; }
DI unsigned pk4_fp8(float a, float b, float c, float d) {
    a = fminf(fmaxf(a, -448.f), 448.f); b = fminf(fmaxf(b, -448.f), 448.f); c = fminf(fmaxf(c, -448.f), 448.f); d = fminf(fmaxf(d, -448.f), 448.f);
    int w = 0; w = __builtin_amdgcn_cvt_pk_fp8_f32(a, b, w, false); w = __builtin_amdgcn_cvt_pk_fp8_f32(c, d, w, true); return (unsigned)w; }
DI float ex2(float x) { return __builtin_amdgcn_exp2f(x); }
DI float wave_sum(float v) {
#pragma unroll
    for (int o = 1; o < 64; o <<= 1) v += __shfl_xor(v, o);
    return v;
}
DI float wave_max(float v) {
#pragma unroll
    for (int o = 1; o < 64; o <<= 1) v = fmaxf(v, __shfl_xor(v, o));
    return v;
}
DI unsigned ld_u32(const unsigned* p) { return __hip_atomic_load(p, RLX_AGENT); }
DI int crow(int r, int hi) { return (r & 3) + 8 * (r >> 2) + 4 * hi; }
DI f32x16 mfma32(bf16x8 a, bf16x8 b, f32x16 c) { return __builtin_amdgcn_mfma_f32_32x32x16_bf16(a, b, c, 0, 0, 0); }
DI f32x4 mfma16(bf16x8 a, bf16x8 b, f32x4 c) { return __builtin_amdgcn_mfma_f32_16x16x32_bf16(a, b, c, 0, 0, 0); }
typedef short v4i16_t __attribute__((ext_vector_type(4)));
DI s16x4 vtr(LAS const char* p) { return __builtin_bit_cast(s16x4, __builtin_amdgcn_ds_read_tr16_b64_v4i16((LAS v4i16_t*)p)); }
DI bf16x8 cat8(s16x4 a, s16x4 b) { return (bf16x8){a[0], a[1], a[2], a[3], b[0], b[1], b[2], b[3]}; }
DI int t5_bucket(int n) {
    if (n < 16) return n;
    int bkt = 16;
    bkt += (n >= 21); bkt += (n >= 27); bkt += (n >= 35); bkt += (n >= 46); bkt += (n >= 59); bkt += (n >= 77); bkt += (n >= 99); bkt += (n >= 128);
    bkt += (n >= 166); bkt += (n >= 216); bkt += (n >= 280); bkt += (n >= 363); bkt += (n >= 470); bkt += (n >= 609); bkt += (n >= 790);
    return bkt;
}
namespace pg8 {
#define PG8_LAS __attribute__((address_space(3)))
typedef unsigned short bf16_t;
typedef short bf16x8 __attribute__((ext_vector_type(8)));
typedef float f32x4 __attribute__((ext_vector_type(4)));
typedef unsigned u32x4 __attribute__((ext_vector_type(4)));
constexpr int BM = 256, BK = 64, HALF = 128, HTB = HALF * BK * 2  , STAGE_BYTES = 8 * HTB, NXCD = 8, WGM = 8;

__host__ __device__ __forceinline__ int lds_byte(int r, int c) { const int st = (r >> 4) * 2 + (c >> 5), rr = r & 15, cc = c & 31, ob = rr * 64 + cc * 2; return st * 1024 + (ob ^ (((ob >> 9) & 1) << 5)); }
__host__ __device__ __forceinline__ void stage_rc(int b, int& R, int& C) { const int st = b / 1024, sb = b % 1024, swz = sb ^ (((sb >> 9) & 1) << 5); R = (st >> 1) * 16 + swz / 64; C = (st & 1) * 32 + (swz % 64) / 2; }
__host__ __device__ __forceinline__ int perm32(int rho) { const int n = rho >> 4, i = rho & 15; return 8 * (i >> 2) + 4 * n + (i & 3); }

typedef int i32x8 __attribute__((ext_vector_type(8))); typedef int i32x4v __attribute__((ext_vector_type(4)));
__device__ __forceinline__ i32x8 pg8_cat8(bf16x8 lo, bf16x8 hi) { const i32x4v a = __builtin_bit_cast(i32x4v, lo), b = __builtin_bit_cast(i32x4v, hi); return (i32x8){a[0], a[1], a[2], a[3], b[0], b[1], b[2], b[3]}; }
struct Unit { int pm, pn; };
struct Gemm { const bf16_t* A; const bf16_t* Bt; int M, N, K; };

struct StaticOrder {
    int nM, nN, nwg, G, c;
    __host__ __device__ void init(int M, int N, int G_, int c_) { nM = M / BM; nN = N / BM; nwg = nM * nN; G = G_; c = c_; }
    __host__ __device__ bool next(int i, Unit& u) const {
        const long L = (long)i * G + c; if (L >= nwg) return false;
        int wgid = (int)L; { const int q = nwg / NXCD, r = nwg % NXCD, xcd = wgid % NXCD, off = wgid / NXCD; wgid = (xcd < r ? xcd * (q + 1) : r * (q + 1) + (xcd - r) * q) + off; }
        const int nig = WGM * nN, gid = wgid / nig, fm = gid * WGM, gsz = (nM - fm) < WGM ? (nM - fm) : WGM;
        u.pm = fm + ((wgid % nig) % gsz); u.pn = (wgid % nig) / gsz; return true;
    }
    __device__ __forceinline__ void a_ready(const Unit&) const {}
    __device__ __forceinline__ void done(const Unit&) const {}
};

__device__ __forceinline__ unsigned cvt_pk_bf16(float lo, float hi) { unsigned r; asm volatile("v_cvt_pk_bf16_f32 %0, %1, %2" : "=v"(r) : "v"(lo), "v"(hi)); return r; }
typedef float f32x2 __attribute__((ext_vector_type(2)));
__device__ __forceinline__ f32x2 gelu_pk(f32x2 v) {
    const f32x2 av = __builtin_elementwise_abs(v), d = av * 0.2316418882f + 1.0f;
    f32x2 t; t.x = __builtin_amdgcn_rcpf(d.x); t.y = __builtin_amdgcn_rcpf(d.y);
    f32x2 q = t * 0.5307027145f + (-0.7265760135f); q = q * t + 0.7107068705f; q = q * t + (-0.142248368f); q = q * t + 0.127414796f; q = q * t;
    const f32x2 s = (v * v) * (-0.72134752044f);
    f32x2 e; e.x = __builtin_amdgcn_exp2f(s.x); e.y = __builtin_amdgcn_exp2f(s.y);
    const f32x2 m = v * (q * e), r = v - m;
    f32x2 o; o.x = v.x < 0.f ? m.x : r.x; o.y = v.y < 0.f ? m.y : r.y; return o;
}

template <int ACT  > struct EpiBf16 {
    static constexpr bool PERM = true, AFTER_DRAIN = false; static_assert(ACT == 0 || ACT == 1, "EpiBf16: ACT is 0 (none) or 1 (gelu_pk)");
    bf16_t* O; int ldc; const float* bias; int split_cols; size_t split_stride; float scale0;
    __device__ __forceinline__ void operator()(const f32x4 (&acc)[2][2][4][2], const Unit& u, int wr, int wc, int fr, int fq) const {
        const int row0 = u.pm * BM + wr * 64 + fr; int colt = u.pn * BM; bf16_t* base = O;
        float sc = 1.f; if (split_cols) { const int t = colt / split_cols; base += (size_t)t * split_stride; colt -= t * split_cols; if (t == 0) sc = scale0; }
        const int col0 = colt + wc * 32 + 8 * fq, bcol0 = u.pn * BM + wc * 32 + 8 * fq;
        f32x4 bv[2][2];
#pragma unroll
        for (int bj = 0; bj < 2; ++bj)
#pragma unroll
            for (int n = 0; n < 2; ++n) bv[bj][n] = bias ? *(const f32x4*)(bias + bcol0 + bj * HALF + 4 * n) : (f32x4){0.f, 0.f, 0.f, 0.f};
#pragma unroll
        for (int ai = 0; ai < 2; ++ai)
#pragma unroll
            for (int m = 0; m < 4; ++m) { bf16_t* rowp = base + (size_t)(row0 + ai * HALF + m * 16) * ldc + col0;
#pragma unroll
                for (int bj = 0; bj < 2; ++bj) { f32x4 v0 = acc[ai][bj][m][0] + bv[bj][0], v1 = acc[ai][bj][m][1] + bv[bj][1];
                    if (ACT == 1) { f32x2 a = gelu_pk((f32x2){v0[0], v0[1]}), b = gelu_pk((f32x2){v0[2], v0[3]}), c = gelu_pk((f32x2){v1[0], v1[1]}), d = gelu_pk((f32x2){v1[2], v1[3]});
                        v0 = (f32x4){a.x, a.y, b.x, b.y}; v1 = (f32x4){c.x, c.y, d.x, d.y}; }
                    v0 = v0 * sc; v1 = v1 * sc; u32x4 w; w.x = cvt_pk_bf16(v0[0], v0[1]); w.y = cvt_pk_bf16(v0[2], v0[3]); w.z = cvt_pk_bf16(v1[0], v1[1]); w.w = cvt_pk_bf16(v1[2], v1[3]);
                    *(u32x4*)(rowp + bj * HALF) = w; } }
    }
};

template <class Epi, class Sched, bool ALIGN_EPI = false, bool SP2 = false, bool F8 = false, bool GATH = false  >
__device__ __forceinline__ void gemm_phase(PG8_LAS unsigned char* lds, const Gemm g, const Sched& S, const Epi& E, int tid_in) {
    int tid_l = tid_in; asm volatile("" : "+v"(tid_l));
    const int tid = tid_l, wid = __builtin_amdgcn_readfirstlane(tid >> 6), lane = tid & 63, wr = wid >> 2, wc = wid & 3, fr = lane & 15, fq = lane >> 4;
    const int K = g.K, nt = K / BK;
    unsigned voffA[2], voffB[2]; int rowA[2]; unsigned colA[2];
#pragma unroll
    for (int i = 0; i < 2; ++i) { int R, C; stage_rc(tid * 16 + i * 8192, R, C); const int Rb = Epi::PERM ? ((R & ~31) + perm32(R & 31)) : R;
        voffA[i] = (unsigned)(R * K + C) * 2u; voffB[i] = (unsigned)(Rb * K + C) * 2u; rowA[i] = R; colA[i] = (unsigned)C * 2u; }
    static_assert(!GATH || SP2, "GATH: SP2 schedule only");
    unsigned cgo[2][2], ngo[2][2];
#define PG8_GOFF(dst, uidx) do { _Pragma("unroll") for (int _h = 0; _h < 2; ++_h) _Pragma("unroll") for (int _i = 0; _i < 2; ++_i) dst[_h][_i] = S.gsrc((uidx), _h * HALF + rowA[_i]) + colA[_i]; } while (0)
#define PG8_STAGE_G(bufoff, kb, o0, o1) do { \
        __builtin_amdgcn_global_load_lds((const unsigned*)((const char*)g.A + (kb) + (o0)), (PG8_LAS unsigned*)(lds + (bufoff) + ldsw), 16, 0, 0); \
        __builtin_amdgcn_global_load_lds((const unsigned*)((const char*)g.A + (kb) + (o1)), (PG8_LAS unsigned*)(lds + (bufoff) + ldsw + 8192), 16, 0, 0); } while (0)
    const size_t kstep = (size_t)(BK * 2);
    const size_t hstep = (size_t)HALF * K * 2;
    const size_t tstep = 2 * hstep;
    const unsigned ldsw = (unsigned)wid * 1024u;
    const int aoff = lds_byte(wr * 64 + fr, fq * 8), boff = lds_byte(wc * 32 + fr, fq * 8);
#define PG8_SA(b, h) (((b) * 2 + (h)) * HTB)
#define PG8_SB(b, h) ((4 + (b) * 2 + (h)) * HTB)
#define PG8_STAGE(bufoff, gbase, voff) do { _Pragma("unroll") for (int _i = 0; _i < 2; ++_i) \
        __builtin_amdgcn_global_load_lds((const unsigned*)((const char*)(gbase) + (voff)[_i]), (PG8_LAS unsigned*)(lds + (bufoff) + ldsw + _i * 8192), 16, 0, 0); } while (0)
#define PG8_LDA(dst, b, h) do { _Pragma("unroll") for (int m = 0; m < 4; ++m) _Pragma("unroll") for (int k = 0; k < 2; ++k) dst[m][k] = *(const PG8_LAS bf16x8*)(lds + PG8_SA(b, h) + aoff + m * 2048 + k * 1024); } while (0)
#define PG8_LDB(dst, b, h) do { _Pragma("unroll") for (int n = 0; n < 2; ++n) _Pragma("unroll") for (int k = 0; k < 2; ++k) dst[n][k] = *(const PG8_LAS bf16x8*)(lds + PG8_SB(b, h) + boff + n * 2048 + k * 1024); } while (0)
#define PG8_MMA(ai, bj, At, Bt) do { __builtin_amdgcn_s_setprio(1); if constexpr (!F8) { _Pragma("unroll") for (int m = 0; m < 4; ++m) _Pragma("unroll") for (int n = 0; n < 2; ++n) _Pragma("unroll") for (int k = 0; k < 2; ++k) \
        acc[ai][bj][m][n] = __builtin_amdgcn_mfma_f32_16x16x32_bf16(Bt[n][k], At[m][k], acc[ai][bj][m][n], 0, 0, 0); } else { _Pragma("unroll") for (int m = 0; m < 4; ++m) _Pragma("unroll") for (int n = 0; n < 2; ++n) \
        acc[ai][bj][m][n] = __builtin_amdgcn_mfma_scale_f32_16x16x128_f8f6f4(pg8_cat8(Bt[n][0], Bt[n][1]), pg8_cat8(At[m][0], At[m][1]), acc[ai][bj][m][n], 0, 0, 0, 0x7F7F7F7F, 0, 0x7F7F7F7F); \
        _Pragma("unroll") for (int m = 0; m < 4; ++m) _Pragma("unroll") for (int n = 0; n < 2; ++n) asm volatile("" : "+v"(acc[ai][bj][m][n]));   } __builtin_amdgcn_s_setprio(0); } while (0)
#define PG8_WAIT_V(n) asm volatile("s_waitcnt vmcnt(" #n ")" ::: "memory")
#define PG8_WAIT_L(n) asm volatile("s_waitcnt lgkmcnt(" #n ")" ::: "memory")
#define PG8_BAR __builtin_amdgcn_s_barrier()
#define PG8_SCHED __builtin_amdgcn_sched_barrier(0)
    Unit cur, nxt; int ui = 0;
    if (!S.next(0, cur)) return;
    f32x4 acc[2][2][4][2];
#pragma unroll
    for (int a = 0; a < 2; ++a)
#pragma unroll
        for (int b = 0; b < 2; ++b)
#pragma unroll
            for (int m = 0; m < 4; ++m)
#pragma unroll
                for (int n = 0; n < 2; ++n) acc[a][b][m][n] = (f32x4){0.f, 0.f, 0.f, 0.f};
    bf16x8 At[4][2], B0[2][2], B1[2][2];
    const char* cA = (const char*)g.A + (size_t)cur.pm * tstep; const char* cB = (const char*)g.Bt + (size_t)cur.pn * tstep;
    S.a_ready(cur);
    if constexpr (SP2) {
        if constexpr (GATH) { PG8_GOFF(cgo, 0); }
        PG8_STAGE(PG8_SB(0, 0), cB, voffB); PG8_STAGE(PG8_SB(0, 1), cB + hstep, voffB);
        if constexpr (GATH) { PG8_STAGE_G(PG8_SA(0, 0), 0, cgo[0][0], cgo[0][1]); PG8_STAGE_G(PG8_SA(0, 1), 0, cgo[1][0], cgo[1][1]); }
        else { PG8_STAGE(PG8_SA(0, 0), cA, voffA); PG8_STAGE(PG8_SA(0, 1), cA + hstep, voffA); }
        if (wr == 1) PG8_BAR;
        PG8_WAIT_V(2); PG8_BAR;
        PG8_STAGE(PG8_SB(1, 0), cB + kstep, voffB);
        if constexpr (GATH) { PG8_STAGE_G(PG8_SA(1, 0), kstep, cgo[0][0], cgo[0][1]); } else { PG8_STAGE(PG8_SA(1, 0), cA + kstep, voffA); }
        PG8_STAGE(PG8_SB(1, 1), cB + hstep + kstep, voffB);
        PG8_WAIT_V(6); PG8_BAR;
    } else {
        PG8_STAGE(PG8_SB(0, 0), cB, voffB); PG8_STAGE(PG8_SA(0, 0), cA, voffA); PG8_STAGE(PG8_SB(0, 1), cB + hstep, voffB); PG8_STAGE(PG8_SA(0, 1), cA + hstep, voffA);
        if (wr == 1) PG8_BAR;
        PG8_WAIT_V(4); PG8_BAR;
        PG8_STAGE(PG8_SB(1, 0), cB + kstep, voffB); PG8_STAGE(PG8_SA(1, 0), cA + kstep, voffA); PG8_STAGE(PG8_SB(1, 1), cB + hstep + kstep, voffB);
        PG8_WAIT_V(6); PG8_BAR;
    }
    for (;;) {
        const bool has_next = S.next(ui + 1, nxt);
        if constexpr (GATH) { if (has_next) { PG8_GOFF(ngo, ui + 1); } else {
            _Pragma("unroll") for (int _h = 0; _h < 2; ++_h) _Pragma("unroll") for (int _i = 0; _i < 2; ++_i) ngo[_h][_i] = cgo[_h][_i]; } }
        const char* nA = has_next ? (const char*)g.A + (size_t)nxt.pm * tstep : cA; const char* nB = has_next ? (const char*)g.Bt + (size_t)nxt.pn * tstep : cB;
        for (int t = 0; t < nt; t += 2) {
            const bool last = (t == nt - 2);
            const char* a1 = cA + (size_t)(t + 1) * kstep;
            const char* a2 = last ? nA : cA + (size_t)(t + 2) * kstep; const char* b2 = last ? nB : cB + (size_t)(t + 2) * kstep;
            const char* a3 = a2 + kstep; const char* b3 = b2 + kstep;
            if (last && has_next) S.a_ready(nxt);
            unsigned g0a = 0, g0b = 0, g1a = 0, g1b = 0; size_t kb2 = 0;
            if constexpr (GATH) { g0a = last ? ngo[0][0] : cgo[0][0]; g0b = last ? ngo[0][1] : cgo[0][1]; g1a = last ? ngo[1][0] : cgo[1][0]; g1b = last ? ngo[1][1] : cgo[1][1]; kb2 = last ? (size_t)0 : (size_t)(t + 2) * kstep; }
            if constexpr (SP2) {
            PG8_LDB(B0, 0, 0); PG8_LDB(B1, 0, 1); PG8_SCHED; PG8_LDA(At, 0, 0);
            if constexpr (GATH) { PG8_STAGE_G(PG8_SA(1, 1), (size_t)(t + 1) * kstep, cgo[1][0], cgo[1][1]); } else { PG8_STAGE(PG8_SA(1, 1), a1 + hstep, voffA); }
            PG8_WAIT_V(8); PG8_WAIT_L(0); PG8_BAR; PG8_MMA(0, 0, At, B0); PG8_MMA(0, 1, At, B1); PG8_BAR; PG8_SCHED;
            PG8_LDA(At, 0, 1); PG8_STAGE(PG8_SB(0, 0), b2, voffB); PG8_STAGE(PG8_SB(0, 1), b2 + hstep, voffB);
            if constexpr (GATH) { PG8_STAGE_G(PG8_SA(0, 0), kb2, g0a, g0b); } else { PG8_STAGE(PG8_SA(0, 0), a2, voffA); }
            PG8_WAIT_V(8); PG8_WAIT_L(0); PG8_BAR; PG8_MMA(1, 0, At, B0); PG8_MMA(1, 1, At, B1); PG8_BAR; PG8_SCHED;
            PG8_LDB(B0, 1, 0); PG8_LDB(B1, 1, 1); PG8_SCHED; PG8_LDA(At, 1, 0);
            if constexpr (GATH) { PG8_STAGE_G(PG8_SA(0, 1), kb2, g1a, g1b); } else { PG8_STAGE(PG8_SA(0, 1), a2 + hstep, voffA); }
            PG8_WAIT_V(8); PG8_WAIT_L(0); PG8_BAR; PG8_MMA(0, 0, At, B0); PG8_MMA(0, 1, At, B1); PG8_BAR; PG8_SCHED;
            PG8_LDA(At, 1, 1); PG8_STAGE(PG8_SB(1, 0), b3, voffB); PG8_STAGE(PG8_SB(1, 1), b3 + hstep, voffB);
            if constexpr (GATH) { PG8_STAGE_G(PG8_SA(1, 0), kb2 + kstep, g0a, g0b); } else { PG8_STAGE(PG8_SA(1, 0), a3, voffA); }
            PG8_WAIT_V(8); PG8_WAIT_L(0); PG8_BAR; PG8_MMA(1, 0, At, B0); PG8_MMA(1, 1, At, B1); PG8_BAR; PG8_SCHED;
            } else {
            PG8_LDB(B0, 0, 0); PG8_SCHED; PG8_LDA(At, 0, 0); PG8_STAGE(PG8_SA(1, 1), a1 + hstep, voffA);
            PG8_WAIT_L(8); PG8_BAR; PG8_WAIT_L(0); PG8_MMA(0, 0, At, B0); PG8_BAR; PG8_SCHED;
            PG8_LDB(B1, 0, 1); PG8_STAGE(PG8_SB(0, 0), b2, voffB);
            PG8_BAR; PG8_WAIT_L(0); PG8_MMA(0, 1, At, B1); PG8_BAR;
            PG8_LDA(At, 0, 1); PG8_STAGE(PG8_SA(0, 0), a2, voffA);
            PG8_BAR; PG8_WAIT_L(0); PG8_MMA(1, 0, At, B0); PG8_BAR; PG8_SCHED;
            PG8_STAGE(PG8_SB(0, 1), b2 + hstep, voffB);
            PG8_WAIT_V(6); PG8_BAR; PG8_MMA(1, 1, At, B1); PG8_BAR;
            PG8_LDB(B0, 1, 0); PG8_SCHED; PG8_LDA(At, 1, 0); PG8_STAGE(PG8_SA(0, 1), a2 + hstep, voffA);
            PG8_WAIT_L(8); PG8_BAR; PG8_WAIT_L(0); PG8_MMA(0, 0, At, B0); PG8_BAR; PG8_SCHED;
            PG8_LDB(B1, 1, 1); PG8_STAGE(PG8_SB(1, 0), b3, voffB);
            PG8_BAR; PG8_WAIT_L(0); PG8_MMA(0, 1, At, B1); PG8_BAR;
            PG8_LDA(At, 1, 1); PG8_STAGE(PG8_SA(1, 0), a3, voffA);
            PG8_BAR; PG8_WAIT_L(0); PG8_MMA(1, 0, At, B0); PG8_BAR; PG8_SCHED;
            PG8_STAGE(PG8_SB(1, 1), b3 + hstep, voffB);
            PG8_WAIT_V(6); PG8_BAR; PG8_MMA(1, 1, At, B1); PG8_BAR;
            }
        }
        if constexpr (ALIGN_EPI) { if (wr == 0) PG8_BAR; }
        if constexpr (!Epi::AFTER_DRAIN) { E(acc, cur, wr, wc, fr, fq); S.done(cur); }
        if (!has_next) break;
#pragma unroll
        for (int a = 0; a < 2; ++a)
#pragma unroll
            for (int b = 0; b < 2; ++b)
#pragma unroll
                for (int m = 0; m < 4; ++m)
#pragma unroll
                    for (int n = 0; n < 2; ++n) acc[a][b][m][n] = (f32x4){0.f, 0.f, 0.f, 0.f};
        cur = nxt; cA = nA; cB = nB; ++ui;
        if constexpr (GATH) { _Pragma("unroll") for (int _h = 0; _h < 2; ++_h) _Pragma("unroll") for (int _i = 0; _i < 2; ++_i) cgo[_h][_i] = ngo[_h][_i]; }
        if constexpr (ALIGN_EPI) { if (wr == 1) PG8_BAR; }
    }
    PG8_WAIT_V(0);
    if constexpr (!ALIGN_EPI) { if (wr == 0) PG8_BAR; }
    PG8_BAR;
    if constexpr (Epi::AFTER_DRAIN) { E.fused(acc, cur, wr, wc, fr, fq, lds, wid, lane); S.done(cur); }
#undef PG8_SA
#undef PG8_SB
#undef PG8_STAGE
#undef PG8_STAGE_G
#undef PG8_GOFF
#undef PG8_LDA
#undef PG8_LDB
#undef PG8_MMA
#undef PG8_WAIT_V
#undef PG8_WAIT_L
#undef PG8_BAR
#undef PG8_SCHED
}
}

#ifndef PG8_SP2
#define PG8_SP2 true
#endif
#ifndef PG8_ALIGN
#define PG8_ALIGN true
#endif
#define XB_TMO      128
#define XB_XCNT(j)  (256  + 64 * (j))
#define XB_XSUB(j)  (1280 + 64 * (j))
#define XB_XGEN(j)  (2304 + 64 * (j))
#define XB_TOP      3328
#define XB_TOPGEN   3392
#define XCD_BAR_WORDS 3456
#define XB_SPIN_CAP (1u << 18)

__device__ __forceinline__ unsigned xb_ld(unsigned* p)              { return __hip_atomic_load(p, __ATOMIC_RELAXED, __HIP_MEMORY_SCOPE_AGENT); }
__device__ __forceinline__ unsigned xb_add(unsigned* p, unsigned v) { return __hip_atomic_fetch_add(p, v, __ATOMIC_RELAXED, __HIP_MEMORY_SCOPE_AGENT); }
__device__ __forceinline__ unsigned xb_xcc_id() { return (unsigned)__builtin_amdgcn_s_getreg((3 << 11) | 20) & 0xFu; }
#define XB_SPIN(cond, bar) do { unsigned _sp = 0; while (cond) { __builtin_amdgcn_s_sleep(1); \
    if ((++_sp & 255u) == 0u) { if (xb_ld(&(bar)[XB_TMO])) break; if (_sp > XB_SPIN_CAP) { atomicAdd(&(bar)[XB_TMO], 1u); break; } } } } while (0)

struct XcdBarrier {
    unsigned* bar; unsigned x;
    volatile LAS unsigned* st;
};

__device__ __forceinline__ XcdBarrier xcd_barrier_post(unsigned* bar, volatile LAS unsigned* st) {
    XcdBarrier b; b.bar = bar; b.x = xb_xcc_id(); b.st = st;
    if (threadIdx.x == 0) (void)xb_add(&bar[XB_XCNT(b.x)], 1u);
    return b;
}
__device__ __forceinline__ void xcd_barrier_complete(unsigned* bar, unsigned x, unsigned& nloc, unsigned& nx) {
    const unsigned G = gridDim.x * gridDim.y * gridDim.z;
    unsigned sum, cnt, mine, sp = 0u;
    for (;;) {
        sum = 0u; cnt = 0u; mine = 0u;
#pragma unroll
        for (unsigned j = 0; j < 16; ++j) { const unsigned c = xb_ld(&bar[XB_XCNT(j)]); sum += c; cnt += (c > 0u) ? 1u : 0u; mine = (j == x) ? c : mine; }
        if (sum == G) break;
        __builtin_amdgcn_s_sleep(1);
        if ((++sp & 255u) == 0u) { if (xb_ld(&bar[XB_TMO])) break; if (sp > XB_SPIN_CAP) { atomicAdd(&bar[XB_TMO], 1u); break; } }
    }
    nloc = mine > 0u ? mine : 1u; nx = cnt > 0u ? cnt : 1u;
}

__device__ __forceinline__ void xcd_barrier(const XcdBarrier& b, const bool is_t0  ) {
    asm volatile("s_waitcnt vmcnt(0)" ::: "memory");
    __syncthreads();
    if (is_t0) {
        unsigned* bar = b.bar;
        __builtin_amdgcn_s_waitcnt(0);
        unsigned nloc = b.st[0], nx = b.st[1];
        if (nloc == 0u) { xcd_barrier_complete(bar, b.x, nloc, nx); b.st[0] = nloc; b.st[1] = nx; }
        const unsigned old = xb_add(&bar[XB_XSUB(b.x)], 1u);
        const unsigned gen = old / nloc;
        if (old + 1u == (gen + 1u) * nloc) {
            __builtin_amdgcn_fence(__ATOMIC_RELEASE, "agent");
            asm volatile("s_waitcnt vmcnt(0)" ::: "memory");
            const unsigned og = xb_add(&bar[XB_TOP], 1u);
            const unsigned tg = og / nx;
            if (og + 1u == (tg + 1u) * nx) xb_add(&bar[XB_TOPGEN], 1u);
            else XB_SPIN(xb_ld(&bar[XB_TOPGEN]) == tg, bar);
            __builtin_amdgcn_fence(__ATOMIC_ACQUIRE, "agent");
            xb_add(&bar[XB_XGEN(b.x)], 1u);
            asm volatile("s_waitcnt vmcnt(0)" ::: "memory");
        } else {
            XB_SPIN(xb_ld(&bar[XB_XGEN(b.x)]) == gen, bar);
            __builtin_amdgcn_fence(__ATOMIC_ACQUIRE, "agent");
            asm volatile("s_waitcnt vmcnt(0)" ::: "memory");
        }
    }
    __syncthreads();
}
struct EpiResBf16 {
    static constexpr bool PERM = true, AFTER_DRAIN = false;
    const bf16* xin; bf16* yp; float alpha;
    DI void operator()(const pg8::f32x4 (&acc)[2][2][4][2], const pg8::Unit& u, int wr, int wc, int fr, int fq) const {
        const int row0 = u.pm * 256 + wr * 64 + fr, col0 = u.pn * 256 + wc * 32 + 8 * fq;
#pragma unroll
        for (int ai = 0; ai < 2; ++ai)
#pragma unroll
            for (int m = 0; m < 4; ++m) {
                const size_t ro = (size_t)(row0 + ai * 128 + m * 16) * DM;
#pragma unroll
                for (int bj = 0; bj < 2; ++bj) {
                    const size_t o = ro + col0 + bj * 128;
                    const v4u xv = *(const v4u*)(xin + o);
                    const f32x4 a0 = acc[ai][bj][m][0], a1 = acc[ai][bj][m][1];
                    v4u w;
                    w.x = cvtpk(bf2f(xv.x & 0xffffu) * alpha + a0[0], bf2f(xv.x >> 16) * alpha + a0[1]); w.y = cvtpk(bf2f(xv.y & 0xffffu) * alpha + a0[2], bf2f(xv.y >> 16) * alpha + a0[3]);
                    w.z = cvtpk(bf2f(xv.z & 0xffffu) * alpha + a1[0], bf2f(xv.z >> 16) * alpha + a1[1]); w.w = cvtpk(bf2f(xv.w & 0xffffu) * alpha + a1[2], bf2f(xv.w >> 16) * alpha + a1[3]);
                    *(v4u*)(yp + o) = w;
                }
            }
    }
};
struct EpiSwiglu {
    static constexpr bool PERM = true, AFTER_DRAIN = false;
    unsigned char* act; const float* bgu;
    DI void operator()(const pg8::f32x4 (&acc)[2][2][4][2], const pg8::Unit& u, int wr, int wc, int fr, int fq) const {
        const int e = u.pn >> 3, pl = u.pn & 7;
        const int row0 = u.pm * 256 + wr * 64 + fr, cih = pl * 128 + wc * 32 + 8 * fq;
        const float* bg = bgu + e * 2048 + cih;
        const f32x4 bg0 = *(const f32x4*)(bg), bg1 = *(const f32x4*)(bg + 4), bu0 = *(const f32x4*)(bg + 1024), bu1 = *(const f32x4*)(bg + 1028);
#pragma unroll
        for (int ai = 0; ai < 2; ++ai)
#pragma unroll
            for (int m = 0; m < 4; ++m) {
                constexpr float RS = 1.f / (F8_SX * F8_SWG);
                const f32x4 g0 = acc[ai][0][m][0] * RS + bg0, g1 = acc[ai][0][m][1] * RS + bg1, u0 = acc[ai][1][m][0] * RS + bu0, u1 = acc[ai][1][m][1] * RS + bu1;
                float r[8];
#pragma unroll
                for (int i = 0; i < 8; ++i) {
                    float g = i < 4 ? g0[i & 3] : g1[i & 3], uu = i < 4 ? u0[i & 3] : u1[i & 3];
                    g = fminf(g, 7.0f); uu = fminf(fmaxf(uu, -7.0f), 7.0f);
                    const float sg = __builtin_amdgcn_rcpf(1.0f + ex2(-1.702f * LOG2E * g));
                    r[i] = (uu + 1.0f) * g * sg * F8_SA;
                }
                v2u w; w.x = pk4_fp8(r[0], r[1], r[2], r[3]); w.y = pk4_fp8(r[4], r[5], r[6], r[7]);
                *(v2u*)(act + (size_t)(row0 + ai * 128 + m * 16) * DM + cih) = w;
            }
    }
};
struct EpiDown {
    static constexpr bool PERM = true, AFTER_DRAIN = false;
    unsigned char* yr; const float* bdn;
    DI void operator()(const pg8::f32x4 (&acc)[2][2][4][2], const pg8::Unit& u, int wr, int wc, int fr, int fq) const {
        const int e = u.pn >> 2, pl = u.pn & 3;
        const int row0 = u.pm * 256 + wr * 64 + fr, col0 = pl * 256 + wc * 32 + 8 * fq;
        f32x4 bv[2][2];
#pragma unroll
        for (int bj = 0; bj < 2; ++bj) { bv[bj][0] = *(const f32x4*)(bdn + e * 1024 + col0 + bj * 128) * F8_SY; bv[bj][1] = *(const f32x4*)(bdn + e * 1024 + col0 + bj * 128 + 4) * F8_SY; }
#pragma unroll
        for (int ai = 0; ai < 2; ++ai)
#pragma unroll
            for (int m = 0; m < 4; ++m) {
                unsigned char* rp = yr + (size_t)(row0 + ai * 128 + m * 16) * DM + col0;
#pragma unroll
                for (int bj = 0; bj < 2; ++bj) {
                    constexpr float RS = F8_SY / (F8_SA * F8_SWD);
                    const f32x4 v0 = acc[ai][bj][m][0] * RS + bv[bj][0], v1 = acc[ai][bj][m][1] * RS + bv[bj][1];
                    v2u w; w.x = pk4_fp8(v0[0], v0[1], v0[2], v0[3]); w.y = pk4_fp8(v1[0], v1[1], v1[2], v1[3]);
                    *(v2u*)(rp + bj * 128) = w;
                }
            }
    }
};
struct GroupOrder {
    LAS const unsigned* tile_e; int ntiles, lg, G, c; LAS const unsigned short* srcl;
    DI bool next(int i, pg8::Unit& u) const {
        int pm, pl;
        if (G == 256) {
            const int x = c & 7, k = c >> 3; pm = i * (256 >> lg) + x * (32 >> lg) + (k >> lg); pl = k & ((1 << lg) - 1); if (pm >= ntiles) return false; }
        else { const long L = (long)i * G + c; if (L >= ((long)ntiles << lg)) return false; pm = (int)(L >> lg); pl = (int)(L & ((1 << lg) - 1)); }
        const int e = __builtin_amdgcn_readfirstlane((int)tile_e[pm]);
        u.pm = pm; u.pn = (e << lg) + pl; return true;
    }
    DI void a_ready(const pg8::Unit&) const {}
    DI void done(const pg8::Unit&) const {}
    DI unsigned gsrc(int ui, int r) const { return (unsigned)srcl[ui * 256 + r] << 10; }
};
struct Args { const float* in[18]; float* out; unsigned char* ws; int ph_lo, ph_hi; };
struct Fr { LAS unsigned char* lds; unsigned char* ws; unsigned* ctl; int tid, lane, wave, blk, G; };

DI void tr_item(const float* W, int ldw, int K, int k0, int sc0, int nvalid, bf16* WT, int drow0, LAS float* scr, int lane) {
    const int c = lane & 31;
    float v[32];
#pragma unroll
    for (int i = 0; i < 32; ++i) v[i] = (c < nvalid) ? W[(size_t)(k0 + 2 * i + (lane >> 5)) * ldw + sc0 + c] : 0.f;
#pragma unroll
    for (int i = 0; i < 32; ++i) scr[(2 * i + (lane >> 5)) * 33 + c] = v[i];
    LDS_WAIT(); asm volatile("" ::: "memory");
    const int c8 = lane & 7;
#pragma unroll
    for (int j = 0; j < 4; ++j) { const int n = (lane >> 3) + 8 * j; const LAS float* s = scr + (8 * c8) * 33 + n;
        v4u o; o.x = cvtpk(s[0 * 33], s[1 * 33]); o.y = cvtpk(s[2 * 33], s[3 * 33]); o.z = cvtpk(s[4 * 33], s[5 * 33]); o.w = cvtpk(s[6 * 33], s[7 * 33]);
        *(v4u*)(WT + (size_t)(drow0 + n) * K + k0 + 8 * c8) = o; }
    LDS_WAIT(); asm volatile("" ::: "memory");
}
DI void tr_item8(const float* W, int ldw, int K, int k0, int sc0, float scale, unsigned char* WT8, int drow0, LAS float* scr, int lane) {
    const int c = lane & 31;
    float v[32];
#pragma unroll
    for (int i = 0; i < 32; ++i) v[i] = W[(size_t)(k0 + 2 * i + (lane >> 5)) * ldw + sc0 + c];
#pragma unroll
    for (int i = 0; i < 32; ++i) scr[(2 * i + (lane >> 5)) * 33 + c] = v[i] * scale;
    LDS_WAIT(); asm volatile("" ::: "memory");
    const int c16 = lane & 3;
#pragma unroll
    for (int j = 0; j < 2; ++j) { const int n = (lane >> 2) + 16 * j; const LAS float* s = scr + (16 * c16) * 33 + n;
        v4u o; o.x = pk4_fp8(s[0 * 33], s[1 * 33], s[2 * 33], s[3 * 33]); o.y = pk4_fp8(s[4 * 33], s[5 * 33], s[6 * 33], s[7 * 33]);
        o.z = pk4_fp8(s[8 * 33], s[9 * 33], s[10 * 33], s[11 * 33]); o.w = pk4_fp8(s[12 * 33], s[13 * 33], s[14 * 33], s[15 * 33]);
        *(v4u*)(WT8 + (size_t)(drow0 + n) * K + k0 + 16 * c16) = o; }
    LDS_WAIT(); asm volatile("" ::: "memory");
}
DI void ph_prologue(const Args& a, const Fr& F) {
    LAS float* scr = (LAS float*)(F.lds + F.wave * 16384);
    const int gw = F.blk * NWAVES + F.wave, NGW = F.G * NWAVES;
    constexpr int I_EV = 2 * 16 * 80, I_OD = 2 * 16 * 96, I_WO = 4 * 16 * 32;
    constexpr int NITEMS = I_EV + I_OD + I_WO;
    bf16* wev = (bf16*)(F.ws + WS_WEV); bf16* wod = (bf16*)(F.ws + WS_WOD); bf16* wout = (bf16*)(F.ws + WS_WOUT);
    unsigned char* wgu = F.ws + WS_WGU; unsigned char* wdn = F.ws + WS_WDN;
    for (int it = gw; it < NITEMS; it += NGW) {
        int r = it;
        if (r < I_EV) { const int l = r / 1280; r %= 1280; const int kb = r / 80, n0 = (r % 80) * 32; int sc0, nv = 32;
            if (n0 < 512) sc0 = n0; else if (n0 < 1024) sc0 = 964 + (n0 - 512); else if (n0 < 1536) sc0 = 1476 + (n0 - 1024); else if (n0 < 2048) sc0 = 1988 + (n0 - 1536);
            else if (n0 < 2176) sc0 = 512 + (n0 - 2048); else if (n0 < 2432) sc0 = 640 + (n0 - 2176); else if (n0 < 2496) sc0 = 896 + (n0 - 2432);
            else if (n0 < 2528) { sc0 = 960; nv = 4; } else { sc0 = 0; nv = 0; }
            tr_item(a.in[1] + (size_t)l * 1024 * 2500, 2500, 1024, kb * 64, sc0, nv, wev + (size_t)l * EV_N * 1024, n0, scr, F.lane); continue; }
        r -= I_EV;
        if (r < I_OD) { const int l = r / 1536; r %= 1536; const int kb = r / 96, n0 = (r % 96) * 32;
            tr_item(a.in[6] + (size_t)l * 1024 * 3088, 3088, 1024, kb * 64, n0, 32, wod + (size_t)l * OD_N * 1024, n0, scr, F.lane); continue; }
        r -= I_OD;
        if (r < I_WO) { const int l = r / 512; r %= 512; const int kb = r / 32, n0 = (r % 32) * 32;
            const float* src = (l & 1) ? a.in[8] + (size_t)(l >> 1) * 1024 * 1024 : a.in[5] + (size_t)(l >> 1) * 1024 * 1024;
            tr_item(src, 1024, 1024, kb * 64, n0, 32, wout + (size_t)l * 1024 * 1024, n0, scr, F.lane); continue; }
    }
    { __syncthreads();
        LAS float* tile = (LAS float*)F.lds; unsigned char* wgu8 = F.ws + WS_WGU; unsigned char* wdn8 = F.ws + WS_WDN;
        constexpr int T_GU = 128 * 8 * 16, T_DN = 128 * 8 * 8, T_ALL = T_GU + T_DN;
        const int tid = F.tid, c4 = tid & 31, r0 = tid >> 5;
        f32x4 v[8];
        auto locate = [&](int t, const float*& src, int& ldw, unsigned char*& dst, float& scale) {
            if (t < T_GU) { const int le = t >> 7, r = t & 127, kb = r >> 4, nb = r & 15, n0 = nb * 128; const int pn = n0 >> 8, bj = (n0 >> 7) & 1;
                src = a.in[14] + (size_t)le * 1024 * 2048 + (size_t)(kb * 128) * 2048 + bj * 1024 + pn * 128; ldw = 2048; dst = wgu8 + (size_t)le * 2048 * 1024 + (size_t)n0 * 1024 + kb * 128; scale = F8_SWG; }
            else { const int u = t - T_GU, le = u >> 6, r = u & 63, kb = r >> 3, nb = r & 7;
                src = a.in[16] + (size_t)le * 1024 * 1024 + (size_t)(kb * 128) * 1024 + nb * 128; ldw = 1024; dst = wdn8 + (size_t)le * 1024 * 1024 + (size_t)(nb * 128) * 1024 + kb * 128; scale = F8_SWD; } };
        int t = F.blk;
        if (t < T_ALL) { const float* src; int ldw; unsigned char* dst; float sc; locate(t, src, ldw, dst, sc);
#pragma unroll
            for (int i = 0; i < 8; ++i) v[i] = *(const f32x4*)(src + (size_t)(r0 + 16 * i) * ldw + 4 * c4); }
        for (; t < T_ALL; t += F.G) {
            const float* src; int ldw; unsigned char* dst; float sc; locate(t, src, ldw, dst, sc);
#pragma unroll
            for (int i = 0; i < 8; ++i) { LAS float* tp = tile + (r0 + 16 * i) * 129 + 4 * c4; tp[0] = v[i][0] * sc; tp[1] = v[i][1] * sc; tp[2] = v[i][2] * sc; tp[3] = v[i][3] * sc; }
            __syncthreads();
            if (t + F.G < T_ALL) { const float* s2; int l2; unsigned char* d2; float c2; locate(t + F.G, s2, l2, d2, c2);
#pragma unroll
                for (int i = 0; i < 8; ++i) v[i] = *(const f32x4*)(s2 + (size_t)(r0 + 16 * i) * l2 + 4 * c4); }
#pragma unroll
            for (int j = 0; j < 2; ++j) { const int p = tid + 512 * j, kc = p & 7, n = p >> 3; const LAS float* sp = tile + (kc * 16) * 129 + n;
                v4u o; o.x = pk4_fp8(sp[0], sp[129], sp[2 * 129], sp[3 * 129]); o.y = pk4_fp8(sp[4 * 129], sp[5 * 129], sp[6 * 129], sp[7 * 129]);
                o.z = pk4_fp8(sp[8 * 129], sp[9 * 129], sp[10 * 129], sp[11 * 129]); o.w = pk4_fp8(sp[12 * 129], sp[13 * 129], sp[14 * 129], sp[15 * 129]);
                *(v4u*)(dst + (size_t)n * 1024 + kc * 16) = o; }
            __syncthreads();
        }
    }
    bf16* xb = (bf16*)(F.ws + WS_XB);
    for (int m = gw; m < NTOK; m += NGW) {
        const f32x4* xr = (const f32x4*)(a.in[0] + (size_t)m * DM) + F.lane; v2u* o = (v2u*)(xb + (size_t)m * DM) + F.lane;
#pragma unroll
        for (int j = 0; j < 4; ++j) { const f32x4 v = xr[64 * j]; v2u w; w.x = cvtpk(v[0], v[1]); w.y = cvtpk(v[2], v[3]); o[64 * j] = w; }
    }
    bf16* wukt = (bf16*)(F.ws + WS_WUKT); bf16* wuvt = (bf16*)(F.ws + WS_WUVT);
    for (int i = F.blk * NTHR + F.tid; i < 2 * 8 * 128 * 64; i += F.G * NTHR) {
        { const int d = i & 63, c = (i >> 6) & 127, lh = i >> 13; wukt[i] = (bf16)f2bf(a.in[2][((size_t)lh * 64 + d) * 128 + c]); }
        { const int c = i & 127, d = (i >> 7) & 63, lh = i >> 13; wuvt[i] = (bf16)f2bf(a.in[3][((size_t)lh * 128 + c) * 64 + d]); }
    }
}

DI void ln_row(f32x4 (&v)[4], const float* g, const float* b, int lane) {
    float s = 0.f;
#pragma unroll
    for (int j = 0; j < 4; ++j) s += (v[j][0] + v[j][1]) + (v[j][2] + v[j][3]);
    const float mean = wave_sum(s) * (1.f / DM); float s2 = 0.f;
#pragma unroll
    for (int j = 0; j < 4; ++j) { v[j] = v[j] - mean; s2 += (v[j][0] * v[j][0] + v[j][1] * v[j][1]) + (v[j][2] * v[j][2] + v[j][3] * v[j][3]); }
    const float rstd = 1.f / sqrtf(wave_sum(s2) * (1.f / DM) + LN_EPS);
#pragma unroll
    for (int j = 0; j < 4; ++j) { const f32x4 gg = *((const f32x4*)g + lane + 64 * j), bb = *((const f32x4*)b + lane + 64 * j); v[j] = v[j] * rstd * gg + bb; }
}
DI void store_row_f32(float* p, const f32x4 (&v)[4], int lane) {
#pragma unroll
    for (int j = 0; j < 4; ++j) *((f32x4*)p + lane + 64 * j) = v[j];
}
DI void store_row_bf16(bf16* p, const f32x4 (&v)[4], int lane) {
#pragma unroll
    for (int j = 0; j < 4; ++j) { v2u w; w.x = cvtpk(v[j][0], v[j][1]); w.y = cvtpk(v[j][2], v[j][3]); *((v2u*)p + lane + 64 * j) = w; }
}
template <int NL> DI void small_proj(LAS const float* xs, const float* W, int ldw, int lane, float (&acc)[4]) {
    constexpr int PARTS = 64 / NL, DPER = 1024 / PARTS;
    const int n = lane & (NL - 1), part = lane / NL;
    acc[0] = acc[1] = acc[2] = acc[3] = 0.f;
    const float* wp = W + (size_t)(part * DPER) * ldw + n;
    LAS const float* xp = xs + part * DPER;
#pragma unroll 8
    for (int d = 0; d < DPER; ++d) { const float w = wp[(size_t)d * ldw];
        acc[0] += w * xp[d]; acc[1] += w * xp[1024 + d]; acc[2] += w * xp[2048 + d]; acc[3] += w * xp[3072 + d]; }
#pragma unroll
    for (int o = NL; o < 64; o <<= 1) {
#pragma unroll
        for (int k = 0; k < 4; ++k) acc[k] += __shfl_xor(acc[k], o); }
}

DI void ph_even_prep(const Args& a, const Fr& F, int j) {
    const bf16* proj = (const bf16*)(F.ws + WS_PROJ);
    bf16* ckvn = (bf16*)(F.ws + WS_CKVN); bf16* ql = (bf16*)(F.ws + WS_QL); float* kbar = (float*)(F.ws + WS_KBAR);
    const float* kvg = a.in[4] + j * 128;
    const bf16* wukt = (const bf16*)(F.ws + WS_WUKT) + (size_t)j * 8 * 128 * 64;
    const int lane = F.lane, wave = F.wave;
    for (int chunk = F.blk; chunk < 256; chunk += F.G) {
        const int tok0 = chunk * 128;
#pragma unroll 1
        for (int i0 = 0; i0 < 16; i0 += 8) { unsigned wv[8];
#pragma unroll
            for (int i = 0; i < 8; ++i) wv[i] = *((const unsigned*)(proj + (size_t)(tok0 + wave * 16 + i0 + i) * EV_N + EC_CKV) + lane);
#pragma unroll
            for (int i = 0; i < 8; ++i) { const int tok = tok0 + wave * 16 + i0 + i; const float v0 = bf2f(wv[i] & 0xffffu), v1 = bf2f(wv[i] >> 16);
                const float ss = wave_sum(v0 * v0 + v1 * v1);
                const float r = 1.f / sqrtf(ss * (1.f / 128.f) + LN_EPS);
                *((unsigned*)(ckvn + (size_t)tok * 128) + lane) = cvtpk(v0 * r * kvg[2 * lane], v1 * r * kvg[2 * lane + 1]); } }
        { bf16* kic = (bf16*)(F.ws + WS_KIC); const int tok = tok0 + wave * 16 + (lane >> 2), c = (lane & 3) * 16;
            const v4u* src = (const v4u*)(proj + (size_t)tok * EV_N + EC_KI + c); v4u* dst = (v4u*)(kic + (size_t)tok * 64 + c); dst[0] = src[0]; dst[1] = src[1]; }
        { const int h = wave, l15 = lane & 15, kg = lane >> 4;
            bf16x8 af[8][2];
#pragma unroll
            for (int ct = 0; ct < 8; ++ct)
#pragma unroll
                for (int ks = 0; ks < 2; ++ks) af[ct][ks] = *(const bf16x8*)(wukt + ((size_t)h * 128 + ct * 16 + l15) * 64 + ks * 32 + kg * 8);
#pragma unroll 1
            for (int tg = 0; tg < 8; tg += 4) { bf16x8 qf[4][2];
#pragma unroll
                for (int u = 0; u < 4; ++u)
#pragma unroll
                    for (int ks = 0; ks < 2; ++ks) qf[u][ks] = *(const bf16x8*)(proj + (size_t)(tok0 + (tg + u) * 16 + l15) * EV_N + EC_QA + h * 64 + ks * 32 + kg * 8);
#pragma unroll
                for (int u = 0; u < 4; ++u) { const int tok = tok0 + (tg + u) * 16 + l15;
#pragma unroll
                    for (int ct = 0; ct < 8; ++ct) { f32x4 d = {0.f, 0.f, 0.f, 0.f};
                        d = mfma16(af[ct][0], qf[u][0], d); d = mfma16(af[ct][1], qf[u][1], d);
                        v2u w; w.x = cvtpk(d[0], d[1]); w.y = cvtpk(d[2], d[3]);
                        *(v2u*)(ql + (size_t)tok * 1024 + h * 128 + ct * 16 + 4 * kg) = w; } } } }
        if (chunk < 128) { const int b = chunk >> 5, n = chunk & 31; float s8[8];
#pragma unroll
            for (int k = 0; k < 8; ++k) s8[k] = 0.f;
            const bf16* kp = proj + ((size_t)b * SEQ + n * 256 + wave * 32) * EV_N + EC_KB + lane * 8;
#pragma unroll 8
            for (int r = 0; r < 32; ++r) { const v4u w = *(const v4u*)(kp + (size_t)r * EV_N);
#pragma unroll
                for (int k = 0; k < 4; ++k) { s8[2 * k] += bf2f(w[k] & 0xffffu); s8[2 * k + 1] += bf2f(w[k] >> 16); } }
            LAS float* red = (LAS float*)F.lds;
            __syncthreads();
#pragma unroll
            for (int k = 0; k < 8; ++k) red[wave * 512 + lane * 8 + k] = s8[k];
            __syncthreads();
            float s = 0.f;
#pragma unroll
            for (int w = 0; w < 8; ++w) s += red[w * 512 + F.tid];
            const int h = F.tid >> 6, d = F.tid & 63;
            kbar[(((size_t)b * 8 + h) * 32 + n) * 64 + d] = s * (1.f / 256.f); }
    }
}

DI void moba_gate_chunk(const Fr& F, int chunk) {
    const bf16* proj = (const bf16*)(F.ws + WS_PROJ); const float* kbar = (const float*)(F.ws + WS_KBAR); unsigned* sel3 = (unsigned*)(F.ws + WS_SEL3);
    const int tok0 = chunk * 128, b = tok0 / SEQ, own = (tok0 % SEQ) >> 8, h = F.wave, lane = F.lane;
    float q0[64], q1[64];
    { const v4u* p0 = (const v4u*)(proj + (size_t)(tok0 + lane) * EV_N + EC_QB + h * 64); const v4u* p1 = (const v4u*)(proj + (size_t)(tok0 + 64 + lane) * EV_N + EC_QB + h * 64);
#pragma unroll
        for (int i = 0; i < 8; ++i) { const v4u w0 = p0[i], w1 = p1[i];
#pragma unroll
            for (int k = 0; k < 4; ++k) { q0[8 * i + 2 * k] = bf2f(w0[k] & 0xffffu); q0[8 * i + 2 * k + 1] = bf2f(w0[k] >> 16); q1[8 * i + 2 * k] = bf2f(w1[k] & 0xffffu); q1[8 * i + 2 * k + 1] = bf2f(w1[k] >> 16); } } }
    float a0 = -INFINITY, a1 = -INFINITY, a2 = -INFINITY, c0 = -INFINITY, c1 = -INFINITY, c2 = -INFINITY; int ai0 = 0, ai1 = 0, ai2 = 0, ci0 = 0, ci1 = 0, ci2 = 0;
    const float* kb = kbar + (((size_t)b * 8 + h) * 32) * 64;
    for (int n = 0; n < own; ++n) { float g0 = 0.f, g1 = 0.f;
#pragma unroll
        for (int d = 0; d < 64; d += 4) { const f32x4 kv = *(const f32x4*)(kb + n * 64 + d);
#pragma unroll
            for (int k = 0; k < 4; ++k) { g0 += q0[d + k] * kv[k]; g1 += q1[d + k] * kv[k]; } }
        if (g0 > a2) { if (g0 > a1) { a2 = a1; ai2 = ai1; if (g0 > a0) { a1 = a0; ai1 = ai0; a0 = g0; ai0 = n; } else { a1 = g0; ai1 = n; } } else { a2 = g0; ai2 = n; } }
        if (g1 > c2) { if (g1 > c1) { c2 = c1; ci2 = ci1; if (g1 > c0) { c1 = c0; ci1 = ci0; c0 = g1; ci0 = n; } else { c1 = g1; ci1 = n; } } else { c2 = g1; ci2 = n; } }
    }
    const unsigned nv = own < 3 ? own : 3;
    sel3[(size_t)(tok0 + lane) * 8 + h] = (unsigned)ai0 | ((unsigned)ai1 << 8) | ((unsigned)ai2 << 16) | (nv << 24);
    sel3[(size_t)(tok0 + 64 + lane) * 8 + h] = (unsigned)ci0 | ((unsigned)ci1 << 8) | ((unsigned)ci2 << 16) | (nv << 24);
}

constexpr int HS = 257;
DI float relu1(float x) { const unsigned u = __float_as_uint(x); return __uint_as_float(u & ~(unsigned)((int)u >> 31)); }
template <int MODE, bool DIAG> DI void idx_tile(const bf16x8 (&kf)[4], LAS const char* qb  , const float (&wj)[4], int kt, int q, int hi, unsigned c0, unsigned c1,
                                     LAS unsigned* hist, LAS unsigned* mask, LAS unsigned* cmask, LAS unsigned long long* cand, LAS unsigned* rinfo) {
    f32x2 scp[8];
#pragma unroll
    for (int p = 0; p < 8; ++p) scp[p] = (f32x2){0.f, 0.f};
    bf16x8 qv0[2][4], qv1[2][4];
#pragma unroll
    for (int j = 0; j < 2; ++j)
#pragma unroll
        for (int s = 0; s < 4; ++s) qv0[j][s] = *(LAS const bf16x8*)(qb + (j * 8 + s * 2) * 512);
#pragma unroll
    for (int j = 0; j < 2; ++j)
#pragma unroll
        for (int s = 0; s < 4; ++s) qv1[j][s] = *(LAS const bf16x8*)(qb + ((2 + j) * 8 + s * 2) * 512);
    __builtin_amdgcn_sched_barrier(0);
#pragma unroll
    for (int g = 0; g < 2; ++g) { f32x16 acc[2];
#pragma unroll
        for (int j = 0; j < 2; ++j)
#pragma unroll
            for (int r = 0; r < 16; ++r) acc[j][r] = 0.f;
#pragma unroll
        for (int s = 0; s < 4; ++s)
#pragma unroll
            for (int j = 0; j < 2; ++j) { if (MODE != -2) acc[j] = mfma32(kf[s], g == 0 ? qv0[j][s] : qv1[j][s], acc[j]); else acc[j][s] += __builtin_bit_cast(float, (unsigned)(kf[s][0] ^ (g == 0 ? qv0[j][s][0] : qv1[j][s][0]))); }
#pragma unroll
        for (int p = 0; p < 8; ++p)
#pragma unroll
            for (int j = 0; j < 2; ++j) { const f32x2 a = {relu1(acc[j][2 * p]), relu1(acc[j][2 * p + 1])}; const f32x2 w2 = {wj[2 * g + j], wj[2 * g + j]}; scp[p] = a * w2 + scp[p]; } }
    unsigned sel = 0u, cnd = 0u;
    if (MODE <= 0) { float t = 0.f;
#pragma unroll
        for (int p = 0; p < 8; ++p) t += scp[p][0] + scp[p][1];
        if (t == 12345.678f) __hip_atomic_fetch_or(mask + q * HS + kt, 1u, __ATOMIC_RELAXED, __HIP_MEMORY_SCOPE_WORKGROUP);
        return; }
    const float F0 = __uint_as_float(c0), F1 = __uint_as_float(c1);
#pragma unroll
    for (int r = 0; r < 16; ++r) { const int kr = crow(r, hi);
        const bool ok = !DIAG || kr <= q;
        const float scv = scp[r >> 1][r & 1]; const unsigned u = __float_as_uint(scv);
        if (MODE == 1) { const unsigned key = u ^ ((unsigned)((int)u >> 31) | 0x80000000u);
            if (ok && (key >> 24) >= c0) __hip_atomic_fetch_add(hist + q * HS + (key >> 24), 1u, __ATOMIC_RELAXED, __HIP_MEMORY_SCOPE_WORKGROUP); }
        else if (MODE == 2) { if (ok && (u >> 24) == c0) __hip_atomic_fetch_add(hist + q * HS + (((u >> 16) & 255u) ^ c1), 1u, __ATOMIC_RELAXED, __HIP_MEMORY_SCOPE_WORKGROUP); }
        else { const bool ge1 = scv >= F1, ge0 = scv >= F0;
            if (ok && ge1) sel |= 1u << kr;
            if (ok && ge0 && !ge1) { cnd |= 1u << kr; const unsigned key = u ^ ((unsigned)((int)u >> 31) | 0x80000000u);
                const unsigned pos = __hip_atomic_fetch_add(rinfo + 128 + q, 1u, __ATOMIC_RELAXED, __HIP_MEMORY_SCOPE_WORKGROUP);
                if (pos < 64u) cand[q * 64 + pos] = ((unsigned long long)key << 32) | (unsigned)(~(unsigned)(kt * 32 + kr)); } } }
    if (MODE == 3) { if (sel) __hip_atomic_fetch_or(mask + q * HS + kt, sel, __ATOMIC_RELAXED, __HIP_MEMORY_SCOPE_WORKGROUP);
        if (cnd) __hip_atomic_fetch_or(cmask + q * HS + kt, cnd, __ATOMIC_RELAXED, __HIP_MEMORY_SCOPE_WORKGROUP); }
}
#define IDX_LOAD(KF, I) do { int kt_l = wave + 8 * (I); kt_l = kt_l < nkt - 1 ? kt_l : nkt - 1; const bf16* kp_ = kp0 + (size_t)(kt_l * 32) * 64; _Pragma("unroll") for (int s_ = 0; s_ < 4; ++s_) KF[s_] = *(const bf16x8*)(kp_ + s_ * 16); } while (0)
#define IDX_ROT() do { _Pragma("unroll") for (int s_ = 0; s_ < 4; ++s_) { kfa[s_] = kfb[s_]; kfb[s_] = kfc[s_]; } } while (0)
template <int MODE> DI void idx_pass(const bf16* proj, int rowbase, int qt, LAS const char* qimg, const float (&wj)[4], LAS unsigned* hist, LAS unsigned* mask, LAS unsigned* cmask, LAS unsigned long long* cand, LAS unsigned* rinfo, int wave, int lane) {
    const int q = lane & 31, hi = lane >> 5, nkt = qt + 1;
    const unsigned b1 = MODE == 2 ? rinfo[160 + q] : rinfo[224 + q], thr16 = MODE == 2 ? rinfo[192 + q] : rinfo[256 + q];
    const bf16* kp0 = proj + (size_t)(rowbase + q) * 64 + hi * 8;
    LAS const char* qb = qimg + hi * 512 + q * 16;
    const int n_all = nkt > wave ? (nkt - wave + 7) >> 3 : 0;
    if (n_all == 0) return;
    const bool has_diag = (qt & 7) == wave; const int n = n_all - (has_diag ? 1 : 0);
    bf16x8 kfa[4], kfb[4], kfc[4];
#define IDX_TILE(KF, I) idx_tile<MODE, false>(KF, qb, wj, wave + 8 * (I), q, hi, b1, thr16, hist, mask, cmask, cand, rinfo)
    IDX_LOAD(kfa, 0); IDX_LOAD(kfb, 1); IDX_LOAD(kfc, 2);
    int i = 0;
    for (; i + 3 <= n; i += 3) { IDX_TILE(kfa, i); IDX_LOAD(kfa, i + 3); IDX_TILE(kfb, i + 1); IDX_LOAD(kfb, i + 4); IDX_TILE(kfc, i + 2); IDX_LOAD(kfc, i + 5); }
#pragma unroll 1
    for (; i < n; ++i) { IDX_TILE(kfa, i); IDX_ROT(); }
    if (has_diag) idx_tile<MODE, true>(kfa, qb, wj, qt, q, hi, b1, thr16, hist, mask, cmask, cand, rinfo);
#undef IDX_TILE
}
DI void hist_pick(LAS const unsigned* hrow, unsigned need, int lane, unsigned& bin, unsigned& above) {
    unsigned h4[4];
#pragma unroll
    for (int k = 0; k < 4; ++k) h4[k] = hrow[4 * lane + k];
    const unsigned ssum = h4[0] + h4[1] + h4[2] + h4[3];
    unsigned x = ssum;
#pragma unroll
    for (int o = 1; o < 64; o <<= 1) { const unsigned y = __shfl_down(x, o); if (lane + o < 64) x += y; }
    const unsigned long long m = __ballot(x >= need);
    const int Ls = m ? 63 - __builtin_clzll(m) : 0;
    const unsigned xs = __shfl(x, Ls), ss = __shfl(ssum, Ls);
    const unsigned h0 = __shfl(h4[0], Ls), h1 = __shfl(h4[1], Ls), h2 = __shfl(h4[2], Ls), h3 = __shfl(h4[3], Ls);
    unsigned cum = xs - ss;
    if (cum + h3 >= need) { bin = 4 * Ls + 3; above = cum; return; } cum += h3;
    if (cum + h2 >= need) { bin = 4 * Ls + 2; above = cum; return; } cum += h2;
    if (cum + h1 >= need) { bin = 4 * Ls + 1; above = cum; return; } cum += h1;
    bin = 4 * Ls; above = cum; (void)h0;
}
DI void idx_pass1(const bf16* proj, int rowbase, int qt, LAS const char* qimg, const float (&wj)[4], LAS unsigned* hist, LAS unsigned* mask, LAS unsigned* cmask, LAS unsigned long long* cand, LAS unsigned* rinfo, int wave, int lane) {
    const int q = lane & 31, hi = lane >> 5, nkt = qt + 1, nmax = (nkt + 7) >> 3;
    const bf16* kp0 = proj + (size_t)(rowbase + q) * 64 + hi * 8;
    LAS const char* qb = qimg + hi * 512 + q * 16;
    unsigned lb = 0u;
    bf16x8 kfa[4], kfb[4], kfc[4];
#define IDX_TILE(KF, I) idx_tile<1, false>(KF, qb, wj, wave + 8 * (I), q, hi, lb, 0u, hist, mask, cmask, cand, rinfo)
#define IDX_LBUP(I) do { const int i_ = (I); if (((i_ + 1) & i_) == 0 && i_ + 1 < nmax && i_ < 16) {        \
            __syncthreads(); \
            _Pragma("unroll 1") for (int rr = 0; rr < 4; ++rr) { const int row = wave * 4 + rr; unsigned bin, above; hist_pick(hist + row * HS, 256u, lane, bin, above); if (lane == 0) rinfo[288 + row] = bin; } \
            __syncthreads(); \
            { const unsigned nb = rinfo[288 + q]; lb = nb > lb ? nb : lb; } } } while (0)
    IDX_LOAD(kfa, 0); IDX_LOAD(kfb, 1); IDX_LOAD(kfc, 2);
    int i = 0;
    for (; i + 3 <= nmax - 1; i += 3) { IDX_TILE(kfa, i); IDX_LOAD(kfa, i + 3); IDX_LBUP(i); IDX_TILE(kfb, i + 1); IDX_LOAD(kfb, i + 4); IDX_LBUP(i + 1); IDX_TILE(kfc, i + 2); IDX_LOAD(kfc, i + 5); IDX_LBUP(i + 2); }
#pragma unroll 1
    for (; i < nmax - 1; ++i) { IDX_TILE(kfa, i); IDX_ROT(); IDX_LBUP(i); }
    { const int kt = wave + 8 * (nmax - 1);
        if (kt < nkt) { if (kt == qt) idx_tile<1, true>(kfa, qb, wj, kt, q, hi, lb, 0u, hist, mask, cmask, cand, rinfo); else IDX_TILE(kfa, nmax - 1); } }
#undef IDX_TILE
#undef IDX_LBUP
}
#undef IDX_LOAD
#undef IDX_ROT
DI void idx_unit(const Fr& F, int b, int qt, int stop = 0  ) {
    const bf16* proj = (const bf16*)(F.ws + WS_PROJ); const bf16* kic = (const bf16*)(F.ws + WS_KIC); unsigned short* sel = (unsigned short*)(F.ws + WS_SEL);
    LAS unsigned* hist = (LAS unsigned*)(F.lds); LAS unsigned* mask = hist + 32 * HS; LAS unsigned* cmask = mask + 32 * HS;
    LAS unsigned long long* cand = (LAS unsigned long long*)(F.lds + 99328); LAS unsigned* rinfo = (LAS unsigned*)(F.lds + 115712);
    const int lane = F.lane, wave = F.wave, tid = F.tid, t0 = qt * 32, rowbase = b * SEQ;
    __syncthreads();
    for (int i = tid; i < 3 * 32 * HS; i += NTHR) hist[i] = 0u;
    if (tid < 320) rinfo[tid] = 0u;
    __syncthreads();
    if (t0 + 31 <= 255 || (EXPF & 64)) {
        if (lane < 8) {
#pragma unroll
            for (int rr = 0; rr < 4; ++rr) { const int row = wave * 4 + rr, nv = t0 + row + 1;
                const int nv0 = t0 + row + 1; const int nvc = nv0 < 256 ? nv0 : 256; (void)nv; mask[row * HS + lane] = nvc >= 32 * (lane + 1) ? 0xffffffffu : (nvc > 32 * lane ? ((1u << (nvc - 32 * lane)) - 1u) : 0u); } }
    } else {
        const int q = lane & 31;
        float wj[4];
        { const bf16* qp = proj + (size_t)(rowbase + t0 + q) * EV_N;
#pragma unroll
            for (int j = 0; j < 4; ++j) wj[j] = bf2f(qp[EC_WI + j]); }
        LAS char* qimg = (LAS char*)(F.lds + 117248);
#pragma unroll
        for (int i = 0; i < 2; ++i) { const int p = tid + i * NTHR, row = p & 31, c = p >> 5;
            *(LAS v4u*)(qimg + c * 512 + row * 16) = *(const v4u*)(proj + (size_t)(rowbase + t0 + row) * EV_N + EC_QI + c * 8); }
        __syncthreads();
        if (stop == 7) return;
        idx_pass1(kic, rowbase, qt, qimg, wj, hist, mask, cmask, cand, rinfo, wave, lane);
        __syncthreads();
#pragma unroll 1
        for (int rr = 0; rr < 4; ++rr) { const int row = wave * 4 + rr; unsigned bin, above; hist_pick(hist + row * HS, 256u, lane, bin, above);
            if (lane == 0) { rinfo[row] = bin; rinfo[32 + row] = 256u - above; rinfo[160 + row] = bin >= 128u ? bin - 128u : 255u - bin; rinfo[192 + row] = bin >= 128u ? 0u : 255u; } }
        __syncthreads();
        if (stop == 1) return;
        for (int i = tid; i < 32 * HS; i += NTHR) hist[i] = 0u;
        __syncthreads();
        idx_pass<2>(kic, rowbase, qt, qimg, wj, hist, mask, cmask, cand, rinfo, wave, lane);
        __syncthreads();
#pragma unroll 1
        for (int rr = 0; rr < 4; ++rr) { const int row = wave * 4 + rr; const unsigned need1 = rinfo[32 + row]; unsigned bin, above; hist_pick(hist + row * HS, need1, lane, bin, above);
            if (lane == 0) { const unsigned t16 = (rinfo[row] << 8) | bin, k0 = t16 << 16, k1 = (t16 + 1u) << 16;
                rinfo[64 + row] = t16; rinfo[96 + row] = need1 - above;
                rinfo[224 + row] = (k0 & 0x80000000u) ? (k0 ^ 0x80000000u) : ~k0; rinfo[256 + row] = (t16 == 0xffffu) ? 0x7fc00000u : ((k1 & 0x80000000u) ? (k1 ^ 0x80000000u) : ~k1); } }
        __syncthreads();
        if (stop == 2) return;
        idx_pass<3>(kic, rowbase, qt, qimg, wj, hist, mask, cmask, cand, rinfo, wave, lane);
        __syncthreads();
        if (stop == 3) return;
#pragma unroll 1
        for (int rr = 0; rr < 4; ++rr) { const int row = wave * 4 + rr; const unsigned call = rinfo[128 + row], need2 = rinfo[96 + row];
            if (call <= 64u) { const unsigned c = call;
                const unsigned long long mine = cand[row * 64 + lane]; unsigned rank = 0u;
                for (unsigned k = 0; k < c; ++k) rank += (cand[row * 64 + k] > mine) ? 1u : 0u;
                if ((unsigned)lane < c && rank < need2) { const unsigned s = ~(unsigned)mine;
                    __hip_atomic_fetch_or(mask + row * HS + (s >> 5), 1u << (s & 31), __ATOMIC_RELAXED, __HIP_MEMORY_SCOPE_WORKGROUP); } }
            else { unsigned w4[4];
#pragma unroll
                for (int k = 0; k < 4; ++k) w4[k] = cmask[row * HS + 4 * lane + k];
                const unsigned cnt = __popc(w4[0]) + __popc(w4[1]) + __popc(w4[2]) + __popc(w4[3]);
                unsigned x = cnt;
#pragma unroll
                for (int o = 1; o < 64; o <<= 1) { const unsigned y = __shfl_up(x, o); if (lane >= o) x += y; }
                unsigned before = x - cnt;
#pragma unroll
                for (int k = 0; k < 4; ++k) { unsigned w = w4[k]; const unsigned pc = __popc(w); unsigned take = 0u;
                    if (before < need2) { if (before + pc <= need2) take = w; else { unsigned left = need2 - before; while (left) { const unsigned b = w & (0u - w); take |= b; w ^= b; --left; } } }
                    before += pc;
                    if (take) mask[row * HS + 4 * lane + k] |= take; } }
        }
    }
    __syncthreads();
#pragma unroll 1
    for (int rr = 0; rr < 4; ++rr) { const int row = wave * 4 + rr; unsigned short* out = sel + (size_t)(rowbase + t0 + row) * 256;
        unsigned w4[4];
#pragma unroll
        for (int k = 0; k < 4; ++k) w4[k] = mask[row * HS + 4 * lane + k];
        const unsigned cnt = __popc(w4[0]) + __popc(w4[1]) + __popc(w4[2]) + __popc(w4[3]);
        unsigned x = cnt;
#pragma unroll
        for (int o = 1; o < 64; o <<= 1) { const unsigned y = __shfl_up(x, o); if (lane >= o) x += y; }
        const unsigned total = __shfl(x, 63); unsigned pos = x - cnt;
#pragma unroll
        for (int k = 0; k < 4; ++k) { unsigned w = w4[k]; const unsigned base = (unsigned)(4 * lane + k) * 32u;
            while (w) { const unsigned bit = __builtin_ctz(w); if (pos < 256u) out[pos] = (unsigned short)(base + bit); ++pos; w &= w - 1u; } }
        for (unsigned i = total + lane; i < 256u; i += 64u) out[i] = (unsigned short)0xffffu; }
}

struct AttSt { float m, l; f32x16 o0, o1; };
template <class BF> DI void att_subtile(AttSt& S, const bf16x8 (&qf)[4], LAS const char* Kst, LAS const char* Vb, int vdh, int vrow0, int lane, const BF& bias) {
    const int r32 = lane & 31, hi = lane >> 5;
    f32x16 p;
#pragma unroll
    for (int r = 0; r < 16; ++r) p[r] = bias.b(crow(r, hi)) - S.m;
    LAS const char* kp = Kst + hi * 512 + r32 * 16;
#pragma unroll
    for (int s = 0; s < 4; ++s) { const bf16x8 kf = *(LAS const bf16x8*)(kp + s * 1024); p = mfma32(kf, qf[s], p); }
    if (bias.any) {
#pragma unroll
        for (int r = 0; r < 16; ++r) p[r] = bias.msk(crow(r, hi)) ? -INFINITY : p[r]; }
    float mxa[4] = {-INFINITY, -INFINITY, -INFINITY, -INFINITY};
#pragma unroll
    for (int r = 0; r < 16; ++r) mxa[r & 3] = fmaxf(mxa[r & 3], p[r]);
    float mx = fmaxf(fmaxf(mxa[0], mxa[1]), fmaxf(mxa[2], mxa[3]));
    mx = fmaxf(mx, __shfl_xor(mx, 32));
    if (__any(mx > 16.f)) { const float dl = fmaxf(mx, 0.f), sc = ex2(-dl); S.m += dl; S.l *= sc;
#pragma unroll
        for (int r = 0; r < 16; ++r) { p[r] -= dl; S.o0[r] *= sc; S.o1[r] *= sc; } }
    float psa[4] = {0.f, 0.f, 0.f, 0.f};
#pragma unroll
    for (int r = 0; r < 16; ++r) { p[r] = ex2(p[r]); psa[r & 3] += p[r]; }
    S.l += (psa[0] + psa[1]) + (psa[2] + psa[3]);
    v4u pw0, pw1;
    pw0.x = cvtpk(p[0], p[1]); pw0.y = cvtpk(p[2], p[3]); pw0.z = cvtpk(p[4], p[5]); pw0.w = cvtpk(p[6], p[7]);
    pw1.x = cvtpk(p[8], p[9]); pw1.y = cvtpk(p[10], p[11]); pw1.z = cvtpk(p[12], p[13]); pw1.w = cvtpk(p[14], p[15]);
    const bf16x8 pf0 = __builtin_bit_cast(bf16x8, pw0), pf1 = __builtin_bit_cast(bf16x8, pw1);
    LAS const char* vp = Vb + (vrow0 + 4 * hi + ((lane & 15) >> 2)) * 64 + ((lane >> 4) & 1) * 32 + (lane & 3) * 8;
    { const bf16x8 v00 = cat8(vtr(vp), vtr(vp + 512)), v10 = cat8(vtr(vp + vdh), vtr(vp + vdh + 512));
      const bf16x8 v01 = cat8(vtr(vp + 1024), vtr(vp + 1536)), v11 = cat8(vtr(vp + vdh + 1024), vtr(vp + vdh + 1536));
      S.o0 = mfma32(v00, pf0, S.o0); S.o1 = mfma32(v10, pf0, S.o1);
      S.o0 = mfma32(v01, pf1, S.o0); S.o1 = mfma32(v11, pf1, S.o1); }
}
template <class BF0, class BF1> DI void att_tile64(AttSt& S, const bf16x8 (&qf)[4], LAS const char* Kst, LAS const char* Vb, int vdh, int vrow0, int lane, const BF0& bias0, const BF1& bias1) {
    const int r32 = lane & 31, hi = lane >> 5;
    f32x16 p0, p1;
#pragma unroll
    for (int r = 0; r < 16; ++r) { p0[r] = bias0.b(crow(r, hi)) - S.m; p1[r] = bias1.b(crow(r, hi)) - S.m; }
    LAS const char* kp = Kst + hi * 512 + r32 * 16;
#pragma unroll
    for (int s = 0; s < 4; ++s) { const bf16x8 k0 = *(LAS const bf16x8*)(kp + s * 1024), k1 = *(LAS const bf16x8*)(kp + 4096 + s * 1024); p0 = mfma32(k0, qf[s], p0); p1 = mfma32(k1, qf[s], p1); }
    if (bias0.any) {
#pragma unroll
        for (int r = 0; r < 16; ++r) p0[r] = bias0.msk(crow(r, hi)) ? -INFINITY : p0[r]; }
    if (bias1.any) {
#pragma unroll
        for (int r = 0; r < 16; ++r) p1[r] = bias1.msk(crow(r, hi)) ? -INFINITY : p1[r]; }
    float mxa[4] = {-INFINITY, -INFINITY, -INFINITY, -INFINITY};
#pragma unroll
    for (int r = 0; r < 16; ++r) mxa[r & 3] = fmaxf(mxa[r & 3], fmaxf(p0[r], p1[r]));
    float mx = fmaxf(fmaxf(mxa[0], mxa[1]), fmaxf(mxa[2], mxa[3]));
    mx = fmaxf(mx, __shfl_xor(mx, 32));
    if (__any(mx > 16.f)) { const float dl = fmaxf(mx, 0.f), sc = ex2(-dl); S.m += dl; S.l *= sc;
#pragma unroll
        for (int r = 0; r < 16; ++r) { p0[r] -= dl; p1[r] -= dl; S.o0[r] *= sc; S.o1[r] *= sc; } }
    float psa[4] = {0.f, 0.f, 0.f, 0.f};
#pragma unroll
    for (int r = 0; r < 16; ++r) { p0[r] = ex2(p0[r]); p1[r] = ex2(p1[r]); psa[r & 3] += p0[r] + p1[r]; }
    S.l += (psa[0] + psa[1]) + (psa[2] + psa[3]);
    v4u a0, a1, b0, b1;
    a0.x = cvtpk(p0[0], p0[1]); a0.y = cvtpk(p0[2], p0[3]); a0.z = cvtpk(p0[4], p0[5]); a0.w = cvtpk(p0[6], p0[7]);
    a1.x = cvtpk(p0[8], p0[9]); a1.y = cvtpk(p0[10], p0[11]); a1.z = cvtpk(p0[12], p0[13]); a1.w = cvtpk(p0[14], p0[15]);
    b0.x = cvtpk(p1[0], p1[1]); b0.y = cvtpk(p1[2], p1[3]); b0.z = cvtpk(p1[4], p1[5]); b0.w = cvtpk(p1[6], p1[7]);
    b1.x = cvtpk(p1[8], p1[9]); b1.y = cvtpk(p1[10], p1[11]); b1.z = cvtpk(p1[12], p1[13]); b1.w = cvtpk(p1[14], p1[15]);
    LAS const char* vp = Vb + (vrow0 + 4 * hi + ((lane & 15) >> 2)) * 64 + ((lane >> 4) & 1) * 32 + (lane & 3) * 8;
#pragma unroll
    for (int k16 = 0; k16 < 4; ++k16) { const bf16x8 pf = __builtin_bit_cast(bf16x8, k16 == 0 ? a0 : k16 == 1 ? a1 : k16 == 2 ? b0 : b1);
        const bf16x8 v0 = cat8(vtr(vp + k16 * 1024), vtr(vp + k16 * 1024 + 512)), v1 = cat8(vtr(vp + vdh + k16 * 1024), vtr(vp + vdh + k16 * 1024 + 512));
        S.o0 = mfma32(v0, pf, S.o0); S.o1 = mfma32(v1, pf, S.o1); }
}

struct MobaFar { float c; bool any; DI float b(int) const { return c; } DI bool msk(int) const { return false; } };
struct MobaBias { LAS const float* lut; int tq, s0; bool any;
    DI float b(int kvrel) const { const int dist = tq - (s0 + kvrel); return lut[dist < 0 ? 0 : (dist > 1023 ? 1023 : dist)]; }
    DI bool msk(int kvrel) const { return tq - (s0 + kvrel) < 0; } };
DI void moba_qload(bf16x8 (&qf)[4], const bf16* proj, int rowbase, int h, int tq, int hi) {
    const bf16* qp = proj + (size_t)(rowbase + tq) * EV_N + EC_QB + h * 64 + hi * 8;
#pragma unroll
    for (int s = 0; s < 4; ++s) qf[s] = *(const bf16x8*)(qp + s * 16);
}
DI void moba_tile(const Fr& F, const bf16x8 (&qf)[4], int rowbase, int h, int n, int tq, bool valid, int slot, bool own, int wave_tile) {
    LAS const char* Kb = (LAS const char*)F.lds; LAS const char* Vb = (LAS const char*)(F.lds + 32768); LAS const float* lut = (LAS const float*)(F.lds + 98304);
    bf16* po = (bf16*)(F.ws + WS_ACT); float* pml = (float*)(F.ws + WS_PML);
    const int lane = F.lane, hi = lane >> 5;
    AttSt S; S.m = 0.f; S.l = 0.f;
#pragma unroll
    for (int r = 0; r < 16; ++r) { S.o0[r] = 0.f; S.o1[r] = 0.f; }
    const int nst = own ? wave_tile + 1 : 8;
    int tmin = tq;
#pragma unroll
    for (int o = 1; o < 64; o <<= 1) { const int y = __shfl_xor(tmin, o); tmin = y < tmin ? y : tmin; }
    const float cfar = lut[1023];
    int st = 0;
    for (; st + 1 < nst; st += 2) {
        if (!own && tmin - (n * 256 + st * 32 + 63) >= 790) { MobaFar bf{cfar, false}; att_tile64(S, qf, Kb + st * 4096, Vb, 16384, st * 32, lane, bf, bf); }
        else { MobaBias bf0{lut, tq, n * 256 + st * 32, false}, bf1{lut, tq, n * 256 + st * 32 + 32, own && st + 1 == wave_tile}; att_tile64(S, qf, Kb + st * 4096, Vb, 16384, st * 32, lane, bf0, bf1); } }
    if (st < nst) { MobaBias bf{lut, tq, n * 256 + st * 32, own && st == wave_tile}; att_subtile(S, qf, Kb + st * 4096, Vb, 16384, st * 32, lane, bf); }
    const float lt = S.l + __shfl_xor(S.l, 32), inv = 1.f / lt;
    if (valid) { const size_t pi = ((size_t)(rowbase + tq) * 8 + h) * 4 + slot; bf16* o = po + pi * 64;
#pragma unroll
        for (int a4 = 0; a4 < 4; ++a4) { v2u w0, w1;
            w0.x = cvtpk(S.o0[4 * a4] * inv, S.o0[4 * a4 + 1] * inv); w0.y = cvtpk(S.o0[4 * a4 + 2] * inv, S.o0[4 * a4 + 3] * inv);
            w1.x = cvtpk(S.o1[4 * a4] * inv, S.o1[4 * a4 + 1] * inv); w1.y = cvtpk(S.o1[4 * a4 + 2] * inv, S.o1[4 * a4 + 3] * inv);
            *(v2u*)(o + 8 * a4 + 4 * hi) = w0; *(v2u*)(o + 32 + 8 * a4 + 4 * hi) = w1; }
        if (hi == 0) { f32x2 ml = {S.m, lt}; *(f32x2*)(pml + pi * 2) = ml; } }
}
DI void moba_unit(const Args& a, const Fr& F, int b, int h, int n) {
    const bf16* proj = (const bf16*)(F.ws + WS_PROJ); const unsigned* sel3 = (const unsigned*)(F.ws + WS_SEL3);
    LAS unsigned char* lds = F.lds; LAS unsigned* list = (LAS unsigned*)(lds + 65536); LAS float* lut = (LAS float*)(lds + 98304); LAS unsigned* misc = (LAS unsigned*)(lds + 102400);
    const int tid = F.tid, lane = F.lane, wave = F.wave, rowbase = b * SEQ;
    __syncthreads();
    { const bf16* kg = proj + (size_t)(rowbase + n * 256) * EV_N + EC_KB + h * 64; const bf16* vg = proj + (size_t)(rowbase + n * 256) * EV_N + EC_VB + h * 64;
#pragma unroll
        for (int i = 0; i < 4; ++i) { const int p = tid + i * NTHR;
            { const int r = p & 31, c = (p >> 5) & 7, st = p >> 8; const v4u v = *(const v4u*)(kg + (size_t)(st * 32 + r) * EV_N + c * 8); *(LAS v4u*)(lds + st * 4096 + c * 512 + r * 16) = v; }
            { const int cc = p & 3, row = (p >> 2) & 255, dh = p >> 10; const v4u v = *(const v4u*)(vg + (size_t)row * EV_N + dh * 32 + cc * 8); *(LAS v4u*)(lds + 32768 + dh * 16384 + row * 64 + cc * 16) = v; } }
        for (int d = tid; d < 1024; d += NTHR) lut[d] = a.in[9][t5_bucket(d) * 16 + 8 + h] * LOG2E; }
    if (tid == 0) misc[16] = 0u;
    __syncthreads();
    unsigned sv[16];
#pragma unroll
    for (int k = 0; k < 16; ++k) { const int t = (n + 1) * 256 + k * NTHR + tid; sv[k] = t < SEQ ? sel3[(size_t)(rowbase + t) * 8 + h] : 0u; }
#pragma unroll
    for (int k = 0; k < 16; ++k) { const int tb = (n + 1) * 256 + k * NTHR; if (tb < SEQ) { const int t = tb + tid;
        const unsigned s = sv[k]; const unsigned nv = s >> 24; int slot = -1;
        if (nv > 0u && (s & 255u) == (unsigned)n) slot = 0; else if (nv > 1u && ((s >> 8) & 255u) == (unsigned)n) slot = 1; else if (nv > 2u && ((s >> 16) & 255u) == (unsigned)n) slot = 2;
        const unsigned long long bal = __ballot(slot >= 0); const unsigned wcnt = __popcll(bal);
        if (lane == 0) misc[wave] = wcnt;
        __syncthreads();
        unsigned off = misc[16], tot = 0u;
#pragma unroll
        for (int w = 0; w < 8; ++w) { const unsigned c = misc[w]; if (w < wave) off += c; tot += c; }
        if (slot >= 0) list[off + __popcll(bal & ((1ull << lane) - 1ull))] = ((unsigned)t << 2) | (unsigned)slot;
        __syncthreads();
        if (tid == 0) misc[16] += tot; } }
    __syncthreads();
    const int nlist = (int)misc[16];
    const int ntl = (nlist + 31) >> 5, hi = lane >> 5;
    bf16x8 qa[4], qb2[4];
    moba_qload(qa, proj, rowbase, h, n * 256 + wave * 32 + (lane & 31), hi);
    unsigned ea = 0u, eb = 0u; bool va = false, vb = false;
    int tl = wave;
    if (tl < ntl) { const int li = tl * 32 + (lane & 31); vb = li < nlist; eb = list[vb ? li : nlist - 1]; moba_qload(qb2, proj, rowbase, h, (int)(eb >> 2), hi); }
    moba_tile(F, qa, rowbase, h, n, n * 256 + wave * 32 + (lane & 31), true, 3, true, wave);
    for (; tl < ntl; tl += 16) {
        const int t2 = tl + 8, t3 = tl + 16;
        if (t2 < ntl) { const int li = t2 * 32 + (lane & 31); va = li < nlist; ea = list[va ? li : nlist - 1]; moba_qload(qa, proj, rowbase, h, (int)(ea >> 2), hi); }
        moba_tile(F, qb2, rowbase, h, n, (int)(eb >> 2), vb, (int)(eb & 3u), false, 0);
        if (t2 < ntl) {
            if (t3 < ntl) { const int li = t3 * 32 + (lane & 31); vb = li < nlist; eb = list[vb ? li : nlist - 1]; moba_qload(qb2, proj, rowbase, h, (int)(eb >> 2), hi); }
            moba_tile(F, qa, rowbase, h, n, (int)(ea >> 2), va, (int)(ea & 3u), false, 0); }
    }
}

DI void dsa_step(const bf16x8 (&af)[2][4], const bf16x8 (&qlf)[4], int ch, LAS const unsigned char* bsel, LAS unsigned char* cbuf, LAS const float* tab,
                 float& m, float& l, f32x4 (&oT)[8], int l15, int kg, int lane) {
    f32x4 acc[2];
#pragma unroll
    for (int mt = 0; mt < 2; ++mt) { const unsigned b4 = *(LAS const unsigned*)(bsel + ch * 32 + mt * 16 + 4 * kg);
#pragma unroll
        for (int i = 0; i < 4; ++i) { const unsigned bb = (b4 >> (8 * i)) & 255u; const float tb = tab[(bb & 31u) * 8 + (l15 & 7)];
            acc[mt][i] = (tb - m) + (bb != 255u ? 0.f : -INFINITY); } }
#pragma unroll
    for (int mt = 0; mt < 2; ++mt)
#pragma unroll
        for (int ks = 0; ks < 4; ++ks) { acc[mt] = mfma16(af[mt][ks], qlf[ks], acc[mt]); *(LAS bf16x8*)(cbuf + (mt * 16 + l15) * 288 + (ks * 32 + kg * 8) * 2) = af[mt][ks]; }
    float mx = fmaxf(fmaxf(fmaxf(acc[0][0], acc[0][1]), fmaxf(acc[0][2], acc[0][3])), fmaxf(fmaxf(acc[1][0], acc[1][1]), fmaxf(acc[1][2], acc[1][3])));
    if (__any(mx > 16.f)) { mx = fmaxf(mx, __shfl_xor(mx, 16)); mx = fmaxf(mx, __shfl_xor(mx, 32));
        const float dl = fmaxf(mx, 0.f), sc = ex2(-dl); m += dl; l *= sc;
#pragma unroll
        for (int mt = 0; mt < 2; ++mt) acc[mt] = acc[mt] - dl;
#pragma unroll
        for (int ct = 0; ct < 8; ++ct) oT[ct] = oT[ct] * sc; }
    float ps = 0.f;
#pragma unroll
    for (int mt = 0; mt < 2; ++mt)
#pragma unroll
        for (int i = 0; i < 4; ++i) { acc[mt][i] = ex2(acc[mt][i]); ps += acc[mt][i]; }
    l += ps;
    v4u pw; pw.x = cvtpk(acc[0][0], acc[0][1]); pw.y = cvtpk(acc[0][2], acc[0][3]); pw.z = cvtpk(acc[1][0], acc[1][1]); pw.w = cvtpk(acc[1][2], acc[1][3]);
    const bf16x8 pf = __builtin_bit_cast(bf16x8, pw);
    asm volatile("" ::: "memory");
    LAS const char* tp = (LAS const char*)cbuf + (4 * kg + (l15 >> 2)) * 288 + (lane & 3) * 8;
#pragma unroll
    for (int ct = 0; ct < 8; ++ct) { const bf16x8 cf = cat8(vtr(tp + ct * 32), vtr(tp + 16 * 288 + ct * 32)); oT[ct] = mfma16(cf, pf, oT[ct]); }
    asm volatile("" ::: "memory");
}
DI void dsa_gather(bf16x8 (&af)[2][4], const bf16* ckvn, int rowbase, LAS const unsigned short* selb, int ch, int l15, int kg) {
#pragma unroll
    for (int mt = 0; mt < 2; ++mt) { unsigned idx = selb[ch * 32 + mt * 16 + l15]; if (idx == 0xffffu) idx = 0u;
        const bf16* cp = ckvn + (size_t)(rowbase + (int)idx) * 128 + kg * 8;
#pragma unroll
        for (int ks = 0; ks < 4; ++ks) af[mt][ks] = *(const bf16x8*)(cp + ks * 32); }
}
DI void dsa_query(const Fr& F, int tok, const v2u sv, LAS unsigned char* wl, LAS const unsigned char* bkt, LAS const float* tab) {
    const bf16* ql = (const bf16*)(F.ws + WS_QL); const bf16* ckvn = (const bf16*)(F.ws + WS_CKVN); const unsigned short* sel = (const unsigned short*)(F.ws + WS_SEL); bf16* ol = (bf16*)(F.ws + WS_OL);
    const int lane = F.lane, l15 = lane & 15, kg = lane >> 4, t = tok % SEQ, rowbase = tok - t;
    LAS unsigned short* selb = (LAS unsigned short*)wl; LAS unsigned char* bsel = wl + 512; LAS unsigned char* cbuf = wl + 1024;
    { *((LAS v2u*)selb + lane) = sv; unsigned bw = 0u;
#pragma unroll
        for (int i = 0; i < 4; ++i) { const unsigned s = (i < 2 ? (sv.x >> (16 * i)) : (sv.y >> (16 * (i - 2)))) & 0xffffu; const int dist = t - (int)s;
            const unsigned bb = (s != 0xffffu && dist >= 0) ? (unsigned)bkt[dist > 1023 ? 1023 : dist] : 255u; bw |= bb << (8 * i); }
        *((LAS unsigned*)bsel + lane) = bw; }
    bf16x8 qlf[4];
#pragma unroll
    for (int ks = 0; ks < 4; ++ks) { qlf[ks] = *(const bf16x8*)(ql + (size_t)tok * 1024 + (l15 & 7) * 128 + ks * 32 + kg * 8); if (l15 >= 8) qlf[ks] = (bf16x8){0, 0, 0, 0, 0, 0, 0, 0}; }
    float m = 0.f, l = 0.f; f32x4 oT[8];
#pragma unroll
    for (int ct = 0; ct < 8; ++ct) oT[ct] = (f32x4){0.f, 0.f, 0.f, 0.f};
    const int nvalid = t + 1 < 256 ? t + 1 : 256, nch = (nvalid + 31) >> 5;
    LDS_WAIT();
    bf16x8 afa[2][4], afb[2][4], afc[2][4];
    const int lastc = nch - 1;
    dsa_gather(afa, ckvn, rowbase, selb, 0, l15, kg);
    dsa_gather(afb, ckvn, rowbase, selb, lastc < 1 ? lastc : 1, l15, kg);
    int ch = 0;
    for (; ch + 3 <= nch; ch += 3) {
        dsa_gather(afc, ckvn, rowbase, selb, ch + 2, l15, kg);
        dsa_step(afa, qlf, ch, bsel, cbuf, tab, m, l, oT, l15, kg, lane);
        dsa_gather(afa, ckvn, rowbase, selb, ch + 3 < lastc ? ch + 3 : lastc, l15, kg);
        dsa_step(afb, qlf, ch + 1, bsel, cbuf, tab, m, l, oT, l15, kg, lane);
        dsa_gather(afb, ckvn, rowbase, selb, ch + 4 < lastc ? ch + 4 : lastc, l15, kg);
        dsa_step(afc, qlf, ch + 2, bsel, cbuf, tab, m, l, oT, l15, kg, lane);
    }
    if (ch < nch) dsa_step(afa, qlf, ch, bsel, cbuf, tab, m, l, oT, l15, kg, lane);
    if (ch + 1 < nch) dsa_step(afb, qlf, ch + 1, bsel, cbuf, tab, m, l, oT, l15, kg, lane);
    l += __shfl_xor(l, 16); l += __shfl_xor(l, 32);
    const float inv = 1.f / l;
    if (l15 < 8) { bf16* o = ol + (size_t)tok * 1024 + l15 * 128 + 4 * kg;
#pragma unroll
        for (int ct = 0; ct < 8; ++ct) { v2u w; w.x = cvtpk(oT[ct][0] * inv, oT[ct][1] * inv); w.y = cvtpk(oT[ct][2] * inv, oT[ct][3] * inv); *(v2u*)(o + ct * 16) = w; } }
}
DI void dsa_chunk(const Args& a, const Fr& F, int c32) {
    LAS unsigned char* bkt = F.lds + 81920; LAS float* tab = (LAS float*)(F.lds + 82944);
    __syncthreads();
    for (int d = F.tid; d < 1024; d += NTHR) bkt[d] = (unsigned char)t5_bucket(d);
    if (F.tid < 256) tab[F.tid] = a.in[9][(F.tid >> 3) * 16 + (F.tid & 7)] * LOG2E;
    __syncthreads();
    const unsigned short* selg = (const unsigned short*)(F.ws + WS_SEL); v2u svq[4];
#pragma unroll
    for (int i = 0; i < 4; ++i) svq[i] = *((const v2u*)(selg + (size_t)(c32 * 32 + F.wave * 4 + i) * 256) + F.lane);
#pragma unroll
    for (int i = 0; i < 4; ++i) dsa_query(F, c32 * 32 + F.wave * 4 + i, svq[i], F.lds + F.wave * 10240, bkt, tab);
}

DI void ph_even_post(const Fr& F, int j) {
    const bf16* ol = (const bf16*)(F.ws + WS_OL); bf16* ao = (bf16*)(F.ws + WS_AO);
    const bf16* wuvt = (const bf16*)(F.ws + WS_WUVT) + (size_t)j * 8 * 64 * 128;
    const bf16* po = (const bf16*)(F.ws + WS_ACT); const float* pml = (const float*)(F.ws + WS_PML); const unsigned* sel3 = (const unsigned*)(F.ws + WS_SEL3);
    const int lane = F.lane, wave = F.wave, l15 = lane & 15, kg = lane >> 4;
    for (int chunk = F.blk; chunk < 256; chunk += F.G) { const int tok0 = chunk * 128;
        { const int h = wave; bf16x8 af[4][4];
#pragma unroll
            for (int mt = 0; mt < 4; ++mt)
#pragma unroll
                for (int ks = 0; ks < 4; ++ks) af[mt][ks] = *(const bf16x8*)(wuvt + ((size_t)h * 64 + mt * 16 + l15) * 128 + ks * 32 + kg * 8);
#pragma unroll 1
            for (int tg = 0; tg < 8; tg += 2) { bf16x8 bf[2][4];
#pragma unroll
                for (int u = 0; u < 2; ++u)
#pragma unroll
                    for (int ks = 0; ks < 4; ++ks) bf[u][ks] = *(const bf16x8*)(ol + (size_t)(tok0 + (tg + u) * 16 + l15) * 1024 + h * 128 + ks * 32 + kg * 8);
#pragma unroll
                for (int u = 0; u < 2; ++u) { const int tok = tok0 + (tg + u) * 16 + l15;
#pragma unroll
                    for (int mt = 0; mt < 4; ++mt) { f32x4 d = {0.f, 0.f, 0.f, 0.f};
#pragma unroll
                        for (int ks = 0; ks < 4; ++ks) d = mfma16(af[mt][ks], bf[u][ks], d);
                        v2u w; w.x = cvtpk(d[0], d[1]); w.y = cvtpk(d[2], d[3]); *(v2u*)(ao + (size_t)tok * 1024 + h * 64 + mt * 16 + 4 * kg) = w; } } } }
#pragma unroll 1
        for (int i0 = 0; i0 < 16; i0 += 4) { const int h = lane >> 3, d0 = (lane & 7) * 8; unsigned nvv[4]; f32x2 mlv[4][4];
#pragma unroll
            for (int i = 0; i < 4; ++i) { const int tok = tok0 + wave * 16 + i0 + i; const size_t pi = ((size_t)tok * 8 + h) * 4; nvv[i] = sel3[(size_t)tok * 8 + h] >> 24;
#pragma unroll
                for (int s = 0; s < 4; ++s) mlv[i][s] = *(const f32x2*)(pml + (pi + s) * 2); }
#pragma unroll
            for (int i = 0; i < 4; ++i) { const int tok = tok0 + wave * 16 + i0 + i; const size_t pi = ((size_t)tok * 8 + h) * 4;
                float mj[4], lj[4];
#pragma unroll
                for (int s = 0; s < 4; ++s) { const bool ok = (s == 3) || ((unsigned)s < nvv[i]); mj[s] = ok ? mlv[i][s][0] : -1e30f; lj[s] = ok ? mlv[i][s][1] : 0.f; }
                const float ms = fmaxf(fmaxf(mj[0], mj[1]), fmaxf(mj[2], mj[3])); float wsum = 0.f, acc[8], wv[4]; v4u pv[4];
#pragma unroll
                for (int k = 0; k < 8; ++k) acc[k] = 0.f;
#pragma unroll
                for (int s = 0; s < 4; ++s) { wv[s] = lj[s] * ex2(mj[s] - ms); wsum += wv[s]; pv[s] = (v4u){0u, 0u, 0u, 0u}; if (wv[s] > 0.f) pv[s] = *(const v4u*)(po + (pi + s) * 64 + d0); }
#pragma unroll
                for (int s = 0; s < 4; ++s) { if (wv[s] > 0.f) {
#pragma unroll
                    for (int k = 0; k < 4; ++k) { acc[2 * k] += wv[s] * bf2f(pv[s][k] & 0xffffu); acc[2 * k + 1] += wv[s] * bf2f(pv[s][k] >> 16); } } }
                const float inv = 1.f / wsum; v4u o; o.x = cvtpk(acc[0] * inv, acc[1] * inv); o.y = cvtpk(acc[2] * inv, acc[3] * inv); o.z = cvtpk(acc[4] * inv, acc[5] * inv); o.w = cvtpk(acc[6] * inv, acc[7] * inv);
                *(v4u*)(ao + (size_t)tok * 1024 + 512 + h * 64 + d0) = o; } }
    }
}
template <class XT> DI f32x4 ld_x4(const XT* p);
template <> DI f32x4 ld_x4<float>(const float* p) { return *(const f32x4*)p; }
template <> DI f32x4 ld_x4<bf16>(const bf16* p) { const v2u w = *(const v2u*)p; return (f32x4){bf2f(w.x & 0xffffu), bf2f(w.x >> 16), bf2f(w.y & 0xffffu), bf2f(w.y >> 16)}; }
template <class XT> DI f32x16 proj32_f32(const float* W, int ldw, int ncols, const XT* xrow, int d_lo, int lane) {
    const int e = lane & 31, kh = lane >> 5; const bool ev = e < ncols;
    f32x16 D;
#pragma unroll
    for (int r = 0; r < 16; ++r) D[r] = 0.f;
    const float* wp = W + (size_t)(d_lo + 4 * kh) * ldw + (ev ? e : 0);
    const XT* xp = xrow + d_lo + 4 * kh;
#pragma unroll 8
    for (int i = 0; i < 64; ++i) { const f32x4 xv = ld_x4<XT>(xp + 8 * i);
        float a0 = wp[(size_t)(8 * i + 0) * ldw], a1 = wp[(size_t)(8 * i + 1) * ldw], a2 = wp[(size_t)(8 * i + 2) * ldw], a3 = wp[(size_t)(8 * i + 3) * ldw];
        if (!ev) { a0 = 0.f; a1 = 0.f; a2 = 0.f; a3 = 0.f; }
        D = __builtin_amdgcn_mfma_f32_32x32x2f32(a0, xv[0], D, 0, 0, 0); D = __builtin_amdgcn_mfma_f32_32x32x2f32(a1, xv[1], D, 0, 0, 0);
        D = __builtin_amdgcn_mfma_f32_32x32x2f32(a2, xv[2], D, 0, 0, 0); D = __builtin_amdgcn_mfma_f32_32x32x2f32(a3, xv[3], D, 0, 0, 0); }
    return D;
}
DI void ph_odd_prep(const Args& a, const Fr& F, int j, int layer) {
    const bf16* proj = (const bf16*)(F.ws + WS_PROJ); const bf16* x = (const bf16*)(F.ws + WS_XB);
    float* logf = (float*)(F.ws + WS_LOGF); float* cs = (float*)(F.ws + WS_CS);
    const float* wf = a.in[6] + (size_t)j * 1024 * 3088 + 3072; const float* bfv = a.in[7] + j * 16;
    LAS float* red = (LAS float*)(F.lds); LAS float* lfb = (LAS float*)(F.lds + 131072);
    LAS unsigned* kmx = (LAS unsigned*)(F.lds + 131072 + 8192);
    const int lane = F.lane, wave = F.wave, tid = F.tid, l31 = lane & 31, hi = lane >> 5;
    for (int chunk = F.blk; chunk < 256; chunk += F.G) { const int tok0 = chunk * 128, b = tok0 / SEQ, t0 = tok0 % SEQ;
        __syncthreads();
        if (tid < 16) kmx[tid] = 0u;
        const int tl = wave & 3, kr = wave >> 2;
        f32x16 D = proj32_f32(wf, 3088, 16, x + (size_t)(tok0 + tl * 32 + l31) * DM, kr * 512, lane);
        if (kr == 1) {
#pragma unroll
            for (int r = 0; r < 8; ++r) red[(tl * 8 + r) * 64 + lane] = D[r]; }
        __syncthreads();
        if (kr == 0) {
#pragma unroll
            for (int r = 0; r < 8; ++r) { const int h = (r & 3) + 8 * (r >> 2) + 4 * hi; const float z = D[r] + red[(tl * 8 + r) * 64 + lane] + bfv[h];
                const float ls = fminf(z, 0.f) - log1pf(__expf(-fabsf(z)));
                lfb[(tl * 32 + l31) * 16 + h] = ls * LOG2E; } }
#pragma unroll 1
        for (int i = 0; i < 4; ++i) { const int p = tid + i * NTHR, tk = p >> 4, h = p & 15; const v4u* kp = (const v4u*)(proj + (size_t)(tok0 + tk) * OD_N + OC_K + h * 64); float s = 0.f;
#pragma unroll
            for (int c = 0; c < 8; ++c) { const v4u w = kp[c];
#pragma unroll
                for (int k = 0; k < 4; ++k) { const float e0 = bf2f(w[k] & 0xffffu), e1 = bf2f(w[k] >> 16); s += e0 * e0 + e1 * e1; } }
            __hip_atomic_fetch_max(kmx + h, __float_as_uint(s), __ATOMIC_RELAXED, __HIP_MEMORY_SCOPE_WORKGROUP); }
        __syncthreads();
        for (int i = tid; i < 2048; i += NTHR) { const int h = i >> 7, tk = i & 127; logf[((size_t)b * 16 + h) * SEQ + t0 + tk] = lfb[tk * 16 + h]; }
        if (tid < 32) { const int h = tid & 15, c = tid >> 4; float s = 0.f;
            for (int k = 0; k < 64; ++k) s += lfb[(c * 64 + k) * 16 + h];
            cs[((size_t)b * 16 + h) * 128 + (t0 >> 6) + c] = s; }
        if (tid < 16) __hip_atomic_fetch_max(F.ctl + CW_KMAX + layer * 64 + b * 16 + tid, kmx[tid], RLX_AGENT);
    }
}

constexpr float FOX_SKIP_LOG2 = 64.f;
struct FoxBias { LAS const float* ng; int tq, kabs0; bool any;
    DI float b(int kvrel) const { return ng[kvrel]; }
    DI bool msk(int kvrel) const { return (kabs0 + kvrel) > tq; } };
DI void fox_unit(const Fr& F, int layer, int b, int h, int qb) {
    const bf16* proj = (const bf16*)(F.ws + WS_PROJ); const float* logf = (const float*)(F.ws + WS_LOGF); const float* cs = (const float*)(F.ws + WS_CS); bf16* ao = (bf16*)(F.ws + WS_AO);
    LAS unsigned char* lds = F.lds; LAS float* ng = (LAS float*)(lds + 32768); LAS float* red = (LAS float*)(lds + 65536 + 1024); LAS int* ibox = (LAS int*)(lds + 65536 + 2048);
    const int tid = F.tid, lane = F.lane, wave = F.wave, r32 = lane & 31, hi = lane >> 5, t0 = qb * 256, rowbase = b * SEQ, tq = t0 + wave * 32 + r32;
    __syncthreads();
    bf16x8 qf[4]; float qs = 0.f;
    { const bf16* qp = proj + (size_t)(rowbase + tq) * OD_N + OC_Q + h * 64 + hi * 8;
#pragma unroll
        for (int s = 0; s < 4; ++s) { qf[s] = *(const bf16x8*)(qp + s * 16);
#pragma unroll
            for (int k = 0; k < 8; ++k) { const float e = bf2f((unsigned short)qf[s][k]); qs += e * e; } } }
    qs += __shfl_xor(qs, 32); qs = wave_max(qs);
    if (lane == 0) red[wave] = qs;
    if (tid < 128) red[32 + tid] = (tid < t0 / 64) ? cs[((size_t)b * 16 + h) * 128 + tid] : 0.f;
    __syncthreads();
    if (tid == 0) { float qm = red[0];
        for (int w = 1; w < 8; ++w) qm = fmaxf(qm, red[w]);
        const float km = __uint_as_float(ld_u32(F.ctl + CW_KMAX + layer * 64 + b * 16 + h));
        const float B2 = 2.f * (sqrtf(qm * km) * 1.01f + 1.f);
        int kt = t0 / 64 - 1, kts = t0 / 64; float D = 0.f;
        while (kt >= 0 && B2 + D >= -FOX_SKIP_LOG2) { kts = kt; D += red[32 + kt]; --kt; }
        ibox[0] = kts; }
    __syncthreads();
    const int kts = ibox[0], s_start = kts * 64, nel = t0 + 256 - s_start;
    { const int i0 = tid * 16; float v[16]; const float* lp = logf + ((size_t)b * 16 + h) * SEQ + s_start + i0;
        if (i0 < nel) {
#pragma unroll
            for (int c = 0; c < 4; ++c) { const f32x4 w = *(const f32x4*)(lp + 4 * c); v[4 * c] = w[0]; v[4 * c + 1] = w[1]; v[4 * c + 2] = w[2]; v[4 * c + 3] = w[3]; } }
        else {
#pragma unroll
            for (int c = 0; c < 16; ++c) v[c] = 0.f; }
#pragma unroll
        for (int c = 1; c < 16; ++c) v[c] += v[c - 1];
        float xsum = v[15];
#pragma unroll
        for (int o = 1; o < 64; o <<= 1) { const float y = __shfl_up(xsum, o); if (lane >= o) xsum += y; }
        if (lane == 63) red[16 + wave] = xsum;
        __syncthreads();
        float off = xsum - v[15];
        for (int w = 0; w < wave; ++w) off += red[16 + w];
        if (i0 < nel) {
#pragma unroll
            for (int c = 0; c < 4; ++c) { f32x4 w = {-(off + v[4 * c]), -(off + v[4 * c + 1]), -(off + v[4 * c + 2]), -(off + v[4 * c + 3])}; *(LAS f32x4*)(ng + i0 + 4 * c) = w; } }
    }
    const int ntile = t0 / 64 + 4 - kts;
    const bf16* kg = proj + (size_t)rowbase * OD_N + OC_K + h * 64; const bf16* vg = proj + (size_t)rowbase * OD_N + OC_V + h * 64;
    const int kr = tid & 31, kc = (tid >> 5) & 7, kst = tid >> 8, vcc = tid & 3, vrow = (tid >> 2) & 63, vdh = tid >> 8;
    const int koff = kst * 4096 + kc * 512 + kr * 16, voff = 8192 + vdh * 4096 + vrow * 64 + vcc * 16;
    { const v4u kv = *(const v4u*)(kg + (size_t)(kts * 64 + kst * 32 + kr) * OD_N + kc * 8), vv = *(const v4u*)(vg + (size_t)(kts * 64 + vrow) * OD_N + vdh * 32 + vcc * 8);
        *(LAS v4u*)(lds + koff) = kv; *(LAS v4u*)(lds + voff) = vv; }
    __syncthreads();
    AttSt S; S.m = 0.f; S.l = 0.f;
#pragma unroll
    for (int r = 0; r < 16; ++r) { S.o0[r] = 0.f; S.o1[r] = 0.f; }
    const int wlast = t0 + wave * 32 + 31, wfirst = t0 + wave * 32;
    for (int i = 0; i < ntile; ++i) { const int kt = kts + i; LAS unsigned char* buf = lds + (i & 1) * 16384; LAS unsigned char* nbuf = lds + ((i + 1) & 1) * 16384;
        v4u kv, vv; const bool more = i + 1 < ntile;
        if (more) { kv = *(const v4u*)(kg + (size_t)((kt + 1) * 64 + kst * 32 + kr) * OD_N + kc * 8); vv = *(const v4u*)(vg + (size_t)((kt + 1) * 64 + vrow) * OD_N + vdh * 32 + vcc * 8); }
        { const int kv0 = kt * 64;
            if (kv0 + 32 <= wlast) { FoxBias bf0{ng + (kv0 - s_start), tq, kv0, kv0 + 31 > wfirst}, bf1{ng + (kv0 + 32 - s_start), tq, kv0 + 32, kv0 + 63 > wfirst};
                att_tile64(S, qf, (LAS const char*)buf, (LAS const char*)buf + 8192, 4096, 0, lane, bf0, bf1); }
            else if (kv0 <= wlast) { FoxBias bf{ng + (kv0 - s_start), tq, kv0, kv0 + 31 > wfirst};
                att_subtile(S, qf, (LAS const char*)buf, (LAS const char*)buf + 8192, 4096, 0, lane, bf); } }
        if (more) { *(LAS v4u*)(nbuf + koff) = kv; *(LAS v4u*)(nbuf + voff - 8192 + 8192) = vv; }
        __syncthreads(); }
    const float lt = S.l + __shfl_xor(S.l, 32), inv = 1.f / lt;
    bf16* o = ao + (size_t)(rowbase + tq) * 1024 + h * 64;
#pragma unroll
    for (int a4 = 0; a4 < 4; ++a4) { v2u w0, w1;
        w0.x = cvtpk(S.o0[4 * a4] * inv, S.o0[4 * a4 + 1] * inv); w0.y = cvtpk(S.o0[4 * a4 + 2] * inv, S.o0[4 * a4 + 3] * inv);
        w1.x = cvtpk(S.o1[4 * a4] * inv, S.o1[4 * a4 + 1] * inv); w1.y = cvtpk(S.o1[4 * a4 + 2] * inv, S.o1[4 * a4 + 3] * inv);
        *(v2u*)(o + 8 * a4 + 4 * hi) = w0; *(v2u*)(o + 32 + 8 * a4 + 4 * hi) = w1; }
}

DI void ph_ln1_router(const Args& a, const Fr& F, int layer) {
    const bf16* yp = (const bf16*)(F.ws + WS_YP); bf16* x1 = (bf16*)(F.ws + WS_X1); unsigned char* xb8 = F.ws + WS_XB8;
    unsigned* tope = (unsigned*)(F.ws + WS_TOPE); float* gate = (float*)(F.ws + WS_GATE); unsigned* rank = (unsigned*)(F.ws + WS_RANK);
    const float* g = a.in[10] + (size_t)(layer * 2) * DM; const float* bb = a.in[11] + (size_t)(layer * 2) * DM;
    const float* rw = a.in[12] + (size_t)layer * 1024 * 32; const float* rb = a.in[13] + layer * 32;
    LAS float* red = (LAS float*)(F.lds); LAS unsigned* lcnt = (LAS unsigned*)(F.lds + 131072);
    const int lane = F.lane, wave = F.wave, tid = F.tid, l31 = lane & 31, hi = lane >> 5;
    for (int chunk = F.blk; chunk < 256; chunk += F.G) { const int tok0 = chunk * 128;
        __syncthreads();
        if (tid < 32) lcnt[tid] = 0u;
#pragma unroll 1
        for (int k = 0; k < 16; k += 8) { f32x4 v[8][4];
#pragma unroll
            for (int i = 0; i < 8; ++i)
#pragma unroll
                for (int jj = 0; jj < 4; ++jj) { const v2u w = *((const v2u*)(yp + (size_t)(tok0 + wave * 16 + k + i) * DM) + lane + 64 * jj);
                    v[i][jj] = (f32x4){bf2f(w.x & 0xffffu), bf2f(w.x >> 16), bf2f(w.y & 0xffffu), bf2f(w.y >> 16)}; }
#pragma unroll
            for (int i = 0; i < 8; ++i) { const int tok = tok0 + wave * 16 + k + i;
                ln_row(v[i], g, bb, lane);
                store_row_bf16(x1 + (size_t)tok * DM, v[i], lane);
#pragma unroll
                for (int jj = 0; jj < 4; ++jj) *((unsigned*)(xb8 + (size_t)tok * DM) + lane + 64 * jj) = pk4_fp8(v[i][jj][0] * F8_SX, v[i][jj][1] * F8_SX, v[i][jj][2] * F8_SX, v[i][jj][3] * F8_SX); } }
        asm volatile("s_waitcnt vmcnt(0)" ::: "memory");
        __syncthreads();
        const int tl = wave & 3, kr = wave >> 2, tokl = tok0 + tl * 32 + l31;
        f32x16 D = proj32_f32(rw, 32, 32, x1 + (size_t)tokl * DM, kr * 512, lane);
        if (kr == 1) {
#pragma unroll
            for (int r = 0; r < 16; ++r) red[(tl * 16 + r) * 64 + lane] = D[r]; }
        __syncthreads();
        if (kr == 0) {
            float lv[32];
#pragma unroll
            for (int r = 0; r < 16; ++r) { const float own = D[r] + red[(tl * 16 + r) * 64 + lane] + rb[crow(r, hi)]; const float oth = __shfl_xor(own, 32);
                lv[crow(r, 0)] = hi == 0 ? own : oth; lv[crow(r, 1)] = hi == 0 ? oth : own; }
            float tv[4]; int te[4];
#pragma unroll
            for (int r = 0; r < 4; ++r) { float mx = -INFINITY; int me = 0;
#pragma unroll
                for (int e = 0; e < 32; ++e) { if (lv[e] > mx) { mx = lv[e]; me = e; } }
                tv[r] = mx; te[r] = me;
#pragma unroll
                for (int e = 0; e < 32; ++e) { if (e == me) lv[e] = -INFINITY; } }
            const float e1 = __expf(tv[1] - tv[0]), e2 = __expf(tv[2] - tv[0]), e3 = __expf(tv[3] - tv[0]); const float inv = 1.f / (1.f + e1 + e2 + e3);
            if (hi == 0) { const size_t o = (size_t)tokl * 4;
                const float gv[4] = {inv, e1 * inv, e2 * inv, e3 * inv};
#pragma unroll
                for (int r = 0; r < 4; ++r) { const unsigned rk = __hip_atomic_fetch_add(lcnt + (te[r] & 31), 1u, __ATOMIC_RELAXED, __HIP_MEMORY_SCOPE_WORKGROUP);
                    tope[o + r] = (unsigned)(te[r] & 31); gate[o + r] = gv[r]; rank[o + r] = rk; } } }
        __syncthreads();
        if (tid < 32) __hip_atomic_store(F.ctl + CW_CNT + chunk * 32 + tid, lcnt[tid], RLX_AGENT);
    }
}

DI void ph_route(const Fr& F) {
    unsigned short* srcg = (unsigned short*)(F.ws + WS_SRC);
    const unsigned* tope = (const unsigned*)(F.ws + WS_TOPE); const unsigned* rank = (const unsigned*)(F.ws + WS_RANK); unsigned* dest = (unsigned*)(F.ws + WS_DEST);
    LAS unsigned* P = (LAS unsigned*)(F.lds); LAS unsigned* pst = P + 512; LAS unsigned* pad = P + 544; LAS unsigned* base = P + 576; LAS unsigned* nt = P + 608; LAS unsigned* totl = P + 640;
    const int tid = F.tid;
    __syncthreads();
    { const int e = tid & 31, part = tid >> 5; unsigned s = 0u;
        for (int c = 0; c < 16; ++c) s += ld_u32(F.ctl + CW_CNT + (part * 16 + c) * 32 + e);
        P[part * 32 + e] = s; }
    __syncthreads();
    if (tid < 32) { unsigned tot = 0u;
        for (int p = 0; p < 16; ++p) tot += P[p * 32 + tid];
        totl[tid] = tot; pad[tid] = (tot + 255u) & ~255u; }
    __syncthreads();
    if (tid == 0) { unsigned acc = 0u;
        for (int e = 0; e < 32; ++e) { pst[e] = acc; acc += pad[e]; }
        nt[0] = acc >> 8; }
    __syncthreads();
    if (F.blk < 32) { const int e = F.blk;
        for (unsigned i = totl[e] + tid; i < pad[e]; i += NTHR) srcg[pst[e] + i] = (unsigned short)0; }
    for (int chunk = F.blk; chunk < 256; chunk += F.G) {
        __syncthreads();
        if (tid < 32) { unsigned off = 0u; const int pf = chunk >> 4;
            for (int p = 0; p < pf; ++p) off += P[p * 32 + tid];
            for (int c = pf * 16; c < chunk; ++c) off += ld_u32(F.ctl + CW_CNT + c * 32 + tid);
            base[tid] = pst[tid] + off; }
        __syncthreads();
        { const size_t pi = (size_t)chunk * 512 + tid;
            const unsigned d = base[tope[pi] & 31u] + rank[pi];
            dest[pi] = d; srcg[d] = (unsigned short)(pi >> 2); }
        if (chunk == 0) { const unsigned ntl = nt[0];
            if (tid == 0) __hip_atomic_store(F.ctl + CW_TILE, ntl, RLX_AGENT);
            for (unsigned i = tid; i < ntl; i += NTHR) { unsigned e = 0u;
                for (unsigned k = 1; k < 32; ++k) if (pst[k] <= i * 256u) e = k;
                __hip_atomic_store(F.ctl + CW_TILE + 64 + i, e, RLX_AGENT); } }
    }
}

DI void ph_combine_ln2(const Args& a, const Fr& F, int layer) {
    const bf16* x1 = (const bf16*)(F.ws + WS_X1); const unsigned char* yr = F.ws + WS_XG; bf16* xb = (bf16*)(F.ws + WS_XB);
    const float* gate = (const float*)(F.ws + WS_GATE); const unsigned* dest = (const unsigned*)(F.ws + WS_DEST);
    const float* g = a.in[10] + (size_t)(layer * 2 + 1) * DM; const float* bb = a.in[11] + (size_t)(layer * 2 + 1) * DM;
    const int lane = F.lane; const int gw = F.blk * NWAVES + F.wave, NGW = F.G * NWAVES;
    for (int tok = gw; tok < NTOK; tok += 4 * NGW) { f32x4 v[4][4];
#pragma unroll
        for (int i = 0; i < 4; ++i) { const int tk = tok + i * NGW; if (tk < NTOK) {
#pragma unroll
            for (int jj = 0; jj < 4; ++jj) { const v2u w = *((const v2u*)(x1 + (size_t)tk * DM) + lane + 64 * jj);
                v[i][jj] = (f32x4){bf2f(w.x & 0xffffu), bf2f(w.x >> 16), bf2f(w.y & 0xffffu), bf2f(w.y >> 16)} * ALPHA; }
#pragma unroll
            for (int k = 0; k < 4; ++k) { const float gk = gate[(size_t)tk * 4 + k] * (1.f / F8_SY); const unsigned d = dest[(size_t)tk * 4 + k];
#pragma unroll
                for (int jj = 0; jj < 4; ++jj) { const int w = (int)*((const unsigned*)(yr + (size_t)d * DM) + lane + 64 * jj);
                    const f32x2 lo = __builtin_amdgcn_cvt_pk_f32_fp8(w, false), hi2 = __builtin_amdgcn_cvt_pk_f32_fp8(w, true);
                    v[i][jj][0] += gk * lo[0]; v[i][jj][1] += gk * lo[1]; v[i][jj][2] += gk * hi2[0]; v[i][jj][3] += gk * hi2[1]; } } } }
#pragma unroll
        for (int i = 0; i < 4; ++i) { const int tk = tok + i * NGW; if (tk < NTOK) {
            ln_row(v[i], g, bb, lane);
            if (layer == DEPTH - 1) store_row_f32(a.out + (size_t)tk * DM, v[i], lane);
            else store_row_bf16(xb + (size_t)tk * DM, v[i], lane); } } }
}
constexpr int LDS_BYTES = 147456;
constexpr int LDS_BARW = 145408, LDS_QSLOT = 145472, LDS_TILE_E = 133632, LDS_SRCL = 136192;
constexpr int NPL = 11;
constexpr int NPHASE = 1 + NPL * DEPTH;
#ifndef MK_SINGLE
#define MK_SINGLE 1
#endif
DI int q_next(const Fr& F, unsigned* ctr) {
    LAS int* slot = (LAS int*)(F.lds + LDS_QSLOT);
    __syncthreads();
    if (F.tid == 0) *slot = (int)__hip_atomic_fetch_add(ctr, 1u, RLX_AGENT);
    __syncthreads();
    return *slot;
}
DI int lane_id_fresh() { unsigned m_ = ~0u; asm volatile("" : "+s"(m_)); return (int)__builtin_amdgcn_mbcnt_hi(m_, __builtin_amdgcn_mbcnt_lo(m_, 0u)); }
#define RETID(F) do { int t2_ = F.tid; asm volatile("" : "+v"(t2_)); F.tid = t2_; F.lane = t2_ & 63; F.wave = __builtin_amdgcn_readfirstlane(t2_ >> 6); } while (0)
#ifndef PROBE_DUP
#define PROBE_DUP -1
#endif
#define NREP(q) ((PROBE_DUP == (q)) ? 2 : 1)
#define AS4 __attribute__((address_space(4)))
#define SITE() Args a; Fr F; { const AS4 Args* ap = (const AS4 Args*)__builtin_amdgcn_kernarg_segment_ptr(); asm volatile("" : "+s"(ap)); \
        _Pragma("unroll") for (int i_ = 0; i_ < 18; ++i_) a.in[i_] = ap->in[i_]; a.out = ap->out; a.ws = ap->ws; a.ph_lo = 0; a.ph_hi = 0; \
        int w_ = wv_s; asm volatile("" : "+s"(w_)); int t_ = w_ * 64 + lane_id_fresh(); asm volatile("" : "+v"(t_)); F.tid = t_; F.lane = t_ & 63; F.wave = __builtin_amdgcn_readfirstlane(t_ >> 6); \
        F.lds = (LAS unsigned char*)lds_raw; F.ws = a.ws; F.ctl = (unsigned*)(a.ws + WS_CTL); F.blk = blockIdx.x; F.G = gridDim.x; }
__global__ void __launch_bounds__(NTHR, 2) mega_fwd(Args a0) {
    extern __shared__ __attribute__((aligned(16))) unsigned char lds_raw[];
    const int wv_s = __builtin_amdgcn_readfirstlane((int)(threadIdx.x >> 6));
#if MK_SINGLE
    constexpr int lo = 0, hi = NPHASE; constexpr bool single = true;
#else
    const int lo = a0.ph_lo, hi = a0.ph_hi; constexpr bool single = false;
#endif
    if (threadIdx.x == 0) *(LAS v4u*)((LAS unsigned char*)lds_raw + LDS_BARW) = (v4u){0u, 0u, 0u, 0u};
    __syncthreads();
    if (single) (void)xcd_barrier_post((unsigned*)(a0.ws + WS_CTL) + CW_BAR, (volatile LAS unsigned*)((LAS unsigned char*)lds_raw + LDS_BARW));
#define IN(k) (lo <= (k) && (k) < hi)
#define SEAM() do { if (single) { const AS4 Args* ap_ = (const AS4 Args*)__builtin_amdgcn_kernarg_segment_ptr(); asm volatile("" : "+s"(ap_)); int w_ = wv_s; asm volatile("" : "+s"(w_)); \
        XcdBarrier b_; b_.bar = (unsigned*)(ap_->ws + WS_CTL) + CW_BAR; b_.x = xb_xcc_id(); b_.st = (volatile LAS unsigned*)((LAS unsigned char*)lds_raw + LDS_BARW); \
        xcd_barrier(b_, (w_ == 0) && (lane_id_fresh() == 0)); } } while (0)
    if (IN(0)) { _Pragma("unroll 1") for (int rep = 0; rep < NREP(100); ++rep) { { SITE(); ph_prologue(a, F); } SEAM(); } }
#pragma clang loop unroll(full)
    for (int L = 0; L < DEPTH; ++L) {
        const int pb = 1 + NPL * L, j = L >> 1; const bool odd = (L & 1) != 0;
        if (IN(pb + 0)) _Pragma("unroll 1") for (int rep = 0; rep < NREP(0); ++rep) {
            { SITE();
            const bf16* w = odd ? (const bf16*)(F.ws + WS_WOD) + (size_t)j * OD_N * 1024 : (const bf16*)(F.ws + WS_WEV) + (size_t)j * EV_N * 1024;
            const int N = odd ? OD_N : EV_N;
            pg8::Gemm g{(const bf16*)(F.ws + WS_XB), w, NTOK, N, 1024}; pg8::StaticOrder S; S.init(NTOK, N, F.G, F.blk);
            pg8::EpiBf16<0> E{(bf16*)(F.ws + WS_PROJ), N, nullptr, 1024, (size_t)1024, C2F};
            pg8::gemm_phase<pg8::EpiBf16<0>, pg8::StaticOrder, true, true>(F.lds, g, S, E, F.tid); }
            SEAM(); }
        if (IN(pb + 1)) _Pragma("unroll 1") for (int rep = 0; rep < NREP(1); ++rep) { { SITE(); if (odd) ph_odd_prep(a, F, j, L); else ph_even_prep(a, F, j); } SEAM(); }
        if (!odd && IN(pb + 2)) _Pragma("unroll 1") for (int rep = 0; rep < ((PROBE_DUP == 2 || (PROBE_DUP >= 21 && PROBE_DUP <= 22) || (PROBE_DUP >= 211 && PROBE_DUP <= 217)) ? 2 : 1); ++rep) {
            { SITE(); unsigned* ctr = F.ctl + CW_Q + 64 * (L * 2) + 1024 * rep;
            for (;;) { const int it = q_next(F, ctr); if (it >= 1280) break; RETID(F);
                if (it < 1024) { if (!(rep == 1 && PROBE_DUP == 22)) idx_unit(F, it & 3, 255 - (it >> 2), (rep == 1 && PROBE_DUP >= 211) ? PROBE_DUP - 210 : 0); } else { if (!(rep == 1 && (PROBE_DUP == 21 || PROBE_DUP >= 211))) moba_gate_chunk(F, it - 1024); } } }
            SEAM(); }
        if (IN(pb + 3)) _Pragma("unroll 1") for (int rep = 0; rep < ((PROBE_DUP == 3 || (PROBE_DUP == 31 && odd) || ((PROBE_DUP >= 32 && PROBE_DUP <= 34) && !odd)) ? 2 : 1); ++rep) {
            { SITE(); unsigned* ctr = F.ctl + CW_Q + 64 * (L * 2 + 1) + 1024 * rep;
            if (odd) { for (;;) { const int it = q_next(F, ctr); if (it >= 2048) break; RETID(F); const int bh = it & 63; fox_unit(F, L, bh >> 4, bh & 15, 31 - (it >> 6)); } }
            else { for (;;) { const int it = q_next(F, ctr); if (it >= 2048) break; RETID(F);
                    if (it < 1024) { const int bh = it & 31; if (!(rep == 1 && (PROBE_DUP == 33 || PROBE_DUP == 34))) moba_unit(a, F, bh >> 3, bh & 7, it >> 5); } else { if (!(rep == 1 && PROBE_DUP == 32)) dsa_chunk(a, F, it - 1024); } } } }
            SEAM(); }
        if (!odd && IN(pb + 4)) _Pragma("unroll 1") for (int rep = 0; rep < NREP(4); ++rep) { { SITE(); ph_even_post(F, j); } SEAM(); }
        if (IN(pb + 5)) _Pragma("unroll 1") for (int rep = 0; rep < NREP(5); ++rep) {
            { SITE();
            pg8::Gemm g{(const bf16*)(F.ws + WS_AO), (const bf16*)(F.ws + WS_WOUT) + (size_t)L * 1024 * 1024, NTOK, 1024, 1024}; pg8::StaticOrder S; S.init(NTOK, 1024, F.G, F.blk);
            EpiResBf16 E{(const bf16*)(F.ws + WS_XB), (bf16*)(F.ws + WS_YP), ALPHA};
            pg8::gemm_phase<EpiResBf16, pg8::StaticOrder, true, true>(F.lds, g, S, E, F.tid); }
            SEAM(); }
        if (IN(pb + 6)) _Pragma("unroll 1") for (int rep = 0; rep < NREP(6); ++rep) { { SITE(); ph_ln1_router(a, F, L); } SEAM(); }
        if (IN(pb + 7)) _Pragma("unroll 1") for (int rep = 0; rep < NREP(7); ++rep) { { SITE(); ph_route(F); } SEAM(); }
        if (IN(pb + 8)) _Pragma("unroll 1") for (int rep = 0; rep < NREP(8); ++rep) {
            { SITE(); const int ntl = (int)ld_u32(F.ctl + CW_TILE);
            LAS unsigned* tle = (LAS unsigned*)(F.lds + LDS_TILE_E);
            for (int i = F.tid; i < ntl; i += NTHR) tle[i] = ld_u32(F.ctl + CW_TILE + 64 + i);
            LAS unsigned* srcl = (LAS unsigned*)(F.lds + LDS_SRCL); const unsigned* srcg = (const unsigned*)(F.ws + WS_SRC);
            for (int i = F.tid; i < 17 * 128; i += NTHR) { const int pm = (i >> 7) * 32 + (F.blk & 7) * 4 + (F.blk >> 6); if (pm < ntl) srcl[i] = srcg[(size_t)pm * 128 + (i & 127)]; }
            __syncthreads();
            pg8::Gemm g{(const bf16*)(F.ws + WS_XB8), (const bf16*)(F.ws + WS_WGU + (size_t)L * 32 * 2048 * 1024), NR_MAX, 32 * 2048, 512};
            GroupOrder S{tle, ntl, 3, F.G, F.blk, (LAS const unsigned short*)srcl};
            EpiSwiglu E{F.ws + WS_ACT, a.in[15] + (size_t)L * 32 * 2048};
            pg8::gemm_phase<EpiSwiglu, GroupOrder, true, true, true, true>(F.lds, g, S, E, F.tid); }
            SEAM(); }
        if (IN(pb + 9)) _Pragma("unroll 1") for (int rep = 0; rep < NREP(9); ++rep) {
            { SITE(); const int ntl = (int)ld_u32(F.ctl + CW_TILE);
            LAS unsigned* tle = (LAS unsigned*)(F.lds + LDS_TILE_E);
            for (int i = F.tid; i < ntl; i += NTHR) tle[i] = ld_u32(F.ctl + CW_TILE + 64 + i);
            __syncthreads();
            pg8::Gemm g{(const bf16*)(F.ws + WS_ACT), (const bf16*)(F.ws + WS_WDN + (size_t)L * 32 * 1024 * 1024), NR_MAX, 32 * 1024, 512};
            GroupOrder S{tle, ntl, 2, F.G, F.blk, (LAS const unsigned short*)nullptr};
            EpiDown E{F.ws + WS_XG, a.in[17] + (size_t)L * 32 * 1024};
            pg8::gemm_phase<EpiDown, GroupOrder, true, true, true>(F.lds, g, S, E, F.tid); }
            SEAM(); }
        if (IN(pb + 10)) _Pragma("unroll 1") for (int rep = 0; rep < NREP(10); ++rep) { { SITE(); ph_combine_ln2(a, F, L); } if (L + 1 < DEPTH || rep + 1 < NREP(10)) SEAM(); }
        if (PROBE_DUP == 900 && L + 1 < DEPTH) { _Pragma("unroll 1") for (int xb = 0; xb < 10; ++xb) SEAM(); }
    }
#undef IN
#undef SEAM
}

extern "C" void kernel_launch(void* const* d_in, const int* in_sizes, int n_in, void* d_out, int out_size, void* d_ws, size_t ws_size, hipStream_t stream) {
    static int grid = 0;
    if (grid == 0) {
        if (n_in != 18 || out_size != NTOK * DM || ws_size < WS_END) { fprintf(stderr, "kernel_launch: unexpected shapes (n_in %d, out %d, ws %zu); nothing launched\n", n_in, out_size, ws_size); grid = -1; return; }
        int dev = 0, cus = 0, per_cu = 0;
        if (hipGetDevice(&dev) != hipSuccess || hipDeviceGetAttribute(&cus, hipDeviceAttributeMultiprocessorCount, dev) != hipSuccess) { grid = -1; return; }
        if (hipFuncSetAttribute((const void*)mega_fwd, hipFuncAttributeMaxDynamicSharedMemorySize, LDS_BYTES) != hipSuccess) { fprintf(stderr, "kernel_launch: hipFuncSetAttribute failed\n"); grid = -1; return; }
        if (hipOccupancyMaxActiveBlocksPerMultiprocessor(&per_cu, (const void*)mega_fwd, NTHR, LDS_BYTES) != hipSuccess || per_cu < 1) fprintf(stderr, "kernel_launch: occupancy query reports %d\n", per_cu);
        (void)hipGetLastError();
        if (cus < 256) { fprintf(stderr, "kernel_launch: %d CUs (the gathered gate/up GEMM's unit order assumes the MI355X's 256); nothing launched\n", cus); grid = -1; return; }
        grid = 256;
    }
    if (grid < 0) return;
    (void)hipMemsetAsync((char*)d_ws + WS_CTL, 0, CTL_ZERO_BYTES, stream);
#ifdef EXP_SKIP
    (void)hipMemsetAsync((char*)d_ws + WS_AO, 0, 64 * MiB, stream);
    (void)hipMemsetAsync((char*)d_ws + WS_OL, 0, 64 * MiB, stream);
    if (EXP_SKIP & 4) { (void)hipMemsetAsync((char*)d_ws + WS_XG, 0, 272 * MiB, stream); (void)hipMemsetAsync((char*)d_ws + WS_DEST, 0, 1 * MiB, stream); }
#endif
    Args a{};
    for (int i = 0; i < 18; ++i) a.in[i] = (const float*)d_in[i];
    a.out = (float*)d_out; a.ws = (unsigned char*)d_ws;
#if MK_SINGLE
    a.ph_lo = 0; a.ph_hi = NPHASE;
    hipLaunchKernelGGL(mega_fwd, dim3(grid), dim3(NTHR), LDS_BYTES, stream, a);
#else
    for (int p = 0; p < NPHASE; ++p) {
        if (p > 0) { const int L = (p - 1) / NPL, q = (p - 1) % NPL; if ((L & 1) && (q == 2 || q == 4)) continue;
#ifdef EXP_SKIP
            if ((EXP_SKIP & 1) && !(L & 1) && q <= 4) continue;
            if ((EXP_SKIP & 2) && (L & 1) && q <= 4) continue;
            if ((EXP_SKIP & 4) && q >= 7 && q <= 9) continue;
#endif
        }
        a.ph_lo = p; a.ph_hi = p + 1;
        hipLaunchKernelGGL(mega_fwd, dim3(grid), dim3(NTHR), LDS_BYTES, stream, a);
    }
#endif
}
```

```cpp
#include <hip/hip_runtime.h>
#include <cstdio>
#include <cstdint>
#ifdef EXP_SKIP
#define EXPF EXP_SKIP
#else
#define EXPF 0
#endif
constexpr int NB = 4, SEQ = 8192, DM = 1024, NTOK = NB * SEQ, DEPTH = 4;
constexpr int EV_N = 2560, OD_N = 3072;
constexpr int EC_QA = 0, EC_QB = 512, EC_KB = 1024, EC_VB = 1536, EC_CKV = 2048, EC_QI = 2176, EC_KI = 2432, EC_WI = 2496;
constexpr int OC_Q = 0, OC_K = 1024, OC_V = 2048;
constexpr float LOG2E = 1.4426950408889634f;
constexpr float C2F = 0.125f * LOG2E;
constexpr float ALPHA = 1.681792830507429f;
constexpr float LN_EPS = 1e-5f;
constexpr int NR_MAX = 131072 + 32 * 256;
constexpr int NWAVES = 8, NTHR = 512;
constexpr size_t MiB = (size_t)1 << 20;
constexpr size_t WS_CTL = 0, CTL_ZERO_BYTES = 256 * 1024;
constexpr size_t WS_WEV = 8 * MiB, WS_WOD = 18 * MiB, WS_WOUT = 30 * MiB, WS_WUKT = 38 * MiB, WS_WUVT = 39 * MiB;
constexpr size_t WS_WGU = 40 * MiB, WS_WDN = 552 * MiB;
constexpr size_t WS_X = 808 * MiB, WS_X1 = 936 * MiB, WS_YP = 1064 * MiB, WS_XB = 1192 * MiB;
constexpr size_t WS_PROJ = 1256 * MiB, WS_AO = 1448 * MiB, WS_XG = 1512 * MiB, WS_ACT = 1784 * MiB;
constexpr size_t WS_QL = 2056 * MiB, WS_OL = 2120 * MiB, WS_CKVN = 2184 * MiB, WS_SEL = 2192 * MiB;
constexpr size_t WS_KBAR = 2208 * MiB, WS_SEL3 = 2209 * MiB, WS_LOGF = 2210 * MiB, WS_CS = 2212 * MiB;
constexpr size_t WS_TOPE = 2213 * MiB, WS_GATE = 2214 * MiB, WS_RANK = 2215 * MiB, WS_DEST = 2216 * MiB, WS_PML = 2217 * MiB;
constexpr size_t WS_SRC = WS_DEST + 512 * 1024;
constexpr size_t WS_XB8 = 2226 * MiB;
constexpr size_t WS_KIC = 2258 * MiB;
constexpr size_t WS_END = 2262 * MiB;
constexpr float F8_SX = 16.f, F8_SWG = 256.f, F8_SA = 4.f, F8_SWD = 512.f, F8_SY = 32.f;
constexpr int CW_BAR = 4096, CW_Q = 8192, CW_KMAX = 12288, CW_CNT = 16384, CW_TILE = 32768;

#define GAS __attribute__((address_space(1)))
#define LAS __attribute__((address_space(3)))
#define DI __device__ __forceinline__
typedef unsigned short bf16;
typedef unsigned v4u __attribute__((ext_vector_type(4)));
typedef unsigned v2u __attribute__((ext_vector_type(2)));
typedef float f32x4 __attribute__((ext_vector_type(4)));
typedef float f32x2 __attribute__((ext_vector_type(2)));
typedef float f32x16 __attribute__((ext_vector_type(16)));
typedef short bf16x8 __attribute__((ext_vector_type(8)));
typedef short s16x4 __attribute__((ext_vector_type(4)));
typedef __bf16 bf16x2_t __attribute__((ext_vector_type(2)));
typedef GAS unsigned gu32;
#define RLX_AGENT __ATOMIC_RELAXED, __HIP_MEMORY_SCOPE_AGENT
#define LDS_WAIT() asm volatile("s_waitcnt lgkmcnt(0)" ::: "memory")

DI float bf2f(unsigned v) { return __uint_as_float(v << 16); }
DI unsigned cvtpk(float lo, float hi) { f32x2 v = {lo, hi}; bf16x2_t b = __builtin_convertvector(v, bf16x2_t); return __builtin_bit_cast(unsigned, b); }
DI unsigned f2bf(float f) { return cvtpk(f, 0.f) & 0xffffu; }
DI unsigned pk4_fp8(float a, float b, float c, float d) {
    a = fminf(fmaxf(a, -448.f), 448.f); b = fminf(fmaxf(b, -448.f), 448.f); c = fminf(fmaxf(c, -448.f), 448.f); d = fminf(fmaxf(d, -448.f), 448.f);
    int w = 0; w = __builtin_amdgcn_cvt_pk_fp8_f32(a, b, w, false); w = __builtin_amdgcn_cvt_pk_fp8_f32(c, d, w, true); return (unsigned)w; }
DI float ex2(float x) { return __builtin_amdgcn_exp2f(x); }
DI float wave_sum(float v) {
#pragma unroll
    for (int o = 1; o < 64; o <<= 1) v += __shfl_xor(v, o);
    return v;
}
DI float wave_max(float v) {
#pragma unroll
    for (int o = 1; o < 64; o <<= 1) v = fmaxf(v, __shfl_xor(v, o));
    return v;
}
DI unsigned ld_u32(const unsigned* p) { return __hip_atomic_load(p, RLX_AGENT); }
DI int crow(int r, int hi) { return (r & 3) + 8 * (r >> 2) + 4 * hi; }
DI f32x16 mfma32(bf16x8 a, bf16x8 b, f32x16 c) { return __builtin_amdgcn_mfma_f32_32x32x16_bf16(a, b, c, 0, 0, 0); }
DI f32x4 mfma16(bf16x8 a, bf16x8 b, f32x4 c) { return __builtin_amdgcn_mfma_f32_16x16x32_bf16(a, b, c, 0, 0, 0); }
typedef short v4i16_t __attribute__((ext_vector_type(4)));
DI s16x4 vtr(LAS const char* p) { return __builtin_bit_cast(s16x4, __builtin_amdgcn_ds_read_tr16_b64_v4i16((LAS v4i16_t*)p)); }
DI bf16x8 cat8(s16x4 a, s16x4 b) { return (bf16x8){a[0], a[1], a[2], a[3], b[0], b[1], b[2], b[3]}; }
DI int t5_bucket(int n) {
    if (n < 16) return n;
    int bkt = 16;
    bkt += (n >= 21); bkt += (n >= 27); bkt += (n >= 35); bkt += (n >= 46); bkt += (n >= 59); bkt += (n >= 77); bkt += (n >= 99); bkt += (n >= 128);
    bkt += (n >= 166); bkt += (n >= 216); bkt += (n >= 280); bkt += (n >= 363); bkt += (n >= 470); bkt += (n >= 609); bkt += (n >= 790);
    return bkt;
}
namespace pg8 {
#define PG8_LAS __attribute__((address_space(3)))
typedef unsigned short bf16_t;
typedef short bf16x8 __attribute__((ext_vector_type(8)));
typedef float f32x4 __attribute__((ext_vector_type(4)));
typedef unsigned u32x4 __attribute__((ext_vector_type(4)));
constexpr int BM = 256, BK = 64, HALF = 128, HTB = HALF * BK * 2  , STAGE_BYTES = 8 * HTB, NXCD = 8, WGM = 8;

__host__ __device__ __forceinline__ int lds_byte(int r, int c) { const int st = (r >> 4) * 2 + (c >> 5), rr = r & 15, cc = c & 31, ob = rr * 64 + cc * 2; return st * 1024 + (ob ^ (((ob >> 9) & 1) << 5)); }
__host__ __device__ __forceinline__ void stage_rc(int b, int& R, int& C) { const int st = b / 1024, sb = b % 1024, swz = sb ^ (((sb >> 9) & 1) << 5); R = (st >> 1) * 16 + swz / 64; C = (st & 1) * 32 + (swz % 64) / 2; }
__host__ __device__ __forceinline__ int perm32(int rho) { const int n = rho >> 4, i = rho & 15; return 8 * (i >> 2) + 4 * n + (i & 3); }

typedef int i32x8 __attribute__((ext_vector_type(8))); typedef int i32x4v __attribute__((ext_vector_type(4)));
__device__ __forceinline__ i32x8 pg8_cat8(bf16x8 lo, bf16x8 hi) { const i32x4v a = __builtin_bit_cast(i32x4v, lo), b = __builtin_bit_cast(i32x4v, hi); return (i32x8){a[0], a[1], a[2], a[3], b[0], b[1], b[2], b[3]}; }
struct Unit { int pm, pn; };
struct Gemm { const bf16_t* A; const bf16_t* Bt; int M, N, K; };

struct StaticOrder {
    int nM, nN, nwg, G, c;
    __host__ __device__ void init(int M, int N, int G_, int c_) { nM = M / BM; nN = N / BM; nwg = nM * nN; G = G_; c = c_; }
    __host__ __device__ bool next(int i, Unit& u) const {
        const long L = (long)i * G + c; if (L >= nwg) return false;
        int wgid = (int)L; { const int q = nwg / NXCD, r = nwg % NXCD, xcd = wgid % NXCD, off = wgid / NXCD; wgid = (xcd < r ? xcd * (q + 1) : r * (q + 1) + (xcd - r) * q) + off; }
        const int nig = WGM * nN, gid = wgid / nig, fm = gid * WGM, gsz = (nM - fm) < WGM ? (nM - fm) : WGM;
        u.pm = fm + ((wgid % nig) % gsz); u.pn = (wgid % nig) / gsz; return true;
    }
    __device__ __forceinline__ void a_ready(const Unit&) const {}
    __device__ __forceinline__ void done(const Unit&) const {}
};

__device__ __forceinline__ unsigned cvt_pk_bf16(float lo, float hi) { unsigned r; asm volatile("v_cvt_pk_bf16_f32 %0, %1, %2" : "=v"(r) : "v"(lo), "v"(hi)); return r; }
typedef float f32x2 __attribute__((ext_vector_type(2)));
__device__ __forceinline__ f32x2 gelu_pk(f32x2 v) {
    const f32x2 av = __builtin_elementwise_abs(v), d = av * 0.2316418882f + 1.0f;
    f32x2 t; t.x = __builtin_amdgcn_rcpf(d.x); t.y = __builtin_amdgcn_rcpf(d.y);
    f32x2 q = t * 0.5307027145f + (-0.7265760135f); q = q * t + 0.7107068705f; q = q * t + (-0.142248368f); q = q * t + 0.127414796f; q = q * t;
    const f32x2 s = (v * v) * (-0.72134752044f);
    f32x2 e; e.x = __builtin_amdgcn_exp2f(s.x); e.y = __builtin_amdgcn_exp2f(s.y);
    const f32x2 m = v * (q * e), r = v - m;
    f32x2 o; o.x = v.x < 0.f ? m.x : r.x; o.y = v.y < 0.f ? m.y : r.y; return o;
}

template <int ACT  > struct EpiBf16 {
    static constexpr bool PERM = true, AFTER_DRAIN = false; static_assert(ACT == 0 || ACT == 1, "EpiBf16: ACT is 0 (none) or 1 (gelu_pk)");
    bf16_t* O; int ldc; const float* bias; int split_cols; size_t split_stride; float scale0;
    __device__ __forceinline__ void operator()(const f32x4 (&acc)[2][2][4][2], const Unit& u, int wr, int wc, int fr, int fq) const {
        const int row0 = u.pm * BM + wr * 64 + fr; int colt = u.pn * BM; bf16_t* base = O;
        float sc = 1.f; if (split_cols) { const int t = colt / split_cols; base += (size_t)t * split_stride; colt -= t * split_cols; if (t == 0) sc = scale0; }
        const int col0 = colt + wc * 32 + 8 * fq, bcol0 = u.pn * BM + wc * 32 + 8 * fq;
        f32x4 bv[2][2];
#pragma unroll
        for (int bj = 0; bj < 2; ++bj)
#pragma unroll
            for (int n = 0; n < 2; ++n) bv[bj][n] = bias ? *(const f32x4*)(bias + bcol0 + bj * HALF + 4 * n) : (f32x4){0.f, 0.f, 0.f, 0.f};
#pragma unroll
        for (int ai = 0; ai < 2; ++ai)
#pragma unroll
            for (int m = 0; m < 4; ++m) { bf16_t* rowp = base + (size_t)(row0 + ai * HALF + m * 16) * ldc + col0;
#pragma unroll
                for (int bj = 0; bj < 2; ++bj) { f32x4 v0 = acc[ai][bj][m][0] + bv[bj][0], v1 = acc[ai][bj][m][1] + bv[bj][1];
                    if (ACT == 1) { f32x2 a = gelu_pk((f32x2){v0[0], v0[1]}), b = gelu_pk((f32x2){v0[2], v0[3]}), c = gelu_pk((f32x2){v1[0], v1[1]}), d = gelu_pk((f32x2){v1[2], v1[3]});
                        v0 = (f32x4){a.x, a.y, b.x, b.y}; v1 = (f32x4){c.x, c.y, d.x, d.y}; }
                    v0 = v0 * sc; v1 = v1 * sc; u32x4 w; w.x = cvt_pk_bf16(v0[0], v0[1]); w.y = cvt_pk_bf16(v0[2], v0[3]); w.z = cvt_pk_bf16(v1[0], v1[1]); w.w = cvt_pk_bf16(v1[2], v1[3]);
                    *(u32x4*)(rowp + bj * HALF) = w; } }
    }
};

template <class Epi, class Sched, bool ALIGN_EPI = false, bool SP2 = false, bool F8 = false, bool GATH = false  >
__device__ __forceinline__ void gemm_phase(PG8_LAS unsigned char* lds, const Gemm g, const Sched& S, const Epi& E, int tid_in) {
    int tid_l = tid_in; asm volatile("" : "+v"(tid_l));
    const int tid = tid_l, wid = __builtin_amdgcn_readfirstlane(tid >> 6), lane = tid & 63, wr = wid >> 2, wc = wid & 3, fr = lane & 15, fq = lane >> 4;
    const int K = g.K, nt = K / BK;
    unsigned voffA[2], voffB[2]; int rowA[2]; unsigned colA[2];
#pragma unroll
    for (int i = 0; i < 2; ++i) { int R, C; stage_rc(tid * 16 + i * 8192, R, C); const int Rb = Epi::PERM ? ((R & ~31) + perm32(R & 31)) : R;
        voffA[i] = (unsigned)(R * K + C) * 2u; voffB[i] = (unsigned)(Rb * K + C) * 2u; rowA[i] = R; colA[i] = (unsigned)C * 2u; }
    static_assert(!GATH || SP2, "GATH: SP2 schedule only");
    unsigned cgo[2][2], ngo[2][2];
#define PG8_GOFF(dst, uidx) do { _Pragma("unroll") for (int _h = 0; _h < 2; ++_h) _Pragma("unroll") for (int _i = 0; _i < 2; ++_i) dst[_h][_i] = S.gsrc((uidx), _h * HALF + rowA[_i]) + colA[_i]; } while (0)
#define PG8_STAGE_G(bufoff, kb, o0, o1) do { \
        __builtin_amdgcn_global_load_lds((const unsigned*)((const char*)g.A + (kb) + (o0)), (PG8_LAS unsigned*)(lds + (bufoff) + ldsw), 16, 0, 0); \
        __builtin_amdgcn_global_load_lds((const unsigned*)((const char*)g.A + (kb) + (o1)), (PG8_LAS unsigned*)(lds + (bufoff) + ldsw + 8192), 16, 0, 0); } while (0)
    const size_t kstep = (size_t)(BK * 2);
    const size_t hstep = (size_t)HALF * K * 2;
    const size_t tstep = 2 * hstep;
    const unsigned ldsw = (unsigned)wid * 1024u;
    const int aoff = lds_byte(wr * 64 + fr, fq * 8), boff = lds_byte(wc * 32 + fr, fq * 8);
#define PG8_SA(b, h) (((b) * 2 + (h)) * HTB)
#define PG8_SB(b, h) ((4 + (b) * 2 + (h)) * HTB)
#define PG8_STAGE(bufoff, gbase, voff) do { _Pragma("unroll") for (int _i = 0; _i < 2; ++_i) \
        __builtin_amdgcn_global_load_lds((const unsigned*)((const char*)(gbase) + (voff)[_i]), (PG8_LAS unsigned*)(lds + (bufoff) + ldsw + _i * 8192), 16, 0, 0); } while (0)
#define PG8_LDA(dst, b, h) do { _Pragma("unroll") for (int m = 0; m < 4; ++m) _Pragma("unroll") for (int k = 0; k < 2; ++k) dst[m][k] = *(const PG8_LAS bf16x8*)(lds + PG8_SA(b, h) + aoff + m * 2048 + k * 1024); } while (0)
#define PG8_LDB(dst, b, h) do { _Pragma("unroll") for (int n = 0; n < 2; ++n) _Pragma("unroll") for (int k = 0; k < 2; ++k) dst[n][k] = *(const PG8_LAS bf16x8*)(lds + PG8_SB(b, h) + boff + n * 2048 + k * 1024); } while (0)
#define PG8_MMA(ai, bj, At, Bt) do { __builtin_amdgcn_s_setprio(1); if constexpr (!F8) { _Pragma("unroll") for (int m = 0; m < 4; ++m) _Pragma("unroll") for (int n = 0; n < 2; ++n) _Pragma("unroll") for (int k = 0; k < 2; ++k) \
        acc[ai][bj][m][n] = __builtin_amdgcn_mfma_f32_16x16x32_bf16(Bt[n][k], At[m][k], acc[ai][bj][m][n], 0, 0, 0); } else { _Pragma("unroll") for (int m = 0; m < 4; ++m) _Pragma("unroll") for (int n = 0; n < 2; ++n) \
        acc[ai][bj][m][n] = __builtin_amdgcn_mfma_scale_f32_16x16x128_f8f6f4(pg8_cat8(Bt[n][0], Bt[n][1]), pg8_cat8(At[m][0], At[m][1]), acc[ai][bj][m][n], 0, 0, 0, 0x7F7F7F7F, 0, 0x7F7F7F7F); \
        _Pragma("unroll") for (int m = 0; m < 4; ++m) _Pragma("unroll") for (int n = 0; n < 2; ++n) asm volatile("" : "+v"(acc[ai][bj][m][n]));   } __builtin_amdgcn_s_setprio(0); } while (0)
#define PG8_WAIT_V(n) asm volatile("s_waitcnt vmcnt(" #n ")" ::: "memory")
#define PG8_WAIT_L(n) asm volatile("s_waitcnt lgkmcnt(" #n ")" ::: "memory")
#define PG8_BAR __builtin_amdgcn_s_barrier()
#define PG8_SCHED __builtin_amdgcn_sched_barrier(0)
    Unit cur, nxt; int ui = 0;
    if (!S.next(0, cur)) return;
    f32x4 acc[2][2][4][2];
#pragma unroll
    for (int a = 0; a < 2; ++a)
#pragma unroll
        for (int b = 0; b < 2; ++b)
#pragma unroll
            for (int m = 0; m < 4; ++m)
#pragma unroll
                for (int n = 0; n < 2; ++n) acc[a][b][m][n] = (f32x4){0.f, 0.f, 0.f, 0.f};
    bf16x8 At[4][2], B0[2][2], B1[2][2];
    const char* cA = (const char*)g.A + (size_t)cur.pm * tstep; const char* cB = (const char*)g.Bt + (size_t)cur.pn * tstep;
    S.a_ready(cur);
    if constexpr (SP2) {
        if constexpr (GATH) { PG8_GOFF(cgo, 0); }
        PG8_STAGE(PG8_SB(0, 0), cB, voffB); PG8_STAGE(PG8_SB(0, 1), cB + hstep, voffB);
        if constexpr (GATH) { PG8_STAGE_G(PG8_SA(0, 0), 0, cgo[0][0], cgo[0][1]); PG8_STAGE_G(PG8_SA(0, 1), 0, cgo[1][0], cgo[1][1]); }
        else { PG8_STAGE(PG8_SA(0, 0), cA, voffA); PG8_STAGE(PG8_SA(0, 1), cA + hstep, voffA); }
        if (wr == 1) PG8_BAR;
        PG8_WAIT_V(2); PG8_BAR;
        PG8_STAGE(PG8_SB(1, 0), cB + kstep, voffB);
        if constexpr (GATH) { PG8_STAGE_G(PG8_SA(1, 0), kstep, cgo[0][0], cgo[0][1]); } else { PG8_STAGE(PG8_SA(1, 0), cA + kstep, voffA); }
        PG8_STAGE(PG8_SB(1, 1), cB + hstep + kstep, voffB);
        PG8_WAIT_V(6); PG8_BAR;
    } else {
        PG8_STAGE(PG8_SB(0, 0), cB, voffB); PG8_STAGE(PG8_SA(0, 0), cA, voffA); PG8_STAGE(PG8_SB(0, 1), cB + hstep, voffB); PG8_STAGE(PG8_SA(0, 1), cA + hstep, voffA);
        if (wr == 1) PG8_BAR;
        PG8_WAIT_V(4); PG8_BAR;
        PG8_STAGE(PG8_SB(1, 0), cB + kstep, voffB); PG8_STAGE(PG8_SA(1, 0), cA + kstep, voffA); PG8_STAGE(PG8_SB(1, 1), cB + hstep + kstep, voffB);
        PG8_WAIT_V(6); PG8_BAR;
    }
    for (;;) {
        const bool has_next = S.next(ui + 1, nxt);
        if constexpr (GATH) { if (has_next) { PG8_GOFF(ngo, ui + 1); } else {
            _Pragma("unroll") for (int _h = 0; _h < 2; ++_h) _Pragma("unroll") for (int _i = 0; _i < 2; ++_i) ngo[_h][_i] = cgo[_h][_i]; } }
        const char* nA = has_next ? (const char*)g.A + (size_t)nxt.pm * tstep : cA; const char* nB = has_next ? (const char*)g.Bt + (size_t)nxt.pn * tstep : cB;
        for (int t = 0; t < nt; t += 2) {
            const bool last = (t == nt - 2);
            const char* a1 = cA + (size_t)(t + 1) * kstep;
            const char* a2 = last ? nA : cA + (size_t)(t + 2) * kstep; const char* b2 = last ? nB : cB + (size_t)(t + 2) * kstep;
            const char* a3 = a2 + kstep; const char* b3 = b2 + kstep;
            if (last && has_next) S.a_ready(nxt);
            unsigned g0a = 0, g0b = 0, g1a = 0, g1b = 0; size_t kb2 = 0;
            if constexpr (GATH) { g0a = last ? ngo[0][0] : cgo[0][0]; g0b = last ? ngo[0][1] : cgo[0][1]; g1a = last ? ngo[1][0] : cgo[1][0]; g1b = last ? ngo[1][1] : cgo[1][1]; kb2 = last ? (size_t)0 : (size_t)(t + 2) * kstep; }
            if constexpr (SP2) {
            PG8_LDB(B0, 0, 0); PG8_LDB(B1, 0, 1); PG8_SCHED; PG8_LDA(At, 0, 0);
            if constexpr (GATH) { PG8_STAGE_G(PG8_SA(1, 1), (size_t)(t + 1) * kstep, cgo[1][0], cgo[1][1]); } else { PG8_STAGE(PG8_SA(1, 1), a1 + hstep, voffA); }
            PG8_WAIT_V(8); PG8_WAIT_L(0); PG8_BAR; PG8_MMA(0, 0, At, B0); PG8_MMA(0, 1, At, B1); PG8_BAR; PG8_SCHED;
            PG8_LDA(At, 0, 1); PG8_STAGE(PG8_SB(0, 0), b2, voffB); PG8_STAGE(PG8_SB(0, 1), b2 + hstep, voffB);
            if constexpr (GATH) { PG8_STAGE_G(PG8_SA(0, 0), kb2, g0a, g0b); } else { PG8_STAGE(PG8_SA(0, 0), a2, voffA); }
            PG8_WAIT_V(8); PG8_WAIT_L(0); PG8_BAR; PG8_MMA(1, 0, At, B0); PG8_MMA(1, 1, At, B1); PG8_BAR; PG8_SCHED;
            PG8_LDB(B0, 1, 0); PG8_LDB(B1, 1, 1); PG8_SCHED; PG8_LDA(At, 1, 0);
            if constexpr (GATH) { PG8_STAGE_G(PG8_SA(0, 1), kb2, g1a, g1b); } else { PG8_STAGE(PG8_SA(0, 1), a2 + hstep, voffA); }
            PG8_WAIT_V(8); PG8_WAIT_L(0); PG8_BAR; PG8_MMA(0, 0, At, B0); PG8_MMA(0, 1, At, B1); PG8_BAR; PG8_SCHED;
            PG8_LDA(At, 1, 1); PG8_STAGE(PG8_SB(1, 0), b3, voffB); PG8_STAGE(PG8_SB(1, 1), b3 + hstep, voffB);
            if constexpr (GATH) { PG8_STAGE_G(PG8_SA(1, 0), kb2 + kstep, g0a, g0b); } else { PG8_STAGE(PG8_SA(1, 0), a3, voffA); }
            PG8_WAIT_V(8); PG8_WAIT_L(0); PG8_BAR; PG8_MMA(1, 0, At, B0); PG8_MMA(1, 1, At, B1); PG8_BAR; PG8_SCHED;
            } else {
            PG8_LDB(B0, 0, 0); PG8_SCHED; PG8_LDA(At, 0, 0); PG8_STAGE(PG8_SA(1, 1), a1 + hstep, voffA);
            PG8_WAIT_L(8); PG8_BAR; PG8_WAIT_L(0); PG8_MMA(0, 0, At, B0); PG8_BAR; PG8_SCHED;
            PG8_LDB(B1, 0, 1); PG8_STAGE(PG8_SB(0, 0), b2, voffB);
            PG8_BAR; PG8_WAIT_L(0); PG8_MMA(0, 1, At, B1); PG8_BAR;
            PG8_LDA(At, 0, 1); PG8_STAGE(PG8_SA(0, 0), a2, voffA);
            PG8_BAR; PG8_WAIT_L(0); PG8_MMA(1, 0, At, B0); PG8_BAR; PG8_SCHED;
            PG8_STAGE(PG8_SB(0, 1), b2 + hstep, voffB);
            PG8_WAIT_V(6); PG8_BAR; PG8_MMA(1, 1, At, B1); PG8_BAR;
            PG8_LDB(B0, 1, 0); PG8_SCHED; PG8_LDA(At, 1, 0); PG8_STAGE(PG8_SA(0, 1), a2 + hstep, voffA);
            PG8_WAIT_L(8); PG8_BAR; PG8_WAIT_L(0); PG8_MMA(0, 0, At, B0); PG8_BAR; PG8_SCHED;
            PG8_LDB(B1, 1, 1); PG8_STAGE(PG8_SB(1, 0), b3, voffB);
            PG8_BAR; PG8_WAIT_L(0); PG8_MMA(0, 1, At, B1); PG8_BAR;
            PG8_LDA(At, 1, 1); PG8_STAGE(PG8_SA(1, 0), a3, voffA);
            PG8_BAR; PG8_WAIT_L(0); PG8_MMA(1, 0, At, B0); PG8_BAR; PG8_SCHED;
            PG8_STAGE(PG8_SB(1, 1), b3 + hstep, voffB);
            PG8_WAIT_V(6); PG8_BAR; PG8_MMA(1, 1, At, B1); PG8_BAR;
            }
        }
        if constexpr (ALIGN_EPI) { if (wr == 0) PG8_BAR; }
        if constexpr (!Epi::AFTER_DRAIN) { E(acc, cur, wr, wc, fr, fq); S.done(cur); }
        if (!has_next) break;
#pragma unroll
        for (int a = 0; a < 2; ++a)
#pragma unroll
            for (int b = 0; b < 2; ++b)
#pragma unroll
                for (int m = 0; m < 4; ++m)
#pragma unroll
                    for (int n = 0; n < 2; ++n) acc[a][b][m][n] = (f32x4){0.f, 0.f, 0.f, 0.f};
        cur = nxt; cA = nA; cB = nB; ++ui;
        if constexpr (GATH) { _Pragma("unroll") for (int _h = 0; _h < 2; ++_h) _Pragma("unroll") for (int _i = 0; _i < 2; ++_i) cgo[_h][_i] = ngo[_h][_i]; }
        if constexpr (ALIGN_EPI) { if (wr == 1) PG8_BAR; }
    }
    PG8_WAIT_V(0);
    if constexpr (!ALIGN_EPI) { if (wr == 0) PG8_BAR; }
    PG8_BAR;
    if constexpr (Epi::AFTER_DRAIN) { E.fused(acc, cur, wr, wc, fr, fq, lds, wid, lane); S.done(cur); }
#undef PG8_SA
#undef PG8_SB
#undef PG8_STAGE
#undef PG8_STAGE_G
#undef PG8_GOFF
#undef PG8_LDA
#undef PG8_LDB
#undef PG8_MMA
#undef PG8_WAIT_V
#undef PG8_WAIT_L
#undef PG8_BAR
#undef PG8_SCHED
}
}

#ifndef PG8_SP2
#define PG8_SP2 true
#endif
#ifndef PG8_ALIGN
#define PG8_ALIGN true
#endif
#define XB_TMO      128
#define XB_XCNT(j)  (256  + 64 * (j))
#define XB_XSUB(j)  (1280 + 64 * (j))
#define XB_XGEN(j)  (2304 + 64 * (j))
#define XB_TOP      3328
#define XB_TOPGEN   3392
#define XCD_BAR_WORDS 3456
#define XB_SPIN_CAP (1u << 18)

__device__ __forceinline__ unsigned xb_ld(unsigned* p)              { return __hip_atomic_load(p, __ATOMIC_RELAXED, __HIP_MEMORY_SCOPE_AGENT); }
__device__ __forceinline__ unsigned xb_add(unsigned* p, unsigned v) { return __hip_atomic_fetch_add(p, v, __ATOMIC_RELAXED, __HIP_MEMORY_SCOPE_AGENT); }
__device__ __forceinline__ unsigned xb_xcc_id() { return (unsigned)__builtin_amdgcn_s_getreg((3 << 11) | 20) & 0xFu; }
#define XB_SPIN(cond, bar) do { unsigned _sp = 0; while (cond) { __builtin_amdgcn_s_sleep(1); \
    if ((++_sp & 255u) == 0u) { if (xb_ld(&(bar)[XB_TMO])) break; if (_sp > XB_SPIN_CAP) { atomicAdd(&(bar)[XB_TMO], 1u); break; } } } } while (0)

struct XcdBarrier {
    unsigned* bar; unsigned x;
    volatile LAS unsigned* st;
};

__device__ __forceinline__ XcdBarrier xcd_barrier_post(unsigned* bar, volatile LAS unsigned* st) {
    XcdBarrier b; b.bar = bar; b.x = xb_xcc_id(); b.st = st;
    if (threadIdx.x == 0) (void)xb_add(&bar[XB_XCNT(b.x)], 1u);
    return b;
}
__device__ __forceinline__ void xcd_barrier_complete(unsigned* bar, unsigned x, unsigned& nloc, unsigned& nx) {
    const unsigned G = gridDim.x * gridDim.y * gridDim.z;
    unsigned sum, cnt, mine, sp = 0u;
    for (;;) {
        sum = 0u; cnt = 0u; mine = 0u;
#pragma unroll
        for (unsigned j = 0; j < 16; ++j) { const unsigned c = xb_ld(&bar[XB_XCNT(j)]); sum += c; cnt += (c > 0u) ? 1u : 0u; mine = (j == x) ? c : mine; }
        if (sum == G) break;
        __builtin_amdgcn_s_sleep(1);
        if ((++sp & 255u) == 0u) { if (xb_ld(&bar[XB_TMO])) break; if (sp > XB_SPIN_CAP) { atomicAdd(&bar[XB_TMO], 1u); break; } }
    }
    nloc = mine > 0u ? mine : 1u; nx = cnt > 0u ? cnt : 1u;
}

__device__ __forceinline__ void xcd_barrier(const XcdBarrier& b, const bool is_t0  ) {
    asm volatile("s_waitcnt vmcnt(0)" ::: "memory");
    __syncthreads();
    if (is_t0) {
        unsigned* bar = b.bar;
        __builtin_amdgcn_s_waitcnt(0);
        unsigned nloc = b.st[0], nx = b.st[1];
        if (nloc == 0u) { xcd_barrier_complete(bar, b.x, nloc, nx); b.st[0] = nloc; b.st[1] = nx; }
        const unsigned old = xb_add(&bar[XB_XSUB(b.x)], 1u);
        const unsigned gen = old / nloc;
        if (old + 1u == (gen + 1u) * nloc) {
            __builtin_amdgcn_fence(__ATOMIC_RELEASE, "agent");
            asm volatile("s_waitcnt vmcnt(0)" ::: "memory");
            const unsigned og = xb_add(&bar[XB_TOP], 1u);
            const unsigned tg = og / nx;
            if (og + 1u == (tg + 1u) * nx) xb_add(&bar[XB_TOPGEN], 1u);
            else XB_SPIN(xb_ld(&bar[XB_TOPGEN]) == tg, bar);
            __builtin_amdgcn_fence(__ATOMIC_ACQUIRE, "agent");
            xb_add(&bar[XB_XGEN(b.x)], 1u);
            asm volatile("s_waitcnt vmcnt(0)" ::: "memory");
        } else {
            XB_SPIN(xb_ld(&bar[XB_XGEN(b.x)]) == gen, bar);
            __builtin_amdgcn_fence(__ATOMIC_ACQUIRE, "agent");
            asm volatile("s_waitcnt vmcnt(0)" ::: "memory");
        }
    }
    __syncthreads();
}
struct EpiResBf16 {
    static constexpr bool PERM = true, AFTER_DRAIN = false;
    const bf16* xin; bf16* yp; float alpha;
    DI void operator()(const pg8::f32x4 (&acc)[2][2][4][2], const pg8::Unit& u, int wr, int wc, int fr, int fq) const {
        const int row0 = u.pm * 256 + wr * 64 + fr, col0 = u.pn * 256 + wc * 32 + 8 * fq;
#pragma unroll
        for (int ai = 0; ai < 2; ++ai)
#pragma unroll
            for (int m = 0; m < 4; ++m) {
                const size_t ro = (size_t)(row0 + ai * 128 + m * 16) * DM;
#pragma unroll
                for (int bj = 0; bj < 2; ++bj) {
                    const size_t o = ro + col0 + bj * 128;
                    const v4u xv = *(const v4u*)(xin + o);
                    const f32x4 a0 = acc[ai][bj][m][0], a1 = acc[ai][bj][m][1];
                    v4u w;
                    w.x = cvtpk(bf2f(xv.x & 0xffffu) * alpha + a0[0], bf2f(xv.x >> 16) * alpha + a0[1]); w.y = cvtpk(bf2f(xv.y & 0xffffu) * alpha + a0[2], bf2f(xv.y >> 16) * alpha + a0[3]);
                    w.z = cvtpk(bf2f(xv.z & 0xffffu) * alpha + a1[0], bf2f(xv.z >> 16) * alpha + a1[1]); w.w = cvtpk(bf2f(xv.w & 0xffffu) * alpha + a1[2], bf2f(xv.w >> 16) * alpha + a1[3]);
                    *(v4u*)(yp + o) = w;
                }
            }
    }
};
struct EpiSwiglu {
    static constexpr bool PERM = true, AFTER_DRAIN = false;
    unsigned char* act; const float* bgu;
    DI void operator()(const pg8::f32x4 (&acc)[2][2][4][2], const pg8::Unit& u, int wr, int wc, int fr, int fq) const {
        const int e = u.pn >> 3, pl = u.pn & 7;
        const int row0 = u.pm * 256 + wr * 64 + fr, cih = pl * 128 + wc * 32 + 8 * fq;
        const float* bg = bgu + e * 2048 + cih;
        const f32x4 bg0 = *(const f32x4*)(bg), bg1 = *(const f32x4*)(bg + 4), bu0 = *(const f32x4*)(bg + 1024), bu1 = *(const f32x4*)(bg + 1028);
#pragma unroll
        for (int ai = 0; ai < 2; ++ai)
#pragma unroll
            for (int m = 0; m < 4; ++m) {
                constexpr float RS = 1.f / (F8_SX * F8_SWG);
                const f32x4 g0 = acc[ai][0][m][0] * RS + bg0, g1 = acc[ai][0][m][1] * RS + bg1, u0 = acc[ai][1][m][0] * RS + bu0, u1 = acc[ai][1][m][1] * RS + bu1;
                float r[8];
#pragma unroll
                for (int i = 0; i < 8; ++i) {
                    float g = i < 4 ? g0[i & 3] : g1[i & 3], uu = i < 4 ? u0[i & 3] : u1[i & 3];
                    g = fminf(g, 7.0f); uu = fminf(fmaxf(uu, -7.0f), 7.0f);
                    const float sg = __builtin_amdgcn_rcpf(1.0f + ex2(-1.702f * LOG2E * g));
                    r[i] = (uu + 1.0f) * g * sg * F8_SA;
                }
                v2u w; w.x = pk4_fp8(r[0], r[1], r[2], r[3]); w.y = pk4_fp8(r[4], r[5], r[6], r[7]);
                *(v2u*)(act + (size_t)(row0 + ai * 128 + m * 16) * DM + cih) = w;
            }
    }
};
struct EpiDown {
    static constexpr bool PERM = true, AFTER_DRAIN = false;
    unsigned char* yr; const float* bdn;
    DI void operator()(const pg8::f32x4 (&acc)[2][2][4][2], const pg8::Unit& u, int wr, int wc, int fr, int fq) const {
        const int e = u.pn >> 2, pl = u.pn & 3;
        const int row0 = u.pm * 256 + wr * 64 + fr, col0 = pl * 256 + wc * 32 + 8 * fq;
        f32x4 bv[2][2];
#pragma unroll
        for (int bj = 0; bj < 2; ++bj) { bv[bj][0] = *(const f32x4*)(bdn + e * 1024 + col0 + bj * 128) * F8_SY; bv[bj][1] = *(const f32x4*)(bdn + e * 1024 + col0 + bj * 128 + 4) * F8_SY; }
#pragma unroll
        for (int ai = 0; ai < 2; ++ai)
#pragma unroll
            for (int m = 0; m < 4; ++m) {
                unsigned char* rp = yr + (size_t)(row0 + ai * 128 + m * 16) * DM + col0;
#pragma unroll
                for (int bj = 0; bj < 2; ++bj) {
                    constexpr float RS = F8_SY / (F8_SA * F8_SWD);
                    const f32x4 v0 = acc[ai][bj][m][0] * RS + bv[bj][0], v1 = acc[ai][bj][m][1] * RS + bv[bj][1];
                    v2u w; w.x = pk4_fp8(v0[0], v0[1], v0[2], v0[3]); w.y = pk4_fp8(v1[0], v1[1], v1[2], v1[3]);
                    *(v2u*)(rp + bj * 128) = w;
                }
            }
    }
};
struct GroupOrder {
    LAS const unsigned* tile_e; int ntiles, lg, G, c; LAS const unsigned short* srcl;
    DI bool next(int i, pg8::Unit& u) const {
        int pm, pl;
        if (G == 256) {
            const int x = c & 7, k = c >> 3; pm = i * (256 >> lg) + x * (32 >> lg) + (k >> lg); pl = k & ((1 << lg) - 1); if (pm >= ntiles) return false; }
        else { const long L = (long)i * G + c; if (L >= ((long)ntiles << lg)) return false; pm = (int)(L >> lg); pl = (int)(L & ((1 << lg) - 1)); }
        const int e = __builtin_amdgcn_readfirstlane((int)tile_e[pm]);
        u.pm = pm; u.pn = (e << lg) + pl; return true;
    }
    DI void a_ready(const pg8::Unit&) const {}
    DI void done(const pg8::Unit&) const {}
    DI unsigned gsrc(int ui, int r) const { return (unsigned)srcl[ui * 256 + r] << 10; }
};
struct Args { const float* in[18]; float* out; unsigned char* ws; int ph_lo, ph_hi; };
struct Fr { LAS unsigned char* lds; unsigned char* ws; unsigned* ctl; int tid, lane, wave, blk, G; };

DI void tr_item(const float* W, int ldw, int K, int k0, int sc0, int nvalid, bf16* WT, int drow0, LAS float* scr, int lane) {
    const int c = lane & 31;
    float v[32];
#pragma unroll
    for (int i = 0; i < 32; ++i) v[i] = (c < nvalid) ? W[(size_t)(k0 + 2 * i + (lane >> 5)) * ldw + sc0 + c] : 0.f;
#pragma unroll
    for (int i = 0; i < 32; ++i) scr[(2 * i + (lane >> 5)) * 33 + c] = v[i];
    LDS_WAIT(); asm volatile("" ::: "memory");
    const int c8 = lane & 7;
#pragma unroll
    for (int j = 0; j < 4; ++j) { const int n = (lane >> 3) + 8 * j; const LAS float* s = scr + (8 * c8) * 33 + n;
        v4u o; o.x = cvtpk(s[0 * 33], s[1 * 33]); o.y = cvtpk(s[2 * 33], s[3 * 33]); o.z = cvtpk(s[4 * 33], s[5 * 33]); o.w = cvtpk(s[6 * 33], s[7 * 33]);
        *(v4u*)(WT + (size_t)(drow0 + n) * K + k0 + 8 * c8) = o; }
    LDS_WAIT(); asm volatile("" ::: "memory");
}
DI void tr_item8(const float* W, int ldw, int K, int k0, int sc0, float scale, unsigned char* WT8, int drow0, LAS float* scr, int lane) {
    const int c = lane & 31;
    float v[32];
#pragma unroll
    for (int i = 0; i < 32; ++i) v[i] = W[(size_t)(k0 + 2 * i + (lane >> 5)) * ldw + sc0 + c];
#pragma unroll
    for (int i = 0; i < 32; ++i) scr[(2 * i + (lane >> 5)) * 33 + c] = v[i] * scale;
    LDS_WAIT(); asm volatile("" ::: "memory");
    const int c16 = lane & 3;
#pragma unroll
    for (int j = 0; j < 2; ++j) { const int n = (lane >> 2) + 16 * j; const LAS float* s = scr + (16 * c16) * 33 + n;
        v4u o; o.x = pk4_fp8(s[0 * 33], s[1 * 33], s[2 * 33], s[3 * 33]); o.y = pk4_fp8(s[4 * 33], s[5 * 33], s[6 * 33], s[7 * 33]);
        o.z = pk4_fp8(s[8 * 33], s[9 * 33], s[10 * 33], s[11 * 33]); o.w = pk4_fp8(s[12 * 33], s[13 * 33], s[14 * 33], s[15 * 33]);
        *(v4u*)(WT8 + (size_t)(drow0 + n) * K + k0 + 16 * c16) = o; }
    LDS_WAIT(); asm volatile("" ::: "memory");
}
DI void ph_prologue(const Args& a, const Fr& F) {
    LAS float* scr = (LAS float*)(F.lds + F.wave * 16384);
    const int gw = F.blk * NWAVES + F.wave, NGW = F.G * NWAVES;
    constexpr int I_EV = 2 * 16 * 80, I_OD = 2 * 16 * 96, I_WO = 4 * 16 * 32;
    constexpr int NITEMS = I_EV + I_OD + I_WO;
    bf16* wev = (bf16*)(F.ws + WS_WEV); bf16* wod = (bf16*)(F.ws + WS_WOD); bf16* wout = (bf16*)(F.ws + WS_WOUT);
    unsigned char* wgu = F.ws + WS_WGU; unsigned char* wdn = F.ws + WS_WDN;
    for (int it = gw; it < NITEMS; it += NGW) {
        int r = it;
        if (r < I_EV) { const int l = r / 1280; r %= 1280; const int kb = r / 80, n0 = (r % 80) * 32; int sc0, nv = 32;
            if (n0 < 512) sc0 = n0; else if (n0 < 1024) sc0 = 964 + (n0 - 512); else if (n0 < 1536) sc0 = 1476 + (n0 - 1024); else if (n0 < 2048) sc0 = 1988 + (n0 - 1536);
            else if (n0 < 2176) sc0 = 512 + (n0 - 2048); else if (n0 < 2432) sc0 = 640 + (n0 - 2176); else if (n0 < 2496) sc0 = 896 + (n0 - 2432);
            else if (n0 < 2528) { sc0 = 960; nv = 4; } else { sc0 = 0; nv = 0; }
            tr_item(a.in[1] + (size_t)l * 1024 * 2500, 2500, 1024, kb * 64, sc0, nv, wev + (size_t)l * EV_N * 1024, n0, scr, F.lane); continue; }
        r -= I_EV;
        if (r < I_OD) { const int l = r / 1536; r %= 1536; const int kb = r / 96, n0 = (r % 96) * 32;
            tr_item(a.in[6] + (size_t)l * 1024 * 3088, 3088, 1024, kb * 64, n0, 32, wod + (size_t)l * OD_N * 1024, n0, scr, F.lane); continue; }
        r -= I_OD;
        if (r < I_WO) { const int l = r / 512; r %= 512; const int kb = r / 32, n0 = (r % 32) * 32;
            const float* src = (l & 1) ? a.in[8] + (size_t)(l >> 1) * 1024 * 1024 : a.in[5] + (size_t)(l >> 1) * 1024 * 1024;
            tr_item(src, 1024, 1024, kb * 64, n0, 32, wout + (size_t)l * 1024 * 1024, n0, scr, F.lane); continue; }
    }
    { __syncthreads();
        LAS float* tile = (LAS float*)F.lds; unsigned char* wgu8 = F.ws + WS_WGU; unsigned char* wdn8 = F.ws + WS_WDN;
        constexpr int T_GU = 128 * 8 * 16, T_DN = 128 * 8 * 8, T_ALL = T_GU + T_DN;
        const int tid = F.tid, c4 = tid & 31, r0 = tid >> 5;
        f32x4 v[8];
        auto locate = [&](int t, const float*& src, int& ldw, unsigned char*& dst, float& scale) {
            if (t < T_GU) { const int le = t >> 7, r = t & 127, kb = r >> 4, nb = r & 15, n0 = nb * 128; const int pn = n0 >> 8, bj = (n0 >> 7) & 1;
                src = a.in[14] + (size_t)le * 1024 * 2048 + (size_t)(kb * 128) * 2048 + bj * 1024 + pn * 128; ldw = 2048; dst = wgu8 + (size_t)le * 2048 * 1024 + (size_t)n0 * 1024 + kb * 128; scale = F8_SWG; }
            else { const int u = t - T_GU, le = u >> 6, r = u & 63, kb = r >> 3, nb = r & 7;
                src = a.in[16] + (size_t)le * 1024 * 1024 + (size_t)(kb * 128) * 1024 + nb * 128; ldw = 1024; dst = wdn8 + (size_t)le * 1024 * 1024 + (size_t)(nb * 128) * 1024 + kb * 128; scale = F8_SWD; } };
        int t = F.blk;
        if (t < T_ALL) { const float* src; int ldw; unsigned char* dst; float sc; locate(t, src, ldw, dst, sc);
#pragma unroll
            for (int i = 0; i < 8; ++i) v[i] = *(const f32x4*)(src + (size_t)(r0 + 16 * i) * ldw + 4 * c4); }
        for (; t < T_ALL; t += F.G) {
            const float* src; int ldw; unsigned char* dst; float sc; locate(t, src, ldw, dst, sc);
#pragma unroll
            for (int i = 0; i < 8; ++i) { LAS float* tp = tile + (r0 + 16 * i) * 129 + 4 * c4; tp[0] = v[i][0] * sc; tp[1] = v[i][1] * sc; tp[2] = v[i][2] * sc; tp[3] = v[i][3] * sc; }
            __syncthreads();
            if (t + F.G < T_ALL) { const float* s2; int l2; unsigned char* d2; float c2; locate(t + F.G, s2, l2, d2, c2);
#pragma unroll
                for (int i = 0; i < 8; ++i) v[i] = *(const f32x4*)(s2 + (size_t)(r0 + 16 * i) * l2 + 4 * c4); }
#pragma unroll
            for (int j = 0; j < 2; ++j) { const int p = tid + 512 * j, kc = p & 7, n = p >> 3; const LAS float* sp = tile + (kc * 16) * 129 + n;
                v4u o; o.x = pk4_fp8(sp[0], sp[129], sp[2 * 129], sp[3 * 129]); o.y = pk4_fp8(sp[4 * 129], sp[5 * 129], sp[6 * 129], sp[7 * 129]);
                o.z = pk4_fp8(sp[8 * 129], sp[9 * 129], sp[10 * 129], sp[11 * 129]); o.w = pk4_fp8(sp[12 * 129], sp[13 * 129], sp[14 * 129], sp[15 * 129]);
                *(v4u*)(dst + (size_t)n * 1024 + kc * 16) = o; }
            __syncthreads();
        }
    }
    bf16* xb = (bf16*)(F.ws + WS_XB);
    for (int m = gw; m < NTOK; m += NGW) {
        const f32x4* xr = (const f32x4*)(a.in[0] + (size_t)m * DM) + F.lane; v2u* o = (v2u*)(xb + (size_t)m * DM) + F.lane;
#pragma unroll
        for (int j = 0; j < 4; ++j) { const f32x4 v = xr[64 * j]; v2u w; w.x = cvtpk(v[0], v[1]); w.y = cvtpk(v[2], v[3]); o[64 * j] = w; }
    }
    bf16* wukt = (bf16*)(F.ws + WS_WUKT); bf16* wuvt = (bf16*)(F.ws + WS_WUVT);
    for (int i = F.blk * NTHR + F.tid; i < 2 * 8 * 128 * 64; i += F.G * NTHR) {
        { const int d = i & 63, c = (i >> 6) & 127, lh = i >> 13; wukt[i] = (bf16)f2bf(a.in[2][((size_t)lh * 64 + d) * 128 + c]); }
        { const int c = i & 127, d = (i >> 7) & 63, lh = i >> 13; wuvt[i] = (bf16)f2bf(a.in[3][((size_t)lh * 128 + c) * 64 + d]); }
    }
}

DI void ln_row(f32x4 (&v)[4], const float* g, const float* b, int lane) {
    float s = 0.f;
#pragma unroll
    for (int j = 0; j < 4; ++j) s += (v[j][0] + v[j][1]) + (v[j][2] + v[j][3]);
    const float mean = wave_sum(s) * (1.f / DM); float s2 = 0.f;
#pragma unroll
    for (int j = 0; j < 4; ++j) { v[j] = v[j] - mean; s2 += (v[j][0] * v[j][0] + v[j][1] * v[j][1]) + (v[j][2] * v[j][2] + v[j][3] * v[j][3]); }
    const float rstd = 1.f / sqrtf(wave_sum(s2) * (1.f / DM) + LN_EPS);
#pragma unroll
    for (int j = 0; j < 4; ++j) { const f32x4 gg = *((const f32x4*)g + lane + 64 * j), bb = *((const f32x4*)b + lane + 64 * j); v[j] = v[j] * rstd * gg + bb; }
}
DI void store_row_f32(float* p, const f32x4 (&v)[4], int lane) {
#pragma unroll
    for (int j = 0; j < 4; ++j) *((f32x4*)p + lane + 64 * j) = v[j];
}
DI void store_row_bf16(bf16* p, const f32x4 (&v)[4], int lane) {
#pragma unroll
    for (int j = 0; j < 4; ++j) { v2u w; w.x = cvtpk(v[j][0], v[j][1]); w.y = cvtpk(v[j][2], v[j][3]); *((v2u*)p + lane + 64 * j) = w; }
}
template <int NL> DI void small_proj(LAS const float* xs, const float* W, int ldw, int lane, float (&acc)[4]) {
    constexpr int PARTS = 64 / NL, DPER = 1024 / PARTS;
    const int n = lane & (NL - 1), part = lane / NL;
    acc[0] = acc[1] = acc[2] = acc[3] = 0.f;
    const float* wp = W + (size_t)(part * DPER) * ldw + n;
    LAS const float* xp = xs + part * DPER;
#pragma unroll 8
    for (int d = 0; d < DPER; ++d) { const float w = wp[(size_t)d * ldw];
        acc[0] += w * xp[d]; acc[1] += w * xp[1024 + d]; acc[2] += w * xp[2048 + d]; acc[3] += w * xp[3072 + d]; }
#pragma unroll
    for (int o = NL; o < 64; o <<= 1) {
#pragma unroll
        for (int k = 0; k < 4; ++k) acc[k] += __shfl_xor(acc[k], o); }
}

DI void ph_even_prep(const Args& a, const Fr& F, int j) {
    const bf16* proj = (const bf16*)(F.ws + WS_PROJ);
    bf16* ckvn = (bf16*)(F.ws + WS_CKVN); bf16* ql = (bf16*)(F.ws + WS_QL); float* kbar = (float*)(F.ws + WS_KBAR);
    const float* kvg = a.in[4] + j * 128;
    const bf16* wukt = (const bf16*)(F.ws + WS_WUKT) + (size_t)j * 8 * 128 * 64;
    const int lane = F.lane, wave = F.wave;
    for (int chunk = F.blk; chunk < 256; chunk += F.G) {
        const int tok0 = chunk * 128;
#pragma unroll 1
        for (int i0 = 0; i0 < 16; i0 += 8) { unsigned wv[8];
#pragma unroll
            for (int i = 0; i < 8; ++i) wv[i] = *((const unsigned*)(proj + (size_t)(tok0 + wave * 16 + i0 + i) * EV_N + EC_CKV) + lane);
#pragma unroll
            for (int i = 0; i < 8; ++i) { const int tok = tok0 + wave * 16 + i0 + i; const float v0 = bf2f(wv[i] & 0xffffu), v1 = bf2f(wv[i] >> 16);
                const float ss = wave_sum(v0 * v0 + v1 * v1);
                const float r = 1.f / sqrtf(ss * (1.f / 128.f) + LN_EPS);
                *((unsigned*)(ckvn + (size_t)tok * 128) + lane) = cvtpk(v0 * r * kvg[2 * lane], v1 * r * kvg[2 * lane + 1]); } }
        { bf16* kic = (bf16*)(F.ws + WS_KIC); const int tok = tok0 + wave * 16 + (lane >> 2), c = (lane & 3) * 16;
            const v4u* src = (const v4u*)(proj + (size_t)tok * EV_N + EC_KI + c); v4u* dst = (v4u*)(kic + (size_t)tok * 64 + c); dst[0] = src[0]; dst[1] = src[1]; }
        { const int h = wave, l15 = lane & 15, kg = lane >> 4;
            bf16x8 af[8][2];
#pragma unroll
            for (int ct = 0; ct < 8; ++ct)
#pragma unroll
                for (int ks = 0; ks < 2; ++ks) af[ct][ks] = *(const bf16x8*)(wukt + ((size_t)h * 128 + ct * 16 + l15) * 64 + ks * 32 + kg * 8);
#pragma unroll 1
            for (int tg = 0; tg < 8; tg += 4) { bf16x8 qf[4][2];
#pragma unroll
                for (int u = 0; u < 4; ++u)
#pragma unroll
                    for (int ks = 0; ks < 2; ++ks) qf[u][ks] = *(const bf16x8*)(proj + (size_t)(tok0 + (tg + u) * 16 + l15) * EV_N + EC_QA + h * 64 + ks * 32 + kg * 8);
#pragma unroll
                for (int u = 0; u < 4; ++u) { const int tok = tok0 + (tg + u) * 16 + l15;
#pragma unroll
                    for (int ct = 0; ct < 8; ++ct) { f32x4 d = {0.f, 0.f, 0.f, 0.f};
                        d = mfma16(af[ct][0], qf[u][0], d); d = mfma16(af[ct][1], qf[u][1], d);
                        v2u w; w.x = cvtpk(d[0], d[1]); w.y = cvtpk(d[2], d[3]);
                        *(v2u*)(ql + (size_t)tok * 1024 + h * 128 + ct * 16 + 4 * kg) = w; } } } }
        if (chunk < 128) { const int b = chunk >> 5, n = chunk & 31; float s8[8];
#pragma unroll
            for (int k = 0; k < 8; ++k) s8[k] = 0.f;
            const bf16* kp = proj + ((size_t)b * SEQ + n * 256 + wave * 32) * EV_N + EC_KB + lane * 8;
#pragma unroll 8
            for (int r = 0; r < 32; ++r) { const v4u w = *(const v4u*)(kp + (size_t)r * EV_N);
#pragma unroll
                for (int k = 0; k < 4; ++k) { s8[2 * k] += bf2f(w[k] & 0xffffu); s8[2 * k + 1] += bf2f(w[k] >> 16); } }
            LAS float* red = (LAS float*)F.lds;
            __syncthreads();
#pragma unroll
            for (int k = 0; k < 8; ++k) red[wave * 512 + lane * 8 + k] = s8[k];
            __syncthreads();
            float s = 0.f;
#pragma unroll
            for (int w = 0; w < 8; ++w) s += red[w * 512 + F.tid];
            const int h = F.tid >> 6, d = F.tid & 63;
            kbar[(((size_t)b * 8 + h) * 32 + n) * 64 + d] = s * (1.f / 256.f); }
    }
}

DI void moba_gate_chunk(const Fr& F, int chunk) {
    const bf16* proj = (const bf16*)(F.ws + WS_PROJ); const float* kbar = (const float*)(F.ws + WS_KBAR); unsigned* sel3 = (unsigned*)(F.ws + WS_SEL3);
    const int tok0 = chunk * 128, b = tok0 / SEQ, own = (tok0 % SEQ) >> 8, h = F.wave, lane = F.lane;
    float q0[64], q1[64];
    { const v4u* p0 = (const v4u*)(proj + (size_t)(tok0 + lane) * EV_N + EC_QB + h * 64); const v4u* p1 = (const v4u*)(proj + (size_t)(tok0 + 64 + lane) * EV_N + EC_QB + h * 64);
#pragma unroll
        for (int i = 0; i < 8; ++i) { const v4u w0 = p0[i], w1 = p1[i];
#pragma unroll
            for (int k = 0; k < 4; ++k) { q0[8 * i + 2 * k] = bf2f(w0[k] & 0xffffu); q0[8 * i + 2 * k + 1] = bf2f(w0[k] >> 16); q1[8 * i + 2 * k] = bf2f(w1[k] & 0xffffu); q1[8 * i + 2 * k + 1] = bf2f(w1[k] >> 16); } } }
    float a0 = -INFINITY, a1 = -INFINITY, a2 = -INFINITY, c0 = -INFINITY, c1 = -INFINITY, c2 = -INFINITY; int ai0 = 0, ai1 = 0, ai2 = 0, ci0 = 0, ci1 = 0, ci2 = 0;
    const float* kb = kbar + (((size_t)b * 8 + h) * 32) * 64;
    for (int n = 0; n < own; ++n) { float g0 = 0.f, g1 = 0.f;
#pragma unroll
        for (int d = 0; d < 64; d += 4) { const f32x4 kv = *(const f32x4*)(kb + n * 64 + d);
#pragma unroll
            for (int k = 0; k < 4; ++k) { g0 += q0[d + k] * kv[k]; g1 += q1[d + k] * kv[k]; } }
        if (g0 > a2) { if (g0 > a1) { a2 = a1; ai2 = ai1; if (g0 > a0) { a1 = a0; ai1 = ai0; a0 = g0; ai0 = n; } else { a1 = g0; ai1 = n; } } else { a2 = g0; ai2 = n; } }
        if (g1 > c2) { if (g1 > c1) { c2 = c1; ci2 = ci1; if (g1 > c0) { c1 = c0; ci1 = ci0; c0 = g1; ci0 = n; } else { c1 = g1; ci1 = n; } } else { c2 = g1; ci2 = n; } }
    }
    const unsigned nv = own < 3 ? own : 3;
    sel3[(size_t)(tok0 + lane) * 8 + h] = (unsigned)ai0 | ((unsigned)ai1 << 8) | ((unsigned)ai2 << 16) | (nv << 24);
    sel3[(size_t)(tok0 + 64 + lane) * 8 + h] = (unsigned)ci0 | ((unsigned)ci1 << 8) | ((unsigned)ci2 << 16) | (nv << 24);
}

constexpr int HS = 257;
DI float relu1(float x) { const unsigned u = __float_as_uint(x); return __uint_as_float(u & ~(unsigned)((int)u >> 31)); }
template <int MODE, bool DIAG> DI void idx_tile(const bf16x8 (&kf)[4], LAS const char* qb  , const float (&wj)[4], int kt, int q, int hi, unsigned c0, unsigned c1,
                                     LAS unsigned* hist, LAS unsigned* mask, LAS unsigned* cmask, LAS unsigned long long* cand, LAS unsigned* rinfo) {
    f32x2 scp[8];
#pragma unroll
    for (int p = 0; p < 8; ++p) scp[p] = (f32x2){0.f, 0.f};
    bf16x8 qv0[2][4], qv1[2][4];
#pragma unroll
    for (int j = 0; j < 2; ++j)
#pragma unroll
        for (int s = 0; s < 4; ++s) qv0[j][s] = *(LAS const bf16x8*)(qb + (j * 8 + s * 2) * 512);
#pragma unroll
    for (int j = 0; j < 2; ++j)
#pragma unroll
        for (int s = 0; s < 4; ++s) qv1[j][s] = *(LAS const bf16x8*)(qb + ((2 + j) * 8 + s * 2) * 512);
    __builtin_amdgcn_sched_barrier(0);
#pragma unroll
    for (int g = 0; g < 2; ++g) { f32x16 acc[2];
#pragma unroll
        for (int j = 0; j < 2; ++j)
#pragma unroll
            for (int r = 0; r < 16; ++r) acc[j][r] = 0.f;
#pragma unroll
        for (int s = 0; s < 4; ++s)
#pragma unroll
            for (int j = 0; j < 2; ++j) { if (MODE != -2) acc[j] = mfma32(kf[s], g == 0 ? qv0[j][s] : qv1[j][s], acc[j]); else acc[j][s] += __builtin_bit_cast(float, (unsigned)(kf[s][0] ^ (g == 0 ? qv0[j][s][0] : qv1[j][s][0]))); }
#pragma unroll
        for (int p = 0; p < 8; ++p)
#pragma unroll
            for (int j = 0; j < 2; ++j) { const f32x2 a = {relu1(acc[j][2 * p]), relu1(acc[j][2 * p + 1])}; const f32x2 w2 = {wj[2 * g + j], wj[2 * g + j]}; scp[p] = a * w2 + scp[p]; } }
    unsigned sel = 0u, cnd = 0u;
    if (MODE <= 0) { float t = 0.f;
#pragma unroll
        for (int p = 0; p < 8; ++p) t += scp[p][0] + scp[p][1];
        if (t == 12345.678f) __hip_atomic_fetch_or(mask + q * HS + kt, 1u, __ATOMIC_RELAXED, __HIP_MEMORY_SCOPE_WORKGROUP);
        return; }
    const float F0 = __uint_as_float(c0), F1 = __uint_as_float(c1);
#pragma unroll
    for (int r = 0; r < 16; ++r) { const int kr = crow(r, hi);
        const bool ok = !DIAG || kr <= q;
        const float scv = scp[r >> 1][r & 1]; const unsigned u = __float_as_uint(scv);
        if (MODE == 1) { const unsigned key = u ^ ((unsigned)((int)u >> 31) | 0x80000000u);
            if (ok && (key >> 24) >= c0) __hip_atomic_fetch_add(hist + q * HS + (key >> 24), 1u, __ATOMIC_RELAXED, __HIP_MEMORY_SCOPE_WORKGROUP); }
        else if (MODE == 2) { if (ok && (u >> 24) == c0) __hip_atomic_fetch_add(hist + q * HS + (((u >> 16) & 255u) ^ c1), 1u, __ATOMIC_RELAXED, __HIP_MEMORY_SCOPE_WORKGROUP); }
        else { const bool ge1 = scv >= F1, ge0 = scv >= F0;
            if (ok && ge1) sel |= 1u << kr;
            if (ok && ge0 && !ge1) { cnd |= 1u << kr; const unsigned key = u ^ ((unsigned)((int)u >> 31) | 0x80000000u);
                const unsigned pos = __hip_atomic_fetch_add(rinfo + 128 + q, 1u, __ATOMIC_RELAXED, __HIP_MEMORY_SCOPE_WORKGROUP);
                if (pos < 64u) cand[q * 64 + pos] = ((unsigned long long)key << 32) | (unsigned)(~(unsigned)(kt * 32 + kr)); } } }
    if (MODE == 3) { if (sel) __hip_atomic_fetch_or(mask + q * HS + kt, sel, __ATOMIC_RELAXED, __HIP_MEMORY_SCOPE_WORKGROUP);
        if (cnd) __hip_atomic_fetch_or(cmask + q * HS + kt, cnd, __ATOMIC_RELAXED, __HIP_MEMORY_SCOPE_WORKGROUP); }
}
#define IDX_LOAD(KF, I) do { int kt_l = wave + 8 * (I); kt_l = kt_l < nkt - 1 ? kt_l : nkt - 1; const bf16* kp_ = kp0 + (size_t)(kt_l * 32) * 64; _Pragma("unroll") for (int s_ = 0; s_ < 4; ++s_) KF[s_] = *(const bf16x8*)(kp_ + s_ * 16); } while (0)
#define IDX_ROT() do { _Pragma("unroll") for (int s_ = 0; s_ < 4; ++s_) { kfa[s_] = kfb[s_]; kfb[s_] = kfc[s_]; } } while (0)
template <int MODE> DI void idx_pass(const bf16* proj, int rowbase, int qt, LAS const char* qimg, const float (&wj)[4], LAS unsigned* hist, LAS unsigned* mask, LAS unsigned* cmask, LAS unsigned long long* cand, LAS unsigned* rinfo, int wave, int lane) {
    const int q = lane & 31, hi = lane >> 5, nkt = qt + 1;
    const unsigned b1 = MODE == 2 ? rinfo[160 + q] : rinfo[224 + q], thr16 = MODE == 2 ? rinfo[192 + q] : rinfo[256 + q];
    const bf16* kp0 = proj + (size_t)(rowbase + q) * 64 + hi * 8;
    LAS const char* qb = qimg + hi * 512 + q * 16;
    const int n_all = nkt > wave ? (nkt - wave + 7) >> 3 : 0;
    if (n_all == 0) return;
    const bool has_diag = (qt & 7) == wave; const int n = n_all - (has_diag ? 1 : 0);
    bf16x8 kfa[4], kfb[4], kfc[4];
#define IDX_TILE(KF, I) idx_tile<MODE, false>(KF, qb, wj, wave + 8 * (I), q, hi, b1, thr16, hist, mask, cmask, cand, rinfo)
    IDX_LOAD(kfa, 0); IDX_LOAD(kfb, 1); IDX_LOAD(kfc, 2);
    int i = 0;
    for (; i + 3 <= n; i += 3) { IDX_TILE(kfa, i); IDX_LOAD(kfa, i + 3); IDX_TILE(kfb, i + 1); IDX_LOAD(kfb, i + 4); IDX_TILE(kfc, i + 2); IDX_LOAD(kfc, i + 5); }
#pragma unroll 1
    for (; i < n; ++i) { IDX_TILE(kfa, i); IDX_ROT(); }
    if (has_diag) idx_tile<MODE, true>(kfa, qb, wj, qt, q, hi, b1, thr16, hist, mask, cmask, cand, rinfo);
#undef IDX_TILE
}
DI void hist_pick(LAS const unsigned* hrow, unsigned need, int lane, unsigned& bin, unsigned& above) {
    unsigned h4[4];
#pragma unroll
    for (int k = 0; k < 4; ++k) h4[k] = hrow[4 * lane + k];
    const unsigned ssum = h4[0] + h4[1] + h4[2] + h4[3];
    unsigned x = ssum;
#pragma unroll
    for (int o = 1; o < 64; o <<= 1) { const unsigned y = __shfl_down(x, o); if (lane + o < 64) x += y; }
    const unsigned long long m = __ballot(x >= need);
    const int Ls = m ? 63 - __builtin_clzll(m) : 0;
    const unsigned xs = __shfl(x, Ls), ss = __shfl(ssum, Ls);
    const unsigned h0 = __shfl(h4[0], Ls), h1 = __shfl(h4[1], Ls), h2 = __shfl(h4[2], Ls), h3 = __shfl(h4[3], Ls);
    unsigned cum = xs - ss;
    if (cum + h3 >= need) { bin = 4 * Ls + 3; above = cum; return; } cum += h3;
    if (cum + h2 >= need) { bin = 4 * Ls + 2; above = cum; return; } cum += h2;
    if (cum + h1 >= need) { bin = 4 * Ls + 1; above = cum; return; } cum += h1;
    bin = 4 * Ls; above = cum; (void)h0;
}
DI void idx_pass1(const bf16* proj, int rowbase, int qt, LAS const char* qimg, const float (&wj)[4], LAS unsigned* hist, LAS unsigned* mask, LAS unsigned* cmask, LAS unsigned long long* cand, LAS unsigned* rinfo, int wave, int lane) {
    const int q = lane & 31, hi = lane >> 5, nkt = qt + 1, nmax = (nkt + 7) >> 3;
    const bf16* kp0 = proj + (size_t)(rowbase + q) * 64 + hi * 8;
    LAS const char* qb = qimg + hi * 512 + q * 16;
    unsigned lb = 0u;
    bf16x8 kfa[4], kfb[4], kfc[4];
#define IDX_TILE(KF, I) idx_tile<1, false>(KF, qb, wj, wave + 8 * (I), q, hi, lb, 0u, hist, mask, cmask, cand, rinfo)
#define IDX_LBUP(I) do { const int i_ = (I); if (((i_ + 1) & i_) == 0 && i_ + 1 < nmax && i_ < 16) {        \
            __syncthreads(); \
            _Pragma("unroll 1") for (int rr = 0; rr < 4; ++rr) { const int row = wave * 4 + rr; unsigned bin, above; hist_pick(hist + row * HS, 256u, lane, bin, above); if (lane == 0) rinfo[288 + row] = bin; } \
            __syncthreads(); \
            { const unsigned nb = rinfo[288 + q]; lb = nb > lb ? nb : lb; } } } while (0)
    IDX_LOAD(kfa, 0); IDX_LOAD(kfb, 1); IDX_LOAD(kfc, 2);
    int i = 0;
    for (; i + 3 <= nmax - 1; i += 3) { IDX_TILE(kfa, i); IDX_LOAD(kfa, i + 3); IDX_LBUP(i); IDX_TILE(kfb, i + 1); IDX_LOAD(kfb, i + 4); IDX_LBUP(i + 1); IDX_TILE(kfc, i + 2); IDX_LOAD(kfc, i + 5); IDX_LBUP(i + 2); }
#pragma unroll 1
    for (; i < nmax - 1; ++i) { IDX_TILE(kfa, i); IDX_ROT(); IDX_LBUP(i); }
    { const int kt = wave + 8 * (nmax - 1);
        if (kt < nkt) { if (kt == qt) idx_tile<1, true>(kfa, qb, wj, kt, q, hi, lb, 0u, hist, mask, cmask, cand, rinfo); else IDX_TILE(kfa, nmax - 1); } }
#undef IDX_TILE
#undef IDX_LBUP
}
#undef IDX_LOAD
#undef IDX_ROT
DI void idx_unit(const Fr& F, int b, int qt, int stop = 0  ) {
    const bf16* proj = (const bf16*)(F.ws + WS_PROJ); const bf16* kic = (const bf16*)(F.ws + WS_KIC); unsigned short* sel = (unsigned short*)(F.ws + WS_SEL);
    LAS unsigned* hist = (LAS unsigned*)(F.lds); LAS unsigned* mask = hist + 32 * HS; LAS unsigned* cmask = mask + 32 * HS;
    LAS unsigned long long* cand = (LAS unsigned long long*)(F.lds + 99328); LAS unsigned* rinfo = (LAS unsigned*)(F.lds + 115712);
    const int lane = F.lane, wave = F.wave, tid = F.tid, t0 = qt * 32, rowbase = b * SEQ;
    __syncthreads();
    for (int i = tid; i < 3 * 32 * HS; i += NTHR) hist[i] = 0u;
    if (tid < 320) rinfo[tid] = 0u;
    __syncthreads();
    if (t0 + 31 <= 255 || (EXPF & 64)) {
        if (lane < 8) {
#pragma unroll
            for (int rr = 0; rr < 4; ++rr) { const int row = wave * 4 + rr, nv = t0 + row + 1;
                const int nv0 = t0 + row + 1; const int nvc = nv0 < 256 ? nv0 : 256; (void)nv; mask[row * HS + lane] = nvc >= 32 * (lane + 1) ? 0xffffffffu : (nvc > 32 * lane ? ((1u << (nvc - 32 * lane)) - 1u) : 0u); } }
    } else {
        const int q = lane & 31;
        float wj[4];
        { const bf16* qp = proj + (size_t)(rowbase + t0 + q) * EV_N;
#pragma unroll
            for (int j = 0; j < 4; ++j) wj[j] = bf2f(qp[EC_WI + j]); }
        LAS char* qimg = (LAS char*)(F.lds + 117248);
#pragma unroll
        for (int i = 0; i < 2; ++i) { const int p = tid + i * NTHR, row = p & 31, c = p >> 5;
            *(LAS v4u*)(qimg + c * 512 + row * 16) = *(const v4u*)(proj + (size_t)(rowbase + t0 + row) * EV_N + EC_QI + c * 8); }
        __syncthreads();
        if (stop == 7) return;
        idx_pass1(kic, rowbase, qt, qimg, wj, hist, mask, cmask, cand, rinfo, wave, lane);
        __syncthreads();
#pragma unroll 1
        for (int rr = 0; rr < 4; ++rr) { const int row = wave * 4 + rr; unsigned bin, above; hist_pick(hist + row * HS, 256u, lane, bin, above);
            if (lane == 0) { rinfo[row] = bin; rinfo[32 + row] = 256u - above; rinfo[160 + row] = bin >= 128u ? bin - 128u : 255u - bin; rinfo[192 + row] = bin >= 128u ? 0u : 255u; } }
        __syncthreads();
        if (stop == 1) return;
        for (int i = tid; i < 32 * HS; i += NTHR) hist[i] = 0u;
        __syncthreads();
        idx_pass<2>(kic, rowbase, qt, qimg, wj, hist, mask, cmask, cand, rinfo, wave, lane);
        __syncthreads();
#pragma unroll 1
        for (int rr = 0; rr < 4; ++rr) { const int row = wave * 4 + rr; const unsigned need1 = rinfo[32 + row]; unsigned bin, above; hist_pick(hist + row * HS, need1, lane, bin, above);
            if (lane == 0) { const unsigned t16 = (rinfo[row] << 8) | bin, k0 = t16 << 16, k1 = (t16 + 1u) << 16;
                rinfo[64 + row] = t16; rinfo[96 + row] = need1 - above;
                rinfo[224 + row] = (k0 & 0x80000000u) ? (k0 ^ 0x80000000u) : ~k0; rinfo[256 + row] = (t16 == 0xffffu) ? 0x7fc00000u : ((k1 & 0x80000000u) ? (k1 ^ 0x80000000u) : ~k1); } }
        __syncthreads();
        if (stop == 2) return;
        idx_pass<3>(kic, rowbase, qt, qimg, wj, hist, mask, cmask, cand, rinfo, wave, lane);
        __syncthreads();
        if (stop == 3) return;
#pragma unroll 1
        for (int rr = 0; rr < 4; ++rr) { const int row = wave * 4 + rr; const unsigned call = rinfo[128 + row], need2 = rinfo[96 + row];
            if (call <= 64u) { const unsigned c = call;
                const unsigned long long mine = cand[row * 64 + lane]; unsigned rank = 0u;
                for (unsigned k = 0; k < c; ++k) rank += (cand[row * 64 + k] > mine) ? 1u : 0u;
                if ((unsigned)lane < c && rank < need2) { const unsigned s = ~(unsigned)mine;
                    __hip_atomic_fetch_or(mask + row * HS + (s >> 5), 1u << (s & 31), __ATOMIC_RELAXED, __HIP_MEMORY_SCOPE_WORKGROUP); } }
            else { unsigned w4[4];
#pragma unroll
                for (int k = 0; k < 4; ++k) w4[k] = cmask[row * HS + 4 * lane + k];
                const unsigned cnt = __popc(w4[0]) + __popc(w4[1]) + __popc(w4[2]) + __popc(w4[3]);
                unsigned x = cnt;
#pragma unroll
                for (int o = 1; o < 64; o <<= 1) { const unsigned y = __shfl_up(x, o); if (lane >= o) x += y; }
                unsigned before = x - cnt;
#pragma unroll
                for (int k = 0; k < 4; ++k) { unsigned w = w4[k]; const unsigned pc = __popc(w); unsigned take = 0u;
                    if (before < need2) { if (before + pc <= need2) take = w; else { unsigned left = need2 - before; while (left) { const unsigned b = w & (0u - w); take |= b; w ^= b; --left; } } }
                    before += pc;
                    if (take) mask[row * HS + 4 * lane + k] |= take; } }
        }
    }
    __syncthreads();
#pragma unroll 1
    for (int rr = 0; rr < 4; ++rr) { const int row = wave * 4 + rr; unsigned short* out = sel + (size_t)(rowbase + t0 + row) * 256;
        unsigned w4[4];
#pragma unroll
        for (int k = 0; k < 4; ++k) w4[k] = mask[row * HS + 4 * lane + k];
        const unsigned cnt = __popc(w4[0]) + __popc(w4[1]) + __popc(w4[2]) + __popc(w4[3]);
        unsigned x = cnt;
#pragma unroll
        for (int o = 1; o < 64; o <<= 1) { const unsigned y = __shfl_up(x, o); if (lane >= o) x += y; }
        const unsigned total = __shfl(x, 63); unsigned pos = x - cnt;
#pragma unroll
        for (int k = 0; k < 4; ++k) { unsigned w = w4[k]; const unsigned base = (unsigned)(4 * lane + k) * 32u;
            while (w) { const unsigned bit = __builtin_ctz(w); if (pos < 256u) out[pos] = (unsigned short)(base + bit); ++pos; w &= w - 1u; } }
        for (unsigned i = total + lane; i < 256u; i += 64u) out[i] = (unsigned short)0xffffu; }
}

struct AttSt { float m, l; f32x16 o0, o1; };
template <class BF> DI void att_subtile(AttSt& S, const bf16x8 (&qf)[4], LAS const char* Kst, LAS const char* Vb, int vdh, int vrow0, int lane, const BF& bias) {
    const int r32 = lane & 31, hi = lane >> 5;
    f32x16 p;
#pragma unroll
    for (int r = 0; r < 16; ++r) p[r] = bias.b(crow(r, hi)) - S.m;
    LAS const char* kp = Kst + hi * 512 + r32 * 16;
#pragma unroll
    for (int s = 0; s < 4; ++s) { const bf16x8 kf = *(LAS const bf16x8*)(kp + s * 1024); p = mfma32(kf, qf[s], p); }
    if (bias.any) {
#pragma unroll
        for (int r = 0; r < 16; ++r) p[r] = bias.msk(crow(r, hi)) ? -INFINITY : p[r]; }
    float mxa[4] = {-INFINITY, -INFINITY, -INFINITY, -INFINITY};
#pragma unroll
    for (int r = 0; r < 16; ++r) mxa[r & 3] = fmaxf(mxa[r & 3], p[r]);
    float mx = fmaxf(fmaxf(mxa[0], mxa[1]), fmaxf(mxa[2], mxa[3]));
    mx = fmaxf(mx, __shfl_xor(mx, 32));
    if (__any(mx > 16.f)) { const float dl = fmaxf(mx, 0.f), sc = ex2(-dl); S.m += dl; S.l *= sc;
#pragma unroll
        for (int r = 0; r < 16; ++r) { p[r] -= dl; S.o0[r] *= sc; S.o1[r] *= sc; } }
    float psa[4] = {0.f, 0.f, 0.f, 0.f};
#pragma unroll
    for (int r = 0; r < 16; ++r) { p[r] = ex2(p[r]); psa[r & 3] += p[r]; }
    S.l += (psa[0] + psa[1]) + (psa[2] + psa[3]);
    v4u pw0, pw1;
    pw0.x = cvtpk(p[0], p[1]); pw0.y = cvtpk(p[2], p[3]); pw0.z = cvtpk(p[4], p[5]); pw0.w = cvtpk(p[6], p[7]);
    pw1.x = cvtpk(p[8], p[9]); pw1.y = cvtpk(p[10], p[11]); pw1.z = cvtpk(p[12], p[13]); pw1.w = cvtpk(p[14], p[15]);
    const bf16x8 pf0 = __builtin_bit_cast(bf16x8, pw0), pf1 = __builtin_bit_cast(bf16x8, pw1);
    LAS const char* vp = Vb + (vrow0 + 4 * hi + ((lane & 15) >> 2)) * 64 + ((lane >> 4) & 1) * 32 + (lane & 3) * 8;
    { const bf16x8 v00 = cat8(vtr(vp), vtr(vp + 512)), v10 = cat8(vtr(vp + vdh), vtr(vp + vdh + 512));
      const bf16x8 v01 = cat8(vtr(vp + 1024), vtr(vp + 1536)), v11 = cat8(vtr(vp + vdh + 1024), vtr(vp + vdh + 1536));
      S.o0 = mfma32(v00, pf0, S.o0); S.o1 = mfma32(v10, pf0, S.o1);
      S.o0 = mfma32(v01, pf1, S.o0); S.o1 = mfma32(v11, pf1, S.o1); }
}
template <class BF0, class BF1> DI void att_tile64(AttSt& S, const bf16x8 (&qf)[4], LAS const char* Kst, LAS const char* Vb, int vdh, int vrow0, int lane, const BF0& bias0, const BF1& bias1) {
    const int r32 = lane & 31, hi = lane >> 5;
    f32x16 p0, p1;
#pragma unroll
    for (int r = 0; r < 16; ++r) { p0[r] = bias0.b(crow(r, hi)) - S.m; p1[r] = bias1.b(crow(r, hi)) - S.m; }
    LAS const char* kp = Kst + hi * 512 + r32 * 16;
#pragma unroll
    for (int s = 0; s < 4; ++s) { const bf16x8 k0 = *(LAS const bf16x8*)(kp + s * 1024), k1 = *(LAS const bf16x8*)(kp + 4096 + s * 1024); p0 = mfma32(k0, qf[s], p0); p1 = mfma32(k1, qf[s], p1); }
    if (bias0.any) {
#pragma unroll
        for (int r = 0; r < 16; ++r) p0[r] = bias0.msk(crow(r, hi)) ? -INFINITY : p0[r]; }
    if (bias1.any) {
#pragma unroll
        for (int r = 0; r < 16; ++r) p1[r] = bias1.msk(crow(r, hi)) ? -INFINITY : p1[r]; }
    float mxa[4] = {-INFINITY, -INFINITY, -INFINITY, -INFINITY};
#pragma unroll
    for (int r = 0; r < 16; ++r) mxa[r & 3] = fmaxf(mxa[r & 3], fmaxf(p0[r], p1[r]));
    float mx = fmaxf(fmaxf(mxa[0], mxa[1]), fmaxf(mxa[2], mxa[3]));
    mx = fmaxf(mx, __shfl_xor(mx, 32));
    if (__any(mx > 16.f)) { const float dl = fmaxf(mx, 0.f), sc = ex2(-dl); S.m += dl; S.l *= sc;
#pragma unroll
        for (int r = 0; r < 16; ++r) { p0[r] -= dl; p1[r] -= dl; S.o0[r] *= sc; S.o1[r] *= sc; } }
    float psa[4] = {0.f, 0.f, 0.f, 0.f};
#pragma unroll
    for (int r = 0; r < 16; ++r) { p0[r] = ex2(p0[r]); p1[r] = ex2(p1[r]); psa[r & 3] += p0[r] + p1[r]; }
    S.l += (psa[0] + psa[1]) + (psa[2] + psa[3]);
    v4u a0, a1, b0, b1;
    a0.x = cvtpk(p0[0], p0[1]); a0.y = cvtpk(p0[2], p0[3]); a0.z = cvtpk(p0[4], p0[5]); a0.w = cvtpk(p0[6], p0[7]);
    a1.x = cvtpk(p0[8], p0[9]); a1.y = cvtpk(p0[10], p0[11]); a1.z = cvtpk(p0[12], p0[13]); a1.w = cvtpk(p0[14], p0[15]);
    b0.x = cvtpk(p1[0], p1[1]); b0.y = cvtpk(p1[2], p1[3]); b0.z = cvtpk(p1[4], p1[5]); b0.w = cvtpk(p1[6], p1[7]);
    b1.x = cvtpk(p1[8], p1[9]); b1.y = cvtpk(p1[10], p1[11]); b1.z = cvtpk(p1[12], p1[13]); b1.w = cvtpk(p1[14], p1[15]);
    LAS const char* vp = Vb + (vrow0 + 4 * hi + ((lane & 15) >> 2)) * 64 + ((lane >> 4) & 1) * 32 + (lane & 3) * 8;
#pragma unroll
    for (int k16 = 0; k16 < 4; ++k16) { const bf16x8 pf = __builtin_bit_cast(bf16x8, k16 == 0 ? a0 : k16 == 1 ? a1 : k16 == 2 ? b0 : b1);
        const bf16x8 v0 = cat8(vtr(vp + k16 * 1024), vtr(vp + k16 * 1024 + 512)), v1 = cat8(vtr(vp + vdh + k16 * 1024), vtr(vp + vdh + k16 * 1024 + 512));
        S.o0 = mfma32(v0, pf, S.o0); S.o1 = mfma32(v1, pf, S.o1); }
}

struct MobaFar { float c; bool any; DI float b(int) const { return c; } DI bool msk(int) const { return false; } };
struct MobaBias { LAS const float* lut; int tq, s0; bool any;
    DI float b(int kvrel) const { const int dist = tq - (s0 + kvrel); return lut[dist < 0 ? 0 : (dist > 1023 ? 1023 : dist)]; }
    DI bool msk(int kvrel) const { return tq - (s0 + kvrel) < 0; } };
DI void moba_qload(bf16x8 (&qf)[4], const bf16* proj, int rowbase, int h, int tq, int hi) {
    const bf16* qp = proj + (size_t)(rowbase + tq) * EV_N + EC_QB + h * 64 + hi * 8;
#pragma unroll
    for (int s = 0; s < 4; ++s) qf[s] = *(const bf16x8*)(qp + s * 16);
}
DI void moba_tile(const Fr& F, const bf16x8 (&qf)[4], int rowbase, int h, int n, int tq, bool valid, int slot, bool own, int wave_tile) {
    LAS const char* Kb = (LAS const char*)F.lds; LAS const char* Vb = (LAS const char*)(F.lds + 32768); LAS const float* lut = (LAS const float*)(F.lds + 98304);
    bf16* po = (bf16*)(F.ws + WS_ACT); float* pml = (float*)(F.ws + WS_PML);
    const int lane = F.lane, hi = lane >> 5;
    AttSt S; S.m = 0.f; S.l = 0.f;
#pragma unroll
    for (int r = 0; r < 16; ++r) { S.o0[r] = 0.f; S.o1[r] = 0.f; }
    const int nst = own ? wave_tile + 1 : 8;
    int tmin = tq;
#pragma unroll
    for (int o = 1; o < 64; o <<= 1) { const int y = __shfl_xor(tmin, o); tmin = y < tmin ? y : tmin; }
    const float cfar = lut[1023];
    int st = 0;
    for (; st + 1 < nst; st += 2) {
        if (!own && tmin - (n * 256 + st * 32 + 63) >= 790) { MobaFar bf{cfar, false}; att_tile64(S, qf, Kb + st * 4096, Vb, 16384, st * 32, lane, bf, bf); }
        else { MobaBias bf0{lut, tq, n * 256 + st * 32, false}, bf1{lut, tq, n * 256 + st * 32 + 32, own && st + 1 == wave_tile}; att_tile64(S, qf, Kb + st * 4096, Vb, 16384, st * 32, lane, bf0, bf1); } }
    if (st < nst) { MobaBias bf{lut, tq, n * 256 + st * 32, own && st == wave_tile}; att_subtile(S, qf, Kb + st * 4096, Vb, 16384, st * 32, lane, bf); }
    const float lt = S.l + __shfl_xor(S.l, 32), inv = 1.f / lt;
    if (valid) { const size_t pi = ((size_t)(rowbase + tq) * 8 + h) * 4 + slot; bf16* o = po + pi * 64;
#pragma unroll
        for (int a4 = 0; a4 < 4; ++a4) { v2u w0, w1;
            w0.x = cvtpk(S.o0[4 * a4] * inv, S.o0[4 * a4 + 1] * inv); w0.y = cvtpk(S.o0[4 * a4 + 2] * inv, S.o0[4 * a4 + 3] * inv);
            w1.x = cvtpk(S.o1[4 * a4] * inv, S.o1[4 * a4 + 1] * inv); w1.y = cvtpk(S.o1[4 * a4 + 2] * inv, S.o1[4 * a4 + 3] * inv);
            *(v2u*)(o + 8 * a4 + 4 * hi) = w0; *(v2u*)(o + 32 + 8 * a4 + 4 * hi) = w1; }
        if (hi == 0) { f32x2 ml = {S.m, lt}; *(f32x2*)(pml + pi * 2) = ml; } }
}
DI void moba_unit(const Args& a, const Fr& F, int b, int h, int n) {
    const bf16* proj = (const bf16*)(F.ws + WS_PROJ); const unsigned* sel3 = (const unsigned*)(F.ws + WS_SEL3);
    LAS unsigned char* lds = F.lds; LAS unsigned* list = (LAS unsigned*)(lds + 65536); LAS float* lut = (LAS float*)(lds + 98304); LAS unsigned* misc = (LAS unsigned*)(lds + 102400);
    const int tid = F.tid, lane = F.lane, wave = F.wave, rowbase = b * SEQ;
    __syncthreads();
    { const bf16* kg = proj + (size_t)(rowbase + n * 256) * EV_N + EC_KB + h * 64; const bf16* vg = proj + (size_t)(rowbase + n * 256) * EV_N + EC_VB + h * 64;
#pragma unroll
        for (int i = 0; i < 4; ++i) { const int p = tid + i * NTHR;
            { const int r = p & 31, c = (p >> 5) & 7, st = p >> 8; const v4u v = *(const v4u*)(kg + (size_t)(st * 32 + r) * EV_N + c * 8); *(LAS v4u*)(lds + st * 4096 + c * 512 + r * 16) = v; }
            { const int cc = p & 3, row = (p >> 2) & 255, dh = p >> 10; const v4u v = *(const v4u*)(vg + (size_t)row * EV_N + dh * 32 + cc * 8); *(LAS v4u*)(lds + 32768 + dh * 16384 + row * 64 + cc * 16) = v; } }
        for (int d = tid; d < 1024; d += NTHR) lut[d] = a.in[9][t5_bucket(d) * 16 + 8 + h] * LOG2E; }
    if (tid == 0) misc[16] = 0u;
    __syncthreads();
    unsigned sv[16];
#pragma unroll
    for (int k = 0; k < 16; ++k) { const int t = (n + 1) * 256 + k * NTHR + tid; sv[k] = t < SEQ ? sel3[(size_t)(rowbase + t) * 8 + h] : 0u; }
#pragma unroll
    for (int k = 0; k < 16; ++k) { const int tb = (n + 1) * 256 + k * NTHR; if (tb < SEQ) { const int t = tb + tid;
        const unsigned s = sv[k]; const unsigned nv = s >> 24; int slot = -1;
        if (nv > 0u && (s & 255u) == (unsigned)n) slot = 0; else if (nv > 1u && ((s >> 8) & 255u) == (unsigned)n) slot = 1; else if (nv > 2u && ((s >> 16) & 255u) == (unsigned)n) slot = 2;
        const unsigned long long bal = __ballot(slot >= 0); const unsigned wcnt = __popcll(bal);
        if (lane == 0) misc[wave] = wcnt;
        __syncthreads();
        unsigned off = misc[16], tot = 0u;
#pragma unroll
        for (int w = 0; w < 8; ++w) { const unsigned c = misc[w]; if (w < wave) off += c; tot += c; }
        if (slot >= 0) list[off + __popcll(bal & ((1ull << lane) - 1ull))] = ((unsigned)t << 2) | (unsigned)slot;
        __syncthreads();
        if (tid == 0) misc[16] += tot; } }
    __syncthreads();
    const int nlist = (int)misc[16];
    const int ntl = (nlist + 31) >> 5, hi = lane >> 5;
    bf16x8 qa[4], qb2[4];
    moba_qload(qa, proj, rowbase, h, n * 256 + wave * 32 + (lane & 31), hi);
    unsigned ea = 0u, eb = 0u; bool va = false, vb = false;
    const int lastl = nlist > 0 ? nlist - 1 : 0;
#define MOBA_LD(Q, E, V, T) do { const int li_ = (T) * 32 + (lane & 31); V = li_ < nlist; E = list[li_ < lastl ? li_ : lastl]; const int tq_ = (int)(E >> 2); moba_qload(Q, proj, rowbase, h, tq_ < SEQ - 1 ? tq_ : SEQ - 1, hi); } while (0)
    const int nw = ntl > wave ? (ntl - wave + 7) >> 3 : 0;
    MOBA_LD(qb2, eb, vb, wave);
    moba_tile(F, qa, rowbase, h, n, n * 256 + wave * 32 + (lane & 31), true, 3, true, wave);
    int j = 0;
    for (; j + 2 <= nw; j += 2) {
        MOBA_LD(qa, ea, va, wave + 8 * (j + 1));
        moba_tile(F, qb2, rowbase, h, n, (int)(eb >> 2), vb, (int)(eb & 3u), false, 0);
        MOBA_LD(qb2, eb, vb, wave + 8 * (j + 2));
        moba_tile(F, qa, rowbase, h, n, (int)(ea >> 2), va, (int)(ea & 3u), false, 0);
    }
    if (j < nw) moba_tile(F, qb2, rowbase, h, n, (int)(eb >> 2), vb, (int)(eb & 3u), false, 0);
#undef MOBA_LD
}

DI void dsa_step(const bf16x8 (&af)[2][4], const bf16x8 (&qlf)[4], int ch, LAS const unsigned char* bsel, LAS unsigned char* cbuf, LAS const float* tab,
                 float& m, float& l, f32x4 (&oT)[8], int l15, int kg, int lane) {
    f32x4 acc[2];
#pragma unroll
    for (int mt = 0; mt < 2; ++mt) { const unsigned b4 = *(LAS const unsigned*)(bsel + ch * 32 + mt * 16 + 4 * kg);
#pragma unroll
        for (int i = 0; i < 4; ++i) { const unsigned bb = (b4 >> (8 * i)) & 255u; const float tb = tab[(bb & 31u) * 8 + (l15 & 7)];
            acc[mt][i] = (tb - m) + (bb != 255u ? 0.f : -INFINITY); } }
#pragma unroll
    for (int mt = 0; mt < 2; ++mt)
#pragma unroll
        for (int ks = 0; ks < 4; ++ks) { acc[mt] = mfma16(af[mt][ks], qlf[ks], acc[mt]); *(LAS bf16x8*)(cbuf + (mt * 16 + l15) * 288 + (ks * 32 + kg * 8) * 2) = af[mt][ks]; }
    float mx = fmaxf(fmaxf(fmaxf(acc[0][0], acc[0][1]), fmaxf(acc[0][2], acc[0][3])), fmaxf(fmaxf(acc[1][0], acc[1][1]), fmaxf(acc[1][2], acc[1][3])));
    if (__any(mx > 16.f)) { mx = fmaxf(mx, __shfl_xor(mx, 16)); mx = fmaxf(mx, __shfl_xor(mx, 32));
        const float dl = fmaxf(mx, 0.f), sc = ex2(-dl); m += dl; l *= sc;
#pragma unroll
        for (int mt = 0; mt < 2; ++mt) acc[mt] = acc[mt] - dl;
#pragma unroll
        for (int ct = 0; ct < 8; ++ct) oT[ct] = oT[ct] * sc; }
    float ps = 0.f;
#pragma unroll
    for (int mt = 0; mt < 2; ++mt)
#pragma unroll
        for (int i = 0; i < 4; ++i) { acc[mt][i] = ex2(acc[mt][i]); ps += acc[mt][i]; }
    l += ps;
    v4u pw; pw.x = cvtpk(acc[0][0], acc[0][1]); pw.y = cvtpk(acc[0][2], acc[0][3]); pw.z = cvtpk(acc[1][0], acc[1][1]); pw.w = cvtpk(acc[1][2], acc[1][3]);
    const bf16x8 pf = __builtin_bit_cast(bf16x8, pw);
    asm volatile("" ::: "memory");
    LAS const char* tp = (LAS const char*)cbuf + (4 * kg + (l15 >> 2)) * 288 + (lane & 3) * 8;
#pragma unroll
    for (int ct = 0; ct < 8; ++ct) { const bf16x8 cf = cat8(vtr(tp + ct * 32), vtr(tp + 16 * 288 + ct * 32)); oT[ct] = mfma16(cf, pf, oT[ct]); }
    asm volatile("" ::: "memory");
}
DI void dsa_gather(bf16x8 (&af)[2][4], const bf16* ckvn, int rowbase, LAS const unsigned short* selb, int ch, int l15, int kg) {
#pragma unroll
    for (int mt = 0; mt < 2; ++mt) { unsigned idx = selb[ch * 32 + mt * 16 + l15]; if (idx == 0xffffu) idx = 0u;
        const bf16* cp = ckvn + (size_t)(rowbase + (int)idx) * 128 + kg * 8;
#pragma unroll
        for (int ks = 0; ks < 4; ++ks) af[mt][ks] = *(const bf16x8*)(cp + ks * 32); }
}
DI void dsa_query(const Fr& F, int tok, const v2u sv, LAS unsigned char* wl, LAS const unsigned char* bkt, LAS const float* tab) {
    const bf16* ql = (const bf16*)(F.ws + WS_QL); const bf16* ckvn = (const bf16*)(F.ws + WS_CKVN); const unsigned short* sel = (const unsigned short*)(F.ws + WS_SEL); bf16* ol = (bf16*)(F.ws + WS_OL);
    const int lane = F.lane, l15 = lane & 15, kg = lane >> 4, t = tok % SEQ, rowbase = tok - t;
    LAS unsigned short* selb = (LAS unsigned short*)wl; LAS unsigned char* bsel = wl + 512; LAS unsigned char* cbuf = wl + 1024;
    { *((LAS v2u*)selb + lane) = sv; unsigned bw = 0u;
#pragma unroll
        for (int i = 0; i < 4; ++i) { const unsigned s = (i < 2 ? (sv.x >> (16 * i)) : (sv.y >> (16 * (i - 2)))) & 0xffffu; const int dist = t - (int)s;
            const unsigned bb = (s != 0xffffu && dist >= 0) ? (unsigned)bkt[dist > 1023 ? 1023 : dist] : 255u; bw |= bb << (8 * i); }
        *((LAS unsigned*)bsel + lane) = bw; }
    bf16x8 qlf[4];
#pragma unroll
    for (int ks = 0; ks < 4; ++ks) { qlf[ks] = *(const bf16x8*)(ql + (size_t)tok * 1024 + (l15 & 7) * 128 + ks * 32 + kg * 8); if (l15 >= 8) qlf[ks] = (bf16x8){0, 0, 0, 0, 0, 0, 0, 0}; }
    float m = 0.f, l = 0.f; f32x4 oT[8];
#pragma unroll
    for (int ct = 0; ct < 8; ++ct) oT[ct] = (f32x4){0.f, 0.f, 0.f, 0.f};
    const int nvalid = t + 1 < 256 ? t + 1 : 256, nch = (nvalid + 31) >> 5;
    LDS_WAIT();
    bf16x8 afa[2][4], afb[2][4], afc[2][4];
    const int lastc = nch - 1;
    dsa_gather(afa, ckvn, rowbase, selb, 0, l15, kg);
    dsa_gather(afb, ckvn, rowbase, selb, lastc < 1 ? lastc : 1, l15, kg);
    int ch = 0;
    for (; ch + 3 <= nch; ch += 3) {
        dsa_gather(afc, ckvn, rowbase, selb, ch + 2, l15, kg);
        dsa_step(afa, qlf, ch, bsel, cbuf, tab, m, l, oT, l15, kg, lane);
        dsa_gather(afa, ckvn, rowbase, selb, ch + 3 < lastc ? ch + 3 : lastc, l15, kg);
        dsa_step(afb, qlf, ch + 1, bsel, cbuf, tab, m, l, oT, l15, kg, lane);
        dsa_gather(afb, ckvn, rowbase, selb, ch + 4 < lastc ? ch + 4 : lastc, l15, kg);
        dsa_step(afc, qlf, ch + 2, bsel, cbuf, tab, m, l, oT, l15, kg, lane);
    }
    if (ch < nch) dsa_step(afa, qlf, ch, bsel, cbuf, tab, m, l, oT, l15, kg, lane);
    if (ch + 1 < nch) dsa_step(afb, qlf, ch + 1, bsel, cbuf, tab, m, l, oT, l15, kg, lane);
    l += __shfl_xor(l, 16); l += __shfl_xor(l, 32);
    const float inv = 1.f / l;
    if (l15 < 8) { bf16* o = ol + (size_t)tok * 1024 + l15 * 128 + 4 * kg;
#pragma unroll
        for (int ct = 0; ct < 8; ++ct) { v2u w; w.x = cvtpk(oT[ct][0] * inv, oT[ct][1] * inv); w.y = cvtpk(oT[ct][2] * inv, oT[ct][3] * inv); *(v2u*)(o + ct * 16) = w; } }
}
DI void dsa_chunk(const Args& a, const Fr& F, int c32) {
    LAS unsigned char* bkt = F.lds + 81920; LAS float* tab = (LAS float*)(F.lds + 82944);
    __syncthreads();
    for (int d = F.tid; d < 1024; d += NTHR) bkt[d] = (unsigned char)t5_bucket(d);
    if (F.tid < 256) tab[F.tid] = a.in[9][(F.tid >> 3) * 16 + (F.tid & 7)] * LOG2E;
    __syncthreads();
    const unsigned short* selg = (const unsigned short*)(F.ws + WS_SEL); v2u svq[4];
#pragma unroll
    for (int i = 0; i < 4; ++i) svq[i] = *((const v2u*)(selg + (size_t)(c32 * 32 + F.wave * 4 + i) * 256) + F.lane);
#pragma unroll
    for (int i = 0; i < 4; ++i) dsa_query(F, c32 * 32 + F.wave * 4 + i, svq[i], F.lds + F.wave * 10240, bkt, tab);
}

DI void ph_even_post(const Fr& F, int j) {
    const bf16* ol = (const bf16*)(F.ws + WS_OL); bf16* ao = (bf16*)(F.ws + WS_AO);
    const bf16* wuvt = (const bf16*)(F.ws + WS_WUVT) + (size_t)j * 8 * 64 * 128;
    const bf16* po = (const bf16*)(F.ws + WS_ACT); const float* pml = (const float*)(F.ws + WS_PML); const unsigned* sel3 = (const unsigned*)(F.ws + WS_SEL3);
    const int lane = F.lane, wave = F.wave, l15 = lane & 15, kg = lane >> 4;
    for (int chunk = F.blk; chunk < 256; chunk += F.G) { const int tok0 = chunk * 128;
        { const int h = wave; bf16x8 af[4][4];
#pragma unroll
            for (int mt = 0; mt < 4; ++mt)
#pragma unroll
                for (int ks = 0; ks < 4; ++ks) af[mt][ks] = *(const bf16x8*)(wuvt + ((size_t)h * 64 + mt * 16 + l15) * 128 + ks * 32 + kg * 8);
#pragma unroll 1
            for (int tg = 0; tg < 8; tg += 2) { bf16x8 bf[2][4];
#pragma unroll
                for (int u = 0; u < 2; ++u)
#pragma unroll
                    for (int ks = 0; ks < 4; ++ks) bf[u][ks] = *(const bf16x8*)(ol + (size_t)(tok0 + (tg + u) * 16 + l15) * 1024 + h * 128 + ks * 32 + kg * 8);
#pragma unroll
                for (int u = 0; u < 2; ++u) { const int tok = tok0 + (tg + u) * 16 + l15;
#pragma unroll
                    for (int mt = 0; mt < 4; ++mt) { f32x4 d = {0.f, 0.f, 0.f, 0.f};
#pragma unroll
                        for (int ks = 0; ks < 4; ++ks) d = mfma16(af[mt][ks], bf[u][ks], d);
                        v2u w; w.x = cvtpk(d[0], d[1]); w.y = cvtpk(d[2], d[3]); *(v2u*)(ao + (size_t)tok * 1024 + h * 64 + mt * 16 + 4 * kg) = w; } } } }
#pragma unroll 1
        for (int i0 = 0; i0 < 16; i0 += 4) { const int h = lane >> 3, d0 = (lane & 7) * 8; unsigned nvv[4]; f32x2 mlv[4][4];
#pragma unroll
            for (int i = 0; i < 4; ++i) { const int tok = tok0 + wave * 16 + i0 + i; const size_t pi = ((size_t)tok * 8 + h) * 4; nvv[i] = sel3[(size_t)tok * 8 + h] >> 24;
#pragma unroll
                for (int s = 0; s < 4; ++s) mlv[i][s] = *(const f32x2*)(pml + (pi + s) * 2); }
#pragma unroll
            for (int i = 0; i < 4; ++i) { const int tok = tok0 + wave * 16 + i0 + i; const size_t pi = ((size_t)tok * 8 + h) * 4;
                float mj[4], lj[4];
#pragma unroll
                for (int s = 0; s < 4; ++s) { const bool ok = (s == 3) || ((unsigned)s < nvv[i]); mj[s] = ok ? mlv[i][s][0] : -1e30f; lj[s] = ok ? mlv[i][s][1] : 0.f; }
                const float ms = fmaxf(fmaxf(mj[0], mj[1]), fmaxf(mj[2], mj[3])); float wsum = 0.f, acc[8], wv[4]; v4u pv[4];
#pragma unroll
                for (int k = 0; k < 8; ++k) acc[k] = 0.f;
#pragma unroll
                for (int s = 0; s < 4; ++s) { wv[s] = lj[s] * ex2(mj[s] - ms); wsum += wv[s]; pv[s] = (v4u){0u, 0u, 0u, 0u}; if (wv[s] > 0.f) pv[s] = *(const v4u*)(po + (pi + s) * 64 + d0); }
#pragma unroll
                for (int s = 0; s < 4; ++s) { if (wv[s] > 0.f) {
#pragma unroll
                    for (int k = 0; k < 4; ++k) { acc[2 * k] += wv[s] * bf2f(pv[s][k] & 0xffffu); acc[2 * k + 1] += wv[s] * bf2f(pv[s][k] >> 16); } } }
                const float inv = 1.f / wsum; v4u o; o.x = cvtpk(acc[0] * inv, acc[1] * inv); o.y = cvtpk(acc[2] * inv, acc[3] * inv); o.z = cvtpk(acc[4] * inv, acc[5] * inv); o.w = cvtpk(acc[6] * inv, acc[7] * inv);
                *(v4u*)(ao + (size_t)tok * 1024 + 512 + h * 64 + d0) = o; } }
    }
}
template <class XT> DI f32x4 ld_x4(const XT* p);
template <> DI f32x4 ld_x4<float>(const float* p) { return *(const f32x4*)p; }
template <> DI f32x4 ld_x4<bf16>(const bf16* p) { const v2u w = *(const v2u*)p; return (f32x4){bf2f(w.x & 0xffffu), bf2f(w.x >> 16), bf2f(w.y & 0xffffu), bf2f(w.y >> 16)}; }
template <class XT> DI f32x16 proj32_f32(const float* W, int ldw, int ncols, const XT* xrow, int d_lo, int lane) {
    const int e = lane & 31, kh = lane >> 5; const bool ev = e < ncols;
    f32x16 D;
#pragma unroll
    for (int r = 0; r < 16; ++r) D[r] = 0.f;
    const float* wp = W + (size_t)(d_lo + 4 * kh) * ldw + (ev ? e : 0);
    const XT* xp = xrow + d_lo + 4 * kh;
#pragma unroll 8
    for (int i = 0; i < 64; ++i) { const f32x4 xv = ld_x4<XT>(xp + 8 * i);
        float a0 = wp[(size_t)(8 * i + 0) * ldw], a1 = wp[(size_t)(8 * i + 1) * ldw], a2 = wp[(size_t)(8 * i + 2) * ldw], a3 = wp[(size_t)(8 * i + 3) * ldw];
        if (!ev) { a0 = 0.f; a1 = 0.f; a2 = 0.f; a3 = 0.f; }
        D = __builtin_amdgcn_mfma_f32_32x32x2f32(a0, xv[0], D, 0, 0, 0); D = __builtin_amdgcn_mfma_f32_32x32x2f32(a1, xv[1], D, 0, 0, 0);
        D = __builtin_amdgcn_mfma_f32_32x32x2f32(a2, xv[2], D, 0, 0, 0); D = __builtin_amdgcn_mfma_f32_32x32x2f32(a3, xv[3], D, 0, 0, 0); }
    return D;
}
DI void ph_odd_prep(const Args& a, const Fr& F, int j, int layer) {
    const bf16* proj = (const bf16*)(F.ws + WS_PROJ); const bf16* x = (const bf16*)(F.ws + WS_XB);
    float* logf = (float*)(F.ws + WS_LOGF); float* cs = (float*)(F.ws + WS_CS);
    const float* wf = a.in[6] + (size_t)j * 1024 * 3088 + 3072; const float* bfv = a.in[7] + j * 16;
    LAS float* red = (LAS float*)(F.lds); LAS float* lfb = (LAS float*)(F.lds + 131072);
    LAS unsigned* kmx = (LAS unsigned*)(F.lds + 131072 + 8192);
    const int lane = F.lane, wave = F.wave, tid = F.tid, l31 = lane & 31, hi = lane >> 5;
    for (int chunk = F.blk; chunk < 256; chunk += F.G) { const int tok0 = chunk * 128, b = tok0 / SEQ, t0 = tok0 % SEQ;
        __syncthreads();
        if (tid < 16) kmx[tid] = 0u;
        const int tl = wave & 3, kr = wave >> 2;
        f32x16 D = proj32_f32(wf, 3088, 16, x + (size_t)(tok0 + tl * 32 + l31) * DM, kr * 512, lane);
        if (kr == 1) {
#pragma unroll
            for (int r = 0; r < 8; ++r) red[(tl * 8 + r) * 64 + lane] = D[r]; }
        __syncthreads();
        if (kr == 0) {
#pragma unroll
            for (int r = 0; r < 8; ++r) { const int h = (r & 3) + 8 * (r >> 2) + 4 * hi; const float z = D[r] + red[(tl * 8 + r) * 64 + lane] + bfv[h];
                const float ls = fminf(z, 0.f) - log1pf(__expf(-fabsf(z)));
                lfb[(tl * 32 + l31) * 16 + h] = ls * LOG2E; } }
#pragma unroll 1
        for (int i = 0; i < 4; ++i) { const int p = tid + i * NTHR, tk = p >> 4, h = p & 15; const v4u* kp = (const v4u*)(proj + (size_t)(tok0 + tk) * OD_N + OC_K + h * 64); float s = 0.f;
#pragma unroll
            for (int c = 0; c < 8; ++c) { const v4u w = kp[c];
#pragma unroll
                for (int k = 0; k < 4; ++k) { const float e0 = bf2f(w[k] & 0xffffu), e1 = bf2f(w[k] >> 16); s += e0 * e0 + e1 * e1; } }
            __hip_atomic_fetch_max(kmx + h, __float_as_uint(s), __ATOMIC_RELAXED, __HIP_MEMORY_SCOPE_WORKGROUP); }
        __syncthreads();
        for (int i = tid; i < 2048; i += NTHR) { const int h = i >> 7, tk = i & 127; logf[((size_t)b * 16 + h) * SEQ + t0 + tk] = lfb[tk * 16 + h]; }
        if (tid < 32) { const int h = tid & 15, c = tid >> 4; float s = 0.f;
            for (int k = 0; k < 64; ++k) s += lfb[(c * 64 + k) * 16 + h];
            cs[((size_t)b * 16 + h) * 128 + (t0 >> 6) + c] = s; }
        if (tid < 16) __hip_atomic_fetch_max(F.ctl + CW_KMAX + layer * 64 + b * 16 + tid, kmx[tid], RLX_AGENT);
    }
}

constexpr float FOX_SKIP_LOG2 = 64.f;
struct FoxBias { LAS const float* ng; int tq, kabs0; bool any;
    DI float b(int kvrel) const { return ng[kvrel]; }
    DI bool msk(int kvrel) const { return (kabs0 + kvrel) > tq; } };
DI void fox_unit(const Fr& F, int layer, int b, int h, int qb) {
    const bf16* proj = (const bf16*)(F.ws + WS_PROJ); const float* logf = (const float*)(F.ws + WS_LOGF); const float* cs = (const float*)(F.ws + WS_CS); bf16* ao = (bf16*)(F.ws + WS_AO);
    LAS unsigned char* lds = F.lds; LAS float* ng = (LAS float*)(lds + 32768); LAS float* red = (LAS float*)(lds + 65536 + 1024); LAS int* ibox = (LAS int*)(lds + 65536 + 2048);
    const int tid = F.tid, lane = F.lane, wave = F.wave, r32 = lane & 31, hi = lane >> 5, t0 = qb * 256, rowbase = b * SEQ, tq = t0 + wave * 32 + r32;
    __syncthreads();
    bf16x8 qf[4]; float qs = 0.f;
    { const bf16* qp = proj + (size_t)(rowbase + tq) * OD_N + OC_Q + h * 64 + hi * 8;
#pragma unroll
        for (int s = 0; s < 4; ++s) { qf[s] = *(const bf16x8*)(qp + s * 16);
#pragma unroll
            for (int k = 0; k < 8; ++k) { const float e = bf2f((unsigned short)qf[s][k]); qs += e * e; } } }
    qs += __shfl_xor(qs, 32); qs = wave_max(qs);
    if (lane == 0) red[wave] = qs;
    if (tid < 128) red[32 + tid] = (tid < t0 / 64) ? cs[((size_t)b * 16 + h) * 128 + tid] : 0.f;
    __syncthreads();
    if (tid == 0) { float qm = red[0];
        for (int w = 1; w < 8; ++w) qm = fmaxf(qm, red[w]);
        const float km = __uint_as_float(ld_u32(F.ctl + CW_KMAX + layer * 64 + b * 16 + h));
        const float B2 = 2.f * (sqrtf(qm * km) * 1.01f + 1.f);
        int kt = t0 / 64 - 1, kts = t0 / 64; float D = 0.f;
        while (kt >= 0 && B2 + D >= -FOX_SKIP_LOG2) { kts = kt; D += red[32 + kt]; --kt; }
        ibox[0] = kts; }
    __syncthreads();
    const int kts = ibox[0], s_start = kts * 64, nel = t0 + 256 - s_start;
    { const int i0 = tid * 16; float v[16]; const float* lp = logf + ((size_t)b * 16 + h) * SEQ + s_start + i0;
        if (i0 < nel) {
#pragma unroll
            for (int c = 0; c < 4; ++c) { const f32x4 w = *(const f32x4*)(lp + 4 * c); v[4 * c] = w[0]; v[4 * c + 1] = w[1]; v[4 * c + 2] = w[2]; v[4 * c + 3] = w[3]; } }
        else {
#pragma unroll
            for (int c = 0; c < 16; ++c) v[c] = 0.f; }
#pragma unroll
        for (int c = 1; c < 16; ++c) v[c] += v[c - 1];
        float xsum = v[15];
#pragma unroll
        for (int o = 1; o < 64; o <<= 1) { const float y = __shfl_up(xsum, o); if (lane >= o) xsum += y; }
        if (lane == 63) red[16 + wave] = xsum;
        __syncthreads();
        float off = xsum - v[15];
        for (int w = 0; w < wave; ++w) off += red[16 + w];
        if (i0 < nel) {
#pragma unroll
            for (int c = 0; c < 4; ++c) { f32x4 w = {-(off + v[4 * c]), -(off + v[4 * c + 1]), -(off + v[4 * c + 2]), -(off + v[4 * c + 3])}; *(LAS f32x4*)(ng + i0 + 4 * c) = w; } }
    }
    const int ntile = t0 / 64 + 4 - kts;
    const bf16* kg = proj + (size_t)rowbase * OD_N + OC_K + h * 64; const bf16* vg = proj + (size_t)rowbase * OD_N + OC_V + h * 64;
    const int kr = tid & 31, kc = (tid >> 5) & 7, kst = tid >> 8, vcc = tid & 3, vrow = (tid >> 2) & 63, vdh = tid >> 8;
    const int koff = kst * 4096 + kc * 512 + kr * 16, voff = 8192 + vdh * 4096 + vrow * 64 + vcc * 16;
    const bf16* kgp = kg + (size_t)(kts * 64 + kst * 32 + kr) * OD_N + kc * 8; const bf16* vgp = vg + (size_t)(kts * 64 + vrow) * OD_N + vdh * 32 + vcc * 8;
#define FOX_LD(KV, VV, I) do { const int ii_ = (I) < ntile - 1 ? (I) : ntile - 1; KV = *(const v4u*)(kgp + (size_t)ii_ * 64 * OD_N); VV = *(const v4u*)(vgp + (size_t)ii_ * 64 * OD_N); } while (0)
    v4u kvA, vvA, kvB, vvB;
    { v4u kv, vv; FOX_LD(kv, vv, 0); FOX_LD(kvA, vvA, 1);
        *(LAS v4u*)(lds + koff) = kv; *(LAS v4u*)(lds + voff) = vv; }
    __syncthreads();
    AttSt S; S.m = 0.f; S.l = 0.f;
#pragma unroll
    for (int r = 0; r < 16; ++r) { S.o0[r] = 0.f; S.o1[r] = 0.f; }
    const int wlast = t0 + wave * 32 + 31, wfirst = t0 + wave * 32;
#define FOX_COMPUTE(I, BUF) do { const int kv0 = (kts + (I)) * 64; LAS const char* bp_ = (LAS const char*)(lds + (BUF)); \
        if (kv0 + 32 <= wlast) { FoxBias bf0{ng + (kv0 - s_start), tq, kv0, kv0 + 31 > wfirst}, bf1{ng + (kv0 + 32 - s_start), tq, kv0 + 32, kv0 + 63 > wfirst}; \
            att_tile64(S, qf, bp_, bp_ + 8192, 4096, 0, lane, bf0, bf1); } \
        else if (kv0 <= wlast) { FoxBias bf{ng + (kv0 - s_start), tq, kv0, kv0 + 31 > wfirst}; \
            att_subtile(S, qf, bp_, bp_ + 8192, 4096, 0, lane, bf); } } while (0)
    for (int i = 0; i < ntile; i += 2) {
        FOX_LD(kvB, vvB, i + 2);
        FOX_COMPUTE(i, 0);
        if (i + 1 < ntile) { *(LAS v4u*)(lds + 16384 + koff) = kvA; *(LAS v4u*)(lds + 16384 + voff) = vvA; }
        __syncthreads();
        if (i + 1 >= ntile) break;
        FOX_LD(kvA, vvA, i + 3);
        FOX_COMPUTE(i + 1, 16384);
        if (i + 2 < ntile) { *(LAS v4u*)(lds + koff) = kvB; *(LAS v4u*)(lds + voff) = vvB; }
        __syncthreads();
    }
#undef FOX_LD
#undef FOX_COMPUTE
    const float lt = S.l + __shfl_xor(S.l, 32), inv = 1.f / lt;
    bf16* o = ao + (size_t)(rowbase + tq) * 1024 + h * 64;
#pragma unroll
    for (int a4 = 0; a4 < 4; ++a4) { v2u w0, w1;
        w0.x = cvtpk(S.o0[4 * a4] * inv, S.o0[4 * a4 + 1] * inv); w0.y = cvtpk(S.o0[4 * a4 + 2] * inv, S.o0[4 * a4 + 3] * inv);
        w1.x = cvtpk(S.o1[4 * a4] * inv, S.o1[4 * a4 + 1] * inv); w1.y = cvtpk(S.o1[4 * a4 + 2] * inv, S.o1[4 * a4 + 3] * inv);
        *(v2u*)(o + 8 * a4 + 4 * hi) = w0; *(v2u*)(o + 32 + 8 * a4 + 4 * hi) = w1; }
}

DI void ph_ln1_router(const Args& a, const Fr& F, int layer) {
    const bf16* yp = (const bf16*)(F.ws + WS_YP); bf16* x1 = (bf16*)(F.ws + WS_X1); unsigned char* xb8 = F.ws + WS_XB8;
    unsigned* tope = (unsigned*)(F.ws + WS_TOPE); float* gate = (float*)(F.ws + WS_GATE); unsigned* rank = (unsigned*)(F.ws + WS_RANK);
    const float* g = a.in[10] + (size_t)(layer * 2) * DM; const float* bb = a.in[11] + (size_t)(layer * 2) * DM;
    const float* rw = a.in[12] + (size_t)layer * 1024 * 32; const float* rb = a.in[13] + layer * 32;
    LAS float* red = (LAS float*)(F.lds); LAS unsigned* lcnt = (LAS unsigned*)(F.lds + 131072);
    const int lane = F.lane, wave = F.wave, tid = F.tid, l31 = lane & 31, hi = lane >> 5;
    for (int chunk = F.blk; chunk < 256; chunk += F.G) { const int tok0 = chunk * 128;
        __syncthreads();
        if (tid < 32) lcnt[tid] = 0u;
#pragma unroll 1
        for (int k = 0; k < 16; k += 8) { f32x4 v[8][4];
#pragma unroll
            for (int i = 0; i < 8; ++i)
#pragma unroll
                for (int jj = 0; jj < 4; ++jj) { const v2u w = *((const v2u*)(yp + (size_t)(tok0 + wave * 16 + k + i) * DM) + lane + 64 * jj);
                    v[i][jj] = (f32x4){bf2f(w.x & 0xffffu), bf2f(w.x >> 16), bf2f(w.y & 0xffffu), bf2f(w.y >> 16)}; }
#pragma unroll
            for (int i = 0; i < 8; ++i) { const int tok = tok0 + wave * 16 + k + i;
                ln_row(v[i], g, bb, lane);
                store_row_bf16(x1 + (size_t)tok * DM, v[i], lane);
#pragma unroll
                for (int jj = 0; jj < 4; ++jj) *((unsigned*)(xb8 + (size_t)tok * DM) + lane + 64 * jj) = pk4_fp8(v[i][jj][0] * F8_SX, v[i][jj][1] * F8_SX, v[i][jj][2] * F8_SX, v[i][jj][3] * F8_SX); } }
        asm volatile("s_waitcnt vmcnt(0)" ::: "memory");
        __syncthreads();
        const int tl = wave & 3, kr = wave >> 2, tokl = tok0 + tl * 32 + l31;
        f32x16 D = proj32_f32(rw, 32, 32, x1 + (size_t)tokl * DM, kr * 512, lane);
        if (kr == 1) {
#pragma unroll
            for (int r = 0; r < 16; ++r) red[(tl * 16 + r) * 64 + lane] = D[r]; }
        __syncthreads();
        if (kr == 0) {
            float lv[32];
#pragma unroll
            for (int r = 0; r < 16; ++r) { const float own = D[r] + red[(tl * 16 + r) * 64 + lane] + rb[crow(r, hi)]; const float oth = __shfl_xor(own, 32);
                lv[crow(r, 0)] = hi == 0 ? own : oth; lv[crow(r, 1)] = hi == 0 ? oth : own; }
            float tv[4]; int te[4];
#pragma unroll
            for (int r = 0; r < 4; ++r) { float mx = -INFINITY; int me = 0;
#pragma unroll
                for (int e = 0; e < 32; ++e) { if (lv[e] > mx) { mx = lv[e]; me = e; } }
                tv[r] = mx; te[r] = me;
#pragma unroll
                for (int e = 0; e < 32; ++e) { if (e == me) lv[e] = -INFINITY; } }
            const float e1 = __expf(tv[1] - tv[0]), e2 = __expf(tv[2] - tv[0]), e3 = __expf(tv[3] - tv[0]); const float inv = 1.f / (1.f + e1 + e2 + e3);
            if (hi == 0) { const size_t o = (size_t)tokl * 4;
                const float gv[4] = {inv, e1 * inv, e2 * inv, e3 * inv};
#pragma unroll
                for (int r = 0; r < 4; ++r) { const unsigned rk = __hip_atomic_fetch_add(lcnt + (te[r] & 31), 1u, __ATOMIC_RELAXED, __HIP_MEMORY_SCOPE_WORKGROUP);
                    tope[o + r] = (unsigned)(te[r] & 31); gate[o + r] = gv[r]; rank[o + r] = rk; } } }
        __syncthreads();
        if (tid < 32) __hip_atomic_store(F.ctl + CW_CNT + chunk * 32 + tid, lcnt[tid], RLX_AGENT);
    }
}

DI void ph_route(const Fr& F) {
    unsigned short* srcg = (unsigned short*)(F.ws + WS_SRC);
    const unsigned* tope = (const unsigned*)(F.ws + WS_TOPE); const unsigned* rank = (const unsigned*)(F.ws + WS_RANK); unsigned* dest = (unsigned*)(F.ws + WS_DEST);
    LAS unsigned* P = (LAS unsigned*)(F.lds); LAS unsigned* pst = P + 512; LAS unsigned* pad = P + 544; LAS unsigned* base = P + 576; LAS unsigned* nt = P + 608; LAS unsigned* totl = P + 640;
    const int tid = F.tid;
    __syncthreads();
    { const int e = tid & 31, part = tid >> 5; unsigned s = 0u;
        for (int c = 0; c < 16; ++c) s += ld_u32(F.ctl + CW_CNT + (part * 16 + c) * 32 + e);
        P[part * 32 + e] = s; }
    __syncthreads();
    if (tid < 32) { unsigned tot = 0u;
        for (int p = 0; p < 16; ++p) tot += P[p * 32 + tid];
        totl[tid] = tot; pad[tid] = (tot + 255u) & ~255u; }
    __syncthreads();
    if (tid == 0) { unsigned acc = 0u;
        for (int e = 0; e < 32; ++e) { pst[e] = acc; acc += pad[e]; }
        nt[0] = acc >> 8; }
    __syncthreads();
    if (F.blk < 32) { const int e = F.blk;
        for (unsigned i = totl[e] + tid; i < pad[e]; i += NTHR) srcg[pst[e] + i] = (unsigned short)0; }
    for (int chunk = F.blk; chunk < 256; chunk += F.G) {
        __syncthreads();
        if (tid < 32) { unsigned off = 0u; const int pf = chunk >> 4;
            for (int p = 0; p < pf; ++p) off += P[p * 32 + tid];
            for (int c = pf * 16; c < chunk; ++c) off += ld_u32(F.ctl + CW_CNT + c * 32 + tid);
            base[tid] = pst[tid] + off; }
        __syncthreads();
        { const size_t pi = (size_t)chunk * 512 + tid;
            const unsigned d = base[tope[pi] & 31u] + rank[pi];
            dest[pi] = d; srcg[d] = (unsigned short)(pi >> 2); }
        if (chunk == 0) { const unsigned ntl = nt[0];
            if (tid == 0) __hip_atomic_store(F.ctl + CW_TILE, ntl, RLX_AGENT);
            for (unsigned i = tid; i < ntl; i += NTHR) { unsigned e = 0u;
                for (unsigned k = 1; k < 32; ++k) if (pst[k] <= i * 256u) e = k;
                __hip_atomic_store(F.ctl + CW_TILE + 64 + i, e, RLX_AGENT); } }
    }
}

DI void ph_combine_ln2(const Args& a, const Fr& F, int layer) {
    const bf16* x1 = (const bf16*)(F.ws + WS_X1); const unsigned char* yr = F.ws + WS_XG; bf16* xb = (bf16*)(F.ws + WS_XB);
    const float* gate = (const float*)(F.ws + WS_GATE); const unsigned* dest = (const unsigned*)(F.ws + WS_DEST);
    const float* g = a.in[10] + (size_t)(layer * 2 + 1) * DM; const float* bb = a.in[11] + (size_t)(layer * 2 + 1) * DM;
    const int lane = F.lane; const int gw = F.blk * NWAVES + F.wave, NGW = F.G * NWAVES;
    for (int tok = gw; tok < NTOK; tok += 4 * NGW) { f32x4 v[4][4];
#pragma unroll
        for (int i = 0; i < 4; ++i) { const int tk = tok + i * NGW; if (tk < NTOK) {
#pragma unroll
            for (int jj = 0; jj < 4; ++jj) { const v2u w = *((const v2u*)(x1 + (size_t)tk * DM) + lane + 64 * jj);
                v[i][jj] = (f32x4){bf2f(w.x & 0xffffu), bf2f(w.x >> 16), bf2f(w.y & 0xffffu), bf2f(w.y >> 16)} * ALPHA; }
#pragma unroll
            for (int k = 0; k < 4; ++k) { const float gk = gate[(size_t)tk * 4 + k] * (1.f / F8_SY); const unsigned d = dest[(size_t)tk * 4 + k];
#pragma unroll
                for (int jj = 0; jj < 4; ++jj) { const int w = (int)*((const unsigned*)(yr + (size_t)d * DM) + lane + 64 * jj);
                    const f32x2 lo = __builtin_amdgcn_cvt_pk_f32_fp8(w, false), hi2 = __builtin_amdgcn_cvt_pk_f32_fp8(w, true);
                    v[i][jj][0] += gk * lo[0]; v[i][jj][1] += gk * lo[1]; v[i][jj][2] += gk * hi2[0]; v[i][jj][3] += gk * hi2[1]; } } } }
#pragma unroll
        for (int i = 0; i < 4; ++i) { const int tk = tok + i * NGW; if (tk < NTOK) {
            ln_row(v[i], g, bb, lane);
            if (layer == DEPTH - 1) store_row_f32(a.out + (size_t)tk * DM, v[i], lane);
            else store_row_bf16(xb + (size_t)tk * DM, v[i], lane); } } }
}
constexpr int LDS_BYTES = 147456;
constexpr int LDS_BARW = 145408, LDS_QSLOT = 145472, LDS_TILE_E = 133632, LDS_SRCL = 136192;
constexpr int NPL = 11;
constexpr int NPHASE = 1 + NPL * DEPTH;
#ifndef MK_SINGLE
#define MK_SINGLE 1
#endif
DI int q_next(const Fr& F, unsigned* ctr) {
    LAS int* slot = (LAS int*)(F.lds + LDS_QSLOT);
    __syncthreads();
    if (F.tid == 0) *slot = (int)__hip_atomic_fetch_add(ctr, 1u, RLX_AGENT);
    __syncthreads();
    return *slot;
}
DI int lane_id_fresh() { unsigned m_ = ~0u; asm volatile("" : "+s"(m_)); return (int)__builtin_amdgcn_mbcnt_hi(m_, __builtin_amdgcn_mbcnt_lo(m_, 0u)); }
#define RETID(F) do { int t2_ = F.tid; asm volatile("" : "+v"(t2_)); F.tid = t2_; F.lane = t2_ & 63; F.wave = __builtin_amdgcn_readfirstlane(t2_ >> 6); } while (0)
#ifndef PROBE_DUP
#define PROBE_DUP -1
#endif
#define NREP(q) ((PROBE_DUP == (q)) ? 2 : 1)
#define AS4 __attribute__((address_space(4)))
#define SITE() Args a; Fr F; { const AS4 Args* ap = (const AS4 Args*)__builtin_amdgcn_kernarg_segment_ptr(); asm volatile("" : "+s"(ap)); \
        _Pragma("unroll") for (int i_ = 0; i_ < 18; ++i_) a.in[i_] = ap->in[i_]; a.out = ap->out; a.ws = ap->ws; a.ph_lo = 0; a.ph_hi = 0; \
        int w_ = wv_s; asm volatile("" : "+s"(w_)); int t_ = w_ * 64 + lane_id_fresh(); asm volatile("" : "+v"(t_)); F.tid = t_; F.lane = t_ & 63; F.wave = __builtin_amdgcn_readfirstlane(t_ >> 6); \
        F.lds = (LAS unsigned char*)lds_raw; F.ws = a.ws; F.ctl = (unsigned*)(a.ws + WS_CTL); F.blk = blockIdx.x; F.G = gridDim.x; }
__global__ void __launch_bounds__(NTHR, 2) mega_fwd(Args a0) {
    extern __shared__ __attribute__((aligned(16))) unsigned char lds_raw[];
    const int wv_s = __builtin_amdgcn_readfirstlane((int)(threadIdx.x >> 6));
#if MK_SINGLE
    constexpr int lo = 0, hi = NPHASE; constexpr bool single = true;
#else
    const int lo = a0.ph_lo, hi = a0.ph_hi; constexpr bool single = false;
#endif
    if (threadIdx.x == 0) *(LAS v4u*)((LAS unsigned char*)lds_raw + LDS_BARW) = (v4u){0u, 0u, 0u, 0u};
    __syncthreads();
    if (single) (void)xcd_barrier_post((unsigned*)(a0.ws + WS_CTL) + CW_BAR, (volatile LAS unsigned*)((LAS unsigned char*)lds_raw + LDS_BARW));
#define IN(k) (lo <= (k) && (k) < hi)
#define SEAM() do { if (single) { const AS4 Args* ap_ = (const AS4 Args*)__builtin_amdgcn_kernarg_segment_ptr(); asm volatile("" : "+s"(ap_)); int w_ = wv_s; asm volatile("" : "+s"(w_)); \
        XcdBarrier b_; b_.bar = (unsigned*)(ap_->ws + WS_CTL) + CW_BAR; b_.x = xb_xcc_id(); b_.st = (volatile LAS unsigned*)((LAS unsigned char*)lds_raw + LDS_BARW); \
        xcd_barrier(b_, (w_ == 0) && (lane_id_fresh() == 0)); } } while (0)
    if (IN(0)) { _Pragma("unroll 1") for (int rep = 0; rep < NREP(100); ++rep) { { SITE(); ph_prologue(a, F); } SEAM(); } }
#pragma clang loop unroll(full)
    for (int L = 0; L < DEPTH; ++L) {
        const int pb = 1 + NPL * L, j = L >> 1; const bool odd = (L & 1) != 0;
        if (IN(pb + 0)) _Pragma("unroll 1") for (int rep = 0; rep < NREP(0); ++rep) {
            { SITE();
            const bf16* w = odd ? (const bf16*)(F.ws + WS_WOD) + (size_t)j * OD_N * 1024 : (const bf16*)(F.ws + WS_WEV) + (size_t)j * EV_N * 1024;
            const int N = odd ? OD_N : EV_N;
            pg8::Gemm g{(const bf16*)(F.ws + WS_XB), w, NTOK, N, 1024}; pg8::StaticOrder S; S.init(NTOK, N, F.G, F.blk);
            pg8::EpiBf16<0> E{(bf16*)(F.ws + WS_PROJ), N, nullptr, 1024, (size_t)1024, C2F};
            pg8::gemm_phase<pg8::EpiBf16<0>, pg8::StaticOrder, true, true>(F.lds, g, S, E, F.tid); }
            SEAM(); }
        if (IN(pb + 1)) _Pragma("unroll 1") for (int rep = 0; rep < NREP(1); ++rep) { { SITE(); if (odd) ph_odd_prep(a, F, j, L); else ph_even_prep(a, F, j); } SEAM(); }
        if (!odd && IN(pb + 2)) _Pragma("unroll 1") for (int rep = 0; rep < ((PROBE_DUP == 2 || (PROBE_DUP >= 21 && PROBE_DUP <= 22) || (PROBE_DUP >= 211 && PROBE_DUP <= 217)) ? 2 : 1); ++rep) {
            { SITE(); unsigned* ctr = F.ctl + CW_Q + 64 * (L * 2) + 1024 * rep;
            for (;;) { const int it = q_next(F, ctr); if (it >= 1280) break; RETID(F);
                if (it < 1024) { if (!(rep == 1 && PROBE_DUP == 22)) idx_unit(F, it & 3, 255 - (it >> 2), (rep == 1 && PROBE_DUP >= 211) ? PROBE_DUP - 210 : 0); } else { if (!(rep == 1 && (PROBE_DUP == 21 || PROBE_DUP >= 211))) moba_gate_chunk(F, it - 1024); } } }
            SEAM(); }
        if (IN(pb + 3)) _Pragma("unroll 1") for (int rep = 0; rep < ((PROBE_DUP == 3 || (PROBE_DUP == 31 && odd) || ((PROBE_DUP >= 32 && PROBE_DUP <= 34) && !odd)) ? 2 : 1); ++rep) {
            { SITE(); unsigned* ctr = F.ctl + CW_Q + 64 * (L * 2 + 1) + 1024 * rep;
            if (odd) { for (;;) { const int it = q_next(F, ctr); if (it >= 2048) break; RETID(F); const int bh = it & 63; fox_unit(F, L, bh >> 4, bh & 15, 31 - (it >> 6)); } }
            else { for (;;) { const int it = q_next(F, ctr); if (it >= 2048) break; RETID(F);
                    if (it < 1024) { const int bh = it & 31; if (!(rep == 1 && (PROBE_DUP == 33 || PROBE_DUP == 34))) moba_unit(a, F, bh >> 3, bh & 7, it >> 5); } else { if (!(rep == 1 && PROBE_DUP == 32)) dsa_chunk(a, F, it - 1024); } } } }
            SEAM(); }
        if (!odd && IN(pb + 4)) _Pragma("unroll 1") for (int rep = 0; rep < NREP(4); ++rep) { { SITE(); ph_even_post(F, j); } SEAM(); }
        if (IN(pb + 5)) _Pragma("unroll 1") for (int rep = 0; rep < NREP(5); ++rep) {
            { SITE();
            pg8::Gemm g{(const bf16*)(F.ws + WS_AO), (const bf16*)(F.ws + WS_WOUT) + (size_t)L * 1024 * 1024, NTOK, 1024, 1024}; pg8::StaticOrder S; S.init(NTOK, 1024, F.G, F.blk);
            EpiResBf16 E{(const bf16*)(F.ws + WS_XB), (bf16*)(F.ws + WS_YP), ALPHA};
            pg8::gemm_phase<EpiResBf16, pg8::StaticOrder, true, true>(F.lds, g, S, E, F.tid); }
            SEAM(); }
        if (IN(pb + 6)) _Pragma("unroll 1") for (int rep = 0; rep < NREP(6); ++rep) { { SITE(); ph_ln1_router(a, F, L); } SEAM(); }
        if (IN(pb + 7)) _Pragma("unroll 1") for (int rep = 0; rep < NREP(7); ++rep) { { SITE(); ph_route(F); } SEAM(); }
        if (IN(pb + 8)) _Pragma("unroll 1") for (int rep = 0; rep < NREP(8); ++rep) {
            { SITE(); const int ntl = (int)ld_u32(F.ctl + CW_TILE);
            LAS unsigned* tle = (LAS unsigned*)(F.lds + LDS_TILE_E);
            for (int i = F.tid; i < ntl; i += NTHR) tle[i] = ld_u32(F.ctl + CW_TILE + 64 + i);
            LAS unsigned* srcl = (LAS unsigned*)(F.lds + LDS_SRCL); const unsigned* srcg = (const unsigned*)(F.ws + WS_SRC);
            for (int i = F.tid; i < 17 * 128; i += NTHR) { const int pm = (i >> 7) * 32 + (F.blk & 7) * 4 + (F.blk >> 6); if (pm < ntl) srcl[i] = srcg[(size_t)pm * 128 + (i & 127)]; }
            __syncthreads();
            pg8::Gemm g{(const bf16*)(F.ws + WS_XB8), (const bf16*)(F.ws + WS_WGU + (size_t)L * 32 * 2048 * 1024), NR_MAX, 32 * 2048, 512};
            GroupOrder S{tle, ntl, 3, F.G, F.blk, (LAS const unsigned short*)srcl};
            EpiSwiglu E{F.ws + WS_ACT, a.in[15] + (size_t)L * 32 * 2048};
            pg8::gemm_phase<EpiSwiglu, GroupOrder, true, true, true, true>(F.lds, g, S, E, F.tid); }
            SEAM(); }
        if (IN(pb + 9)) _Pragma("unroll 1") for (int rep = 0; rep < NREP(9); ++rep) {
            { SITE(); const int ntl = (int)ld_u32(F.ctl + CW_TILE);
            LAS unsigned* tle = (LAS unsigned*)(F.lds + LDS_TILE_E);
            for (int i = F.tid; i < ntl; i += NTHR) tle[i] = ld_u32(F.ctl + CW_TILE + 64 + i);
            __syncthreads();
            pg8::Gemm g{(const bf16*)(F.ws + WS_ACT), (const bf16*)(F.ws + WS_WDN + (size_t)L * 32 * 1024 * 1024), NR_MAX, 32 * 1024, 512};
            GroupOrder S{tle, ntl, 2, F.G, F.blk, (LAS const unsigned short*)nullptr};
            EpiDown E{F.ws + WS_XG, a.in[17] + (size_t)L * 32 * 1024};
            pg8::gemm_phase<EpiDown, GroupOrder, true, true, true>(F.lds, g, S, E, F.tid); }
            SEAM(); }
        if (IN(pb + 10)) _Pragma("unroll 1") for (int rep = 0; rep < NREP(10); ++rep) { { SITE(); ph_combine_ln2(a, F, L); } if (L + 1 < DEPTH || rep + 1 < NREP(10)) SEAM(); }
        if (PROBE_DUP == 900 && L + 1 < DEPTH) { _Pragma("unroll 1") for (int xb = 0; xb < 10; ++xb) SEAM(); }
    }
#undef IN
#undef SEAM
}

extern "C" void kernel_launch(void* const* d_in, const int* in_sizes, int n_in, void* d_out, int out_size, void* d_ws, size_t ws_size, hipStream_t stream) {
    static int grid = 0;
    if (grid == 0) {
        if (n_in != 18 || out_size != NTOK * DM || ws_size < WS_END) { fprintf(stderr, "kernel_launch: unexpected shapes (n_in %d, out %d, ws %zu); nothing launched\n", n_in, out_size, ws_size); grid = -1; return; }
        int dev = 0, cus = 0, per_cu = 0;
        if (hipGetDevice(&dev) != hipSuccess || hipDeviceGetAttribute(&cus, hipDeviceAttributeMultiprocessorCount, dev) != hipSuccess) { grid = -1; return; }
        if (hipFuncSetAttribute((const void*)mega_fwd, hipFuncAttributeMaxDynamicSharedMemorySize, LDS_BYTES) != hipSuccess) { fprintf(stderr, "kernel_launch: hipFuncSetAttribute failed\n"); grid = -1; return; }
        if (hipOccupancyMaxActiveBlocksPerMultiprocessor(&per_cu, (const void*)mega_fwd, NTHR, LDS_BYTES) != hipSuccess || per_cu < 1) fprintf(stderr, "kernel_launch: occupancy query reports %d\n", per_cu);
        (void)hipGetLastError();
        if (cus < 256) { fprintf(stderr, "kernel_launch: %d CUs (the gathered gate/up GEMM's unit order assumes the MI355X's 256); nothing launched\n", cus); grid = -1; return; }
        grid = 256;
    }
    if (grid < 0) return;
    (void)hipMemsetAsync((char*)d_ws + WS_CTL, 0, CTL_ZERO_BYTES, stream);
#ifdef EXP_SKIP
    (void)hipMemsetAsync((char*)d_ws + WS_AO, 0, 64 * MiB, stream);
    (void)hipMemsetAsync((char*)d_ws + WS_OL, 0, 64 * MiB, stream);
    if (EXP_SKIP & 4) { (void)hipMemsetAsync((char*)d_ws + WS_XG, 0, 272 * MiB, stream); (void)hipMemsetAsync((char*)d_ws + WS_DEST, 0, 1 * MiB, stream); }
#endif
    Args a{};
    for (int i = 0; i < 18; ++i) a.in[i] = (const float*)d_in[i];
    a.out = (float*)d_out; a.ws = (unsigned char*)d_ws;
#if MK_SINGLE
    a.ph_lo = 0; a.ph_hi = NPHASE;
    hipLaunchKernelGGL(mega_fwd, dim3(grid), dim3(NTHR), LDS_BYTES, stream, a);
#else
    for (int p = 0; p < NPHASE; ++p) {
        if (p > 0) { const int L = (p - 1) / NPL, q = (p - 1) % NPL; if ((L & 1) && (q == 2 || q == 4)) continue;
#ifdef EXP_SKIP
            if ((EXP_SKIP & 1) && !(L & 1) && q <= 4) continue;
            if ((EXP_SKIP & 2) && (L & 1) && q <= 4) continue;
            if ((EXP_SKIP & 4) && q >= 7 && q <= 9) continue;
#endif
        }
        a.ph_lo = p; a.ph_hi = p + 1;
        hipLaunchKernelGGL(mega_fwd, dim3(grid), dim3(NTHR), LDS_BYTES, stream, a);
    }
#endif
}
```

```cpp
#include <hip/hip_runtime.h>
#include <cstdio>
#include <cstdint>
#ifdef EXP_SKIP
#define EXPF EXP_SKIP
#else
#define EXPF 0
#endif
constexpr int NB = 4, SEQ = 8192, DM = 1024, NTOK = NB * SEQ, DEPTH = 4;
constexpr int EV_N = 2560, OD_N = 3072;
constexpr int EC_QA = 0, EC_QB = 512, EC_KB = 1024, EC_VB = 1536, EC_CKV = 2048, EC_QI = 2176, EC_KI = 2432, EC_WI = 2496;
constexpr int OC_Q = 0, OC_K = 1024, OC_V = 2048;
constexpr float LOG2E = 1.4426950408889634f;
constexpr float C2F = 0.125f * LOG2E;
constexpr float ALPHA = 1.681792830507429f;
constexpr float LN_EPS = 1e-5f;
constexpr int NR_MAX = 131072 + 32 * 256;
constexpr int NWAVES = 8, NTHR = 512;
constexpr size_t MiB = (size_t)1 << 20;
constexpr size_t WS_CTL = 0, CTL_ZERO_BYTES = 256 * 1024;
constexpr size_t WS_WEV = 8 * MiB, WS_WOD = 18 * MiB, WS_WOUT = 30 * MiB, WS_WUKT = 38 * MiB, WS_WUVT = 39 * MiB;
constexpr size_t WS_WGU = 40 * MiB, WS_WDN = 552 * MiB;
constexpr size_t WS_X = 808 * MiB, WS_X1 = 936 * MiB, WS_YP = 1064 * MiB, WS_XB = 1192 * MiB;
constexpr size_t WS_PROJ = 1256 * MiB, WS_AO = 1448 * MiB, WS_XG = 1512 * MiB, WS_ACT = 1784 * MiB;
constexpr size_t WS_QL = 2056 * MiB, WS_OL = 2120 * MiB, WS_CKVN = 2184 * MiB, WS_SEL = 2192 * MiB;
constexpr size_t WS_KBAR = 2208 * MiB, WS_SEL3 = 2209 * MiB, WS_LOGF = 2210 * MiB, WS_CS = 2212 * MiB;
constexpr size_t WS_TOPE = 2213 * MiB, WS_GATE = 2214 * MiB, WS_RANK = 2215 * MiB, WS_DEST = 2216 * MiB, WS_PML = 2217 * MiB;
constexpr size_t WS_SRC = WS_DEST + 512 * 1024;
constexpr size_t WS_XB8 = 2226 * MiB;
constexpr size_t WS_KIC = 2258 * MiB;
constexpr size_t WS_END = 2262 * MiB;
constexpr float F8_SX = 16.f, F8_SWG = 256.f, F8_SA = 4.f, F8_SWD = 512.f, F8_SY = 32.f;
constexpr int CW_BAR = 4096, CW_Q = 8192, CW_KMAX = 12288, CW_CNT = 16384, CW_TILE = 32768;

#define GAS __attribute__((address_space(1)))
#define LAS __attribute__((address_space(3)))
#define DI __device__ __forceinline__
typedef unsigned short bf16;
typedef unsigned v4u __attribute__((ext_vector_type(4)));
typedef unsigned v2u __attribute__((ext_vector_type(2)));
typedef float f32x4 __attribute__((ext_vector_type(4)));
typedef float f32x2 __attribute__((ext_vector_type(2)));
typedef float f32x16 __attribute__((ext_vector_type(16)));
typedef short bf16x8 __attribute__((ext_vector_type(8)));
typedef short s16x4 __attribute__((ext_vector_type(4)));
typedef __bf16 bf16x2_t __attribute__((ext_vector_type(2)));
typedef GAS unsigned gu32;
#define RLX_AGENT __ATOMIC_RELAXED, __HIP_MEMORY_SCOPE_AGENT
#define LDS_WAIT() asm volatile("s_waitcnt lgkmcnt(0)" ::: "memory")

DI float bf2f(unsigned v) { return __uint_as_float(v << 16); }
DI unsigned cvtpk(float lo, float hi) { f32x2 v = {lo, hi}; bf16x2_t b = __builtin_convertvector(v, bf16x2_t); return __builtin_bit_cast(unsigned, b); }
DI unsigned f2bf(float f) { return cvtpk(f, 0.f) & 0xffffu; }
DI unsigned pk4_fp8(float a, float b, float c, float d) {
    a = fminf(fmaxf(a, -448.f), 448.f); b = fminf(fmaxf(b, -448.f), 448.f); c = fminf(fmaxf(c, -448.f), 448.f); d = fminf(fmaxf(d, -448.f), 448.f);
    int w = 0; w = __builtin_amdgcn_cvt_pk_fp8_f32(a, b, w, false); w = __builtin_amdgcn_cvt_pk_fp8_f32(c, d, w, true); return (unsigned)w; }
DI float ex2(float x) { return __builtin_amdgcn_exp2f(x); }
DI float wave_sum(float v) {
#pragma unroll
    for (int o = 1; o < 64; o <<= 1) v += __shfl_xor(v, o);
    return v;
}
DI float wave_max(float v) {
#pragma unroll
    for (int o = 1; o < 64; o <<= 1) v = fmaxf(v, __shfl_xor(v, o));
    return v;
}
DI unsigned ld_u32(const unsigned* p) { return __hip_atomic_load(p, RLX_AGENT); }
DI int crow(int r, int hi) { return (r & 3) + 8 * (r >> 2) + 4 * hi; }
DI f32x16 mfma32(bf16x8 a, bf16x8 b, f32x16 c) { return __builtin_amdgcn_mfma_f32_32x32x16_bf16(a, b, c, 0, 0, 0); }
DI f32x4 mfma16(bf16x8 a, bf16x8 b, f32x4 c) { return __builtin_amdgcn_mfma_f32_16x16x32_bf16(a, b, c, 0, 0, 0); }
typedef short v4i16_t __attribute__((ext_vector_type(4)));
DI s16x4 vtr(LAS const char* p) { return __builtin_bit_cast(s16x4, __builtin_amdgcn_ds_read_tr16_b64_v4i16((LAS v4i16_t*)p)); }
DI bf16x8 cat8(s16x4 a, s16x4 b) { return (bf16x8){a[0], a[1], a[2], a[3], b[0], b[1], b[2], b[3]}; }
DI int t5_bucket(int n) {
    if (n < 16) return n;
    int bkt = 16;
    bkt += (n >= 21); bkt += (n >= 27); bkt += (n >= 35); bkt += (n >= 46); bkt += (n >= 59); bkt += (n >= 77); bkt += (n >= 99); bkt += (n >= 128);
    bkt += (n >= 166); bkt += (n >= 216); bkt += (n >= 280); bkt += (n >= 363); bkt += (n >= 470); bkt += (n >= 609); bkt += (n >= 790);
    return bkt;
}
namespace pg8 {
#define PG8_LAS __attribute__((address_space(3)))
typedef unsigned short bf16_t;
typedef short bf16x8 __attribute__((ext_vector_type(8)));
typedef float f32x4 __attribute__((ext_vector_type(4)));
typedef unsigned u32x4 __attribute__((ext_vector_type(4)));
constexpr int BM = 256, BK = 64, HALF = 128, HTB = HALF * BK * 2  , STAGE_BYTES = 8 * HTB, NXCD = 8, WGM = 8;

__host__ __device__ __forceinline__ int lds_byte(int r, int c) { const int st = (r >> 4) * 2 + (c >> 5), rr = r & 15, cc = c & 31, ob = rr * 64 + cc * 2; return st * 1024 + (ob ^ (((ob >> 9) & 1) << 5)); }
__host__ __device__ __forceinline__ void stage_rc(int b, int& R, int& C) { const int st = b / 1024, sb = b % 1024, swz = sb ^ (((sb >> 9) & 1) << 5); R = (st >> 1) * 16 + swz / 64; C = (st & 1) * 32 + (swz % 64) / 2; }
__host__ __device__ __forceinline__ int perm32(int rho) { const int n = rho >> 4, i = rho & 15; return 8 * (i >> 2) + 4 * n + (i & 3); }

typedef int i32x8 __attribute__((ext_vector_type(8))); typedef int i32x4v __attribute__((ext_vector_type(4)));
__device__ __forceinline__ i32x8 pg8_cat8(bf16x8 lo, bf16x8 hi) { const i32x4v a = __builtin_bit_cast(i32x4v, lo), b = __builtin_bit_cast(i32x4v, hi); return (i32x8){a[0], a[1], a[2], a[3], b[0], b[1], b[2], b[3]}; }
struct Unit { int pm, pn; };
struct Gemm { const bf16_t* A; const bf16_t* Bt; int M, N, K; };

struct StaticOrder {
    int nM, nN, nwg, G, c;
    __host__ __device__ void init(int M, int N, int G_, int c_) { nM = M / BM; nN = N / BM; nwg = nM * nN; G = G_; c = c_; }
    __host__ __device__ bool next(int i, Unit& u) const {
        const long L = (long)i * G + c; if (L >= nwg) return false;
        int wgid = (int)L; { const int q = nwg / NXCD, r = nwg % NXCD, xcd = wgid % NXCD, off = wgid / NXCD; wgid = (xcd < r ? xcd * (q + 1) : r * (q + 1) + (xcd - r) * q) + off; }
        const int nig = WGM * nN, gid = wgid / nig, fm = gid * WGM, gsz = (nM - fm) < WGM ? (nM - fm) : WGM;
        u.pm = fm + ((wgid % nig) % gsz); u.pn = (wgid % nig) / gsz; return true;
    }
    __device__ __forceinline__ void a_ready(const Unit&) const {}
    __device__ __forceinline__ void done(const Unit&) const {}
};

__device__ __forceinline__ unsigned cvt_pk_bf16(float lo, float hi) { unsigned r; asm volatile("v_cvt_pk_bf16_f32 %0, %1, %2" : "=v"(r) : "v"(lo), "v"(hi)); return r; }
typedef float f32x2 __attribute__((ext_vector_type(2)));
__device__ __forceinline__ f32x2 gelu_pk(f32x2 v) {
    const f32x2 av = __builtin_elementwise_abs(v), d = av * 0.2316418882f + 1.0f;
    f32x2 t; t.x = __builtin_amdgcn_rcpf(d.x); t.y = __builtin_amdgcn_rcpf(d.y);
    f32x2 q = t * 0.5307027145f + (-0.7265760135f); q = q * t + 0.7107068705f; q = q * t + (-0.142248368f); q = q * t + 0.127414796f; q = q * t;
    const f32x2 s = (v * v) * (-0.72134752044f);
    f32x2 e; e.x = __builtin_amdgcn_exp2f(s.x); e.y = __builtin_amdgcn_exp2f(s.y);
    const f32x2 m = v * (q * e), r = v - m;
    f32x2 o; o.x = v.x < 0.f ? m.x : r.x; o.y = v.y < 0.f ? m.y : r.y; return o;
}

template <int ACT  > struct EpiBf16 {
    static constexpr bool PERM = true, AFTER_DRAIN = false; static_assert(ACT == 0 || ACT == 1, "EpiBf16: ACT is 0 (none) or 1 (gelu_pk)");
    bf16_t* O; int ldc; const float* bias; int split_cols; size_t split_stride; float scale0;
    __device__ __forceinline__ void operator()(const f32x4 (&acc)[2][2][4][2], const Unit& u, int wr, int wc, int fr, int fq) const {
        const int row0 = u.pm * BM + wr * 64 + fr; int colt = u.pn * BM; bf16_t* base = O;
        float sc = 1.f; if (split_cols) { const int t = colt / split_cols; base += (size_t)t * split_stride; colt -= t * split_cols; if (t == 0) sc = scale0; }
        const int col0 = colt + wc * 32 + 8 * fq, bcol0 = u.pn * BM + wc * 32 + 8 * fq;
        f32x4 bv[2][2];
#pragma unroll
        for (int bj = 0; bj < 2; ++bj)
#pragma unroll
            for (int n = 0; n < 2; ++n) bv[bj][n] = bias ? *(const f32x4*)(bias + bcol0 + bj * HALF + 4 * n) : (f32x4){0.f, 0.f, 0.f, 0.f};
#pragma unroll
        for (int ai = 0; ai < 2; ++ai)
#pragma unroll
            for (int m = 0; m < 4; ++m) { bf16_t* rowp = base + (size_t)(row0 + ai * HALF + m * 16) * ldc + col0;
#pragma unroll
                for (int bj = 0; bj < 2; ++bj) { f32x4 v0 = acc[ai][bj][m][0] + bv[bj][0], v1 = acc[ai][bj][m][1] + bv[bj][1];
                    if (ACT == 1) { f32x2 a = gelu_pk((f32x2){v0[0], v0[1]}), b = gelu_pk((f32x2){v0[2], v0[3]}), c = gelu_pk((f32x2){v1[0], v1[1]}), d = gelu_pk((f32x2){v1[2], v1[3]});
                        v0 = (f32x4){a.x, a.y, b.x, b.y}; v1 = (f32x4){c.x, c.y, d.x, d.y}; }
                    v0 = v0 * sc; v1 = v1 * sc; u32x4 w; w.x = cvt_pk_bf16(v0[0], v0[1]); w.y = cvt_pk_bf16(v0[2], v0[3]); w.z = cvt_pk_bf16(v1[0], v1[1]); w.w = cvt_pk_bf16(v1[2], v1[3]);
                    *(u32x4*)(rowp + bj * HALF) = w; } }
    }
};

template <class Epi, class Sched, bool ALIGN_EPI = false, bool SP2 = false, bool F8 = false, bool GATH = false  >
__device__ __forceinline__ void gemm_phase(PG8_LAS unsigned char* lds, const Gemm g, const Sched& S, const Epi& E, int tid_in) {
    int tid_l = tid_in; asm volatile("" : "+v"(tid_l));
    const int tid = tid_l, wid = __builtin_amdgcn_readfirstlane(tid >> 6), lane = tid & 63, wr = wid >> 2, wc = wid & 3, fr = lane & 15, fq = lane >> 4;
    const int K = g.K, nt = K / BK;
    unsigned voffA[2], voffB[2]; int rowA[2]; unsigned colA[2];
#pragma unroll
    for (int i = 0; i < 2; ++i) { int R, C; stage_rc(tid * 16 + i * 8192, R, C); const int Rb = Epi::PERM ? ((R & ~31) + perm32(R & 31)) : R;
        voffA[i] = (unsigned)(R * K + C) * 2u; voffB[i] = (unsigned)(Rb * K + C) * 2u; rowA[i] = R; colA[i] = (unsigned)C * 2u; }
    static_assert(!GATH || SP2, "GATH: SP2 schedule only");
    unsigned cgo[2][2], ngo[2][2];
#define PG8_GOFF(dst, uidx) do { _Pragma("unroll") for (int _h = 0; _h < 2; ++_h) _Pragma("unroll") for (int _i = 0; _i < 2; ++_i) dst[_h][_i] = S.gsrc((uidx), _h * HALF + rowA[_i]) + colA[_i]; } while (0)
#define PG8_STAGE_G(bufoff, kb, o0, o1) do { \
        __builtin_amdgcn_global_load_lds((const unsigned*)((const char*)g.A + (kb) + (o0)), (PG8_LAS unsigned*)(lds + (bufoff) + ldsw), 16, 0, 0); \
        __builtin_amdgcn_global_load_lds((const unsigned*)((const char*)g.A + (kb) + (o1)), (PG8_LAS unsigned*)(lds + (bufoff) + ldsw + 8192), 16, 0, 0); } while (0)
    const size_t kstep = (size_t)(BK * 2);
    const size_t hstep = (size_t)HALF * K * 2;
    const size_t tstep = 2 * hstep;
    const unsigned ldsw = (unsigned)wid * 1024u;
    const int aoff = lds_byte(wr * 64 + fr, fq * 8), boff = lds_byte(wc * 32 + fr, fq * 8);
#define PG8_SA(b, h) (((b) * 2 + (h)) * HTB)
#define PG8_SB(b, h) ((4 + (b) * 2 + (h)) * HTB)
#define PG8_STAGE(bufoff, gbase, voff) do { _Pragma("unroll") for (int _i = 0; _i < 2; ++_i) \
        __builtin_amdgcn_global_load_lds((const unsigned*)((const char*)(gbase) + (voff)[_i]), (PG8_LAS unsigned*)(lds + (bufoff) + ldsw + _i * 8192), 16, 0, 0); } while (0)
#define PG8_LDA(dst, b, h) do { _Pragma("unroll") for (int m = 0; m < 4; ++m) _Pragma("unroll") for (int k = 0; k < 2; ++k) dst[m][k] = *(const PG8_LAS bf16x8*)(lds + PG8_SA(b, h) + aoff + m * 2048 + k * 1024); } while (0)
#define PG8_LDB(dst, b, h) do { _Pragma("unroll") for (int n = 0; n < 2; ++n) _Pragma("unroll") for (int k = 0; k < 2; ++k) dst[n][k] = *(const PG8_LAS bf16x8*)(lds + PG8_SB(b, h) + boff + n * 2048 + k * 1024); } while (0)
#define PG8_MMA(ai, bj, At, Bt) do { __builtin_amdgcn_s_setprio(1); if constexpr (!F8) { _Pragma("unroll") for (int m = 0; m < 4; ++m) _Pragma("unroll") for (int n = 0; n < 2; ++n) _Pragma("unroll") for (int k = 0; k < 2; ++k) \
        acc[ai][bj][m][n] = __builtin_amdgcn_mfma_f32_16x16x32_bf16(Bt[n][k], At[m][k], acc[ai][bj][m][n], 0, 0, 0); } else { _Pragma("unroll") for (int m = 0; m < 4; ++m) _Pragma("unroll") for (int n = 0; n < 2; ++n) \
        acc[ai][bj][m][n] = __builtin_amdgcn_mfma_scale_f32_16x16x128_f8f6f4(pg8_cat8(Bt[n][0], Bt[n][1]), pg8_cat8(At[m][0], At[m][1]), acc[ai][bj][m][n], 0, 0, 0, 0x7F7F7F7F, 0, 0x7F7F7F7F); \
        _Pragma("unroll") for (int m = 0; m < 4; ++m) _Pragma("unroll") for (int n = 0; n < 2; ++n) asm volatile("" : "+v"(acc[ai][bj][m][n]));   } __builtin_amdgcn_s_setprio(0); } while (0)
#define PG8_WAIT_V(n) asm volatile("s_waitcnt vmcnt(" #n ")" ::: "memory")
#define PG8_WAIT_L(n) asm volatile("s_waitcnt lgkmcnt(" #n ")" ::: "memory")
#define PG8_BAR __builtin_amdgcn_s_barrier()
#define PG8_SCHED __builtin_amdgcn_sched_barrier(0)
    Unit cur, nxt; int ui = 0;
    if (!S.next(0, cur)) return;
    f32x4 acc[2][2][4][2];
#pragma unroll
    for (int a = 0; a < 2; ++a)
#pragma unroll
        for (int b = 0; b < 2; ++b)
#pragma unroll
            for (int m = 0; m < 4; ++m)
#pragma unroll
                for (int n = 0; n < 2; ++n) acc[a][b][m][n] = (f32x4){0.f, 0.f, 0.f, 0.f};
    bf16x8 At[4][2], B0[2][2], B1[2][2];
    const char* cA = (const char*)g.A + (size_t)cur.pm * tstep; const char* cB = (const char*)g.Bt + (size_t)cur.pn * tstep;
    S.a_ready(cur);
    if constexpr (SP2) {
        if constexpr (GATH) { PG8_GOFF(cgo, 0); }
        PG8_STAGE(PG8_SB(0, 0), cB, voffB); PG8_STAGE(PG8_SB(0, 1), cB + hstep, voffB);
        if constexpr (GATH) { PG8_STAGE_G(PG8_SA(0, 0), 0, cgo[0][0], cgo[0][1]); PG8_STAGE_G(PG8_SA(0, 1), 0, cgo[1][0], cgo[1][1]); }
        else { PG8_STAGE(PG8_SA(0, 0), cA, voffA); PG8_STAGE(PG8_SA(0, 1), cA + hstep, voffA); }
        if (wr == 1) PG8_BAR;
        PG8_WAIT_V(2); PG8_BAR;
        PG8_STAGE(PG8_SB(1, 0), cB + kstep, voffB);
        if constexpr (GATH) { PG8_STAGE_G(PG8_SA(1, 0), kstep, cgo[0][0], cgo[0][1]); } else { PG8_STAGE(PG8_SA(1, 0), cA + kstep, voffA); }
        PG8_STAGE(PG8_SB(1, 1), cB + hstep + kstep, voffB);
        PG8_WAIT_V(6); PG8_BAR;
    } else {
        PG8_STAGE(PG8_SB(0, 0), cB, voffB); PG8_STAGE(PG8_SA(0, 0), cA, voffA); PG8_STAGE(PG8_SB(0, 1), cB + hstep, voffB); PG8_STAGE(PG8_SA(0, 1), cA + hstep, voffA);
        if (wr == 1) PG8_BAR;
        PG8_WAIT_V(4); PG8_BAR;
        PG8_STAGE(PG8_SB(1, 0), cB + kstep, voffB); PG8_STAGE(PG8_SA(1, 0), cA + kstep, voffA); PG8_STAGE(PG8_SB(1, 1), cB + hstep + kstep, voffB);
        PG8_WAIT_V(6); PG8_BAR;
    }
    for (;;) {
        const bool has_next = S.next(ui + 1, nxt);
        if constexpr (GATH) { if (has_next) { PG8_GOFF(ngo, ui + 1); } else {
            _Pragma("unroll") for (int _h = 0; _h < 2; ++_h) _Pragma("unroll") for (int _i = 0; _i < 2; ++_i) ngo[_h][_i] = cgo[_h][_i]; } }
        const char* nA = has_next ? (const char*)g.A + (size_t)nxt.pm * tstep : cA; const char* nB = has_next ? (const char*)g.Bt + (size_t)nxt.pn * tstep : cB;
        for (int t = 0; t < nt; t += 2) {
            const bool last = (t == nt - 2);
            const char* a1 = cA + (size_t)(t + 1) * kstep;
            const char* a2 = last ? nA : cA + (size_t)(t + 2) * kstep; const char* b2 = last ? nB : cB + (size_t)(t + 2) * kstep;
            const char* a3 = a2 + kstep; const char* b3 = b2 + kstep;
            if (last && has_next) S.a_ready(nxt);
            unsigned g0a = 0, g0b = 0, g1a = 0, g1b = 0; size_t kb2 = 0;
            if constexpr (GATH) { g0a = last ? ngo[0][0] : cgo[0][0]; g0b = last ? ngo[0][1] : cgo[0][1]; g1a = last ? ngo[1][0] : cgo[1][0]; g1b = last ? ngo[1][1] : cgo[1][1]; kb2 = last ? (size_t)0 : (size_t)(t + 2) * kstep; }
            if constexpr (SP2) {
            PG8_LDB(B0, 0, 0); PG8_LDB(B1, 0, 1); PG8_SCHED; PG8_LDA(At, 0, 0);
            if constexpr (GATH) { PG8_STAGE_G(PG8_SA(1, 1), (size_t)(t + 1) * kstep, cgo[1][0], cgo[1][1]); } else { PG8_STAGE(PG8_SA(1, 1), a1 + hstep, voffA); }
            PG8_WAIT_V(8); PG8_WAIT_L(0); PG8_BAR; PG8_MMA(0, 0, At, B0); PG8_MMA(0, 1, At, B1); PG8_BAR; PG8_SCHED;
            PG8_LDA(At, 0, 1); PG8_STAGE(PG8_SB(0, 0), b2, voffB); PG8_STAGE(PG8_SB(0, 1), b2 + hstep, voffB);
            if constexpr (GATH) { PG8_STAGE_G(PG8_SA(0, 0), kb2, g0a, g0b); } else { PG8_STAGE(PG8_SA(0, 0), a2, voffA); }
            PG8_WAIT_V(8); PG8_WAIT_L(0); PG8_BAR; PG8_MMA(1, 0, At, B0); PG8_MMA(1, 1, At, B1); PG8_BAR; PG8_SCHED;
            PG8_LDB(B0, 1, 0); PG8_LDB(B1, 1, 1); PG8_SCHED; PG8_LDA(At, 1, 0);
            if constexpr (GATH) { PG8_STAGE_G(PG8_SA(0, 1), kb2, g1a, g1b); } else { PG8_STAGE(PG8_SA(0, 1), a2 + hstep, voffA); }
            PG8_WAIT_V(8); PG8_WAIT_L(0); PG8_BAR; PG8_MMA(0, 0, At, B0); PG8_MMA(0, 1, At, B1); PG8_BAR; PG8_SCHED;
            PG8_LDA(At, 1, 1); PG8_STAGE(PG8_SB(1, 0), b3, voffB); PG8_STAGE(PG8_SB(1, 1), b3 + hstep, voffB);
            if constexpr (GATH) { PG8_STAGE_G(PG8_SA(1, 0), kb2 + kstep, g0a, g0b); } else { PG8_STAGE(PG8_SA(1, 0), a3, voffA); }
            PG8_WAIT_V(8); PG8_WAIT_L(0); PG8_BAR; PG8_MMA(1, 0, At, B0); PG8_MMA(1, 1, At, B1); PG8_BAR; PG8_SCHED;
            } else {
            PG8_LDB(B0, 0, 0); PG8_SCHED; PG8_LDA(At, 0, 0); PG8_STAGE(PG8_SA(1, 1), a1 + hstep, voffA);
            PG8_WAIT_L(8); PG8_BAR; PG8_WAIT_L(0); PG8_MMA(0, 0, At, B0); PG8_BAR; PG8_SCHED;
            PG8_LDB(B1, 0, 1); PG8_STAGE(PG8_SB(0, 0), b2, voffB);
            PG8_BAR; PG8_WAIT_L(0); PG8_MMA(0, 1, At, B1); PG8_BAR;
            PG8_LDA(At, 0, 1); PG8_STAGE(PG8_SA(0, 0), a2, voffA);
            PG8_BAR; PG8_WAIT_L(0); PG8_MMA(1, 0, At, B0); PG8_BAR; PG8_SCHED;
            PG8_STAGE(PG8_SB(0, 1), b2 + hstep, voffB);
            PG8_WAIT_V(6); PG8_BAR; PG8_MMA(1, 1, At, B1); PG8_BAR;
            PG8_LDB(B0, 1, 0); PG8_SCHED; PG8_LDA(At, 1, 0); PG8_STAGE(PG8_SA(0, 1), a2 + hstep, voffA);
            PG8_WAIT_L(8); PG8_BAR; PG8_WAIT_L(0); PG8_MMA(0, 0, At, B0); PG8_BAR; PG8_SCHED;
            PG8_LDB(B1, 1, 1); PG8_STAGE(PG8_SB(1, 0), b3, voffB);
            PG8_BAR; PG8_WAIT_L(0); PG8_MMA(0, 1, At, B1); PG8_BAR;
            PG8_LDA(At, 1, 1); PG8_STAGE(PG8_SA(1, 0), a3, voffA);
            PG8_BAR; PG8_WAIT_L(0); PG8_MMA(1, 0, At, B0); PG8_BAR; PG8_SCHED;
            PG8_STAGE(PG8_SB(1, 1), b3 + hstep, voffB);
            PG8_WAIT_V(6); PG8_BAR; PG8_MMA(1, 1, At, B1); PG8_BAR;
            }
        }
        if constexpr (ALIGN_EPI) { if (wr == 0) PG8_BAR; }
        if constexpr (!Epi::AFTER_DRAIN) { E(acc, cur, wr, wc, fr, fq); S.done(cur); }
        if (!has_next) break;
#pragma unroll
        for (int a = 0; a < 2; ++a)
#pragma unroll
            for (int b = 0; b < 2; ++b)
#pragma unroll
                for (int m = 0; m < 4; ++m)
#pragma unroll
                    for (int n = 0; n < 2; ++n) acc[a][b][m][n] = (f32x4){0.f, 0.f, 0.f, 0.f};
        cur = nxt; cA = nA; cB = nB; ++ui;
        if constexpr (GATH) { _Pragma("unroll") for (int _h = 0; _h < 2; ++_h) _Pragma("unroll") for (int _i = 0; _i < 2; ++_i) cgo[_h][_i] = ngo[_h][_i]; }
        if constexpr (ALIGN_EPI) { if (wr == 1) PG8_BAR; }
    }
    PG8_WAIT_V(0);
    if constexpr (!ALIGN_EPI) { if (wr == 0) PG8_BAR; }
    PG8_BAR;
    if constexpr (Epi::AFTER_DRAIN) { E.fused(acc, cur, wr, wc, fr, fq, lds, wid, lane); S.done(cur); }
#undef PG8_SA
#undef PG8_SB
#undef PG8_STAGE
#undef PG8_STAGE_G
#undef PG8_GOFF
#undef PG8_LDA
#undef PG8_LDB
#undef PG8_MMA
#undef PG8_WAIT_V
#undef PG8_WAIT_L
#undef PG8_BAR
#undef PG8_SCHED
}
}

#ifndef PG8_SP2
#define PG8_SP2 true
#endif
#ifndef PG8_ALIGN
#define PG8_ALIGN true
#endif
#define XB_TMO      128
#define XB_XCNT(j)  (256  + 64 * (j))
#define XB_XSUB(j)  (1280 + 64 * (j))
#define XB_XGEN(j)  (2304 + 64 * (j))
#define XB_TOP      3328
#define XB_TOPGEN   3392
#define XCD_BAR_WORDS 3456
#define XB_SPIN_CAP (1u << 18)

__device__ __forceinline__ unsigned xb_ld(unsigned* p)              { return __hip_atomic_load(p, __ATOMIC_RELAXED, __HIP_MEMORY_SCOPE_AGENT); }
__device__ __forceinline__ unsigned xb_add(unsigned* p, unsigned v) { return __hip_atomic_fetch_add(p, v, __ATOMIC_RELAXED, __HIP_MEMORY_SCOPE_AGENT); }
__device__ __forceinline__ unsigned xb_xcc_id() { return (unsigned)__builtin_amdgcn_s_getreg((3 << 11) | 20) & 0xFu; }
#define XB_SPIN(cond, bar) do { unsigned _sp = 0; while (cond) { __builtin_amdgcn_s_sleep(1); \
    if ((++_sp & 255u) == 0u) { if (xb_ld(&(bar)[XB_TMO])) break; if (_sp > XB_SPIN_CAP) { atomicAdd(&(bar)[XB_TMO], 1u); break; } } } } while (0)

struct XcdBarrier {
    unsigned* bar; unsigned x;
    volatile LAS unsigned* st;
};

__device__ __forceinline__ XcdBarrier xcd_barrier_post(unsigned* bar, volatile LAS unsigned* st) {
    XcdBarrier b; b.bar = bar; b.x = xb_xcc_id(); b.st = st;
    if (threadIdx.x == 0) (void)xb_add(&bar[XB_XCNT(b.x)], 1u);
    return b;
}
__device__ __forceinline__ void xcd_barrier_complete(unsigned* bar, unsigned x, unsigned& nloc, unsigned& nx) {
    const unsigned G = gridDim.x * gridDim.y * gridDim.z;
    unsigned sum, cnt, mine, sp = 0u;
    for (;;) {
        sum = 0u; cnt = 0u; mine = 0u;
#pragma unroll
        for (unsigned j = 0; j < 16; ++j) { const unsigned c = xb_ld(&bar[XB_XCNT(j)]); sum += c; cnt += (c > 0u) ? 1u : 0u; mine = (j == x) ? c : mine; }
        if (sum == G) break;
        __builtin_amdgcn_s_sleep(1);
        if ((++sp & 255u) == 0u) { if (xb_ld(&bar[XB_TMO])) break; if (sp > XB_SPIN_CAP) { atomicAdd(&bar[XB_TMO], 1u); break; } }
    }
    nloc = mine > 0u ? mine : 1u; nx = cnt > 0u ? cnt : 1u;
}

__device__ __forceinline__ void xcd_barrier(const XcdBarrier& b, const bool is_t0  ) {
    asm volatile("s_waitcnt vmcnt(0)" ::: "memory");
    __syncthreads();
    if (is_t0) {
        unsigned* bar = b.bar;
        __builtin_amdgcn_s_waitcnt(0);
        unsigned nloc = b.st[0], nx = b.st[1];
        if (nloc == 0u) { xcd_barrier_complete(bar, b.x, nloc, nx); b.st[0] = nloc; b.st[1] = nx; }
        const unsigned old = xb_add(&bar[XB_XSUB(b.x)], 1u);
        const unsigned gen = old / nloc;
        if (old + 1u == (gen + 1u) * nloc) {
            __builtin_amdgcn_fence(__ATOMIC_RELEASE, "agent");
            asm volatile("s_waitcnt vmcnt(0)" ::: "memory");
            const unsigned og = xb_add(&bar[XB_TOP], 1u);
            const unsigned tg = og / nx;
            if (og + 1u == (tg + 1u) * nx) xb_add(&bar[XB_TOPGEN], 1u);
            else XB_SPIN(xb_ld(&bar[XB_TOPGEN]) == tg, bar);
            __builtin_amdgcn_fence(__ATOMIC_ACQUIRE, "agent");
            xb_add(&bar[XB_XGEN(b.x)], 1u);
            asm volatile("s_waitcnt vmcnt(0)" ::: "memory");
        } else {
            XB_SPIN(xb_ld(&bar[XB_XGEN(b.x)]) == gen, bar);
            __builtin_amdgcn_fence(__ATOMIC_ACQUIRE, "agent");
            asm volatile("s_waitcnt vmcnt(0)" ::: "memory");
        }
    }
    __syncthreads();
}
struct EpiResBf16 {
    static constexpr bool PERM = true, AFTER_DRAIN = false;
    const bf16* xin; bf16* yp; float alpha;
    DI void operator()(const pg8::f32x4 (&acc)[2][2][4][2], const pg8::Unit& u, int wr, int wc, int fr, int fq) const {
        const int row0 = u.pm * 256 + wr * 64 + fr, col0 = u.pn * 256 + wc * 32 + 8 * fq;
#pragma unroll
        for (int ai = 0; ai < 2; ++ai)
#pragma unroll
            for (int m = 0; m < 4; ++m) {
                const size_t ro = (size_t)(row0 + ai * 128 + m * 16) * DM;
#pragma unroll
                for (int bj = 0; bj < 2; ++bj) {
                    const size_t o = ro + col0 + bj * 128;
                    const v4u xv = *(const v4u*)(xin + o);
                    const f32x4 a0 = acc[ai][bj][m][0], a1 = acc[ai][bj][m][1];
                    v4u w;
                    w.x = cvtpk(bf2f(xv.x & 0xffffu) * alpha + a0[0], bf2f(xv.x >> 16) * alpha + a0[1]); w.y = cvtpk(bf2f(xv.y & 0xffffu) * alpha + a0[2], bf2f(xv.y >> 16) * alpha + a0[3]);
                    w.z = cvtpk(bf2f(xv.z & 0xffffu) * alpha + a1[0], bf2f(xv.z >> 16) * alpha + a1[1]); w.w = cvtpk(bf2f(xv.w & 0xffffu) * alpha + a1[2], bf2f(xv.w >> 16) * alpha + a1[3]);
                    *(v4u*)(yp + o) = w;
                }
            }
    }
};
struct EpiSwiglu {
    static constexpr bool PERM = true, AFTER_DRAIN = false;
    unsigned char* act; const float* bgu;
    DI void operator()(const pg8::f32x4 (&acc)[2][2][4][2], const pg8::Unit& u, int wr, int wc, int fr, int fq) const {
        const int e = u.pn >> 3, pl = u.pn & 7;
        const int row0 = u.pm * 256 + wr * 64 + fr, cih = pl * 128 + wc * 32 + 8 * fq;
        const float* bg = bgu + e * 2048 + cih;
        const f32x4 bg0 = *(const f32x4*)(bg), bg1 = *(const f32x4*)(bg + 4), bu0 = *(const f32x4*)(bg + 1024), bu1 = *(const f32x4*)(bg + 1028);
#pragma unroll
        for (int ai = 0; ai < 2; ++ai)
#pragma unroll
            for (int m = 0; m < 4; ++m) {
                constexpr float RS = 1.f / (F8_SX * F8_SWG);
                const f32x4 g0 = acc[ai][0][m][0] * RS + bg0, g1 = acc[ai][0][m][1] * RS + bg1, u0 = acc[ai][1][m][0] * RS + bu0, u1 = acc[ai][1][m][1] * RS + bu1;
                float r[8];
#pragma unroll
                for (int i = 0; i < 8; ++i) {
                    float g = i < 4 ? g0[i & 3] : g1[i & 3], uu = i < 4 ? u0[i & 3] : u1[i & 3];
                    g = fminf(g, 7.0f); uu = fminf(fmaxf(uu, -7.0f), 7.0f);
                    const float sg = __builtin_amdgcn_rcpf(1.0f + ex2(-1.702f * LOG2E * g));
                    r[i] = (uu + 1.0f) * g * sg * F8_SA;
                }
                v2u w; w.x = pk4_fp8(r[0], r[1], r[2], r[3]); w.y = pk4_fp8(r[4], r[5], r[6], r[7]);
                *(v2u*)(act + (size_t)(row0 + ai * 128 + m * 16) * DM + cih) = w;
            }
    }
};
struct EpiDown {
    static constexpr bool PERM = true, AFTER_DRAIN = false;
    unsigned char* yr; const float* bdn;
    DI void operator()(const pg8::f32x4 (&acc)[2][2][4][2], const pg8::Unit& u, int wr, int wc, int fr, int fq) const {
        const int e = u.pn >> 2, pl = u.pn & 3;
        const int row0 = u.pm * 256 + wr * 64 + fr, col0 = pl * 256 + wc * 32 + 8 * fq;
        f32x4 bv[2][2];
#pragma unroll
        for (int bj = 0; bj < 2; ++bj) { bv[bj][0] = *(const f32x4*)(bdn + e * 1024 + col0 + bj * 128) * F8_SY; bv[bj][1] = *(const f32x4*)(bdn + e * 1024 + col0 + bj * 128 + 4) * F8_SY; }
#pragma unroll
        for (int ai = 0; ai < 2; ++ai)
#pragma unroll
            for (int m = 0; m < 4; ++m) {
                unsigned char* rp = yr + (size_t)(row0 + ai * 128 + m * 16) * DM + col0;
#pragma unroll
                for (int bj = 0; bj < 2; ++bj) {
                    constexpr float RS = F8_SY / (F8_SA * F8_SWD);
                    const f32x4 v0 = acc[ai][bj][m][0] * RS + bv[bj][0], v1 = acc[ai][bj][m][1] * RS + bv[bj][1];
                    v2u w; w.x = pk4_fp8(v0[0], v0[1], v0[2], v0[3]); w.y = pk4_fp8(v1[0], v1[1], v1[2], v1[3]);
                    *(v2u*)(rp + bj * 128) = w;
                }
            }
    }
};
struct GroupOrder {
    LAS const unsigned* tile_e; int ntiles, lg, G, c; LAS const unsigned short* srcl;
    DI bool next(int i, pg8::Unit& u) const {
        int pm, pl;
        if (G == 256) {
            const int x = c & 7, k = c >> 3; pm = i * (256 >> lg) + x * (32 >> lg) + (k >> lg); pl = k & ((1 << lg) - 1); if (pm >= ntiles) return false; }
        else { const long L = (long)i * G + c; if (L >= ((long)ntiles << lg)) return false; pm = (int)(L >> lg); pl = (int)(L & ((1 << lg) - 1)); }
        const int e = __builtin_amdgcn_readfirstlane((int)tile_e[pm]);
        u.pm = pm; u.pn = (e << lg) + pl; return true;
    }
    DI void a_ready(const pg8::Unit&) const {}
    DI void done(const pg8::Unit&) const {}
    DI unsigned gsrc(int ui, int r) const { return (unsigned)srcl[ui * 256 + r] << 10; }
};
struct Args { const float* in[18]; float* out; unsigned char* ws; int ph_lo, ph_hi; };
struct Fr { LAS unsigned char* lds; unsigned char* ws; unsigned* ctl; int tid, lane, wave, blk, G; };

DI void tr_item(const float* W, int ldw, int K, int k0, int sc0, int nvalid, bf16* WT, int drow0, LAS float* scr, int lane) {
    const int c = lane & 31;
    float v[32];
#pragma unroll
    for (int i = 0; i < 32; ++i) v[i] = (c < nvalid) ? W[(size_t)(k0 + 2 * i + (lane >> 5)) * ldw + sc0 + c] : 0.f;
#pragma unroll
    for (int i = 0; i < 32; ++i) scr[(2 * i + (lane >> 5)) * 33 + c] = v[i];
    LDS_WAIT(); asm volatile("" ::: "memory");
    const int c8 = lane & 7;
#pragma unroll
    for (int j = 0; j < 4; ++j) { const int n = (lane >> 3) + 8 * j; const LAS float* s = scr + (8 * c8) * 33 + n;
        v4u o; o.x = cvtpk(s[0 * 33], s[1 * 33]); o.y = cvtpk(s[2 * 33], s[3 * 33]); o.z = cvtpk(s[4 * 33], s[5 * 33]); o.w = cvtpk(s[6 * 33], s[7 * 33]);
        *(v4u*)(WT + (size_t)(drow0 + n) * K + k0 + 8 * c8) = o; }
    LDS_WAIT(); asm volatile("" ::: "memory");
}
DI void tr_item8(const float* W, int ldw, int K, int k0, int sc0, float scale, unsigned char* WT8, int drow0, LAS float* scr, int lane) {
    const int c = lane & 31;
    float v[32];
#pragma unroll
    for (int i = 0; i < 32; ++i) v[i] = W[(size_t)(k0 + 2 * i + (lane >> 5)) * ldw + sc0 + c];
#pragma unroll
    for (int i = 0; i < 32; ++i) scr[(2 * i + (lane >> 5)) * 33 + c] = v[i] * scale;
    LDS_WAIT(); asm volatile("" ::: "memory");
    const int c16 = lane & 3;
#pragma unroll
    for (int j = 0; j < 2; ++j) { const int n = (lane >> 2) + 16 * j; const LAS float* s = scr + (16 * c16) * 33 + n;
        v4u o; o.x = pk4_fp8(s[0 * 33], s[1 * 33], s[2 * 33], s[3 * 33]); o.y = pk4_fp8(s[4 * 33], s[5 * 33], s[6 * 33], s[7 * 33]);
        o.z = pk4_fp8(s[8 * 33], s[9 * 33], s[10 * 33], s[11 * 33]); o.w = pk4_fp8(s[12 * 33], s[13 * 33], s[14 * 33], s[15 * 33]);
        *(v4u*)(WT8 + (size_t)(drow0 + n) * K + k0 + 16 * c16) = o; }
    LDS_WAIT(); asm volatile("" ::: "memory");
}
DI void ph_prologue(const Args& a, const Fr& F) {
    LAS float* scr = (LAS float*)(F.lds + F.wave * 16384);
    const int gw = F.blk * NWAVES + F.wave, NGW = F.G * NWAVES;
    constexpr int I_EV = 2 * 16 * 80, I_OD = 2 * 16 * 96, I_WO = 4 * 16 * 32;
    constexpr int NITEMS = I_EV + I_OD + I_WO;
    bf16* wev = (bf16*)(F.ws + WS_WEV); bf16* wod = (bf16*)(F.ws + WS_WOD); bf16* wout = (bf16*)(F.ws + WS_WOUT);
    unsigned char* wgu = F.ws + WS_WGU; unsigned char* wdn = F.ws + WS_WDN;
    for (int it = gw; it < NITEMS; it += NGW) {
        int r = it;
        if (r < I_EV) { const int l = r / 1280; r %= 1280; const int kb = r / 80, n0 = (r % 80) * 32; int sc0, nv = 32;
            if (n0 < 512) sc0 = n0; else if (n0 < 1024) sc0 = 964 + (n0 - 512); else if (n0 < 1536) sc0 = 1476 + (n0 - 1024); else if (n0 < 2048) sc0 = 1988 + (n0 - 1536);
            else if (n0 < 2176) sc0 = 512 + (n0 - 2048); else if (n0 < 2432) sc0 = 640 + (n0 - 2176); else if (n0 < 2496) sc0 = 896 + (n0 - 2432);
            else if (n0 < 2528) { sc0 = 960; nv = 4; } else { sc0 = 0; nv = 0; }
            tr_item(a.in[1] + (size_t)l * 1024 * 2500, 2500, 1024, kb * 64, sc0, nv, wev + (size_t)l * EV_N * 1024, n0, scr, F.lane); continue; }
        r -= I_EV;
        if (r < I_OD) { const int l = r / 1536; r %= 1536; const int kb = r / 96, n0 = (r % 96) * 32;
            tr_item(a.in[6] + (size_t)l * 1024 * 3088, 3088, 1024, kb * 64, n0, 32, wod + (size_t)l * OD_N * 1024, n0, scr, F.lane); continue; }
        r -= I_OD;
        if (r < I_WO) { const int l = r / 512; r %= 512; const int kb = r / 32, n0 = (r % 32) * 32;
            const float* src = (l & 1) ? a.in[8] + (size_t)(l >> 1) * 1024 * 1024 : a.in[5] + (size_t)(l >> 1) * 1024 * 1024;
            tr_item(src, 1024, 1024, kb * 64, n0, 32, wout + (size_t)l * 1024 * 1024, n0, scr, F.lane); continue; }
    }
    { __syncthreads();
        LAS float* tile = (LAS float*)F.lds; unsigned char* wgu8 = F.ws + WS_WGU; unsigned char* wdn8 = F.ws + WS_WDN;
        constexpr int T_GU = 128 * 8 * 16, T_DN = 128 * 8 * 8, T_ALL = T_GU + T_DN;
        const int tid = F.tid, c4 = tid & 31, r0 = tid >> 5;
        f32x4 v[8];
        auto locate = [&](int t, const float*& src, int& ldw, unsigned char*& dst, float& scale) {
            if (t < T_GU) { const int le = t >> 7, r = t & 127, kb = r >> 4, nb = r & 15, n0 = nb * 128; const int pn = n0 >> 8, bj = (n0 >> 7) & 1;
                src = a.in[14] + (size_t)le * 1024 * 2048 + (size_t)(kb * 128) * 2048 + bj * 1024 + pn * 128; ldw = 2048; dst = wgu8 + (size_t)le * 2048 * 1024 + (size_t)n0 * 1024 + kb * 128; scale = F8_SWG; }
            else { const int u = t - T_GU, le = u >> 6, r = u & 63, kb = r >> 3, nb = r & 7;
                src = a.in[16] + (size_t)le * 1024 * 1024 + (size_t)(kb * 128) * 1024 + nb * 128; ldw = 1024; dst = wdn8 + (size_t)le * 1024 * 1024 + (size_t)(nb * 128) * 1024 + kb * 128; scale = F8_SWD; } };
        int t = F.blk;
        if (t < T_ALL) { const float* src; int ldw; unsigned char* dst; float sc; locate(t, src, ldw, dst, sc);
#pragma unroll
            for (int i = 0; i < 8; ++i) v[i] = *(const f32x4*)(src + (size_t)(r0 + 16 * i) * ldw + 4 * c4); }
        for (; t < T_ALL; t += F.G) {
            const float* src; int ldw; unsigned char* dst; float sc; locate(t, src, ldw, dst, sc);
#pragma unroll
            for (int i = 0; i < 8; ++i) { LAS float* tp = tile + (r0 + 16 * i) * 129 + 4 * c4; tp[0] = v[i][0] * sc; tp[1] = v[i][1] * sc; tp[2] = v[i][2] * sc; tp[3] = v[i][3] * sc; }
            __syncthreads();
            if (t + F.G < T_ALL) { const float* s2; int l2; unsigned char* d2; float c2; locate(t + F.G, s2, l2, d2, c2);
#pragma unroll
                for (int i = 0; i < 8; ++i) v[i] = *(const f32x4*)(s2 + (size_t)(r0 + 16 * i) * l2 + 4 * c4); }
#pragma unroll
            for (int j = 0; j < 2; ++j) { const int p = tid + 512 * j, kc = p & 7, n = p >> 3; const LAS float* sp = tile + (kc * 16) * 129 + n;
                v4u o; o.x = pk4_fp8(sp[0], sp[129], sp[2 * 129], sp[3 * 129]); o.y = pk4_fp8(sp[4 * 129], sp[5 * 129], sp[6 * 129], sp[7 * 129]);
                o.z = pk4_fp8(sp[8 * 129], sp[9 * 129], sp[10 * 129], sp[11 * 129]); o.w = pk4_fp8(sp[12 * 129], sp[13 * 129], sp[14 * 129], sp[15 * 129]);
                *(v4u*)(dst + (size_t)n * 1024 + kc * 16) = o; }
            __syncthreads();
        }
    }
    bf16* xb = (bf16*)(F.ws + WS_XB);
    for (int m = gw; m < NTOK; m += NGW) {
        const f32x4* xr = (const f32x4*)(a.in[0] + (size_t)m * DM) + F.lane; v2u* o = (v2u*)(xb + (size_t)m * DM) + F.lane;
#pragma unroll
        for (int j = 0; j < 4; ++j) { const f32x4 v = xr[64 * j]; v2u w; w.x = cvtpk(v[0], v[1]); w.y = cvtpk(v[2], v[3]); o[64 * j] = w; }
    }
    bf16* wukt = (bf16*)(F.ws + WS_WUKT); bf16* wuvt = (bf16*)(F.ws + WS_WUVT);
    for (int i = F.blk * NTHR + F.tid; i < 2 * 8 * 128 * 64; i += F.G * NTHR) {
        { const int d = i & 63, c = (i >> 6) & 127, lh = i >> 13; wukt[i] = (bf16)f2bf(a.in[2][((size_t)lh * 64 + d) * 128 + c]); }
        { const int c = i & 127, d = (i >> 7) & 63, lh = i >> 13; wuvt[i] = (bf16)f2bf(a.in[3][((size_t)lh * 128 + c) * 64 + d]); }
    }
}

DI void ln_row(f32x4 (&v)[4], const float* g, const float* b, int lane) {
    float s = 0.f;
#pragma unroll
    for (int j = 0; j < 4; ++j) s += (v[j][0] + v[j][1]) + (v[j][2] + v[j][3]);
    const float mean = wave_sum(s) * (1.f / DM); float s2 = 0.f;
#pragma unroll
    for (int j = 0; j < 4; ++j) { v[j] = v[j] - mean; s2 += (v[j][0] * v[j][0] + v[j][1] * v[j][1]) + (v[j][2] * v[j][2] + v[j][3] * v[j][3]); }
    const float rstd = 1.f / sqrtf(wave_sum(s2) * (1.f / DM) + LN_EPS);
#pragma unroll
    for (int j = 0; j < 4; ++j) { const f32x4 gg = *((const f32x4*)g + lane + 64 * j), bb = *((const f32x4*)b + lane + 64 * j); v[j] = v[j] * rstd * gg + bb; }
}
DI void store_row_f32(float* p, const f32x4 (&v)[4], int lane) {
#pragma unroll
    for (int j = 0; j < 4; ++j) *((f32x4*)p + lane + 64 * j) = v[j];
}
DI void store_row_bf16(bf16* p, const f32x4 (&v)[4], int lane) {
#pragma unroll
    for (int j = 0; j < 4; ++j) { v2u w; w.x = cvtpk(v[j][0], v[j][1]); w.y = cvtpk(v[j][2], v[j][3]); *((v2u*)p + lane + 64 * j) = w; }
}
template <int NL> DI void small_proj(LAS const float* xs, const float* W, int ldw, int lane, float (&acc)[4]) {
    constexpr int PARTS = 64 / NL, DPER = 1024 / PARTS;
    const int n = lane & (NL - 1), part = lane / NL;
    acc[0] = acc[1] = acc[2] = acc[3] = 0.f;
    const float* wp = W + (size_t)(part * DPER) * ldw + n;
    LAS const float* xp = xs + part * DPER;
#pragma unroll 8
    for (int d = 0; d < DPER; ++d) { const float w = wp[(size_t)d * ldw];
        acc[0] += w * xp[d]; acc[1] += w * xp[1024 + d]; acc[2] += w * xp[2048 + d]; acc[3] += w * xp[3072 + d]; }
#pragma unroll
    for (int o = NL; o < 64; o <<= 1) {
#pragma unroll
        for (int k = 0; k < 4; ++k) acc[k] += __shfl_xor(acc[k], o); }
}

DI void ph_even_prep(const Args& a, const Fr& F, int j) {
    const bf16* proj = (const bf16*)(F.ws + WS_PROJ);
    bf16* ckvn = (bf16*)(F.ws + WS_CKVN); bf16* ql = (bf16*)(F.ws + WS_QL); float* kbar = (float*)(F.ws + WS_KBAR);
    const float* kvg = a.in[4] + j * 128;
    const bf16* wukt = (const bf16*)(F.ws + WS_WUKT) + (size_t)j * 8 * 128 * 64;
    const int lane = F.lane, wave = F.wave;
    for (int chunk = F.blk; chunk < 256; chunk += F.G) {
        const int tok0 = chunk * 128;
#pragma unroll 1
        for (int i0 = 0; i0 < 16; i0 += 8) { unsigned wv[8];
#pragma unroll
            for (int i = 0; i < 8; ++i) wv[i] = *((const unsigned*)(proj + (size_t)(tok0 + wave * 16 + i0 + i) * EV_N + EC_CKV) + lane);
#pragma unroll
            for (int i = 0; i < 8; ++i) { const int tok = tok0 + wave * 16 + i0 + i; const float v0 = bf2f(wv[i] & 0xffffu), v1 = bf2f(wv[i] >> 16);
                const float ss = wave_sum(v0 * v0 + v1 * v1);
                const float r = 1.f / sqrtf(ss * (1.f / 128.f) + LN_EPS);
                *((unsigned*)(ckvn + (size_t)tok * 128) + lane) = cvtpk(v0 * r * kvg[2 * lane], v1 * r * kvg[2 * lane + 1]); } }
        { bf16* kic = (bf16*)(F.ws + WS_KIC); const int tok = tok0 + wave * 16 + (lane >> 2), c = (lane & 3) * 16;
            const v4u* src = (const v4u*)(proj + (size_t)tok * EV_N + EC_KI + c); v4u* dst = (v4u*)(kic + (size_t)tok * 64 + c); dst[0] = src[0]; dst[1] = src[1]; }
        { const int h = wave, l15 = lane & 15, kg = lane >> 4;
            bf16x8 af[8][2];
#pragma unroll
            for (int ct = 0; ct < 8; ++ct)
#pragma unroll
                for (int ks = 0; ks < 2; ++ks) af[ct][ks] = *(const bf16x8*)(wukt + ((size_t)h * 128 + ct * 16 + l15) * 64 + ks * 32 + kg * 8);
#pragma unroll 1
            for (int tg = 0; tg < 8; tg += 4) { bf16x8 qf[4][2];
#pragma unroll
                for (int u = 0; u < 4; ++u)
#pragma unroll
                    for (int ks = 0; ks < 2; ++ks) qf[u][ks] = *(const bf16x8*)(proj + (size_t)(tok0 + (tg + u) * 16 + l15) * EV_N + EC_QA + h * 64 + ks * 32 + kg * 8);
#pragma unroll
                for (int u = 0; u < 4; ++u) { const int tok = tok0 + (tg + u) * 16 + l15;
#pragma unroll
                    for (int ct = 0; ct < 8; ++ct) { f32x4 d = {0.f, 0.f, 0.f, 0.f};
                        d = mfma16(af[ct][0], qf[u][0], d); d = mfma16(af[ct][1], qf[u][1], d);
                        v2u w; w.x = cvtpk(d[0], d[1]); w.y = cvtpk(d[2], d[3]);
                        *(v2u*)(ql + (size_t)tok * 1024 + h * 128 + ct * 16 + 4 * kg) = w; } } } }
        if (chunk < 128) { const int b = chunk >> 5, n = chunk & 31; float s8[8];
#pragma unroll
            for (int k = 0; k < 8; ++k) s8[k] = 0.f;
            const bf16* kp = proj + ((size_t)b * SEQ + n * 256 + wave * 32) * EV_N + EC_KB + lane * 8;
#pragma unroll 8
            for (int r = 0; r < 32; ++r) { const v4u w = *(const v4u*)(kp + (size_t)r * EV_N);
#pragma unroll
                for (int k = 0; k < 4; ++k) { s8[2 * k] += bf2f(w[k] & 0xffffu); s8[2 * k + 1] += bf2f(w[k] >> 16); } }
            LAS float* red = (LAS float*)F.lds;
            __syncthreads();
#pragma unroll
            for (int k = 0; k < 8; ++k) red[wave * 512 + lane * 8 + k] = s8[k];
            __syncthreads();
            float s = 0.f;
#pragma unroll
            for (int w = 0; w < 8; ++w) s += red[w * 512 + F.tid];
            const int h = F.tid >> 6, d = F.tid & 63;
            kbar[(((size_t)b * 8 + h) * 32 + n) * 64 + d] = s * (1.f / 256.f); }
    }
}

DI void moba_gate_chunk(const Fr& F, int chunk) {
    const bf16* proj = (const bf16*)(F.ws + WS_PROJ); const float* kbar = (const float*)(F.ws + WS_KBAR); unsigned* sel3 = (unsigned*)(F.ws + WS_SEL3);
    const int tok0 = chunk * 128, b = tok0 / SEQ, own = (tok0 % SEQ) >> 8, h = F.wave, lane = F.lane;
    float q0[64], q1[64];
    { const v4u* p0 = (const v4u*)(proj + (size_t)(tok0 + lane) * EV_N + EC_QB + h * 64); const v4u* p1 = (const v4u*)(proj + (size_t)(tok0 + 64 + lane) * EV_N + EC_QB + h * 64);
#pragma unroll
        for (int i = 0; i < 8; ++i) { const v4u w0 = p0[i], w1 = p1[i];
#pragma unroll
            for (int k = 0; k < 4; ++k) { q0[8 * i + 2 * k] = bf2f(w0[k] & 0xffffu); q0[8 * i + 2 * k + 1] = bf2f(w0[k] >> 16); q1[8 * i + 2 * k] = bf2f(w1[k] & 0xffffu); q1[8 * i + 2 * k + 1] = bf2f(w1[k] >> 16); } } }
    float a0 = -INFINITY, a1 = -INFINITY, a2 = -INFINITY, c0 = -INFINITY, c1 = -INFINITY, c2 = -INFINITY; int ai0 = 0, ai1 = 0, ai2 = 0, ci0 = 0, ci1 = 0, ci2 = 0;
    const float* kb = kbar + (((size_t)b * 8 + h) * 32) * 64;
    for (int n = 0; n < own; ++n) { float g0 = 0.f, g1 = 0.f;
#pragma unroll
        for (int d = 0; d < 64; d += 4) { const f32x4 kv = *(const f32x4*)(kb + n * 64 + d);
#pragma unroll
            for (int k = 0; k < 4; ++k) { g0 += q0[d + k] * kv[k]; g1 += q1[d + k] * kv[k]; } }
        if (g0 > a2) { if (g0 > a1) { a2 = a1; ai2 = ai1; if (g0 > a0) { a1 = a0; ai1 = ai0; a0 = g0; ai0 = n; } else { a1 = g0; ai1 = n; } } else { a2 = g0; ai2 = n; } }
        if (g1 > c2) { if (g1 > c1) { c2 = c1; ci2 = ci1; if (g1 > c0) { c1 = c0; ci1 = ci0; c0 = g1; ci0 = n; } else { c1 = g1; ci1 = n; } } else { c2 = g1; ci2 = n; } }
    }
    const unsigned nv = own < 3 ? own : 3;
    sel3[(size_t)(tok0 + lane) * 8 + h] = (unsigned)ai0 | ((unsigned)ai1 << 8) | ((unsigned)ai2 << 16) | (nv << 24);
    sel3[(size_t)(tok0 + 64 + lane) * 8 + h] = (unsigned)ci0 | ((unsigned)ci1 << 8) | ((unsigned)ci2 << 16) | (nv << 24);
}

constexpr int HS = 257;
DI float relu1(float x) { const unsigned u = __float_as_uint(x); return __uint_as_float(u & ~(unsigned)((int)u >> 31)); }
template <int MODE, bool DIAG> DI void idx_tile(const bf16x8 (&kf)[4], LAS const char* qb  , const float (&wj)[4], int kt, int q, int hi, unsigned c0, unsigned c1,
                                     LAS unsigned* hist, LAS unsigned* mask, LAS unsigned* cmask, LAS unsigned long long* cand, LAS unsigned* rinfo) {
    f32x2 scp[8];
#pragma unroll
    for (int p = 0; p < 8; ++p) scp[p] = (f32x2){0.f, 0.f};
    bf16x8 qv0[2][4], qv1[2][4];
#pragma unroll
    for (int j = 0; j < 2; ++j)
#pragma unroll
        for (int s = 0; s < 4; ++s) qv0[j][s] = *(LAS const bf16x8*)(qb + (j * 8 + s * 2) * 512);
#pragma unroll
    for (int j = 0; j < 2; ++j)
#pragma unroll
        for (int s = 0; s < 4; ++s) qv1[j][s] = *(LAS const bf16x8*)(qb + ((2 + j) * 8 + s * 2) * 512);
    __builtin_amdgcn_sched_barrier(0);
#pragma unroll
    for (int g = 0; g < 2; ++g) { f32x16 acc[2];
#pragma unroll
        for (int j = 0; j < 2; ++j)
#pragma unroll
            for (int r = 0; r < 16; ++r) acc[j][r] = 0.f;
#pragma unroll
        for (int s = 0; s < 4; ++s)
#pragma unroll
            for (int j = 0; j < 2; ++j) { if (MODE != -2) acc[j] = mfma32(kf[s], g == 0 ? qv0[j][s] : qv1[j][s], acc[j]); else acc[j][s] += __builtin_bit_cast(float, (unsigned)(kf[s][0] ^ (g == 0 ? qv0[j][s][0] : qv1[j][s][0]))); }
#pragma unroll
        for (int p = 0; p < 8; ++p)
#pragma unroll
            for (int j = 0; j < 2; ++j) { const f32x2 a = {relu1(acc[j][2 * p]), relu1(acc[j][2 * p + 1])}; const f32x2 w2 = {wj[2 * g + j], wj[2 * g + j]}; scp[p] = a * w2 + scp[p]; } }
    unsigned sel = 0u, cnd = 0u;
    if (MODE <= 0) { float t = 0.f;
#pragma unroll
        for (int p = 0; p < 8; ++p) t += scp[p][0] + scp[p][1];
        if (t == 12345.678f) __hip_atomic_fetch_or(mask + q * HS + kt, 1u, __ATOMIC_RELAXED, __HIP_MEMORY_SCOPE_WORKGROUP);
        return; }
    const float F0 = __uint_as_float(c0), F1 = __uint_as_float(c1);
#pragma unroll
    for (int r = 0; r < 16; ++r) { const int kr = crow(r, hi);
        const bool ok = !DIAG || kr <= q;
        const float scv = scp[r >> 1][r & 1]; const unsigned u = __float_as_uint(scv);
        if (MODE == 1) { const unsigned key = u ^ ((unsigned)((int)u >> 31) | 0x80000000u);
            if (ok && (key >> 24) >= c0) __hip_atomic_fetch_add(hist + q * HS + (key >> 24), 1u, __ATOMIC_RELAXED, __HIP_MEMORY_SCOPE_WORKGROUP); }
        else if (MODE == 2) { if (ok && (u >> 24) == c0) __hip_atomic_fetch_add(hist + q * HS + (((u >> 16) & 255u) ^ c1), 1u, __ATOMIC_RELAXED, __HIP_MEMORY_SCOPE_WORKGROUP); }
        else { const bool ge1 = scv >= F1, ge0 = scv >= F0;
            if (ok && ge1) sel |= 1u << kr;
            if (ok && ge0 && !ge1) { cnd |= 1u << kr; const unsigned key = u ^ ((unsigned)((int)u >> 31) | 0x80000000u);
                const unsigned pos = __hip_atomic_fetch_add(rinfo + 128 + q, 1u, __ATOMIC_RELAXED, __HIP_MEMORY_SCOPE_WORKGROUP);
                if (pos < 64u) cand[q * 64 + pos] = ((unsigned long long)key << 32) | (unsigned)(~(unsigned)(kt * 32 + kr)); } } }
    if (MODE == 3) { if (sel) __hip_atomic_fetch_or(mask + q * HS + kt, sel, __ATOMIC_RELAXED, __HIP_MEMORY_SCOPE_WORKGROUP);
        if (cnd) __hip_atomic_fetch_or(cmask + q * HS + kt, cnd, __ATOMIC_RELAXED, __HIP_MEMORY_SCOPE_WORKGROUP); }
}
#define IDX_LOAD(KF, I) do { int kt_l = wave + 8 * (I); kt_l = kt_l < nkt - 1 ? kt_l : nkt - 1; const bf16* kp_ = kp0 + (size_t)(kt_l * 32) * 64; _Pragma("unroll") for (int s_ = 0; s_ < 4; ++s_) KF[s_] = *(const bf16x8*)(kp_ + s_ * 16); } while (0)
#define IDX_ROT() do { _Pragma("unroll") for (int s_ = 0; s_ < 4; ++s_) { kfa[s_] = kfb[s_]; kfb[s_] = kfc[s_]; } } while (0)
template <int MODE> DI void idx_pass(const bf16* proj, int rowbase, int qt, LAS const char* qimg, const float (&wj)[4], LAS unsigned* hist, LAS unsigned* mask, LAS unsigned* cmask, LAS unsigned long long* cand, LAS unsigned* rinfo, int wave, int lane) {
    const int q = lane & 31, hi = lane >> 5, nkt = qt + 1;
    const unsigned b1 = MODE == 2 ? rinfo[160 + q] : rinfo[224 + q], thr16 = MODE == 2 ? rinfo[192 + q] : rinfo[256 + q];
    const bf16* kp0 = proj + (size_t)(rowbase + q) * 64 + hi * 8;
    LAS const char* qb = qimg + hi * 512 + q * 16;
    const int n_all = nkt > wave ? (nkt - wave + 7) >> 3 : 0;
    if (n_all == 0) return;
    const bool has_diag = (qt & 7) == wave; const int n = n_all - (has_diag ? 1 : 0);
    bf16x8 kfa[4], kfb[4], kfc[4];
#define IDX_TILE(KF, I) idx_tile<MODE, false>(KF, qb, wj, wave + 8 * (I), q, hi, b1, thr16, hist, mask, cmask, cand, rinfo)
    IDX_LOAD(kfa, 0); IDX_LOAD(kfb, 1); IDX_LOAD(kfc, 2);
    int i = 0;
    for (; i + 3 <= n; i += 3) { IDX_TILE(kfa, i); IDX_LOAD(kfa, i + 3); IDX_TILE(kfb, i + 1); IDX_LOAD(kfb, i + 4); IDX_TILE(kfc, i + 2); IDX_LOAD(kfc, i + 5); }
#pragma unroll 1
    for (; i < n; ++i) { IDX_TILE(kfa, i); IDX_ROT(); }
    if (has_diag) idx_tile<MODE, true>(kfa, qb, wj, qt, q, hi, b1, thr16, hist, mask, cmask, cand, rinfo);
#undef IDX_TILE
}
DI void hist_pick(LAS const unsigned* hrow, unsigned need, int lane, unsigned& bin, unsigned& above) {
    unsigned h4[4];
#pragma unroll
    for (int k = 0; k < 4; ++k) h4[k] = hrow[4 * lane + k];
    const unsigned ssum = h4[0] + h4[1] + h4[2] + h4[3];
    unsigned x = ssum;
#pragma unroll
    for (int o = 1; o < 64; o <<= 1) { const unsigned y = __shfl_down(x, o); if (lane + o < 64) x += y; }
    const unsigned long long m = __ballot(x >= need);
    const int Ls = m ? 63 - __builtin_clzll(m) : 0;
    const unsigned xs = __shfl(x, Ls), ss = __shfl(ssum, Ls);
    const unsigned h0 = __shfl(h4[0], Ls), h1 = __shfl(h4[1], Ls), h2 = __shfl(h4[2], Ls), h3 = __shfl(h4[3], Ls);
    unsigned cum = xs - ss;
    if (cum + h3 >= need) { bin = 4 * Ls + 3; above = cum; return; } cum += h3;
    if (cum + h2 >= need) { bin = 4 * Ls + 2; above = cum; return; } cum += h2;
    if (cum + h1 >= need) { bin = 4 * Ls + 1; above = cum; return; } cum += h1;
    bin = 4 * Ls; above = cum; (void)h0;
}
DI void idx_pass1(const bf16* proj, int rowbase, int qt, LAS const char* qimg, const float (&wj)[4], LAS unsigned* hist, LAS unsigned* mask, LAS unsigned* cmask, LAS unsigned long long* cand, LAS unsigned* rinfo, int wave, int lane) {
    const int q = lane & 31, hi = lane >> 5, nkt = qt + 1, nmax = (nkt + 7) >> 3;
    const bf16* kp0 = proj + (size_t)(rowbase + q) * 64 + hi * 8;
    LAS const char* qb = qimg + hi * 512 + q * 16;
    unsigned lb = 0u;
    bf16x8 kfa[4], kfb[4], kfc[4];
#define IDX_TILE(KF, I) idx_tile<1, false>(KF, qb, wj, wave + 8 * (I), q, hi, lb, 0u, hist, mask, cmask, cand, rinfo)
#define IDX_LBUP(I) do { const int i_ = (I); if (((i_ + 1) & i_) == 0 && i_ + 1 < nmax && i_ < 16) {        \
            __syncthreads(); \
            _Pragma("unroll 1") for (int rr = 0; rr < 4; ++rr) { const int row = wave * 4 + rr; unsigned bin, above; hist_pick(hist + row * HS, 256u, lane, bin, above); if (lane == 0) rinfo[288 + row] = bin; } \
            __syncthreads(); \
            { const unsigned nb = rinfo[288 + q]; lb = nb > lb ? nb : lb; } } } while (0)
    IDX_LOAD(kfa, 0); IDX_LOAD(kfb, 1); IDX_LOAD(kfc, 2);
    int i = 0;
    for (; i + 3 <= nmax - 1; i += 3) { IDX_TILE(kfa, i); IDX_LOAD(kfa, i + 3); IDX_LBUP(i); IDX_TILE(kfb, i + 1); IDX_LOAD(kfb, i + 4); IDX_LBUP(i + 1); IDX_TILE(kfc, i + 2); IDX_LOAD(kfc, i + 5); IDX_LBUP(i + 2); }
#pragma unroll 1
    for (; i < nmax - 1; ++i) { IDX_TILE(kfa, i); IDX_ROT(); IDX_LBUP(i); }
    { const int kt = wave + 8 * (nmax - 1);
        if (kt < nkt) { if (kt == qt) idx_tile<1, true>(kfa, qb, wj, kt, q, hi, lb, 0u, hist, mask, cmask, cand, rinfo); else IDX_TILE(kfa, nmax - 1); } }
#undef IDX_TILE
#undef IDX_LBUP
}
#undef IDX_LOAD
#undef IDX_ROT
DI void idx_unit(const Fr& F, int b, int qt, int stop = 0  ) {
    const bf16* proj = (const bf16*)(F.ws + WS_PROJ); const bf16* kic = (const bf16*)(F.ws + WS_KIC); unsigned short* sel = (unsigned short*)(F.ws + WS_SEL);
    LAS unsigned* hist = (LAS unsigned*)(F.lds); LAS unsigned* mask = hist + 32 * HS; LAS unsigned* cmask = mask + 32 * HS;
    LAS unsigned long long* cand = (LAS unsigned long long*)(F.lds + 99328); LAS unsigned* rinfo = (LAS unsigned*)(F.lds + 115712);
    const int lane = F.lane, wave = F.wave, tid = F.tid, t0 = qt * 32, rowbase = b * SEQ;
    __syncthreads();
    for (int i = tid; i < 3 * 32 * HS; i += NTHR) hist[i] = 0u;
    if (tid < 320) rinfo[tid] = 0u;
    __syncthreads();
    if (t0 + 31 <= 255 || (EXPF & 64)) {
        if (lane < 8) {
#pragma unroll
            for (int rr = 0; rr < 4; ++rr) { const int row = wave * 4 + rr, nv = t0 + row + 1;
                const int nv0 = t0 + row + 1; const int nvc = nv0 < 256 ? nv0 : 256; (void)nv; mask[row * HS + lane] = nvc >= 32 * (lane + 1) ? 0xffffffffu : (nvc > 32 * lane ? ((1u << (nvc - 32 * lane)) - 1u) : 0u); } }
    } else {
        const int q = lane & 31;
        float wj[4];
        { const bf16* qp = proj + (size_t)(rowbase + t0 + q) * EV_N;
#pragma unroll
            for (int j = 0; j < 4; ++j) wj[j] = bf2f(qp[EC_WI + j]); }
        LAS char* qimg = (LAS char*)(F.lds + 117248);
#pragma unroll
        for (int i = 0; i < 2; ++i) { const int p = tid + i * NTHR, row = p & 31, c = p >> 5;
            *(LAS v4u*)(qimg + c * 512 + row * 16) = *(const v4u*)(proj + (size_t)(rowbase + t0 + row) * EV_N + EC_QI + c * 8); }
        __syncthreads();
        if (stop == 7) return;
        idx_pass1(kic, rowbase, qt, qimg, wj, hist, mask, cmask, cand, rinfo, wave, lane);
        __syncthreads();
#pragma unroll 1
        for (int rr = 0; rr < 4; ++rr) { const int row = wave * 4 + rr; unsigned bin, above; hist_pick(hist + row * HS, 256u, lane, bin, above);
            if (lane == 0) { rinfo[row] = bin; rinfo[32 + row] = 256u - above; rinfo[160 + row] = bin >= 128u ? bin - 128u : 255u - bin; rinfo[192 + row] = bin >= 128u ? 0u : 255u; } }
        __syncthreads();
        if (stop == 1) return;
        for (int i = tid; i < 32 * HS; i += NTHR) hist[i] = 0u;
        __syncthreads();
        idx_pass<2>(kic, rowbase, qt, qimg, wj, hist, mask, cmask, cand, rinfo, wave, lane);
        __syncthreads();
#pragma unroll 1
        for (int rr = 0; rr < 4; ++rr) { const int row = wave * 4 + rr; const unsigned need1 = rinfo[32 + row]; unsigned bin, above; hist_pick(hist + row * HS, need1, lane, bin, above);
            if (lane == 0) { const unsigned t16 = (rinfo[row] << 8) | bin, k0 = t16 << 16, k1 = (t16 + 1u) << 16;
                rinfo[64 + row] = t16; rinfo[96 + row] = need1 - above;
                rinfo[224 + row] = (k0 & 0x80000000u) ? (k0 ^ 0x80000000u) : ~k0; rinfo[256 + row] = (t16 == 0xffffu) ? 0x7fc00000u : ((k1 & 0x80000000u) ? (k1 ^ 0x80000000u) : ~k1); } }
        __syncthreads();
        if (stop == 2) return;
        idx_pass<3>(kic, rowbase, qt, qimg, wj, hist, mask, cmask, cand, rinfo, wave, lane);
        __syncthreads();
        if (stop == 3) return;
#pragma unroll 1
        for (int rr = 0; rr < 4; ++rr) { const int row = wave * 4 + rr; const unsigned call = rinfo[128 + row], need2 = rinfo[96 + row];
            if (call <= 64u) { const unsigned c = call;
                const unsigned long long mine = cand[row * 64 + lane]; unsigned rank = 0u;
                for (unsigned k = 0; k < c; ++k) rank += (cand[row * 64 + k] > mine) ? 1u : 0u;
                if ((unsigned)lane < c && rank < need2) { const unsigned s = ~(unsigned)mine;
                    __hip_atomic_fetch_or(mask + row * HS + (s >> 5), 1u << (s & 31), __ATOMIC_RELAXED, __HIP_MEMORY_SCOPE_WORKGROUP); } }
            else { unsigned w4[4];
#pragma unroll
                for (int k = 0; k < 4; ++k) w4[k] = cmask[row * HS + 4 * lane + k];
                const unsigned cnt = __popc(w4[0]) + __popc(w4[1]) + __popc(w4[2]) + __popc(w4[3]);
                unsigned x = cnt;
#pragma unroll
                for (int o = 1; o < 64; o <<= 1) { const unsigned y = __shfl_up(x, o); if (lane >= o) x += y; }
                unsigned before = x - cnt;
#pragma unroll
                for (int k = 0; k < 4; ++k) { unsigned w = w4[k]; const unsigned pc = __popc(w); unsigned take = 0u;
                    if (before < need2) { if (before + pc <= need2) take = w; else { unsigned left = need2 - before; while (left) { const unsigned b = w & (0u - w); take |= b; w ^= b; --left; } } }
                    before += pc;
                    if (take) mask[row * HS + 4 * lane + k] |= take; } }
        }
    }
    __syncthreads();
#pragma unroll 1
    for (int rr = 0; rr < 4; ++rr) { const int row = wave * 4 + rr; unsigned short* out = sel + (size_t)(rowbase + t0 + row) * 256;
        unsigned w4[4];
#pragma unroll
        for (int k = 0; k < 4; ++k) w4[k] = mask[row * HS + 4 * lane + k];
        const unsigned cnt = __popc(w4[0]) + __popc(w4[1]) + __popc(w4[2]) + __popc(w4[3]);
        unsigned x = cnt;
#pragma unroll
        for (int o = 1; o < 64; o <<= 1) { const unsigned y = __shfl_up(x, o); if (lane >= o) x += y; }
        const unsigned total = __shfl(x, 63); unsigned pos = x - cnt;
#pragma unroll
        for (int k = 0; k < 4; ++k) { unsigned w = w4[k]; const unsigned base = (unsigned)(4 * lane + k) * 32u;
            while (w) { const unsigned bit = __builtin_ctz(w); if (pos < 256u) out[pos] = (unsigned short)(base + bit); ++pos; w &= w - 1u; } }
        for (unsigned i = total + lane; i < 256u; i += 64u) out[i] = (unsigned short)0xffffu; }
}

struct AttSt { float m, l; f32x16 o0, o1; };
template <class BF> DI void att_subtile(AttSt& S, const bf16x8 (&qf)[4], LAS const char* Kst, LAS const char* Vb, int vdh, int vrow0, int lane, const BF& bias) {
    const int r32 = lane & 31, hi = lane >> 5;
    f32x16 p;
#pragma unroll
    for (int r = 0; r < 16; ++r) p[r] = bias.b(crow(r, hi)) - S.m;
    LAS const char* kp = Kst + hi * 512 + r32 * 16;
#pragma unroll
    for (int s = 0; s < 4; ++s) { const bf16x8 kf = *(LAS const bf16x8*)(kp + s * 1024); p = mfma32(kf, qf[s], p); }
    if (bias.any) {
#pragma unroll
        for (int r = 0; r < 16; ++r) p[r] = bias.msk(crow(r, hi)) ? -INFINITY : p[r]; }
    float mxa[4] = {-INFINITY, -INFINITY, -INFINITY, -INFINITY};
#pragma unroll
    for (int r = 0; r < 16; ++r) mxa[r & 3] = fmaxf(mxa[r & 3], p[r]);
    float mx = fmaxf(fmaxf(mxa[0], mxa[1]), fmaxf(mxa[2], mxa[3]));
    mx = fmaxf(mx, __shfl_xor(mx, 32));
    if (__any(mx > 16.f)) { const float dl = fmaxf(mx, 0.f), sc = ex2(-dl); S.m += dl; S.l *= sc;
#pragma unroll
        for (int r = 0; r < 16; ++r) { p[r] -= dl; S.o0[r] *= sc; S.o1[r] *= sc; } }
    float psa[4] = {0.f, 0.f, 0.f, 0.f};
#pragma unroll
    for (int r = 0; r < 16; ++r) { p[r] = ex2(p[r]); psa[r & 3] += p[r]; }
    S.l += (psa[0] + psa[1]) + (psa[2] + psa[3]);
    v4u pw0, pw1;
    pw0.x = cvtpk(p[0], p[1]); pw0.y = cvtpk(p[2], p[3]); pw0.z = cvtpk(p[4], p[5]); pw0.w = cvtpk(p[6], p[7]);
    pw1.x = cvtpk(p[8], p[9]); pw1.y = cvtpk(p[10], p[11]); pw1.z = cvtpk(p[12], p[13]); pw1.w = cvtpk(p[14], p[15]);
    const bf16x8 pf0 = __builtin_bit_cast(bf16x8, pw0), pf1 = __builtin_bit_cast(bf16x8, pw1);
    LAS const char* vp = Vb + (vrow0 + 4 * hi + ((lane & 15) >> 2)) * 64 + ((lane >> 4) & 1) * 32 + (lane & 3) * 8;
    { const bf16x8 v00 = cat8(vtr(vp), vtr(vp + 512)), v10 = cat8(vtr(vp + vdh), vtr(vp + vdh + 512));
      const bf16x8 v01 = cat8(vtr(vp + 1024), vtr(vp + 1536)), v11 = cat8(vtr(vp + vdh + 1024), vtr(vp + vdh + 1536));
      S.o0 = mfma32(v00, pf0, S.o0); S.o1 = mfma32(v10, pf0, S.o1);
      S.o0 = mfma32(v01, pf1, S.o0); S.o1 = mfma32(v11, pf1, S.o1); }
}
template <class BF0, class BF1> DI void att_tile64(AttSt& S, const bf16x8 (&qf)[4], LAS const char* Kst, LAS const char* Vb, int vdh, int vrow0, int lane, const BF0& bias0, const BF1& bias1) {
    const int r32 = lane & 31, hi = lane >> 5;
    f32x16 p0, p1;
#pragma unroll
    for (int r = 0; r < 16; ++r) { p0[r] = bias0.b(crow(r, hi)) - S.m; p1[r] = bias1.b(crow(r, hi)) - S.m; }
    LAS const char* kp = Kst + hi * 512 + r32 * 16;
#pragma unroll
    for (int s = 0; s < 4; ++s) { const bf16x8 k0 = *(LAS const bf16x8*)(kp + s * 1024), k1 = *(LAS const bf16x8*)(kp + 4096 + s * 1024); p0 = mfma32(k0, qf[s], p0); p1 = mfma32(k1, qf[s], p1); }
    if (bias0.any) {
#pragma unroll
        for (int r = 0; r < 16; ++r) p0[r] = bias0.msk(crow(r, hi)) ? -INFINITY : p0[r]; }
    if (bias1.any) {
#pragma unroll
        for (int r = 0; r < 16; ++r) p1[r] = bias1.msk(crow(r, hi)) ? -INFINITY : p1[r]; }
    float mxa[4] = {-INFINITY, -INFINITY, -INFINITY, -INFINITY};
#pragma unroll
    for (int r = 0; r < 16; ++r) mxa[r & 3] = fmaxf(mxa[r & 3], fmaxf(p0[r], p1[r]));
    float mx = fmaxf(fmaxf(mxa[0], mxa[1]), fmaxf(mxa[2], mxa[3]));
    mx = fmaxf(mx, __shfl_xor(mx, 32));
    if (__any(mx > 16.f)) { const float dl = fmaxf(mx, 0.f), sc = ex2(-dl); S.m += dl; S.l *= sc;
#pragma unroll
        for (int r = 0; r < 16; ++r) { p0[r] -= dl; p1[r] -= dl; S.o0[r] *= sc; S.o1[r] *= sc; } }
    float psa[4] = {0.f, 0.f, 0.f, 0.f};
#pragma unroll
    for (int r = 0; r < 16; ++r) { p0[r] = ex2(p0[r]); p1[r] = ex2(p1[r]); psa[r & 3] += p0[r] + p1[r]; }
    S.l += (psa[0] + psa[1]) + (psa[2] + psa[3]);
    v4u a0, a1, b0, b1;
    a0.x = cvtpk(p0[0], p0[1]); a0.y = cvtpk(p0[2], p0[3]); a0.z = cvtpk(p0[4], p0[5]); a0.w = cvtpk(p0[6], p0[7]);
    a1.x = cvtpk(p0[8], p0[9]); a1.y = cvtpk(p0[10], p0[11]); a1.z = cvtpk(p0[12], p0[13]); a1.w = cvtpk(p0[14], p0[15]);
    b0.x = cvtpk(p1[0], p1[1]); b0.y = cvtpk(p1[2], p1[3]); b0.z = cvtpk(p1[4], p1[5]); b0.w = cvtpk(p1[6], p1[7]);
    b1.x = cvtpk(p1[8], p1[9]); b1.y = cvtpk(p1[10], p1[11]); b1.z = cvtpk(p1[12], p1[13]); b1.w = cvtpk(p1[14], p1[15]);
    LAS const char* vp = Vb + (vrow0 + 4 * hi + ((lane & 15) >> 2)) * 64 + ((lane >> 4) & 1) * 32 + (lane & 3) * 8;
#pragma unroll
    for (int k16 = 0; k16 < 4; ++k16) { const bf16x8 pf = __builtin_bit_cast(bf16x8, k16 == 0 ? a0 : k16 == 1 ? a1 : k16 == 2 ? b0 : b1);
        const bf16x8 v0 = cat8(vtr(vp + k16 * 1024), vtr(vp + k16 * 1024 + 512)), v1 = cat8(vtr(vp + vdh + k16 * 1024), vtr(vp + vdh + k16 * 1024 + 512));
        S.o0 = mfma32(v0, pf, S.o0); S.o1 = mfma32(v1, pf, S.o1); }
}

struct MobaFar { float c; bool any; DI float b(int) const { return c; } DI bool msk(int) const { return false; } };
struct MobaBias { LAS const float* lut; int tq, s0; bool any;
    DI float b(int kvrel) const { const int dist = tq - (s0 + kvrel); return lut[dist < 0 ? 0 : (dist > 1023 ? 1023 : dist)]; }
    DI bool msk(int kvrel) const { return tq - (s0 + kvrel) < 0; } };
DI void moba_qload(bf16x8 (&qf)[4], const bf16* proj, int rowbase, int h, int tq, int hi) {
    const bf16* qp = proj + (size_t)(rowbase + tq) * EV_N + EC_QB + h * 64 + hi * 8;
#pragma unroll
    for (int s = 0; s < 4; ++s) qf[s] = *(const bf16x8*)(qp + s * 16);
}
DI void moba_tile(const Fr& F, const bf16x8 (&qf)[4], int rowbase, int h, int n, int tq, bool valid, int slot, bool own, int wave_tile) {
    LAS const char* Kb = (LAS const char*)F.lds; LAS const char* Vb = (LAS const char*)(F.lds + 32768); LAS const float* lut = (LAS const float*)(F.lds + 98304);
    unsigned char* po = F.ws + WS_ACT; float* pml = (float*)(F.ws + WS_PML);
    const int lane = F.lane, hi = lane >> 5;
    AttSt S; S.m = 0.f; S.l = 0.f;
#pragma unroll
    for (int r = 0; r < 16; ++r) { S.o0[r] = 0.f; S.o1[r] = 0.f; }
    const int nst = own ? wave_tile + 1 : 8;
    int tmin = tq;
#pragma unroll
    for (int o = 1; o < 64; o <<= 1) { const int y = __shfl_xor(tmin, o); tmin = y < tmin ? y : tmin; }
    const float cfar = lut[1023];
    int st = 0;
    for (; st + 1 < nst; st += 2) {
        if (!own && tmin - (n * 256 + st * 32 + 63) >= 790) { MobaFar bf{cfar, false}; att_tile64(S, qf, Kb + st * 4096, Vb, 16384, st * 32, lane, bf, bf); }
        else { MobaBias bf0{lut, tq, n * 256 + st * 32, false}, bf1{lut, tq, n * 256 + st * 32 + 32, own && st + 1 == wave_tile}; att_tile64(S, qf, Kb + st * 4096, Vb, 16384, st * 32, lane, bf0, bf1); } }
    if (st < nst) { MobaBias bf{lut, tq, n * 256 + st * 32, own && st == wave_tile}; att_subtile(S, qf, Kb + st * 4096, Vb, 16384, st * 32, lane, bf); }
    const float lt = S.l + __shfl_xor(S.l, 32), inv = 1.f / lt;
    if (valid) { const size_t pi = ((size_t)(rowbase + tq) * 8 + h) * 4 + slot; unsigned char* o = po + pi * 64; const float i16 = inv * 16.f;
#pragma unroll
        for (int a4 = 0; a4 < 4; ++a4) {
            *(unsigned*)(o + 8 * a4 + 4 * hi) = pk4_fp8(S.o0[4 * a4] * i16, S.o0[4 * a4 + 1] * i16, S.o0[4 * a4 + 2] * i16, S.o0[4 * a4 + 3] * i16);
            *(unsigned*)(o + 32 + 8 * a4 + 4 * hi) = pk4_fp8(S.o1[4 * a4] * i16, S.o1[4 * a4 + 1] * i16, S.o1[4 * a4 + 2] * i16, S.o1[4 * a4 + 3] * i16); }
        if (hi == 0) { f32x2 ml = {S.m, lt}; *(f32x2*)(pml + pi * 2) = ml; } }
}
DI void moba_unit(const Args& a, const Fr& F, int b, int h, int n) {
    const bf16* proj = (const bf16*)(F.ws + WS_PROJ); const unsigned* sel3 = (const unsigned*)(F.ws + WS_SEL3);
    LAS unsigned char* lds = F.lds; LAS unsigned* list = (LAS unsigned*)(lds + 65536); LAS float* lut = (LAS float*)(lds + 98304); LAS unsigned* misc = (LAS unsigned*)(lds + 102400);
    const int tid = F.tid, lane = F.lane, wave = F.wave, rowbase = b * SEQ;
    __syncthreads();
    { const bf16* kg = proj + (size_t)(rowbase + n * 256) * EV_N + EC_KB + h * 64; const bf16* vg = proj + (size_t)(rowbase + n * 256) * EV_N + EC_VB + h * 64;
#pragma unroll
        for (int i = 0; i < 4; ++i) { const int p = tid + i * NTHR;
            { const int r = p & 31, c = (p >> 5) & 7, st = p >> 8; const v4u v = *(const v4u*)(kg + (size_t)(st * 32 + r) * EV_N + c * 8); *(LAS v4u*)(lds + st * 4096 + c * 512 + r * 16) = v; }
            { const int cc = p & 3, row = (p >> 2) & 255, dh = p >> 10; const v4u v = *(const v4u*)(vg + (size_t)row * EV_N + dh * 32 + cc * 8); *(LAS v4u*)(lds + 32768 + dh * 16384 + row * 64 + cc * 16) = v; } }
        for (int d = tid; d < 1024; d += NTHR) lut[d] = a.in[9][t5_bucket(d) * 16 + 8 + h] * LOG2E; }
    if (tid == 0) misc[16] = 0u;
    __syncthreads();
    unsigned sv[16];
#pragma unroll
    for (int k = 0; k < 16; ++k) { const int t = (n + 1) * 256 + k * NTHR + tid; sv[k] = t < SEQ ? sel3[(size_t)(rowbase + t) * 8 + h] : 0u; }
#pragma unroll
    for (int k = 0; k < 16; ++k) { const int tb = (n + 1) * 256 + k * NTHR; if (tb < SEQ) { const int t = tb + tid;
        const unsigned s = sv[k]; const unsigned nv = s >> 24; int slot = -1;
        if (nv > 0u && (s & 255u) == (unsigned)n) slot = 0; else if (nv > 1u && ((s >> 8) & 255u) == (unsigned)n) slot = 1; else if (nv > 2u && ((s >> 16) & 255u) == (unsigned)n) slot = 2;
        const unsigned long long bal = __ballot(slot >= 0); const unsigned wcnt = __popcll(bal);
        if (lane == 0) misc[wave] = wcnt;
        __syncthreads();
        unsigned off = misc[16], tot = 0u;
#pragma unroll
        for (int w = 0; w < 8; ++w) { const unsigned c = misc[w]; if (w < wave) off += c; tot += c; }
        if (slot >= 0) list[off + __popcll(bal & ((1ull << lane) - 1ull))] = ((unsigned)t << 2) | (unsigned)slot;
        __syncthreads();
        if (tid == 0) misc[16] += tot; } }
    __syncthreads();
    const int nlist = (int)misc[16];
    const int ntl = (nlist + 31) >> 5, hi = lane >> 5;
    bf16x8 qa[4], qb2[4];
    moba_qload(qa, proj, rowbase, h, n * 256 + wave * 32 + (lane & 31), hi);
    unsigned ea = 0u, eb = 0u; bool va = false, vb = false;
    const int lastl = nlist > 0 ? nlist - 1 : 0;
#define MOBA_LD(Q, E, V, T) do { const int li_ = (T) * 32 + (lane & 31); V = li_ < nlist; E = list[li_ < lastl ? li_ : lastl]; const int tq_ = (int)(E >> 2); moba_qload(Q, proj, rowbase, h, tq_ < SEQ - 1 ? tq_ : SEQ - 1, hi); } while (0)
    const int nw = ntl > wave ? (ntl - wave + 7) >> 3 : 0;
    MOBA_LD(qb2, eb, vb, wave);
    moba_tile(F, qa, rowbase, h, n, n * 256 + wave * 32 + (lane & 31), true, 3, true, wave);
    int j = 0;
    for (; j + 2 <= nw; j += 2) {
        MOBA_LD(qa, ea, va, wave + 8 * (j + 1));
        moba_tile(F, qb2, rowbase, h, n, (int)(eb >> 2), vb, (int)(eb & 3u), false, 0);
        MOBA_LD(qb2, eb, vb, wave + 8 * (j + 2));
        moba_tile(F, qa, rowbase, h, n, (int)(ea >> 2), va, (int)(ea & 3u), false, 0);
    }
    if (j < nw) moba_tile(F, qb2, rowbase, h, n, (int)(eb >> 2), vb, (int)(eb & 3u), false, 0);
#undef MOBA_LD
}

DI void dsa_step(const bf16x8 (&af)[2][4], const bf16x8 (&qlf)[4], int ch, LAS const unsigned char* bsel, LAS unsigned char* cbuf, LAS const float* tab,
                 float& m, float& l, f32x4 (&oT)[8], int l15, int kg, int lane) {
    f32x4 acc[2];
#pragma unroll
    for (int mt = 0; mt < 2; ++mt) { const unsigned b4 = *(LAS const unsigned*)(bsel + ch * 32 + mt * 16 + 4 * kg);
#pragma unroll
        for (int i = 0; i < 4; ++i) { const unsigned bb = (b4 >> (8 * i)) & 255u; const float tb = tab[(bb & 31u) * 8 + (l15 & 7)];
            acc[mt][i] = (tb - m) + (bb != 255u ? 0.f : -INFINITY); } }
#pragma unroll
    for (int mt = 0; mt < 2; ++mt)
#pragma unroll
        for (int ks = 0; ks < 4; ++ks) { acc[mt] = mfma16(af[mt][ks], qlf[ks], acc[mt]); *(LAS bf16x8*)(cbuf + (mt * 16 + l15) * 288 + (ks * 32 + kg * 8) * 2) = af[mt][ks]; }
    float mx = fmaxf(fmaxf(fmaxf(acc[0][0], acc[0][1]), fmaxf(acc[0][2], acc[0][3])), fmaxf(fmaxf(acc[1][0], acc[1][1]), fmaxf(acc[1][2], acc[1][3])));
    if (__any(mx > 16.f)) { mx = fmaxf(mx, __shfl_xor(mx, 16)); mx = fmaxf(mx, __shfl_xor(mx, 32));
        const float dl = fmaxf(mx, 0.f), sc = ex2(-dl); m += dl; l *= sc;
#pragma unroll
        for (int mt = 0; mt < 2; ++mt) acc[mt] = acc[mt] - dl;
#pragma unroll
        for (int ct = 0; ct < 8; ++ct) oT[ct] = oT[ct] * sc; }
    float ps = 0.f;
#pragma unroll
    for (int mt = 0; mt < 2; ++mt)
#pragma unroll
        for (int i = 0; i < 4; ++i) { acc[mt][i] = ex2(acc[mt][i]); ps += acc[mt][i]; }
    l += ps;
    v4u pw; pw.x = cvtpk(acc[0][0], acc[0][1]); pw.y = cvtpk(acc[0][2], acc[0][3]); pw.z = cvtpk(acc[1][0], acc[1][1]); pw.w = cvtpk(acc[1][2], acc[1][3]);
    const bf16x8 pf = __builtin_bit_cast(bf16x8, pw);
    asm volatile("" ::: "memory");
    LAS const char* tp = (LAS const char*)cbuf + (4 * kg + (l15 >> 2)) * 288 + (lane & 3) * 8;
#pragma unroll
    for (int ct = 0; ct < 8; ++ct) { const bf16x8 cf = cat8(vtr(tp + ct * 32), vtr(tp + 16 * 288 + ct * 32)); oT[ct] = mfma16(cf, pf, oT[ct]); }
    asm volatile("" ::: "memory");
}
DI void dsa_gather(bf16x8 (&af)[2][4], const bf16* ckvn, int rowbase, LAS const unsigned short* selb, int ch, int l15, int kg) {
#pragma unroll
    for (int mt = 0; mt < 2; ++mt) { unsigned idx = selb[ch * 32 + mt * 16 + l15]; if (idx == 0xffffu) idx = 0u;
        const bf16* cp = ckvn + (size_t)(rowbase + (int)idx) * 128 + kg * 8;
#pragma unroll
        for (int ks = 0; ks < 4; ++ks) af[mt][ks] = *(const bf16x8*)(cp + ks * 32); }
}
DI void dsa_query(const Fr& F, int tok, const v2u sv, LAS unsigned char* wl, LAS const unsigned char* bkt, LAS const float* tab) {
    const bf16* ql = (const bf16*)(F.ws + WS_QL); const bf16* ckvn = (const bf16*)(F.ws + WS_CKVN); const unsigned short* sel = (const unsigned short*)(F.ws + WS_SEL); bf16* ol = (bf16*)(F.ws + WS_OL);
    const int lane = F.lane, l15 = lane & 15, kg = lane >> 4, t = tok % SEQ, rowbase = tok - t;
    LAS unsigned short* selb = (LAS unsigned short*)wl; LAS unsigned char* bsel = wl + 512; LAS unsigned char* cbuf = wl + 1024;
    { *((LAS v2u*)selb + lane) = sv; unsigned bw = 0u;
#pragma unroll
        for (int i = 0; i < 4; ++i) { const unsigned s = (i < 2 ? (sv.x >> (16 * i)) : (sv.y >> (16 * (i - 2)))) & 0xffffu; const int dist = t - (int)s;
            const unsigned bb = (s != 0xffffu && dist >= 0) ? (unsigned)bkt[dist > 1023 ? 1023 : dist] : 255u; bw |= bb << (8 * i); }
        *((LAS unsigned*)bsel + lane) = bw; }
    bf16x8 qlf[4];
#pragma unroll
    for (int ks = 0; ks < 4; ++ks) { qlf[ks] = *(const bf16x8*)(ql + (size_t)tok * 1024 + (l15 & 7) * 128 + ks * 32 + kg * 8); if (l15 >= 8) qlf[ks] = (bf16x8){0, 0, 0, 0, 0, 0, 0, 0}; }
    float m = 0.f, l = 0.f; f32x4 oT[8];
#pragma unroll
    for (int ct = 0; ct < 8; ++ct) oT[ct] = (f32x4){0.f, 0.f, 0.f, 0.f};
    const int nvalid = t + 1 < 256 ? t + 1 : 256, nch = (nvalid + 31) >> 5;
    LDS_WAIT();
    bf16x8 afa[2][4], afb[2][4], afc[2][4];
    const int lastc = nch - 1;
    dsa_gather(afa, ckvn, rowbase, selb, 0, l15, kg);
    dsa_gather(afb, ckvn, rowbase, selb, lastc < 1 ? lastc : 1, l15, kg);
    int ch = 0;
    for (; ch + 3 <= nch; ch += 3) {
        dsa_gather(afc, ckvn, rowbase, selb, ch + 2, l15, kg);
        dsa_step(afa, qlf, ch, bsel, cbuf, tab, m, l, oT, l15, kg, lane);
        dsa_gather(afa, ckvn, rowbase, selb, ch + 3 < lastc ? ch + 3 : lastc, l15, kg);
        dsa_step(afb, qlf, ch + 1, bsel, cbuf, tab, m, l, oT, l15, kg, lane);
        dsa_gather(afb, ckvn, rowbase, selb, ch + 4 < lastc ? ch + 4 : lastc, l15, kg);
        dsa_step(afc, qlf, ch + 2, bsel, cbuf, tab, m, l, oT, l15, kg, lane);
    }
    if (ch < nch) dsa_step(afa, qlf, ch, bsel, cbuf, tab, m, l, oT, l15, kg, lane);
    if (ch + 1 < nch) dsa_step(afb, qlf, ch + 1, bsel, cbuf, tab, m, l, oT, l15, kg, lane);
    l += __shfl_xor(l, 16); l += __shfl_xor(l, 32);
    const float inv = 1.f / l;
    if (l15 < 8) { bf16* o = ol + (size_t)tok * 1024 + l15 * 128 + 4 * kg;
#pragma unroll
        for (int ct = 0; ct < 8; ++ct) { v2u w; w.x = cvtpk(oT[ct][0] * inv, oT[ct][1] * inv); w.y = cvtpk(oT[ct][2] * inv, oT[ct][3] * inv); *(v2u*)(o + ct * 16) = w; } }
}
DI void dsa_chunk(const Args& a, const Fr& F, int c32) {
    LAS unsigned char* bkt = F.lds + 81920; LAS float* tab = (LAS float*)(F.lds + 82944);
    __syncthreads();
    for (int d = F.tid; d < 1024; d += NTHR) bkt[d] = (unsigned char)t5_bucket(d);
    if (F.tid < 256) tab[F.tid] = a.in[9][(F.tid >> 3) * 16 + (F.tid & 7)] * LOG2E;
    __syncthreads();
    const unsigned short* selg = (const unsigned short*)(F.ws + WS_SEL); v2u svq[4];
#pragma unroll
    for (int i = 0; i < 4; ++i) svq[i] = *((const v2u*)(selg + (size_t)(c32 * 32 + F.wave * 4 + i) * 256) + F.lane);
#pragma unroll
    for (int i = 0; i < 4; ++i) dsa_query(F, c32 * 32 + F.wave * 4 + i, svq[i], F.lds + F.wave * 10240, bkt, tab);
}

DI void ph_even_post(const Fr& F, int j) {
    const bf16* ol = (const bf16*)(F.ws + WS_OL); bf16* ao = (bf16*)(F.ws + WS_AO);
    const bf16* wuvt = (const bf16*)(F.ws + WS_WUVT) + (size_t)j * 8 * 64 * 128;
    const unsigned char* po = F.ws + WS_ACT; const float* pml = (const float*)(F.ws + WS_PML); const unsigned* sel3 = (const unsigned*)(F.ws + WS_SEL3);
    const int lane = F.lane, wave = F.wave, l15 = lane & 15, kg = lane >> 4;
    for (int chunk = F.blk; chunk < 256; chunk += F.G) { const int tok0 = chunk * 128;
        { const int h = wave; bf16x8 af[4][4];
#pragma unroll
            for (int mt = 0; mt < 4; ++mt)
#pragma unroll
                for (int ks = 0; ks < 4; ++ks) af[mt][ks] = *(const bf16x8*)(wuvt + ((size_t)h * 64 + mt * 16 + l15) * 128 + ks * 32 + kg * 8);
#pragma unroll 1
            for (int tg = 0; tg < 8; tg += 2) { bf16x8 bf[2][4];
#pragma unroll
                for (int u = 0; u < 2; ++u)
#pragma unroll
                    for (int ks = 0; ks < 4; ++ks) bf[u][ks] = *(const bf16x8*)(ol + (size_t)(tok0 + (tg + u) * 16 + l15) * 1024 + h * 128 + ks * 32 + kg * 8);
#pragma unroll
                for (int u = 0; u < 2; ++u) { const int tok = tok0 + (tg + u) * 16 + l15;
#pragma unroll
                    for (int mt = 0; mt < 4; ++mt) { f32x4 d = {0.f, 0.f, 0.f, 0.f};
#pragma unroll
                        for (int ks = 0; ks < 4; ++ks) d = mfma16(af[mt][ks], bf[u][ks], d);
                        v2u w; w.x = cvtpk(d[0], d[1]); w.y = cvtpk(d[2], d[3]); *(v2u*)(ao + (size_t)tok * 1024 + h * 64 + mt * 16 + 4 * kg) = w; } } } }
#pragma unroll 1
        for (int i0 = 0; i0 < 16; i0 += 4) { const int h = lane >> 3, d0 = (lane & 7) * 8; unsigned nvv[4]; f32x2 mlv[4][4];
#pragma unroll
            for (int i = 0; i < 4; ++i) { const int tok = tok0 + wave * 16 + i0 + i; const size_t pi = ((size_t)tok * 8 + h) * 4; nvv[i] = sel3[(size_t)tok * 8 + h] >> 24;
#pragma unroll
                for (int s = 0; s < 4; ++s) mlv[i][s] = *(const f32x2*)(pml + (pi + s) * 2); }
#pragma unroll
            for (int i = 0; i < 4; ++i) { const int tok = tok0 + wave * 16 + i0 + i; const size_t pi = ((size_t)tok * 8 + h) * 4;
                float mj[4], lj[4];
#pragma unroll
                for (int s = 0; s < 4; ++s) { const bool ok = (s == 3) || ((unsigned)s < nvv[i]); mj[s] = ok ? mlv[i][s][0] : -1e30f; lj[s] = ok ? mlv[i][s][1] : 0.f; }
                const float ms = fmaxf(fmaxf(mj[0], mj[1]), fmaxf(mj[2], mj[3])); float wsum = 0.f, acc[8], wv[4]; v2u pv[4];
#pragma unroll
                for (int k = 0; k < 8; ++k) acc[k] = 0.f;
#pragma unroll
                for (int s = 0; s < 4; ++s) { wv[s] = lj[s] * ex2(mj[s] - ms); wsum += wv[s]; pv[s] = (v2u){0u, 0u}; if (wv[s] > 0.f) pv[s] = *(const v2u*)(po + (pi + s) * 64 + d0); }
#pragma unroll
                for (int s = 0; s < 4; ++s) { if (wv[s] > 0.f) {
#pragma unroll
                    for (int k = 0; k < 2; ++k) { const f32x2 lo = __builtin_amdgcn_cvt_pk_f32_fp8((int)pv[s][k], false), hi2 = __builtin_amdgcn_cvt_pk_f32_fp8((int)pv[s][k], true);
                        acc[4 * k] += wv[s] * lo[0]; acc[4 * k + 1] += wv[s] * lo[1]; acc[4 * k + 2] += wv[s] * hi2[0]; acc[4 * k + 3] += wv[s] * hi2[1]; } } }
                const float inv = (1.f / 16.f) / wsum; v4u o; o.x = cvtpk(acc[0] * inv, acc[1] * inv); o.y = cvtpk(acc[2] * inv, acc[3] * inv); o.z = cvtpk(acc[4] * inv, acc[5] * inv); o.w = cvtpk(acc[6] * inv, acc[7] * inv);
                *(v4u*)(ao + (size_t)tok * 1024 + 512 + h * 64 + d0) = o; } }
    }
}
template <class XT> DI f32x4 ld_x4(const XT* p);
template <> DI f32x4 ld_x4<float>(const float* p) { return *(const f32x4*)p; }
template <> DI f32x4 ld_x4<bf16>(const bf16* p) { const v2u w = *(const v2u*)p; return (f32x4){bf2f(w.x & 0xffffu), bf2f(w.x >> 16), bf2f(w.y & 0xffffu), bf2f(w.y >> 16)}; }
template <class XT> DI f32x16 proj32_f32(const float* W, int ldw, int ncols, const XT* xrow, int d_lo, int lane) {
    const int e = lane & 31, kh = lane >> 5; const bool ev = e < ncols;
    f32x16 D;
#pragma unroll
    for (int r = 0; r < 16; ++r) D[r] = 0.f;
    const float* wp = W + (size_t)(d_lo + 4 * kh) * ldw + (ev ? e : 0);
    const XT* xp = xrow + d_lo + 4 * kh;
#pragma unroll 8
    for (int i = 0; i < 64; ++i) { const f32x4 xv = ld_x4<XT>(xp + 8 * i);
        float a0 = wp[(size_t)(8 * i + 0) * ldw], a1 = wp[(size_t)(8 * i + 1) * ldw], a2 = wp[(size_t)(8 * i + 2) * ldw], a3 = wp[(size_t)(8 * i + 3) * ldw];
        if (!ev) { a0 = 0.f; a1 = 0.f; a2 = 0.f; a3 = 0.f; }
        D = __builtin_amdgcn_mfma_f32_32x32x2f32(a0, xv[0], D, 0, 0, 0); D = __builtin_amdgcn_mfma_f32_32x32x2f32(a1, xv[1], D, 0, 0, 0);
        D = __builtin_amdgcn_mfma_f32_32x32x2f32(a2, xv[2], D, 0, 0, 0); D = __builtin_amdgcn_mfma_f32_32x32x2f32(a3, xv[3], D, 0, 0, 0); }
    return D;
}
DI void ph_odd_prep(const Args& a, const Fr& F, int j, int layer) {
    const bf16* proj = (const bf16*)(F.ws + WS_PROJ); const bf16* x = (const bf16*)(F.ws + WS_XB);
    float* logf = (float*)(F.ws + WS_LOGF); float* cs = (float*)(F.ws + WS_CS);
    const float* wf = a.in[6] + (size_t)j * 1024 * 3088 + 3072; const float* bfv = a.in[7] + j * 16;
    LAS float* red = (LAS float*)(F.lds); LAS float* lfb = (LAS float*)(F.lds + 131072);
    LAS unsigned* kmx = (LAS unsigned*)(F.lds + 131072 + 8192);
    const int lane = F.lane, wave = F.wave, tid = F.tid, l31 = lane & 31, hi = lane >> 5;
    for (int chunk = F.blk; chunk < 256; chunk += F.G) { const int tok0 = chunk * 128, b = tok0 / SEQ, t0 = tok0 % SEQ;
        __syncthreads();
        if (tid < 16) kmx[tid] = 0u;
        const int tl = wave & 3, kr = wave >> 2;
        f32x16 D = proj32_f32(wf, 3088, 16, x + (size_t)(tok0 + tl * 32 + l31) * DM, kr * 512, lane);
        if (kr == 1) {
#pragma unroll
            for (int r = 0; r < 8; ++r) red[(tl * 8 + r) * 64 + lane] = D[r]; }
        __syncthreads();
        if (kr == 0) {
#pragma unroll
            for (int r = 0; r < 8; ++r) { const int h = (r & 3) + 8 * (r >> 2) + 4 * hi; const float z = D[r] + red[(tl * 8 + r) * 64 + lane] + bfv[h];
                const float ls = fminf(z, 0.f) - log1pf(__expf(-fabsf(z)));
                lfb[(tl * 32 + l31) * 16 + h] = ls * LOG2E; } }
#pragma unroll 1
        for (int i = 0; i < 4; ++i) { const int p = tid + i * NTHR, tk = p >> 4, h = p & 15; const v4u* kp = (const v4u*)(proj + (size_t)(tok0 + tk) * OD_N + OC_K + h * 64); float s = 0.f;
#pragma unroll
            for (int c = 0; c < 8; ++c) { const v4u w = kp[c];
#pragma unroll
                for (int k = 0; k < 4; ++k) { const float e0 = bf2f(w[k] & 0xffffu), e1 = bf2f(w[k] >> 16); s += e0 * e0 + e1 * e1; } }
            __hip_atomic_fetch_max(kmx + h, __float_as_uint(s), __ATOMIC_RELAXED, __HIP_MEMORY_SCOPE_WORKGROUP); }
        __syncthreads();
        for (int i = tid; i < 2048; i += NTHR) { const int h = i >> 7, tk = i & 127; logf[((size_t)b * 16 + h) * SEQ + t0 + tk] = lfb[tk * 16 + h]; }
        if (tid < 32) { const int h = tid & 15, c = tid >> 4; float s = 0.f;
            for (int k = 0; k < 64; ++k) s += lfb[(c * 64 + k) * 16 + h];
            cs[((size_t)b * 16 + h) * 128 + (t0 >> 6) + c] = s; }
        if (tid < 16) __hip_atomic_fetch_max(F.ctl + CW_KMAX + layer * 64 + b * 16 + tid, kmx[tid], RLX_AGENT);
    }
}

constexpr float FOX_SKIP_LOG2 = 64.f;
struct FoxBias { LAS const float* ng; int tq, kabs0; bool any;
    DI float b(int kvrel) const { return ng[kvrel]; }
    DI bool msk(int kvrel) const { return (kabs0 + kvrel) > tq; } };
DI void fox_unit(const Fr& F, int layer, int b, int h, int qb) {
    const bf16* proj = (const bf16*)(F.ws + WS_PROJ); const float* logf = (const float*)(F.ws + WS_LOGF); const float* cs = (const float*)(F.ws + WS_CS); bf16* ao = (bf16*)(F.ws + WS_AO);
    LAS unsigned char* lds = F.lds; LAS float* ng = (LAS float*)(lds + 32768); LAS float* red = (LAS float*)(lds + 65536 + 1024); LAS int* ibox = (LAS int*)(lds + 65536 + 2048);
    const int tid = F.tid, lane = F.lane, wave = F.wave, r32 = lane & 31, hi = lane >> 5, t0 = qb * 256, rowbase = b * SEQ, tq = t0 + wave * 32 + r32;
    __syncthreads();
    bf16x8 qf[4]; float qs = 0.f;
    { const bf16* qp = proj + (size_t)(rowbase + tq) * OD_N + OC_Q + h * 64 + hi * 8;
#pragma unroll
        for (int s = 0; s < 4; ++s) { qf[s] = *(const bf16x8*)(qp + s * 16);
#pragma unroll
            for (int k = 0; k < 8; ++k) { const float e = bf2f((unsigned short)qf[s][k]); qs += e * e; } } }
    qs += __shfl_xor(qs, 32); qs = wave_max(qs);
    if (lane == 0) red[wave] = qs;
    if (tid < 128) red[32 + tid] = (tid < t0 / 64) ? cs[((size_t)b * 16 + h) * 128 + tid] : 0.f;
    __syncthreads();
    if (tid == 0) { float qm = red[0];
        for (int w = 1; w < 8; ++w) qm = fmaxf(qm, red[w]);
        const float km = __uint_as_float(ld_u32(F.ctl + CW_KMAX + layer * 64 + b * 16 + h));
        const float B2 = 2.f * (sqrtf(qm * km) * 1.01f + 1.f);
        int kt = t0 / 64 - 1, kts = t0 / 64; float D = 0.f;
        while (kt >= 0 && B2 + D >= -FOX_SKIP_LOG2) { kts = kt; D += red[32 + kt]; --kt; }
        ibox[0] = kts; }
    __syncthreads();
    const int kts = ibox[0], s_start = kts * 64, nel = t0 + 256 - s_start;
    { const int i0 = tid * 16; float v[16]; const float* lp = logf + ((size_t)b * 16 + h) * SEQ + s_start + i0;
        if (i0 < nel) {
#pragma unroll
            for (int c = 0; c < 4; ++c) { const f32x4 w = *(const f32x4*)(lp + 4 * c); v[4 * c] = w[0]; v[4 * c + 1] = w[1]; v[4 * c + 2] = w[2]; v[4 * c + 3] = w[3]; } }
        else {
#pragma unroll
            for (int c = 0; c < 16; ++c) v[c] = 0.f; }
#pragma unroll
        for (int c = 1; c < 16; ++c) v[c] += v[c - 1];
        float xsum = v[15];
#pragma unroll
        for (int o = 1; o < 64; o <<= 1) { const float y = __shfl_up(xsum, o); if (lane >= o) xsum += y; }
        if (lane == 63) red[16 + wave] = xsum;
        __syncthreads();
        float off = xsum - v[15];
        for (int w = 0; w < wave; ++w) off += red[16 + w];
        if (i0 < nel) {
#pragma unroll
            for (int c = 0; c < 4; ++c) { f32x4 w = {-(off + v[4 * c]), -(off + v[4 * c + 1]), -(off + v[4 * c + 2]), -(off + v[4 * c + 3])}; *(LAS f32x4*)(ng + i0 + 4 * c) = w; } }
    }
    const int ntile = t0 / 64 + 4 - kts;
    const bf16* kg = proj + (size_t)rowbase * OD_N + OC_K + h * 64; const bf16* vg = proj + (size_t)rowbase * OD_N + OC_V + h * 64;
    const int kr = tid & 31, kc = (tid >> 5) & 7, kst = tid >> 8, vcc = tid & 3, vrow = (tid >> 2) & 63, vdh = tid >> 8;
    const int koff = kst * 4096 + kc * 512 + kr * 16, voff = 8192 + vdh * 4096 + vrow * 64 + vcc * 16;
    const bf16* kgp = kg + (size_t)(kts * 64 + kst * 32 + kr) * OD_N + kc * 8; const bf16* vgp = vg + (size_t)(kts * 64 + vrow) * OD_N + vdh * 32 + vcc * 8;
#define FOX_LD(KV, VV, I) do { const int ii_ = (I) < ntile - 1 ? (I) : ntile - 1; KV = *(const v4u*)(kgp + (size_t)ii_ * 64 * OD_N); VV = *(const v4u*)(vgp + (size_t)ii_ * 64 * OD_N); } while (0)
    v4u kvA, vvA, kvB, vvB;
    { v4u kv, vv; FOX_LD(kv, vv, 0); FOX_LD(kvA, vvA, 1);
        *(LAS v4u*)(lds + koff) = kv; *(LAS v4u*)(lds + voff) = vv; }
    __syncthreads();
    AttSt S; S.m = 0.f; S.l = 0.f;
#pragma unroll
    for (int r = 0; r < 16; ++r) { S.o0[r] = 0.f; S.o1[r] = 0.f; }
    const int wlast = t0 + wave * 32 + 31, wfirst = t0 + wave * 32;
#define FOX_COMPUTE(I, BUF) do { const int kv0 = (kts + (I)) * 64; LAS const char* bp_ = (LAS const char*)(lds + (BUF)); \
        if (kv0 + 32 <= wlast) { FoxBias bf0{ng + (kv0 - s_start), tq, kv0, kv0 + 31 > wfirst}, bf1{ng + (kv0 + 32 - s_start), tq, kv0 + 32, kv0 + 63 > wfirst}; \
            att_tile64(S, qf, bp_, bp_ + 8192, 4096, 0, lane, bf0, bf1); } \
        else if (kv0 <= wlast) { FoxBias bf{ng + (kv0 - s_start), tq, kv0, kv0 + 31 > wfirst}; \
            att_subtile(S, qf, bp_, bp_ + 8192, 4096, 0, lane, bf); } } while (0)
    for (int i = 0; i < ntile; i += 2) {
        FOX_LD(kvB, vvB, i + 2);
        FOX_COMPUTE(i, 0);
        if (i + 1 < ntile) { *(LAS v4u*)(lds + 16384 + koff) = kvA; *(LAS v4u*)(lds + 16384 + voff) = vvA; }
        __syncthreads();
        if (i + 1 >= ntile) break;
        FOX_LD(kvA, vvA, i + 3);
        FOX_COMPUTE(i + 1, 16384);
        if (i + 2 < ntile) { *(LAS v4u*)(lds + koff) = kvB; *(LAS v4u*)(lds + voff) = vvB; }
        __syncthreads();
    }
#undef FOX_LD
#undef FOX_COMPUTE
    const float lt = S.l + __shfl_xor(S.l, 32), inv = 1.f / lt;
    bf16* o = ao + (size_t)(rowbase + tq) * 1024 + h * 64;
#pragma unroll
    for (int a4 = 0; a4 < 4; ++a4) { v2u w0, w1;
        w0.x = cvtpk(S.o0[4 * a4] * inv, S.o0[4 * a4 + 1] * inv); w0.y = cvtpk(S.o0[4 * a4 + 2] * inv, S.o0[4 * a4 + 3] * inv);
        w1.x = cvtpk(S.o1[4 * a4] * inv, S.o1[4 * a4 + 1] * inv); w1.y = cvtpk(S.o1[4 * a4 + 2] * inv, S.o1[4 * a4 + 3] * inv);
        *(v2u*)(o + 8 * a4 + 4 * hi) = w0; *(v2u*)(o + 32 + 8 * a4 + 4 * hi) = w1; }
}

DI void ph_ln1_router(const Args& a, const Fr& F, int layer) {
    const bf16* yp = (const bf16*)(F.ws + WS_YP); bf16* x1 = (bf16*)(F.ws + WS_X1); unsigned char* xb8 = F.ws + WS_XB8;
    unsigned* tope = (unsigned*)(F.ws + WS_TOPE); float* gate = (float*)(F.ws + WS_GATE); unsigned* rank = (unsigned*)(F.ws + WS_RANK);
    const float* g = a.in[10] + (size_t)(layer * 2) * DM; const float* bb = a.in[11] + (size_t)(layer * 2) * DM;
    const float* rw = a.in[12] + (size_t)layer * 1024 * 32; const float* rb = a.in[13] + layer * 32;
    LAS float* red = (LAS float*)(F.lds); LAS unsigned* lcnt = (LAS unsigned*)(F.lds + 131072);
    const int lane = F.lane, wave = F.wave, tid = F.tid, l31 = lane & 31, hi = lane >> 5;
    for (int chunk = F.blk; chunk < 256; chunk += F.G) { const int tok0 = chunk * 128;
        __syncthreads();
        if (tid < 32) lcnt[tid] = 0u;
#pragma unroll 1
        for (int k = 0; k < 16; k += 8) { f32x4 v[8][4];
#pragma unroll
            for (int i = 0; i < 8; ++i)
#pragma unroll
                for (int jj = 0; jj < 4; ++jj) { const v2u w = *((const v2u*)(yp + (size_t)(tok0 + wave * 16 + k + i) * DM) + lane + 64 * jj);
                    v[i][jj] = (f32x4){bf2f(w.x & 0xffffu), bf2f(w.x >> 16), bf2f(w.y & 0xffffu), bf2f(w.y >> 16)}; }
#pragma unroll
            for (int i = 0; i < 8; ++i) { const int tok = tok0 + wave * 16 + k + i;
                ln_row(v[i], g, bb, lane);
                store_row_bf16(x1 + (size_t)tok * DM, v[i], lane);
#pragma unroll
                for (int jj = 0; jj < 4; ++jj) *((unsigned*)(xb8 + (size_t)tok * DM) + lane + 64 * jj) = pk4_fp8(v[i][jj][0] * F8_SX, v[i][jj][1] * F8_SX, v[i][jj][2] * F8_SX, v[i][jj][3] * F8_SX); } }
        asm volatile("s_waitcnt vmcnt(0)" ::: "memory");
        __syncthreads();
        const int tl = wave & 3, kr = wave >> 2, tokl = tok0 + tl * 32 + l31;
        f32x16 D = proj32_f32(rw, 32, 32, x1 + (size_t)tokl * DM, kr * 512, lane);
        if (kr == 1) {
#pragma unroll
            for (int r = 0; r < 16; ++r) red[(tl * 16 + r) * 64 + lane] = D[r]; }
        __syncthreads();
        if (kr == 0) {
            float lv[32];
#pragma unroll
            for (int r = 0; r < 16; ++r) { const float own = D[r] + red[(tl * 16 + r) * 64 + lane] + rb[crow(r, hi)]; const float oth = __shfl_xor(own, 32);
                lv[crow(r, 0)] = hi == 0 ? own : oth; lv[crow(r, 1)] = hi == 0 ? oth : own; }
            float tv[4]; int te[4];
#pragma unroll
            for (int r = 0; r < 4; ++r) { float mx = -INFINITY; int me = 0;
#pragma unroll
                for (int e = 0; e < 32; ++e) { if (lv[e] > mx) { mx = lv[e]; me = e; } }
                tv[r] = mx; te[r] = me;
#pragma unroll
                for (int e = 0; e < 32; ++e) { if (e == me) lv[e] = -INFINITY; } }
            const float e1 = __expf(tv[1] - tv[0]), e2 = __expf(tv[2] - tv[0]), e3 = __expf(tv[3] - tv[0]); const float inv = 1.f / (1.f + e1 + e2 + e3);
            if (hi == 0) { const size_t o = (size_t)tokl * 4;
                const float gv[4] = {inv, e1 * inv, e2 * inv, e3 * inv};
#pragma unroll
                for (int r = 0; r < 4; ++r) { const unsigned rk = __hip_atomic_fetch_add(lcnt + (te[r] & 31), 1u, __ATOMIC_RELAXED, __HIP_MEMORY_SCOPE_WORKGROUP);
                    tope[o + r] = (unsigned)(te[r] & 31); gate[o + r] = gv[r]; rank[o + r] = rk; } } }
        __syncthreads();
        if (tid < 32) __hip_atomic_store(F.ctl + CW_CNT + chunk * 32 + tid, lcnt[tid], RLX_AGENT);
    }
}

DI void ph_route(const Fr& F) {
    unsigned short* srcg = (unsigned short*)(F.ws + WS_SRC);
    const unsigned* tope = (const unsigned*)(F.ws + WS_TOPE); const unsigned* rank = (const unsigned*)(F.ws + WS_RANK); unsigned* dest = (unsigned*)(F.ws + WS_DEST);
    LAS unsigned* P = (LAS unsigned*)(F.lds); LAS unsigned* pst = P + 512; LAS unsigned* pad = P + 544; LAS unsigned* base = P + 576; LAS unsigned* nt = P + 608; LAS unsigned* totl = P + 640;
    const int tid = F.tid;
    __syncthreads();
    { const int e = tid & 31, part = tid >> 5; unsigned s = 0u;
        for (int c = 0; c < 16; ++c) s += ld_u32(F.ctl + CW_CNT + (part * 16 + c) * 32 + e);
        P[part * 32 + e] = s; }
    __syncthreads();
    if (tid < 32) { unsigned tot = 0u;
        for (int p = 0; p < 16; ++p) tot += P[p * 32 + tid];
        totl[tid] = tot; pad[tid] = (tot + 255u) & ~255u; }
    __syncthreads();
    if (tid == 0) { unsigned acc = 0u;
        for (int e = 0; e < 32; ++e) { pst[e] = acc; acc += pad[e]; }
        nt[0] = acc >> 8; }
    __syncthreads();
    if (F.blk < 32) { const int e = F.blk;
        for (unsigned i = totl[e] + tid; i < pad[e]; i += NTHR) srcg[pst[e] + i] = (unsigned short)0; }
    for (int chunk = F.blk; chunk < 256; chunk += F.G) {
        __syncthreads();
        if (tid < 32) { unsigned off = 0u; const int pf = chunk >> 4;
            for (int p = 0; p < pf; ++p) off += P[p * 32 + tid];
            for (int c = pf * 16; c < chunk; ++c) off += ld_u32(F.ctl + CW_CNT + c * 32 + tid);
            base[tid] = pst[tid] + off; }
        __syncthreads();
        { const size_t pi = (size_t)chunk * 512 + tid;
            const unsigned d = base[tope[pi] & 31u] + rank[pi];
            dest[pi] = d; srcg[d] = (unsigned short)(pi >> 2); }
        if (chunk == 0) { const unsigned ntl = nt[0];
            if (tid == 0) __hip_atomic_store(F.ctl + CW_TILE, ntl, RLX_AGENT);
            for (unsigned i = tid; i < ntl; i += NTHR) { unsigned e = 0u;
                for (unsigned k = 1; k < 32; ++k) if (pst[k] <= i * 256u) e = k;
                __hip_atomic_store(F.ctl + CW_TILE + 64 + i, e, RLX_AGENT); } }
    }
}

DI void ph_combine_ln2(const Args& a, const Fr& F, int layer) {
    const bf16* x1 = (const bf16*)(F.ws + WS_X1); const unsigned char* yr = F.ws + WS_XG; bf16* xb = (bf16*)(F.ws + WS_XB);
    const float* gate = (const float*)(F.ws + WS_GATE); const unsigned* dest = (const unsigned*)(F.ws + WS_DEST);
    const float* g = a.in[10] + (size_t)(layer * 2 + 1) * DM; const float* bb = a.in[11] + (size_t)(layer * 2 + 1) * DM;
    const int lane = F.lane; const int gw = F.blk * NWAVES + F.wave, NGW = F.G * NWAVES;
    for (int tok = gw; tok < NTOK; tok += 4 * NGW) { f32x4 v[4][4];
#pragma unroll
        for (int i = 0; i < 4; ++i) { const int tk = tok + i * NGW; if (tk < NTOK) {
#pragma unroll
            for (int jj = 0; jj < 4; ++jj) { const v2u w = *((const v2u*)(x1 + (size_t)tk * DM) + lane + 64 * jj);
                v[i][jj] = (f32x4){bf2f(w.x & 0xffffu), bf2f(w.x >> 16), bf2f(w.y & 0xffffu), bf2f(w.y >> 16)} * ALPHA; }
#pragma unroll
            for (int k = 0; k < 4; ++k) { const float gk = gate[(size_t)tk * 4 + k] * (1.f / F8_SY); const unsigned d = dest[(size_t)tk * 4 + k];
#pragma unroll
                for (int jj = 0; jj < 4; ++jj) { const int w = (int)*((const unsigned*)(yr + (size_t)d * DM) + lane + 64 * jj);
                    const f32x2 lo = __builtin_amdgcn_cvt_pk_f32_fp8(w, false), hi2 = __builtin_amdgcn_cvt_pk_f32_fp8(w, true);
                    v[i][jj][0] += gk * lo[0]; v[i][jj][1] += gk * lo[1]; v[i][jj][2] += gk * hi2[0]; v[i][jj][3] += gk * hi2[1]; } } } }
#pragma unroll
        for (int i = 0; i < 4; ++i) { const int tk = tok + i * NGW; if (tk < NTOK) {
            ln_row(v[i], g, bb, lane);
            if (layer == DEPTH - 1) store_row_f32(a.out + (size_t)tk * DM, v[i], lane);
            else store_row_bf16(xb + (size_t)tk * DM, v[i], lane); } } }
}
constexpr int LDS_BYTES = 147456;
constexpr int LDS_BARW = 145408, LDS_QSLOT = 145472, LDS_TILE_E = 133632, LDS_SRCL = 136192;
constexpr int NPL = 11;
constexpr int NPHASE = 1 + NPL * DEPTH;
#ifndef MK_SINGLE
#define MK_SINGLE 1
#endif
DI int q_next(const Fr& F, unsigned* ctr) {
    LAS int* slot = (LAS int*)(F.lds + LDS_QSLOT);
    __syncthreads();
    if (F.tid == 0) *slot = (int)__hip_atomic_fetch_add(ctr, 1u, RLX_AGENT);
    __syncthreads();
    return *slot;
}
DI int lane_id_fresh() { unsigned m_ = ~0u; asm volatile("" : "+s"(m_)); return (int)__builtin_amdgcn_mbcnt_hi(m_, __builtin_amdgcn_mbcnt_lo(m_, 0u)); }
#define RETID(F) do { int t2_ = F.tid; asm volatile("" : "+v"(t2_)); F.tid = t2_; F.lane = t2_ & 63; F.wave = __builtin_amdgcn_readfirstlane(t2_ >> 6); } while (0)
#ifndef PROBE_DUP
#define PROBE_DUP -1
#endif
#define NREP(q) ((PROBE_DUP == (q)) ? 2 : 1)
#define AS4 __attribute__((address_space(4)))
#define SITE() Args a; Fr F; { const AS4 Args* ap = (const AS4 Args*)__builtin_amdgcn_kernarg_segment_ptr(); asm volatile("" : "+s"(ap)); \
        _Pragma("unroll") for (int i_ = 0; i_ < 18; ++i_) a.in[i_] = ap->in[i_]; a.out = ap->out; a.ws = ap->ws; a.ph_lo = 0; a.ph_hi = 0; \
        int w_ = wv_s; asm volatile("" : "+s"(w_)); int t_ = w_ * 64 + lane_id_fresh(); asm volatile("" : "+v"(t_)); F.tid = t_; F.lane = t_ & 63; F.wave = __builtin_amdgcn_readfirstlane(t_ >> 6); \
        F.lds = (LAS unsigned char*)lds_raw; F.ws = a.ws; F.ctl = (unsigned*)(a.ws + WS_CTL); F.blk = blockIdx.x; F.G = gridDim.x; }
__global__ void __launch_bounds__(NTHR, 2) mega_fwd(Args a0) {
    extern __shared__ __attribute__((aligned(16))) unsigned char lds_raw[];
    const int wv_s = __builtin_amdgcn_readfirstlane((int)(threadIdx.x >> 6));
#if MK_SINGLE
    constexpr int lo = 0, hi = NPHASE; constexpr bool single = true;
#else
    const int lo = a0.ph_lo, hi = a0.ph_hi; constexpr bool single = false;
#endif
    if (threadIdx.x == 0) *(LAS v4u*)((LAS unsigned char*)lds_raw + LDS_BARW) = (v4u){0u, 0u, 0u, 0u};
    __syncthreads();
    if (single) (void)xcd_barrier_post((unsigned*)(a0.ws + WS_CTL) + CW_BAR, (volatile LAS unsigned*)((LAS unsigned char*)lds_raw + LDS_BARW));
#define IN(k) (lo <= (k) && (k) < hi)
#define SEAM() do { if (single) { const AS4 Args* ap_ = (const AS4 Args*)__builtin_amdgcn_kernarg_segment_ptr(); asm volatile("" : "+s"(ap_)); int w_ = wv_s; asm volatile("" : "+s"(w_)); \
        XcdBarrier b_; b_.bar = (unsigned*)(ap_->ws + WS_CTL) + CW_BAR; b_.x = xb_xcc_id(); b_.st = (volatile LAS unsigned*)((LAS unsigned char*)lds_raw + LDS_BARW); \
        xcd_barrier(b_, (w_ == 0) && (lane_id_fresh() == 0)); } } while (0)
    if (IN(0)) { _Pragma("unroll 1") for (int rep = 0; rep < NREP(100); ++rep) { { SITE(); ph_prologue(a, F); } SEAM(); } }
#pragma clang loop unroll(full)
    for (int L = 0; L < DEPTH; ++L) {
        const int pb = 1 + NPL * L, j = L >> 1; const bool odd = (L & 1) != 0;
        if (IN(pb + 0)) _Pragma("unroll 1") for (int rep = 0; rep < NREP(0); ++rep) {
            { SITE();
            const bf16* w = odd ? (const bf16*)(F.ws + WS_WOD) + (size_t)j * OD_N * 1024 : (const bf16*)(F.ws + WS_WEV) + (size_t)j * EV_N * 1024;
            const int N = odd ? OD_N : EV_N;
            pg8::Gemm g{(const bf16*)(F.ws + WS_XB), w, NTOK, N, 1024}; pg8::StaticOrder S; S.init(NTOK, N, F.G, F.blk);
            pg8::EpiBf16<0> E{(bf16*)(F.ws + WS_PROJ), N, nullptr, 1024, (size_t)1024, C2F};
            pg8::gemm_phase<pg8::EpiBf16<0>, pg8::StaticOrder, true, true>(F.lds, g, S, E, F.tid); }
            SEAM(); }
        if (IN(pb + 1)) _Pragma("unroll 1") for (int rep = 0; rep < NREP(1); ++rep) { { SITE(); if (odd) ph_odd_prep(a, F, j, L); else ph_even_prep(a, F, j); } SEAM(); }
        if (!odd && IN(pb + 2)) _Pragma("unroll 1") for (int rep = 0; rep < ((PROBE_DUP == 2 || (PROBE_DUP >= 21 && PROBE_DUP <= 22) || (PROBE_DUP >= 211 && PROBE_DUP <= 217)) ? 2 : 1); ++rep) {
            { SITE(); unsigned* ctr = F.ctl + CW_Q + 64 * (L * 2) + 1024 * rep;
            for (;;) { const int it = q_next(F, ctr); if (it >= 1280) break; RETID(F);
                if (it < 1024) { if (!(rep == 1 && PROBE_DUP == 22)) idx_unit(F, it & 3, 255 - (it >> 2), (rep == 1 && PROBE_DUP >= 211) ? PROBE_DUP - 210 : 0); } else { if (!(rep == 1 && (PROBE_DUP == 21 || PROBE_DUP >= 211))) moba_gate_chunk(F, it - 1024); } } }
            SEAM(); }
        if (IN(pb + 3)) _Pragma("unroll 1") for (int rep = 0; rep < ((PROBE_DUP == 3 || (PROBE_DUP == 31 && odd) || ((PROBE_DUP >= 32 && PROBE_DUP <= 34) && !odd)) ? 2 : 1); ++rep) {
            { SITE(); unsigned* ctr = F.ctl + CW_Q + 64 * (L * 2 + 1) + 1024 * rep;
            if (odd) { for (;;) { const int it = q_next(F, ctr); if (it >= 2048) break; RETID(F); const int bh = it & 63; fox_unit(F, L, bh >> 4, bh & 15, 31 - (it >> 6)); } }
            else { for (;;) { const int it = q_next(F, ctr); if (it >= 2048) break; RETID(F);
                    if (it < 1024) { const int bh = it & 31; if (!(rep == 1 && (PROBE_DUP == 33 || PROBE_DUP == 34))) moba_unit(a, F, bh >> 3, bh & 7, it >> 5); } else { if (!(rep == 1 && PROBE_DUP == 32)) dsa_chunk(a, F, it - 1024); } } } }
            SEAM(); }
        if (!odd && IN(pb + 4)) _Pragma("unroll 1") for (int rep = 0; rep < NREP(4); ++rep) { { SITE(); ph_even_post(F, j); } SEAM(); }
        if (IN(pb + 5)) _Pragma("unroll 1") for (int rep = 0; rep < NREP(5); ++rep) {
            { SITE();
            pg8::Gemm g{(const bf16*)(F.ws + WS_AO), (const bf16*)(F.ws + WS_WOUT) + (size_t)L * 1024 * 1024, NTOK, 1024, 1024}; pg8::StaticOrder S; S.init(NTOK, 1024, F.G, F.blk);
            EpiResBf16 E{(const bf16*)(F.ws + WS_XB), (bf16*)(F.ws + WS_YP), ALPHA};
            pg8::gemm_phase<EpiResBf16, pg8::StaticOrder, true, true>(F.lds, g, S, E, F.tid); }
            SEAM(); }
        if (IN(pb + 6)) _Pragma("unroll 1") for (int rep = 0; rep < NREP(6); ++rep) { { SITE(); ph_ln1_router(a, F, L); } SEAM(); }
        if (IN(pb + 7)) _Pragma("unroll 1") for (int rep = 0; rep < NREP(7); ++rep) { { SITE(); ph_route(F); } SEAM(); }
        if (IN(pb + 8)) _Pragma("unroll 1") for (int rep = 0; rep < NREP(8); ++rep) {
            { SITE(); const int ntl = (int)ld_u32(F.ctl + CW_TILE);
            LAS unsigned* tle = (LAS unsigned*)(F.lds + LDS_TILE_E);
            for (int i = F.tid; i < ntl; i += NTHR) tle[i] = ld_u32(F.ctl + CW_TILE + 64 + i);
            LAS unsigned* srcl = (LAS unsigned*)(F.lds + LDS_SRCL); const unsigned* srcg = (const unsigned*)(F.ws + WS_SRC);
            for (int i = F.tid; i < 17 * 128; i += NTHR) { const int pm = (i >> 7) * 32 + (F.blk & 7) * 4 + (F.blk >> 6); if (pm < ntl) srcl[i] = srcg[(size_t)pm * 128 + (i & 127)]; }
            __syncthreads();
            pg8::Gemm g{(const bf16*)(F.ws + WS_XB8), (const bf16*)(F.ws + WS_WGU + (size_t)L * 32 * 2048 * 1024), NR_MAX, 32 * 2048, 512};
            GroupOrder S{tle, ntl, 3, F.G, F.blk, (LAS const unsigned short*)srcl};
            EpiSwiglu E{F.ws + WS_ACT, a.in[15] + (size_t)L * 32 * 2048};
            pg8::gemm_phase<EpiSwiglu, GroupOrder, true, true, true, true>(F.lds, g, S, E, F.tid); }
            SEAM(); }
        if (IN(pb + 9)) _Pragma("unroll 1") for (int rep = 0; rep < NREP(9); ++rep) {
            { SITE(); const int ntl = (int)ld_u32(F.ctl + CW_TILE);
            LAS unsigned* tle = (LAS unsigned*)(F.lds + LDS_TILE_E);
            for (int i = F.tid; i < ntl; i += NTHR) tle[i] = ld_u32(F.ctl + CW_TILE + 64 + i);
            __syncthreads();
            pg8::Gemm g{(const bf16*)(F.ws + WS_ACT), (const bf16*)(F.ws + WS_WDN + (size_t)L * 32 * 1024 * 1024), NR_MAX, 32 * 1024, 512};
            GroupOrder S{tle, ntl, 2, F.G, F.blk, (LAS const unsigned short*)nullptr};
            EpiDown E{F.ws + WS_XG, a.in[17] + (size_t)L * 32 * 1024};
            pg8::gemm_phase<EpiDown, GroupOrder, true, true, true>(F.lds, g, S, E, F.tid); }
            SEAM(); }
        if (IN(pb + 10)) _Pragma("unroll 1") for (int rep = 0; rep < NREP(10); ++rep) { { SITE(); ph_combine_ln2(a, F, L); } if (L + 1 < DEPTH || rep + 1 < NREP(10)) SEAM(); }
        if (PROBE_DUP == 900 && L + 1 < DEPTH) { _Pragma("unroll 1") for (int xb = 0; xb < 10; ++xb) SEAM(); }
    }
#undef IN
#undef SEAM
}

extern "C" void kernel_launch(void* const* d_in, const int* in_sizes, int n_in, void* d_out, int out_size, void* d_ws, size_t ws_size, hipStream_t stream) {
    static int grid = 0;
    if (grid == 0) {
        if (n_in != 18 || out_size != NTOK * DM || ws_size < WS_END) { fprintf(stderr, "kernel_launch: unexpected shapes (n_in %d, out %d, ws %zu); nothing launched\n", n_in, out_size, ws_size); grid = -1; return; }
        int dev = 0, cus = 0, per_cu = 0;
        if (hipGetDevice(&dev) != hipSuccess || hipDeviceGetAttribute(&cus, hipDeviceAttributeMultiprocessorCount, dev) != hipSuccess) { grid = -1; return; }
        if (hipFuncSetAttribute((const void*)mega_fwd, hipFuncAttributeMaxDynamicSharedMemorySize, LDS_BYTES) != hipSuccess) { fprintf(stderr, "kernel_launch: hipFuncSetAttribute failed\n"); grid = -1; return; }
        if (hipOccupancyMaxActiveBlocksPerMultiprocessor(&per_cu, (const void*)mega_fwd, NTHR, LDS_BYTES) != hipSuccess || per_cu < 1) fprintf(stderr, "kernel_launch: occupancy query reports %d\n", per_cu);
        (void)hipGetLastError();
        if (cus < 256) { fprintf(stderr, "kernel_launch: %d CUs (the gathered gate/up GEMM's unit order assumes the MI355X's 256); nothing launched\n", cus); grid = -1; return; }
        grid = 256;
    }
    if (grid < 0) return;
    (void)hipMemsetAsync((char*)d_ws + WS_CTL, 0, CTL_ZERO_BYTES, stream);
#ifdef EXP_SKIP
    (void)hipMemsetAsync((char*)d_ws + WS_AO, 0, 64 * MiB, stream);
    (void)hipMemsetAsync((char*)d_ws + WS_OL, 0, 64 * MiB, stream);
    if (EXP_SKIP & 4) { (void)hipMemsetAsync((char*)d_ws + WS_XG, 0, 272 * MiB, stream); (void)hipMemsetAsync((char*)d_ws + WS_DEST, 0, 1 * MiB, stream); }
#endif
    Args a{};
    for (int i = 0; i < 18; ++i) a.in[i] = (const float*)d_in[i];
    a.out = (float*)d_out; a.ws = (unsigned char*)d_ws;
#if MK_SINGLE
    a.ph_lo = 0; a.ph_hi = NPHASE;
    hipLaunchKernelGGL(mega_fwd, dim3(grid), dim3(NTHR), LDS_BYTES, stream, a);
#else
    for (int p = 0; p < NPHASE; ++p) {
        if (p > 0) { const int L = (p - 1) / NPL, q = (p - 1) % NPL; if ((L & 1) && (q == 2 || q == 4)) continue;
#ifdef EXP_SKIP
            if ((EXP_SKIP & 1) && !(L & 1) && q <= 4) continue;
            if ((EXP_SKIP & 2) && (L & 1) && q <= 4) continue;
            if ((EXP_SKIP & 4) && q >= 7 && q <= 9) continue;
#endif
        }
        a.ph_lo = p; a.ph_hi = p + 1;
        hipLaunchKernelGGL(mega_fwd, dim3(grid), dim3(NTHR), LDS_BYTES, stream, a);
    }
#endif
}
```

```cpp
#include <hip/hip_runtime.h>
#include <cstdio>
#include <cstdint>
#ifdef EXP_SKIP
#define EXPF EXP_SKIP
#else
#define EXPF 0
#endif
constexpr int NB = 4, SEQ = 8192, DM = 1024, NTOK = NB * SEQ, DEPTH = 4;
constexpr int EV_N = 2560, OD_N = 3072;
constexpr int EC_QA = 0, EC_QB = 512, EC_KB = 1024, EC_VB = 1536, EC_CKV = 2048, EC_QI = 2176, EC_KI = 2432, EC_WI = 2496;
constexpr int OC_Q = 0, OC_K = 1024, OC_V = 2048;
constexpr float LOG2E = 1.4426950408889634f;
constexpr float C2F = 0.125f * LOG2E;
constexpr float ALPHA = 1.681792830507429f;
constexpr float LN_EPS = 1e-5f;
constexpr int NR_MAX = 131072 + 32 * 256;
constexpr int NWAVES = 8, NTHR = 512;
constexpr size_t MiB = (size_t)1 << 20;
constexpr size_t WS_CTL = 0, CTL_ZERO_BYTES = 256 * 1024;
constexpr size_t WS_WEV = 8 * MiB, WS_WOD = 18 * MiB, WS_WOUT = 30 * MiB, WS_WUKT = 38 * MiB, WS_WUVT = 39 * MiB;
constexpr size_t WS_WGU = 40 * MiB, WS_WDN = 552 * MiB;
constexpr size_t WS_X = 808 * MiB, WS_X1 = 936 * MiB, WS_YP = 1064 * MiB, WS_XB = 1192 * MiB;
constexpr size_t WS_PROJ = 1256 * MiB, WS_AO = 1448 * MiB, WS_XG = 1512 * MiB, WS_ACT = 1784 * MiB;
constexpr size_t WS_QL = 2056 * MiB, WS_OL = 2120 * MiB, WS_CKVN = 2184 * MiB, WS_SEL = 2192 * MiB;
constexpr size_t WS_KBAR = 2208 * MiB, WS_SEL3 = 2209 * MiB, WS_LOGF = 2210 * MiB, WS_CS = 2212 * MiB;
constexpr size_t WS_TOPE = 2213 * MiB, WS_GATE = 2214 * MiB, WS_RANK = 2215 * MiB, WS_DEST = 2216 * MiB, WS_PML = 2217 * MiB;
constexpr size_t WS_SRC = WS_DEST + 512 * 1024;
constexpr size_t WS_XB8 = 2226 * MiB;
constexpr size_t WS_KIC = 2258 * MiB;
constexpr size_t WS_END = 2262 * MiB;
constexpr float F8_SX = 16.f, F8_SWG = 256.f, F8_SA = 4.f, F8_SWD = 512.f, F8_SY = 32.f, F8_SAO = 16.f, F8_SWO = 1024.f;
constexpr int CW_BAR = 4096, CW_Q = 8192, CW_KMAX = 12288, CW_CNT = 16384, CW_TILE = 32768;

#define GAS __attribute__((address_space(1)))
#define LAS __attribute__((address_space(3)))
#define DI __device__ __forceinline__
typedef unsigned short bf16;
typedef unsigned v4u __attribute__((ext_vector_type(4)));
typedef unsigned v2u __attribute__((ext_vector_type(2)));
typedef float f32x4 __attribute__((ext_vector_type(4)));
typedef float f32x2 __attribute__((ext_vector_type(2)));
typedef float f32x16 __attribute__((ext_vector_type(16)));
typedef short bf16x8 __attribute__((ext_vector_type(8)));
typedef short s16x4 __attribute__((ext_vector_type(4)));
typedef __bf16 bf16x2_t __attribute__((ext_vector_type(2)));
typedef GAS unsigned gu32;
#define RLX_AGENT __ATOMIC_RELAXED, __HIP_MEMORY_SCOPE_AGENT
#define LDS_WAIT() asm volatile("s_waitcnt lgkmcnt(0)" ::: "memory")

DI float bf2f(unsigned v) { return __uint_as_float(v << 16); }
DI unsigned cvtpk(float lo, float hi) { f32x2 v = {lo, hi}; bf16x2_t b = __builtin_convertvector(v, bf16x2_t); return __builtin_bit_cast(unsigned, b); }
DI unsigned f2bf(float f) { return cvtpk(f, 0.f) & 0xffffu; }
DI unsigned pk4_fp8(float a, float b, float c, float d) {
    a = fminf(fmaxf(a, -448.f), 448.f); b = fminf(fmaxf(b, -448.f), 448.f); c = fminf(fmaxf(c, -448.f), 448.f); d = fminf(fmaxf(d, -448.f), 448.f);
    int w = 0; w = __builtin_amdgcn_cvt_pk_fp8_f32(a, b, w, false); w = __builtin_amdgcn_cvt_pk_fp8_f32(c, d, w, true); return (unsigned)w; }
DI float ex2(float x) { return __builtin_amdgcn_exp2f(x); }
DI float wave_sum(float v) {
#pragma unroll
    for (int o = 1; o < 64; o <<= 1) v += __shfl_xor(v, o);
    return v;
}
DI float wave_max(float v) {
#pragma unroll
    for (int o = 1; o < 64; o <<= 1) v = fmaxf(v, __shfl_xor(v, o));
    return v;
}
DI unsigned ld_u32(const unsigned* p) { return __hip_atomic_load(p, RLX_AGENT); }
DI int crow(int r, int hi) { return (r & 3) + 8 * (r >> 2) + 4 * hi; }
DI f32x16 mfma32(bf16x8 a, bf16x8 b, f32x16 c) { return __builtin_amdgcn_mfma_f32_32x32x16_bf16(a, b, c, 0, 0, 0); }
DI f32x4 mfma16(bf16x8 a, bf16x8 b, f32x4 c) { return __builtin_amdgcn_mfma_f32_16x16x32_bf16(a, b, c, 0, 0, 0); }
typedef short v4i16_t __attribute__((ext_vector_type(4)));
DI s16x4 vtr(LAS const char* p) { return __builtin_bit_cast(s16x4, __builtin_amdgcn_ds_read_tr16_b64_v4i16((LAS v4i16_t*)p)); }
DI bf16x8 cat8(s16x4 a, s16x4 b) { return (bf16x8){a[0], a[1], a[2], a[3], b[0], b[1], b[2], b[3]}; }
DI int t5_bucket(int n) {
    if (n < 16) return n;
    int bkt = 16;
    bkt += (n >= 21); bkt += (n >= 27); bkt += (n >= 35); bkt += (n >= 46); bkt += (n >= 59); bkt += (n >= 77); bkt += (n >= 99); bkt += (n >= 128);
    bkt += (n >= 166); bkt += (n >= 216); bkt += (n >= 280); bkt += (n >= 363); bkt += (n >= 470); bkt += (n >= 609); bkt += (n >= 790);
    return bkt;
}
namespace pg8 {
#define PG8_LAS __attribute__((address_space(3)))
typedef unsigned short bf16_t;
typedef short bf16x8 __attribute__((ext_vector_type(8)));
typedef float f32x4 __attribute__((ext_vector_type(4)));
typedef unsigned u32x4 __attribute__((ext_vector_type(4)));
constexpr int BM = 256, BK = 64, HALF = 128, HTB = HALF * BK * 2  , STAGE_BYTES = 8 * HTB, NXCD = 8, WGM = 8;

__host__ __device__ __forceinline__ int lds_byte(int r, int c) { const int st = (r >> 4) * 2 + (c >> 5), rr = r & 15, cc = c & 31, ob = rr * 64 + cc * 2; return st * 1024 + (ob ^ (((ob >> 9) & 1) << 5)); }
__host__ __device__ __forceinline__ void stage_rc(int b, int& R, int& C) { const int st = b / 1024, sb = b % 1024, swz = sb ^ (((sb >> 9) & 1) << 5); R = (st >> 1) * 16 + swz / 64; C = (st & 1) * 32 + (swz % 64) / 2; }
__host__ __device__ __forceinline__ int perm32(int rho) { const int n = rho >> 4, i = rho & 15; return 8 * (i >> 2) + 4 * n + (i & 3); }

typedef int i32x8 __attribute__((ext_vector_type(8))); typedef int i32x4v __attribute__((ext_vector_type(4)));
__device__ __forceinline__ i32x8 pg8_cat8(bf16x8 lo, bf16x8 hi) { const i32x4v a = __builtin_bit_cast(i32x4v, lo), b = __builtin_bit_cast(i32x4v, hi); return (i32x8){a[0], a[1], a[2], a[3], b[0], b[1], b[2], b[3]}; }
struct Unit { int pm, pn; };
struct Gemm { const bf16_t* A; const bf16_t* Bt; int M, N, K; };

struct StaticOrder {
    int nM, nN, nwg, G, c;
    __host__ __device__ void init(int M, int N, int G_, int c_) { nM = M / BM; nN = N / BM; nwg = nM * nN; G = G_; c = c_; }
    __host__ __device__ bool next(int i, Unit& u) const {
        const long L = (long)i * G + c; if (L >= nwg) return false;
        int wgid = (int)L; { const int q = nwg / NXCD, r = nwg % NXCD, xcd = wgid % NXCD, off = wgid / NXCD; wgid = (xcd < r ? xcd * (q + 1) : r * (q + 1) + (xcd - r) * q) + off; }
        const int nig = WGM * nN, gid = wgid / nig, fm = gid * WGM, gsz = (nM - fm) < WGM ? (nM - fm) : WGM;
        u.pm = fm + ((wgid % nig) % gsz); u.pn = (wgid % nig) / gsz; return true;
    }
    __device__ __forceinline__ void a_ready(const Unit&) const {}
    __device__ __forceinline__ void done(const Unit&) const {}
};

__device__ __forceinline__ unsigned cvt_pk_bf16(float lo, float hi) { unsigned r; asm volatile("v_cvt_pk_bf16_f32 %0, %1, %2" : "=v"(r) : "v"(lo), "v"(hi)); return r; }
typedef float f32x2 __attribute__((ext_vector_type(2)));
__device__ __forceinline__ f32x2 gelu_pk(f32x2 v) {
    const f32x2 av = __builtin_elementwise_abs(v), d = av * 0.2316418882f + 1.0f;
    f32x2 t; t.x = __builtin_amdgcn_rcpf(d.x); t.y = __builtin_amdgcn_rcpf(d.y);
    f32x2 q = t * 0.5307027145f + (-0.7265760135f); q = q * t + 0.7107068705f; q = q * t + (-0.142248368f); q = q * t + 0.127414796f; q = q * t;
    const f32x2 s = (v * v) * (-0.72134752044f);
    f32x2 e; e.x = __builtin_amdgcn_exp2f(s.x); e.y = __builtin_amdgcn_exp2f(s.y);
    const f32x2 m = v * (q * e), r = v - m;
    f32x2 o; o.x = v.x < 0.f ? m.x : r.x; o.y = v.y < 0.f ? m.y : r.y; return o;
}

template <int ACT  > struct EpiBf16 {
    static constexpr bool PERM = true, AFTER_DRAIN = false; static_assert(ACT == 0 || ACT == 1, "EpiBf16: ACT is 0 (none) or 1 (gelu_pk)");
    bf16_t* O; int ldc; const float* bias; int split_cols; size_t split_stride; float scale0;
    __device__ __forceinline__ void operator()(const f32x4 (&acc)[2][2][4][2], const Unit& u, int wr, int wc, int fr, int fq) const {
        const int row0 = u.pm * BM + wr * 64 + fr; int colt = u.pn * BM; bf16_t* base = O;
        float sc = 1.f; if (split_cols) { const int t = colt / split_cols; base += (size_t)t * split_stride; colt -= t * split_cols; if (t == 0) sc = scale0; }
        const int col0 = colt + wc * 32 + 8 * fq, bcol0 = u.pn * BM + wc * 32 + 8 * fq;
        f32x4 bv[2][2];
#pragma unroll
        for (int bj = 0; bj < 2; ++bj)
#pragma unroll
            for (int n = 0; n < 2; ++n) bv[bj][n] = bias ? *(const f32x4*)(bias + bcol0 + bj * HALF + 4 * n) : (f32x4){0.f, 0.f, 0.f, 0.f};
#pragma unroll
        for (int ai = 0; ai < 2; ++ai)
#pragma unroll
            for (int m = 0; m < 4; ++m) { bf16_t* rowp = base + (size_t)(row0 + ai * HALF + m * 16) * ldc + col0;
#pragma unroll
                for (int bj = 0; bj < 2; ++bj) { f32x4 v0 = acc[ai][bj][m][0] + bv[bj][0], v1 = acc[ai][bj][m][1] + bv[bj][1];
                    if (ACT == 1) { f32x2 a = gelu_pk((f32x2){v0[0], v0[1]}), b = gelu_pk((f32x2){v0[2], v0[3]}), c = gelu_pk((f32x2){v1[0], v1[1]}), d = gelu_pk((f32x2){v1[2], v1[3]});
                        v0 = (f32x4){a.x, a.y, b.x, b.y}; v1 = (f32x4){c.x, c.y, d.x, d.y}; }
                    v0 = v0 * sc; v1 = v1 * sc; u32x4 w; w.x = cvt_pk_bf16(v0[0], v0[1]); w.y = cvt_pk_bf16(v0[2], v0[3]); w.z = cvt_pk_bf16(v1[0], v1[1]); w.w = cvt_pk_bf16(v1[2], v1[3]);
                    *(u32x4*)(rowp + bj * HALF) = w; } }
    }
};

template <class Epi, class Sched, bool ALIGN_EPI = false, bool SP2 = false, bool F8 = false, bool GATH = false  >
__device__ __forceinline__ void gemm_phase(PG8_LAS unsigned char* lds, const Gemm g, const Sched& S, const Epi& E, int tid_in) {
    int tid_l = tid_in; asm volatile("" : "+v"(tid_l));
    const int tid = tid_l, wid = __builtin_amdgcn_readfirstlane(tid >> 6), lane = tid & 63, wr = wid >> 2, wc = wid & 3, fr = lane & 15, fq = lane >> 4;
    const int K = g.K, nt = K / BK;
    unsigned voffA[2], voffB[2]; int rowA[2]; unsigned colA[2];
#pragma unroll
    for (int i = 0; i < 2; ++i) { int R, C; stage_rc(tid * 16 + i * 8192, R, C); const int Rb = Epi::PERM ? ((R & ~31) + perm32(R & 31)) : R;
        voffA[i] = (unsigned)(R * K + C) * 2u; voffB[i] = (unsigned)(Rb * K + C) * 2u; rowA[i] = R; colA[i] = (unsigned)C * 2u; }
    static_assert(!GATH || SP2, "GATH: SP2 schedule only");
    unsigned cgo[2][2], ngo[2][2];
#define PG8_GOFF(dst, uidx) do { _Pragma("unroll") for (int _h = 0; _h < 2; ++_h) _Pragma("unroll") for (int _i = 0; _i < 2; ++_i) dst[_h][_i] = S.gsrc((uidx), _h * HALF + rowA[_i]) + colA[_i]; } while (0)
#define PG8_STAGE_G(bufoff, kb, o0, o1) do { \
        __builtin_amdgcn_global_load_lds((const unsigned*)((const char*)g.A + (kb) + (o0)), (PG8_LAS unsigned*)(lds + (bufoff) + ldsw), 16, 0, 0); \
        __builtin_amdgcn_global_load_lds((const unsigned*)((const char*)g.A + (kb) + (o1)), (PG8_LAS unsigned*)(lds + (bufoff) + ldsw + 8192), 16, 0, 0); } while (0)
    const size_t kstep = (size_t)(BK * 2);
    const size_t hstep = (size_t)HALF * K * 2;
    const size_t tstep = 2 * hstep;
    const unsigned ldsw = (unsigned)wid * 1024u;
    const int aoff = lds_byte(wr * 64 + fr, fq * 8), boff = lds_byte(wc * 32 + fr, fq * 8);
#define PG8_SA(b, h) (((b) * 2 + (h)) * HTB)
#define PG8_SB(b, h) ((4 + (b) * 2 + (h)) * HTB)
#define PG8_STAGE(bufoff, gbase, voff) do { _Pragma("unroll") for (int _i = 0; _i < 2; ++_i) \
        __builtin_amdgcn_global_load_lds((const unsigned*)((const char*)(gbase) + (voff)[_i]), (PG8_LAS unsigned*)(lds + (bufoff) + ldsw + _i * 8192), 16, 0, 0); } while (0)
#define PG8_LDA(dst, b, h) do { _Pragma("unroll") for (int m = 0; m < 4; ++m) _Pragma("unroll") for (int k = 0; k < 2; ++k) dst[m][k] = *(const PG8_LAS bf16x8*)(lds + PG8_SA(b, h) + aoff + m * 2048 + k * 1024); } while (0)
#define PG8_LDB(dst, b, h) do { _Pragma("unroll") for (int n = 0; n < 2; ++n) _Pragma("unroll") for (int k = 0; k < 2; ++k) dst[n][k] = *(const PG8_LAS bf16x8*)(lds + PG8_SB(b, h) + boff + n * 2048 + k * 1024); } while (0)
#define PG8_MMA(ai, bj, At, Bt) do { __builtin_amdgcn_s_setprio(1); if constexpr (!F8) { _Pragma("unroll") for (int m = 0; m < 4; ++m) _Pragma("unroll") for (int n = 0; n < 2; ++n) _Pragma("unroll") for (int k = 0; k < 2; ++k) \
        acc[ai][bj][m][n] = __builtin_amdgcn_mfma_f32_16x16x32_bf16(Bt[n][k], At[m][k], acc[ai][bj][m][n], 0, 0, 0); } else { _Pragma("unroll") for (int m = 0; m < 4; ++m) _Pragma("unroll") for (int n = 0; n < 2; ++n) \
        acc[ai][bj][m][n] = __builtin_amdgcn_mfma_scale_f32_16x16x128_f8f6f4(pg8_cat8(Bt[n][0], Bt[n][1]), pg8_cat8(At[m][0], At[m][1]), acc[ai][bj][m][n], 0, 0, 0, 0x7F7F7F7F, 0, 0x7F7F7F7F); \
        _Pragma("unroll") for (int m = 0; m < 4; ++m) _Pragma("unroll") for (int n = 0; n < 2; ++n) asm volatile("" : "+v"(acc[ai][bj][m][n]));   } __builtin_amdgcn_s_setprio(0); } while (0)
#define PG8_WAIT_V(n) asm volatile("s_waitcnt vmcnt(" #n ")" ::: "memory")
#define PG8_WAIT_L(n) asm volatile("s_waitcnt lgkmcnt(" #n ")" ::: "memory")
#define PG8_BAR __builtin_amdgcn_s_barrier()
#define PG8_SCHED __builtin_amdgcn_sched_barrier(0)
    Unit cur, nxt; int ui = 0;
    if (!S.next(0, cur)) return;
    f32x4 acc[2][2][4][2];
#pragma unroll
    for (int a = 0; a < 2; ++a)
#pragma unroll
        for (int b = 0; b < 2; ++b)
#pragma unroll
            for (int m = 0; m < 4; ++m)
#pragma unroll
                for (int n = 0; n < 2; ++n) acc[a][b][m][n] = (f32x4){0.f, 0.f, 0.f, 0.f};
    bf16x8 At[4][2], B0[2][2], B1[2][2];
    const char* cA = (const char*)g.A + (size_t)cur.pm * tstep; const char* cB = (const char*)g.Bt + (size_t)cur.pn * tstep;
    S.a_ready(cur);
    if constexpr (SP2) {
        if constexpr (GATH) { PG8_GOFF(cgo, 0); }
        PG8_STAGE(PG8_SB(0, 0), cB, voffB); PG8_STAGE(PG8_SB(0, 1), cB + hstep, voffB);
        if constexpr (GATH) { PG8_STAGE_G(PG8_SA(0, 0), 0, cgo[0][0], cgo[0][1]); PG8_STAGE_G(PG8_SA(0, 1), 0, cgo[1][0], cgo[1][1]); }
        else { PG8_STAGE(PG8_SA(0, 0), cA, voffA); PG8_STAGE(PG8_SA(0, 1), cA + hstep, voffA); }
        if (wr == 1) PG8_BAR;
        PG8_WAIT_V(2); PG8_BAR;
        PG8_STAGE(PG8_SB(1, 0), cB + kstep, voffB);
        if constexpr (GATH) { PG8_STAGE_G(PG8_SA(1, 0), kstep, cgo[0][0], cgo[0][1]); } else { PG8_STAGE(PG8_SA(1, 0), cA + kstep, voffA); }
        PG8_STAGE(PG8_SB(1, 1), cB + hstep + kstep, voffB);
        PG8_WAIT_V(6); PG8_BAR;
    } else {
        PG8_STAGE(PG8_SB(0, 0), cB, voffB); PG8_STAGE(PG8_SA(0, 0), cA, voffA); PG8_STAGE(PG8_SB(0, 1), cB + hstep, voffB); PG8_STAGE(PG8_SA(0, 1), cA + hstep, voffA);
        if (wr == 1) PG8_BAR;
        PG8_WAIT_V(4); PG8_BAR;
        PG8_STAGE(PG8_SB(1, 0), cB + kstep, voffB); PG8_STAGE(PG8_SA(1, 0), cA + kstep, voffA); PG8_STAGE(PG8_SB(1, 1), cB + hstep + kstep, voffB);
        PG8_WAIT_V(6); PG8_BAR;
    }
    for (;;) {
        const bool has_next = S.next(ui + 1, nxt);
        if constexpr (GATH) { if (has_next) { PG8_GOFF(ngo, ui + 1); } else {
            _Pragma("unroll") for (int _h = 0; _h < 2; ++_h) _Pragma("unroll") for (int _i = 0; _i < 2; ++_i) ngo[_h][_i] = cgo[_h][_i]; } }
        const char* nA = has_next ? (const char*)g.A + (size_t)nxt.pm * tstep : cA; const char* nB = has_next ? (const char*)g.Bt + (size_t)nxt.pn * tstep : cB;
        for (int t = 0; t < nt; t += 2) {
            const bool last = (t == nt - 2);
            const char* a1 = cA + (size_t)(t + 1) * kstep;
            const char* a2 = last ? nA : cA + (size_t)(t + 2) * kstep; const char* b2 = last ? nB : cB + (size_t)(t + 2) * kstep;
            const char* a3 = a2 + kstep; const char* b3 = b2 + kstep;
            if (last && has_next) S.a_ready(nxt);
            unsigned g0a = 0, g0b = 0, g1a = 0, g1b = 0; size_t kb2 = 0;
            if constexpr (GATH) { g0a = last ? ngo[0][0] : cgo[0][0]; g0b = last ? ngo[0][1] : cgo[0][1]; g1a = last ? ngo[1][0] : cgo[1][0]; g1b = last ? ngo[1][1] : cgo[1][1]; kb2 = last ? (size_t)0 : (size_t)(t + 2) * kstep; }
            if constexpr (SP2) {
            PG8_LDB(B0, 0, 0); PG8_LDB(B1, 0, 1); PG8_SCHED; PG8_LDA(At, 0, 0);
            if constexpr (GATH) { PG8_STAGE_G(PG8_SA(1, 1), (size_t)(t + 1) * kstep, cgo[1][0], cgo[1][1]); } else { PG8_STAGE(PG8_SA(1, 1), a1 + hstep, voffA); }
            PG8_WAIT_V(8); PG8_WAIT_L(0); PG8_BAR; PG8_MMA(0, 0, At, B0); PG8_MMA(0, 1, At, B1); PG8_BAR; PG8_SCHED;
            PG8_LDA(At, 0, 1); PG8_STAGE(PG8_SB(0, 0), b2, voffB); PG8_STAGE(PG8_SB(0, 1), b2 + hstep, voffB);
            if constexpr (GATH) { PG8_STAGE_G(PG8_SA(0, 0), kb2, g0a, g0b); } else { PG8_STAGE(PG8_SA(0, 0), a2, voffA); }
            PG8_WAIT_V(8); PG8_WAIT_L(0); PG8_BAR; PG8_MMA(1, 0, At, B0); PG8_MMA(1, 1, At, B1); PG8_BAR; PG8_SCHED;
            PG8_LDB(B0, 1, 0); PG8_LDB(B1, 1, 1); PG8_SCHED; PG8_LDA(At, 1, 0);
            if constexpr (GATH) { PG8_STAGE_G(PG8_SA(0, 1), kb2, g1a, g1b); } else { PG8_STAGE(PG8_SA(0, 1), a2 + hstep, voffA); }
            PG8_WAIT_V(8); PG8_WAIT_L(0); PG8_BAR; PG8_MMA(0, 0, At, B0); PG8_MMA(0, 1, At, B1); PG8_BAR; PG8_SCHED;
            PG8_LDA(At, 1, 1); PG8_STAGE(PG8_SB(1, 0), b3, voffB); PG8_STAGE(PG8_SB(1, 1), b3 + hstep, voffB);
            if constexpr (GATH) { PG8_STAGE_G(PG8_SA(1, 0), kb2 + kstep, g0a, g0b); } else { PG8_STAGE(PG8_SA(1, 0), a3, voffA); }
            PG8_WAIT_V(8); PG8_WAIT_L(0); PG8_BAR; PG8_MMA(1, 0, At, B0); PG8_MMA(1, 1, At, B1); PG8_BAR; PG8_SCHED;
            } else {
            PG8_LDB(B0, 0, 0); PG8_SCHED; PG8_LDA(At, 0, 0); PG8_STAGE(PG8_SA(1, 1), a1 + hstep, voffA);
            PG8_WAIT_L(8); PG8_BAR; PG8_WAIT_L(0); PG8_MMA(0, 0, At, B0); PG8_BAR; PG8_SCHED;
            PG8_LDB(B1, 0, 1); PG8_STAGE(PG8_SB(0, 0), b2, voffB);
            PG8_BAR; PG8_WAIT_L(0); PG8_MMA(0, 1, At, B1); PG8_BAR;
            PG8_LDA(At, 0, 1); PG8_STAGE(PG8_SA(0, 0), a2, voffA);
            PG8_BAR; PG8_WAIT_L(0); PG8_MMA(1, 0, At, B0); PG8_BAR; PG8_SCHED;
            PG8_STAGE(PG8_SB(0, 1), b2 + hstep, voffB);
            PG8_WAIT_V(6); PG8_BAR; PG8_MMA(1, 1, At, B1); PG8_BAR;
            PG8_LDB(B0, 1, 0); PG8_SCHED; PG8_LDA(At, 1, 0); PG8_STAGE(PG8_SA(0, 1), a2 + hstep, voffA);
            PG8_WAIT_L(8); PG8_BAR; PG8_WAIT_L(0); PG8_MMA(0, 0, At, B0); PG8_BAR; PG8_SCHED;
            PG8_LDB(B1, 1, 1); PG8_STAGE(PG8_SB(1, 0), b3, voffB);
            PG8_BAR; PG8_WAIT_L(0); PG8_MMA(0, 1, At, B1); PG8_BAR;
            PG8_LDA(At, 1, 1); PG8_STAGE(PG8_SA(1, 0), a3, voffA);
            PG8_BAR; PG8_WAIT_L(0); PG8_MMA(1, 0, At, B0); PG8_BAR; PG8_SCHED;
            PG8_STAGE(PG8_SB(1, 1), b3 + hstep, voffB);
            PG8_WAIT_V(6); PG8_BAR; PG8_MMA(1, 1, At, B1); PG8_BAR;
            }
        }
        if constexpr (ALIGN_EPI) { if (wr == 0) PG8_BAR; }
        if constexpr (!Epi::AFTER_DRAIN) { E(acc, cur, wr, wc, fr, fq); S.done(cur); }
        if (!has_next) break;
#pragma unroll
        for (int a = 0; a < 2; ++a)
#pragma unroll
            for (int b = 0; b < 2; ++b)
#pragma unroll
                for (int m = 0; m < 4; ++m)
#pragma unroll
                    for (int n = 0; n < 2; ++n) acc[a][b][m][n] = (f32x4){0.f, 0.f, 0.f, 0.f};
        cur = nxt; cA = nA; cB = nB; ++ui;
        if constexpr (GATH) { _Pragma("unroll") for (int _h = 0; _h < 2; ++_h) _Pragma("unroll") for (int _i = 0; _i < 2; ++_i) cgo[_h][_i] = ngo[_h][_i]; }
        if constexpr (ALIGN_EPI) { if (wr == 1) PG8_BAR; }
    }
    PG8_WAIT_V(0);
    if constexpr (!ALIGN_EPI) { if (wr == 0) PG8_BAR; }
    PG8_BAR;
    if constexpr (Epi::AFTER_DRAIN) { E.fused(acc, cur, wr, wc, fr, fq, lds, wid, lane); S.done(cur); }
#undef PG8_SA
#undef PG8_SB
#undef PG8_STAGE
#undef PG8_STAGE_G
#undef PG8_GOFF
#undef PG8_LDA
#undef PG8_LDB
#undef PG8_MMA
#undef PG8_WAIT_V
#undef PG8_WAIT_L
#undef PG8_BAR
#undef PG8_SCHED
}
}

#ifndef PG8_SP2
#define PG8_SP2 true
#endif
#ifndef PG8_ALIGN
#define PG8_ALIGN true
#endif
#define XB_TMO      128
#define XB_XCNT(j)  (256  + 64 * (j))
#define XB_XSUB(j)  (1280 + 64 * (j))
#define XB_XGEN(j)  (2304 + 64 * (j))
#define XB_TOP      3328
#define XB_TOPGEN   3392
#define XCD_BAR_WORDS 3456
#define XB_SPIN_CAP (1u << 18)

__device__ __forceinline__ unsigned xb_ld(unsigned* p)              { return __hip_atomic_load(p, __ATOMIC_RELAXED, __HIP_MEMORY_SCOPE_AGENT); }
__device__ __forceinline__ unsigned xb_add(unsigned* p, unsigned v) { return __hip_atomic_fetch_add(p, v, __ATOMIC_RELAXED, __HIP_MEMORY_SCOPE_AGENT); }
__device__ __forceinline__ unsigned xb_xcc_id() { return (unsigned)__builtin_amdgcn_s_getreg((3 << 11) | 20) & 0xFu; }
#define XB_SPIN(cond, bar) do { unsigned _sp = 0; while (cond) { __builtin_amdgcn_s_sleep(1); \
    if ((++_sp & 255u) == 0u) { if (xb_ld(&(bar)[XB_TMO])) break; if (_sp > XB_SPIN_CAP) { atomicAdd(&(bar)[XB_TMO], 1u); break; } } } } while (0)

struct XcdBarrier {
    unsigned* bar; unsigned x;
    volatile LAS unsigned* st;
};

__device__ __forceinline__ XcdBarrier xcd_barrier_post(unsigned* bar, volatile LAS unsigned* st) {
    XcdBarrier b; b.bar = bar; b.x = xb_xcc_id(); b.st = st;
    if (threadIdx.x == 0) (void)xb_add(&bar[XB_XCNT(b.x)], 1u);
    return b;
}
__device__ __forceinline__ void xcd_barrier_complete(unsigned* bar, unsigned x, unsigned& nloc, unsigned& nx) {
    const unsigned G = gridDim.x * gridDim.y * gridDim.z;
    unsigned sum, cnt, mine, sp = 0u;
    for (;;) {
        sum = 0u; cnt = 0u; mine = 0u;
#pragma unroll
        for (unsigned j = 0; j < 16; ++j) { const unsigned c = xb_ld(&bar[XB_XCNT(j)]); sum += c; cnt += (c > 0u) ? 1u : 0u; mine = (j == x) ? c : mine; }
        if (sum == G) break;
        __builtin_amdgcn_s_sleep(1);
        if ((++sp & 255u) == 0u) { if (xb_ld(&bar[XB_TMO])) break; if (sp > XB_SPIN_CAP) { atomicAdd(&bar[XB_TMO], 1u); break; } }
    }
    nloc = mine > 0u ? mine : 1u; nx = cnt > 0u ? cnt : 1u;
}

__device__ __forceinline__ void xcd_barrier(const XcdBarrier& b, const bool is_t0  ) {
    asm volatile("s_waitcnt vmcnt(0)" ::: "memory");
    __syncthreads();
    if (is_t0) {
        unsigned* bar = b.bar;
        __builtin_amdgcn_s_waitcnt(0);
        unsigned nloc = b.st[0], nx = b.st[1];
        if (nloc == 0u) { xcd_barrier_complete(bar, b.x, nloc, nx); b.st[0] = nloc; b.st[1] = nx; }
        const unsigned old = xb_add(&bar[XB_XSUB(b.x)], 1u);
        const unsigned gen = old / nloc;
        if (old + 1u == (gen + 1u) * nloc) {
            __builtin_amdgcn_fence(__ATOMIC_RELEASE, "agent");
            asm volatile("s_waitcnt vmcnt(0)" ::: "memory");
            const unsigned og = xb_add(&bar[XB_TOP], 1u);
            const unsigned tg = og / nx;
            if (og + 1u == (tg + 1u) * nx) xb_add(&bar[XB_TOPGEN], 1u);
            else XB_SPIN(xb_ld(&bar[XB_TOPGEN]) == tg, bar);
            __builtin_amdgcn_fence(__ATOMIC_ACQUIRE, "agent");
            xb_add(&bar[XB_XGEN(b.x)], 1u);
            asm volatile("s_waitcnt vmcnt(0)" ::: "memory");
        } else {
            XB_SPIN(xb_ld(&bar[XB_XGEN(b.x)]) == gen, bar);
            __builtin_amdgcn_fence(__ATOMIC_ACQUIRE, "agent");
            asm volatile("s_waitcnt vmcnt(0)" ::: "memory");
        }
    }
    __syncthreads();
}
struct EpiResBf16 {
    static constexpr bool PERM = true, AFTER_DRAIN = false;
    const bf16* xin; bf16* yp; float alpha, rs;
    DI void operator()(const pg8::f32x4 (&acc)[2][2][4][2], const pg8::Unit& u, int wr, int wc, int fr, int fq) const {
        const int row0 = u.pm * 256 + wr * 64 + fr, col0 = u.pn * 256 + wc * 32 + 8 * fq;
#pragma unroll
        for (int ai = 0; ai < 2; ++ai)
#pragma unroll
            for (int m = 0; m < 4; ++m) {
                const size_t ro = (size_t)(row0 + ai * 128 + m * 16) * DM;
#pragma unroll
                for (int bj = 0; bj < 2; ++bj) {
                    const size_t o = ro + col0 + bj * 128;
                    const v4u xv = *(const v4u*)(xin + o);
                    const f32x4 a0 = acc[ai][bj][m][0] * rs, a1 = acc[ai][bj][m][1] * rs;
                    v4u w;
                    w.x = cvtpk(bf2f(xv.x & 0xffffu) * alpha + a0[0], bf2f(xv.x >> 16) * alpha + a0[1]); w.y = cvtpk(bf2f(xv.y & 0xffffu) * alpha + a0[2], bf2f(xv.y >> 16) * alpha + a0[3]);
                    w.z = cvtpk(bf2f(xv.z & 0xffffu) * alpha + a1[0], bf2f(xv.z >> 16) * alpha + a1[1]); w.w = cvtpk(bf2f(xv.w & 0xffffu) * alpha + a1[2], bf2f(xv.w >> 16) * alpha + a1[3]);
                    *(v4u*)(yp + o) = w;
                }
            }
    }
};
struct EpiSwiglu {
    static constexpr bool PERM = true, AFTER_DRAIN = false;
    unsigned char* act; const float* bgu;
    DI void operator()(const pg8::f32x4 (&acc)[2][2][4][2], const pg8::Unit& u, int wr, int wc, int fr, int fq) const {
        const int e = u.pn >> 3, pl = u.pn & 7;
        const int row0 = u.pm * 256 + wr * 64 + fr, cih = pl * 128 + wc * 32 + 8 * fq;
        const float* bg = bgu + e * 2048 + cih;
        const f32x4 bg0 = *(const f32x4*)(bg), bg1 = *(const f32x4*)(bg + 4), bu0 = *(const f32x4*)(bg + 1024), bu1 = *(const f32x4*)(bg + 1028);
#pragma unroll
        for (int ai = 0; ai < 2; ++ai)
#pragma unroll
            for (int m = 0; m < 4; ++m) {
                constexpr float RS = 1.f / (F8_SX * F8_SWG);
                const f32x4 g0 = acc[ai][0][m][0] * RS + bg0, g1 = acc[ai][0][m][1] * RS + bg1, u0 = acc[ai][1][m][0] * RS + bu0, u1 = acc[ai][1][m][1] * RS + bu1;
                float r[8];
#pragma unroll
                for (int i = 0; i < 8; ++i) {
                    float g = i < 4 ? g0[i & 3] : g1[i & 3], uu = i < 4 ? u0[i & 3] : u1[i & 3];
                    g = fminf(g, 7.0f); uu = fminf(fmaxf(uu, -7.0f), 7.0f);
                    const float sg = __builtin_amdgcn_rcpf(1.0f + ex2(-1.702f * LOG2E * g));
                    r[i] = (uu + 1.0f) * g * sg * F8_SA;
                }
                v2u w; w.x = pk4_fp8(r[0], r[1], r[2], r[3]); w.y = pk4_fp8(r[4], r[5], r[6], r[7]);
                *(v2u*)(act + (size_t)(row0 + ai * 128 + m * 16) * DM + cih) = w;
            }
    }
};
struct EpiDown {
    static constexpr bool PERM = true, AFTER_DRAIN = false;
    unsigned char* yr; const float* bdn;
    DI void operator()(const pg8::f32x4 (&acc)[2][2][4][2], const pg8::Unit& u, int wr, int wc, int fr, int fq) const {
        const int e = u.pn >> 2, pl = u.pn & 3;
        const int row0 = u.pm * 256 + wr * 64 + fr, col0 = pl * 256 + wc * 32 + 8 * fq;
        f32x4 bv[2][2];
#pragma unroll
        for (int bj = 0; bj < 2; ++bj) { bv[bj][0] = *(const f32x4*)(bdn + e * 1024 + col0 + bj * 128) * F8_SY; bv[bj][1] = *(const f32x4*)(bdn + e * 1024 + col0 + bj * 128 + 4) * F8_SY; }
#pragma unroll
        for (int ai = 0; ai < 2; ++ai)
#pragma unroll
            for (int m = 0; m < 4; ++m) {
                unsigned char* rp = yr + (size_t)(row0 + ai * 128 + m * 16) * DM + col0;
#pragma unroll
                for (int bj = 0; bj < 2; ++bj) {
                    constexpr float RS = F8_SY / (F8_SA * F8_SWD);
                    const f32x4 v0 = acc[ai][bj][m][0] * RS + bv[bj][0], v1 = acc[ai][bj][m][1] * RS + bv[bj][1];
                    v2u w; w.x = pk4_fp8(v0[0], v0[1], v0[2], v0[3]); w.y = pk4_fp8(v1[0], v1[1], v1[2], v1[3]);
                    *(v2u*)(rp + bj * 128) = w;
                }
            }
    }
};
struct GroupOrder {
    LAS const unsigned* tile_e; int ntiles, lg, G, c; LAS const unsigned short* srcl;
    DI bool next(int i, pg8::Unit& u) const {
        int pm, pl;
        if (G == 256) {
            const int x = c & 7, k = c >> 3; pm = i * (256 >> lg) + x * (32 >> lg) + (k >> lg); pl = k & ((1 << lg) - 1); if (pm >= ntiles) return false; }
        else { const long L = (long)i * G + c; if (L >= ((long)ntiles << lg)) return false; pm = (int)(L >> lg); pl = (int)(L & ((1 << lg) - 1)); }
        const int e = __builtin_amdgcn_readfirstlane((int)tile_e[pm]);
        u.pm = pm; u.pn = (e << lg) + pl; return true;
    }
    DI void a_ready(const pg8::Unit&) const {}
    DI void done(const pg8::Unit&) const {}
    DI unsigned gsrc(int ui, int r) const { return (unsigned)srcl[ui * 256 + r] << 10; }
};
struct Args { const float* in[18]; float* out; unsigned char* ws; int ph_lo, ph_hi; };
struct Fr { LAS unsigned char* lds; unsigned char* ws; unsigned* ctl; int tid, lane, wave, blk, G; };

DI void tr_item(const float* W, int ldw, int K, int k0, int sc0, int nvalid, bf16* WT, int drow0, LAS float* scr, int lane) {
    const int c = lane & 31;
    float v[32];
#pragma unroll
    for (int i = 0; i < 32; ++i) v[i] = (c < nvalid) ? W[(size_t)(k0 + 2 * i + (lane >> 5)) * ldw + sc0 + c] : 0.f;
#pragma unroll
    for (int i = 0; i < 32; ++i) scr[(2 * i + (lane >> 5)) * 33 + c] = v[i];
    LDS_WAIT(); asm volatile("" ::: "memory");
    const int c8 = lane & 7;
#pragma unroll
    for (int j = 0; j < 4; ++j) { const int n = (lane >> 3) + 8 * j; const LAS float* s = scr + (8 * c8) * 33 + n;
        v4u o; o.x = cvtpk(s[0 * 33], s[1 * 33]); o.y = cvtpk(s[2 * 33], s[3 * 33]); o.z = cvtpk(s[4 * 33], s[5 * 33]); o.w = cvtpk(s[6 * 33], s[7 * 33]);
        *(v4u*)(WT + (size_t)(drow0 + n) * K + k0 + 8 * c8) = o; }
    LDS_WAIT(); asm volatile("" ::: "memory");
}
DI void tr_item8(const float* W, int ldw, int K, int k0, int sc0, float scale, unsigned char* WT8, int drow0, LAS float* scr, int lane) {
    const int c = lane & 31;
    float v[32];
#pragma unroll
    for (int i = 0; i < 32; ++i) v[i] = W[(size_t)(k0 + 2 * i + (lane >> 5)) * ldw + sc0 + c];
#pragma unroll
    for (int i = 0; i < 32; ++i) scr[(2 * i + (lane >> 5)) * 33 + c] = v[i] * scale;
    LDS_WAIT(); asm volatile("" ::: "memory");
    const int c16 = lane & 3;
#pragma unroll
    for (int j = 0; j < 2; ++j) { const int n = (lane >> 2) + 16 * j; const LAS float* s = scr + (16 * c16) * 33 + n;
        v4u o; o.x = pk4_fp8(s[0 * 33], s[1 * 33], s[2 * 33], s[3 * 33]); o.y = pk4_fp8(s[4 * 33], s[5 * 33], s[6 * 33], s[7 * 33]);
        o.z = pk4_fp8(s[8 * 33], s[9 * 33], s[10 * 33], s[11 * 33]); o.w = pk4_fp8(s[12 * 33], s[13 * 33], s[14 * 33], s[15 * 33]);
        *(v4u*)(WT8 + (size_t)(drow0 + n) * K + k0 + 16 * c16) = o; }
    LDS_WAIT(); asm volatile("" ::: "memory");
}
DI void ph_prologue(const Args& a, const Fr& F) {
    LAS float* scr = (LAS float*)(F.lds + F.wave * 16384);
    const int gw = F.blk * NWAVES + F.wave, NGW = F.G * NWAVES;
    constexpr int I_EV = 2 * 16 * 80, I_OD = 2 * 16 * 96, I_WO = 4 * 16 * 32;
    constexpr int NITEMS = I_EV + I_OD + I_WO;
    bf16* wev = (bf16*)(F.ws + WS_WEV); bf16* wod = (bf16*)(F.ws + WS_WOD); bf16* wout = (bf16*)(F.ws + WS_WOUT);
    unsigned char* wgu = F.ws + WS_WGU; unsigned char* wdn = F.ws + WS_WDN;
    for (int it = gw; it < NITEMS; it += NGW) {
        int r = it;
        if (r < I_EV) { const int l = r / 1280; r %= 1280; const int kb = r / 80, n0 = (r % 80) * 32; int sc0, nv = 32;
            if (n0 < 512) sc0 = n0; else if (n0 < 1024) sc0 = 964 + (n0 - 512); else if (n0 < 1536) sc0 = 1476 + (n0 - 1024); else if (n0 < 2048) sc0 = 1988 + (n0 - 1536);
            else if (n0 < 2176) sc0 = 512 + (n0 - 2048); else if (n0 < 2432) sc0 = 640 + (n0 - 2176); else if (n0 < 2496) sc0 = 896 + (n0 - 2432);
            else if (n0 < 2528) { sc0 = 960; nv = 4; } else { sc0 = 0; nv = 0; }
            tr_item(a.in[1] + (size_t)l * 1024 * 2500, 2500, 1024, kb * 64, sc0, nv, wev + (size_t)l * EV_N * 1024, n0, scr, F.lane); continue; }
        r -= I_EV;
        if (r < I_OD) { const int l = r / 1536; r %= 1536; const int kb = r / 96, n0 = (r % 96) * 32;
            tr_item(a.in[6] + (size_t)l * 1024 * 3088, 3088, 1024, kb * 64, n0, 32, wod + (size_t)l * OD_N * 1024, n0, scr, F.lane); continue; }
        r -= I_OD;
        if (r < I_WO) { const int l = r / 512; r %= 512; const int kb = r / 32, n0 = (r % 32) * 32;
            const float* src = (l & 1) ? a.in[8] + (size_t)(l >> 1) * 1024 * 1024 : a.in[5] + (size_t)(l >> 1) * 1024 * 1024;
            tr_item8(src, 1024, 1024, kb * 64, n0, F8_SWO, (unsigned char*)wout + (size_t)l * 1024 * 1024, n0, scr, F.lane); continue; }
    }
    { __syncthreads();
        LAS float* tile = (LAS float*)F.lds; unsigned char* wgu8 = F.ws + WS_WGU; unsigned char* wdn8 = F.ws + WS_WDN;
        constexpr int T_GU = 128 * 8 * 16, T_DN = 128 * 8 * 8, T_ALL = T_GU + T_DN;
        const int tid = F.tid, c4 = tid & 31, r0 = tid >> 5;
        f32x4 v[8];
        auto locate = [&](int t, const float*& src, int& ldw, unsigned char*& dst, float& scale) {
            if (t < T_GU) { const int le = t >> 7, r = t & 127, kb = r >> 4, nb = r & 15, n0 = nb * 128; const int pn = n0 >> 8, bj = (n0 >> 7) & 1;
                src = a.in[14] + (size_t)le * 1024 * 2048 + (size_t)(kb * 128) * 2048 + bj * 1024 + pn * 128; ldw = 2048; dst = wgu8 + (size_t)le * 2048 * 1024 + (size_t)n0 * 1024 + kb * 128; scale = F8_SWG; }
            else { const int u = t - T_GU, le = u >> 6, r = u & 63, kb = r >> 3, nb = r & 7;
                src = a.in[16] + (size_t)le * 1024 * 1024 + (size_t)(kb * 128) * 1024 + nb * 128; ldw = 1024; dst = wdn8 + (size_t)le * 1024 * 1024 + (size_t)(nb * 128) * 1024 + kb * 128; scale = F8_SWD; } };
        int t = F.blk;
        if (t < T_ALL) { const float* src; int ldw; unsigned char* dst; float sc; locate(t, src, ldw, dst, sc);
#pragma unroll
            for (int i = 0; i < 8; ++i) v[i] = *(const f32x4*)(src + (size_t)(r0 + 16 * i) * ldw + 4 * c4); }
        for (; t < T_ALL; t += F.G) {
            const float* src; int ldw; unsigned char* dst; float sc; locate(t, src, ldw, dst, sc);
#pragma unroll
            for (int i = 0; i < 8; ++i) { LAS float* tp = tile + (r0 + 16 * i) * 129 + 4 * c4; tp[0] = v[i][0] * sc; tp[1] = v[i][1] * sc; tp[2] = v[i][2] * sc; tp[3] = v[i][3] * sc; }
            __syncthreads();
            if (t + F.G < T_ALL) { const float* s2; int l2; unsigned char* d2; float c2; locate(t + F.G, s2, l2, d2, c2);
#pragma unroll
                for (int i = 0; i < 8; ++i) v[i] = *(const f32x4*)(s2 + (size_t)(r0 + 16 * i) * l2 + 4 * c4); }
#pragma unroll
            for (int j = 0; j < 2; ++j) { const int p = tid + 512 * j, kc = p & 7, n = p >> 3; const LAS float* sp = tile + (kc * 16) * 129 + n;
                v4u o; o.x = pk4_fp8(sp[0], sp[129], sp[2 * 129], sp[3 * 129]); o.y = pk4_fp8(sp[4 * 129], sp[5 * 129], sp[6 * 129], sp[7 * 129]);
                o.z = pk4_fp8(sp[8 * 129], sp[9 * 129], sp[10 * 129], sp[11 * 129]); o.w = pk4_fp8(sp[12 * 129], sp[13 * 129], sp[14 * 129], sp[15 * 129]);
                *(v4u*)(dst + (size_t)n * 1024 + kc * 16) = o; }
            __syncthreads();
        }
    }
    bf16* xb = (bf16*)(F.ws + WS_XB);
    for (int m = gw; m < NTOK; m += NGW) {
        const f32x4* xr = (const f32x4*)(a.in[0] + (size_t)m * DM) + F.lane; v2u* o = (v2u*)(xb + (size_t)m * DM) + F.lane;
#pragma unroll
        for (int j = 0; j < 4; ++j) { const f32x4 v = xr[64 * j]; v2u w; w.x = cvtpk(v[0], v[1]); w.y = cvtpk(v[2], v[3]); o[64 * j] = w; }
    }
    bf16* wukt = (bf16*)(F.ws + WS_WUKT); bf16* wuvt = (bf16*)(F.ws + WS_WUVT);
    for (int i = F.blk * NTHR + F.tid; i < 2 * 8 * 128 * 64; i += F.G * NTHR) {
        { const int d = i & 63, c = (i >> 6) & 127, lh = i >> 13; wukt[i] = (bf16)f2bf(a.in[2][((size_t)lh * 64 + d) * 128 + c]); }
        { const int c = i & 127, d = (i >> 7) & 63, lh = i >> 13; wuvt[i] = (bf16)f2bf(a.in[3][((size_t)lh * 128 + c) * 64 + d]); }
    }
}

DI void ln_row(f32x4 (&v)[4], const float* g, const float* b, int lane) {
    float s = 0.f;
#pragma unroll
    for (int j = 0; j < 4; ++j) s += (v[j][0] + v[j][1]) + (v[j][2] + v[j][3]);
    const float mean = wave_sum(s) * (1.f / DM); float s2 = 0.f;
#pragma unroll
    for (int j = 0; j < 4; ++j) { v[j] = v[j] - mean; s2 += (v[j][0] * v[j][0] + v[j][1] * v[j][1]) + (v[j][2] * v[j][2] + v[j][3] * v[j][3]); }
    const float rstd = 1.f / sqrtf(wave_sum(s2) * (1.f / DM) + LN_EPS);
#pragma unroll
    for (int j = 0; j < 4; ++j) { const f32x4 gg = *((const f32x4*)g + lane + 64 * j), bb = *((const f32x4*)b + lane + 64 * j); v[j] = v[j] * rstd * gg + bb; }
}
DI void store_row_f32(float* p, const f32x4 (&v)[4], int lane) {
#pragma unroll
    for (int j = 0; j < 4; ++j) *((f32x4*)p + lane + 64 * j) = v[j];
}
DI void store_row_bf16(bf16* p, const f32x4 (&v)[4], int lane) {
#pragma unroll
    for (int j = 0; j < 4; ++j) { v2u w; w.x = cvtpk(v[j][0], v[j][1]); w.y = cvtpk(v[j][2], v[j][3]); *((v2u*)p + lane + 64 * j) = w; }
}
template <int NL> DI void small_proj(LAS const float* xs, const float* W, int ldw, int lane, float (&acc)[4]) {
    constexpr int PARTS = 64 / NL, DPER = 1024 / PARTS;
    const int n = lane & (NL - 1), part = lane / NL;
    acc[0] = acc[1] = acc[2] = acc[3] = 0.f;
    const float* wp = W + (size_t)(part * DPER) * ldw + n;
    LAS const float* xp = xs + part * DPER;
#pragma unroll 8
    for (int d = 0; d < DPER; ++d) { const float w = wp[(size_t)d * ldw];
        acc[0] += w * xp[d]; acc[1] += w * xp[1024 + d]; acc[2] += w * xp[2048 + d]; acc[3] += w * xp[3072 + d]; }
#pragma unroll
    for (int o = NL; o < 64; o <<= 1) {
#pragma unroll
        for (int k = 0; k < 4; ++k) acc[k] += __shfl_xor(acc[k], o); }
}

DI void ph_even_prep(const Args& a, const Fr& F, int j) {
    const bf16* proj = (const bf16*)(F.ws + WS_PROJ);
    bf16* ckvn = (bf16*)(F.ws + WS_CKVN); bf16* ql = (bf16*)(F.ws + WS_QL); float* kbar = (float*)(F.ws + WS_KBAR);
    const float* kvg = a.in[4] + j * 128;
    const bf16* wukt = (const bf16*)(F.ws + WS_WUKT) + (size_t)j * 8 * 128 * 64;
    const int lane = F.lane, wave = F.wave;
    for (int chunk = F.blk; chunk < 256; chunk += F.G) {
        const int tok0 = chunk * 128;
#pragma unroll 1
        for (int i0 = 0; i0 < 16; i0 += 8) { unsigned wv[8];
#pragma unroll
            for (int i = 0; i < 8; ++i) wv[i] = *((const unsigned*)(proj + (size_t)(tok0 + wave * 16 + i0 + i) * EV_N + EC_CKV) + lane);
#pragma unroll
            for (int i = 0; i < 8; ++i) { const int tok = tok0 + wave * 16 + i0 + i; const float v0 = bf2f(wv[i] & 0xffffu), v1 = bf2f(wv[i] >> 16);
                const float ss = wave_sum(v0 * v0 + v1 * v1);
                const float r = 1.f / sqrtf(ss * (1.f / 128.f) + LN_EPS);
                *((unsigned*)(ckvn + (size_t)tok * 128) + lane) = cvtpk(v0 * r * kvg[2 * lane], v1 * r * kvg[2 * lane + 1]); } }
        { bf16* kic = (bf16*)(F.ws + WS_KIC); const int tok = tok0 + wave * 16 + (lane >> 2), c = (lane & 3) * 16;
            const v4u* src = (const v4u*)(proj + (size_t)tok * EV_N + EC_KI + c); v4u* dst = (v4u*)(kic + (size_t)tok * 64 + c); dst[0] = src[0]; dst[1] = src[1]; }
        { const int h = wave, l15 = lane & 15, kg = lane >> 4;
            bf16x8 af[8][2];
#pragma unroll
            for (int ct = 0; ct < 8; ++ct)
#pragma unroll
                for (int ks = 0; ks < 2; ++ks) af[ct][ks] = *(const bf16x8*)(wukt + ((size_t)h * 128 + ct * 16 + l15) * 64 + ks * 32 + kg * 8);
#pragma unroll 1
            for (int tg = 0; tg < 8; tg += 4) { bf16x8 qf[4][2];
#pragma unroll
                for (int u = 0; u < 4; ++u)
#pragma unroll
                    for (int ks = 0; ks < 2; ++ks) qf[u][ks] = *(const bf16x8*)(proj + (size_t)(tok0 + (tg + u) * 16 + l15) * EV_N + EC_QA + h * 64 + ks * 32 + kg * 8);
#pragma unroll
                for (int u = 0; u < 4; ++u) { const int tok = tok0 + (tg + u) * 16 + l15;
#pragma unroll
                    for (int ct = 0; ct < 8; ++ct) { f32x4 d = {0.f, 0.f, 0.f, 0.f};
                        d = mfma16(af[ct][0], qf[u][0], d); d = mfma16(af[ct][1], qf[u][1], d);
                        v2u w; w.x = cvtpk(d[0], d[1]); w.y = cvtpk(d[2], d[3]);
                        *(v2u*)(ql + (size_t)tok * 1024 + h * 128 + ct * 16 + 4 * kg) = w; } } } }
        if (chunk < 128) { const int b = chunk >> 5, n = chunk & 31; float s8[8];
#pragma unroll
            for (int k = 0; k < 8; ++k) s8[k] = 0.f;
            const bf16* kp = proj + ((size_t)b * SEQ + n * 256 + wave * 32) * EV_N + EC_KB + lane * 8;
#pragma unroll 8
            for (int r = 0; r < 32; ++r) { const v4u w = *(const v4u*)(kp + (size_t)r * EV_N);
#pragma unroll
                for (int k = 0; k < 4; ++k) { s8[2 * k] += bf2f(w[k] & 0xffffu); s8[2 * k + 1] += bf2f(w[k] >> 16); } }
            LAS float* red = (LAS float*)F.lds;
            __syncthreads();
#pragma unroll
            for (int k = 0; k < 8; ++k) red[wave * 512 + lane * 8 + k] = s8[k];
            __syncthreads();
            float s = 0.f;
#pragma unroll
            for (int w = 0; w < 8; ++w) s += red[w * 512 + F.tid];
            const int h = F.tid >> 6, d = F.tid & 63;
            kbar[(((size_t)b * 8 + h) * 32 + n) * 64 + d] = s * (1.f / 256.f); }
    }
}

DI void moba_gate_chunk(const Fr& F, int chunk) {
    const bf16* proj = (const bf16*)(F.ws + WS_PROJ); const float* kbar = (const float*)(F.ws + WS_KBAR); unsigned* sel3 = (unsigned*)(F.ws + WS_SEL3);
    const int tok0 = chunk * 128, b = tok0 / SEQ, own = (tok0 % SEQ) >> 8, h = F.wave, lane = F.lane;
    float q0[64], q1[64];
    { const v4u* p0 = (const v4u*)(proj + (size_t)(tok0 + lane) * EV_N + EC_QB + h * 64); const v4u* p1 = (const v4u*)(proj + (size_t)(tok0 + 64 + lane) * EV_N + EC_QB + h * 64);
#pragma unroll
        for (int i = 0; i < 8; ++i) { const v4u w0 = p0[i], w1 = p1[i];
#pragma unroll
            for (int k = 0; k < 4; ++k) { q0[8 * i + 2 * k] = bf2f(w0[k] & 0xffffu); q0[8 * i + 2 * k + 1] = bf2f(w0[k] >> 16); q1[8 * i + 2 * k] = bf2f(w1[k] & 0xffffu); q1[8 * i + 2 * k + 1] = bf2f(w1[k] >> 16); } } }
    float a0 = -INFINITY, a1 = -INFINITY, a2 = -INFINITY, c0 = -INFINITY, c1 = -INFINITY, c2 = -INFINITY; int ai0 = 0, ai1 = 0, ai2 = 0, ci0 = 0, ci1 = 0, ci2 = 0;
    const float* kb = kbar + (((size_t)b * 8 + h) * 32) * 64;
    for (int n = 0; n < own; ++n) { float g0 = 0.f, g1 = 0.f;
#pragma unroll
        for (int d = 0; d < 64; d += 4) { const f32x4 kv = *(const f32x4*)(kb + n * 64 + d);
#pragma unroll
            for (int k = 0; k < 4; ++k) { g0 += q0[d + k] * kv[k]; g1 += q1[d + k] * kv[k]; } }
        if (g0 > a2) { if (g0 > a1) { a2 = a1; ai2 = ai1; if (g0 > a0) { a1 = a0; ai1 = ai0; a0 = g0; ai0 = n; } else { a1 = g0; ai1 = n; } } else { a2 = g0; ai2 = n; } }
        if (g1 > c2) { if (g1 > c1) { c2 = c1; ci2 = ci1; if (g1 > c0) { c1 = c0; ci1 = ci0; c0 = g1; ci0 = n; } else { c1 = g1; ci1 = n; } } else { c2 = g1; ci2 = n; } }
    }
    const unsigned nv = own < 3 ? own : 3;
    sel3[(size_t)(tok0 + lane) * 8 + h] = (unsigned)ai0 | ((unsigned)ai1 << 8) | ((unsigned)ai2 << 16) | (nv << 24);
    sel3[(size_t)(tok0 + 64 + lane) * 8 + h] = (unsigned)ci0 | ((unsigned)ci1 << 8) | ((unsigned)ci2 << 16) | (nv << 24);
}

constexpr int HS = 257;
DI float relu1(float x) { const unsigned u = __float_as_uint(x); return __uint_as_float(u & ~(unsigned)((int)u >> 31)); }
template <int MODE, bool DIAG> DI void idx_tile(const bf16x8 (&kf)[4], LAS const char* qb  , const float (&wj)[4], int kt, int q, int hi, unsigned c0, unsigned c1,
                                     LAS unsigned* hist, LAS unsigned* mask, LAS unsigned* cmask, LAS unsigned long long* cand, LAS unsigned* rinfo) {
    f32x2 scp[8];
#pragma unroll
    for (int p = 0; p < 8; ++p) scp[p] = (f32x2){0.f, 0.f};
    bf16x8 qv0[2][4], qv1[2][4];
#pragma unroll
    for (int j = 0; j < 2; ++j)
#pragma unroll
        for (int s = 0; s < 4; ++s) qv0[j][s] = *(LAS const bf16x8*)(qb + (j * 8 + s * 2) * 512);
#pragma unroll
    for (int j = 0; j < 2; ++j)
#pragma unroll
        for (int s = 0; s < 4; ++s) qv1[j][s] = *(LAS const bf16x8*)(qb + ((2 + j) * 8 + s * 2) * 512);
    __builtin_amdgcn_sched_barrier(0);
#pragma unroll
    for (int g = 0; g < 2; ++g) { f32x16 acc[2];
#pragma unroll
        for (int j = 0; j < 2; ++j)
#pragma unroll
            for (int r = 0; r < 16; ++r) acc[j][r] = 0.f;
#pragma unroll
        for (int s = 0; s < 4; ++s)
#pragma unroll
            for (int j = 0; j < 2; ++j) { if (MODE != -2) acc[j] = mfma32(kf[s], g == 0 ? qv0[j][s] : qv1[j][s], acc[j]); else acc[j][s] += __builtin_bit_cast(float, (unsigned)(kf[s][0] ^ (g == 0 ? qv0[j][s][0] : qv1[j][s][0]))); }
#pragma unroll
        for (int p = 0; p < 8; ++p)
#pragma unroll
            for (int j = 0; j < 2; ++j) { const f32x2 a = {relu1(acc[j][2 * p]), relu1(acc[j][2 * p + 1])}; const f32x2 w2 = {wj[2 * g + j], wj[2 * g + j]}; scp[p] = a * w2 + scp[p]; } }
    unsigned sel = 0u, cnd = 0u;
    if (MODE <= 0) { float t = 0.f;
#pragma unroll
        for (int p = 0; p < 8; ++p) t += scp[p][0] + scp[p][1];
        if (t == 12345.678f) __hip_atomic_fetch_or(mask + q * HS + kt, 1u, __ATOMIC_RELAXED, __HIP_MEMORY_SCOPE_WORKGROUP);
        return; }
    const float F0 = __uint_as_float(c0), F1 = __uint_as_float(c1);
#pragma unroll
    for (int r = 0; r < 16; ++r) { const int kr = crow(r, hi);
        const bool ok = !DIAG || kr <= q;
        const float scv = scp[r >> 1][r & 1]; const unsigned u = __float_as_uint(scv);
        if (MODE == 1) { const unsigned key = u ^ ((unsigned)((int)u >> 31) | 0x80000000u);
            if (ok && (key >> 24) >= c0) __hip_atomic_fetch_add(hist + q * HS + (key >> 24), 1u, __ATOMIC_RELAXED, __HIP_MEMORY_SCOPE_WORKGROUP); }
        else if (MODE == 2) { if (ok && (u >> 24) == c0) __hip_atomic_fetch_add(hist + q * HS + (((u >> 16) & 255u) ^ c1), 1u, __ATOMIC_RELAXED, __HIP_MEMORY_SCOPE_WORKGROUP); }
        else { const bool ge1 = scv >= F1, ge0 = scv >= F0;
            if (ok && ge1) sel |= 1u << kr;
            if (ok && ge0 && !ge1) { cnd |= 1u << kr; const unsigned key = u ^ ((unsigned)((int)u >> 31) | 0x80000000u);
                const unsigned pos = __hip_atomic_fetch_add(rinfo + 128 + q, 1u, __ATOMIC_RELAXED, __HIP_MEMORY_SCOPE_WORKGROUP);
                if (pos < 64u) cand[q * 64 + pos] = ((unsigned long long)key << 32) | (unsigned)(~(unsigned)(kt * 32 + kr)); } } }
    if (MODE == 3) { if (sel) __hip_atomic_fetch_or(mask + q * HS + kt, sel, __ATOMIC_RELAXED, __HIP_MEMORY_SCOPE_WORKGROUP);
        if (cnd) __hip_atomic_fetch_or(cmask + q * HS + kt, cnd, __ATOMIC_RELAXED, __HIP_MEMORY_SCOPE_WORKGROUP); }
}
#define IDX_LOAD(KF, I) do { int kt_l = wave + 8 * (I); kt_l = kt_l < nkt - 1 ? kt_l : nkt - 1; const bf16* kp_ = kp0 + (size_t)(kt_l * 32) * 64; _Pragma("unroll") for (int s_ = 0; s_ < 4; ++s_) KF[s_] = *(const bf16x8*)(kp_ + s_ * 16); } while (0)
#define IDX_ROT() do { _Pragma("unroll") for (int s_ = 0; s_ < 4; ++s_) { kfa[s_] = kfb[s_]; kfb[s_] = kfc[s_]; } } while (0)
template <int MODE> DI void idx_pass(const bf16* proj, int rowbase, int qt, LAS const char* qimg, const float (&wj)[4], LAS unsigned* hist, LAS unsigned* mask, LAS unsigned* cmask, LAS unsigned long long* cand, LAS unsigned* rinfo, int wave, int lane) {
    const int q = lane & 31, hi = lane >> 5, nkt = qt + 1;
    const unsigned b1 = MODE == 2 ? rinfo[160 + q] : rinfo[224 + q], thr16 = MODE == 2 ? rinfo[192 + q] : rinfo[256 + q];
    const bf16* kp0 = proj + (size_t)(rowbase + q) * 64 + hi * 8;
    LAS const char* qb = qimg + hi * 512 + q * 16;
    const int n_all = nkt > wave ? (nkt - wave + 7) >> 3 : 0;
    if (n_all == 0) return;
    const bool has_diag = (qt & 7) == wave; const int n = n_all - (has_diag ? 1 : 0);
    bf16x8 kfa[4], kfb[4], kfc[4];
#define IDX_TILE(KF, I) idx_tile<MODE, false>(KF, qb, wj, wave + 8 * (I), q, hi, b1, thr16, hist, mask, cmask, cand, rinfo)
    IDX_LOAD(kfa, 0); IDX_LOAD(kfb, 1); IDX_LOAD(kfc, 2);
    int i = 0;
    for (; i + 3 <= n; i += 3) { IDX_TILE(kfa, i); IDX_LOAD(kfa, i + 3); IDX_TILE(kfb, i + 1); IDX_LOAD(kfb, i + 4); IDX_TILE(kfc, i + 2); IDX_LOAD(kfc, i + 5); }
#pragma unroll 1
    for (; i < n; ++i) { IDX_TILE(kfa, i); IDX_ROT(); }
    if (has_diag) idx_tile<MODE, true>(kfa, qb, wj, qt, q, hi, b1, thr16, hist, mask, cmask, cand, rinfo);
#undef IDX_TILE
}
DI void hist_pick(LAS const unsigned* hrow, unsigned need, int lane, unsigned& bin, unsigned& above) {
    unsigned h4[4];
#pragma unroll
    for (int k = 0; k < 4; ++k) h4[k] = hrow[4 * lane + k];
    const unsigned ssum = h4[0] + h4[1] + h4[2] + h4[3];
    unsigned x = ssum;
#pragma unroll
    for (int o = 1; o < 64; o <<= 1) { const unsigned y = __shfl_down(x, o); if (lane + o < 64) x += y; }
    const unsigned long long m = __ballot(x >= need);
    const int Ls = m ? 63 - __builtin_clzll(m) : 0;
    const unsigned xs = __shfl(x, Ls), ss = __shfl(ssum, Ls);
    const unsigned h0 = __shfl(h4[0], Ls), h1 = __shfl(h4[1], Ls), h2 = __shfl(h4[2], Ls), h3 = __shfl(h4[3], Ls);
    unsigned cum = xs - ss;
    if (cum + h3 >= need) { bin = 4 * Ls + 3; above = cum; return; } cum += h3;
    if (cum + h2 >= need) { bin = 4 * Ls + 2; above = cum; return; } cum += h2;
    if (cum + h1 >= need) { bin = 4 * Ls + 1; above = cum; return; } cum += h1;
    bin = 4 * Ls; above = cum; (void)h0;
}
DI void idx_pass1(const bf16* proj, int rowbase, int qt, LAS const char* qimg, const float (&wj)[4], LAS unsigned* hist, LAS unsigned* mask, LAS unsigned* cmask, LAS unsigned long long* cand, LAS unsigned* rinfo, int wave, int lane) {
    const int q = lane & 31, hi = lane >> 5, nkt = qt + 1, nmax = (nkt + 7) >> 3;
    const bf16* kp0 = proj + (size_t)(rowbase + q) * 64 + hi * 8;
    LAS const char* qb = qimg + hi * 512 + q * 16;
    unsigned lb = 0u;
    bf16x8 kfa[4], kfb[4], kfc[4];
#define IDX_TILE(KF, I) idx_tile<1, false>(KF, qb, wj, wave + 8 * (I), q, hi, lb, 0u, hist, mask, cmask, cand, rinfo)
#define IDX_LBUP(I) do { const int i_ = (I); if (((i_ + 1) & i_) == 0 && i_ + 1 < nmax && i_ < 16) {        \
            __syncthreads(); \
            _Pragma("unroll 1") for (int rr = 0; rr < 4; ++rr) { const int row = wave * 4 + rr; unsigned bin, above; hist_pick(hist + row * HS, 256u, lane, bin, above); if (lane == 0) rinfo[288 + row] = bin; } \
            __syncthreads(); \
            { const unsigned nb = rinfo[288 + q]; lb = nb > lb ? nb : lb; } } } while (0)
    IDX_LOAD(kfa, 0); IDX_LOAD(kfb, 1); IDX_LOAD(kfc, 2);
    int i = 0;
    for (; i + 3 <= nmax - 1; i += 3) { IDX_TILE(kfa, i); IDX_LOAD(kfa, i + 3); IDX_LBUP(i); IDX_TILE(kfb, i + 1); IDX_LOAD(kfb, i + 4); IDX_LBUP(i + 1); IDX_TILE(kfc, i + 2); IDX_LOAD(kfc, i + 5); IDX_LBUP(i + 2); }
#pragma unroll 1
    for (; i < nmax - 1; ++i) { IDX_TILE(kfa, i); IDX_ROT(); IDX_LBUP(i); }
    { const int kt = wave + 8 * (nmax - 1);
        if (kt < nkt) { if (kt == qt) idx_tile<1, true>(kfa, qb, wj, kt, q, hi, lb, 0u, hist, mask, cmask, cand, rinfo); else IDX_TILE(kfa, nmax - 1); } }
#undef IDX_TILE
#undef IDX_LBUP
}
#undef IDX_LOAD
#undef IDX_ROT
DI void idx_unit(const Fr& F, int b, int qt, int stop = 0  ) {
    const bf16* proj = (const bf16*)(F.ws + WS_PROJ); const bf16* kic = (const bf16*)(F.ws + WS_KIC); unsigned short* sel = (unsigned short*)(F.ws + WS_SEL);
    LAS unsigned* hist = (LAS unsigned*)(F.lds); LAS unsigned* mask = hist + 32 * HS; LAS unsigned* cmask = mask + 32 * HS;
    LAS unsigned long long* cand = (LAS unsigned long long*)(F.lds + 99328); LAS unsigned* rinfo = (LAS unsigned*)(F.lds + 115712);
    const int lane = F.lane, wave = F.wave, tid = F.tid, t0 = qt * 32, rowbase = b * SEQ;
    __syncthreads();
    for (int i = tid; i < 3 * 32 * HS; i += NTHR) hist[i] = 0u;
    if (tid < 320) rinfo[tid] = 0u;
    __syncthreads();
    if (t0 + 31 <= 255 || (EXPF & 64)) {
        if (lane < 8) {
#pragma unroll
            for (int rr = 0; rr < 4; ++rr) { const int row = wave * 4 + rr, nv = t0 + row + 1;
                const int nv0 = t0 + row + 1; const int nvc = nv0 < 256 ? nv0 : 256; (void)nv; mask[row * HS + lane] = nvc >= 32 * (lane + 1) ? 0xffffffffu : (nvc > 32 * lane ? ((1u << (nvc - 32 * lane)) - 1u) : 0u); } }
    } else {
        const int q = lane & 31;
        float wj[4];
        { const bf16* qp = proj + (size_t)(rowbase + t0 + q) * EV_N;
#pragma unroll
            for (int j = 0; j < 4; ++j) wj[j] = bf2f(qp[EC_WI + j]); }
        LAS char* qimg = (LAS char*)(F.lds + 117248);
#pragma unroll
        for (int i = 0; i < 2; ++i) { const int p = tid + i * NTHR, row = p & 31, c = p >> 5;
            *(LAS v4u*)(qimg + c * 512 + row * 16) = *(const v4u*)(proj + (size_t)(rowbase + t0 + row) * EV_N + EC_QI + c * 8); }
        __syncthreads();
        if (stop == 7) return;
        idx_pass1(kic, rowbase, qt, qimg, wj, hist, mask, cmask, cand, rinfo, wave, lane);
        __syncthreads();
#pragma unroll 1
        for (int rr = 0; rr < 4; ++rr) { const int row = wave * 4 + rr; unsigned bin, above; hist_pick(hist + row * HS, 256u, lane, bin, above);
            if (lane == 0) { rinfo[row] = bin; rinfo[32 + row] = 256u - above; rinfo[160 + row] = bin >= 128u ? bin - 128u : 255u - bin; rinfo[192 + row] = bin >= 128u ? 0u : 255u; } }
        __syncthreads();
        if (stop == 1) return;
        for (int i = tid; i < 32 * HS; i += NTHR) hist[i] = 0u;
        __syncthreads();
        idx_pass<2>(kic, rowbase, qt, qimg, wj, hist, mask, cmask, cand, rinfo, wave, lane);
        __syncthreads();
#pragma unroll 1
        for (int rr = 0; rr < 4; ++rr) { const int row = wave * 4 + rr; const unsigned need1 = rinfo[32 + row]; unsigned bin, above; hist_pick(hist + row * HS, need1, lane, bin, above);
            if (lane == 0) { const unsigned t16 = (rinfo[row] << 8) | bin, k0 = t16 << 16, k1 = (t16 + 1u) << 16;
                rinfo[64 + row] = t16; rinfo[96 + row] = need1 - above;
                rinfo[224 + row] = (k0 & 0x80000000u) ? (k0 ^ 0x80000000u) : ~k0; rinfo[256 + row] = (t16 == 0xffffu) ? 0x7fc00000u : ((k1 & 0x80000000u) ? (k1 ^ 0x80000000u) : ~k1); } }
        __syncthreads();
        if (stop == 2) return;
        idx_pass<3>(kic, rowbase, qt, qimg, wj, hist, mask, cmask, cand, rinfo, wave, lane);
        __syncthreads();
        if (stop == 3) return;
#pragma unroll 1
        for (int rr = 0; rr < 4; ++rr) { const int row = wave * 4 + rr; const unsigned call = rinfo[128 + row], need2 = rinfo[96 + row];
            if (call <= 64u) { const unsigned c = call;
                const unsigned long long mine = cand[row * 64 + lane]; unsigned rank = 0u;
                for (unsigned k = 0; k < c; ++k) rank += (cand[row * 64 + k] > mine) ? 1u : 0u;
                if ((unsigned)lane < c && rank < need2) { const unsigned s = ~(unsigned)mine;
                    __hip_atomic_fetch_or(mask + row * HS + (s >> 5), 1u << (s & 31), __ATOMIC_RELAXED, __HIP_MEMORY_SCOPE_WORKGROUP); } }
            else { unsigned w4[4];
#pragma unroll
                for (int k = 0; k < 4; ++k) w4[k] = cmask[row * HS + 4 * lane + k];
                const unsigned cnt = __popc(w4[0]) + __popc(w4[1]) + __popc(w4[2]) + __popc(w4[3]);
                unsigned x = cnt;
#pragma unroll
                for (int o = 1; o < 64; o <<= 1) { const unsigned y = __shfl_up(x, o); if (lane >= o) x += y; }
                unsigned before = x - cnt;
#pragma unroll
                for (int k = 0; k < 4; ++k) { unsigned w = w4[k]; const unsigned pc = __popc(w); unsigned take = 0u;
                    if (before < need2) { if (before + pc <= need2) take = w; else { unsigned left = need2 - before; while (left) { const unsigned b = w & (0u - w); take |= b; w ^= b; --left; } } }
                    before += pc;
                    if (take) mask[row * HS + 4 * lane + k] |= take; } }
        }
    }
    __syncthreads();
#pragma unroll 1
    for (int rr = 0; rr < 4; ++rr) { const int row = wave * 4 + rr; unsigned short* out = sel + (size_t)(rowbase + t0 + row) * 256;
        unsigned w4[4];
#pragma unroll
        for (int k = 0; k < 4; ++k) w4[k] = mask[row * HS + 4 * lane + k];
        const unsigned cnt = __popc(w4[0]) + __popc(w4[1]) + __popc(w4[2]) + __popc(w4[3]);
        unsigned x = cnt;
#pragma unroll
        for (int o = 1; o < 64; o <<= 1) { const unsigned y = __shfl_up(x, o); if (lane >= o) x += y; }
        const unsigned total = __shfl(x, 63); unsigned pos = x - cnt;
#pragma unroll
        for (int k = 0; k < 4; ++k) { unsigned w = w4[k]; const unsigned base = (unsigned)(4 * lane + k) * 32u;
            while (w) { const unsigned bit = __builtin_ctz(w); if (pos < 256u) out[pos] = (unsigned short)(base + bit); ++pos; w &= w - 1u; } }
        for (unsigned i = total + lane; i < 256u; i += 64u) out[i] = (unsigned short)0xffffu; }
}

struct AttSt { float m, l; f32x16 o0, o1; };
template <class BF> DI void att_subtile(AttSt& S, const bf16x8 (&qf)[4], LAS const char* Kst, LAS const char* Vb, int vdh, int vrow0, int lane, const BF& bias) {
    const int r32 = lane & 31, hi = lane >> 5;
    f32x16 p;
#pragma unroll
    for (int r = 0; r < 16; ++r) p[r] = bias.b(crow(r, hi)) - S.m;
    LAS const char* kp = Kst + hi * 512 + r32 * 16;
#pragma unroll
    for (int s = 0; s < 4; ++s) { const bf16x8 kf = *(LAS const bf16x8*)(kp + s * 1024); p = mfma32(kf, qf[s], p); }
    if (bias.any) {
#pragma unroll
        for (int r = 0; r < 16; ++r) p[r] = bias.msk(crow(r, hi)) ? -INFINITY : p[r]; }
    float mxa[4] = {-INFINITY, -INFINITY, -INFINITY, -INFINITY};
#pragma unroll
    for (int r = 0; r < 16; ++r) mxa[r & 3] = fmaxf(mxa[r & 3], p[r]);
    float mx = fmaxf(fmaxf(mxa[0], mxa[1]), fmaxf(mxa[2], mxa[3]));
    mx = fmaxf(mx, __shfl_xor(mx, 32));
    if (__any(mx > 16.f)) { const float dl = fmaxf(mx, 0.f), sc = ex2(-dl); S.m += dl; S.l *= sc;
#pragma unroll
        for (int r = 0; r < 16; ++r) { p[r] -= dl; S.o0[r] *= sc; S.o1[r] *= sc; } }
    float psa[4] = {0.f, 0.f, 0.f, 0.f};
#pragma unroll
    for (int r = 0; r < 16; ++r) { p[r] = ex2(p[r]); psa[r & 3] += p[r]; }
    S.l += (psa[0] + psa[1]) + (psa[2] + psa[3]);
    v4u pw0, pw1;
    pw0.x = cvtpk(p[0], p[1]); pw0.y = cvtpk(p[2], p[3]); pw0.z = cvtpk(p[4], p[5]); pw0.w = cvtpk(p[6], p[7]);
    pw1.x = cvtpk(p[8], p[9]); pw1.y = cvtpk(p[10], p[11]); pw1.z = cvtpk(p[12], p[13]); pw1.w = cvtpk(p[14], p[15]);
    const bf16x8 pf0 = __builtin_bit_cast(bf16x8, pw0), pf1 = __builtin_bit_cast(bf16x8, pw1);
    LAS const char* vp = Vb + (vrow0 + 4 * hi + ((lane & 15) >> 2)) * 64 + ((lane >> 4) & 1) * 32 + (lane & 3) * 8;
    { const bf16x8 v00 = cat8(vtr(vp), vtr(vp + 512)), v10 = cat8(vtr(vp + vdh), vtr(vp + vdh + 512));
      const bf16x8 v01 = cat8(vtr(vp + 1024), vtr(vp + 1536)), v11 = cat8(vtr(vp + vdh + 1024), vtr(vp + vdh + 1536));
      S.o0 = mfma32(v00, pf0, S.o0); S.o1 = mfma32(v10, pf0, S.o1);
      S.o0 = mfma32(v01, pf1, S.o0); S.o1 = mfma32(v11, pf1, S.o1); }
}
template <class BF0, class BF1> DI void att_tile64(AttSt& S, const bf16x8 (&qf)[4], LAS const char* Kst, LAS const char* Vb, int vdh, int vrow0, int lane, const BF0& bias0, const BF1& bias1) {
    const int r32 = lane & 31, hi = lane >> 5;
    f32x16 p0, p1;
#pragma unroll
    for (int r = 0; r < 16; ++r) { p0[r] = bias0.b(crow(r, hi)) - S.m; p1[r] = bias1.b(crow(r, hi)) - S.m; }
    LAS const char* kp = Kst + hi * 512 + r32 * 16;
#pragma unroll
    for (int s = 0; s < 4; ++s) { const bf16x8 k0 = *(LAS const bf16x8*)(kp + s * 1024), k1 = *(LAS const bf16x8*)(kp + 4096 + s * 1024); p0 = mfma32(k0, qf[s], p0); p1 = mfma32(k1, qf[s], p1); }
    if (bias0.any) {
#pragma unroll
        for (int r = 0; r < 16; ++r) p0[r] = bias0.msk(crow(r, hi)) ? -INFINITY : p0[r]; }
    if (bias1.any) {
#pragma unroll
        for (int r = 0; r < 16; ++r) p1[r] = bias1.msk(crow(r, hi)) ? -INFINITY : p1[r]; }
    float mxa[4] = {-INFINITY, -INFINITY, -INFINITY, -INFINITY};
#pragma unroll
    for (int r = 0; r < 16; ++r) mxa[r & 3] = fmaxf(mxa[r & 3], fmaxf(p0[r], p1[r]));
    float mx = fmaxf(fmaxf(mxa[0], mxa[1]), fmaxf(mxa[2], mxa[3]));
    mx = fmaxf(mx, __shfl_xor(mx, 32));
    if (__any(mx > 16.f)) { const float dl = fmaxf(mx, 0.f), sc = ex2(-dl); S.m += dl; S.l *= sc;
#pragma unroll
        for (int r = 0; r < 16; ++r) { p0[r] -= dl; p1[r] -= dl; S.o0[r] *= sc; S.o1[r] *= sc; } }
    float psa[4] = {0.f, 0.f, 0.f, 0.f};
#pragma unroll
    for (int r = 0; r < 16; ++r) { p0[r] = ex2(p0[r]); p1[r] = ex2(p1[r]); psa[r & 3] += p0[r] + p1[r]; }
    S.l += (psa[0] + psa[1]) + (psa[2] + psa[3]);
    v4u a0, a1, b0, b1;
    a0.x = cvtpk(p0[0], p0[1]); a0.y = cvtpk(p0[2], p0[3]); a0.z = cvtpk(p0[4], p0[5]); a0.w = cvtpk(p0[6], p0[7]);
    a1.x = cvtpk(p0[8], p0[9]); a1.y = cvtpk(p0[10], p0[11]); a1.z = cvtpk(p0[12], p0[13]); a1.w = cvtpk(p0[14], p0[15]);
    b0.x = cvtpk(p1[0], p1[1]); b0.y = cvtpk(p1[2], p1[3]); b0.z = cvtpk(p1[4], p1[5]); b0.w = cvtpk(p1[6], p1[7]);
    b1.x = cvtpk(p1[8], p1[9]); b1.y = cvtpk(p1[10], p1[11]); b1.z = cvtpk(p1[12], p1[13]); b1.w = cvtpk(p1[14], p1[15]);
    LAS const char* vp = Vb + (vrow0 + 4 * hi + ((lane & 15) >> 2)) * 64 + ((lane >> 4) & 1) * 32 + (lane & 3) * 8;
#pragma unroll
    for (int k16 = 0; k16 < 4; ++k16) { const bf16x8 pf = __builtin_bit_cast(bf16x8, k16 == 0 ? a0 : k16 == 1 ? a1 : k16 == 2 ? b0 : b1);
        const bf16x8 v0 = cat8(vtr(vp + k16 * 1024), vtr(vp + k16 * 1024 + 512)), v1 = cat8(vtr(vp + vdh + k16 * 1024), vtr(vp + vdh + k16 * 1024 + 512));
        S.o0 = mfma32(v0, pf, S.o0); S.o1 = mfma32(v1, pf, S.o1); }
}

struct MobaFar { float c; bool any; DI float b(int) const { return c; } DI bool msk(int) const { return false; } };
struct MobaBias { LAS const float* lut; int tq, s0; bool any;
    DI float b(int kvrel) const { const int dist = tq - (s0 + kvrel); return lut[dist < 0 ? 0 : (dist > 1023 ? 1023 : dist)]; }
    DI bool msk(int kvrel) const { return tq - (s0 + kvrel) < 0; } };
DI void moba_qload(bf16x8 (&qf)[4], const bf16* proj, int rowbase, int h, int tq, int hi) {
    const bf16* qp = proj + (size_t)(rowbase + tq) * EV_N + EC_QB + h * 64 + hi * 8;
#pragma unroll
    for (int s = 0; s < 4; ++s) qf[s] = *(const bf16x8*)(qp + s * 16);
}
DI void moba_tile(const Fr& F, const bf16x8 (&qf)[4], int rowbase, int h, int n, int tq, bool valid, int slot, bool own, int wave_tile) {
    LAS const char* Kb = (LAS const char*)F.lds; LAS const char* Vb = (LAS const char*)(F.lds + 32768); LAS const float* lut = (LAS const float*)(F.lds + 98304);
    unsigned char* po = F.ws + WS_ACT; float* pml = (float*)(F.ws + WS_PML);
    const int lane = F.lane, hi = lane >> 5;
    AttSt S; S.m = 0.f; S.l = 0.f;
#pragma unroll
    for (int r = 0; r < 16; ++r) { S.o0[r] = 0.f; S.o1[r] = 0.f; }
    const int nst = own ? wave_tile + 1 : 8;
    int tmin = tq;
#pragma unroll
    for (int o = 1; o < 64; o <<= 1) { const int y = __shfl_xor(tmin, o); tmin = y < tmin ? y : tmin; }
    const float cfar = lut[1023];
    int st = 0;
    for (; st + 1 < nst; st += 2) {
        if (!own && tmin - (n * 256 + st * 32 + 63) >= 790) { MobaFar bf{cfar, false}; att_tile64(S, qf, Kb + st * 4096, Vb, 16384, st * 32, lane, bf, bf); }
        else { MobaBias bf0{lut, tq, n * 256 + st * 32, false}, bf1{lut, tq, n * 256 + st * 32 + 32, own && st + 1 == wave_tile}; att_tile64(S, qf, Kb + st * 4096, Vb, 16384, st * 32, lane, bf0, bf1); } }
    if (st < nst) { MobaBias bf{lut, tq, n * 256 + st * 32, own && st == wave_tile}; att_subtile(S, qf, Kb + st * 4096, Vb, 16384, st * 32, lane, bf); }
    const float lt = S.l + __shfl_xor(S.l, 32), inv = 1.f / lt;
    if (valid) { const size_t pi = ((size_t)(rowbase + tq) * 8 + h) * 4 + slot; unsigned char* o = po + pi * 64; const float i16 = inv * 16.f;
#pragma unroll
        for (int a4 = 0; a4 < 4; ++a4) {
            *(unsigned*)(o + 8 * a4 + 4 * hi) = pk4_fp8(S.o0[4 * a4] * i16, S.o0[4 * a4 + 1] * i16, S.o0[4 * a4 + 2] * i16, S.o0[4 * a4 + 3] * i16);
            *(unsigned*)(o + 32 + 8 * a4 + 4 * hi) = pk4_fp8(S.o1[4 * a4] * i16, S.o1[4 * a4 + 1] * i16, S.o1[4 * a4 + 2] * i16, S.o1[4 * a4 + 3] * i16); }
        if (hi == 0) { f32x2 ml = {S.m, lt}; *(f32x2*)(pml + pi * 2) = ml; } }
}
DI void moba_unit(const Args& a, const Fr& F, int b, int h, int n) {
    const bf16* proj = (const bf16*)(F.ws + WS_PROJ); const unsigned* sel3 = (const unsigned*)(F.ws + WS_SEL3);
    LAS unsigned char* lds = F.lds; LAS unsigned* list = (LAS unsigned*)(lds + 65536); LAS float* lut = (LAS float*)(lds + 98304); LAS unsigned* misc = (LAS unsigned*)(lds + 102400);
    const int tid = F.tid, lane = F.lane, wave = F.wave, rowbase = b * SEQ;
    __syncthreads();
    { const bf16* kg = proj + (size_t)(rowbase + n * 256) * EV_N + EC_KB + h * 64; const bf16* vg = proj + (size_t)(rowbase + n * 256) * EV_N + EC_VB + h * 64;
#pragma unroll
        for (int i = 0; i < 4; ++i) { const int p = tid + i * NTHR;
            { const int r = p & 31, c = (p >> 5) & 7, st = p >> 8; const v4u v = *(const v4u*)(kg + (size_t)(st * 32 + r) * EV_N + c * 8); *(LAS v4u*)(lds + st * 4096 + c * 512 + r * 16) = v; }
            { const int cc = p & 3, row = (p >> 2) & 255, dh = p >> 10; const v4u v = *(const v4u*)(vg + (size_t)row * EV_N + dh * 32 + cc * 8); *(LAS v4u*)(lds + 32768 + dh * 16384 + row * 64 + cc * 16) = v; } }
        for (int d = tid; d < 1024; d += NTHR) lut[d] = a.in[9][t5_bucket(d) * 16 + 8 + h] * LOG2E; }
    if (tid == 0) misc[16] = 0u;
    __syncthreads();
    unsigned sv[16];
#pragma unroll
    for (int k = 0; k < 16; ++k) { const int t = (n + 1) * 256 + k * NTHR + tid; sv[k] = t < SEQ ? sel3[(size_t)(rowbase + t) * 8 + h] : 0u; }
#pragma unroll
    for (int k = 0; k < 16; ++k) { const int tb = (n + 1) * 256 + k * NTHR; if (tb < SEQ) { const int t = tb + tid;
        const unsigned s = sv[k]; const unsigned nv = s >> 24; int slot = -1;
        if (nv > 0u && (s & 255u) == (unsigned)n) slot = 0; else if (nv > 1u && ((s >> 8) & 255u) == (unsigned)n) slot = 1; else if (nv > 2u && ((s >> 16) & 255u) == (unsigned)n) slot = 2;
        const unsigned long long bal = __ballot(slot >= 0); const unsigned wcnt = __popcll(bal);
        if (lane == 0) misc[wave] = wcnt;
        __syncthreads();
        unsigned off = misc[16], tot = 0u;
#pragma unroll
        for (int w = 0; w < 8; ++w) { const unsigned c = misc[w]; if (w < wave) off += c; tot += c; }
        if (slot >= 0) list[off + __popcll(bal & ((1ull << lane) - 1ull))] = ((unsigned)t << 2) | (unsigned)slot;
        __syncthreads();
        if (tid == 0) misc[16] += tot; } }
    __syncthreads();
    const int nlist = (int)misc[16];
    const int ntl = (nlist + 31) >> 5, hi = lane >> 5;
    bf16x8 qa[4], qb2[4];
    moba_qload(qa, proj, rowbase, h, n * 256 + wave * 32 + (lane & 31), hi);
    unsigned ea = 0u, eb = 0u; bool va = false, vb = false;
    const int lastl = nlist > 0 ? nlist - 1 : 0;
#define MOBA_LD(Q, E, V, T) do { const int li_ = (T) * 32 + (lane & 31); V = li_ < nlist; E = list[li_ < lastl ? li_ : lastl]; const int tq_ = (int)(E >> 2); moba_qload(Q, proj, rowbase, h, tq_ < SEQ - 1 ? tq_ : SEQ - 1, hi); } while (0)
    const int nw = ntl > wave ? (ntl - wave + 7) >> 3 : 0;
    MOBA_LD(qb2, eb, vb, wave);
    moba_tile(F, qa, rowbase, h, n, n * 256 + wave * 32 + (lane & 31), true, 3, true, wave);
    int j = 0;
    for (; j + 2 <= nw; j += 2) {
        MOBA_LD(qa, ea, va, wave + 8 * (j + 1));
        moba_tile(F, qb2, rowbase, h, n, (int)(eb >> 2), vb, (int)(eb & 3u), false, 0);
        MOBA_LD(qb2, eb, vb, wave + 8 * (j + 2));
        moba_tile(F, qa, rowbase, h, n, (int)(ea >> 2), va, (int)(ea & 3u), false, 0);
    }
    if (j < nw) moba_tile(F, qb2, rowbase, h, n, (int)(eb >> 2), vb, (int)(eb & 3u), false, 0);
#undef MOBA_LD
}

DI void dsa_step(const bf16x8 (&af)[2][4], const bf16x8 (&qlf)[4], int ch, LAS const unsigned char* bsel, LAS unsigned char* cbuf, LAS const float* tab,
                 float& m, float& l, f32x4 (&oT)[8], int l15, int kg, int lane) {
    f32x4 acc[2];
#pragma unroll
    for (int mt = 0; mt < 2; ++mt) { const unsigned b4 = *(LAS const unsigned*)(bsel + ch * 32 + mt * 16 + 4 * kg);
#pragma unroll
        for (int i = 0; i < 4; ++i) { const unsigned bb = (b4 >> (8 * i)) & 255u; const float tb = tab[(bb & 31u) * 8 + (l15 & 7)];
            acc[mt][i] = (tb - m) + (bb != 255u ? 0.f : -INFINITY); } }
#pragma unroll
    for (int mt = 0; mt < 2; ++mt)
#pragma unroll
        for (int ks = 0; ks < 4; ++ks) { acc[mt] = mfma16(af[mt][ks], qlf[ks], acc[mt]); *(LAS bf16x8*)(cbuf + (mt * 16 + l15) * 288 + (ks * 32 + kg * 8) * 2) = af[mt][ks]; }
    float mx = fmaxf(fmaxf(fmaxf(acc[0][0], acc[0][1]), fmaxf(acc[0][2], acc[0][3])), fmaxf(fmaxf(acc[1][0], acc[1][1]), fmaxf(acc[1][2], acc[1][3])));
    if (__any(mx > 16.f)) { mx = fmaxf(mx, __shfl_xor(mx, 16)); mx = fmaxf(mx, __shfl_xor(mx, 32));
        const float dl = fmaxf(mx, 0.f), sc = ex2(-dl); m += dl; l *= sc;
#pragma unroll
        for (int mt = 0; mt < 2; ++mt) acc[mt] = acc[mt] - dl;
#pragma unroll
        for (int ct = 0; ct < 8; ++ct) oT[ct] = oT[ct] * sc; }
    float ps = 0.f;
#pragma unroll
    for (int mt = 0; mt < 2; ++mt)
#pragma unroll
        for (int i = 0; i < 4; ++i) { acc[mt][i] = ex2(acc[mt][i]); ps += acc[mt][i]; }
    l += ps;
    v4u pw; pw.x = cvtpk(acc[0][0], acc[0][1]); pw.y = cvtpk(acc[0][2], acc[0][3]); pw.z = cvtpk(acc[1][0], acc[1][1]); pw.w = cvtpk(acc[1][2], acc[1][3]);
    const bf16x8 pf = __builtin_bit_cast(bf16x8, pw);
    asm volatile("" ::: "memory");
    LAS const char* tp = (LAS const char*)cbuf + (4 * kg + (l15 >> 2)) * 288 + (lane & 3) * 8;
#pragma unroll
    for (int ct = 0; ct < 8; ++ct) { const bf16x8 cf = cat8(vtr(tp + ct * 32), vtr(tp + 16 * 288 + ct * 32)); oT[ct] = mfma16(cf, pf, oT[ct]); }
    asm volatile("" ::: "memory");
}
DI void dsa_gather(bf16x8 (&af)[2][4], const bf16* ckvn, int rowbase, LAS const unsigned short* selb, int ch, int l15, int kg) {
#pragma unroll
    for (int mt = 0; mt < 2; ++mt) { unsigned idx = selb[ch * 32 + mt * 16 + l15]; if (idx == 0xffffu) idx = 0u;
        const bf16* cp = ckvn + (size_t)(rowbase + (int)idx) * 128 + kg * 8;
#pragma unroll
        for (int ks = 0; ks < 4; ++ks) af[mt][ks] = *(const bf16x8*)(cp + ks * 32); }
}
DI void dsa_query(const Fr& F, int tok, const v2u sv, LAS unsigned char* wl, LAS const unsigned char* bkt, LAS const float* tab) {
    const bf16* ql = (const bf16*)(F.ws + WS_QL); const bf16* ckvn = (const bf16*)(F.ws + WS_CKVN); const unsigned short* sel = (const unsigned short*)(F.ws + WS_SEL); bf16* ol = (bf16*)(F.ws + WS_OL);
    const int lane = F.lane, l15 = lane & 15, kg = lane >> 4, t = tok % SEQ, rowbase = tok - t;
    LAS unsigned short* selb = (LAS unsigned short*)wl; LAS unsigned char* bsel = wl + 512; LAS unsigned char* cbuf = wl + 1024;
    { *((LAS v2u*)selb + lane) = sv; unsigned bw = 0u;
#pragma unroll
        for (int i = 0; i < 4; ++i) { const unsigned s = (i < 2 ? (sv.x >> (16 * i)) : (sv.y >> (16 * (i - 2)))) & 0xffffu; const int dist = t - (int)s;
            const unsigned bb = (s != 0xffffu && dist >= 0) ? (unsigned)bkt[dist > 1023 ? 1023 : dist] : 255u; bw |= bb << (8 * i); }
        *((LAS unsigned*)bsel + lane) = bw; }
    bf16x8 qlf[4];
#pragma unroll
    for (int ks = 0; ks < 4; ++ks) { qlf[ks] = *(const bf16x8*)(ql + (size_t)tok * 1024 + (l15 & 7) * 128 + ks * 32 + kg * 8); if (l15 >= 8) qlf[ks] = (bf16x8){0, 0, 0, 0, 0, 0, 0, 0}; }
    float m = 0.f, l = 0.f; f32x4 oT[8];
#pragma unroll
    for (int ct = 0; ct < 8; ++ct) oT[ct] = (f32x4){0.f, 0.f, 0.f, 0.f};
    const int nvalid = t + 1 < 256 ? t + 1 : 256, nch = (nvalid + 31) >> 5;
    LDS_WAIT();
    bf16x8 afa[2][4], afb[2][4], afc[2][4];
    const int lastc = nch - 1;
    dsa_gather(afa, ckvn, rowbase, selb, 0, l15, kg);
    dsa_gather(afb, ckvn, rowbase, selb, lastc < 1 ? lastc : 1, l15, kg);
    int ch = 0;
    for (; ch + 3 <= nch; ch += 3) {
        dsa_gather(afc, ckvn, rowbase, selb, ch + 2, l15, kg);
        dsa_step(afa, qlf, ch, bsel, cbuf, tab, m, l, oT, l15, kg, lane);
        dsa_gather(afa, ckvn, rowbase, selb, ch + 3 < lastc ? ch + 3 : lastc, l15, kg);
        dsa_step(afb, qlf, ch + 1, bsel, cbuf, tab, m, l, oT, l15, kg, lane);
        dsa_gather(afb, ckvn, rowbase, selb, ch + 4 < lastc ? ch + 4 : lastc, l15, kg);
        dsa_step(afc, qlf, ch + 2, bsel, cbuf, tab, m, l, oT, l15, kg, lane);
    }
    if (ch < nch) dsa_step(afa, qlf, ch, bsel, cbuf, tab, m, l, oT, l15, kg, lane);
    if (ch + 1 < nch) dsa_step(afb, qlf, ch + 1, bsel, cbuf, tab, m, l, oT, l15, kg, lane);
    l += __shfl_xor(l, 16); l += __shfl_xor(l, 32);
    const float inv = 1.f / l;
    if (l15 < 8) { bf16* o = ol + (size_t)tok * 1024 + l15 * 128 + 4 * kg;
#pragma unroll
        for (int ct = 0; ct < 8; ++ct) { v2u w; w.x = cvtpk(oT[ct][0] * inv, oT[ct][1] * inv); w.y = cvtpk(oT[ct][2] * inv, oT[ct][3] * inv); *(v2u*)(o + ct * 16) = w; } }
}
DI void dsa_chunk(const Args& a, const Fr& F, int c32) {
    LAS unsigned char* bkt = F.lds + 81920; LAS float* tab = (LAS float*)(F.lds + 82944);
    __syncthreads();
    for (int d = F.tid; d < 1024; d += NTHR) bkt[d] = (unsigned char)t5_bucket(d);
    if (F.tid < 256) tab[F.tid] = a.in[9][(F.tid >> 3) * 16 + (F.tid & 7)] * LOG2E;
    __syncthreads();
    const unsigned short* selg = (const unsigned short*)(F.ws + WS_SEL); v2u svq[4];
#pragma unroll
    for (int i = 0; i < 4; ++i) svq[i] = *((const v2u*)(selg + (size_t)(c32 * 32 + F.wave * 4 + i) * 256) + F.lane);
#pragma unroll
    for (int i = 0; i < 4; ++i) dsa_query(F, c32 * 32 + F.wave * 4 + i, svq[i], F.lds + F.wave * 10240, bkt, tab);
}

DI void ph_even_post(const Fr& F, int j) {
    const bf16* ol = (const bf16*)(F.ws + WS_OL); unsigned char* ao = F.ws + WS_AO;
    const bf16* wuvt = (const bf16*)(F.ws + WS_WUVT) + (size_t)j * 8 * 64 * 128;
    const unsigned char* po = F.ws + WS_ACT; const float* pml = (const float*)(F.ws + WS_PML); const unsigned* sel3 = (const unsigned*)(F.ws + WS_SEL3);
    const int lane = F.lane, wave = F.wave, l15 = lane & 15, kg = lane >> 4;
    for (int chunk = F.blk; chunk < 256; chunk += F.G) { const int tok0 = chunk * 128;
        { const int h = wave; bf16x8 af[4][4];
#pragma unroll
            for (int mt = 0; mt < 4; ++mt)
#pragma unroll
                for (int ks = 0; ks < 4; ++ks) af[mt][ks] = *(const bf16x8*)(wuvt + ((size_t)h * 64 + mt * 16 + l15) * 128 + ks * 32 + kg * 8);
#pragma unroll 1
            for (int tg = 0; tg < 8; tg += 2) { bf16x8 bf[2][4];
#pragma unroll
                for (int u = 0; u < 2; ++u)
#pragma unroll
                    for (int ks = 0; ks < 4; ++ks) bf[u][ks] = *(const bf16x8*)(ol + (size_t)(tok0 + (tg + u) * 16 + l15) * 1024 + h * 128 + ks * 32 + kg * 8);
#pragma unroll
                for (int u = 0; u < 2; ++u) { const int tok = tok0 + (tg + u) * 16 + l15;
#pragma unroll
                    for (int mt = 0; mt < 4; ++mt) { f32x4 d = {0.f, 0.f, 0.f, 0.f};
#pragma unroll
                        for (int ks = 0; ks < 4; ++ks) d = mfma16(af[mt][ks], bf[u][ks], d);
                        *(unsigned*)(ao + (size_t)tok * 1024 + h * 64 + mt * 16 + 4 * kg) = pk4_fp8(d[0] * F8_SAO, d[1] * F8_SAO, d[2] * F8_SAO, d[3] * F8_SAO); } } } }
#pragma unroll 1
        for (int i0 = 0; i0 < 16; i0 += 4) { const int h = lane >> 3, d0 = (lane & 7) * 8; unsigned nvv[4]; f32x2 mlv[4][4];
#pragma unroll
            for (int i = 0; i < 4; ++i) { const int tok = tok0 + wave * 16 + i0 + i; const size_t pi = ((size_t)tok * 8 + h) * 4; nvv[i] = sel3[(size_t)tok * 8 + h] >> 24;
#pragma unroll
                for (int s = 0; s < 4; ++s) mlv[i][s] = *(const f32x2*)(pml + (pi + s) * 2); }
#pragma unroll
            for (int i = 0; i < 4; ++i) { const int tok = tok0 + wave * 16 + i0 + i; const size_t pi = ((size_t)tok * 8 + h) * 4;
                float mj[4], lj[4];
#pragma unroll
                for (int s = 0; s < 4; ++s) { const bool ok = (s == 3) || ((unsigned)s < nvv[i]); mj[s] = ok ? mlv[i][s][0] : -1e30f; lj[s] = ok ? mlv[i][s][1] : 0.f; }
                const float ms = fmaxf(fmaxf(mj[0], mj[1]), fmaxf(mj[2], mj[3])); float wsum = 0.f, acc[8], wv[4]; v2u pv[4];
#pragma unroll
                for (int k = 0; k < 8; ++k) acc[k] = 0.f;
#pragma unroll
                for (int s = 0; s < 4; ++s) { wv[s] = lj[s] * ex2(mj[s] - ms); wsum += wv[s]; pv[s] = (v2u){0u, 0u}; if (wv[s] > 0.f) pv[s] = *(const v2u*)(po + (pi + s) * 64 + d0); }
#pragma unroll
                for (int s = 0; s < 4; ++s) { if (wv[s] > 0.f) {
#pragma unroll
                    for (int k = 0; k < 2; ++k) { const f32x2 lo = __builtin_amdgcn_cvt_pk_f32_fp8((int)pv[s][k], false), hi2 = __builtin_amdgcn_cvt_pk_f32_fp8((int)pv[s][k], true);
                        acc[4 * k] += wv[s] * lo[0]; acc[4 * k + 1] += wv[s] * lo[1]; acc[4 * k + 2] += wv[s] * hi2[0]; acc[4 * k + 3] += wv[s] * hi2[1]; } } }
                const float inv = (F8_SAO / 16.f) / wsum; v2u o; o.x = pk4_fp8(acc[0] * inv, acc[1] * inv, acc[2] * inv, acc[3] * inv); o.y = pk4_fp8(acc[4] * inv, acc[5] * inv, acc[6] * inv, acc[7] * inv);
                *(v2u*)(ao + (size_t)tok * 1024 + 512 + h * 64 + d0) = o; } }
    }
}
template <class XT> DI f32x4 ld_x4(const XT* p);
template <> DI f32x4 ld_x4<float>(const float* p) { return *(const f32x4*)p; }
template <> DI f32x4 ld_x4<bf16>(const bf16* p) { const v2u w = *(const v2u*)p; return (f32x4){bf2f(w.x & 0xffffu), bf2f(w.x >> 16), bf2f(w.y & 0xffffu), bf2f(w.y >> 16)}; }
template <class XT> DI f32x16 proj32_f32(const float* W, int ldw, int ncols, const XT* xrow, int d_lo, int lane) {
    const int e = lane & 31, kh = lane >> 5; const bool ev = e < ncols;
    f32x16 D;
#pragma unroll
    for (int r = 0; r < 16; ++r) D[r] = 0.f;
    const float* wp = W + (size_t)(d_lo + 4 * kh) * ldw + (ev ? e : 0);
    const XT* xp = xrow + d_lo + 4 * kh;
#pragma unroll 8
    for (int i = 0; i < 64; ++i) { const f32x4 xv = ld_x4<XT>(xp + 8 * i);
        float a0 = wp[(size_t)(8 * i + 0) * ldw], a1 = wp[(size_t)(8 * i + 1) * ldw], a2 = wp[(size_t)(8 * i + 2) * ldw], a3 = wp[(size_t)(8 * i + 3) * ldw];
        if (!ev) { a0 = 0.f; a1 = 0.f; a2 = 0.f; a3 = 0.f; }
        D = __builtin_amdgcn_mfma_f32_32x32x2f32(a0, xv[0], D, 0, 0, 0); D = __builtin_amdgcn_mfma_f32_32x32x2f32(a1, xv[1], D, 0, 0, 0);
        D = __builtin_amdgcn_mfma_f32_32x32x2f32(a2, xv[2], D, 0, 0, 0); D = __builtin_amdgcn_mfma_f32_32x32x2f32(a3, xv[3], D, 0, 0, 0); }
    return D;
}
DI void ph_odd_prep(const Args& a, const Fr& F, int j, int layer) {
    const bf16* proj = (const bf16*)(F.ws + WS_PROJ); const bf16* x = (const bf16*)(F.ws + WS_XB);
    float* logf = (float*)(F.ws + WS_LOGF); float* cs = (float*)(F.ws + WS_CS);
    const float* wf = a.in[6] + (size_t)j * 1024 * 3088 + 3072; const float* bfv = a.in[7] + j * 16;
    LAS float* red = (LAS float*)(F.lds); LAS float* lfb = (LAS float*)(F.lds + 131072);
    LAS unsigned* kmx = (LAS unsigned*)(F.lds + 131072 + 8192);
    const int lane = F.lane, wave = F.wave, tid = F.tid, l31 = lane & 31, hi = lane >> 5;
    for (int chunk = F.blk; chunk < 256; chunk += F.G) { const int tok0 = chunk * 128, b = tok0 / SEQ, t0 = tok0 % SEQ;
        __syncthreads();
        if (tid < 16) kmx[tid] = 0u;
        const int tl = wave & 3, kr = wave >> 2;
        f32x16 D = proj32_f32(wf, 3088, 16, x + (size_t)(tok0 + tl * 32 + l31) * DM, kr * 512, lane);
        if (kr == 1) {
#pragma unroll
            for (int r = 0; r < 8; ++r) red[(tl * 8 + r) * 64 + lane] = D[r]; }
        __syncthreads();
        if (kr == 0) {
#pragma unroll
            for (int r = 0; r < 8; ++r) { const int h = (r & 3) + 8 * (r >> 2) + 4 * hi; const float z = D[r] + red[(tl * 8 + r) * 64 + lane] + bfv[h];
                const float ls = fminf(z, 0.f) - log1pf(__expf(-fabsf(z)));
                lfb[(tl * 32 + l31) * 16 + h] = ls * LOG2E; } }
#pragma unroll 1
        for (int i = 0; i < 4; ++i) { const int p = tid + i * NTHR, tk = p >> 4, h = p & 15; const v4u* kp = (const v4u*)(proj + (size_t)(tok0 + tk) * OD_N + OC_K + h * 64); float s = 0.f;
#pragma unroll
            for (int c = 0; c < 8; ++c) { const v4u w = kp[c];
#pragma unroll
                for (int k = 0; k < 4; ++k) { const float e0 = bf2f(w[k] & 0xffffu), e1 = bf2f(w[k] >> 16); s += e0 * e0 + e1 * e1; } }
            __hip_atomic_fetch_max(kmx + h, __float_as_uint(s), __ATOMIC_RELAXED, __HIP_MEMORY_SCOPE_WORKGROUP); }
        __syncthreads();
        for (int i = tid; i < 2048; i += NTHR) { const int h = i >> 7, tk = i & 127; logf[((size_t)b * 16 + h) * SEQ + t0 + tk] = lfb[tk * 16 + h]; }
        if (tid < 32) { const int h = tid & 15, c = tid >> 4; float s = 0.f;
            for (int k = 0; k < 64; ++k) s += lfb[(c * 64 + k) * 16 + h];
            cs[((size_t)b * 16 + h) * 128 + (t0 >> 6) + c] = s; }
        if (tid < 16) __hip_atomic_fetch_max(F.ctl + CW_KMAX + layer * 64 + b * 16 + tid, kmx[tid], RLX_AGENT);
    }
}

constexpr float FOX_SKIP_LOG2 = 64.f;
struct FoxBias { LAS const float* ng; int tq, kabs0; bool any;
    DI float b(int kvrel) const { return ng[kvrel]; }
    DI bool msk(int kvrel) const { return (kabs0 + kvrel) > tq; } };
DI void fox_unit(const Fr& F, int layer, int b, int h, int qb) {
    const bf16* proj = (const bf16*)(F.ws + WS_PROJ); const float* logf = (const float*)(F.ws + WS_LOGF); const float* cs = (const float*)(F.ws + WS_CS); unsigned char* ao = F.ws + WS_AO;
    LAS unsigned char* lds = F.lds; LAS float* ng = (LAS float*)(lds + 32768); LAS float* red = (LAS float*)(lds + 65536 + 1024); LAS int* ibox = (LAS int*)(lds + 65536 + 2048);
    const int tid = F.tid, lane = F.lane, wave = F.wave, r32 = lane & 31, hi = lane >> 5, t0 = qb * 256, rowbase = b * SEQ, tq = t0 + wave * 32 + r32;
    __syncthreads();
    bf16x8 qf[4]; float qs = 0.f;
    { const bf16* qp = proj + (size_t)(rowbase + tq) * OD_N + OC_Q + h * 64 + hi * 8;
#pragma unroll
        for (int s = 0; s < 4; ++s) { qf[s] = *(const bf16x8*)(qp + s * 16);
#pragma unroll
            for (int k = 0; k < 8; ++k) { const float e = bf2f((unsigned short)qf[s][k]); qs += e * e; } } }
    qs += __shfl_xor(qs, 32); qs = wave_max(qs);
    if (lane == 0) red[wave] = qs;
    if (tid < 128) red[32 + tid] = (tid < t0 / 64) ? cs[((size_t)b * 16 + h) * 128 + tid] : 0.f;
    __syncthreads();
    if (tid == 0) { float qm = red[0];
        for (int w = 1; w < 8; ++w) qm = fmaxf(qm, red[w]);
        const float km = __uint_as_float(ld_u32(F.ctl + CW_KMAX + layer * 64 + b * 16 + h));
        const float B2 = 2.f * (sqrtf(qm * km) * 1.01f + 1.f);
        int kt = t0 / 64 - 1, kts = t0 / 64; float D = 0.f;
        while (kt >= 0 && B2 + D >= -FOX_SKIP_LOG2) { kts = kt; D += red[32 + kt]; --kt; }
        ibox[0] = kts; }
    __syncthreads();
    const int kts = ibox[0], s_start = kts * 64, nel = t0 + 256 - s_start;
    { const int i0 = tid * 16; float v[16]; const float* lp = logf + ((size_t)b * 16 + h) * SEQ + s_start + i0;
        if (i0 < nel) {
#pragma unroll
            for (int c = 0; c < 4; ++c) { const f32x4 w = *(const f32x4*)(lp + 4 * c); v[4 * c] = w[0]; v[4 * c + 1] = w[1]; v[4 * c + 2] = w[2]; v[4 * c + 3] = w[3]; } }
        else {
#pragma unroll
            for (int c = 0; c < 16; ++c) v[c] = 0.f; }
#pragma unroll
        for (int c = 1; c < 16; ++c) v[c] += v[c - 1];
        float xsum = v[15];
#pragma unroll
        for (int o = 1; o < 64; o <<= 1) { const float y = __shfl_up(xsum, o); if (lane >= o) xsum += y; }
        if (lane == 63) red[16 + wave] = xsum;
        __syncthreads();
        float off = xsum - v[15];
        for (int w = 0; w < wave; ++w) off += red[16 + w];
        if (i0 < nel) {
#pragma unroll
            for (int c = 0; c < 4; ++c) { f32x4 w = {-(off + v[4 * c]), -(off + v[4 * c + 1]), -(off + v[4 * c + 2]), -(off + v[4 * c + 3])}; *(LAS f32x4*)(ng + i0 + 4 * c) = w; } }
    }
    const int ntile = t0 / 64 + 4 - kts;
    const bf16* kg = proj + (size_t)rowbase * OD_N + OC_K + h * 64; const bf16* vg = proj + (size_t)rowbase * OD_N + OC_V + h * 64;
    const int kr = tid & 31, kc = (tid >> 5) & 7, kst = tid >> 8, vcc = tid & 3, vrow = (tid >> 2) & 63, vdh = tid >> 8;
    const int koff = kst * 4096 + kc * 512 + kr * 16, voff = 8192 + vdh * 4096 + vrow * 64 + vcc * 16;
    const bf16* kgp = kg + (size_t)(kts * 64 + kst * 32 + kr) * OD_N + kc * 8; const bf16* vgp = vg + (size_t)(kts * 64 + vrow) * OD_N + vdh * 32 + vcc * 8;
#define FOX_LD(KV, VV, I) do { const int ii_ = (I) < ntile - 1 ? (I) : ntile - 1; KV = *(const v4u*)(kgp + (size_t)ii_ * 64 * OD_N); VV = *(const v4u*)(vgp + (size_t)ii_ * 64 * OD_N); } while (0)
    v4u kvA, vvA, kvB, vvB;
    { v4u kv, vv; FOX_LD(kv, vv, 0); FOX_LD(kvA, vvA, 1);
        *(LAS v4u*)(lds + koff) = kv; *(LAS v4u*)(lds + voff) = vv; }
    __syncthreads();
    AttSt S; S.m = 0.f; S.l = 0.f;
#pragma unroll
    for (int r = 0; r < 16; ++r) { S.o0[r] = 0.f; S.o1[r] = 0.f; }
    const int wlast = t0 + wave * 32 + 31, wfirst = t0 + wave * 32;
#define FOX_COMPUTE(I, BUF) do { const int kv0 = (kts + (I)) * 64; LAS const char* bp_ = (LAS const char*)(lds + (BUF)); \
        if (kv0 + 32 <= wlast) { FoxBias bf0{ng + (kv0 - s_start), tq, kv0, kv0 + 31 > wfirst}, bf1{ng + (kv0 + 32 - s_start), tq, kv0 + 32, kv0 + 63 > wfirst}; \
            att_tile64(S, qf, bp_, bp_ + 8192, 4096, 0, lane, bf0, bf1); } \
        else if (kv0 <= wlast) { FoxBias bf{ng + (kv0 - s_start), tq, kv0, kv0 + 31 > wfirst}; \
            att_subtile(S, qf, bp_, bp_ + 8192, 4096, 0, lane, bf); } } while (0)
    for (int i = 0; i < ntile; i += 2) {
        FOX_LD(kvB, vvB, i + 2);
        FOX_COMPUTE(i, 0);
        if (i + 1 < ntile) { *(LAS v4u*)(lds + 16384 + koff) = kvA; *(LAS v4u*)(lds + 16384 + voff) = vvA; }
        __syncthreads();
        if (i + 1 >= ntile) break;
        FOX_LD(kvA, vvA, i + 3);
        FOX_COMPUTE(i + 1, 16384);
        if (i + 2 < ntile) { *(LAS v4u*)(lds + koff) = kvB; *(LAS v4u*)(lds + voff) = vvB; }
        __syncthreads();
    }
#undef FOX_LD
#undef FOX_COMPUTE
    const float lt = S.l + __shfl_xor(S.l, 32), inv = 1.f / lt;
    unsigned char* o = ao + (size_t)(rowbase + tq) * 1024 + h * 64; const float i16 = inv * F8_SAO;
#pragma unroll
    for (int a4 = 0; a4 < 4; ++a4) {
        *(unsigned*)(o + 8 * a4 + 4 * hi) = pk4_fp8(S.o0[4 * a4] * i16, S.o0[4 * a4 + 1] * i16, S.o0[4 * a4 + 2] * i16, S.o0[4 * a4 + 3] * i16);
        *(unsigned*)(o + 32 + 8 * a4 + 4 * hi) = pk4_fp8(S.o1[4 * a4] * i16, S.o1[4 * a4 + 1] * i16, S.o1[4 * a4 + 2] * i16, S.o1[4 * a4 + 3] * i16); }
}

DI void ph_ln1_router(const Args& a, const Fr& F, int layer) {
    const bf16* yp = (const bf16*)(F.ws + WS_YP); bf16* x1 = (bf16*)(F.ws + WS_X1); unsigned char* xb8 = F.ws + WS_XB8;
    unsigned* tope = (unsigned*)(F.ws + WS_TOPE); float* gate = (float*)(F.ws + WS_GATE); unsigned* rank = (unsigned*)(F.ws + WS_RANK);
    const float* g = a.in[10] + (size_t)(layer * 2) * DM; const float* bb = a.in[11] + (size_t)(layer * 2) * DM;
    const float* rw = a.in[12] + (size_t)layer * 1024 * 32; const float* rb = a.in[13] + layer * 32;
    LAS float* red = (LAS float*)(F.lds); LAS unsigned* lcnt = (LAS unsigned*)(F.lds + 131072);
    const int lane = F.lane, wave = F.wave, tid = F.tid, l31 = lane & 31, hi = lane >> 5;
    for (int chunk = F.blk; chunk < 256; chunk += F.G) { const int tok0 = chunk * 128;
        __syncthreads();
        if (tid < 32) lcnt[tid] = 0u;
#pragma unroll 1
        for (int k = 0; k < 16; k += 8) { f32x4 v[8][4];
#pragma unroll
            for (int i = 0; i < 8; ++i)
#pragma unroll
                for (int jj = 0; jj < 4; ++jj) { const v2u w = *((const v2u*)(yp + (size_t)(tok0 + wave * 16 + k + i) * DM) + lane + 64 * jj);
                    v[i][jj] = (f32x4){bf2f(w.x & 0xffffu), bf2f(w.x >> 16), bf2f(w.y & 0xffffu), bf2f(w.y >> 16)}; }
#pragma unroll
            for (int i = 0; i < 8; ++i) { const int tok = tok0 + wave * 16 + k + i;
                ln_row(v[i], g, bb, lane);
                store_row_bf16(x1 + (size_t)tok * DM, v[i], lane);
#pragma unroll
                for (int jj = 0; jj < 4; ++jj) *((unsigned*)(xb8 + (size_t)tok * DM) + lane + 64 * jj) = pk4_fp8(v[i][jj][0] * F8_SX, v[i][jj][1] * F8_SX, v[i][jj][2] * F8_SX, v[i][jj][3] * F8_SX); } }
        asm volatile("s_waitcnt vmcnt(0)" ::: "memory");
        __syncthreads();
        const int tl = wave & 3, kr = wave >> 2, tokl = tok0 + tl * 32 + l31;
        f32x16 D = proj32_f32(rw, 32, 32, x1 + (size_t)tokl * DM, kr * 512, lane);
        if (kr == 1) {
#pragma unroll
            for (int r = 0; r < 16; ++r) red[(tl * 16 + r) * 64 + lane] = D[r]; }
        __syncthreads();
        if (kr == 0) {
            float lv[32];
#pragma unroll
            for (int r = 0; r < 16; ++r) { const float own = D[r] + red[(tl * 16 + r) * 64 + lane] + rb[crow(r, hi)]; const float oth = __shfl_xor(own, 32);
                lv[crow(r, 0)] = hi == 0 ? own : oth; lv[crow(r, 1)] = hi == 0 ? oth : own; }
            float tv[4]; int te[4];
#pragma unroll
            for (int r = 0; r < 4; ++r) { float mx = -INFINITY; int me = 0;
#pragma unroll
                for (int e = 0; e < 32; ++e) { if (lv[e] > mx) { mx = lv[e]; me = e; } }
                tv[r] = mx; te[r] = me;
#pragma unroll
                for (int e = 0; e < 32; ++e) { if (e == me) lv[e] = -INFINITY; } }
            const float e1 = __expf(tv[1] - tv[0]), e2 = __expf(tv[2] - tv[0]), e3 = __expf(tv[3] - tv[0]); const float inv = 1.f / (1.f + e1 + e2 + e3);
            if (hi == 0) { const size_t o = (size_t)tokl * 4;
                const float gv[4] = {inv, e1 * inv, e2 * inv, e3 * inv};
#pragma unroll
                for (int r = 0; r < 4; ++r) { const unsigned rk = __hip_atomic_fetch_add(lcnt + (te[r] & 31), 1u, __ATOMIC_RELAXED, __HIP_MEMORY_SCOPE_WORKGROUP);
                    tope[o + r] = (unsigned)(te[r] & 31); gate[o + r] = gv[r]; rank[o + r] = rk; } } }
        __syncthreads();
        if (tid < 32) __hip_atomic_store(F.ctl + CW_CNT + chunk * 32 + tid, lcnt[tid], RLX_AGENT);
    }
}

DI void ph_route(const Fr& F) {
    unsigned short* srcg = (unsigned short*)(F.ws + WS_SRC);
    const unsigned* tope = (const unsigned*)(F.ws + WS_TOPE); const unsigned* rank = (const unsigned*)(F.ws + WS_RANK); unsigned* dest = (unsigned*)(F.ws + WS_DEST);
    LAS unsigned* P = (LAS unsigned*)(F.lds); LAS unsigned* pst = P + 512; LAS unsigned* pad = P + 544; LAS unsigned* base = P + 576; LAS unsigned* nt = P + 608; LAS unsigned* totl = P + 640;
    const int tid = F.tid;
    __syncthreads();
    { const int e = tid & 31, part = tid >> 5; unsigned s = 0u;
        for (int c = 0; c < 16; ++c) s += ld_u32(F.ctl + CW_CNT + (part * 16 + c) * 32 + e);
        P[part * 32 + e] = s; }
    __syncthreads();
    if (tid < 32) { unsigned tot = 0u;
        for (int p = 0; p < 16; ++p) tot += P[p * 32 + tid];
        totl[tid] = tot; pad[tid] = (tot + 255u) & ~255u; }
    __syncthreads();
    if (tid == 0) { unsigned acc = 0u;
        for (int e = 0; e < 32; ++e) { pst[e] = acc; acc += pad[e]; }
        nt[0] = acc >> 8; }
    __syncthreads();
    if (F.blk < 32) { const int e = F.blk;
        for (unsigned i = totl[e] + tid; i < pad[e]; i += NTHR) srcg[pst[e] + i] = (unsigned short)0; }
    for (int chunk = F.blk; chunk < 256; chunk += F.G) {
        __syncthreads();
        if (tid < 32) { unsigned off = 0u; const int pf = chunk >> 4;
            for (int p = 0; p < pf; ++p) off += P[p * 32 + tid];
            for (int c = pf * 16; c < chunk; ++c) off += ld_u32(F.ctl + CW_CNT + c * 32 + tid);
            base[tid] = pst[tid] + off; }
        __syncthreads();
        { const size_t pi = (size_t)chunk * 512 + tid;
            const unsigned d = base[tope[pi] & 31u] + rank[pi];
            dest[pi] = d; srcg[d] = (unsigned short)(pi >> 2); }
        if (chunk == 0) { const unsigned ntl = nt[0];
            if (tid == 0) __hip_atomic_store(F.ctl + CW_TILE, ntl, RLX_AGENT);
            for (unsigned i = tid; i < ntl; i += NTHR) { unsigned e = 0u;
                for (unsigned k = 1; k < 32; ++k) if (pst[k] <= i * 256u) e = k;
                __hip_atomic_store(F.ctl + CW_TILE + 64 + i, e, RLX_AGENT); } }
    }
}

DI void ph_combine_ln2(const Args& a, const Fr& F, int layer) {
    const bf16* x1 = (const bf16*)(F.ws + WS_X1); const unsigned char* yr = F.ws + WS_XG; bf16* xb = (bf16*)(F.ws + WS_XB);
    const float* gate = (const float*)(F.ws + WS_GATE); const unsigned* dest = (const unsigned*)(F.ws + WS_DEST);
    const float* g = a.in[10] + (size_t)(layer * 2 + 1) * DM; const float* bb = a.in[11] + (size_t)(layer * 2 + 1) * DM;
    const int lane = F.lane; const int gw = F.blk * NWAVES + F.wave, NGW = F.G * NWAVES;
    for (int tok = gw; tok < NTOK; tok += 4 * NGW) { f32x4 v[4][4];
#pragma unroll
        for (int i = 0; i < 4; ++i) { const int tk = tok + i * NGW; if (tk < NTOK) {
#pragma unroll
            for (int jj = 0; jj < 4; ++jj) { const v2u w = *((const v2u*)(x1 + (size_t)tk * DM) + lane + 64 * jj);
                v[i][jj] = (f32x4){bf2f(w.x & 0xffffu), bf2f(w.x >> 16), bf2f(w.y & 0xffffu), bf2f(w.y >> 16)} * ALPHA; }
#pragma unroll
            for (int k = 0; k < 4; ++k) { const float gk = gate[(size_t)tk * 4 + k] * (1.f / F8_SY); const unsigned d = dest[(size_t)tk * 4 + k];
#pragma unroll
                for (int jj = 0; jj < 4; ++jj) { const int w = (int)*((const unsigned*)(yr + (size_t)d * DM) + lane + 64 * jj);
                    const f32x2 lo = __builtin_amdgcn_cvt_pk_f32_fp8(w, false), hi2 = __builtin_amdgcn_cvt_pk_f32_fp8(w, true);
                    v[i][jj][0] += gk * lo[0]; v[i][jj][1] += gk * lo[1]; v[i][jj][2] += gk * hi2[0]; v[i][jj][3] += gk * hi2[1]; } } } }
#pragma unroll
        for (int i = 0; i < 4; ++i) { const int tk = tok + i * NGW; if (tk < NTOK) {
            ln_row(v[i], g, bb, lane);
            if (layer == DEPTH - 1) store_row_f32(a.out + (size_t)tk * DM, v[i], lane);
            else store_row_bf16(xb + (size_t)tk * DM, v[i], lane); } } }
}
constexpr int LDS_BYTES = 147456;
constexpr int LDS_BARW = 145408, LDS_QSLOT = 145472, LDS_TILE_E = 133632, LDS_SRCL = 136192;
constexpr int NPL = 11;
constexpr int NPHASE = 1 + NPL * DEPTH;
#ifndef MK_SINGLE
#define MK_SINGLE 1
#endif
DI int q_next(const Fr& F, unsigned* ctr) {
    LAS int* slot = (LAS int*)(F.lds + LDS_QSLOT);
    __syncthreads();
    if (F.tid == 0) *slot = (int)__hip_atomic_fetch_add(ctr, 1u, RLX_AGENT);
    __syncthreads();
    return *slot;
}
DI int lane_id_fresh() { unsigned m_ = ~0u; asm volatile("" : "+s"(m_)); return (int)__builtin_amdgcn_mbcnt_hi(m_, __builtin_amdgcn_mbcnt_lo(m_, 0u)); }
#define RETID(F) do { int t2_ = F.tid; asm volatile("" : "+v"(t2_)); F.tid = t2_; F.lane = t2_ & 63; F.wave = __builtin_amdgcn_readfirstlane(t2_ >> 6); } while (0)
#ifndef PROBE_DUP
#define PROBE_DUP -1
#endif
#define NREP(q) ((PROBE_DUP == (q)) ? 2 : 1)
#define AS4 __attribute__((address_space(4)))
#define SITE() Args a; Fr F; { const AS4 Args* ap = (const AS4 Args*)__builtin_amdgcn_kernarg_segment_ptr(); asm volatile("" : "+s"(ap)); \
        _Pragma("unroll") for (int i_ = 0; i_ < 18; ++i_) a.in[i_] = ap->in[i_]; a.out = ap->out; a.ws = ap->ws; a.ph_lo = 0; a.ph_hi = 0; \
        int w_ = wv_s; asm volatile("" : "+s"(w_)); int t_ = w_ * 64 + lane_id_fresh(); asm volatile("" : "+v"(t_)); F.tid = t_; F.lane = t_ & 63; F.wave = __builtin_amdgcn_readfirstlane(t_ >> 6); \
        F.lds = (LAS unsigned char*)lds_raw; F.ws = a.ws; F.ctl = (unsigned*)(a.ws + WS_CTL); F.blk = blockIdx.x; F.G = gridDim.x; }
__global__ void __launch_bounds__(NTHR, 2) mega_fwd(Args a0) {
    extern __shared__ __attribute__((aligned(16))) unsigned char lds_raw[];
    const int wv_s = __builtin_amdgcn_readfirstlane((int)(threadIdx.x >> 6));
#if MK_SINGLE
    constexpr int lo = 0, hi = NPHASE; constexpr bool single = true;
#else
    const int lo = a0.ph_lo, hi = a0.ph_hi; constexpr bool single = false;
#endif
    if (threadIdx.x == 0) *(LAS v4u*)((LAS unsigned char*)lds_raw + LDS_BARW) = (v4u){0u, 0u, 0u, 0u};
    __syncthreads();
    if (single) (void)xcd_barrier_post((unsigned*)(a0.ws + WS_CTL) + CW_BAR, (volatile LAS unsigned*)((LAS unsigned char*)lds_raw + LDS_BARW));
#define IN(k) (lo <= (k) && (k) < hi)
#define SEAM() do { if (single) { const AS4 Args* ap_ = (const AS4 Args*)__builtin_amdgcn_kernarg_segment_ptr(); asm volatile("" : "+s"(ap_)); int w_ = wv_s; asm volatile("" : "+s"(w_)); \
        XcdBarrier b_; b_.bar = (unsigned*)(ap_->ws + WS_CTL) + CW_BAR; b_.x = xb_xcc_id(); b_.st = (volatile LAS unsigned*)((LAS unsigned char*)lds_raw + LDS_BARW); \
        xcd_barrier(b_, (w_ == 0) && (lane_id_fresh() == 0)); } } while (0)
    if (IN(0)) { _Pragma("unroll 1") for (int rep = 0; rep < NREP(100); ++rep) { { SITE(); ph_prologue(a, F); } SEAM(); } }
#pragma clang loop unroll(full)
    for (int L = 0; L < DEPTH; ++L) {
        const int pb = 1 + NPL * L, j = L >> 1; const bool odd = (L & 1) != 0;
        if (IN(pb + 0)) _Pragma("unroll 1") for (int rep = 0; rep < NREP(0); ++rep) {
            { SITE();
            const bf16* w = odd ? (const bf16*)(F.ws + WS_WOD) + (size_t)j * OD_N * 1024 : (const bf16*)(F.ws + WS_WEV) + (size_t)j * EV_N * 1024;
            const int N = odd ? OD_N : EV_N;
            pg8::Gemm g{(const bf16*)(F.ws + WS_XB), w, NTOK, N, 1024}; pg8::StaticOrder S; S.init(NTOK, N, F.G, F.blk);
            pg8::EpiBf16<0> E{(bf16*)(F.ws + WS_PROJ), N, nullptr, 1024, (size_t)1024, C2F};
            pg8::gemm_phase<pg8::EpiBf16<0>, pg8::StaticOrder, true, true>(F.lds, g, S, E, F.tid); }
            SEAM(); }
        if (IN(pb + 1)) _Pragma("unroll 1") for (int rep = 0; rep < NREP(1); ++rep) { { SITE(); if (odd) ph_odd_prep(a, F, j, L); else ph_even_prep(a, F, j); } SEAM(); }
        if (!odd && IN(pb + 2)) _Pragma("unroll 1") for (int rep = 0; rep < ((PROBE_DUP == 2 || (PROBE_DUP >= 21 && PROBE_DUP <= 22) || (PROBE_DUP >= 211 && PROBE_DUP <= 217)) ? 2 : 1); ++rep) {
            { SITE(); unsigned* ctr = F.ctl + CW_Q + 64 * (L * 2) + 1024 * rep;
            for (;;) { const int it = q_next(F, ctr); if (it >= 1280) break; RETID(F);
                if (it < 1024) { if (!(rep == 1 && PROBE_DUP == 22)) idx_unit(F, it & 3, 255 - (it >> 2), (rep == 1 && PROBE_DUP >= 211) ? PROBE_DUP - 210 : 0); } else { if (!(rep == 1 && (PROBE_DUP == 21 || PROBE_DUP >= 211))) moba_gate_chunk(F, it - 1024); } } }
            SEAM(); }
        if (IN(pb + 3)) _Pragma("unroll 1") for (int rep = 0; rep < ((PROBE_DUP == 3 || (PROBE_DUP == 31 && odd) || ((PROBE_DUP >= 32 && PROBE_DUP <= 34) && !odd)) ? 2 : 1); ++rep) {
            { SITE(); unsigned* ctr = F.ctl + CW_Q + 64 * (L * 2 + 1) + 1024 * rep;
            if (odd) { for (;;) { const int it = q_next(F, ctr); if (it >= 2048) break; RETID(F); const int bh = it & 63; fox_unit(F, L, bh >> 4, bh & 15, 31 - (it >> 6)); } }
            else { for (;;) { const int it = q_next(F, ctr); if (it >= 2048) break; RETID(F);
                    if (it < 1024) { const int bh = it & 31; if (!(rep == 1 && (PROBE_DUP == 33 || PROBE_DUP == 34))) moba_unit(a, F, bh >> 3, bh & 7, it >> 5); } else { if (!(rep == 1 && PROBE_DUP == 32)) dsa_chunk(a, F, it - 1024); } } } }
            SEAM(); }
        if (!odd && IN(pb + 4)) _Pragma("unroll 1") for (int rep = 0; rep < NREP(4); ++rep) { { SITE(); ph_even_post(F, j); } SEAM(); }
        if (IN(pb + 5)) _Pragma("unroll 1") for (int rep = 0; rep < NREP(5); ++rep) {
            { SITE();
            pg8::Gemm g{(const bf16*)(F.ws + WS_AO), (const bf16*)(F.ws + WS_WOUT + (size_t)L * 1024 * 1024), NTOK, 1024, 512}; pg8::StaticOrder S; S.init(NTOK, 1024, F.G, F.blk);
            EpiResBf16 E{(const bf16*)(F.ws + WS_XB), (bf16*)(F.ws + WS_YP), ALPHA, 1.f / (F8_SAO * F8_SWO)};
            pg8::gemm_phase<EpiResBf16, pg8::StaticOrder, true, true, true>(F.lds, g, S, E, F.tid); }
            SEAM(); }
        if (IN(pb + 6)) _Pragma("unroll 1") for (int rep = 0; rep < NREP(6); ++rep) { { SITE(); ph_ln1_router(a, F, L); } SEAM(); }
        if (IN(pb + 7)) _Pragma("unroll 1") for (int rep = 0; rep < NREP(7); ++rep) { { SITE(); ph_route(F); } SEAM(); }
        if (IN(pb + 8)) _Pragma("unroll 1") for (int rep = 0; rep < NREP(8); ++rep) {
            { SITE(); const int ntl = (int)ld_u32(F.ctl + CW_TILE);
            LAS unsigned* tle = (LAS unsigned*)(F.lds + LDS_TILE_E);
            for (int i = F.tid; i < ntl; i += NTHR) tle[i] = ld_u32(F.ctl + CW_TILE + 64 + i);
            LAS unsigned* srcl = (LAS unsigned*)(F.lds + LDS_SRCL); const unsigned* srcg = (const unsigned*)(F.ws + WS_SRC);
            for (int i = F.tid; i < 17 * 128; i += NTHR) { const int pm = (i >> 7) * 32 + (F.blk & 7) * 4 + (F.blk >> 6); if (pm < ntl) srcl[i] = srcg[(size_t)pm * 128 + (i & 127)]; }
            __syncthreads();
            pg8::Gemm g{(const bf16*)(F.ws + WS_XB8), (const bf16*)(F.ws + WS_WGU + (size_t)L * 32 * 2048 * 1024), NR_MAX, 32 * 2048, 512};
            GroupOrder S{tle, ntl, 3, F.G, F.blk, (LAS const unsigned short*)srcl};
            EpiSwiglu E{F.ws + WS_ACT, a.in[15] + (size_t)L * 32 * 2048};
            pg8::gemm_phase<EpiSwiglu, GroupOrder, true, true, true, true>(F.lds, g, S, E, F.tid); }
            SEAM(); }
        if (IN(pb + 9)) _Pragma("unroll 1") for (int rep = 0; rep < NREP(9); ++rep) {
            { SITE(); const int ntl = (int)ld_u32(F.ctl + CW_TILE);
            LAS unsigned* tle = (LAS unsigned*)(F.lds + LDS_TILE_E);
            for (int i = F.tid; i < ntl; i += NTHR) tle[i] = ld_u32(F.ctl + CW_TILE + 64 + i);
            __syncthreads();
            pg8::Gemm g{(const bf16*)(F.ws + WS_ACT), (const bf16*)(F.ws + WS_WDN + (size_t)L * 32 * 1024 * 1024), NR_MAX, 32 * 1024, 512};
            GroupOrder S{tle, ntl, 2, F.G, F.blk, (LAS const unsigned short*)nullptr};
            EpiDown E{F.ws + WS_XG, a.in[17] + (size_t)L * 32 * 1024};
            pg8::gemm_phase<EpiDown, GroupOrder, true, true, true>(F.lds, g, S, E, F.tid); }
            SEAM(); }
        if (IN(pb + 10)) _Pragma("unroll 1") for (int rep = 0; rep < NREP(10); ++rep) { { SITE(); ph_combine_ln2(a, F, L); } if (L + 1 < DEPTH || rep + 1 < NREP(10)) SEAM(); }
        if (PROBE_DUP == 900 && L + 1 < DEPTH) { _Pragma("unroll 1") for (int xb = 0; xb < 10; ++xb) SEAM(); }
    }
#undef IN
#undef SEAM
}

extern "C" void kernel_launch(void* const* d_in, const int* in_sizes, int n_in, void* d_out, int out_size, void* d_ws, size_t ws_size, hipStream_t stream) {
    static int grid = 0;
    if (grid == 0) {
        if (n_in != 18 || out_size != NTOK * DM || ws_size < WS_END) { fprintf(stderr, "kernel_launch: unexpected shapes (n_in %d, out %d, ws %zu); nothing launched\n", n_in, out_size, ws_size); grid = -1; return; }
        int dev = 0, cus = 0, per_cu = 0;
        if (hipGetDevice(&dev) != hipSuccess || hipDeviceGetAttribute(&cus, hipDeviceAttributeMultiprocessorCount, dev) != hipSuccess) { grid = -1; return; }
        if (hipFuncSetAttribute((const void*)mega_fwd, hipFuncAttributeMaxDynamicSharedMemorySize, LDS_BYTES) != hipSuccess) { fprintf(stderr, "kernel_launch: hipFuncSetAttribute failed\n"); grid = -1; return; }
        if (hipOccupancyMaxActiveBlocksPerMultiprocessor(&per_cu, (const void*)mega_fwd, NTHR, LDS_BYTES) != hipSuccess || per_cu < 1) fprintf(stderr, "kernel_launch: occupancy query reports %d\n", per_cu);
        (void)hipGetLastError();
        if (cus < 256) { fprintf(stderr, "kernel_launch: %d CUs (the gathered gate/up GEMM's unit order assumes the MI355X's 256); nothing launched\n", cus); grid = -1; return; }
        grid = 256;
    }
    if (grid < 0) return;
    (void)hipMemsetAsync((char*)d_ws + WS_CTL, 0, CTL_ZERO_BYTES, stream);
#ifdef EXP_SKIP
    (void)hipMemsetAsync((char*)d_ws + WS_AO, 0, 64 * MiB, stream);
    (void)hipMemsetAsync((char*)d_ws + WS_OL, 0, 64 * MiB, stream);
    if (EXP_SKIP & 4) { (void)hipMemsetAsync((char*)d_ws + WS_XG, 0, 272 * MiB, stream); (void)hipMemsetAsync((char*)d_ws + WS_DEST, 0, 1 * MiB, stream); }
#endif
    Args a{};
    for (int i = 0; i < 18; ++i) a.in[i] = (const float*)d_in[i];
    a.out = (float*)d_out; a.ws = (unsigned char*)d_ws;
#if MK_SINGLE
    a.ph_lo = 0; a.ph_hi = NPHASE;
    hipLaunchKernelGGL(mega_fwd, dim3(grid), dim3(NTHR), LDS_BYTES, stream, a);
#else
    for (int p = 0; p < NPHASE; ++p) {
        if (p > 0) { const int L = (p - 1) / NPL, q = (p - 1) % NPL; if ((L & 1) && (q == 2 || q == 4)) continue;
#ifdef EXP_SKIP
            if ((EXP_SKIP & 1) && !(L & 1) && q <= 4) continue;
            if ((EXP_SKIP & 2) && (L & 1) && q <= 4) continue;
            if ((EXP_SKIP & 4) && q >= 7 && q <= 9) continue;
#endif
        }
        a.ph_lo = p; a.ph_hi = p + 1;
        hipLaunchKernelGGL(mega_fwd, dim3(grid), dim3(NTHR), LDS_BYTES, stream, a);
    }
#endif
}
```

```cpp
#include <hip/hip_runtime.h>
#include <cstdio>
#include <cstdint>
#ifdef EXP_SKIP
#define EXPF EXP_SKIP
#else
#define EXPF 0
#endif
constexpr int NB = 4, SEQ = 8192, DM = 1024, NTOK = NB * SEQ, DEPTH = 4;
constexpr int EV_N = 2560, OD_N = 3072;
constexpr int EC_QA = 0, EC_QB = 512, EC_KB = 1024, EC_VB = 1536, EC_CKV = 2048, EC_QI = 2176, EC_KI = 2432, EC_WI = 2496;
constexpr int OC_Q = 0, OC_K = 1024, OC_V = 2048;
constexpr float LOG2E = 1.4426950408889634f;
constexpr float C2F = 0.125f * LOG2E;
constexpr float ALPHA = 1.681792830507429f;
constexpr float LN_EPS = 1e-5f;
constexpr int NR_MAX = 131072 + 32 * 256;
constexpr int NWAVES = 8, NTHR = 512;
constexpr size_t MiB = (size_t)1 << 20;
constexpr size_t WS_CTL = 0, CTL_ZERO_BYTES = 256 * 1024;
constexpr size_t WS_WEV = 8 * MiB, WS_WOD = 18 * MiB, WS_WOUT = 30 * MiB, WS_WUKT = 38 * MiB, WS_WUVT = 39 * MiB;
constexpr size_t WS_WGU = 40 * MiB, WS_WDN = 552 * MiB;
constexpr size_t WS_X = 808 * MiB, WS_X1 = 936 * MiB, WS_YP = 1064 * MiB, WS_XB = 1192 * MiB;
constexpr size_t WS_PROJ = 1256 * MiB, WS_AO = 1448 * MiB, WS_XG = 1512 * MiB, WS_ACT = 1784 * MiB;
constexpr size_t WS_QL = 2056 * MiB, WS_OL = 2120 * MiB, WS_CKVN = 2184 * MiB, WS_SEL = 2192 * MiB;
constexpr size_t WS_KBAR = 2208 * MiB, WS_SEL3 = 2209 * MiB, WS_LOGF = 2210 * MiB, WS_CS = 2212 * MiB;
constexpr size_t WS_TOPE = 2213 * MiB, WS_GATE = 2214 * MiB, WS_RANK = 2215 * MiB, WS_DEST = 2216 * MiB, WS_PML = 2217 * MiB;
constexpr size_t WS_SRC = WS_DEST + 512 * 1024;
constexpr size_t WS_XB8 = 2226 * MiB;
constexpr size_t WS_KIC = 2258 * MiB;
constexpr size_t WS_END = 2262 * MiB;
constexpr float F8_SX = 16.f, F8_SWG = 256.f, F8_SA = 4.f, F8_SWD = 512.f, F8_SY = 32.f, F8_SAO = 16.f, F8_SWO = 1024.f;
constexpr int CW_BAR = 4096, CW_Q = 8192, CW_KMAX = 12288, CW_CNT = 16384, CW_TILE = 32768;

#define GAS __attribute__((address_space(1)))
#define LAS __attribute__((address_space(3)))
#define DI __device__ __forceinline__
typedef unsigned short bf16;
typedef unsigned v4u __attribute__((ext_vector_type(4)));
typedef unsigned v2u __attribute__((ext_vector_type(2)));
typedef float f32x4 __attribute__((ext_vector_type(4)));
typedef float f32x2 __attribute__((ext_vector_type(2)));
typedef float f32x16 __attribute__((ext_vector_type(16)));
typedef short bf16x8 __attribute__((ext_vector_type(8)));
typedef short s16x4 __attribute__((ext_vector_type(4)));
typedef __bf16 bf16x2_t __attribute__((ext_vector_type(2)));
typedef GAS unsigned gu32;
#define RLX_AGENT __ATOMIC_RELAXED, __HIP_MEMORY_SCOPE_AGENT
#define LDS_WAIT() asm volatile("s_waitcnt lgkmcnt(0)" ::: "memory")

DI float bf2f(unsigned v) { return __uint_as_float(v << 16); }
DI unsigned cvtpk(float lo, float hi) { f32x2 v = {lo, hi}; bf16x2_t b = __builtin_convertvector(v, bf16x2_t); return __builtin_bit_cast(unsigned, b); }
DI unsigned f2bf(float f) { return cvtpk(f, 0.f) & 0xffffu; }
DI unsigned pk4_fp8(float a, float b, float c, float d) {
    a = fminf(fmaxf(a, -448.f), 448.f); b = fminf(fmaxf(b, -448.f), 448.f); c = fminf(fmaxf(c, -448.f), 448.f); d = fminf(fmaxf(d, -448.f), 448.f);
    int w = 0; w = __builtin_amdgcn_cvt_pk_fp8_f32(a, b, w, false); w = __builtin_amdgcn_cvt_pk_fp8_f32(c, d, w, true); return (unsigned)w; }
DI float ex2(float x) { return __builtin_amdgcn_exp2f(x); }
DI float wave_sum(float v) {
#pragma unroll
    for (int o = 1; o < 64; o <<= 1) v += __shfl_xor(v, o);
    return v;
}
DI float wave_max(float v) {
#pragma unroll
    for (int o = 1; o < 64; o <<= 1) v = fmaxf(v, __shfl_xor(v, o));
    return v;
}
DI unsigned ld_u32(const unsigned* p) { return __hip_atomic_load(p, RLX_AGENT); }
DI int crow(int r, int hi) { return (r & 3) + 8 * (r >> 2) + 4 * hi; }
DI f32x16 mfma32(bf16x8 a, bf16x8 b, f32x16 c) { return __builtin_amdgcn_mfma_f32_32x32x16_bf16(a, b, c, 0, 0, 0); }
DI f32x4 mfma16(bf16x8 a, bf16x8 b, f32x4 c) { return __builtin_amdgcn_mfma_f32_16x16x32_bf16(a, b, c, 0, 0, 0); }
typedef short v4i16_t __attribute__((ext_vector_type(4)));
DI s16x4 vtr(LAS const char* p) { return __builtin_bit_cast(s16x4, __builtin_amdgcn_ds_read_tr16_b64_v4i16((LAS v4i16_t*)p)); }
DI bf16x8 cat8(s16x4 a, s16x4 b) { return (bf16x8){a[0], a[1], a[2], a[3], b[0], b[1], b[2], b[3]}; }
DI int t5_bucket(int n) {
    if (n < 16) return n;
    int bkt = 16;
    bkt += (n >= 21); bkt += (n >= 27); bkt += (n >= 35); bkt += (n >= 46); bkt += (n >= 59); bkt += (n >= 77); bkt += (n >= 99); bkt += (n >= 128);
    bkt += (n >= 166); bkt += (n >= 216); bkt += (n >= 280); bkt += (n >= 363); bkt += (n >= 470); bkt += (n >= 609); bkt += (n >= 790);
    return bkt;
}
namespace pg8 {
#define PG8_LAS __attribute__((address_space(3)))
typedef unsigned short bf16_t;
typedef short bf16x8 __attribute__((ext_vector_type(8)));
typedef float f32x4 __attribute__((ext_vector_type(4)));
typedef unsigned u32x4 __attribute__((ext_vector_type(4)));
constexpr int BM = 256, BK = 64, HALF = 128, HTB = HALF * BK * 2  , STAGE_BYTES = 8 * HTB, NXCD = 8, WGM = 8;

__host__ __device__ __forceinline__ int lds_byte(int r, int c) { const int st = (r >> 4) * 2 + (c >> 5), rr = r & 15, cc = c & 31, ob = rr * 64 + cc * 2; return st * 1024 + (ob ^ (((ob >> 9) & 1) << 5)); }
__host__ __device__ __forceinline__ void stage_rc(int b, int& R, int& C) { const int st = b / 1024, sb = b % 1024, swz = sb ^ (((sb >> 9) & 1) << 5); R = (st >> 1) * 16 + swz / 64; C = (st & 1) * 32 + (swz % 64) / 2; }
__host__ __device__ __forceinline__ int perm32(int rho) { const int n = rho >> 4, i = rho & 15; return 8 * (i >> 2) + 4 * n + (i & 3); }

typedef int i32x8 __attribute__((ext_vector_type(8))); typedef int i32x4v __attribute__((ext_vector_type(4)));
__device__ __forceinline__ i32x8 pg8_cat8(bf16x8 lo, bf16x8 hi) { const i32x4v a = __builtin_bit_cast(i32x4v, lo), b = __builtin_bit_cast(i32x4v, hi); return (i32x8){a[0], a[1], a[2], a[3], b[0], b[1], b[2], b[3]}; }
struct Unit { int pm, pn; };
struct Gemm { const bf16_t* A; const bf16_t* Bt; int M, N, K; };

struct StaticOrder {
    int nM, nN, nwg, G, c;
    __host__ __device__ void init(int M, int N, int G_, int c_) { nM = M / BM; nN = N / BM; nwg = nM * nN; G = G_; c = c_; }
    __host__ __device__ bool next(int i, Unit& u) const {
        const long L = (long)i * G + c; if (L >= nwg) return false;
        int wgid = (int)L; { const int q = nwg / NXCD, r = nwg % NXCD, xcd = wgid % NXCD, off = wgid / NXCD; wgid = (xcd < r ? xcd * (q + 1) : r * (q + 1) + (xcd - r) * q) + off; }
        const int nig = WGM * nN, gid = wgid / nig, fm = gid * WGM, gsz = (nM - fm) < WGM ? (nM - fm) : WGM;
        u.pm = fm + ((wgid % nig) % gsz); u.pn = (wgid % nig) / gsz; return true;
    }
    __device__ __forceinline__ void a_ready(const Unit&) const {}
    __device__ __forceinline__ void done(const Unit&) const {}
};

__device__ __forceinline__ unsigned cvt_pk_bf16(float lo, float hi) { unsigned r; asm volatile("v_cvt_pk_bf16_f32 %0, %1, %2" : "=v"(r) : "v"(lo), "v"(hi)); return r; }
typedef float f32x2 __attribute__((ext_vector_type(2)));
__device__ __forceinline__ f32x2 gelu_pk(f32x2 v) {
    const f32x2 av = __builtin_elementwise_abs(v), d = av * 0.2316418882f + 1.0f;
    f32x2 t; t.x = __builtin_amdgcn_rcpf(d.x); t.y = __builtin_amdgcn_rcpf(d.y);
    f32x2 q = t * 0.5307027145f + (-0.7265760135f); q = q * t + 0.7107068705f; q = q * t + (-0.142248368f); q = q * t + 0.127414796f; q = q * t;
    const f32x2 s = (v * v) * (-0.72134752044f);
    f32x2 e; e.x = __builtin_amdgcn_exp2f(s.x); e.y = __builtin_amdgcn_exp2f(s.y);
    const f32x2 m = v * (q * e), r = v - m;
    f32x2 o; o.x = v.x < 0.f ? m.x : r.x; o.y = v.y < 0.f ? m.y : r.y; return o;
}

template <int ACT  > struct EpiBf16 {
    static constexpr bool PERM = true, AFTER_DRAIN = false; static_assert(ACT == 0 || ACT == 1, "EpiBf16: ACT is 0 (none) or 1 (gelu_pk)");
    bf16_t* O; int ldc; const float* bias; int split_cols; size_t split_stride; float scale0;
    __device__ __forceinline__ void operator()(const f32x4 (&acc)[2][2][4][2], const Unit& u, int wr, int wc, int fr, int fq) const {
        const int row0 = u.pm * BM + wr * 64 + fr; int colt = u.pn * BM; bf16_t* base = O;
        float sc = 1.f; if (split_cols) { const int t = colt / split_cols; base += (size_t)t * split_stride; colt -= t * split_cols; if (t == 0) sc = scale0; }
        const int col0 = colt + wc * 32 + 8 * fq, bcol0 = u.pn * BM + wc * 32 + 8 * fq;
        f32x4 bv[2][2];
#pragma unroll
        for (int bj = 0; bj < 2; ++bj)
#pragma unroll
            for (int n = 0; n < 2; ++n) bv[bj][n] = bias ? *(const f32x4*)(bias + bcol0 + bj * HALF + 4 * n) : (f32x4){0.f, 0.f, 0.f, 0.f};
#pragma unroll
        for (int ai = 0; ai < 2; ++ai)
#pragma unroll
            for (int m = 0; m < 4; ++m) { bf16_t* rowp = base + (size_t)(row0 + ai * HALF + m * 16) * ldc + col0;
#pragma unroll
                for (int bj = 0; bj < 2; ++bj) { f32x4 v0 = acc[ai][bj][m][0] + bv[bj][0], v1 = acc[ai][bj][m][1] + bv[bj][1];
                    if (ACT == 1) { f32x2 a = gelu_pk((f32x2){v0[0], v0[1]}), b = gelu_pk((f32x2){v0[2], v0[3]}), c = gelu_pk((f32x2){v1[0], v1[1]}), d = gelu_pk((f32x2){v1[2], v1[3]});
                        v0 = (f32x4){a.x, a.y, b.x, b.y}; v1 = (f32x4){c.x, c.y, d.x, d.y}; }
                    v0 = v0 * sc; v1 = v1 * sc; u32x4 w; w.x = cvt_pk_bf16(v0[0], v0[1]); w.y = cvt_pk_bf16(v0[2], v0[3]); w.z = cvt_pk_bf16(v1[0], v1[1]); w.w = cvt_pk_bf16(v1[2], v1[3]);
                    *(u32x4*)(rowp + bj * HALF) = w; } }
    }
};

template <class Epi, class Sched, bool ALIGN_EPI = false, bool SP2 = false, bool F8 = false, bool GATH = false  >
__device__ __forceinline__ void gemm_phase(PG8_LAS unsigned char* lds, const Gemm g, const Sched& S, const Epi& E, int tid_in) {
    int tid_l = tid_in; asm volatile("" : "+v"(tid_l));
    const int tid = tid_l, wid = __builtin_amdgcn_readfirstlane(tid >> 6), lane = tid & 63, wr = wid >> 2, wc = wid & 3, fr = lane & 15, fq = lane >> 4;
    const int K = g.K, nt = K / BK;
    unsigned voffA[2], voffB[2]; int rowA[2]; unsigned colA[2];
#pragma unroll
    for (int i = 0; i < 2; ++i) { int R, C; stage_rc(tid * 16 + i * 8192, R, C); const int Rb = Epi::PERM ? ((R & ~31) + perm32(R & 31)) : R;
        voffA[i] = (unsigned)(R * K + C) * 2u; voffB[i] = (unsigned)(Rb * K + C) * 2u; rowA[i] = R; colA[i] = (unsigned)C * 2u; }
    static_assert(!GATH || SP2, "GATH: SP2 schedule only");
    unsigned cgo[2][2], ngo[2][2];
#define PG8_GOFF(dst, uidx) do { _Pragma("unroll") for (int _h = 0; _h < 2; ++_h) _Pragma("unroll") for (int _i = 0; _i < 2; ++_i) dst[_h][_i] = S.gsrc((uidx), _h * HALF + rowA[_i]) + colA[_i]; } while (0)
#define PG8_STAGE_G(bufoff, kb, o0, o1) do { \
        __builtin_amdgcn_global_load_lds((const unsigned*)((const char*)g.A + (kb) + (o0)), (PG8_LAS unsigned*)(lds + (bufoff) + ldsw), 16, 0, 0); \
        __builtin_amdgcn_global_load_lds((const unsigned*)((const char*)g.A + (kb) + (o1)), (PG8_LAS unsigned*)(lds + (bufoff) + ldsw + 8192), 16, 0, 0); } while (0)
    const size_t kstep = (size_t)(BK * 2);
    const size_t hstep = (size_t)HALF * K * 2;
    const size_t tstep = 2 * hstep;
    const unsigned ldsw = (unsigned)wid * 1024u;
    const int aoff = lds_byte(wr * 64 + fr, fq * 8), boff = lds_byte(wc * 32 + fr, fq * 8);
#define PG8_SA(b, h) (((b) * 2 + (h)) * HTB)
#define PG8_SB(b, h) ((4 + (b) * 2 + (h)) * HTB)
#define PG8_STAGE(bufoff, gbase, voff) do { _Pragma("unroll") for (int _i = 0; _i < 2; ++_i) \
        __builtin_amdgcn_global_load_lds((const unsigned*)((const char*)(gbase) + (voff)[_i]), (PG8_LAS unsigned*)(lds + (bufoff) + ldsw + _i * 8192), 16, 0, 0); } while (0)
#define PG8_LDA(dst, b, h) do { _Pragma("unroll") for (int m = 0; m < 4; ++m) _Pragma("unroll") for (int k = 0; k < 2; ++k) dst[m][k] = *(const PG8_LAS bf16x8*)(lds + PG8_SA(b, h) + aoff + m * 2048 + k * 1024); } while (0)
#define PG8_LDB(dst, b, h) do { _Pragma("unroll") for (int n = 0; n < 2; ++n) _Pragma("unroll") for (int k = 0; k < 2; ++k) dst[n][k] = *(const PG8_LAS bf16x8*)(lds + PG8_SB(b, h) + boff + n * 2048 + k * 1024); } while (0)
#define PG8_MMA(ai, bj, At, Bt) do { __builtin_amdgcn_s_setprio(1); if constexpr (!F8) { _Pragma("unroll") for (int m = 0; m < 4; ++m) _Pragma("unroll") for (int n = 0; n < 2; ++n) _Pragma("unroll") for (int k = 0; k < 2; ++k) \
        acc[ai][bj][m][n] = __builtin_amdgcn_mfma_f32_16x16x32_bf16(Bt[n][k], At[m][k], acc[ai][bj][m][n], 0, 0, 0); } else { _Pragma("unroll") for (int m = 0; m < 4; ++m) _Pragma("unroll") for (int n = 0; n < 2; ++n) \
        acc[ai][bj][m][n] = __builtin_amdgcn_mfma_scale_f32_16x16x128_f8f6f4(pg8_cat8(Bt[n][0], Bt[n][1]), pg8_cat8(At[m][0], At[m][1]), acc[ai][bj][m][n], 0, 0, 0, 0x7F7F7F7F, 0, 0x7F7F7F7F); \
        _Pragma("unroll") for (int m = 0; m < 4; ++m) _Pragma("unroll") for (int n = 0; n < 2; ++n) asm volatile("" : "+v"(acc[ai][bj][m][n]));   } __builtin_amdgcn_s_setprio(0); } while (0)
#define PG8_WAIT_V(n) asm volatile("s_waitcnt vmcnt(" #n ")" ::: "memory")
#define PG8_WAIT_L(n) asm volatile("s_waitcnt lgkmcnt(" #n ")" ::: "memory")
#define PG8_BAR __builtin_amdgcn_s_barrier()
#define PG8_SCHED __builtin_amdgcn_sched_barrier(0)
    Unit cur, nxt; int ui = 0;
    if (!S.next(0, cur)) return;
    f32x4 acc[2][2][4][2];
#pragma unroll
    for (int a = 0; a < 2; ++a)
#pragma unroll
        for (int b = 0; b < 2; ++b)
#pragma unroll
            for (int m = 0; m < 4; ++m)
#pragma unroll
                for (int n = 0; n < 2; ++n) acc[a][b][m][n] = (f32x4){0.f, 0.f, 0.f, 0.f};
    bf16x8 At[4][2], B0[2][2], B1[2][2];
    const char* cA = (const char*)g.A + (size_t)cur.pm * tstep; const char* cB = (const char*)g.Bt + (size_t)cur.pn * tstep;
    S.a_ready(cur);
    if constexpr (SP2) {
        if constexpr (GATH) { PG8_GOFF(cgo, 0); }
        PG8_STAGE(PG8_SB(0, 0), cB, voffB); PG8_STAGE(PG8_SB(0, 1), cB + hstep, voffB);
        if constexpr (GATH) { PG8_STAGE_G(PG8_SA(0, 0), 0, cgo[0][0], cgo[0][1]); PG8_STAGE_G(PG8_SA(0, 1), 0, cgo[1][0], cgo[1][1]); }
        else { PG8_STAGE(PG8_SA(0, 0), cA, voffA); PG8_STAGE(PG8_SA(0, 1), cA + hstep, voffA); }
        if (wr == 1) PG8_BAR;
        PG8_WAIT_V(2); PG8_BAR;
        PG8_STAGE(PG8_SB(1, 0), cB + kstep, voffB);
        if constexpr (GATH) { PG8_STAGE_G(PG8_SA(1, 0), kstep, cgo[0][0], cgo[0][1]); } else { PG8_STAGE(PG8_SA(1, 0), cA + kstep, voffA); }
        PG8_STAGE(PG8_SB(1, 1), cB + hstep + kstep, voffB);
        PG8_WAIT_V(6); PG8_BAR;
    } else {
        PG8_STAGE(PG8_SB(0, 0), cB, voffB); PG8_STAGE(PG8_SA(0, 0), cA, voffA); PG8_STAGE(PG8_SB(0, 1), cB + hstep, voffB); PG8_STAGE(PG8_SA(0, 1), cA + hstep, voffA);
        if (wr == 1) PG8_BAR;
        PG8_WAIT_V(4); PG8_BAR;
        PG8_STAGE(PG8_SB(1, 0), cB + kstep, voffB); PG8_STAGE(PG8_SA(1, 0), cA + kstep, voffA); PG8_STAGE(PG8_SB(1, 1), cB + hstep + kstep, voffB);
        PG8_WAIT_V(6); PG8_BAR;
    }
    for (;;) {
        const bool has_next = S.next(ui + 1, nxt);
        if constexpr (GATH) { if (has_next) { PG8_GOFF(ngo, ui + 1); } else {
            _Pragma("unroll") for (int _h = 0; _h < 2; ++_h) _Pragma("unroll") for (int _i = 0; _i < 2; ++_i) ngo[_h][_i] = cgo[_h][_i]; } }
        const char* nA = has_next ? (const char*)g.A + (size_t)nxt.pm * tstep : cA; const char* nB = has_next ? (const char*)g.Bt + (size_t)nxt.pn * tstep : cB;
        for (int t = 0; t < nt; t += 2) {
            const bool last = (t == nt - 2);
            const char* a1 = cA + (size_t)(t + 1) * kstep;
            const char* a2 = last ? nA : cA + (size_t)(t + 2) * kstep; const char* b2 = last ? nB : cB + (size_t)(t + 2) * kstep;
            const char* a3 = a2 + kstep; const char* b3 = b2 + kstep;
            if (last && has_next) S.a_ready(nxt);
            unsigned g0a = 0, g0b = 0, g1a = 0, g1b = 0; size_t kb2 = 0;
            if constexpr (GATH) { g0a = last ? ngo[0][0] : cgo[0][0]; g0b = last ? ngo[0][1] : cgo[0][1]; g1a = last ? ngo[1][0] : cgo[1][0]; g1b = last ? ngo[1][1] : cgo[1][1]; kb2 = last ? (size_t)0 : (size_t)(t + 2) * kstep; }
            if constexpr (SP2) {
            PG8_LDB(B0, 0, 0); PG8_LDB(B1, 0, 1); PG8_SCHED; PG8_LDA(At, 0, 0);
            if constexpr (GATH) { PG8_STAGE_G(PG8_SA(1, 1), (size_t)(t + 1) * kstep, cgo[1][0], cgo[1][1]); } else { PG8_STAGE(PG8_SA(1, 1), a1 + hstep, voffA); }
            PG8_WAIT_V(8); PG8_WAIT_L(0); PG8_BAR; PG8_MMA(0, 0, At, B0); PG8_MMA(0, 1, At, B1); PG8_BAR; PG8_SCHED;
            PG8_LDA(At, 0, 1); PG8_STAGE(PG8_SB(0, 0), b2, voffB); PG8_STAGE(PG8_SB(0, 1), b2 + hstep, voffB);
            if constexpr (GATH) { PG8_STAGE_G(PG8_SA(0, 0), kb2, g0a, g0b); } else { PG8_STAGE(PG8_SA(0, 0), a2, voffA); }
            PG8_WAIT_V(8); PG8_WAIT_L(0); PG8_BAR; PG8_MMA(1, 0, At, B0); PG8_MMA(1, 1, At, B1); PG8_BAR; PG8_SCHED;
            PG8_LDB(B0, 1, 0); PG8_LDB(B1, 1, 1); PG8_SCHED; PG8_LDA(At, 1, 0);
            if constexpr (GATH) { PG8_STAGE_G(PG8_SA(0, 1), kb2, g1a, g1b); } else { PG8_STAGE(PG8_SA(0, 1), a2 + hstep, voffA); }
            PG8_WAIT_V(8); PG8_WAIT_L(0); PG8_BAR; PG8_MMA(0, 0, At, B0); PG8_MMA(0, 1, At, B1); PG8_BAR; PG8_SCHED;
            PG8_LDA(At, 1, 1); PG8_STAGE(PG8_SB(1, 0), b3, voffB); PG8_STAGE(PG8_SB(1, 1), b3 + hstep, voffB);
            if constexpr (GATH) { PG8_STAGE_G(PG8_SA(1, 0), kb2 + kstep, g0a, g0b); } else { PG8_STAGE(PG8_SA(1, 0), a3, voffA); }
            PG8_WAIT_V(8); PG8_WAIT_L(0); PG8_BAR; PG8_MMA(1, 0, At, B0); PG8_MMA(1, 1, At, B1); PG8_BAR; PG8_SCHED;
            } else {
            PG8_LDB(B0, 0, 0); PG8_SCHED; PG8_LDA(At, 0, 0); PG8_STAGE(PG8_SA(1, 1), a1 + hstep, voffA);
            PG8_WAIT_L(8); PG8_BAR; PG8_WAIT_L(0); PG8_MMA(0, 0, At, B0); PG8_BAR; PG8_SCHED;
            PG8_LDB(B1, 0, 1); PG8_STAGE(PG8_SB(0, 0), b2, voffB);
            PG8_BAR; PG8_WAIT_L(0); PG8_MMA(0, 1, At, B1); PG8_BAR;
            PG8_LDA(At, 0, 1); PG8_STAGE(PG8_SA(0, 0), a2, voffA);
            PG8_BAR; PG8_WAIT_L(0); PG8_MMA(1, 0, At, B0); PG8_BAR; PG8_SCHED;
            PG8_STAGE(PG8_SB(0, 1), b2 + hstep, voffB);
            PG8_WAIT_V(6); PG8_BAR; PG8_MMA(1, 1, At, B1); PG8_BAR;
            PG8_LDB(B0, 1, 0); PG8_SCHED; PG8_LDA(At, 1, 0); PG8_STAGE(PG8_SA(0, 1), a2 + hstep, voffA);
            PG8_WAIT_L(8); PG8_BAR; PG8_WAIT_L(0); PG8_MMA(0, 0, At, B0); PG8_BAR; PG8_SCHED;
            PG8_LDB(B1, 1, 1); PG8_STAGE(PG8_SB(1, 0), b3, voffB);
            PG8_BAR; PG8_WAIT_L(0); PG8_MMA(0, 1, At, B1); PG8_BAR;
            PG8_LDA(At, 1, 1); PG8_STAGE(PG8_SA(1, 0), a3, voffA);
            PG8_BAR; PG8_WAIT_L(0); PG8_MMA(1, 0, At, B0); PG8_BAR; PG8_SCHED;
            PG8_STAGE(PG8_SB(1, 1), b3 + hstep, voffB);
            PG8_WAIT_V(6); PG8_BAR; PG8_MMA(1, 1, At, B1); PG8_BAR;
            }
        }
        if constexpr (ALIGN_EPI) { if (wr == 0) PG8_BAR; }
        if constexpr (!Epi::AFTER_DRAIN) { E(acc, cur, wr, wc, fr, fq); S.done(cur); }
        if (!has_next) break;
#pragma unroll
        for (int a = 0; a < 2; ++a)
#pragma unroll
            for (int b = 0; b < 2; ++b)
#pragma unroll
                for (int m = 0; m < 4; ++m)
#pragma unroll
                    for (int n = 0; n < 2; ++n) acc[a][b][m][n] = (f32x4){0.f, 0.f, 0.f, 0.f};
        cur = nxt; cA = nA; cB = nB; ++ui;
        if constexpr (GATH) { _Pragma("unroll") for (int _h = 0; _h < 2; ++_h) _Pragma("unroll") for (int _i = 0; _i < 2; ++_i) cgo[_h][_i] = ngo[_h][_i]; }
        if constexpr (ALIGN_EPI) { if (wr == 1) PG8_BAR; }
    }
    PG8_WAIT_V(0);
    if constexpr (!ALIGN_EPI) { if (wr == 0) PG8_BAR; }
    PG8_BAR;
    if constexpr (Epi::AFTER_DRAIN) { E.fused(acc, cur, wr, wc, fr, fq, lds, wid, lane); S.done(cur); }
#undef PG8_SA
#undef PG8_SB
#undef PG8_STAGE
#undef PG8_STAGE_G
#undef PG8_GOFF
#undef PG8_LDA
#undef PG8_LDB
#undef PG8_MMA
#undef PG8_WAIT_V
#undef PG8_WAIT_L
#undef PG8_BAR
#undef PG8_SCHED
}
}

#ifndef PG8_SP2
#define PG8_SP2 true
#endif
#ifndef PG8_ALIGN
#define PG8_ALIGN true
#endif
#define XB_TMO      128
#define XB_XCNT(j)  (256  + 64 * (j))
#define XB_XSUB(j)  (1280 + 64 * (j))
#define XB_XGEN(j)  (2304 + 64 * (j))
#define XB_TOP      3328
#define XB_TOPGEN   3392
#define XCD_BAR_WORDS 3456
#define XB_SPIN_CAP (1u << 18)

__device__ __forceinline__ unsigned xb_ld(unsigned* p)              { return __hip_atomic_load(p, __ATOMIC_RELAXED, __HIP_MEMORY_SCOPE_AGENT); }
__device__ __forceinline__ unsigned xb_add(unsigned* p, unsigned v) { return __hip_atomic_fetch_add(p, v, __ATOMIC_RELAXED, __HIP_MEMORY_SCOPE_AGENT); }
__device__ __forceinline__ unsigned xb_xcc_id() { return (unsigned)__builtin_amdgcn_s_getreg((3 << 11) | 20) & 0xFu; }
#define XB_SPIN(cond, bar) do { unsigned _sp = 0; while (cond) { __builtin_amdgcn_s_sleep(1); \
    if ((++_sp & 255u) == 0u) { if (xb_ld(&(bar)[XB_TMO])) break; if (_sp > XB_SPIN_CAP) { atomicAdd(&(bar)[XB_TMO], 1u); break; } } } } while (0)

struct XcdBarrier {
    unsigned* bar; unsigned x;
    volatile LAS unsigned* st;
};

__device__ __forceinline__ XcdBarrier xcd_barrier_post(unsigned* bar, volatile LAS unsigned* st) {
    XcdBarrier b; b.bar = bar; b.x = xb_xcc_id(); b.st = st;
    if (threadIdx.x == 0) (void)xb_add(&bar[XB_XCNT(b.x)], 1u);
    return b;
}
__device__ __forceinline__ void xcd_barrier_complete(unsigned* bar, unsigned x, unsigned& nloc, unsigned& nx) {
    const unsigned G = gridDim.x * gridDim.y * gridDim.z;
    unsigned sum, cnt, mine, sp = 0u;
    for (;;) {
        sum = 0u; cnt = 0u; mine = 0u;
#pragma unroll
        for (unsigned j = 0; j < 16; ++j) { const unsigned c = xb_ld(&bar[XB_XCNT(j)]); sum += c; cnt += (c > 0u) ? 1u : 0u; mine = (j == x) ? c : mine; }
        if (sum == G) break;
        __builtin_amdgcn_s_sleep(1);
        if ((++sp & 255u) == 0u) { if (xb_ld(&bar[XB_TMO])) break; if (sp > XB_SPIN_CAP) { atomicAdd(&bar[XB_TMO], 1u); break; } }
    }
    nloc = mine > 0u ? mine : 1u; nx = cnt > 0u ? cnt : 1u;
}

__device__ __forceinline__ void xcd_barrier(const XcdBarrier& b, const bool is_t0  ) {
    asm volatile("s_waitcnt vmcnt(0)" ::: "memory");
    __syncthreads();
    if (is_t0) {
        unsigned* bar = b.bar;
        __builtin_amdgcn_s_waitcnt(0);
        unsigned nloc = b.st[0], nx = b.st[1];
        if (nloc == 0u) { xcd_barrier_complete(bar, b.x, nloc, nx); b.st[0] = nloc; b.st[1] = nx; }
        const unsigned old = xb_add(&bar[XB_XSUB(b.x)], 1u);
        const unsigned gen = old / nloc;
        if (old + 1u == (gen + 1u) * nloc) {
            __builtin_amdgcn_fence(__ATOMIC_RELEASE, "agent");
            asm volatile("s_waitcnt vmcnt(0)" ::: "memory");
            const unsigned og = xb_add(&bar[XB_TOP], 1u);
            const unsigned tg = og / nx;
            if (og + 1u == (tg + 1u) * nx) xb_add(&bar[XB_TOPGEN], 1u);
            else XB_SPIN(xb_ld(&bar[XB_TOPGEN]) == tg, bar);
            __builtin_amdgcn_fence(__ATOMIC_ACQUIRE, "agent");
            xb_add(&bar[XB_XGEN(b.x)], 1u);
            asm volatile("s_waitcnt vmcnt(0)" ::: "memory");
        } else {
            XB_SPIN(xb_ld(&bar[XB_XGEN(b.x)]) == gen, bar);
            __builtin_amdgcn_fence(__ATOMIC_ACQUIRE, "agent");
            asm volatile("s_waitcnt vmcnt(0)" ::: "memory");
        }
    }
    __syncthreads();
}
struct EpiResBf16 {
    static constexpr bool PERM = true, AFTER_DRAIN = false;
    const bf16* xin; bf16* yp; float alpha, rs;
    DI void operator()(const pg8::f32x4 (&acc)[2][2][4][2], const pg8::Unit& u, int wr, int wc, int fr, int fq) const {
        const int row0 = u.pm * 256 + wr * 64 + fr, col0 = u.pn * 256 + wc * 32 + 8 * fq;
#pragma unroll
        for (int ai = 0; ai < 2; ++ai)
#pragma unroll
            for (int m = 0; m < 4; ++m) {
                const size_t ro = (size_t)(row0 + ai * 128 + m * 16) * DM;
#pragma unroll
                for (int bj = 0; bj < 2; ++bj) {
                    const size_t o = ro + col0 + bj * 128;
                    const v4u xv = *(const v4u*)(xin + o);
                    const f32x4 a0 = acc[ai][bj][m][0] * rs, a1 = acc[ai][bj][m][1] * rs;
                    v4u w;
                    w.x = cvtpk(bf2f(xv.x & 0xffffu) * alpha + a0[0], bf2f(xv.x >> 16) * alpha + a0[1]); w.y = cvtpk(bf2f(xv.y & 0xffffu) * alpha + a0[2], bf2f(xv.y >> 16) * alpha + a0[3]);
                    w.z = cvtpk(bf2f(xv.z & 0xffffu) * alpha + a1[0], bf2f(xv.z >> 16) * alpha + a1[1]); w.w = cvtpk(bf2f(xv.w & 0xffffu) * alpha + a1[2], bf2f(xv.w >> 16) * alpha + a1[3]);
                    *(v4u*)(yp + o) = w;
                }
            }
    }
};
struct EpiSwiglu {
    static constexpr bool PERM = true, AFTER_DRAIN = false;
    unsigned char* act; const float* bgu;
    DI void operator()(const pg8::f32x4 (&acc)[2][2][4][2], const pg8::Unit& u, int wr, int wc, int fr, int fq) const {
        const int e = u.pn >> 3, pl = u.pn & 7;
        const int row0 = u.pm * 256 + wr * 64 + fr, cih = pl * 128 + wc * 32 + 8 * fq;
        const float* bg = bgu + e * 2048 + cih;
        const f32x4 bg0 = *(const f32x4*)(bg), bg1 = *(const f32x4*)(bg + 4), bu0 = *(const f32x4*)(bg + 1024), bu1 = *(const f32x4*)(bg + 1028);
#pragma unroll
        for (int ai = 0; ai < 2; ++ai)
#pragma unroll
            for (int m = 0; m < 4; ++m) {
                constexpr float RS = 1.f / (F8_SX * F8_SWG);
                const f32x4 g0 = acc[ai][0][m][0] * RS + bg0, g1 = acc[ai][0][m][1] * RS + bg1, u0 = acc[ai][1][m][0] * RS + bu0, u1 = acc[ai][1][m][1] * RS + bu1;
                float r[8];
#pragma unroll
                for (int i = 0; i < 8; ++i) {
                    float g = i < 4 ? g0[i & 3] : g1[i & 3], uu = i < 4 ? u0[i & 3] : u1[i & 3];
                    g = fminf(g, 7.0f); uu = fminf(fmaxf(uu, -7.0f), 7.0f);
                    const float sg = __builtin_amdgcn_rcpf(1.0f + ex2(-1.702f * LOG2E * g));
                    r[i] = (uu + 1.0f) * g * sg * F8_SA;
                }
                v2u w; w.x = pk4_fp8(r[0], r[1], r[2], r[3]); w.y = pk4_fp8(r[4], r[5], r[6], r[7]);
                *(v2u*)(act + (size_t)(row0 + ai * 128 + m * 16) * DM + cih) = w;
            }
    }
};
struct EpiDown {
    static constexpr bool PERM = true, AFTER_DRAIN = false;
    unsigned char* yr; const float* bdn;
    DI void operator()(const pg8::f32x4 (&acc)[2][2][4][2], const pg8::Unit& u, int wr, int wc, int fr, int fq) const {
        const int e = u.pn >> 2, pl = u.pn & 3;
        const int row0 = u.pm * 256 + wr * 64 + fr, col0 = pl * 256 + wc * 32 + 8 * fq;
        f32x4 bv[2][2];
#pragma unroll
        for (int bj = 0; bj < 2; ++bj) { bv[bj][0] = *(const f32x4*)(bdn + e * 1024 + col0 + bj * 128) * F8_SY; bv[bj][1] = *(const f32x4*)(bdn + e * 1024 + col0 + bj * 128 + 4) * F8_SY; }
#pragma unroll
        for (int ai = 0; ai < 2; ++ai)
#pragma unroll
            for (int m = 0; m < 4; ++m) {
                unsigned char* rp = yr + (size_t)(row0 + ai * 128 + m * 16) * DM + col0;
#pragma unroll
                for (int bj = 0; bj < 2; ++bj) {
                    constexpr float RS = F8_SY / (F8_SA * F8_SWD);
                    const f32x4 v0 = acc[ai][bj][m][0] * RS + bv[bj][0], v1 = acc[ai][bj][m][1] * RS + bv[bj][1];
                    v2u w; w.x = pk4_fp8(v0[0], v0[1], v0[2], v0[3]); w.y = pk4_fp8(v1[0], v1[1], v1[2], v1[3]);
                    *(v2u*)(rp + bj * 128) = w;
                }
            }
    }
};
struct GroupOrder {
    LAS const unsigned* tile_e; int ntiles, lg, G, c; LAS const unsigned short* srcl;
    DI bool next(int i, pg8::Unit& u) const {
        int pm, pl;
        if (G == 256) {
            const int x = c & 7, k = c >> 3; pm = i * (256 >> lg) + x * (32 >> lg) + (k >> lg); pl = k & ((1 << lg) - 1); if (pm >= ntiles) return false; }
        else { const long L = (long)i * G + c; if (L >= ((long)ntiles << lg)) return false; pm = (int)(L >> lg); pl = (int)(L & ((1 << lg) - 1)); }
        const int e = __builtin_amdgcn_readfirstlane((int)tile_e[pm]);
        u.pm = pm; u.pn = (e << lg) + pl; return true;
    }
    DI void a_ready(const pg8::Unit&) const {}
    DI void done(const pg8::Unit&) const {}
    DI unsigned gsrc(int ui, int r) const { return (unsigned)srcl[ui * 256 + r] << 10; }
};
struct Args { const float* in[18]; float* out; unsigned char* ws; int ph_lo, ph_hi; };
struct Fr { LAS unsigned char* lds; unsigned char* ws; unsigned* ctl; int tid, lane, wave, blk, G; };

DI void tr_item(const float* W, int ldw, int K, int k0, int sc0, int nvalid, bf16* WT, int drow0, LAS float* scr, int lane) {
    const int c = lane & 31;
    float v[32];
#pragma unroll
    for (int i = 0; i < 32; ++i) v[i] = (c < nvalid) ? W[(size_t)(k0 + 2 * i + (lane >> 5)) * ldw + sc0 + c] : 0.f;
#pragma unroll
    for (int i = 0; i < 32; ++i) scr[(2 * i + (lane >> 5)) * 33 + c] = v[i];
    LDS_WAIT(); asm volatile("" ::: "memory");
    const int c8 = lane & 7;
#pragma unroll
    for (int j = 0; j < 4; ++j) { const int n = (lane >> 3) + 8 * j; const LAS float* s = scr + (8 * c8) * 33 + n;
        v4u o; o.x = cvtpk(s[0 * 33], s[1 * 33]); o.y = cvtpk(s[2 * 33], s[3 * 33]); o.z = cvtpk(s[4 * 33], s[5 * 33]); o.w = cvtpk(s[6 * 33], s[7 * 33]);
        *(v4u*)(WT + (size_t)(drow0 + n) * K + k0 + 8 * c8) = o; }
    LDS_WAIT(); asm volatile("" ::: "memory");
}
DI void tr_item8(const float* W, int ldw, int K, int k0, int sc0, float scale, unsigned char* WT8, int drow0, LAS float* scr, int lane) {
    const int c = lane & 31;
    float v[32];
#pragma unroll
    for (int i = 0; i < 32; ++i) v[i] = W[(size_t)(k0 + 2 * i + (lane >> 5)) * ldw + sc0 + c];
#pragma unroll
    for (int i = 0; i < 32; ++i) scr[(2 * i + (lane >> 5)) * 33 + c] = v[i] * scale;
    LDS_WAIT(); asm volatile("" ::: "memory");
    const int c16 = lane & 3;
#pragma unroll
    for (int j = 0; j < 2; ++j) { const int n = (lane >> 2) + 16 * j; const LAS float* s = scr + (16 * c16) * 33 + n;
        v4u o; o.x = pk4_fp8(s[0 * 33], s[1 * 33], s[2 * 33], s[3 * 33]); o.y = pk4_fp8(s[4 * 33], s[5 * 33], s[6 * 33], s[7 * 33]);
        o.z = pk4_fp8(s[8 * 33], s[9 * 33], s[10 * 33], s[11 * 33]); o.w = pk4_fp8(s[12 * 33], s[13 * 33], s[14 * 33], s[15 * 33]);
        *(v4u*)(WT8 + (size_t)(drow0 + n) * K + k0 + 16 * c16) = o; }
    LDS_WAIT(); asm volatile("" ::: "memory");
}
DI void ph_prologue(const Args& a, const Fr& F) {
    LAS float* scr = (LAS float*)(F.lds + F.wave * 16384);
    const int gw = F.blk * NWAVES + F.wave, NGW = F.G * NWAVES;
    constexpr int I_EV = 2 * 16 * 80, I_OD = 2 * 16 * 96, I_WO = 4 * 16 * 32;
    constexpr int NITEMS = I_EV + I_OD + I_WO;
    bf16* wev = (bf16*)(F.ws + WS_WEV); bf16* wod = (bf16*)(F.ws + WS_WOD); bf16* wout = (bf16*)(F.ws + WS_WOUT);
    unsigned char* wgu = F.ws + WS_WGU; unsigned char* wdn = F.ws + WS_WDN;
    for (int it = gw; it < NITEMS; it += NGW) {
        int r = it;
        if (r < I_EV) { const int l = r / 1280; r %= 1280; const int kb = r / 80, n0 = (r % 80) * 32; int sc0, nv = 32;
            if (n0 < 512) sc0 = n0; else if (n0 < 1024) sc0 = 964 + (n0 - 512); else if (n0 < 1536) sc0 = 1476 + (n0 - 1024); else if (n0 < 2048) sc0 = 1988 + (n0 - 1536);
            else if (n0 < 2176) sc0 = 512 + (n0 - 2048); else if (n0 < 2432) sc0 = 640 + (n0 - 2176); else if (n0 < 2496) sc0 = 896 + (n0 - 2432);
            else if (n0 < 2528) { sc0 = 960; nv = 4; } else { sc0 = 0; nv = 0; }
            tr_item(a.in[1] + (size_t)l * 1024 * 2500, 2500, 1024, kb * 64, sc0, nv, wev + (size_t)l * EV_N * 1024, n0, scr, F.lane); continue; }
        r -= I_EV;
        if (r < I_OD) { const int l = r / 1536; r %= 1536; const int kb = r / 96, n0 = (r % 96) * 32;
            tr_item(a.in[6] + (size_t)l * 1024 * 3088, 3088, 1024, kb * 64, n0, 32, wod + (size_t)l * OD_N * 1024, n0, scr, F.lane); continue; }
        r -= I_OD;
        if (r < I_WO) { const int l = r / 512; r %= 512; const int kb = r / 32, n0 = (r % 32) * 32;
            const float* src = (l & 1) ? a.in[8] + (size_t)(l >> 1) * 1024 * 1024 : a.in[5] + (size_t)(l >> 1) * 1024 * 1024;
            tr_item8(src, 1024, 1024, kb * 64, n0, F8_SWO, (unsigned char*)wout + (size_t)l * 1024 * 1024, n0, scr, F.lane); continue; }
    }
    { __syncthreads();
        LAS float* tile = (LAS float*)F.lds; unsigned char* wgu8 = F.ws + WS_WGU; unsigned char* wdn8 = F.ws + WS_WDN;
        constexpr int T_GU = 128 * 8 * 16, T_DN = 128 * 8 * 8, T_ALL = T_GU + T_DN;
        const int tid = F.tid, c4 = tid & 31, r0 = tid >> 5;
        f32x4 v[8];
        auto locate = [&](int t, const float*& src, int& ldw, unsigned char*& dst, float& scale) {
            if (t < T_GU) { const int le = t >> 7, r = t & 127, kb = r >> 4, nb = r & 15, n0 = nb * 128; const int pn = n0 >> 8, bj = (n0 >> 7) & 1;
                src = a.in[14] + (size_t)le * 1024 * 2048 + (size_t)(kb * 128) * 2048 + bj * 1024 + pn * 128; ldw = 2048; dst = wgu8 + (size_t)le * 2048 * 1024 + (size_t)n0 * 1024 + kb * 128; scale = F8_SWG; }
            else { const int u = t - T_GU, le = u >> 6, r = u & 63, kb = r >> 3, nb = r & 7;
                src = a.in[16] + (size_t)le * 1024 * 1024 + (size_t)(kb * 128) * 1024 + nb * 128; ldw = 1024; dst = wdn8 + (size_t)le * 1024 * 1024 + (size_t)(nb * 128) * 1024 + kb * 128; scale = F8_SWD; } };
        int t = F.blk;
        if (t < T_ALL) { const float* src; int ldw; unsigned char* dst; float sc; locate(t, src, ldw, dst, sc);
#pragma unroll
            for (int i = 0; i < 8; ++i) v[i] = *(const f32x4*)(src + (size_t)(r0 + 16 * i) * ldw + 4 * c4); }
        for (; t < T_ALL; t += F.G) {
            const float* src; int ldw; unsigned char* dst; float sc; locate(t, src, ldw, dst, sc);
#pragma unroll
            for (int i = 0; i < 8; ++i) { LAS float* tp = tile + (r0 + 16 * i) * 129 + 4 * c4; tp[0] = v[i][0] * sc; tp[1] = v[i][1] * sc; tp[2] = v[i][2] * sc; tp[3] = v[i][3] * sc; }
            __syncthreads();
            if (t + F.G < T_ALL) { const float* s2; int l2; unsigned char* d2; float c2; locate(t + F.G, s2, l2, d2, c2);
#pragma unroll
                for (int i = 0; i < 8; ++i) v[i] = *(const f32x4*)(s2 + (size_t)(r0 + 16 * i) * l2 + 4 * c4); }
#pragma unroll
            for (int j = 0; j < 2; ++j) { const int p = tid + 512 * j, kc = p & 7, n = p >> 3; const LAS float* sp = tile + (kc * 16) * 129 + n;
                v4u o; o.x = pk4_fp8(sp[0], sp[129], sp[2 * 129], sp[3 * 129]); o.y = pk4_fp8(sp[4 * 129], sp[5 * 129], sp[6 * 129], sp[7 * 129]);
                o.z = pk4_fp8(sp[8 * 129], sp[9 * 129], sp[10 * 129], sp[11 * 129]); o.w = pk4_fp8(sp[12 * 129], sp[13 * 129], sp[14 * 129], sp[15 * 129]);
                *(v4u*)(dst + (size_t)n * 1024 + kc * 16) = o; }
            __syncthreads();
        }
    }
    bf16* xb = (bf16*)(F.ws + WS_XB);
    for (int m = gw; m < NTOK; m += NGW) {
        const f32x4* xr = (const f32x4*)(a.in[0] + (size_t)m * DM) + F.lane; v2u* o = (v2u*)(xb + (size_t)m * DM) + F.lane;
#pragma unroll
        for (int j = 0; j < 4; ++j) { const f32x4 v = xr[64 * j]; v2u w; w.x = cvtpk(v[0], v[1]); w.y = cvtpk(v[2], v[3]); o[64 * j] = w; }
    }
    bf16* wukt = (bf16*)(F.ws + WS_WUKT); bf16* wuvt = (bf16*)(F.ws + WS_WUVT);
    for (int i = F.blk * NTHR + F.tid; i < 2 * 8 * 128 * 64; i += F.G * NTHR) {
        { const int d = i & 63, c = (i >> 6) & 127, lh = i >> 13; wukt[i] = (bf16)f2bf(a.in[2][((size_t)lh * 64 + d) * 128 + c]); }
        { const int c = i & 127, d = (i >> 7) & 63, lh = i >> 13; wuvt[i] = (bf16)f2bf(a.in[3][((size_t)lh * 128 + c) * 64 + d]); }
    }
}

DI void ln_row(f32x4 (&v)[4], const float* g, const float* b, int lane) {
    float s = 0.f;
#pragma unroll
    for (int j = 0; j < 4; ++j) s += (v[j][0] + v[j][1]) + (v[j][2] + v[j][3]);
    const float mean = wave_sum(s) * (1.f / DM); float s2 = 0.f;
#pragma unroll
    for (int j = 0; j < 4; ++j) { v[j] = v[j] - mean; s2 += (v[j][0] * v[j][0] + v[j][1] * v[j][1]) + (v[j][2] * v[j][2] + v[j][3] * v[j][3]); }
    const float rstd = 1.f / sqrtf(wave_sum(s2) * (1.f / DM) + LN_EPS);
#pragma unroll
    for (int j = 0; j < 4; ++j) { const f32x4 gg = *((const f32x4*)g + lane + 64 * j), bb = *((const f32x4*)b + lane + 64 * j); v[j] = v[j] * rstd * gg + bb; }
}
DI void ln_row_r(f32x4 (&v)[4], const f32x4 (&gg)[4], const f32x4 (&bb)[4]) {
    float s = 0.f;
#pragma unroll
    for (int j = 0; j < 4; ++j) s += (v[j][0] + v[j][1]) + (v[j][2] + v[j][3]);
    const float mean = wave_sum(s) * (1.f / DM); float s2 = 0.f;
#pragma unroll
    for (int j = 0; j < 4; ++j) { v[j] = v[j] - mean; s2 += (v[j][0] * v[j][0] + v[j][1] * v[j][1]) + (v[j][2] * v[j][2] + v[j][3] * v[j][3]); }
    const float rstd = 1.f / sqrtf(wave_sum(s2) * (1.f / DM) + LN_EPS);
#pragma unroll
    for (int j = 0; j < 4; ++j) v[j] = v[j] * rstd * gg[j] + bb[j];
}
DI void store_row_f32(float* p, const f32x4 (&v)[4], int lane) {
#pragma unroll
    for (int j = 0; j < 4; ++j) *((f32x4*)p + lane + 64 * j) = v[j];
}
DI void store_row_bf16(bf16* p, const f32x4 (&v)[4], int lane) {
#pragma unroll
    for (int j = 0; j < 4; ++j) { v2u w; w.x = cvtpk(v[j][0], v[j][1]); w.y = cvtpk(v[j][2], v[j][3]); *((v2u*)p + lane + 64 * j) = w; }
}
template <int NL> DI void small_proj(LAS const float* xs, const float* W, int ldw, int lane, float (&acc)[4]) {
    constexpr int PARTS = 64 / NL, DPER = 1024 / PARTS;
    const int n = lane & (NL - 1), part = lane / NL;
    acc[0] = acc[1] = acc[2] = acc[3] = 0.f;
    const float* wp = W + (size_t)(part * DPER) * ldw + n;
    LAS const float* xp = xs + part * DPER;
#pragma unroll 8
    for (int d = 0; d < DPER; ++d) { const float w = wp[(size_t)d * ldw];
        acc[0] += w * xp[d]; acc[1] += w * xp[1024 + d]; acc[2] += w * xp[2048 + d]; acc[3] += w * xp[3072 + d]; }
#pragma unroll
    for (int o = NL; o < 64; o <<= 1) {
#pragma unroll
        for (int k = 0; k < 4; ++k) acc[k] += __shfl_xor(acc[k], o); }
}

DI void ph_even_prep(const Args& a, const Fr& F, int j) {
    const bf16* proj = (const bf16*)(F.ws + WS_PROJ);
    bf16* ckvn = (bf16*)(F.ws + WS_CKVN); bf16* ql = (bf16*)(F.ws + WS_QL); float* kbar = (float*)(F.ws + WS_KBAR);
    const float* kvg = a.in[4] + j * 128;
    const bf16* wukt = (const bf16*)(F.ws + WS_WUKT) + (size_t)j * 8 * 128 * 64;
    const int lane = F.lane, wave = F.wave;
    for (int chunk = F.blk; chunk < 256; chunk += F.G) {
        const int tok0 = chunk * 128;
#pragma unroll 1
        for (int i0 = 0; i0 < 16; i0 += 8) { unsigned wv[8];
#pragma unroll
            for (int i = 0; i < 8; ++i) wv[i] = *((const unsigned*)(proj + (size_t)(tok0 + wave * 16 + i0 + i) * EV_N + EC_CKV) + lane);
#pragma unroll
            for (int i = 0; i < 8; ++i) { const int tok = tok0 + wave * 16 + i0 + i; const float v0 = bf2f(wv[i] & 0xffffu), v1 = bf2f(wv[i] >> 16);
                const float ss = wave_sum(v0 * v0 + v1 * v1);
                const float r = 1.f / sqrtf(ss * (1.f / 128.f) + LN_EPS);
                *((unsigned*)(ckvn + (size_t)tok * 128) + lane) = cvtpk(v0 * r * kvg[2 * lane], v1 * r * kvg[2 * lane + 1]); } }
        { bf16* kic = (bf16*)(F.ws + WS_KIC); const int tok = tok0 + wave * 16 + (lane >> 2), c = (lane & 3) * 16;
            const v4u* src = (const v4u*)(proj + (size_t)tok * EV_N + EC_KI + c); v4u* dst = (v4u*)(kic + (size_t)tok * 64 + c); dst[0] = src[0]; dst[1] = src[1]; }
        { const int h = wave, l15 = lane & 15, kg = lane >> 4;
            bf16x8 af[8][2];
#pragma unroll
            for (int ct = 0; ct < 8; ++ct)
#pragma unroll
                for (int ks = 0; ks < 2; ++ks) af[ct][ks] = *(const bf16x8*)(wukt + ((size_t)h * 128 + ct * 16 + l15) * 64 + ks * 32 + kg * 8);
#pragma unroll 1
            for (int tg = 0; tg < 8; tg += 4) { bf16x8 qf[4][2];
#pragma unroll
                for (int u = 0; u < 4; ++u)
#pragma unroll
                    for (int ks = 0; ks < 2; ++ks) qf[u][ks] = *(const bf16x8*)(proj + (size_t)(tok0 + (tg + u) * 16 + l15) * EV_N + EC_QA + h * 64 + ks * 32 + kg * 8);
#pragma unroll
                for (int u = 0; u < 4; ++u) { const int tok = tok0 + (tg + u) * 16 + l15;
#pragma unroll
                    for (int ct = 0; ct < 8; ++ct) { f32x4 d = {0.f, 0.f, 0.f, 0.f};
                        d = mfma16(af[ct][0], qf[u][0], d); d = mfma16(af[ct][1], qf[u][1], d);
                        v2u w; w.x = cvtpk(d[0], d[1]); w.y = cvtpk(d[2], d[3]);
                        *(v2u*)(ql + (size_t)tok * 1024 + h * 128 + ct * 16 + 4 * kg) = w; } } } }
        if (chunk < 128) { const int b = chunk >> 5, n = chunk & 31; float s8[8];
#pragma unroll
            for (int k = 0; k < 8; ++k) s8[k] = 0.f;
            const bf16* kp = proj + ((size_t)b * SEQ + n * 256 + wave * 32) * EV_N + EC_KB + lane * 8;
#pragma unroll 8
            for (int r = 0; r < 32; ++r) { const v4u w = *(const v4u*)(kp + (size_t)r * EV_N);
#pragma unroll
                for (int k = 0; k < 4; ++k) { s8[2 * k] += bf2f(w[k] & 0xffffu); s8[2 * k + 1] += bf2f(w[k] >> 16); } }
            LAS float* red = (LAS float*)F.lds;
            __syncthreads();
#pragma unroll
            for (int k = 0; k < 8; ++k) red[wave * 512 + lane * 8 + k] = s8[k];
            __syncthreads();
            float s = 0.f;
#pragma unroll
            for (int w = 0; w < 8; ++w) s += red[w * 512 + F.tid];
            const int h = F.tid >> 6, d = F.tid & 63;
            kbar[(((size_t)b * 8 + h) * 32 + n) * 64 + d] = s * (1.f / 256.f); }
    }
}

DI void moba_gate_chunk(const Fr& F, int chunk) {
    const bf16* proj = (const bf16*)(F.ws + WS_PROJ); const float* kbar = (const float*)(F.ws + WS_KBAR); unsigned* sel3 = (unsigned*)(F.ws + WS_SEL3);
    const int tok0 = chunk * 128, b = tok0 / SEQ, own = (tok0 % SEQ) >> 8, h = F.wave, lane = F.lane;
    float q0[64], q1[64];
    { const v4u* p0 = (const v4u*)(proj + (size_t)(tok0 + lane) * EV_N + EC_QB + h * 64); const v4u* p1 = (const v4u*)(proj + (size_t)(tok0 + 64 + lane) * EV_N + EC_QB + h * 64);
#pragma unroll
        for (int i = 0; i < 8; ++i) { const v4u w0 = p0[i], w1 = p1[i];
#pragma unroll
            for (int k = 0; k < 4; ++k) { q0[8 * i + 2 * k] = bf2f(w0[k] & 0xffffu); q0[8 * i + 2 * k + 1] = bf2f(w0[k] >> 16); q1[8 * i + 2 * k] = bf2f(w1[k] & 0xffffu); q1[8 * i + 2 * k + 1] = bf2f(w1[k] >> 16); } } }
    float a0 = -INFINITY, a1 = -INFINITY, a2 = -INFINITY, c0 = -INFINITY, c1 = -INFINITY, c2 = -INFINITY; int ai0 = 0, ai1 = 0, ai2 = 0, ci0 = 0, ci1 = 0, ci2 = 0;
    const float* kb = kbar + (((size_t)b * 8 + h) * 32) * 64;
    for (int n = 0; n < own; ++n) { float g0 = 0.f, g1 = 0.f;
#pragma unroll
        for (int d = 0; d < 64; d += 4) { const f32x4 kv = *(const f32x4*)(kb + n * 64 + d);
#pragma unroll
            for (int k = 0; k < 4; ++k) { g0 += q0[d + k] * kv[k]; g1 += q1[d + k] * kv[k]; } }
        if (g0 > a2) { if (g0 > a1) { a2 = a1; ai2 = ai1; if (g0 > a0) { a1 = a0; ai1 = ai0; a0 = g0; ai0 = n; } else { a1 = g0; ai1 = n; } } else { a2 = g0; ai2 = n; } }
        if (g1 > c2) { if (g1 > c1) { c2 = c1; ci2 = ci1; if (g1 > c0) { c1 = c0; ci1 = ci0; c0 = g1; ci0 = n; } else { c1 = g1; ci1 = n; } } else { c2 = g1; ci2 = n; } }
    }
    const unsigned nv = own < 3 ? own : 3;
    sel3[(size_t)(tok0 + lane) * 8 + h] = (unsigned)ai0 | ((unsigned)ai1 << 8) | ((unsigned)ai2 << 16) | (nv << 24);
    sel3[(size_t)(tok0 + 64 + lane) * 8 + h] = (unsigned)ci0 | ((unsigned)ci1 << 8) | ((unsigned)ci2 << 16) | (nv << 24);
}

constexpr int HS = 257;
DI float relu1(float x) { const unsigned u = __float_as_uint(x); return __uint_as_float(u & ~(unsigned)((int)u >> 31)); }
template <int MODE, bool DIAG> DI void idx_tile(const bf16x8 (&kf)[4], LAS const char* qb  , const float (&wj)[4], int kt, int q, int hi, unsigned c0, unsigned c1,
                                     LAS unsigned* hist, LAS unsigned* mask, LAS unsigned* cmask, LAS unsigned long long* cand, LAS unsigned* rinfo) {
    f32x2 scp[8];
#pragma unroll
    for (int p = 0; p < 8; ++p) scp[p] = (f32x2){0.f, 0.f};
    bf16x8 qv0[2][4], qv1[2][4];
#pragma unroll
    for (int j = 0; j < 2; ++j)
#pragma unroll
        for (int s = 0; s < 4; ++s) qv0[j][s] = *(LAS const bf16x8*)(qb + (j * 8 + s * 2) * 512);
#pragma unroll
    for (int j = 0; j < 2; ++j)
#pragma unroll
        for (int s = 0; s < 4; ++s) qv1[j][s] = *(LAS const bf16x8*)(qb + ((2 + j) * 8 + s * 2) * 512);
    __builtin_amdgcn_sched_barrier(0);
#pragma unroll
    for (int g = 0; g < 2; ++g) { f32x16 acc[2];
#pragma unroll
        for (int j = 0; j < 2; ++j)
#pragma unroll
            for (int r = 0; r < 16; ++r) acc[j][r] = 0.f;
#pragma unroll
        for (int s = 0; s < 4; ++s)
#pragma unroll
            for (int j = 0; j < 2; ++j) { if (MODE != -2) acc[j] = mfma32(kf[s], g == 0 ? qv0[j][s] : qv1[j][s], acc[j]); else acc[j][s] += __builtin_bit_cast(float, (unsigned)(kf[s][0] ^ (g == 0 ? qv0[j][s][0] : qv1[j][s][0]))); }
#pragma unroll
        for (int p = 0; p < 8; ++p)
#pragma unroll
            for (int j = 0; j < 2; ++j) { const f32x2 a = {relu1(acc[j][2 * p]), relu1(acc[j][2 * p + 1])}; const f32x2 w2 = {wj[2 * g + j], wj[2 * g + j]}; scp[p] = a * w2 + scp[p]; } }
    unsigned sel = 0u, cnd = 0u;
    if (MODE <= 0) { float t = 0.f;
#pragma unroll
        for (int p = 0; p < 8; ++p) t += scp[p][0] + scp[p][1];
        if (t == 12345.678f) __hip_atomic_fetch_or(mask + q * HS + kt, 1u, __ATOMIC_RELAXED, __HIP_MEMORY_SCOPE_WORKGROUP);
        return; }
    const float F0 = __uint_as_float(c0), F1 = __uint_as_float(c1);
#pragma unroll
    for (int r = 0; r < 16; ++r) { const int kr = crow(r, hi);
        const bool ok = !DIAG || kr <= q;
        const float scv = scp[r >> 1][r & 1]; const unsigned u = __float_as_uint(scv);
        if (MODE == 1) { const unsigned key = u ^ ((unsigned)((int)u >> 31) | 0x80000000u);
            if (ok && (key >> 24) >= c0) __hip_atomic_fetch_add(hist + q * HS + (key >> 24), 1u, __ATOMIC_RELAXED, __HIP_MEMORY_SCOPE_WORKGROUP); }
        else if (MODE == 2) { if (ok && (u >> 24) == c0) __hip_atomic_fetch_add(hist + q * HS + (((u >> 16) & 255u) ^ c1), 1u, __ATOMIC_RELAXED, __HIP_MEMORY_SCOPE_WORKGROUP); }
        else { const bool ge1 = scv >= F1, ge0 = scv >= F0;
            if (ok && ge1) sel |= 1u << kr;
            if (ok && ge0 && !ge1) { cnd |= 1u << kr; const unsigned key = u ^ ((unsigned)((int)u >> 31) | 0x80000000u);
                const unsigned pos = __hip_atomic_fetch_add(rinfo + 128 + q, 1u, __ATOMIC_RELAXED, __HIP_MEMORY_SCOPE_WORKGROUP);
                if (pos < 64u) cand[q * 64 + pos] = ((unsigned long long)key << 32) | (unsigned)(~(unsigned)(kt * 32 + kr)); } } }
    if (MODE == 3) { if (sel) __hip_atomic_fetch_or(mask + q * HS + kt, sel, __ATOMIC_RELAXED, __HIP_MEMORY_SCOPE_WORKGROUP);
        if (cnd) __hip_atomic_fetch_or(cmask + q * HS + kt, cnd, __ATOMIC_RELAXED, __HIP_MEMORY_SCOPE_WORKGROUP); }
}
#define IDX_LOAD(KF, I) do { int kt_l = wave + 8 * (I); kt_l = kt_l < nkt - 1 ? kt_l : nkt - 1; const bf16* kp_ = kp0 + (size_t)(kt_l * 32) * 64; _Pragma("unroll") for (int s_ = 0; s_ < 4; ++s_) KF[s_] = *(const bf16x8*)(kp_ + s_ * 16); } while (0)
#define IDX_ROT() do { _Pragma("unroll") for (int s_ = 0; s_ < 4; ++s_) { kfa[s_] = kfb[s_]; kfb[s_] = kfc[s_]; } } while (0)
template <int MODE> DI void idx_pass(const bf16* proj, int rowbase, int qt, LAS const char* qimg, const float (&wj)[4], LAS unsigned* hist, LAS unsigned* mask, LAS unsigned* cmask, LAS unsigned long long* cand, LAS unsigned* rinfo, int wave, int lane) {
    const int q = lane & 31, hi = lane >> 5, nkt = qt + 1;
    const unsigned b1 = MODE == 2 ? rinfo[160 + q] : rinfo[224 + q], thr16 = MODE == 2 ? rinfo[192 + q] : rinfo[256 + q];
    const bf16* kp0 = proj + (size_t)(rowbase + q) * 64 + hi * 8;
    LAS const char* qb = qimg + hi * 512 + q * 16;
    const int n_all = nkt > wave ? (nkt - wave + 7) >> 3 : 0;
    if (n_all == 0) return;
    const bool has_diag = (qt & 7) == wave; const int n = n_all - (has_diag ? 1 : 0);
    bf16x8 kfa[4], kfb[4], kfc[4];
#define IDX_TILE(KF, I) idx_tile<MODE, false>(KF, qb, wj, wave + 8 * (I), q, hi, b1, thr16, hist, mask, cmask, cand, rinfo)
    IDX_LOAD(kfa, 0); IDX_LOAD(kfb, 1); IDX_LOAD(kfc, 2);
    int i = 0;
    for (; i + 3 <= n; i += 3) { IDX_TILE(kfa, i); IDX_LOAD(kfa, i + 3); IDX_TILE(kfb, i + 1); IDX_LOAD(kfb, i + 4); IDX_TILE(kfc, i + 2); IDX_LOAD(kfc, i + 5); }
#pragma unroll 1
    for (; i < n; ++i) { IDX_TILE(kfa, i); IDX_ROT(); }
    if (has_diag) idx_tile<MODE, true>(kfa, qb, wj, qt, q, hi, b1, thr16, hist, mask, cmask, cand, rinfo);
#undef IDX_TILE
}
DI void hist_pick(LAS const unsigned* hrow, unsigned need, int lane, unsigned& bin, unsigned& above) {
    unsigned h4[4];
#pragma unroll
    for (int k = 0; k < 4; ++k) h4[k] = hrow[4 * lane + k];
    const unsigned ssum = h4[0] + h4[1] + h4[2] + h4[3];
    unsigned x = ssum;
#pragma unroll
    for (int o = 1; o < 64; o <<= 1) { const unsigned y = __shfl_down(x, o); if (lane + o < 64) x += y; }
    const unsigned long long m = __ballot(x >= need);
    const int Ls = m ? 63 - __builtin_clzll(m) : 0;
    const unsigned xs = __shfl(x, Ls), ss = __shfl(ssum, Ls);
    const unsigned h0 = __shfl(h4[0], Ls), h1 = __shfl(h4[1], Ls), h2 = __shfl(h4[2], Ls), h3 = __shfl(h4[3], Ls);
    unsigned cum = xs - ss;
    if (cum + h3 >= need) { bin = 4 * Ls + 3; above = cum; return; } cum += h3;
    if (cum + h2 >= need) { bin = 4 * Ls + 2; above = cum; return; } cum += h2;
    if (cum + h1 >= need) { bin = 4 * Ls + 1; above = cum; return; } cum += h1;
    bin = 4 * Ls; above = cum; (void)h0;
}
DI void idx_pass1(const bf16* proj, int rowbase, int qt, LAS const char* qimg, const float (&wj)[4], LAS unsigned* hist, LAS unsigned* mask, LAS unsigned* cmask, LAS unsigned long long* cand, LAS unsigned* rinfo, int wave, int lane) {
    const int q = lane & 31, hi = lane >> 5, nkt = qt + 1, nmax = (nkt + 7) >> 3;
    const bf16* kp0 = proj + (size_t)(rowbase + q) * 64 + hi * 8;
    LAS const char* qb = qimg + hi * 512 + q * 16;
    unsigned lb = 0u;
    bf16x8 kfa[4], kfb[4], kfc[4];
#define IDX_TILE(KF, I) idx_tile<1, false>(KF, qb, wj, wave + 8 * (I), q, hi, lb, 0u, hist, mask, cmask, cand, rinfo)
#define IDX_LBUP(I) do { const int i_ = (I); if (((i_ + 1) & i_) == 0 && i_ + 1 < nmax && i_ < 16) {        \
            __syncthreads(); \
            _Pragma("unroll 1") for (int rr = 0; rr < 4; ++rr) { const int row = wave * 4 + rr; unsigned bin, above; hist_pick(hist + row * HS, 256u, lane, bin, above); if (lane == 0) rinfo[288 + row] = bin; } \
            __syncthreads(); \
            { const unsigned nb = rinfo[288 + q]; lb = nb > lb ? nb : lb; } } } while (0)
    IDX_LOAD(kfa, 0); IDX_LOAD(kfb, 1); IDX_LOAD(kfc, 2);
    int i = 0;
    for (; i + 3 <= nmax - 1; i += 3) { IDX_TILE(kfa, i); IDX_LOAD(kfa, i + 3); IDX_LBUP(i); IDX_TILE(kfb, i + 1); IDX_LOAD(kfb, i + 4); IDX_LBUP(i + 1); IDX_TILE(kfc, i + 2); IDX_LOAD(kfc, i + 5); IDX_LBUP(i + 2); }
#pragma unroll 1
    for (; i < nmax - 1; ++i) { IDX_TILE(kfa, i); IDX_ROT(); IDX_LBUP(i); }
    { const int kt = wave + 8 * (nmax - 1);
        if (kt < nkt) { if (kt == qt) idx_tile<1, true>(kfa, qb, wj, kt, q, hi, lb, 0u, hist, mask, cmask, cand, rinfo); else IDX_TILE(kfa, nmax - 1); } }
#undef IDX_TILE
#undef IDX_LBUP
}
#undef IDX_LOAD
#undef IDX_ROT
DI void idx_unit(const Fr& F, int b, int qt, int stop = 0  ) {
    const bf16* proj = (const bf16*)(F.ws + WS_PROJ); const bf16* kic = (const bf16*)(F.ws + WS_KIC); unsigned short* sel = (unsigned short*)(F.ws + WS_SEL);
    LAS unsigned* hist = (LAS unsigned*)(F.lds); LAS unsigned* mask = hist + 32 * HS; LAS unsigned* cmask = mask + 32 * HS;
    LAS unsigned long long* cand = (LAS unsigned long long*)(F.lds + 99328); LAS unsigned* rinfo = (LAS unsigned*)(F.lds + 115712);
    const int lane = F.lane, wave = F.wave, tid = F.tid, t0 = qt * 32, rowbase = b * SEQ;
    __syncthreads();
    for (int i = tid; i < 3 * 32 * HS; i += NTHR) hist[i] = 0u;
    if (tid < 320) rinfo[tid] = 0u;
    __syncthreads();
    if (t0 + 31 <= 255 || (EXPF & 64)) {
        if (lane < 8) {
#pragma unroll
            for (int rr = 0; rr < 4; ++rr) { const int row = wave * 4 + rr, nv = t0 + row + 1;
                const int nv0 = t0 + row + 1; const int nvc = nv0 < 256 ? nv0 : 256; (void)nv; mask[row * HS + lane] = nvc >= 32 * (lane + 1) ? 0xffffffffu : (nvc > 32 * lane ? ((1u << (nvc - 32 * lane)) - 1u) : 0u); } }
    } else {
        const int q = lane & 31;
        float wj[4];
        { const bf16* qp = proj + (size_t)(rowbase + t0 + q) * EV_N;
#pragma unroll
            for (int j = 0; j < 4; ++j) wj[j] = bf2f(qp[EC_WI + j]); }
        LAS char* qimg = (LAS char*)(F.lds + 117248);
#pragma unroll
        for (int i = 0; i < 2; ++i) { const int p = tid + i * NTHR, row = p & 31, c = p >> 5;
            *(LAS v4u*)(qimg + c * 512 + row * 16) = *(const v4u*)(proj + (size_t)(rowbase + t0 + row) * EV_N + EC_QI + c * 8); }
        __syncthreads();
        if (stop == 7) return;
        idx_pass1(kic, rowbase, qt, qimg, wj, hist, mask, cmask, cand, rinfo, wave, lane);
        __syncthreads();
#pragma unroll 1
        for (int rr = 0; rr < 4; ++rr) { const int row = wave * 4 + rr; unsigned bin, above; hist_pick(hist + row * HS, 256u, lane, bin, above);
            if (lane == 0) { rinfo[row] = bin; rinfo[32 + row] = 256u - above; rinfo[160 + row] = bin >= 128u ? bin - 128u : 255u - bin; rinfo[192 + row] = bin >= 128u ? 0u : 255u; } }
        __syncthreads();
        if (stop == 1) return;
        for (int i = tid; i < 32 * HS; i += NTHR) hist[i] = 0u;
        __syncthreads();
        idx_pass<2>(kic, rowbase, qt, qimg, wj, hist, mask, cmask, cand, rinfo, wave, lane);
        __syncthreads();
#pragma unroll 1
        for (int rr = 0; rr < 4; ++rr) { const int row = wave * 4 + rr; const unsigned need1 = rinfo[32 + row]; unsigned bin, above; hist_pick(hist + row * HS, need1, lane, bin, above);
            if (lane == 0) { const unsigned t16 = (rinfo[row] << 8) | bin, k0 = t16 << 16, k1 = (t16 + 1u) << 16;
                rinfo[64 + row] = t16; rinfo[96 + row] = need1 - above;
                rinfo[224 + row] = (k0 & 0x80000000u) ? (k0 ^ 0x80000000u) : ~k0; rinfo[256 + row] = (t16 == 0xffffu) ? 0x7fc00000u : ((k1 & 0x80000000u) ? (k1 ^ 0x80000000u) : ~k1); } }
        __syncthreads();
        if (stop == 2) return;
        idx_pass<3>(kic, rowbase, qt, qimg, wj, hist, mask, cmask, cand, rinfo, wave, lane);
        __syncthreads();
        if (stop == 3) return;
#pragma unroll 1
        for (int rr = 0; rr < 4; ++rr) { const int row = wave * 4 + rr; const unsigned call = rinfo[128 + row], need2 = rinfo[96 + row];
            if (call <= 64u) { const unsigned c = call;
                const unsigned long long mine = cand[row * 64 + lane]; unsigned rank = 0u;
                for (unsigned k = 0; k < c; ++k) rank += (cand[row * 64 + k] > mine) ? 1u : 0u;
                if ((unsigned)lane < c && rank < need2) { const unsigned s = ~(unsigned)mine;
                    __hip_atomic_fetch_or(mask + row * HS + (s >> 5), 1u << (s & 31), __ATOMIC_RELAXED, __HIP_MEMORY_SCOPE_WORKGROUP); } }
            else { unsigned w4[4];
#pragma unroll
                for (int k = 0; k < 4; ++k) w4[k] = cmask[row * HS + 4 * lane + k];
                const unsigned cnt = __popc(w4[0]) + __popc(w4[1]) + __popc(w4[2]) + __popc(w4[3]);
                unsigned x = cnt;
#pragma unroll
                for (int o = 1; o < 64; o <<= 1) { const unsigned y = __shfl_up(x, o); if (lane >= o) x += y; }
                unsigned before = x - cnt;
#pragma unroll
                for (int k = 0; k < 4; ++k) { unsigned w = w4[k]; const unsigned pc = __popc(w); unsigned take = 0u;
                    if (before < need2) { if (before + pc <= need2) take = w; else { unsigned left = need2 - before; while (left) { const unsigned b = w & (0u - w); take |= b; w ^= b; --left; } } }
                    before += pc;
                    if (take) mask[row * HS + 4 * lane + k] |= take; } }
        }
    }
    __syncthreads();
#pragma unroll 1
    for (int rr = 0; rr < 4; ++rr) { const int row = wave * 4 + rr; unsigned short* out = sel + (size_t)(rowbase + t0 + row) * 256;
        unsigned w4[4];
#pragma unroll
        for (int k = 0; k < 4; ++k) w4[k] = mask[row * HS + 4 * lane + k];
        const unsigned cnt = __popc(w4[0]) + __popc(w4[1]) + __popc(w4[2]) + __popc(w4[3]);
        unsigned x = cnt;
#pragma unroll
        for (int o = 1; o < 64; o <<= 1) { const unsigned y = __shfl_up(x, o); if (lane >= o) x += y; }
        const unsigned total = __shfl(x, 63); unsigned pos = x - cnt;
#pragma unroll
        for (int k = 0; k < 4; ++k) { unsigned w = w4[k]; const unsigned base = (unsigned)(4 * lane + k) * 32u;
            while (w) { const unsigned bit = __builtin_ctz(w); if (pos < 256u) out[pos] = (unsigned short)(base + bit); ++pos; w &= w - 1u; } }
        for (unsigned i = total + lane; i < 256u; i += 64u) out[i] = (unsigned short)0xffffu; }
}

struct AttSt { float m, l; f32x16 o0, o1; };
template <class BF> DI void att_subtile(AttSt& S, const bf16x8 (&qf)[4], LAS const char* Kst, LAS const char* Vb, int vdh, int vrow0, int lane, const BF& bias) {
    const int r32 = lane & 31, hi = lane >> 5;
    f32x16 p;
#pragma unroll
    for (int r = 0; r < 16; ++r) p[r] = bias.b(crow(r, hi)) - S.m;
    LAS const char* kp = Kst + hi * 512 + r32 * 16;
#pragma unroll
    for (int s = 0; s < 4; ++s) { const bf16x8 kf = *(LAS const bf16x8*)(kp + s * 1024); p = mfma32(kf, qf[s], p); }
    if (bias.any) {
#pragma unroll
        for (int r = 0; r < 16; ++r) p[r] = bias.msk(crow(r, hi)) ? -INFINITY : p[r]; }
    float mxa[4] = {-INFINITY, -INFINITY, -INFINITY, -INFINITY};
#pragma unroll
    for (int r = 0; r < 16; ++r) mxa[r & 3] = fmaxf(mxa[r & 3], p[r]);
    float mx = fmaxf(fmaxf(mxa[0], mxa[1]), fmaxf(mxa[2], mxa[3]));
    mx = fmaxf(mx, __shfl_xor(mx, 32));
    if (__any(mx > 16.f)) { const float dl = fmaxf(mx, 0.f), sc = ex2(-dl); S.m += dl; S.l *= sc;
#pragma unroll
        for (int r = 0; r < 16; ++r) { p[r] -= dl; S.o0[r] *= sc; S.o1[r] *= sc; } }
    float psa[4] = {0.f, 0.f, 0.f, 0.f};
#pragma unroll
    for (int r = 0; r < 16; ++r) { p[r] = ex2(p[r]); psa[r & 3] += p[r]; }
    S.l += (psa[0] + psa[1]) + (psa[2] + psa[3]);
    v4u pw0, pw1;
    pw0.x = cvtpk(p[0], p[1]); pw0.y = cvtpk(p[2], p[3]); pw0.z = cvtpk(p[4], p[5]); pw0.w = cvtpk(p[6], p[7]);
    pw1.x = cvtpk(p[8], p[9]); pw1.y = cvtpk(p[10], p[11]); pw1.z = cvtpk(p[12], p[13]); pw1.w = cvtpk(p[14], p[15]);
    const bf16x8 pf0 = __builtin_bit_cast(bf16x8, pw0), pf1 = __builtin_bit_cast(bf16x8, pw1);
    LAS const char* vp = Vb + (vrow0 + 4 * hi + ((lane & 15) >> 2)) * 64 + ((lane >> 4) & 1) * 32 + (lane & 3) * 8;
    { const bf16x8 v00 = cat8(vtr(vp), vtr(vp + 512)), v10 = cat8(vtr(vp + vdh), vtr(vp + vdh + 512));
      const bf16x8 v01 = cat8(vtr(vp + 1024), vtr(vp + 1536)), v11 = cat8(vtr(vp + vdh + 1024), vtr(vp + vdh + 1536));
      S.o0 = mfma32(v00, pf0, S.o0); S.o1 = mfma32(v10, pf0, S.o1);
      S.o0 = mfma32(v01, pf1, S.o0); S.o1 = mfma32(v11, pf1, S.o1); }
}
template <class BF0, class BF1> DI void att_tile64(AttSt& S, const bf16x8 (&qf)[4], LAS const char* Kst, LAS const char* Vb, int vdh, int vrow0, int lane, const BF0& bias0, const BF1& bias1) {
    const int r32 = lane & 31, hi = lane >> 5;
    f32x16 p0, p1;
#pragma unroll
    for (int r = 0; r < 16; ++r) { p0[r] = bias0.b(crow(r, hi)) - S.m; p1[r] = bias1.b(crow(r, hi)) - S.m; }
    LAS const char* kp = Kst + hi * 512 + r32 * 16;
#pragma unroll
    for (int s = 0; s < 4; ++s) { const bf16x8 k0 = *(LAS const bf16x8*)(kp + s * 1024), k1 = *(LAS const bf16x8*)(kp + 4096 + s * 1024); p0 = mfma32(k0, qf[s], p0); p1 = mfma32(k1, qf[s], p1); }
    if (bias0.any) {
#pragma unroll
        for (int r = 0; r < 16; ++r) p0[r] = bias0.msk(crow(r, hi)) ? -INFINITY : p0[r]; }
    if (bias1.any) {
#pragma unroll
        for (int r = 0; r < 16; ++r) p1[r] = bias1.msk(crow(r, hi)) ? -INFINITY : p1[r]; }
    float mxa[4] = {-INFINITY, -INFINITY, -INFINITY, -INFINITY};
#pragma unroll
    for (int r = 0; r < 16; ++r) mxa[r & 3] = fmaxf(mxa[r & 3], fmaxf(p0[r], p1[r]));
    float mx = fmaxf(fmaxf(mxa[0], mxa[1]), fmaxf(mxa[2], mxa[3]));
    mx = fmaxf(mx, __shfl_xor(mx, 32));
    if (__any(mx > 16.f)) { const float dl = fmaxf(mx, 0.f), sc = ex2(-dl); S.m += dl; S.l *= sc;
#pragma unroll
        for (int r = 0; r < 16; ++r) { p0[r] -= dl; p1[r] -= dl; S.o0[r] *= sc; S.o1[r] *= sc; } }
    float psa[4] = {0.f, 0.f, 0.f, 0.f};
#pragma unroll
    for (int r = 0; r < 16; ++r) { p0[r] = ex2(p0[r]); p1[r] = ex2(p1[r]); psa[r & 3] += p0[r] + p1[r]; }
    S.l += (psa[0] + psa[1]) + (psa[2] + psa[3]);
    v4u a0, a1, b0, b1;
    a0.x = cvtpk(p0[0], p0[1]); a0.y = cvtpk(p0[2], p0[3]); a0.z = cvtpk(p0[4], p0[5]); a0.w = cvtpk(p0[6], p0[7]);
    a1.x = cvtpk(p0[8], p0[9]); a1.y = cvtpk(p0[10], p0[11]); a1.z = cvtpk(p0[12], p0[13]); a1.w = cvtpk(p0[14], p0[15]);
    b0.x = cvtpk(p1[0], p1[1]); b0.y = cvtpk(p1[2], p1[3]); b0.z = cvtpk(p1[4], p1[5]); b0.w = cvtpk(p1[6], p1[7]);
    b1.x = cvtpk(p1[8], p1[9]); b1.y = cvtpk(p1[10], p1[11]); b1.z = cvtpk(p1[12], p1[13]); b1.w = cvtpk(p1[14], p1[15]);
    LAS const char* vp = Vb + (vrow0 + 4 * hi + ((lane & 15) >> 2)) * 64 + ((lane >> 4) & 1) * 32 + (lane & 3) * 8;
#pragma unroll
    for (int k16 = 0; k16 < 4; ++k16) { const bf16x8 pf = __builtin_bit_cast(bf16x8, k16 == 0 ? a0 : k16 == 1 ? a1 : k16 == 2 ? b0 : b1);
        const bf16x8 v0 = cat8(vtr(vp + k16 * 1024), vtr(vp + k16 * 1024 + 512)), v1 = cat8(vtr(vp + vdh + k16 * 1024), vtr(vp + vdh + k16 * 1024 + 512));
        S.o0 = mfma32(v0, pf, S.o0); S.o1 = mfma32(v1, pf, S.o1); }
}

struct MobaFar { float c; bool any; DI float b(int) const { return c; } DI bool msk(int) const { return false; } };
struct MobaBias { LAS const float* lut; int tq, s0; bool any;
    DI float b(int kvrel) const { const int dist = tq - (s0 + kvrel); return lut[dist < 0 ? 0 : (dist > 1023 ? 1023 : dist)]; }
    DI bool msk(int kvrel) const { return tq - (s0 + kvrel) < 0; } };
DI void moba_qload(bf16x8 (&qf)[4], const bf16* proj, int rowbase, int h, int tq, int hi) {
    const bf16* qp = proj + (size_t)(rowbase + tq) * EV_N + EC_QB + h * 64 + hi * 8;
#pragma unroll
    for (int s = 0; s < 4; ++s) qf[s] = *(const bf16x8*)(qp + s * 16);
}
DI void moba_tile(const Fr& F, const bf16x8 (&qf)[4], int rowbase, int h, int n, int tq, bool valid, int slot, bool own, int wave_tile) {
    LAS const char* Kb = (LAS const char*)F.lds; LAS const char* Vb = (LAS const char*)(F.lds + 32768); LAS const float* lut = (LAS const float*)(F.lds + 98304);
    unsigned char* po = F.ws + WS_ACT; float* pml = (float*)(F.ws + WS_PML);
    const int lane = F.lane, hi = lane >> 5;
    AttSt S; S.m = 0.f; S.l = 0.f;
#pragma unroll
    for (int r = 0; r < 16; ++r) { S.o0[r] = 0.f; S.o1[r] = 0.f; }
    const int nst = own ? wave_tile + 1 : 8;
    int tmin = tq;
#pragma unroll
    for (int o = 1; o < 64; o <<= 1) { const int y = __shfl_xor(tmin, o); tmin = y < tmin ? y : tmin; }
    const float cfar = lut[1023];
    int st = 0;
    for (; st + 1 < nst; st += 2) {
        if (!own && tmin - (n * 256 + st * 32 + 63) >= 790) { MobaFar bf{cfar, false}; att_tile64(S, qf, Kb + st * 4096, Vb, 16384, st * 32, lane, bf, bf); }
        else { MobaBias bf0{lut, tq, n * 256 + st * 32, false}, bf1{lut, tq, n * 256 + st * 32 + 32, own && st + 1 == wave_tile}; att_tile64(S, qf, Kb + st * 4096, Vb, 16384, st * 32, lane, bf0, bf1); } }
    if (st < nst) { MobaBias bf{lut, tq, n * 256 + st * 32, own && st == wave_tile}; att_subtile(S, qf, Kb + st * 4096, Vb, 16384, st * 32, lane, bf); }
    const float lt = S.l + __shfl_xor(S.l, 32), inv = 1.f / lt;
    if (valid) { const size_t pi = ((size_t)(rowbase + tq) * 8 + h) * 4 + slot; unsigned char* o = po + pi * 64; const float i16 = inv * 16.f;
#pragma unroll
        for (int a4 = 0; a4 < 4; ++a4) {
            *(unsigned*)(o + 8 * a4 + 4 * hi) = pk4_fp8(S.o0[4 * a4] * i16, S.o0[4 * a4 + 1] * i16, S.o0[4 * a4 + 2] * i16, S.o0[4 * a4 + 3] * i16);
            *(unsigned*)(o + 32 + 8 * a4 + 4 * hi) = pk4_fp8(S.o1[4 * a4] * i16, S.o1[4 * a4 + 1] * i16, S.o1[4 * a4 + 2] * i16, S.o1[4 * a4 + 3] * i16); }
        if (hi == 0) { f32x2 ml = {S.m, lt}; *(f32x2*)(pml + pi * 2) = ml; } }
}
DI void moba_unit(const Args& a, const Fr& F, int b, int h, int n) {
    const bf16* proj = (const bf16*)(F.ws + WS_PROJ); const unsigned* sel3 = (const unsigned*)(F.ws + WS_SEL3);
    LAS unsigned char* lds = F.lds; LAS unsigned* list = (LAS unsigned*)(lds + 65536); LAS float* lut = (LAS float*)(lds + 98304); LAS unsigned* misc = (LAS unsigned*)(lds + 102400);
    const int tid = F.tid, lane = F.lane, wave = F.wave, rowbase = b * SEQ;
    __syncthreads();
    { const bf16* kg = proj + (size_t)(rowbase + n * 256) * EV_N + EC_KB + h * 64; const bf16* vg = proj + (size_t)(rowbase + n * 256) * EV_N + EC_VB + h * 64;
#pragma unroll
        for (int i = 0; i < 4; ++i) { const int p = tid + i * NTHR;
            { const int r = p & 31, c = (p >> 5) & 7, st = p >> 8; const v4u v = *(const v4u*)(kg + (size_t)(st * 32 + r) * EV_N + c * 8); *(LAS v4u*)(lds + st * 4096 + c * 512 + r * 16) = v; }
            { const int cc = p & 3, row = (p >> 2) & 255, dh = p >> 10; const v4u v = *(const v4u*)(vg + (size_t)row * EV_N + dh * 32 + cc * 8); *(LAS v4u*)(lds + 32768 + dh * 16384 + row * 64 + cc * 16) = v; } }
        for (int d = tid; d < 1024; d += NTHR) lut[d] = a.in[9][t5_bucket(d) * 16 + 8 + h] * LOG2E; }
    if (tid == 0) misc[16] = 0u;
    __syncthreads();
    unsigned sv[16];
#pragma unroll
    for (int k = 0; k < 16; ++k) { const int t = (n + 1) * 256 + k * NTHR + tid; sv[k] = t < SEQ ? sel3[(size_t)(rowbase + t) * 8 + h] : 0u; }
#pragma unroll
    for (int k = 0; k < 16; ++k) { const int tb = (n + 1) * 256 + k * NTHR; if (tb < SEQ) { const int t = tb + tid;
        const unsigned s = sv[k]; const unsigned nv = s >> 24; int slot = -1;
        if (nv > 0u && (s & 255u) == (unsigned)n) slot = 0; else if (nv > 1u && ((s >> 8) & 255u) == (unsigned)n) slot = 1; else if (nv > 2u && ((s >> 16) & 255u) == (unsigned)n) slot = 2;
        const unsigned long long bal = __ballot(slot >= 0); const unsigned wcnt = __popcll(bal);
        if (lane == 0) misc[wave] = wcnt;
        __syncthreads();
        unsigned off = misc[16], tot = 0u;
#pragma unroll
        for (int w = 0; w < 8; ++w) { const unsigned c = misc[w]; if (w < wave) off += c; tot += c; }
        if (slot >= 0) list[off + __popcll(bal & ((1ull << lane) - 1ull))] = ((unsigned)t << 2) | (unsigned)slot;
        __syncthreads();
        if (tid == 0) misc[16] += tot; } }
    __syncthreads();
    const int nlist = (int)misc[16];
    const int ntl = (nlist + 31) >> 5, hi = lane >> 5;
    bf16x8 qa[4], qb2[4];
    moba_qload(qa, proj, rowbase, h, n * 256 + wave * 32 + (lane & 31), hi);
    unsigned ea = 0u, eb = 0u; bool va = false, vb = false;
    const int lastl = nlist > 0 ? nlist - 1 : 0;
#define MOBA_LD(Q, E, V, T) do { const int li_ = (T) * 32 + (lane & 31); V = li_ < nlist; E = list[li_ < lastl ? li_ : lastl]; const int tq_ = (int)(E >> 2); moba_qload(Q, proj, rowbase, h, tq_ < SEQ - 1 ? tq_ : SEQ - 1, hi); } while (0)
    const int nw = ntl > wave ? (ntl - wave + 7) >> 3 : 0;
    MOBA_LD(qb2, eb, vb, wave);
    moba_tile(F, qa, rowbase, h, n, n * 256 + wave * 32 + (lane & 31), true, 3, true, wave);
    int j = 0;
    for (; j + 2 <= nw; j += 2) {
        MOBA_LD(qa, ea, va, wave + 8 * (j + 1));
        moba_tile(F, qb2, rowbase, h, n, (int)(eb >> 2), vb, (int)(eb & 3u), false, 0);
        MOBA_LD(qb2, eb, vb, wave + 8 * (j + 2));
        moba_tile(F, qa, rowbase, h, n, (int)(ea >> 2), va, (int)(ea & 3u), false, 0);
    }
    if (j < nw) moba_tile(F, qb2, rowbase, h, n, (int)(eb >> 2), vb, (int)(eb & 3u), false, 0);
#undef MOBA_LD
}

DI void dsa_step(const bf16x8 (&af)[2][4], const bf16x8 (&qlf)[4], int ch, LAS const unsigned char* bsel, LAS unsigned char* cbuf, LAS const float* tab,
                 float& m, float& l, f32x4 (&oT)[8], int l15, int kg, int lane) {
    f32x4 acc[2];
#pragma unroll
    for (int mt = 0; mt < 2; ++mt) { const unsigned b4 = *(LAS const unsigned*)(bsel + ch * 32 + mt * 16 + 4 * kg);
#pragma unroll
        for (int i = 0; i < 4; ++i) { const unsigned bb = (b4 >> (8 * i)) & 255u; const float tb = tab[(bb & 31u) * 8 + (l15 & 7)];
            acc[mt][i] = (tb - m) + (bb != 255u ? 0.f : -INFINITY); } }
#pragma unroll
    for (int mt = 0; mt < 2; ++mt)
#pragma unroll
        for (int ks = 0; ks < 4; ++ks) { acc[mt] = mfma16(af[mt][ks], qlf[ks], acc[mt]); *(LAS bf16x8*)(cbuf + (mt * 16 + l15) * 288 + (ks * 32 + kg * 8) * 2) = af[mt][ks]; }
    float mx = fmaxf(fmaxf(fmaxf(acc[0][0], acc[0][1]), fmaxf(acc[0][2], acc[0][3])), fmaxf(fmaxf(acc[1][0], acc[1][1]), fmaxf(acc[1][2], acc[1][3])));
    if (__any(mx > 16.f)) { mx = fmaxf(mx, __shfl_xor(mx, 16)); mx = fmaxf(mx, __shfl_xor(mx, 32));
        const float dl = fmaxf(mx, 0.f), sc = ex2(-dl); m += dl; l *= sc;
#pragma unroll
        for (int mt = 0; mt < 2; ++mt) acc[mt] = acc[mt] - dl;
#pragma unroll
        for (int ct = 0; ct < 8; ++ct) oT[ct] = oT[ct] * sc; }
    float ps = 0.f;
#pragma unroll
    for (int mt = 0; mt < 2; ++mt)
#pragma unroll
        for (int i = 0; i < 4; ++i) { acc[mt][i] = ex2(acc[mt][i]); ps += acc[mt][i]; }
    l += ps;
    v4u pw; pw.x = cvtpk(acc[0][0], acc[0][1]); pw.y = cvtpk(acc[0][2], acc[0][3]); pw.z = cvtpk(acc[1][0], acc[1][1]); pw.w = cvtpk(acc[1][2], acc[1][3]);
    const bf16x8 pf = __builtin_bit_cast(bf16x8, pw);
    asm volatile("" ::: "memory");
    LAS const char* tp = (LAS const char*)cbuf + (4 * kg + (l15 >> 2)) * 288 + (lane & 3) * 8;
#pragma unroll
    for (int ct = 0; ct < 8; ++ct) { const bf16x8 cf = cat8(vtr(tp + ct * 32), vtr(tp + 16 * 288 + ct * 32)); oT[ct] = mfma16(cf, pf, oT[ct]); }
    asm volatile("" ::: "memory");
}
DI void dsa_gather(bf16x8 (&af)[2][4], const bf16* ckvn, int rowbase, LAS const unsigned short* selb, int ch, int l15, int kg) {
#pragma unroll
    for (int mt = 0; mt < 2; ++mt) { unsigned idx = selb[ch * 32 + mt * 16 + l15]; if (idx == 0xffffu) idx = 0u;
        const bf16* cp = ckvn + (size_t)(rowbase + (int)idx) * 128 + kg * 8;
#pragma unroll
        for (int ks = 0; ks < 4; ++ks) af[mt][ks] = *(const bf16x8*)(cp + ks * 32); }
}
DI void dsa_query(const Fr& F, int tok, const v2u sv, LAS unsigned char* wl, LAS const unsigned char* bkt, LAS const float* tab) {
    const bf16* ql = (const bf16*)(F.ws + WS_QL); const bf16* ckvn = (const bf16*)(F.ws + WS_CKVN); const unsigned short* sel = (const unsigned short*)(F.ws + WS_SEL); bf16* ol = (bf16*)(F.ws + WS_OL);
    const int lane = F.lane, l15 = lane & 15, kg = lane >> 4, t = tok % SEQ, rowbase = tok - t;
    LAS unsigned short* selb = (LAS unsigned short*)wl; LAS unsigned char* bsel = wl + 512; LAS unsigned char* cbuf = wl + 1024;
    { *((LAS v2u*)selb + lane) = sv; unsigned bw = 0u;
#pragma unroll
        for (int i = 0; i < 4; ++i) { const unsigned s = (i < 2 ? (sv.x >> (16 * i)) : (sv.y >> (16 * (i - 2)))) & 0xffffu; const int dist = t - (int)s;
            const unsigned bb = (s != 0xffffu && dist >= 0) ? (unsigned)bkt[dist > 1023 ? 1023 : dist] : 255u; bw |= bb << (8 * i); }
        *((LAS unsigned*)bsel + lane) = bw; }
    bf16x8 qlf[4];
#pragma unroll
    for (int ks = 0; ks < 4; ++ks) { qlf[ks] = *(const bf16x8*)(ql + (size_t)tok * 1024 + (l15 & 7) * 128 + ks * 32 + kg * 8); if (l15 >= 8) qlf[ks] = (bf16x8){0, 0, 0, 0, 0, 0, 0, 0}; }
    float m = 0.f, l = 0.f; f32x4 oT[8];
#pragma unroll
    for (int ct = 0; ct < 8; ++ct) oT[ct] = (f32x4){0.f, 0.f, 0.f, 0.f};
    const int nvalid = t + 1 < 256 ? t + 1 : 256, nch = (nvalid + 31) >> 5;
    LDS_WAIT();
    bf16x8 afa[2][4], afb[2][4], afc[2][4];
    const int lastc = nch - 1;
    dsa_gather(afa, ckvn, rowbase, selb, 0, l15, kg);
    dsa_gather(afb, ckvn, rowbase, selb, lastc < 1 ? lastc : 1, l15, kg);
    int ch = 0;
    for (; ch + 3 <= nch; ch += 3) {
        dsa_gather(afc, ckvn, rowbase, selb, ch + 2, l15, kg);
        dsa_step(afa, qlf, ch, bsel, cbuf, tab, m, l, oT, l15, kg, lane);
        dsa_gather(afa, ckvn, rowbase, selb, ch + 3 < lastc ? ch + 3 : lastc, l15, kg);
        dsa_step(afb, qlf, ch + 1, bsel, cbuf, tab, m, l, oT, l15, kg, lane);
        dsa_gather(afb, ckvn, rowbase, selb, ch + 4 < lastc ? ch + 4 : lastc, l15, kg);
        dsa_step(afc, qlf, ch + 2, bsel, cbuf, tab, m, l, oT, l15, kg, lane);
    }
    if (ch < nch) dsa_step(afa, qlf, ch, bsel, cbuf, tab, m, l, oT, l15, kg, lane);
    if (ch + 1 < nch) dsa_step(afb, qlf, ch + 1, bsel, cbuf, tab, m, l, oT, l15, kg, lane);
    l += __shfl_xor(l, 16); l += __shfl_xor(l, 32);
    const float inv = 1.f / l;
    if (l15 < 8) { bf16* o = ol + (size_t)tok * 1024 + l15 * 128 + 4 * kg;
#pragma unroll
        for (int ct = 0; ct < 8; ++ct) { v2u w; w.x = cvtpk(oT[ct][0] * inv, oT[ct][1] * inv); w.y = cvtpk(oT[ct][2] * inv, oT[ct][3] * inv); *(v2u*)(o + ct * 16) = w; } }
}
DI void dsa_chunk(const Args& a, const Fr& F, int c32) {
    LAS unsigned char* bkt = F.lds + 81920; LAS float* tab = (LAS float*)(F.lds + 82944);
    __syncthreads();
    for (int d = F.tid; d < 1024; d += NTHR) bkt[d] = (unsigned char)t5_bucket(d);
    if (F.tid < 256) tab[F.tid] = a.in[9][(F.tid >> 3) * 16 + (F.tid & 7)] * LOG2E;
    __syncthreads();
    const unsigned short* selg = (const unsigned short*)(F.ws + WS_SEL); v2u svq[4];
#pragma unroll
    for (int i = 0; i < 4; ++i) svq[i] = *((const v2u*)(selg + (size_t)(c32 * 32 + F.wave * 4 + i) * 256) + F.lane);
#pragma unroll
    for (int i = 0; i < 4; ++i) dsa_query(F, c32 * 32 + F.wave * 4 + i, svq[i], F.lds + F.wave * 10240, bkt, tab);
}

DI void ph_even_post(const Fr& F, int j) {
    const bf16* ol = (const bf16*)(F.ws + WS_OL); unsigned char* ao = F.ws + WS_AO;
    const bf16* wuvt = (const bf16*)(F.ws + WS_WUVT) + (size_t)j * 8 * 64 * 128;
    const unsigned char* po = F.ws + WS_ACT; const float* pml = (const float*)(F.ws + WS_PML); const unsigned* sel3 = (const unsigned*)(F.ws + WS_SEL3);
    const int lane = F.lane, wave = F.wave, l15 = lane & 15, kg = lane >> 4;
    for (int chunk = F.blk; chunk < 256; chunk += F.G) { const int tok0 = chunk * 128;
        { const int h = wave; bf16x8 af[4][4];
#pragma unroll
            for (int mt = 0; mt < 4; ++mt)
#pragma unroll
                for (int ks = 0; ks < 4; ++ks) af[mt][ks] = *(const bf16x8*)(wuvt + ((size_t)h * 64 + mt * 16 + l15) * 128 + ks * 32 + kg * 8);
#pragma unroll 1
            for (int tg = 0; tg < 8; tg += 2) { bf16x8 bf[2][4];
#pragma unroll
                for (int u = 0; u < 2; ++u)
#pragma unroll
                    for (int ks = 0; ks < 4; ++ks) bf[u][ks] = *(const bf16x8*)(ol + (size_t)(tok0 + (tg + u) * 16 + l15) * 1024 + h * 128 + ks * 32 + kg * 8);
#pragma unroll
                for (int u = 0; u < 2; ++u) { const int tok = tok0 + (tg + u) * 16 + l15;
#pragma unroll
                    for (int mt = 0; mt < 4; ++mt) { f32x4 d = {0.f, 0.f, 0.f, 0.f};
#pragma unroll
                        for (int ks = 0; ks < 4; ++ks) d = mfma16(af[mt][ks], bf[u][ks], d);
                        *(unsigned*)(ao + (size_t)tok * 1024 + h * 64 + mt * 16 + 4 * kg) = pk4_fp8(d[0] * F8_SAO, d[1] * F8_SAO, d[2] * F8_SAO, d[3] * F8_SAO); } } } }
#pragma unroll 1
        for (int i0 = 0; i0 < 16; i0 += 4) { const int h = lane >> 3, d0 = (lane & 7) * 8; unsigned nvv[4]; f32x2 mlv[4][4];
#pragma unroll
            for (int i = 0; i < 4; ++i) { const int tok = tok0 + wave * 16 + i0 + i; const size_t pi = ((size_t)tok * 8 + h) * 4; nvv[i] = sel3[(size_t)tok * 8 + h] >> 24;
#pragma unroll
                for (int s = 0; s < 4; ++s) mlv[i][s] = *(const f32x2*)(pml + (pi + s) * 2); }
#pragma unroll
            for (int i = 0; i < 4; ++i) { const int tok = tok0 + wave * 16 + i0 + i; const size_t pi = ((size_t)tok * 8 + h) * 4;
                float mj[4], lj[4];
#pragma unroll
                for (int s = 0; s < 4; ++s) { const bool ok = (s == 3) || ((unsigned)s < nvv[i]); mj[s] = ok ? mlv[i][s][0] : -1e30f; lj[s] = ok ? mlv[i][s][1] : 0.f; }
                const float ms = fmaxf(fmaxf(mj[0], mj[1]), fmaxf(mj[2], mj[3])); float wsum = 0.f, acc[8], wv[4]; v2u pv[4];
#pragma unroll
                for (int k = 0; k < 8; ++k) acc[k] = 0.f;
#pragma unroll
                for (int s = 0; s < 4; ++s) { wv[s] = lj[s] * ex2(mj[s] - ms); wsum += wv[s]; pv[s] = (v2u){0u, 0u}; if (wv[s] > 0.f) pv[s] = *(const v2u*)(po + (pi + s) * 64 + d0); }
#pragma unroll
                for (int s = 0; s < 4; ++s) { if (wv[s] > 0.f) {
#pragma unroll
                    for (int k = 0; k < 2; ++k) { const f32x2 lo = __builtin_amdgcn_cvt_pk_f32_fp8((int)pv[s][k], false), hi2 = __builtin_amdgcn_cvt_pk_f32_fp8((int)pv[s][k], true);
                        acc[4 * k] += wv[s] * lo[0]; acc[4 * k + 1] += wv[s] * lo[1]; acc[4 * k + 2] += wv[s] * hi2[0]; acc[4 * k + 3] += wv[s] * hi2[1]; } } }
                const float inv = (F8_SAO / 16.f) / wsum; v2u o; o.x = pk4_fp8(acc[0] * inv, acc[1] * inv, acc[2] * inv, acc[3] * inv); o.y = pk4_fp8(acc[4] * inv, acc[5] * inv, acc[6] * inv, acc[7] * inv);
                *(v2u*)(ao + (size_t)tok * 1024 + 512 + h * 64 + d0) = o; } }
    }
}
template <class XT> DI f32x4 ld_x4(const XT* p);
template <> DI f32x4 ld_x4<float>(const float* p) { return *(const f32x4*)p; }
template <> DI f32x4 ld_x4<bf16>(const bf16* p) { const v2u w = *(const v2u*)p; return (f32x4){bf2f(w.x & 0xffffu), bf2f(w.x >> 16), bf2f(w.y & 0xffffu), bf2f(w.y >> 16)}; }
template <class XT> DI f32x16 proj32_f32(const float* W, int ldw, int ncols, const XT* xrow, int d_lo, int lane) {
    const int e = lane & 31, kh = lane >> 5; const bool ev = e < ncols;
    f32x16 D;
#pragma unroll
    for (int r = 0; r < 16; ++r) D[r] = 0.f;
    const float* wp = W + (size_t)(d_lo + 4 * kh) * ldw + (ev ? e : 0);
    const XT* xp = xrow + d_lo + 4 * kh;
#pragma unroll 8
    for (int i = 0; i < 64; ++i) { const f32x4 xv = ld_x4<XT>(xp + 8 * i);
        float a0 = wp[(size_t)(8 * i + 0) * ldw], a1 = wp[(size_t)(8 * i + 1) * ldw], a2 = wp[(size_t)(8 * i + 2) * ldw], a3 = wp[(size_t)(8 * i + 3) * ldw];
        if (!ev) { a0 = 0.f; a1 = 0.f; a2 = 0.f; a3 = 0.f; }
        D = __builtin_amdgcn_mfma_f32_32x32x2f32(a0, xv[0], D, 0, 0, 0); D = __builtin_amdgcn_mfma_f32_32x32x2f32(a1, xv[1], D, 0, 0, 0);
        D = __builtin_amdgcn_mfma_f32_32x32x2f32(a2, xv[2], D, 0, 0, 0); D = __builtin_amdgcn_mfma_f32_32x32x2f32(a3, xv[3], D, 0, 0, 0); }
    return D;
}
DI void ph_odd_prep(const Args& a, const Fr& F, int j, int layer) {
    const bf16* proj = (const bf16*)(F.ws + WS_PROJ); const bf16* x = (const bf16*)(F.ws + WS_XB);
    float* logf = (float*)(F.ws + WS_LOGF); float* cs = (float*)(F.ws + WS_CS);
    const float* wf = a.in[6] + (size_t)j * 1024 * 3088 + 3072; const float* bfv = a.in[7] + j * 16;
    LAS float* red = (LAS float*)(F.lds); LAS float* lfb = (LAS float*)(F.lds + 131072);
    LAS unsigned* kmx = (LAS unsigned*)(F.lds + 131072 + 8192);
    const int lane = F.lane, wave = F.wave, tid = F.tid, l31 = lane & 31, hi = lane >> 5;
    for (int chunk = F.blk; chunk < 256; chunk += F.G) { const int tok0 = chunk * 128, b = tok0 / SEQ, t0 = tok0 % SEQ;
        __syncthreads();
        if (tid < 16) kmx[tid] = 0u;
        const int tl = wave & 3, kr = wave >> 2;
        f32x16 D = proj32_f32(wf, 3088, 16, x + (size_t)(tok0 + tl * 32 + l31) * DM, kr * 512, lane);
        if (kr == 1) {
#pragma unroll
            for (int r = 0; r < 8; ++r) red[(tl * 8 + r) * 64 + lane] = D[r]; }
        __syncthreads();
        if (kr == 0) {
#pragma unroll
            for (int r = 0; r < 8; ++r) { const int h = (r & 3) + 8 * (r >> 2) + 4 * hi; const float z = D[r] + red[(tl * 8 + r) * 64 + lane] + bfv[h];
                const float ls = fminf(z, 0.f) - log1pf(__expf(-fabsf(z)));
                lfb[(tl * 32 + l31) * 16 + h] = ls * LOG2E; } }
#pragma unroll 1
        for (int i = 0; i < 4; ++i) { const int p = tid + i * NTHR, tk = p >> 4, h = p & 15; const v4u* kp = (const v4u*)(proj + (size_t)(tok0 + tk) * OD_N + OC_K + h * 64); float s = 0.f;
#pragma unroll
            for (int c = 0; c < 8; ++c) { const v4u w = kp[c];
#pragma unroll
                for (int k = 0; k < 4; ++k) { const float e0 = bf2f(w[k] & 0xffffu), e1 = bf2f(w[k] >> 16); s += e0 * e0 + e1 * e1; } }
            __hip_atomic_fetch_max(kmx + h, __float_as_uint(s), __ATOMIC_RELAXED, __HIP_MEMORY_SCOPE_WORKGROUP); }
        __syncthreads();
        for (int i = tid; i < 2048; i += NTHR) { const int h = i >> 7, tk = i & 127; logf[((size_t)b * 16 + h) * SEQ + t0 + tk] = lfb[tk * 16 + h]; }
        if (tid < 32) { const int h = tid & 15, c = tid >> 4; float s = 0.f;
            for (int k = 0; k < 64; ++k) s += lfb[(c * 64 + k) * 16 + h];
            cs[((size_t)b * 16 + h) * 128 + (t0 >> 6) + c] = s; }
        if (tid < 16) __hip_atomic_fetch_max(F.ctl + CW_KMAX + layer * 64 + b * 16 + tid, kmx[tid], RLX_AGENT);
    }
}

constexpr float FOX_SKIP_LOG2 = 64.f;
struct FoxBias { LAS const float* ng; int tq, kabs0; bool any;
    DI float b(int kvrel) const { return ng[kvrel]; }
    DI bool msk(int kvrel) const { return (kabs0 + kvrel) > tq; } };
DI void fox_unit(const Fr& F, int layer, int b, int h, int qb) {
    const bf16* proj = (const bf16*)(F.ws + WS_PROJ); const float* logf = (const float*)(F.ws + WS_LOGF); const float* cs = (const float*)(F.ws + WS_CS); unsigned char* ao = F.ws + WS_AO;
    LAS unsigned char* lds = F.lds; LAS float* ng = (LAS float*)(lds + 32768); LAS float* red = (LAS float*)(lds + 65536 + 1024); LAS int* ibox = (LAS int*)(lds + 65536 + 2048);
    const int tid = F.tid, lane = F.lane, wave = F.wave, r32 = lane & 31, hi = lane >> 5, t0 = qb * 256, rowbase = b * SEQ, tq = t0 + wave * 32 + r32;
    __syncthreads();
    bf16x8 qf[4]; float qs = 0.f;
    { const bf16* qp = proj + (size_t)(rowbase + tq) * OD_N + OC_Q + h * 64 + hi * 8;
#pragma unroll
        for (int s = 0; s < 4; ++s) { qf[s] = *(const bf16x8*)(qp + s * 16);
#pragma unroll
            for (int k = 0; k < 8; ++k) { const float e = bf2f((unsigned short)qf[s][k]); qs += e * e; } } }
    qs += __shfl_xor(qs, 32); qs = wave_max(qs);
    if (lane == 0) red[wave] = qs;
    if (tid < 128) red[32 + tid] = (tid < t0 / 64) ? cs[((size_t)b * 16 + h) * 128 + tid] : 0.f;
    __syncthreads();
    if (tid == 0) { float qm = red[0];
        for (int w = 1; w < 8; ++w) qm = fmaxf(qm, red[w]);
        const float km = __uint_as_float(ld_u32(F.ctl + CW_KMAX + layer * 64 + b * 16 + h));
        const float B2 = 2.f * (sqrtf(qm * km) * 1.01f + 1.f);
        int kt = t0 / 64 - 1, kts = t0 / 64; float D = 0.f;
        while (kt >= 0 && B2 + D >= -FOX_SKIP_LOG2) { kts = kt; D += red[32 + kt]; --kt; }
        ibox[0] = kts; }
    __syncthreads();
    const int kts = ibox[0], s_start = kts * 64, nel = t0 + 256 - s_start;
    { const int i0 = tid * 16; float v[16]; const float* lp = logf + ((size_t)b * 16 + h) * SEQ + s_start + i0;
        if (i0 < nel) {
#pragma unroll
            for (int c = 0; c < 4; ++c) { const f32x4 w = *(const f32x4*)(lp + 4 * c); v[4 * c] = w[0]; v[4 * c + 1] = w[1]; v[4 * c + 2] = w[2]; v[4 * c + 3] = w[3]; } }
        else {
#pragma unroll
            for (int c = 0; c < 16; ++c) v[c] = 0.f; }
#pragma unroll
        for (int c = 1; c < 16; ++c) v[c] += v[c - 1];
        float xsum = v[15];
#pragma unroll
        for (int o = 1; o < 64; o <<= 1) { const float y = __shfl_up(xsum, o); if (lane >= o) xsum += y; }
        if (lane == 63) red[16 + wave] = xsum;
        __syncthreads();
        float off = xsum - v[15];
        for (int w = 0; w < wave; ++w) off += red[16 + w];
        if (i0 < nel) {
#pragma unroll
            for (int c = 0; c < 4; ++c) { f32x4 w = {-(off + v[4 * c]), -(off + v[4 * c + 1]), -(off + v[4 * c + 2]), -(off + v[4 * c + 3])}; *(LAS f32x4*)(ng + i0 + 4 * c) = w; } }
    }
    const int ntile = t0 / 64 + 4 - kts;
    const bf16* kg = proj + (size_t)rowbase * OD_N + OC_K + h * 64; const bf16* vg = proj + (size_t)rowbase * OD_N + OC_V + h * 64;
    const int kr = tid & 31, kc = (tid >> 5) & 7, kst = tid >> 8, vcc = tid & 3, vrow = (tid >> 2) & 63, vdh = tid >> 8;
    const int koff = kst * 4096 + kc * 512 + kr * 16, voff = 8192 + vdh * 4096 + vrow * 64 + vcc * 16;
    const bf16* kgp = kg + (size_t)(kts * 64 + kst * 32 + kr) * OD_N + kc * 8; const bf16* vgp = vg + (size_t)(kts * 64 + vrow) * OD_N + vdh * 32 + vcc * 8;
#define FOX_LD(KV, VV, I) do { const int ii_ = (I) < ntile - 1 ? (I) : ntile - 1; KV = *(const v4u*)(kgp + (size_t)ii_ * 64 * OD_N); VV = *(const v4u*)(vgp + (size_t)ii_ * 64 * OD_N); } while (0)
    v4u kvA, vvA, kvB, vvB;
    { v4u kv, vv; FOX_LD(kv, vv, 0); FOX_LD(kvA, vvA, 1);
        *(LAS v4u*)(lds + koff) = kv; *(LAS v4u*)(lds + voff) = vv; }
    __syncthreads();
    AttSt S; S.m = 0.f; S.l = 0.f;
#pragma unroll
    for (int r = 0; r < 16; ++r) { S.o0[r] = 0.f; S.o1[r] = 0.f; }
    const int wlast = t0 + wave * 32 + 31, wfirst = t0 + wave * 32;
#define FOX_COMPUTE(I, BUF) do { const int kv0 = (kts + (I)) * 64; LAS const char* bp_ = (LAS const char*)(lds + (BUF)); \
        if (kv0 + 32 <= wlast) { FoxBias bf0{ng + (kv0 - s_start), tq, kv0, kv0 + 31 > wfirst}, bf1{ng + (kv0 + 32 - s_start), tq, kv0 + 32, kv0 + 63 > wfirst}; \
            att_tile64(S, qf, bp_, bp_ + 8192, 4096, 0, lane, bf0, bf1); } \
        else if (kv0 <= wlast) { FoxBias bf{ng + (kv0 - s_start), tq, kv0, kv0 + 31 > wfirst}; \
            att_subtile(S, qf, bp_, bp_ + 8192, 4096, 0, lane, bf); } } while (0)
    for (int i = 0; i < ntile; i += 2) {
        FOX_LD(kvB, vvB, i + 2);
        FOX_COMPUTE(i, 0);
        if (i + 1 < ntile) { *(LAS v4u*)(lds + 16384 + koff) = kvA; *(LAS v4u*)(lds + 16384 + voff) = vvA; }
        __syncthreads();
        if (i + 1 >= ntile) break;
        FOX_LD(kvA, vvA, i + 3);
        FOX_COMPUTE(i + 1, 16384);
        if (i + 2 < ntile) { *(LAS v4u*)(lds + koff) = kvB; *(LAS v4u*)(lds + voff) = vvB; }
        __syncthreads();
    }
#undef FOX_LD
#undef FOX_COMPUTE
    const float lt = S.l + __shfl_xor(S.l, 32), inv = 1.f / lt;
    unsigned char* o = ao + (size_t)(rowbase + tq) * 1024 + h * 64; const float i16 = inv * F8_SAO;
#pragma unroll
    for (int a4 = 0; a4 < 4; ++a4) {
        *(unsigned*)(o + 8 * a4 + 4 * hi) = pk4_fp8(S.o0[4 * a4] * i16, S.o0[4 * a4 + 1] * i16, S.o0[4 * a4 + 2] * i16, S.o0[4 * a4 + 3] * i16);
        *(unsigned*)(o + 32 + 8 * a4 + 4 * hi) = pk4_fp8(S.o1[4 * a4] * i16, S.o1[4 * a4 + 1] * i16, S.o1[4 * a4 + 2] * i16, S.o1[4 * a4 + 3] * i16); }
}

DI void ph_ln1_router(const Args& a, const Fr& F, int layer, int probe = 0  ) {
    const bf16* yp = (const bf16*)(F.ws + WS_YP); bf16* x1 = (bf16*)(F.ws + WS_X1); unsigned char* xb8 = F.ws + WS_XB8;
    unsigned* tope = (unsigned*)(F.ws + WS_TOPE); float* gate = (float*)(F.ws + WS_GATE); unsigned* rank = (unsigned*)(F.ws + WS_RANK);
    const float* g = a.in[10] + (size_t)(layer * 2) * DM; const float* bb = a.in[11] + (size_t)(layer * 2) * DM;
    const float* rw = a.in[12] + (size_t)layer * 1024 * 32; const float* rb = a.in[13] + layer * 32;
    LAS float* red = (LAS float*)(F.lds); LAS unsigned* lcnt = (LAS unsigned*)(F.lds + 131072);
    const int lane = F.lane, wave = F.wave, tid = F.tid, l31 = lane & 31, hi = lane >> 5;
    for (int chunk = F.blk; chunk < 256; chunk += F.G) { const int tok0 = chunk * 128;
        __syncthreads();
        if (tid < 32) lcnt[tid] = 0u;
        f32x4 gg[4], bbv[4];
#pragma unroll
        for (int jj = 0; jj < 4; ++jj) { gg[jj] = *((const f32x4*)g + lane + 64 * jj); bbv[jj] = *((const f32x4*)bb + lane + 64 * jj); }
        v2u raw[16][4];
#pragma unroll
        for (int i = 0; i < 16; ++i)
#pragma unroll
            for (int jj = 0; jj < 4; ++jj) raw[i][jj] = *((const v2u*)(yp + (size_t)(tok0 + wave * 16 + i) * DM) + lane + 64 * jj);
#pragma unroll
        for (int i = 0; i < 16; ++i) { const int tok = tok0 + wave * 16 + i; f32x4 v[4];
#pragma unroll
            for (int jj = 0; jj < 4; ++jj) { const v2u w = raw[i][jj]; v[jj] = (f32x4){bf2f(w.x & 0xffffu), bf2f(w.x >> 16), bf2f(w.y & 0xffffu), bf2f(w.y >> 16)}; }
            ln_row_r(v, gg, bbv);
            store_row_bf16(x1 + (size_t)tok * DM, v, lane);
#pragma unroll
            for (int jj = 0; jj < 4; ++jj) *((unsigned*)(xb8 + (size_t)tok * DM) + lane + 64 * jj) = pk4_fp8(v[jj][0] * F8_SX, v[jj][1] * F8_SX, v[jj][2] * F8_SX, v[jj][3] * F8_SX); }
        asm volatile("s_waitcnt vmcnt(0)" ::: "memory");
        __syncthreads();
        if (probe == 1) continue;
        const int tl = wave & 3, kr = wave >> 2, tokl = tok0 + tl * 32 + l31;
        f32x16 D = proj32_f32(rw, 32, 32, x1 + (size_t)tokl * DM, kr * 512, lane);
        if (kr == 1) {
#pragma unroll
            for (int r = 0; r < 16; ++r) red[(tl * 16 + r) * 64 + lane] = D[r]; }
        __syncthreads();
        if (kr == 0) {
            float lv[32];
#pragma unroll
            for (int r = 0; r < 16; ++r) { const float own = D[r] + red[(tl * 16 + r) * 64 + lane] + rb[crow(r, hi)]; const float oth = __shfl_xor(own, 32);
                lv[crow(r, 0)] = hi == 0 ? own : oth; lv[crow(r, 1)] = hi == 0 ? oth : own; }
            float tv[4]; int te[4];
#pragma unroll
            for (int r = 0; r < 4; ++r) { float mx = -INFINITY; int me = 0;
#pragma unroll
                for (int e = 0; e < 32; ++e) { if (lv[e] > mx) { mx = lv[e]; me = e; } }
                tv[r] = mx; te[r] = me;
#pragma unroll
                for (int e = 0; e < 32; ++e) { if (e == me) lv[e] = -INFINITY; } }
            const float e1 = __expf(tv[1] - tv[0]), e2 = __expf(tv[2] - tv[0]), e3 = __expf(tv[3] - tv[0]); const float inv = 1.f / (1.f + e1 + e2 + e3);
            if (hi == 0) { const size_t o = (size_t)tokl * 4;
                const float gv[4] = {inv, e1 * inv, e2 * inv, e3 * inv};
#pragma unroll
                for (int r = 0; r < 4; ++r) { const unsigned rk = __hip_atomic_fetch_add(lcnt + (te[r] & 31), 1u, __ATOMIC_RELAXED, __HIP_MEMORY_SCOPE_WORKGROUP);
                    tope[o + r] = (unsigned)(te[r] & 31); gate[o + r] = gv[r]; rank[o + r] = rk; } } }
        __syncthreads();
        if (tid < 32) __hip_atomic_store(F.ctl + CW_CNT + chunk * 32 + tid, lcnt[tid], RLX_AGENT);
    }
}

DI void ph_route(const Fr& F) {
    unsigned short* srcg = (unsigned short*)(F.ws + WS_SRC);
    const unsigned* tope = (const unsigned*)(F.ws + WS_TOPE); const unsigned* rank = (const unsigned*)(F.ws + WS_RANK); unsigned* dest = (unsigned*)(F.ws + WS_DEST);
    LAS unsigned* P = (LAS unsigned*)(F.lds); LAS unsigned* pst = P + 512; LAS unsigned* pad = P + 544; LAS unsigned* base = P + 576; LAS unsigned* nt = P + 608; LAS unsigned* totl = P + 640;
    const int tid = F.tid;
    __syncthreads();
    { const int e = tid & 31, part = tid >> 5; unsigned s = 0u;
        for (int c = 0; c < 16; ++c) s += ld_u32(F.ctl + CW_CNT + (part * 16 + c) * 32 + e);
        P[part * 32 + e] = s; }
    __syncthreads();
    if (tid < 32) { unsigned tot = 0u;
        for (int p = 0; p < 16; ++p) tot += P[p * 32 + tid];
        totl[tid] = tot; pad[tid] = (tot + 255u) & ~255u; }
    __syncthreads();
    if (tid == 0) { unsigned acc = 0u;
        for (int e = 0; e < 32; ++e) { pst[e] = acc; acc += pad[e]; }
        nt[0] = acc >> 8; }
    __syncthreads();
    if (F.blk < 32) { const int e = F.blk;
        for (unsigned i = totl[e] + tid; i < pad[e]; i += NTHR) srcg[pst[e] + i] = (unsigned short)0; }
    for (int chunk = F.blk; chunk < 256; chunk += F.G) {
        __syncthreads();
        if (tid < 32) { unsigned off = 0u; const int pf = chunk >> 4;
            for (int p = 0; p < pf; ++p) off += P[p * 32 + tid];
            for (int c = pf * 16; c < chunk; ++c) off += ld_u32(F.ctl + CW_CNT + c * 32 + tid);
            base[tid] = pst[tid] + off; }
        __syncthreads();
        { const size_t pi = (size_t)chunk * 512 + tid;
            const unsigned d = base[tope[pi] & 31u] + rank[pi];
            dest[pi] = d; srcg[d] = (unsigned short)(pi >> 2); }
        if (chunk == 0) { const unsigned ntl = nt[0];
            if (tid == 0) __hip_atomic_store(F.ctl + CW_TILE, ntl, RLX_AGENT);
            for (unsigned i = tid; i < ntl; i += NTHR) { unsigned e = 0u;
                for (unsigned k = 1; k < 32; ++k) if (pst[k] <= i * 256u) e = k;
                __hip_atomic_store(F.ctl + CW_TILE + 64 + i, e, RLX_AGENT); } }
    }
}

DI void ph_combine_ln2(const Args& a, const Fr& F, int layer) {
    const bf16* x1 = (const bf16*)(F.ws + WS_X1); const unsigned char* yr = F.ws + WS_XG; bf16* xb = (bf16*)(F.ws + WS_XB);
    const float* gate = (const float*)(F.ws + WS_GATE); const unsigned* dest = (const unsigned*)(F.ws + WS_DEST);
    const float* g = a.in[10] + (size_t)(layer * 2 + 1) * DM; const float* bb = a.in[11] + (size_t)(layer * 2 + 1) * DM;
    const int lane = F.lane; const int gw = F.blk * NWAVES + F.wave, NGW = F.G * NWAVES;
    for (int tok = gw; tok < NTOK; tok += 4 * NGW) { f32x4 v[4][4];
#pragma unroll
        for (int i = 0; i < 4; ++i) { const int tk = tok + i * NGW; if (tk < NTOK) {
#pragma unroll
            for (int jj = 0; jj < 4; ++jj) { const v2u w = *((const v2u*)(x1 + (size_t)tk * DM) + lane + 64 * jj);
                v[i][jj] = (f32x4){bf2f(w.x & 0xffffu), bf2f(w.x >> 16), bf2f(w.y & 0xffffu), bf2f(w.y >> 16)} * ALPHA; }
#pragma unroll
            for (int k = 0; k < 4; ++k) { const float gk = gate[(size_t)tk * 4 + k] * (1.f / F8_SY); const unsigned d = dest[(size_t)tk * 4 + k];
#pragma unroll
                for (int jj = 0; jj < 4; ++jj) { const int w = (int)*((const unsigned*)(yr + (size_t)d * DM) + lane + 64 * jj);
                    const f32x2 lo = __builtin_amdgcn_cvt_pk_f32_fp8(w, false), hi2 = __builtin_amdgcn_cvt_pk_f32_fp8(w, true);
                    v[i][jj][0] += gk * lo[0]; v[i][jj][1] += gk * lo[1]; v[i][jj][2] += gk * hi2[0]; v[i][jj][3] += gk * hi2[1]; } } } }
#pragma unroll
        for (int i = 0; i < 4; ++i) { const int tk = tok + i * NGW; if (tk < NTOK) {
            ln_row(v[i], g, bb, lane);
            if (layer == DEPTH - 1) store_row_f32(a.out + (size_t)tk * DM, v[i], lane);
            else store_row_bf16(xb + (size_t)tk * DM, v[i], lane); } } }
}
constexpr int LDS_BYTES = 147456;
constexpr int LDS_BARW = 145408, LDS_QSLOT = 145472, LDS_TILE_E = 133632, LDS_SRCL = 136192;
constexpr int NPL = 11;
constexpr int NPHASE = 1 + NPL * DEPTH;
#ifndef MK_SINGLE
#define MK_SINGLE 1
#endif
DI int q_next(const Fr& F, unsigned* ctr) {
    LAS int* slot = (LAS int*)(F.lds + LDS_QSLOT);
    __syncthreads();
    if (F.tid == 0) *slot = (int)__hip_atomic_fetch_add(ctr, 1u, RLX_AGENT);
    __syncthreads();
    return *slot;
}
DI int lane_id_fresh() { unsigned m_ = ~0u; asm volatile("" : "+s"(m_)); return (int)__builtin_amdgcn_mbcnt_hi(m_, __builtin_amdgcn_mbcnt_lo(m_, 0u)); }
#define RETID(F) do { int t2_ = F.tid; asm volatile("" : "+v"(t2_)); F.tid = t2_; F.lane = t2_ & 63; F.wave = __builtin_amdgcn_readfirstlane(t2_ >> 6); } while (0)
#ifndef PROBE_DUP
#define PROBE_DUP -1
#endif
#define NREP(q) ((PROBE_DUP == (q)) ? 2 : 1)
#define AS4 __attribute__((address_space(4)))
#define SITE() Args a; Fr F; { const AS4 Args* ap = (const AS4 Args*)__builtin_amdgcn_kernarg_segment_ptr(); asm volatile("" : "+s"(ap)); \
        _Pragma("unroll") for (int i_ = 0; i_ < 18; ++i_) a.in[i_] = ap->in[i_]; a.out = ap->out; a.ws = ap->ws; a.ph_lo = 0; a.ph_hi = 0; \
        int w_ = wv_s; asm volatile("" : "+s"(w_)); int t_ = w_ * 64 + lane_id_fresh(); asm volatile("" : "+v"(t_)); F.tid = t_; F.lane = t_ & 63; F.wave = __builtin_amdgcn_readfirstlane(t_ >> 6); \
        F.lds = (LAS unsigned char*)lds_raw; F.ws = a.ws; F.ctl = (unsigned*)(a.ws + WS_CTL); F.blk = blockIdx.x; F.G = gridDim.x; }
__global__ void __launch_bounds__(NTHR, 2) mega_fwd(Args a0) {
    extern __shared__ __attribute__((aligned(16))) unsigned char lds_raw[];
    const int wv_s = __builtin_amdgcn_readfirstlane((int)(threadIdx.x >> 6));
#if MK_SINGLE
    constexpr int lo = 0, hi = NPHASE; constexpr bool single = true;
#else
    const int lo = a0.ph_lo, hi = a0.ph_hi; constexpr bool single = false;
#endif
    if (threadIdx.x == 0) *(LAS v4u*)((LAS unsigned char*)lds_raw + LDS_BARW) = (v4u){0u, 0u, 0u, 0u};
    __syncthreads();
    if (single) (void)xcd_barrier_post((unsigned*)(a0.ws + WS_CTL) + CW_BAR, (volatile LAS unsigned*)((LAS unsigned char*)lds_raw + LDS_BARW));
#define IN(k) (lo <= (k) && (k) < hi)
#define SEAM() do { if (single) { const AS4 Args* ap_ = (const AS4 Args*)__builtin_amdgcn_kernarg_segment_ptr(); asm volatile("" : "+s"(ap_)); int w_ = wv_s; asm volatile("" : "+s"(w_)); \
        XcdBarrier b_; b_.bar = (unsigned*)(ap_->ws + WS_CTL) + CW_BAR; b_.x = xb_xcc_id(); b_.st = (volatile LAS unsigned*)((LAS unsigned char*)lds_raw + LDS_BARW); \
        xcd_barrier(b_, (w_ == 0) && (lane_id_fresh() == 0)); } } while (0)
    if (IN(0)) { _Pragma("unroll 1") for (int rep = 0; rep < NREP(100); ++rep) { { SITE(); ph_prologue(a, F); } SEAM(); } }
#pragma clang loop unroll(full)
    for (int L = 0; L < DEPTH; ++L) {
        const int pb = 1 + NPL * L, j = L >> 1; const bool odd = (L & 1) != 0;
        if (IN(pb + 0)) _Pragma("unroll 1") for (int rep = 0; rep < NREP(0); ++rep) {
            { SITE();
            const bf16* w = odd ? (const bf16*)(F.ws + WS_WOD) + (size_t)j * OD_N * 1024 : (const bf16*)(F.ws + WS_WEV) + (size_t)j * EV_N * 1024;
            const int N = odd ? OD_N : EV_N;
            pg8::Gemm g{(const bf16*)(F.ws + WS_XB), w, NTOK, N, 1024}; pg8::StaticOrder S; S.init(NTOK, N, F.G, F.blk);
            pg8::EpiBf16<0> E{(bf16*)(F.ws + WS_PROJ), N, nullptr, 1024, (size_t)1024, C2F};
            pg8::gemm_phase<pg8::EpiBf16<0>, pg8::StaticOrder, true, true>(F.lds, g, S, E, F.tid); }
            SEAM(); }
        if (IN(pb + 1)) _Pragma("unroll 1") for (int rep = 0; rep < NREP(1); ++rep) { { SITE(); if (odd) ph_odd_prep(a, F, j, L); else ph_even_prep(a, F, j); } SEAM(); }
        if (!odd && IN(pb + 2)) _Pragma("unroll 1") for (int rep = 0; rep < ((PROBE_DUP == 2 || (PROBE_DUP >= 21 && PROBE_DUP <= 22) || (PROBE_DUP >= 211 && PROBE_DUP <= 217)) ? 2 : 1); ++rep) {
            { SITE(); unsigned* ctr = F.ctl + CW_Q + 64 * (L * 2) + 1024 * rep;
            for (;;) { const int it = q_next(F, ctr); if (it >= 1280) break; RETID(F);
                if (it < 1024) { if (!(rep == 1 && PROBE_DUP == 22)) idx_unit(F, it & 3, 255 - (it >> 2), (rep == 1 && PROBE_DUP >= 211) ? PROBE_DUP - 210 : 0); } else { if (!(rep == 1 && (PROBE_DUP == 21 || PROBE_DUP >= 211))) moba_gate_chunk(F, it - 1024); } } }
            SEAM(); }
        if (IN(pb + 3)) _Pragma("unroll 1") for (int rep = 0; rep < ((PROBE_DUP == 3 || (PROBE_DUP == 31 && odd) || ((PROBE_DUP >= 32 && PROBE_DUP <= 34) && !odd)) ? 2 : 1); ++rep) {
            { SITE(); unsigned* ctr = F.ctl + CW_Q + 64 * (L * 2 + 1) + 1024 * rep;
            if (odd) { for (;;) { const int it = q_next(F, ctr); if (it >= 2048) break; RETID(F); const int bh = it & 63; fox_unit(F, L, bh >> 4, bh & 15, 31 - (it >> 6)); } }
            else { for (;;) { const int it = q_next(F, ctr); if (it >= 2048) break; RETID(F);
                    if (it < 1024) { const int bh = it & 31; if (!(rep == 1 && (PROBE_DUP == 33 || PROBE_DUP == 34))) moba_unit(a, F, bh >> 3, bh & 7, it >> 5); } else { if (!(rep == 1 && PROBE_DUP == 32)) dsa_chunk(a, F, it - 1024); } } } }
            SEAM(); }
        if (!odd && IN(pb + 4)) _Pragma("unroll 1") for (int rep = 0; rep < NREP(4); ++rep) { { SITE(); ph_even_post(F, j); } SEAM(); }
        if (IN(pb + 5)) _Pragma("unroll 1") for (int rep = 0; rep < NREP(5); ++rep) {
            { SITE();
            pg8::Gemm g{(const bf16*)(F.ws + WS_AO), (const bf16*)(F.ws + WS_WOUT + (size_t)L * 1024 * 1024), NTOK, 1024, 512}; pg8::StaticOrder S; S.init(NTOK, 1024, F.G, F.blk);
            EpiResBf16 E{(const bf16*)(F.ws + WS_XB), (bf16*)(F.ws + WS_YP), ALPHA, 1.f / (F8_SAO * F8_SWO)};
            pg8::gemm_phase<EpiResBf16, pg8::StaticOrder, true, true, true>(F.lds, g, S, E, F.tid); }
            SEAM(); }
        if (IN(pb + 6)) _Pragma("unroll 1") for (int rep = 0; rep < ((PROBE_DUP == 6 || PROBE_DUP == 61) ? 2 : 1); ++rep) { { SITE(); ph_ln1_router(a, F, L, (rep == 1 && PROBE_DUP == 61) ? 1 : 0); } SEAM(); }
        if (IN(pb + 7)) _Pragma("unroll 1") for (int rep = 0; rep < NREP(7); ++rep) { { SITE(); ph_route(F); } SEAM(); }
        if (IN(pb + 8)) _Pragma("unroll 1") for (int rep = 0; rep < NREP(8); ++rep) {
            { SITE(); const int ntl = (int)ld_u32(F.ctl + CW_TILE);
            LAS unsigned* tle = (LAS unsigned*)(F.lds + LDS_TILE_E);
            for (int i = F.tid; i < ntl; i += NTHR) tle[i] = ld_u32(F.ctl + CW_TILE + 64 + i);
            LAS unsigned* srcl = (LAS unsigned*)(F.lds + LDS_SRCL); const unsigned* srcg = (const unsigned*)(F.ws + WS_SRC);
            for (int i = F.tid; i < 17 * 128; i += NTHR) { const int pm = (i >> 7) * 32 + (F.blk & 7) * 4 + (F.blk >> 6); if (pm < ntl) srcl[i] = srcg[(size_t)pm * 128 + (i & 127)]; }
            __syncthreads();
            pg8::Gemm g{(const bf16*)(F.ws + WS_XB8), (const bf16*)(F.ws + WS_WGU + (size_t)L * 32 * 2048 * 1024), NR_MAX, 32 * 2048, 512};
            GroupOrder S{tle, ntl, 3, F.G, F.blk, (LAS const unsigned short*)srcl};
            EpiSwiglu E{F.ws + WS_ACT, a.in[15] + (size_t)L * 32 * 2048};
            pg8::gemm_phase<EpiSwiglu, GroupOrder, true, true, true, true>(F.lds, g, S, E, F.tid); }
            SEAM(); }
        if (IN(pb + 9)) _Pragma("unroll 1") for (int rep = 0; rep < NREP(9); ++rep) {
            { SITE(); const int ntl = (int)ld_u32(F.ctl + CW_TILE);
            LAS unsigned* tle = (LAS unsigned*)(F.lds + LDS_TILE_E);
            for (int i = F.tid; i < ntl; i += NTHR) tle[i] = ld_u32(F.ctl + CW_TILE + 64 + i);
            __syncthreads();
            pg8::Gemm g{(const bf16*)(F.ws + WS_ACT), (const bf16*)(F.ws + WS_WDN + (size_t)L * 32 * 1024 * 1024), NR_MAX, 32 * 1024, 512};
            GroupOrder S{tle, ntl, 2, F.G, F.blk, (LAS const unsigned short*)nullptr};
            EpiDown E{F.ws + WS_XG, a.in[17] + (size_t)L * 32 * 1024};
            pg8::gemm_phase<EpiDown, GroupOrder, true, true, true>(F.lds, g, S, E, F.tid); }
            SEAM(); }
        if (IN(pb + 10)) _Pragma("unroll 1") for (int rep = 0; rep < NREP(10); ++rep) { { SITE(); ph_combine_ln2(a, F, L); } if (L + 1 < DEPTH || rep + 1 < NREP(10)) SEAM(); }
        if (PROBE_DUP == 900 && L + 1 < DEPTH) { _Pragma("unroll 1") for (int xb = 0; xb < 10; ++xb) SEAM(); }
    }
#undef IN
#undef SEAM
}

extern "C" void kernel_launch(void* const* d_in, const int* in_sizes, int n_in, void* d_out, int out_size, void* d_ws, size_t ws_size, hipStream_t stream) {
    static int grid = 0;
    if (grid == 0) {
        if (n_in != 18 || out_size != NTOK * DM || ws_size < WS_END) { fprintf(stderr, "kernel_launch: unexpected shapes (n_in %d, out %d, ws %zu); nothing launched\n", n_in, out_size, ws_size); grid = -1; return; }
        int dev = 0, cus = 0, per_cu = 0;
        if (hipGetDevice(&dev) != hipSuccess || hipDeviceGetAttribute(&cus, hipDeviceAttributeMultiprocessorCount, dev) != hipSuccess) { grid = -1; return; }
        if (hipFuncSetAttribute((const void*)mega_fwd, hipFuncAttributeMaxDynamicSharedMemorySize, LDS_BYTES) != hipSuccess) { fprintf(stderr, "kernel_launch: hipFuncSetAttribute failed\n"); grid = -1; return; }
        if (hipOccupancyMaxActiveBlocksPerMultiprocessor(&per_cu, (const void*)mega_fwd, NTHR, LDS_BYTES) != hipSuccess || per_cu < 1) fprintf(stderr, "kernel_launch: occupancy query reports %d\n", per_cu);
        (void)hipGetLastError();
        if (cus < 256) { fprintf(stderr, "kernel_launch: %d CUs (the gathered gate/up GEMM's unit order assumes the MI355X's 256); nothing launched\n", cus); grid = -1; return; }
        grid = 256;
    }
    if (grid < 0) return;
    (void)hipMemsetAsync((char*)d_ws + WS_CTL, 0, CTL_ZERO_BYTES, stream);
#ifdef EXP_SKIP
    (void)hipMemsetAsync((char*)d_ws + WS_AO, 0, 64 * MiB, stream);
    (void)hipMemsetAsync((char*)d_ws + WS_OL, 0, 64 * MiB, stream);
    if (EXP_SKIP & 4) { (void)hipMemsetAsync((char*)d_ws + WS_XG, 0, 272 * MiB, stream); (void)hipMemsetAsync((char*)d_ws + WS_DEST, 0, 1 * MiB, stream); }
#endif
    Args a{};
    for (int i = 0; i < 18; ++i) a.in[i] = (const float*)d_in[i];
    a.out = (float*)d_out; a.ws = (unsigned char*)d_ws;
#if MK_SINGLE
    a.ph_lo = 0; a.ph_hi = NPHASE;
    hipLaunchKernelGGL(mega_fwd, dim3(grid), dim3(NTHR), LDS_BYTES, stream, a);
#else
    for (int p = 0; p < NPHASE; ++p) {
        if (p > 0) { const int L = (p - 1) / NPL, q = (p - 1) % NPL; if ((L & 1) && (q == 2 || q == 4)) continue;
#ifdef EXP_SKIP
            if ((EXP_SKIP & 1) && !(L & 1) && q <= 4) continue;
            if ((EXP_SKIP & 2) && (L & 1) && q <= 4) continue;
            if ((EXP_SKIP & 4) && q >= 7 && q <= 9) continue;
#endif
        }
        a.ph_lo = p; a.ph_hi = p + 1;
        hipLaunchKernelGGL(mega_fwd, dim3(grid), dim3(NTHR), LDS_BYTES, stream, a);
    }
#endif
}
```
